# Optimizing an MI355X kernel written in HIP

```python
import math
import jax, jax.numpy as jnp
from jax import lax
import numpy as np

D_MODEL = 1024
BATCH = 2
SEQ = 16384
DEPTH = 1

CTX_LEN = 256
GRID_W = 64
DN_HEAD_DIM = 128
DN_HEADS = D_MODEL // DN_HEAD_DIM
DN_DIM = DN_HEADS * DN_HEAD_DIM
SHORT_CONV = 5
CHUNK = 64
HEAD_DIM = 128
ATTN_HEADS = D_MODEL // HEAD_DIM
ATTN_KV_HEADS = ATTN_HEADS // 4
ATTN_GROUPS = ATTN_HEADS // ATTN_KV_HEADS
ATTN_DIM = ATTN_HEADS * HEAD_DIM
KV_DIM = ATTN_KV_HEADS * HEAD_DIM
WINDOW = 128
ATTN_BLOCK = 128
ROPE_BASE = 10000.0
ROPE_FREQS = HEAD_DIM // 4
D_FF = ((8 * D_MODEL // 3 + 127) // 128) * 128
FFN_CONV = 3
RMS_EPS = 1e-6
IN_SIZES = (3 * DN_DIM, DN_DIM, 2 * DN_HEADS, 2 * DN_HEADS, ATTN_DIM, KV_DIM, KV_DIM, 2 * D_MODEL)
IN_DIM = 4 * DN_DIM + 4 * DN_HEADS + ATTN_DIM + 2 * KV_DIM + 2 * D_MODEL

kernel_name = 'hybrid_deltanet_swa_dit_layer'


def rms_norm(x, w):
    xf = x.astype(jnp.float32)
    y = xf * lax.rsqrt(jnp.mean(xf * xf, axis=-1, keepdims=True) + RMS_EPS)
    return y.astype(x.dtype) * w


def l2_normalize(x):
    return x * lax.rsqrt(jnp.sum(x * x, axis=-1, keepdims=True) + RMS_EPS)


def modulate(h, shift, scale):
    return h * (1.0 + scale) + shift


def dwconv_centred(x, w):
    width = w.shape[0]
    r = width // 2
    length = x.shape[1]
    xp = jnp.pad(x, ((0, 0), (r, r), (0, 0)))
    out = xp[:, :length] * w[0]
    for j in range(1, width):
        out = out + xp[:, j:j + length] * w[j]
    return out


def split_in(p):
    cuts = np.cumsum(IN_SIZES)[:-1].tolist()
    return jnp.split(p, cuts, axis=-1)


def rope_tables_2d(rows, dtype):
    row = jnp.broadcast_to(jnp.arange(rows, dtype=jnp.float32)[:, None], (rows, GRID_W)).reshape(-1)
    col = jnp.broadcast_to(jnp.arange(GRID_W, dtype=jnp.float32)[None, :], (rows, GRID_W)).reshape(-1)
    inv_freq = ROPE_BASE ** (-jnp.arange(ROPE_FREQS, dtype=jnp.float32) / ROPE_FREQS)
    ang_r = row[:, None] * inv_freq
    ang_c = col[:, None] * inv_freq
    return (jnp.cos(ang_r).astype(dtype), jnp.sin(ang_r).astype(dtype),
            jnp.cos(ang_c).astype(dtype), jnp.sin(ang_c).astype(dtype))


def rope_1d(x, cos, sin):
    x1, x2 = jnp.split(x, 2, axis=-1)
    cos = cos[None, :, None, :]
    sin = sin[None, :, None, :]
    return jnp.concatenate([x1 * cos - x2 * sin, x2 * cos + x1 * sin], axis=-1)


def rope_2d(x, tables):
    cos_r, sin_r, cos_c, sin_c = tables
    half = HEAD_DIM // 2
    return jnp.concatenate([rope_1d(x[..., :half], cos_r, sin_r),
                            rope_1d(x[..., half:], cos_c, sin_c)], axis=-1)


def dn_prepare(qkv, b, a, conv_w, a_log, dt_bias):
    bsz, length = qkv.shape[:2]
    qkv = jax.nn.silu(dwconv_centred(qkv, conv_w)).astype(jnp.float32)
    q, k, v = jnp.split(qkv, 3, axis=-1)
    q = l2_normalize(q.reshape(bsz, length, DN_HEADS, DN_HEAD_DIM)) * (DN_HEAD_DIM ** -0.5)
    k = l2_normalize(k.reshape(bsz, length, DN_HEADS, DN_HEAD_DIM))
    v = v.reshape(bsz, length, DN_HEADS, DN_HEAD_DIM)
    beta = jax.nn.sigmoid(b.astype(jnp.float32)).reshape(bsz, length, 2, DN_HEADS)
    a = a.astype(jnp.float32).reshape(bsz, length, 2, DN_HEADS)
    g = -jnp.exp(a_log.astype(jnp.float32)) * jax.nn.softplus(a + dt_bias.astype(jnp.float32))
    return q, k, v, g, beta


def gated_delta_chunked(q, k, v, g, beta, s0):
    bsz, length, heads, _ = q.shape
    dv = v.shape[-1]
    n = length // CHUNK

    def to_chunks(t):
        t = t.reshape((bsz, n, CHUNK, heads) + t.shape[3:])
        return jnp.moveaxis(t, (1, 3), (0, 2))

    qc, kc, vc, bc = to_chunks(q), to_chunks(k), to_chunks(v), to_chunks(beta)
    gc = jnp.cumsum(to_chunks(g), axis=-1)
    idx = jnp.arange(CHUNK)
    incl = idx[:, None] >= idx[None, :]
    strict = idx[:, None] > idx[None, :]
    diff = gc[..., :, None] - gc[..., None, :]
    decay = jnp.where(incl, jnp.exp(jnp.where(incl, diff, 0.0)), 0.0)
    kk = jnp.einsum('nbhid,nbhjd->nbhij', kc, kc)
    a_mat = jnp.where(strict, bc[..., :, None] * kk * decay, 0.0)
    rhs = jnp.concatenate([vc * bc[..., None], kc * (bc * jnp.exp(gc))[..., None]], axis=-1)
    sol = lax.linalg.triangular_solve(a_mat, rhs, left_side=True, lower=True, unit_diagonal=True)
    u, w = sol[..., :dv], sol[..., dv:]
    qk = jnp.einsum('nbhid,nbhjd->nbhij', qc, kc) * decay
    qg = qc * jnp.exp(gc)[..., None]
    kd = kc * jnp.exp(gc[..., -1:] - gc)[..., None]
    g_last = jnp.exp(gc[..., -1])

    def step(s, xs):
        u_i, w_i, qg_i, qk_i, kd_i, gl_i = xs
        v_new = u_i - jnp.einsum('bhcd,bhde->bhce', w_i, s)
        o_i = jnp.einsum('bhcd,bhde->bhce', qg_i, s) + jnp.einsum('bhij,bhje->bhie', qk_i, v_new)
        s = s * gl_i[..., None, None] + jnp.einsum('bhcd,bhce->bhde', kd_i, v_new)
        return s, o_i

    s_fin, o = lax.scan(step, s0, (u, w, qg, qk, kd, g_last))
    o = jnp.moveaxis(o, (0, 2), (1, 3)).reshape(bsz, length, heads, dv)
    return o, s_fin


def bidirectional_delta(lat, ctx_side):
    qx, kx, vx, gx, bx = lat
    qc, kc, vc, gc, bc = ctx_side
    s0 = jnp.zeros((qc.shape[0], DN_HEADS, DN_HEAD_DIM, DN_HEAD_DIM), jnp.float32)
    rev = lambda t: jnp.flip(t, axis=1)
    oc_f, sc_f = gated_delta_chunked(qc, kc, vc, gc[:, :, 0], bc[:, :, 0], s0)
    ox_f, _ = gated_delta_chunked(qx, kx, vx, gx[:, :, 0], bx[:, :, 0], sc_f)
    oc_b, sc_b = gated_delta_chunked(rev(qc), rev(kc), rev(vc), rev(gc[:, :, 1]), rev(bc[:, :, 1]), s0)
    ox_b, _ = gated_delta_chunked(rev(qx), rev(kx), rev(vx), rev(gx[:, :, 1]), rev(bx[:, :, 1]), sc_b)
    return ox_f + rev(ox_b), oc_f + rev(oc_b)


def gated_head_norm(o, gate, w):
    bsz, length = o.shape[:2]
    y = rms_norm(o, w) * jax.nn.silu(gate.reshape(bsz, length, DN_HEADS, DN_HEAD_DIM).astype(jnp.float32))
    return y.reshape(bsz, length, DN_DIM).astype(gate.dtype)


def attn_heads(q, k, v, q_norm, k_norm):
    bsz, length = q.shape[:2]
    q = rms_norm(q.reshape(bsz, length, ATTN_HEADS, HEAD_DIM), q_norm)
    k = rms_norm(k.reshape(bsz, length, ATTN_KV_HEADS, HEAD_DIM), k_norm)
    v = v.reshape(bsz, length, ATTN_KV_HEADS, HEAD_DIM)
    return q, k, v


def window_attention_latent(q, k, v, k_ctx, v_ctx, sink):
    bsz, length = q.shape[:2]
    n_ctx = k_ctx.shape[1]
    nb = length // ATTN_BLOCK
    band = 3 * ATTN_BLOCK
    scale = HEAD_DIM ** -0.5
    pad = ((0, 0), (ATTN_BLOCK, ATTN_BLOCK), (0, 0), (0, 0))
    kp = jnp.pad(k, pad)
    vp = jnp.pad(v, pad)
    qb = jnp.moveaxis(q.reshape(bsz, nb, ATTN_BLOCK, ATTN_KV_HEADS, ATTN_GROUPS, HEAD_DIM), 1, 0)
    sink_l = jnp.broadcast_to(sink.astype(jnp.float32).reshape(1, ATTN_KV_HEADS, ATTN_GROUPS, 1, 1),
                              (bsz, ATTN_KV_HEADS, ATTN_GROUPS, ATTN_BLOCK, 1))

    def block(args):
        i, q_i = args
        start = i * ATTN_BLOCK
        k_i = lax.dynamic_slice_in_dim(kp, start, band, axis=1)
        v_i = lax.dynamic_slice_in_dim(vp, start, band, axis=1)
        qpos = start + jnp.arange(ATTN_BLOCK)
        kpos = start - ATTN_BLOCK + jnp.arange(band)
        ok = (jnp.abs(qpos[:, None] - kpos[None, :]) <= WINDOW) & (kpos[None, :] >= 0) & (kpos[None, :] < length)
        s_win = jnp.einsum('bqkgd,bskd->bkgqs', q_i, k_i).astype(jnp.float32) * scale
        s_win = jnp.where(ok, s_win, -jnp.inf)
        s_ctx = jnp.einsum('bqkgd,bskd->bkgqs', q_i, k_ctx).astype(jnp.float32) * scale
        p = jax.nn.softmax(jnp.concatenate([s_win, s_ctx, sink_l], axis=-1), axis=-1).astype(v.dtype)
        return (jnp.einsum('bkgqs,bskd->bqkgd', p[..., :band], v_i)
                + jnp.einsum('bkgqs,bskd->bqkgd', p[..., band:band + n_ctx], v_ctx))

    o = lax.map(block, (jnp.arange(nb), qb))
    return jnp.moveaxis(o, 0, 1).reshape(bsz, length, ATTN_DIM)


def context_attention(q, k, v, sink):
    bsz, n_ctx = q.shape[:2]
    qg = q.reshape(bsz, n_ctx, ATTN_KV_HEADS, ATTN_GROUPS, HEAD_DIM)
    s = jnp.einsum('bqkgd,bskd->bkgqs', qg, k).astype(jnp.float32) * (HEAD_DIM ** -0.5)
    sink_c = jnp.broadcast_to(sink.astype(jnp.float32).reshape(1, ATTN_KV_HEADS, ATTN_GROUPS, 1, 1),
                              (bsz, ATTN_KV_HEADS, ATTN_GROUPS, n_ctx, 1))
    p = jax.nn.softmax(jnp.concatenate([s, sink_c], axis=-1), axis=-1).astype(v.dtype)
    o = jnp.einsum('bkgqs,bskd->bqkgd', p[..., :n_ctx], v)
    return o.reshape(bsz, n_ctx, ATTN_DIM)


def merge_branches(y_dn, y_at, gates, w_branch_dn, w_branch_attn, w_out):
    g_dn, g_at = jnp.split(gates, 2, axis=-1)
    merged = jax.nn.sigmoid(g_dn) * (y_dn @ w_branch_dn) + jax.nn.sigmoid(g_at) * (y_at @ w_branch_attn)
    return merged @ w_out


def conv_ffn(h, up, conv_w, conv_b, down):
    u = dwconv_centred(h @ up, conv_w) + conv_b
    u_gate, u_val = jnp.split(u, 2, axis=-1)
    return (jax.nn.silu(u_gate) * u_val) @ down


def hybrid_layer(x, ctx, c, c_ctx, rope, w_ada, b_ada, norm_mix, norm_ffn, w_in, dn_conv, dn_a_log,
                 dn_dt_bias, dn_norm, q_norm, k_norm, attn_sink, w_branch_dn, w_branch_attn, w_out,
                 ffn_up, ffn_conv, ffn_conv_b, ffn_down, update_ctx):
    mod_x = (jax.nn.silu(c) @ w_ada + b_ada)[:, None, :]
    mod_c = (jax.nn.silu(c_ctx) @ w_ada + b_ada)[None, None, :]
    sh_a_x, sc_a_x, g_a_x, sh_f_x, sc_f_x, g_f_x = jnp.split(mod_x, 6, axis=-1)
    sh_a_c, sc_a_c, g_a_c, sh_f_c, sc_f_c, g_f_c = jnp.split(mod_c, 6, axis=-1)

    p_x = modulate(rms_norm(x, norm_mix), sh_a_x, sc_a_x) @ w_in
    p_c = modulate(rms_norm(ctx, norm_mix), sh_a_c, sc_a_c) @ w_in
    qkv_dn_x, gt_dn_x, b_dn_x, a_dn_x, q_at_x, k_at_x, v_at_x, mg_x = split_in(p_x)
    qkv_dn_c, gt_dn_c, b_dn_c, a_dn_c, q_at_c, k_at_c, v_at_c, mg_c = split_in(p_c)

    dn_x = dn_prepare(qkv_dn_x, b_dn_x, a_dn_x, dn_conv, dn_a_log, dn_dt_bias)
    dn_c = dn_prepare(qkv_dn_c, b_dn_c, a_dn_c, dn_conv, dn_a_log, dn_dt_bias)
    o_dn_x, o_dn_c = bidirectional_delta(dn_x, dn_c)
    y_dn_x = gated_head_norm(o_dn_x, gt_dn_x, dn_norm)

    qx, kx, vx = attn_heads(q_at_x, k_at_x, v_at_x, q_norm, k_norm)
    qc, kc, vc = attn_heads(q_at_c, k_at_c, v_at_c, q_norm, k_norm)
    qx = rope_2d(qx, rope)
    kx = rope_2d(kx, rope)
    y_at_x = window_attention_latent(qx, kx, vx, kc, vc, attn_sink)

    x = x + g_a_x * merge_branches(y_dn_x, y_at_x, mg_x, w_branch_dn, w_branch_attn, w_out)
    x = x + g_f_x * conv_ffn(modulate(rms_norm(x, norm_ffn), sh_f_x, sc_f_x), ffn_up, ffn_conv, ffn_conv_b, ffn_down)

    if update_ctx:
        y_dn_c = gated_head_norm(o_dn_c, gt_dn_c, dn_norm)
        y_at_c = context_attention(qc, kc, vc, attn_sink)
        ctx = ctx + g_a_c * merge_branches(y_dn_c, y_at_c, mg_c, w_branch_dn, w_branch_attn, w_out)
        ctx = ctx + g_f_c * conv_ffn(modulate(rms_norm(ctx, norm_ffn), sh_f_c, sc_f_c), ffn_up, ffn_conv, ffn_conv_b, ffn_down)
    return x, ctx


def setup_inputs(seed: int = 0) -> dict:
    key = jax.random.key(seed)
    ks = jax.random.split(key, 24)

    def nrm(k, shape, s):
        return jax.random.normal(k, shape, jnp.float32) * s

    x = nrm(ks[0], (BATCH, SEQ, D_MODEL), 1.0)
    c = nrm(ks[1], (BATCH, D_MODEL), 1.0)
    ctx = nrm(ks[2], (BATCH, CTX_LEN, D_MODEL), 1.0)
    c_ctx = nrm(ks[3], (D_MODEL,), 1.0)
    w_ada = nrm(ks[4], (DEPTH, D_MODEL, 6 * D_MODEL), 0.5 * D_MODEL ** -0.5)
    b_ada = nrm(ks[5], (DEPTH, 6 * D_MODEL), 0.02)
    norm_mix = 1.0 + nrm(ks[6], (DEPTH, D_MODEL), 0.1)
    norm_ffn = 1.0 + nrm(ks[7], (DEPTH, D_MODEL), 0.1)
    w_in = nrm(ks[8], (DEPTH, D_MODEL, IN_DIM), D_MODEL ** -0.5)
    dn_conv = nrm(ks[9], (DEPTH, SHORT_CONV, 3 * DN_DIM), SHORT_CONV ** -0.5)
    dn_a_log = jnp.log(jax.random.uniform(ks[10], (DEPTH, 2, DN_HEADS), jnp.float32, minval=1.0, maxval=16.0))
    dt = jnp.exp(jax.random.uniform(ks[11], (DEPTH, 2, DN_HEADS), jnp.float32,
                                    minval=math.log(1e-3), maxval=math.log(1e-1)))
    dn_dt_bias = dt + jnp.log(-jnp.expm1(-dt))
    dn_norm = 1.0 + nrm(ks[12], (DEPTH, DN_HEAD_DIM), 0.1)
    q_norm = 1.0 + nrm(ks[13], (DEPTH, HEAD_DIM), 0.1)
    k_norm = 1.0 + nrm(ks[14], (DEPTH, HEAD_DIM), 0.1)
    attn_sink = nrm(ks[15], (DEPTH, ATTN_HEADS), 0.5)
    w_branch_dn = nrm(ks[16], (DEPTH, DN_DIM, D_MODEL), DN_DIM ** -0.5)
    w_branch_attn = nrm(ks[17], (DEPTH, ATTN_DIM, D_MODEL), ATTN_DIM ** -0.5)
    w_out = nrm(ks[18], (DEPTH, D_MODEL, D_MODEL), D_MODEL ** -0.5)
    ffn_up = nrm(ks[19], (DEPTH, D_MODEL, 2 * D_FF), D_MODEL ** -0.5)
    ffn_conv = nrm(ks[20], (DEPTH, FFN_CONV, 2 * D_FF), FFN_CONV ** -0.5)
    ffn_conv_b = nrm(ks[21], (DEPTH, 2 * D_FF), 0.02)
    ffn_down = nrm(ks[22], (DEPTH, D_FF, D_MODEL), D_FF ** -0.5)
    return {'x': x, 'c': c, 'ctx': ctx, 'c_ctx': c_ctx, 'w_ada': w_ada, 'b_ada': b_ada,
            'norm_mix': norm_mix, 'norm_ffn': norm_ffn, 'w_in': w_in, 'dn_conv': dn_conv,
            'dn_a_log': dn_a_log, 'dn_dt_bias': dn_dt_bias, 'dn_norm': dn_norm, 'q_norm': q_norm,
            'k_norm': k_norm, 'attn_sink': attn_sink, 'w_branch_dn': w_branch_dn,
            'w_branch_attn': w_branch_attn, 'w_out': w_out, 'ffn_up': ffn_up, 'ffn_conv': ffn_conv,
            'ffn_conv_b': ffn_conv_b, 'ffn_down': ffn_down}


def reference(x, c, ctx, c_ctx, w_ada, b_ada, norm_mix, norm_ffn, w_in, dn_conv, dn_a_log, dn_dt_bias,
              dn_norm, q_norm, k_norm, attn_sink, w_branch_dn, w_branch_attn, w_out, ffn_up, ffn_conv,
              ffn_conv_b, ffn_down):
    rows = x.shape[1] // GRID_W
    rope = rope_tables_2d(rows, x.dtype)
    for layer in range(DEPTH):
        x, ctx = hybrid_layer(x, ctx, c, c_ctx, rope, w_ada[layer], b_ada[layer], norm_mix[layer],
                              norm_ffn[layer], w_in[layer], dn_conv[layer], dn_a_log[layer],
                              dn_dt_bias[layer], dn_norm[layer], q_norm[layer], k_norm[layer],
                              attn_sink[layer], w_branch_dn[layer], w_branch_attn[layer], w_out[layer],
                              ffn_up[layer], ffn_conv[layer], ffn_conv_b[layer], ffn_down[layer],
                              update_ctx=layer + 1 < DEPTH)
    return x
```

```cpp
#include <hip/hip_runtime.h>
#include <hip/hip_cooperative_groups.h>
#include <cstdio>
#include <cstdint>
namespace cg = cooperative_groups;

#ifndef MK_ONE_LAUNCH
#define MK_ONE_LAUNCH 1
#endif

#define DEVI __device__ __forceinline__
#define LAS __attribute__((address_space(3)))
typedef unsigned short bf16_t;
typedef short bf16x8 __attribute__((ext_vector_type(8)));
typedef float f32x4 __attribute__((ext_vector_type(4)));
typedef float f32x2 __attribute__((ext_vector_type(2)));
typedef float f32x16 __attribute__((ext_vector_type(16)));
typedef unsigned u32x4 __attribute__((ext_vector_type(4)));
typedef unsigned u32x2 __attribute__((ext_vector_type(2)));
typedef short s16x4 __attribute__((ext_vector_type(4)));

constexpr int BATCH = 2, SEQ = 16384, DM = 1024, CTX = 256;
constexpr int ML = BATCH * SEQ;
constexpr int MC = BATCH * CTX;
constexpr int MT = ML + MC;
constexpr int NA = 3328;
constexpr int NC = 4608;
constexpr int NSH = NA + NC;
constexpr int DFF = 2816, NUP = 5632;
constexpr float EPS = 1e-6f;

constexpr size_t MiB = 1u << 20;
constexpr size_t WS_CTL = 0, CTL_ZERO_BYTES = 1 * MiB;
constexpr size_t CTL_MODACC = 64 * 1024;
constexpr size_t CTL_ROWSS2 = 256 * 1024;
constexpr size_t WS_SMALL = 1 * MiB;
constexpr size_t SM_ROWSS1 = WS_SMALL;
constexpr size_t SM_SHWA = WS_SMALL + 256 * 1024;
constexpr size_t SM_SHWF = WS_SMALL + 384 * 1024;
constexpr size_t SM_ROPE = WS_SMALL + 512 * 1024;
constexpr size_t WS_BA = 2 * MiB;
constexpr size_t WS_G = 7 * MiB;
constexpr size_t WS_BETA = 10 * MiB;
constexpr size_t WS_WINA = 13 * MiB, WS_WINC = 20 * MiB, WS_WBR = 29 * MiB, WS_WOUT = 33 * MiB, WS_WUP = 35 * MiB, WS_WDN = 46 * MiB;
constexpr size_t WS_XN = 52 * MiB;
constexpr size_t WS_QKVR = 117 * MiB;
constexpr size_t WS_QKVP = 312 * MiB;
constexpr size_t WS_MG = 180 * MiB;
constexpr size_t WS_GT = 310 * MiB;
constexpr size_t WS_QAT = 375 * MiB;
constexpr size_t WS_KAT = 440 * MiB;
constexpr size_t WS_VAT = 457 * MiB;
constexpr size_t WS_Y = 52 * MiB;
constexpr size_t WS_MERGED = 375 * MiB;
constexpr size_t WS_X1S = 440 * MiB;
constexpr size_t WS_U = 52 * MiB;
constexpr size_t WS_ACT = 228 * MiB;
constexpr size_t WS_END = 512 * MiB;

constexpr int LDS_BYTES = 147456;

DEVI float bf2f(unsigned short h) { return __uint_as_float((unsigned)h << 16); }
DEVI float bflo(unsigned w) { return __uint_as_float(w << 16); }
DEVI float bfhi(unsigned w) { return __uint_as_float(w & 0xffff0000u); }
DEVI unsigned f2bf(float f) { unsigned u = __float_as_uint(f); return (u + 0x7fffu + ((u >> 16) & 1u)) >> 16; }
DEVI unsigned pk2(float lo, float hi) { return f2bf(lo) | (f2bf(hi) << 16); }
DEVI float wave_sum(float v) {
#pragma unroll
    for (int o = 1; o < 64; o <<= 1) v += __shfl_xor(v, o);
    return v;
}
DEVI float siluf(float x) { return x / (1.f + __expf(-x)); }
DEVI float sigmoidf_(float x) { return 1.f / (1.f + __expf(-x)); }

struct Args { const float* in[23]; float* out; unsigned char* ws; int ph_lo, ph_hi; };

namespace pg8 {
constexpr int BM = 256, BK = 64, HALF = 128, HTB = HALF * BK * 2, STAGE_BYTES = 8 * HTB, NXCD = 8, WGM = 8;
__host__ __device__ __forceinline__ int lds_byte(int r, int c) { const int st = (r >> 4) * 2 + (c >> 5), rr = r & 15, cc = c & 31, ob = rr * 64 + cc * 2; return st * 1024 + (ob ^ (((ob >> 9) & 1) << 5)); }
__host__ __device__ __forceinline__ void stage_rc(int b, int& R, int& C) { const int st = b / 1024, sb = b % 1024, swz = sb ^ (((sb >> 9) & 1) << 5); R = (st >> 1) * 16 + swz / 64; C = (st & 1) * 32 + (swz % 64) / 2; }
__host__ __device__ __forceinline__ int perm32(int rho) { const int n = rho >> 4, i = rho & 15; return 8 * (i >> 2) + 4 * n + (i & 3); }
struct Unit { int pm, pn; };
struct Gemm { const bf16_t* A; const bf16_t* Bt; int M, N, K; };
struct StaticOrder {
    int nM, nN, nwg, G, c;
    __device__ void init(int M, int N, int G_, int c_) { nM = M / BM; nN = N / BM; nwg = nM * nN; G = G_; c = c_; }
    __device__ bool next(int i, Unit& u) const {
        const long L = (long)i * G + c; if (L >= nwg) return false;
        int wgid = (int)L; { const int q = nwg / NXCD, r = nwg % NXCD, xcd = wgid % NXCD, off = wgid / NXCD; wgid = (xcd < r ? xcd * (q + 1) : r * (q + 1) + (xcd - r) * q) + off; }
        const int nig = WGM * nN, gid = wgid / nig, fm = gid * WGM, gsz = (nM - fm) < WGM ? (nM - fm) : WGM;
        u.pm = fm + ((wgid % nig) % gsz); u.pn = (wgid % nig) / gsz; return true;
    }
};
template <class Epi, class Sched, bool ALIGN_EPI, bool SP2>
__device__ __forceinline__ void gemm_phase(LAS unsigned char* lds, const Gemm g, const Sched& S, const Epi& E) {
    const int tid = threadIdx.x, wid = __builtin_amdgcn_readfirstlane(tid >> 6), lane = tid & 63, wr = wid >> 2, wc = wid & 3, fr = lane & 15, fq = lane >> 4;
    const int K = g.K, nt = K / BK;
    unsigned voffA[2], voffB[2];
#pragma unroll
    for (int i = 0; i < 2; ++i) { int R, C; stage_rc(tid * 16 + i * 8192, R, C); const int Rb = Epi::PERM ? ((R & ~31) + perm32(R & 31)) : R;
        voffA[i] = (unsigned)(R * K + C) * 2u; voffB[i] = (unsigned)(Rb * K + C) * 2u; }
    const size_t kstep = (size_t)(BK * 2);
    const size_t hstep = (size_t)HALF * K * 2;
    const size_t tstep = 2 * hstep;
    const unsigned ldsw = (unsigned)wid * 1024u;
    const int aoff = lds_byte(wr * 64 + fr, fq * 8), boff = lds_byte(wc * 32 + fr, fq * 8);
#define PG8_SA(b, h) (((b) * 2 + (h)) * HTB)
#define PG8_SB(b, h) ((4 + (b) * 2 + (h)) * HTB)
#define PG8_STAGE(bufoff, gbase, voff) do { _Pragma("unroll") for (int _i = 0; _i < 2; ++_i) \
        __builtin_amdgcn_global_load_lds((const unsigned*)((const char*)(gbase) + (voff)[_i]), (LAS unsigned*)(lds + (bufoff) + ldsw + _i * 8192), 16, 0, 0); } while (0)
#define PG8_LDA(dst, b, h) do { _Pragma("unroll") for (int m = 0; m < 4; ++m) _Pragma("unroll") for (int k = 0; k < 2; ++k) dst[m][k] = *(const LAS bf16x8*)(lds + PG8_SA(b, h) + aoff + m * 2048 + k * 1024); } while (0)
#define PG8_LDB(dst, b, h) do { _Pragma("unroll") for (int n = 0; n < 2; ++n) _Pragma("unroll") for (int k = 0; k < 2; ++k) dst[n][k] = *(const LAS bf16x8*)(lds + PG8_SB(b, h) + boff + n * 2048 + k * 1024); } while (0)
#define PG8_MMA(ai, bj, At, Bt) do { __builtin_amdgcn_s_setprio(1); _Pragma("unroll") for (int m = 0; m < 4; ++m) _Pragma("unroll") for (int n = 0; n < 2; ++n) _Pragma("unroll") for (int k = 0; k < 2; ++k) \
        acc[ai][bj][m][n] = __builtin_amdgcn_mfma_f32_16x16x32_bf16(Bt[n][k], At[m][k], acc[ai][bj][m][n], 0, 0, 0); __builtin_amdgcn_s_setprio(0); } while (0)
#define PG8_WAIT_V(n) asm volatile("s_waitcnt vmcnt(" #n ")" ::: "memory")
#define PG8_WAIT_L(n) asm volatile("s_waitcnt lgkmcnt(" #n ")" ::: "memory")
#define PG8_BAR __builtin_amdgcn_s_barrier()
#define PG8_SCHED __builtin_amdgcn_sched_barrier(0)
    Unit cur, nxt; int ui = 0;
    if (!S.next(0, cur)) return;
    f32x4 acc[2][2][4][2];
#pragma unroll
    for (int a = 0; a < 2; ++a)
#pragma unroll
        for (int b = 0; b < 2; ++b)
#pragma unroll
            for (int m = 0; m < 4; ++m)
#pragma unroll
                for (int n = 0; n < 2; ++n) acc[a][b][m][n] = (f32x4){0.f, 0.f, 0.f, 0.f};
    bf16x8 At[4][2], B0[2][2], B1[2][2];
    const char* cA = (const char*)g.A + (size_t)cur.pm * tstep; const char* cB = (const char*)g.Bt + (size_t)cur.pn * tstep;
    if constexpr (SP2) {
        PG8_STAGE(PG8_SB(0, 0), cB, voffB); PG8_STAGE(PG8_SB(0, 1), cB + hstep, voffB); PG8_STAGE(PG8_SA(0, 0), cA, voffA); PG8_STAGE(PG8_SA(0, 1), cA + hstep, voffA);
        if (wr == 1) PG8_BAR;
        PG8_WAIT_V(2); PG8_BAR;
        PG8_STAGE(PG8_SB(1, 0), cB + kstep, voffB); PG8_STAGE(PG8_SA(1, 0), cA + kstep, voffA); PG8_STAGE(PG8_SB(1, 1), cB + hstep + kstep, voffB);
        PG8_WAIT_V(6); PG8_BAR;
    } else {
        PG8_STAGE(PG8_SB(0, 0), cB, voffB); PG8_STAGE(PG8_SA(0, 0), cA, voffA); PG8_STAGE(PG8_SB(0, 1), cB + hstep, voffB); PG8_STAGE(PG8_SA(0, 1), cA + hstep, voffA);
        if (wr == 1) PG8_BAR;
        PG8_WAIT_V(4); PG8_BAR;
        PG8_STAGE(PG8_SB(1, 0), cB + kstep, voffB); PG8_STAGE(PG8_SA(1, 0), cA + kstep, voffA); PG8_STAGE(PG8_SB(1, 1), cB + hstep + kstep, voffB);
        PG8_WAIT_V(6); PG8_BAR;
    }
    for (;;) {
        const bool has_next = S.next(ui + 1, nxt);
        const char* nA = has_next ? (const char*)g.A + (size_t)nxt.pm * tstep : cA; const char* nB = has_next ? (const char*)g.Bt + (size_t)nxt.pn * tstep : cB;
#pragma unroll 1
        for (int t = 0; t < nt; t += 2) {
            const bool last = (t == nt - 2);
            if constexpr (Epi::MID) { if (t == nt / 2) E.mid(acc, cur, wr, wc, fr, fq); }
            const char* a1 = cA + (size_t)(t + 1) * kstep;
            const char* a2 = last ? nA : cA + (size_t)(t + 2) * kstep; const char* b2 = last ? nB : cB + (size_t)(t + 2) * kstep;
            const char* a3 = a2 + kstep; const char* b3 = b2 + kstep;
            if constexpr (SP2) {
            PG8_LDB(B0, 0, 0); PG8_LDB(B1, 0, 1); PG8_SCHED; PG8_LDA(At, 0, 0); PG8_STAGE(PG8_SA(1, 1), a1 + hstep, voffA);
            PG8_WAIT_V(8); PG8_WAIT_L(0); PG8_BAR; PG8_MMA(0, 0, At, B0); PG8_MMA(0, 1, At, B1); PG8_BAR; PG8_SCHED;
            PG8_LDA(At, 0, 1); PG8_STAGE(PG8_SB(0, 0), b2, voffB); PG8_STAGE(PG8_SB(0, 1), b2 + hstep, voffB); PG8_STAGE(PG8_SA(0, 0), a2, voffA);
            PG8_WAIT_V(8); PG8_WAIT_L(0); PG8_BAR; PG8_MMA(1, 0, At, B0); PG8_MMA(1, 1, At, B1); PG8_BAR; PG8_SCHED;
            PG8_LDB(B0, 1, 0); PG8_LDB(B1, 1, 1); PG8_SCHED; PG8_LDA(At, 1, 0); PG8_STAGE(PG8_SA(0, 1), a2 + hstep, voffA);
            PG8_WAIT_V(8); PG8_WAIT_L(0); PG8_BAR; PG8_MMA(0, 0, At, B0); PG8_MMA(0, 1, At, B1); PG8_BAR; PG8_SCHED;
            PG8_LDA(At, 1, 1); PG8_STAGE(PG8_SB(1, 0), b3, voffB); PG8_STAGE(PG8_SB(1, 1), b3 + hstep, voffB); PG8_STAGE(PG8_SA(1, 0), a3, voffA);
            PG8_WAIT_V(8); PG8_WAIT_L(0); PG8_BAR; PG8_MMA(1, 0, At, B0); PG8_MMA(1, 1, At, B1); PG8_BAR; PG8_SCHED;
            } else {
            PG8_LDB(B0, 0, 0); PG8_SCHED; PG8_LDA(At, 0, 0); PG8_STAGE(PG8_SA(1, 1), a1 + hstep, voffA);
            PG8_WAIT_L(8); PG8_BAR; PG8_WAIT_L(0); PG8_MMA(0, 0, At, B0); PG8_BAR; PG8_SCHED;
            PG8_LDB(B1, 0, 1); PG8_STAGE(PG8_SB(0, 0), b2, voffB);
            PG8_BAR; PG8_WAIT_L(0); PG8_MMA(0, 1, At, B1); PG8_BAR;
            PG8_LDA(At, 0, 1); PG8_STAGE(PG8_SA(0, 0), a2, voffA);
            PG8_BAR; PG8_WAIT_L(0); PG8_MMA(1, 0, At, B0); PG8_BAR; PG8_SCHED;
            PG8_STAGE(PG8_SB(0, 1), b2 + hstep, voffB);
            PG8_WAIT_V(6); PG8_BAR; PG8_MMA(1, 1, At, B1); PG8_BAR;
            PG8_LDB(B0, 1, 0); PG8_SCHED; PG8_LDA(At, 1, 0); PG8_STAGE(PG8_SA(0, 1), a2 + hstep, voffA);
            PG8_WAIT_L(8); PG8_BAR; PG8_WAIT_L(0); PG8_MMA(0, 0, At, B0); PG8_BAR; PG8_SCHED;
            PG8_LDB(B1, 1, 1); PG8_STAGE(PG8_SB(1, 0), b3, voffB);
            PG8_BAR; PG8_WAIT_L(0); PG8_MMA(0, 1, At, B1); PG8_BAR;
            PG8_LDA(At, 1, 1); PG8_STAGE(PG8_SA(1, 0), a3, voffA);
            PG8_BAR; PG8_WAIT_L(0); PG8_MMA(1, 0, At, B0); PG8_BAR; PG8_SCHED;
            PG8_STAGE(PG8_SB(1, 1), b3 + hstep, voffB);
            PG8_WAIT_V(6); PG8_BAR; PG8_MMA(1, 1, At, B1); PG8_BAR;
            }
        }
        if constexpr (ALIGN_EPI) { if (wr == 0) PG8_BAR; }
        E(acc, cur, wr, wc, fr, fq);
        if (!has_next) break;
#pragma unroll
        for (int a = 0; a < 2; ++a)
#pragma unroll
            for (int b = 0; b < 2; ++b)
#pragma unroll
                for (int m = 0; m < 4; ++m)
#pragma unroll
                    for (int n = 0; n < 2; ++n) acc[a][b][m][n] = (f32x4){0.f, 0.f, 0.f, 0.f};
        cur = nxt; cA = nA; cB = nB; ++ui;
        if constexpr (ALIGN_EPI) { if (wr == 1) PG8_BAR; }
    }
    PG8_WAIT_V(0);
    if constexpr (!ALIGN_EPI) { if (wr == 0) PG8_BAR; }
    PG8_BAR;
#undef PG8_SA
#undef PG8_SB
#undef PG8_STAGE
#undef PG8_LDA
#undef PG8_LDB
#undef PG8_MMA
#undef PG8_WAIT_V
#undef PG8_WAIT_L
#undef PG8_BAR
#undef PG8_SCHED
}
}
using pg8::HALF;

DEVI u32x4 pack8(const f32x4& a, const f32x4& b) { u32x4 w; w.x = pk2(a[0], a[1]); w.y = pk2(a[2], a[3]); w.z = pk2(b[0], b[1]); w.w = pk2(b[2], b[3]); return w; }

struct EpiIn {
    static constexpr bool PERM = true, MID = false;
    const float* rowss; const float* shW; int job;
    bf16_t *d0, *d1, *d2, *d3, *d4; float* ba;
    DEVI void operator()(const f32x4 (&acc)[2][2][4][2], const pg8::Unit& u, int wr, int wc, int fr, int fq) const {
        asm volatile("" : "+v"(fr), "+v"(fq));
        const int vs = u.pm < 64 ? 0 : (u.pm < 128 ? 1 : 2);
        bf16_t* base; int pitch, colt; bool isba = false;
        if (job == 0) { base = d0; pitch = 3072; colt = u.pn * 256; if (u.pn >= 12) isba = true; }
        else {
            if (u.pn < 4) { base = d0; pitch = 1024; colt = u.pn * 256; }
            else if (u.pn < 8) { base = d1; pitch = 1024; colt = (u.pn - 4) * 256; }
            else if (u.pn == 8) { base = d2; pitch = 256; colt = 0; }
            else if (u.pn == 9) { base = d3; pitch = 256; colt = 0; }
            else { base = d4; pitch = 2048; colt = (u.pn - 10) * 256; }
        }
        const int ncol0 = u.pn * 256 + wc * 32 + 8 * fq;
        f32x4 sv[2][2];
#pragma unroll
        for (int bj = 0; bj < 2; ++bj)
#pragma unroll
            for (int n = 0; n < 2; ++n) sv[bj][n] = *(const f32x4*)(shW + vs * NSH + ncol0 + bj * HALF + 4 * n);
        const int row0 = u.pm * 256 + wr * 64 + fr;
#pragma unroll
        for (int ai = 0; ai < 2; ++ai)
#pragma unroll
            for (int m = 0; m < 4; ++m) {
                const int row = row0 + ai * HALF + m * 16;
                const float rs = rsqrtf(rowss[row] * (1.f / 1024.f) + EPS);
                if (!isba) {
                    bf16_t* rowp = base + (size_t)row * pitch + colt + wc * 32 + 8 * fq;
#pragma unroll
                    for (int bj = 0; bj < 2; ++bj) { const f32x4 v0 = acc[ai][bj][m][0] * rs + sv[bj][0], v1 = acc[ai][bj][m][1] * rs + sv[bj][1]; *(u32x4*)(rowp + bj * HALF) = pack8(v0, v1); }
                } else if (wc == 0) {
                    float* rowp = ba + (size_t)row * 32 + 8 * fq;
                    *(f32x4*)(rowp) = acc[ai][0][m][0] * rs + sv[0][0]; *(f32x4*)(rowp + 4) = acc[ai][0][m][1] * rs + sv[0][1];
                }
            }
    }
};
struct EpiBr {
    static constexpr bool PERM = true, MID = true;
    const bf16_t* mg; bf16_t* out;
    DEVI void mid(f32x4 (&acc)[2][2][4][2], const pg8::Unit& u, int wr, int wc, int fr, int fq) const {
        asm volatile("" : "+v"(fr), "+v"(fq));
        const int row0 = u.pm * 256 + wr * 64 + fr, col0 = u.pn * 256 + wc * 32 + 8 * fq;
#pragma unroll
        for (int ai = 0; ai < 2; ++ai)
#pragma unroll
            for (int m = 0; m < 4; ++m) {
                const bf16_t* rp = mg + (size_t)(row0 + ai * HALF + m * 16) * 2048 + col0;
#pragma unroll
                for (int bj = 0; bj < 2; ++bj) {
                    const u32x4 gd = *(const u32x4*)(rp + bj * HALF), ga = *(const u32x4*)(rp + 1024 + bj * HALF);
                    float r[8];
#pragma unroll
                    for (int i = 0; i < 4; ++i) {
                        const float d0 = bflo(gd[i]), d1 = bfhi(gd[i]), a0 = bflo(ga[i]), a1 = bfhi(ga[i]);
                        r[2 * i] = (1.f + __expf(fminf(-a0, 80.f))) * __builtin_amdgcn_rcpf(1.f + __expf(fminf(-d0, 80.f)));
                        r[2 * i + 1] = (1.f + __expf(fminf(-a1, 80.f))) * __builtin_amdgcn_rcpf(1.f + __expf(fminf(-d1, 80.f)));
                    }
                    acc[ai][bj][m][0] *= (f32x4){r[0], r[1], r[2], r[3]}; acc[ai][bj][m][1] *= (f32x4){r[4], r[5], r[6], r[7]};
                    asm volatile("" ::: "memory");
                }
            }
    }
    DEVI void operator()(const f32x4 (&acc)[2][2][4][2], const pg8::Unit& u, int wr, int wc, int fr, int fq) const {
        asm volatile("" : "+v"(fr), "+v"(fq));
        const int row0 = u.pm * 256 + wr * 64 + fr, col0 = u.pn * 256 + wc * 32 + 8 * fq;
#pragma unroll
        for (int ai = 0; ai < 2; ++ai)
#pragma unroll
            for (int m = 0; m < 4; ++m) {
                const size_t row = (size_t)(row0 + ai * HALF + m * 16);
                const bf16_t* rp = mg + row * 2048 + 1024 + col0;
#pragma unroll
                for (int bj = 0; bj < 2; ++bj) {
                    const u32x4 ga = *(const u32x4*)(rp + bj * HALF);
                    float s[8];
#pragma unroll
                    for (int i = 0; i < 4; ++i) { s[2 * i] = __builtin_amdgcn_rcpf(1.f + __expf(fminf(-bflo(ga[i]), 80.f))); s[2 * i + 1] = __builtin_amdgcn_rcpf(1.f + __expf(fminf(-bfhi(ga[i]), 80.f))); }
                    const f32x4 v0 = acc[ai][bj][m][0] * (f32x4){s[0], s[1], s[2], s[3]}, v1 = acc[ai][bj][m][1] * (f32x4){s[4], s[5], s[6], s[7]};
                    *(u32x4*)(out + row * 1024 + col0 + bj * HALF) = pack8(v0, v1);
                }
            }
    }
};
struct EpiOut {
    static constexpr bool PERM = false, MID = false;
    const float* x; const float* modacc; const float* bada; const float* nwf; float* out; bf16_t* x1s; float* rowss2;
    DEVI void operator()(const f32x4 (&acc)[2][2][4][2], const pg8::Unit& u, int wr, int wc, int fr, int fq) const {
        asm volatile("" : "+v"(fr), "+v"(fq));
        const int b = u.pm >> 6; const int row0 = u.pm * 256 + wr * 64 + fr, col0 = u.pn * 256 + wc * 32 + 4 * fq;
        f32x4 ga[2][2], sc[2][2];
#pragma unroll
        for (int bj = 0; bj < 2; ++bj)
#pragma unroll
            for (int n = 0; n < 2; ++n) { const int c = col0 + bj * HALF + n * 16;
                ga[bj][n] = *(const f32x4*)(modacc + b * 6144 + 2048 + c) + *(const f32x4*)(bada + 2048 + c);
                sc[bj][n] = (*(const f32x4*)(modacc + b * 6144 + 4096 + c) + *(const f32x4*)(bada + 4096 + c) + 1.f) * *(const f32x4*)(nwf + c); }
#pragma unroll
        for (int ai = 0; ai < 2; ++ai)
#pragma unroll
            for (int m = 0; m < 4; ++m) {
                const size_t off = (size_t)(row0 + ai * HALF + m * 16) * 1024 + col0; float ss = 0.f;
#pragma unroll
                for (int bj = 0; bj < 2; ++bj)
#pragma unroll
                    for (int n = 0; n < 2; ++n) {
                        const f32x4 xv = *(const f32x4*)(x + off + bj * HALF + n * 16);
                        const f32x4 o = xv + ga[bj][n] * acc[ai][bj][m][n];
                        *(f32x4*)(out + off + bj * HALF + n * 16) = o;
                        ss += (o[0] * o[0] + o[1] * o[1]) + (o[2] * o[2] + o[3] * o[3]);
                        const f32x4 s = o * sc[bj][n]; u32x2 w; w.x = pk2(s[0], s[1]); w.y = pk2(s[2], s[3]);
                        *(u32x2*)(x1s + off + bj * HALF + n * 16) = w;
                    }
                ss += __shfl_xor(ss, 16); ss += __shfl_xor(ss, 32);
                if (fq == 0) atomicAdd(rowss2 + row0 + ai * HALF + m * 16, ss);
            }
    }
};
struct EpiUp {
    static constexpr bool PERM = true, MID = false;
    const float* rowss2; const float* shWf; bf16_t* u_;
    DEVI void operator()(const f32x4 (&acc)[2][2][4][2], const pg8::Unit& u, int wr, int wc, int fr, int fq) const {
        asm volatile("" : "+v"(fr), "+v"(fq));
        const int row0 = u.pm * 256 + wr * 64 + fr, col0 = u.pn * 256 + wc * 32 + 8 * fq;
#pragma unroll
        for (int bj = 0; bj < 2; ++bj) {
            const f32x4 sv0 = *(const f32x4*)(shWf + col0 + bj * HALF), sv1 = *(const f32x4*)(shWf + col0 + bj * HALF + 4);
#pragma unroll
            for (int ai = 0; ai < 2; ++ai)
#pragma unroll
                for (int m = 0; m < 4; ++m) {
                    const int row = row0 + ai * HALF + m * 16;
                    const float rs = rsqrtf(rowss2[row] * (1.f / 1024.f) + EPS);
                    const f32x4 v0 = acc[ai][bj][m][0] * rs + sv0, v1 = acc[ai][bj][m][1] * rs + sv1;
                    *(u32x4*)(u_ + (size_t)row * NUP + col0 + bj * HALF) = pack8(v0, v1);
                }
        }
    }
};
struct EpiDown {
    static constexpr bool PERM = false, MID = false;
    const float* modacc; const float* bada; float* out;
    DEVI void operator()(const f32x4 (&acc)[2][2][4][2], const pg8::Unit& u, int wr, int wc, int fr, int fq) const {
        asm volatile("" : "+v"(fr), "+v"(fq));
        const int b = u.pm >> 6; const int row0 = u.pm * 256 + wr * 64 + fr, col0 = u.pn * 256 + wc * 32 + 4 * fq;
        f32x4 gf[2][2];
#pragma unroll
        for (int bj = 0; bj < 2; ++bj)
#pragma unroll
            for (int n = 0; n < 2; ++n) { const int c = col0 + bj * HALF + n * 16; gf[bj][n] = *(const f32x4*)(modacc + b * 6144 + 5120 + c) + *(const f32x4*)(bada + 5120 + c); }
#pragma unroll
        for (int ai = 0; ai < 2; ++ai)
#pragma unroll
            for (int m = 0; m < 4; ++m) {
                const size_t off = (size_t)(row0 + ai * HALF + m * 16) * 1024 + col0;
#pragma unroll
                for (int bj = 0; bj < 2; ++bj)
#pragma unroll
                    for (int n = 0; n < 2; ++n) { float* p = out + off + bj * HALF + n * 16; *(f32x4*)p = *(const f32x4*)p + gf[bj][n] * acc[ai][bj][m][n]; }
            }
    }
};

DEVI void transpose_item(const float* W, int srcN, int k0, int n0, bf16_t* dst  , int dstK, LAS float* scr, int lane) {
#pragma unroll 8
    for (int i = 0; i < 32; ++i) { const int kk = 2 * i + (lane >> 5); scr[kk * 33 + (lane & 31)] = W[(size_t)(k0 + kk) * srcN + n0 + (lane & 31)]; }
    asm volatile("s_waitcnt lgkmcnt(0)" ::: "memory");
    const int c = lane & 7;
#pragma unroll
    for (int j = 0; j < 4; ++j) { const int n = (lane >> 3) + 8 * j; const LAS float* s = scr + (8 * c) * 33 + n;
        u32x4 o; o.x = pk2(s[0 * 33], s[1 * 33]); o.y = pk2(s[2 * 33], s[3 * 33]); o.z = pk2(s[4 * 33], s[5 * 33]); o.w = pk2(s[6 * 33], s[7 * 33]);
        *(u32x4*)(dst + (size_t)n * dstK + 8 * c) = o; }
    asm volatile("s_waitcnt lgkmcnt(0)" ::: "memory");
}
DEVI void phase0(const Args& a, LAS unsigned char* lds, int tid, int lane, int wave) {
    unsigned char* ws = a.ws;
    bf16_t* WinA = (bf16_t*)(ws + WS_WINA); bf16_t* WinC = (bf16_t*)(ws + WS_WINC); bf16_t* Wbr = (bf16_t*)(ws + WS_WBR);
    bf16_t* Wout = (bf16_t*)(ws + WS_WOUT); bf16_t* Wup = (bf16_t*)(ws + WS_WUP); bf16_t* Wdn = (bf16_t*)(ws + WS_WDN);
    LAS float* scr = (LAS float*)(lds + wave * 16384);
    const int gw = blockIdx.x * 8 + wave, NGW = gridDim.x * 8;
    constexpr int I_IN = 16 * 241, I_BR = 16 * 32, I_UP = 16 * 176, I_DN = 44 * 32;
    constexpr int NITEMS = I_IN + 3 * I_BR + I_UP + I_DN;
    for (int it = gw; it < NITEMS; it += NGW) {
        int r = it;
        if (r < I_IN) { const int kb = r / 241, nb = r % 241, c0 = nb * 32; bf16_t* d; int row;
            if (c0 < 3072) { d = WinA; row = c0; } else if (c0 < 4096) { d = WinC; row = c0 - 3072; } else if (c0 == 4096) { d = WinA; row = 3072; }
            else if (c0 < 5152) { d = WinC; row = 1024 + (c0 - 4128); } else if (c0 < 5408) { d = WinC; row = 2048 + (c0 - 5152); }
            else if (c0 < 5664) { d = WinC; row = 2304 + (c0 - 5408); } else { d = WinC; row = 2560 + (c0 - 5664); }
            transpose_item(a.in[8], 7712, kb * 64, c0, d + (size_t)row * 1024 + kb * 64, 1024, scr, lane); continue; }
        r -= I_IN;
        if (r < I_BR) { const int kb = r / 32, nb = r % 32; transpose_item(a.in[16], 1024, kb * 64, nb * 32, Wbr + (size_t)(nb * 32) * 2048 + kb * 64, 2048, scr, lane); continue; }
        r -= I_BR;
        if (r < I_BR) { const int kb = r / 32, nb = r % 32; transpose_item(a.in[17], 1024, kb * 64, nb * 32, Wbr + (size_t)(nb * 32) * 2048 + 1024 + kb * 64, 2048, scr, lane); continue; }
        r -= I_BR;
        if (r < I_BR) { const int kb = r / 32, nb = r % 32; transpose_item(a.in[18], 1024, kb * 64, nb * 32, Wout + (size_t)(nb * 32) * 1024 + kb * 64, 1024, scr, lane); continue; }
        r -= I_BR;
        if (r < I_UP) { const int kb = r / 176, nb = r % 176, c0 = nb * 32; int row;
            if (c0 < DFF) row = 256 * (c0 / 128) + (c0 % 128); else { const int c1 = c0 - DFF; row = 256 * (c1 / 128) + 128 + (c1 % 128); }
            transpose_item(a.in[19], NUP, kb * 64, c0, Wup + (size_t)row * 1024 + kb * 64, 1024, scr, lane); continue; }
        r -= I_UP;
        { const int kb = r / 32, nb = r % 32; transpose_item(a.in[22], 1024, kb * 64, nb * 32, Wdn + (size_t)(nb * 32) * DFF + kb * 64, DFF, scr, lane); }
    }
    float* modacc = (float*)(ws + CTL_MODACC);
    for (int it = blockIdx.x; it < 12 * 16; it += gridDim.x) {
        const int cb = it % 12, ks = it / 12, n = cb * 512 + tid;
        float a0 = 0.f, a1 = 0.f, a2 = 0.f;
#pragma unroll 8
        for (int k = ks * 64; k < ks * 64 + 64; ++k) {
            const float w = a.in[4][(size_t)k * 6144 + n];
            a0 += siluf(a.in[1][k]) * w; a1 += siluf(a.in[1][1024 + k]) * w; a2 += siluf(a.in[3][k]) * w;
        }
        atomicAdd(modacc + n, a0); atomicAdd(modacc + 6144 + n, a1); atomicAdd(modacc + 12288 + n, a2);
    }
    float* rope = (float*)(ws + SM_ROPE);
    for (int i = blockIdx.x * 512 + tid; i < 320 * 32; i += gridDim.x * 512) {
        const int p = i >> 5, f = i & 31; const float inv = powf(10000.f, -(float)f / 32.f);
        if (p < 256) { const float ang = (float)p * inv; rope[p * 32 + f] = cosf(ang); rope[8192 + p * 32 + f] = sinf(ang); }
        else { const int q = p - 256; const float ang = (float)q * inv; rope[16384 + q * 32 + f] = cosf(ang); rope[16384 + 2048 + q * 32 + f] = sinf(ang); }
    }
}

DEVI void phase1(const Args& a, int tid, int lane, int wave) {
    unsigned char* ws = a.ws;
    const float* modacc = (const float*)(ws + CTL_MODACC); const float* bada = a.in[5];
    bf16_t* XN = (bf16_t*)(ws + WS_XN); float* rowss1 = (float*)(ws + SM_ROWSS1);
    const int gw = blockIdx.x * 8 + wave, NGW = gridDim.x * 8;
    for (int row = gw; row < MT; row += NGW) {
        const int vs = row < SEQ ? 0 : (row < ML ? 1 : 2);
        const float* xr = row < ML ? a.in[0] + (size_t)row * 1024 : a.in[2] + (size_t)(row - ML) * 1024;
        float ss = 0.f;
#pragma unroll
        for (int j = 0; j < 4; ++j) {
            const int c = 4 * lane + 256 * j;
            const f32x4 v = *(const f32x4*)(xr + c);
            ss += (v[0] * v[0] + v[1] * v[1]) + (v[2] * v[2] + v[3] * v[3]);
            const f32x4 s = (*(const f32x4*)(modacc + vs * 6144 + 1024 + c) + *(const f32x4*)(bada + 1024 + c) + 1.f) * *(const f32x4*)(a.in[6] + c);
            const f32x4 o = v * s; u32x2 w; w.x = pk2(o[0], o[1]); w.y = pk2(o[2], o[3]);
            *(u32x2*)(XN + (size_t)row * 1024 + c) = w;
        }
        ss = wave_sum(ss);
        if (lane == 0) rowss1[row] = ss;
    }
    const bf16_t* WinA = (const bf16_t*)(ws + WS_WINA); const bf16_t* WinC = (const bf16_t*)(ws + WS_WINC); const bf16_t* Wup = (const bf16_t*)(ws + WS_WUP);
    float* shWa = (float*)(ws + SM_SHWA); float* shWf = (float*)(ws + SM_SHWF);
    for (int n = gw; n < NSH + NUP; n += NGW) {
        const bool isf = n >= NSH;
        const bf16_t* wrow = isf ? Wup + (size_t)(n - NSH) * 1024 : (n < NA ? WinA + (size_t)n * 1024 : WinC + (size_t)(n - NA) * 1024);
        const int shoff = isf ? 3072 : 0;
        float s0 = 0.f, s1 = 0.f, s2 = 0.f;
#pragma unroll
        for (int h = 0; h < 2; ++h) {
            const int k0 = h * 512 + lane * 8;
            const u32x4 w = *(const u32x4*)(wrow + k0);
#pragma unroll
            for (int i = 0; i < 4; ++i) {
                const float wl = bflo(w[i]), wh = bfhi(w[i]); const int k = k0 + 2 * i;
                const float b0 = bada[shoff + k], b1 = bada[shoff + k + 1];
                s0 += (modacc[shoff + k] + b0) * wl + (modacc[shoff + k + 1] + b1) * wh;
                s1 += (modacc[6144 + shoff + k] + b0) * wl + (modacc[6144 + shoff + k + 1] + b1) * wh;
                s2 += (modacc[12288 + shoff + k] + b0) * wl + (modacc[12288 + shoff + k + 1] + b1) * wh;
            }
        }
        s0 = wave_sum(s0); s1 = wave_sum(s1); s2 = wave_sum(s2);
        if (lane == 0) {
            if (isf) { shWf[n - NSH] = s0; shWf[NUP + n - NSH] = s1; }
            else { shWa[n] = s0; shWa[NSH + n] = s1; shWa[2 * NSH + n] = s2; }
        }
    }
}

DEVI void phase_dnprep(const Args& a, int tid) {
    unsigned char* ws = a.ws;
    const bf16_t* QR = (const bf16_t*)(ws + WS_QKVR); bf16_t* QP = (bf16_t*)(ws + WS_QKVP);
    const float* convw = a.in[9]; const float* ba = (const float*)(ws + WS_BA);
    float* gb = (float*)(ws + WS_G); float* bb = (float*)(ws + WS_BETA);
    const int cg_ = tid & 15, rr = tid >> 4;
    for (int it = blockIdx.x; it < 520 * 24; it += gridDim.x) {
        const int cidx = it / 24, s = it % 24;
        int seq_start, t0, seq_len;
        if (cidx < 512) { seq_start = (cidx >> 8) * SEQ; t0 = (cidx & 255) * 64; seq_len = SEQ; }
        else { const int c2 = cidx - 512; seq_start = ML + (c2 >> 2) * CTX; t0 = (c2 & 3) * 64; seq_len = CTX; }
        const int col = s * 128 + cg_ * 8;
        f32x4 w0[5], w1[5];
#pragma unroll
        for (int j = 0; j < 5; ++j) { w0[j] = *(const f32x4*)(convw + j * 3072 + col); w1[j] = *(const f32x4*)(convw + j * 3072 + col + 4); }
#pragma unroll
        for (int pass = 0; pass < 2; ++pass) {
            const int r = rr + pass * 32;
            f32x4 acc0 = {0.f, 0.f, 0.f, 0.f}, acc1 = {0.f, 0.f, 0.f, 0.f};
#pragma unroll
            for (int j = 0; j < 5; ++j) {
                const int tt = t0 + r + j - 2;
                if (tt >= 0 && tt < seq_len) {
                    const u32x4 x = *(const u32x4*)(QR + (size_t)(seq_start + tt) * 3072 + col);
                    acc0 += (f32x4){bflo(x[0]), bfhi(x[0]), bflo(x[1]), bfhi(x[1])} * w0[j];
                    acc1 += (f32x4){bflo(x[2]), bfhi(x[2]), bflo(x[3]), bfhi(x[3])} * w1[j];
                }
            }
            float y[8];
#pragma unroll
            for (int i = 0; i < 4; ++i) { y[i] = siluf(acc0[i]); y[4 + i] = siluf(acc1[i]); }
            if (s < 16) {
                float ss = 0.f;
#pragma unroll
                for (int i = 0; i < 8; ++i) ss += y[i] * y[i];
                ss += __shfl_xor(ss, 1); ss += __shfl_xor(ss, 2); ss += __shfl_xor(ss, 4); ss += __shfl_xor(ss, 8);
                const float sc = rsqrtf(ss + EPS) * (s < 8 ? 0.08838834764831845f : 1.f);
#pragma unroll
                for (int i = 0; i < 8; ++i) y[i] *= sc;
            }
            u32x4 o; o.x = pk2(y[0], y[1]); o.y = pk2(y[2], y[3]); o.z = pk2(y[4], y[5]); o.w = pk2(y[6], y[7]);
            *(u32x4*)(QP + (size_t)(seq_start + t0 + r) * 3072 + col) = o;
        }
        if (s == 0) {
#pragma unroll
            for (int q = 0; q < 2; ++q) {
                const int e = tid + q * 512, r = e >> 4, idx = e & 15, row = seq_start + t0 + r;
                const float bv = ba[(size_t)row * 32 + idx], av = ba[(size_t)row * 32 + 16 + idx];
                const float xs = av + a.in[11][idx];
                const float sp = fmaxf(xs, 0.f) + log1pf(expf(-fabsf(xs)));
                const float g = -expf(a.in[10][idx]) * sp;
                const int dir = idx >> 3, h = idx & 7;
                gb[((size_t)dir * MT + row) * 8 + h] = g;
                bb[((size_t)dir * MT + row) * 8 + h] = 1.f / (1.f + expf(-bv));
            }
        }
    }
}

DEVI void phase_dnscan(const Args& a, int lane, int wave) {
    unsigned char* ws = a.ws;
    const bf16_t* QP = (const bf16_t*)(ws + WS_QKVP);
    const float* gb = (const float*)(ws + WS_G); const float* bb = (const float*)(ws + WS_BETA);
    bf16_t* Of = (bf16_t*)a.out; bf16_t* Ob = Of + (size_t)ML * 1024;
    const int gw = blockIdx.x * 8 + wave, NGW = gridDim.x * 8;
    for (int item = gw; item < 2048; item += NGW) {
        const int chain = item >> 6, ep = item & 63, dir = chain >> 4, b = (chain >> 3) & 1, h = chain & 7;
        bf16_t* O = dir ? Ob : Of;
        float S00 = 0.f, S01 = 0.f, S10 = 0.f, S11 = 0.f;
        const int NTOK = CTX + SEQ;
        constexpr int U = 4;
        unsigned kq[U], qq[U], vv[U]; float gg[U], be[U]; int rows[U];
        auto rowof = [&](int s) -> int { if (s < CTX) { const int t = dir ? CTX - 1 - s : s; return ML + b * CTX + t; } const int t2 = s - CTX; const int t = dir ? SEQ - 1 - t2 : t2; return b * SEQ + t; };
#define SC_LOAD(i, s) do { const int row_ = rowof(s); rows[i] = row_; const bf16_t* p_ = QP + (size_t)row_ * 3072 + h * 128; \
        qq[i] = *(const unsigned*)(p_ + 2 * lane); kq[i] = *(const unsigned*)(p_ + 1024 + 2 * lane); vv[i] = *(const unsigned*)(p_ + 2048 + 2 * ep); \
        gg[i] = gb[((size_t)dir * MT + row_) * 8 + h]; be[i] = bb[((size_t)dir * MT + row_) * 8 + h]; } while (0)
        for (int s0 = 0; s0 < NTOK; s0 += U) {
#pragma unroll
            for (int i = 0; i < U; ++i) SC_LOAD(i, s0 + i);
#pragma unroll
            for (int i = 0; i < U; ++i) {
                const float k0 = bflo(kq[i]), k1 = bfhi(kq[i]), q0 = bflo(qq[i]), q1 = bfhi(qq[i]), v0 = bflo(vv[i]), v1 = bfhi(vv[i]);
                const float eg = __expf(gg[i]), bt = be[i];
                float p0 = k0 * S00 + k1 * S10, p1 = k0 * S01 + k1 * S11;
                p0 = wave_sum(p0); p1 = wave_sum(p1);
                const float vn0 = bt * (v0 - eg * p0), vn1 = bt * (v1 - eg * p1);
                S00 = eg * S00 + k0 * vn0; S01 = eg * S01 + k0 * vn1; S10 = eg * S10 + k1 * vn0; S11 = eg * S11 + k1 * vn1;
                float o0 = q0 * S00 + q1 * S10, o1 = q0 * S01 + q1 * S11;
                o0 = wave_sum(o0); o1 = wave_sum(o1);
                if (lane == 0 && rows[i] < ML) *(unsigned*)(O + (size_t)rows[i] * 1024 + h * 128 + 2 * ep) = pk2(o0, o1);
            }
        }
#undef SC_LOAD
    }
}

DEVI void phase_prep2(const Args& a, int lane, int wave) {
    unsigned char* ws = a.ws;
    bf16_t* KAT = (bf16_t*)(ws + WS_KAT); const float* rope = (const float*)(ws + SM_ROPE); const float* knw = a.in[14];
    const int gw = blockIdx.x * 8 + wave, NGW = gridDim.x * 8;
    for (int row = gw; row < MT; row += NGW) {
        bf16_t* p = KAT + (size_t)row * 256 + lane * 4;
        const u32x2 w = *(const u32x2*)p;
        float x[4] = {bflo(w.x), bfhi(w.x), bflo(w.y), bfhi(w.y)};
        float ss = (x[0] * x[0] + x[1] * x[1]) + (x[2] * x[2] + x[3] * x[3]);
        ss += __shfl_xor(ss, 1); ss += __shfl_xor(ss, 2); ss += __shfl_xor(ss, 4); ss += __shfl_xor(ss, 8); ss += __shfl_xor(ss, 16);
        const float rs = rsqrtf(ss * (1.f / 128.f) + EPS);
        const int d = (lane & 31) * 4;
        const f32x4 nw = *(const f32x4*)(knw + d);
#pragma unroll
        for (int i = 0; i < 4; ++i) x[i] = x[i] * rs * nw[i];
        float pr[4];
#pragma unroll
        for (int i = 0; i < 4; ++i) pr[i] = __shfl_xor(x[i], 8);
        if (row < ML) {
            const int t = row & (SEQ - 1), lg = (lane & 31) >> 3, fi = (lane & 7) * 4;
            const float* ct = lg < 2 ? rope + (t >> 6) * 32 + fi : rope + 16384 + (t & 63) * 32 + fi;
            const float* st = lg < 2 ? ct + 8192 : ct + 2048;
            const f32x4 c = *(const f32x4*)ct, s = *(const f32x4*)st;
            const float sg = (lg & 1) ? 1.f : -1.f;
#pragma unroll
            for (int i = 0; i < 4; ++i) x[i] = x[i] * c[i] + sg * pr[i] * s[i];
        }
        u32x2 o; o.x = pk2(x[0], x[1]); o.y = pk2(x[2], x[3]);
        *(u32x2*)p = o;
    }
    const bf16_t* Of = (const bf16_t*)a.out; const bf16_t* Ob = Of + (size_t)ML * 1024;
    const bf16_t* GT = (const bf16_t*)(ws + WS_GT); bf16_t* Y = (bf16_t*)(ws + WS_Y); const float* dnw = a.in[12];
    for (int row = gw; row < ML; row += NGW) {
        const int c0 = lane * 16;
        float o[16];
#pragma unroll
        for (int hh = 0; hh < 2; ++hh) {
            const u32x4 f = *(const u32x4*)(Of + (size_t)row * 1024 + c0 + hh * 8), bk = *(const u32x4*)(Ob + (size_t)row * 1024 + c0 + hh * 8);
#pragma unroll
            for (int i = 0; i < 4; ++i) { o[hh * 8 + 2 * i] = bflo(f[i]) + bflo(bk[i]); o[hh * 8 + 2 * i + 1] = bfhi(f[i]) + bfhi(bk[i]); }
        }
        float ss = 0.f;
#pragma unroll
        for (int i = 0; i < 16; ++i) ss += o[i] * o[i];
        ss += __shfl_xor(ss, 1); ss += __shfl_xor(ss, 2); ss += __shfl_xor(ss, 4);
        const float rs = rsqrtf(ss * (1.f / 128.f) + EPS);
        const int d0 = c0 & 127;
#pragma unroll
        for (int hh = 0; hh < 2; ++hh) {
            const u32x4 gt = *(const u32x4*)(GT + (size_t)row * 1024 + c0 + hh * 8);
            float y[8];
#pragma unroll
            for (int i = 0; i < 4; ++i) {
                y[2 * i] = o[hh * 8 + 2 * i] * rs * dnw[d0 + hh * 8 + 2 * i] * siluf(bflo(gt[i]));
                y[2 * i + 1] = o[hh * 8 + 2 * i + 1] * rs * dnw[d0 + hh * 8 + 2 * i + 1] * siluf(bfhi(gt[i]));
            }
            u32x4 w; w.x = pk2(y[0], y[1]); w.y = pk2(y[2], y[3]); w.z = pk2(y[4], y[5]); w.w = pk2(y[6], y[7]);
            *(u32x4*)(Y + (size_t)row * 2048 + c0 + hh * 8) = w;
        }
    }
}

namespace att {
constexpr int D = 128, NW = 8, QBLK = 32, KVBLK = 64;
constexpr float SCALE = 0.088388347648318440f;
constexpr float THR = 8.f;
constexpr int LDK = 256;
constexpr size_t SHM_V = KVBLK * D * 2, SHM_K = KVBLK * D * 2;
constexpr size_t OFF_WS = 2 * SHM_V + 2 * SHM_K, OFF_OST = OFF_WS + NW * 64 * 4;
#define KSWZ(row, colB) ((row) * 256 + ((colB) ^ (((row) & 7) << 4)))
#define SBAR() __builtin_amdgcn_sched_barrier(0)
DEVI int crow(int r, int hi) { return (r & 3) + 8 * (r >> 2) + 4 * hi; }
DEVI unsigned cvtpk(float lo, float hi) { unsigned r; asm volatile("v_cvt_pk_bf16_f32 %0, %1, %2" : "=v"(r) : "v"(lo), "v"(hi)); return r; }
DEVI void partialSM(f32x16& p0, f32x16& p1, float& m_reg, float& mn, float& alpha) {
    constexpr float C = SCALE * 1.4426950408889634f;
    float pmax = p0[0];
#pragma unroll
    for (int r = 1; r < 16; ++r) pmax = fmaxf(pmax, p0[r]);
#pragma unroll
    for (int r = 0; r < 16; ++r) pmax = fmaxf(pmax, p1[r]);
    { auto rr = __builtin_amdgcn_permlane32_swap(__float_as_uint(pmax), __float_as_uint(pmax), false, false);
      pmax = fmaxf(__uint_as_float(rr[0]), __uint_as_float(rr[1])); }
    if (__builtin_expect(__all(pmax - m_reg <= THR / SCALE), 1)) { mn = m_reg; alpha = 1.f; }
    else { mn = fmaxf(m_reg, pmax); alpha = __builtin_amdgcn_exp2f((m_reg - mn) * C); m_reg = mn; }
    const float mnC = -mn * C;
#pragma unroll
    for (int r = 0; r < 16; ++r) p0[r] = fmaf(p0[r], C, mnC);
#pragma unroll
    for (int r = 0; r < 16; ++r) p1[r] = fmaf(p1[r], C, mnC);
#pragma unroll
    for (int r = 0; r < 16; ++r) p0[r] = __builtin_amdgcn_exp2f(p0[r]);
}
DEVI void finishSM(f32x16& p0, f32x16& p1, float alpha, float& l_reg, bf16x8& pa0, bf16x8& pa1, bf16x8& pa2, bf16x8& pa3) {
#pragma unroll
    for (int r = 0; r < 16; ++r) p1[r] = __builtin_amdgcn_exp2f(p1[r]);
    float ps = 0;
#pragma unroll
    for (int r = 0; r < 16; ++r) ps += p0[r];
#pragma unroll
    for (int r = 0; r < 16; ++r) ps += p1[r];
    { auto rr = __builtin_amdgcn_permlane32_swap(__float_as_uint(ps), __float_as_uint(ps), false, false);
      ps = __uint_as_float(rr[0]) + __uint_as_float(rr[1]); }
    l_reg = l_reg * alpha + ps;
#define PK4(P, BASE, OUT) do { unsigned a0 = cvtpk(P[BASE + 0], P[BASE + 1]), a1 = cvtpk(P[BASE + 2], P[BASE + 3]);   \
    unsigned b0 = cvtpk(P[BASE + 4], P[BASE + 5]), b1 = cvtpk(P[BASE + 6], P[BASE + 7]);                              \
    auto r0 = __builtin_amdgcn_permlane32_swap(a0, b0, false, false); auto r1 = __builtin_amdgcn_permlane32_swap(a1, b1, false, false); \
    u32x4 w = {r0[0], r1[0], r0[1], r1[1]}; OUT = *reinterpret_cast<bf16x8*>(&w); } while (0)
    PK4(p0, 0, pa0); PK4(p0, 8, pa1); PK4(p1, 0, pa2); PK4(p1, 8, pa3);
#undef PK4
}
DEVI void qkt(f32x16& p0, f32x16& p1, const char* Ks, const bf16x8* qr, int r32, int hi) {
    p0 = f32x16{}; p1 = f32x16{};
#pragma unroll
    for (int d0 = 0; d0 < 8; ++d0) { const int cb = (d0 * 16 + hi * 8) * 2;
        const bf16x8 b0 = *reinterpret_cast<const bf16x8*>(Ks + KSWZ(r32, cb));
        const bf16x8 b1 = *reinterpret_cast<const bf16x8*>(Ks + KSWZ(32 + r32, cb));
        p0 = __builtin_amdgcn_mfma_f32_32x32x16_bf16(b0, qr[d0], p0, 0, 0, 0);
        p1 = __builtin_amdgcn_mfma_f32_32x32x16_bf16(b1, qr[d0], p1, 0, 0, 0); }
}
DEVI int v_st(int k, int c) { const int kk = (k & ~0xC) | ((k & 4) << 1) | ((k & 8) >> 1); return ((kk >> 3) * 4 + (c >> 5)) * 512 + ((kk & 7) * 32 + (c & 31)) * 2; }
DEVI int v_rd_base(int lane) { return ((lane & 3) << 3) | (((lane >> 2) & 3) << 6) | (((lane >> 4) & 1) << 5) | (((lane >> 5) & 1) << 8); }
constexpr int v_rd_off(int d0, int ks, int half) { return d0 * 512 + ks * 4096 + half * 2048; }
template <int OFF> DEVI s16x4 tr_read(int vb) { s16x4 r; asm volatile("ds_read_b64_tr_b16 %0, %1 offset:%2" : "=&v"(r) : "v"(vb), "i"(OFF) : "memory"); return r; }
template <int D0> DEVI void pv_one(f32x16& od, int vb, bf16x8 pa0, bf16x8 pa1, bf16x8 pa2, bf16x8 pa3) {
    const s16x4 l0 = tr_read<v_rd_off(D0, 0, 0)>(vb), h0 = tr_read<v_rd_off(D0, 0, 1)>(vb), l1 = tr_read<v_rd_off(D0, 1, 0)>(vb), h1 = tr_read<v_rd_off(D0, 1, 1)>(vb);
    const s16x4 l2 = tr_read<v_rd_off(D0, 2, 0)>(vb), h2 = tr_read<v_rd_off(D0, 2, 1)>(vb), l3 = tr_read<v_rd_off(D0, 3, 0)>(vb), h3 = tr_read<v_rd_off(D0, 3, 1)>(vb);
    asm volatile("s_waitcnt lgkmcnt(0)" ::: "memory"); SBAR();
#define PK(L, H) (bf16x8){L[0], L[1], L[2], L[3], H[0], H[1], H[2], H[3]}
    od = __builtin_amdgcn_mfma_f32_32x32x16_bf16(pa0, PK(l0, h0), od, 0, 0, 0);
    od = __builtin_amdgcn_mfma_f32_32x32x16_bf16(pa1, PK(l1, h1), od, 0, 0, 0);
    od = __builtin_amdgcn_mfma_f32_32x32x16_bf16(pa2, PK(l2, h2), od, 0, 0, 0);
    od = __builtin_amdgcn_mfma_f32_32x32x16_bf16(pa3, PK(l3, h3), od, 0, 0, 0);
#undef PK
}
DEVI void pv_d0(f32x16* o, int vb, bf16x8 pa0, bf16x8 pa1, bf16x8 pa2, bf16x8 pa3) {
    pv_one<0>(o[0], vb, pa0, pa1, pa2, pa3); pv_one<1>(o[1], vb, pa0, pa1, pa2, pa3); pv_one<2>(o[2], vb, pa0, pa1, pa2, pa3); pv_one<3>(o[3], vb, pa0, pa1, pa2, pa3);
}
DEVI void wmask(f32x16& p0, f32x16& p1, int qp, int kt0, int hi) {
#pragma unroll
    for (int r = 0; r < 16; ++r) { const int kp = kt0 + crow(r, hi); const int d0 = qp - kp, d1 = d0 - 32;
        if (d0 > 128 || d0 < -128) p0[r] = -1e30f; if (d1 > 128 || d1 < -128) p1[r] = -1e30f; }
}
DEVI void attn_unit(const Args& a, int b, int h, int qb, char* lds) {
    unsigned char* ws = a.ws;
    const bf16_t* QAT = (const bf16_t*)(ws + WS_QAT); const bf16_t* KAT = (const bf16_t*)(ws + WS_KAT); const bf16_t* VAT = (const bf16_t*)(ws + WS_VAT);
    bf16_t* Y = (bf16_t*)(ws + WS_Y); const float* rope = (const float*)(ws + SM_ROPE);
    const int tid = threadIdx.x, wid = tid >> 6, lane = tid & 63, r32 = lane & 31, hi = lane >> 5;
    const int kvh = h >> 2, t0 = qb * 256;
    char* V_lds = lds; char* K_lds = lds + 2 * SHM_V;
    float* wsf = (float*)(lds + OFF_WS) + wid * 64; float* li_l = wsf; float* al_l = wsf + 32;
    float m_reg = -1e30f, l_reg = 0; f32x16 o[4] = {}; bf16x8 qr[8];
    const int qp = t0 + wid * QBLK + r32;
    {
        const bf16_t* Qw = QAT + (size_t)(b * SEQ + qp) * 1024 + h * 128 + hi * 8;
        u32x4 raw[8]; float ss = 0.f;
#pragma unroll
        for (int d0 = 0; d0 < 8; ++d0) { raw[d0] = *(const u32x4*)(Qw + d0 * 16);
#pragma unroll
            for (int i = 0; i < 4; ++i) { const float lo_ = bflo(raw[d0][i]), hi_ = bfhi(raw[d0][i]); ss += lo_ * lo_ + hi_ * hi_; } }
        { auto rr = __builtin_amdgcn_permlane32_swap(__float_as_uint(ss), __float_as_uint(ss), false, false); ss = __uint_as_float(rr[0]) + __uint_as_float(rr[1]); }
        const float rs = rsqrtf(ss * (1.f / 128.f) + EPS);
        const float* qnw = a.in[13];
#pragma unroll
        for (int half = 0; half < 2; ++half) {
            const float* ct = half == 0 ? rope + (qp >> 6) * 32 : rope + 16384 + (qp & 63) * 32;
            const float* st = half == 0 ? ct + 8192 : ct + 2048;
#pragma unroll
            for (int dd = 0; dd < 2; ++dd) {
                const int fi = dd * 16 + hi * 8, da = half * 4 + dd, db = da + 2;
                u32x4 oa, ob;
#pragma unroll
                for (int q4 = 0; q4 < 2; ++q4) {
                    const f32x4 c = *(const f32x4*)(ct + fi + 4 * q4), s = *(const f32x4*)(st + fi + 4 * q4);
                    const f32x4 wa = *(const f32x4*)(qnw + da * 16 + hi * 8 + 4 * q4), wb = *(const f32x4*)(qnw + db * 16 + hi * 8 + 4 * q4);
                    float ya[4], yb[4];
#pragma unroll
                    for (int j = 0; j < 4; ++j) {
                        const unsigned ra = raw[da][2 * q4 + (j >> 1)], rb = raw[db][2 * q4 + (j >> 1)];
                        const float x1 = ((j & 1) ? bfhi(ra) : bflo(ra)) * rs * wa[j], x2 = ((j & 1) ? bfhi(rb) : bflo(rb)) * rs * wb[j];
                        ya[j] = x1 * c[j] - x2 * s[j]; yb[j] = x2 * c[j] + x1 * s[j];
                    }
                    oa[2 * q4] = cvtpk(ya[0], ya[1]); oa[2 * q4 + 1] = cvtpk(ya[2], ya[3]); ob[2 * q4] = cvtpk(yb[0], yb[1]); ob[2 * q4 + 1] = cvtpk(yb[2], yb[3]);
                }
                qr[da] = *reinterpret_cast<bf16x8*>(&oa); qr[db] = *reinterpret_cast<bf16x8*>(&ob);
            }
        }
    }
    const int tk0 = t0 - 128 < 0 ? 0 : t0 - 128, tk1 = t0 + 384 > SEQ ? SEQ : t0 + 384;
    const int NT = 4 + (tk1 - tk0) / 64;
    const int ctxrow = ML + b * CTX, latrow = b * SEQ + tk0 - 256;
#define TROW(j) ((j) < 4 ? ctxrow + 64 * (j) : latrow + 64 * (j))
    const bf16_t* Kh = KAT + kvh * 128; const bf16_t* Vh = VAT + kvh * 128;
    const int sr = tid >> 4, sc = (tid & 15) * 8, vst0 = v_st(sr, sc), vst1 = v_st(32 + sr, sc);
    const int vb0 = (int)(uintptr_t)V_lds + v_rd_base(lane);
    struct { bf16x8 vs0, vs1, ks0, ks1; } sr_[1];
#define SLOAD(i, j) do { const int k0_ = TROW(j); sr_[i].vs0 = *(const bf16x8*)(Vh + (size_t)(k0_ + sr) * LDK + sc); sr_[i].vs1 = *(const bf16x8*)(Vh + (size_t)(k0_ + 32 + sr) * LDK + sc); \
    sr_[i].ks0 = *(const bf16x8*)(Kh + (size_t)(k0_ + sr) * LDK + sc); sr_[i].ks1 = *(const bf16x8*)(Kh + (size_t)(k0_ + 32 + sr) * LDK + sc); } while (0)
#define SWRITE(bf, i) do { *(bf16x8*)(V_lds + (bf) * SHM_V + vst0) = sr_[i].vs0; *(bf16x8*)(V_lds + (bf) * SHM_V + vst1) = sr_[i].vs1; const int kc = sc * 2; \
    *(bf16x8*)(K_lds + (bf) * SHM_K + KSWZ(sr, kc)) = sr_[i].ks0; *(bf16x8*)(K_lds + (bf) * SHM_K + KSWZ(32 + sr, kc)) = sr_[i].ks1; } while (0)
#define SWAIT() asm volatile("s_waitcnt vmcnt(0)" ::: "memory")
#define RESC(al) do { if (__any((al) < 1.f)) { if (hi == 0) al_l[r32] = (al); asm volatile("s_waitcnt lgkmcnt(0)" ::: "memory"); \
    _Pragma("unroll") for (int d = 0; d < 4; ++d) _Pragma("unroll") for (int r = 0; r < 16; ++r) o[d][r] *= al_l[crow(r, hi)]; } } while (0)
#define WMASK(P0, P1, j) do { if ((j) >= 4) wmask(P0, P1, qp, tk0 + 64 * ((j) - 4), hi); } while (0)
    f32x16 pA0, pA1, pB0, pB1; float mnA, mnB, alA, alB; bf16x8 pa0, pa1, pa2, pa3;
    constexpr int SE = 0, SO = 0;
    SLOAD(SE, 0); asm volatile("s_waitcnt vmcnt(0)" ::: "memory"); SWRITE(0, SE); __syncthreads();
    qkt(pA0, pA1, K_lds, qr, r32, hi); partialSM(pA0, pA1, m_reg, mnA, alA);
    SLOAD(SO, 1);
    SWAIT(); SWRITE(1, SO); __syncthreads();
    for (int j = 1; j + 1 < NT; j += 2) {
        SBAR(); qkt(pB0, pB1, K_lds + SHM_K, qr, r32, hi); WMASK(pB0, pB1, j);
        finishSM(pA0, pA1, alA, l_reg, pa0, pa1, pa2, pa3); SBAR();
        SLOAD(SO, j + 1); SBAR();
        pv_d0(o, vb0, pa0, pa1, pa2, pa3); partialSM(pB0, pB1, m_reg, mnB, alB);
        __syncthreads(); SWAIT(); SWRITE(0, SE);
        RESC(alB); __syncthreads();
        SBAR(); qkt(pA0, pA1, K_lds, qr, r32, hi); WMASK(pA0, pA1, j + 1);
        finishSM(pB0, pB1, alB, l_reg, pa0, pa1, pa2, pa3); SBAR();
        SLOAD(SE, j + 2); SBAR();
        pv_d0(o, vb0 + (int)SHM_V, pa0, pa1, pa2, pa3); partialSM(pA0, pA1, m_reg, mnA, alA);
        __syncthreads(); SWAIT(); SWRITE(1, SO);
        RESC(alA); __syncthreads();
    }
    SBAR(); qkt(pB0, pB1, K_lds + SHM_K, qr, r32, hi); WMASK(pB0, pB1, NT - 1);
    finishSM(pA0, pA1, alA, l_reg, pa0, pa1, pa2, pa3); SBAR();
    pv_d0(o, vb0, pa0, pa1, pa2, pa3); partialSM(pB0, pB1, m_reg, mnB, alB);
    __syncthreads(); RESC(alB);
    finishSM(pB0, pB1, alB, l_reg, pa0, pa1, pa2, pa3); SBAR();
    pv_d0(o, vb0 + (int)SHM_V, pa0, pa1, pa2, pa3);
    l_reg += __builtin_amdgcn_exp2f(a.in[15][h] * 1.4426950408889634f - m_reg * (SCALE * 1.4426950408889634f));
    if (hi == 0) li_l[r32] = l_reg; asm volatile("s_waitcnt lgkmcnt(0)" ::: "memory");
    float rli[16];
#pragma unroll
    for (int r = 0; r < 16; ++r) rli[r] = __builtin_amdgcn_rcpf(li_l[crow(r, hi)]);
    {
        bf16_t* stg = (bf16_t*)(lds + OFF_OST) + wid * 4096;
#pragma unroll
        for (int r = 0; r < 16; ++r) { const int orow = crow(r, hi);
#pragma unroll
            for (int d0 = 0; d0 < 4; ++d0) stg[orow * 128 + d0 * 32 + r32] = (bf16_t)f2bf(o[d0][r] * rli[r]); }
        asm volatile("s_waitcnt lgkmcnt(0)" ::: "memory");
        bf16_t* Ow = Y + (size_t)(b * SEQ + t0 + wid * QBLK) * 2048 + 1024 + h * 128;
#pragma unroll
        for (int i = 0; i < 8; ++i) { const int row = i * 4 + (lane >> 4), ch = lane & 15; const u32x4 v = *(const u32x4*)(stg + row * 128 + ch * 8); *(u32x4*)(Ow + (size_t)row * 2048 + ch * 8) = v; }
    }
    __syncthreads();
#undef TROW
#undef SLOAD
#undef SWRITE
#undef SWAIT
#undef RESC
#undef WMASK
}
#undef KSWZ
#undef SBAR
}

DEVI void phase_ffnconv(const Args& a, int b, int tid) {
    unsigned char* ws = a.ws;
    const bf16_t* U = (const bf16_t*)(ws + WS_U); bf16_t* ACT = (bf16_t*)(ws + WS_ACT) + (size_t)b * SEQ * DFF;
    const float* cw = a.in[20]; const float* cb = a.in[21];
    const long total = (long)SEQ * (DFF / 8);
    for (long i = (long)blockIdx.x * 512 + tid; i < total; i += (long)gridDim.x * 512) {
        const int row = (int)(i / (DFF / 8)), f0 = (int)(i % (DFF / 8)) * 8;
        const int pn = f0 >> 7, j = f0 & 127, gc = 256 * pn + j, vc = gc + 128;
        float ug[8], uv[8];
#pragma unroll
        for (int q = 0; q < 8; ++q) { ug[q] = cb[f0 + q]; uv[q] = cb[DFF + f0 + q]; }
#pragma unroll
        for (int jt = 0; jt < 3; ++jt) {
            const int rr = row + jt - 1;
            if (rr >= 0 && rr < SEQ) {
                const u32x4 g = *(const u32x4*)(U + (size_t)rr * NUP + gc), v = *(const u32x4*)(U + (size_t)rr * NUP + vc);
                const f32x4 wg0 = *(const f32x4*)(cw + jt * NUP + f0), wg1 = *(const f32x4*)(cw + jt * NUP + f0 + 4);
                const f32x4 wv0 = *(const f32x4*)(cw + jt * NUP + DFF + f0), wv1 = *(const f32x4*)(cw + jt * NUP + DFF + f0 + 4);
#pragma unroll
                for (int q = 0; q < 4; ++q) {
                    const float wgl = q < 2 ? wg0[2 * q] : wg1[2 * q - 4], wgh = q < 2 ? wg0[2 * q + 1] : wg1[2 * q - 3];
                    const float wvl = q < 2 ? wv0[2 * q] : wv1[2 * q - 4], wvh = q < 2 ? wv0[2 * q + 1] : wv1[2 * q - 3];
                    ug[2 * q] += bflo(g[q]) * wgl; ug[2 * q + 1] += bfhi(g[q]) * wgh;
                    uv[2 * q] += bflo(v[q]) * wvl; uv[2 * q + 1] += bfhi(v[q]) * wvh;
                }
            }
        }
        u32x4 o;
        o.x = pk2(siluf(ug[0]) * uv[0], siluf(ug[1]) * uv[1]); o.y = pk2(siluf(ug[2]) * uv[2], siluf(ug[3]) * uv[3]);
        o.z = pk2(siluf(ug[4]) * uv[4], siluf(ug[5]) * uv[5]); o.w = pk2(siluf(ug[6]) * uv[6], siluf(ug[7]) * uv[7]);
        *(u32x4*)(ACT + (size_t)row * DFF + f0) = o;
    }
}

constexpr int NPHASE = 16;
__global__ void __launch_bounds__(512, 2) mega(Args a) {
    extern __shared__ __attribute__((aligned(16))) unsigned char lds_raw[];
    LAS unsigned char* lds = (LAS unsigned char*)lds_raw;
    const int tid = threadIdx.x, lane = tid & 63, wave = __builtin_amdgcn_readfirstlane(tid >> 6);
    unsigned char* ws = a.ws;
    const int lo = a.ph_lo, hi = a.ph_hi;
#define IN(k) (lo <= (k) && (k) < hi)
#if MK_ONE_LAUNCH
#define SEAM(k) do { if (IN(k) && IN((k) + 1)) cg::this_grid().sync(); } while (0)
#else
#define SEAM(k) do { } while (0)
#endif
    const float* modacc = (const float*)(ws + CTL_MODACC);
    if (IN(0)) { phase0(a, lds, tid, lane, wave); } SEAM(0);
    if (IN(1)) { phase1(a, tid, lane, wave); } SEAM(1);
    if (IN(2)) {
        pg8::Gemm g{(const bf16_t*)(ws + WS_XN), (const bf16_t*)(ws + WS_WINA), MT, NA, 1024}; pg8::StaticOrder S; S.init(MT, NA, gridDim.x, blockIdx.x);
        EpiIn E{(const float*)(ws + SM_ROWSS1), (const float*)(ws + SM_SHWA), 0, (bf16_t*)(ws + WS_QKVR), nullptr, nullptr, nullptr, nullptr, (float*)(ws + WS_BA)};
        pg8::gemm_phase<EpiIn, pg8::StaticOrder, true, true>(lds, g, S, E);
    } SEAM(2);
    if (IN(3)) { phase_dnprep(a, tid); } SEAM(3);
    if (IN(4)) { phase_dnscan(a, lane, wave); } SEAM(4);
    if (IN(5)) {
        pg8::Gemm g{(const bf16_t*)(ws + WS_XN), (const bf16_t*)(ws + WS_WINC), MT, NC, 1024}; pg8::StaticOrder S; S.init(MT, NC, gridDim.x, blockIdx.x);
        EpiIn E{(const float*)(ws + SM_ROWSS1), (const float*)(ws + SM_SHWA) + NA, 1, (bf16_t*)(ws + WS_GT), (bf16_t*)(ws + WS_QAT), (bf16_t*)(ws + WS_KAT), (bf16_t*)(ws + WS_VAT), (bf16_t*)(ws + WS_MG), nullptr};
        pg8::gemm_phase<EpiIn, pg8::StaticOrder, true, true>(lds, g, S, E);
    } SEAM(5);
    if (IN(6)) { phase_prep2(a, lane, wave); } SEAM(6);
    if (IN(7)) {
#pragma unroll 1
        for (int k = 0; k < 1024; ++k) {
            const int idx = 4 * ((int)blockIdx.x + (int)gridDim.x * (k >> 2)) + (k & 3); if (idx >= 1024) break;
            const int g = idx & 3, qb = (idx >> 2) & 63, kvh = (idx >> 8) & 1, b = idx >> 9;
            att::attn_unit(a, b, kvh * 4 + g, qb, (char*)lds_raw); }
    } SEAM(7);
    if (IN(8)) {
        pg8::Gemm g{(const bf16_t*)(ws + WS_Y), (const bf16_t*)(ws + WS_WBR), ML, 1024, 2048}; pg8::StaticOrder S; S.init(ML, 1024, gridDim.x, blockIdx.x);
        EpiBr E{(const bf16_t*)(ws + WS_MG), (bf16_t*)(ws + WS_MERGED)};
        pg8::gemm_phase<EpiBr, pg8::StaticOrder, true, true>(lds, g, S, E);
    } SEAM(8);
    if (IN(9)) {
        pg8::Gemm g{(const bf16_t*)(ws + WS_MERGED), (const bf16_t*)(ws + WS_WOUT), ML, 1024, 1024}; pg8::StaticOrder S; S.init(ML, 1024, gridDim.x, blockIdx.x);
        EpiOut E{a.in[0], modacc, a.in[5], a.in[7], a.out, (bf16_t*)(ws + WS_X1S), (float*)(ws + CTL_ROWSS2)};
        pg8::gemm_phase<EpiOut, pg8::StaticOrder, true, true>(lds, g, S, E);
    } SEAM(9);
#define FFN_UP(PH, BB) if (IN(PH)) { \
        pg8::Gemm g{(const bf16_t*)(ws + WS_X1S) + (size_t)(BB) * SEQ * 1024, (const bf16_t*)(ws + WS_WUP), SEQ, NUP, 1024}; pg8::StaticOrder S; S.init(SEQ, NUP, gridDim.x, blockIdx.x); \
        EpiUp E{(const float*)(ws + CTL_ROWSS2) + (BB) * SEQ, (const float*)(ws + SM_SHWF) + (BB) * NUP, (bf16_t*)(ws + WS_U)}; \
        pg8::gemm_phase<EpiUp, pg8::StaticOrder, true, true>(lds, g, S, E); }
    FFN_UP(10, 0) SEAM(10);
    if (IN(11)) { phase_ffnconv(a, 0, tid); } SEAM(11);
    FFN_UP(12, 1) SEAM(12);
    if (IN(13)) { phase_ffnconv(a, 1, tid); } SEAM(13);
#undef FFN_UP
    if (IN(14)) {
        pg8::Gemm g{(const bf16_t*)(ws + WS_ACT), (const bf16_t*)(ws + WS_WDN), ML, 1024, DFF}; pg8::StaticOrder S; S.init(ML, 1024, gridDim.x, blockIdx.x);
        EpiDown E{modacc, a.in[5], a.out};
        pg8::gemm_phase<EpiDown, pg8::StaticOrder, true, true>(lds, g, S, E);
    }
#undef IN
#undef SEAM
}

extern "C" void kernel_launch(void* const* d_in, const int* in_sizes, int n_in, void* d_out, int out_size, void* d_ws, size_t ws_size, hipStream_t stream) {
    static int grid = 0;
    if (grid == 0) {
        if (n_in != 23 || in_sizes[0] != ML * DM || out_size != ML * DM || ws_size < WS_END) {
            fprintf(stderr, "kernel_launch: unexpected shapes n_in %d in0 %d out %d ws %zu (need %zu)\n", n_in, n_in > 0 ? in_sizes[0] : -1, out_size, ws_size, (size_t)WS_END); grid = -1; return; }
        int dev = 0, cus = 0, per_cu = 0;
        hipGetDevice(&dev); hipDeviceGetAttribute(&cus, hipDeviceAttributeMultiprocessorCount, dev);
        if (hipFuncSetAttribute((const void*)mega, hipFuncAttributeMaxDynamicSharedMemorySize, LDS_BYTES) != hipSuccess) { fprintf(stderr, "kernel_launch: hipFuncSetAttribute failed\n"); grid = -1; return; }
        hipOccupancyMaxActiveBlocksPerMultiprocessor(&per_cu, (const void*)mega, 512, LDS_BYTES);
        (void)hipGetLastError();
        if (per_cu < 1) { fprintf(stderr, "kernel_launch: occupancy query says %d blocks per CU\n", per_cu); per_cu = 1; }
        grid = cus;
    }
    if (grid < 0) return;
    hipMemsetAsync((char*)d_ws + WS_CTL, 0, CTL_ZERO_BYTES, stream);
    Args a{};
    for (int i = 0; i < 23; ++i) a.in[i] = (const float*)d_in[i];
    a.out = (float*)d_out; a.ws = (unsigned char*)d_ws;
#if MK_ONE_LAUNCH
    a.ph_lo = 0; a.ph_hi = NPHASE;
    void* args[] = {&a};
    hipError_t e = hipLaunchCooperativeKernel((const void*)mega, dim3(grid), dim3(512), args, LDS_BYTES, stream);
    if (e != hipSuccess) fprintf(stderr, "cooperative launch failed: %s (grid %d)\n", hipGetErrorString(e), grid);
#else
    for (int p = 0; p < 15; ++p) {
        a.ph_lo = p; a.ph_hi = p + 1;
        hipLaunchKernelGGL(mega, dim3(grid), dim3(512), LDS_BYTES, stream, a);
    }
    hipError_t e = hipPeekAtLastError();
    if (e != hipSuccess) fprintf(stderr, "launch failed: %s\n", hipGetErrorString(e));
#endif
}
```

```cpp
#include <hip/hip_runtime.h>
#include <hip/hip_cooperative_groups.h>
#include <cstdio>
#include <cstdint>
namespace cg = cooperative_groups;

#ifndef MK_ONE_LAUNCH
#define MK_ONE_LAUNCH 1
#endif

#define DEVI __device__ __forceinline__
#define LAS __attribute__((address_space(3)))
typedef unsigned short bf16_t;
typedef short bf16x8 __attribute__((ext_vector_type(8)));
typedef float f32x4 __attribute__((ext_vector_type(4)));
typedef float f32x2 __attribute__((ext_vector_type(2)));
typedef float f32x16 __attribute__((ext_vector_type(16)));
typedef unsigned u32x4 __attribute__((ext_vector_type(4)));
typedef unsigned u32x2 __attribute__((ext_vector_type(2)));
typedef short s16x4 __attribute__((ext_vector_type(4)));

constexpr int BATCH = 2, SEQ = 16384, DM = 1024, CTX = 256;
constexpr int ML = BATCH * SEQ;
constexpr int MC = BATCH * CTX;
constexpr int MT = ML + MC;
constexpr int NA = 3328;
constexpr int NC = 4608;
constexpr int NSH = NA + NC;
constexpr int DFF = 2816, NUP = 5632;
constexpr float EPS = 1e-6f;

constexpr size_t MiB = 1u << 20;
constexpr size_t WS_CTL = 0, CTL_ZERO_BYTES = 1 * MiB;
constexpr size_t CTL_MODACC = 64 * 1024;
constexpr size_t CTL_ROWSS2 = 256 * 1024;
constexpr size_t WS_SMALL = 1 * MiB;
constexpr size_t SM_ROWSS1 = WS_SMALL;
constexpr size_t SM_SHWA = WS_SMALL + 256 * 1024;
constexpr size_t SM_SHWF = WS_SMALL + 384 * 1024;
constexpr size_t SM_ROPE = WS_SMALL + 512 * 1024;
constexpr size_t WS_BA = 2 * MiB;
constexpr size_t WS_G = 7 * MiB;
constexpr size_t WS_BETA = 10 * MiB;
constexpr size_t WS_WINA = 13 * MiB, WS_WINC = 20 * MiB, WS_WBR = 29 * MiB, WS_WOUT = 33 * MiB, WS_WUP = 35 * MiB, WS_WDN = 46 * MiB;
constexpr size_t WS_XN = 52 * MiB;
constexpr size_t WS_QKVR = 117 * MiB;
constexpr size_t WS_QKVP = 312 * MiB;
constexpr size_t WS_MG = 180 * MiB;
constexpr size_t WS_GT = 310 * MiB;
constexpr size_t WS_QAT = 375 * MiB;
constexpr size_t WS_KAT = 440 * MiB;
constexpr size_t WS_VAT = 457 * MiB;
constexpr size_t WS_Y = 52 * MiB;
constexpr size_t WS_MERGED = 375 * MiB;
constexpr size_t WS_X1S = 440 * MiB;
constexpr size_t WS_U = 52 * MiB;
constexpr size_t WS_ACT = 228 * MiB;
constexpr size_t WS_TQ = 117 * MiB;
constexpr size_t WS_AVEC = 248 * MiB;
constexpr size_t WS_END = 512 * MiB;

constexpr int LDS_BYTES = 147456;

DEVI float bf2f(unsigned short h) { return __uint_as_float((unsigned)h << 16); }
DEVI float bflo(unsigned w) { return __uint_as_float(w << 16); }
DEVI float bfhi(unsigned w) { return __uint_as_float(w & 0xffff0000u); }
DEVI unsigned f2bf(float f) { unsigned u = __float_as_uint(f); return (u + 0x7fffu + ((u >> 16) & 1u)) >> 16; }
DEVI unsigned pk2(float lo, float hi) { return f2bf(lo) | (f2bf(hi) << 16); }
DEVI float wave_sum(float v) {
#pragma unroll
    for (int o = 1; o < 64; o <<= 1) v += __shfl_xor(v, o);
    return v;
}
DEVI float siluf(float x) { return x / (1.f + __expf(-x)); }
DEVI float sigmoidf_(float x) { return 1.f / (1.f + __expf(-x)); }

struct Args { const float* in[23]; float* out; unsigned char* ws; int ph_lo, ph_hi; };

namespace pg8 {
constexpr int BM = 256, BK = 64, HALF = 128, HTB = HALF * BK * 2, STAGE_BYTES = 8 * HTB, NXCD = 8, WGM = 8;
__host__ __device__ __forceinline__ int lds_byte(int r, int c) { const int st = (r >> 4) * 2 + (c >> 5), rr = r & 15, cc = c & 31, ob = rr * 64 + cc * 2; return st * 1024 + (ob ^ (((ob >> 9) & 1) << 5)); }
__host__ __device__ __forceinline__ void stage_rc(int b, int& R, int& C) { const int st = b / 1024, sb = b % 1024, swz = sb ^ (((sb >> 9) & 1) << 5); R = (st >> 1) * 16 + swz / 64; C = (st & 1) * 32 + (swz % 64) / 2; }
__host__ __device__ __forceinline__ int perm32(int rho) { const int n = rho >> 4, i = rho & 15; return 8 * (i >> 2) + 4 * n + (i & 3); }
struct Unit { int pm, pn; };
struct Gemm { const bf16_t* A; const bf16_t* Bt; int M, N, K; };
struct StaticOrder {
    int nM, nN, nwg, G, c;
    __device__ void init(int M, int N, int G_, int c_) { nM = M / BM; nN = N / BM; nwg = nM * nN; G = G_; c = c_; }
    __device__ bool next(int i, Unit& u) const {
        const long L = (long)i * G + c; if (L >= nwg) return false;
        int wgid = (int)L; { const int q = nwg / NXCD, r = nwg % NXCD, xcd = wgid % NXCD, off = wgid / NXCD; wgid = (xcd < r ? xcd * (q + 1) : r * (q + 1) + (xcd - r) * q) + off; }
        const int nig = WGM * nN, gid = wgid / nig, fm = gid * WGM, gsz = (nM - fm) < WGM ? (nM - fm) : WGM;
        u.pm = fm + ((wgid % nig) % gsz); u.pn = (wgid % nig) / gsz; return true;
    }
};
template <class Epi, class Sched, bool ALIGN_EPI, bool SP2>
__device__ __forceinline__ void gemm_phase(LAS unsigned char* lds, const Gemm g, const Sched& S, const Epi& E) {
    const int tid = threadIdx.x, wid = __builtin_amdgcn_readfirstlane(tid >> 6), lane = tid & 63, wr = wid >> 2, wc = wid & 3, fr = lane & 15, fq = lane >> 4;
    const int K = g.K, nt = K / BK;
    unsigned voffA[2], voffB[2];
#pragma unroll
    for (int i = 0; i < 2; ++i) { int R, C; stage_rc(tid * 16 + i * 8192, R, C); const int Rb = Epi::PERM ? ((R & ~31) + perm32(R & 31)) : R;
        voffA[i] = (unsigned)(R * K + C) * 2u; voffB[i] = (unsigned)(Rb * K + C) * 2u; }
    const size_t kstep = (size_t)(BK * 2);
    const size_t hstep = (size_t)HALF * K * 2;
    const size_t tstep = 2 * hstep;
    const unsigned ldsw = (unsigned)wid * 1024u;
    const int aoff = lds_byte(wr * 64 + fr, fq * 8), boff = lds_byte(wc * 32 + fr, fq * 8);
#define PG8_SA(b, h) (((b) * 2 + (h)) * HTB)
#define PG8_SB(b, h) ((4 + (b) * 2 + (h)) * HTB)
#define PG8_STAGE(bufoff, gbase, voff) do { _Pragma("unroll") for (int _i = 0; _i < 2; ++_i) \
        __builtin_amdgcn_global_load_lds((const unsigned*)((const char*)(gbase) + (voff)[_i]), (LAS unsigned*)(lds + (bufoff) + ldsw + _i * 8192), 16, 0, 0); } while (0)
#define PG8_LDA(dst, b, h) do { _Pragma("unroll") for (int m = 0; m < 4; ++m) _Pragma("unroll") for (int k = 0; k < 2; ++k) dst[m][k] = *(const LAS bf16x8*)(lds + PG8_SA(b, h) + aoff + m * 2048 + k * 1024); } while (0)
#define PG8_LDB(dst, b, h) do { _Pragma("unroll") for (int n = 0; n < 2; ++n) _Pragma("unroll") for (int k = 0; k < 2; ++k) dst[n][k] = *(const LAS bf16x8*)(lds + PG8_SB(b, h) + boff + n * 2048 + k * 1024); } while (0)
#define PG8_MMA(ai, bj, At, Bt) do { __builtin_amdgcn_s_setprio(1); _Pragma("unroll") for (int m = 0; m < 4; ++m) _Pragma("unroll") for (int n = 0; n < 2; ++n) _Pragma("unroll") for (int k = 0; k < 2; ++k) \
        acc[ai][bj][m][n] = __builtin_amdgcn_mfma_f32_16x16x32_bf16(Bt[n][k], At[m][k], acc[ai][bj][m][n], 0, 0, 0); __builtin_amdgcn_s_setprio(0); } while (0)
#define PG8_WAIT_V(n) asm volatile("s_waitcnt vmcnt(" #n ")" ::: "memory")
#define PG8_WAIT_L(n) asm volatile("s_waitcnt lgkmcnt(" #n ")" ::: "memory")
#define PG8_BAR __builtin_amdgcn_s_barrier()
#define PG8_SCHED __builtin_amdgcn_sched_barrier(0)
    Unit cur, nxt; int ui = 0;
    if (!S.next(0, cur)) return;
    f32x4 acc[2][2][4][2];
#pragma unroll
    for (int a = 0; a < 2; ++a)
#pragma unroll
        for (int b = 0; b < 2; ++b)
#pragma unroll
            for (int m = 0; m < 4; ++m)
#pragma unroll
                for (int n = 0; n < 2; ++n) acc[a][b][m][n] = (f32x4){0.f, 0.f, 0.f, 0.f};
    bf16x8 At[4][2], B0[2][2], B1[2][2];
    const char* cA = (const char*)g.A + (size_t)cur.pm * tstep; const char* cB = (const char*)g.Bt + (size_t)cur.pn * tstep;
    if constexpr (SP2) {
        PG8_STAGE(PG8_SB(0, 0), cB, voffB); PG8_STAGE(PG8_SB(0, 1), cB + hstep, voffB); PG8_STAGE(PG8_SA(0, 0), cA, voffA); PG8_STAGE(PG8_SA(0, 1), cA + hstep, voffA);
        if (wr == 1) PG8_BAR;
        PG8_WAIT_V(2); PG8_BAR;
        PG8_STAGE(PG8_SB(1, 0), cB + kstep, voffB); PG8_STAGE(PG8_SA(1, 0), cA + kstep, voffA); PG8_STAGE(PG8_SB(1, 1), cB + hstep + kstep, voffB);
        PG8_WAIT_V(6); PG8_BAR;
    } else {
        PG8_STAGE(PG8_SB(0, 0), cB, voffB); PG8_STAGE(PG8_SA(0, 0), cA, voffA); PG8_STAGE(PG8_SB(0, 1), cB + hstep, voffB); PG8_STAGE(PG8_SA(0, 1), cA + hstep, voffA);
        if (wr == 1) PG8_BAR;
        PG8_WAIT_V(4); PG8_BAR;
        PG8_STAGE(PG8_SB(1, 0), cB + kstep, voffB); PG8_STAGE(PG8_SA(1, 0), cA + kstep, voffA); PG8_STAGE(PG8_SB(1, 1), cB + hstep + kstep, voffB);
        PG8_WAIT_V(6); PG8_BAR;
    }
    for (;;) {
        const bool has_next = S.next(ui + 1, nxt);
        const char* nA = has_next ? (const char*)g.A + (size_t)nxt.pm * tstep : cA; const char* nB = has_next ? (const char*)g.Bt + (size_t)nxt.pn * tstep : cB;
#pragma unroll 1
        for (int t = 0; t < nt; t += 2) {
            const bool last = (t == nt - 2);
            if constexpr (Epi::MID) { if (t == nt / 2) E.mid(acc, cur, wr, wc, fr, fq); }
            const char* a1 = cA + (size_t)(t + 1) * kstep;
            const char* a2 = last ? nA : cA + (size_t)(t + 2) * kstep; const char* b2 = last ? nB : cB + (size_t)(t + 2) * kstep;
            const char* a3 = a2 + kstep; const char* b3 = b2 + kstep;
            if constexpr (SP2) {
            PG8_LDB(B0, 0, 0); PG8_LDB(B1, 0, 1); PG8_SCHED; PG8_LDA(At, 0, 0); PG8_STAGE(PG8_SA(1, 1), a1 + hstep, voffA);
            PG8_WAIT_V(8); PG8_WAIT_L(0); PG8_BAR; PG8_MMA(0, 0, At, B0); PG8_MMA(0, 1, At, B1); PG8_BAR; PG8_SCHED;
            PG8_LDA(At, 0, 1); PG8_STAGE(PG8_SB(0, 0), b2, voffB); PG8_STAGE(PG8_SB(0, 1), b2 + hstep, voffB); PG8_STAGE(PG8_SA(0, 0), a2, voffA);
            PG8_WAIT_V(8); PG8_WAIT_L(0); PG8_BAR; PG8_MMA(1, 0, At, B0); PG8_MMA(1, 1, At, B1); PG8_BAR; PG8_SCHED;
            PG8_LDB(B0, 1, 0); PG8_LDB(B1, 1, 1); PG8_SCHED; PG8_LDA(At, 1, 0); PG8_STAGE(PG8_SA(0, 1), a2 + hstep, voffA);
            PG8_WAIT_V(8); PG8_WAIT_L(0); PG8_BAR; PG8_MMA(0, 0, At, B0); PG8_MMA(0, 1, At, B1); PG8_BAR; PG8_SCHED;
            PG8_LDA(At, 1, 1); PG8_STAGE(PG8_SB(1, 0), b3, voffB); PG8_STAGE(PG8_SB(1, 1), b3 + hstep, voffB); PG8_STAGE(PG8_SA(1, 0), a3, voffA);
            PG8_WAIT_V(8); PG8_WAIT_L(0); PG8_BAR; PG8_MMA(1, 0, At, B0); PG8_MMA(1, 1, At, B1); PG8_BAR; PG8_SCHED;
            } else {
            PG8_LDB(B0, 0, 0); PG8_SCHED; PG8_LDA(At, 0, 0); PG8_STAGE(PG8_SA(1, 1), a1 + hstep, voffA);
            PG8_WAIT_L(8); PG8_BAR; PG8_WAIT_L(0); PG8_MMA(0, 0, At, B0); PG8_BAR; PG8_SCHED;
            PG8_LDB(B1, 0, 1); PG8_STAGE(PG8_SB(0, 0), b2, voffB);
            PG8_BAR; PG8_WAIT_L(0); PG8_MMA(0, 1, At, B1); PG8_BAR;
            PG8_LDA(At, 0, 1); PG8_STAGE(PG8_SA(0, 0), a2, voffA);
            PG8_BAR; PG8_WAIT_L(0); PG8_MMA(1, 0, At, B0); PG8_BAR; PG8_SCHED;
            PG8_STAGE(PG8_SB(0, 1), b2 + hstep, voffB);
            PG8_WAIT_V(6); PG8_BAR; PG8_MMA(1, 1, At, B1); PG8_BAR;
            PG8_LDB(B0, 1, 0); PG8_SCHED; PG8_LDA(At, 1, 0); PG8_STAGE(PG8_SA(0, 1), a2 + hstep, voffA);
            PG8_WAIT_L(8); PG8_BAR; PG8_WAIT_L(0); PG8_MMA(0, 0, At, B0); PG8_BAR; PG8_SCHED;
            PG8_LDB(B1, 1, 1); PG8_STAGE(PG8_SB(1, 0), b3, voffB);
            PG8_BAR; PG8_WAIT_L(0); PG8_MMA(0, 1, At, B1); PG8_BAR;
            PG8_LDA(At, 1, 1); PG8_STAGE(PG8_SA(1, 0), a3, voffA);
            PG8_BAR; PG8_WAIT_L(0); PG8_MMA(1, 0, At, B0); PG8_BAR; PG8_SCHED;
            PG8_STAGE(PG8_SB(1, 1), b3 + hstep, voffB);
            PG8_WAIT_V(6); PG8_BAR; PG8_MMA(1, 1, At, B1); PG8_BAR;
            }
        }
        if constexpr (ALIGN_EPI) { if (wr == 0) PG8_BAR; }
        E(acc, cur, wr, wc, fr, fq);
        if (!has_next) break;
#pragma unroll
        for (int a = 0; a < 2; ++a)
#pragma unroll
            for (int b = 0; b < 2; ++b)
#pragma unroll
                for (int m = 0; m < 4; ++m)
#pragma unroll
                    for (int n = 0; n < 2; ++n) acc[a][b][m][n] = (f32x4){0.f, 0.f, 0.f, 0.f};
        cur = nxt; cA = nA; cB = nB; ++ui;
        if constexpr (ALIGN_EPI) { if (wr == 1) PG8_BAR; }
    }
    PG8_WAIT_V(0);
    if constexpr (!ALIGN_EPI) { if (wr == 0) PG8_BAR; }
    PG8_BAR;
#undef PG8_SA
#undef PG8_SB
#undef PG8_STAGE
#undef PG8_LDA
#undef PG8_LDB
#undef PG8_MMA
#undef PG8_WAIT_V
#undef PG8_WAIT_L
#undef PG8_BAR
#undef PG8_SCHED
}
}
using pg8::HALF;

DEVI u32x4 pack8(const f32x4& a, const f32x4& b) { u32x4 w; w.x = pk2(a[0], a[1]); w.y = pk2(a[2], a[3]); w.z = pk2(b[0], b[1]); w.w = pk2(b[2], b[3]); return w; }

struct EpiIn {
    static constexpr bool PERM = true, MID = false;
    const float* rowss; const float* shW; int job;
    bf16_t *d0, *d1, *d2, *d3, *d4; float* ba;
    DEVI void operator()(const f32x4 (&acc)[2][2][4][2], const pg8::Unit& u, int wr, int wc, int fr, int fq) const {
        asm volatile("" : "+v"(fr), "+v"(fq));
        const int vs = u.pm < 64 ? 0 : (u.pm < 128 ? 1 : 2);
        bf16_t* base; int pitch, colt; bool isba = false;
        if (job == 0) { base = d0; pitch = 3072; colt = u.pn * 256; if (u.pn >= 12) isba = true; }
        else {
            if (u.pn < 4) { base = d0; pitch = 1024; colt = u.pn * 256; }
            else if (u.pn < 8) { base = d1; pitch = 1024; colt = (u.pn - 4) * 256; }
            else if (u.pn == 8) { base = d2; pitch = 256; colt = 0; }
            else if (u.pn == 9) { base = d3; pitch = 256; colt = 0; }
            else { base = d4; pitch = 2048; colt = (u.pn - 10) * 256; }
        }
        const int ncol0 = u.pn * 256 + wc * 32 + 8 * fq;
        f32x4 sv[2][2];
#pragma unroll
        for (int bj = 0; bj < 2; ++bj)
#pragma unroll
            for (int n = 0; n < 2; ++n) sv[bj][n] = *(const f32x4*)(shW + vs * NSH + ncol0 + bj * HALF + 4 * n);
        const int row0 = u.pm * 256 + wr * 64 + fr;
#pragma unroll
        for (int ai = 0; ai < 2; ++ai)
#pragma unroll
            for (int m = 0; m < 4; ++m) {
                const int row = row0 + ai * HALF + m * 16;
                const float rs = rsqrtf(rowss[row] * (1.f / 1024.f) + EPS);
                if (!isba) {
                    bf16_t* rowp = base + (size_t)row * pitch + colt + wc * 32 + 8 * fq;
#pragma unroll
                    for (int bj = 0; bj < 2; ++bj) { const f32x4 v0 = acc[ai][bj][m][0] * rs + sv[bj][0], v1 = acc[ai][bj][m][1] * rs + sv[bj][1]; *(u32x4*)(rowp + bj * HALF) = pack8(v0, v1); }
                } else if (wc == 0) {
                    float* rowp = ba + (size_t)row * 32 + 8 * fq;
                    *(f32x4*)(rowp) = acc[ai][0][m][0] * rs + sv[0][0]; *(f32x4*)(rowp + 4) = acc[ai][0][m][1] * rs + sv[0][1];
                }
            }
    }
};
struct EpiBr {
    static constexpr bool PERM = true, MID = true;
    const bf16_t* mg; bf16_t* out;
    DEVI void mid(f32x4 (&acc)[2][2][4][2], const pg8::Unit& u, int wr, int wc, int fr, int fq) const {
        asm volatile("" : "+v"(fr), "+v"(fq));
        const int row0 = u.pm * 256 + wr * 64 + fr, col0 = u.pn * 256 + wc * 32 + 8 * fq;
#pragma unroll
        for (int ai = 0; ai < 2; ++ai)
#pragma unroll
            for (int m = 0; m < 4; ++m) {
                const bf16_t* rp = mg + (size_t)(row0 + ai * HALF + m * 16) * 2048 + col0;
#pragma unroll
                for (int bj = 0; bj < 2; ++bj) {
                    const u32x4 gd = *(const u32x4*)(rp + bj * HALF), ga = *(const u32x4*)(rp + 1024 + bj * HALF);
                    float r[8];
#pragma unroll
                    for (int i = 0; i < 4; ++i) {
                        const float d0 = bflo(gd[i]), d1 = bfhi(gd[i]), a0 = bflo(ga[i]), a1 = bfhi(ga[i]);
                        r[2 * i] = (1.f + __expf(fminf(-a0, 80.f))) * __builtin_amdgcn_rcpf(1.f + __expf(fminf(-d0, 80.f)));
                        r[2 * i + 1] = (1.f + __expf(fminf(-a1, 80.f))) * __builtin_amdgcn_rcpf(1.f + __expf(fminf(-d1, 80.f)));
                    }
                    acc[ai][bj][m][0] *= (f32x4){r[0], r[1], r[2], r[3]}; acc[ai][bj][m][1] *= (f32x4){r[4], r[5], r[6], r[7]};
                    asm volatile("" ::: "memory");
                }
            }
    }
    DEVI void operator()(const f32x4 (&acc)[2][2][4][2], const pg8::Unit& u, int wr, int wc, int fr, int fq) const {
        asm volatile("" : "+v"(fr), "+v"(fq));
        const int row0 = u.pm * 256 + wr * 64 + fr, col0 = u.pn * 256 + wc * 32 + 8 * fq;
#pragma unroll
        for (int ai = 0; ai < 2; ++ai)
#pragma unroll
            for (int m = 0; m < 4; ++m) {
                const size_t row = (size_t)(row0 + ai * HALF + m * 16);
                const bf16_t* rp = mg + row * 2048 + 1024 + col0;
#pragma unroll
                for (int bj = 0; bj < 2; ++bj) {
                    const u32x4 ga = *(const u32x4*)(rp + bj * HALF);
                    float s[8];
#pragma unroll
                    for (int i = 0; i < 4; ++i) { s[2 * i] = __builtin_amdgcn_rcpf(1.f + __expf(fminf(-bflo(ga[i]), 80.f))); s[2 * i + 1] = __builtin_amdgcn_rcpf(1.f + __expf(fminf(-bfhi(ga[i]), 80.f))); }
                    const f32x4 v0 = acc[ai][bj][m][0] * (f32x4){s[0], s[1], s[2], s[3]}, v1 = acc[ai][bj][m][1] * (f32x4){s[4], s[5], s[6], s[7]};
                    *(u32x4*)(out + row * 1024 + col0 + bj * HALF) = pack8(v0, v1);
                }
            }
    }
};
struct EpiOut {
    static constexpr bool PERM = false, MID = false;
    const float* x; const float* modacc; const float* bada; const float* nwf; float* out; bf16_t* x1s; float* rowss2;
    DEVI void operator()(const f32x4 (&acc)[2][2][4][2], const pg8::Unit& u, int wr, int wc, int fr, int fq) const {
        asm volatile("" : "+v"(fr), "+v"(fq));
        const int b = u.pm >> 6; const int row0 = u.pm * 256 + wr * 64 + fr, col0 = u.pn * 256 + wc * 32 + 4 * fq;
        f32x4 ga[2][2], sc[2][2];
#pragma unroll
        for (int bj = 0; bj < 2; ++bj)
#pragma unroll
            for (int n = 0; n < 2; ++n) { const int c = col0 + bj * HALF + n * 16;
                ga[bj][n] = *(const f32x4*)(modacc + b * 6144 + 2048 + c) + *(const f32x4*)(bada + 2048 + c);
                sc[bj][n] = (*(const f32x4*)(modacc + b * 6144 + 4096 + c) + *(const f32x4*)(bada + 4096 + c) + 1.f) * *(const f32x4*)(nwf + c); }
#pragma unroll
        for (int ai = 0; ai < 2; ++ai)
#pragma unroll
            for (int m = 0; m < 4; ++m) {
                const size_t off = (size_t)(row0 + ai * HALF + m * 16) * 1024 + col0; float ss = 0.f;
#pragma unroll
                for (int bj = 0; bj < 2; ++bj)
#pragma unroll
                    for (int n = 0; n < 2; ++n) {
                        const f32x4 xv = *(const f32x4*)(x + off + bj * HALF + n * 16);
                        const f32x4 o = xv + ga[bj][n] * acc[ai][bj][m][n];
                        *(f32x4*)(out + off + bj * HALF + n * 16) = o;
                        ss += (o[0] * o[0] + o[1] * o[1]) + (o[2] * o[2] + o[3] * o[3]);
                        const f32x4 s = o * sc[bj][n]; u32x2 w; w.x = pk2(s[0], s[1]); w.y = pk2(s[2], s[3]);
                        *(u32x2*)(x1s + off + bj * HALF + n * 16) = w;
                    }
                ss += __shfl_xor(ss, 16); ss += __shfl_xor(ss, 32);
                if (fq == 0) atomicAdd(rowss2 + row0 + ai * HALF + m * 16, ss);
            }
    }
};
struct EpiUp {
    static constexpr bool PERM = true, MID = false;
    const float* rowss2; const float* shWf; bf16_t* u_;
    DEVI void operator()(const f32x4 (&acc)[2][2][4][2], const pg8::Unit& u, int wr, int wc, int fr, int fq) const {
        asm volatile("" : "+v"(fr), "+v"(fq));
        const int row0 = u.pm * 256 + wr * 64 + fr, col0 = u.pn * 256 + wc * 32 + 8 * fq;
#pragma unroll
        for (int bj = 0; bj < 2; ++bj) {
            const f32x4 sv0 = *(const f32x4*)(shWf + col0 + bj * HALF), sv1 = *(const f32x4*)(shWf + col0 + bj * HALF + 4);
#pragma unroll
            for (int ai = 0; ai < 2; ++ai)
#pragma unroll
                for (int m = 0; m < 4; ++m) {
                    const int row = row0 + ai * HALF + m * 16;
                    const float rs = rsqrtf(rowss2[row] * (1.f / 1024.f) + EPS);
                    const f32x4 v0 = acc[ai][bj][m][0] * rs + sv0, v1 = acc[ai][bj][m][1] * rs + sv1;
                    *(u32x4*)(u_ + (size_t)row * NUP + col0 + bj * HALF) = pack8(v0, v1);
                }
        }
    }
};
struct EpiDown {
    static constexpr bool PERM = false, MID = false;
    const float* modacc; const float* bada; float* out;
    DEVI void operator()(const f32x4 (&acc)[2][2][4][2], const pg8::Unit& u, int wr, int wc, int fr, int fq) const {
        asm volatile("" : "+v"(fr), "+v"(fq));
        const int b = u.pm >> 6; const int row0 = u.pm * 256 + wr * 64 + fr, col0 = u.pn * 256 + wc * 32 + 4 * fq;
        f32x4 gf[2][2];
#pragma unroll
        for (int bj = 0; bj < 2; ++bj)
#pragma unroll
            for (int n = 0; n < 2; ++n) { const int c = col0 + bj * HALF + n * 16; gf[bj][n] = *(const f32x4*)(modacc + b * 6144 + 5120 + c) + *(const f32x4*)(bada + 5120 + c); }
#pragma unroll
        for (int ai = 0; ai < 2; ++ai)
#pragma unroll
            for (int m = 0; m < 4; ++m) {
                const size_t off = (size_t)(row0 + ai * HALF + m * 16) * 1024 + col0;
#pragma unroll
                for (int bj = 0; bj < 2; ++bj)
#pragma unroll
                    for (int n = 0; n < 2; ++n) { float* p = out + off + bj * HALF + n * 16; *(f32x4*)p = *(const f32x4*)p + gf[bj][n] * acc[ai][bj][m][n]; }
            }
    }
};

DEVI void transpose_item(const float* W, int srcN, int k0, int n0, bf16_t* dst  , int dstK, LAS float* scr, int lane) {
#pragma unroll 8
    for (int i = 0; i < 32; ++i) { const int kk = 2 * i + (lane >> 5); scr[kk * 33 + (lane & 31)] = W[(size_t)(k0 + kk) * srcN + n0 + (lane & 31)]; }
    asm volatile("s_waitcnt lgkmcnt(0)" ::: "memory");
    const int c = lane & 7;
#pragma unroll
    for (int j = 0; j < 4; ++j) { const int n = (lane >> 3) + 8 * j; const LAS float* s = scr + (8 * c) * 33 + n;
        u32x4 o; o.x = pk2(s[0 * 33], s[1 * 33]); o.y = pk2(s[2 * 33], s[3 * 33]); o.z = pk2(s[4 * 33], s[5 * 33]); o.w = pk2(s[6 * 33], s[7 * 33]);
        *(u32x4*)(dst + (size_t)n * dstK + 8 * c) = o; }
    asm volatile("s_waitcnt lgkmcnt(0)" ::: "memory");
}
DEVI void phase0(const Args& a, LAS unsigned char* lds, int tid, int lane, int wave) {
    unsigned char* ws = a.ws;
    bf16_t* WinA = (bf16_t*)(ws + WS_WINA); bf16_t* WinC = (bf16_t*)(ws + WS_WINC); bf16_t* Wbr = (bf16_t*)(ws + WS_WBR);
    bf16_t* Wout = (bf16_t*)(ws + WS_WOUT); bf16_t* Wup = (bf16_t*)(ws + WS_WUP); bf16_t* Wdn = (bf16_t*)(ws + WS_WDN);
    LAS float* scr = (LAS float*)(lds + wave * 16384);
    const int gw = blockIdx.x * 8 + wave, NGW = gridDim.x * 8;
    constexpr int I_IN = 16 * 241, I_BR = 16 * 32, I_UP = 16 * 176, I_DN = 44 * 32;
    constexpr int NITEMS = I_IN + 3 * I_BR + I_UP + I_DN;
    for (int it = gw; it < NITEMS; it += NGW) {
        int r = it;
        if (r < I_IN) { const int kb = r / 241, nb = r % 241, c0 = nb * 32; bf16_t* d; int row;
            if (c0 < 3072) { d = WinA; row = c0; } else if (c0 < 4096) { d = WinC; row = c0 - 3072; } else if (c0 == 4096) { d = WinA; row = 3072; }
            else if (c0 < 5152) { d = WinC; row = 1024 + (c0 - 4128); } else if (c0 < 5408) { d = WinC; row = 2048 + (c0 - 5152); }
            else if (c0 < 5664) { d = WinC; row = 2304 + (c0 - 5408); } else { d = WinC; row = 2560 + (c0 - 5664); }
            transpose_item(a.in[8], 7712, kb * 64, c0, d + (size_t)row * 1024 + kb * 64, 1024, scr, lane); continue; }
        r -= I_IN;
        if (r < I_BR) { const int kb = r / 32, nb = r % 32; transpose_item(a.in[16], 1024, kb * 64, nb * 32, Wbr + (size_t)(nb * 32) * 2048 + kb * 64, 2048, scr, lane); continue; }
        r -= I_BR;
        if (r < I_BR) { const int kb = r / 32, nb = r % 32; transpose_item(a.in[17], 1024, kb * 64, nb * 32, Wbr + (size_t)(nb * 32) * 2048 + 1024 + kb * 64, 2048, scr, lane); continue; }
        r -= I_BR;
        if (r < I_BR) { const int kb = r / 32, nb = r % 32; transpose_item(a.in[18], 1024, kb * 64, nb * 32, Wout + (size_t)(nb * 32) * 1024 + kb * 64, 1024, scr, lane); continue; }
        r -= I_BR;
        if (r < I_UP) { const int kb = r / 176, nb = r % 176, c0 = nb * 32; int row;
            if (c0 < DFF) row = 256 * (c0 / 128) + (c0 % 128); else { const int c1 = c0 - DFF; row = 256 * (c1 / 128) + 128 + (c1 % 128); }
            transpose_item(a.in[19], NUP, kb * 64, c0, Wup + (size_t)row * 1024 + kb * 64, 1024, scr, lane); continue; }
        r -= I_UP;
        { const int kb = r / 32, nb = r % 32; transpose_item(a.in[22], 1024, kb * 64, nb * 32, Wdn + (size_t)(nb * 32) * DFF + kb * 64, DFF, scr, lane); }
    }
    float* modacc = (float*)(ws + CTL_MODACC);
    for (int it = blockIdx.x; it < 12 * 16; it += gridDim.x) {
        const int cb = it % 12, ks = it / 12, n = cb * 512 + tid;
        float a0 = 0.f, a1 = 0.f, a2 = 0.f;
#pragma unroll 8
        for (int k = ks * 64; k < ks * 64 + 64; ++k) {
            const float w = a.in[4][(size_t)k * 6144 + n];
            a0 += siluf(a.in[1][k]) * w; a1 += siluf(a.in[1][1024 + k]) * w; a2 += siluf(a.in[3][k]) * w;
        }
        atomicAdd(modacc + n, a0); atomicAdd(modacc + 6144 + n, a1); atomicAdd(modacc + 12288 + n, a2);
    }
    float* rope = (float*)(ws + SM_ROPE);
    for (int i = blockIdx.x * 512 + tid; i < 320 * 32; i += gridDim.x * 512) {
        const int p = i >> 5, f = i & 31; const float inv = powf(10000.f, -(float)f / 32.f);
        if (p < 256) { const float ang = (float)p * inv; rope[p * 32 + f] = cosf(ang); rope[8192 + p * 32 + f] = sinf(ang); }
        else { const int q = p - 256; const float ang = (float)q * inv; rope[16384 + q * 32 + f] = cosf(ang); rope[16384 + 2048 + q * 32 + f] = sinf(ang); }
    }
}

DEVI void phase1(const Args& a, int tid, int lane, int wave) {
    unsigned char* ws = a.ws;
    const float* modacc = (const float*)(ws + CTL_MODACC); const float* bada = a.in[5];
    bf16_t* XN = (bf16_t*)(ws + WS_XN); float* rowss1 = (float*)(ws + SM_ROWSS1);
    const int gw = blockIdx.x * 8 + wave, NGW = gridDim.x * 8;
    for (int row = gw; row < MT; row += NGW) {
        const int vs = row < SEQ ? 0 : (row < ML ? 1 : 2);
        const float* xr = row < ML ? a.in[0] + (size_t)row * 1024 : a.in[2] + (size_t)(row - ML) * 1024;
        float ss = 0.f;
#pragma unroll
        for (int j = 0; j < 4; ++j) {
            const int c = 4 * lane + 256 * j;
            const f32x4 v = *(const f32x4*)(xr + c);
            ss += (v[0] * v[0] + v[1] * v[1]) + (v[2] * v[2] + v[3] * v[3]);
            const f32x4 s = (*(const f32x4*)(modacc + vs * 6144 + 1024 + c) + *(const f32x4*)(bada + 1024 + c) + 1.f) * *(const f32x4*)(a.in[6] + c);
            const f32x4 o = v * s; u32x2 w; w.x = pk2(o[0], o[1]); w.y = pk2(o[2], o[3]);
            *(u32x2*)(XN + (size_t)row * 1024 + c) = w;
        }
        ss = wave_sum(ss);
        if (lane == 0) rowss1[row] = ss;
    }
    const bf16_t* WinA = (const bf16_t*)(ws + WS_WINA); const bf16_t* WinC = (const bf16_t*)(ws + WS_WINC); const bf16_t* Wup = (const bf16_t*)(ws + WS_WUP);
    float* shWa = (float*)(ws + SM_SHWA); float* shWf = (float*)(ws + SM_SHWF);
    for (int n = gw; n < NSH + NUP; n += NGW) {
        const bool isf = n >= NSH;
        const bf16_t* wrow = isf ? Wup + (size_t)(n - NSH) * 1024 : (n < NA ? WinA + (size_t)n * 1024 : WinC + (size_t)(n - NA) * 1024);
        const int shoff = isf ? 3072 : 0;
        float s0 = 0.f, s1 = 0.f, s2 = 0.f;
#pragma unroll
        for (int h = 0; h < 2; ++h) {
            const int k0 = h * 512 + lane * 8;
            const u32x4 w = *(const u32x4*)(wrow + k0);
#pragma unroll
            for (int i = 0; i < 4; ++i) {
                const float wl = bflo(w[i]), wh = bfhi(w[i]); const int k = k0 + 2 * i;
                const float b0 = bada[shoff + k], b1 = bada[shoff + k + 1];
                s0 += (modacc[shoff + k] + b0) * wl + (modacc[shoff + k + 1] + b1) * wh;
                s1 += (modacc[6144 + shoff + k] + b0) * wl + (modacc[6144 + shoff + k + 1] + b1) * wh;
                s2 += (modacc[12288 + shoff + k] + b0) * wl + (modacc[12288 + shoff + k + 1] + b1) * wh;
            }
        }
        s0 = wave_sum(s0); s1 = wave_sum(s1); s2 = wave_sum(s2);
        if (lane == 0) {
            if (isf) { shWf[n - NSH] = s0; shWf[NUP + n - NSH] = s1; }
            else { shWa[n] = s0; shWa[NSH + n] = s1; shWa[2 * NSH + n] = s2; }
        }
    }
}

DEVI void phase_dnprep(const Args& a, int tid) {
    unsigned char* ws = a.ws;
    const bf16_t* QR = (const bf16_t*)(ws + WS_QKVR); bf16_t* QP = (bf16_t*)(ws + WS_QKVP);
    const float* convw = a.in[9]; const float* ba = (const float*)(ws + WS_BA);
    float* gb = (float*)(ws + WS_G); float* bb = (float*)(ws + WS_BETA);
    const int cg_ = tid & 15, rr = tid >> 4;
    for (int it = blockIdx.x; it < 520 * 24; it += gridDim.x) {
        const int cidx = it / 24, s = it % 24;
        int seq_start, t0, seq_len;
        if (cidx < 512) { seq_start = (cidx >> 8) * SEQ; t0 = (cidx & 255) * 64; seq_len = SEQ; }
        else { const int c2 = cidx - 512; seq_start = ML + (c2 >> 2) * CTX; t0 = (c2 & 3) * 64; seq_len = CTX; }
        const int col = s * 128 + cg_ * 8;
        f32x4 w0[5], w1[5];
#pragma unroll
        for (int j = 0; j < 5; ++j) { w0[j] = *(const f32x4*)(convw + j * 3072 + col); w1[j] = *(const f32x4*)(convw + j * 3072 + col + 4); }
#pragma unroll
        for (int pass = 0; pass < 2; ++pass) {
            const int r = rr + pass * 32;
            f32x4 acc0 = {0.f, 0.f, 0.f, 0.f}, acc1 = {0.f, 0.f, 0.f, 0.f};
#pragma unroll
            for (int j = 0; j < 5; ++j) {
                const int tt = t0 + r + j - 2;
                if (tt >= 0 && tt < seq_len) {
                    const u32x4 x = *(const u32x4*)(QR + (size_t)(seq_start + tt) * 3072 + col);
                    acc0 += (f32x4){bflo(x[0]), bfhi(x[0]), bflo(x[1]), bfhi(x[1])} * w0[j];
                    acc1 += (f32x4){bflo(x[2]), bfhi(x[2]), bflo(x[3]), bfhi(x[3])} * w1[j];
                }
            }
            float y[8];
#pragma unroll
            for (int i = 0; i < 4; ++i) { y[i] = siluf(acc0[i]); y[4 + i] = siluf(acc1[i]); }
            if (s < 16) {
                float ss = 0.f;
#pragma unroll
                for (int i = 0; i < 8; ++i) ss += y[i] * y[i];
                ss += __shfl_xor(ss, 1); ss += __shfl_xor(ss, 2); ss += __shfl_xor(ss, 4); ss += __shfl_xor(ss, 8);
                const float sc = rsqrtf(ss + EPS) * (s < 8 ? 0.08838834764831845f : 1.f);
#pragma unroll
                for (int i = 0; i < 8; ++i) y[i] *= sc;
            }
            u32x4 o; o.x = pk2(y[0], y[1]); o.y = pk2(y[2], y[3]); o.z = pk2(y[4], y[5]); o.w = pk2(y[6], y[7]);
            *(u32x4*)(QP + (size_t)(seq_start + t0 + r) * 3072 + col) = o;
        }
        if (s == 0) {
#pragma unroll
            for (int q = 0; q < 2; ++q) {
                const int e = tid + q * 512, r = e >> 4, idx = e & 15, row = seq_start + t0 + r;
                const float bv = ba[(size_t)row * 32 + idx], av = ba[(size_t)row * 32 + 16 + idx];
                const float xs = av + a.in[11][idx];
                const float sp = fmaxf(xs, 0.f) + log1pf(expf(-fabsf(xs)));
                const float g = -expf(a.in[10][idx]) * sp;
                const int dir = idx >> 3, h = idx & 7;
                gb[((size_t)dir * MT + row) * 8 + h] = g;
                bb[((size_t)dir * MT + row) * 8 + h] = 1.f / (1.f + expf(-bv));
            }
        }
    }
}

DEVI void phase_dnscan(const Args& a, int lane, int wave) {
    unsigned char* ws = a.ws;
    const bf16_t* QP = (const bf16_t*)(ws + WS_QKVP);
    const float* gb = (const float*)(ws + WS_G); const float* bb = (const float*)(ws + WS_BETA);
    bf16_t* Of = (bf16_t*)a.out; bf16_t* Ob = Of + (size_t)ML * 1024;
    const int gw = blockIdx.x * 8 + wave, NGW = gridDim.x * 8;
    for (int item = gw; item < 2048; item += NGW) {
        const int chain = item >> 6, ep = item & 63, dir = chain >> 4, b = (chain >> 3) & 1, h = chain & 7;
        bf16_t* O = dir ? Ob : Of;
        float S00 = 0.f, S01 = 0.f, S10 = 0.f, S11 = 0.f;
        const int NTOK = CTX + SEQ;
        constexpr int U = 4;
        unsigned kq[U], qq[U], vv[U]; float gg[U], be[U]; int rows[U];
        auto rowof = [&](int s) -> int { if (s < CTX) { const int t = dir ? CTX - 1 - s : s; return ML + b * CTX + t; } const int t2 = s - CTX; const int t = dir ? SEQ - 1 - t2 : t2; return b * SEQ + t; };
#define SC_LOAD(i, s) do { const int row_ = rowof(s); rows[i] = row_; const bf16_t* p_ = QP + (size_t)row_ * 3072 + h * 128; \
        qq[i] = *(const unsigned*)(p_ + 2 * lane); kq[i] = *(const unsigned*)(p_ + 1024 + 2 * lane); vv[i] = *(const unsigned*)(p_ + 2048 + 2 * ep); \
        gg[i] = gb[((size_t)dir * MT + row_) * 8 + h]; be[i] = bb[((size_t)dir * MT + row_) * 8 + h]; } while (0)
        for (int s0 = 0; s0 < NTOK; s0 += U) {
#pragma unroll
            for (int i = 0; i < U; ++i) SC_LOAD(i, s0 + i);
#pragma unroll
            for (int i = 0; i < U; ++i) {
                const float k0 = bflo(kq[i]), k1 = bfhi(kq[i]), q0 = bflo(qq[i]), q1 = bfhi(qq[i]), v0 = bflo(vv[i]), v1 = bfhi(vv[i]);
                const float eg = __expf(gg[i]), bt = be[i];
                float p0 = k0 * S00 + k1 * S10, p1 = k0 * S01 + k1 * S11;
                p0 = wave_sum(p0); p1 = wave_sum(p1);
                const float vn0 = bt * (v0 - eg * p0), vn1 = bt * (v1 - eg * p1);
                S00 = eg * S00 + k0 * vn0; S01 = eg * S01 + k0 * vn1; S10 = eg * S10 + k1 * vn0; S11 = eg * S11 + k1 * vn1;
                float o0 = q0 * S00 + q1 * S10, o1 = q0 * S01 + q1 * S11;
                o0 = wave_sum(o0); o1 = wave_sum(o1);
                if (lane == 0 && rows[i] < ML) *(unsigned*)(O + (size_t)rows[i] * 1024 + h * 128 + 2 * ep) = pk2(o0, o1);
            }
        }
#undef SC_LOAD
    }
}

DEVI bf16x8 ld_b128(LAS const unsigned char* p) { return *(LAS const bf16x8*)p; }
DEVI bf16x8 ld_2b64(LAS const unsigned char* p0, LAS const unsigned char* p1) { const u32x2 a = *(LAS const u32x2*)p0, b = *(LAS const u32x2*)p1; u32x4 w = {a.x, a.y, b.x, b.y}; return __builtin_bit_cast(bf16x8, w); }
DEVI bf16x8 pack_frag(const f32x4& lo, const f32x4& hi) { u32x4 w = {pk2(lo[0], lo[1]), pk2(lo[2], lo[3]), pk2(hi[0], hi[1]), pk2(hi[2], hi[3])}; return __builtin_bit_cast(bf16x8, w); }
#define MFMA16(A, B, C) __builtin_amdgcn_mfma_f32_16x16x32_bf16(A, B, C, 0, 0, 0)
DEVI void phase_dnchunk(const Args& a, LAS unsigned char* lds, int tid, int lane, int wave) {
    unsigned char* ws = a.ws;
    const bf16_t* QP = (const bf16_t*)(ws + WS_QKVP); const float* gb = (const float*)(ws + WS_G); const float* bb = (const float*)(ws + WS_BETA);
    bf16_t* TQ = (bf16_t*)(ws + WS_TQ); float* AV = (float*)(ws + WS_AVEC);
    constexpr int KL = 0, QL = 17408, KKF = 34816, QKF = 52224, VEC = 131072;
    const int fr = lane & 15, g = lane >> 4, d = wave >> 2, wq = wave & 3;
    LAS unsigned char* dbase = lds + d * 64512;
    LAS float* Gg = (LAS float*)(lds + VEC); LAS float* Bv = Gg + 128; LAS float* GC = Gg + 256;
    for (int item = blockIdx.x; item < 520 * 8; item += gridDim.x) {
        const int cidx = item >> 3, h = item & 7;
        const int row0 = cidx < 512 ? cidx * 64 : ML + (cidx - 512) * 64;
#pragma unroll
        for (int i = 0; i < 2; ++i) { const int c = tid + i * 512, r = c >> 4, ch = c & 15;
            const bf16_t* src = QP + (size_t)(row0 + r) * 3072 + h * 128 + ch * 8;
            *(LAS u32x4*)(lds + QL + r * 272 + ch * 16) = *(const u32x4*)src; *(LAS u32x4*)(lds + KL + r * 272 + ch * 16) = *(const u32x4*)(src + 1024); }
        if (tid < 128) { const int dd = tid >> 6, pos = tid & 63; Gg[tid] = gb[((size_t)dd * MT + row0 + pos) * 8 + h]; Bv[tid] = bb[((size_t)dd * MT + row0 + pos) * 8 + h]; }
        __syncthreads();
        if (wave < 2) {
            const int dd = wave, pos = dd ? 63 - lane : lane; float x = Gg[dd * 64 + pos];
#pragma unroll
            for (int o = 1; o < 64; o <<= 1) { const float y = __shfl_up(x, o); if (lane >= o) x += y; }
            const float total = __shfl(x, 63);
            GC[dd * 64 + pos] = x;
            float* av = AV + ((size_t)item * 2 + dd) * 256;
            av[pos] = __expf(x); av[64 + pos] = Bv[dd * 64 + pos]; av[128 + pos] = __expf(total - x); if (lane == 0) av[192] = __expf(total);
        }
        {
            const int src = d ? QL : KL;
            f32x4 acc[4] = {{0.f, 0.f, 0.f, 0.f}, {0.f, 0.f, 0.f, 0.f}, {0.f, 0.f, 0.f, 0.f}, {0.f, 0.f, 0.f, 0.f}};
#pragma unroll
            for (int s4 = 0; s4 < 4; ++s4) { const bf16x8 A = ld_b128(lds + src + (16 * wq + fr) * 272 + (32 * s4 + 8 * g) * 2);
#pragma unroll
                for (int jt = 0; jt < 4; ++jt) { const bf16x8 Bf = ld_b128(lds + KL + (16 * jt + fr) * 272 + (32 * s4 + 8 * g) * 2); acc[jt] = MFMA16(A, Bf, acc[jt]); } }
            LAS float* dst = (LAS float*)(lds + (d ? QKF : KKF));
#pragma unroll
            for (int jt = 0; jt < 4; ++jt)
#pragma unroll
                for (int r = 0; r < 4; ++r) dst[(16 * wq + 4 * g + r) * 68 + 16 * jt + fr] = acc[jt][r];
        }
        __syncthreads();
        f32x4 P[4], qd[4];
        {
            const LAS float* kkf = (const LAS float*)(lds + KKF); const LAS float* qkf = (const LAS float*)(lds + QKF);
            float gci[4], bei[4];
#pragma unroll
            for (int r = 0; r < 4; ++r) { gci[r] = GC[d * 64 + 16 * wq + 4 * g + r]; bei[r] = Bv[d * 64 + 16 * wq + 4 * g + r]; }
#pragma unroll
            for (int jt = 0; jt < 4; ++jt) { const int j = 16 * jt + fr; const float gcj = GC[d * 64 + j];
#pragma unroll
                for (int r = 0; r < 4; ++r) { const int i = 16 * wq + 4 * g + r; const bool incl = d ? (i <= j) : (i >= j);
                    const float e = incl ? __expf(gci[r] - gcj) : 0.f;
                    qd[jt][r] = qkf[i * 68 + j] * e; P[jt][r] = (i != j) ? -bei[r] * kkf[i * 68 + j] * e : 0.f; } }
        }
        __syncthreads();
        {
#pragma unroll
            for (int jt = 0; jt < 4; ++jt) {
#pragma unroll
                for (int r = 0; r < 4; ++r) { const int i = 16 * wq + 4 * g + r, j = 16 * jt + fr;
                    *(LAS unsigned short*)(dbase + 0 + i * 144 + j * 2) = (unsigned short)f2bf(P[jt][r]);
                    *(LAS unsigned short*)(dbase + 36864 + 9216 + i * 144 + j * 2) = (unsigned short)f2bf(P[jt][r]);
                    *(LAS unsigned short*)(dbase + 55296 + i * 144 + j * 2) = (unsigned short)f2bf(qd[jt][r]); }
                u32x2 w = {pk2(P[jt][0], P[jt][1]), pk2(P[jt][2], P[jt][3])};
                *(LAS u32x2*)(dbase + 18432 + (16 * jt + fr) * 144 + (16 * wq + 4 * g) * 2) = w; }
        }
        __syncthreads();
        int cur = 0;
#pragma unroll 1
        for (int it = 0; it < 5; ++it) {
            LAS unsigned char* NRc = dbase + cur * 9216; LAS unsigned char* NTc = dbase + 18432 + cur * 9216;
            LAS unsigned char* NRn = dbase + (cur ^ 1) * 9216; LAS unsigned char* NTn = dbase + 18432 + (cur ^ 1) * 9216;
            LAS unsigned char* PRo = dbase + 36864 + ((it + 1) & 1) * 9216; LAS unsigned char* PRn = dbase + 36864 + (it & 1) * 9216;
            f32x4 n2[4] = {{0.f, 0.f, 0.f, 0.f}, {0.f, 0.f, 0.f, 0.f}, {0.f, 0.f, 0.f, 0.f}, {0.f, 0.f, 0.f, 0.f}};
#pragma unroll
            for (int s2 = 0; s2 < 2; ++s2) { const bf16x8 A = ld_b128(NRc + (16 * wq + fr) * 144 + (32 * s2 + 8 * g) * 2);
#pragma unroll
                for (int jt = 0; jt < 4; ++jt) { const bf16x8 Bf = ld_b128(NTc + (16 * jt + fr) * 144 + (32 * s2 + 8 * g) * 2); n2[jt] = MFMA16(A, Bf, n2[jt]); } }
#pragma unroll
            for (int jt = 0; jt < 4; ++jt) {
#pragma unroll
                for (int r = 0; r < 4; ++r) *(LAS unsigned short*)(NRn + (16 * wq + 4 * g + r) * 144 + (16 * jt + fr) * 2) = (unsigned short)f2bf(n2[jt][r]);
                u32x2 w = {pk2(n2[jt][0], n2[jt][1]), pk2(n2[jt][2], n2[jt][3])};
                *(LAS u32x2*)(NTn + (16 * jt + fr) * 144 + (16 * wq + 4 * g) * 2) = w;
                P[jt] += n2[jt]; }
            __syncthreads();
#pragma unroll
            for (int s2 = 0; s2 < 2; ++s2) { const bf16x8 A = ld_b128(PRo + (16 * wq + fr) * 144 + (32 * s2 + 8 * g) * 2);
#pragma unroll
                for (int jt = 0; jt < 4; ++jt) { const bf16x8 Bf = ld_b128(NTn + (16 * jt + fr) * 144 + (32 * s2 + 8 * g) * 2); P[jt] = MFMA16(A, Bf, P[jt]); } }
#pragma unroll
            for (int jt = 0; jt < 4; ++jt)
#pragma unroll
                for (int r = 0; r < 4; ++r) *(LAS unsigned short*)(PRn + (16 * wq + 4 * g + r) * 144 + (16 * jt + fr) * 2) = (unsigned short)f2bf(P[jt][r]);
            cur ^= 1;
        }
        __syncthreads();
        {
            bf16_t* dst = TQ + ((size_t)item * 2 + d) * 8192; const int t2 = tid & 255;
#pragma unroll
            for (int k = 0; k < 4; ++k) { const int c = t2 + 256 * k, mat = c >> 9, r = (c >> 3) & 63, ch = c & 7;
                const u32x4 v = *(LAS const u32x4*)(dbase + (mat ? 55296 : 36864) + r * 144 + ch * 16);
                *(u32x4*)(dst + mat * 4096 + r * 64 + ch * 8) = v; }
        }
        __syncthreads();
    }
}

DEVI void phase_dnscan2(const Args& a, LAS unsigned char* lds, int tid, int lane, int wave) {
    const int v = blockIdx.x;
    if (v < 64) {
    unsigned char* ws = a.ws;
    const bf16_t* QP = (const bf16_t*)(ws + WS_QKVP); const bf16_t* TQ = (const bf16_t*)(ws + WS_TQ); const float* AV = (const float*)(ws + WS_AVEC);
    const int chain = (v & 7) + 8 * (v >> 4), hf = (v >> 3) & 1, dir = chain >> 4, b = (chain >> 3) & 1, h = chain & 7;
    bf16_t* O = (bf16_t*)a.out + (size_t)dir * ML * 1024;
    constexpr int KL = 0, QL = 17408, VL = 34816, TL = 44032, DL = 53248, AL = 62464, BUFB = 63488, OT = 2 * BUFB, NSTEP = 260;
    const int fr = lane & 15, g = lane >> 4, ltid = tid - 256;
    auto step_cidx = [&](int s) -> int { if (s < 4) return 512 + b * 4 + (dir ? 3 - s : s); const int c = s - 4; return b * 256 + (dir ? 255 - c : c); };
    u32x4 kreg[4], qreg[4], vreg[2], treg[2], dreg[2], areg;
#define LD_ISSUE(s_) do { const int cidx_ = step_cidx(s_); const int row0_ = cidx_ < 512 ? cidx_ * 64 : ML + (cidx_ - 512) * 64; \
        const bf16_t* tqb_ = TQ + ((size_t)(cidx_ * 8 + h) * 2 + dir) * 8192; const float* avb_ = AV + ((size_t)(cidx_ * 8 + h) * 2 + dir) * 256; \
        _Pragma("unroll") for (int i = 0; i < 4; ++i) { const int c = ltid + 256 * i, r = c >> 4, ch = c & 15; const bf16_t* p_ = QP + (size_t)(row0_ + r) * 3072 + h * 128 + ch * 8; qreg[i] = *(const u32x4*)p_; kreg[i] = *(const u32x4*)(p_ + 1024); } \
        _Pragma("unroll") for (int i = 0; i < 2; ++i) { const int c = ltid + 256 * i, r = c >> 3, ch = c & 7; vreg[i] = *(const u32x4*)(QP + (size_t)(row0_ + r) * 3072 + 2048 + h * 128 + hf * 64 + ch * 8); \
            treg[i] = *(const u32x4*)(tqb_ + r * 64 + ch * 8); dreg[i] = *(const u32x4*)(tqb_ + 4096 + r * 64 + ch * 8); } \
        if (ltid < 64) areg = *(const u32x4*)(avb_ + ltid * 4); } while (0)
#define LD_WRITE(bo_) do { LAS unsigned char* B_ = lds + (bo_); \
        _Pragma("unroll") for (int i = 0; i < 4; ++i) { const int c = ltid + 256 * i, r = c >> 4, ch = c & 15; *(LAS u32x4*)(B_ + QL + r * 272 + ch * 16) = qreg[i]; *(LAS u32x4*)(B_ + KL + r * 272 + ch * 16) = kreg[i]; } \
        _Pragma("unroll") for (int i = 0; i < 2; ++i) { const int c = ltid + 256 * i, r = c >> 3, ch = c & 7; *(LAS u32x4*)(B_ + VL + r * 144 + ch * 16) = vreg[i]; \
            *(LAS u32x4*)(B_ + TL + r * 144 + ch * 16) = treg[i]; *(LAS u32x4*)(B_ + DL + r * 144 + ch * 16) = dreg[i]; } \
        if (ltid < 64) *(LAS u32x4*)(B_ + AL + ltid * 16) = areg; } while (0)
#define OT_OUT(s_) do { const int cidx_ = step_cidx(s_); const int row0_ = cidx_ * 64; LAS const unsigned char* ot_ = lds + OT + ((s_) & 1) * 9216; \
        _Pragma("unroll") for (int i = 0; i < 2; ++i) { const int c = ltid + 256 * i, r = c >> 3, ch = c & 7; \
            *(u32x4*)(O + (size_t)(row0_ + r) * 1024 + h * 128 + hf * 64 + ch * 8) = *(LAS const u32x4*)(ot_ + r * 144 + ch * 16); } } while (0)
    f32x4 S[8];
#pragma unroll
    for (int i = 0; i < 8; ++i) S[i] = (f32x4){0.f, 0.f, 0.f, 0.f};
    if (wave >= 4) { LD_ISSUE(0); LD_WRITE(0); }
#pragma unroll 1
    for (int s = 0; s < NSTEP; ++s) {
        __syncthreads();
        if (wave >= 4) {
            if (s + 1 < NSTEP) LD_ISSUE(s + 1);
            if (s >= 5) OT_OUT(s - 1);
            if (s + 1 < NSTEP) LD_WRITE(((s + 1) & 1) * BUFB);
        } else {
            LAS const unsigned char* B = lds + (s & 1) * BUFB;
            const LAS float* avl = (const LAS float*)(B + AL);
            bf16x8 Sb[4];
#pragma unroll
            for (int s4 = 0; s4 < 4; ++s4) Sb[s4] = pack_frag(S[2 * s4], S[2 * s4 + 1]);
            f32x4 Z[4], OQ[4];
#pragma unroll
            for (int pt = 0; pt < 4; ++pt) { Z[pt] = (f32x4){0.f, 0.f, 0.f, 0.f}; OQ[pt] = (f32x4){0.f, 0.f, 0.f, 0.f};
#pragma unroll
                for (int s4 = 0; s4 < 4; ++s4) { const int off = (16 * pt + fr) * 272 + (32 * s4 + 4 * g) * 2;
                    Z[pt] = MFMA16(ld_2b64(B + KL + off, B + KL + off + 32), Sb[s4], Z[pt]);
                    OQ[pt] = MFMA16(ld_2b64(B + QL + off, B + QL + off + 32), Sb[s4], OQ[pt]); } }
            f32x4 av[4];
#pragma unroll
            for (int pt = 0; pt < 4; ++pt) { av[pt] = *(const LAS f32x4*)(avl + 16 * pt + 4 * g); const f32x4 bv = *(const LAS f32x4*)(avl + 64 + 16 * pt + 4 * g);
#pragma unroll
                for (int r = 0; r < 4; ++r) { const float vv = bf2f(*(const LAS unsigned short*)(B + VL + (16 * pt + 4 * g + r) * 144 + (16 * wave + fr) * 2)); Z[pt][r] = bv[r] * (vv - av[pt][r] * Z[pt][r]); } }
            f32x4 X[4];
            { const bf16x8 Zb0 = pack_frag(Z[0], Z[1]), Zb1 = pack_frag(Z[2], Z[3]);
#pragma unroll
              for (int pt = 0; pt < 4; ++pt) { const int off = (16 * pt + fr) * 144 + (4 * g) * 2;
                  X[pt] = MFMA16(ld_2b64(B + TL + off, B + TL + off + 32), Zb0, Z[pt]);
                  X[pt] = MFMA16(ld_2b64(B + TL + off + 64, B + TL + off + 96), Zb1, X[pt]); } }
            bf16x8 Xc0, Xc1;
            { const bf16x8 Xb0 = pack_frag(X[0], X[1]), Xb1 = pack_frag(X[2], X[3]);
              LAS unsigned char* ot = lds + OT + (s & 1) * 9216;
#pragma unroll
              for (int pt = 0; pt < 4; ++pt) { const int off = (16 * pt + fr) * 144 + (4 * g) * 2;
                  f32x4 o2 = av[pt] * OQ[pt];
                  o2 = MFMA16(ld_2b64(B + DL + off, B + DL + off + 32), Xb0, o2);
                  o2 = MFMA16(ld_2b64(B + DL + off + 64, B + DL + off + 96), Xb1, o2);
#pragma unroll
                  for (int r = 0; r < 4; ++r) *(LAS unsigned short*)(ot + (16 * pt + 4 * g + r) * 144 + (16 * wave + fr) * 2) = (unsigned short)f2bf(o2[r]); }
              f32x4 cx[4];
#pragma unroll
              for (int pt = 0; pt < 4; ++pt) cx[pt] = X[pt] * *(const LAS f32x4*)(avl + 128 + 16 * pt + 4 * g);
              Xc0 = pack_frag(cx[0], cx[1]); Xc1 = pack_frag(cx[2], cx[3]); }
            const float egl = avl[192];
            const int trq = fr >> 2, trp = fr & 3;
#pragma unroll
            for (int dt = 0; dt < 8; ++dt) {
                LAS unsigned char* kp = (LAS unsigned char*)(B + KL + (4 * g + trq) * 272 + (16 * dt + 4 * trp) * 2);
                const s16x4 a0 = __builtin_bit_cast(s16x4, __builtin_amdgcn_ds_read_tr16_b64_v4i16((LAS s16x4*)(kp)));
                const s16x4 a1 = __builtin_bit_cast(s16x4, __builtin_amdgcn_ds_read_tr16_b64_v4i16((LAS s16x4*)(kp + 16 * 272)));
                const s16x4 a2 = __builtin_bit_cast(s16x4, __builtin_amdgcn_ds_read_tr16_b64_v4i16((LAS s16x4*)(kp + 32 * 272)));
                const s16x4 a3 = __builtin_bit_cast(s16x4, __builtin_amdgcn_ds_read_tr16_b64_v4i16((LAS s16x4*)(kp + 48 * 272)));
                f32x4 sn = S[dt] * egl;
                sn = MFMA16(((bf16x8){a0[0], a0[1], a0[2], a0[3], a1[0], a1[1], a1[2], a1[3]}), Xc0, sn);
                sn = MFMA16(((bf16x8){a2[0], a2[1], a2[2], a2[3], a3[0], a3[1], a3[2], a3[3]}), Xc1, sn);
                S[dt] = sn; }
        }
    }
    __syncthreads();
    if (wave >= 4) OT_OUT(NSTEP - 1);
#undef LD_ISSUE
#undef LD_WRITE
#undef OT_OUT
    }
}

DEVI void phase_prep2(const Args& a, int lane, int wave) {
    unsigned char* ws = a.ws;
    bf16_t* KAT = (bf16_t*)(ws + WS_KAT); const float* rope = (const float*)(ws + SM_ROPE); const float* knw = a.in[14];
    const int gw = blockIdx.x * 8 + wave, NGW = gridDim.x * 8;
    for (int row = gw; row < MT; row += NGW) {
        bf16_t* p = KAT + (size_t)row * 256 + lane * 4;
        const u32x2 w = *(const u32x2*)p;
        float x[4] = {bflo(w.x), bfhi(w.x), bflo(w.y), bfhi(w.y)};
        float ss = (x[0] * x[0] + x[1] * x[1]) + (x[2] * x[2] + x[3] * x[3]);
        ss += __shfl_xor(ss, 1); ss += __shfl_xor(ss, 2); ss += __shfl_xor(ss, 4); ss += __shfl_xor(ss, 8); ss += __shfl_xor(ss, 16);
        const float rs = rsqrtf(ss * (1.f / 128.f) + EPS);
        const int d = (lane & 31) * 4;
        const f32x4 nw = *(const f32x4*)(knw + d);
#pragma unroll
        for (int i = 0; i < 4; ++i) x[i] = x[i] * rs * nw[i];
        float pr[4];
#pragma unroll
        for (int i = 0; i < 4; ++i) pr[i] = __shfl_xor(x[i], 8);
        if (row < ML) {
            const int t = row & (SEQ - 1), lg = (lane & 31) >> 3, fi = (lane & 7) * 4;
            const float* ct = lg < 2 ? rope + (t >> 6) * 32 + fi : rope + 16384 + (t & 63) * 32 + fi;
            const float* st = lg < 2 ? ct + 8192 : ct + 2048;
            const f32x4 c = *(const f32x4*)ct, s = *(const f32x4*)st;
            const float sg = (lg & 1) ? 1.f : -1.f;
#pragma unroll
            for (int i = 0; i < 4; ++i) x[i] = x[i] * c[i] + sg * pr[i] * s[i];
        }
        u32x2 o; o.x = pk2(x[0], x[1]); o.y = pk2(x[2], x[3]);
        *(u32x2*)p = o;
    }
    const bf16_t* Of = (const bf16_t*)a.out; const bf16_t* Ob = Of + (size_t)ML * 1024;
    const bf16_t* GT = (const bf16_t*)(ws + WS_GT); bf16_t* Y = (bf16_t*)(ws + WS_Y); const float* dnw = a.in[12];
    for (int row = gw; row < ML; row += NGW) {
        const int c0 = lane * 16;
        float o[16];
#pragma unroll
        for (int hh = 0; hh < 2; ++hh) {
            const u32x4 f = *(const u32x4*)(Of + (size_t)row * 1024 + c0 + hh * 8), bk = *(const u32x4*)(Ob + (size_t)row * 1024 + c0 + hh * 8);
#pragma unroll
            for (int i = 0; i < 4; ++i) { o[hh * 8 + 2 * i] = bflo(f[i]) + bflo(bk[i]); o[hh * 8 + 2 * i + 1] = bfhi(f[i]) + bfhi(bk[i]); }
        }
        float ss = 0.f;
#pragma unroll
        for (int i = 0; i < 16; ++i) ss += o[i] * o[i];
        ss += __shfl_xor(ss, 1); ss += __shfl_xor(ss, 2); ss += __shfl_xor(ss, 4);
        const float rs = rsqrtf(ss * (1.f / 128.f) + EPS);
        const int d0 = c0 & 127;
#pragma unroll
        for (int hh = 0; hh < 2; ++hh) {
            const u32x4 gt = *(const u32x4*)(GT + (size_t)row * 1024 + c0 + hh * 8);
            float y[8];
#pragma unroll
            for (int i = 0; i < 4; ++i) {
                y[2 * i] = o[hh * 8 + 2 * i] * rs * dnw[d0 + hh * 8 + 2 * i] * siluf(bflo(gt[i]));
                y[2 * i + 1] = o[hh * 8 + 2 * i + 1] * rs * dnw[d0 + hh * 8 + 2 * i + 1] * siluf(bfhi(gt[i]));
            }
            u32x4 w; w.x = pk2(y[0], y[1]); w.y = pk2(y[2], y[3]); w.z = pk2(y[4], y[5]); w.w = pk2(y[6], y[7]);
            *(u32x4*)(Y + (size_t)row * 2048 + c0 + hh * 8) = w;
        }
    }
}

namespace att {
constexpr int D = 128, NW = 8, QBLK = 32, KVBLK = 64;
constexpr float SCALE = 0.088388347648318440f;
constexpr float THR = 8.f;
constexpr int LDK = 256;
constexpr size_t SHM_V = KVBLK * D * 2, SHM_K = KVBLK * D * 2;
constexpr size_t OFF_WS = 2 * SHM_V + 2 * SHM_K, OFF_OST = OFF_WS + NW * 64 * 4;
#define KSWZ(row, colB) ((row) * 256 + ((colB) ^ (((row) & 7) << 4)))
#define SBAR() __builtin_amdgcn_sched_barrier(0)
DEVI int crow(int r, int hi) { return (r & 3) + 8 * (r >> 2) + 4 * hi; }
DEVI unsigned cvtpk(float lo, float hi) { unsigned r; asm volatile("v_cvt_pk_bf16_f32 %0, %1, %2" : "=v"(r) : "v"(lo), "v"(hi)); return r; }
DEVI void partialSM(f32x16& p0, f32x16& p1, float& m_reg, float& mn, float& alpha) {
    constexpr float C = SCALE * 1.4426950408889634f;
    float pmax = p0[0];
#pragma unroll
    for (int r = 1; r < 16; ++r) pmax = fmaxf(pmax, p0[r]);
#pragma unroll
    for (int r = 0; r < 16; ++r) pmax = fmaxf(pmax, p1[r]);
    { auto rr = __builtin_amdgcn_permlane32_swap(__float_as_uint(pmax), __float_as_uint(pmax), false, false);
      pmax = fmaxf(__uint_as_float(rr[0]), __uint_as_float(rr[1])); }
    if (__builtin_expect(__all(pmax - m_reg <= THR / SCALE), 1)) { mn = m_reg; alpha = 1.f; }
    else { mn = fmaxf(m_reg, pmax); alpha = __builtin_amdgcn_exp2f((m_reg - mn) * C); m_reg = mn; }
    const float mnC = -mn * C;
#pragma unroll
    for (int r = 0; r < 16; ++r) p0[r] = fmaf(p0[r], C, mnC);
#pragma unroll
    for (int r = 0; r < 16; ++r) p1[r] = fmaf(p1[r], C, mnC);
#pragma unroll
    for (int r = 0; r < 16; ++r) p0[r] = __builtin_amdgcn_exp2f(p0[r]);
}
DEVI void finishSM(f32x16& p0, f32x16& p1, float alpha, float& l_reg, bf16x8& pa0, bf16x8& pa1, bf16x8& pa2, bf16x8& pa3) {
#pragma unroll
    for (int r = 0; r < 16; ++r) p1[r] = __builtin_amdgcn_exp2f(p1[r]);
    float ps = 0;
#pragma unroll
    for (int r = 0; r < 16; ++r) ps += p0[r];
#pragma unroll
    for (int r = 0; r < 16; ++r) ps += p1[r];
    { auto rr = __builtin_amdgcn_permlane32_swap(__float_as_uint(ps), __float_as_uint(ps), false, false);
      ps = __uint_as_float(rr[0]) + __uint_as_float(rr[1]); }
    l_reg = l_reg * alpha + ps;
#define PK4(P, BASE, OUT) do { unsigned a0 = cvtpk(P[BASE + 0], P[BASE + 1]), a1 = cvtpk(P[BASE + 2], P[BASE + 3]);   \
    unsigned b0 = cvtpk(P[BASE + 4], P[BASE + 5]), b1 = cvtpk(P[BASE + 6], P[BASE + 7]);                              \
    auto r0 = __builtin_amdgcn_permlane32_swap(a0, b0, false, false); auto r1 = __builtin_amdgcn_permlane32_swap(a1, b1, false, false); \
    u32x4 w = {r0[0], r1[0], r0[1], r1[1]}; OUT = *reinterpret_cast<bf16x8*>(&w); } while (0)
    PK4(p0, 0, pa0); PK4(p0, 8, pa1); PK4(p1, 0, pa2); PK4(p1, 8, pa3);
#undef PK4
}
DEVI void qkt(f32x16& p0, f32x16& p1, const char* Ks, const bf16x8* qr, int r32, int hi) {
    p0 = f32x16{}; p1 = f32x16{};
#pragma unroll
    for (int d0 = 0; d0 < 8; ++d0) { const int cb = (d0 * 16 + hi * 8) * 2;
        const bf16x8 b0 = *reinterpret_cast<const bf16x8*>(Ks + KSWZ(r32, cb));
        const bf16x8 b1 = *reinterpret_cast<const bf16x8*>(Ks + KSWZ(32 + r32, cb));
        p0 = __builtin_amdgcn_mfma_f32_32x32x16_bf16(b0, qr[d0], p0, 0, 0, 0);
        p1 = __builtin_amdgcn_mfma_f32_32x32x16_bf16(b1, qr[d0], p1, 0, 0, 0); }
}
DEVI int v_st(int k, int c) { const int kk = (k & ~0xC) | ((k & 4) << 1) | ((k & 8) >> 1); return ((kk >> 3) * 4 + (c >> 5)) * 512 + ((kk & 7) * 32 + (c & 31)) * 2; }
DEVI int v_rd_base(int lane) { return ((lane & 3) << 3) | (((lane >> 2) & 3) << 6) | (((lane >> 4) & 1) << 5) | (((lane >> 5) & 1) << 8); }
constexpr int v_rd_off(int d0, int ks, int half) { return d0 * 512 + ks * 4096 + half * 2048; }
template <int OFF> DEVI s16x4 tr_read(int vb) { s16x4 r; asm volatile("ds_read_b64_tr_b16 %0, %1 offset:%2" : "=&v"(r) : "v"(vb), "i"(OFF) : "memory"); return r; }
template <int D0> DEVI void pv_one(f32x16& od, int vb, bf16x8 pa0, bf16x8 pa1, bf16x8 pa2, bf16x8 pa3) {
    const s16x4 l0 = tr_read<v_rd_off(D0, 0, 0)>(vb), h0 = tr_read<v_rd_off(D0, 0, 1)>(vb), l1 = tr_read<v_rd_off(D0, 1, 0)>(vb), h1 = tr_read<v_rd_off(D0, 1, 1)>(vb);
    const s16x4 l2 = tr_read<v_rd_off(D0, 2, 0)>(vb), h2 = tr_read<v_rd_off(D0, 2, 1)>(vb), l3 = tr_read<v_rd_off(D0, 3, 0)>(vb), h3 = tr_read<v_rd_off(D0, 3, 1)>(vb);
    asm volatile("s_waitcnt lgkmcnt(0)" ::: "memory"); SBAR();
#define PK(L, H) (bf16x8){L[0], L[1], L[2], L[3], H[0], H[1], H[2], H[3]}
    od = __builtin_amdgcn_mfma_f32_32x32x16_bf16(pa0, PK(l0, h0), od, 0, 0, 0);
    od = __builtin_amdgcn_mfma_f32_32x32x16_bf16(pa1, PK(l1, h1), od, 0, 0, 0);
    od = __builtin_amdgcn_mfma_f32_32x32x16_bf16(pa2, PK(l2, h2), od, 0, 0, 0);
    od = __builtin_amdgcn_mfma_f32_32x32x16_bf16(pa3, PK(l3, h3), od, 0, 0, 0);
#undef PK
}
DEVI void pv_d0(f32x16* o, int vb, bf16x8 pa0, bf16x8 pa1, bf16x8 pa2, bf16x8 pa3) {
    pv_one<0>(o[0], vb, pa0, pa1, pa2, pa3); pv_one<1>(o[1], vb, pa0, pa1, pa2, pa3); pv_one<2>(o[2], vb, pa0, pa1, pa2, pa3); pv_one<3>(o[3], vb, pa0, pa1, pa2, pa3);
}
DEVI void wmask(f32x16& p0, f32x16& p1, int qp, int kt0, int hi) {
#pragma unroll
    for (int r = 0; r < 16; ++r) { const int kp = kt0 + crow(r, hi); const int d0 = qp - kp, d1 = d0 - 32;
        if (d0 > 128 || d0 < -128) p0[r] = -1e30f; if (d1 > 128 || d1 < -128) p1[r] = -1e30f; }
}
DEVI void attn_unit(const Args& a, int b, int h, int qb, char* lds) {
    unsigned char* ws = a.ws;
    const bf16_t* QAT = (const bf16_t*)(ws + WS_QAT); const bf16_t* KAT = (const bf16_t*)(ws + WS_KAT); const bf16_t* VAT = (const bf16_t*)(ws + WS_VAT);
    bf16_t* Y = (bf16_t*)(ws + WS_Y); const float* rope = (const float*)(ws + SM_ROPE);
    const int tid = threadIdx.x, wid = tid >> 6, lane = tid & 63, r32 = lane & 31, hi = lane >> 5;
    const int kvh = h >> 2, t0 = qb * 256;
    char* V_lds = lds; char* K_lds = lds + 2 * SHM_V;
    float* wsf = (float*)(lds + OFF_WS) + wid * 64; float* li_l = wsf; float* al_l = wsf + 32;
    float m_reg = -1e30f, l_reg = 0; f32x16 o[4] = {}; bf16x8 qr[8];
    const int qp = t0 + wid * QBLK + r32;
    {
        const bf16_t* Qw = QAT + (size_t)(b * SEQ + qp) * 1024 + h * 128 + hi * 8;
        u32x4 raw[8]; float ss = 0.f;
#pragma unroll
        for (int d0 = 0; d0 < 8; ++d0) { raw[d0] = *(const u32x4*)(Qw + d0 * 16);
#pragma unroll
            for (int i = 0; i < 4; ++i) { const float lo_ = bflo(raw[d0][i]), hi_ = bfhi(raw[d0][i]); ss += lo_ * lo_ + hi_ * hi_; } }
        { auto rr = __builtin_amdgcn_permlane32_swap(__float_as_uint(ss), __float_as_uint(ss), false, false); ss = __uint_as_float(rr[0]) + __uint_as_float(rr[1]); }
        const float rs = rsqrtf(ss * (1.f / 128.f) + EPS);
        const float* qnw = a.in[13];
#pragma unroll
        for (int half = 0; half < 2; ++half) {
            const float* ct = half == 0 ? rope + (qp >> 6) * 32 : rope + 16384 + (qp & 63) * 32;
            const float* st = half == 0 ? ct + 8192 : ct + 2048;
#pragma unroll
            for (int dd = 0; dd < 2; ++dd) {
                const int fi = dd * 16 + hi * 8, da = half * 4 + dd, db = da + 2;
                u32x4 oa, ob;
#pragma unroll
                for (int q4 = 0; q4 < 2; ++q4) {
                    const f32x4 c = *(const f32x4*)(ct + fi + 4 * q4), s = *(const f32x4*)(st + fi + 4 * q4);
                    const f32x4 wa = *(const f32x4*)(qnw + da * 16 + hi * 8 + 4 * q4), wb = *(const f32x4*)(qnw + db * 16 + hi * 8 + 4 * q4);
                    float ya[4], yb[4];
#pragma unroll
                    for (int j = 0; j < 4; ++j) {
                        const unsigned ra = raw[da][2 * q4 + (j >> 1)], rb = raw[db][2 * q4 + (j >> 1)];
                        const float x1 = ((j & 1) ? bfhi(ra) : bflo(ra)) * rs * wa[j], x2 = ((j & 1) ? bfhi(rb) : bflo(rb)) * rs * wb[j];
                        ya[j] = x1 * c[j] - x2 * s[j]; yb[j] = x2 * c[j] + x1 * s[j];
                    }
                    oa[2 * q4] = cvtpk(ya[0], ya[1]); oa[2 * q4 + 1] = cvtpk(ya[2], ya[3]); ob[2 * q4] = cvtpk(yb[0], yb[1]); ob[2 * q4 + 1] = cvtpk(yb[2], yb[3]);
                }
                qr[da] = *reinterpret_cast<bf16x8*>(&oa); qr[db] = *reinterpret_cast<bf16x8*>(&ob);
            }
        }
    }
    const int tk0 = t0 - 128 < 0 ? 0 : t0 - 128, tk1 = t0 + 384 > SEQ ? SEQ : t0 + 384;
    const int NT = 4 + (tk1 - tk0) / 64;
    const int ctxrow = ML + b * CTX, latrow = b * SEQ + tk0 - 256;
#define TROW(j) ((j) < 4 ? ctxrow + 64 * (j) : latrow + 64 * (j))
    const bf16_t* Kh = KAT + kvh * 128; const bf16_t* Vh = VAT + kvh * 128;
    const int sr = tid >> 4, sc = (tid & 15) * 8, vst0 = v_st(sr, sc), vst1 = v_st(32 + sr, sc);
    const int vb0 = (int)(uintptr_t)V_lds + v_rd_base(lane);
    struct { bf16x8 vs0, vs1, ks0, ks1; } sr_[1];
#define SLOAD(i, j) do { const int k0_ = TROW(j); sr_[i].vs0 = *(const bf16x8*)(Vh + (size_t)(k0_ + sr) * LDK + sc); sr_[i].vs1 = *(const bf16x8*)(Vh + (size_t)(k0_ + 32 + sr) * LDK + sc); \
    sr_[i].ks0 = *(const bf16x8*)(Kh + (size_t)(k0_ + sr) * LDK + sc); sr_[i].ks1 = *(const bf16x8*)(Kh + (size_t)(k0_ + 32 + sr) * LDK + sc); } while (0)
#define SWRITE(bf, i) do { *(bf16x8*)(V_lds + (bf) * SHM_V + vst0) = sr_[i].vs0; *(bf16x8*)(V_lds + (bf) * SHM_V + vst1) = sr_[i].vs1; const int kc = sc * 2; \
    *(bf16x8*)(K_lds + (bf) * SHM_K + KSWZ(sr, kc)) = sr_[i].ks0; *(bf16x8*)(K_lds + (bf) * SHM_K + KSWZ(32 + sr, kc)) = sr_[i].ks1; } while (0)
#define SWAIT() asm volatile("s_waitcnt vmcnt(0)" ::: "memory")
#define RESC(al) do { if (__any((al) < 1.f)) { if (hi == 0) al_l[r32] = (al); asm volatile("s_waitcnt lgkmcnt(0)" ::: "memory"); \
    _Pragma("unroll") for (int d = 0; d < 4; ++d) _Pragma("unroll") for (int r = 0; r < 16; ++r) o[d][r] *= al_l[crow(r, hi)]; } } while (0)
#define WMASK(P0, P1, j) do { if ((j) >= 4) wmask(P0, P1, qp, tk0 + 64 * ((j) - 4), hi); } while (0)
    f32x16 pA0, pA1, pB0, pB1; float mnA, mnB, alA, alB; bf16x8 pa0, pa1, pa2, pa3;
    constexpr int SE = 0, SO = 0;
    SLOAD(SE, 0); asm volatile("s_waitcnt vmcnt(0)" ::: "memory"); SWRITE(0, SE); __syncthreads();
    qkt(pA0, pA1, K_lds, qr, r32, hi); partialSM(pA0, pA1, m_reg, mnA, alA);
    SLOAD(SO, 1);
    SWAIT(); SWRITE(1, SO); __syncthreads();
    for (int j = 1; j + 1 < NT; j += 2) {
        SBAR(); qkt(pB0, pB1, K_lds + SHM_K, qr, r32, hi); WMASK(pB0, pB1, j);
        finishSM(pA0, pA1, alA, l_reg, pa0, pa1, pa2, pa3); SBAR();
        SLOAD(SO, j + 1); SBAR();
        pv_d0(o, vb0, pa0, pa1, pa2, pa3); partialSM(pB0, pB1, m_reg, mnB, alB);
        __syncthreads(); SWAIT(); SWRITE(0, SE);
        RESC(alB); __syncthreads();
        SBAR(); qkt(pA0, pA1, K_lds, qr, r32, hi); WMASK(pA0, pA1, j + 1);
        finishSM(pB0, pB1, alB, l_reg, pa0, pa1, pa2, pa3); SBAR();
        SLOAD(SE, j + 2); SBAR();
        pv_d0(o, vb0 + (int)SHM_V, pa0, pa1, pa2, pa3); partialSM(pA0, pA1, m_reg, mnA, alA);
        __syncthreads(); SWAIT(); SWRITE(1, SO);
        RESC(alA); __syncthreads();
    }
    SBAR(); qkt(pB0, pB1, K_lds + SHM_K, qr, r32, hi); WMASK(pB0, pB1, NT - 1);
    finishSM(pA0, pA1, alA, l_reg, pa0, pa1, pa2, pa3); SBAR();
    pv_d0(o, vb0, pa0, pa1, pa2, pa3); partialSM(pB0, pB1, m_reg, mnB, alB);
    __syncthreads(); RESC(alB);
    finishSM(pB0, pB1, alB, l_reg, pa0, pa1, pa2, pa3); SBAR();
    pv_d0(o, vb0 + (int)SHM_V, pa0, pa1, pa2, pa3);
    l_reg += __builtin_amdgcn_exp2f(a.in[15][h] * 1.4426950408889634f - m_reg * (SCALE * 1.4426950408889634f));
    if (hi == 0) li_l[r32] = l_reg; asm volatile("s_waitcnt lgkmcnt(0)" ::: "memory");
    float rli[16];
#pragma unroll
    for (int r = 0; r < 16; ++r) rli[r] = __builtin_amdgcn_rcpf(li_l[crow(r, hi)]);
    {
        bf16_t* stg = (bf16_t*)(lds + OFF_OST) + wid * 4096;
#pragma unroll
        for (int r = 0; r < 16; ++r) { const int orow = crow(r, hi);
#pragma unroll
            for (int d0 = 0; d0 < 4; ++d0) stg[orow * 128 + d0 * 32 + r32] = (bf16_t)f2bf(o[d0][r] * rli[r]); }
        asm volatile("s_waitcnt lgkmcnt(0)" ::: "memory");
        bf16_t* Ow = Y + (size_t)(b * SEQ + t0 + wid * QBLK) * 2048 + 1024 + h * 128;
#pragma unroll
        for (int i = 0; i < 8; ++i) { const int row = i * 4 + (lane >> 4), ch = lane & 15; const u32x4 v = *(const u32x4*)(stg + row * 128 + ch * 8); *(u32x4*)(Ow + (size_t)row * 2048 + ch * 8) = v; }
    }
    __syncthreads();
#undef TROW
#undef SLOAD
#undef SWRITE
#undef SWAIT
#undef RESC
#undef WMASK
}
#undef KSWZ
#undef SBAR
}

DEVI void phase_ffnconv(const Args& a, int b, int tid) {
    unsigned char* ws = a.ws;
    const bf16_t* U = (const bf16_t*)(ws + WS_U); bf16_t* ACT = (bf16_t*)(ws + WS_ACT) + (size_t)b * SEQ * DFF;
    const float* cw = a.in[20]; const float* cb = a.in[21];
    const long total = (long)SEQ * (DFF / 8);
    for (long i = (long)blockIdx.x * 512 + tid; i < total; i += (long)gridDim.x * 512) {
        const int row = (int)(i / (DFF / 8)), f0 = (int)(i % (DFF / 8)) * 8;
        const int pn = f0 >> 7, j = f0 & 127, gc = 256 * pn + j, vc = gc + 128;
        float ug[8], uv[8];
#pragma unroll
        for (int q = 0; q < 8; ++q) { ug[q] = cb[f0 + q]; uv[q] = cb[DFF + f0 + q]; }
#pragma unroll
        for (int jt = 0; jt < 3; ++jt) {
            const int rr = row + jt - 1;
            if (rr >= 0 && rr < SEQ) {
                const u32x4 g = *(const u32x4*)(U + (size_t)rr * NUP + gc), v = *(const u32x4*)(U + (size_t)rr * NUP + vc);
                const f32x4 wg0 = *(const f32x4*)(cw + jt * NUP + f0), wg1 = *(const f32x4*)(cw + jt * NUP + f0 + 4);
                const f32x4 wv0 = *(const f32x4*)(cw + jt * NUP + DFF + f0), wv1 = *(const f32x4*)(cw + jt * NUP + DFF + f0 + 4);
#pragma unroll
                for (int q = 0; q < 4; ++q) {
                    const float wgl = q < 2 ? wg0[2 * q] : wg1[2 * q - 4], wgh = q < 2 ? wg0[2 * q + 1] : wg1[2 * q - 3];
                    const float wvl = q < 2 ? wv0[2 * q] : wv1[2 * q - 4], wvh = q < 2 ? wv0[2 * q + 1] : wv1[2 * q - 3];
                    ug[2 * q] += bflo(g[q]) * wgl; ug[2 * q + 1] += bfhi(g[q]) * wgh;
                    uv[2 * q] += bflo(v[q]) * wvl; uv[2 * q + 1] += bfhi(v[q]) * wvh;
                }
            }
        }
        u32x4 o;
        o.x = pk2(siluf(ug[0]) * uv[0], siluf(ug[1]) * uv[1]); o.y = pk2(siluf(ug[2]) * uv[2], siluf(ug[3]) * uv[3]);
        o.z = pk2(siluf(ug[4]) * uv[4], siluf(ug[5]) * uv[5]); o.w = pk2(siluf(ug[6]) * uv[6], siluf(ug[7]) * uv[7]);
        *(u32x4*)(ACT + (size_t)row * DFF + f0) = o;
    }
}

constexpr int NPHASE = 16;
__global__ void __launch_bounds__(512, 2) mega(Args a) {
    extern __shared__ __attribute__((aligned(16))) unsigned char lds_raw[];
    LAS unsigned char* lds = (LAS unsigned char*)lds_raw;
    const int tid = threadIdx.x, lane = tid & 63, wave = __builtin_amdgcn_readfirstlane(tid >> 6);
    unsigned char* ws = a.ws;
    const int lo = a.ph_lo, hi = a.ph_hi;
#define IN(k) (lo <= (k) && (k) < hi)
#if MK_ONE_LAUNCH
#define SEAM(k) do { if (IN(k) && IN((k) + 1)) cg::this_grid().sync(); } while (0)
#else
#define SEAM(k) do { } while (0)
#endif
    const float* modacc = (const float*)(ws + CTL_MODACC);
    if (IN(0)) { phase0(a, lds, tid, lane, wave); } SEAM(0);
    if (IN(1)) { phase1(a, tid, lane, wave); } SEAM(1);
    if (IN(2)) {
        pg8::Gemm g{(const bf16_t*)(ws + WS_XN), (const bf16_t*)(ws + WS_WINA), MT, NA, 1024}; pg8::StaticOrder S; S.init(MT, NA, gridDim.x, blockIdx.x);
        EpiIn E{(const float*)(ws + SM_ROWSS1), (const float*)(ws + SM_SHWA), 0, (bf16_t*)(ws + WS_QKVR), nullptr, nullptr, nullptr, nullptr, (float*)(ws + WS_BA)};
        pg8::gemm_phase<EpiIn, pg8::StaticOrder, true, true>(lds, g, S, E);
    } SEAM(2);
    if (IN(3)) { phase_dnprep(a, tid); } SEAM(3);
    if (IN(4)) { phase_dnchunk(a, lds, tid, lane, wave); } SEAM(4);
    if (IN(5)) { phase_dnscan2(a, lds, tid, lane, wave); } SEAM(5);
    if (IN(6)) {
        pg8::Gemm g{(const bf16_t*)(ws + WS_XN), (const bf16_t*)(ws + WS_WINC), MT, NC, 1024}; pg8::StaticOrder S; S.init(MT, NC, gridDim.x, blockIdx.x);
        EpiIn E{(const float*)(ws + SM_ROWSS1), (const float*)(ws + SM_SHWA) + NA, 1, (bf16_t*)(ws + WS_GT), (bf16_t*)(ws + WS_QAT), (bf16_t*)(ws + WS_KAT), (bf16_t*)(ws + WS_VAT), (bf16_t*)(ws + WS_MG), nullptr};
        pg8::gemm_phase<EpiIn, pg8::StaticOrder, true, true>(lds, g, S, E);
    } SEAM(6);
    if (IN(7)) { phase_prep2(a, lane, wave); } SEAM(7);
    if (IN(8)) {
#pragma unroll 1
        for (int k = 0; k < 1024; ++k) {
            const int idx = 4 * ((int)blockIdx.x + (int)gridDim.x * (k >> 2)) + (k & 3); if (idx >= 1024) break;
            const int g = idx & 3, qb = (idx >> 2) & 63, kvh = (idx >> 8) & 1, b = idx >> 9;
            att::attn_unit(a, b, kvh * 4 + g, qb, (char*)lds_raw); }
    } SEAM(8);
    if (IN(9)) {
        pg8::Gemm g{(const bf16_t*)(ws + WS_Y), (const bf16_t*)(ws + WS_WBR), ML, 1024, 2048}; pg8::StaticOrder S; S.init(ML, 1024, gridDim.x, blockIdx.x);
        EpiBr E{(const bf16_t*)(ws + WS_MG), (bf16_t*)(ws + WS_MERGED)};
        pg8::gemm_phase<EpiBr, pg8::StaticOrder, true, true>(lds, g, S, E);
    } SEAM(9);
    if (IN(10)) {
        pg8::Gemm g{(const bf16_t*)(ws + WS_MERGED), (const bf16_t*)(ws + WS_WOUT), ML, 1024, 1024}; pg8::StaticOrder S; S.init(ML, 1024, gridDim.x, blockIdx.x);
        EpiOut E{a.in[0], modacc, a.in[5], a.in[7], a.out, (bf16_t*)(ws + WS_X1S), (float*)(ws + CTL_ROWSS2)};
        pg8::gemm_phase<EpiOut, pg8::StaticOrder, true, true>(lds, g, S, E);
    } SEAM(10);
#define FFN_UP(PH, BB) if (IN(PH)) { \
        pg8::Gemm g{(const bf16_t*)(ws + WS_X1S) + (size_t)(BB) * SEQ * 1024, (const bf16_t*)(ws + WS_WUP), SEQ, NUP, 1024}; pg8::StaticOrder S; S.init(SEQ, NUP, gridDim.x, blockIdx.x); \
        EpiUp E{(const float*)(ws + CTL_ROWSS2) + (BB) * SEQ, (const float*)(ws + SM_SHWF) + (BB) * NUP, (bf16_t*)(ws + WS_U)}; \
        pg8::gemm_phase<EpiUp, pg8::StaticOrder, true, true>(lds, g, S, E); }
    FFN_UP(11, 0) SEAM(11);
    if (IN(12)) { phase_ffnconv(a, 0, tid); } SEAM(12);
    FFN_UP(13, 1) SEAM(13);
    if (IN(14)) { phase_ffnconv(a, 1, tid); } SEAM(14);
#undef FFN_UP
    if (IN(15)) {
        pg8::Gemm g{(const bf16_t*)(ws + WS_ACT), (const bf16_t*)(ws + WS_WDN), ML, 1024, DFF}; pg8::StaticOrder S; S.init(ML, 1024, gridDim.x, blockIdx.x);
        EpiDown E{modacc, a.in[5], a.out};
        pg8::gemm_phase<EpiDown, pg8::StaticOrder, true, true>(lds, g, S, E);
    }
#undef IN
#undef SEAM
}

extern "C" void kernel_launch(void* const* d_in, const int* in_sizes, int n_in, void* d_out, int out_size, void* d_ws, size_t ws_size, hipStream_t stream) {
    static int grid = 0;
    if (grid == 0) {
        if (n_in != 23 || in_sizes[0] != ML * DM || out_size != ML * DM || ws_size < WS_END) {
            fprintf(stderr, "kernel_launch: unexpected shapes n_in %d in0 %d out %d ws %zu (need %zu)\n", n_in, n_in > 0 ? in_sizes[0] : -1, out_size, ws_size, (size_t)WS_END); grid = -1; return; }
        int dev = 0, cus = 0, per_cu = 0;
        hipGetDevice(&dev); hipDeviceGetAttribute(&cus, hipDeviceAttributeMultiprocessorCount, dev);
        if (hipFuncSetAttribute((const void*)mega, hipFuncAttributeMaxDynamicSharedMemorySize, LDS_BYTES) != hipSuccess) { fprintf(stderr, "kernel_launch: hipFuncSetAttribute failed\n"); grid = -1; return; }
        hipOccupancyMaxActiveBlocksPerMultiprocessor(&per_cu, (const void*)mega, 512, LDS_BYTES);
        (void)hipGetLastError();
        if (per_cu < 1) { fprintf(stderr, "kernel_launch: occupancy query says %d blocks per CU\n", per_cu); per_cu = 1; }
        grid = cus;
    }
    if (grid < 0) return;
    hipMemsetAsync((char*)d_ws + WS_CTL, 0, CTL_ZERO_BYTES, stream);
    Args a{};
    for (int i = 0; i < 23; ++i) a.in[i] = (const float*)d_in[i];
    a.out = (float*)d_out; a.ws = (unsigned char*)d_ws;
#if MK_ONE_LAUNCH
    a.ph_lo = 0; a.ph_hi = NPHASE;
    void* args[] = {&a};
    hipError_t e = hipLaunchCooperativeKernel((const void*)mega, dim3(grid), dim3(512), args, LDS_BYTES, stream);
    if (e != hipSuccess) fprintf(stderr, "cooperative launch failed: %s (grid %d)\n", hipGetErrorString(e), grid);
#else
    for (int p = 0; p < NPHASE; ++p) {
        a.ph_lo = p; a.ph_hi = p + 1;
        hipLaunchKernelGGL(mega, dim3(grid), dim3(512), LDS_BYTES, stream, a);
    }
    hipError_t e = hipPeekAtLastError();
    if (e != hipSuccess) fprintf(stderr, "launch failed: %s\n", hipGetErrorString(e));
#endif
}
```

```cpp
#include <hip/hip_runtime.h>
#include <hip/hip_cooperative_groups.h>
#include <cstdio>
#include <cstdint>
namespace cg = cooperative_groups;

#ifndef MK_ONE_LAUNCH
#define MK_ONE_LAUNCH 1
#endif

#define DEVI __device__ __forceinline__
#define LAS __attribute__((address_space(3)))
typedef unsigned short bf16_t;
typedef short bf16x8 __attribute__((ext_vector_type(8)));
typedef float f32x4 __attribute__((ext_vector_type(4)));
typedef float f32x2 __attribute__((ext_vector_type(2)));
typedef float f32x16 __attribute__((ext_vector_type(16)));
typedef unsigned u32x4 __attribute__((ext_vector_type(4)));
typedef unsigned u32x2 __attribute__((ext_vector_type(2)));
typedef short s16x4 __attribute__((ext_vector_type(4)));

constexpr int BATCH = 2, SEQ = 16384, DM = 1024, CTX = 256;
constexpr int ML = BATCH * SEQ;
constexpr int MC = BATCH * CTX;
constexpr int MT = ML + MC;
constexpr int NA = 3328;
constexpr int NC = 4608;
constexpr int NSH = NA + NC;
constexpr int DFF = 2816, NUP = 5632;
constexpr float EPS = 1e-6f;

constexpr size_t MiB = 1u << 20;
constexpr size_t WS_CTL = 0, CTL_ZERO_BYTES = 1 * MiB;
constexpr size_t CTL_MODACC = 64 * 1024;
constexpr size_t CTL_ROWSS2 = 256 * 1024;
constexpr size_t WS_SMALL = 1 * MiB;
constexpr size_t SM_ROWSS1 = WS_SMALL;
constexpr size_t SM_SHWA = WS_SMALL + 256 * 1024;
constexpr size_t SM_SHWF = WS_SMALL + 384 * 1024;
constexpr size_t SM_ROPE = WS_SMALL + 512 * 1024;
constexpr size_t WS_BA = 2 * MiB;
constexpr size_t WS_G = 7 * MiB;
constexpr size_t WS_BETA = 10 * MiB;
constexpr size_t WS_WINA = 13 * MiB, WS_WINC = 20 * MiB, WS_WBR = 29 * MiB, WS_WOUT = 33 * MiB, WS_WUP = 35 * MiB, WS_WDN = 46 * MiB;
constexpr size_t WS_XN = 52 * MiB;
constexpr size_t WS_QKVR = 117 * MiB;
constexpr size_t WS_QKVP = 312 * MiB;
constexpr size_t WS_MG = 180 * MiB;
constexpr size_t WS_GT = 310 * MiB;
constexpr size_t WS_QAT = 375 * MiB;
constexpr size_t WS_KAT = 440 * MiB;
constexpr size_t WS_VAT = 457 * MiB;
constexpr size_t WS_Y = 52 * MiB;
constexpr size_t WS_MERGED = 375 * MiB;
constexpr size_t WS_X1S = 440 * MiB;
constexpr size_t WS_U = 52 * MiB;
constexpr size_t WS_ACT = 228 * MiB;
constexpr size_t WS_TQ = 117 * MiB;
constexpr size_t WS_AVEC = 248 * MiB;
constexpr size_t WS_END = 512 * MiB;

constexpr int LDS_BYTES = 147456;

DEVI float bf2f(unsigned short h) { return __uint_as_float((unsigned)h << 16); }
DEVI float bflo(unsigned w) { return __uint_as_float(w << 16); }
DEVI float bfhi(unsigned w) { return __uint_as_float(w & 0xffff0000u); }
DEVI unsigned f2bf(float f) { unsigned u = __float_as_uint(f); return (u + 0x7fffu + ((u >> 16) & 1u)) >> 16; }
DEVI unsigned pk2(float lo, float hi) { return f2bf(lo) | (f2bf(hi) << 16); }
DEVI float wave_sum(float v) {
#pragma unroll
    for (int o = 1; o < 64; o <<= 1) v += __shfl_xor(v, o);
    return v;
}
DEVI float siluf(float x) { return x / (1.f + __expf(-x)); }
DEVI float sigmoidf_(float x) { return 1.f / (1.f + __expf(-x)); }

struct Args { const float* in[23]; float* out; unsigned char* ws; int ph_lo, ph_hi; };

namespace pg8 {
constexpr int BM = 256, BK = 64, HALF = 128, HTB = HALF * BK * 2, STAGE_BYTES = 8 * HTB, NXCD = 8, WGM = 8;
__host__ __device__ __forceinline__ int lds_byte(int r, int c) { const int st = (r >> 4) * 2 + (c >> 5), rr = r & 15, cc = c & 31, ob = rr * 64 + cc * 2; return st * 1024 + (ob ^ (((ob >> 9) & 1) << 5)); }
__host__ __device__ __forceinline__ void stage_rc(int b, int& R, int& C) { const int st = b / 1024, sb = b % 1024, swz = sb ^ (((sb >> 9) & 1) << 5); R = (st >> 1) * 16 + swz / 64; C = (st & 1) * 32 + (swz % 64) / 2; }
__host__ __device__ __forceinline__ int perm32(int rho) { const int n = rho >> 4, i = rho & 15; return 8 * (i >> 2) + 4 * n + (i & 3); }
struct Unit { int pm, pn; };
struct Gemm { const bf16_t* A; const bf16_t* Bt; int M, N, K; };
struct StaticOrder {
    int nM, nN, nwg, G, c;
    __device__ void init(int M, int N, int G_, int c_) { nM = M / BM; nN = N / BM; nwg = nM * nN; G = G_; c = c_; }
    __device__ bool next(int i, Unit& u) const {
        const long L = (long)i * G + c; if (L >= nwg) return false;
        int wgid = (int)L; { const int q = nwg / NXCD, r = nwg % NXCD, xcd = wgid % NXCD, off = wgid / NXCD; wgid = (xcd < r ? xcd * (q + 1) : r * (q + 1) + (xcd - r) * q) + off; }
        const int nig = WGM * nN, gid = wgid / nig, fm = gid * WGM, gsz = (nM - fm) < WGM ? (nM - fm) : WGM;
        u.pm = fm + ((wgid % nig) % gsz); u.pn = (wgid % nig) / gsz; return true;
    }
};
template <class Epi, class Sched, bool ALIGN_EPI, bool SP2>
__device__ __forceinline__ void gemm_phase(LAS unsigned char* lds, const Gemm g, const Sched& S, const Epi& E) {
    const int tid = threadIdx.x, wid = __builtin_amdgcn_readfirstlane(tid >> 6), lane = tid & 63, wr = wid >> 2, wc = wid & 3, fr = lane & 15, fq = lane >> 4;
    const int K = g.K, nt = K / BK;
    unsigned voffA[2], voffB[2];
#pragma unroll
    for (int i = 0; i < 2; ++i) { int R, C; stage_rc(tid * 16 + i * 8192, R, C); const int Rb = Epi::PERM ? ((R & ~31) + perm32(R & 31)) : R;
        voffA[i] = (unsigned)(R * K + C) * 2u; voffB[i] = (unsigned)(Rb * K + C) * 2u; }
    const size_t kstep = (size_t)(BK * 2);
    const size_t hstep = (size_t)HALF * K * 2;
    const size_t tstep = 2 * hstep;
    const unsigned ldsw = (unsigned)wid * 1024u;
    const int aoff = lds_byte(wr * 64 + fr, fq * 8), boff = lds_byte(wc * 32 + fr, fq * 8);
#define PG8_SA(b, h) (((b) * 2 + (h)) * HTB)
#define PG8_SB(b, h) ((4 + (b) * 2 + (h)) * HTB)
#define PG8_STAGE(bufoff, gbase, voff) do { _Pragma("unroll") for (int _i = 0; _i < 2; ++_i) \
        __builtin_amdgcn_global_load_lds((const unsigned*)((const char*)(gbase) + (voff)[_i]), (LAS unsigned*)(lds + (bufoff) + ldsw + _i * 8192), 16, 0, 0); } while (0)
#define PG8_LDA(dst, b, h) do { _Pragma("unroll") for (int m = 0; m < 4; ++m) _Pragma("unroll") for (int k = 0; k < 2; ++k) dst[m][k] = *(const LAS bf16x8*)(lds + PG8_SA(b, h) + aoff + m * 2048 + k * 1024); } while (0)
#define PG8_LDB(dst, b, h) do { _Pragma("unroll") for (int n = 0; n < 2; ++n) _Pragma("unroll") for (int k = 0; k < 2; ++k) dst[n][k] = *(const LAS bf16x8*)(lds + PG8_SB(b, h) + boff + n * 2048 + k * 1024); } while (0)
#define PG8_MMA(ai, bj, At, Bt) do { __builtin_amdgcn_s_setprio(1); _Pragma("unroll") for (int m = 0; m < 4; ++m) _Pragma("unroll") for (int n = 0; n < 2; ++n) _Pragma("unroll") for (int k = 0; k < 2; ++k) \
        acc[ai][bj][m][n] = __builtin_amdgcn_mfma_f32_16x16x32_bf16(Bt[n][k], At[m][k], acc[ai][bj][m][n], 0, 0, 0); __builtin_amdgcn_s_setprio(0); } while (0)
#define PG8_WAIT_V(n) asm volatile("s_waitcnt vmcnt(" #n ")" ::: "memory")
#define PG8_WAIT_L(n) asm volatile("s_waitcnt lgkmcnt(" #n ")" ::: "memory")
#define PG8_BAR __builtin_amdgcn_s_barrier()
#define PG8_SCHED __builtin_amdgcn_sched_barrier(0)
    Unit cur, nxt; int ui = 0;
    if (!S.next(0, cur)) return;
    f32x4 acc[2][2][4][2];
#pragma unroll
    for (int a = 0; a < 2; ++a)
#pragma unroll
        for (int b = 0; b < 2; ++b)
#pragma unroll
            for (int m = 0; m < 4; ++m)
#pragma unroll
                for (int n = 0; n < 2; ++n) acc[a][b][m][n] = (f32x4){0.f, 0.f, 0.f, 0.f};
    bf16x8 At[4][2], B0[2][2], B1[2][2];
    const char* cA = (const char*)g.A + (size_t)cur.pm * tstep; const char* cB = (const char*)g.Bt + (size_t)cur.pn * tstep;
    if constexpr (SP2) {
        PG8_STAGE(PG8_SB(0, 0), cB, voffB); PG8_STAGE(PG8_SB(0, 1), cB + hstep, voffB); PG8_STAGE(PG8_SA(0, 0), cA, voffA); PG8_STAGE(PG8_SA(0, 1), cA + hstep, voffA);
        if (wr == 1) PG8_BAR;
        PG8_WAIT_V(2); PG8_BAR;
        PG8_STAGE(PG8_SB(1, 0), cB + kstep, voffB); PG8_STAGE(PG8_SA(1, 0), cA + kstep, voffA); PG8_STAGE(PG8_SB(1, 1), cB + hstep + kstep, voffB);
        PG8_WAIT_V(6); PG8_BAR;
    } else {
        PG8_STAGE(PG8_SB(0, 0), cB, voffB); PG8_STAGE(PG8_SA(0, 0), cA, voffA); PG8_STAGE(PG8_SB(0, 1), cB + hstep, voffB); PG8_STAGE(PG8_SA(0, 1), cA + hstep, voffA);
        if (wr == 1) PG8_BAR;
        PG8_WAIT_V(4); PG8_BAR;
        PG8_STAGE(PG8_SB(1, 0), cB + kstep, voffB); PG8_STAGE(PG8_SA(1, 0), cA + kstep, voffA); PG8_STAGE(PG8_SB(1, 1), cB + hstep + kstep, voffB);
        PG8_WAIT_V(6); PG8_BAR;
    }
    for (;;) {
        const bool has_next = S.next(ui + 1, nxt);
        const char* nA = has_next ? (const char*)g.A + (size_t)nxt.pm * tstep : cA; const char* nB = has_next ? (const char*)g.Bt + (size_t)nxt.pn * tstep : cB;
#pragma unroll 1
        for (int t = 0; t < nt; t += 2) {
            const bool last = (t == nt - 2);
            if constexpr (Epi::MID) { if (t == nt / 2) E.mid(acc, cur, wr, wc, fr, fq); }
            const char* a1 = cA + (size_t)(t + 1) * kstep;
            const char* a2 = last ? nA : cA + (size_t)(t + 2) * kstep; const char* b2 = last ? nB : cB + (size_t)(t + 2) * kstep;
            const char* a3 = a2 + kstep; const char* b3 = b2 + kstep;
            if constexpr (SP2) {
            PG8_LDB(B0, 0, 0); PG8_LDB(B1, 0, 1); PG8_SCHED; PG8_LDA(At, 0, 0); PG8_STAGE(PG8_SA(1, 1), a1 + hstep, voffA);
            PG8_WAIT_V(8); PG8_WAIT_L(0); PG8_BAR; PG8_MMA(0, 0, At, B0); PG8_MMA(0, 1, At, B1); PG8_BAR; PG8_SCHED;
            PG8_LDA(At, 0, 1); PG8_STAGE(PG8_SB(0, 0), b2, voffB); PG8_STAGE(PG8_SB(0, 1), b2 + hstep, voffB); PG8_STAGE(PG8_SA(0, 0), a2, voffA);
            PG8_WAIT_V(8); PG8_WAIT_L(0); PG8_BAR; PG8_MMA(1, 0, At, B0); PG8_MMA(1, 1, At, B1); PG8_BAR; PG8_SCHED;
            PG8_LDB(B0, 1, 0); PG8_LDB(B1, 1, 1); PG8_SCHED; PG8_LDA(At, 1, 0); PG8_STAGE(PG8_SA(0, 1), a2 + hstep, voffA);
            PG8_WAIT_V(8); PG8_WAIT_L(0); PG8_BAR; PG8_MMA(0, 0, At, B0); PG8_MMA(0, 1, At, B1); PG8_BAR; PG8_SCHED;
            PG8_LDA(At, 1, 1); PG8_STAGE(PG8_SB(1, 0), b3, voffB); PG8_STAGE(PG8_SB(1, 1), b3 + hstep, voffB); PG8_STAGE(PG8_SA(1, 0), a3, voffA);
            PG8_WAIT_V(8); PG8_WAIT_L(0); PG8_BAR; PG8_MMA(1, 0, At, B0); PG8_MMA(1, 1, At, B1); PG8_BAR; PG8_SCHED;
            } else {
            PG8_LDB(B0, 0, 0); PG8_SCHED; PG8_LDA(At, 0, 0); PG8_STAGE(PG8_SA(1, 1), a1 + hstep, voffA);
            PG8_WAIT_L(8); PG8_BAR; PG8_WAIT_L(0); PG8_MMA(0, 0, At, B0); PG8_BAR; PG8_SCHED;
            PG8_LDB(B1, 0, 1); PG8_STAGE(PG8_SB(0, 0), b2, voffB);
            PG8_BAR; PG8_WAIT_L(0); PG8_MMA(0, 1, At, B1); PG8_BAR;
            PG8_LDA(At, 0, 1); PG8_STAGE(PG8_SA(0, 0), a2, voffA);
            PG8_BAR; PG8_WAIT_L(0); PG8_MMA(1, 0, At, B0); PG8_BAR; PG8_SCHED;
            PG8_STAGE(PG8_SB(0, 1), b2 + hstep, voffB);
            PG8_WAIT_V(6); PG8_BAR; PG8_MMA(1, 1, At, B1); PG8_BAR;
            PG8_LDB(B0, 1, 0); PG8_SCHED; PG8_LDA(At, 1, 0); PG8_STAGE(PG8_SA(0, 1), a2 + hstep, voffA);
            PG8_WAIT_L(8); PG8_BAR; PG8_WAIT_L(0); PG8_MMA(0, 0, At, B0); PG8_BAR; PG8_SCHED;
            PG8_LDB(B1, 1, 1); PG8_STAGE(PG8_SB(1, 0), b3, voffB);
            PG8_BAR; PG8_WAIT_L(0); PG8_MMA(0, 1, At, B1); PG8_BAR;
            PG8_LDA(At, 1, 1); PG8_STAGE(PG8_SA(1, 0), a3, voffA);
            PG8_BAR; PG8_WAIT_L(0); PG8_MMA(1, 0, At, B0); PG8_BAR; PG8_SCHED;
            PG8_STAGE(PG8_SB(1, 1), b3 + hstep, voffB);
            PG8_WAIT_V(6); PG8_BAR; PG8_MMA(1, 1, At, B1); PG8_BAR;
            }
        }
        if constexpr (ALIGN_EPI) { if (wr == 0) PG8_BAR; }
        E(acc, cur, wr, wc, fr, fq);
        if (!has_next) break;
#pragma unroll
        for (int a = 0; a < 2; ++a)
#pragma unroll
            for (int b = 0; b < 2; ++b)
#pragma unroll
                for (int m = 0; m < 4; ++m)
#pragma unroll
                    for (int n = 0; n < 2; ++n) acc[a][b][m][n] = (f32x4){0.f, 0.f, 0.f, 0.f};
        cur = nxt; cA = nA; cB = nB; ++ui;
        if constexpr (ALIGN_EPI) { if (wr == 1) PG8_BAR; }
    }
    PG8_WAIT_V(0);
    if constexpr (!ALIGN_EPI) { if (wr == 0) PG8_BAR; }
    PG8_BAR;
#undef PG8_SA
#undef PG8_SB
#undef PG8_STAGE
#undef PG8_LDA
#undef PG8_LDB
#undef PG8_MMA
#undef PG8_WAIT_V
#undef PG8_WAIT_L
#undef PG8_BAR
#undef PG8_SCHED
}
}
using pg8::HALF;

DEVI u32x4 pack8(const f32x4& a, const f32x4& b) { u32x4 w; w.x = pk2(a[0], a[1]); w.y = pk2(a[2], a[3]); w.z = pk2(b[0], b[1]); w.w = pk2(b[2], b[3]); return w; }

struct EpiIn {
    static constexpr bool PERM = true, MID = false;
    const float* rowss; const float* shW; int job;
    bf16_t *d0, *d1, *d2, *d3, *d4; float* ba;
    DEVI void operator()(const f32x4 (&acc)[2][2][4][2], const pg8::Unit& u, int wr, int wc, int fr, int fq) const {
        asm volatile("" : "+v"(fr), "+v"(fq));
        const int vs = u.pm < 64 ? 0 : (u.pm < 128 ? 1 : 2);
        bf16_t* base; int pitch, colt; bool isba = false;
        if (job == 0) { base = d0; pitch = 3072; colt = u.pn * 256; if (u.pn >= 12) isba = true; }
        else {
            if (u.pn < 4) { base = d0; pitch = 1024; colt = u.pn * 256; }
            else if (u.pn < 8) { base = d1; pitch = 1024; colt = (u.pn - 4) * 256; }
            else if (u.pn == 8) { base = d2; pitch = 256; colt = 0; }
            else if (u.pn == 9) { base = d3; pitch = 256; colt = 0; }
            else { base = d4; pitch = 2048; colt = (u.pn - 10) * 256; }
        }
        const int ncol0 = u.pn * 256 + wc * 32 + 8 * fq;
        f32x4 sv[2][2];
#pragma unroll
        for (int bj = 0; bj < 2; ++bj)
#pragma unroll
            for (int n = 0; n < 2; ++n) sv[bj][n] = *(const f32x4*)(shW + vs * NSH + ncol0 + bj * HALF + 4 * n);
        const int row0 = u.pm * 256 + wr * 64 + fr;
#pragma unroll
        for (int ai = 0; ai < 2; ++ai)
#pragma unroll
            for (int m = 0; m < 4; ++m) {
                const int row = row0 + ai * HALF + m * 16;
                const float rs = rsqrtf(rowss[row] * (1.f / 1024.f) + EPS);
                if (!isba) {
                    bf16_t* rowp = base + (size_t)row * pitch + colt + wc * 32 + 8 * fq;
#pragma unroll
                    for (int bj = 0; bj < 2; ++bj) { const f32x4 v0 = acc[ai][bj][m][0] * rs + sv[bj][0], v1 = acc[ai][bj][m][1] * rs + sv[bj][1]; *(u32x4*)(rowp + bj * HALF) = pack8(v0, v1); }
                } else if (wc == 0) {
                    float* rowp = ba + (size_t)row * 32 + 8 * fq;
                    *(f32x4*)(rowp) = acc[ai][0][m][0] * rs + sv[0][0]; *(f32x4*)(rowp + 4) = acc[ai][0][m][1] * rs + sv[0][1];
                }
            }
    }
};
struct EpiBr {
    static constexpr bool PERM = true, MID = true;
    const bf16_t* mg; bf16_t* out;
    DEVI void mid(f32x4 (&acc)[2][2][4][2], const pg8::Unit& u, int wr, int wc, int fr, int fq) const {
        asm volatile("" : "+v"(fr), "+v"(fq));
        const int row0 = u.pm * 256 + wr * 64 + fr, col0 = u.pn * 256 + wc * 32 + 8 * fq;
#pragma unroll
        for (int ai = 0; ai < 2; ++ai)
#pragma unroll
            for (int m = 0; m < 4; ++m) {
                const bf16_t* rp = mg + (size_t)(row0 + ai * HALF + m * 16) * 2048 + col0;
#pragma unroll
                for (int bj = 0; bj < 2; ++bj) {
                    const u32x4 gd = *(const u32x4*)(rp + bj * HALF), ga = *(const u32x4*)(rp + 1024 + bj * HALF);
                    float r[8];
#pragma unroll
                    for (int i = 0; i < 4; ++i) {
                        const float d0 = bflo(gd[i]), d1 = bfhi(gd[i]), a0 = bflo(ga[i]), a1 = bfhi(ga[i]);
                        r[2 * i] = (1.f + __expf(fminf(-a0, 80.f))) * __builtin_amdgcn_rcpf(1.f + __expf(fminf(-d0, 80.f)));
                        r[2 * i + 1] = (1.f + __expf(fminf(-a1, 80.f))) * __builtin_amdgcn_rcpf(1.f + __expf(fminf(-d1, 80.f)));
                    }
                    acc[ai][bj][m][0] *= (f32x4){r[0], r[1], r[2], r[3]}; acc[ai][bj][m][1] *= (f32x4){r[4], r[5], r[6], r[7]};
                    asm volatile("" ::: "memory");
                }
            }
    }
    DEVI void operator()(const f32x4 (&acc)[2][2][4][2], const pg8::Unit& u, int wr, int wc, int fr, int fq) const {
        asm volatile("" : "+v"(fr), "+v"(fq));
        const int row0 = u.pm * 256 + wr * 64 + fr, col0 = u.pn * 256 + wc * 32 + 8 * fq;
#pragma unroll
        for (int ai = 0; ai < 2; ++ai)
#pragma unroll
            for (int m = 0; m < 4; ++m) {
                const size_t row = (size_t)(row0 + ai * HALF + m * 16);
                const bf16_t* rp = mg + row * 2048 + 1024 + col0;
#pragma unroll
                for (int bj = 0; bj < 2; ++bj) {
                    const u32x4 ga = *(const u32x4*)(rp + bj * HALF);
                    float s[8];
#pragma unroll
                    for (int i = 0; i < 4; ++i) { s[2 * i] = __builtin_amdgcn_rcpf(1.f + __expf(fminf(-bflo(ga[i]), 80.f))); s[2 * i + 1] = __builtin_amdgcn_rcpf(1.f + __expf(fminf(-bfhi(ga[i]), 80.f))); }
                    const f32x4 v0 = acc[ai][bj][m][0] * (f32x4){s[0], s[1], s[2], s[3]}, v1 = acc[ai][bj][m][1] * (f32x4){s[4], s[5], s[6], s[7]};
                    *(u32x4*)(out + row * 1024 + col0 + bj * HALF) = pack8(v0, v1);
                }
            }
    }
};
struct EpiOut {
    static constexpr bool PERM = false, MID = false;
    const float* x; const float* modacc; const float* bada; const float* nwf; float* out; bf16_t* x1s; float* rowss2;
    DEVI void operator()(const f32x4 (&acc)[2][2][4][2], const pg8::Unit& u, int wr, int wc, int fr, int fq) const {
        asm volatile("" : "+v"(fr), "+v"(fq));
        const int b = u.pm >> 6; const int row0 = u.pm * 256 + wr * 64 + fr, col0 = u.pn * 256 + wc * 32 + 4 * fq;
        f32x4 ga[2][2], sc[2][2];
#pragma unroll
        for (int bj = 0; bj < 2; ++bj)
#pragma unroll
            for (int n = 0; n < 2; ++n) { const int c = col0 + bj * HALF + n * 16;
                ga[bj][n] = *(const f32x4*)(modacc + b * 6144 + 2048 + c) + *(const f32x4*)(bada + 2048 + c);
                sc[bj][n] = (*(const f32x4*)(modacc + b * 6144 + 4096 + c) + *(const f32x4*)(bada + 4096 + c) + 1.f) * *(const f32x4*)(nwf + c); }
#pragma unroll
        for (int ai = 0; ai < 2; ++ai)
#pragma unroll
            for (int m = 0; m < 4; ++m) {
                const size_t off = (size_t)(row0 + ai * HALF + m * 16) * 1024 + col0; float ss = 0.f;
#pragma unroll
                for (int bj = 0; bj < 2; ++bj)
#pragma unroll
                    for (int n = 0; n < 2; ++n) {
                        const f32x4 xv = *(const f32x4*)(x + off + bj * HALF + n * 16);
                        const f32x4 o = xv + ga[bj][n] * acc[ai][bj][m][n];
                        *(f32x4*)(out + off + bj * HALF + n * 16) = o;
                        ss += (o[0] * o[0] + o[1] * o[1]) + (o[2] * o[2] + o[3] * o[3]);
                        const f32x4 s = o * sc[bj][n]; u32x2 w; w.x = pk2(s[0], s[1]); w.y = pk2(s[2], s[3]);
                        *(u32x2*)(x1s + off + bj * HALF + n * 16) = w;
                    }
                ss += __shfl_xor(ss, 16); ss += __shfl_xor(ss, 32);
                if (fq == 0) atomicAdd(rowss2 + row0 + ai * HALF + m * 16, ss);
            }
    }
};
struct EpiUp {
    static constexpr bool PERM = true, MID = false;
    const float* rowss2; const float* shWf; bf16_t* u_;
    DEVI void operator()(const f32x4 (&acc)[2][2][4][2], const pg8::Unit& u, int wr, int wc, int fr, int fq) const {
        asm volatile("" : "+v"(fr), "+v"(fq));
        const int row0 = u.pm * 256 + wr * 64 + fr, col0 = u.pn * 256 + wc * 32 + 8 * fq;
#pragma unroll
        for (int bj = 0; bj < 2; ++bj) {
            const f32x4 sv0 = *(const f32x4*)(shWf + col0 + bj * HALF), sv1 = *(const f32x4*)(shWf + col0 + bj * HALF + 4);
#pragma unroll
            for (int ai = 0; ai < 2; ++ai)
#pragma unroll
                for (int m = 0; m < 4; ++m) {
                    const int row = row0 + ai * HALF + m * 16;
                    const float rs = rsqrtf(rowss2[row] * (1.f / 1024.f) + EPS);
                    const f32x4 v0 = acc[ai][bj][m][0] * rs + sv0, v1 = acc[ai][bj][m][1] * rs + sv1;
                    *(u32x4*)(u_ + (size_t)row * NUP + col0 + bj * HALF) = pack8(v0, v1);
                }
        }
    }
};
struct EpiDown {
    static constexpr bool PERM = false, MID = false;
    const float* modacc; const float* bada; float* out;
    DEVI void operator()(const f32x4 (&acc)[2][2][4][2], const pg8::Unit& u, int wr, int wc, int fr, int fq) const {
        asm volatile("" : "+v"(fr), "+v"(fq));
        const int b = u.pm >> 6; const int row0 = u.pm * 256 + wr * 64 + fr, col0 = u.pn * 256 + wc * 32 + 4 * fq;
        f32x4 gf[2][2];
#pragma unroll
        for (int bj = 0; bj < 2; ++bj)
#pragma unroll
            for (int n = 0; n < 2; ++n) { const int c = col0 + bj * HALF + n * 16; gf[bj][n] = *(const f32x4*)(modacc + b * 6144 + 5120 + c) + *(const f32x4*)(bada + 5120 + c); }
#pragma unroll
        for (int ai = 0; ai < 2; ++ai)
#pragma unroll
            for (int m = 0; m < 4; ++m) {
                const size_t off = (size_t)(row0 + ai * HALF + m * 16) * 1024 + col0;
#pragma unroll
                for (int bj = 0; bj < 2; ++bj)
#pragma unroll
                    for (int n = 0; n < 2; ++n) { float* p = out + off + bj * HALF + n * 16; *(f32x4*)p = *(const f32x4*)p + gf[bj][n] * acc[ai][bj][m][n]; }
            }
    }
};

DEVI void transpose_item(const float* W, int srcN, int k0, int n0, bf16_t* dst  , int dstK, LAS float* scr, int lane) {
#pragma unroll 8
    for (int i = 0; i < 32; ++i) { const int kk = 2 * i + (lane >> 5); scr[kk * 33 + (lane & 31)] = W[(size_t)(k0 + kk) * srcN + n0 + (lane & 31)]; }
    asm volatile("s_waitcnt lgkmcnt(0)" ::: "memory");
    const int c = lane & 7;
#pragma unroll
    for (int j = 0; j < 4; ++j) { const int n = (lane >> 3) + 8 * j; const LAS float* s = scr + (8 * c) * 33 + n;
        u32x4 o; o.x = pk2(s[0 * 33], s[1 * 33]); o.y = pk2(s[2 * 33], s[3 * 33]); o.z = pk2(s[4 * 33], s[5 * 33]); o.w = pk2(s[6 * 33], s[7 * 33]);
        *(u32x4*)(dst + (size_t)n * dstK + 8 * c) = o; }
    asm volatile("s_waitcnt lgkmcnt(0)" ::: "memory");
}
DEVI void phase0(const Args& a, LAS unsigned char* lds, int tid, int lane, int wave) {
    unsigned char* ws = a.ws;
    bf16_t* WinA = (bf16_t*)(ws + WS_WINA); bf16_t* WinC = (bf16_t*)(ws + WS_WINC); bf16_t* Wbr = (bf16_t*)(ws + WS_WBR);
    bf16_t* Wout = (bf16_t*)(ws + WS_WOUT); bf16_t* Wup = (bf16_t*)(ws + WS_WUP); bf16_t* Wdn = (bf16_t*)(ws + WS_WDN);
    LAS float* scr = (LAS float*)(lds + wave * 16384);
    const int gw = blockIdx.x * 8 + wave, NGW = gridDim.x * 8;
    constexpr int I_IN = 16 * 241, I_BR = 16 * 32, I_UP = 16 * 176, I_DN = 44 * 32;
    constexpr int NITEMS = I_IN + 3 * I_BR + I_UP + I_DN;
    for (int it = gw; it < NITEMS; it += NGW) {
        int r = it;
        if (r < I_IN) { const int kb = r / 241, nb = r % 241, c0 = nb * 32; bf16_t* d; int row;
            if (c0 < 3072) { d = WinA; row = c0; } else if (c0 < 4096) { d = WinC; row = c0 - 3072; } else if (c0 == 4096) { d = WinA; row = 3072; }
            else if (c0 < 5152) { d = WinC; row = 1024 + (c0 - 4128); } else if (c0 < 5408) { d = WinC; row = 2048 + (c0 - 5152); }
            else if (c0 < 5664) { d = WinC; row = 2304 + (c0 - 5408); } else { d = WinC; row = 2560 + (c0 - 5664); }
            transpose_item(a.in[8], 7712, kb * 64, c0, d + (size_t)row * 1024 + kb * 64, 1024, scr, lane); continue; }
        r -= I_IN;
        if (r < I_BR) { const int kb = r / 32, nb = r % 32; transpose_item(a.in[16], 1024, kb * 64, nb * 32, Wbr + (size_t)(nb * 32) * 2048 + kb * 64, 2048, scr, lane); continue; }
        r -= I_BR;
        if (r < I_BR) { const int kb = r / 32, nb = r % 32; transpose_item(a.in[17], 1024, kb * 64, nb * 32, Wbr + (size_t)(nb * 32) * 2048 + 1024 + kb * 64, 2048, scr, lane); continue; }
        r -= I_BR;
        if (r < I_BR) { const int kb = r / 32, nb = r % 32; transpose_item(a.in[18], 1024, kb * 64, nb * 32, Wout + (size_t)(nb * 32) * 1024 + kb * 64, 1024, scr, lane); continue; }
        r -= I_BR;
        if (r < I_UP) { const int kb = r / 176, nb = r % 176, c0 = nb * 32; int row;
            if (c0 < DFF) row = 256 * (c0 / 128) + (c0 % 128); else { const int c1 = c0 - DFF; row = 256 * (c1 / 128) + 128 + (c1 % 128); }
            transpose_item(a.in[19], NUP, kb * 64, c0, Wup + (size_t)row * 1024 + kb * 64, 1024, scr, lane); continue; }
        r -= I_UP;
        { const int kb = r / 32, nb = r % 32; transpose_item(a.in[22], 1024, kb * 64, nb * 32, Wdn + (size_t)(nb * 32) * DFF + kb * 64, DFF, scr, lane); }
    }
    float* modacc = (float*)(ws + CTL_MODACC);
    for (int it = blockIdx.x; it < 12 * 16; it += gridDim.x) {
        const int cb = it % 12, ks = it / 12, n = cb * 512 + tid;
        float a0 = 0.f, a1 = 0.f, a2 = 0.f;
#pragma unroll 8
        for (int k = ks * 64; k < ks * 64 + 64; ++k) {
            const float w = a.in[4][(size_t)k * 6144 + n];
            a0 += siluf(a.in[1][k]) * w; a1 += siluf(a.in[1][1024 + k]) * w; a2 += siluf(a.in[3][k]) * w;
        }
        atomicAdd(modacc + n, a0); atomicAdd(modacc + 6144 + n, a1); atomicAdd(modacc + 12288 + n, a2);
    }
    float* rope = (float*)(ws + SM_ROPE);
    for (int i = blockIdx.x * 512 + tid; i < 320 * 32; i += gridDim.x * 512) {
        const int p = i >> 5, f = i & 31; const float inv = powf(10000.f, -(float)f / 32.f);
        if (p < 256) { const float ang = (float)p * inv; rope[p * 32 + f] = cosf(ang); rope[8192 + p * 32 + f] = sinf(ang); }
        else { const int q = p - 256; const float ang = (float)q * inv; rope[16384 + q * 32 + f] = cosf(ang); rope[16384 + 2048 + q * 32 + f] = sinf(ang); }
    }
}

DEVI void phase1(const Args& a, int tid, int lane, int wave) {
    unsigned char* ws = a.ws;
    const float* modacc = (const float*)(ws + CTL_MODACC); const float* bada = a.in[5];
    bf16_t* XN = (bf16_t*)(ws + WS_XN); float* rowss1 = (float*)(ws + SM_ROWSS1);
    const int gw = blockIdx.x * 8 + wave, NGW = gridDim.x * 8;
    for (int row = gw; row < MT; row += NGW) {
        const int vs = row < SEQ ? 0 : (row < ML ? 1 : 2);
        const float* xr = row < ML ? a.in[0] + (size_t)row * 1024 : a.in[2] + (size_t)(row - ML) * 1024;
        float ss = 0.f;
#pragma unroll
        for (int j = 0; j < 4; ++j) {
            const int c = 4 * lane + 256 * j;
            const f32x4 v = *(const f32x4*)(xr + c);
            ss += (v[0] * v[0] + v[1] * v[1]) + (v[2] * v[2] + v[3] * v[3]);
            const f32x4 s = (*(const f32x4*)(modacc + vs * 6144 + 1024 + c) + *(const f32x4*)(bada + 1024 + c) + 1.f) * *(const f32x4*)(a.in[6] + c);
            const f32x4 o = v * s; u32x2 w; w.x = pk2(o[0], o[1]); w.y = pk2(o[2], o[3]);
            *(u32x2*)(XN + (size_t)row * 1024 + c) = w;
        }
        ss = wave_sum(ss);
        if (lane == 0) rowss1[row] = ss;
    }
    const bf16_t* WinA = (const bf16_t*)(ws + WS_WINA); const bf16_t* WinC = (const bf16_t*)(ws + WS_WINC); const bf16_t* Wup = (const bf16_t*)(ws + WS_WUP);
    float* shWa = (float*)(ws + SM_SHWA); float* shWf = (float*)(ws + SM_SHWF);
    for (int n = gw; n < NSH + NUP; n += NGW) {
        const bool isf = n >= NSH;
        const bf16_t* wrow = isf ? Wup + (size_t)(n - NSH) * 1024 : (n < NA ? WinA + (size_t)n * 1024 : WinC + (size_t)(n - NA) * 1024);
        const int shoff = isf ? 3072 : 0;
        float s0 = 0.f, s1 = 0.f, s2 = 0.f;
#pragma unroll
        for (int h = 0; h < 2; ++h) {
            const int k0 = h * 512 + lane * 8;
            const u32x4 w = *(const u32x4*)(wrow + k0);
#pragma unroll
            for (int i = 0; i < 4; ++i) {
                const float wl = bflo(w[i]), wh = bfhi(w[i]); const int k = k0 + 2 * i;
                const float b0 = bada[shoff + k], b1 = bada[shoff + k + 1];
                s0 += (modacc[shoff + k] + b0) * wl + (modacc[shoff + k + 1] + b1) * wh;
                s1 += (modacc[6144 + shoff + k] + b0) * wl + (modacc[6144 + shoff + k + 1] + b1) * wh;
                s2 += (modacc[12288 + shoff + k] + b0) * wl + (modacc[12288 + shoff + k + 1] + b1) * wh;
            }
        }
        s0 = wave_sum(s0); s1 = wave_sum(s1); s2 = wave_sum(s2);
        if (lane == 0) {
            if (isf) { shWf[n - NSH] = s0; shWf[NUP + n - NSH] = s1; }
            else { shWa[n] = s0; shWa[NSH + n] = s1; shWa[2 * NSH + n] = s2; }
        }
    }
}

DEVI void phase_dnprep(const Args& a, int tid) {
    unsigned char* ws = a.ws;
    const bf16_t* QR = (const bf16_t*)(ws + WS_QKVR); bf16_t* QP = (bf16_t*)(ws + WS_QKVP);
    const float* convw = a.in[9]; const float* ba = (const float*)(ws + WS_BA);
    float* gb = (float*)(ws + WS_G); float* bb = (float*)(ws + WS_BETA);
    const int cg_ = tid & 15, rr = tid >> 4;
    for (int it = blockIdx.x; it < 520 * 24; it += gridDim.x) {
        const int cidx = it / 24, s = it % 24;
        int seq_start, t0, seq_len;
        if (cidx < 512) { seq_start = (cidx >> 8) * SEQ; t0 = (cidx & 255) * 64; seq_len = SEQ; }
        else { const int c2 = cidx - 512; seq_start = ML + (c2 >> 2) * CTX; t0 = (c2 & 3) * 64; seq_len = CTX; }
        const int col = s * 128 + cg_ * 8;
        f32x4 w0[5], w1[5];
#pragma unroll
        for (int j = 0; j < 5; ++j) { w0[j] = *(const f32x4*)(convw + j * 3072 + col); w1[j] = *(const f32x4*)(convw + j * 3072 + col + 4); }
#pragma unroll
        for (int pass = 0; pass < 2; ++pass) {
            const int r = rr + pass * 32;
            f32x4 acc0 = {0.f, 0.f, 0.f, 0.f}, acc1 = {0.f, 0.f, 0.f, 0.f};
#pragma unroll
            for (int j = 0; j < 5; ++j) {
                const int tt = t0 + r + j - 2;
                if (tt >= 0 && tt < seq_len) {
                    const u32x4 x = *(const u32x4*)(QR + (size_t)(seq_start + tt) * 3072 + col);
                    acc0 += (f32x4){bflo(x[0]), bfhi(x[0]), bflo(x[1]), bfhi(x[1])} * w0[j];
                    acc1 += (f32x4){bflo(x[2]), bfhi(x[2]), bflo(x[3]), bfhi(x[3])} * w1[j];
                }
            }
            float y[8];
#pragma unroll
            for (int i = 0; i < 4; ++i) { y[i] = siluf(acc0[i]); y[4 + i] = siluf(acc1[i]); }
            if (s < 16) {
                float ss = 0.f;
#pragma unroll
                for (int i = 0; i < 8; ++i) ss += y[i] * y[i];
                ss += __shfl_xor(ss, 1); ss += __shfl_xor(ss, 2); ss += __shfl_xor(ss, 4); ss += __shfl_xor(ss, 8);
                const float sc = rsqrtf(ss + EPS) * (s < 8 ? 0.08838834764831845f : 1.f);
#pragma unroll
                for (int i = 0; i < 8; ++i) y[i] *= sc;
            }
            u32x4 o; o.x = pk2(y[0], y[1]); o.y = pk2(y[2], y[3]); o.z = pk2(y[4], y[5]); o.w = pk2(y[6], y[7]);
            *(u32x4*)(QP + (size_t)(seq_start + t0 + r) * 3072 + col) = o;
        }
        if (s == 0) {
#pragma unroll
            for (int q = 0; q < 2; ++q) {
                const int e = tid + q * 512, r = e >> 4, idx = e & 15, row = seq_start + t0 + r;
                const float bv = ba[(size_t)row * 32 + idx], av = ba[(size_t)row * 32 + 16 + idx];
                const float xs = av + a.in[11][idx];
                const float sp = fmaxf(xs, 0.f) + log1pf(expf(-fabsf(xs)));
                const float g = -expf(a.in[10][idx]) * sp;
                const int dir = idx >> 3, h = idx & 7;
                gb[((size_t)dir * MT + row) * 8 + h] = g;
                bb[((size_t)dir * MT + row) * 8 + h] = 1.f / (1.f + expf(-bv));
            }
        }
    }
}

DEVI void phase_dnscan(const Args& a, int lane, int wave) {
    unsigned char* ws = a.ws;
    const bf16_t* QP = (const bf16_t*)(ws + WS_QKVP);
    const float* gb = (const float*)(ws + WS_G); const float* bb = (const float*)(ws + WS_BETA);
    bf16_t* Of = (bf16_t*)a.out; bf16_t* Ob = Of + (size_t)ML * 1024;
    const int gw = blockIdx.x * 8 + wave, NGW = gridDim.x * 8;
    for (int item = gw; item < 2048; item += NGW) {
        const int chain = item >> 6, ep = item & 63, dir = chain >> 4, b = (chain >> 3) & 1, h = chain & 7;
        bf16_t* O = dir ? Ob : Of;
        float S00 = 0.f, S01 = 0.f, S10 = 0.f, S11 = 0.f;
        const int NTOK = CTX + SEQ;
        constexpr int U = 4;
        unsigned kq[U], qq[U], vv[U]; float gg[U], be[U]; int rows[U];
        auto rowof = [&](int s) -> int { if (s < CTX) { const int t = dir ? CTX - 1 - s : s; return ML + b * CTX + t; } const int t2 = s - CTX; const int t = dir ? SEQ - 1 - t2 : t2; return b * SEQ + t; };
#define SC_LOAD(i, s) do { const int row_ = rowof(s); rows[i] = row_; const bf16_t* p_ = QP + (size_t)row_ * 3072 + h * 128; \
        qq[i] = *(const unsigned*)(p_ + 2 * lane); kq[i] = *(const unsigned*)(p_ + 1024 + 2 * lane); vv[i] = *(const unsigned*)(p_ + 2048 + 2 * ep); \
        gg[i] = gb[((size_t)dir * MT + row_) * 8 + h]; be[i] = bb[((size_t)dir * MT + row_) * 8 + h]; } while (0)
        for (int s0 = 0; s0 < NTOK; s0 += U) {
#pragma unroll
            for (int i = 0; i < U; ++i) SC_LOAD(i, s0 + i);
#pragma unroll
            for (int i = 0; i < U; ++i) {
                const float k0 = bflo(kq[i]), k1 = bfhi(kq[i]), q0 = bflo(qq[i]), q1 = bfhi(qq[i]), v0 = bflo(vv[i]), v1 = bfhi(vv[i]);
                const float eg = __expf(gg[i]), bt = be[i];
                float p0 = k0 * S00 + k1 * S10, p1 = k0 * S01 + k1 * S11;
                p0 = wave_sum(p0); p1 = wave_sum(p1);
                const float vn0 = bt * (v0 - eg * p0), vn1 = bt * (v1 - eg * p1);
                S00 = eg * S00 + k0 * vn0; S01 = eg * S01 + k0 * vn1; S10 = eg * S10 + k1 * vn0; S11 = eg * S11 + k1 * vn1;
                float o0 = q0 * S00 + q1 * S10, o1 = q0 * S01 + q1 * S11;
                o0 = wave_sum(o0); o1 = wave_sum(o1);
                if (lane == 0 && rows[i] < ML) *(unsigned*)(O + (size_t)rows[i] * 1024 + h * 128 + 2 * ep) = pk2(o0, o1);
            }
        }
#undef SC_LOAD
    }
}

DEVI bf16x8 ld_b128(LAS const unsigned char* p) { return *(LAS const bf16x8*)p; }
DEVI bf16x8 ld_2b64(LAS const unsigned char* p0, LAS const unsigned char* p1) { const u32x2 a = *(LAS const u32x2*)p0, b = *(LAS const u32x2*)p1; u32x4 w = {a.x, a.y, b.x, b.y}; return __builtin_bit_cast(bf16x8, w); }
DEVI bf16x8 pack_frag(const f32x4& lo, const f32x4& hi) { u32x4 w = {pk2(lo[0], lo[1]), pk2(lo[2], lo[3]), pk2(hi[0], hi[1]), pk2(hi[2], hi[3])}; return __builtin_bit_cast(bf16x8, w); }
#define MFMA16(A, B, C) __builtin_amdgcn_mfma_f32_16x16x32_bf16(A, B, C, 0, 0, 0)
DEVI void phase_dnchunk(const Args& a, LAS unsigned char* lds, int tid, int lane, int wave) {
    unsigned char* ws = a.ws;
    const bf16_t* QP = (const bf16_t*)(ws + WS_QKVP); const float* gb = (const float*)(ws + WS_G); const float* bb = (const float*)(ws + WS_BETA);
    bf16_t* TQ = (bf16_t*)(ws + WS_TQ); float* AV = (float*)(ws + WS_AVEC);
    constexpr int KL = 0, QL = 17408, KKF = 34816, QKF = 52224, VEC = 131072;
    const int fr = lane & 15, g = lane >> 4, d = wave >> 2, wq = wave & 3;
    LAS unsigned char* dbase = lds + d * 64512;
    LAS float* Gg = (LAS float*)(lds + VEC); LAS float* Bv = Gg + 128; LAS float* GC = Gg + 256;
    for (int item = blockIdx.x; item < 520 * 8; item += gridDim.x) {
        const int cidx = item >> 3, h = item & 7;
        const int row0 = cidx < 512 ? cidx * 64 : ML + (cidx - 512) * 64;
#pragma unroll
        for (int i = 0; i < 2; ++i) { const int c = tid + i * 512, r = c >> 4, ch = c & 15;
            const bf16_t* src = QP + (size_t)(row0 + r) * 3072 + h * 128 + ch * 8;
            *(LAS u32x4*)(lds + QL + r * 272 + ch * 16) = *(const u32x4*)src; *(LAS u32x4*)(lds + KL + r * 272 + ch * 16) = *(const u32x4*)(src + 1024); }
        if (tid < 128) { const int dd = tid >> 6, pos = tid & 63; Gg[tid] = gb[((size_t)dd * MT + row0 + pos) * 8 + h]; Bv[tid] = bb[((size_t)dd * MT + row0 + pos) * 8 + h]; }
        __syncthreads();
        if (wave < 2) {
            const int dd = wave, pos = dd ? 63 - lane : lane; float x = Gg[dd * 64 + pos];
#pragma unroll
            for (int o = 1; o < 64; o <<= 1) { const float y = __shfl_up(x, o); if (lane >= o) x += y; }
            const float total = __shfl(x, 63);
            GC[dd * 64 + pos] = x;
            float* av = AV + ((size_t)item * 2 + dd) * 256;
            av[pos] = __expf(x); av[64 + pos] = Bv[dd * 64 + pos]; av[128 + pos] = __expf(total - x); if (lane == 0) av[192] = __expf(total);
        }
        {
            const int src = d ? QL : KL;
            f32x4 acc[4] = {{0.f, 0.f, 0.f, 0.f}, {0.f, 0.f, 0.f, 0.f}, {0.f, 0.f, 0.f, 0.f}, {0.f, 0.f, 0.f, 0.f}};
#pragma unroll
            for (int s4 = 0; s4 < 4; ++s4) { const bf16x8 A = ld_b128(lds + src + (16 * wq + fr) * 272 + (32 * s4 + 8 * g) * 2);
#pragma unroll
                for (int jt = 0; jt < 4; ++jt) { const bf16x8 Bf = ld_b128(lds + KL + (16 * jt + fr) * 272 + (32 * s4 + 8 * g) * 2); acc[jt] = MFMA16(A, Bf, acc[jt]); } }
            LAS float* dst = (LAS float*)(lds + (d ? QKF : KKF));
#pragma unroll
            for (int jt = 0; jt < 4; ++jt)
#pragma unroll
                for (int r = 0; r < 4; ++r) dst[(16 * wq + 4 * g + r) * 68 + 16 * jt + fr] = acc[jt][r];
        }
        __syncthreads();
        f32x4 P[4], qd[4];
        {
            const LAS float* kkf = (const LAS float*)(lds + KKF); const LAS float* qkf = (const LAS float*)(lds + QKF);
            float gci[4], bei[4];
#pragma unroll
            for (int r = 0; r < 4; ++r) { gci[r] = GC[d * 64 + 16 * wq + 4 * g + r]; bei[r] = Bv[d * 64 + 16 * wq + 4 * g + r]; }
#pragma unroll
            for (int jt = 0; jt < 4; ++jt) { const int j = 16 * jt + fr; const float gcj = GC[d * 64 + j];
#pragma unroll
                for (int r = 0; r < 4; ++r) { const int i = 16 * wq + 4 * g + r; const bool incl = d ? (i <= j) : (i >= j);
                    const float e = incl ? __expf(gci[r] - gcj) : 0.f;
                    qd[jt][r] = qkf[i * 68 + j] * e; P[jt][r] = (i != j) ? -bei[r] * kkf[i * 68 + j] * e : 0.f; } }
        }
        __syncthreads();
        {
#pragma unroll
            for (int jt = 0; jt < 4; ++jt) {
#pragma unroll
                for (int r = 0; r < 4; ++r) { const int i = 16 * wq + 4 * g + r, j = 16 * jt + fr;
                    *(LAS unsigned short*)(dbase + 0 + i * 144 + j * 2) = (unsigned short)f2bf(P[jt][r]);
                    *(LAS unsigned short*)(dbase + 36864 + 9216 + i * 144 + j * 2) = (unsigned short)f2bf(P[jt][r]);
                    *(LAS unsigned short*)(dbase + 55296 + i * 144 + j * 2) = (unsigned short)f2bf(qd[jt][r]); }
                u32x2 w = {pk2(P[jt][0], P[jt][1]), pk2(P[jt][2], P[jt][3])};
                *(LAS u32x2*)(dbase + 18432 + (16 * jt + fr) * 144 + (16 * wq + 4 * g) * 2) = w; }
        }
        __syncthreads();
        int cur = 0;
#pragma unroll 1
        for (int it = 0; it < 5; ++it) {
            LAS unsigned char* NRc = dbase + cur * 9216; LAS unsigned char* NTc = dbase + 18432 + cur * 9216;
            LAS unsigned char* NRn = dbase + (cur ^ 1) * 9216; LAS unsigned char* NTn = dbase + 18432 + (cur ^ 1) * 9216;
            LAS unsigned char* PRo = dbase + 36864 + ((it + 1) & 1) * 9216; LAS unsigned char* PRn = dbase + 36864 + (it & 1) * 9216;
            f32x4 n2[4] = {{0.f, 0.f, 0.f, 0.f}, {0.f, 0.f, 0.f, 0.f}, {0.f, 0.f, 0.f, 0.f}, {0.f, 0.f, 0.f, 0.f}};
#pragma unroll
            for (int s2 = 0; s2 < 2; ++s2) { const bf16x8 A = ld_b128(NRc + (16 * wq + fr) * 144 + (32 * s2 + 8 * g) * 2);
#pragma unroll
                for (int jt = 0; jt < 4; ++jt) { const bf16x8 Bf = ld_b128(NTc + (16 * jt + fr) * 144 + (32 * s2 + 8 * g) * 2); n2[jt] = MFMA16(A, Bf, n2[jt]); } }
#pragma unroll
            for (int jt = 0; jt < 4; ++jt) {
#pragma unroll
                for (int r = 0; r < 4; ++r) *(LAS unsigned short*)(NRn + (16 * wq + 4 * g + r) * 144 + (16 * jt + fr) * 2) = (unsigned short)f2bf(n2[jt][r]);
                u32x2 w = {pk2(n2[jt][0], n2[jt][1]), pk2(n2[jt][2], n2[jt][3])};
                *(LAS u32x2*)(NTn + (16 * jt + fr) * 144 + (16 * wq + 4 * g) * 2) = w;
                P[jt] += n2[jt]; }
            __syncthreads();
#pragma unroll
            for (int s2 = 0; s2 < 2; ++s2) { const bf16x8 A = ld_b128(PRo + (16 * wq + fr) * 144 + (32 * s2 + 8 * g) * 2);
#pragma unroll
                for (int jt = 0; jt < 4; ++jt) { const bf16x8 Bf = ld_b128(NTn + (16 * jt + fr) * 144 + (32 * s2 + 8 * g) * 2); P[jt] = MFMA16(A, Bf, P[jt]); } }
#pragma unroll
            for (int jt = 0; jt < 4; ++jt)
#pragma unroll
                for (int r = 0; r < 4; ++r) *(LAS unsigned short*)(PRn + (16 * wq + 4 * g + r) * 144 + (16 * jt + fr) * 2) = (unsigned short)f2bf(P[jt][r]);
            cur ^= 1;
        }
        __syncthreads();
        {
            bf16_t* dst = TQ + ((size_t)item * 2 + d) * 8192; const int t2 = tid & 255;
#pragma unroll
            for (int k = 0; k < 4; ++k) { const int c = t2 + 256 * k, mat = c >> 9, r = (c >> 3) & 63, ch = c & 7;
                const u32x4 v = *(LAS const u32x4*)(dbase + (mat ? 55296 : 36864) + r * 144 + ch * 16);
                *(u32x4*)(dst + mat * 4096 + r * 64 + ch * 8) = v; }
        }
        __syncthreads();
    }
}

DEVI void phase_dnscan2(const Args& a, LAS unsigned char* lds, int tid, int lane, int wave) {
    const int v = blockIdx.x;
    if (v < 64) {
    unsigned char* ws = a.ws;
    const bf16_t* QP = (const bf16_t*)(ws + WS_QKVP); const bf16_t* TQ = (const bf16_t*)(ws + WS_TQ); const float* AV = (const float*)(ws + WS_AVEC);
    const int chain = (v & 7) + 8 * (v >> 4), hf = (v >> 3) & 1, dir = chain >> 4, b = (chain >> 3) & 1, h = chain & 7;
    bf16_t* O = (bf16_t*)a.out + (size_t)dir * ML * 1024;
    constexpr int KL = 0, QL = 17408, VL = 34816, TL = 44032, DL = 53248, AL = 62464, BUFB = 63488, OT = 2 * BUFB, NSTEP = 260;
    const int fr = lane & 15, g = lane >> 4, ltid = tid - 256;
    auto step_cidx = [&](int s) -> int { if (s < 4) return 512 + b * 4 + (dir ? 3 - s : s); const int c = s - 4; return b * 256 + (dir ? 255 - c : c); };
    u32x4 kreg[4], qreg[4], vreg[2], treg[2], dreg[2], areg;
#define LD_ISSUE(s_) do { const int cidx_ = step_cidx(s_); const int row0_ = cidx_ < 512 ? cidx_ * 64 : ML + (cidx_ - 512) * 64; \
        const bf16_t* tqb_ = TQ + ((size_t)(cidx_ * 8 + h) * 2 + dir) * 8192; const float* avb_ = AV + ((size_t)(cidx_ * 8 + h) * 2 + dir) * 256; \
        _Pragma("unroll") for (int i = 0; i < 4; ++i) { const int c = ltid + 256 * i, r = c >> 4, ch = c & 15; const bf16_t* p_ = QP + (size_t)(row0_ + r) * 3072 + h * 128 + ch * 8; qreg[i] = *(const u32x4*)p_; kreg[i] = *(const u32x4*)(p_ + 1024); } \
        _Pragma("unroll") for (int i = 0; i < 2; ++i) { const int c = ltid + 256 * i, r = c >> 3, ch = c & 7; vreg[i] = *(const u32x4*)(QP + (size_t)(row0_ + r) * 3072 + 2048 + h * 128 + hf * 64 + ch * 8); \
            treg[i] = *(const u32x4*)(tqb_ + r * 64 + ch * 8); dreg[i] = *(const u32x4*)(tqb_ + 4096 + r * 64 + ch * 8); } \
        if (ltid < 64) areg = *(const u32x4*)(avb_ + ltid * 4); } while (0)
#define LD_WRITE(bo_) do { LAS unsigned char* B_ = lds + (bo_); \
        _Pragma("unroll") for (int i = 0; i < 4; ++i) { const int c = ltid + 256 * i, r = c >> 4, ch = c & 15; *(LAS u32x4*)(B_ + QL + r * 272 + ch * 16) = qreg[i]; *(LAS u32x4*)(B_ + KL + r * 272 + ch * 16) = kreg[i]; } \
        _Pragma("unroll") for (int i = 0; i < 2; ++i) { const int c = ltid + 256 * i, r = c >> 3, ch = c & 7; *(LAS u32x4*)(B_ + VL + r * 144 + ch * 16) = vreg[i]; \
            *(LAS u32x4*)(B_ + TL + r * 144 + ch * 16) = treg[i]; *(LAS u32x4*)(B_ + DL + r * 144 + ch * 16) = dreg[i]; } \
        if (ltid < 64) *(LAS u32x4*)(B_ + AL + ltid * 16) = areg; } while (0)
#define OT_OUT(s_) do { const int cidx_ = step_cidx(s_); const int row0_ = cidx_ * 64; LAS const unsigned char* ot_ = lds + OT + ((s_) & 1) * 9216; \
        _Pragma("unroll") for (int i = 0; i < 2; ++i) { const int c = ltid + 256 * i, r = c >> 3, ch = c & 7; \
            *(u32x4*)(O + (size_t)(row0_ + r) * 1024 + h * 128 + hf * 64 + ch * 8) = *(LAS const u32x4*)(ot_ + r * 144 + ch * 16); } } while (0)
    f32x4 S[8];
#pragma unroll
    for (int i = 0; i < 8; ++i) S[i] = (f32x4){0.f, 0.f, 0.f, 0.f};
    if (wave >= 4) { LD_ISSUE(0); LD_WRITE(0); }
#pragma unroll 1
    for (int s = 0; s < NSTEP; ++s) {
        __syncthreads();
        if (wave >= 4) {
            if (s + 1 < NSTEP) LD_ISSUE(s + 1);
            if (s >= 5) OT_OUT(s - 1);
            if (s + 1 < NSTEP) LD_WRITE(((s + 1) & 1) * BUFB);
        } else {
            LAS const unsigned char* B = lds + (s & 1) * BUFB;
            const LAS float* avl = (const LAS float*)(B + AL);
            bf16x8 Sb[4];
#pragma unroll
            for (int s4 = 0; s4 < 4; ++s4) Sb[s4] = pack_frag(S[2 * s4], S[2 * s4 + 1]);
            f32x4 Z[4], OQ[4];
#pragma unroll
            for (int pt = 0; pt < 4; ++pt) { Z[pt] = (f32x4){0.f, 0.f, 0.f, 0.f}; OQ[pt] = (f32x4){0.f, 0.f, 0.f, 0.f};
#pragma unroll
                for (int s4 = 0; s4 < 4; ++s4) { const int off = (16 * pt + fr) * 272 + (32 * s4 + 4 * g) * 2;
                    Z[pt] = MFMA16(ld_2b64(B + KL + off, B + KL + off + 32), Sb[s4], Z[pt]);
                    OQ[pt] = MFMA16(ld_2b64(B + QL + off, B + QL + off + 32), Sb[s4], OQ[pt]); } }
            f32x4 av[4];
#pragma unroll
            for (int pt = 0; pt < 4; ++pt) { av[pt] = *(const LAS f32x4*)(avl + 16 * pt + 4 * g); const f32x4 bv = *(const LAS f32x4*)(avl + 64 + 16 * pt + 4 * g);
#pragma unroll
                for (int r = 0; r < 4; ++r) { const float vv = bf2f(*(const LAS unsigned short*)(B + VL + (16 * pt + 4 * g + r) * 144 + (16 * wave + fr) * 2)); Z[pt][r] = bv[r] * (vv - av[pt][r] * Z[pt][r]); } }
            f32x4 X[4];
            { const bf16x8 Zb0 = pack_frag(Z[0], Z[1]), Zb1 = pack_frag(Z[2], Z[3]);
#pragma unroll
              for (int pt = 0; pt < 4; ++pt) { const int off = (16 * pt + fr) * 144 + (4 * g) * 2;
                  X[pt] = MFMA16(ld_2b64(B + TL + off, B + TL + off + 32), Zb0, Z[pt]);
                  X[pt] = MFMA16(ld_2b64(B + TL + off + 64, B + TL + off + 96), Zb1, X[pt]); } }
            bf16x8 Xc0, Xc1;
            { const bf16x8 Xb0 = pack_frag(X[0], X[1]), Xb1 = pack_frag(X[2], X[3]);
              LAS unsigned char* ot = lds + OT + (s & 1) * 9216;
#pragma unroll
              for (int pt = 0; pt < 4; ++pt) { const int off = (16 * pt + fr) * 144 + (4 * g) * 2;
                  f32x4 o2 = av[pt] * OQ[pt];
                  o2 = MFMA16(ld_2b64(B + DL + off, B + DL + off + 32), Xb0, o2);
                  o2 = MFMA16(ld_2b64(B + DL + off + 64, B + DL + off + 96), Xb1, o2);
#pragma unroll
                  for (int r = 0; r < 4; ++r) *(LAS unsigned short*)(ot + (16 * pt + 4 * g + r) * 144 + (16 * wave + fr) * 2) = (unsigned short)f2bf(o2[r]); }
              f32x4 cx[4];
#pragma unroll
              for (int pt = 0; pt < 4; ++pt) cx[pt] = X[pt] * *(const LAS f32x4*)(avl + 128 + 16 * pt + 4 * g);
              Xc0 = pack_frag(cx[0], cx[1]); Xc1 = pack_frag(cx[2], cx[3]); }
            const float egl = avl[192];
            const int trq = fr >> 2, trp = fr & 3;
#pragma unroll
            for (int dt = 0; dt < 8; ++dt) {
                LAS unsigned char* kp = (LAS unsigned char*)(B + KL + (4 * g + trq) * 272 + (16 * dt + 4 * trp) * 2);
                const s16x4 a0 = __builtin_bit_cast(s16x4, __builtin_amdgcn_ds_read_tr16_b64_v4i16((LAS s16x4*)(kp)));
                const s16x4 a1 = __builtin_bit_cast(s16x4, __builtin_amdgcn_ds_read_tr16_b64_v4i16((LAS s16x4*)(kp + 16 * 272)));
                const s16x4 a2 = __builtin_bit_cast(s16x4, __builtin_amdgcn_ds_read_tr16_b64_v4i16((LAS s16x4*)(kp + 32 * 272)));
                const s16x4 a3 = __builtin_bit_cast(s16x4, __builtin_amdgcn_ds_read_tr16_b64_v4i16((LAS s16x4*)(kp + 48 * 272)));
                f32x4 sn = S[dt] * egl;
                sn = MFMA16(((bf16x8){a0[0], a0[1], a0[2], a0[3], a1[0], a1[1], a1[2], a1[3]}), Xc0, sn);
                sn = MFMA16(((bf16x8){a2[0], a2[1], a2[2], a2[3], a3[0], a3[1], a3[2], a3[3]}), Xc1, sn);
                S[dt] = sn; }
        }
    }
    __syncthreads();
    if (wave >= 4) OT_OUT(NSTEP - 1);
#undef LD_ISSUE
#undef LD_WRITE
#undef OT_OUT
    }
}

DEVI void phase_prep2(const Args& a, int lane, int wave) {
    unsigned char* ws = a.ws;
    bf16_t* KAT = (bf16_t*)(ws + WS_KAT); const float* rope = (const float*)(ws + SM_ROPE); const float* knw = a.in[14];
    const int gw = blockIdx.x * 8 + wave, NGW = gridDim.x * 8;
    for (int row = gw; row < MT; row += NGW) {
        bf16_t* p = KAT + (size_t)row * 256 + lane * 4;
        const u32x2 w = *(const u32x2*)p;
        float x[4] = {bflo(w.x), bfhi(w.x), bflo(w.y), bfhi(w.y)};
        float ss = (x[0] * x[0] + x[1] * x[1]) + (x[2] * x[2] + x[3] * x[3]);
        ss += __shfl_xor(ss, 1); ss += __shfl_xor(ss, 2); ss += __shfl_xor(ss, 4); ss += __shfl_xor(ss, 8); ss += __shfl_xor(ss, 16);
        const float rs = rsqrtf(ss * (1.f / 128.f) + EPS);
        const int d = (lane & 31) * 4;
        const f32x4 nw = *(const f32x4*)(knw + d);
#pragma unroll
        for (int i = 0; i < 4; ++i) x[i] = x[i] * rs * nw[i];
        float pr[4];
#pragma unroll
        for (int i = 0; i < 4; ++i) pr[i] = __shfl_xor(x[i], 8);
        if (row < ML) {
            const int t = row & (SEQ - 1), lg = (lane & 31) >> 3, fi = (lane & 7) * 4;
            const float* ct = lg < 2 ? rope + (t >> 6) * 32 + fi : rope + 16384 + (t & 63) * 32 + fi;
            const float* st = lg < 2 ? ct + 8192 : ct + 2048;
            const f32x4 c = *(const f32x4*)ct, s = *(const f32x4*)st;
            const float sg = (lg & 1) ? 1.f : -1.f;
#pragma unroll
            for (int i = 0; i < 4; ++i) x[i] = x[i] * c[i] + sg * pr[i] * s[i];
        }
        u32x2 o; o.x = pk2(x[0], x[1]); o.y = pk2(x[2], x[3]);
        *(u32x2*)p = o;
    }
    const bf16_t* Of = (const bf16_t*)a.out; const bf16_t* Ob = Of + (size_t)ML * 1024;
    const bf16_t* GT = (const bf16_t*)(ws + WS_GT); bf16_t* Y = (bf16_t*)(ws + WS_Y); const float* dnw = a.in[12];
    for (int row = gw; row < ML; row += NGW) {
        const int c0 = lane * 16;
        float o[16];
#pragma unroll
        for (int hh = 0; hh < 2; ++hh) {
            const u32x4 f = *(const u32x4*)(Of + (size_t)row * 1024 + c0 + hh * 8), bk = *(const u32x4*)(Ob + (size_t)row * 1024 + c0 + hh * 8);
#pragma unroll
            for (int i = 0; i < 4; ++i) { o[hh * 8 + 2 * i] = bflo(f[i]) + bflo(bk[i]); o[hh * 8 + 2 * i + 1] = bfhi(f[i]) + bfhi(bk[i]); }
        }
        float ss = 0.f;
#pragma unroll
        for (int i = 0; i < 16; ++i) ss += o[i] * o[i];
        ss += __shfl_xor(ss, 1); ss += __shfl_xor(ss, 2); ss += __shfl_xor(ss, 4);
        const float rs = rsqrtf(ss * (1.f / 128.f) + EPS);
        const int d0 = c0 & 127;
#pragma unroll
        for (int hh = 0; hh < 2; ++hh) {
            const u32x4 gt = *(const u32x4*)(GT + (size_t)row * 1024 + c0 + hh * 8);
            float y[8];
#pragma unroll
            for (int i = 0; i < 4; ++i) {
                y[2 * i] = o[hh * 8 + 2 * i] * rs * dnw[d0 + hh * 8 + 2 * i] * siluf(bflo(gt[i]));
                y[2 * i + 1] = o[hh * 8 + 2 * i + 1] * rs * dnw[d0 + hh * 8 + 2 * i + 1] * siluf(bfhi(gt[i]));
            }
            u32x4 w; w.x = pk2(y[0], y[1]); w.y = pk2(y[2], y[3]); w.z = pk2(y[4], y[5]); w.w = pk2(y[6], y[7]);
            *(u32x4*)(Y + (size_t)row * 2048 + c0 + hh * 8) = w;
        }
    }
}

namespace att {
constexpr int D = 128, NW = 8, QBLK = 32, KVBLK = 64;
constexpr float SCALE = 0.088388347648318440f;
constexpr float THR = 8.f;
constexpr int LDK = 256;
constexpr size_t SHM_V = KVBLK * D * 2, SHM_K = KVBLK * D * 2;
constexpr size_t OFF_WS = 2 * SHM_V + 2 * SHM_K, OFF_OST = OFF_WS + NW * 64 * 4;
#define KSWZ(row, colB) ((row) * 256 + ((colB) ^ (((row) & 7) << 4)))
#define SBAR() __builtin_amdgcn_sched_barrier(0)
DEVI int crow(int r, int hi) { return (r & 3) + 8 * (r >> 2) + 4 * hi; }
DEVI unsigned cvtpk(float lo, float hi) { unsigned r; asm volatile("v_cvt_pk_bf16_f32 %0, %1, %2" : "=v"(r) : "v"(lo), "v"(hi)); return r; }
DEVI void partialSM(f32x16& p0, f32x16& p1, float& m_reg, float& mn, float& alpha) {
    constexpr float C = SCALE * 1.4426950408889634f;
    float pmax = p0[0];
#pragma unroll
    for (int r = 1; r < 16; ++r) pmax = fmaxf(pmax, p0[r]);
#pragma unroll
    for (int r = 0; r < 16; ++r) pmax = fmaxf(pmax, p1[r]);
    { auto rr = __builtin_amdgcn_permlane32_swap(__float_as_uint(pmax), __float_as_uint(pmax), false, false);
      pmax = fmaxf(__uint_as_float(rr[0]), __uint_as_float(rr[1])); }
    if (__builtin_expect(__all(pmax - m_reg <= THR / SCALE), 1)) { mn = m_reg; alpha = 1.f; }
    else { mn = fmaxf(m_reg, pmax); alpha = __builtin_amdgcn_exp2f((m_reg - mn) * C); m_reg = mn; }
    const float mnC = -mn * C;
#pragma unroll
    for (int r = 0; r < 16; ++r) p0[r] = fmaf(p0[r], C, mnC);
#pragma unroll
    for (int r = 0; r < 16; ++r) p1[r] = fmaf(p1[r], C, mnC);
#pragma unroll
    for (int r = 0; r < 16; ++r) p0[r] = __builtin_amdgcn_exp2f(p0[r]);
}
DEVI void finishSM(f32x16& p0, f32x16& p1, float alpha, float& l_reg, bf16x8& pa0, bf16x8& pa1, bf16x8& pa2, bf16x8& pa3) {
#pragma unroll
    for (int r = 0; r < 16; ++r) p1[r] = __builtin_amdgcn_exp2f(p1[r]);
    float ps = 0;
#pragma unroll
    for (int r = 0; r < 16; ++r) ps += p0[r];
#pragma unroll
    for (int r = 0; r < 16; ++r) ps += p1[r];
    { auto rr = __builtin_amdgcn_permlane32_swap(__float_as_uint(ps), __float_as_uint(ps), false, false);
      ps = __uint_as_float(rr[0]) + __uint_as_float(rr[1]); }
    l_reg = l_reg * alpha + ps;
#define PK4(P, BASE, OUT) do { unsigned a0 = cvtpk(P[BASE + 0], P[BASE + 1]), a1 = cvtpk(P[BASE + 2], P[BASE + 3]);   \
    unsigned b0 = cvtpk(P[BASE + 4], P[BASE + 5]), b1 = cvtpk(P[BASE + 6], P[BASE + 7]);                              \
    auto r0 = __builtin_amdgcn_permlane32_swap(a0, b0, false, false); auto r1 = __builtin_amdgcn_permlane32_swap(a1, b1, false, false); \
    u32x4 w = {r0[0], r1[0], r0[1], r1[1]}; OUT = *reinterpret_cast<bf16x8*>(&w); } while (0)
    PK4(p0, 0, pa0); PK4(p0, 8, pa1); PK4(p1, 0, pa2); PK4(p1, 8, pa3);
#undef PK4
}
DEVI void qkt(f32x16& p0, f32x16& p1, const char* Ks, const bf16x8* qr, int r32, int hi) {
    p0 = f32x16{}; p1 = f32x16{};
#pragma unroll
    for (int d0 = 0; d0 < 8; ++d0) { const int cb = (d0 * 16 + hi * 8) * 2;
        const bf16x8 b0 = *reinterpret_cast<const bf16x8*>(Ks + KSWZ(r32, cb));
        const bf16x8 b1 = *reinterpret_cast<const bf16x8*>(Ks + KSWZ(32 + r32, cb));
        p0 = __builtin_amdgcn_mfma_f32_32x32x16_bf16(b0, qr[d0], p0, 0, 0, 0);
        p1 = __builtin_amdgcn_mfma_f32_32x32x16_bf16(b1, qr[d0], p1, 0, 0, 0); }
}
DEVI int v_st(int k, int c) { const int kk = (k & ~0xC) | ((k & 4) << 1) | ((k & 8) >> 1); return ((kk >> 3) * 4 + (c >> 5)) * 512 + ((kk & 7) * 32 + (c & 31)) * 2; }
DEVI int v_rd_base(int lane) { return ((lane & 3) << 3) | (((lane >> 2) & 3) << 6) | (((lane >> 4) & 1) << 5) | (((lane >> 5) & 1) << 8); }
constexpr int v_rd_off(int d0, int ks, int half) { return d0 * 512 + ks * 4096 + half * 2048; }
template <int OFF> DEVI s16x4 tr_read(int vb) { s16x4 r; asm volatile("ds_read_b64_tr_b16 %0, %1 offset:%2" : "=&v"(r) : "v"(vb), "i"(OFF) : "memory"); return r; }
template <int D0> DEVI void pv_one(f32x16& od, int vb, bf16x8 pa0, bf16x8 pa1, bf16x8 pa2, bf16x8 pa3) {
    const s16x4 l0 = tr_read<v_rd_off(D0, 0, 0)>(vb), h0 = tr_read<v_rd_off(D0, 0, 1)>(vb), l1 = tr_read<v_rd_off(D0, 1, 0)>(vb), h1 = tr_read<v_rd_off(D0, 1, 1)>(vb);
    const s16x4 l2 = tr_read<v_rd_off(D0, 2, 0)>(vb), h2 = tr_read<v_rd_off(D0, 2, 1)>(vb), l3 = tr_read<v_rd_off(D0, 3, 0)>(vb), h3 = tr_read<v_rd_off(D0, 3, 1)>(vb);
    asm volatile("s_waitcnt lgkmcnt(0)" ::: "memory"); SBAR();
#define PK(L, H) (bf16x8){L[0], L[1], L[2], L[3], H[0], H[1], H[2], H[3]}
    od = __builtin_amdgcn_mfma_f32_32x32x16_bf16(pa0, PK(l0, h0), od, 0, 0, 0);
    od = __builtin_amdgcn_mfma_f32_32x32x16_bf16(pa1, PK(l1, h1), od, 0, 0, 0);
    od = __builtin_amdgcn_mfma_f32_32x32x16_bf16(pa2, PK(l2, h2), od, 0, 0, 0);
    od = __builtin_amdgcn_mfma_f32_32x32x16_bf16(pa3, PK(l3, h3), od, 0, 0, 0);
#undef PK
}
DEVI void pv_d0(f32x16* o, int vb, bf16x8 pa0, bf16x8 pa1, bf16x8 pa2, bf16x8 pa3) {
    pv_one<0>(o[0], vb, pa0, pa1, pa2, pa3); pv_one<1>(o[1], vb, pa0, pa1, pa2, pa3); pv_one<2>(o[2], vb, pa0, pa1, pa2, pa3); pv_one<3>(o[3], vb, pa0, pa1, pa2, pa3);
}
DEVI void wmask(f32x16& p0, f32x16& p1, int qp, int kt0, int hi) {
#pragma unroll
    for (int r = 0; r < 16; ++r) { const int kp = kt0 + crow(r, hi); const int d0 = qp - kp, d1 = d0 - 32;
        if (d0 > 128 || d0 < -128) p0[r] = -1e30f; if (d1 > 128 || d1 < -128) p1[r] = -1e30f; }
}
DEVI void attn_unit(const Args& a, int b, int h, int qb, char* lds) {
    unsigned char* ws = a.ws;
    const bf16_t* QAT = (const bf16_t*)(ws + WS_QAT); const bf16_t* KAT = (const bf16_t*)(ws + WS_KAT); const bf16_t* VAT = (const bf16_t*)(ws + WS_VAT);
    bf16_t* Y = (bf16_t*)(ws + WS_Y); const float* rope = (const float*)(ws + SM_ROPE);
    const int tid = threadIdx.x, wid = tid >> 6, lane = tid & 63, r32 = lane & 31, hi = lane >> 5;
    const int kvh = h >> 2, t0 = qb * 256;
    char* V_lds = lds; char* K_lds = lds + 2 * SHM_V;
    float* wsf = (float*)(lds + OFF_WS) + wid * 64; float* li_l = wsf; float* al_l = wsf + 32;
    float m_reg = -1e30f, l_reg = 0; f32x16 o[4] = {}; bf16x8 qr[8];
    const int qp = t0 + wid * QBLK + r32;
    {
        const bf16_t* Qw = QAT + (size_t)(b * SEQ + qp) * 1024 + h * 128 + hi * 8;
        u32x4 raw[8]; float ss = 0.f;
#pragma unroll
        for (int d0 = 0; d0 < 8; ++d0) { raw[d0] = *(const u32x4*)(Qw + d0 * 16);
#pragma unroll
            for (int i = 0; i < 4; ++i) { const float lo_ = bflo(raw[d0][i]), hi_ = bfhi(raw[d0][i]); ss += lo_ * lo_ + hi_ * hi_; } }
        { auto rr = __builtin_amdgcn_permlane32_swap(__float_as_uint(ss), __float_as_uint(ss), false, false); ss = __uint_as_float(rr[0]) + __uint_as_float(rr[1]); }
        const float rs = rsqrtf(ss * (1.f / 128.f) + EPS);
        const float* qnw = a.in[13];
#pragma unroll
        for (int half = 0; half < 2; ++half) {
            const float* ct = half == 0 ? rope + (qp >> 6) * 32 : rope + 16384 + (qp & 63) * 32;
            const float* st = half == 0 ? ct + 8192 : ct + 2048;
#pragma unroll
            for (int dd = 0; dd < 2; ++dd) {
                const int fi = dd * 16 + hi * 8, da = half * 4 + dd, db = da + 2;
                u32x4 oa, ob;
#pragma unroll
                for (int q4 = 0; q4 < 2; ++q4) {
                    const f32x4 c = *(const f32x4*)(ct + fi + 4 * q4), s = *(const f32x4*)(st + fi + 4 * q4);
                    const f32x4 wa = *(const f32x4*)(qnw + da * 16 + hi * 8 + 4 * q4), wb = *(const f32x4*)(qnw + db * 16 + hi * 8 + 4 * q4);
                    float ya[4], yb[4];
#pragma unroll
                    for (int j = 0; j < 4; ++j) {
                        const unsigned ra = raw[da][2 * q4 + (j >> 1)], rb = raw[db][2 * q4 + (j >> 1)];
                        const float x1 = ((j & 1) ? bfhi(ra) : bflo(ra)) * rs * wa[j], x2 = ((j & 1) ? bfhi(rb) : bflo(rb)) * rs * wb[j];
                        ya[j] = x1 * c[j] - x2 * s[j]; yb[j] = x2 * c[j] + x1 * s[j];
                    }
                    oa[2 * q4] = cvtpk(ya[0], ya[1]); oa[2 * q4 + 1] = cvtpk(ya[2], ya[3]); ob[2 * q4] = cvtpk(yb[0], yb[1]); ob[2 * q4 + 1] = cvtpk(yb[2], yb[3]);
                }
                qr[da] = *reinterpret_cast<bf16x8*>(&oa); qr[db] = *reinterpret_cast<bf16x8*>(&ob);
            }
        }
    }
    const int tk0 = t0 - 128 < 0 ? 0 : t0 - 128, tk1 = t0 + 384 > SEQ ? SEQ : t0 + 384;
    const int NT = 4 + (tk1 - tk0) / 64;
    const int ctxrow = ML + b * CTX, latrow = b * SEQ + tk0 - 256;
#define TROW(j) ((j) < 4 ? ctxrow + 64 * (j) : latrow + 64 * (j))
    const bf16_t* Kh = KAT + kvh * 128; const bf16_t* Vh = VAT + kvh * 128;
    const int sr = tid >> 4, sc = (tid & 15) * 8, vst0 = v_st(sr, sc), vst1 = v_st(32 + sr, sc);
    const int vb0 = (int)(uintptr_t)V_lds + v_rd_base(lane);
    struct { bf16x8 vs0, vs1, ks0, ks1; } sr_[1];
#define SLOAD(i, j) do { const int k0_ = TROW(j); sr_[i].vs0 = *(const bf16x8*)(Vh + (size_t)(k0_ + sr) * LDK + sc); sr_[i].vs1 = *(const bf16x8*)(Vh + (size_t)(k0_ + 32 + sr) * LDK + sc); \
    sr_[i].ks0 = *(const bf16x8*)(Kh + (size_t)(k0_ + sr) * LDK + sc); sr_[i].ks1 = *(const bf16x8*)(Kh + (size_t)(k0_ + 32 + sr) * LDK + sc); } while (0)
#define SWRITE(bf, i) do { *(bf16x8*)(V_lds + (bf) * SHM_V + vst0) = sr_[i].vs0; *(bf16x8*)(V_lds + (bf) * SHM_V + vst1) = sr_[i].vs1; const int kc = sc * 2; \
    *(bf16x8*)(K_lds + (bf) * SHM_K + KSWZ(sr, kc)) = sr_[i].ks0; *(bf16x8*)(K_lds + (bf) * SHM_K + KSWZ(32 + sr, kc)) = sr_[i].ks1; } while (0)
#define SWAIT() asm volatile("s_waitcnt vmcnt(0)" ::: "memory")
#define RESC(al) do { if (__any((al) < 1.f)) { if (hi == 0) al_l[r32] = (al); asm volatile("s_waitcnt lgkmcnt(0)" ::: "memory"); \
    _Pragma("unroll") for (int d = 0; d < 4; ++d) _Pragma("unroll") for (int r = 0; r < 16; ++r) o[d][r] *= al_l[crow(r, hi)]; } } while (0)
#define WMASK(P0, P1, j) do { if ((j) >= 4) wmask(P0, P1, qp, tk0 + 64 * ((j) - 4), hi); } while (0)
    f32x16 pA0, pA1, pB0, pB1; float mnA, mnB, alA, alB; bf16x8 pa0, pa1, pa2, pa3;
    constexpr int SE = 0, SO = 0;
    SLOAD(SE, 0); asm volatile("s_waitcnt vmcnt(0)" ::: "memory"); SWRITE(0, SE); __syncthreads();
    qkt(pA0, pA1, K_lds, qr, r32, hi); partialSM(pA0, pA1, m_reg, mnA, alA);
    SLOAD(SO, 1);
    SWAIT(); SWRITE(1, SO); __syncthreads();
    for (int j = 1; j + 1 < NT; j += 2) {
        SBAR(); qkt(pB0, pB1, K_lds + SHM_K, qr, r32, hi); WMASK(pB0, pB1, j);
        finishSM(pA0, pA1, alA, l_reg, pa0, pa1, pa2, pa3); SBAR();
        SLOAD(SO, j + 1); SBAR();
        pv_d0(o, vb0, pa0, pa1, pa2, pa3); partialSM(pB0, pB1, m_reg, mnB, alB);
        __syncthreads(); SWAIT(); SWRITE(0, SE);
        RESC(alB); __syncthreads();
        SBAR(); qkt(pA0, pA1, K_lds, qr, r32, hi); WMASK(pA0, pA1, j + 1);
        finishSM(pB0, pB1, alB, l_reg, pa0, pa1, pa2, pa3); SBAR();
        SLOAD(SE, j + 2); SBAR();
        pv_d0(o, vb0 + (int)SHM_V, pa0, pa1, pa2, pa3); partialSM(pA0, pA1, m_reg, mnA, alA);
        __syncthreads(); SWAIT(); SWRITE(1, SO);
        RESC(alA); __syncthreads();
    }
    SBAR(); qkt(pB0, pB1, K_lds + SHM_K, qr, r32, hi); WMASK(pB0, pB1, NT - 1);
    finishSM(pA0, pA1, alA, l_reg, pa0, pa1, pa2, pa3); SBAR();
    pv_d0(o, vb0, pa0, pa1, pa2, pa3); partialSM(pB0, pB1, m_reg, mnB, alB);
    __syncthreads(); RESC(alB);
    finishSM(pB0, pB1, alB, l_reg, pa0, pa1, pa2, pa3); SBAR();
    pv_d0(o, vb0 + (int)SHM_V, pa0, pa1, pa2, pa3);
    l_reg += __builtin_amdgcn_exp2f(a.in[15][h] * 1.4426950408889634f - m_reg * (SCALE * 1.4426950408889634f));
    if (hi == 0) li_l[r32] = l_reg; asm volatile("s_waitcnt lgkmcnt(0)" ::: "memory");
    float rli[16];
#pragma unroll
    for (int r = 0; r < 16; ++r) rli[r] = __builtin_amdgcn_rcpf(li_l[crow(r, hi)]);
    {
        bf16_t* stg = (bf16_t*)(lds + OFF_OST) + wid * 4096;
#pragma unroll
        for (int r = 0; r < 16; ++r) { const int orow = crow(r, hi);
#pragma unroll
            for (int d0 = 0; d0 < 4; ++d0) stg[orow * 128 + d0 * 32 + r32] = (bf16_t)f2bf(o[d0][r] * rli[r]); }
        asm volatile("s_waitcnt lgkmcnt(0)" ::: "memory");
        bf16_t* Ow = Y + (size_t)(b * SEQ + t0 + wid * QBLK) * 2048 + 1024 + h * 128;
#pragma unroll
        for (int i = 0; i < 8; ++i) { const int row = i * 4 + (lane >> 4), ch = lane & 15; const u32x4 v = *(const u32x4*)(stg + row * 128 + ch * 8); *(u32x4*)(Ow + (size_t)row * 2048 + ch * 8) = v; }
    }
    __syncthreads();
#undef TROW
#undef SLOAD
#undef SWRITE
#undef SWAIT
#undef RESC
#undef WMASK
}
#undef KSWZ
#undef SBAR
}

DEVI void phase_ffnconv(const Args& a, int b, int tid) {
    unsigned char* ws = a.ws;
    const bf16_t* U = (const bf16_t*)(ws + WS_U); bf16_t* ACT = (bf16_t*)(ws + WS_ACT) + (size_t)b * SEQ * DFF;
    const float* cw = a.in[20]; const float* cb = a.in[21];
    const long total = (long)SEQ * (DFF / 8);
    for (long i = (long)blockIdx.x * 512 + tid; i < total; i += (long)gridDim.x * 512) {
        const int row = (int)(i / (DFF / 8)), f0 = (int)(i % (DFF / 8)) * 8;
        const int pn = f0 >> 7, j = f0 & 127, gc = 256 * pn + j, vc = gc + 128;
        float ug[8], uv[8];
#pragma unroll
        for (int q = 0; q < 8; ++q) { ug[q] = cb[f0 + q]; uv[q] = cb[DFF + f0 + q]; }
#pragma unroll
        for (int jt = 0; jt < 3; ++jt) {
            const int rr = row + jt - 1;
            if (rr >= 0 && rr < SEQ) {
                const u32x4 g = *(const u32x4*)(U + (size_t)rr * NUP + gc), v = *(const u32x4*)(U + (size_t)rr * NUP + vc);
                const f32x4 wg0 = *(const f32x4*)(cw + jt * NUP + f0), wg1 = *(const f32x4*)(cw + jt * NUP + f0 + 4);
                const f32x4 wv0 = *(const f32x4*)(cw + jt * NUP + DFF + f0), wv1 = *(const f32x4*)(cw + jt * NUP + DFF + f0 + 4);
#pragma unroll
                for (int q = 0; q < 4; ++q) {
                    const float wgl = q < 2 ? wg0[2 * q] : wg1[2 * q - 4], wgh = q < 2 ? wg0[2 * q + 1] : wg1[2 * q - 3];
                    const float wvl = q < 2 ? wv0[2 * q] : wv1[2 * q - 4], wvh = q < 2 ? wv0[2 * q + 1] : wv1[2 * q - 3];
                    ug[2 * q] += bflo(g[q]) * wgl; ug[2 * q + 1] += bfhi(g[q]) * wgh;
                    uv[2 * q] += bflo(v[q]) * wvl; uv[2 * q + 1] += bfhi(v[q]) * wvh;
                }
            }
        }
        u32x4 o;
        o.x = pk2(siluf(ug[0]) * uv[0], siluf(ug[1]) * uv[1]); o.y = pk2(siluf(ug[2]) * uv[2], siluf(ug[3]) * uv[3]);
        o.z = pk2(siluf(ug[4]) * uv[4], siluf(ug[5]) * uv[5]); o.w = pk2(siluf(ug[6]) * uv[6], siluf(ug[7]) * uv[7]);
        *(u32x4*)(ACT + (size_t)row * DFF + f0) = o;
    }
}


#define XB_TMO      128
#define XB_XCNT(j)  (256  + 64 * (j))
#define XB_XSUB(j)  (1280 + 64 * (j))
#define XB_XGEN(j)  (2304 + 64 * (j))
#define XB_TOP      3328
#define XB_TOPGEN   3392
#define XCD_BAR_WORDS 3456
#define XB_SPIN_CAP (1u << 18)
__device__ __forceinline__ unsigned xb_ld(unsigned* p)              { return __hip_atomic_load(p, __ATOMIC_RELAXED, __HIP_MEMORY_SCOPE_AGENT); }
__device__ __forceinline__ unsigned xb_add(unsigned* p, unsigned v) { return __hip_atomic_fetch_add(p, v, __ATOMIC_RELAXED, __HIP_MEMORY_SCOPE_AGENT); }
__device__ __forceinline__ unsigned xb_xcc_id() { return (unsigned)__builtin_amdgcn_s_getreg((3 << 11) | 20) & 0xFu; }
#define XB_SPIN(cond, bar) do { unsigned _sp = 0; while (cond) { __builtin_amdgcn_s_sleep(1); \
    if ((++_sp & 255u) == 0u) { if (xb_ld(&(bar)[XB_TMO])) break; if (_sp > XB_SPIN_CAP) { atomicAdd(&(bar)[XB_TMO], 1u); break; } } } } while (0)
struct XcdBarrier { unsigned* bar; unsigned x; volatile LAS unsigned* st; };
__device__ __forceinline__ XcdBarrier xcd_barrier_post(unsigned* bar, volatile LAS unsigned* st) {
    XcdBarrier b; b.bar = bar; b.x = xb_xcc_id(); b.st = st;
    if (threadIdx.x == 0) (void)xb_add(&bar[XB_XCNT(b.x)], 1u);
    return b;
}
__device__ __forceinline__ void xcd_barrier_complete(unsigned* bar, unsigned x, unsigned& nloc, unsigned& nx) {
    const unsigned G = gridDim.x * gridDim.y * gridDim.z;
    unsigned sum, cnt, mine, sp = 0u;
    for (;;) {
        sum = 0u; cnt = 0u; mine = 0u;
#pragma unroll
        for (unsigned j = 0; j < 16; ++j) { const unsigned c = xb_ld(&bar[XB_XCNT(j)]); sum += c; cnt += (c > 0u) ? 1u : 0u; mine = (j == x) ? c : mine; }
        if (sum == G) break;
        __builtin_amdgcn_s_sleep(1);
        if ((++sp & 255u) == 0u) { if (xb_ld(&bar[XB_TMO])) break; if (sp > XB_SPIN_CAP) { atomicAdd(&bar[XB_TMO], 1u); break; } }
    }
    nloc = mine > 0u ? mine : 1u; nx = cnt > 0u ? cnt : 1u;
}
__device__ __forceinline__ void xcd_barrier(const XcdBarrier& b) {
    asm volatile("s_waitcnt vmcnt(0)" ::: "memory");
    __syncthreads();
    if (threadIdx.x == 0) {
        unsigned* bar = b.bar;
        __builtin_amdgcn_s_waitcnt(0);
        unsigned nloc = b.st[0], nx = b.st[1];
        if (nloc == 0u) { xcd_barrier_complete(bar, b.x, nloc, nx); b.st[0] = nloc; b.st[1] = nx; }
        const unsigned old = xb_add(&bar[XB_XSUB(b.x)], 1u);
        const unsigned gen = old / nloc;
        if (old + 1u == (gen + 1u) * nloc) {
            __builtin_amdgcn_fence(__ATOMIC_RELEASE, "agent");
            asm volatile("s_waitcnt vmcnt(0)" ::: "memory");
            const unsigned og = xb_add(&bar[XB_TOP], 1u);
            const unsigned tg = og / nx;
            if (og + 1u == (tg + 1u) * nx) xb_add(&bar[XB_TOPGEN], 1u);
            else XB_SPIN(xb_ld(&bar[XB_TOPGEN]) == tg, bar);
            __builtin_amdgcn_fence(__ATOMIC_ACQUIRE, "agent");
            xb_add(&bar[XB_XGEN(b.x)], 1u);
            asm volatile("s_waitcnt vmcnt(0)" ::: "memory");
        } else {
            XB_SPIN(xb_ld(&bar[XB_XGEN(b.x)]) == gen, bar);
            __builtin_amdgcn_fence(__ATOMIC_ACQUIRE, "agent");
            asm volatile("s_waitcnt vmcnt(0)" ::: "memory");
        }
    }
    __syncthreads();
}

constexpr int NPHASE = 16;
__global__ void __launch_bounds__(512, 2) mega(Args a) {
    extern __shared__ __attribute__((aligned(16))) unsigned char lds_raw[];
    LAS unsigned char* lds = (LAS unsigned char*)lds_raw;
    const int tid = threadIdx.x, lane = tid & 63, wave = __builtin_amdgcn_readfirstlane(tid >> 6);
    unsigned char* ws = a.ws;
    const int lo = a.ph_lo, hi = a.ph_hi;
#define IN(k) (lo <= (k) && (k) < hi)
#if MK_ONE_LAUNCH
    volatile LAS unsigned* bst = (volatile LAS unsigned*)(lds + 147440);
    if (tid < 4) bst[tid] = 0u;
    __syncthreads();
    const XcdBarrier gbar = xcd_barrier_post((unsigned*)(ws + WS_CTL), bst);
#define SEAM(k) do { if (IN(k) && IN((k) + 1)) xcd_barrier(gbar); } while (0)
#else
#define SEAM(k) do { } while (0)
#endif
    const float* modacc = (const float*)(ws + CTL_MODACC);
    if (IN(0)) { phase0(a, lds, tid, lane, wave); } SEAM(0);
    if (IN(1)) { phase1(a, tid, lane, wave); } SEAM(1);
    if (IN(2)) {
        pg8::Gemm g{(const bf16_t*)(ws + WS_XN), (const bf16_t*)(ws + WS_WINA), MT, NA, 1024}; pg8::StaticOrder S; S.init(MT, NA, gridDim.x, blockIdx.x);
        EpiIn E{(const float*)(ws + SM_ROWSS1), (const float*)(ws + SM_SHWA), 0, (bf16_t*)(ws + WS_QKVR), nullptr, nullptr, nullptr, nullptr, (float*)(ws + WS_BA)};
        pg8::gemm_phase<EpiIn, pg8::StaticOrder, true, true>(lds, g, S, E);
    } SEAM(2);
    if (IN(3)) { phase_dnprep(a, tid); } SEAM(3);
    if (IN(4)) { phase_dnchunk(a, lds, tid, lane, wave); } SEAM(4);
    if (IN(5)) { phase_dnscan2(a, lds, tid, lane, wave); } SEAM(5);
    if (IN(6)) {
        pg8::Gemm g{(const bf16_t*)(ws + WS_XN), (const bf16_t*)(ws + WS_WINC), MT, NC, 1024}; pg8::StaticOrder S; S.init(MT, NC, gridDim.x, blockIdx.x);
        EpiIn E{(const float*)(ws + SM_ROWSS1), (const float*)(ws + SM_SHWA) + NA, 1, (bf16_t*)(ws + WS_GT), (bf16_t*)(ws + WS_QAT), (bf16_t*)(ws + WS_KAT), (bf16_t*)(ws + WS_VAT), (bf16_t*)(ws + WS_MG), nullptr};
        pg8::gemm_phase<EpiIn, pg8::StaticOrder, true, true>(lds, g, S, E);
    } SEAM(6);
    if (IN(7)) { phase_prep2(a, lane, wave); } SEAM(7);
    if (IN(8)) {
#pragma unroll 1
        for (int k = 0; k < 1024; ++k) {
            const int idx = 4 * ((int)blockIdx.x + (int)gridDim.x * (k >> 2)) + (k & 3); if (idx >= 1024) break;
            const int g = idx & 3, qb = (idx >> 2) & 63, kvh = (idx >> 8) & 1, b = idx >> 9;
            att::attn_unit(a, b, kvh * 4 + g, qb, (char*)lds_raw); }
    } SEAM(8);
    if (IN(9)) {
        pg8::Gemm g{(const bf16_t*)(ws + WS_Y), (const bf16_t*)(ws + WS_WBR), ML, 1024, 2048}; pg8::StaticOrder S; S.init(ML, 1024, gridDim.x, blockIdx.x);
        EpiBr E{(const bf16_t*)(ws + WS_MG), (bf16_t*)(ws + WS_MERGED)};
        pg8::gemm_phase<EpiBr, pg8::StaticOrder, true, true>(lds, g, S, E);
    } SEAM(9);
    if (IN(10)) {
        pg8::Gemm g{(const bf16_t*)(ws + WS_MERGED), (const bf16_t*)(ws + WS_WOUT), ML, 1024, 1024}; pg8::StaticOrder S; S.init(ML, 1024, gridDim.x, blockIdx.x);
        EpiOut E{a.in[0], modacc, a.in[5], a.in[7], a.out, (bf16_t*)(ws + WS_X1S), (float*)(ws + CTL_ROWSS2)};
        pg8::gemm_phase<EpiOut, pg8::StaticOrder, true, true>(lds, g, S, E);
    } SEAM(10);
#define FFN_UP(PH, BB) if (IN(PH)) { \
        pg8::Gemm g{(const bf16_t*)(ws + WS_X1S) + (size_t)(BB) * SEQ * 1024, (const bf16_t*)(ws + WS_WUP), SEQ, NUP, 1024}; pg8::StaticOrder S; S.init(SEQ, NUP, gridDim.x, blockIdx.x); \
        EpiUp E{(const float*)(ws + CTL_ROWSS2) + (BB) * SEQ, (const float*)(ws + SM_SHWF) + (BB) * NUP, (bf16_t*)(ws + WS_U)}; \
        pg8::gemm_phase<EpiUp, pg8::StaticOrder, true, true>(lds, g, S, E); }
    FFN_UP(11, 0) SEAM(11);
    if (IN(12)) { phase_ffnconv(a, 0, tid); } SEAM(12);
    FFN_UP(13, 1) SEAM(13);
    if (IN(14)) { phase_ffnconv(a, 1, tid); } SEAM(14);
#undef FFN_UP
    if (IN(15)) {
        pg8::Gemm g{(const bf16_t*)(ws + WS_ACT), (const bf16_t*)(ws + WS_WDN), ML, 1024, DFF}; pg8::StaticOrder S; S.init(ML, 1024, gridDim.x, blockIdx.x);
        EpiDown E{modacc, a.in[5], a.out};
        pg8::gemm_phase<EpiDown, pg8::StaticOrder, true, true>(lds, g, S, E);
    }
#undef IN
#undef SEAM
}

extern "C" void kernel_launch(void* const* d_in, const int* in_sizes, int n_in, void* d_out, int out_size, void* d_ws, size_t ws_size, hipStream_t stream) {
    static int grid = 0;
    if (grid == 0) {
        if (n_in != 23 || in_sizes[0] != ML * DM || out_size != ML * DM || ws_size < WS_END) {
            fprintf(stderr, "kernel_launch: unexpected shapes n_in %d in0 %d out %d ws %zu (need %zu)\n", n_in, n_in > 0 ? in_sizes[0] : -1, out_size, ws_size, (size_t)WS_END); grid = -1; return; }
        int dev = 0, cus = 0, per_cu = 0;
        hipGetDevice(&dev); hipDeviceGetAttribute(&cus, hipDeviceAttributeMultiprocessorCount, dev);
        if (hipFuncSetAttribute((const void*)mega, hipFuncAttributeMaxDynamicSharedMemorySize, LDS_BYTES) != hipSuccess) { fprintf(stderr, "kernel_launch: hipFuncSetAttribute failed\n"); grid = -1; return; }
        hipOccupancyMaxActiveBlocksPerMultiprocessor(&per_cu, (const void*)mega, 512, LDS_BYTES);
        (void)hipGetLastError();
        if (per_cu < 1) { fprintf(stderr, "kernel_launch: occupancy query says %d blocks per CU\n", per_cu); per_cu = 1; }
        grid = cus;
    }
    if (grid < 0) return;
    hipMemsetAsync((char*)d_ws + WS_CTL, 0, CTL_ZERO_BYTES, stream);
    Args a{};
    for (int i = 0; i < 23; ++i) a.in[i] = (const float*)d_in[i];
    a.out = (float*)d_out; a.ws = (unsigned char*)d_ws;
#if MK_ONE_LAUNCH
    a.ph_lo = 0; a.ph_hi = NPHASE;
    void* args[] = {&a};
    hipError_t e = hipLaunchCooperativeKernel((const void*)mega, dim3(grid), dim3(512), args, LDS_BYTES, stream);
    if (e != hipSuccess) fprintf(stderr, "cooperative launch failed: %s (grid %d)\n", hipGetErrorString(e), grid);
#else
    for (int p = 0; p < NPHASE; ++p) {
        a.ph_lo = p; a.ph_hi = p + 1;
        hipLaunchKernelGGL(mega, dim3(grid), dim3(512), LDS_BYTES, stream, a);
    }
    hipError_t e = hipPeekAtLastError();
    if (e != hipSuccess) fprintf(stderr, "launch failed: %s\n", hipGetErrorString(e));
#endif
}
```

```cpp
#include <hip/hip_runtime.h>
#include <hip/hip_cooperative_groups.h>
#include <cstdio>
#include <cstdint>
namespace cg = cooperative_groups;

#ifndef PROBE_MASK
#define PROBE_MASK 0u
#endif
#ifndef PROBE_SUB
#define PROBE_SUB 0
#endif
#ifndef MK_ONE_LAUNCH
#define MK_ONE_LAUNCH 1
#endif

#define DEVI __device__ __forceinline__
#define LAS __attribute__((address_space(3)))
typedef unsigned short bf16_t;
typedef short bf16x8 __attribute__((ext_vector_type(8)));
typedef float f32x4 __attribute__((ext_vector_type(4)));
typedef float f32x2 __attribute__((ext_vector_type(2)));
typedef float f32x16 __attribute__((ext_vector_type(16)));
typedef unsigned u32x4 __attribute__((ext_vector_type(4)));
typedef unsigned u32x2 __attribute__((ext_vector_type(2)));
typedef short s16x4 __attribute__((ext_vector_type(4)));

constexpr int BATCH = 2, SEQ = 16384, DM = 1024, CTX = 256;
constexpr int ML = BATCH * SEQ;
constexpr int MC = BATCH * CTX;
constexpr int MT = ML + MC;
constexpr int NA = 3328;
constexpr int NC = 4608;
constexpr int NSH = NA + NC;
constexpr int DFF = 2816, NUP = 5632;
constexpr float EPS = 1e-6f;

constexpr size_t MiB = 1u << 20;
constexpr size_t WS_CTL = 0, CTL_ZERO_BYTES = 1 * MiB;
constexpr size_t CTL_MODACC = 64 * 1024;
constexpr size_t CTL_ROWSS2 = 256 * 1024;
constexpr size_t WS_SMALL = 1 * MiB;
constexpr size_t SM_ROWSS1 = WS_SMALL;
constexpr size_t SM_SHWA = WS_SMALL + 256 * 1024;
constexpr size_t SM_SHWF = WS_SMALL + 384 * 1024;
constexpr size_t SM_ROPE = WS_SMALL + 512 * 1024;
constexpr size_t WS_BA = 2 * MiB;
constexpr size_t WS_G = 7 * MiB;
constexpr size_t WS_BETA = 10 * MiB;
constexpr size_t WS_WINA = 13 * MiB, WS_WINC = 20 * MiB, WS_WBR = 29 * MiB, WS_WOUT = 33 * MiB, WS_WUP = 35 * MiB, WS_WDN = 46 * MiB;
constexpr size_t WS_XN = 52 * MiB;
constexpr size_t WS_QKVR = 117 * MiB;
constexpr size_t WS_QKVP = 312 * MiB;
constexpr size_t WS_MG = 180 * MiB;
constexpr size_t WS_GT = 310 * MiB;
constexpr size_t WS_QAT = 375 * MiB;
constexpr size_t WS_KAT = 440 * MiB;
constexpr size_t WS_VAT = 457 * MiB;
constexpr size_t WS_Y = 52 * MiB;
constexpr size_t WS_MERGED = 375 * MiB;
constexpr size_t WS_X1S = 440 * MiB;
constexpr size_t WS_U = 52 * MiB;
constexpr size_t WS_ACT = 228 * MiB;
constexpr size_t WS_TQ = 117 * MiB;
constexpr size_t WS_AVEC = 248 * MiB;
constexpr size_t WS_END = 512 * MiB;

constexpr int LDS_BYTES = 147456;

DEVI float bf2f(unsigned short h) { return __uint_as_float((unsigned)h << 16); }
DEVI float bflo(unsigned w) { return __uint_as_float(w << 16); }
DEVI float bfhi(unsigned w) { return __uint_as_float(w & 0xffff0000u); }
typedef __bf16 bf16x2_t __attribute__((ext_vector_type(2)));
DEVI unsigned pk2(float lo, float hi) { const f32x2 v = {lo, hi}; const bf16x2_t b = __builtin_convertvector(v, bf16x2_t); return __builtin_bit_cast(unsigned, b); }
DEVI unsigned f2bf(float f) { return pk2(f, 0.f) & 0xffffu; }
DEVI float wave_sum(float v) {
#pragma unroll
    for (int o = 1; o < 64; o <<= 1) v += __shfl_xor(v, o);
    return v;
}
DEVI float siluf(float x) { return x / (1.f + __expf(-x)); }
DEVI float sigmoidf_(float x) { return 1.f / (1.f + __expf(-x)); }

struct Args { const float* in[23]; float* out; unsigned char* ws; int ph_lo, ph_hi; };

namespace pg8 {
constexpr int BM = 256, BK = 64, HALF = 128, HTB = HALF * BK * 2, STAGE_BYTES = 8 * HTB, NXCD = 8, WGM = 8;
__host__ __device__ __forceinline__ int lds_byte(int r, int c) { const int st = (r >> 4) * 2 + (c >> 5), rr = r & 15, cc = c & 31, ob = rr * 64 + cc * 2; return st * 1024 + (ob ^ (((ob >> 9) & 1) << 5)); }
__host__ __device__ __forceinline__ void stage_rc(int b, int& R, int& C) { const int st = b / 1024, sb = b % 1024, swz = sb ^ (((sb >> 9) & 1) << 5); R = (st >> 1) * 16 + swz / 64; C = (st & 1) * 32 + (swz % 64) / 2; }
__host__ __device__ __forceinline__ int perm32(int rho) { const int n = rho >> 4, i = rho & 15; return 8 * (i >> 2) + 4 * n + (i & 3); }
struct Unit { int pm, pn; };
struct Gemm { const bf16_t* A; const bf16_t* Bt; int M, N, K; };
struct StaticOrder {
    int nM, nN, nwg, G, c;
    __device__ void init(int M, int N, int G_, int c_) { nM = M / BM; nN = N / BM; nwg = nM * nN; G = G_; c = c_; }
    __device__ bool next(int i, Unit& u) const {
        const long L = (long)i * G + c; if (L >= nwg) return false;
        int wgid = (int)L; { const int q = nwg / NXCD, r = nwg % NXCD, xcd = wgid % NXCD, off = wgid / NXCD; wgid = (xcd < r ? xcd * (q + 1) : r * (q + 1) + (xcd - r) * q) + off; }
        const int nig = WGM * nN, gid = wgid / nig, fm = gid * WGM, gsz = (nM - fm) < WGM ? (nM - fm) : WGM;
        u.pm = fm + ((wgid % nig) % gsz); u.pn = (wgid % nig) / gsz; return true;
    }
};
template <class Epi, class Sched, bool ALIGN_EPI, bool SP2>
__device__ __forceinline__ void gemm_phase(LAS unsigned char* lds, const Gemm g, const Sched& S, const Epi& E) {
    const int tid = threadIdx.x, wid = __builtin_amdgcn_readfirstlane(tid >> 6), lane = tid & 63, wr = wid >> 2, wc = wid & 3, fr = lane & 15, fq = lane >> 4;
    const int K = g.K, nt = K / BK;
    unsigned voffA[2], voffB[2];
#pragma unroll
    for (int i = 0; i < 2; ++i) { int R, C; stage_rc(tid * 16 + i * 8192, R, C); const int Rb = Epi::PERM ? ((R & ~31) + perm32(R & 31)) : R;
        voffA[i] = (unsigned)(R * K + C) * 2u; voffB[i] = (unsigned)(Rb * K + C) * 2u; }
    const size_t kstep = (size_t)(BK * 2);
    const size_t hstep = (size_t)HALF * K * 2;
    const size_t tstep = 2 * hstep;
    const unsigned ldsw = (unsigned)wid * 1024u;
    const int aoff = lds_byte(wr * 64 + fr, fq * 8), boff = lds_byte(wc * 32 + fr, fq * 8);
#define PG8_SA(b, h) (((b) * 2 + (h)) * HTB)
#define PG8_SB(b, h) ((4 + (b) * 2 + (h)) * HTB)
#define PG8_STAGE(bufoff, gbase, voff) do { _Pragma("unroll") for (int _i = 0; _i < 2; ++_i) \
        __builtin_amdgcn_global_load_lds((const unsigned*)((const char*)(gbase) + (voff)[_i]), (LAS unsigned*)(lds + (bufoff) + ldsw + _i * 8192), 16, 0, 0); } while (0)
#define PG8_LDA(dst, b, h) do { _Pragma("unroll") for (int m = 0; m < 4; ++m) _Pragma("unroll") for (int k = 0; k < 2; ++k) dst[m][k] = *(const LAS bf16x8*)(lds + PG8_SA(b, h) + aoff + m * 2048 + k * 1024); } while (0)
#define PG8_LDB(dst, b, h) do { _Pragma("unroll") for (int n = 0; n < 2; ++n) _Pragma("unroll") for (int k = 0; k < 2; ++k) dst[n][k] = *(const LAS bf16x8*)(lds + PG8_SB(b, h) + boff + n * 2048 + k * 1024); } while (0)
#define PG8_MMA(ai, bj, At, Bt) do { __builtin_amdgcn_s_setprio(1); _Pragma("unroll") for (int m = 0; m < 4; ++m) _Pragma("unroll") for (int n = 0; n < 2; ++n) _Pragma("unroll") for (int k = 0; k < 2; ++k) \
        acc[ai][bj][m][n] = __builtin_amdgcn_mfma_f32_16x16x32_bf16(Bt[n][k], At[m][k], acc[ai][bj][m][n], 0, 0, 0); __builtin_amdgcn_s_setprio(0); } while (0)
#define PG8_WAIT_V(n) asm volatile("s_waitcnt vmcnt(" #n ")" ::: "memory")
#define PG8_WAIT_L(n) asm volatile("s_waitcnt lgkmcnt(" #n ")" ::: "memory")
#define PG8_BAR __builtin_amdgcn_s_barrier()
#define PG8_SCHED __builtin_amdgcn_sched_barrier(0)
    Unit cur, nxt; int ui = 0;
    if (!S.next(0, cur)) return;
    f32x4 acc[2][2][4][2];
#pragma unroll
    for (int a = 0; a < 2; ++a)
#pragma unroll
        for (int b = 0; b < 2; ++b)
#pragma unroll
            for (int m = 0; m < 4; ++m)
#pragma unroll
                for (int n = 0; n < 2; ++n) acc[a][b][m][n] = (f32x4){0.f, 0.f, 0.f, 0.f};
    bf16x8 At[4][2], B0[2][2], B1[2][2];
    const char* cA = (const char*)g.A + (size_t)cur.pm * tstep; const char* cB = (const char*)g.Bt + (size_t)cur.pn * tstep;
    if constexpr (SP2) {
        PG8_STAGE(PG8_SB(0, 0), cB, voffB); PG8_STAGE(PG8_SB(0, 1), cB + hstep, voffB); PG8_STAGE(PG8_SA(0, 0), cA, voffA); PG8_STAGE(PG8_SA(0, 1), cA + hstep, voffA);
        if (wr == 1) PG8_BAR;
        PG8_WAIT_V(2); PG8_BAR;
        PG8_STAGE(PG8_SB(1, 0), cB + kstep, voffB); PG8_STAGE(PG8_SA(1, 0), cA + kstep, voffA); PG8_STAGE(PG8_SB(1, 1), cB + hstep + kstep, voffB);
        PG8_WAIT_V(6); PG8_BAR;
    } else {
        PG8_STAGE(PG8_SB(0, 0), cB, voffB); PG8_STAGE(PG8_SA(0, 0), cA, voffA); PG8_STAGE(PG8_SB(0, 1), cB + hstep, voffB); PG8_STAGE(PG8_SA(0, 1), cA + hstep, voffA);
        if (wr == 1) PG8_BAR;
        PG8_WAIT_V(4); PG8_BAR;
        PG8_STAGE(PG8_SB(1, 0), cB + kstep, voffB); PG8_STAGE(PG8_SA(1, 0), cA + kstep, voffA); PG8_STAGE(PG8_SB(1, 1), cB + hstep + kstep, voffB);
        PG8_WAIT_V(6); PG8_BAR;
    }
    for (;;) {
        const bool has_next = S.next(ui + 1, nxt);
        const char* nA = has_next ? (const char*)g.A + (size_t)nxt.pm * tstep : cA; const char* nB = has_next ? (const char*)g.Bt + (size_t)nxt.pn * tstep : cB;
#pragma unroll 1
        for (int t = 0; t < nt; t += 2) {
            const bool last = (t == nt - 2);
            if constexpr (Epi::MID) { if (t == nt / 2) E.mid(acc, cur, wr, wc, fr, fq); }
            const char* a1 = cA + (size_t)(t + 1) * kstep;
            const char* a2 = last ? nA : cA + (size_t)(t + 2) * kstep; const char* b2 = last ? nB : cB + (size_t)(t + 2) * kstep;
            const char* a3 = a2 + kstep; const char* b3 = b2 + kstep;
            if constexpr (SP2) {
            PG8_LDB(B0, 0, 0); PG8_LDB(B1, 0, 1); PG8_SCHED; PG8_LDA(At, 0, 0); PG8_STAGE(PG8_SA(1, 1), a1 + hstep, voffA);
            PG8_WAIT_V(8); PG8_WAIT_L(0); PG8_BAR; PG8_MMA(0, 0, At, B0); PG8_MMA(0, 1, At, B1); PG8_BAR; PG8_SCHED;
            PG8_LDA(At, 0, 1); PG8_STAGE(PG8_SB(0, 0), b2, voffB); PG8_STAGE(PG8_SB(0, 1), b2 + hstep, voffB); PG8_STAGE(PG8_SA(0, 0), a2, voffA);
            PG8_WAIT_V(8); PG8_WAIT_L(0); PG8_BAR; PG8_MMA(1, 0, At, B0); PG8_MMA(1, 1, At, B1); PG8_BAR; PG8_SCHED;
            PG8_LDB(B0, 1, 0); PG8_LDB(B1, 1, 1); PG8_SCHED; PG8_LDA(At, 1, 0); PG8_STAGE(PG8_SA(0, 1), a2 + hstep, voffA);
            PG8_WAIT_V(8); PG8_WAIT_L(0); PG8_BAR; PG8_MMA(0, 0, At, B0); PG8_MMA(0, 1, At, B1); PG8_BAR; PG8_SCHED;
            PG8_LDA(At, 1, 1); PG8_STAGE(PG8_SB(1, 0), b3, voffB); PG8_STAGE(PG8_SB(1, 1), b3 + hstep, voffB); PG8_STAGE(PG8_SA(1, 0), a3, voffA);
            PG8_WAIT_V(8); PG8_WAIT_L(0); PG8_BAR; PG8_MMA(1, 0, At, B0); PG8_MMA(1, 1, At, B1); PG8_BAR; PG8_SCHED;
            } else {
            PG8_LDB(B0, 0, 0); PG8_SCHED; PG8_LDA(At, 0, 0); PG8_STAGE(PG8_SA(1, 1), a1 + hstep, voffA);
            PG8_WAIT_L(8); PG8_BAR; PG8_WAIT_L(0); PG8_MMA(0, 0, At, B0); PG8_BAR; PG8_SCHED;
            PG8_LDB(B1, 0, 1); PG8_STAGE(PG8_SB(0, 0), b2, voffB);
            PG8_BAR; PG8_WAIT_L(0); PG8_MMA(0, 1, At, B1); PG8_BAR;
            PG8_LDA(At, 0, 1); PG8_STAGE(PG8_SA(0, 0), a2, voffA);
            PG8_BAR; PG8_WAIT_L(0); PG8_MMA(1, 0, At, B0); PG8_BAR; PG8_SCHED;
            PG8_STAGE(PG8_SB(0, 1), b2 + hstep, voffB);
            PG8_WAIT_V(6); PG8_BAR; PG8_MMA(1, 1, At, B1); PG8_BAR;
            PG8_LDB(B0, 1, 0); PG8_SCHED; PG8_LDA(At, 1, 0); PG8_STAGE(PG8_SA(0, 1), a2 + hstep, voffA);
            PG8_WAIT_L(8); PG8_BAR; PG8_WAIT_L(0); PG8_MMA(0, 0, At, B0); PG8_BAR; PG8_SCHED;
            PG8_LDB(B1, 1, 1); PG8_STAGE(PG8_SB(1, 0), b3, voffB);
            PG8_BAR; PG8_WAIT_L(0); PG8_MMA(0, 1, At, B1); PG8_BAR;
            PG8_LDA(At, 1, 1); PG8_STAGE(PG8_SA(1, 0), a3, voffA);
            PG8_BAR; PG8_WAIT_L(0); PG8_MMA(1, 0, At, B0); PG8_BAR; PG8_SCHED;
            PG8_STAGE(PG8_SB(1, 1), b3 + hstep, voffB);
            PG8_WAIT_V(6); PG8_BAR; PG8_MMA(1, 1, At, B1); PG8_BAR;
            }
        }
        if constexpr (ALIGN_EPI) { if (wr == 0) PG8_BAR; }
        E(acc, cur, wr, wc, fr, fq);
        if (!has_next) break;
#pragma unroll
        for (int a = 0; a < 2; ++a)
#pragma unroll
            for (int b = 0; b < 2; ++b)
#pragma unroll
                for (int m = 0; m < 4; ++m)
#pragma unroll
                    for (int n = 0; n < 2; ++n) acc[a][b][m][n] = (f32x4){0.f, 0.f, 0.f, 0.f};
        cur = nxt; cA = nA; cB = nB; ++ui;
        if constexpr (ALIGN_EPI) { if (wr == 1) PG8_BAR; }
    }
    PG8_WAIT_V(0);
    if constexpr (!ALIGN_EPI) { if (wr == 0) PG8_BAR; }
    PG8_BAR;
#undef PG8_SA
#undef PG8_SB
#undef PG8_STAGE
#undef PG8_LDA
#undef PG8_LDB
#undef PG8_MMA
#undef PG8_WAIT_V
#undef PG8_WAIT_L
#undef PG8_BAR
#undef PG8_SCHED
}
}
using pg8::HALF;

DEVI u32x4 pack8(const f32x4& a, const f32x4& b) { u32x4 w; w.x = pk2(a[0], a[1]); w.y = pk2(a[2], a[3]); w.z = pk2(b[0], b[1]); w.w = pk2(b[2], b[3]); return w; }

struct EpiIn {
    static constexpr bool PERM = true, MID = false;
    const float* rowss; const float* shW; int job;
    bf16_t *d0, *d1, *d2, *d3, *d4; float* ba;
    DEVI void operator()(const f32x4 (&acc)[2][2][4][2], const pg8::Unit& u, int wr, int wc, int fr, int fq) const {
        asm volatile("" : "+v"(fr), "+v"(fq));
        const int vs = u.pm < 64 ? 0 : (u.pm < 128 ? 1 : 2);
        bf16_t* base; int pitch, colt; bool isba = false;
        if (job == 0) { base = d0; pitch = 3072; colt = u.pn * 256; if (u.pn >= 12) isba = true; }
        else {
            if (u.pn < 4) { base = d0; pitch = 1024; colt = u.pn * 256; }
            else if (u.pn < 8) { base = d1; pitch = 1024; colt = (u.pn - 4) * 256; }
            else if (u.pn == 8) { base = d2; pitch = 256; colt = 0; }
            else if (u.pn == 9) { base = d3; pitch = 256; colt = 0; }
            else { base = d4; pitch = 2048; colt = (u.pn - 10) * 256; }
        }
        const int ncol0 = u.pn * 256 + wc * 32 + 8 * fq;
        f32x4 sv[2][2];
#pragma unroll
        for (int bj = 0; bj < 2; ++bj)
#pragma unroll
            for (int n = 0; n < 2; ++n) sv[bj][n] = *(const f32x4*)(shW + vs * NSH + ncol0 + bj * HALF + 4 * n);
        const int row0 = u.pm * 256 + wr * 64 + fr;
#pragma unroll
        for (int ai = 0; ai < 2; ++ai)
#pragma unroll
            for (int m = 0; m < 4; ++m) {
                const int row = row0 + ai * HALF + m * 16;
                const float rs = rsqrtf(rowss[row] * (1.f / 1024.f) + EPS);
                if (!isba) {
                    bf16_t* rowp = base + (size_t)row * pitch + colt + wc * 32 + 8 * fq;
#pragma unroll
                    for (int bj = 0; bj < 2; ++bj) { const f32x4 v0 = acc[ai][bj][m][0] * rs + sv[bj][0], v1 = acc[ai][bj][m][1] * rs + sv[bj][1]; *(u32x4*)(rowp + bj * HALF) = pack8(v0, v1); }
                } else if (wc == 0) {
                    float* rowp = ba + (size_t)row * 32 + 8 * fq;
                    *(f32x4*)(rowp) = acc[ai][0][m][0] * rs + sv[0][0]; *(f32x4*)(rowp + 4) = acc[ai][0][m][1] * rs + sv[0][1];
                }
            }
    }
};
struct EpiBr {
    static constexpr bool PERM = true, MID = true;
    const bf16_t* mg; bf16_t* out;
    DEVI void mid(f32x4 (&acc)[2][2][4][2], const pg8::Unit& u, int wr, int wc, int fr, int fq) const {
        asm volatile("" : "+v"(fr), "+v"(fq));
        const int row0 = u.pm * 256 + wr * 64 + fr, col0 = u.pn * 256 + wc * 32 + 8 * fq;
#pragma unroll
        for (int ai = 0; ai < 2; ++ai)
#pragma unroll
            for (int m = 0; m < 4; ++m) {
                const bf16_t* rp = mg + (size_t)(row0 + ai * HALF + m * 16) * 2048 + col0;
#pragma unroll
                for (int bj = 0; bj < 2; ++bj) {
                    const u32x4 gd = *(const u32x4*)(rp + bj * HALF), ga = *(const u32x4*)(rp + 1024 + bj * HALF);
                    float r[8];
#pragma unroll
                    for (int i = 0; i < 4; ++i) {
                        const float d0 = bflo(gd[i]), d1 = bfhi(gd[i]), a0 = bflo(ga[i]), a1 = bfhi(ga[i]);
                        r[2 * i] = (1.f + __expf(fminf(-a0, 80.f))) * __builtin_amdgcn_rcpf(1.f + __expf(fminf(-d0, 80.f)));
                        r[2 * i + 1] = (1.f + __expf(fminf(-a1, 80.f))) * __builtin_amdgcn_rcpf(1.f + __expf(fminf(-d1, 80.f)));
                    }
                    acc[ai][bj][m][0] *= (f32x4){r[0], r[1], r[2], r[3]}; acc[ai][bj][m][1] *= (f32x4){r[4], r[5], r[6], r[7]};
                    asm volatile("" ::: "memory");
                }
            }
    }
    DEVI void operator()(const f32x4 (&acc)[2][2][4][2], const pg8::Unit& u, int wr, int wc, int fr, int fq) const {
        asm volatile("" : "+v"(fr), "+v"(fq));
        const int row0 = u.pm * 256 + wr * 64 + fr, col0 = u.pn * 256 + wc * 32 + 8 * fq;
#pragma unroll
        for (int ai = 0; ai < 2; ++ai)
#pragma unroll
            for (int m = 0; m < 4; ++m) {
                const size_t row = (size_t)(row0 + ai * HALF + m * 16);
                const bf16_t* rp = mg + row * 2048 + 1024 + col0;
#pragma unroll
                for (int bj = 0; bj < 2; ++bj) {
                    const u32x4 ga = *(const u32x4*)(rp + bj * HALF);
                    float s[8];
#pragma unroll
                    for (int i = 0; i < 4; ++i) { s[2 * i] = __builtin_amdgcn_rcpf(1.f + __expf(fminf(-bflo(ga[i]), 80.f))); s[2 * i + 1] = __builtin_amdgcn_rcpf(1.f + __expf(fminf(-bfhi(ga[i]), 80.f))); }
                    const f32x4 v0 = acc[ai][bj][m][0] * (f32x4){s[0], s[1], s[2], s[3]}, v1 = acc[ai][bj][m][1] * (f32x4){s[4], s[5], s[6], s[7]};
                    *(u32x4*)(out + row * 1024 + col0 + bj * HALF) = pack8(v0, v1);
                }
            }
    }
};
struct EpiOut {
    static constexpr bool PERM = false, MID = false;
    const float* x; const float* modacc; const float* bada; const float* nwf; float* out; bf16_t* x1s; float* rowss2;
    DEVI void operator()(const f32x4 (&acc)[2][2][4][2], const pg8::Unit& u, int wr, int wc, int fr, int fq) const {
        asm volatile("" : "+v"(fr), "+v"(fq));
        const int b = u.pm >> 6; const int row0 = u.pm * 256 + wr * 64 + fr, col0 = u.pn * 256 + wc * 32 + 4 * fq;
        f32x4 ga[2][2], sc[2][2];
#pragma unroll
        for (int bj = 0; bj < 2; ++bj)
#pragma unroll
            for (int n = 0; n < 2; ++n) { const int c = col0 + bj * HALF + n * 16;
                ga[bj][n] = *(const f32x4*)(modacc + b * 6144 + 2048 + c) + *(const f32x4*)(bada + 2048 + c);
                sc[bj][n] = (*(const f32x4*)(modacc + b * 6144 + 4096 + c) + *(const f32x4*)(bada + 4096 + c) + 1.f) * *(const f32x4*)(nwf + c); }
#pragma unroll
        for (int ai = 0; ai < 2; ++ai)
#pragma unroll
            for (int m = 0; m < 4; ++m) {
                const size_t off = (size_t)(row0 + ai * HALF + m * 16) * 1024 + col0; float ss = 0.f;
#pragma unroll
                for (int bj = 0; bj < 2; ++bj)
#pragma unroll
                    for (int n = 0; n < 2; ++n) {
                        const f32x4 xv = *(const f32x4*)(x + off + bj * HALF + n * 16);
                        const f32x4 o = xv + ga[bj][n] * acc[ai][bj][m][n];
                        *(f32x4*)(out + off + bj * HALF + n * 16) = o;
                        ss += (o[0] * o[0] + o[1] * o[1]) + (o[2] * o[2] + o[3] * o[3]);
                        const f32x4 s = o * sc[bj][n]; u32x2 w; w.x = pk2(s[0], s[1]); w.y = pk2(s[2], s[3]);
                        *(u32x2*)(x1s + off + bj * HALF + n * 16) = w;
                    }
                ss += __shfl_xor(ss, 16); ss += __shfl_xor(ss, 32);
                if (fq == 0) atomicAdd(rowss2 + row0 + ai * HALF + m * 16, ss);
            }
    }
};
struct EpiUp {
    static constexpr bool PERM = true, MID = false;
    const float* rowss2; const float* shWf; bf16_t* u_;
    DEVI void operator()(const f32x4 (&acc)[2][2][4][2], const pg8::Unit& u, int wr, int wc, int fr, int fq) const {
        asm volatile("" : "+v"(fr), "+v"(fq));
        const int row0 = u.pm * 256 + wr * 64 + fr, col0 = u.pn * 256 + wc * 32 + 8 * fq;
#pragma unroll
        for (int bj = 0; bj < 2; ++bj) {
            const f32x4 sv0 = *(const f32x4*)(shWf + col0 + bj * HALF), sv1 = *(const f32x4*)(shWf + col0 + bj * HALF + 4);
#pragma unroll
            for (int ai = 0; ai < 2; ++ai)
#pragma unroll
                for (int m = 0; m < 4; ++m) {
                    const int row = row0 + ai * HALF + m * 16;
                    const float rs = rsqrtf(rowss2[row] * (1.f / 1024.f) + EPS);
                    const f32x4 v0 = acc[ai][bj][m][0] * rs + sv0, v1 = acc[ai][bj][m][1] * rs + sv1;
                    *(u32x4*)(u_ + (size_t)row * NUP + col0 + bj * HALF) = pack8(v0, v1);
                }
        }
    }
};
struct EpiDown {
    static constexpr bool PERM = false, MID = false;
    const float* modacc; const float* bada; float* out;
    DEVI void operator()(const f32x4 (&acc)[2][2][4][2], const pg8::Unit& u, int wr, int wc, int fr, int fq) const {
        asm volatile("" : "+v"(fr), "+v"(fq));
        const int b = u.pm >> 6; const int row0 = u.pm * 256 + wr * 64 + fr, col0 = u.pn * 256 + wc * 32 + 4 * fq;
        f32x4 gf[2][2];
#pragma unroll
        for (int bj = 0; bj < 2; ++bj)
#pragma unroll
            for (int n = 0; n < 2; ++n) { const int c = col0 + bj * HALF + n * 16; gf[bj][n] = *(const f32x4*)(modacc + b * 6144 + 5120 + c) + *(const f32x4*)(bada + 5120 + c); }
#pragma unroll
        for (int ai = 0; ai < 2; ++ai)
#pragma unroll
            for (int m = 0; m < 4; ++m) {
                const size_t off = (size_t)(row0 + ai * HALF + m * 16) * 1024 + col0;
#pragma unroll
                for (int bj = 0; bj < 2; ++bj)
#pragma unroll
                    for (int n = 0; n < 2; ++n) { float* p = out + off + bj * HALF + n * 16; *(f32x4*)p = *(const f32x4*)p + gf[bj][n] * acc[ai][bj][m][n]; }
            }
    }
};

DEVI void transpose_item(const float* W, int srcN, int k0, int n0, bf16_t* dst  , int dstK, LAS float* scr, int lane) {
#pragma unroll 8
    for (int i = 0; i < 32; ++i) { const int kk = 2 * i + (lane >> 5); scr[kk * 33 + (lane & 31)] = W[(size_t)(k0 + kk) * srcN + n0 + (lane & 31)]; }
    asm volatile("s_waitcnt lgkmcnt(0)" ::: "memory");
    const int c = lane & 7;
#pragma unroll
    for (int j = 0; j < 4; ++j) { const int n = (lane >> 3) + 8 * j; const LAS float* s = scr + (8 * c) * 33 + n;
        u32x4 o; o.x = pk2(s[0 * 33], s[1 * 33]); o.y = pk2(s[2 * 33], s[3 * 33]); o.z = pk2(s[4 * 33], s[5 * 33]); o.w = pk2(s[6 * 33], s[7 * 33]);
        *(u32x4*)(dst + (size_t)n * dstK + 8 * c) = o; }
    asm volatile("s_waitcnt lgkmcnt(0)" ::: "memory");
}
DEVI void phase0(const Args& a, LAS unsigned char* lds, int tid, int lane, int wave) {
    unsigned char* ws = a.ws;
    bf16_t* WinA = (bf16_t*)(ws + WS_WINA); bf16_t* WinC = (bf16_t*)(ws + WS_WINC); bf16_t* Wbr = (bf16_t*)(ws + WS_WBR);
    bf16_t* Wout = (bf16_t*)(ws + WS_WOUT); bf16_t* Wup = (bf16_t*)(ws + WS_WUP); bf16_t* Wdn = (bf16_t*)(ws + WS_WDN);
    LAS float* scr = (LAS float*)(lds + wave * 16384);
    const int gw = blockIdx.x * 8 + wave, NGW = gridDim.x * 8;
    constexpr int I_IN = 16 * 241, I_BR = 16 * 32, I_UP = 16 * 176, I_DN = 44 * 32;
    constexpr int NITEMS = I_IN + 3 * I_BR + I_UP + I_DN;
    for (int it = gw; it < NITEMS; it += NGW) {
        int r = it;
        if (r < I_IN) { const int kb = r / 241, nb = r % 241, c0 = nb * 32; bf16_t* d; int row;
            if (c0 < 3072) { d = WinA; row = c0; } else if (c0 < 4096) { d = WinC; row = c0 - 3072; } else if (c0 == 4096) { d = WinA; row = 3072; }
            else if (c0 < 5152) { d = WinC; row = 1024 + (c0 - 4128); } else if (c0 < 5408) { d = WinC; row = 2048 + (c0 - 5152); }
            else if (c0 < 5664) { d = WinC; row = 2304 + (c0 - 5408); } else { d = WinC; row = 2560 + (c0 - 5664); }
            transpose_item(a.in[8], 7712, kb * 64, c0, d + (size_t)row * 1024 + kb * 64, 1024, scr, lane); continue; }
        r -= I_IN;
        if (r < I_BR) { const int kb = r / 32, nb = r % 32; transpose_item(a.in[16], 1024, kb * 64, nb * 32, Wbr + (size_t)(nb * 32) * 2048 + kb * 64, 2048, scr, lane); continue; }
        r -= I_BR;
        if (r < I_BR) { const int kb = r / 32, nb = r % 32; transpose_item(a.in[17], 1024, kb * 64, nb * 32, Wbr + (size_t)(nb * 32) * 2048 + 1024 + kb * 64, 2048, scr, lane); continue; }
        r -= I_BR;
        if (r < I_BR) { const int kb = r / 32, nb = r % 32; transpose_item(a.in[18], 1024, kb * 64, nb * 32, Wout + (size_t)(nb * 32) * 1024 + kb * 64, 1024, scr, lane); continue; }
        r -= I_BR;
        if (r < I_UP) { const int kb = r / 176, nb = r % 176, c0 = nb * 32; int row;
            if (c0 < DFF) row = 256 * (c0 / 128) + (c0 % 128); else { const int c1 = c0 - DFF; row = 256 * (c1 / 128) + 128 + (c1 % 128); }
            transpose_item(a.in[19], NUP, kb * 64, c0, Wup + (size_t)row * 1024 + kb * 64, 1024, scr, lane); continue; }
        r -= I_UP;
        { const int kb = r / 32, nb = r % 32; transpose_item(a.in[22], 1024, kb * 64, nb * 32, Wdn + (size_t)(nb * 32) * DFF + kb * 64, DFF, scr, lane); }
    }
    float* modacc = (float*)(ws + CTL_MODACC);
    for (int it = blockIdx.x; it < 12 * 16; it += gridDim.x) {
        const int cb = it % 12, ks = it / 12, n = cb * 512 + tid;
        float a0 = 0.f, a1 = 0.f, a2 = 0.f;
#pragma unroll 8
        for (int k = ks * 64; k < ks * 64 + 64; ++k) {
            const float w = a.in[4][(size_t)k * 6144 + n];
            a0 += siluf(a.in[1][k]) * w; a1 += siluf(a.in[1][1024 + k]) * w; a2 += siluf(a.in[3][k]) * w;
        }
        atomicAdd(modacc + n, a0); atomicAdd(modacc + 6144 + n, a1); atomicAdd(modacc + 12288 + n, a2);
    }
    float* rope = (float*)(ws + SM_ROPE);
    for (int i = blockIdx.x * 512 + tid; i < 320 * 32; i += gridDim.x * 512) {
        const int p = i >> 5, f = i & 31; const float inv = powf(10000.f, -(float)f / 32.f);
        if (p < 256) { const float ang = (float)p * inv; rope[p * 32 + f] = cosf(ang); rope[8192 + p * 32 + f] = sinf(ang); }
        else { const int q = p - 256; const float ang = (float)q * inv; rope[16384 + q * 32 + f] = cosf(ang); rope[16384 + 2048 + q * 32 + f] = sinf(ang); }
    }
}

DEVI void phase1(const Args& a, int tid, int lane, int wave) {
    unsigned char* ws = a.ws;
    const float* modacc = (const float*)(ws + CTL_MODACC); const float* bada = a.in[5];
    bf16_t* XN = (bf16_t*)(ws + WS_XN); float* rowss1 = (float*)(ws + SM_ROWSS1);
    const int gw = blockIdx.x * 8 + wave, NGW = gridDim.x * 8;
    for (int row = gw; row < MT; row += NGW) {
        const int vs = row < SEQ ? 0 : (row < ML ? 1 : 2);
        const float* xr = row < ML ? a.in[0] + (size_t)row * 1024 : a.in[2] + (size_t)(row - ML) * 1024;
        float ss = 0.f;
#pragma unroll
        for (int j = 0; j < 4; ++j) {
            const int c = 4 * lane + 256 * j;
            const f32x4 v = *(const f32x4*)(xr + c);
            ss += (v[0] * v[0] + v[1] * v[1]) + (v[2] * v[2] + v[3] * v[3]);
            const f32x4 s = (*(const f32x4*)(modacc + vs * 6144 + 1024 + c) + *(const f32x4*)(bada + 1024 + c) + 1.f) * *(const f32x4*)(a.in[6] + c);
            const f32x4 o = v * s; u32x2 w; w.x = pk2(o[0], o[1]); w.y = pk2(o[2], o[3]);
            *(u32x2*)(XN + (size_t)row * 1024 + c) = w;
        }
        ss = wave_sum(ss);
        if (lane == 0) rowss1[row] = ss;
    }
    const bf16_t* WinA = (const bf16_t*)(ws + WS_WINA); const bf16_t* WinC = (const bf16_t*)(ws + WS_WINC); const bf16_t* Wup = (const bf16_t*)(ws + WS_WUP);
    float* shWa = (float*)(ws + SM_SHWA); float* shWf = (float*)(ws + SM_SHWF);
    for (int n = gw; n < NSH + NUP; n += NGW) {
        const bool isf = n >= NSH;
        const bf16_t* wrow = isf ? Wup + (size_t)(n - NSH) * 1024 : (n < NA ? WinA + (size_t)n * 1024 : WinC + (size_t)(n - NA) * 1024);
        const int shoff = isf ? 3072 : 0;
        float s0 = 0.f, s1 = 0.f, s2 = 0.f;
#pragma unroll
        for (int h = 0; h < 2; ++h) {
            const int k0 = h * 512 + lane * 8;
            const u32x4 w = *(const u32x4*)(wrow + k0);
#pragma unroll
            for (int i = 0; i < 4; ++i) {
                const float wl = bflo(w[i]), wh = bfhi(w[i]); const int k = k0 + 2 * i;
                const float b0 = bada[shoff + k], b1 = bada[shoff + k + 1];
                s0 += (modacc[shoff + k] + b0) * wl + (modacc[shoff + k + 1] + b1) * wh;
                s1 += (modacc[6144 + shoff + k] + b0) * wl + (modacc[6144 + shoff + k + 1] + b1) * wh;
                s2 += (modacc[12288 + shoff + k] + b0) * wl + (modacc[12288 + shoff + k + 1] + b1) * wh;
            }
        }
        s0 = wave_sum(s0); s1 = wave_sum(s1); s2 = wave_sum(s2);
        if (lane == 0) {
            if (isf) { shWf[n - NSH] = s0; shWf[NUP + n - NSH] = s1; }
            else { shWa[n] = s0; shWa[NSH + n] = s1; shWa[2 * NSH + n] = s2; }
        }
    }
}

DEVI void phase_dnprep(const Args& a, int tid) {
    unsigned char* ws = a.ws;
    const bf16_t* QR = (const bf16_t*)(ws + WS_QKVR); bf16_t* QP = (bf16_t*)(ws + WS_QKVP);
    const float* convw = a.in[9]; const float* ba = (const float*)(ws + WS_BA);
    float* gb = (float*)(ws + WS_G); float* bb = (float*)(ws + WS_BETA);
    const int cg_ = tid & 15, rr = tid >> 4;
    for (int it = blockIdx.x; it < 520 * 24; it += gridDim.x) {
        const int cidx = it / 24, s = it % 24;
        int seq_start, t0, seq_len;
        if (cidx < 512) { seq_start = (cidx >> 8) * SEQ; t0 = (cidx & 255) * 64; seq_len = SEQ; }
        else { const int c2 = cidx - 512; seq_start = ML + (c2 >> 2) * CTX; t0 = (c2 & 3) * 64; seq_len = CTX; }
        const int col = s * 128 + cg_ * 8;
        f32x4 w0[5], w1[5];
#pragma unroll
        for (int j = 0; j < 5; ++j) { w0[j] = *(const f32x4*)(convw + j * 3072 + col); w1[j] = *(const f32x4*)(convw + j * 3072 + col + 4); }
#pragma unroll
        for (int pass = 0; pass < 2; ++pass) {
            const int r = rr + pass * 32;
            f32x4 acc0 = {0.f, 0.f, 0.f, 0.f}, acc1 = {0.f, 0.f, 0.f, 0.f};
#pragma unroll
            for (int j = 0; j < 5; ++j) {
                const int tt = t0 + r + j - 2;
                if (tt >= 0 && tt < seq_len) {
                    const u32x4 x = *(const u32x4*)(QR + (size_t)(seq_start + tt) * 3072 + col);
                    acc0 += (f32x4){bflo(x[0]), bfhi(x[0]), bflo(x[1]), bfhi(x[1])} * w0[j];
                    acc1 += (f32x4){bflo(x[2]), bfhi(x[2]), bflo(x[3]), bfhi(x[3])} * w1[j];
                }
            }
            float y[8];
#pragma unroll
            for (int i = 0; i < 4; ++i) { y[i] = siluf(acc0[i]); y[4 + i] = siluf(acc1[i]); }
            if (s < 16) {
                float ss = 0.f;
#pragma unroll
                for (int i = 0; i < 8; ++i) ss += y[i] * y[i];
                ss += __shfl_xor(ss, 1); ss += __shfl_xor(ss, 2); ss += __shfl_xor(ss, 4); ss += __shfl_xor(ss, 8);
                const float sc = rsqrtf(ss + EPS) * (s < 8 ? 0.08838834764831845f : 1.f);
#pragma unroll
                for (int i = 0; i < 8; ++i) y[i] *= sc;
            }
            u32x4 o; o.x = pk2(y[0], y[1]); o.y = pk2(y[2], y[3]); o.z = pk2(y[4], y[5]); o.w = pk2(y[6], y[7]);
            *(u32x4*)(QP + (size_t)(seq_start + t0 + r) * 3072 + col) = o;
        }
        if (s == 0) {
#pragma unroll
            for (int q = 0; q < 2; ++q) {
                const int e = tid + q * 512, r = e >> 4, idx = e & 15, row = seq_start + t0 + r;
                const float bv = ba[(size_t)row * 32 + idx], av = ba[(size_t)row * 32 + 16 + idx];
                const float xs = av + a.in[11][idx];
                const float sp = fmaxf(xs, 0.f) + log1pf(expf(-fabsf(xs)));
                const float g = -expf(a.in[10][idx]) * sp;
                const int dir = idx >> 3, h = idx & 7;
                gb[((size_t)dir * MT + row) * 8 + h] = g;
                bb[((size_t)dir * MT + row) * 8 + h] = 1.f / (1.f + expf(-bv));
            }
        }
    }
}

DEVI void phase_dnscan(const Args& a, int lane, int wave) {
    unsigned char* ws = a.ws;
    const bf16_t* QP = (const bf16_t*)(ws + WS_QKVP);
    const float* gb = (const float*)(ws + WS_G); const float* bb = (const float*)(ws + WS_BETA);
    bf16_t* Of = (bf16_t*)a.out; bf16_t* Ob = Of + (size_t)ML * 1024;
    const int gw = blockIdx.x * 8 + wave, NGW = gridDim.x * 8;
    for (int item = gw; item < 2048; item += NGW) {
        const int chain = item >> 6, ep = item & 63, dir = chain >> 4, b = (chain >> 3) & 1, h = chain & 7;
        bf16_t* O = dir ? Ob : Of;
        float S00 = 0.f, S01 = 0.f, S10 = 0.f, S11 = 0.f;
        const int NTOK = CTX + SEQ;
        constexpr int U = 4;
        unsigned kq[U], qq[U], vv[U]; float gg[U], be[U]; int rows[U];
        auto rowof = [&](int s) -> int { if (s < CTX) { const int t = dir ? CTX - 1 - s : s; return ML + b * CTX + t; } const int t2 = s - CTX; const int t = dir ? SEQ - 1 - t2 : t2; return b * SEQ + t; };
#define SC_LOAD(i, s) do { const int row_ = rowof(s); rows[i] = row_; const bf16_t* p_ = QP + (size_t)row_ * 3072 + h * 128; \
        qq[i] = *(const unsigned*)(p_ + 2 * lane); kq[i] = *(const unsigned*)(p_ + 1024 + 2 * lane); vv[i] = *(const unsigned*)(p_ + 2048 + 2 * ep); \
        gg[i] = gb[((size_t)dir * MT + row_) * 8 + h]; be[i] = bb[((size_t)dir * MT + row_) * 8 + h]; } while (0)
        for (int s0 = 0; s0 < NTOK; s0 += U) {
#pragma unroll
            for (int i = 0; i < U; ++i) SC_LOAD(i, s0 + i);
#pragma unroll
            for (int i = 0; i < U; ++i) {
                const float k0 = bflo(kq[i]), k1 = bfhi(kq[i]), q0 = bflo(qq[i]), q1 = bfhi(qq[i]), v0 = bflo(vv[i]), v1 = bfhi(vv[i]);
                const float eg = __expf(gg[i]), bt = be[i];
                float p0 = k0 * S00 + k1 * S10, p1 = k0 * S01 + k1 * S11;
                p0 = wave_sum(p0); p1 = wave_sum(p1);
                const float vn0 = bt * (v0 - eg * p0), vn1 = bt * (v1 - eg * p1);
                S00 = eg * S00 + k0 * vn0; S01 = eg * S01 + k0 * vn1; S10 = eg * S10 + k1 * vn0; S11 = eg * S11 + k1 * vn1;
                float o0 = q0 * S00 + q1 * S10, o1 = q0 * S01 + q1 * S11;
                o0 = wave_sum(o0); o1 = wave_sum(o1);
                if (lane == 0 && rows[i] < ML) *(unsigned*)(O + (size_t)rows[i] * 1024 + h * 128 + 2 * ep) = pk2(o0, o1);
            }
        }
#undef SC_LOAD
    }
}

DEVI bf16x8 ld_b128(LAS const unsigned char* p) { return *(LAS const bf16x8*)p; }
DEVI bf16x8 ld_2b64(LAS const unsigned char* p0, LAS const unsigned char* p1) { const u32x2 a = *(LAS const u32x2*)p0, b = *(LAS const u32x2*)p1; u32x4 w = {a.x, a.y, b.x, b.y}; return __builtin_bit_cast(bf16x8, w); }
DEVI bf16x8 pack_frag(const f32x4& lo, const f32x4& hi) { u32x4 w = {pk2(lo[0], lo[1]), pk2(lo[2], lo[3]), pk2(hi[0], hi[1]), pk2(hi[2], hi[3])}; return __builtin_bit_cast(bf16x8, w); }
#define MFMA16(A, B, C) __builtin_amdgcn_mfma_f32_16x16x32_bf16(A, B, C, 0, 0, 0)
DEVI void phase_dnchunk(const Args& a, LAS unsigned char* lds, int tid, int lane, int wave) {
    unsigned char* ws = a.ws;
    const bf16_t* QP = (const bf16_t*)(ws + WS_QKVP); const float* gb = (const float*)(ws + WS_G); const float* bb = (const float*)(ws + WS_BETA);
    bf16_t* TQ = (bf16_t*)(ws + WS_TQ); float* AV = (float*)(ws + WS_AVEC);
    constexpr int KL = 0, QL = 17408, KKF = 34816, QKF = 52224, VEC = 131072;
    const int fr = lane & 15, g = lane >> 4, d = wave >> 2, wq = wave & 3;
    LAS unsigned char* dbase = lds + d * 64512;
    LAS float* Gg = (LAS float*)(lds + VEC); LAS float* Bv = Gg + 128; LAS float* GC = Gg + 256;
    for (int item = blockIdx.x; item < 520 * 8; item += gridDim.x) {
        const int cidx = item >> 3, h = item & 7;
        const int row0 = cidx < 512 ? cidx * 64 : ML + (cidx - 512) * 64;
#pragma unroll
        for (int i = 0; i < 2; ++i) { const int c = tid + i * 512, r = c >> 4, ch = c & 15;
            const bf16_t* src = QP + (size_t)(row0 + r) * 3072 + h * 128 + ch * 8;
            *(LAS u32x4*)(lds + QL + r * 272 + ch * 16) = *(const u32x4*)src; *(LAS u32x4*)(lds + KL + r * 272 + ch * 16) = *(const u32x4*)(src + 1024); }
        if (tid < 128) { const int dd = tid >> 6, pos = tid & 63; Gg[tid] = gb[((size_t)dd * MT + row0 + pos) * 8 + h]; Bv[tid] = bb[((size_t)dd * MT + row0 + pos) * 8 + h]; }
        __syncthreads();
        if (wave < 2) {
            const int dd = wave, pos = dd ? 63 - lane : lane; float x = Gg[dd * 64 + pos];
#pragma unroll
            for (int o = 1; o < 64; o <<= 1) { const float y = __shfl_up(x, o); if (lane >= o) x += y; }
            const float total = __shfl(x, 63);
            GC[dd * 64 + pos] = x;
            float* av = AV + ((size_t)item * 2 + dd) * 256;
            av[pos] = __expf(x); av[64 + pos] = Bv[dd * 64 + pos]; av[128 + pos] = __expf(total - x); if (lane == 0) av[192] = __expf(total);
        }
        {
            const int src = d ? QL : KL;
            f32x4 acc[4] = {{0.f, 0.f, 0.f, 0.f}, {0.f, 0.f, 0.f, 0.f}, {0.f, 0.f, 0.f, 0.f}, {0.f, 0.f, 0.f, 0.f}};
#pragma unroll
            for (int s4 = 0; s4 < 4; ++s4) { const bf16x8 A = ld_b128(lds + src + (16 * wq + fr) * 272 + (32 * s4 + 8 * g) * 2);
#pragma unroll
                for (int jt = 0; jt < 4; ++jt) { const bf16x8 Bf = ld_b128(lds + KL + (16 * jt + fr) * 272 + (32 * s4 + 8 * g) * 2); acc[jt] = MFMA16(A, Bf, acc[jt]); } }
            LAS float* dst = (LAS float*)(lds + (d ? QKF : KKF));
#pragma unroll
            for (int jt = 0; jt < 4; ++jt)
#pragma unroll
                for (int r = 0; r < 4; ++r) dst[(16 * wq + 4 * g + r) * 68 + 16 * jt + fr] = acc[jt][r];
        }
        __syncthreads();
        f32x4 P[4], qd[4];
        {
            const LAS float* kkf = (const LAS float*)(lds + KKF); const LAS float* qkf = (const LAS float*)(lds + QKF);
            float gci[4], bei[4];
#pragma unroll
            for (int r = 0; r < 4; ++r) { gci[r] = GC[d * 64 + 16 * wq + 4 * g + r]; bei[r] = Bv[d * 64 + 16 * wq + 4 * g + r]; }
#pragma unroll
            for (int jt = 0; jt < 4; ++jt) { const int j = 16 * jt + fr; const float gcj = GC[d * 64 + j];
#pragma unroll
                for (int r = 0; r < 4; ++r) { const int i = 16 * wq + 4 * g + r; const bool incl = d ? (i <= j) : (i >= j);
                    const float e = incl ? __expf(gci[r] - gcj) : 0.f;
                    qd[jt][r] = qkf[i * 68 + j] * e; P[jt][r] = (i != j) ? -bei[r] * kkf[i * 68 + j] * e : 0.f; } }
        }
        __syncthreads();
        {
#pragma unroll
            for (int jt = 0; jt < 4; ++jt) {
#pragma unroll
                for (int r = 0; r < 4; ++r) { const int i = 16 * wq + 4 * g + r, j = 16 * jt + fr;
                    *(LAS unsigned short*)(dbase + 0 + i * 144 + j * 2) = (unsigned short)f2bf(P[jt][r]);
                    *(LAS unsigned short*)(dbase + 36864 + 9216 + i * 144 + j * 2) = (unsigned short)f2bf(P[jt][r]);
                    *(LAS unsigned short*)(dbase + 55296 + i * 144 + j * 2) = (unsigned short)f2bf(qd[jt][r]); }
                u32x2 w = {pk2(P[jt][0], P[jt][1]), pk2(P[jt][2], P[jt][3])};
                *(LAS u32x2*)(dbase + 18432 + (16 * jt + fr) * 144 + (16 * wq + 4 * g) * 2) = w; }
        }
        __syncthreads();
        int cur = 0;
#pragma unroll 1
        for (int it = 0; it < 5; ++it) {
            LAS unsigned char* NRc = dbase + cur * 9216; LAS unsigned char* NTc = dbase + 18432 + cur * 9216;
            LAS unsigned char* NRn = dbase + (cur ^ 1) * 9216; LAS unsigned char* NTn = dbase + 18432 + (cur ^ 1) * 9216;
            LAS unsigned char* PRo = dbase + 36864 + ((it + 1) & 1) * 9216; LAS unsigned char* PRn = dbase + 36864 + (it & 1) * 9216;
            f32x4 n2[4] = {{0.f, 0.f, 0.f, 0.f}, {0.f, 0.f, 0.f, 0.f}, {0.f, 0.f, 0.f, 0.f}, {0.f, 0.f, 0.f, 0.f}};
#pragma unroll
            for (int s2 = 0; s2 < 2; ++s2) { const bf16x8 A = ld_b128(NRc + (16 * wq + fr) * 144 + (32 * s2 + 8 * g) * 2);
#pragma unroll
                for (int jt = 0; jt < 4; ++jt) { const bf16x8 Bf = ld_b128(NTc + (16 * jt + fr) * 144 + (32 * s2 + 8 * g) * 2); n2[jt] = MFMA16(A, Bf, n2[jt]); } }
#pragma unroll
            for (int jt = 0; jt < 4; ++jt) {
#pragma unroll
                for (int r = 0; r < 4; ++r) *(LAS unsigned short*)(NRn + (16 * wq + 4 * g + r) * 144 + (16 * jt + fr) * 2) = (unsigned short)f2bf(n2[jt][r]);
                u32x2 w = {pk2(n2[jt][0], n2[jt][1]), pk2(n2[jt][2], n2[jt][3])};
                *(LAS u32x2*)(NTn + (16 * jt + fr) * 144 + (16 * wq + 4 * g) * 2) = w;
                P[jt] += n2[jt]; }
            __syncthreads();
#pragma unroll
            for (int s2 = 0; s2 < 2; ++s2) { const bf16x8 A = ld_b128(PRo + (16 * wq + fr) * 144 + (32 * s2 + 8 * g) * 2);
#pragma unroll
                for (int jt = 0; jt < 4; ++jt) { const bf16x8 Bf = ld_b128(NTn + (16 * jt + fr) * 144 + (32 * s2 + 8 * g) * 2); P[jt] = MFMA16(A, Bf, P[jt]); } }
#pragma unroll
            for (int jt = 0; jt < 4; ++jt)
#pragma unroll
                for (int r = 0; r < 4; ++r) *(LAS unsigned short*)(PRn + (16 * wq + 4 * g + r) * 144 + (16 * jt + fr) * 2) = (unsigned short)f2bf(P[jt][r]);
            cur ^= 1;
        }
        __syncthreads();
        {
            bf16_t* dst = TQ + ((size_t)item * 2 + d) * 8192; const int t2 = tid & 255;
#pragma unroll
            for (int k = 0; k < 4; ++k) { const int c = t2 + 256 * k, mat = c >> 9, r = (c >> 3) & 63, ch = c & 7;
                const u32x4 v = *(LAS const u32x4*)(dbase + (mat ? 55296 : 36864) + r * 144 + ch * 16);
                *(u32x4*)(dst + mat * 4096 + r * 64 + ch * 8) = v; }
        }
        __syncthreads();
    }
}

DEVI void phase_dnscan2(const Args& a, LAS unsigned char* lds, int tid, int lane, int wave, unsigned long long& pr_extra) {
    const int v = blockIdx.x;
    if (v < 64) {
    unsigned char* ws = a.ws;
    const bf16_t* QP = (const bf16_t*)(ws + WS_QKVP); const bf16_t* TQ = (const bf16_t*)(ws + WS_TQ); const float* AV = (const float*)(ws + WS_AVEC);
    const int chain = (v & 7) + 8 * (v >> 4), hf = (v >> 3) & 1, dir = chain >> 4, b = (chain >> 3) & 1, h = chain & 7;
    bf16_t* O = (bf16_t*)a.out + (size_t)dir * ML * 1024;
    constexpr int KL = 0, QL = 16384, VL = 32768, TL = 41984, DL = 50176, AL = 58368, BUFB = 59392, OT = 2 * BUFB, PFD = OT + 18432, NSTEP = 260;
    const int fr0 = lane & 15, g0 = lane >> 4, ltid = tid - 256;
    auto step_cidx = [&](int s) -> int { if (s < 4) return 512 + b * 4 + (dir ? 3 - s : s); const int c = s - 4; return b * 256 + (dir ? 255 - c : c); };
    u32x4 rq[6], rk[6], rv[3], rt[3], rd[3], ra;
#define LD_ISSUE(s_) do { const int cidx_ = step_cidx(s_); const int row0_ = cidx_ < 512 ? cidx_ * 64 : ML + (cidx_ - 512) * 64; \
        const bf16_t* tqb_ = TQ + ((size_t)(cidx_ * 8 + h) * 2 + dir) * 8192; const float* avb_ = AV + ((size_t)(cidx_ * 8 + h) * 2 + dir) * 256; \
        int lt_ = ltid; asm volatile("" : "+v"(lt_)); \
        const bf16_t* pq_ = QP + (size_t)(row0_ + (lt_ >> 4)) * 3072 + h * 128 + (lt_ & 15) * 8; \
        const bf16_t* pv_ = QP + (size_t)(row0_ + (lt_ >> 3)) * 3072 + 2048 + h * 128 + hf * 64 + (lt_ & 7) * 8; \
        const bf16_t* pt_ = tqb_ + (lt_ >> 3) * 64 + (lt_ & 7) * 8; \
        _Pragma("unroll") for (int i = 0; i < 6; ++i) { const size_t o_ = (i < 5 || lt_ < 64) ? (size_t)i * 12 * 3072 : 0; rq[i] = *(const u32x4*)(pq_ + o_); rk[i] = *(const u32x4*)(pq_ + o_ + 1024); } \
        _Pragma("unroll") for (int i = 0; i < 3; ++i) { const int ok_ = (i < 2 || lt_ < 128); rv[i] = *(const u32x4*)(pv_ + (ok_ ? (size_t)i * 24 * 3072 : 0)); rt[i] = *(const u32x4*)(pt_ + (ok_ ? i * 24 * 64 : 0)); rd[i] = *(const u32x4*)(pt_ + 4096 + (ok_ ? i * 24 * 64 : 0)); } \
        ra = *(const u32x4*)(avb_ + (lt_ & 63) * 4); } while (0)
#define LD_WRITE(bo_) do { int lt_ = ltid; asm volatile("" : "+v"(lt_)); LAS unsigned char* B_ = lds + (bo_); \
        const int chq_ = lt_ & 15, chv_ = lt_ & 7; \
        _Pragma("unroll") for (int i = 0; i < 6; ++i) if (i < 5 || lt_ < 64) { const int r = (lt_ >> 4) + 12 * i; const int o_ = r * 256 + ((chq_ ^ (4 * (r & 3) + ((r >> 3) & 3))) << 4); \
            *(LAS u32x4*)(B_ + QL + o_) = rq[i]; *(LAS u32x4*)(B_ + KL + o_) = rk[i]; } \
        _Pragma("unroll") for (int i = 0; i < 3; ++i) if (i < 2 || lt_ < 128) { const int r = (lt_ >> 3) + 24 * i; const int o_ = r * 128 + ((chv_ ^ (2 * ((r >> 3) & 3) + ((r >> 1) & 1))) << 4); \
            *(LAS u32x4*)(B_ + VL + r * 144 + chv_ * 16) = rv[i]; *(LAS u32x4*)(B_ + TL + o_) = rt[i]; *(LAS u32x4*)(B_ + DL + o_) = rd[i]; } \
        if (lt_ < 64) *(LAS u32x4*)(B_ + AL + lt_ * 16) = ra; } while (0)
#define OT_OUT(s_) do { const int cidx_ = step_cidx(s_); const int row0_ = cidx_ * 64; LAS const unsigned char* ot_ = lds + OT + ((s_) & 1) * 9216; \
        int lt_ = ltid; asm volatile("" : "+v"(lt_)); \
        for (int c = lt_; c < 512; c += 192) { const int r = c >> 3, ch = c & 7; \
            *(u32x4*)(O + (size_t)(row0_ + r) * 1024 + h * 128 + hf * 64 + ch * 8) = *(LAS const u32x4*)(ot_ + r * 144 + ch * 16); } } while (0)
    constexpr int PF_D = 3; constexpr bool PF_ON = false;
    const unsigned pfdst = (unsigned)__builtin_amdgcn_readfirstlane((int)(unsigned)(uintptr_t)(lds + PFD));
#define PF_ISSUE(s_) do { const int cidx_ = step_cidx(s_); const int row0_ = cidx_ < 512 ? cidx_ * 64 : ML + (cidx_ - 512) * 64; \
        const char* tqb_ = (const char*)(TQ + ((size_t)(cidx_ * 8 + h) * 2 + dir) * 8192); const char* avb_ = (const char*)(AV + ((size_t)(cidx_ * 8 + h) * 2 + dir) * 256); \
        int ln_ = lane; asm volatile("" : "+v"(ln_)); \
        _Pragma("unroll") for (int j = 0; j < 8; ++j) { const int L = j * 64 + ln_; const char* p_; \
            if (L < 320) { const int rw = L / 5, part = L - rw * 5; p_ = (const char*)(QP + (size_t)(row0_ + rw) * 3072 + h * 128) + (part < 2 ? part * 128 : part < 4 ? 2048 + (part - 2) * 128 : 4096 + hf * 128); } \
            else if (L < 448) p_ = tqb_ + (L - 320) * 128; else p_ = avb_ + ((L - 448) & 7) * 128; \
            { unsigned keep_; asm volatile("s_mov_b32 %0, m0\n\ts_mov_b32 m0, %2\n\ts_nop 0\n\tglobal_load_lds_dword %1, off\n\ts_mov_b32 m0, %0" : "=&s"(keep_) : "v"(p_), "s"(pfdst) : "memory"); } } } while (0)
    f32x4 S[8];
#pragma unroll
    for (int i = 0; i < 8; ++i) S[i] = (f32x4){0.f, 0.f, 0.f, 0.f};
    if (wave >= 4 && wave < 7) { LD_ISSUE(0); LD_WRITE(0); }
    if (wave == 7) {
#pragma unroll 1
        for (int s = 1; s < PF_D; ++s) if (PF_ON) PF_ISSUE(s); }
#pragma unroll 1
    for (int s = 0; s < NSTEP; ++s) {
        if (wave == 7) {
            __builtin_amdgcn_s_barrier();
            if (PF_ON && s + PF_D < NSTEP) PF_ISSUE(s + PF_D);
            continue;
        }
        const unsigned long long tb_ = PROBE_SUB ? __builtin_amdgcn_s_memrealtime() : 0ull;
        asm volatile("s_waitcnt lgkmcnt(0)" ::: "memory"); __builtin_amdgcn_s_barrier(); asm volatile("" ::: "memory");
        if ((PROBE_SUB == 1 && wave == 0) || (PROBE_SUB == 2 && wave == 4)) pr_extra += __builtin_amdgcn_s_memrealtime() - tb_;
        if (wave >= 4) {
            if (s + 1 < NSTEP) { LD_ISSUE(s + 1); if (s >= 5) OT_OUT(s - 1); LD_WRITE(((s + 1) & 1) * BUFB); }
            else { OT_OUT(s - 1); }
        } else {
            int fr = fr0, g = g0; asm volatile("" : "+v"(fr), "+v"(g));
            LAS const unsigned char* B = lds + (s & 1) * BUFB;
            const LAS float* avl = (const LAS float*)(B + AL);
            const int rowl = 8 * (fr >> 2) + (fr & 3);
            const int fk = 4 * (fr & 3) + (fr >> 2), ft = 2 * (fr >> 2) + ((fr >> 1) & 1);
#define SBAR_() __builtin_amdgcn_sched_barrier(0)
#define ROWK(pt) ((32 * ((pt) >> 1) + 4 * ((pt) & 1) + rowl) * 256)
#define ROWT(pt) ((32 * ((pt) >> 1) + 4 * ((pt) & 1) + rowl) * 128)
#define P0(pt) (32 * ((pt) >> 1) + 8 * g + 4 * ((pt) & 1))
#define LDK8(dst, base, pa) do { _Pragma("unroll") for (int s4 = 0; s4 < 4; ++s4) { dst[s4] = ld_b128(B + (base) + ROWK(pa) + (((4 * s4 + g) ^ fk) << 4)); dst[4 + s4] = ld_b128(B + (base) + ROWK((pa) + 1) + (((4 * s4 + g) ^ fk) << 4)); } } while (0)
#define LDT8(dst, base) do { _Pragma("unroll") for (int pt = 0; pt < 4; ++pt) { dst[2 * pt] = ld_b128(B + (base) + ROWT(pt) + ((g ^ ft) << 4)); dst[2 * pt + 1] = ld_b128(B + (base) + ROWT(pt) + (((4 + g) ^ ft) << 4)); } } while (0)
#define MM8(acc, fa, pa) do { _Pragma("unroll") for (int s4 = 0; s4 < 4; ++s4) { acc[pa] = MFMA16(fa[s4], Sb[s4], acc[pa]); acc[(pa) + 1] = MFMA16(fa[4 + s4], Sb[s4], acc[(pa) + 1]); } } while (0)
            bf16x8 fA[8], fB[8];
            LDK8(fA, KL, 0);
            bf16x8 Sb[4];
#pragma unroll
            for (int s4 = 0; s4 < 4; ++s4) Sb[s4] = pack_frag(S[2 * s4], S[2 * s4 + 1]);
            f32x4 Z[4], OQ[4], X[4];
#pragma unroll
            for (int pt = 0; pt < 4; ++pt) { Z[pt] = (f32x4){0.f, 0.f, 0.f, 0.f}; OQ[pt] = (f32x4){0.f, 0.f, 0.f, 0.f}; }
            SBAR_();
            LDK8(fB, KL, 2); SBAR_(); MM8(Z, fA, 0); SBAR_();
            LDT8(fA, TL); SBAR_(); MM8(Z, fB, 2); SBAR_();
            f32x4 avp[4];
            {
                f32x4 bvp[4]; unsigned short vraw[4][4];
#pragma unroll
                for (int pt = 0; pt < 4; ++pt) { avp[pt] = *(const LAS f32x4*)(avl + P0(pt)); bvp[pt] = *(const LAS f32x4*)(avl + 64 + P0(pt));
#pragma unroll
                    for (int r = 0; r < 4; ++r) vraw[pt][r] = *(const LAS unsigned short*)(B + VL + (P0(pt) + r) * 144 + (16 * wave + fr) * 2); }
                LDK8(fB, QL, 0);
                SBAR_();
#pragma unroll
                for (int pt = 0; pt < 4; ++pt)
#pragma unroll
                    for (int r = 0; r < 4; ++r) Z[pt][r] = bvp[pt][r] * (bf2f(vraw[pt][r]) - avp[pt][r] * Z[pt][r]);
            }
            { const bf16x8 Zb0 = pack_frag(Z[0], Z[1]), Zb1 = pack_frag(Z[2], Z[3]);
#pragma unroll
              for (int pt = 0; pt < 4; ++pt) { X[pt] = MFMA16(fA[2 * pt], Zb0, Z[pt]); X[pt] = MFMA16(fA[2 * pt + 1], Zb1, X[pt]); } }
            SBAR_();
            LDK8(fA, QL, 2); SBAR_(); MM8(OQ, fB, 0); SBAR_();
            LDT8(fB, DL); SBAR_(); MM8(OQ, fA, 2); SBAR_();
            const int trq = fr >> 2, trp = fr & 3;
            LAS unsigned char* kp0 = (LAS unsigned char*)(B + KL + (8 * g + trq) * 256);
            const int fkt = 4 * trq + g;
#define KT_LOAD(dst, d0) do { _Pragma("unroll") for (int j = 0; j < 4; ++j) { const int dt_ = (d0) + j; const int co = (((4 * (dt_ >> 1) + trp) ^ fkt) << 4) + 8 * (dt_ & 1); \
                const s16x4 a0 = __builtin_bit_cast(s16x4, __builtin_amdgcn_ds_read_tr16_b64_v4i16((LAS s16x4*)(kp0 + co))), a1 = __builtin_bit_cast(s16x4, __builtin_amdgcn_ds_read_tr16_b64_v4i16((LAS s16x4*)(kp0 + co + 4 * 256))); \
                const s16x4 a2 = __builtin_bit_cast(s16x4, __builtin_amdgcn_ds_read_tr16_b64_v4i16((LAS s16x4*)(kp0 + co + 32 * 256))), a3 = __builtin_bit_cast(s16x4, __builtin_amdgcn_ds_read_tr16_b64_v4i16((LAS s16x4*)(kp0 + co + 36 * 256))); \
                dst[2 * j] = (bf16x8){a0[0], a0[1], a0[2], a0[3], a1[0], a1[1], a1[2], a1[3]}; dst[2 * j + 1] = (bf16x8){a2[0], a2[1], a2[2], a2[3], a3[0], a3[1], a3[2], a3[3]}; } } while (0)
            KT_LOAD(fA, 0);
            const float egl = avl[192];
            bf16x8 Xc0, Xc1;
            { const bf16x8 Xb0 = pack_frag(X[0], X[1]), Xb1 = pack_frag(X[2], X[3]);
              f32x4 cx[4];
#pragma unroll
              for (int pt = 0; pt < 4; ++pt) cx[pt] = X[pt] * *(const LAS f32x4*)(avl + 128 + P0(pt));
              Xc0 = pack_frag(cx[0], cx[1]); Xc1 = pack_frag(cx[2], cx[3]);
              SBAR_();
#pragma unroll
              for (int pt = 0; pt < 4; ++pt) { f32x4 o2 = OQ[pt] * avp[pt]; o2 = MFMA16(fB[2 * pt], Xb0, o2); OQ[pt] = MFMA16(fB[2 * pt + 1], Xb1, o2); } }
            SBAR_();
            KT_LOAD(fB, 4); SBAR_();
#pragma unroll
            for (int j = 0; j < 4; ++j) { f32x4 sn = S[j] * egl; sn = MFMA16(fA[2 * j], Xc0, sn); S[j] = MFMA16(fA[2 * j + 1], Xc1, sn); }
            SBAR_();
#pragma unroll
            for (int j = 0; j < 4; ++j) { f32x4 sn = S[4 + j] * egl; sn = MFMA16(fB[2 * j], Xc0, sn); S[4 + j] = MFMA16(fB[2 * j + 1], Xc1, sn); }
            { LAS unsigned char* ot = lds + OT + (s & 1) * 9216;
#pragma unroll
              for (int pt = 0; pt < 4; ++pt)
#pragma unroll
                  for (int r = 0; r < 4; ++r) *(LAS unsigned short*)(ot + (P0(pt) + r) * 144 + (16 * wave + fr) * 2) = (unsigned short)f2bf(OQ[pt][r]); }
#undef KT_LOAD
#undef LDK8
#undef LDT8
#undef MM8
#undef ROWK
#undef ROWT
#undef P0
#undef SBAR_
        }
    }
    if (wave == 7) { __builtin_amdgcn_s_barrier(); asm volatile("s_waitcnt vmcnt(0)" ::: "memory"); }
    else { asm volatile("s_waitcnt lgkmcnt(0)" ::: "memory"); __builtin_amdgcn_s_barrier(); asm volatile("" ::: "memory"); if (wave >= 4) OT_OUT(NSTEP - 1); }
#undef PF_ISSUE
#undef LD_ISSUE
#undef LD_WRITE
#undef OT_OUT
    }
}

DEVI void phase_prep2(const Args& a, int lane, int wave) {
    unsigned char* ws = a.ws;
    bf16_t* KAT = (bf16_t*)(ws + WS_KAT); const float* rope = (const float*)(ws + SM_ROPE); const float* knw = a.in[14];
    const int gw = blockIdx.x * 8 + wave, NGW = gridDim.x * 8;
    for (int row = gw; row < MT; row += NGW) {
        bf16_t* p = KAT + (size_t)row * 256 + lane * 4;
        const u32x2 w = *(const u32x2*)p;
        float x[4] = {bflo(w.x), bfhi(w.x), bflo(w.y), bfhi(w.y)};
        float ss = (x[0] * x[0] + x[1] * x[1]) + (x[2] * x[2] + x[3] * x[3]);
        ss += __shfl_xor(ss, 1); ss += __shfl_xor(ss, 2); ss += __shfl_xor(ss, 4); ss += __shfl_xor(ss, 8); ss += __shfl_xor(ss, 16);
        const float rs = rsqrtf(ss * (1.f / 128.f) + EPS);
        const int d = (lane & 31) * 4;
        const f32x4 nw = *(const f32x4*)(knw + d);
#pragma unroll
        for (int i = 0; i < 4; ++i) x[i] = x[i] * rs * nw[i];
        float pr[4];
#pragma unroll
        for (int i = 0; i < 4; ++i) pr[i] = __shfl_xor(x[i], 8);
        if (row < ML) {
            const int t = row & (SEQ - 1), lg = (lane & 31) >> 3, fi = (lane & 7) * 4;
            const float* ct = lg < 2 ? rope + (t >> 6) * 32 + fi : rope + 16384 + (t & 63) * 32 + fi;
            const float* st = lg < 2 ? ct + 8192 : ct + 2048;
            const f32x4 c = *(const f32x4*)ct, s = *(const f32x4*)st;
            const float sg = (lg & 1) ? 1.f : -1.f;
#pragma unroll
            for (int i = 0; i < 4; ++i) x[i] = x[i] * c[i] + sg * pr[i] * s[i];
        }
        u32x2 o; o.x = pk2(x[0], x[1]); o.y = pk2(x[2], x[3]);
        *(u32x2*)p = o;
    }
    const bf16_t* Of = (const bf16_t*)a.out; const bf16_t* Ob = Of + (size_t)ML * 1024;
    const bf16_t* GT = (const bf16_t*)(ws + WS_GT); bf16_t* Y = (bf16_t*)(ws + WS_Y); const float* dnw = a.in[12];
    for (int row = gw; row < ML; row += NGW) {
        const int c0 = lane * 16;
        float o[16];
#pragma unroll
        for (int hh = 0; hh < 2; ++hh) {
            const u32x4 f = *(const u32x4*)(Of + (size_t)row * 1024 + c0 + hh * 8), bk = *(const u32x4*)(Ob + (size_t)row * 1024 + c0 + hh * 8);
#pragma unroll
            for (int i = 0; i < 4; ++i) { o[hh * 8 + 2 * i] = bflo(f[i]) + bflo(bk[i]); o[hh * 8 + 2 * i + 1] = bfhi(f[i]) + bfhi(bk[i]); }
        }
        float ss = 0.f;
#pragma unroll
        for (int i = 0; i < 16; ++i) ss += o[i] * o[i];
        ss += __shfl_xor(ss, 1); ss += __shfl_xor(ss, 2); ss += __shfl_xor(ss, 4);
        const float rs = rsqrtf(ss * (1.f / 128.f) + EPS);
        const int d0 = c0 & 127;
#pragma unroll
        for (int hh = 0; hh < 2; ++hh) {
            const u32x4 gt = *(const u32x4*)(GT + (size_t)row * 1024 + c0 + hh * 8);
            float y[8];
#pragma unroll
            for (int i = 0; i < 4; ++i) {
                y[2 * i] = o[hh * 8 + 2 * i] * rs * dnw[d0 + hh * 8 + 2 * i] * siluf(bflo(gt[i]));
                y[2 * i + 1] = o[hh * 8 + 2 * i + 1] * rs * dnw[d0 + hh * 8 + 2 * i + 1] * siluf(bfhi(gt[i]));
            }
            u32x4 w; w.x = pk2(y[0], y[1]); w.y = pk2(y[2], y[3]); w.z = pk2(y[4], y[5]); w.w = pk2(y[6], y[7]);
            *(u32x4*)(Y + (size_t)row * 2048 + c0 + hh * 8) = w;
        }
    }
}

namespace att {
constexpr int D = 128, NW = 8, QBLK = 32, KVBLK = 64;
constexpr float SCALE = 0.088388347648318440f;
constexpr float THR = 8.f;
constexpr int LDK = 256;
constexpr size_t SHM_V = KVBLK * D * 2, SHM_K = KVBLK * D * 2;
constexpr size_t OFF_WS = 2 * SHM_V + 2 * SHM_K, OFF_OST = OFF_WS + NW * 64 * 4;
#define KSWZ(row, colB) ((row) * 256 + ((colB) ^ (((row) & 7) << 4)))
#define SBAR() __builtin_amdgcn_sched_barrier(0)
DEVI int crow(int r, int hi) { return (r & 3) + 8 * (r >> 2) + 4 * hi; }
DEVI unsigned cvtpk(float lo, float hi) { unsigned r; asm volatile("v_cvt_pk_bf16_f32 %0, %1, %2" : "=v"(r) : "v"(lo), "v"(hi)); return r; }
DEVI void partialSM(f32x16& p0, f32x16& p1, float& m_reg, float& mn, float& alpha) {
    constexpr float C = SCALE * 1.4426950408889634f;
    float pmax = p0[0];
#pragma unroll
    for (int r = 1; r < 16; ++r) pmax = fmaxf(pmax, p0[r]);
#pragma unroll
    for (int r = 0; r < 16; ++r) pmax = fmaxf(pmax, p1[r]);
    { auto rr = __builtin_amdgcn_permlane32_swap(__float_as_uint(pmax), __float_as_uint(pmax), false, false);
      pmax = fmaxf(__uint_as_float(rr[0]), __uint_as_float(rr[1])); }
    if (__builtin_expect(__all(pmax - m_reg <= THR / SCALE), 1)) { mn = m_reg; alpha = 1.f; }
    else { mn = fmaxf(m_reg, pmax); alpha = __builtin_amdgcn_exp2f((m_reg - mn) * C); m_reg = mn; }
    const float mnC = -mn * C;
#pragma unroll
    for (int r = 0; r < 16; ++r) p0[r] = fmaf(p0[r], C, mnC);
#pragma unroll
    for (int r = 0; r < 16; ++r) p1[r] = fmaf(p1[r], C, mnC);
#pragma unroll
    for (int r = 0; r < 16; ++r) p0[r] = __builtin_amdgcn_exp2f(p0[r]);
}
DEVI void finishSM(f32x16& p0, f32x16& p1, float alpha, float& l_reg, bf16x8& pa0, bf16x8& pa1, bf16x8& pa2, bf16x8& pa3) {
#pragma unroll
    for (int r = 0; r < 16; ++r) p1[r] = __builtin_amdgcn_exp2f(p1[r]);
    float ps = 0;
#pragma unroll
    for (int r = 0; r < 16; ++r) ps += p0[r];
#pragma unroll
    for (int r = 0; r < 16; ++r) ps += p1[r];
    { auto rr = __builtin_amdgcn_permlane32_swap(__float_as_uint(ps), __float_as_uint(ps), false, false);
      ps = __uint_as_float(rr[0]) + __uint_as_float(rr[1]); }
    l_reg = l_reg * alpha + ps;
#define PK4(P, BASE, OUT) do { unsigned a0 = cvtpk(P[BASE + 0], P[BASE + 1]), a1 = cvtpk(P[BASE + 2], P[BASE + 3]);   \
    unsigned b0 = cvtpk(P[BASE + 4], P[BASE + 5]), b1 = cvtpk(P[BASE + 6], P[BASE + 7]);                              \
    auto r0 = __builtin_amdgcn_permlane32_swap(a0, b0, false, false); auto r1 = __builtin_amdgcn_permlane32_swap(a1, b1, false, false); \
    u32x4 w = {r0[0], r1[0], r0[1], r1[1]}; OUT = *reinterpret_cast<bf16x8*>(&w); } while (0)
    PK4(p0, 0, pa0); PK4(p0, 8, pa1); PK4(p1, 0, pa2); PK4(p1, 8, pa3);
#undef PK4
}
DEVI void qkt(f32x16& p0, f32x16& p1, const char* Ks, const bf16x8* qr, int r32, int hi) {
    p0 = f32x16{}; p1 = f32x16{};
#pragma unroll
    for (int d0 = 0; d0 < 8; ++d0) { const int cb = (d0 * 16 + hi * 8) * 2;
        const bf16x8 b0 = *reinterpret_cast<const bf16x8*>(Ks + KSWZ(r32, cb));
        const bf16x8 b1 = *reinterpret_cast<const bf16x8*>(Ks + KSWZ(32 + r32, cb));
        p0 = __builtin_amdgcn_mfma_f32_32x32x16_bf16(b0, qr[d0], p0, 0, 0, 0);
        p1 = __builtin_amdgcn_mfma_f32_32x32x16_bf16(b1, qr[d0], p1, 0, 0, 0); }
}
DEVI int v_st(int k, int c) { const int kk = (k & ~0xC) | ((k & 4) << 1) | ((k & 8) >> 1); return ((kk >> 3) * 4 + (c >> 5)) * 512 + ((kk & 7) * 32 + (c & 31)) * 2; }
DEVI int v_rd_base(int lane) { return ((lane & 3) << 3) | (((lane >> 2) & 3) << 6) | (((lane >> 4) & 1) << 5) | (((lane >> 5) & 1) << 8); }
constexpr int v_rd_off(int d0, int ks, int half) { return d0 * 512 + ks * 4096 + half * 2048; }
template <int OFF> DEVI s16x4 tr_read(int vb) { s16x4 r; asm volatile("ds_read_b64_tr_b16 %0, %1 offset:%2" : "=&v"(r) : "v"(vb), "i"(OFF) : "memory"); return r; }
template <int D0> DEVI void pv_one(f32x16& od, int vb, bf16x8 pa0, bf16x8 pa1, bf16x8 pa2, bf16x8 pa3) {
    const s16x4 l0 = tr_read<v_rd_off(D0, 0, 0)>(vb), h0 = tr_read<v_rd_off(D0, 0, 1)>(vb), l1 = tr_read<v_rd_off(D0, 1, 0)>(vb), h1 = tr_read<v_rd_off(D0, 1, 1)>(vb);
    const s16x4 l2 = tr_read<v_rd_off(D0, 2, 0)>(vb), h2 = tr_read<v_rd_off(D0, 2, 1)>(vb), l3 = tr_read<v_rd_off(D0, 3, 0)>(vb), h3 = tr_read<v_rd_off(D0, 3, 1)>(vb);
    asm volatile("s_waitcnt lgkmcnt(0)" ::: "memory"); SBAR();
#define PK(L, H) (bf16x8){L[0], L[1], L[2], L[3], H[0], H[1], H[2], H[3]}
    od = __builtin_amdgcn_mfma_f32_32x32x16_bf16(pa0, PK(l0, h0), od, 0, 0, 0);
    od = __builtin_amdgcn_mfma_f32_32x32x16_bf16(pa1, PK(l1, h1), od, 0, 0, 0);
    od = __builtin_amdgcn_mfma_f32_32x32x16_bf16(pa2, PK(l2, h2), od, 0, 0, 0);
    od = __builtin_amdgcn_mfma_f32_32x32x16_bf16(pa3, PK(l3, h3), od, 0, 0, 0);
#undef PK
}
DEVI void pv_d0(f32x16* o, int vb, bf16x8 pa0, bf16x8 pa1, bf16x8 pa2, bf16x8 pa3) {
    pv_one<0>(o[0], vb, pa0, pa1, pa2, pa3); pv_one<1>(o[1], vb, pa0, pa1, pa2, pa3); pv_one<2>(o[2], vb, pa0, pa1, pa2, pa3); pv_one<3>(o[3], vb, pa0, pa1, pa2, pa3);
}
DEVI void wmask(f32x16& p0, f32x16& p1, int qp, int kt0, int hi) {
#pragma unroll
    for (int r = 0; r < 16; ++r) { const int kp = kt0 + crow(r, hi); const int d0 = qp - kp, d1 = d0 - 32;
        if (d0 > 128 || d0 < -128) p0[r] = -1e30f; if (d1 > 128 || d1 < -128) p1[r] = -1e30f; }
}
DEVI void attn_unit(const Args& a, int b, int h, int qb, char* lds) {
    unsigned char* ws = a.ws;
    const bf16_t* QAT = (const bf16_t*)(ws + WS_QAT); const bf16_t* KAT = (const bf16_t*)(ws + WS_KAT); const bf16_t* VAT = (const bf16_t*)(ws + WS_VAT);
    bf16_t* Y = (bf16_t*)(ws + WS_Y); const float* rope = (const float*)(ws + SM_ROPE);
    const int tid = threadIdx.x, wid = tid >> 6, lane = tid & 63, r32 = lane & 31, hi = lane >> 5;
    const int kvh = h >> 2, t0 = qb * 256;
    char* V_lds = lds; char* K_lds = lds + 2 * SHM_V;
    float* wsf = (float*)(lds + OFF_WS) + wid * 64; float* li_l = wsf; float* al_l = wsf + 32;
    float m_reg = -1e30f, l_reg = 0; f32x16 o[4] = {}; bf16x8 qr[8];
    const int qp = t0 + wid * QBLK + r32;
    {
        const bf16_t* Qw = QAT + (size_t)(b * SEQ + qp) * 1024 + h * 128 + hi * 8;
        u32x4 raw[8]; float ss = 0.f;
#pragma unroll
        for (int d0 = 0; d0 < 8; ++d0) { raw[d0] = *(const u32x4*)(Qw + d0 * 16);
#pragma unroll
            for (int i = 0; i < 4; ++i) { const float lo_ = bflo(raw[d0][i]), hi_ = bfhi(raw[d0][i]); ss += lo_ * lo_ + hi_ * hi_; } }
        { auto rr = __builtin_amdgcn_permlane32_swap(__float_as_uint(ss), __float_as_uint(ss), false, false); ss = __uint_as_float(rr[0]) + __uint_as_float(rr[1]); }
        const float rs = rsqrtf(ss * (1.f / 128.f) + EPS);
        const float* qnw = a.in[13];
#pragma unroll
        for (int half = 0; half < 2; ++half) {
            const float* ct = half == 0 ? rope + (qp >> 6) * 32 : rope + 16384 + (qp & 63) * 32;
            const float* st = half == 0 ? ct + 8192 : ct + 2048;
#pragma unroll
            for (int dd = 0; dd < 2; ++dd) {
                const int fi = dd * 16 + hi * 8, da = half * 4 + dd, db = da + 2;
                u32x4 oa, ob;
#pragma unroll
                for (int q4 = 0; q4 < 2; ++q4) {
                    const f32x4 c = *(const f32x4*)(ct + fi + 4 * q4), s = *(const f32x4*)(st + fi + 4 * q4);
                    const f32x4 wa = *(const f32x4*)(qnw + da * 16 + hi * 8 + 4 * q4), wb = *(const f32x4*)(qnw + db * 16 + hi * 8 + 4 * q4);
                    float ya[4], yb[4];
#pragma unroll
                    for (int j = 0; j < 4; ++j) {
                        const unsigned ra = raw[da][2 * q4 + (j >> 1)], rb = raw[db][2 * q4 + (j >> 1)];
                        const float x1 = ((j & 1) ? bfhi(ra) : bflo(ra)) * rs * wa[j], x2 = ((j & 1) ? bfhi(rb) : bflo(rb)) * rs * wb[j];
                        ya[j] = x1 * c[j] - x2 * s[j]; yb[j] = x2 * c[j] + x1 * s[j];
                    }
                    oa[2 * q4] = cvtpk(ya[0], ya[1]); oa[2 * q4 + 1] = cvtpk(ya[2], ya[3]); ob[2 * q4] = cvtpk(yb[0], yb[1]); ob[2 * q4 + 1] = cvtpk(yb[2], yb[3]);
                }
                qr[da] = *reinterpret_cast<bf16x8*>(&oa); qr[db] = *reinterpret_cast<bf16x8*>(&ob);
            }
        }
    }
    const int tk0 = t0 - 128 < 0 ? 0 : t0 - 128, tk1 = t0 + 384 > SEQ ? SEQ : t0 + 384;
    const int NT = 4 + (tk1 - tk0) / 64;
    const int ctxrow = ML + b * CTX, latrow = b * SEQ + tk0 - 256;
#define TROW(j) ((j) < 4 ? ctxrow + 64 * (j) : latrow + 64 * (j))
    const bf16_t* Kh = KAT + kvh * 128; const bf16_t* Vh = VAT + kvh * 128;
    const int sr = tid >> 4, sc = (tid & 15) * 8, vst0 = v_st(sr, sc), vst1 = v_st(32 + sr, sc);
    const int vb0 = (int)(uintptr_t)V_lds + v_rd_base(lane);
    struct { bf16x8 vs0, vs1, ks0, ks1; } sr_[1];
#define SLOAD(i, j) do { const int k0_ = TROW(j); sr_[i].vs0 = *(const bf16x8*)(Vh + (size_t)(k0_ + sr) * LDK + sc); sr_[i].vs1 = *(const bf16x8*)(Vh + (size_t)(k0_ + 32 + sr) * LDK + sc); \
    sr_[i].ks0 = *(const bf16x8*)(Kh + (size_t)(k0_ + sr) * LDK + sc); sr_[i].ks1 = *(const bf16x8*)(Kh + (size_t)(k0_ + 32 + sr) * LDK + sc); } while (0)
#define SWRITE(bf, i) do { *(bf16x8*)(V_lds + (bf) * SHM_V + vst0) = sr_[i].vs0; *(bf16x8*)(V_lds + (bf) * SHM_V + vst1) = sr_[i].vs1; const int kc = sc * 2; \
    *(bf16x8*)(K_lds + (bf) * SHM_K + KSWZ(sr, kc)) = sr_[i].ks0; *(bf16x8*)(K_lds + (bf) * SHM_K + KSWZ(32 + sr, kc)) = sr_[i].ks1; } while (0)
#define SWAIT() asm volatile("s_waitcnt vmcnt(0)" ::: "memory")
#define RESC(al) do { if (__any((al) < 1.f)) { if (hi == 0) al_l[r32] = (al); asm volatile("s_waitcnt lgkmcnt(0)" ::: "memory"); \
    _Pragma("unroll") for (int d = 0; d < 4; ++d) _Pragma("unroll") for (int r = 0; r < 16; ++r) o[d][r] *= al_l[crow(r, hi)]; } } while (0)
#define WMASK(P0, P1, j) do { if ((j) >= 4) wmask(P0, P1, qp, tk0 + 64 * ((j) - 4), hi); } while (0)
    f32x16 pA0, pA1, pB0, pB1; float mnA, mnB, alA, alB; bf16x8 pa0, pa1, pa2, pa3;
    constexpr int SE = 0, SO = 0;
    SLOAD(SE, 0); asm volatile("s_waitcnt vmcnt(0)" ::: "memory"); SWRITE(0, SE); __syncthreads();
    qkt(pA0, pA1, K_lds, qr, r32, hi); partialSM(pA0, pA1, m_reg, mnA, alA);
    SLOAD(SO, 1);
    SWAIT(); SWRITE(1, SO); __syncthreads();
    for (int j = 1; j + 1 < NT; j += 2) {
        SBAR(); qkt(pB0, pB1, K_lds + SHM_K, qr, r32, hi); WMASK(pB0, pB1, j);
        finishSM(pA0, pA1, alA, l_reg, pa0, pa1, pa2, pa3); SBAR();
        SLOAD(SO, j + 1); SBAR();
        pv_d0(o, vb0, pa0, pa1, pa2, pa3); partialSM(pB0, pB1, m_reg, mnB, alB);
        __syncthreads(); SWAIT(); SWRITE(0, SE);
        RESC(alB); __syncthreads();
        SBAR(); qkt(pA0, pA1, K_lds, qr, r32, hi); WMASK(pA0, pA1, j + 1);
        finishSM(pB0, pB1, alB, l_reg, pa0, pa1, pa2, pa3); SBAR();
        SLOAD(SE, j + 2); SBAR();
        pv_d0(o, vb0 + (int)SHM_V, pa0, pa1, pa2, pa3); partialSM(pA0, pA1, m_reg, mnA, alA);
        __syncthreads(); SWAIT(); SWRITE(1, SO);
        RESC(alA); __syncthreads();
    }
    SBAR(); qkt(pB0, pB1, K_lds + SHM_K, qr, r32, hi); WMASK(pB0, pB1, NT - 1);
    finishSM(pA0, pA1, alA, l_reg, pa0, pa1, pa2, pa3); SBAR();
    pv_d0(o, vb0, pa0, pa1, pa2, pa3); partialSM(pB0, pB1, m_reg, mnB, alB);
    __syncthreads(); RESC(alB);
    finishSM(pB0, pB1, alB, l_reg, pa0, pa1, pa2, pa3); SBAR();
    pv_d0(o, vb0 + (int)SHM_V, pa0, pa1, pa2, pa3);
    l_reg += __builtin_amdgcn_exp2f(a.in[15][h] * 1.4426950408889634f - m_reg * (SCALE * 1.4426950408889634f));
    if (hi == 0) li_l[r32] = l_reg; asm volatile("s_waitcnt lgkmcnt(0)" ::: "memory");
    float rli[16];
#pragma unroll
    for (int r = 0; r < 16; ++r) rli[r] = __builtin_amdgcn_rcpf(li_l[crow(r, hi)]);
    {
        bf16_t* stg = (bf16_t*)(lds + OFF_OST) + wid * 4096;
#pragma unroll
        for (int r = 0; r < 16; ++r) { const int orow = crow(r, hi);
#pragma unroll
            for (int d0 = 0; d0 < 4; ++d0) stg[orow * 128 + d0 * 32 + r32] = (bf16_t)f2bf(o[d0][r] * rli[r]); }
        asm volatile("s_waitcnt lgkmcnt(0)" ::: "memory");
        bf16_t* Ow = Y + (size_t)(b * SEQ + t0 + wid * QBLK) * 2048 + 1024 + h * 128;
#pragma unroll
        for (int i = 0; i < 8; ++i) { const int row = i * 4 + (lane >> 4), ch = lane & 15; const u32x4 v = *(const u32x4*)(stg + row * 128 + ch * 8); *(u32x4*)(Ow + (size_t)row * 2048 + ch * 8) = v; }
    }
    __syncthreads();
#undef TROW
#undef SLOAD
#undef SWRITE
#undef SWAIT
#undef RESC
#undef WMASK
}
#undef KSWZ
#undef SBAR
}

DEVI void phase_ffnconv(const Args& a, int b, int tid) {
    unsigned char* ws = a.ws;
    const bf16_t* U = (const bf16_t*)(ws + WS_U); bf16_t* ACT = (bf16_t*)(ws + WS_ACT) + (size_t)b * SEQ * DFF;
    const float* cw = a.in[20]; const float* cb = a.in[21];
    const long total = (long)SEQ * (DFF / 8);
    for (long i = (long)blockIdx.x * 512 + tid; i < total; i += (long)gridDim.x * 512) {
        const int row = (int)(i / (DFF / 8)), f0 = (int)(i % (DFF / 8)) * 8;
        const int pn = f0 >> 7, j = f0 & 127, gc = 256 * pn + j, vc = gc + 128;
        float ug[8], uv[8];
#pragma unroll
        for (int q = 0; q < 8; ++q) { ug[q] = cb[f0 + q]; uv[q] = cb[DFF + f0 + q]; }
#pragma unroll
        for (int jt = 0; jt < 3; ++jt) {
            const int rr = row + jt - 1;
            if (rr >= 0 && rr < SEQ) {
                const u32x4 g = *(const u32x4*)(U + (size_t)rr * NUP + gc), v = *(const u32x4*)(U + (size_t)rr * NUP + vc);
                const f32x4 wg0 = *(const f32x4*)(cw + jt * NUP + f0), wg1 = *(const f32x4*)(cw + jt * NUP + f0 + 4);
                const f32x4 wv0 = *(const f32x4*)(cw + jt * NUP + DFF + f0), wv1 = *(const f32x4*)(cw + jt * NUP + DFF + f0 + 4);
#pragma unroll
                for (int q = 0; q < 4; ++q) {
                    const float wgl = q < 2 ? wg0[2 * q] : wg1[2 * q - 4], wgh = q < 2 ? wg0[2 * q + 1] : wg1[2 * q - 3];
                    const float wvl = q < 2 ? wv0[2 * q] : wv1[2 * q - 4], wvh = q < 2 ? wv0[2 * q + 1] : wv1[2 * q - 3];
                    ug[2 * q] += bflo(g[q]) * wgl; ug[2 * q + 1] += bfhi(g[q]) * wgh;
                    uv[2 * q] += bflo(v[q]) * wvl; uv[2 * q + 1] += bfhi(v[q]) * wvh;
                }
            }
        }
        u32x4 o;
        o.x = pk2(siluf(ug[0]) * uv[0], siluf(ug[1]) * uv[1]); o.y = pk2(siluf(ug[2]) * uv[2], siluf(ug[3]) * uv[3]);
        o.z = pk2(siluf(ug[4]) * uv[4], siluf(ug[5]) * uv[5]); o.w = pk2(siluf(ug[6]) * uv[6], siluf(ug[7]) * uv[7]);
        *(u32x4*)(ACT + (size_t)row * DFF + f0) = o;
    }
}


#define XB_TMO      128
#define XB_XCNT(j)  (256  + 64 * (j))
#define XB_XSUB(j)  (1280 + 64 * (j))
#define XB_XGEN(j)  (2304 + 64 * (j))
#define XB_TOP      3328
#define XB_TOPGEN   3392
#define XCD_BAR_WORDS 3456
#define XB_SPIN_CAP (1u << 18)
__device__ __forceinline__ unsigned xb_ld(unsigned* p)              { return __hip_atomic_load(p, __ATOMIC_RELAXED, __HIP_MEMORY_SCOPE_AGENT); }
__device__ __forceinline__ unsigned xb_add(unsigned* p, unsigned v) { return __hip_atomic_fetch_add(p, v, __ATOMIC_RELAXED, __HIP_MEMORY_SCOPE_AGENT); }
__device__ __forceinline__ unsigned xb_xcc_id() { return (unsigned)__builtin_amdgcn_s_getreg((3 << 11) | 20) & 0xFu; }
#define XB_SPIN(cond, bar) do { unsigned _sp = 0; while (cond) { __builtin_amdgcn_s_sleep(1); \
    if ((++_sp & 255u) == 0u) { if (xb_ld(&(bar)[XB_TMO])) break; if (_sp > XB_SPIN_CAP) { atomicAdd(&(bar)[XB_TMO], 1u); break; } } } } while (0)
struct XcdBarrier { unsigned* bar; unsigned x; volatile LAS unsigned* st; };
__device__ __forceinline__ XcdBarrier xcd_barrier_post(unsigned* bar, volatile LAS unsigned* st) {
    XcdBarrier b; b.bar = bar; b.x = xb_xcc_id(); b.st = st;
    if (threadIdx.x == 0) (void)xb_add(&bar[XB_XCNT(b.x)], 1u);
    return b;
}
__device__ __forceinline__ void xcd_barrier_complete(unsigned* bar, unsigned x, unsigned& nloc, unsigned& nx) {
    const unsigned G = gridDim.x * gridDim.y * gridDim.z;
    unsigned sum, cnt, mine, sp = 0u;
    for (;;) {
        sum = 0u; cnt = 0u; mine = 0u;
#pragma unroll
        for (unsigned j = 0; j < 16; ++j) { const unsigned c = xb_ld(&bar[XB_XCNT(j)]); sum += c; cnt += (c > 0u) ? 1u : 0u; mine = (j == x) ? c : mine; }
        if (sum == G) break;
        __builtin_amdgcn_s_sleep(1);
        if ((++sp & 255u) == 0u) { if (xb_ld(&bar[XB_TMO])) break; if (sp > XB_SPIN_CAP) { atomicAdd(&bar[XB_TMO], 1u); break; } }
    }
    nloc = mine > 0u ? mine : 1u; nx = cnt > 0u ? cnt : 1u;
}
__device__ __forceinline__ void xcd_barrier(const XcdBarrier& b) {
    asm volatile("s_waitcnt vmcnt(0)" ::: "memory");
    __syncthreads();
    if (threadIdx.x == 0) {
        unsigned* bar = b.bar;
        __builtin_amdgcn_s_waitcnt(0);
        unsigned nloc = b.st[0], nx = b.st[1];
        if (nloc == 0u) { xcd_barrier_complete(bar, b.x, nloc, nx); b.st[0] = nloc; b.st[1] = nx; }
        const unsigned old = xb_add(&bar[XB_XSUB(b.x)], 1u);
        const unsigned gen = old / nloc;
        if (old + 1u == (gen + 1u) * nloc) {
            __builtin_amdgcn_fence(__ATOMIC_RELEASE, "agent");
            asm volatile("s_waitcnt vmcnt(0)" ::: "memory");
            const unsigned og = xb_add(&bar[XB_TOP], 1u);
            const unsigned tg = og / nx;
            if (og + 1u == (tg + 1u) * nx) xb_add(&bar[XB_TOPGEN], 1u);
            else XB_SPIN(xb_ld(&bar[XB_TOPGEN]) == tg, bar);
            __builtin_amdgcn_fence(__ATOMIC_ACQUIRE, "agent");
            xb_add(&bar[XB_XGEN(b.x)], 1u);
            asm volatile("s_waitcnt vmcnt(0)" ::: "memory");
        } else {
            XB_SPIN(xb_ld(&bar[XB_XGEN(b.x)]) == gen, bar);
            __builtin_amdgcn_fence(__ATOMIC_ACQUIRE, "agent");
            asm volatile("s_waitcnt vmcnt(0)" ::: "memory");
        }
    }
    __syncthreads();
}

constexpr int NPHASE = 16;
__global__ void __launch_bounds__(512, 2) mega(Args a) {
    extern __shared__ __attribute__((aligned(16))) unsigned char lds_raw[];
    LAS unsigned char* lds = (LAS unsigned char*)lds_raw;
    const int tid = threadIdx.x, lane = tid & 63, wave = __builtin_amdgcn_readfirstlane(tid >> 6);
    unsigned char* ws = a.ws;
    const int lo = a.ph_lo, hi = a.ph_hi;
#define IN(k) (lo <= (k) && (k) < hi)
#if MK_ONE_LAUNCH
    volatile LAS unsigned* bst = (volatile LAS unsigned*)(lds + 147440);
    if (tid < 4) bst[tid] = 0u;
    __syncthreads();
    const XcdBarrier gbar = xcd_barrier_post((unsigned*)(ws + WS_CTL), bst);
#define SEAM(k) do { if (IN(k) && IN((k) + 1)) xcd_barrier(gbar); } while (0)
#else
#define SEAM(k) do { } while (0)
#endif
    const float* modacc = (const float*)(ws + CTL_MODACC);
    unsigned long long pr_prev = PROBE_MASK ? __builtin_amdgcn_s_memrealtime() : 0ull, pr_acc = 0ull;
#define STAMP(k) do { if (PROBE_MASK) { const unsigned long long now_ = __builtin_amdgcn_s_memrealtime(); if ((PROBE_MASK >> (k)) & 1u) pr_acc += now_ - pr_prev; pr_prev = now_; } } while (0)
    if (IN(0)) { phase0(a, lds, tid, lane, wave); } SEAM(0); STAMP(0);
    if (IN(1)) { phase1(a, tid, lane, wave); } SEAM(1); STAMP(1);
    if (IN(2)) {
        pg8::Gemm g{(const bf16_t*)(ws + WS_XN), (const bf16_t*)(ws + WS_WINA), MT, NA, 1024}; pg8::StaticOrder S; S.init(MT, NA, gridDim.x, blockIdx.x);
        EpiIn E{(const float*)(ws + SM_ROWSS1), (const float*)(ws + SM_SHWA), 0, (bf16_t*)(ws + WS_QKVR), nullptr, nullptr, nullptr, nullptr, (float*)(ws + WS_BA)};
        pg8::gemm_phase<EpiIn, pg8::StaticOrder, true, true>(lds, g, S, E);
    } SEAM(2); STAMP(2);
    if (IN(3)) { phase_dnprep(a, tid); } SEAM(3); STAMP(3);
    if (IN(4)) { phase_dnchunk(a, lds, tid, lane, wave); } SEAM(4); STAMP(4);
    if (IN(5)) { phase_dnscan2(a, lds, tid, lane, wave, pr_acc); } SEAM(5); STAMP(5);
    if (IN(6)) {
        pg8::Gemm g{(const bf16_t*)(ws + WS_XN), (const bf16_t*)(ws + WS_WINC), MT, NC, 1024}; pg8::StaticOrder S; S.init(MT, NC, gridDim.x, blockIdx.x);
        EpiIn E{(const float*)(ws + SM_ROWSS1), (const float*)(ws + SM_SHWA) + NA, 1, (bf16_t*)(ws + WS_GT), (bf16_t*)(ws + WS_QAT), (bf16_t*)(ws + WS_KAT), (bf16_t*)(ws + WS_VAT), (bf16_t*)(ws + WS_MG), nullptr};
        pg8::gemm_phase<EpiIn, pg8::StaticOrder, true, true>(lds, g, S, E);
    } SEAM(6); STAMP(6);
    if (IN(7)) { phase_prep2(a, lane, wave); } SEAM(7); STAMP(7);
    if (IN(8)) {
#pragma unroll 1
        for (int k = 0; k < 1024; ++k) {
            const int idx = 4 * ((int)blockIdx.x + (int)gridDim.x * (k >> 2)) + (k & 3); if (idx >= 1024) break;
            const int g = idx & 3, qb = (idx >> 2) & 63, kvh = (idx >> 8) & 1, b = idx >> 9;
            att::attn_unit(a, b, kvh * 4 + g, qb, (char*)lds_raw); }
    } SEAM(8); STAMP(8);
    if (IN(9)) {
        pg8::Gemm g{(const bf16_t*)(ws + WS_Y), (const bf16_t*)(ws + WS_WBR), ML, 1024, 2048}; pg8::StaticOrder S; S.init(ML, 1024, gridDim.x, blockIdx.x);
        EpiBr E{(const bf16_t*)(ws + WS_MG), (bf16_t*)(ws + WS_MERGED)};
        pg8::gemm_phase<EpiBr, pg8::StaticOrder, true, true>(lds, g, S, E);
    } SEAM(9); STAMP(9);
    if (IN(10)) {
        pg8::Gemm g{(const bf16_t*)(ws + WS_MERGED), (const bf16_t*)(ws + WS_WOUT), ML, 1024, 1024}; pg8::StaticOrder S; S.init(ML, 1024, gridDim.x, blockIdx.x);
        EpiOut E{a.in[0], modacc, a.in[5], a.in[7], a.out, (bf16_t*)(ws + WS_X1S), (float*)(ws + CTL_ROWSS2)};
        pg8::gemm_phase<EpiOut, pg8::StaticOrder, true, true>(lds, g, S, E);
    } SEAM(10); STAMP(10);
#define FFN_UP(PH, BB) if (IN(PH)) { \
        pg8::Gemm g{(const bf16_t*)(ws + WS_X1S) + (size_t)(BB) * SEQ * 1024, (const bf16_t*)(ws + WS_WUP), SEQ, NUP, 1024}; pg8::StaticOrder S; S.init(SEQ, NUP, gridDim.x, blockIdx.x); \
        EpiUp E{(const float*)(ws + CTL_ROWSS2) + (BB) * SEQ, (const float*)(ws + SM_SHWF) + (BB) * NUP, (bf16_t*)(ws + WS_U)}; \
        pg8::gemm_phase<EpiUp, pg8::StaticOrder, true, true>(lds, g, S, E); }
    FFN_UP(11, 0) SEAM(11); STAMP(11);
    if (IN(12)) { phase_ffnconv(a, 0, tid); } SEAM(12); STAMP(12);
    FFN_UP(13, 1) SEAM(13); STAMP(13);
    if (IN(14)) { phase_ffnconv(a, 1, tid); } SEAM(14); STAMP(14);
#undef FFN_UP
    if (IN(15)) {
        pg8::Gemm g{(const bf16_t*)(ws + WS_ACT), (const bf16_t*)(ws + WS_WDN), ML, 1024, DFF}; pg8::StaticOrder S; S.init(ML, 1024, gridDim.x, blockIdx.x);
        EpiDown E{modacc, a.in[5], a.out};
        pg8::gemm_phase<EpiDown, pg8::StaticOrder, true, true>(lds, g, S, E);
    }
    STAMP(15);
    if ((PROBE_MASK || PROBE_SUB) && blockIdx.x == 0) { const unsigned long long t0_ = __builtin_amdgcn_s_memrealtime(); while (__builtin_amdgcn_s_memrealtime() - t0_ < pr_acc) __builtin_amdgcn_s_sleep(8); }
#undef STAMP
#undef IN
#undef SEAM
}

extern "C" void kernel_launch(void* const* d_in, const int* in_sizes, int n_in, void* d_out, int out_size, void* d_ws, size_t ws_size, hipStream_t stream) {
    static int grid = 0;
    if (grid == 0) {
        if (n_in != 23 || in_sizes[0] != ML * DM || out_size != ML * DM || ws_size < WS_END) {
            fprintf(stderr, "kernel_launch: unexpected shapes n_in %d in0 %d out %d ws %zu (need %zu)\n", n_in, n_in > 0 ? in_sizes[0] : -1, out_size, ws_size, (size_t)WS_END); grid = -1; return; }
        int dev = 0, cus = 0, per_cu = 0;
        hipGetDevice(&dev); hipDeviceGetAttribute(&cus, hipDeviceAttributeMultiprocessorCount, dev);
        if (hipFuncSetAttribute((const void*)mega, hipFuncAttributeMaxDynamicSharedMemorySize, LDS_BYTES) != hipSuccess) { fprintf(stderr, "kernel_launch: hipFuncSetAttribute failed\n"); grid = -1; return; }
        hipOccupancyMaxActiveBlocksPerMultiprocessor(&per_cu, (const void*)mega, 512, LDS_BYTES);
        (void)hipGetLastError();
        if (per_cu < 1) { fprintf(stderr, "kernel_launch: occupancy query says %d blocks per CU\n", per_cu); per_cu = 1; }
        grid = cus;
    }
    if (grid < 0) return;
    hipMemsetAsync((char*)d_ws + WS_CTL, 0, CTL_ZERO_BYTES, stream);
    Args a{};
    for (int i = 0; i < 23; ++i) a.in[i] = (const float*)d_in[i];
    a.out = (float*)d_out; a.ws = (unsigned char*)d_ws;
#if MK_ONE_LAUNCH
    a.ph_lo = 0; a.ph_hi = NPHASE;
    void* args[] = {&a};
    hipError_t e = hipLaunchCooperativeKernel((const void*)mega, dim3(grid), dim3(512), args, LDS_BYTES, stream);
    if (e != hipSuccess) fprintf(stderr, "cooperative launch failed: %s (grid %d)\n", hipGetErrorString(e), grid);
#else
    for (int p = 0; p < NPHASE; ++p) {
        a.ph_lo = p; a.ph_hi = p + 1;
        hipLaunchKernelGGL(mega, dim3(grid), dim3(512), LDS_BYTES, stream, a);
    }
    hipError_t e = hipPeekAtLastError();
    if (e != hipSuccess) fprintf(stderr, "launch failed: %s\n", hipGetErrorString(e));
#endif
}
```

```cpp
#include <hip/hip_runtime.h>
#include <hip/hip_cooperative_groups.h>
#include <cstdio>
#include <cstdint>
namespace cg = cooperative_groups;

#ifndef PROBE_MASK
#define PROBE_MASK 0u
#endif
#ifndef PROBE_SUB
#define PROBE_SUB 0
#endif
#ifndef MK_ONE_LAUNCH
#define MK_ONE_LAUNCH 1
#endif

#define DEVI __device__ __forceinline__
#define LAS __attribute__((address_space(3)))
typedef unsigned short bf16_t;
typedef short bf16x8 __attribute__((ext_vector_type(8)));
typedef float f32x4 __attribute__((ext_vector_type(4)));
typedef float f32x2 __attribute__((ext_vector_type(2)));
typedef float f32x16 __attribute__((ext_vector_type(16)));
typedef unsigned u32x4 __attribute__((ext_vector_type(4)));
typedef unsigned u32x2 __attribute__((ext_vector_type(2)));
typedef short s16x4 __attribute__((ext_vector_type(4)));

constexpr int BATCH = 2, SEQ = 16384, DM = 1024, CTX = 256;
constexpr int ML = BATCH * SEQ;
constexpr int MC = BATCH * CTX;
constexpr int MT = ML + MC;
constexpr int NA = 3328;
constexpr int NC = 4608;
constexpr int NSH = NA + NC;
constexpr int DFF = 2816, NUP = 5632;
constexpr float EPS = 1e-6f;

constexpr size_t MiB = 1u << 20;
constexpr size_t WS_CTL = 0, CTL_ZERO_BYTES = 1 * MiB;
constexpr size_t CTL_PROG = 32 * 1024;
constexpr size_t CTL_MODACC = 64 * 1024;
constexpr size_t CTL_ROWSS2 = 256 * 1024;
constexpr size_t WS_SMALL = 1 * MiB;
constexpr size_t SM_ROWSS1 = WS_SMALL;
constexpr size_t SM_SHWA = WS_SMALL + 256 * 1024;
constexpr size_t SM_SHWF = WS_SMALL + 384 * 1024;
constexpr size_t SM_ROPE = WS_SMALL + 512 * 1024;
constexpr size_t WS_BA = 2 * MiB;
constexpr size_t WS_G = 7 * MiB;
constexpr size_t WS_BETA = 10 * MiB;
constexpr size_t WS_WINA = 13 * MiB, WS_WINC = 20 * MiB, WS_WBR = 29 * MiB, WS_WOUT = 33 * MiB, WS_WUP = 35 * MiB, WS_WDN = 46 * MiB;
constexpr size_t WS_XN = 52 * MiB;
constexpr size_t WS_QKVR = 117 * MiB;
constexpr size_t WS_QKVP = 312 * MiB;
constexpr size_t WS_MG = 180 * MiB;
constexpr size_t WS_GT = 310 * MiB;
constexpr size_t WS_QAT = 375 * MiB;
constexpr size_t WS_KAT = 440 * MiB;
constexpr size_t WS_VAT = 457 * MiB;
constexpr size_t WS_Y = 52 * MiB;
constexpr size_t WS_MERGED = 375 * MiB;
constexpr size_t WS_X1S = 440 * MiB;
constexpr size_t WS_U = 52 * MiB;
constexpr size_t WS_ACT = 228 * MiB;
constexpr size_t WS_TQ = 117 * MiB;
constexpr size_t WS_AVEC = 248 * MiB;
constexpr size_t WS_END = 512 * MiB;

constexpr int LDS_BYTES = 147456;

DEVI float bf2f(unsigned short h) { return __uint_as_float((unsigned)h << 16); }
DEVI float bflo(unsigned w) { return __uint_as_float(w << 16); }
DEVI float bfhi(unsigned w) { return __uint_as_float(w & 0xffff0000u); }
typedef __bf16 bf16x2_t __attribute__((ext_vector_type(2)));
DEVI unsigned pk2(float lo, float hi) { const f32x2 v = {lo, hi}; const bf16x2_t b = __builtin_convertvector(v, bf16x2_t); return __builtin_bit_cast(unsigned, b); }
DEVI unsigned f2bf(float f) { return pk2(f, 0.f) & 0xffffu; }
DEVI float wave_sum(float v) {
#pragma unroll
    for (int o = 1; o < 64; o <<= 1) v += __shfl_xor(v, o);
    return v;
}
DEVI float siluf(float x) { return x / (1.f + __expf(-x)); }
DEVI float sigmoidf_(float x) { return 1.f / (1.f + __expf(-x)); }

struct Args { const float* in[23]; float* out; unsigned char* ws; int ph_lo, ph_hi; };

namespace pg8 {
constexpr int BM = 256, BK = 64, HALF = 128, HTB = HALF * BK * 2, STAGE_BYTES = 8 * HTB, NXCD = 8, WGM = 8;
__host__ __device__ __forceinline__ int lds_byte(int r, int c) { const int st = (r >> 4) * 2 + (c >> 5), rr = r & 15, cc = c & 31, ob = rr * 64 + cc * 2; return st * 1024 + (ob ^ (((ob >> 9) & 1) << 5)); }
__host__ __device__ __forceinline__ void stage_rc(int b, int& R, int& C) { const int st = b / 1024, sb = b % 1024, swz = sb ^ (((sb >> 9) & 1) << 5); R = (st >> 1) * 16 + swz / 64; C = (st & 1) * 32 + (swz % 64) / 2; }
__host__ __device__ __forceinline__ int perm32(int rho) { const int n = rho >> 4, i = rho & 15; return 8 * (i >> 2) + 4 * n + (i & 3); }
struct Unit { int pm, pn; };
struct Gemm { const bf16_t* A; const bf16_t* Bt; int M, N, K; };
struct StaticOrder {
    int nM, nN, nwg, G, c;
    __device__ void init(int M, int N, int G_, int c_) { nM = M / BM; nN = N / BM; nwg = nM * nN; G = G_; c = c_; }
    __device__ bool next(int i, Unit& u) const {
        const long L = (long)i * G + c; if (L >= nwg) return false;
        int wgid = (int)L; { const int q = nwg / NXCD, r = nwg % NXCD, xcd = wgid % NXCD, off = wgid / NXCD; wgid = (xcd < r ? xcd * (q + 1) : r * (q + 1) + (xcd - r) * q) + off; }
        const int nig = WGM * nN, gid = wgid / nig, fm = gid * WGM, gsz = (nM - fm) < WGM ? (nM - fm) : WGM;
        u.pm = fm + ((wgid % nig) % gsz); u.pn = (wgid % nig) / gsz; return true;
    }
};
template <class Epi, class Sched, bool ALIGN_EPI, bool SP2>
__device__ __forceinline__ void gemm_phase(LAS unsigned char* lds, const Gemm g, const Sched& S, const Epi& E) {
    const int tid = threadIdx.x, wid = __builtin_amdgcn_readfirstlane(tid >> 6), lane = tid & 63, wr = wid >> 2, wc = wid & 3, fr = lane & 15, fq = lane >> 4;
    const int K = g.K, nt = K / BK;
    unsigned voffA[2], voffB[2];
#pragma unroll
    for (int i = 0; i < 2; ++i) { int R, C; stage_rc(tid * 16 + i * 8192, R, C); const int Rb = Epi::PERM ? ((R & ~31) + perm32(R & 31)) : R;
        voffA[i] = (unsigned)(R * K + C) * 2u; voffB[i] = (unsigned)(Rb * K + C) * 2u; }
    const size_t kstep = (size_t)(BK * 2);
    const size_t hstep = (size_t)HALF * K * 2;
    const size_t tstep = 2 * hstep;
    const unsigned ldsw = (unsigned)wid * 1024u;
    const int aoff = lds_byte(wr * 64 + fr, fq * 8), boff = lds_byte(wc * 32 + fr, fq * 8);
#define PG8_SA(b, h) (((b) * 2 + (h)) * HTB)
#define PG8_SB(b, h) ((4 + (b) * 2 + (h)) * HTB)
#define PG8_STAGE(bufoff, gbase, voff) do { _Pragma("unroll") for (int _i = 0; _i < 2; ++_i) \
        __builtin_amdgcn_global_load_lds((const unsigned*)((const char*)(gbase) + (voff)[_i]), (LAS unsigned*)(lds + (bufoff) + ldsw + _i * 8192), 16, 0, 0); } while (0)
#define PG8_LDA(dst, b, h) do { _Pragma("unroll") for (int m = 0; m < 4; ++m) _Pragma("unroll") for (int k = 0; k < 2; ++k) dst[m][k] = *(const LAS bf16x8*)(lds + PG8_SA(b, h) + aoff + m * 2048 + k * 1024); } while (0)
#define PG8_LDB(dst, b, h) do { _Pragma("unroll") for (int n = 0; n < 2; ++n) _Pragma("unroll") for (int k = 0; k < 2; ++k) dst[n][k] = *(const LAS bf16x8*)(lds + PG8_SB(b, h) + boff + n * 2048 + k * 1024); } while (0)
#define PG8_MMA(ai, bj, At, Bt) do { __builtin_amdgcn_s_setprio(1); _Pragma("unroll") for (int m = 0; m < 4; ++m) _Pragma("unroll") for (int n = 0; n < 2; ++n) _Pragma("unroll") for (int k = 0; k < 2; ++k) \
        acc[ai][bj][m][n] = __builtin_amdgcn_mfma_f32_16x16x32_bf16(Bt[n][k], At[m][k], acc[ai][bj][m][n], 0, 0, 0); __builtin_amdgcn_s_setprio(0); } while (0)
#define PG8_WAIT_V(n) asm volatile("s_waitcnt vmcnt(" #n ")" ::: "memory")
#define PG8_WAIT_L(n) asm volatile("s_waitcnt lgkmcnt(" #n ")" ::: "memory")
#define PG8_BAR __builtin_amdgcn_s_barrier()
#define PG8_SCHED __builtin_amdgcn_sched_barrier(0)
    Unit cur, nxt; int ui = 0;
    if (!S.next(0, cur)) return;
    f32x4 acc[2][2][4][2];
#pragma unroll
    for (int a = 0; a < 2; ++a)
#pragma unroll
        for (int b = 0; b < 2; ++b)
#pragma unroll
            for (int m = 0; m < 4; ++m)
#pragma unroll
                for (int n = 0; n < 2; ++n) acc[a][b][m][n] = (f32x4){0.f, 0.f, 0.f, 0.f};
    bf16x8 At[4][2], B0[2][2], B1[2][2];
    const char* cA = (const char*)g.A + (size_t)cur.pm * tstep; const char* cB = (const char*)g.Bt + (size_t)cur.pn * tstep;
    if constexpr (SP2) {
        PG8_STAGE(PG8_SB(0, 0), cB, voffB); PG8_STAGE(PG8_SB(0, 1), cB + hstep, voffB); PG8_STAGE(PG8_SA(0, 0), cA, voffA); PG8_STAGE(PG8_SA(0, 1), cA + hstep, voffA);
        if (wr == 1) PG8_BAR;
        PG8_WAIT_V(2); PG8_BAR;
        PG8_STAGE(PG8_SB(1, 0), cB + kstep, voffB); PG8_STAGE(PG8_SA(1, 0), cA + kstep, voffA); PG8_STAGE(PG8_SB(1, 1), cB + hstep + kstep, voffB);
        PG8_WAIT_V(6); PG8_BAR;
    } else {
        PG8_STAGE(PG8_SB(0, 0), cB, voffB); PG8_STAGE(PG8_SA(0, 0), cA, voffA); PG8_STAGE(PG8_SB(0, 1), cB + hstep, voffB); PG8_STAGE(PG8_SA(0, 1), cA + hstep, voffA);
        if (wr == 1) PG8_BAR;
        PG8_WAIT_V(4); PG8_BAR;
        PG8_STAGE(PG8_SB(1, 0), cB + kstep, voffB); PG8_STAGE(PG8_SA(1, 0), cA + kstep, voffA); PG8_STAGE(PG8_SB(1, 1), cB + hstep + kstep, voffB);
        PG8_WAIT_V(6); PG8_BAR;
    }
    for (;;) {
        const bool has_next = S.next(ui + 1, nxt);
        const char* nA = has_next ? (const char*)g.A + (size_t)nxt.pm * tstep : cA; const char* nB = has_next ? (const char*)g.Bt + (size_t)nxt.pn * tstep : cB;
#pragma unroll 1
        for (int t = 0; t < nt; t += 2) {
            const bool last = (t == nt - 2);
            if constexpr (Epi::MID) { if (t == nt / 2) E.mid(acc, cur, wr, wc, fr, fq); }
            const char* a1 = cA + (size_t)(t + 1) * kstep;
            const char* a2 = last ? nA : cA + (size_t)(t + 2) * kstep; const char* b2 = last ? nB : cB + (size_t)(t + 2) * kstep;
            const char* a3 = a2 + kstep; const char* b3 = b2 + kstep;
            if constexpr (SP2) {
            PG8_LDB(B0, 0, 0); PG8_LDB(B1, 0, 1); PG8_SCHED; PG8_LDA(At, 0, 0); PG8_STAGE(PG8_SA(1, 1), a1 + hstep, voffA);
            PG8_WAIT_V(8); PG8_WAIT_L(0); PG8_BAR; PG8_MMA(0, 0, At, B0); PG8_MMA(0, 1, At, B1); PG8_BAR; PG8_SCHED;
            PG8_LDA(At, 0, 1); PG8_STAGE(PG8_SB(0, 0), b2, voffB); PG8_STAGE(PG8_SB(0, 1), b2 + hstep, voffB); PG8_STAGE(PG8_SA(0, 0), a2, voffA);
            PG8_WAIT_V(8); PG8_WAIT_L(0); PG8_BAR; PG8_MMA(1, 0, At, B0); PG8_MMA(1, 1, At, B1); PG8_BAR; PG8_SCHED;
            PG8_LDB(B0, 1, 0); PG8_LDB(B1, 1, 1); PG8_SCHED; PG8_LDA(At, 1, 0); PG8_STAGE(PG8_SA(0, 1), a2 + hstep, voffA);
            PG8_WAIT_V(8); PG8_WAIT_L(0); PG8_BAR; PG8_MMA(0, 0, At, B0); PG8_MMA(0, 1, At, B1); PG8_BAR; PG8_SCHED;
            PG8_LDA(At, 1, 1); PG8_STAGE(PG8_SB(1, 0), b3, voffB); PG8_STAGE(PG8_SB(1, 1), b3 + hstep, voffB); PG8_STAGE(PG8_SA(1, 0), a3, voffA);
            PG8_WAIT_V(8); PG8_WAIT_L(0); PG8_BAR; PG8_MMA(1, 0, At, B0); PG8_MMA(1, 1, At, B1); PG8_BAR; PG8_SCHED;
            } else {
            PG8_LDB(B0, 0, 0); PG8_SCHED; PG8_LDA(At, 0, 0); PG8_STAGE(PG8_SA(1, 1), a1 + hstep, voffA);
            PG8_WAIT_L(8); PG8_BAR; PG8_WAIT_L(0); PG8_MMA(0, 0, At, B0); PG8_BAR; PG8_SCHED;
            PG8_LDB(B1, 0, 1); PG8_STAGE(PG8_SB(0, 0), b2, voffB);
            PG8_BAR; PG8_WAIT_L(0); PG8_MMA(0, 1, At, B1); PG8_BAR;
            PG8_LDA(At, 0, 1); PG8_STAGE(PG8_SA(0, 0), a2, voffA);
            PG8_BAR; PG8_WAIT_L(0); PG8_MMA(1, 0, At, B0); PG8_BAR; PG8_SCHED;
            PG8_STAGE(PG8_SB(0, 1), b2 + hstep, voffB);
            PG8_WAIT_V(6); PG8_BAR; PG8_MMA(1, 1, At, B1); PG8_BAR;
            PG8_LDB(B0, 1, 0); PG8_SCHED; PG8_LDA(At, 1, 0); PG8_STAGE(PG8_SA(0, 1), a2 + hstep, voffA);
            PG8_WAIT_L(8); PG8_BAR; PG8_WAIT_L(0); PG8_MMA(0, 0, At, B0); PG8_BAR; PG8_SCHED;
            PG8_LDB(B1, 1, 1); PG8_STAGE(PG8_SB(1, 0), b3, voffB);
            PG8_BAR; PG8_WAIT_L(0); PG8_MMA(0, 1, At, B1); PG8_BAR;
            PG8_LDA(At, 1, 1); PG8_STAGE(PG8_SA(1, 0), a3, voffA);
            PG8_BAR; PG8_WAIT_L(0); PG8_MMA(1, 0, At, B0); PG8_BAR; PG8_SCHED;
            PG8_STAGE(PG8_SB(1, 1), b3 + hstep, voffB);
            PG8_WAIT_V(6); PG8_BAR; PG8_MMA(1, 1, At, B1); PG8_BAR;
            }
        }
        if constexpr (ALIGN_EPI) { if (wr == 0) PG8_BAR; }
        E(acc, cur, wr, wc, fr, fq);
        if (!has_next) break;
#pragma unroll
        for (int a = 0; a < 2; ++a)
#pragma unroll
            for (int b = 0; b < 2; ++b)
#pragma unroll
                for (int m = 0; m < 4; ++m)
#pragma unroll
                    for (int n = 0; n < 2; ++n) acc[a][b][m][n] = (f32x4){0.f, 0.f, 0.f, 0.f};
        cur = nxt; cA = nA; cB = nB; ++ui;
        if constexpr (ALIGN_EPI) { if (wr == 1) PG8_BAR; }
    }
    PG8_WAIT_V(0);
    if constexpr (!ALIGN_EPI) { if (wr == 0) PG8_BAR; }
    PG8_BAR;
#undef PG8_SA
#undef PG8_SB
#undef PG8_STAGE
#undef PG8_LDA
#undef PG8_LDB
#undef PG8_MMA
#undef PG8_WAIT_V
#undef PG8_WAIT_L
#undef PG8_BAR
#undef PG8_SCHED
}
}
using pg8::HALF;

DEVI u32x4 pack8(const f32x4& a, const f32x4& b) { u32x4 w; w.x = pk2(a[0], a[1]); w.y = pk2(a[2], a[3]); w.z = pk2(b[0], b[1]); w.w = pk2(b[2], b[3]); return w; }

struct EpiIn {
    static constexpr bool PERM = true, MID = false;
    const float* rowss; const float* shW; int job;
    bf16_t *d0, *d1, *d2, *d3, *d4; float* ba;
    DEVI void operator()(const f32x4 (&acc)[2][2][4][2], const pg8::Unit& u, int wr, int wc, int fr, int fq) const {
        asm volatile("" : "+v"(fr), "+v"(fq));
        const int vs = u.pm < 64 ? 0 : (u.pm < 128 ? 1 : 2);
        bf16_t* base; int pitch, colt; bool isba = false;
        if (job == 0) { base = d0; pitch = 3072; colt = u.pn * 256; if (u.pn >= 12) isba = true; }
        else {
            if (u.pn < 4) { base = d0; pitch = 1024; colt = u.pn * 256; }
            else if (u.pn < 8) { base = d1; pitch = 1024; colt = (u.pn - 4) * 256; }
            else if (u.pn == 8) { base = d2; pitch = 256; colt = 0; }
            else if (u.pn == 9) { base = d3; pitch = 256; colt = 0; }
            else { base = d4; pitch = 2048; colt = (u.pn - 10) * 256; }
        }
        const int ncol0 = u.pn * 256 + wc * 32 + 8 * fq;
        f32x4 sv[2][2];
#pragma unroll
        for (int bj = 0; bj < 2; ++bj)
#pragma unroll
            for (int n = 0; n < 2; ++n) sv[bj][n] = *(const f32x4*)(shW + vs * NSH + ncol0 + bj * HALF + 4 * n);
        const int row0 = u.pm * 256 + wr * 64 + fr;
#pragma unroll
        for (int ai = 0; ai < 2; ++ai)
#pragma unroll
            for (int m = 0; m < 4; ++m) {
                const int row = row0 + ai * HALF + m * 16;
                const float rs = rsqrtf(rowss[row] * (1.f / 1024.f) + EPS);
                if (!isba) {
                    bf16_t* rowp = base + (size_t)row * pitch + colt + wc * 32 + 8 * fq;
#pragma unroll
                    for (int bj = 0; bj < 2; ++bj) { const f32x4 v0 = acc[ai][bj][m][0] * rs + sv[bj][0], v1 = acc[ai][bj][m][1] * rs + sv[bj][1]; *(u32x4*)(rowp + bj * HALF) = pack8(v0, v1); }
                } else if (wc == 0) {
                    float* rowp = ba + (size_t)row * 32 + 8 * fq;
                    *(f32x4*)(rowp) = acc[ai][0][m][0] * rs + sv[0][0]; *(f32x4*)(rowp + 4) = acc[ai][0][m][1] * rs + sv[0][1];
                }
            }
    }
};
struct EpiBr {
    static constexpr bool PERM = true, MID = true;
    const bf16_t* mg; bf16_t* out;
    DEVI void mid(f32x4 (&acc)[2][2][4][2], const pg8::Unit& u, int wr, int wc, int fr, int fq) const {
        asm volatile("" : "+v"(fr), "+v"(fq));
        const int row0 = u.pm * 256 + wr * 64 + fr, col0 = u.pn * 256 + wc * 32 + 8 * fq;
#pragma unroll
        for (int ai = 0; ai < 2; ++ai)
#pragma unroll
            for (int m = 0; m < 4; ++m) {
                const bf16_t* rp = mg + (size_t)(row0 + ai * HALF + m * 16) * 2048 + col0;
#pragma unroll
                for (int bj = 0; bj < 2; ++bj) {
                    const u32x4 gd = *(const u32x4*)(rp + bj * HALF), ga = *(const u32x4*)(rp + 1024 + bj * HALF);
                    float r[8];
#pragma unroll
                    for (int i = 0; i < 4; ++i) {
                        const float d0 = bflo(gd[i]), d1 = bfhi(gd[i]), a0 = bflo(ga[i]), a1 = bfhi(ga[i]);
                        r[2 * i] = (1.f + __expf(fminf(-a0, 80.f))) * __builtin_amdgcn_rcpf(1.f + __expf(fminf(-d0, 80.f)));
                        r[2 * i + 1] = (1.f + __expf(fminf(-a1, 80.f))) * __builtin_amdgcn_rcpf(1.f + __expf(fminf(-d1, 80.f)));
                    }
                    acc[ai][bj][m][0] *= (f32x4){r[0], r[1], r[2], r[3]}; acc[ai][bj][m][1] *= (f32x4){r[4], r[5], r[6], r[7]};
                    asm volatile("" ::: "memory");
                }
            }
    }
    DEVI void operator()(const f32x4 (&acc)[2][2][4][2], const pg8::Unit& u, int wr, int wc, int fr, int fq) const {
        asm volatile("" : "+v"(fr), "+v"(fq));
        const int row0 = u.pm * 256 + wr * 64 + fr, col0 = u.pn * 256 + wc * 32 + 8 * fq;
#pragma unroll
        for (int ai = 0; ai < 2; ++ai)
#pragma unroll
            for (int m = 0; m < 4; ++m) {
                const size_t row = (size_t)(row0 + ai * HALF + m * 16);
                const bf16_t* rp = mg + row * 2048 + 1024 + col0;
#pragma unroll
                for (int bj = 0; bj < 2; ++bj) {
                    const u32x4 ga = *(const u32x4*)(rp + bj * HALF);
                    float s[8];
#pragma unroll
                    for (int i = 0; i < 4; ++i) { s[2 * i] = __builtin_amdgcn_rcpf(1.f + __expf(fminf(-bflo(ga[i]), 80.f))); s[2 * i + 1] = __builtin_amdgcn_rcpf(1.f + __expf(fminf(-bfhi(ga[i]), 80.f))); }
                    const f32x4 v0 = acc[ai][bj][m][0] * (f32x4){s[0], s[1], s[2], s[3]}, v1 = acc[ai][bj][m][1] * (f32x4){s[4], s[5], s[6], s[7]};
                    *(u32x4*)(out + row * 1024 + col0 + bj * HALF) = pack8(v0, v1);
                }
            }
    }
};
struct EpiOut {
    static constexpr bool PERM = false, MID = false;
    const float* x; const float* modacc; const float* bada; const float* nwf; float* out; bf16_t* x1s; float* rowss2;
    DEVI void operator()(const f32x4 (&acc)[2][2][4][2], const pg8::Unit& u, int wr, int wc, int fr, int fq) const {
        asm volatile("" : "+v"(fr), "+v"(fq));
        const int b = u.pm >> 6; const int row0 = u.pm * 256 + wr * 64 + fr, col0 = u.pn * 256 + wc * 32 + 4 * fq;
        f32x4 ga[2][2], sc[2][2];
#pragma unroll
        for (int bj = 0; bj < 2; ++bj)
#pragma unroll
            for (int n = 0; n < 2; ++n) { const int c = col0 + bj * HALF + n * 16;
                ga[bj][n] = *(const f32x4*)(modacc + b * 6144 + 2048 + c) + *(const f32x4*)(bada + 2048 + c);
                sc[bj][n] = (*(const f32x4*)(modacc + b * 6144 + 4096 + c) + *(const f32x4*)(bada + 4096 + c) + 1.f) * *(const f32x4*)(nwf + c); }
#pragma unroll
        for (int ai = 0; ai < 2; ++ai)
#pragma unroll
            for (int m = 0; m < 4; ++m) {
                const size_t off = (size_t)(row0 + ai * HALF + m * 16) * 1024 + col0; float ss = 0.f;
#pragma unroll
                for (int bj = 0; bj < 2; ++bj)
#pragma unroll
                    for (int n = 0; n < 2; ++n) {
                        const f32x4 xv = *(const f32x4*)(x + off + bj * HALF + n * 16);
                        const f32x4 o = xv + ga[bj][n] * acc[ai][bj][m][n];
                        *(f32x4*)(out + off + bj * HALF + n * 16) = o;
                        ss += (o[0] * o[0] + o[1] * o[1]) + (o[2] * o[2] + o[3] * o[3]);
                        const f32x4 s = o * sc[bj][n]; u32x2 w; w.x = pk2(s[0], s[1]); w.y = pk2(s[2], s[3]);
                        *(u32x2*)(x1s + off + bj * HALF + n * 16) = w;
                    }
                ss += __shfl_xor(ss, 16); ss += __shfl_xor(ss, 32);
                if (fq == 0) atomicAdd(rowss2 + row0 + ai * HALF + m * 16, ss);
            }
    }
};
struct EpiUp {
    static constexpr bool PERM = true, MID = false;
    const float* rowss2; const float* shWf; bf16_t* u_;
    DEVI void operator()(const f32x4 (&acc)[2][2][4][2], const pg8::Unit& u, int wr, int wc, int fr, int fq) const {
        asm volatile("" : "+v"(fr), "+v"(fq));
        const int row0 = u.pm * 256 + wr * 64 + fr, col0 = u.pn * 256 + wc * 32 + 8 * fq;
#pragma unroll
        for (int bj = 0; bj < 2; ++bj) {
            const f32x4 sv0 = *(const f32x4*)(shWf + col0 + bj * HALF), sv1 = *(const f32x4*)(shWf + col0 + bj * HALF + 4);
#pragma unroll
            for (int ai = 0; ai < 2; ++ai)
#pragma unroll
                for (int m = 0; m < 4; ++m) {
                    const int row = row0 + ai * HALF + m * 16;
                    const float rs = rsqrtf(rowss2[row] * (1.f / 1024.f) + EPS);
                    const f32x4 v0 = acc[ai][bj][m][0] * rs + sv0, v1 = acc[ai][bj][m][1] * rs + sv1;
                    *(u32x4*)(u_ + (size_t)row * NUP + col0 + bj * HALF) = pack8(v0, v1);
                }
        }
    }
};
struct EpiDown {
    static constexpr bool PERM = false, MID = false;
    const float* modacc; const float* bada; float* out;
    DEVI void operator()(const f32x4 (&acc)[2][2][4][2], const pg8::Unit& u, int wr, int wc, int fr, int fq) const {
        asm volatile("" : "+v"(fr), "+v"(fq));
        const int b = u.pm >> 6; const int row0 = u.pm * 256 + wr * 64 + fr, col0 = u.pn * 256 + wc * 32 + 4 * fq;
        f32x4 gf[2][2];
#pragma unroll
        for (int bj = 0; bj < 2; ++bj)
#pragma unroll
            for (int n = 0; n < 2; ++n) { const int c = col0 + bj * HALF + n * 16; gf[bj][n] = *(const f32x4*)(modacc + b * 6144 + 5120 + c) + *(const f32x4*)(bada + 5120 + c); }
#pragma unroll
        for (int ai = 0; ai < 2; ++ai)
#pragma unroll
            for (int m = 0; m < 4; ++m) {
                const size_t off = (size_t)(row0 + ai * HALF + m * 16) * 1024 + col0;
#pragma unroll
                for (int bj = 0; bj < 2; ++bj)
#pragma unroll
                    for (int n = 0; n < 2; ++n) { float* p = out + off + bj * HALF + n * 16; *(f32x4*)p = *(const f32x4*)p + gf[bj][n] * acc[ai][bj][m][n]; }
            }
    }
};

DEVI void transpose_item(const float* W, int srcN, int k0, int n0, bf16_t* dst  , int dstK, LAS float* scr, int lane) {
#pragma unroll 8
    for (int i = 0; i < 32; ++i) { const int kk = 2 * i + (lane >> 5); scr[kk * 33 + (lane & 31)] = W[(size_t)(k0 + kk) * srcN + n0 + (lane & 31)]; }
    asm volatile("s_waitcnt lgkmcnt(0)" ::: "memory");
    const int c = lane & 7;
#pragma unroll
    for (int j = 0; j < 4; ++j) { const int n = (lane >> 3) + 8 * j; const LAS float* s = scr + (8 * c) * 33 + n;
        u32x4 o; o.x = pk2(s[0 * 33], s[1 * 33]); o.y = pk2(s[2 * 33], s[3 * 33]); o.z = pk2(s[4 * 33], s[5 * 33]); o.w = pk2(s[6 * 33], s[7 * 33]);
        *(u32x4*)(dst + (size_t)n * dstK + 8 * c) = o; }
    asm volatile("s_waitcnt lgkmcnt(0)" ::: "memory");
}
DEVI void phase0(const Args& a, LAS unsigned char* lds, int tid, int lane, int wave) {
    unsigned char* ws = a.ws;
    bf16_t* WinA = (bf16_t*)(ws + WS_WINA); bf16_t* WinC = (bf16_t*)(ws + WS_WINC); bf16_t* Wbr = (bf16_t*)(ws + WS_WBR);
    bf16_t* Wout = (bf16_t*)(ws + WS_WOUT); bf16_t* Wup = (bf16_t*)(ws + WS_WUP); bf16_t* Wdn = (bf16_t*)(ws + WS_WDN);
    LAS float* scr = (LAS float*)(lds + wave * 16384);
    const int gw = blockIdx.x * 8 + wave, NGW = gridDim.x * 8;
    constexpr int I_IN = 16 * 241, I_BR = 16 * 32, I_UP = 16 * 176, I_DN = 44 * 32;
    constexpr int NITEMS = I_IN + 3 * I_BR + I_UP + I_DN;
    for (int it = gw; it < NITEMS; it += NGW) {
        int r = it;
        if (r < I_IN) { const int kb = r / 241, nb = r % 241, c0 = nb * 32; bf16_t* d; int row;
            if (c0 < 3072) { d = WinA; row = c0; } else if (c0 < 4096) { d = WinC; row = c0 - 3072; } else if (c0 == 4096) { d = WinA; row = 3072; }
            else if (c0 < 5152) { d = WinC; row = 1024 + (c0 - 4128); } else if (c0 < 5408) { d = WinC; row = 2048 + (c0 - 5152); }
            else if (c0 < 5664) { d = WinC; row = 2304 + (c0 - 5408); } else { d = WinC; row = 2560 + (c0 - 5664); }
            transpose_item(a.in[8], 7712, kb * 64, c0, d + (size_t)row * 1024 + kb * 64, 1024, scr, lane); continue; }
        r -= I_IN;
        if (r < I_BR) { const int kb = r / 32, nb = r % 32; transpose_item(a.in[16], 1024, kb * 64, nb * 32, Wbr + (size_t)(nb * 32) * 2048 + kb * 64, 2048, scr, lane); continue; }
        r -= I_BR;
        if (r < I_BR) { const int kb = r / 32, nb = r % 32; transpose_item(a.in[17], 1024, kb * 64, nb * 32, Wbr + (size_t)(nb * 32) * 2048 + 1024 + kb * 64, 2048, scr, lane); continue; }
        r -= I_BR;
        if (r < I_BR) { const int kb = r / 32, nb = r % 32; transpose_item(a.in[18], 1024, kb * 64, nb * 32, Wout + (size_t)(nb * 32) * 1024 + kb * 64, 1024, scr, lane); continue; }
        r -= I_BR;
        if (r < I_UP) { const int kb = r / 176, nb = r % 176, c0 = nb * 32; int row;
            if (c0 < DFF) row = 256 * (c0 / 128) + (c0 % 128); else { const int c1 = c0 - DFF; row = 256 * (c1 / 128) + 128 + (c1 % 128); }
            transpose_item(a.in[19], NUP, kb * 64, c0, Wup + (size_t)row * 1024 + kb * 64, 1024, scr, lane); continue; }
        r -= I_UP;
        { const int kb = r / 32, nb = r % 32; transpose_item(a.in[22], 1024, kb * 64, nb * 32, Wdn + (size_t)(nb * 32) * DFF + kb * 64, DFF, scr, lane); }
    }
    float* modacc = (float*)(ws + CTL_MODACC);
    for (int it = blockIdx.x; it < 12 * 16; it += gridDim.x) {
        const int cb = it % 12, ks = it / 12, n = cb * 512 + tid;
        float a0 = 0.f, a1 = 0.f, a2 = 0.f;
#pragma unroll 8
        for (int k = ks * 64; k < ks * 64 + 64; ++k) {
            const float w = a.in[4][(size_t)k * 6144 + n];
            a0 += siluf(a.in[1][k]) * w; a1 += siluf(a.in[1][1024 + k]) * w; a2 += siluf(a.in[3][k]) * w;
        }
        atomicAdd(modacc + n, a0); atomicAdd(modacc + 6144 + n, a1); atomicAdd(modacc + 12288 + n, a2);
    }
    float* rope = (float*)(ws + SM_ROPE);
    for (int i = blockIdx.x * 512 + tid; i < 320 * 32; i += gridDim.x * 512) {
        const int p = i >> 5, f = i & 31; const float inv = powf(10000.f, -(float)f / 32.f);
        if (p < 256) { const float ang = (float)p * inv; rope[p * 32 + f] = cosf(ang); rope[8192 + p * 32 + f] = sinf(ang); }
        else { const int q = p - 256; const float ang = (float)q * inv; rope[16384 + q * 32 + f] = cosf(ang); rope[16384 + 2048 + q * 32 + f] = sinf(ang); }
    }
}

DEVI void phase1(const Args& a, int tid, int lane, int wave) {
    unsigned char* ws = a.ws;
    const float* modacc = (const float*)(ws + CTL_MODACC); const float* bada = a.in[5];
    bf16_t* XN = (bf16_t*)(ws + WS_XN); float* rowss1 = (float*)(ws + SM_ROWSS1);
    const int gw = blockIdx.x * 8 + wave, NGW = gridDim.x * 8;
    for (int row = gw; row < MT; row += NGW) {
        const int vs = row < SEQ ? 0 : (row < ML ? 1 : 2);
        const float* xr = row < ML ? a.in[0] + (size_t)row * 1024 : a.in[2] + (size_t)(row - ML) * 1024;
        float ss = 0.f;
#pragma unroll
        for (int j = 0; j < 4; ++j) {
            const int c = 4 * lane + 256 * j;
            const f32x4 v = *(const f32x4*)(xr + c);
            ss += (v[0] * v[0] + v[1] * v[1]) + (v[2] * v[2] + v[3] * v[3]);
            const f32x4 s = (*(const f32x4*)(modacc + vs * 6144 + 1024 + c) + *(const f32x4*)(bada + 1024 + c) + 1.f) * *(const f32x4*)(a.in[6] + c);
            const f32x4 o = v * s; u32x2 w; w.x = pk2(o[0], o[1]); w.y = pk2(o[2], o[3]);
            *(u32x2*)(XN + (size_t)row * 1024 + c) = w;
        }
        ss = wave_sum(ss);
        if (lane == 0) rowss1[row] = ss;
    }
    const bf16_t* WinA = (const bf16_t*)(ws + WS_WINA); const bf16_t* WinC = (const bf16_t*)(ws + WS_WINC); const bf16_t* Wup = (const bf16_t*)(ws + WS_WUP);
    float* shWa = (float*)(ws + SM_SHWA); float* shWf = (float*)(ws + SM_SHWF);
    for (int n = gw; n < NSH + NUP; n += NGW) {
        const bool isf = n >= NSH;
        const bf16_t* wrow = isf ? Wup + (size_t)(n - NSH) * 1024 : (n < NA ? WinA + (size_t)n * 1024 : WinC + (size_t)(n - NA) * 1024);
        const int shoff = isf ? 3072 : 0;
        float s0 = 0.f, s1 = 0.f, s2 = 0.f;
#pragma unroll
        for (int h = 0; h < 2; ++h) {
            const int k0 = h * 512 + lane * 8;
            const u32x4 w = *(const u32x4*)(wrow + k0);
#pragma unroll
            for (int i = 0; i < 4; ++i) {
                const float wl = bflo(w[i]), wh = bfhi(w[i]); const int k = k0 + 2 * i;
                const float b0 = bada[shoff + k], b1 = bada[shoff + k + 1];
                s0 += (modacc[shoff + k] + b0) * wl + (modacc[shoff + k + 1] + b1) * wh;
                s1 += (modacc[6144 + shoff + k] + b0) * wl + (modacc[6144 + shoff + k + 1] + b1) * wh;
                s2 += (modacc[12288 + shoff + k] + b0) * wl + (modacc[12288 + shoff + k + 1] + b1) * wh;
            }
        }
        s0 = wave_sum(s0); s1 = wave_sum(s1); s2 = wave_sum(s2);
        if (lane == 0) {
            if (isf) { shWf[n - NSH] = s0; shWf[NUP + n - NSH] = s1; }
            else { shWa[n] = s0; shWa[NSH + n] = s1; shWa[2 * NSH + n] = s2; }
        }
    }
}

DEVI void phase_dnprep(const Args& a, int tid) {
    unsigned char* ws = a.ws;
    const bf16_t* QR = (const bf16_t*)(ws + WS_QKVR); bf16_t* QP = (bf16_t*)(ws + WS_QKVP);
    const float* convw = a.in[9]; const float* ba = (const float*)(ws + WS_BA);
    float* gb = (float*)(ws + WS_G); float* bb = (float*)(ws + WS_BETA);
    const int cgp = tid & 127, strip = tid >> 7;
    for (int it = blockIdx.x; it < 520 * 3; it += gridDim.x) {
        const int cidx = it / 3, sec = it - cidx * 3;
        int seq_start, t0, seq_len;
        if (cidx < 512) { seq_start = (cidx >> 8) * SEQ; t0 = (cidx & 255) * 64; seq_len = SEQ; }
        else { const int c2 = cidx - 512; seq_start = ML + (c2 >> 2) * CTX; t0 = (c2 & 3) * 64; seq_len = CTX; }
        const int col = sec * 1024 + cgp * 8;
        f32x4 w0[5], w1[5];
#pragma unroll
        for (int j = 0; j < 5; ++j) { w0[j] = *(const f32x4*)(convw + j * 3072 + col); w1[j] = *(const f32x4*)(convw + j * 3072 + col + 4); }
        const int tb = t0 + strip * 16;
        u32x4 win[5];
#define LDROW(tt) (((tt) >= 0 && (tt) < seq_len) ? *(const u32x4*)(QR + (size_t)(seq_start + (tt)) * 3072 + col) : (u32x4){0u, 0u, 0u, 0u})
        win[0] = LDROW(tb - 2); win[1] = LDROW(tb - 1); win[2] = LDROW(tb); win[3] = LDROW(tb + 1);
#pragma unroll
        for (int r = 0; r < 16; ++r) {
            win[4] = LDROW(tb + r + 2);
            f32x4 acc0 = {0.f, 0.f, 0.f, 0.f}, acc1 = {0.f, 0.f, 0.f, 0.f};
#pragma unroll
            for (int j = 0; j < 5; ++j) { const u32x4 x = win[j];
                acc0 += (f32x4){bflo(x[0]), bfhi(x[0]), bflo(x[1]), bfhi(x[1])} * w0[j];
                acc1 += (f32x4){bflo(x[2]), bfhi(x[2]), bflo(x[3]), bfhi(x[3])} * w1[j]; }
            float y[8];
#pragma unroll
            for (int i = 0; i < 4; ++i) { y[i] = siluf(acc0[i]); y[4 + i] = siluf(acc1[i]); }
            if (sec < 2) {
                float ss = 0.f;
#pragma unroll
                for (int i = 0; i < 8; ++i) ss += y[i] * y[i];
                ss += __shfl_xor(ss, 1); ss += __shfl_xor(ss, 2); ss += __shfl_xor(ss, 4); ss += __shfl_xor(ss, 8);
                const float sc = rsqrtf(ss + EPS) * (sec == 0 ? 0.08838834764831845f : 1.f);
#pragma unroll
                for (int i = 0; i < 8; ++i) y[i] *= sc;
            }
            u32x4 o; o.x = pk2(y[0], y[1]); o.y = pk2(y[2], y[3]); o.z = pk2(y[4], y[5]); o.w = pk2(y[6], y[7]);
            *(u32x4*)(QP + (size_t)(seq_start + tb + r) * 3072 + col) = o;
            win[0] = win[1]; win[1] = win[2]; win[2] = win[3]; win[3] = win[4];
        }
#undef LDROW
        if (sec == 0) {
#pragma unroll
            for (int q = 0; q < 2; ++q) {
                const int e = tid + q * 512, r = e >> 4, idx = e & 15, row = seq_start + t0 + r;
                const float bv = ba[(size_t)row * 32 + idx], av = ba[(size_t)row * 32 + 16 + idx];
                const float xs = av + a.in[11][idx];
                const float sp = fmaxf(xs, 0.f) + log1pf(expf(-fabsf(xs)));
                const float g = -expf(a.in[10][idx]) * sp;
                const int dir = idx >> 3, h = idx & 7;
                gb[((size_t)dir * MT + row) * 8 + h] = g;
                bb[((size_t)dir * MT + row) * 8 + h] = 1.f / (1.f + expf(-bv));
            }
        }
    }
}

DEVI void phase_dnscan(const Args& a, int lane, int wave) {
    unsigned char* ws = a.ws;
    const bf16_t* QP = (const bf16_t*)(ws + WS_QKVP);
    const float* gb = (const float*)(ws + WS_G); const float* bb = (const float*)(ws + WS_BETA);
    bf16_t* Of = (bf16_t*)a.out; bf16_t* Ob = Of + (size_t)ML * 1024;
    const int gw = blockIdx.x * 8 + wave, NGW = gridDim.x * 8;
    for (int item = gw; item < 2048; item += NGW) {
        const int chain = item >> 6, ep = item & 63, dir = chain >> 4, b = (chain >> 3) & 1, h = chain & 7;
        bf16_t* O = dir ? Ob : Of;
        float S00 = 0.f, S01 = 0.f, S10 = 0.f, S11 = 0.f;
        const int NTOK = CTX + SEQ;
        constexpr int U = 4;
        unsigned kq[U], qq[U], vv[U]; float gg[U], be[U]; int rows[U];
        auto rowof = [&](int s) -> int { if (s < CTX) { const int t = dir ? CTX - 1 - s : s; return ML + b * CTX + t; } const int t2 = s - CTX; const int t = dir ? SEQ - 1 - t2 : t2; return b * SEQ + t; };
#define SC_LOAD(i, s) do { const int row_ = rowof(s); rows[i] = row_; const bf16_t* p_ = QP + (size_t)row_ * 3072 + h * 128; \
        qq[i] = *(const unsigned*)(p_ + 2 * lane); kq[i] = *(const unsigned*)(p_ + 1024 + 2 * lane); vv[i] = *(const unsigned*)(p_ + 2048 + 2 * ep); \
        gg[i] = gb[((size_t)dir * MT + row_) * 8 + h]; be[i] = bb[((size_t)dir * MT + row_) * 8 + h]; } while (0)
        for (int s0 = 0; s0 < NTOK; s0 += U) {
#pragma unroll
            for (int i = 0; i < U; ++i) SC_LOAD(i, s0 + i);
#pragma unroll
            for (int i = 0; i < U; ++i) {
                const float k0 = bflo(kq[i]), k1 = bfhi(kq[i]), q0 = bflo(qq[i]), q1 = bfhi(qq[i]), v0 = bflo(vv[i]), v1 = bfhi(vv[i]);
                const float eg = __expf(gg[i]), bt = be[i];
                float p0 = k0 * S00 + k1 * S10, p1 = k0 * S01 + k1 * S11;
                p0 = wave_sum(p0); p1 = wave_sum(p1);
                const float vn0 = bt * (v0 - eg * p0), vn1 = bt * (v1 - eg * p1);
                S00 = eg * S00 + k0 * vn0; S01 = eg * S01 + k0 * vn1; S10 = eg * S10 + k1 * vn0; S11 = eg * S11 + k1 * vn1;
                float o0 = q0 * S00 + q1 * S10, o1 = q0 * S01 + q1 * S11;
                o0 = wave_sum(o0); o1 = wave_sum(o1);
                if (lane == 0 && rows[i] < ML) *(unsigned*)(O + (size_t)rows[i] * 1024 + h * 128 + 2 * ep) = pk2(o0, o1);
            }
        }
#undef SC_LOAD
    }
}

DEVI bf16x8 ld_b128(LAS const unsigned char* p) { return *(LAS const bf16x8*)p; }
DEVI bf16x8 ld_2b64(LAS const unsigned char* p0, LAS const unsigned char* p1) { const u32x2 a = *(LAS const u32x2*)p0, b = *(LAS const u32x2*)p1; u32x4 w = {a.x, a.y, b.x, b.y}; return __builtin_bit_cast(bf16x8, w); }
DEVI bf16x8 pack_frag(const f32x4& lo, const f32x4& hi) { u32x4 w = {pk2(lo[0], lo[1]), pk2(lo[2], lo[3]), pk2(hi[0], hi[1]), pk2(hi[2], hi[3])}; return __builtin_bit_cast(bf16x8, w); }
#define MFMA16(A, B, C) __builtin_amdgcn_mfma_f32_16x16x32_bf16(A, B, C, 0, 0, 0)
DEVI void phase_dnchunk(const Args& a, LAS unsigned char* lds, int tid, int lane, int wave) {
    unsigned char* ws = a.ws;
    const bf16_t* QP = (const bf16_t*)(ws + WS_QKVP); const float* gb = (const float*)(ws + WS_G); const float* bb = (const float*)(ws + WS_BETA);
    bf16_t* TQ = (bf16_t*)(ws + WS_TQ); float* AV = (float*)(ws + WS_AVEC);
    constexpr int KL = 0, QL = 17408, KKF = 34816, QKF = 52224, VEC = 131072;
    const int fr = lane & 15, g = lane >> 4, d = wave >> 2, wq = wave & 3;
    LAS unsigned char* dbase = lds + d * 64512;
    LAS float* Gg = (LAS float*)(lds + VEC); LAS float* Bv = Gg + 128; LAS float* GC = Gg + 256;
    for (int item = blockIdx.x; item < 520 * 8; item += gridDim.x) {
        const int cidx = item >> 3, h = item & 7;
        const int row0 = cidx < 512 ? cidx * 64 : ML + (cidx - 512) * 64;
#pragma unroll
        for (int i = 0; i < 2; ++i) { const int c = tid + i * 512, r = c >> 4, ch = c & 15;
            const bf16_t* src = QP + (size_t)(row0 + r) * 3072 + h * 128 + ch * 8;
            *(LAS u32x4*)(lds + QL + r * 272 + ch * 16) = *(const u32x4*)src; *(LAS u32x4*)(lds + KL + r * 272 + ch * 16) = *(const u32x4*)(src + 1024); }
        if (tid < 128) { const int dd = tid >> 6, pos = tid & 63; Gg[tid] = gb[((size_t)dd * MT + row0 + pos) * 8 + h]; Bv[tid] = bb[((size_t)dd * MT + row0 + pos) * 8 + h]; }
        __syncthreads();
        if (wave < 2) {
            const int dd = wave, pos = dd ? 63 - lane : lane; float x = Gg[dd * 64 + pos];
#pragma unroll
            for (int o = 1; o < 64; o <<= 1) { const float y = __shfl_up(x, o); if (lane >= o) x += y; }
            const float total = __shfl(x, 63);
            GC[dd * 64 + pos] = x;
            float* av = AV + ((size_t)item * 2 + dd) * 256;
            av[pos] = __expf(x); av[64 + pos] = Bv[dd * 64 + pos]; av[128 + pos] = __expf(total - x); if (lane == 0) av[192] = __expf(total);
        }
        {
            const int src = d ? QL : KL;
            f32x4 acc[4] = {{0.f, 0.f, 0.f, 0.f}, {0.f, 0.f, 0.f, 0.f}, {0.f, 0.f, 0.f, 0.f}, {0.f, 0.f, 0.f, 0.f}};
#pragma unroll
            for (int s4 = 0; s4 < 4; ++s4) { const bf16x8 A = ld_b128(lds + src + (16 * wq + fr) * 272 + (32 * s4 + 8 * g) * 2);
#pragma unroll
                for (int jt = 0; jt < 4; ++jt) { const bf16x8 Bf = ld_b128(lds + KL + (16 * jt + fr) * 272 + (32 * s4 + 8 * g) * 2); acc[jt] = MFMA16(A, Bf, acc[jt]); } }
            LAS float* dst = (LAS float*)(lds + (d ? QKF : KKF));
#pragma unroll
            for (int jt = 0; jt < 4; ++jt)
#pragma unroll
                for (int r = 0; r < 4; ++r) dst[(16 * wq + 4 * g + r) * 68 + 16 * jt + fr] = acc[jt][r];
        }
        __syncthreads();
        f32x4 P[4], qd[4];
        {
            const LAS float* kkf = (const LAS float*)(lds + KKF); const LAS float* qkf = (const LAS float*)(lds + QKF);
            float gci[4], bei[4];
#pragma unroll
            for (int r = 0; r < 4; ++r) { gci[r] = GC[d * 64 + 16 * wq + 4 * g + r]; bei[r] = Bv[d * 64 + 16 * wq + 4 * g + r]; }
#pragma unroll
            for (int jt = 0; jt < 4; ++jt) { const int j = 16 * jt + fr; const float gcj = GC[d * 64 + j];
#pragma unroll
                for (int r = 0; r < 4; ++r) { const int i = 16 * wq + 4 * g + r; const bool incl = d ? (i <= j) : (i >= j);
                    const float e = incl ? __expf(gci[r] - gcj) : 0.f;
                    qd[jt][r] = qkf[i * 68 + j] * e; P[jt][r] = (i != j) ? -bei[r] * kkf[i * 68 + j] * e : 0.f; } }
        }
        __syncthreads();
        {
#pragma unroll
            for (int jt = 0; jt < 4; ++jt) {
#pragma unroll
                for (int r = 0; r < 4; ++r) { const int i = 16 * wq + 4 * g + r, j = 16 * jt + fr;
                    *(LAS unsigned short*)(dbase + 0 + i * 144 + j * 2) = (unsigned short)f2bf(P[jt][r]);
                    *(LAS unsigned short*)(dbase + 36864 + 9216 + i * 144 + j * 2) = (unsigned short)f2bf(P[jt][r]);
                    *(LAS unsigned short*)(dbase + 55296 + i * 144 + j * 2) = (unsigned short)f2bf(qd[jt][r]); }
                u32x2 w = {pk2(P[jt][0], P[jt][1]), pk2(P[jt][2], P[jt][3])};
                *(LAS u32x2*)(dbase + 18432 + (16 * jt + fr) * 144 + (16 * wq + 4 * g) * 2) = w; }
        }
        __syncthreads();
        int cur = 0;
#pragma unroll 1
        for (int it = 0; it < 5; ++it) {
            LAS unsigned char* NRc = dbase + cur * 9216; LAS unsigned char* NTc = dbase + 18432 + cur * 9216;
            LAS unsigned char* NRn = dbase + (cur ^ 1) * 9216; LAS unsigned char* NTn = dbase + 18432 + (cur ^ 1) * 9216;
            LAS unsigned char* PRo = dbase + 36864 + ((it + 1) & 1) * 9216; LAS unsigned char* PRn = dbase + 36864 + (it & 1) * 9216;
            f32x4 n2[4] = {{0.f, 0.f, 0.f, 0.f}, {0.f, 0.f, 0.f, 0.f}, {0.f, 0.f, 0.f, 0.f}, {0.f, 0.f, 0.f, 0.f}};
#pragma unroll
            for (int s2 = 0; s2 < 2; ++s2) { const bf16x8 A = ld_b128(NRc + (16 * wq + fr) * 144 + (32 * s2 + 8 * g) * 2);
#pragma unroll
                for (int jt = 0; jt < 4; ++jt) { const bf16x8 Bf = ld_b128(NTc + (16 * jt + fr) * 144 + (32 * s2 + 8 * g) * 2); n2[jt] = MFMA16(A, Bf, n2[jt]); } }
#pragma unroll
            for (int jt = 0; jt < 4; ++jt) {
#pragma unroll
                for (int r = 0; r < 4; ++r) *(LAS unsigned short*)(NRn + (16 * wq + 4 * g + r) * 144 + (16 * jt + fr) * 2) = (unsigned short)f2bf(n2[jt][r]);
                u32x2 w = {pk2(n2[jt][0], n2[jt][1]), pk2(n2[jt][2], n2[jt][3])};
                *(LAS u32x2*)(NTn + (16 * jt + fr) * 144 + (16 * wq + 4 * g) * 2) = w;
                P[jt] += n2[jt]; }
            __syncthreads();
#pragma unroll
            for (int s2 = 0; s2 < 2; ++s2) { const bf16x8 A = ld_b128(PRo + (16 * wq + fr) * 144 + (32 * s2 + 8 * g) * 2);
#pragma unroll
                for (int jt = 0; jt < 4; ++jt) { const bf16x8 Bf = ld_b128(NTn + (16 * jt + fr) * 144 + (32 * s2 + 8 * g) * 2); P[jt] = MFMA16(A, Bf, P[jt]); } }
#pragma unroll
            for (int jt = 0; jt < 4; ++jt)
#pragma unroll
                for (int r = 0; r < 4; ++r) *(LAS unsigned short*)(PRn + (16 * wq + 4 * g + r) * 144 + (16 * jt + fr) * 2) = (unsigned short)f2bf(P[jt][r]);
            cur ^= 1;
        }
        __syncthreads();
        {
            bf16_t* dst = TQ + ((size_t)item * 2 + d) * 8192; const int t2 = tid & 255;
#pragma unroll
            for (int k = 0; k < 4; ++k) { const int c = t2 + 256 * k, mat = c >> 9, r = (c >> 3) & 63, ch = c & 7;
                const u32x4 v = *(LAS const u32x4*)(dbase + (mat ? 55296 : 36864) + r * 144 + ch * 16);
                *(u32x4*)(dst + mat * 4096 + r * 64 + ch * 8) = v; }
        }
        __syncthreads();
    }
}

DEVI void phase_dnscan2(const Args& a, LAS unsigned char* lds, int tid, int lane, int wave, unsigned long long& pr_extra) {
    const int v = blockIdx.x;
    if (v < 64) {
    unsigned char* ws = a.ws;
    const bf16_t* QP = (const bf16_t*)(ws + WS_QKVP); const bf16_t* TQ = (const bf16_t*)(ws + WS_TQ); const float* AV = (const float*)(ws + WS_AVEC);
    const int chain = (v & 7) + 8 * (v >> 4), hf = (v >> 3) & 1, dir = chain >> 4, b = (chain >> 3) & 1, h = chain & 7;
    bf16_t* O = (bf16_t*)a.out + (size_t)dir * ML * 1024;
    unsigned* prog = (unsigned*)(ws + CTL_PROG);
    constexpr int KL = 0, QL = 16384, VL = 32768, TL = 41984, DL = 50176, AL = 58368, BUFB = 59392, OT = 2 * BUFB, PFD = OT + 18432, NSTEP = 260;
    const int fr0 = lane & 15, g0 = lane >> 4, ltid = tid - 256;
    auto step_cidx = [&](int s) -> int { if (s < 4) return 512 + b * 4 + (dir ? 3 - s : s); const int c = s - 4; return b * 256 + (dir ? 255 - c : c); };
    u32x4 rq[6], rk[6], rv[3], rt[3], rd[3], ra;
#define LD_ISSUE(s_) do { const int cidx_ = step_cidx(s_); const int row0_ = cidx_ < 512 ? cidx_ * 64 : ML + (cidx_ - 512) * 64; \
        const bf16_t* tqb_ = TQ + ((size_t)(cidx_ * 8 + h) * 2 + dir) * 8192; const float* avb_ = AV + ((size_t)(cidx_ * 8 + h) * 2 + dir) * 256; \
        int lt_ = ltid; asm volatile("" : "+v"(lt_)); \
        const bf16_t* pq_ = QP + (size_t)(row0_ + (lt_ >> 4)) * 3072 + h * 128 + (lt_ & 15) * 8; \
        const bf16_t* pv_ = QP + (size_t)(row0_ + (lt_ >> 3)) * 3072 + 2048 + h * 128 + hf * 64 + (lt_ & 7) * 8; \
        const bf16_t* pt_ = tqb_ + (lt_ >> 3) * 64 + (lt_ & 7) * 8; \
        _Pragma("unroll") for (int i = 0; i < 6; ++i) { const size_t o_ = (i < 5 || lt_ < 64) ? (size_t)i * 12 * 3072 : 0; rq[i] = *(const u32x4*)(pq_ + o_); rk[i] = *(const u32x4*)(pq_ + o_ + 1024); } \
        _Pragma("unroll") for (int i = 0; i < 3; ++i) { const int ok_ = (i < 2 || lt_ < 128); rv[i] = *(const u32x4*)(pv_ + (ok_ ? (size_t)i * 24 * 3072 : 0)); rt[i] = *(const u32x4*)(pt_ + (ok_ ? i * 24 * 64 : 0)); rd[i] = *(const u32x4*)(pt_ + 4096 + (ok_ ? i * 24 * 64 : 0)); } \
        ra = *(const u32x4*)(avb_ + (lt_ & 63) * 4); } while (0)
#define LD_WRITE(bo_) do { int lt_ = ltid; asm volatile("" : "+v"(lt_)); LAS unsigned char* B_ = lds + (bo_); \
        const int chq_ = lt_ & 15, chv_ = lt_ & 7; \
        _Pragma("unroll") for (int i = 0; i < 6; ++i) if (i < 5 || lt_ < 64) { const int r = (lt_ >> 4) + 12 * i; const int o_ = r * 256 + ((chq_ ^ (4 * (r & 3) + ((r >> 3) & 3))) << 4); \
            *(LAS u32x4*)(B_ + QL + o_) = rq[i]; *(LAS u32x4*)(B_ + KL + o_) = rk[i]; } \
        _Pragma("unroll") for (int i = 0; i < 3; ++i) if (i < 2 || lt_ < 128) { const int r = (lt_ >> 3) + 24 * i; const int o_ = r * 128 + ((chv_ ^ (2 * ((r >> 3) & 3) + ((r >> 1) & 1))) << 4); \
            *(LAS u32x4*)(B_ + VL + r * 144 + chv_ * 16) = rv[i]; *(LAS u32x4*)(B_ + TL + o_) = rt[i]; *(LAS u32x4*)(B_ + DL + o_) = rd[i]; } \
        if (lt_ < 64) *(LAS u32x4*)(B_ + AL + lt_ * 16) = ra; } while (0)
#define OT_OUT(s_) do { const int cidx_ = step_cidx(s_); const int row0_ = cidx_ * 64; LAS const unsigned char* ot_ = lds + OT + ((s_) & 1) * 9216; \
        int lt_ = ltid; asm volatile("" : "+v"(lt_)); \
        for (int c = lt_; c < 512; c += 192) { const int r = c >> 3, ch = c & 7; \
            *(u32x4*)(O + (size_t)(row0_ + r) * 1024 + h * 128 + hf * 64 + ch * 8) = *(LAS const u32x4*)(ot_ + r * 144 + ch * 16); } } while (0)
    constexpr int PF_D = 3; constexpr bool PF_ON = false;
    const unsigned pfdst = (unsigned)__builtin_amdgcn_readfirstlane((int)(unsigned)(uintptr_t)(lds + PFD));
#define PF_ISSUE(s_) do { const int cidx_ = step_cidx(s_); const int row0_ = cidx_ < 512 ? cidx_ * 64 : ML + (cidx_ - 512) * 64; \
        const char* tqb_ = (const char*)(TQ + ((size_t)(cidx_ * 8 + h) * 2 + dir) * 8192); const char* avb_ = (const char*)(AV + ((size_t)(cidx_ * 8 + h) * 2 + dir) * 256); \
        int ln_ = lane; asm volatile("" : "+v"(ln_)); \
        _Pragma("unroll") for (int j = 0; j < 8; ++j) { const int L = j * 64 + ln_; const char* p_; \
            if (L < 320) { const int rw = L / 5, part = L - rw * 5; p_ = (const char*)(QP + (size_t)(row0_ + rw) * 3072 + h * 128) + (part < 2 ? part * 128 : part < 4 ? 2048 + (part - 2) * 128 : 4096 + hf * 128); } \
            else if (L < 448) p_ = tqb_ + (L - 320) * 128; else p_ = avb_ + ((L - 448) & 7) * 128; \
            { unsigned keep_; asm volatile("s_mov_b32 %0, m0\n\ts_mov_b32 m0, %2\n\ts_nop 0\n\tglobal_load_lds_dword %1, off\n\ts_mov_b32 m0, %0" : "=&s"(keep_) : "v"(p_), "s"(pfdst) : "memory"); } } } while (0)
    f32x4 S[8];
#pragma unroll
    for (int i = 0; i < 8; ++i) S[i] = (f32x4){0.f, 0.f, 0.f, 0.f};
    if (wave >= 4 && wave < 7) { LD_ISSUE(0); LD_WRITE(0); }
    if (wave == 7) {
#pragma unroll 1
        for (int s = 1; s < PF_D; ++s) if (PF_ON) PF_ISSUE(s); }
#pragma unroll 1
    for (int s = 0; s < NSTEP; ++s) {
        if (wave == 7) {
            __builtin_amdgcn_s_barrier();
            if (PF_ON && s + PF_D < NSTEP) PF_ISSUE(s + PF_D);
            continue;
        }
        const unsigned long long tb_ = PROBE_SUB ? __builtin_amdgcn_s_memrealtime() : 0ull;
        asm volatile("s_waitcnt lgkmcnt(0)" ::: "memory"); __builtin_amdgcn_s_barrier(); asm volatile("" ::: "memory");
        if ((PROBE_SUB == 1 && wave == 0) || (PROBE_SUB == 2 && wave == 4)) pr_extra += __builtin_amdgcn_s_memrealtime() - tb_;
        if (wave >= 4) {
            if (hf == 0 && ltid == 0) __hip_atomic_store(prog + chain * 64, (unsigned)(s + 1), __ATOMIC_RELAXED, __HIP_MEMORY_SCOPE_AGENT);
            if (s + 1 < NSTEP) { LD_ISSUE(s + 1); LD_WRITE(((s + 1) & 1) * BUFB); if (s >= 5) OT_OUT(s - 1); }
            else { OT_OUT(s - 1); }
        } else {
            int fr = fr0, g = g0; asm volatile("" : "+v"(fr), "+v"(g));
            LAS const unsigned char* B = lds + (s & 1) * BUFB;
            const LAS float* avl = (const LAS float*)(B + AL);
            const int rowl = 8 * (fr >> 2) + (fr & 3);
            const int fk = 4 * (fr & 3) + (fr >> 2), ft = 2 * (fr >> 2) + ((fr >> 1) & 1);
#define SBAR_() __builtin_amdgcn_sched_barrier(0)
#define ROWK(pt) ((32 * ((pt) >> 1) + 4 * ((pt) & 1) + rowl) * 256)
#define ROWT(pt) ((32 * ((pt) >> 1) + 4 * ((pt) & 1) + rowl) * 128)
#define P0(pt) (32 * ((pt) >> 1) + 8 * g + 4 * ((pt) & 1))
#define LDK8(dst, base, pa) do { _Pragma("unroll") for (int s4 = 0; s4 < 4; ++s4) { dst[s4] = ld_b128(B + (base) + ROWK(pa) + (((4 * s4 + g) ^ fk) << 4)); dst[4 + s4] = ld_b128(B + (base) + ROWK((pa) + 1) + (((4 * s4 + g) ^ fk) << 4)); } } while (0)
#define LDT8(dst, base) do { _Pragma("unroll") for (int pt = 0; pt < 4; ++pt) { dst[2 * pt] = ld_b128(B + (base) + ROWT(pt) + ((g ^ ft) << 4)); dst[2 * pt + 1] = ld_b128(B + (base) + ROWT(pt) + (((4 + g) ^ ft) << 4)); } } while (0)
#define MM8(acc, fa, pa) do { _Pragma("unroll") for (int s4 = 0; s4 < 4; ++s4) { acc[pa] = MFMA16(fa[s4], Sb[s4], acc[pa]); acc[(pa) + 1] = MFMA16(fa[4 + s4], Sb[s4], acc[(pa) + 1]); } } while (0)
            bf16x8 fA[8], fB[8];
            LDK8(fA, KL, 0);
            bf16x8 Sb[4];
#pragma unroll
            for (int s4 = 0; s4 < 4; ++s4) Sb[s4] = pack_frag(S[2 * s4], S[2 * s4 + 1]);
            f32x4 Z[4], OQ[4], X[4];
#pragma unroll
            for (int pt = 0; pt < 4; ++pt) { Z[pt] = (f32x4){0.f, 0.f, 0.f, 0.f}; OQ[pt] = (f32x4){0.f, 0.f, 0.f, 0.f}; }
            SBAR_();
            LDK8(fB, KL, 2); SBAR_(); MM8(Z, fA, 0); SBAR_();
            LDT8(fA, TL); SBAR_(); MM8(Z, fB, 2); SBAR_();
            f32x4 avp[4];
            {
                f32x4 bvp[4]; unsigned short vraw[4][4];
#pragma unroll
                for (int pt = 0; pt < 4; ++pt) { avp[pt] = *(const LAS f32x4*)(avl + P0(pt)); bvp[pt] = *(const LAS f32x4*)(avl + 64 + P0(pt));
#pragma unroll
                    for (int r = 0; r < 4; ++r) vraw[pt][r] = *(const LAS unsigned short*)(B + VL + (P0(pt) + r) * 144 + (16 * wave + fr) * 2); }
                LDK8(fB, QL, 0);
                SBAR_();
#pragma unroll
                for (int pt = 0; pt < 4; ++pt)
#pragma unroll
                    for (int r = 0; r < 4; ++r) Z[pt][r] = bvp[pt][r] * (bf2f(vraw[pt][r]) - avp[pt][r] * Z[pt][r]);
            }
            { const bf16x8 Zb0 = pack_frag(Z[0], Z[1]), Zb1 = pack_frag(Z[2], Z[3]);
#pragma unroll
              for (int pt = 0; pt < 4; ++pt) { X[pt] = MFMA16(fA[2 * pt], Zb0, Z[pt]); X[pt] = MFMA16(fA[2 * pt + 1], Zb1, X[pt]); } }
            SBAR_();
            LDK8(fA, QL, 2); SBAR_(); MM8(OQ, fB, 0); SBAR_();
            LDT8(fB, DL); SBAR_(); MM8(OQ, fA, 2); SBAR_();
            const int trq = fr >> 2, trp = fr & 3;
            LAS unsigned char* kp0 = (LAS unsigned char*)(B + KL + (8 * g + trq) * 256);
            const int fkt = 4 * trq + g;
#define KT_LOAD(dst, d0) do { _Pragma("unroll") for (int j = 0; j < 4; ++j) { const int dt_ = (d0) + j; const int co = (((4 * (dt_ >> 1) + trp) ^ fkt) << 4) + 8 * (dt_ & 1); \
                const s16x4 a0 = __builtin_bit_cast(s16x4, __builtin_amdgcn_ds_read_tr16_b64_v4i16((LAS s16x4*)(kp0 + co))), a1 = __builtin_bit_cast(s16x4, __builtin_amdgcn_ds_read_tr16_b64_v4i16((LAS s16x4*)(kp0 + co + 4 * 256))); \
                const s16x4 a2 = __builtin_bit_cast(s16x4, __builtin_amdgcn_ds_read_tr16_b64_v4i16((LAS s16x4*)(kp0 + co + 32 * 256))), a3 = __builtin_bit_cast(s16x4, __builtin_amdgcn_ds_read_tr16_b64_v4i16((LAS s16x4*)(kp0 + co + 36 * 256))); \
                dst[2 * j] = (bf16x8){a0[0], a0[1], a0[2], a0[3], a1[0], a1[1], a1[2], a1[3]}; dst[2 * j + 1] = (bf16x8){a2[0], a2[1], a2[2], a2[3], a3[0], a3[1], a3[2], a3[3]}; } } while (0)
            KT_LOAD(fA, 0);
            const float egl = avl[192];
            bf16x8 Xc0, Xc1;
            { const bf16x8 Xb0 = pack_frag(X[0], X[1]), Xb1 = pack_frag(X[2], X[3]);
              f32x4 cx[4];
#pragma unroll
              for (int pt = 0; pt < 4; ++pt) cx[pt] = X[pt] * *(const LAS f32x4*)(avl + 128 + P0(pt));
              Xc0 = pack_frag(cx[0], cx[1]); Xc1 = pack_frag(cx[2], cx[3]);
              SBAR_();
#pragma unroll
              for (int pt = 0; pt < 4; ++pt) { f32x4 o2 = OQ[pt] * avp[pt]; o2 = MFMA16(fB[2 * pt], Xb0, o2); OQ[pt] = MFMA16(fB[2 * pt + 1], Xb1, o2); } }
            SBAR_();
            KT_LOAD(fB, 4); SBAR_();
#pragma unroll
            for (int j = 0; j < 4; ++j) { f32x4 sn = S[j] * egl; sn = MFMA16(fA[2 * j], Xc0, sn); S[j] = MFMA16(fA[2 * j + 1], Xc1, sn); }
            SBAR_();
#pragma unroll
            for (int j = 0; j < 4; ++j) { f32x4 sn = S[4 + j] * egl; sn = MFMA16(fB[2 * j], Xc0, sn); S[4 + j] = MFMA16(fB[2 * j + 1], Xc1, sn); }
            { LAS unsigned char* ot = lds + OT + (s & 1) * 9216;
#pragma unroll
              for (int pt = 0; pt < 4; ++pt)
#pragma unroll
                  for (int r = 0; r < 4; ++r) *(LAS unsigned short*)(ot + (P0(pt) + r) * 144 + (16 * wave + fr) * 2) = (unsigned short)f2bf(OQ[pt][r]); }
#undef KT_LOAD
#undef LDK8
#undef LDT8
#undef MM8
#undef ROWK
#undef ROWT
#undef P0
#undef SBAR_
        }
    }
    if (wave == 7) { __builtin_amdgcn_s_barrier(); asm volatile("s_waitcnt vmcnt(0)" ::: "memory"); }
    else { asm volatile("s_waitcnt lgkmcnt(0)" ::: "memory"); __builtin_amdgcn_s_barrier(); asm volatile("" ::: "memory"); if (wave >= 4) OT_OUT(NSTEP - 1); }
#undef PF_ISSUE
#undef LD_ISSUE
#undef LD_WRITE
#undef OT_OUT
    } else {
        unsigned char* ws = a.ws;
        const bf16_t* QP = (const bf16_t*)(ws + WS_QKVP); const bf16_t* TQ = (const bf16_t*)(ws + WS_TQ); const float* AV = (const float*)(ws + WS_AVEC);
        unsigned* prog = (unsigned*)(ws + CTL_PROG);
        const int vp = v - 64, chain = (vp & 7) + 8 * ((vp >> 3) & 3), role = vp >> 5, dir = chain >> 4, b = (chain >> 3) & 1, h = chain & 7;
        const int nteam = (((int)gridDim.x - 64) >> 5) * 8;
        constexpr int NSTEP = 260, PFD2 = 5;
        if (role * 8 + wave < nteam) {
#pragma unroll 1
        for (int st = role * 8 + wave; st < NSTEP; st += nteam) {
            unsigned spins = 0;
            while ((int)__builtin_amdgcn_readfirstlane((int)__hip_atomic_load(prog + chain * 64, __ATOMIC_RELAXED, __HIP_MEMORY_SCOPE_AGENT)) + PFD2 < st) { __builtin_amdgcn_s_sleep(8); if (++spins > (1u << 20)) break; }
            int cidx; if (st < 4) cidx = 512 + b * 4 + (dir ? 3 - st : st); else { const int c = st - 4; cidx = b * 256 + (dir ? 255 - c : c); }
            const int row0 = cidx < 512 ? cidx * 64 : ML + (cidx - 512) * 64;
            const char* tqb = (const char*)(TQ + ((size_t)(cidx * 8 + h) * 2 + dir) * 8192); const char* avb = (const char*)(AV + ((size_t)(cidx * 8 + h) * 2 + dir) * 256);
            unsigned acc = 0;
#pragma unroll
            for (int j = 0; j < 9; ++j) { const int L = j * 64 + lane; const char* p_;
                if (L < 384) { const int rw = L / 6, part = L - rw * 6; p_ = (const char*)(QP + (size_t)(row0 + rw) * 3072 + h * 128) + (part >> 1) * 2048 + (part & 1) * 128; }
                else if (L < 512) p_ = tqb + (L - 384) * 128; else p_ = avb + ((L - 512) & 7) * 128;
                acc ^= *(const unsigned*)p_; }
            asm volatile("" :: "v"(acc));
        }
        }
    }
}

DEVI void phase_prep2(const Args& a, int lane, int wave) {
    unsigned char* ws = a.ws;
    bf16_t* KAT = (bf16_t*)(ws + WS_KAT); const float* rope = (const float*)(ws + SM_ROPE); const float* knw = a.in[14];
    const int gw = blockIdx.x * 8 + wave, NGW = gridDim.x * 8;
    for (int row = gw; row < MT; row += NGW) {
        bf16_t* p = KAT + (size_t)row * 256 + lane * 4;
        const u32x2 w = *(const u32x2*)p;
        float x[4] = {bflo(w.x), bfhi(w.x), bflo(w.y), bfhi(w.y)};
        float ss = (x[0] * x[0] + x[1] * x[1]) + (x[2] * x[2] + x[3] * x[3]);
        ss += __shfl_xor(ss, 1); ss += __shfl_xor(ss, 2); ss += __shfl_xor(ss, 4); ss += __shfl_xor(ss, 8); ss += __shfl_xor(ss, 16);
        const float rs = rsqrtf(ss * (1.f / 128.f) + EPS);
        const int d = (lane & 31) * 4;
        const f32x4 nw = *(const f32x4*)(knw + d);
#pragma unroll
        for (int i = 0; i < 4; ++i) x[i] = x[i] * rs * nw[i];
        float pr[4];
#pragma unroll
        for (int i = 0; i < 4; ++i) pr[i] = __shfl_xor(x[i], 8);
        if (row < ML) {
            const int t = row & (SEQ - 1), lg = (lane & 31) >> 3, fi = (lane & 7) * 4;
            const float* ct = lg < 2 ? rope + (t >> 6) * 32 + fi : rope + 16384 + (t & 63) * 32 + fi;
            const float* st = lg < 2 ? ct + 8192 : ct + 2048;
            const f32x4 c = *(const f32x4*)ct, s = *(const f32x4*)st;
            const float sg = (lg & 1) ? 1.f : -1.f;
#pragma unroll
            for (int i = 0; i < 4; ++i) x[i] = x[i] * c[i] + sg * pr[i] * s[i];
        }
        u32x2 o; o.x = pk2(x[0], x[1]); o.y = pk2(x[2], x[3]);
        *(u32x2*)p = o;
    }
    const bf16_t* Of = (const bf16_t*)a.out; const bf16_t* Ob = Of + (size_t)ML * 1024;
    const bf16_t* GT = (const bf16_t*)(ws + WS_GT); bf16_t* Y = (bf16_t*)(ws + WS_Y); const float* dnw = a.in[12];
    for (int row = gw; row < ML; row += NGW) {
        const int c0 = lane * 16;
        float o[16];
#pragma unroll
        for (int hh = 0; hh < 2; ++hh) {
            const u32x4 f = *(const u32x4*)(Of + (size_t)row * 1024 + c0 + hh * 8), bk = *(const u32x4*)(Ob + (size_t)row * 1024 + c0 + hh * 8);
#pragma unroll
            for (int i = 0; i < 4; ++i) { o[hh * 8 + 2 * i] = bflo(f[i]) + bflo(bk[i]); o[hh * 8 + 2 * i + 1] = bfhi(f[i]) + bfhi(bk[i]); }
        }
        float ss = 0.f;
#pragma unroll
        for (int i = 0; i < 16; ++i) ss += o[i] * o[i];
        ss += __shfl_xor(ss, 1); ss += __shfl_xor(ss, 2); ss += __shfl_xor(ss, 4);
        const float rs = rsqrtf(ss * (1.f / 128.f) + EPS);
        const int d0 = c0 & 127;
#pragma unroll
        for (int hh = 0; hh < 2; ++hh) {
            const u32x4 gt = *(const u32x4*)(GT + (size_t)row * 1024 + c0 + hh * 8);
            float y[8];
#pragma unroll
            for (int i = 0; i < 4; ++i) {
                y[2 * i] = o[hh * 8 + 2 * i] * rs * dnw[d0 + hh * 8 + 2 * i] * siluf(bflo(gt[i]));
                y[2 * i + 1] = o[hh * 8 + 2 * i + 1] * rs * dnw[d0 + hh * 8 + 2 * i + 1] * siluf(bfhi(gt[i]));
            }
            u32x4 w; w.x = pk2(y[0], y[1]); w.y = pk2(y[2], y[3]); w.z = pk2(y[4], y[5]); w.w = pk2(y[6], y[7]);
            *(u32x4*)(Y + (size_t)row * 2048 + c0 + hh * 8) = w;
        }
    }
}

namespace att {
constexpr int D = 128, NW = 8, QBLK = 32, KVBLK = 64;
constexpr float SCALE = 0.088388347648318440f;
constexpr float THR = 8.f;
constexpr int LDK = 256;
constexpr size_t SHM_V = KVBLK * D * 2, SHM_K = KVBLK * D * 2;
constexpr size_t OFF_WS = 2 * SHM_V + 2 * SHM_K, OFF_OST = OFF_WS + NW * 64 * 4;
#define KSWZ(row, colB) ((row) * 256 + ((colB) ^ (((row) & 7) << 4)))
#define SBAR() __builtin_amdgcn_sched_barrier(0)
DEVI int crow(int r, int hi) { return (r & 3) + 8 * (r >> 2) + 4 * hi; }
DEVI unsigned cvtpk(float lo, float hi) { unsigned r; asm volatile("v_cvt_pk_bf16_f32 %0, %1, %2" : "=v"(r) : "v"(lo), "v"(hi)); return r; }
DEVI void partialSM(f32x16& p0, f32x16& p1, float& m_reg, float& mn, float& alpha) {
    constexpr float C = SCALE * 1.4426950408889634f;
    float pmax = p0[0];
#pragma unroll
    for (int r = 1; r < 16; ++r) pmax = fmaxf(pmax, p0[r]);
#pragma unroll
    for (int r = 0; r < 16; ++r) pmax = fmaxf(pmax, p1[r]);
    { auto rr = __builtin_amdgcn_permlane32_swap(__float_as_uint(pmax), __float_as_uint(pmax), false, false);
      pmax = fmaxf(__uint_as_float(rr[0]), __uint_as_float(rr[1])); }
    if (__builtin_expect(__all(pmax - m_reg <= THR / SCALE), 1)) { mn = m_reg; alpha = 1.f; }
    else { mn = fmaxf(m_reg, pmax); alpha = __builtin_amdgcn_exp2f((m_reg - mn) * C); m_reg = mn; }
    const float mnC = -mn * C;
#pragma unroll
    for (int r = 0; r < 16; ++r) p0[r] = fmaf(p0[r], C, mnC);
#pragma unroll
    for (int r = 0; r < 16; ++r) p1[r] = fmaf(p1[r], C, mnC);
#pragma unroll
    for (int r = 0; r < 16; ++r) p0[r] = __builtin_amdgcn_exp2f(p0[r]);
}
DEVI void finishSM(f32x16& p0, f32x16& p1, float alpha, float& l_reg, bf16x8& pa0, bf16x8& pa1, bf16x8& pa2, bf16x8& pa3) {
#pragma unroll
    for (int r = 0; r < 16; ++r) p1[r] = __builtin_amdgcn_exp2f(p1[r]);
    float ps = 0;
#pragma unroll
    for (int r = 0; r < 16; ++r) ps += p0[r];
#pragma unroll
    for (int r = 0; r < 16; ++r) ps += p1[r];
    { auto rr = __builtin_amdgcn_permlane32_swap(__float_as_uint(ps), __float_as_uint(ps), false, false);
      ps = __uint_as_float(rr[0]) + __uint_as_float(rr[1]); }
    l_reg = l_reg * alpha + ps;
#define PK4(P, BASE, OUT) do { unsigned a0 = cvtpk(P[BASE + 0], P[BASE + 1]), a1 = cvtpk(P[BASE + 2], P[BASE + 3]);   \
    unsigned b0 = cvtpk(P[BASE + 4], P[BASE + 5]), b1 = cvtpk(P[BASE + 6], P[BASE + 7]);                              \
    auto r0 = __builtin_amdgcn_permlane32_swap(a0, b0, false, false); auto r1 = __builtin_amdgcn_permlane32_swap(a1, b1, false, false); \
    u32x4 w = {r0[0], r1[0], r0[1], r1[1]}; OUT = *reinterpret_cast<bf16x8*>(&w); } while (0)
    PK4(p0, 0, pa0); PK4(p0, 8, pa1); PK4(p1, 0, pa2); PK4(p1, 8, pa3);
#undef PK4
}
DEVI void qkt(f32x16& p0, f32x16& p1, const char* Ks, const bf16x8* qr, int r32, int hi) {
    p0 = f32x16{}; p1 = f32x16{};
#pragma unroll
    for (int d0 = 0; d0 < 8; ++d0) { const int cb = (d0 * 16 + hi * 8) * 2;
        const bf16x8 b0 = *reinterpret_cast<const bf16x8*>(Ks + KSWZ(r32, cb));
        const bf16x8 b1 = *reinterpret_cast<const bf16x8*>(Ks + KSWZ(32 + r32, cb));
        p0 = __builtin_amdgcn_mfma_f32_32x32x16_bf16(b0, qr[d0], p0, 0, 0, 0);
        p1 = __builtin_amdgcn_mfma_f32_32x32x16_bf16(b1, qr[d0], p1, 0, 0, 0); }
}
DEVI int v_st(int k, int c) { const int kk = (k & ~0xC) | ((k & 4) << 1) | ((k & 8) >> 1); return ((kk >> 3) * 4 + (c >> 5)) * 512 + ((kk & 7) * 32 + (c & 31)) * 2; }
DEVI int v_rd_base(int lane) { return ((lane & 3) << 3) | (((lane >> 2) & 3) << 6) | (((lane >> 4) & 1) << 5) | (((lane >> 5) & 1) << 8); }
constexpr int v_rd_off(int d0, int ks, int half) { return d0 * 512 + ks * 4096 + half * 2048; }
template <int OFF> DEVI s16x4 tr_read(int vb) { s16x4 r; asm volatile("ds_read_b64_tr_b16 %0, %1 offset:%2" : "=&v"(r) : "v"(vb), "i"(OFF) : "memory"); return r; }
template <int D0> DEVI void pv_one(f32x16& od, int vb, bf16x8 pa0, bf16x8 pa1, bf16x8 pa2, bf16x8 pa3) {
    const s16x4 l0 = tr_read<v_rd_off(D0, 0, 0)>(vb), h0 = tr_read<v_rd_off(D0, 0, 1)>(vb), l1 = tr_read<v_rd_off(D0, 1, 0)>(vb), h1 = tr_read<v_rd_off(D0, 1, 1)>(vb);
    const s16x4 l2 = tr_read<v_rd_off(D0, 2, 0)>(vb), h2 = tr_read<v_rd_off(D0, 2, 1)>(vb), l3 = tr_read<v_rd_off(D0, 3, 0)>(vb), h3 = tr_read<v_rd_off(D0, 3, 1)>(vb);
    asm volatile("s_waitcnt lgkmcnt(0)" ::: "memory"); SBAR();
#define PK(L, H) (bf16x8){L[0], L[1], L[2], L[3], H[0], H[1], H[2], H[3]}
    od = __builtin_amdgcn_mfma_f32_32x32x16_bf16(pa0, PK(l0, h0), od, 0, 0, 0);
    od = __builtin_amdgcn_mfma_f32_32x32x16_bf16(pa1, PK(l1, h1), od, 0, 0, 0);
    od = __builtin_amdgcn_mfma_f32_32x32x16_bf16(pa2, PK(l2, h2), od, 0, 0, 0);
    od = __builtin_amdgcn_mfma_f32_32x32x16_bf16(pa3, PK(l3, h3), od, 0, 0, 0);
#undef PK
}
DEVI void pv_d0(f32x16* o, int vb, bf16x8 pa0, bf16x8 pa1, bf16x8 pa2, bf16x8 pa3) {
    pv_one<0>(o[0], vb, pa0, pa1, pa2, pa3); pv_one<1>(o[1], vb, pa0, pa1, pa2, pa3); pv_one<2>(o[2], vb, pa0, pa1, pa2, pa3); pv_one<3>(o[3], vb, pa0, pa1, pa2, pa3);
}
DEVI void wmask(f32x16& p0, f32x16& p1, int qp, int kt0, int hi) {
#pragma unroll
    for (int r = 0; r < 16; ++r) { const int kp = kt0 + crow(r, hi); const int d0 = qp - kp, d1 = d0 - 32;
        if (d0 > 128 || d0 < -128) p0[r] = -1e30f; if (d1 > 128 || d1 < -128) p1[r] = -1e30f; }
}
DEVI void attn_unit(const Args& a, int b, int h, int qb, char* lds) {
    unsigned char* ws = a.ws;
    const bf16_t* QAT = (const bf16_t*)(ws + WS_QAT); const bf16_t* KAT = (const bf16_t*)(ws + WS_KAT); const bf16_t* VAT = (const bf16_t*)(ws + WS_VAT);
    bf16_t* Y = (bf16_t*)(ws + WS_Y); const float* rope = (const float*)(ws + SM_ROPE);
    const int tid = threadIdx.x, wid = tid >> 6, lane = tid & 63, r32 = lane & 31, hi = lane >> 5;
    const int kvh = h >> 2, t0 = qb * 256;
    char* V_lds = lds; char* K_lds = lds + 2 * SHM_V;
    float* wsf = (float*)(lds + OFF_WS) + wid * 64; float* li_l = wsf; float* al_l = wsf + 32;
    float m_reg = -1e30f, l_reg = 0; f32x16 o[4] = {}; bf16x8 qr[8];
    const int qp = t0 + wid * QBLK + r32;
    {
        const bf16_t* Qw = QAT + (size_t)(b * SEQ + qp) * 1024 + h * 128 + hi * 8;
        u32x4 raw[8]; float ss = 0.f;
#pragma unroll
        for (int d0 = 0; d0 < 8; ++d0) { raw[d0] = *(const u32x4*)(Qw + d0 * 16);
#pragma unroll
            for (int i = 0; i < 4; ++i) { const float lo_ = bflo(raw[d0][i]), hi_ = bfhi(raw[d0][i]); ss += lo_ * lo_ + hi_ * hi_; } }
        { auto rr = __builtin_amdgcn_permlane32_swap(__float_as_uint(ss), __float_as_uint(ss), false, false); ss = __uint_as_float(rr[0]) + __uint_as_float(rr[1]); }
        const float rs = rsqrtf(ss * (1.f / 128.f) + EPS);
        const float* qnw = a.in[13];
#pragma unroll
        for (int half = 0; half < 2; ++half) {
            const float* ct = half == 0 ? rope + (qp >> 6) * 32 : rope + 16384 + (qp & 63) * 32;
            const float* st = half == 0 ? ct + 8192 : ct + 2048;
#pragma unroll
            for (int dd = 0; dd < 2; ++dd) {
                const int fi = dd * 16 + hi * 8, da = half * 4 + dd, db = da + 2;
                u32x4 oa, ob;
#pragma unroll
                for (int q4 = 0; q4 < 2; ++q4) {
                    const f32x4 c = *(const f32x4*)(ct + fi + 4 * q4), s = *(const f32x4*)(st + fi + 4 * q4);
                    const f32x4 wa = *(const f32x4*)(qnw + da * 16 + hi * 8 + 4 * q4), wb = *(const f32x4*)(qnw + db * 16 + hi * 8 + 4 * q4);
                    float ya[4], yb[4];
#pragma unroll
                    for (int j = 0; j < 4; ++j) {
                        const unsigned ra = raw[da][2 * q4 + (j >> 1)], rb = raw[db][2 * q4 + (j >> 1)];
                        const float x1 = ((j & 1) ? bfhi(ra) : bflo(ra)) * rs * wa[j], x2 = ((j & 1) ? bfhi(rb) : bflo(rb)) * rs * wb[j];
                        ya[j] = x1 * c[j] - x2 * s[j]; yb[j] = x2 * c[j] + x1 * s[j];
                    }
                    oa[2 * q4] = cvtpk(ya[0], ya[1]); oa[2 * q4 + 1] = cvtpk(ya[2], ya[3]); ob[2 * q4] = cvtpk(yb[0], yb[1]); ob[2 * q4 + 1] = cvtpk(yb[2], yb[3]);
                }
                qr[da] = *reinterpret_cast<bf16x8*>(&oa); qr[db] = *reinterpret_cast<bf16x8*>(&ob);
            }
        }
    }
    const int tk0 = t0 - 128 < 0 ? 0 : t0 - 128, tk1 = t0 + 384 > SEQ ? SEQ : t0 + 384;
    const int NT = 4 + (tk1 - tk0) / 64;
    const int ctxrow = ML + b * CTX, latrow = b * SEQ + tk0 - 256;
#define TROW(j) ((j) < 4 ? ctxrow + 64 * (j) : latrow + 64 * (j))
    const bf16_t* Kh = KAT + kvh * 128; const bf16_t* Vh = VAT + kvh * 128;
    const int sr = tid >> 4, sc = (tid & 15) * 8, vst0 = v_st(sr, sc), vst1 = v_st(32 + sr, sc);
    const int vb0 = (int)(uintptr_t)V_lds + v_rd_base(lane);
    struct { bf16x8 vs0, vs1, ks0, ks1; } sr_[1];
#define SLOAD(i, j) do { const int k0_ = TROW(j); sr_[i].vs0 = *(const bf16x8*)(Vh + (size_t)(k0_ + sr) * LDK + sc); sr_[i].vs1 = *(const bf16x8*)(Vh + (size_t)(k0_ + 32 + sr) * LDK + sc); \
    sr_[i].ks0 = *(const bf16x8*)(Kh + (size_t)(k0_ + sr) * LDK + sc); sr_[i].ks1 = *(const bf16x8*)(Kh + (size_t)(k0_ + 32 + sr) * LDK + sc); } while (0)
#define SWRITE(bf, i) do { *(bf16x8*)(V_lds + (bf) * SHM_V + vst0) = sr_[i].vs0; *(bf16x8*)(V_lds + (bf) * SHM_V + vst1) = sr_[i].vs1; const int kc = sc * 2; \
    *(bf16x8*)(K_lds + (bf) * SHM_K + KSWZ(sr, kc)) = sr_[i].ks0; *(bf16x8*)(K_lds + (bf) * SHM_K + KSWZ(32 + sr, kc)) = sr_[i].ks1; } while (0)
#define SWAIT() asm volatile("s_waitcnt vmcnt(0)" ::: "memory")
#define RESC(al) do { if (__any((al) < 1.f)) { if (hi == 0) al_l[r32] = (al); asm volatile("s_waitcnt lgkmcnt(0)" ::: "memory"); \
    _Pragma("unroll") for (int d = 0; d < 4; ++d) _Pragma("unroll") for (int r = 0; r < 16; ++r) o[d][r] *= al_l[crow(r, hi)]; } } while (0)
#define WMASK(P0, P1, j) do { if ((j) >= 4) wmask(P0, P1, qp, tk0 + 64 * ((j) - 4), hi); } while (0)
    f32x16 pA0, pA1, pB0, pB1; float mnA, mnB, alA, alB; bf16x8 pa0, pa1, pa2, pa3;
    constexpr int SE = 0, SO = 0;
    SLOAD(SE, 0); asm volatile("s_waitcnt vmcnt(0)" ::: "memory"); SWRITE(0, SE); __syncthreads();
    qkt(pA0, pA1, K_lds, qr, r32, hi); partialSM(pA0, pA1, m_reg, mnA, alA);
    SLOAD(SO, 1);
    SWAIT(); SWRITE(1, SO); __syncthreads();
    for (int j = 1; j + 1 < NT; j += 2) {
        SBAR(); qkt(pB0, pB1, K_lds + SHM_K, qr, r32, hi); WMASK(pB0, pB1, j);
        finishSM(pA0, pA1, alA, l_reg, pa0, pa1, pa2, pa3); SBAR();
        SLOAD(SO, j + 1); SBAR();
        pv_d0(o, vb0, pa0, pa1, pa2, pa3); partialSM(pB0, pB1, m_reg, mnB, alB);
        __syncthreads(); SWAIT(); SWRITE(0, SE);
        RESC(alB); __syncthreads();
        SBAR(); qkt(pA0, pA1, K_lds, qr, r32, hi); WMASK(pA0, pA1, j + 1);
        finishSM(pB0, pB1, alB, l_reg, pa0, pa1, pa2, pa3); SBAR();
        SLOAD(SE, j + 2); SBAR();
        pv_d0(o, vb0 + (int)SHM_V, pa0, pa1, pa2, pa3); partialSM(pA0, pA1, m_reg, mnA, alA);
        __syncthreads(); SWAIT(); SWRITE(1, SO);
        RESC(alA); __syncthreads();
    }
    SBAR(); qkt(pB0, pB1, K_lds + SHM_K, qr, r32, hi); WMASK(pB0, pB1, NT - 1);
    finishSM(pA0, pA1, alA, l_reg, pa0, pa1, pa2, pa3); SBAR();
    pv_d0(o, vb0, pa0, pa1, pa2, pa3); partialSM(pB0, pB1, m_reg, mnB, alB);
    __syncthreads(); RESC(alB);
    finishSM(pB0, pB1, alB, l_reg, pa0, pa1, pa2, pa3); SBAR();
    pv_d0(o, vb0 + (int)SHM_V, pa0, pa1, pa2, pa3);
    l_reg += __builtin_amdgcn_exp2f(a.in[15][h] * 1.4426950408889634f - m_reg * (SCALE * 1.4426950408889634f));
    if (hi == 0) li_l[r32] = l_reg; asm volatile("s_waitcnt lgkmcnt(0)" ::: "memory");
    float rli[16];
#pragma unroll
    for (int r = 0; r < 16; ++r) rli[r] = __builtin_amdgcn_rcpf(li_l[crow(r, hi)]);
    {
        bf16_t* stg = (bf16_t*)(lds + OFF_OST) + wid * 4096;
#pragma unroll
        for (int r = 0; r < 16; ++r) { const int orow = crow(r, hi);
#pragma unroll
            for (int d0 = 0; d0 < 4; ++d0) stg[orow * 128 + d0 * 32 + r32] = (bf16_t)f2bf(o[d0][r] * rli[r]); }
        asm volatile("s_waitcnt lgkmcnt(0)" ::: "memory");
        bf16_t* Ow = Y + (size_t)(b * SEQ + t0 + wid * QBLK) * 2048 + 1024 + h * 128;
#pragma unroll
        for (int i = 0; i < 8; ++i) { const int row = i * 4 + (lane >> 4), ch = lane & 15; const u32x4 v = *(const u32x4*)(stg + row * 128 + ch * 8); *(u32x4*)(Ow + (size_t)row * 2048 + ch * 8) = v; }
    }
    __syncthreads();
#undef TROW
#undef SLOAD
#undef SWRITE
#undef SWAIT
#undef RESC
#undef WMASK
}
#undef KSWZ
#undef SBAR
}

DEVI void phase_ffnconv(const Args& a, int b, int tid) {
    unsigned char* ws = a.ws;
    const bf16_t* U = (const bf16_t*)(ws + WS_U); bf16_t* ACT = (bf16_t*)(ws + WS_ACT) + (size_t)b * SEQ * DFF;
    const float* cw = a.in[20]; const float* cb = a.in[21];
    if (tid < DFF / 8) {
        const int f0 = tid * 8, pn = f0 >> 7, j = f0 & 127, gc = 256 * pn + j, vc = gc + 128;
        float wg[3][8], wv[3][8], bg[8], bvv[8];
#pragma unroll
        for (int jt = 0; jt < 3; ++jt)
#pragma unroll
            for (int q = 0; q < 8; ++q) { wg[jt][q] = cw[jt * NUP + f0 + q]; wv[jt][q] = cw[jt * NUP + DFF + f0 + q]; }
#pragma unroll
        for (int q = 0; q < 8; ++q) { bg[q] = cb[f0 + q]; bvv[q] = cb[DFF + f0 + q]; }
        for (int it = blockIdx.x; it < SEQ / 32; it += gridDim.x) {
            const int r0 = it * 32;
            u32x4 gw_[3], vw_[3];
#define LDU(rr, c) (((rr) >= 0 && (rr) < SEQ) ? *(const u32x4*)(U + (size_t)(rr) * NUP + (c)) : (u32x4){0u, 0u, 0u, 0u})
            gw_[0] = LDU(r0 - 1, gc); vw_[0] = LDU(r0 - 1, vc); gw_[1] = LDU(r0, gc); vw_[1] = LDU(r0, vc);
#pragma unroll 8
            for (int r = 0; r < 32; ++r) {
                gw_[2] = LDU(r0 + r + 1, gc); vw_[2] = LDU(r0 + r + 1, vc);
                float ug[8], uv[8];
#pragma unroll
                for (int q = 0; q < 8; ++q) { ug[q] = bg[q]; uv[q] = bvv[q]; }
#pragma unroll
                for (int jt = 0; jt < 3; ++jt)
#pragma unroll
                    for (int q = 0; q < 4; ++q) {
                        ug[2 * q] += bflo(gw_[jt][q]) * wg[jt][2 * q]; ug[2 * q + 1] += bfhi(gw_[jt][q]) * wg[jt][2 * q + 1];
                        uv[2 * q] += bflo(vw_[jt][q]) * wv[jt][2 * q]; uv[2 * q + 1] += bfhi(vw_[jt][q]) * wv[jt][2 * q + 1]; }
                u32x4 o;
                o.x = pk2(siluf(ug[0]) * uv[0], siluf(ug[1]) * uv[1]); o.y = pk2(siluf(ug[2]) * uv[2], siluf(ug[3]) * uv[3]);
                o.z = pk2(siluf(ug[4]) * uv[4], siluf(ug[5]) * uv[5]); o.w = pk2(siluf(ug[6]) * uv[6], siluf(ug[7]) * uv[7]);
                *(u32x4*)(ACT + (size_t)(r0 + r) * DFF + f0) = o;
                gw_[0] = gw_[1]; gw_[1] = gw_[2]; vw_[0] = vw_[1]; vw_[1] = vw_[2];
            }
#undef LDU
        }
    }
}

#define XB_TMO      128
#define XB_XCNT(j)  (256  + 64 * (j))
#define XB_XSUB(j)  (1280 + 64 * (j))
#define XB_XGEN(j)  (2304 + 64 * (j))
#define XB_TOP      3328
#define XB_TOPGEN   3392
#define XCD_BAR_WORDS 3456
#define XB_SPIN_CAP (1u << 18)
__device__ __forceinline__ unsigned xb_ld(unsigned* p)              { return __hip_atomic_load(p, __ATOMIC_RELAXED, __HIP_MEMORY_SCOPE_AGENT); }
__device__ __forceinline__ unsigned xb_add(unsigned* p, unsigned v) { return __hip_atomic_fetch_add(p, v, __ATOMIC_RELAXED, __HIP_MEMORY_SCOPE_AGENT); }
__device__ __forceinline__ unsigned xb_xcc_id() { return (unsigned)__builtin_amdgcn_s_getreg((3 << 11) | 20) & 0xFu; }
#define XB_SPIN(cond, bar) do { unsigned _sp = 0; while (cond) { __builtin_amdgcn_s_sleep(1); \
    if ((++_sp & 255u) == 0u) { if (xb_ld(&(bar)[XB_TMO])) break; if (_sp > XB_SPIN_CAP) { atomicAdd(&(bar)[XB_TMO], 1u); break; } } } } while (0)
struct XcdBarrier { unsigned* bar; unsigned x; volatile LAS unsigned* st; };
__device__ __forceinline__ XcdBarrier xcd_barrier_post(unsigned* bar, volatile LAS unsigned* st) {
    XcdBarrier b; b.bar = bar; b.x = xb_xcc_id(); b.st = st;
    if (threadIdx.x == 0) (void)xb_add(&bar[XB_XCNT(b.x)], 1u);
    return b;
}
__device__ __forceinline__ void xcd_barrier_complete(unsigned* bar, unsigned x, unsigned& nloc, unsigned& nx) {
    const unsigned G = gridDim.x * gridDim.y * gridDim.z;
    unsigned sum, cnt, mine, sp = 0u;
    for (;;) {
        sum = 0u; cnt = 0u; mine = 0u;
#pragma unroll
        for (unsigned j = 0; j < 16; ++j) { const unsigned c = xb_ld(&bar[XB_XCNT(j)]); sum += c; cnt += (c > 0u) ? 1u : 0u; mine = (j == x) ? c : mine; }
        if (sum == G) break;
        __builtin_amdgcn_s_sleep(1);
        if ((++sp & 255u) == 0u) { if (xb_ld(&bar[XB_TMO])) break; if (sp > XB_SPIN_CAP) { atomicAdd(&bar[XB_TMO], 1u); break; } }
    }
    nloc = mine > 0u ? mine : 1u; nx = cnt > 0u ? cnt : 1u;
}
__device__ __forceinline__ void xcd_barrier(const XcdBarrier& b) {
    asm volatile("s_waitcnt vmcnt(0)" ::: "memory");
    __syncthreads();
    if (threadIdx.x == 0) {
        unsigned* bar = b.bar;
        __builtin_amdgcn_s_waitcnt(0);
        unsigned nloc = b.st[0], nx = b.st[1];
        if (nloc == 0u) { xcd_barrier_complete(bar, b.x, nloc, nx); b.st[0] = nloc; b.st[1] = nx; }
        const unsigned old = xb_add(&bar[XB_XSUB(b.x)], 1u);
        const unsigned gen = old / nloc;
        if (old + 1u == (gen + 1u) * nloc) {
            __builtin_amdgcn_fence(__ATOMIC_RELEASE, "agent");
            asm volatile("s_waitcnt vmcnt(0)" ::: "memory");
            const unsigned og = xb_add(&bar[XB_TOP], 1u);
            const unsigned tg = og / nx;
            if (og + 1u == (tg + 1u) * nx) xb_add(&bar[XB_TOPGEN], 1u);
            else XB_SPIN(xb_ld(&bar[XB_TOPGEN]) == tg, bar);
            __builtin_amdgcn_fence(__ATOMIC_ACQUIRE, "agent");
            xb_add(&bar[XB_XGEN(b.x)], 1u);
            asm volatile("s_waitcnt vmcnt(0)" ::: "memory");
        } else {
            XB_SPIN(xb_ld(&bar[XB_XGEN(b.x)]) == gen, bar);
            __builtin_amdgcn_fence(__ATOMIC_ACQUIRE, "agent");
            asm volatile("s_waitcnt vmcnt(0)" ::: "memory");
        }
    }
    __syncthreads();
}

constexpr int NPHASE = 16;
__global__ void __launch_bounds__(512, 2) mega(Args a) {
    extern __shared__ __attribute__((aligned(16))) unsigned char lds_raw[];
    LAS unsigned char* lds = (LAS unsigned char*)lds_raw;
    const int tid = threadIdx.x, lane = tid & 63, wave = __builtin_amdgcn_readfirstlane(tid >> 6);
    unsigned char* ws = a.ws;
    const int lo = a.ph_lo, hi = a.ph_hi;
#define IN(k) (lo <= (k) && (k) < hi)
#if MK_ONE_LAUNCH
    volatile LAS unsigned* bst = (volatile LAS unsigned*)(lds + 147440);
    if (tid < 4) bst[tid] = 0u;
    __syncthreads();
    const XcdBarrier gbar = xcd_barrier_post((unsigned*)(ws + WS_CTL), bst);
#define SEAM(k) do { if (IN(k) && IN((k) + 1)) xcd_barrier(gbar); } while (0)
#else
#define SEAM(k) do { } while (0)
#endif
    const float* modacc = (const float*)(ws + CTL_MODACC);
    unsigned long long pr_prev = PROBE_MASK ? __builtin_amdgcn_s_memrealtime() : 0ull, pr_acc = 0ull;
#define STAMP(k) do { if (PROBE_MASK) { const unsigned long long now_ = __builtin_amdgcn_s_memrealtime(); if ((PROBE_MASK >> (k)) & 1u) pr_acc += now_ - pr_prev; pr_prev = now_; } } while (0)
    if (IN(0)) { phase0(a, lds, tid, lane, wave); } SEAM(0); STAMP(0);
    if (IN(1)) { phase1(a, tid, lane, wave); } SEAM(1); STAMP(1);
    if (IN(2)) {
        pg8::Gemm g{(const bf16_t*)(ws + WS_XN), (const bf16_t*)(ws + WS_WINA), MT, NA, 1024}; pg8::StaticOrder S; S.init(MT, NA, gridDim.x, blockIdx.x);
        EpiIn E{(const float*)(ws + SM_ROWSS1), (const float*)(ws + SM_SHWA), 0, (bf16_t*)(ws + WS_QKVR), nullptr, nullptr, nullptr, nullptr, (float*)(ws + WS_BA)};
        pg8::gemm_phase<EpiIn, pg8::StaticOrder, true, true>(lds, g, S, E);
    } SEAM(2); STAMP(2);
    if (IN(3)) { phase_dnprep(a, tid); } SEAM(3); STAMP(3);
    if (IN(4)) { phase_dnchunk(a, lds, tid, lane, wave); } SEAM(4); STAMP(4);
    if (IN(5)) { phase_dnscan2(a, lds, tid, lane, wave, pr_acc); } SEAM(5); STAMP(5);
    if (IN(6)) {
        pg8::Gemm g{(const bf16_t*)(ws + WS_XN), (const bf16_t*)(ws + WS_WINC), MT, NC, 1024}; pg8::StaticOrder S; S.init(MT, NC, gridDim.x, blockIdx.x);
        EpiIn E{(const float*)(ws + SM_ROWSS1), (const float*)(ws + SM_SHWA) + NA, 1, (bf16_t*)(ws + WS_GT), (bf16_t*)(ws + WS_QAT), (bf16_t*)(ws + WS_KAT), (bf16_t*)(ws + WS_VAT), (bf16_t*)(ws + WS_MG), nullptr};
        pg8::gemm_phase<EpiIn, pg8::StaticOrder, true, true>(lds, g, S, E);
    } SEAM(6); STAMP(6);
    if (IN(7)) { phase_prep2(a, lane, wave); } SEAM(7); STAMP(7);
    if (IN(8)) {
#pragma unroll 1
        for (int k = 0; k < 1024; ++k) {
            const int idx = 4 * ((int)blockIdx.x + (int)gridDim.x * (k >> 2)) + (k & 3); if (idx >= 1024) break;
            const int g = idx & 3, qb = (idx >> 2) & 63, kvh = (idx >> 8) & 1, b = idx >> 9;
            att::attn_unit(a, b, kvh * 4 + g, qb, (char*)lds_raw); }
    } SEAM(8); STAMP(8);
    if (IN(9)) {
        pg8::Gemm g{(const bf16_t*)(ws + WS_Y), (const bf16_t*)(ws + WS_WBR), ML, 1024, 2048}; pg8::StaticOrder S; S.init(ML, 1024, gridDim.x, blockIdx.x);
        EpiBr E{(const bf16_t*)(ws + WS_MG), (bf16_t*)(ws + WS_MERGED)};
        pg8::gemm_phase<EpiBr, pg8::StaticOrder, true, true>(lds, g, S, E);
    } SEAM(9); STAMP(9);
    if (IN(10)) {
        pg8::Gemm g{(const bf16_t*)(ws + WS_MERGED), (const bf16_t*)(ws + WS_WOUT), ML, 1024, 1024}; pg8::StaticOrder S; S.init(ML, 1024, gridDim.x, blockIdx.x);
        EpiOut E{a.in[0], modacc, a.in[5], a.in[7], a.out, (bf16_t*)(ws + WS_X1S), (float*)(ws + CTL_ROWSS2)};
        pg8::gemm_phase<EpiOut, pg8::StaticOrder, true, true>(lds, g, S, E);
    } SEAM(10); STAMP(10);
#define FFN_UP(PH, BB) if (IN(PH)) { \
        pg8::Gemm g{(const bf16_t*)(ws + WS_X1S) + (size_t)(BB) * SEQ * 1024, (const bf16_t*)(ws + WS_WUP), SEQ, NUP, 1024}; pg8::StaticOrder S; S.init(SEQ, NUP, gridDim.x, blockIdx.x); \
        EpiUp E{(const float*)(ws + CTL_ROWSS2) + (BB) * SEQ, (const float*)(ws + SM_SHWF) + (BB) * NUP, (bf16_t*)(ws + WS_U)}; \
        pg8::gemm_phase<EpiUp, pg8::StaticOrder, true, true>(lds, g, S, E); }
    FFN_UP(11, 0) SEAM(11); STAMP(11);
    if (IN(12)) { phase_ffnconv(a, 0, tid); } SEAM(12); STAMP(12);
    FFN_UP(13, 1) SEAM(13); STAMP(13);
    if (IN(14)) { phase_ffnconv(a, 1, tid); } SEAM(14); STAMP(14);
#undef FFN_UP
    if (IN(15)) {
        pg8::Gemm g{(const bf16_t*)(ws + WS_ACT), (const bf16_t*)(ws + WS_WDN), ML, 1024, DFF}; pg8::StaticOrder S; S.init(ML, 1024, gridDim.x, blockIdx.x);
        EpiDown E{modacc, a.in[5], a.out};
        pg8::gemm_phase<EpiDown, pg8::StaticOrder, true, true>(lds, g, S, E);
    }
    STAMP(15);
    if ((PROBE_MASK || PROBE_SUB) && blockIdx.x == 0) { const unsigned long long t0_ = __builtin_amdgcn_s_memrealtime(); while (__builtin_amdgcn_s_memrealtime() - t0_ < pr_acc) __builtin_amdgcn_s_sleep(8); }
#undef STAMP
#undef IN
#undef SEAM
}

extern "C" void kernel_launch(void* const* d_in, const int* in_sizes, int n_in, void* d_out, int out_size, void* d_ws, size_t ws_size, hipStream_t stream) {
    static int grid = 0;
    if (grid == 0) {
        if (n_in != 23 || in_sizes[0] != ML * DM || out_size != ML * DM || ws_size < WS_END) {
            fprintf(stderr, "kernel_launch: unexpected shapes n_in %d in0 %d out %d ws %zu (need %zu)\n", n_in, n_in > 0 ? in_sizes[0] : -1, out_size, ws_size, (size_t)WS_END); grid = -1; return; }
        int dev = 0, cus = 0, per_cu = 0;
        hipGetDevice(&dev); hipDeviceGetAttribute(&cus, hipDeviceAttributeMultiprocessorCount, dev);
        if (hipFuncSetAttribute((const void*)mega, hipFuncAttributeMaxDynamicSharedMemorySize, LDS_BYTES) != hipSuccess) { fprintf(stderr, "kernel_launch: hipFuncSetAttribute failed\n"); grid = -1; return; }
        hipOccupancyMaxActiveBlocksPerMultiprocessor(&per_cu, (const void*)mega, 512, LDS_BYTES);
        (void)hipGetLastError();
        if (per_cu < 1) { fprintf(stderr, "kernel_launch: occupancy query says %d blocks per CU\n", per_cu); per_cu = 1; }
        grid = cus;
    }
    if (grid < 0) return;
    hipMemsetAsync((char*)d_ws + WS_CTL, 0, CTL_ZERO_BYTES, stream);
    Args a{};
    for (int i = 0; i < 23; ++i) a.in[i] = (const float*)d_in[i];
    a.out = (float*)d_out; a.ws = (unsigned char*)d_ws;
#if MK_ONE_LAUNCH
    a.ph_lo = 0; a.ph_hi = NPHASE;
    void* args[] = {&a};
    hipError_t e = hipLaunchCooperativeKernel((const void*)mega, dim3(grid), dim3(512), args, LDS_BYTES, stream);
    if (e != hipSuccess) fprintf(stderr, "cooperative launch failed: %s (grid %d)\n", hipGetErrorString(e), grid);
#else
    for (int p = 0; p < NPHASE; ++p) {
        a.ph_lo = p; a.ph_hi = p + 1;
        hipLaunchKernelGGL(mega, dim3(grid), dim3(512), LDS_BYTES, stream, a);
    }
    hipError_t e = hipPeekAtLastError();
    if (e != hipSuccess) fprintf(stderr, "launch failed: %s\n", hipGetErrorString(e));
#endif
}
```

```cpp
#include <hip/hip_runtime.h>
#include <hip/hip_cooperative_groups.h>
#include <cstdio>
#include <cstdint>
namespace cg = cooperative_groups;

#ifndef PROBE_MASK
#define PROBE_MASK 0u
#endif
#ifndef PROBE_SUB
#define PROBE_SUB 0
#endif
#ifndef MK_ONE_LAUNCH
#define MK_ONE_LAUNCH 1
#endif

#define DEVI __device__ __forceinline__
#define LAS __attribute__((address_space(3)))
typedef unsigned short bf16_t;
typedef short bf16x8 __attribute__((ext_vector_type(8)));
typedef float f32x4 __attribute__((ext_vector_type(4)));
typedef float f32x2 __attribute__((ext_vector_type(2)));
typedef float f32x16 __attribute__((ext_vector_type(16)));
typedef unsigned u32x4 __attribute__((ext_vector_type(4)));
typedef unsigned u32x2 __attribute__((ext_vector_type(2)));
typedef short s16x4 __attribute__((ext_vector_type(4)));

constexpr int BATCH = 2, SEQ = 16384, DM = 1024, CTX = 256;
constexpr int ML = BATCH * SEQ;
constexpr int MC = BATCH * CTX;
constexpr int MT = ML + MC;
constexpr int NA = 3328;
constexpr int NC = 4608;
constexpr int NSH = NA + NC;
constexpr int DFF = 2816, NUP = 5632;
constexpr int RB = SEQ + 256;
constexpr int TPB = 65;
constexpr float EPS = 1e-6f;

constexpr size_t MiB = 1u << 20;
constexpr size_t WS_CTL = 0, CTL_ZERO_BYTES = 1 * MiB;
constexpr size_t CTL_PROG = 32 * 1024;
constexpr size_t CTL_MODACC = 64 * 1024;
constexpr size_t CTL_ROWSS2 = 256 * 1024;
constexpr size_t WS_SMALL = 1 * MiB;
constexpr size_t SM_ROWSS1 = WS_SMALL;
constexpr size_t SM_SHWA = WS_SMALL + 256 * 1024;
constexpr size_t SM_SHWF = WS_SMALL + 384 * 1024;
constexpr size_t SM_ROPE = WS_SMALL + 512 * 1024;
constexpr size_t WS_BA = 2 * MiB;
constexpr size_t WS_G = 7 * MiB;
constexpr size_t WS_BETA = 10 * MiB;
constexpr size_t WS_WINA = 13 * MiB, WS_WINC = 20 * MiB, WS_WBR = 29 * MiB, WS_WOUT = 33 * MiB, WS_WUP = 35 * MiB, WS_WDN = 46 * MiB;
constexpr size_t WS_XN = 52 * MiB;
constexpr size_t WS_QKVR = 117 * MiB;
constexpr size_t WS_QKVP = 312 * MiB;
constexpr size_t WS_MG = 180 * MiB;
constexpr size_t WS_GT = 310 * MiB;
constexpr size_t WS_QAT = 375 * MiB;
constexpr size_t WS_KAT = 440 * MiB;
constexpr size_t WS_VAT = 457 * MiB;
constexpr size_t WS_Y = 52 * MiB;
constexpr size_t WS_MERGED = 375 * MiB;
constexpr size_t WS_X1S = 440 * MiB;
constexpr size_t WS_U = 52 * MiB;
constexpr size_t WS_ACT = 228 * MiB;
constexpr size_t WS_TQ = 117 * MiB;
constexpr size_t WS_AVEC = 248 * MiB;
constexpr size_t WS_END = 512 * MiB;

constexpr int LDS_BYTES = 147456;

DEVI float bf2f(unsigned short h) { return __uint_as_float((unsigned)h << 16); }
DEVI float bflo(unsigned w) { return __uint_as_float(w << 16); }
DEVI float bfhi(unsigned w) { return __uint_as_float(w & 0xffff0000u); }
typedef __bf16 bf16x2_t __attribute__((ext_vector_type(2)));
DEVI unsigned pk2(float lo, float hi) { const f32x2 v = {lo, hi}; const bf16x2_t b = __builtin_convertvector(v, bf16x2_t); return __builtin_bit_cast(unsigned, b); }
DEVI unsigned f2bf(float f) { return pk2(f, 0.f) & 0xffffu; }
DEVI float wave_sum(float v) {
#pragma unroll
    for (int o = 1; o < 64; o <<= 1) v += __shfl_xor(v, o);
    return v;
}
DEVI float siluf(float x) { return x / (1.f + __expf(-x)); }
DEVI float sigmoidf_(float x) { return 1.f / (1.f + __expf(-x)); }

struct Args { const float* in[23]; float* out; unsigned char* ws; int ph_lo, ph_hi; };

namespace pg8 {
constexpr int BM = 256, BK = 64, HALF = 128, HTB = HALF * BK * 2, STAGE_BYTES = 8 * HTB, NXCD = 8, WGM = 8;
__host__ __device__ __forceinline__ int lds_byte(int r, int c) { const int st = (r >> 4) * 2 + (c >> 5), rr = r & 15, cc = c & 31, ob = rr * 64 + cc * 2; return st * 1024 + (ob ^ (((ob >> 9) & 1) << 5)); }
__host__ __device__ __forceinline__ void stage_rc(int b, int& R, int& C) { const int st = b / 1024, sb = b % 1024, swz = sb ^ (((sb >> 9) & 1) << 5); R = (st >> 1) * 16 + swz / 64; C = (st & 1) * 32 + (swz % 64) / 2; }
__host__ __device__ __forceinline__ int perm32(int rho) { const int n = rho >> 4, i = rho & 15; return 8 * (i >> 2) + 4 * n + (i & 3); }
struct Unit { int pm, pn; };
struct Gemm { const bf16_t* A; const bf16_t* Bt; int M, N, K; };
struct StaticOrder {
    int nM, nN, nwg, G, c;
    __device__ void init(int M, int N, int G_, int c_) { nM = M / BM; nN = N / BM; nwg = nM * nN; G = G_; c = c_; }
    __device__ bool next(int i, Unit& u) const {
        const long L = (long)i * G + c; if (L >= nwg) return false;
        int wgid = (int)L; { const int q = nwg / NXCD, r = nwg % NXCD, xcd = wgid % NXCD, off = wgid / NXCD; wgid = (xcd < r ? xcd * (q + 1) : r * (q + 1) + (xcd - r) * q) + off; }
        const int nig = WGM * nN, gid = wgid / nig, fm = gid * WGM, gsz = (nM - fm) < WGM ? (nM - fm) : WGM;
        u.pm = fm + ((wgid % nig) % gsz); u.pn = (wgid % nig) / gsz; return true;
    }
};
template <class Epi> __device__ __forceinline__ size_t a_off(const Epi& E, int pm, int K, size_t tstep) { if constexpr (Epi::AROW) return (size_t)E.arow(pm) * K * 2; else return (size_t)pm * tstep; }
template <class Epi, class Sched, bool ALIGN_EPI, bool SP2>
__device__ __forceinline__ void gemm_phase(LAS unsigned char* lds, const Gemm g, const Sched& S, const Epi& E) {
    const int tid = threadIdx.x, wid = __builtin_amdgcn_readfirstlane(tid >> 6), lane = tid & 63, wr = wid >> 2, wc = wid & 3, fr = lane & 15, fq = lane >> 4;
    const int K = g.K, nt = K / BK;
    unsigned voffA[2], voffB[2];
#pragma unroll
    for (int i = 0; i < 2; ++i) { int R, C; stage_rc(tid * 16 + i * 8192, R, C); const int Rb = Epi::PERM ? ((R & ~31) + perm32(R & 31)) : R;
        voffA[i] = (unsigned)(R * K + C) * 2u; voffB[i] = (unsigned)(Rb * K + C) * 2u; }
    const size_t kstep = (size_t)(BK * 2);
    const size_t hstep = (size_t)HALF * K * 2;
    const size_t tstep = 2 * hstep;
    const unsigned ldsw = (unsigned)wid * 1024u;
    const int aoff = lds_byte(wr * 64 + fr, fq * 8), boff = lds_byte(wc * 32 + fr, fq * 8);
#define PG8_SA(b, h) (((b) * 2 + (h)) * HTB)
#define PG8_SB(b, h) ((4 + (b) * 2 + (h)) * HTB)
#define PG8_STAGE(bufoff, gbase, voff) do { _Pragma("unroll") for (int _i = 0; _i < 2; ++_i) \
        __builtin_amdgcn_global_load_lds((const unsigned*)((const char*)(gbase) + (voff)[_i]), (LAS unsigned*)(lds + (bufoff) + ldsw + _i * 8192), 16, 0, 0); } while (0)
#define PG8_LDA(dst, b, h) do { _Pragma("unroll") for (int m = 0; m < 4; ++m) _Pragma("unroll") for (int k = 0; k < 2; ++k) dst[m][k] = *(const LAS bf16x8*)(lds + PG8_SA(b, h) + aoff + m * 2048 + k * 1024); } while (0)
#define PG8_LDB(dst, b, h) do { _Pragma("unroll") for (int n = 0; n < 2; ++n) _Pragma("unroll") for (int k = 0; k < 2; ++k) dst[n][k] = *(const LAS bf16x8*)(lds + PG8_SB(b, h) + boff + n * 2048 + k * 1024); } while (0)
#define PG8_MMA(ai, bj, At, Bt) do { __builtin_amdgcn_s_setprio(1); _Pragma("unroll") for (int m = 0; m < 4; ++m) _Pragma("unroll") for (int n = 0; n < 2; ++n) _Pragma("unroll") for (int k = 0; k < 2; ++k) \
        acc[ai][bj][m][n] = __builtin_amdgcn_mfma_f32_16x16x32_bf16(Bt[n][k], At[m][k], acc[ai][bj][m][n], 0, 0, 0); __builtin_amdgcn_s_setprio(0); } while (0)
#define PG8_WAIT_V(n) asm volatile("s_waitcnt vmcnt(" #n ")" ::: "memory")
#define PG8_WAIT_L(n) asm volatile("s_waitcnt lgkmcnt(" #n ")" ::: "memory")
#define PG8_BAR __builtin_amdgcn_s_barrier()
#define PG8_SCHED __builtin_amdgcn_sched_barrier(0)
    Unit cur, nxt; int ui = 0;
    if (!S.next(0, cur)) return;
    f32x4 acc[2][2][4][2];
#pragma unroll
    for (int a = 0; a < 2; ++a)
#pragma unroll
        for (int b = 0; b < 2; ++b)
#pragma unroll
            for (int m = 0; m < 4; ++m)
#pragma unroll
                for (int n = 0; n < 2; ++n) acc[a][b][m][n] = (f32x4){0.f, 0.f, 0.f, 0.f};
    bf16x8 At[4][2], B0[2][2], B1[2][2];
    const char* cA = (const char*)g.A + a_off<Epi>(E, cur.pm, K, tstep); const char* cB = (const char*)g.Bt + (size_t)cur.pn * tstep;
    if constexpr (SP2) {
        PG8_STAGE(PG8_SB(0, 0), cB, voffB); PG8_STAGE(PG8_SB(0, 1), cB + hstep, voffB); PG8_STAGE(PG8_SA(0, 0), cA, voffA); PG8_STAGE(PG8_SA(0, 1), cA + hstep, voffA);
        if (wr == 1) PG8_BAR;
        PG8_WAIT_V(2); PG8_BAR;
        PG8_STAGE(PG8_SB(1, 0), cB + kstep, voffB); PG8_STAGE(PG8_SA(1, 0), cA + kstep, voffA); PG8_STAGE(PG8_SB(1, 1), cB + hstep + kstep, voffB);
        PG8_WAIT_V(6); PG8_BAR;
    } else {
        PG8_STAGE(PG8_SB(0, 0), cB, voffB); PG8_STAGE(PG8_SA(0, 0), cA, voffA); PG8_STAGE(PG8_SB(0, 1), cB + hstep, voffB); PG8_STAGE(PG8_SA(0, 1), cA + hstep, voffA);
        if (wr == 1) PG8_BAR;
        PG8_WAIT_V(4); PG8_BAR;
        PG8_STAGE(PG8_SB(1, 0), cB + kstep, voffB); PG8_STAGE(PG8_SA(1, 0), cA + kstep, voffA); PG8_STAGE(PG8_SB(1, 1), cB + hstep + kstep, voffB);
        PG8_WAIT_V(6); PG8_BAR;
    }
    for (;;) {
        const bool has_next = S.next(ui + 1, nxt);
        const char* nA = has_next ? (const char*)g.A + a_off<Epi>(E, nxt.pm, K, tstep) : cA; const char* nB = has_next ? (const char*)g.Bt + (size_t)nxt.pn * tstep : cB;
#pragma unroll 1
        for (int t = 0; t < nt; t += 2) {
            const bool last = (t == nt - 2);
            if constexpr (Epi::MID) { if (t == nt / 2) E.mid(acc, cur, wr, wc, fr, fq); }
            const char* a1 = cA + (size_t)(t + 1) * kstep;
            const char* a2 = last ? nA : cA + (size_t)(t + 2) * kstep; const char* b2 = last ? nB : cB + (size_t)(t + 2) * kstep;
            const char* a3 = a2 + kstep; const char* b3 = b2 + kstep;
            if constexpr (SP2) {
            PG8_LDB(B0, 0, 0); PG8_LDB(B1, 0, 1); PG8_SCHED; PG8_LDA(At, 0, 0); PG8_STAGE(PG8_SA(1, 1), a1 + hstep, voffA);
            PG8_WAIT_V(8); PG8_WAIT_L(0); PG8_BAR; PG8_MMA(0, 0, At, B0); PG8_MMA(0, 1, At, B1); PG8_BAR; PG8_SCHED;
            PG8_LDA(At, 0, 1); PG8_STAGE(PG8_SB(0, 0), b2, voffB); PG8_STAGE(PG8_SB(0, 1), b2 + hstep, voffB); PG8_STAGE(PG8_SA(0, 0), a2, voffA);
            PG8_WAIT_V(8); PG8_WAIT_L(0); PG8_BAR; PG8_MMA(1, 0, At, B0); PG8_MMA(1, 1, At, B1); PG8_BAR; PG8_SCHED;
            PG8_LDB(B0, 1, 0); PG8_LDB(B1, 1, 1); PG8_SCHED; PG8_LDA(At, 1, 0); PG8_STAGE(PG8_SA(0, 1), a2 + hstep, voffA);
            PG8_WAIT_V(8); PG8_WAIT_L(0); PG8_BAR; PG8_MMA(0, 0, At, B0); PG8_MMA(0, 1, At, B1); PG8_BAR; PG8_SCHED;
            PG8_LDA(At, 1, 1); PG8_STAGE(PG8_SB(1, 0), b3, voffB); PG8_STAGE(PG8_SB(1, 1), b3 + hstep, voffB); PG8_STAGE(PG8_SA(1, 0), a3, voffA);
            PG8_WAIT_V(8); PG8_WAIT_L(0); PG8_BAR; PG8_MMA(1, 0, At, B0); PG8_MMA(1, 1, At, B1); PG8_BAR; PG8_SCHED;
            } else {
            PG8_LDB(B0, 0, 0); PG8_SCHED; PG8_LDA(At, 0, 0); PG8_STAGE(PG8_SA(1, 1), a1 + hstep, voffA);
            PG8_WAIT_L(8); PG8_BAR; PG8_WAIT_L(0); PG8_MMA(0, 0, At, B0); PG8_BAR; PG8_SCHED;
            PG8_LDB(B1, 0, 1); PG8_STAGE(PG8_SB(0, 0), b2, voffB);
            PG8_BAR; PG8_WAIT_L(0); PG8_MMA(0, 1, At, B1); PG8_BAR;
            PG8_LDA(At, 0, 1); PG8_STAGE(PG8_SA(0, 0), a2, voffA);
            PG8_BAR; PG8_WAIT_L(0); PG8_MMA(1, 0, At, B0); PG8_BAR; PG8_SCHED;
            PG8_STAGE(PG8_SB(0, 1), b2 + hstep, voffB);
            PG8_WAIT_V(6); PG8_BAR; PG8_MMA(1, 1, At, B1); PG8_BAR;
            PG8_LDB(B0, 1, 0); PG8_SCHED; PG8_LDA(At, 1, 0); PG8_STAGE(PG8_SA(0, 1), a2 + hstep, voffA);
            PG8_WAIT_L(8); PG8_BAR; PG8_WAIT_L(0); PG8_MMA(0, 0, At, B0); PG8_BAR; PG8_SCHED;
            PG8_LDB(B1, 1, 1); PG8_STAGE(PG8_SB(1, 0), b3, voffB);
            PG8_BAR; PG8_WAIT_L(0); PG8_MMA(0, 1, At, B1); PG8_BAR;
            PG8_LDA(At, 1, 1); PG8_STAGE(PG8_SA(1, 0), a3, voffA);
            PG8_BAR; PG8_WAIT_L(0); PG8_MMA(1, 0, At, B0); PG8_BAR; PG8_SCHED;
            PG8_STAGE(PG8_SB(1, 1), b3 + hstep, voffB);
            PG8_WAIT_V(6); PG8_BAR; PG8_MMA(1, 1, At, B1); PG8_BAR;
            }
        }
        if constexpr (ALIGN_EPI) { if (wr == 0) PG8_BAR; }
        E(acc, cur, wr, wc, fr, fq);
        if (!has_next) break;
#pragma unroll
        for (int a = 0; a < 2; ++a)
#pragma unroll
            for (int b = 0; b < 2; ++b)
#pragma unroll
                for (int m = 0; m < 4; ++m)
#pragma unroll
                    for (int n = 0; n < 2; ++n) acc[a][b][m][n] = (f32x4){0.f, 0.f, 0.f, 0.f};
        cur = nxt; cA = nA; cB = nB; ++ui;
        if constexpr (ALIGN_EPI) { if (wr == 1) PG8_BAR; }
    }
    PG8_WAIT_V(0);
    if constexpr (!ALIGN_EPI) { if (wr == 0) PG8_BAR; }
    PG8_BAR;
#undef PG8_SA
#undef PG8_SB
#undef PG8_STAGE
#undef PG8_LDA
#undef PG8_LDB
#undef PG8_MMA
#undef PG8_WAIT_V
#undef PG8_WAIT_L
#undef PG8_BAR
#undef PG8_SCHED
}
}
using pg8::HALF;

DEVI u32x4 pack8(const f32x4& a, const f32x4& b) { u32x4 w; w.x = pk2(a[0], a[1]); w.y = pk2(a[2], a[3]); w.z = pk2(b[0], b[1]); w.w = pk2(b[2], b[3]); return w; }

struct EpiIn {
    static constexpr bool PERM = true, MID = false, AROW = false;
    const float* rowss; const float* shW; int job;
    bf16_t *d0, *d1, *d2, *d3, *d4; float* ba;
    DEVI void operator()(const f32x4 (&acc)[2][2][4][2], const pg8::Unit& u, int wr, int wc, int fr, int fq) const {
        asm volatile("" : "+v"(fr), "+v"(fq));
        const int vs = u.pm < 64 ? 0 : (u.pm < 128 ? 1 : 2);
        bf16_t* base; int pitch, colt; bool isba = false;
        if (job == 0) { base = d0; pitch = 3072; colt = u.pn * 256; if (u.pn >= 12) isba = true; }
        else {
            if (u.pn < 4) { base = d0; pitch = 1024; colt = u.pn * 256; }
            else if (u.pn < 8) { base = d1; pitch = 1024; colt = (u.pn - 4) * 256; }
            else if (u.pn == 8) { base = d2; pitch = 256; colt = 0; }
            else if (u.pn == 9) { base = d3; pitch = 256; colt = 0; }
            else { base = d4; pitch = 2048; colt = (u.pn - 10) * 256; }
        }
        const int ncol0 = u.pn * 256 + wc * 32 + 8 * fq;
        f32x4 sv[2][2];
#pragma unroll
        for (int bj = 0; bj < 2; ++bj)
#pragma unroll
            for (int n = 0; n < 2; ++n) sv[bj][n] = *(const f32x4*)(shW + vs * NSH + ncol0 + bj * HALF + 4 * n);
        const int row0 = u.pm * 256 + wr * 64 + fr;
#pragma unroll
        for (int ai = 0; ai < 2; ++ai)
#pragma unroll
            for (int m = 0; m < 4; ++m) {
                const int row = row0 + ai * HALF + m * 16;
                const float rs = rsqrtf(rowss[row] * (1.f / 1024.f) + EPS);
                if (!isba) {
                    bf16_t* rowp = base + (size_t)row * pitch + colt + wc * 32 + 8 * fq;
#pragma unroll
                    for (int bj = 0; bj < 2; ++bj) { const f32x4 v0 = acc[ai][bj][m][0] * rs + sv[bj][0], v1 = acc[ai][bj][m][1] * rs + sv[bj][1]; *(u32x4*)(rowp + bj * HALF) = pack8(v0, v1); }
                } else if (wc == 0) {
                    float* rowp = ba + (size_t)row * 32 + 8 * fq;
                    *(f32x4*)(rowp) = acc[ai][0][m][0] * rs + sv[0][0]; *(f32x4*)(rowp + 4) = acc[ai][0][m][1] * rs + sv[0][1];
                }
            }
    }
};
struct EpiBr {
    static constexpr bool PERM = true, MID = true, AROW = false;
    const bf16_t* mg; bf16_t* out;
    DEVI void mid(f32x4 (&acc)[2][2][4][2], const pg8::Unit& u, int wr, int wc, int fr, int fq) const {
        asm volatile("" : "+v"(fr), "+v"(fq));
        const int row0 = u.pm * 256 + wr * 64 + fr, col0 = u.pn * 256 + wc * 32 + 8 * fq;
#pragma unroll
        for (int ai = 0; ai < 2; ++ai)
#pragma unroll
            for (int m = 0; m < 4; ++m) {
                const bf16_t* rp = mg + (size_t)(row0 + ai * HALF + m * 16) * 2048 + col0;
#pragma unroll
                for (int bj = 0; bj < 2; ++bj) {
                    const u32x4 gd = *(const u32x4*)(rp + bj * HALF), ga = *(const u32x4*)(rp + 1024 + bj * HALF);
                    float r[8];
#pragma unroll
                    for (int i = 0; i < 4; ++i) {
                        const float d0 = bflo(gd[i]), d1 = bfhi(gd[i]), a0 = bflo(ga[i]), a1 = bfhi(ga[i]);
                        r[2 * i] = (1.f + __expf(fminf(-a0, 80.f))) * __builtin_amdgcn_rcpf(1.f + __expf(fminf(-d0, 80.f)));
                        r[2 * i + 1] = (1.f + __expf(fminf(-a1, 80.f))) * __builtin_amdgcn_rcpf(1.f + __expf(fminf(-d1, 80.f)));
                    }
                    acc[ai][bj][m][0] *= (f32x4){r[0], r[1], r[2], r[3]}; acc[ai][bj][m][1] *= (f32x4){r[4], r[5], r[6], r[7]};
                    asm volatile("" ::: "memory");
                }
            }
    }
    DEVI void operator()(const f32x4 (&acc)[2][2][4][2], const pg8::Unit& u, int wr, int wc, int fr, int fq) const {
        asm volatile("" : "+v"(fr), "+v"(fq));
        const int row0 = u.pm * 256 + wr * 64 + fr, col0 = u.pn * 256 + wc * 32 + 8 * fq;
#pragma unroll
        for (int ai = 0; ai < 2; ++ai)
#pragma unroll
            for (int m = 0; m < 4; ++m) {
                const size_t row = (size_t)(row0 + ai * HALF + m * 16);
                const bf16_t* rp = mg + row * 2048 + 1024 + col0;
#pragma unroll
                for (int bj = 0; bj < 2; ++bj) {
                    const u32x4 ga = *(const u32x4*)(rp + bj * HALF);
                    float s[8];
#pragma unroll
                    for (int i = 0; i < 4; ++i) { s[2 * i] = __builtin_amdgcn_rcpf(1.f + __expf(fminf(-bflo(ga[i]), 80.f))); s[2 * i + 1] = __builtin_amdgcn_rcpf(1.f + __expf(fminf(-bfhi(ga[i]), 80.f))); }
                    const f32x4 v0 = acc[ai][bj][m][0] * (f32x4){s[0], s[1], s[2], s[3]}, v1 = acc[ai][bj][m][1] * (f32x4){s[4], s[5], s[6], s[7]};
                    *(u32x4*)(out + row * 1024 + col0 + bj * HALF) = pack8(v0, v1);
                }
            }
    }
};
struct EpiOut {
    static constexpr bool PERM = false, MID = false, AROW = false;
    const float* x; const float* modacc; const float* bada; const float* nwf; float* out; bf16_t* x1s; float* rowss2;
    DEVI void operator()(const f32x4 (&acc)[2][2][4][2], const pg8::Unit& u, int wr, int wc, int fr, int fq) const {
        asm volatile("" : "+v"(fr), "+v"(fq));
        const int b = u.pm >> 6; const int row0 = u.pm * 256 + wr * 64 + fr, col0 = u.pn * 256 + wc * 32 + 4 * fq;
        f32x4 ga[2][2], sc[2][2];
#pragma unroll
        for (int bj = 0; bj < 2; ++bj)
#pragma unroll
            for (int n = 0; n < 2; ++n) { const int c = col0 + bj * HALF + n * 16;
                ga[bj][n] = *(const f32x4*)(modacc + b * 6144 + 2048 + c) + *(const f32x4*)(bada + 2048 + c);
                sc[bj][n] = (*(const f32x4*)(modacc + b * 6144 + 4096 + c) + *(const f32x4*)(bada + 4096 + c) + 1.f) * *(const f32x4*)(nwf + c); }
#pragma unroll
        for (int ai = 0; ai < 2; ++ai)
#pragma unroll
            for (int m = 0; m < 4; ++m) {
                const size_t off = (size_t)(row0 + ai * HALF + m * 16) * 1024 + col0; float ss = 0.f;
#pragma unroll
                for (int bj = 0; bj < 2; ++bj)
#pragma unroll
                    for (int n = 0; n < 2; ++n) {
                        const f32x4 xv = *(const f32x4*)(x + off + bj * HALF + n * 16);
                        const f32x4 o = xv + ga[bj][n] * acc[ai][bj][m][n];
                        *(f32x4*)(out + off + bj * HALF + n * 16) = o;
                        ss += (o[0] * o[0] + o[1] * o[1]) + (o[2] * o[2] + o[3] * o[3]);
                        const f32x4 s = o * sc[bj][n]; u32x2 w; w.x = pk2(s[0], s[1]); w.y = pk2(s[2], s[3]);
                        *(u32x2*)(x1s + off + (size_t)(b * (RB - SEQ) + 1) * 1024 + bj * HALF + n * 16) = w;
                    }
                ss += __shfl_xor(ss, 16); ss += __shfl_xor(ss, 32);
                if (fq == 0) atomicAdd(rowss2 + row0 + ai * HALF + m * 16, ss);
            }
    }
};
DEVI f32x4 dpp_ror1(const f32x4& x) { f32x4 r;
#pragma unroll
    for (int i = 0; i < 4; ++i) r[i] = __int_as_float(__builtin_amdgcn_update_dpp(0, __float_as_int(x[i]), 0x121, 0xf, 0xf, false));
    return r; }
DEVI f32x4 dpp_rol1(const f32x4& x) { f32x4 r;
#pragma unroll
    for (int i = 0; i < 4; ++i) r[i] = __int_as_float(__builtin_amdgcn_update_dpp(0, __float_as_int(x[i]), 0x12F, 0xf, 0xf, false));
    return r; }
struct EpiUpConv {
    static constexpr bool PERM = true, MID = false, AROW = true;
    const float* rowss2; const float* shWf; const float* cw; const float* cb; bf16_t* act; LAS float* xb;
    DEVI int arow(int pm) const { const int b = pm / TPB, i = pm - b * TPB; return b * RB + 254 * i; }
    DEVI void operator()(f32x4 (&acc)[2][2][4][2], const pg8::Unit& u, int wr, int wc, int fr, int fq) const {
        asm volatile("" : "+v"(fr), "+v"(fq));
        const int b = u.pm / TPB, ti = u.pm - b * TPB, tok0 = 254 * ti - 1;
        const int cl0 = wc * 32 + 8 * fq;
#pragma unroll
        for (int bj = 0; bj < 2; ++bj) {
            const f32x4 sv0 = *(const f32x4*)(shWf + b * NUP + u.pn * 256 + bj * HALF + cl0), sv1 = *(const f32x4*)(shWf + b * NUP + u.pn * 256 + bj * HALF + cl0 + 4);
#pragma unroll
            for (int ai = 0; ai < 2; ++ai)
#pragma unroll
                for (int m = 0; m < 4; ++m) {
                    const int tok = tok0 + ai * HALF + wr * 64 + m * 16 + fr; const bool ok = tok >= 0 && tok < SEQ;
                    const float rs = ok ? rsqrtf(rowss2[b * SEQ + (ok ? tok : 0)] * (1.f / 1024.f) + EPS) : 0.f;
                    acc[ai][bj][m][0] = ok ? acc[ai][bj][m][0] * rs + sv0 : (f32x4){0.f, 0.f, 0.f, 0.f};
                    acc[ai][bj][m][1] = ok ? acc[ai][bj][m][1] * rs + sv1 : (f32x4){0.f, 0.f, 0.f, 0.f};
                }
        }
#pragma unroll
        for (int ai = 0; ai < 2; ++ai) { const int blk = 2 * ai + wr;
#pragma unroll
            for (int bj = 0; bj < 2; ++bj)
#pragma unroll
                for (int n = 0; n < 2; ++n) {
                    if (fr == 0) *(LAS f32x4*)(xb + (blk * 2 + 0) * 256 + bj * HALF + cl0 + 4 * n) = acc[ai][bj][0][n];
                    if (fr == 15) *(LAS f32x4*)(xb + (blk * 2 + 1) * 256 + bj * HALF + cl0 + 4 * n) = acc[ai][bj][3][n];
                } }
        asm volatile("s_waitcnt lgkmcnt(0)" ::: "memory"); __builtin_amdgcn_s_barrier(); asm volatile("" ::: "memory");
        const int f0 = u.pn * 128 + cl0;
#pragma unroll
        for (int n = 0; n < 2; ++n) {
            f32x4 wg[3], wv[3];
#pragma unroll
            for (int j = 0; j < 3; ++j) { wg[j] = *(const f32x4*)(cw + j * NUP + f0 + 4 * n); wv[j] = *(const f32x4*)(cw + j * NUP + DFF + f0 + 4 * n); }
            const f32x4 bgv = *(const f32x4*)(cb + f0 + 4 * n), bvv = *(const f32x4*)(cb + DFF + f0 + 4 * n);
#pragma unroll
            for (int ai = 0; ai < 2; ++ai) { const int blk = 2 * ai + wr;
                const f32x4 pg = *(const LAS f32x4*)(xb + (((blk + 3) & 3) * 2 + 1) * 256 + cl0 + 4 * n), pv = *(const LAS f32x4*)(xb + (((blk + 3) & 3) * 2 + 1) * 256 + HALF + cl0 + 4 * n);
                const f32x4 ng = *(const LAS f32x4*)(xb + (((blk + 1) & 3) * 2 + 0) * 256 + cl0 + 4 * n), nv = *(const LAS f32x4*)(xb + (((blk + 1) & 3) * 2 + 0) * 256 + HALF + cl0 + 4 * n);
#pragma unroll
                for (int m = 0; m < 4; ++m) {
                    f32x4 ug, uv;
                    { const f32x4 c = acc[ai][0][m][n];
                      f32x4 ra = dpp_ror1(c), la = dpp_rol1(c), rb = m > 0 ? dpp_ror1(acc[ai][0][m > 0 ? m - 1 : 0][n]) : pg, lb = m < 3 ? dpp_rol1(acc[ai][0][m < 3 ? m + 1 : 3][n]) : ng;
                      asm volatile("" : "+v"(ra), "+v"(la), "+v"(rb), "+v"(lb));
                      const f32x4 pr = fr == 0 ? rb : ra, nx = fr == 15 ? lb : la;
                      ug = bgv + wg[0] * pr + wg[1] * c + wg[2] * nx; }
                    asm volatile("" : "+v"(ug));
                    { const f32x4 c = acc[ai][1][m][n];
                      f32x4 ra = dpp_ror1(c), la = dpp_rol1(c), rb = m > 0 ? dpp_ror1(acc[ai][1][m > 0 ? m - 1 : 0][n]) : pv, lb = m < 3 ? dpp_rol1(acc[ai][1][m < 3 ? m + 1 : 3][n]) : nv;
                      asm volatile("" : "+v"(ra), "+v"(la), "+v"(rb), "+v"(lb));
                      const f32x4 pr = fr == 0 ? rb : ra, nx = fr == 15 ? lb : la;
                      uv = bvv + wv[0] * pr + wv[1] * c + wv[2] * nx; }
                    const int r = ai * HALF + wr * 64 + m * 16 + fr, tok = tok0 + r;
                    if (r >= 1 && r <= 254 && tok < SEQ) {
                        u32x2 w; w.x = pk2(siluf(ug[0]) * uv[0], siluf(ug[1]) * uv[1]); w.y = pk2(siluf(ug[2]) * uv[2], siluf(ug[3]) * uv[3]);
                        *(u32x2*)(act + (size_t)(b * SEQ + tok) * DFF + f0 + 4 * n) = w; }
                    asm volatile("" ::: "memory");
                }
            }
        }
    }
};
struct EpiDown {
    static constexpr bool PERM = false, MID = false, AROW = false;
    const float* modacc; const float* bada; float* out;
    DEVI void operator()(const f32x4 (&acc)[2][2][4][2], const pg8::Unit& u, int wr, int wc, int fr, int fq) const {
        asm volatile("" : "+v"(fr), "+v"(fq));
        const int b = u.pm >> 6; const int row0 = u.pm * 256 + wr * 64 + fr, col0 = u.pn * 256 + wc * 32 + 4 * fq;
        f32x4 gf[2][2];
#pragma unroll
        for (int bj = 0; bj < 2; ++bj)
#pragma unroll
            for (int n = 0; n < 2; ++n) { const int c = col0 + bj * HALF + n * 16; gf[bj][n] = *(const f32x4*)(modacc + b * 6144 + 5120 + c) + *(const f32x4*)(bada + 5120 + c); }
#pragma unroll
        for (int ai = 0; ai < 2; ++ai)
#pragma unroll
            for (int m = 0; m < 4; ++m) {
                const size_t off = (size_t)(row0 + ai * HALF + m * 16) * 1024 + col0;
#pragma unroll
                for (int bj = 0; bj < 2; ++bj)
#pragma unroll
                    for (int n = 0; n < 2; ++n) { float* p = out + off + bj * HALF + n * 16; *(f32x4*)p = *(const f32x4*)p + gf[bj][n] * acc[ai][bj][m][n]; }
            }
    }
};

DEVI void transpose_item(const float* W, int srcN, int k0, int n0, bf16_t* dst  , int dstK, LAS float* scr, int lane) {
#pragma unroll 8
    for (int i = 0; i < 32; ++i) { const int kk = 2 * i + (lane >> 5); scr[kk * 33 + (lane & 31)] = W[(size_t)(k0 + kk) * srcN + n0 + (lane & 31)]; }
    asm volatile("s_waitcnt lgkmcnt(0)" ::: "memory");
    const int c = lane & 7;
#pragma unroll
    for (int j = 0; j < 4; ++j) { const int n = (lane >> 3) + 8 * j; const LAS float* s = scr + (8 * c) * 33 + n;
        u32x4 o; o.x = pk2(s[0 * 33], s[1 * 33]); o.y = pk2(s[2 * 33], s[3 * 33]); o.z = pk2(s[4 * 33], s[5 * 33]); o.w = pk2(s[6 * 33], s[7 * 33]);
        *(u32x4*)(dst + (size_t)n * dstK + 8 * c) = o; }
    asm volatile("s_waitcnt lgkmcnt(0)" ::: "memory");
}
DEVI void phase0(const Args& a, LAS unsigned char* lds, int tid, int lane, int wave) {
    unsigned char* ws = a.ws;
    bf16_t* WinA = (bf16_t*)(ws + WS_WINA); bf16_t* WinC = (bf16_t*)(ws + WS_WINC); bf16_t* Wbr = (bf16_t*)(ws + WS_WBR);
    bf16_t* Wout = (bf16_t*)(ws + WS_WOUT); bf16_t* Wup = (bf16_t*)(ws + WS_WUP); bf16_t* Wdn = (bf16_t*)(ws + WS_WDN);
    LAS float* scr = (LAS float*)(lds + wave * 16384);
    const int gw = blockIdx.x * 8 + wave, NGW = gridDim.x * 8;
    constexpr int I_IN = 16 * 241, I_BR = 16 * 32, I_UP = 16 * 176, I_DN = 44 * 32;
    constexpr int NITEMS = I_IN + 3 * I_BR + I_UP + I_DN;
    for (int it = gw; it < NITEMS; it += NGW) {
        int r = it;
        if (r < I_IN) { const int kb = r / 241, nb = r % 241, c0 = nb * 32; bf16_t* d; int row;
            if (c0 < 3072) { d = WinA; row = c0; } else if (c0 < 4096) { d = WinC; row = c0 - 3072; } else if (c0 == 4096) { d = WinA; row = 3072; }
            else if (c0 < 5152) { d = WinC; row = 1024 + (c0 - 4128); } else if (c0 < 5408) { d = WinC; row = 2048 + (c0 - 5152); }
            else if (c0 < 5664) { d = WinC; row = 2304 + (c0 - 5408); } else { d = WinC; row = 2560 + (c0 - 5664); }
            transpose_item(a.in[8], 7712, kb * 64, c0, d + (size_t)row * 1024 + kb * 64, 1024, scr, lane); continue; }
        r -= I_IN;
        if (r < I_BR) { const int kb = r / 32, nb = r % 32; transpose_item(a.in[16], 1024, kb * 64, nb * 32, Wbr + (size_t)(nb * 32) * 2048 + kb * 64, 2048, scr, lane); continue; }
        r -= I_BR;
        if (r < I_BR) { const int kb = r / 32, nb = r % 32; transpose_item(a.in[17], 1024, kb * 64, nb * 32, Wbr + (size_t)(nb * 32) * 2048 + 1024 + kb * 64, 2048, scr, lane); continue; }
        r -= I_BR;
        if (r < I_BR) { const int kb = r / 32, nb = r % 32; transpose_item(a.in[18], 1024, kb * 64, nb * 32, Wout + (size_t)(nb * 32) * 1024 + kb * 64, 1024, scr, lane); continue; }
        r -= I_BR;
        if (r < I_UP) { const int kb = r / 176, nb = r % 176, c0 = nb * 32; int row;
            if (c0 < DFF) row = 256 * (c0 / 128) + (c0 % 128); else { const int c1 = c0 - DFF; row = 256 * (c1 / 128) + 128 + (c1 % 128); }
            transpose_item(a.in[19], NUP, kb * 64, c0, Wup + (size_t)row * 1024 + kb * 64, 1024, scr, lane); continue; }
        r -= I_UP;
        { const int kb = r / 32, nb = r % 32; transpose_item(a.in[22], 1024, kb * 64, nb * 32, Wdn + (size_t)(nb * 32) * DFF + kb * 64, DFF, scr, lane); }
    }
    float* modacc = (float*)(ws + CTL_MODACC);
    for (int it = blockIdx.x; it < 12 * 16; it += gridDim.x) {
        const int cb = it % 12, ks = it / 12, n = cb * 512 + tid;
        float a0 = 0.f, a1 = 0.f, a2 = 0.f;
#pragma unroll 8
        for (int k = ks * 64; k < ks * 64 + 64; ++k) {
            const float w = a.in[4][(size_t)k * 6144 + n];
            a0 += siluf(a.in[1][k]) * w; a1 += siluf(a.in[1][1024 + k]) * w; a2 += siluf(a.in[3][k]) * w;
        }
        atomicAdd(modacc + n, a0); atomicAdd(modacc + 6144 + n, a1); atomicAdd(modacc + 12288 + n, a2);
    }
    float* rope = (float*)(ws + SM_ROPE);
    for (int i = blockIdx.x * 512 + tid; i < 320 * 32; i += gridDim.x * 512) {
        const int p = i >> 5, f = i & 31; const float inv = powf(10000.f, -(float)f / 32.f);
        if (p < 256) { const float ang = (float)p * inv; rope[p * 32 + f] = cosf(ang); rope[8192 + p * 32 + f] = sinf(ang); }
        else { const int q = p - 256; const float ang = (float)q * inv; rope[16384 + q * 32 + f] = cosf(ang); rope[16384 + 2048 + q * 32 + f] = sinf(ang); }
    }
}

DEVI void phase1(const Args& a, int tid, int lane, int wave) {
    unsigned char* ws = a.ws;
    const float* modacc = (const float*)(ws + CTL_MODACC); const float* bada = a.in[5];
    bf16_t* XN = (bf16_t*)(ws + WS_XN); float* rowss1 = (float*)(ws + SM_ROWSS1);
    const int gw = blockIdx.x * 8 + wave, NGW = gridDim.x * 8;
    for (int row = gw; row < MT; row += NGW) {
        const int vs = row < SEQ ? 0 : (row < ML ? 1 : 2);
        const float* xr = row < ML ? a.in[0] + (size_t)row * 1024 : a.in[2] + (size_t)(row - ML) * 1024;
        float ss = 0.f;
#pragma unroll
        for (int j = 0; j < 4; ++j) {
            const int c = 4 * lane + 256 * j;
            const f32x4 v = *(const f32x4*)(xr + c);
            ss += (v[0] * v[0] + v[1] * v[1]) + (v[2] * v[2] + v[3] * v[3]);
            const f32x4 s = (*(const f32x4*)(modacc + vs * 6144 + 1024 + c) + *(const f32x4*)(bada + 1024 + c) + 1.f) * *(const f32x4*)(a.in[6] + c);
            const f32x4 o = v * s; u32x2 w; w.x = pk2(o[0], o[1]); w.y = pk2(o[2], o[3]);
            *(u32x2*)(XN + (size_t)row * 1024 + c) = w;
        }
        ss = wave_sum(ss);
        if (lane == 0) rowss1[row] = ss;
    }
    const bf16_t* WinA = (const bf16_t*)(ws + WS_WINA); const bf16_t* WinC = (const bf16_t*)(ws + WS_WINC); const bf16_t* Wup = (const bf16_t*)(ws + WS_WUP);
    float* shWa = (float*)(ws + SM_SHWA); float* shWf = (float*)(ws + SM_SHWF);
    for (int n = gw; n < NSH + NUP; n += NGW) {
        const bool isf = n >= NSH;
        const bf16_t* wrow = isf ? Wup + (size_t)(n - NSH) * 1024 : (n < NA ? WinA + (size_t)n * 1024 : WinC + (size_t)(n - NA) * 1024);
        const int shoff = isf ? 3072 : 0;
        float s0 = 0.f, s1 = 0.f, s2 = 0.f;
#pragma unroll
        for (int h = 0; h < 2; ++h) {
            const int k0 = h * 512 + lane * 8;
            const u32x4 w = *(const u32x4*)(wrow + k0);
#pragma unroll
            for (int i = 0; i < 4; ++i) {
                const float wl = bflo(w[i]), wh = bfhi(w[i]); const int k = k0 + 2 * i;
                const float b0 = bada[shoff + k], b1 = bada[shoff + k + 1];
                s0 += (modacc[shoff + k] + b0) * wl + (modacc[shoff + k + 1] + b1) * wh;
                s1 += (modacc[6144 + shoff + k] + b0) * wl + (modacc[6144 + shoff + k + 1] + b1) * wh;
                s2 += (modacc[12288 + shoff + k] + b0) * wl + (modacc[12288 + shoff + k + 1] + b1) * wh;
            }
        }
        s0 = wave_sum(s0); s1 = wave_sum(s1); s2 = wave_sum(s2);
        if (lane == 0) {
            if (isf) { shWf[n - NSH] = s0; shWf[NUP + n - NSH] = s1; }
            else { shWa[n] = s0; shWa[NSH + n] = s1; shWa[2 * NSH + n] = s2; }
        }
    }
}

DEVI u32x4 ldrow_(const bf16_t* base, int seq_start, int seq_len, int tt) {
    const int tc = tt < 0 ? 0 : (tt >= seq_len ? seq_len - 1 : tt);
    const u32x4 v = *(const u32x4*)(base + (size_t)(seq_start + tc) * 3072);
    const unsigned m = (tt == tc) ? 0xffffffffu : 0u;
    return (u32x4){v[0] & m, v[1] & m, v[2] & m, v[3] & m};
}
DEVI void phase_dnprep(const Args& a, int tid) {
    unsigned char* ws = a.ws;
    const bf16_t* QR = (const bf16_t*)(ws + WS_QKVR); bf16_t* QP = (bf16_t*)(ws + WS_QKVP);
    const float* convw = a.in[9]; const float* ba = (const float*)(ws + WS_BA);
    float* gb = (float*)(ws + WS_G); float* bb = (float*)(ws + WS_BETA);
    const int cgp = tid & 127, strip = tid >> 7;
    for (int it = blockIdx.x; it < 520 * 3; it += gridDim.x) {
        const int cidx = it / 3, sec = it - cidx * 3;
        int seq_start, t0, seq_len;
        if (cidx < 512) { seq_start = (cidx >> 8) * SEQ; t0 = (cidx & 255) * 64; seq_len = SEQ; }
        else { const int c2 = cidx - 512; seq_start = ML + (c2 >> 2) * CTX; t0 = (c2 & 3) * 64; seq_len = CTX; }
        const int col = sec * 1024 + cgp * 8;
        f32x4 w0[5], w1[5];
#pragma unroll
        for (int j = 0; j < 5; ++j) { w0[j] = *(const f32x4*)(convw + j * 3072 + col); w1[j] = *(const f32x4*)(convw + j * 3072 + col + 4); }
        const int tb = t0 + strip * 16;
        u32x4 win[5];
#define LDROW(tt) ldrow_(QR + col, seq_start, seq_len, (tt))
        win[0] = LDROW(tb - 2); win[1] = LDROW(tb - 1); win[2] = LDROW(tb); win[3] = LDROW(tb + 1);
#pragma unroll
        for (int r = 0; r < 16; ++r) {
            win[4] = LDROW(tb + r + 2);
            f32x4 acc0 = {0.f, 0.f, 0.f, 0.f}, acc1 = {0.f, 0.f, 0.f, 0.f};
#pragma unroll
            for (int j = 0; j < 5; ++j) { const u32x4 x = win[j];
                acc0 += (f32x4){bflo(x[0]), bfhi(x[0]), bflo(x[1]), bfhi(x[1])} * w0[j];
                acc1 += (f32x4){bflo(x[2]), bfhi(x[2]), bflo(x[3]), bfhi(x[3])} * w1[j]; }
            float y[8];
#pragma unroll
            for (int i = 0; i < 4; ++i) { y[i] = siluf(acc0[i]); y[4 + i] = siluf(acc1[i]); }
            if (sec < 2) {
                float ss = 0.f;
#pragma unroll
                for (int i = 0; i < 8; ++i) ss += y[i] * y[i];
                ss += __shfl_xor(ss, 1); ss += __shfl_xor(ss, 2); ss += __shfl_xor(ss, 4); ss += __shfl_xor(ss, 8);
                const float sc = rsqrtf(ss + EPS) * (sec == 0 ? 0.08838834764831845f : 1.f);
#pragma unroll
                for (int i = 0; i < 8; ++i) y[i] *= sc;
            }
            u32x4 o; o.x = pk2(y[0], y[1]); o.y = pk2(y[2], y[3]); o.z = pk2(y[4], y[5]); o.w = pk2(y[6], y[7]);
            *(u32x4*)(QP + (size_t)(seq_start + tb + r) * 3072 + col) = o;
            win[0] = win[1]; win[1] = win[2]; win[2] = win[3]; win[3] = win[4];
        }
#undef LDROW
        if (sec == 0) {
#pragma unroll
            for (int q = 0; q < 2; ++q) {
                const int e = tid + q * 512, r = e >> 4, idx = e & 15, row = seq_start + t0 + r;
                const float bv = ba[(size_t)row * 32 + idx], av = ba[(size_t)row * 32 + 16 + idx];
                const float xs = av + a.in[11][idx];
                const float sp = fmaxf(xs, 0.f) + log1pf(expf(-fabsf(xs)));
                const float g = -expf(a.in[10][idx]) * sp;
                const int dir = idx >> 3, h = idx & 7;
                gb[((size_t)dir * MT + row) * 8 + h] = g;
                bb[((size_t)dir * MT + row) * 8 + h] = 1.f / (1.f + expf(-bv));
            }
        }
    }
}

DEVI void phase_dnscan(const Args& a, int lane, int wave) {
    unsigned char* ws = a.ws;
    const bf16_t* QP = (const bf16_t*)(ws + WS_QKVP);
    const float* gb = (const float*)(ws + WS_G); const float* bb = (const float*)(ws + WS_BETA);
    bf16_t* Of = (bf16_t*)a.out; bf16_t* Ob = Of + (size_t)ML * 1024;
    const int gw = blockIdx.x * 8 + wave, NGW = gridDim.x * 8;
    for (int item = gw; item < 2048; item += NGW) {
        const int chain = item >> 6, ep = item & 63, dir = chain >> 4, b = (chain >> 3) & 1, h = chain & 7;
        bf16_t* O = dir ? Ob : Of;
        float S00 = 0.f, S01 = 0.f, S10 = 0.f, S11 = 0.f;
        const int NTOK = CTX + SEQ;
        constexpr int U = 4;
        unsigned kq[U], qq[U], vv[U]; float gg[U], be[U]; int rows[U];
        auto rowof = [&](int s) -> int { if (s < CTX) { const int t = dir ? CTX - 1 - s : s; return ML + b * CTX + t; } const int t2 = s - CTX; const int t = dir ? SEQ - 1 - t2 : t2; return b * SEQ + t; };
#define SC_LOAD(i, s) do { const int row_ = rowof(s); rows[i] = row_; const bf16_t* p_ = QP + (size_t)row_ * 3072 + h * 128; \
        qq[i] = *(const unsigned*)(p_ + 2 * lane); kq[i] = *(const unsigned*)(p_ + 1024 + 2 * lane); vv[i] = *(const unsigned*)(p_ + 2048 + 2 * ep); \
        gg[i] = gb[((size_t)dir * MT + row_) * 8 + h]; be[i] = bb[((size_t)dir * MT + row_) * 8 + h]; } while (0)
        for (int s0 = 0; s0 < NTOK; s0 += U) {
#pragma unroll
            for (int i = 0; i < U; ++i) SC_LOAD(i, s0 + i);
#pragma unroll
            for (int i = 0; i < U; ++i) {
                const float k0 = bflo(kq[i]), k1 = bfhi(kq[i]), q0 = bflo(qq[i]), q1 = bfhi(qq[i]), v0 = bflo(vv[i]), v1 = bfhi(vv[i]);
                const float eg = __expf(gg[i]), bt = be[i];
                float p0 = k0 * S00 + k1 * S10, p1 = k0 * S01 + k1 * S11;
                p0 = wave_sum(p0); p1 = wave_sum(p1);
                const float vn0 = bt * (v0 - eg * p0), vn1 = bt * (v1 - eg * p1);
                S00 = eg * S00 + k0 * vn0; S01 = eg * S01 + k0 * vn1; S10 = eg * S10 + k1 * vn0; S11 = eg * S11 + k1 * vn1;
                float o0 = q0 * S00 + q1 * S10, o1 = q0 * S01 + q1 * S11;
                o0 = wave_sum(o0); o1 = wave_sum(o1);
                if (lane == 0 && rows[i] < ML) *(unsigned*)(O + (size_t)rows[i] * 1024 + h * 128 + 2 * ep) = pk2(o0, o1);
            }
        }
#undef SC_LOAD
    }
}

DEVI bf16x8 ld_b128(LAS const unsigned char* p) { return *(LAS const bf16x8*)p; }
DEVI bf16x8 ld_2b64(LAS const unsigned char* p0, LAS const unsigned char* p1) { const u32x2 a = *(LAS const u32x2*)p0, b = *(LAS const u32x2*)p1; u32x4 w = {a.x, a.y, b.x, b.y}; return __builtin_bit_cast(bf16x8, w); }
DEVI bf16x8 pack_frag(const f32x4& lo, const f32x4& hi) { u32x4 w = {pk2(lo[0], lo[1]), pk2(lo[2], lo[3]), pk2(hi[0], hi[1]), pk2(hi[2], hi[3])}; return __builtin_bit_cast(bf16x8, w); }
#define MFMA16(A, B, C) __builtin_amdgcn_mfma_f32_16x16x32_bf16(A, B, C, 0, 0, 0)
DEVI void phase_dnchunk(const Args& a, LAS unsigned char* lds, int tid, int lane, int wave) {
    unsigned char* ws = a.ws;
    const bf16_t* QP = (const bf16_t*)(ws + WS_QKVP); const float* gb = (const float*)(ws + WS_G); const float* bb = (const float*)(ws + WS_BETA);
    bf16_t* TQ = (bf16_t*)(ws + WS_TQ); float* AV = (float*)(ws + WS_AVEC);
    constexpr int KL = 0, QL = 17408, KKF = 34816, QKF = 52224, VEC = 131072;
    const int fr = lane & 15, g = lane >> 4, d = wave >> 2, wq = wave & 3;
    LAS unsigned char* dbase = lds + d * 64512;
    LAS float* Gg = (LAS float*)(lds + VEC); LAS float* Bv = Gg + 128; LAS float* GC = Gg + 256;
    for (int item = blockIdx.x; item < 520 * 8; item += gridDim.x) {
        const int cidx = item >> 3, h = item & 7;
        const int row0 = cidx < 512 ? cidx * 64 : ML + (cidx - 512) * 64;
#pragma unroll
        for (int i = 0; i < 2; ++i) { const int c = tid + i * 512, r = c >> 4, ch = c & 15;
            const bf16_t* src = QP + (size_t)(row0 + r) * 3072 + h * 128 + ch * 8;
            *(LAS u32x4*)(lds + QL + r * 272 + ch * 16) = *(const u32x4*)src; *(LAS u32x4*)(lds + KL + r * 272 + ch * 16) = *(const u32x4*)(src + 1024); }
        if (tid < 128) { const int dd = tid >> 6, pos = tid & 63; Gg[tid] = gb[((size_t)dd * MT + row0 + pos) * 8 + h]; Bv[tid] = bb[((size_t)dd * MT + row0 + pos) * 8 + h]; }
        __syncthreads();
        if (wave < 2) {
            const int dd = wave, pos = dd ? 63 - lane : lane; float x = Gg[dd * 64 + pos];
#pragma unroll
            for (int o = 1; o < 64; o <<= 1) { const float y = __shfl_up(x, o); if (lane >= o) x += y; }
            const float total = __shfl(x, 63);
            GC[dd * 64 + pos] = x;
            float* av = AV + ((size_t)item * 2 + dd) * 256;
            av[pos] = __expf(x); av[64 + pos] = Bv[dd * 64 + pos]; av[128 + pos] = __expf(total - x); if (lane == 0) av[192] = __expf(total);
        }
        {
            const int src = d ? QL : KL;
            f32x4 acc[4] = {{0.f, 0.f, 0.f, 0.f}, {0.f, 0.f, 0.f, 0.f}, {0.f, 0.f, 0.f, 0.f}, {0.f, 0.f, 0.f, 0.f}};
#pragma unroll
            for (int s4 = 0; s4 < 4; ++s4) { const bf16x8 A = ld_b128(lds + src + (16 * wq + fr) * 272 + (32 * s4 + 8 * g) * 2);
#pragma unroll
                for (int jt = 0; jt < 4; ++jt) { const bf16x8 Bf = ld_b128(lds + KL + (16 * jt + fr) * 272 + (32 * s4 + 8 * g) * 2); acc[jt] = MFMA16(A, Bf, acc[jt]); } }
            LAS float* dst = (LAS float*)(lds + (d ? QKF : KKF));
#pragma unroll
            for (int jt = 0; jt < 4; ++jt)
#pragma unroll
                for (int r = 0; r < 4; ++r) dst[(16 * wq + 4 * g + r) * 68 + 16 * jt + fr] = acc[jt][r];
        }
        __syncthreads();
        f32x4 P[4], qd[4];
        {
            const LAS float* kkf = (const LAS float*)(lds + KKF); const LAS float* qkf = (const LAS float*)(lds + QKF);
            float gci[4], bei[4];
#pragma unroll
            for (int r = 0; r < 4; ++r) { gci[r] = GC[d * 64 + 16 * wq + 4 * g + r]; bei[r] = Bv[d * 64 + 16 * wq + 4 * g + r]; }
#pragma unroll
            for (int jt = 0; jt < 4; ++jt) { const int j = 16 * jt + fr; const float gcj = GC[d * 64 + j];
#pragma unroll
                for (int r = 0; r < 4; ++r) { const int i = 16 * wq + 4 * g + r; const bool incl = d ? (i <= j) : (i >= j);
                    const float e = incl ? __expf(gci[r] - gcj) : 0.f;
                    qd[jt][r] = qkf[i * 68 + j] * e; P[jt][r] = (i != j) ? -bei[r] * kkf[i * 68 + j] * e : 0.f; } }
        }
        __syncthreads();
        {
#pragma unroll
            for (int jt = 0; jt < 4; ++jt) {
#pragma unroll
                for (int r = 0; r < 4; ++r) { const int i = 16 * wq + 4 * g + r, j = 16 * jt + fr;
                    *(LAS unsigned short*)(dbase + 0 + i * 144 + j * 2) = (unsigned short)f2bf(P[jt][r]);
                    *(LAS unsigned short*)(dbase + 36864 + 9216 + i * 144 + j * 2) = (unsigned short)f2bf(P[jt][r]);
                    *(LAS unsigned short*)(dbase + 55296 + i * 144 + j * 2) = (unsigned short)f2bf(qd[jt][r]); }
                u32x2 w = {pk2(P[jt][0], P[jt][1]), pk2(P[jt][2], P[jt][3])};
                *(LAS u32x2*)(dbase + 18432 + (16 * jt + fr) * 144 + (16 * wq + 4 * g) * 2) = w; }
        }
        __syncthreads();
        int cur = 0;
#pragma unroll 1
        for (int it = 0; it < 5; ++it) {
            LAS unsigned char* NRc = dbase + cur * 9216; LAS unsigned char* NTc = dbase + 18432 + cur * 9216;
            LAS unsigned char* NRn = dbase + (cur ^ 1) * 9216; LAS unsigned char* NTn = dbase + 18432 + (cur ^ 1) * 9216;
            LAS unsigned char* PRo = dbase + 36864 + ((it + 1) & 1) * 9216; LAS unsigned char* PRn = dbase + 36864 + (it & 1) * 9216;
            f32x4 n2[4] = {{0.f, 0.f, 0.f, 0.f}, {0.f, 0.f, 0.f, 0.f}, {0.f, 0.f, 0.f, 0.f}, {0.f, 0.f, 0.f, 0.f}};
#pragma unroll
            for (int s2 = 0; s2 < 2; ++s2) { const bf16x8 A = ld_b128(NRc + (16 * wq + fr) * 144 + (32 * s2 + 8 * g) * 2);
#pragma unroll
                for (int jt = 0; jt < 4; ++jt) { const bf16x8 Bf = ld_b128(NTc + (16 * jt + fr) * 144 + (32 * s2 + 8 * g) * 2); n2[jt] = MFMA16(A, Bf, n2[jt]); } }
#pragma unroll
            for (int jt = 0; jt < 4; ++jt) {
#pragma unroll
                for (int r = 0; r < 4; ++r) *(LAS unsigned short*)(NRn + (16 * wq + 4 * g + r) * 144 + (16 * jt + fr) * 2) = (unsigned short)f2bf(n2[jt][r]);
                u32x2 w = {pk2(n2[jt][0], n2[jt][1]), pk2(n2[jt][2], n2[jt][3])};
                *(LAS u32x2*)(NTn + (16 * jt + fr) * 144 + (16 * wq + 4 * g) * 2) = w;
                P[jt] += n2[jt]; }
            __syncthreads();
#pragma unroll
            for (int s2 = 0; s2 < 2; ++s2) { const bf16x8 A = ld_b128(PRo + (16 * wq + fr) * 144 + (32 * s2 + 8 * g) * 2);
#pragma unroll
                for (int jt = 0; jt < 4; ++jt) { const bf16x8 Bf = ld_b128(NTn + (16 * jt + fr) * 144 + (32 * s2 + 8 * g) * 2); P[jt] = MFMA16(A, Bf, P[jt]); } }
#pragma unroll
            for (int jt = 0; jt < 4; ++jt)
#pragma unroll
                for (int r = 0; r < 4; ++r) *(LAS unsigned short*)(PRn + (16 * wq + 4 * g + r) * 144 + (16 * jt + fr) * 2) = (unsigned short)f2bf(P[jt][r]);
            cur ^= 1;
        }
        __syncthreads();
        {
            bf16_t* dst = TQ + ((size_t)item * 2 + d) * 8192; const int t2 = tid & 255;
#pragma unroll
            for (int k = 0; k < 4; ++k) { const int c = t2 + 256 * k, mat = c >> 9, r = (c >> 3) & 63, ch = c & 7;
                const u32x4 v = *(LAS const u32x4*)(dbase + (mat ? 55296 : 36864) + r * 144 + ch * 16);
                *(u32x4*)(dst + mat * 4096 + r * 64 + ch * 8) = v; }
        }
        __syncthreads();
    }
}

DEVI void phase_dnscan2(const Args& a, LAS unsigned char* lds, int tid, int lane, int wave, unsigned long long& pr_extra) {
    const int v = blockIdx.x;
    unsigned char* ws = a.ws;
    const bf16_t* QP = (const bf16_t*)(ws + WS_QKVP); const bf16_t* TQ = (const bf16_t*)(ws + WS_TQ); const float* AV = (const float*)(ws + WS_AVEC);
    unsigned* prog = (unsigned*)(ws + CTL_PROG);
    constexpr int NSTEP = 260;
    if (v < 128) {
    const int chain = (v & 7) + 8 * ((v >> 3) & 3), qt = v >> 5, dir = chain >> 4, b = (chain >> 3) & 1, h = chain & 7;
    bf16_t* O = (bf16_t*)a.out + (size_t)dir * ML * 1024;
    constexpr int KL = 0, QL = 16384, TL = 32768, DL = 40960, VL = 49152, AL = 53248, BUFB = 54272, OT = 2 * BUFB;
    const int fr0 = lane & 15, g0 = lane >> 4, ltid = tid - 128;
    auto step_cidx = [&](int s) -> int { if (s < 4) return 512 + b * 4 + (dir ? 3 - s : s); const int c = s - 4; return b * 256 + (dir ? 255 - c : c); };
    struct LSet { u32x4 q[3], k[3], t[2], d[2], v, av; };
#define LD_ISSUE(R, s_) do { const int cidx_ = step_cidx(s_); const int row0_ = cidx_ < 512 ? cidx_ * 64 : ML + (cidx_ - 512) * 64; \
        const bf16_t* tqb_ = TQ + ((size_t)(cidx_ * 8 + h) * 2 + dir) * 8192; const float* avb_ = AV + ((size_t)(cidx_ * 8 + h) * 2 + dir) * 256; \
        int lt_ = ltid; asm volatile("" : "+v"(lt_)); \
        const bf16_t* pq_ = QP + (size_t)(row0_ + (lt_ >> 4)) * 3072 + h * 128 + (lt_ & 15) * 8; \
        const bf16_t* pt_ = tqb_ + (lt_ >> 3) * 64 + (lt_ & 7) * 8; \
        _Pragma("unroll") for (int i = 0; i < 3; ++i) { const size_t o_ = (i < 2 || lt_ < 256) ? (size_t)i * 24 * 3072 : 0; R.q[i] = *(const u32x4*)(pq_ + o_); R.k[i] = *(const u32x4*)(pq_ + o_ + 1024); } \
        _Pragma("unroll") for (int i = 0; i < 2; ++i) { const int o_ = (i < 1 || lt_ < 128) ? i * 48 * 64 : 0; R.t[i] = *(const u32x4*)(pt_ + o_); R.d[i] = *(const u32x4*)(pt_ + 4096 + o_); } \
        R.v = *(const u32x4*)(QP + (size_t)(row0_ + ((lt_ & 255) >> 2)) * 3072 + 2048 + h * 128 + qt * 32 + (lt_ & 3) * 8); \
        R.av = *(const u32x4*)(avb_ + (lt_ & 63) * 4); } while (0)
#define LD_WRITE(R, bo_) do { int lt_ = ltid; asm volatile("" : "+v"(lt_)); LAS unsigned char* B_ = lds + (bo_); \
        const int chq_ = lt_ & 15, cht_ = lt_ & 7; \
        _Pragma("unroll") for (int i = 0; i < 3; ++i) if (i < 2 || lt_ < 256) { const int r = (lt_ >> 4) + 24 * i; const int o_ = r * 256 + ((chq_ ^ (4 * (r & 3) + ((r >> 3) & 3))) << 4); \
            *(LAS u32x4*)(B_ + QL + o_) = R.q[i]; *(LAS u32x4*)(B_ + KL + o_) = R.k[i]; } \
        _Pragma("unroll") for (int i = 0; i < 2; ++i) if (i < 1 || lt_ < 128) { const int r = (lt_ >> 3) + 48 * i; const int o_ = r * 128 + ((cht_ ^ (2 * ((r >> 3) & 3) + ((r >> 1) & 1))) << 4); \
            *(LAS u32x4*)(B_ + TL + o_) = R.t[i]; *(LAS u32x4*)(B_ + DL + o_) = R.d[i]; } \
        if (lt_ < 256) { const int r = lt_ >> 2; *(LAS u32x4*)(B_ + VL + r * 64 + (((lt_ & 3) ^ (2 * ((r >> 3) & 1))) << 4)) = R.v; } \
        if (lt_ < 64) *(LAS u32x4*)(B_ + AL + lt_ * 16) = R.av; } while (0)
#define OT_OUT(s_) do { const int cidx_ = step_cidx(s_); const int row0_ = cidx_ * 64; LAS const unsigned char* ot_ = lds + OT + ((s_) & 1) * 4096; \
        int lt_ = ltid; asm volatile("" : "+v"(lt_)); \
        if (lt_ < 256) { const int r = lt_ >> 2, ch = lt_ & 3; \
            *(u32x4*)(O + (size_t)(row0_ + r) * 1024 + h * 128 + qt * 32 + ch * 8) = *(LAS const u32x4*)(ot_ + r * 64 + ((ch ^ (2 * ((r >> 3) & 1))) << 4)); } } while (0)
    f32x4 S[8];
#pragma unroll
    for (int i = 0; i < 8; ++i) S[i] = (f32x4){0.f, 0.f, 0.f, 0.f};
#define STEP_BAR(wsel) do { const unsigned long long tb_ = PROBE_SUB ? __builtin_amdgcn_s_memrealtime() : 0ull; \
        asm volatile("s_waitcnt lgkmcnt(0)" ::: "memory"); __builtin_amdgcn_s_barrier(); asm volatile("" ::: "memory"); \
        if ((PROBE_SUB == 1 && wave == 0 && (wsel) == 0) || (PROBE_SUB == 2 && wave == 2 && (wsel) == 1)) pr_extra += __builtin_amdgcn_s_memrealtime() - tb_; } while (0)
#define LOAD_STEP(s, RW) do { STEP_BAR(1); \
            if (qt == 0 && ltid == 0) __hip_atomic_store(prog + chain * 64, (unsigned)((s) + 1), __ATOMIC_RELAXED, __HIP_MEMORY_SCOPE_AGENT); \
            if ((s) + 1 < NSTEP) LD_WRITE(RW, (((s) + 1) & 1) * BUFB); \
            if ((s) + 4 < NSTEP) LD_ISSUE(RW, (s) + 4); \
            if ((s) >= 5) OT_OUT((s) - 1); } while (0)
    auto scan_compute = [&](int s) {
            int fr = fr0, g = g0; asm volatile("" : "+v"(fr), "+v"(g));
            LAS const unsigned char* B = lds + (s & 1) * BUFB;
            const LAS float* avl = (const LAS float*)(B + AL);
            const int rowl = 8 * (fr >> 2) + (fr & 3);
            const int fk = 4 * (fr & 3) + (fr >> 2), ft = 2 * (fr >> 2) + ((fr >> 1) & 1);
            const int vcol = ((((2 * wave + (fr >> 3)) ^ (2 * (g & 1))) << 4) + (fr & 7) * 2);
#define SBAR_() __builtin_amdgcn_sched_barrier(0)
#define ROWK(pt) ((32 * ((pt) >> 1) + 4 * ((pt) & 1) + rowl) * 256)
#define ROWT(pt) ((32 * ((pt) >> 1) + 4 * ((pt) & 1) + rowl) * 128)
#define P0(pt) (32 * ((pt) >> 1) + 8 * g + 4 * ((pt) & 1))
#define LDK8(dst, base, pa) do { _Pragma("unroll") for (int s4 = 0; s4 < 4; ++s4) { dst[s4] = ld_b128(B + (base) + ROWK(pa) + (((4 * s4 + g) ^ fk) << 4)); dst[4 + s4] = ld_b128(B + (base) + ROWK((pa) + 1) + (((4 * s4 + g) ^ fk) << 4)); } } while (0)
#define LDT8(dst, base) do { _Pragma("unroll") for (int pt = 0; pt < 4; ++pt) { dst[2 * pt] = ld_b128(B + (base) + ROWT(pt) + ((g ^ ft) << 4)); dst[2 * pt + 1] = ld_b128(B + (base) + ROWT(pt) + (((4 + g) ^ ft) << 4)); } } while (0)
#define MM8(acc, fa, pa) do { _Pragma("unroll") for (int s4 = 0; s4 < 4; ++s4) { acc[pa] = MFMA16(fa[s4], Sb[s4], acc[pa]); acc[(pa) + 1] = MFMA16(fa[4 + s4], Sb[s4], acc[(pa) + 1]); } } while (0)
            const int trq = fr >> 2, trp = fr & 3;
            LAS unsigned char* kp0 = (LAS unsigned char*)(B + KL + (8 * g + trq) * 256);
            const int fkt = 4 * trq + g;
#define KT_LOAD(dst, d0) do { _Pragma("unroll") for (int j = 0; j < 4; ++j) { const int dt_ = (d0) + j; const int co = (((4 * (dt_ >> 1) + trp) ^ fkt) << 4) + 8 * (dt_ & 1); \
                const s16x4 a0 = __builtin_bit_cast(s16x4, __builtin_amdgcn_ds_read_tr16_b64_v4i16((LAS s16x4*)(kp0 + co))), a1 = __builtin_bit_cast(s16x4, __builtin_amdgcn_ds_read_tr16_b64_v4i16((LAS s16x4*)(kp0 + co + 4 * 256))); \
                const s16x4 a2 = __builtin_bit_cast(s16x4, __builtin_amdgcn_ds_read_tr16_b64_v4i16((LAS s16x4*)(kp0 + co + 32 * 256))), a3 = __builtin_bit_cast(s16x4, __builtin_amdgcn_ds_read_tr16_b64_v4i16((LAS s16x4*)(kp0 + co + 36 * 256))); \
                dst[2 * j] = (bf16x8){a0[0], a0[1], a0[2], a0[3], a1[0], a1[1], a1[2], a1[3]}; dst[2 * j + 1] = (bf16x8){a2[0], a2[1], a2[2], a2[3], a3[0], a3[1], a3[2], a3[3]}; } } while (0)
            bf16x8 fA[8], fB[8], fC[8];
            f32x4 avp[4], bvp[4]; unsigned short vraw[4][4];
            LDK8(fA, KL, 0); LDK8(fB, KL, 2);
#pragma unroll
            for (int pt = 0; pt < 4; ++pt) { avp[pt] = *(const LAS f32x4*)(avl + P0(pt)); bvp[pt] = *(const LAS f32x4*)(avl + 64 + P0(pt));
#pragma unroll
                for (int r = 0; r < 4; ++r) vraw[pt][r] = *(const LAS unsigned short*)(B + VL + (P0(pt) + r) * 64 + vcol); }
            bf16x8 Sb[4];
#pragma unroll
            for (int s4 = 0; s4 < 4; ++s4) Sb[s4] = pack_frag(S[2 * s4], S[2 * s4 + 1]);
            f32x4 Z[4], OQ[4], X[4];
#pragma unroll
            for (int pt = 0; pt < 4; ++pt) { Z[pt] = (f32x4){0.f, 0.f, 0.f, 0.f}; OQ[pt] = (f32x4){0.f, 0.f, 0.f, 0.f}; }
            SBAR_();
            LDT8(fC, TL); SBAR_(); MM8(Z, fA, 0); SBAR_();
            LDK8(fA, QL, 0); SBAR_(); MM8(Z, fB, 2); SBAR_();
#pragma unroll
            for (int pt = 0; pt < 4; ++pt)
#pragma unroll
                for (int r = 0; r < 4; ++r) Z[pt][r] = bvp[pt][r] * (bf2f(vraw[pt][r]) - avp[pt][r] * Z[pt][r]);
            LDK8(fB, QL, 2); SBAR_();
            { const bf16x8 Zb0 = pack_frag(Z[0], Z[1]), Zb1 = pack_frag(Z[2], Z[3]);
#pragma unroll
              for (int pt = 0; pt < 4; ++pt) { X[pt] = MFMA16(fC[2 * pt], Zb0, Z[pt]); X[pt] = MFMA16(fC[2 * pt + 1], Zb1, X[pt]); } }
            SBAR_();
            LDT8(fC, DL); SBAR_(); MM8(OQ, fA, 0); SBAR_();
            KT_LOAD(fA, 0); SBAR_(); MM8(OQ, fB, 2); SBAR_();
            const float egl = avl[192];
            bf16x8 Xc0, Xc1;
            { const bf16x8 Xb0 = pack_frag(X[0], X[1]), Xb1 = pack_frag(X[2], X[3]);
              f32x4 cx[4];
#pragma unroll
              for (int pt = 0; pt < 4; ++pt) cx[pt] = X[pt] * *(const LAS f32x4*)(avl + 128 + P0(pt));
              Xc0 = pack_frag(cx[0], cx[1]); Xc1 = pack_frag(cx[2], cx[3]);
              KT_LOAD(fB, 4); SBAR_();
#pragma unroll
              for (int pt = 0; pt < 4; ++pt) { f32x4 o2 = OQ[pt] * avp[pt]; o2 = MFMA16(fC[2 * pt], Xb0, o2); OQ[pt] = MFMA16(fC[2 * pt + 1], Xb1, o2); } }
            SBAR_();
#pragma unroll
            for (int j = 0; j < 4; ++j) { f32x4 sn = S[j] * egl; sn = MFMA16(fA[2 * j], Xc0, sn); S[j] = MFMA16(fA[2 * j + 1], Xc1, sn); }
            SBAR_();
#pragma unroll
            for (int j = 0; j < 4; ++j) { f32x4 sn = S[4 + j] * egl; sn = MFMA16(fB[2 * j], Xc0, sn); S[4 + j] = MFMA16(fB[2 * j + 1], Xc1, sn); }
            { LAS unsigned char* ot = lds + OT + (s & 1) * 4096;
#pragma unroll
              for (int pt = 0; pt < 4; ++pt)
#pragma unroll
                  for (int r = 0; r < 4; ++r) *(LAS unsigned short*)(ot + (P0(pt) + r) * 64 + vcol) = (unsigned short)f2bf(OQ[pt][r]); }
#undef KT_LOAD
#undef LDK8
#undef LDT8
#undef MM8
#undef ROWK
#undef ROWT
#undef P0
#undef SBAR_
    };
    if (wave >= 2) {
        LSet R0, R1, R2;
        LD_ISSUE(R0, 0); LD_WRITE(R0, 0); LD_ISSUE(R1, 1); LD_ISSUE(R2, 2); LD_ISSUE(R0, 3);
#pragma unroll 1
        for (int s0 = 0; s0 < NSTEP; s0 += 3) {
            LOAD_STEP(s0, R1);
            if (s0 + 1 < NSTEP) LOAD_STEP(s0 + 1, R2);
            if (s0 + 2 < NSTEP) LOAD_STEP(s0 + 2, R0);
        }
        STEP_BAR(2);
        OT_OUT(NSTEP - 1);
    } else {
#pragma unroll 1
        for (int s = 0; s < NSTEP; ++s) { STEP_BAR(0); scan_compute(s); }
        STEP_BAR(2);
    }
#undef LOAD_STEP
#undef STEP_BAR
#undef LD_ISSUE
#undef LD_WRITE
#undef OT_OUT
    } else {
        const int vp = v - 128, chain = (vp & 7) + 8 * ((vp >> 3) & 3), role = vp >> 5, dir = chain >> 4, b = (chain >> 3) & 1, h = chain & 7;
        const int nteam = (((int)gridDim.x - 128) >> 5) * 8;
        constexpr int PFD2 = 6;
        if (role * 8 + wave < nteam) {
#pragma unroll 1
        for (int st = role * 8 + wave; st < NSTEP; st += nteam) {
            unsigned spins = 0;
            while ((int)__builtin_amdgcn_readfirstlane((int)__hip_atomic_load(prog + chain * 64, __ATOMIC_RELAXED, __HIP_MEMORY_SCOPE_AGENT)) + PFD2 < st) { __builtin_amdgcn_s_sleep(8); if (++spins > (1u << 20)) break; }
            int cidx; if (st < 4) cidx = 512 + b * 4 + (dir ? 3 - st : st); else { const int c = st - 4; cidx = b * 256 + (dir ? 255 - c : c); }
            const int row0 = cidx < 512 ? cidx * 64 : ML + (cidx - 512) * 64;
            const char* tqb = (const char*)(TQ + ((size_t)(cidx * 8 + h) * 2 + dir) * 8192); const char* avb = (const char*)(AV + ((size_t)(cidx * 8 + h) * 2 + dir) * 256);
            unsigned acc = 0;
#pragma unroll
            for (int j = 0; j < 9; ++j) { const int L = j * 64 + lane; const char* p_;
                if (L < 384) { const int rw = L / 6, part = L - rw * 6; p_ = (const char*)(QP + (size_t)(row0 + rw) * 3072 + h * 128) + (part >> 1) * 2048 + (part & 1) * 128; }
                else if (L < 512) p_ = tqb + (L - 384) * 128; else p_ = avb + ((L - 512) & 7) * 128;
                acc ^= *(const unsigned*)p_; }
            asm volatile("" :: "v"(acc));
        }
        }
    }
}

DEVI void phase_prep2(const Args& a, int lane, int wave) {
    unsigned char* ws = a.ws;
    bf16_t* KAT = (bf16_t*)(ws + WS_KAT); const float* rope = (const float*)(ws + SM_ROPE); const float* knw = a.in[14];
    const int gw = blockIdx.x * 8 + wave, NGW = gridDim.x * 8;
    for (int row = gw; row < MT; row += NGW) {
        bf16_t* p = KAT + (size_t)row * 256 + lane * 4;
        const u32x2 w = *(const u32x2*)p;
        float x[4] = {bflo(w.x), bfhi(w.x), bflo(w.y), bfhi(w.y)};
        float ss = (x[0] * x[0] + x[1] * x[1]) + (x[2] * x[2] + x[3] * x[3]);
        ss += __shfl_xor(ss, 1); ss += __shfl_xor(ss, 2); ss += __shfl_xor(ss, 4); ss += __shfl_xor(ss, 8); ss += __shfl_xor(ss, 16);
        const float rs = rsqrtf(ss * (1.f / 128.f) + EPS);
        const int d = (lane & 31) * 4;
        const f32x4 nw = *(const f32x4*)(knw + d);
#pragma unroll
        for (int i = 0; i < 4; ++i) x[i] = x[i] * rs * nw[i];
        float pr[4];
#pragma unroll
        for (int i = 0; i < 4; ++i) pr[i] = __shfl_xor(x[i], 8);
        if (row < ML) {
            const int t = row & (SEQ - 1), lg = (lane & 31) >> 3, fi = (lane & 7) * 4;
            const float* ct = lg < 2 ? rope + (t >> 6) * 32 + fi : rope + 16384 + (t & 63) * 32 + fi;
            const float* st = lg < 2 ? ct + 8192 : ct + 2048;
            const f32x4 c = *(const f32x4*)ct, s = *(const f32x4*)st;
            const float sg = (lg & 1) ? 1.f : -1.f;
#pragma unroll
            for (int i = 0; i < 4; ++i) x[i] = x[i] * c[i] + sg * pr[i] * s[i];
        }
        u32x2 o; o.x = pk2(x[0], x[1]); o.y = pk2(x[2], x[3]);
        *(u32x2*)p = o;
    }
    const bf16_t* Of = (const bf16_t*)a.out; const bf16_t* Ob = Of + (size_t)ML * 1024;
    const bf16_t* GT = (const bf16_t*)(ws + WS_GT); bf16_t* Y = (bf16_t*)(ws + WS_Y); const float* dnw = a.in[12];
    for (int row = gw; row < ML; row += NGW) {
        const int c0 = lane * 16;
        float o[16];
#pragma unroll
        for (int hh = 0; hh < 2; ++hh) {
            const u32x4 f = *(const u32x4*)(Of + (size_t)row * 1024 + c0 + hh * 8), bk = *(const u32x4*)(Ob + (size_t)row * 1024 + c0 + hh * 8);
#pragma unroll
            for (int i = 0; i < 4; ++i) { o[hh * 8 + 2 * i] = bflo(f[i]) + bflo(bk[i]); o[hh * 8 + 2 * i + 1] = bfhi(f[i]) + bfhi(bk[i]); }
        }
        float ss = 0.f;
#pragma unroll
        for (int i = 0; i < 16; ++i) ss += o[i] * o[i];
        ss += __shfl_xor(ss, 1); ss += __shfl_xor(ss, 2); ss += __shfl_xor(ss, 4);
        const float rs = rsqrtf(ss * (1.f / 128.f) + EPS);
        const int d0 = c0 & 127;
#pragma unroll
        for (int hh = 0; hh < 2; ++hh) {
            const u32x4 gt = *(const u32x4*)(GT + (size_t)row * 1024 + c0 + hh * 8);
            float y[8];
#pragma unroll
            for (int i = 0; i < 4; ++i) {
                y[2 * i] = o[hh * 8 + 2 * i] * rs * dnw[d0 + hh * 8 + 2 * i] * siluf(bflo(gt[i]));
                y[2 * i + 1] = o[hh * 8 + 2 * i + 1] * rs * dnw[d0 + hh * 8 + 2 * i + 1] * siluf(bfhi(gt[i]));
            }
            u32x4 w; w.x = pk2(y[0], y[1]); w.y = pk2(y[2], y[3]); w.z = pk2(y[4], y[5]); w.w = pk2(y[6], y[7]);
            *(u32x4*)(Y + (size_t)row * 2048 + c0 + hh * 8) = w;
        }
    }
}

namespace att {
constexpr int D = 128, NW = 8, QBLK = 32, KVBLK = 64;
constexpr float SCALE = 0.088388347648318440f;
constexpr float THR = 8.f;
constexpr int LDK = 256;
constexpr size_t SHM_V = KVBLK * D * 2, SHM_K = KVBLK * D * 2;
constexpr size_t OFF_WS = 2 * SHM_V + 2 * SHM_K, OFF_OST = OFF_WS + NW * 64 * 4;
#define KSWZ(row, colB) ((row) * 256 + ((colB) ^ (((row) & 7) << 4)))
#define SBAR() __builtin_amdgcn_sched_barrier(0)
DEVI int crow(int r, int hi) { return (r & 3) + 8 * (r >> 2) + 4 * hi; }
DEVI unsigned cvtpk(float lo, float hi) { unsigned r; asm volatile("v_cvt_pk_bf16_f32 %0, %1, %2" : "=v"(r) : "v"(lo), "v"(hi)); return r; }
DEVI void partialSM(f32x16& p0, f32x16& p1, float& m_reg, float& mn, float& alpha) {
    constexpr float C = SCALE * 1.4426950408889634f;
    float pmax = p0[0];
#pragma unroll
    for (int r = 1; r < 16; ++r) pmax = fmaxf(pmax, p0[r]);
#pragma unroll
    for (int r = 0; r < 16; ++r) pmax = fmaxf(pmax, p1[r]);
    { auto rr = __builtin_amdgcn_permlane32_swap(__float_as_uint(pmax), __float_as_uint(pmax), false, false);
      pmax = fmaxf(__uint_as_float(rr[0]), __uint_as_float(rr[1])); }
    if (__builtin_expect(__all(pmax - m_reg <= THR / SCALE), 1)) { mn = m_reg; alpha = 1.f; }
    else { mn = fmaxf(m_reg, pmax); alpha = __builtin_amdgcn_exp2f((m_reg - mn) * C); m_reg = mn; }
    const float mnC = -mn * C;
#pragma unroll
    for (int r = 0; r < 16; ++r) p0[r] = fmaf(p0[r], C, mnC);
#pragma unroll
    for (int r = 0; r < 16; ++r) p1[r] = fmaf(p1[r], C, mnC);
#pragma unroll
    for (int r = 0; r < 16; ++r) p0[r] = __builtin_amdgcn_exp2f(p0[r]);
}
DEVI void finishSM(f32x16& p0, f32x16& p1, float alpha, float& l_reg, bf16x8& pa0, bf16x8& pa1, bf16x8& pa2, bf16x8& pa3) {
#pragma unroll
    for (int r = 0; r < 16; ++r) p1[r] = __builtin_amdgcn_exp2f(p1[r]);
    float ps = 0;
#pragma unroll
    for (int r = 0; r < 16; ++r) ps += p0[r];
#pragma unroll
    for (int r = 0; r < 16; ++r) ps += p1[r];
    { auto rr = __builtin_amdgcn_permlane32_swap(__float_as_uint(ps), __float_as_uint(ps), false, false);
      ps = __uint_as_float(rr[0]) + __uint_as_float(rr[1]); }
    l_reg = l_reg * alpha + ps;
#define PK4(P, BASE, OUT) do { unsigned a0 = cvtpk(P[BASE + 0], P[BASE + 1]), a1 = cvtpk(P[BASE + 2], P[BASE + 3]);   \
    unsigned b0 = cvtpk(P[BASE + 4], P[BASE + 5]), b1 = cvtpk(P[BASE + 6], P[BASE + 7]);                              \
    auto r0 = __builtin_amdgcn_permlane32_swap(a0, b0, false, false); auto r1 = __builtin_amdgcn_permlane32_swap(a1, b1, false, false); \
    u32x4 w = {r0[0], r1[0], r0[1], r1[1]}; OUT = *reinterpret_cast<bf16x8*>(&w); } while (0)
    PK4(p0, 0, pa0); PK4(p0, 8, pa1); PK4(p1, 0, pa2); PK4(p1, 8, pa3);
#undef PK4
}
DEVI void qkt(f32x16& p0, f32x16& p1, const char* Ks, const bf16x8* qr, int r32, int hi) {
    p0 = f32x16{}; p1 = f32x16{};
#pragma unroll
    for (int d0 = 0; d0 < 8; ++d0) { const int cb = (d0 * 16 + hi * 8) * 2;
        const bf16x8 b0 = *reinterpret_cast<const bf16x8*>(Ks + KSWZ(r32, cb));
        const bf16x8 b1 = *reinterpret_cast<const bf16x8*>(Ks + KSWZ(32 + r32, cb));
        p0 = __builtin_amdgcn_mfma_f32_32x32x16_bf16(b0, qr[d0], p0, 0, 0, 0);
        p1 = __builtin_amdgcn_mfma_f32_32x32x16_bf16(b1, qr[d0], p1, 0, 0, 0); }
}
DEVI int v_st(int k, int c) { const int kk = (k & ~0xC) | ((k & 4) << 1) | ((k & 8) >> 1); return ((kk >> 3) * 4 + (c >> 5)) * 512 + ((kk & 7) * 32 + (c & 31)) * 2; }
DEVI int v_rd_base(int lane) { return ((lane & 3) << 3) | (((lane >> 2) & 3) << 6) | (((lane >> 4) & 1) << 5) | (((lane >> 5) & 1) << 8); }
constexpr int v_rd_off(int d0, int ks, int half) { return d0 * 512 + ks * 4096 + half * 2048; }
template <int OFF> DEVI s16x4 tr_read(int vb) { s16x4 r; asm volatile("ds_read_b64_tr_b16 %0, %1 offset:%2" : "=&v"(r) : "v"(vb), "i"(OFF) : "memory"); return r; }
template <int D0> DEVI void pv_one(f32x16& od, int vb, bf16x8 pa0, bf16x8 pa1, bf16x8 pa2, bf16x8 pa3) {
    const s16x4 l0 = tr_read<v_rd_off(D0, 0, 0)>(vb), h0 = tr_read<v_rd_off(D0, 0, 1)>(vb), l1 = tr_read<v_rd_off(D0, 1, 0)>(vb), h1 = tr_read<v_rd_off(D0, 1, 1)>(vb);
    const s16x4 l2 = tr_read<v_rd_off(D0, 2, 0)>(vb), h2 = tr_read<v_rd_off(D0, 2, 1)>(vb), l3 = tr_read<v_rd_off(D0, 3, 0)>(vb), h3 = tr_read<v_rd_off(D0, 3, 1)>(vb);
    asm volatile("s_waitcnt lgkmcnt(0)" ::: "memory"); SBAR();
#define PK(L, H) (bf16x8){L[0], L[1], L[2], L[3], H[0], H[1], H[2], H[3]}
    od = __builtin_amdgcn_mfma_f32_32x32x16_bf16(pa0, PK(l0, h0), od, 0, 0, 0);
    od = __builtin_amdgcn_mfma_f32_32x32x16_bf16(pa1, PK(l1, h1), od, 0, 0, 0);
    od = __builtin_amdgcn_mfma_f32_32x32x16_bf16(pa2, PK(l2, h2), od, 0, 0, 0);
    od = __builtin_amdgcn_mfma_f32_32x32x16_bf16(pa3, PK(l3, h3), od, 0, 0, 0);
#undef PK
}
DEVI void pv_d0(f32x16* o, int vb, bf16x8 pa0, bf16x8 pa1, bf16x8 pa2, bf16x8 pa3) {
    pv_one<0>(o[0], vb, pa0, pa1, pa2, pa3); pv_one<1>(o[1], vb, pa0, pa1, pa2, pa3); pv_one<2>(o[2], vb, pa0, pa1, pa2, pa3); pv_one<3>(o[3], vb, pa0, pa1, pa2, pa3);
}
DEVI void wmask(f32x16& p0, f32x16& p1, int qp, int kt0, int hi) {
#pragma unroll
    for (int r = 0; r < 16; ++r) { const int kp = kt0 + crow(r, hi); const int d0 = qp - kp, d1 = d0 - 32;
        if (d0 > 128 || d0 < -128) p0[r] = -1e30f; if (d1 > 128 || d1 < -128) p1[r] = -1e30f; }
}
DEVI void attn_unit(const Args& a, int b, int h, int qb, char* lds) {
    unsigned char* ws = a.ws;
    const bf16_t* QAT = (const bf16_t*)(ws + WS_QAT); const bf16_t* KAT = (const bf16_t*)(ws + WS_KAT); const bf16_t* VAT = (const bf16_t*)(ws + WS_VAT);
    bf16_t* Y = (bf16_t*)(ws + WS_Y); const float* rope = (const float*)(ws + SM_ROPE);
    const int tid = threadIdx.x, wid = tid >> 6, lane = tid & 63, r32 = lane & 31, hi = lane >> 5;
    const int kvh = h >> 2, t0 = qb * 256;
    char* V_lds = lds; char* K_lds = lds + 2 * SHM_V;
    float* wsf = (float*)(lds + OFF_WS) + wid * 64; float* li_l = wsf; float* al_l = wsf + 32;
    float m_reg = -1e30f, l_reg = 0; f32x16 o[4] = {}; bf16x8 qr[8];
    const int qp = t0 + wid * QBLK + r32;
    {
        const bf16_t* Qw = QAT + (size_t)(b * SEQ + qp) * 1024 + h * 128 + hi * 8;
        u32x4 raw[8]; float ss = 0.f;
#pragma unroll
        for (int d0 = 0; d0 < 8; ++d0) { raw[d0] = *(const u32x4*)(Qw + d0 * 16);
#pragma unroll
            for (int i = 0; i < 4; ++i) { const float lo_ = bflo(raw[d0][i]), hi_ = bfhi(raw[d0][i]); ss += lo_ * lo_ + hi_ * hi_; } }
        { auto rr = __builtin_amdgcn_permlane32_swap(__float_as_uint(ss), __float_as_uint(ss), false, false); ss = __uint_as_float(rr[0]) + __uint_as_float(rr[1]); }
        const float rs = rsqrtf(ss * (1.f / 128.f) + EPS);
        const float* qnw = a.in[13];
#pragma unroll
        for (int half = 0; half < 2; ++half) {
            const float* ct = half == 0 ? rope + (qp >> 6) * 32 : rope + 16384 + (qp & 63) * 32;
            const float* st = half == 0 ? ct + 8192 : ct + 2048;
#pragma unroll
            for (int dd = 0; dd < 2; ++dd) {
                const int fi = dd * 16 + hi * 8, da = half * 4 + dd, db = da + 2;
                u32x4 oa, ob;
#pragma unroll
                for (int q4 = 0; q4 < 2; ++q4) {
                    const f32x4 c = *(const f32x4*)(ct + fi + 4 * q4), s = *(const f32x4*)(st + fi + 4 * q4);
                    const f32x4 wa = *(const f32x4*)(qnw + da * 16 + hi * 8 + 4 * q4), wb = *(const f32x4*)(qnw + db * 16 + hi * 8 + 4 * q4);
                    float ya[4], yb[4];
#pragma unroll
                    for (int j = 0; j < 4; ++j) {
                        const unsigned ra = raw[da][2 * q4 + (j >> 1)], rb = raw[db][2 * q4 + (j >> 1)];
                        const float x1 = ((j & 1) ? bfhi(ra) : bflo(ra)) * rs * wa[j], x2 = ((j & 1) ? bfhi(rb) : bflo(rb)) * rs * wb[j];
                        ya[j] = x1 * c[j] - x2 * s[j]; yb[j] = x2 * c[j] + x1 * s[j];
                    }
                    oa[2 * q4] = cvtpk(ya[0], ya[1]); oa[2 * q4 + 1] = cvtpk(ya[2], ya[3]); ob[2 * q4] = cvtpk(yb[0], yb[1]); ob[2 * q4 + 1] = cvtpk(yb[2], yb[3]);
                }
                qr[da] = *reinterpret_cast<bf16x8*>(&oa); qr[db] = *reinterpret_cast<bf16x8*>(&ob);
            }
        }
    }
    const int tk0 = t0 - 128 < 0 ? 0 : t0 - 128, tk1 = t0 + 384 > SEQ ? SEQ : t0 + 384;
    const int NT = 4 + (tk1 - tk0) / 64;
    const int ctxrow = ML + b * CTX, latrow = b * SEQ + tk0 - 256;
#define TROW(j) ((j) < 4 ? ctxrow + 64 * (j) : latrow + 64 * (j))
    const bf16_t* Kh = KAT + kvh * 128; const bf16_t* Vh = VAT + kvh * 128;
    const int sr = tid >> 4, sc = (tid & 15) * 8, vst0 = v_st(sr, sc), vst1 = v_st(32 + sr, sc);
    const int vb0 = (int)(uintptr_t)V_lds + v_rd_base(lane);
    struct { bf16x8 vs0, vs1, ks0, ks1; } sr_[1];
#define SLOAD(i, j) do { const int k0_ = TROW(j); sr_[i].vs0 = *(const bf16x8*)(Vh + (size_t)(k0_ + sr) * LDK + sc); sr_[i].vs1 = *(const bf16x8*)(Vh + (size_t)(k0_ + 32 + sr) * LDK + sc); \
    sr_[i].ks0 = *(const bf16x8*)(Kh + (size_t)(k0_ + sr) * LDK + sc); sr_[i].ks1 = *(const bf16x8*)(Kh + (size_t)(k0_ + 32 + sr) * LDK + sc); } while (0)
#define SWRITE(bf, i) do { *(bf16x8*)(V_lds + (bf) * SHM_V + vst0) = sr_[i].vs0; *(bf16x8*)(V_lds + (bf) * SHM_V + vst1) = sr_[i].vs1; const int kc = sc * 2; \
    *(bf16x8*)(K_lds + (bf) * SHM_K + KSWZ(sr, kc)) = sr_[i].ks0; *(bf16x8*)(K_lds + (bf) * SHM_K + KSWZ(32 + sr, kc)) = sr_[i].ks1; } while (0)
#define SWAIT() asm volatile("s_waitcnt vmcnt(0)" ::: "memory")
#define RESC(al) do { if (__any((al) < 1.f)) { if (hi == 0) al_l[r32] = (al); asm volatile("s_waitcnt lgkmcnt(0)" ::: "memory"); \
    _Pragma("unroll") for (int d = 0; d < 4; ++d) _Pragma("unroll") for (int r = 0; r < 16; ++r) o[d][r] *= al_l[crow(r, hi)]; } } while (0)
#define WMASK(P0, P1, j) do { if ((j) >= 4) wmask(P0, P1, qp, tk0 + 64 * ((j) - 4), hi); } while (0)
    f32x16 pA0, pA1, pB0, pB1; float mnA, mnB, alA, alB; bf16x8 pa0, pa1, pa2, pa3;
    constexpr int SE = 0, SO = 0;
    SLOAD(SE, 0); asm volatile("s_waitcnt vmcnt(0)" ::: "memory"); SWRITE(0, SE); __syncthreads();
    qkt(pA0, pA1, K_lds, qr, r32, hi); partialSM(pA0, pA1, m_reg, mnA, alA);
    SLOAD(SO, 1);
    SWAIT(); SWRITE(1, SO); __syncthreads();
    for (int j = 1; j + 1 < NT; j += 2) {
        SBAR(); qkt(pB0, pB1, K_lds + SHM_K, qr, r32, hi); WMASK(pB0, pB1, j);
        finishSM(pA0, pA1, alA, l_reg, pa0, pa1, pa2, pa3); SBAR();
        SLOAD(SO, j + 1); SBAR();
        pv_d0(o, vb0, pa0, pa1, pa2, pa3); partialSM(pB0, pB1, m_reg, mnB, alB);
        __syncthreads(); SWAIT(); SWRITE(0, SE);
        RESC(alB); __syncthreads();
        SBAR(); qkt(pA0, pA1, K_lds, qr, r32, hi); WMASK(pA0, pA1, j + 1);
        finishSM(pB0, pB1, alB, l_reg, pa0, pa1, pa2, pa3); SBAR();
        SLOAD(SE, j + 2); SBAR();
        pv_d0(o, vb0 + (int)SHM_V, pa0, pa1, pa2, pa3); partialSM(pA0, pA1, m_reg, mnA, alA);
        __syncthreads(); SWAIT(); SWRITE(1, SO);
        RESC(alA); __syncthreads();
    }
    SBAR(); qkt(pB0, pB1, K_lds + SHM_K, qr, r32, hi); WMASK(pB0, pB1, NT - 1);
    finishSM(pA0, pA1, alA, l_reg, pa0, pa1, pa2, pa3); SBAR();
    pv_d0(o, vb0, pa0, pa1, pa2, pa3); partialSM(pB0, pB1, m_reg, mnB, alB);
    __syncthreads(); RESC(alB);
    finishSM(pB0, pB1, alB, l_reg, pa0, pa1, pa2, pa3); SBAR();
    pv_d0(o, vb0 + (int)SHM_V, pa0, pa1, pa2, pa3);
    l_reg += __builtin_amdgcn_exp2f(a.in[15][h] * 1.4426950408889634f - m_reg * (SCALE * 1.4426950408889634f));
    if (hi == 0) li_l[r32] = l_reg; asm volatile("s_waitcnt lgkmcnt(0)" ::: "memory");
    float rli[16];
#pragma unroll
    for (int r = 0; r < 16; ++r) rli[r] = __builtin_amdgcn_rcpf(li_l[crow(r, hi)]);
    {
        bf16_t* stg = (bf16_t*)(lds + OFF_OST) + wid * 4096;
#pragma unroll
        for (int r = 0; r < 16; ++r) { const int orow = crow(r, hi);
#pragma unroll
            for (int d0 = 0; d0 < 4; ++d0) stg[orow * 128 + d0 * 32 + r32] = (bf16_t)f2bf(o[d0][r] * rli[r]); }
        asm volatile("s_waitcnt lgkmcnt(0)" ::: "memory");
        bf16_t* Ow = Y + (size_t)(b * SEQ + t0 + wid * QBLK) * 2048 + 1024 + h * 128;
#pragma unroll
        for (int i = 0; i < 8; ++i) { const int row = i * 4 + (lane >> 4), ch = lane & 15; const u32x4 v = *(const u32x4*)(stg + row * 128 + ch * 8); *(u32x4*)(Ow + (size_t)row * 2048 + ch * 8) = v; }
    }
    __syncthreads();
#undef TROW
#undef SLOAD
#undef SWRITE
#undef SWAIT
#undef RESC
#undef WMASK
}
#undef KSWZ
#undef SBAR
}

DEVI u32x4 ldu_(const bf16_t* base, int rr) {
    const int rc = rr < 0 ? 0 : (rr >= SEQ ? SEQ - 1 : rr);
    const u32x4 v = *(const u32x4*)(base + (size_t)rc * NUP);
    const unsigned m = (rr == rc) ? 0xffffffffu : 0u;
    return (u32x4){v[0] & m, v[1] & m, v[2] & m, v[3] & m};
}
DEVI void phase_ffnconv(const Args& a, int b, int tid) {
    unsigned char* ws = a.ws;
    const bf16_t* U = (const bf16_t*)(ws + WS_U); bf16_t* ACT = (bf16_t*)(ws + WS_ACT) + (size_t)b * SEQ * DFF;
    const float* cw = a.in[20]; const float* cb = a.in[21];
    if (tid < DFF / 8) {
        const int f0 = tid * 8, pn = f0 >> 7, j = f0 & 127, gc = 256 * pn + j, vc = gc + 128;
        float wg[3][8], wv[3][8], bg[8], bvv[8];
#pragma unroll
        for (int jt = 0; jt < 3; ++jt)
#pragma unroll
            for (int q = 0; q < 8; ++q) { wg[jt][q] = cw[jt * NUP + f0 + q]; wv[jt][q] = cw[jt * NUP + DFF + f0 + q]; }
#pragma unroll
        for (int q = 0; q < 8; ++q) { bg[q] = cb[f0 + q]; bvv[q] = cb[DFF + f0 + q]; }
        for (int it = blockIdx.x; it < SEQ / 32; it += gridDim.x) {
            const int r0 = it * 32;
            u32x4 gw_[3], vw_[3];
#define LDU(rr, c) ldu_(U + (c), (rr))
            gw_[0] = LDU(r0 - 1, gc); vw_[0] = LDU(r0 - 1, vc); gw_[1] = LDU(r0, gc); vw_[1] = LDU(r0, vc);
#pragma unroll 8
            for (int r = 0; r < 32; ++r) {
                gw_[2] = LDU(r0 + r + 1, gc); vw_[2] = LDU(r0 + r + 1, vc);
                float ug[8], uv[8];
#pragma unroll
                for (int q = 0; q < 8; ++q) { ug[q] = bg[q]; uv[q] = bvv[q]; }
#pragma unroll
                for (int jt = 0; jt < 3; ++jt)
#pragma unroll
                    for (int q = 0; q < 4; ++q) {
                        ug[2 * q] += bflo(gw_[jt][q]) * wg[jt][2 * q]; ug[2 * q + 1] += bfhi(gw_[jt][q]) * wg[jt][2 * q + 1];
                        uv[2 * q] += bflo(vw_[jt][q]) * wv[jt][2 * q]; uv[2 * q + 1] += bfhi(vw_[jt][q]) * wv[jt][2 * q + 1]; }
                u32x4 o;
                o.x = pk2(siluf(ug[0]) * uv[0], siluf(ug[1]) * uv[1]); o.y = pk2(siluf(ug[2]) * uv[2], siluf(ug[3]) * uv[3]);
                o.z = pk2(siluf(ug[4]) * uv[4], siluf(ug[5]) * uv[5]); o.w = pk2(siluf(ug[6]) * uv[6], siluf(ug[7]) * uv[7]);
                *(u32x4*)(ACT + (size_t)(r0 + r) * DFF + f0) = o;
                gw_[0] = gw_[1]; gw_[1] = gw_[2]; vw_[0] = vw_[1]; vw_[1] = vw_[2];
            }
#undef LDU
        }
    }
}

#define XB_TMO      128
#define XB_XCNT(j)  (256  + 64 * (j))
#define XB_XSUB(j)  (1280 + 64 * (j))
#define XB_XGEN(j)  (2304 + 64 * (j))
#define XB_TOP      3328
#define XB_TOPGEN   3392
#define XCD_BAR_WORDS 3456
#define XB_SPIN_CAP (1u << 18)
__device__ __forceinline__ unsigned xb_ld(unsigned* p)              { return __hip_atomic_load(p, __ATOMIC_RELAXED, __HIP_MEMORY_SCOPE_AGENT); }
__device__ __forceinline__ unsigned xb_add(unsigned* p, unsigned v) { return __hip_atomic_fetch_add(p, v, __ATOMIC_RELAXED, __HIP_MEMORY_SCOPE_AGENT); }
__device__ __forceinline__ unsigned xb_xcc_id() { return (unsigned)__builtin_amdgcn_s_getreg((3 << 11) | 20) & 0xFu; }
#define XB_SPIN(cond, bar) do { unsigned _sp = 0; while (cond) { __builtin_amdgcn_s_sleep(1); \
    if ((++_sp & 255u) == 0u) { if (xb_ld(&(bar)[XB_TMO])) break; if (_sp > XB_SPIN_CAP) { atomicAdd(&(bar)[XB_TMO], 1u); break; } } } } while (0)
struct XcdBarrier { unsigned* bar; unsigned x; volatile LAS unsigned* st; };
__device__ __forceinline__ XcdBarrier xcd_barrier_post(unsigned* bar, volatile LAS unsigned* st) {
    XcdBarrier b; b.bar = bar; b.x = xb_xcc_id(); b.st = st;
    if (threadIdx.x == 0) (void)xb_add(&bar[XB_XCNT(b.x)], 1u);
    return b;
}
__device__ __forceinline__ void xcd_barrier_complete(unsigned* bar, unsigned x, unsigned& nloc, unsigned& nx) {
    const unsigned G = gridDim.x * gridDim.y * gridDim.z;
    unsigned sum, cnt, mine, sp = 0u;
    for (;;) {
        sum = 0u; cnt = 0u; mine = 0u;
#pragma unroll
        for (unsigned j = 0; j < 16; ++j) { const unsigned c = xb_ld(&bar[XB_XCNT(j)]); sum += c; cnt += (c > 0u) ? 1u : 0u; mine = (j == x) ? c : mine; }
        if (sum == G) break;
        __builtin_amdgcn_s_sleep(1);
        if ((++sp & 255u) == 0u) { if (xb_ld(&bar[XB_TMO])) break; if (sp > XB_SPIN_CAP) { atomicAdd(&bar[XB_TMO], 1u); break; } }
    }
    nloc = mine > 0u ? mine : 1u; nx = cnt > 0u ? cnt : 1u;
}
__device__ __forceinline__ void xcd_barrier(const XcdBarrier& b) {
    asm volatile("s_waitcnt vmcnt(0)" ::: "memory");
    __syncthreads();
    if (threadIdx.x == 0) {
        unsigned* bar = b.bar;
        __builtin_amdgcn_s_waitcnt(0);
        unsigned nloc = b.st[0], nx = b.st[1];
        if (nloc == 0u) { xcd_barrier_complete(bar, b.x, nloc, nx); b.st[0] = nloc; b.st[1] = nx; }
        const unsigned old = xb_add(&bar[XB_XSUB(b.x)], 1u);
        const unsigned gen = old / nloc;
        if (old + 1u == (gen + 1u) * nloc) {
            __builtin_amdgcn_fence(__ATOMIC_RELEASE, "agent");
            asm volatile("s_waitcnt vmcnt(0)" ::: "memory");
            const unsigned og = xb_add(&bar[XB_TOP], 1u);
            const unsigned tg = og / nx;
            if (og + 1u == (tg + 1u) * nx) xb_add(&bar[XB_TOPGEN], 1u);
            else XB_SPIN(xb_ld(&bar[XB_TOPGEN]) == tg, bar);
            __builtin_amdgcn_fence(__ATOMIC_ACQUIRE, "agent");
            xb_add(&bar[XB_XGEN(b.x)], 1u);
            asm volatile("s_waitcnt vmcnt(0)" ::: "memory");
        } else {
            XB_SPIN(xb_ld(&bar[XB_XGEN(b.x)]) == gen, bar);
            __builtin_amdgcn_fence(__ATOMIC_ACQUIRE, "agent");
            asm volatile("s_waitcnt vmcnt(0)" ::: "memory");
        }
    }
    __syncthreads();
}

constexpr int NPHASE = 13;
__global__ void __launch_bounds__(512, 2) mega(Args a) {
    extern __shared__ __attribute__((aligned(16))) unsigned char lds_raw[];
    LAS unsigned char* lds = (LAS unsigned char*)lds_raw;
    const int tid = threadIdx.x, lane = tid & 63, wave = __builtin_amdgcn_readfirstlane(tid >> 6);
    unsigned char* ws = a.ws;
    const int lo = a.ph_lo, hi = a.ph_hi;
#define IN(k) (lo <= (k) && (k) < hi)
#if MK_ONE_LAUNCH
    volatile LAS unsigned* bst = (volatile LAS unsigned*)(lds + 147440);
    if (tid < 4) bst[tid] = 0u;
    __syncthreads();
    const XcdBarrier gbar = xcd_barrier_post((unsigned*)(ws + WS_CTL), bst);
#define SEAM(k) do { if (IN(k) && IN((k) + 1)) xcd_barrier(gbar); } while (0)
#else
#define SEAM(k) do { } while (0)
#endif
    const float* modacc = (const float*)(ws + CTL_MODACC);
    unsigned long long pr_prev = PROBE_MASK ? __builtin_amdgcn_s_memrealtime() : 0ull, pr_acc = 0ull;
#define STAMP(k) do { if (PROBE_MASK) { const unsigned long long now_ = __builtin_amdgcn_s_memrealtime(); if ((PROBE_MASK >> (k)) & 1u) pr_acc += now_ - pr_prev; pr_prev = now_; } } while (0)
    if (IN(0)) { phase0(a, lds, tid, lane, wave); } SEAM(0); STAMP(0);
    if (IN(1)) { phase1(a, tid, lane, wave); } SEAM(1); STAMP(1);
    if (IN(2)) {
        pg8::Gemm g{(const bf16_t*)(ws + WS_XN), (const bf16_t*)(ws + WS_WINA), MT, NA, 1024}; pg8::StaticOrder S; S.init(MT, NA, gridDim.x, blockIdx.x);
        EpiIn E{(const float*)(ws + SM_ROWSS1), (const float*)(ws + SM_SHWA), 0, (bf16_t*)(ws + WS_QKVR), nullptr, nullptr, nullptr, nullptr, (float*)(ws + WS_BA)};
        pg8::gemm_phase<EpiIn, pg8::StaticOrder, true, true>(lds, g, S, E);
    } SEAM(2); STAMP(2);
    if (IN(3)) { phase_dnprep(a, tid); } SEAM(3); STAMP(3);
    if (IN(4)) { phase_dnchunk(a, lds, tid, lane, wave); } SEAM(4); STAMP(4);
    if (IN(5)) { phase_dnscan2(a, lds, tid, lane, wave, pr_acc); } SEAM(5); STAMP(5);
    if (IN(6)) {
        pg8::Gemm g{(const bf16_t*)(ws + WS_XN), (const bf16_t*)(ws + WS_WINC), MT, NC, 1024}; pg8::StaticOrder S; S.init(MT, NC, gridDim.x, blockIdx.x);
        EpiIn E{(const float*)(ws + SM_ROWSS1), (const float*)(ws + SM_SHWA) + NA, 1, (bf16_t*)(ws + WS_GT), (bf16_t*)(ws + WS_QAT), (bf16_t*)(ws + WS_KAT), (bf16_t*)(ws + WS_VAT), (bf16_t*)(ws + WS_MG), nullptr};
        pg8::gemm_phase<EpiIn, pg8::StaticOrder, true, true>(lds, g, S, E);
    } SEAM(6); STAMP(6);
    if (IN(7)) { phase_prep2(a, lane, wave); } SEAM(7); STAMP(7);
    if (IN(8)) {
#pragma unroll 1
        for (int k = 0; k < 1024; ++k) {
            const int idx = 4 * ((int)blockIdx.x + (int)gridDim.x * (k >> 2)) + (k & 3); if (idx >= 1024) break;
            const int g = idx & 3, qb = (idx >> 2) & 63, kvh = (idx >> 8) & 1, b = idx >> 9;
            att::attn_unit(a, b, kvh * 4 + g, qb, (char*)lds_raw); }
    } SEAM(8); STAMP(8);
    if (IN(9)) {
        pg8::Gemm g{(const bf16_t*)(ws + WS_Y), (const bf16_t*)(ws + WS_WBR), ML, 1024, 2048}; pg8::StaticOrder S; S.init(ML, 1024, gridDim.x, blockIdx.x);
        EpiBr E{(const bf16_t*)(ws + WS_MG), (bf16_t*)(ws + WS_MERGED)};
        pg8::gemm_phase<EpiBr, pg8::StaticOrder, true, true>(lds, g, S, E);
    } SEAM(9); STAMP(9);
    if (IN(10)) {
        pg8::Gemm g{(const bf16_t*)(ws + WS_MERGED), (const bf16_t*)(ws + WS_WOUT), ML, 1024, 1024}; pg8::StaticOrder S; S.init(ML, 1024, gridDim.x, blockIdx.x);
        EpiOut E{a.in[0], modacc, a.in[5], a.in[7], a.out, (bf16_t*)(ws + WS_X1S), (float*)(ws + CTL_ROWSS2)};
        pg8::gemm_phase<EpiOut, pg8::StaticOrder, true, true>(lds, g, S, E);
    } SEAM(10); STAMP(10);
    if (IN(11)) {
        pg8::Gemm g{(const bf16_t*)(ws + WS_X1S), (const bf16_t*)(ws + WS_WUP), 2 * TPB * 256, NUP, 1024}; pg8::StaticOrder S; S.init(2 * TPB * 256, NUP, gridDim.x, blockIdx.x);
        EpiUpConv E{(const float*)(ws + CTL_ROWSS2), (const float*)(ws + SM_SHWF), a.in[20], a.in[21], (bf16_t*)(ws + WS_ACT), (LAS float*)(lds + 131072)};
        pg8::gemm_phase<EpiUpConv, pg8::StaticOrder, true, true>(lds, g, S, E);
    } SEAM(11); STAMP(11);
    if (IN(12)) {
        pg8::Gemm g{(const bf16_t*)(ws + WS_ACT), (const bf16_t*)(ws + WS_WDN), ML, 1024, DFF}; pg8::StaticOrder S; S.init(ML, 1024, gridDim.x, blockIdx.x);
        EpiDown E{modacc, a.in[5], a.out};
        pg8::gemm_phase<EpiDown, pg8::StaticOrder, true, true>(lds, g, S, E);
    }
    STAMP(12);
    if ((PROBE_MASK || PROBE_SUB) && blockIdx.x == 0) { const unsigned long long t0_ = __builtin_amdgcn_s_memrealtime(); while (__builtin_amdgcn_s_memrealtime() - t0_ < pr_acc) __builtin_amdgcn_s_sleep(8); }
#undef STAMP
#undef IN
#undef SEAM
}

extern "C" void kernel_launch(void* const* d_in, const int* in_sizes, int n_in, void* d_out, int out_size, void* d_ws, size_t ws_size, hipStream_t stream) {
    static int grid = 0;
    if (grid == 0) {
        if (n_in != 23 || in_sizes[0] != ML * DM || out_size != ML * DM || ws_size < WS_END) {
            fprintf(stderr, "kernel_launch: unexpected shapes n_in %d in0 %d out %d ws %zu (need %zu)\n", n_in, n_in > 0 ? in_sizes[0] : -1, out_size, ws_size, (size_t)WS_END); grid = -1; return; }
        int dev = 0, cus = 0, per_cu = 0;
        hipGetDevice(&dev); hipDeviceGetAttribute(&cus, hipDeviceAttributeMultiprocessorCount, dev);
        if (hipFuncSetAttribute((const void*)mega, hipFuncAttributeMaxDynamicSharedMemorySize, LDS_BYTES) != hipSuccess) { fprintf(stderr, "kernel_launch: hipFuncSetAttribute failed\n"); grid = -1; return; }
        hipOccupancyMaxActiveBlocksPerMultiprocessor(&per_cu, (const void*)mega, 512, LDS_BYTES);
        (void)hipGetLastError();
        if (per_cu < 1) { fprintf(stderr, "kernel_launch: occupancy query says %d blocks per CU\n", per_cu); per_cu = 1; }
        grid = cus;
    }
    if (grid < 0) return;
    hipMemsetAsync((char*)d_ws + WS_CTL, 0, CTL_ZERO_BYTES, stream);
    Args a{};
    for (int i = 0; i < 23; ++i) a.in[i] = (const float*)d_in[i];
    a.out = (float*)d_out; a.ws = (unsigned char*)d_ws;
#if MK_ONE_LAUNCH
    a.ph_lo = 0; a.ph_hi = NPHASE;
    void* args[] = {&a};
    hipError_t e = hipLaunchCooperativeKernel((const void*)mega, dim3(grid), dim3(512), args, LDS_BYTES, stream);
    if (e != hipSuccess) fprintf(stderr, "cooperative launch failed: %s (grid %d)\n", hipGetErrorString(e), grid);
#else
    for (int p = 0; p < NPHASE; ++p) {
        a.ph_lo = p; a.ph_hi = p + 1;
        hipLaunchKernelGGL(mega, dim3(grid), dim3(512), LDS_BYTES, stream, a);
    }
    hipError_t e = hipPeekAtLastError();
    if (e != hipSuccess) fprintf(stderr, "launch failed: %s\n", hipGetErrorString(e));
#endif
}
```

```cpp
#include <hip/hip_runtime.h>
#include <hip/hip_cooperative_groups.h>
#include <cstdio>
#include <cstdint>
namespace cg = cooperative_groups;

#ifndef PROBE_MASK
#define PROBE_MASK 0u
#endif
#ifndef PROBE_SUB
#define PROBE_SUB 0
#endif
#ifndef MK_ONE_LAUNCH
#define MK_ONE_LAUNCH 1
#endif

#define DEVI __device__ __forceinline__
#define LAS __attribute__((address_space(3)))
typedef unsigned short bf16_t;
typedef short bf16x8 __attribute__((ext_vector_type(8)));
typedef float f32x4 __attribute__((ext_vector_type(4)));
typedef float f32x2 __attribute__((ext_vector_type(2)));
typedef float f32x16 __attribute__((ext_vector_type(16)));
typedef unsigned u32x4 __attribute__((ext_vector_type(4)));
typedef unsigned u32x2 __attribute__((ext_vector_type(2)));
typedef short s16x4 __attribute__((ext_vector_type(4)));

constexpr int BATCH = 2, SEQ = 16384, DM = 1024, CTX = 256;
constexpr int ML = BATCH * SEQ;
constexpr int MC = BATCH * CTX;
constexpr int MT = ML + MC;
constexpr int NA = 3328;
constexpr int NC = 4608;
constexpr int NSH = NA + NC;
constexpr int DFF = 2816, NUP = 5632;
constexpr int RB = SEQ + 256;
constexpr int TPB = 65;
constexpr float EPS = 1e-6f;

constexpr size_t MiB = 1u << 20;
constexpr size_t WS_CTL = 0, CTL_ZERO_BYTES = 1 * MiB;
constexpr size_t CTL_XRANK = 24 * 1024;
constexpr size_t CTL_PROG = 32 * 1024;
constexpr size_t CTL_MODACC = 64 * 1024;
constexpr size_t CTL_ROWSS2 = 256 * 1024;
constexpr size_t WS_SMALL = 1 * MiB;
constexpr size_t SM_ROWSS1 = WS_SMALL;
constexpr size_t SM_SHWA = WS_SMALL + 256 * 1024;
constexpr size_t SM_SHWF = WS_SMALL + 384 * 1024;
constexpr size_t SM_ROPE = WS_SMALL + 512 * 1024;
constexpr size_t WS_BA = 2 * MiB;
constexpr size_t WS_G = 7 * MiB;
constexpr size_t WS_BETA = 10 * MiB;
constexpr size_t WS_WINA = 13 * MiB, WS_WINC = 20 * MiB, WS_WBR = 29 * MiB, WS_WOUT = 33 * MiB, WS_WUP = 35 * MiB, WS_WDN = 46 * MiB;
constexpr size_t WS_XN = 52 * MiB;
constexpr size_t WS_QKVR = 117 * MiB;
constexpr size_t WS_QKVP = 312 * MiB;
constexpr size_t WS_MG = 180 * MiB;
constexpr size_t WS_GT = 310 * MiB;
constexpr size_t WS_QAT = 375 * MiB;
constexpr size_t WS_KAT = 440 * MiB;
constexpr size_t WS_VAT = 457 * MiB;
constexpr size_t WS_Y = 52 * MiB;
constexpr size_t WS_MERGED = 375 * MiB;
constexpr size_t WS_X1S = 440 * MiB;
constexpr size_t WS_U = 52 * MiB;
constexpr size_t WS_ACT = 228 * MiB;
constexpr size_t WS_TQ = 117 * MiB;
constexpr size_t WS_AVEC = 248 * MiB;
constexpr size_t WS_END = 512 * MiB;

constexpr int LDS_BYTES = 147456;

DEVI float bf2f(unsigned short h) { return __uint_as_float((unsigned)h << 16); }
DEVI float bflo(unsigned w) { return __uint_as_float(w << 16); }
DEVI float bfhi(unsigned w) { return __uint_as_float(w & 0xffff0000u); }
typedef __bf16 bf16x2_t __attribute__((ext_vector_type(2)));
DEVI unsigned pk2(float lo, float hi) { const f32x2 v = {lo, hi}; const bf16x2_t b = __builtin_convertvector(v, bf16x2_t); return __builtin_bit_cast(unsigned, b); }
DEVI unsigned f2bf(float f) { return pk2(f, 0.f) & 0xffffu; }
DEVI float wave_sum(float v) {
#pragma unroll
    for (int o = 1; o < 64; o <<= 1) v += __shfl_xor(v, o);
    return v;
}
DEVI float siluf(float x) { return x * __builtin_amdgcn_rcpf(1.f + __expf(-x)); }
DEVI float sigmoidf_(float x) { return 1.f / (1.f + __expf(-x)); }

struct Args { const float* in[23]; float* out; unsigned char* ws; int ph_lo, ph_hi; };

namespace pg8 {
constexpr int BM = 256, BK = 64, HALF = 128, HTB = HALF * BK * 2, STAGE_BYTES = 8 * HTB, NXCD = 8, WGM = 8;
__host__ __device__ __forceinline__ int lds_byte(int r, int c) { const int st = (r >> 4) * 2 + (c >> 5), rr = r & 15, cc = c & 31, ob = rr * 64 + cc * 2; return st * 1024 + (ob ^ (((ob >> 9) & 1) << 5)); }
__host__ __device__ __forceinline__ void stage_rc(int b, int& R, int& C) { const int st = b / 1024, sb = b % 1024, swz = sb ^ (((sb >> 9) & 1) << 5); R = (st >> 1) * 16 + swz / 64; C = (st & 1) * 32 + (swz % 64) / 2; }
__host__ __device__ __forceinline__ int perm32(int rho) { const int n = rho >> 4, i = rho & 15; return 8 * (i >> 2) + 4 * n + (i & 3); }
struct Unit { int pm, pn; };
struct Gemm { const bf16_t* A; const bf16_t* Bt; int M, N, K; };
struct StaticOrder {
    int nM, nN, nwg, G, c;
    __device__ void init(int M, int N, int G_, int c_) { nM = M / BM; nN = N / BM; nwg = nM * nN; G = G_; c = c_; }
    __device__ bool next(int i, Unit& u) const {
        const long L = (long)i * G + c; if (L >= nwg) return false;
        int wgid = (int)L; { const int q = nwg / NXCD, r = nwg % NXCD, xcd = wgid % NXCD, off = wgid / NXCD; wgid = (xcd < r ? xcd * (q + 1) : r * (q + 1) + (xcd - r) * q) + off; }
        const int nig = WGM * nN, gid = wgid / nig, fm = gid * WGM, gsz = (nM - fm) < WGM ? (nM - fm) : WGM;
        u.pm = fm + ((wgid % nig) % gsz); u.pn = (wgid % nig) / gsz; return true;
    }
};
template <class Epi> __device__ __forceinline__ size_t a_off(const Epi& E, int pm, int K, size_t tstep) { if constexpr (Epi::AROW) return (size_t)E.arow(pm) * K * 2; else return (size_t)pm * tstep; }
template <class Epi, class Sched, bool ALIGN_EPI, bool SP2>
__device__ __forceinline__ void gemm_phase(LAS unsigned char* lds, const Gemm g, const Sched& S, const Epi& E) {
    const int tid = threadIdx.x, wid = __builtin_amdgcn_readfirstlane(tid >> 6), lane = tid & 63, wr = wid >> 2, wc = wid & 3, fr = lane & 15, fq = lane >> 4;
    const int K = g.K, nt = K / BK;
    unsigned voffA[2], voffB[2];
#pragma unroll
    for (int i = 0; i < 2; ++i) { int R, C; stage_rc(tid * 16 + i * 8192, R, C); const int Rb = Epi::PERM ? ((R & ~31) + perm32(R & 31)) : R;
        voffA[i] = (unsigned)(R * K + C) * 2u; voffB[i] = (unsigned)(Rb * K + C) * 2u; }
    const size_t kstep = (size_t)(BK * 2);
    const size_t hstep = (size_t)HALF * K * 2;
    const size_t tstep = 2 * hstep;
    const unsigned ldsw = (unsigned)wid * 1024u;
    const int aoff = lds_byte(wr * 64 + fr, fq * 8), boff = lds_byte(wc * 32 + fr, fq * 8);
#define PG8_SA(b, h) (((b) * 2 + (h)) * HTB)
#define PG8_SB(b, h) ((4 + (b) * 2 + (h)) * HTB)
#define PG8_STAGE(bufoff, gbase, voff) do { _Pragma("unroll") for (int _i = 0; _i < 2; ++_i) \
        __builtin_amdgcn_global_load_lds((const unsigned*)((const char*)(gbase) + (voff)[_i]), (LAS unsigned*)(lds + (bufoff) + ldsw + _i * 8192), 16, 0, 0); } while (0)
#define PG8_LDA(dst, b, h) do { _Pragma("unroll") for (int m = 0; m < 4; ++m) _Pragma("unroll") for (int k = 0; k < 2; ++k) dst[m][k] = *(const LAS bf16x8*)(lds + PG8_SA(b, h) + aoff + m * 2048 + k * 1024); } while (0)
#define PG8_LDB(dst, b, h) do { _Pragma("unroll") for (int n = 0; n < 2; ++n) _Pragma("unroll") for (int k = 0; k < 2; ++k) dst[n][k] = *(const LAS bf16x8*)(lds + PG8_SB(b, h) + boff + n * 2048 + k * 1024); } while (0)
#define PG8_MMA(ai, bj, At, Bt) do { __builtin_amdgcn_s_setprio(1); _Pragma("unroll") for (int m = 0; m < 4; ++m) _Pragma("unroll") for (int n = 0; n < 2; ++n) _Pragma("unroll") for (int k = 0; k < 2; ++k) \
        acc[ai][bj][m][n] = __builtin_amdgcn_mfma_f32_16x16x32_bf16(Bt[n][k], At[m][k], acc[ai][bj][m][n], 0, 0, 0); __builtin_amdgcn_s_setprio(0); } while (0)
#define PG8_WAIT_V(n) asm volatile("s_waitcnt vmcnt(" #n ")" ::: "memory")
#define PG8_WAIT_L(n) asm volatile("s_waitcnt lgkmcnt(" #n ")" ::: "memory")
#define PG8_BAR __builtin_amdgcn_s_barrier()
#define PG8_SCHED __builtin_amdgcn_sched_barrier(0)
    Unit cur, nxt; int ui = 0;
    if (!S.next(0, cur)) return;
    f32x4 acc[2][2][4][2];
#pragma unroll
    for (int a = 0; a < 2; ++a)
#pragma unroll
        for (int b = 0; b < 2; ++b)
#pragma unroll
            for (int m = 0; m < 4; ++m)
#pragma unroll
                for (int n = 0; n < 2; ++n) acc[a][b][m][n] = (f32x4){0.f, 0.f, 0.f, 0.f};
    bf16x8 At[4][2], B0[2][2], B1[2][2];
    const char* cA = (const char*)g.A + a_off<Epi>(E, cur.pm, K, tstep); const char* cB = (const char*)g.Bt + (size_t)cur.pn * tstep;
    if constexpr (SP2) {
        PG8_STAGE(PG8_SB(0, 0), cB, voffB); PG8_STAGE(PG8_SB(0, 1), cB + hstep, voffB); PG8_STAGE(PG8_SA(0, 0), cA, voffA); PG8_STAGE(PG8_SA(0, 1), cA + hstep, voffA);
        if (wr == 1) PG8_BAR;
        PG8_WAIT_V(2); PG8_BAR;
        PG8_STAGE(PG8_SB(1, 0), cB + kstep, voffB); PG8_STAGE(PG8_SA(1, 0), cA + kstep, voffA); PG8_STAGE(PG8_SB(1, 1), cB + hstep + kstep, voffB);
        PG8_WAIT_V(6); PG8_BAR;
    } else {
        PG8_STAGE(PG8_SB(0, 0), cB, voffB); PG8_STAGE(PG8_SA(0, 0), cA, voffA); PG8_STAGE(PG8_SB(0, 1), cB + hstep, voffB); PG8_STAGE(PG8_SA(0, 1), cA + hstep, voffA);
        if (wr == 1) PG8_BAR;
        PG8_WAIT_V(4); PG8_BAR;
        PG8_STAGE(PG8_SB(1, 0), cB + kstep, voffB); PG8_STAGE(PG8_SA(1, 0), cA + kstep, voffA); PG8_STAGE(PG8_SB(1, 1), cB + hstep + kstep, voffB);
        PG8_WAIT_V(6); PG8_BAR;
    }
    for (;;) {
        const bool has_next = S.next(ui + 1, nxt);
        const char* nA = has_next ? (const char*)g.A + a_off<Epi>(E, nxt.pm, K, tstep) : cA; const char* nB = has_next ? (const char*)g.Bt + (size_t)nxt.pn * tstep : cB;
#pragma unroll 1
        for (int t = 0; t < nt; t += 2) {
            const bool last = (t == nt - 2);
            if constexpr (Epi::MID) { if (t == nt / 2) E.mid(acc, cur, wr, wc, fr, fq); }
            const char* a1 = cA + (size_t)(t + 1) * kstep;
            const char* a2 = last ? nA : cA + (size_t)(t + 2) * kstep; const char* b2 = last ? nB : cB + (size_t)(t + 2) * kstep;
            const char* a3 = a2 + kstep; const char* b3 = b2 + kstep;
            if constexpr (SP2) {
            PG8_LDB(B0, 0, 0); PG8_LDB(B1, 0, 1); PG8_SCHED; PG8_LDA(At, 0, 0); PG8_STAGE(PG8_SA(1, 1), a1 + hstep, voffA);
            PG8_WAIT_V(8); PG8_WAIT_L(0); PG8_BAR; PG8_MMA(0, 0, At, B0); PG8_MMA(0, 1, At, B1); PG8_BAR; PG8_SCHED;
            PG8_LDA(At, 0, 1); PG8_STAGE(PG8_SB(0, 0), b2, voffB); PG8_STAGE(PG8_SB(0, 1), b2 + hstep, voffB); PG8_STAGE(PG8_SA(0, 0), a2, voffA);
            PG8_WAIT_V(8); PG8_WAIT_L(0); PG8_BAR; PG8_MMA(1, 0, At, B0); PG8_MMA(1, 1, At, B1); PG8_BAR; PG8_SCHED;
            PG8_LDB(B0, 1, 0); PG8_LDB(B1, 1, 1); PG8_SCHED; PG8_LDA(At, 1, 0); PG8_STAGE(PG8_SA(0, 1), a2 + hstep, voffA);
            PG8_WAIT_V(8); PG8_WAIT_L(0); PG8_BAR; PG8_MMA(0, 0, At, B0); PG8_MMA(0, 1, At, B1); PG8_BAR; PG8_SCHED;
            PG8_LDA(At, 1, 1); PG8_STAGE(PG8_SB(1, 0), b3, voffB); PG8_STAGE(PG8_SB(1, 1), b3 + hstep, voffB); PG8_STAGE(PG8_SA(1, 0), a3, voffA);
            PG8_WAIT_V(8); PG8_WAIT_L(0); PG8_BAR; PG8_MMA(1, 0, At, B0); PG8_MMA(1, 1, At, B1); PG8_BAR; PG8_SCHED;
            } else {
            PG8_LDB(B0, 0, 0); PG8_SCHED; PG8_LDA(At, 0, 0); PG8_STAGE(PG8_SA(1, 1), a1 + hstep, voffA);
            PG8_WAIT_L(8); PG8_BAR; PG8_WAIT_L(0); PG8_MMA(0, 0, At, B0); PG8_BAR; PG8_SCHED;
            PG8_LDB(B1, 0, 1); PG8_STAGE(PG8_SB(0, 0), b2, voffB);
            PG8_BAR; PG8_WAIT_L(0); PG8_MMA(0, 1, At, B1); PG8_BAR;
            PG8_LDA(At, 0, 1); PG8_STAGE(PG8_SA(0, 0), a2, voffA);
            PG8_BAR; PG8_WAIT_L(0); PG8_MMA(1, 0, At, B0); PG8_BAR; PG8_SCHED;
            PG8_STAGE(PG8_SB(0, 1), b2 + hstep, voffB);
            PG8_WAIT_V(6); PG8_BAR; PG8_MMA(1, 1, At, B1); PG8_BAR;
            PG8_LDB(B0, 1, 0); PG8_SCHED; PG8_LDA(At, 1, 0); PG8_STAGE(PG8_SA(0, 1), a2 + hstep, voffA);
            PG8_WAIT_L(8); PG8_BAR; PG8_WAIT_L(0); PG8_MMA(0, 0, At, B0); PG8_BAR; PG8_SCHED;
            PG8_LDB(B1, 1, 1); PG8_STAGE(PG8_SB(1, 0), b3, voffB);
            PG8_BAR; PG8_WAIT_L(0); PG8_MMA(0, 1, At, B1); PG8_BAR;
            PG8_LDA(At, 1, 1); PG8_STAGE(PG8_SA(1, 0), a3, voffA);
            PG8_BAR; PG8_WAIT_L(0); PG8_MMA(1, 0, At, B0); PG8_BAR; PG8_SCHED;
            PG8_STAGE(PG8_SB(1, 1), b3 + hstep, voffB);
            PG8_WAIT_V(6); PG8_BAR; PG8_MMA(1, 1, At, B1); PG8_BAR;
            }
        }
        if constexpr (ALIGN_EPI) { if (wr == 0) PG8_BAR; }
        E(acc, cur, wr, wc, fr, fq);
        if (!has_next) break;
#pragma unroll
        for (int a = 0; a < 2; ++a)
#pragma unroll
            for (int b = 0; b < 2; ++b)
#pragma unroll
                for (int m = 0; m < 4; ++m)
#pragma unroll
                    for (int n = 0; n < 2; ++n) acc[a][b][m][n] = (f32x4){0.f, 0.f, 0.f, 0.f};
        cur = nxt; cA = nA; cB = nB; ++ui;
        if constexpr (ALIGN_EPI) { if (wr == 1) PG8_BAR; }
    }
    PG8_WAIT_V(0);
    if constexpr (!ALIGN_EPI) { if (wr == 0) PG8_BAR; }
    PG8_BAR;
#undef PG8_SA
#undef PG8_SB
#undef PG8_STAGE
#undef PG8_LDA
#undef PG8_LDB
#undef PG8_MMA
#undef PG8_WAIT_V
#undef PG8_WAIT_L
#undef PG8_BAR
#undef PG8_SCHED
}
}
using pg8::HALF;

DEVI u32x4 pack8(const f32x4& a, const f32x4& b) { u32x4 w; w.x = pk2(a[0], a[1]); w.y = pk2(a[2], a[3]); w.z = pk2(b[0], b[1]); w.w = pk2(b[2], b[3]); return w; }

struct EpiIn {
    static constexpr bool PERM = true, MID = false, AROW = false;
    const float* rowss; const float* shW; int job;
    bf16_t *d0, *d1, *d2, *d3, *d4; float* ba;
    DEVI void operator()(const f32x4 (&acc)[2][2][4][2], const pg8::Unit& u, int wr, int wc, int fr, int fq) const {
        asm volatile("" : "+v"(fr), "+v"(fq));
        const int vs = u.pm < 64 ? 0 : (u.pm < 128 ? 1 : 2);
        bf16_t* base; int pitch, colt; bool isba = false;
        if (job == 0) { base = d0; pitch = 3072; colt = u.pn * 256; if (u.pn >= 12) isba = true; }
        else {
            if (u.pn < 4) { base = d0; pitch = 1024; colt = u.pn * 256; }
            else if (u.pn < 8) { base = d1; pitch = 1024; colt = (u.pn - 4) * 256; }
            else if (u.pn == 8) { base = d2; pitch = 256; colt = 0; }
            else if (u.pn == 9) { base = d3; pitch = 256; colt = 0; }
            else { base = d4; pitch = 2048; colt = (u.pn - 10) * 256; }
        }
        const int ncol0 = u.pn * 256 + wc * 32 + 8 * fq;
        f32x4 sv[2][2];
#pragma unroll
        for (int bj = 0; bj < 2; ++bj)
#pragma unroll
            for (int n = 0; n < 2; ++n) sv[bj][n] = *(const f32x4*)(shW + vs * NSH + ncol0 + bj * HALF + 4 * n);
        const int row0 = u.pm * 256 + wr * 64 + fr;
#pragma unroll
        for (int ai = 0; ai < 2; ++ai)
#pragma unroll
            for (int m = 0; m < 4; ++m) {
                const int row = row0 + ai * HALF + m * 16;
                const float rs = rsqrtf(rowss[row] * (1.f / 1024.f) + EPS);
                if (!isba) {
                    bf16_t* rowp = base + (size_t)row * pitch + colt + wc * 32 + 8 * fq;
#pragma unroll
                    for (int bj = 0; bj < 2; ++bj) { const f32x4 v0 = acc[ai][bj][m][0] * rs + sv[bj][0], v1 = acc[ai][bj][m][1] * rs + sv[bj][1]; *(u32x4*)(rowp + bj * HALF) = pack8(v0, v1); }
                } else if (wc == 0) {
                    float* rowp = ba + (size_t)row * 32 + 8 * fq;
                    *(f32x4*)(rowp) = acc[ai][0][m][0] * rs + sv[0][0]; *(f32x4*)(rowp + 4) = acc[ai][0][m][1] * rs + sv[0][1];
                }
            }
    }
};
struct EpiBr {
    static constexpr bool PERM = true, MID = true, AROW = false;
    const bf16_t* mg; bf16_t* out;
    DEVI void mid(f32x4 (&acc)[2][2][4][2], const pg8::Unit& u, int wr, int wc, int fr, int fq) const {
        asm volatile("" : "+v"(fr), "+v"(fq));
        const int row0 = u.pm * 256 + wr * 64 + fr, col0 = u.pn * 256 + wc * 32 + 8 * fq;
#pragma unroll
        for (int ai = 0; ai < 2; ++ai)
#pragma unroll
            for (int m = 0; m < 4; ++m) {
                const bf16_t* rp = mg + (size_t)(row0 + ai * HALF + m * 16) * 2048 + col0;
#pragma unroll
                for (int bj = 0; bj < 2; ++bj) {
                    const u32x4 gd = *(const u32x4*)(rp + bj * HALF), ga = *(const u32x4*)(rp + 1024 + bj * HALF);
                    float r[8];
#pragma unroll
                    for (int i = 0; i < 4; ++i) {
                        const float d0 = bflo(gd[i]), d1 = bfhi(gd[i]), a0 = bflo(ga[i]), a1 = bfhi(ga[i]);
                        r[2 * i] = (1.f + __expf(fminf(-a0, 80.f))) * __builtin_amdgcn_rcpf(1.f + __expf(fminf(-d0, 80.f)));
                        r[2 * i + 1] = (1.f + __expf(fminf(-a1, 80.f))) * __builtin_amdgcn_rcpf(1.f + __expf(fminf(-d1, 80.f)));
                    }
                    acc[ai][bj][m][0] *= (f32x4){r[0], r[1], r[2], r[3]}; acc[ai][bj][m][1] *= (f32x4){r[4], r[5], r[6], r[7]};
                    asm volatile("" ::: "memory");
                }
            }
    }
    DEVI void operator()(const f32x4 (&acc)[2][2][4][2], const pg8::Unit& u, int wr, int wc, int fr, int fq) const {
        asm volatile("" : "+v"(fr), "+v"(fq));
        const int row0 = u.pm * 256 + wr * 64 + fr, col0 = u.pn * 256 + wc * 32 + 8 * fq;
#pragma unroll
        for (int ai = 0; ai < 2; ++ai)
#pragma unroll
            for (int m = 0; m < 4; ++m) {
                const size_t row = (size_t)(row0 + ai * HALF + m * 16);
                const bf16_t* rp = mg + row * 2048 + 1024 + col0;
#pragma unroll
                for (int bj = 0; bj < 2; ++bj) {
                    const u32x4 ga = *(const u32x4*)(rp + bj * HALF);
                    float s[8];
#pragma unroll
                    for (int i = 0; i < 4; ++i) { s[2 * i] = __builtin_amdgcn_rcpf(1.f + __expf(fminf(-bflo(ga[i]), 80.f))); s[2 * i + 1] = __builtin_amdgcn_rcpf(1.f + __expf(fminf(-bfhi(ga[i]), 80.f))); }
                    const f32x4 v0 = acc[ai][bj][m][0] * (f32x4){s[0], s[1], s[2], s[3]}, v1 = acc[ai][bj][m][1] * (f32x4){s[4], s[5], s[6], s[7]};
                    *(u32x4*)(out + row * 1024 + col0 + bj * HALF) = pack8(v0, v1);
                }
            }
    }
};
struct EpiOut {
    static constexpr bool PERM = false, MID = false, AROW = false;
    const float* x; const float* modacc; const float* bada; const float* nwf; float* out; bf16_t* x1s; float* rowss2;
    DEVI void operator()(const f32x4 (&acc)[2][2][4][2], const pg8::Unit& u, int wr, int wc, int fr, int fq) const {
        asm volatile("" : "+v"(fr), "+v"(fq));
        const int b = u.pm >> 6; const int row0 = u.pm * 256 + wr * 64 + fr, col0 = u.pn * 256 + wc * 32 + 4 * fq;
        f32x4 ga[2][2], sc[2][2];
#pragma unroll
        for (int bj = 0; bj < 2; ++bj)
#pragma unroll
            for (int n = 0; n < 2; ++n) { const int c = col0 + bj * HALF + n * 16;
                ga[bj][n] = *(const f32x4*)(modacc + b * 6144 + 2048 + c) + *(const f32x4*)(bada + 2048 + c);
                sc[bj][n] = (*(const f32x4*)(modacc + b * 6144 + 4096 + c) + *(const f32x4*)(bada + 4096 + c) + 1.f) * *(const f32x4*)(nwf + c); }
#pragma unroll
        for (int ai = 0; ai < 2; ++ai)
#pragma unroll
            for (int m = 0; m < 4; ++m) {
                const size_t off = (size_t)(row0 + ai * HALF + m * 16) * 1024 + col0; float ss = 0.f;
#pragma unroll
                for (int bj = 0; bj < 2; ++bj)
#pragma unroll
                    for (int n = 0; n < 2; ++n) {
                        const f32x4 xv = *(const f32x4*)(x + off + bj * HALF + n * 16);
                        const f32x4 o = xv + ga[bj][n] * acc[ai][bj][m][n];
                        *(f32x4*)(out + off + bj * HALF + n * 16) = o;
                        ss += (o[0] * o[0] + o[1] * o[1]) + (o[2] * o[2] + o[3] * o[3]);
                        const f32x4 s = o * sc[bj][n]; u32x2 w; w.x = pk2(s[0], s[1]); w.y = pk2(s[2], s[3]);
                        *(u32x2*)(x1s + off + (size_t)(b * (RB - SEQ) + 1) * 1024 + bj * HALF + n * 16) = w;
                    }
                ss += __shfl_xor(ss, 16); ss += __shfl_xor(ss, 32);
                if (fq == 0) atomicAdd(rowss2 + row0 + ai * HALF + m * 16, ss);
            }
    }
};
DEVI f32x4 dpp_ror1(const f32x4& x) { f32x4 r;
#pragma unroll
    for (int i = 0; i < 4; ++i) r[i] = __int_as_float(__builtin_amdgcn_update_dpp(0, __float_as_int(x[i]), 0x121, 0xf, 0xf, false));
    return r; }
DEVI f32x4 dpp_rol1(const f32x4& x) { f32x4 r;
#pragma unroll
    for (int i = 0; i < 4; ++i) r[i] = __int_as_float(__builtin_amdgcn_update_dpp(0, __float_as_int(x[i]), 0x12F, 0xf, 0xf, false));
    return r; }
struct EpiUpConv {
    static constexpr bool PERM = true, MID = false, AROW = true;
    const float* rowss2; const float* shWf; const float* cw; const float* cb; bf16_t* act; LAS float* xb;
    DEVI int arow(int pm) const { const int b = pm / TPB, i = pm - b * TPB; return b * RB + 254 * i; }
    DEVI void operator()(f32x4 (&acc)[2][2][4][2], const pg8::Unit& u, int wr, int wc, int fr, int fq) const {
        asm volatile("" : "+v"(fr), "+v"(fq));
        const int b = u.pm / TPB, ti = u.pm - b * TPB, tok0 = 254 * ti - 1;
        const int cl0 = wc * 32 + 8 * fq;
#pragma unroll
        for (int bj = 0; bj < 2; ++bj) {
            const f32x4 sv0 = *(const f32x4*)(shWf + b * NUP + u.pn * 256 + bj * HALF + cl0), sv1 = *(const f32x4*)(shWf + b * NUP + u.pn * 256 + bj * HALF + cl0 + 4);
#pragma unroll
            for (int ai = 0; ai < 2; ++ai)
#pragma unroll
                for (int m = 0; m < 4; ++m) {
                    const int tok = tok0 + ai * HALF + wr * 64 + m * 16 + fr; const bool ok = tok >= 0 && tok < SEQ;
                    const float rs = ok ? rsqrtf(rowss2[b * SEQ + (ok ? tok : 0)] * (1.f / 1024.f) + EPS) : 0.f;
                    acc[ai][bj][m][0] = ok ? acc[ai][bj][m][0] * rs + sv0 : (f32x4){0.f, 0.f, 0.f, 0.f};
                    acc[ai][bj][m][1] = ok ? acc[ai][bj][m][1] * rs + sv1 : (f32x4){0.f, 0.f, 0.f, 0.f};
                }
        }
#pragma unroll
        for (int ai = 0; ai < 2; ++ai) { const int blk = 2 * ai + wr;
#pragma unroll
            for (int bj = 0; bj < 2; ++bj)
#pragma unroll
                for (int n = 0; n < 2; ++n) {
                    if (fr == 0) *(LAS f32x4*)(xb + (blk * 2 + 0) * 256 + bj * HALF + cl0 + 4 * n) = acc[ai][bj][0][n];
                    if (fr == 15) *(LAS f32x4*)(xb + (blk * 2 + 1) * 256 + bj * HALF + cl0 + 4 * n) = acc[ai][bj][3][n];
                } }
        asm volatile("s_waitcnt lgkmcnt(0)" ::: "memory"); __builtin_amdgcn_s_barrier(); asm volatile("" ::: "memory");
        const int f0 = u.pn * 128 + cl0;
#pragma unroll
        for (int n = 0; n < 2; ++n) {
            f32x4 wg[3], wv[3];
#pragma unroll
            for (int j = 0; j < 3; ++j) { wg[j] = *(const f32x4*)(cw + j * NUP + f0 + 4 * n); wv[j] = *(const f32x4*)(cw + j * NUP + DFF + f0 + 4 * n); }
            const f32x4 bgv = *(const f32x4*)(cb + f0 + 4 * n), bvv = *(const f32x4*)(cb + DFF + f0 + 4 * n);
#pragma unroll
            for (int ai = 0; ai < 2; ++ai) { const int blk = 2 * ai + wr;
                const f32x4 pgx = *(const LAS f32x4*)(xb + (((blk + 3) & 3) * 2 + 1) * 256 + cl0 + 4 * n), pvx = *(const LAS f32x4*)(xb + (((blk + 3) & 3) * 2 + 1) * 256 + HALF + cl0 + 4 * n);
                const f32x4 ngx = *(const LAS f32x4*)(xb + (((blk + 1) & 3) * 2 + 0) * 256 + cl0 + 4 * n), nvx = *(const LAS f32x4*)(xb + (((blk + 1) & 3) * 2 + 0) * 256 + HALF + cl0 + 4 * n);
#pragma unroll
                for (int m = 0; m < 4; ++m) {
                    f32x4 ug, uv;
                    { const f32x4 c = acc[ai][0][m][n], up = m > 0 ? acc[ai][0][m > 0 ? m - 1 : 0][n] : pgx, dn = m < 3 ? acc[ai][0][m < 3 ? m + 1 : 3][n] : ngx;
                      f32x4 pr = dpp_ror1(fr == 15 ? up : c), nx = dpp_rol1(fr == 0 ? dn : c);
                      asm volatile("" : "+v"(pr), "+v"(nx));
                      ug = bgv + wg[0] * pr + wg[1] * c + wg[2] * nx; }
                    { const f32x4 c = acc[ai][1][m][n], up = m > 0 ? acc[ai][1][m > 0 ? m - 1 : 0][n] : pvx, dn = m < 3 ? acc[ai][1][m < 3 ? m + 1 : 3][n] : nvx;
                      f32x4 pr = dpp_ror1(fr == 15 ? up : c), nx = dpp_rol1(fr == 0 ? dn : c);
                      asm volatile("" : "+v"(pr), "+v"(nx));
                      uv = bvv + wv[0] * pr + wv[1] * c + wv[2] * nx; }
                    const int r = ai * HALF + wr * 64 + m * 16 + fr, tok = tok0 + r;
                    if (r >= 1 && r <= 254 && tok < SEQ) {
                        u32x2 w; w.x = pk2(siluf(ug[0]) * uv[0], siluf(ug[1]) * uv[1]); w.y = pk2(siluf(ug[2]) * uv[2], siluf(ug[3]) * uv[3]);
                        *(u32x2*)(act + (size_t)(b * SEQ + tok) * DFF + f0 + 4 * n) = w; }
                    asm volatile("" ::: "memory");
                }
            }
        }
    }
};
struct EpiDown {
    static constexpr bool PERM = false, MID = false, AROW = false;
    const float* modacc; const float* bada; float* out;
    DEVI void operator()(const f32x4 (&acc)[2][2][4][2], const pg8::Unit& u, int wr, int wc, int fr, int fq) const {
        asm volatile("" : "+v"(fr), "+v"(fq));
        const int b = u.pm >> 6; const int row0 = u.pm * 256 + wr * 64 + fr, col0 = u.pn * 256 + wc * 32 + 4 * fq;
        f32x4 gf[2][2];
#pragma unroll
        for (int bj = 0; bj < 2; ++bj)
#pragma unroll
            for (int n = 0; n < 2; ++n) { const int c = col0 + bj * HALF + n * 16; gf[bj][n] = *(const f32x4*)(modacc + b * 6144 + 5120 + c) + *(const f32x4*)(bada + 5120 + c); }
#pragma unroll
        for (int ai = 0; ai < 2; ++ai)
#pragma unroll
            for (int m = 0; m < 4; ++m) {
                const size_t off = (size_t)(row0 + ai * HALF + m * 16) * 1024 + col0;
#pragma unroll
                for (int bj = 0; bj < 2; ++bj)
#pragma unroll
                    for (int n = 0; n < 2; ++n) { float* p = out + off + bj * HALF + n * 16; *(f32x4*)p = *(const f32x4*)p + gf[bj][n] * acc[ai][bj][m][n]; }
            }
    }
};

DEVI void transpose_item(const float* W, int srcN, int k0, int n0, bf16_t* dst  , int dstK, LAS float* scr, int lane) {
#pragma unroll 8
    for (int i = 0; i < 32; ++i) { const int kk = 2 * i + (lane >> 5); scr[kk * 33 + (lane & 31)] = W[(size_t)(k0 + kk) * srcN + n0 + (lane & 31)]; }
    asm volatile("s_waitcnt lgkmcnt(0)" ::: "memory");
    const int c = lane & 7;
#pragma unroll
    for (int j = 0; j < 4; ++j) { const int n = (lane >> 3) + 8 * j; const LAS float* s = scr + (8 * c) * 33 + n;
        u32x4 o; o.x = pk2(s[0 * 33], s[1 * 33]); o.y = pk2(s[2 * 33], s[3 * 33]); o.z = pk2(s[4 * 33], s[5 * 33]); o.w = pk2(s[6 * 33], s[7 * 33]);
        *(u32x4*)(dst + (size_t)n * dstK + 8 * c) = o; }
    asm volatile("s_waitcnt lgkmcnt(0)" ::: "memory");
}
DEVI void phase0(const Args& a, LAS unsigned char* lds, int tid, int lane, int wave) {
    unsigned char* ws = a.ws;
    bf16_t* WinA = (bf16_t*)(ws + WS_WINA); bf16_t* WinC = (bf16_t*)(ws + WS_WINC); bf16_t* Wbr = (bf16_t*)(ws + WS_WBR);
    bf16_t* Wout = (bf16_t*)(ws + WS_WOUT); bf16_t* Wup = (bf16_t*)(ws + WS_WUP); bf16_t* Wdn = (bf16_t*)(ws + WS_WDN);
    LAS float* scr = (LAS float*)(lds + wave * 16384);
    const int gw = blockIdx.x * 8 + wave, NGW = gridDim.x * 8;
    constexpr int I_IN = 16 * 241, I_BR = 16 * 32, I_UP = 16 * 176, I_DN = 44 * 32;
    constexpr int NITEMS = I_IN + 3 * I_BR + I_UP + I_DN;
    for (int it = gw; it < NITEMS; it += NGW) {
        int r = it;
        if (r < I_IN) { const int kb = r / 241, nb = r % 241, c0 = nb * 32; bf16_t* d; int row;
            if (c0 < 3072) { d = WinA; row = c0; } else if (c0 < 4096) { d = WinC; row = c0 - 3072; } else if (c0 == 4096) { d = WinA; row = 3072; }
            else if (c0 < 5152) { d = WinC; row = 1024 + (c0 - 4128); } else if (c0 < 5408) { d = WinC; row = 2048 + (c0 - 5152); }
            else if (c0 < 5664) { d = WinC; row = 2304 + (c0 - 5408); } else { d = WinC; row = 2560 + (c0 - 5664); }
            transpose_item(a.in[8], 7712, kb * 64, c0, d + (size_t)row * 1024 + kb * 64, 1024, scr, lane); continue; }
        r -= I_IN;
        if (r < I_BR) { const int kb = r / 32, nb = r % 32; transpose_item(a.in[16], 1024, kb * 64, nb * 32, Wbr + (size_t)(nb * 32) * 2048 + kb * 64, 2048, scr, lane); continue; }
        r -= I_BR;
        if (r < I_BR) { const int kb = r / 32, nb = r % 32; transpose_item(a.in[17], 1024, kb * 64, nb * 32, Wbr + (size_t)(nb * 32) * 2048 + 1024 + kb * 64, 2048, scr, lane); continue; }
        r -= I_BR;
        if (r < I_BR) { const int kb = r / 32, nb = r % 32; transpose_item(a.in[18], 1024, kb * 64, nb * 32, Wout + (size_t)(nb * 32) * 1024 + kb * 64, 1024, scr, lane); continue; }
        r -= I_BR;
        if (r < I_UP) { const int kb = r / 176, nb = r % 176, c0 = nb * 32; int row;
            if (c0 < DFF) row = 256 * (c0 / 128) + (c0 % 128); else { const int c1 = c0 - DFF; row = 256 * (c1 / 128) + 128 + (c1 % 128); }
            transpose_item(a.in[19], NUP, kb * 64, c0, Wup + (size_t)row * 1024 + kb * 64, 1024, scr, lane); continue; }
        r -= I_UP;
        { const int kb = r / 32, nb = r % 32; transpose_item(a.in[22], 1024, kb * 64, nb * 32, Wdn + (size_t)(nb * 32) * DFF + kb * 64, DFF, scr, lane); }
    }
    float* modacc = (float*)(ws + CTL_MODACC);
    for (int it = blockIdx.x; it < 12 * 16; it += gridDim.x) {
        const int cb = it % 12, ks = it / 12, n = cb * 512 + tid;
        float a0 = 0.f, a1 = 0.f, a2 = 0.f;
#pragma unroll 8
        for (int k = ks * 64; k < ks * 64 + 64; ++k) {
            const float w = a.in[4][(size_t)k * 6144 + n];
            a0 += siluf(a.in[1][k]) * w; a1 += siluf(a.in[1][1024 + k]) * w; a2 += siluf(a.in[3][k]) * w;
        }
        atomicAdd(modacc + n, a0); atomicAdd(modacc + 6144 + n, a1); atomicAdd(modacc + 12288 + n, a2);
    }
    float* rope = (float*)(ws + SM_ROPE);
    for (int i = blockIdx.x * 512 + tid; i < 320 * 32; i += gridDim.x * 512) {
        const int p = i >> 5, f = i & 31; const float inv = powf(10000.f, -(float)f / 32.f);
        if (p < 256) { const float ang = (float)p * inv; rope[p * 32 + f] = cosf(ang); rope[8192 + p * 32 + f] = sinf(ang); }
        else { const int q = p - 256; const float ang = (float)q * inv; rope[16384 + q * 32 + f] = cosf(ang); rope[16384 + 2048 + q * 32 + f] = sinf(ang); }
    }
}

DEVI void phase1(const Args& a, int tid, int lane, int wave) {
    unsigned char* ws = a.ws;
    const float* modacc = (const float*)(ws + CTL_MODACC); const float* bada = a.in[5];
    bf16_t* XN = (bf16_t*)(ws + WS_XN); float* rowss1 = (float*)(ws + SM_ROWSS1);
    const int gw = blockIdx.x * 8 + wave, NGW = gridDim.x * 8;
    for (int row = gw; row < MT; row += NGW) {
        const int vs = row < SEQ ? 0 : (row < ML ? 1 : 2);
        const float* xr = row < ML ? a.in[0] + (size_t)row * 1024 : a.in[2] + (size_t)(row - ML) * 1024;
        float ss = 0.f;
#pragma unroll
        for (int j = 0; j < 4; ++j) {
            const int c = 4 * lane + 256 * j;
            const f32x4 v = *(const f32x4*)(xr + c);
            ss += (v[0] * v[0] + v[1] * v[1]) + (v[2] * v[2] + v[3] * v[3]);
            const f32x4 s = (*(const f32x4*)(modacc + vs * 6144 + 1024 + c) + *(const f32x4*)(bada + 1024 + c) + 1.f) * *(const f32x4*)(a.in[6] + c);
            const f32x4 o = v * s; u32x2 w; w.x = pk2(o[0], o[1]); w.y = pk2(o[2], o[3]);
            *(u32x2*)(XN + (size_t)row * 1024 + c) = w;
        }
        ss = wave_sum(ss);
        if (lane == 0) rowss1[row] = ss;
    }
    const bf16_t* WinA = (const bf16_t*)(ws + WS_WINA); const bf16_t* WinC = (const bf16_t*)(ws + WS_WINC); const bf16_t* Wup = (const bf16_t*)(ws + WS_WUP);
    float* shWa = (float*)(ws + SM_SHWA); float* shWf = (float*)(ws + SM_SHWF);
    for (int n = gw; n < NSH + NUP; n += NGW) {
        const bool isf = n >= NSH;
        const bf16_t* wrow = isf ? Wup + (size_t)(n - NSH) * 1024 : (n < NA ? WinA + (size_t)n * 1024 : WinC + (size_t)(n - NA) * 1024);
        const int shoff = isf ? 3072 : 0;
        float s0 = 0.f, s1 = 0.f, s2 = 0.f;
#pragma unroll
        for (int h = 0; h < 2; ++h) {
            const int k0 = h * 512 + lane * 8;
            const u32x4 w = *(const u32x4*)(wrow + k0);
#pragma unroll
            for (int i = 0; i < 4; ++i) {
                const float wl = bflo(w[i]), wh = bfhi(w[i]); const int k = k0 + 2 * i;
                const float b0 = bada[shoff + k], b1 = bada[shoff + k + 1];
                s0 += (modacc[shoff + k] + b0) * wl + (modacc[shoff + k + 1] + b1) * wh;
                s1 += (modacc[6144 + shoff + k] + b0) * wl + (modacc[6144 + shoff + k + 1] + b1) * wh;
                s2 += (modacc[12288 + shoff + k] + b0) * wl + (modacc[12288 + shoff + k + 1] + b1) * wh;
            }
        }
        s0 = wave_sum(s0); s1 = wave_sum(s1); s2 = wave_sum(s2);
        if (lane == 0) {
            if (isf) { shWf[n - NSH] = s0; shWf[NUP + n - NSH] = s1; }
            else { shWa[n] = s0; shWa[NSH + n] = s1; shWa[2 * NSH + n] = s2; }
        }
    }
}

DEVI u32x4 ldrow_(const bf16_t* base, int seq_start, int seq_len, int tt) {
    const int tc = tt < 0 ? 0 : (tt >= seq_len ? seq_len - 1 : tt);
    const u32x4 v = *(const u32x4*)(base + (size_t)(seq_start + tc) * 3072);
    const unsigned m = (tt == tc) ? 0xffffffffu : 0u;
    return (u32x4){v[0] & m, v[1] & m, v[2] & m, v[3] & m};
}
DEVI void phase_dnprep(const Args& a, int tid) {
    unsigned char* ws = a.ws;
    const bf16_t* QR = (const bf16_t*)(ws + WS_QKVR); bf16_t* QP = (bf16_t*)(ws + WS_QKVP);
    const float* convw = a.in[9]; const float* ba = (const float*)(ws + WS_BA);
    float* gb = (float*)(ws + WS_G); float* bb = (float*)(ws + WS_BETA);
    const int cgp = tid & 127, strip = tid >> 7;
    for (int it = blockIdx.x; it < 520 * 3; it += gridDim.x) {
        const int cidx = it / 3, sec = it - cidx * 3;
        int seq_start, t0, seq_len;
        if (cidx < 512) { seq_start = (cidx >> 8) * SEQ; t0 = (cidx & 255) * 64; seq_len = SEQ; }
        else { const int c2 = cidx - 512; seq_start = ML + (c2 >> 2) * CTX; t0 = (c2 & 3) * 64; seq_len = CTX; }
        const int col = sec * 1024 + cgp * 8;
        f32x4 w0[5], w1[5];
#pragma unroll
        for (int j = 0; j < 5; ++j) { w0[j] = *(const f32x4*)(convw + j * 3072 + col); w1[j] = *(const f32x4*)(convw + j * 3072 + col + 4); }
        const int tb = t0 + strip * 16;
        u32x4 win[5];
#define LDROW(tt) ldrow_(QR + col, seq_start, seq_len, (tt))
        win[0] = LDROW(tb - 2); win[1] = LDROW(tb - 1); win[2] = LDROW(tb); win[3] = LDROW(tb + 1);
#pragma unroll
        for (int r = 0; r < 16; ++r) {
            win[4] = LDROW(tb + r + 2);
            f32x4 acc0 = {0.f, 0.f, 0.f, 0.f}, acc1 = {0.f, 0.f, 0.f, 0.f};
#pragma unroll
            for (int j = 0; j < 5; ++j) { const u32x4 x = win[j];
                acc0 += (f32x4){bflo(x[0]), bfhi(x[0]), bflo(x[1]), bfhi(x[1])} * w0[j];
                acc1 += (f32x4){bflo(x[2]), bfhi(x[2]), bflo(x[3]), bfhi(x[3])} * w1[j]; }
            float y[8];
#pragma unroll
            for (int i = 0; i < 4; ++i) { y[i] = siluf(acc0[i]); y[4 + i] = siluf(acc1[i]); }
            if (sec < 2) {
                float ss = 0.f;
#pragma unroll
                for (int i = 0; i < 8; ++i) ss += y[i] * y[i];
                ss += __shfl_xor(ss, 1); ss += __shfl_xor(ss, 2); ss += __shfl_xor(ss, 4); ss += __shfl_xor(ss, 8);
                const float sc = rsqrtf(ss + EPS) * (sec == 0 ? 0.08838834764831845f : 1.f);
#pragma unroll
                for (int i = 0; i < 8; ++i) y[i] *= sc;
            }
            u32x4 o; o.x = pk2(y[0], y[1]); o.y = pk2(y[2], y[3]); o.z = pk2(y[4], y[5]); o.w = pk2(y[6], y[7]);
            *(u32x4*)(QP + (size_t)(seq_start + tb + r) * 3072 + col) = o;
            win[0] = win[1]; win[1] = win[2]; win[2] = win[3]; win[3] = win[4];
        }
#undef LDROW
        if (sec == 0) {
#pragma unroll
            for (int q = 0; q < 2; ++q) {
                const int e = tid + q * 512, r = e >> 4, idx = e & 15, row = seq_start + t0 + r;
                const float bv = ba[(size_t)row * 32 + idx], av = ba[(size_t)row * 32 + 16 + idx];
                const float xs = av + a.in[11][idx];
                const float sp = fmaxf(xs, 0.f) + log1pf(expf(-fabsf(xs)));
                const float g = -expf(a.in[10][idx]) * sp;
                const int dir = idx >> 3, h = idx & 7;
                gb[((size_t)dir * MT + row) * 8 + h] = g;
                bb[((size_t)dir * MT + row) * 8 + h] = 1.f / (1.f + expf(-bv));
            }
        }
    }
}

DEVI void phase_dnscan(const Args& a, int lane, int wave) {
    unsigned char* ws = a.ws;
    const bf16_t* QP = (const bf16_t*)(ws + WS_QKVP);
    const float* gb = (const float*)(ws + WS_G); const float* bb = (const float*)(ws + WS_BETA);
    bf16_t* Of = (bf16_t*)a.out; bf16_t* Ob = Of + (size_t)ML * 1024;
    const int gw = blockIdx.x * 8 + wave, NGW = gridDim.x * 8;
    for (int item = gw; item < 2048; item += NGW) {
        const int chain = item >> 6, ep = item & 63, dir = chain >> 4, b = (chain >> 3) & 1, h = chain & 7;
        bf16_t* O = dir ? Ob : Of;
        float S00 = 0.f, S01 = 0.f, S10 = 0.f, S11 = 0.f;
        const int NTOK = CTX + SEQ;
        constexpr int U = 4;
        unsigned kq[U], qq[U], vv[U]; float gg[U], be[U]; int rows[U];
        auto rowof = [&](int s) -> int { if (s < CTX) { const int t = dir ? CTX - 1 - s : s; return ML + b * CTX + t; } const int t2 = s - CTX; const int t = dir ? SEQ - 1 - t2 : t2; return b * SEQ + t; };
#define SC_LOAD(i, s) do { const int row_ = rowof(s); rows[i] = row_; const bf16_t* p_ = QP + (size_t)row_ * 3072 + h * 128; \
        qq[i] = *(const unsigned*)(p_ + 2 * lane); kq[i] = *(const unsigned*)(p_ + 1024 + 2 * lane); vv[i] = *(const unsigned*)(p_ + 2048 + 2 * ep); \
        gg[i] = gb[((size_t)dir * MT + row_) * 8 + h]; be[i] = bb[((size_t)dir * MT + row_) * 8 + h]; } while (0)
        for (int s0 = 0; s0 < NTOK; s0 += U) {
#pragma unroll
            for (int i = 0; i < U; ++i) SC_LOAD(i, s0 + i);
#pragma unroll
            for (int i = 0; i < U; ++i) {
                const float k0 = bflo(kq[i]), k1 = bfhi(kq[i]), q0 = bflo(qq[i]), q1 = bfhi(qq[i]), v0 = bflo(vv[i]), v1 = bfhi(vv[i]);
                const float eg = __expf(gg[i]), bt = be[i];
                float p0 = k0 * S00 + k1 * S10, p1 = k0 * S01 + k1 * S11;
                p0 = wave_sum(p0); p1 = wave_sum(p1);
                const float vn0 = bt * (v0 - eg * p0), vn1 = bt * (v1 - eg * p1);
                S00 = eg * S00 + k0 * vn0; S01 = eg * S01 + k0 * vn1; S10 = eg * S10 + k1 * vn0; S11 = eg * S11 + k1 * vn1;
                float o0 = q0 * S00 + q1 * S10, o1 = q0 * S01 + q1 * S11;
                o0 = wave_sum(o0); o1 = wave_sum(o1);
                if (lane == 0 && rows[i] < ML) *(unsigned*)(O + (size_t)rows[i] * 1024 + h * 128 + 2 * ep) = pk2(o0, o1);
            }
        }
#undef SC_LOAD
    }
}

DEVI bf16x8 ld_b128(LAS const unsigned char* p) { return *(LAS const bf16x8*)p; }
DEVI bf16x8 ld_2b64(LAS const unsigned char* p0, LAS const unsigned char* p1) { const u32x2 a = *(LAS const u32x2*)p0, b = *(LAS const u32x2*)p1; u32x4 w = {a.x, a.y, b.x, b.y}; return __builtin_bit_cast(bf16x8, w); }
DEVI bf16x8 pack_frag(const f32x4& lo, const f32x4& hi) { u32x4 w = {pk2(lo[0], lo[1]), pk2(lo[2], lo[3]), pk2(hi[0], hi[1]), pk2(hi[2], hi[3])}; return __builtin_bit_cast(bf16x8, w); }
#define MFMA16(A, B, C) __builtin_amdgcn_mfma_f32_16x16x32_bf16(A, B, C, 0, 0, 0)
DEVI void phase_dnchunk(const Args& a, LAS unsigned char* lds, int tid, int lane, int wave) {
    unsigned char* ws = a.ws;
    const bf16_t* QP = (const bf16_t*)(ws + WS_QKVP); const float* gb = (const float*)(ws + WS_G); const float* bb = (const float*)(ws + WS_BETA);
    bf16_t* TQ = (bf16_t*)(ws + WS_TQ); float* AV = (float*)(ws + WS_AVEC);
    constexpr int KL = 0, QL = 17408, KKF = 34816, QKF = 52224, VEC = 131072;
    const int fr = lane & 15, g = lane >> 4, d = wave >> 2, wq = wave & 3;
    LAS unsigned char* dbase = lds + d * 64512;
    LAS float* Gg = (LAS float*)(lds + VEC); LAS float* Bv = Gg + 128; LAS float* GC = Gg + 256;
    for (int item = blockIdx.x; item < 520 * 8; item += gridDim.x) {
        const int cidx = item >> 3, h = item & 7;
        const int row0 = cidx < 512 ? cidx * 64 : ML + (cidx - 512) * 64;
#pragma unroll
        for (int i = 0; i < 2; ++i) { const int c = tid + i * 512, r = c >> 4, ch = c & 15;
            const bf16_t* src = QP + (size_t)(row0 + r) * 3072 + h * 128 + ch * 8;
            *(LAS u32x4*)(lds + QL + r * 272 + ch * 16) = *(const u32x4*)src; *(LAS u32x4*)(lds + KL + r * 272 + ch * 16) = *(const u32x4*)(src + 1024); }
        if (tid < 128) { const int dd = tid >> 6, pos = tid & 63; Gg[tid] = gb[((size_t)dd * MT + row0 + pos) * 8 + h]; Bv[tid] = bb[((size_t)dd * MT + row0 + pos) * 8 + h]; }
        __syncthreads();
        if (wave < 2) {
            const int dd = wave, pos = dd ? 63 - lane : lane; float x = Gg[dd * 64 + pos];
#pragma unroll
            for (int o = 1; o < 64; o <<= 1) { const float y = __shfl_up(x, o); if (lane >= o) x += y; }
            const float total = __shfl(x, 63);
            GC[dd * 64 + pos] = x;
            float* av = AV + ((size_t)item * 2 + dd) * 256;
            av[pos] = __expf(x); av[64 + pos] = Bv[dd * 64 + pos]; av[128 + pos] = __expf(total - x); if (lane == 0) av[192] = __expf(total);
        }
        {
            const int src = d ? QL : KL;
            f32x4 acc[4] = {{0.f, 0.f, 0.f, 0.f}, {0.f, 0.f, 0.f, 0.f}, {0.f, 0.f, 0.f, 0.f}, {0.f, 0.f, 0.f, 0.f}};
#pragma unroll
            for (int s4 = 0; s4 < 4; ++s4) { const bf16x8 A = ld_b128(lds + src + (16 * wq + fr) * 272 + (32 * s4 + 8 * g) * 2);
#pragma unroll
                for (int jt = 0; jt < 4; ++jt) { const bf16x8 Bf = ld_b128(lds + KL + (16 * jt + fr) * 272 + (32 * s4 + 8 * g) * 2); acc[jt] = MFMA16(A, Bf, acc[jt]); } }
            LAS float* dst = (LAS float*)(lds + (d ? QKF : KKF));
#pragma unroll
            for (int jt = 0; jt < 4; ++jt)
#pragma unroll
                for (int r = 0; r < 4; ++r) dst[(16 * wq + 4 * g + r) * 68 + 16 * jt + fr] = acc[jt][r];
        }
        __syncthreads();
        f32x4 P[4], qd[4];
        {
            const LAS float* kkf = (const LAS float*)(lds + KKF); const LAS float* qkf = (const LAS float*)(lds + QKF);
            float gci[4], bei[4];
#pragma unroll
            for (int r = 0; r < 4; ++r) { gci[r] = GC[d * 64 + 16 * wq + 4 * g + r]; bei[r] = Bv[d * 64 + 16 * wq + 4 * g + r]; }
#pragma unroll
            for (int jt = 0; jt < 4; ++jt) { const int j = 16 * jt + fr; const float gcj = GC[d * 64 + j];
#pragma unroll
                for (int r = 0; r < 4; ++r) { const int i = 16 * wq + 4 * g + r; const bool incl = d ? (i <= j) : (i >= j);
                    const float e = incl ? __expf(gci[r] - gcj) : 0.f;
                    qd[jt][r] = qkf[i * 68 + j] * e; P[jt][r] = (i != j) ? -bei[r] * kkf[i * 68 + j] * e : 0.f; } }
        }
        __syncthreads();
        {
#pragma unroll
            for (int jt = 0; jt < 4; ++jt) {
#pragma unroll
                for (int r = 0; r < 4; ++r) { const int i = 16 * wq + 4 * g + r, j = 16 * jt + fr;
                    *(LAS unsigned short*)(dbase + 0 + i * 144 + j * 2) = (unsigned short)f2bf(P[jt][r]);
                    *(LAS unsigned short*)(dbase + 36864 + 9216 + i * 144 + j * 2) = (unsigned short)f2bf(P[jt][r]);
                    *(LAS unsigned short*)(dbase + 55296 + i * 144 + j * 2) = (unsigned short)f2bf(qd[jt][r]); }
                u32x2 w = {pk2(P[jt][0], P[jt][1]), pk2(P[jt][2], P[jt][3])};
                *(LAS u32x2*)(dbase + 18432 + (16 * jt + fr) * 144 + (16 * wq + 4 * g) * 2) = w; }
        }
        __syncthreads();
        int cur = 0;
#pragma unroll 1
        for (int it = 0; it < 5; ++it) {
            LAS unsigned char* NRc = dbase + cur * 9216; LAS unsigned char* NTc = dbase + 18432 + cur * 9216;
            LAS unsigned char* NRn = dbase + (cur ^ 1) * 9216; LAS unsigned char* NTn = dbase + 18432 + (cur ^ 1) * 9216;
            LAS unsigned char* PRo = dbase + 36864 + ((it + 1) & 1) * 9216; LAS unsigned char* PRn = dbase + 36864 + (it & 1) * 9216;
            f32x4 n2[4] = {{0.f, 0.f, 0.f, 0.f}, {0.f, 0.f, 0.f, 0.f}, {0.f, 0.f, 0.f, 0.f}, {0.f, 0.f, 0.f, 0.f}};
#pragma unroll
            for (int s2 = 0; s2 < 2; ++s2) { const bf16x8 A = ld_b128(NRc + (16 * wq + fr) * 144 + (32 * s2 + 8 * g) * 2);
#pragma unroll
                for (int jt = 0; jt < 4; ++jt) { const bf16x8 Bf = ld_b128(NTc + (16 * jt + fr) * 144 + (32 * s2 + 8 * g) * 2); n2[jt] = MFMA16(A, Bf, n2[jt]); } }
#pragma unroll
            for (int jt = 0; jt < 4; ++jt) {
#pragma unroll
                for (int r = 0; r < 4; ++r) *(LAS unsigned short*)(NRn + (16 * wq + 4 * g + r) * 144 + (16 * jt + fr) * 2) = (unsigned short)f2bf(n2[jt][r]);
                u32x2 w = {pk2(n2[jt][0], n2[jt][1]), pk2(n2[jt][2], n2[jt][3])};
                *(LAS u32x2*)(NTn + (16 * jt + fr) * 144 + (16 * wq + 4 * g) * 2) = w;
                P[jt] += n2[jt]; }
            __syncthreads();
#pragma unroll
            for (int s2 = 0; s2 < 2; ++s2) { const bf16x8 A = ld_b128(PRo + (16 * wq + fr) * 144 + (32 * s2 + 8 * g) * 2);
#pragma unroll
                for (int jt = 0; jt < 4; ++jt) { const bf16x8 Bf = ld_b128(NTn + (16 * jt + fr) * 144 + (32 * s2 + 8 * g) * 2); P[jt] = MFMA16(A, Bf, P[jt]); } }
#pragma unroll
            for (int jt = 0; jt < 4; ++jt)
#pragma unroll
                for (int r = 0; r < 4; ++r) *(LAS unsigned short*)(PRn + (16 * wq + 4 * g + r) * 144 + (16 * jt + fr) * 2) = (unsigned short)f2bf(P[jt][r]);
            cur ^= 1;
        }
        __syncthreads();
        {
            bf16_t* dst = TQ + ((size_t)item * 2 + d) * 8192; const int t2 = tid & 255;
#pragma unroll
            for (int k = 0; k < 4; ++k) { const int c = t2 + 256 * k, mat = c >> 9, r = (c >> 3) & 63, ch = c & 7;
                const u32x4 v = *(LAS const u32x4*)(dbase + (mat ? 55296 : 36864) + r * 144 + ch * 16);
                *(u32x4*)(dst + mat * 4096 + r * 64 + ch * 8) = v; }
        }
        __syncthreads();
    }
}

DEVI void phase_dnscan2(const Args& a, LAS unsigned char* lds, int tid, int lane, int wave, unsigned long long& pr_extra) {
    const int v = blockIdx.x;
    unsigned char* ws = a.ws;
    const bf16_t* QP = (const bf16_t*)(ws + WS_QKVP); const bf16_t* TQ = (const bf16_t*)(ws + WS_TQ); const float* AV = (const float*)(ws + WS_AVEC);
    unsigned* prog = (unsigned*)(ws + CTL_PROG);
    constexpr int NSTEP = 260;
    int vrole = v;
#if MK_ONE_LAUNCH
    {
        unsigned* bar_ = (unsigned*)(ws + WS_CTL); unsigned* xr_ = (unsigned*)(ws + CTL_XRANK);
        bool dyn = gridDim.x == 256;
#pragma unroll
        for (int j = 0; j < 16; ++j) { const unsigned c_ = __hip_atomic_load(&bar_[256 + 64 * j], __ATOMIC_RELAXED, __HIP_MEMORY_SCOPE_AGENT); dyn = dyn && (c_ == (j < 8 ? 32u : 0u)); }
        if (dyn) {
            const unsigned xcc = (unsigned)__builtin_amdgcn_s_getreg((3 << 11) | 20) & 0xFu;
            LAS unsigned* bw = (LAS unsigned*)(lds + 147200);
            if (tid == 0) *bw = __hip_atomic_fetch_add(&xr_[xcc * 64], 1u, __ATOMIC_RELAXED, __HIP_MEMORY_SCOPE_AGENT);
            __syncthreads();
            const unsigned rank = *bw & 31u;
            vrole = rank < 16u ? (int)(xcc + 8u * (rank >> 2) + 32u * (rank & 3u)) : (int)(128u + xcc + 8u * ((rank - 16u) >> 2) + 32u * ((rank - 16u) & 3u));
            __syncthreads();
        }
    }
#endif
    if (vrole < 128) {
    const int chain = (vrole & 7) + 8 * ((vrole >> 3) & 3), qt = vrole >> 5, dir = chain >> 4, b = (chain >> 3) & 1, h = chain & 7;
    bf16_t* O = (bf16_t*)a.out + (size_t)dir * ML * 1024;
    constexpr int KL = 0, QL = 16384, TL = 32768, DL = 40960, VL = 49152, AL = 53248, BUFB = 54272, OT = 2 * BUFB, SBX = OT + 8192, XBX = SBX + 16384, FLG = XBX + 4096;
    const int fr0 = lane & 15, g0 = lane >> 4, ltid = tid - 256;
    auto step_cidx = [&](int s) -> int { if (s < 4) return 512 + b * 4 + (dir ? 3 - s : s); const int c = s - 4; return b * 256 + (dir ? 255 - c : c); };
    struct LSet { u32x4 q[4], k[4], t[2], d[2], v, av; };
#define LD_ISSUE(R, s_) do { const int cidx_ = step_cidx(s_); const int row0_ = cidx_ < 512 ? cidx_ * 64 : ML + (cidx_ - 512) * 64; \
        const bf16_t* tqb_ = TQ + ((size_t)(cidx_ * 8 + h) * 2 + dir) * 8192; const float* avb_ = AV + ((size_t)(cidx_ * 8 + h) * 2 + dir) * 256; \
        int lt_ = ltid; asm volatile("" : "+v"(lt_)); \
        const bf16_t* pq_ = QP + (size_t)(row0_ + (lt_ >> 4)) * 3072 + h * 128 + (lt_ & 15) * 8; \
        const bf16_t* pt_ = tqb_ + (lt_ >> 3) * 64 + (lt_ & 7) * 8; \
        _Pragma("unroll") for (int i = 0; i < 4; ++i) { R.q[i] = *(const u32x4*)(pq_ + (size_t)i * 16 * 3072); R.k[i] = *(const u32x4*)(pq_ + (size_t)i * 16 * 3072 + 1024); } \
        _Pragma("unroll") for (int i = 0; i < 2; ++i) { R.t[i] = *(const u32x4*)(pt_ + i * 32 * 64); R.d[i] = *(const u32x4*)(pt_ + 4096 + i * 32 * 64); } \
        R.v = *(const u32x4*)(QP + (size_t)(row0_ + (lt_ >> 2)) * 3072 + 2048 + h * 128 + qt * 32 + (lt_ & 3) * 8); \
        R.av = *(const u32x4*)(avb_ + (lt_ & 63) * 4); } while (0)
#define LD_WRITE(R, bo_) do { int lt_ = ltid; asm volatile("" : "+v"(lt_)); LAS unsigned char* B_ = lds + (bo_); \
        const int chq_ = lt_ & 15, cht_ = lt_ & 7; \
        _Pragma("unroll") for (int i = 0; i < 4; ++i) { const int r = (lt_ >> 4) + 16 * i; const int o_ = r * 256 + ((chq_ ^ (4 * (r & 3) + ((r >> 3) & 3))) << 4); \
            *(LAS u32x4*)(B_ + QL + o_) = R.q[i]; *(LAS u32x4*)(B_ + KL + o_) = R.k[i]; } \
        _Pragma("unroll") for (int i = 0; i < 2; ++i) { const int r = (lt_ >> 3) + 32 * i; const int o_ = r * 128 + ((cht_ ^ (2 * ((r >> 3) & 3) + ((r >> 1) & 1))) << 4); \
            *(LAS u32x4*)(B_ + TL + o_) = R.t[i]; *(LAS u32x4*)(B_ + DL + o_) = R.d[i]; } \
        { const int r = lt_ >> 2; *(LAS u32x4*)(B_ + VL + r * 64 + (((lt_ & 3) ^ (2 * ((r >> 3) & 1))) << 4)) = R.v; } \
        if (lt_ < 64) *(LAS u32x4*)(B_ + AL + lt_ * 16) = R.av; } while (0)
#define OT_OUT(s_) do { const int cidx_ = step_cidx(s_); const int row0_ = cidx_ * 64; LAS const unsigned char* ot_ = lds + OT + ((s_) & 1) * 4096; \
        int lt_ = ltid; asm volatile("" : "+v"(lt_)); \
        { const int r = lt_ >> 2, ch = lt_ & 3; \
            *(u32x4*)(O + (size_t)(row0_ + r) * 1024 + h * 128 + qt * 32 + ch * 8) = *(LAS const u32x4*)(ot_ + r * 64 + ((ch ^ (2 * ((r >> 3) & 1))) << 4)); } } while (0)
#define STEP_BAR(wsel) do { const unsigned long long tb_ = PROBE_SUB ? __builtin_amdgcn_s_memrealtime() : 0ull; \
        asm volatile("s_waitcnt lgkmcnt(0)" ::: "memory"); __builtin_amdgcn_s_barrier(); asm volatile("" ::: "memory"); \
        if ((PROBE_SUB == 1 && wave == 0 && (wsel) == 0) || (PROBE_SUB == 2 && wave == 4 && (wsel) == 1) || (PROBE_SUB == 3 && wave == 2 && (wsel) == 3)) pr_extra += __builtin_amdgcn_s_memrealtime() - tb_; } while (0)
#define LOAD_STEP(s, RW) do { STEP_BAR(1); \
            if (qt == 0 && ltid == 0) __hip_atomic_store(prog + chain * 64, (unsigned)((s) + 1), __ATOMIC_RELAXED, __HIP_MEMORY_SCOPE_AGENT); \
            { const unsigned long long tw_ = (PROBE_SUB == 5) ? __builtin_amdgcn_s_memrealtime() : 0ull; if ((s) + 1 < NSTEP) LD_WRITE(RW, (((s) + 1) & 1) * BUFB); \
              if (PROBE_SUB == 5 && wave == 4) { asm volatile("s_waitcnt lgkmcnt(0)" ::: "memory"); pr_extra += __builtin_amdgcn_s_memrealtime() - tw_; } } \
            if ((s) + 4 < NSTEP) LD_ISSUE(RW, (s) + 4); \
            if ((s) >= 5) OT_OUT((s) - 1); } while (0)
#define SBAR_() __builtin_amdgcn_sched_barrier(0)
#define ROWK(pt) ((32 * ((pt) >> 1) + 4 * ((pt) & 1) + rowl) * 256)
#define ROWT(pt) ((32 * ((pt) >> 1) + 4 * ((pt) & 1) + rowl) * 128)
#define P0(pt) (32 * ((pt) >> 1) + 8 * g + 4 * ((pt) & 1))
#define LDK8(dst, base, pa) do { _Pragma("unroll") for (int s4 = 0; s4 < 4; ++s4) { dst[s4] = ld_b128(B + (base) + ROWK(pa) + (((4 * s4 + g) ^ fk) << 4)); dst[4 + s4] = ld_b128(B + (base) + ROWK((pa) + 1) + (((4 * s4 + g) ^ fk) << 4)); } } while (0)
#define LDT8(dst, base) do { _Pragma("unroll") for (int pt = 0; pt < 4; ++pt) { dst[2 * pt] = ld_b128(B + (base) + ROWT(pt) + ((g ^ ft) << 4)); dst[2 * pt + 1] = ld_b128(B + (base) + ROWT(pt) + (((4 + g) ^ ft) << 4)); } } while (0)
#define MM8(acc, fa, pa) do { _Pragma("unroll") for (int s4 = 0; s4 < 4; ++s4) { acc[pa] = MFMA16(fa[s4], Sb[s4], acc[pa]); acc[(pa) + 1] = MFMA16(fa[4 + s4], Sb[s4], acc[(pa) + 1]); } } while (0)
    if (wave >= 4) {
        LSet R0, R1, R2;
        LD_ISSUE(R0, 0); LD_WRITE(R0, 0); LD_ISSUE(R1, 1); LD_ISSUE(R2, 2); LD_ISSUE(R0, 3);
#pragma unroll 1
        for (int s0 = 0; s0 < NSTEP; s0 += 3) {
            LOAD_STEP(s0, R1);
            if (s0 + 1 < NSTEP) LOAD_STEP(s0 + 1, R2);
            if (s0 + 2 < NSTEP) LOAD_STEP(s0 + 2, R0);
        }
        STEP_BAR(2);
        OT_OUT(NSTEP - 1);
    } else if (wave < 2) {
        f32x4 S[8];
#pragma unroll
        for (int i = 0; i < 8; ++i) S[i] = (f32x4){0.f, 0.f, 0.f, 0.f};
        bf16x8 Sb[4];
#pragma unroll
        for (int s4 = 0; s4 < 4; ++s4) { Sb[s4] = (bf16x8){0, 0, 0, 0, 0, 0, 0, 0}; *(LAS bf16x8*)(lds + SBX + wave * 4096 + s4 * 1024 + lane * 16) = Sb[s4]; }
        if (lane == 0) *(LAS unsigned*)(lds + FLG + wave * 4) = 0u;
#pragma unroll 1
        for (int s = 0; s < NSTEP; ++s) {
            STEP_BAR(0);
            int fr = fr0, g = g0; asm volatile("" : "+v"(fr), "+v"(g));
            LAS const unsigned char* B = lds + (s & 1) * BUFB;
            const LAS float* avl = (const LAS float*)(B + AL);
            const int rowl = 8 * (fr >> 2) + (fr & 3);
            const int fk = 4 * (fr & 3) + (fr >> 2), ft = 2 * (fr >> 2) + ((fr >> 1) & 1);
            const int vcol = ((((2 * wave + (fr >> 3)) ^ (2 * (g & 1))) << 4) + (fr & 7) * 2);
            const int trq = fr >> 2, trp = fr & 3;
            LAS unsigned char* kp0 = (LAS unsigned char*)(B + KL + (8 * g + trq) * 256);
            const int fkt = 4 * trq + g;
#define KT_LOAD(dst, d0) do { _Pragma("unroll") for (int j = 0; j < 4; ++j) { const int dt_ = (d0) + j; const int co = (((4 * (dt_ >> 1) + trp) ^ fkt) << 4) + 8 * (dt_ & 1); \
                const s16x4 a0 = __builtin_bit_cast(s16x4, __builtin_amdgcn_ds_read_tr16_b64_v4i16((LAS s16x4*)(kp0 + co))), a1 = __builtin_bit_cast(s16x4, __builtin_amdgcn_ds_read_tr16_b64_v4i16((LAS s16x4*)(kp0 + co + 4 * 256))); \
                const s16x4 a2 = __builtin_bit_cast(s16x4, __builtin_amdgcn_ds_read_tr16_b64_v4i16((LAS s16x4*)(kp0 + co + 32 * 256))), a3 = __builtin_bit_cast(s16x4, __builtin_amdgcn_ds_read_tr16_b64_v4i16((LAS s16x4*)(kp0 + co + 36 * 256))); \
                dst[2 * j] = (bf16x8){a0[0], a0[1], a0[2], a0[3], a1[0], a1[1], a1[2], a1[3]}; dst[2 * j + 1] = (bf16x8){a2[0], a2[1], a2[2], a2[3], a3[0], a3[1], a3[2], a3[3]}; } } while (0)
            bf16x8 fA[8], fB[8], fC[8];
            f32x4 avp[4], bvp[4]; unsigned short vraw[4][4];
            LDK8(fA, KL, 0); LDK8(fB, KL, 2);
#pragma unroll
            for (int pt = 0; pt < 4; ++pt) { avp[pt] = *(const LAS f32x4*)(avl + P0(pt)); bvp[pt] = *(const LAS f32x4*)(avl + 64 + P0(pt));
#pragma unroll
                for (int r = 0; r < 4; ++r) vraw[pt][r] = *(const LAS unsigned short*)(B + VL + (P0(pt) + r) * 64 + vcol); }
            f32x4 Z[4], X[4];
#pragma unroll
            for (int pt = 0; pt < 4; ++pt) Z[pt] = (f32x4){0.f, 0.f, 0.f, 0.f};
            SBAR_();
            LDT8(fC, TL); SBAR_(); MM8(Z, fA, 0); SBAR_();
            KT_LOAD(fA, 0); SBAR_(); MM8(Z, fB, 2); SBAR_();
#pragma unroll
            for (int pt = 0; pt < 4; ++pt)
#pragma unroll
                for (int r = 0; r < 4; ++r) Z[pt][r] = bvp[pt][r] * (bf2f(vraw[pt][r]) - avp[pt][r] * Z[pt][r]);
            KT_LOAD(fB, 4); SBAR_();
            { const bf16x8 Zb0 = pack_frag(Z[0], Z[1]), Zb1 = pack_frag(Z[2], Z[3]);
#pragma unroll
              for (int pt = 0; pt < 4; ++pt) { X[pt] = MFMA16(fC[2 * pt], Zb0, Z[pt]); X[pt] = MFMA16(fC[2 * pt + 1], Zb1, X[pt]); } }
            SBAR_();
            const float egl = avl[192];
            bf16x8 Xc0, Xc1;
            { const bf16x8 Xb0 = pack_frag(X[0], X[1]), Xb1 = pack_frag(X[2], X[3]);
              *(LAS bf16x8*)(lds + XBX + wave * 2048 + lane * 16) = Xb0; *(LAS bf16x8*)(lds + XBX + wave * 2048 + 1024 + lane * 16) = Xb1;
              if (lane == 0) *(LAS volatile unsigned*)(lds + FLG + wave * 4) = (unsigned)(s + 1);
              f32x4 cx[4];
#pragma unroll
              for (int pt = 0; pt < 4; ++pt) cx[pt] = X[pt] * *(const LAS f32x4*)(avl + 128 + P0(pt));
              Xc0 = pack_frag(cx[0], cx[1]); Xc1 = pack_frag(cx[2], cx[3]); }
            SBAR_();
#pragma unroll
            for (int j = 0; j < 4; ++j) { f32x4 sn = S[j] * egl; sn = MFMA16(fA[2 * j], Xc0, sn); S[j] = MFMA16(fA[2 * j + 1], Xc1, sn); }
            SBAR_();
#pragma unroll
            for (int j = 0; j < 4; ++j) { f32x4 sn = S[4 + j] * egl; sn = MFMA16(fB[2 * j], Xc0, sn); S[4 + j] = MFMA16(fB[2 * j + 1], Xc1, sn); }
#pragma unroll
            for (int s4 = 0; s4 < 4; ++s4) { Sb[s4] = pack_frag(S[2 * s4], S[2 * s4 + 1]); *(LAS bf16x8*)(lds + SBX + ((s + 1) & 1) * 8192 + wave * 4096 + s4 * 1024 + lane * 16) = Sb[s4]; }
#undef KT_LOAD
        }
        STEP_BAR(2);
    } else {
        const int sl = wave - 2;
#pragma unroll 1
        for (int s = 0; s < NSTEP; ++s) {
            STEP_BAR(3);
            if (s >= 4) {
            int fr = fr0, g = g0; asm volatile("" : "+v"(fr), "+v"(g));
            LAS const unsigned char* B = lds + (s & 1) * BUFB;
            const LAS float* avl = (const LAS float*)(B + AL);
            const int rowl = 8 * (fr >> 2) + (fr & 3);
            const int fk = 4 * (fr & 3) + (fr >> 2), ft = 2 * (fr >> 2) + ((fr >> 1) & 1);
            const int vcol = ((((2 * sl + (fr >> 3)) ^ (2 * (g & 1))) << 4) + (fr & 7) * 2);
            bf16x8 fA[8], fB[8], fC[8], Sb[4];
            LDK8(fA, QL, 0); LDK8(fB, QL, 2);
#pragma unroll
            for (int s4 = 0; s4 < 4; ++s4) Sb[s4] = *(const LAS bf16x8*)(lds + SBX + (s & 1) * 8192 + sl * 4096 + s4 * 1024 + lane * 16);
            f32x4 OQ[4], avp[4];
#pragma unroll
            for (int pt = 0; pt < 4; ++pt) { OQ[pt] = (f32x4){0.f, 0.f, 0.f, 0.f}; avp[pt] = *(const LAS f32x4*)(avl + P0(pt)); }
            SBAR_();
            LDT8(fC, DL); SBAR_(); MM8(OQ, fA, 0); SBAR_(); MM8(OQ, fB, 2); SBAR_();
            { unsigned spins = 0;
              while ((unsigned)__builtin_amdgcn_readfirstlane((int)*(LAS volatile unsigned*)(lds + FLG + sl * 4)) != (unsigned)(s + 1)) { __builtin_amdgcn_s_sleep(1); if (++spins > (1u << 22)) break; } }
            asm volatile("" ::: "memory");
            const bf16x8 Xb0 = *(const LAS bf16x8*)(lds + XBX + sl * 2048 + lane * 16), Xb1 = *(const LAS bf16x8*)(lds + XBX + sl * 2048 + 1024 + lane * 16);
#pragma unroll
            for (int pt = 0; pt < 4; ++pt) { f32x4 o2 = OQ[pt] * avp[pt]; o2 = MFMA16(fC[2 * pt], Xb0, o2); OQ[pt] = MFMA16(fC[2 * pt + 1], Xb1, o2); }
            { LAS unsigned char* ot = lds + OT + (s & 1) * 4096;
#pragma unroll
              for (int pt = 0; pt < 4; ++pt)
#pragma unroll
                  for (int r = 0; r < 4; ++r) *(LAS unsigned short*)(ot + (P0(pt) + r) * 64 + vcol) = (unsigned short)f2bf(OQ[pt][r]); }
            }
        }
        STEP_BAR(2);
    }
#undef LDK8
#undef LDT8
#undef MM8
#undef ROWK
#undef ROWT
#undef P0
#undef SBAR_
#undef LOAD_STEP
#undef STEP_BAR
#undef LD_ISSUE
#undef LD_WRITE
#undef OT_OUT
    } else {
        const int vp = vrole - 128, chain = (vp & 7) + 8 * ((vp >> 3) & 3), role = vp >> 5, dir = chain >> 4, b = (chain >> 3) & 1, h = chain & 7;
        const int nteam = (((int)gridDim.x - 128) >> 5) * 8;
        constexpr int PFD2 = 6;
        if (role * 8 + wave < nteam) {
#pragma unroll 1
        for (int st = role * 8 + wave; st < NSTEP; st += nteam) {
            unsigned spins = 0;
            while ((int)__builtin_amdgcn_readfirstlane((int)__hip_atomic_load(prog + chain * 64, __ATOMIC_RELAXED, __HIP_MEMORY_SCOPE_AGENT)) + PFD2 < st) { __builtin_amdgcn_s_sleep(8); if (++spins > (1u << 20)) break; }
            int cidx; if (st < 4) cidx = 512 + b * 4 + (dir ? 3 - st : st); else { const int c = st - 4; cidx = b * 256 + (dir ? 255 - c : c); }
            const int row0 = cidx < 512 ? cidx * 64 : ML + (cidx - 512) * 64;
            const char* tqb = (const char*)(TQ + ((size_t)(cidx * 8 + h) * 2 + dir) * 8192); const char* avb = (const char*)(AV + ((size_t)(cidx * 8 + h) * 2 + dir) * 256);
            unsigned acc = 0;
#pragma unroll
            for (int j = 0; j < 9; ++j) { const int L = j * 64 + lane; const char* p_;
                if (L < 384) { const int rw = L / 6, part = L - rw * 6; p_ = (const char*)(QP + (size_t)(row0 + rw) * 3072 + h * 128) + (part >> 1) * 2048 + (part & 1) * 128; }
                else if (L < 512) p_ = tqb + (L - 384) * 128; else p_ = avb + ((L - 512) & 7) * 128;
                acc ^= *(const unsigned*)p_; }
            asm volatile("" :: "v"(acc));
        }
        }
    }
}

DEVI void phase_prep2(const Args& a, int lane, int wave) {
    unsigned char* ws = a.ws;
    bf16_t* KAT = (bf16_t*)(ws + WS_KAT); const float* rope = (const float*)(ws + SM_ROPE); const float* knw = a.in[14];
    const int gw = blockIdx.x * 8 + wave, NGW = gridDim.x * 8;
    for (int row = gw; row < MT; row += NGW) {
        bf16_t* p = KAT + (size_t)row * 256 + lane * 4;
        const u32x2 w = *(const u32x2*)p;
        float x[4] = {bflo(w.x), bfhi(w.x), bflo(w.y), bfhi(w.y)};
        float ss = (x[0] * x[0] + x[1] * x[1]) + (x[2] * x[2] + x[3] * x[3]);
        ss += __shfl_xor(ss, 1); ss += __shfl_xor(ss, 2); ss += __shfl_xor(ss, 4); ss += __shfl_xor(ss, 8); ss += __shfl_xor(ss, 16);
        const float rs = rsqrtf(ss * (1.f / 128.f) + EPS);
        const int d = (lane & 31) * 4;
        const f32x4 nw = *(const f32x4*)(knw + d);
#pragma unroll
        for (int i = 0; i < 4; ++i) x[i] = x[i] * rs * nw[i];
        float pr[4];
#pragma unroll
        for (int i = 0; i < 4; ++i) pr[i] = __shfl_xor(x[i], 8);
        if (row < ML) {
            const int t = row & (SEQ - 1), lg = (lane & 31) >> 3, fi = (lane & 7) * 4;
            const float* ct = lg < 2 ? rope + (t >> 6) * 32 + fi : rope + 16384 + (t & 63) * 32 + fi;
            const float* st = lg < 2 ? ct + 8192 : ct + 2048;
            const f32x4 c = *(const f32x4*)ct, s = *(const f32x4*)st;
            const float sg = (lg & 1) ? 1.f : -1.f;
#pragma unroll
            for (int i = 0; i < 4; ++i) x[i] = x[i] * c[i] + sg * pr[i] * s[i];
        }
        u32x2 o; o.x = pk2(x[0], x[1]); o.y = pk2(x[2], x[3]);
        *(u32x2*)p = o;
    }
    const bf16_t* Of = (const bf16_t*)a.out; const bf16_t* Ob = Of + (size_t)ML * 1024;
    const bf16_t* GT = (const bf16_t*)(ws + WS_GT); bf16_t* Y = (bf16_t*)(ws + WS_Y); const float* dnw = a.in[12];
    for (int row = gw; row < ML; row += NGW) {
        const int c0 = lane * 16;
        float o[16];
#pragma unroll
        for (int hh = 0; hh < 2; ++hh) {
            const u32x4 f = *(const u32x4*)(Of + (size_t)row * 1024 + c0 + hh * 8), bk = *(const u32x4*)(Ob + (size_t)row * 1024 + c0 + hh * 8);
#pragma unroll
            for (int i = 0; i < 4; ++i) { o[hh * 8 + 2 * i] = bflo(f[i]) + bflo(bk[i]); o[hh * 8 + 2 * i + 1] = bfhi(f[i]) + bfhi(bk[i]); }
        }
        float ss = 0.f;
#pragma unroll
        for (int i = 0; i < 16; ++i) ss += o[i] * o[i];
        ss += __shfl_xor(ss, 1); ss += __shfl_xor(ss, 2); ss += __shfl_xor(ss, 4);
        const float rs = rsqrtf(ss * (1.f / 128.f) + EPS);
        const int d0 = c0 & 127;
#pragma unroll
        for (int hh = 0; hh < 2; ++hh) {
            const u32x4 gt = *(const u32x4*)(GT + (size_t)row * 1024 + c0 + hh * 8);
            float y[8];
#pragma unroll
            for (int i = 0; i < 4; ++i) {
                y[2 * i] = o[hh * 8 + 2 * i] * rs * dnw[d0 + hh * 8 + 2 * i] * siluf(bflo(gt[i]));
                y[2 * i + 1] = o[hh * 8 + 2 * i + 1] * rs * dnw[d0 + hh * 8 + 2 * i + 1] * siluf(bfhi(gt[i]));
            }
            u32x4 w; w.x = pk2(y[0], y[1]); w.y = pk2(y[2], y[3]); w.z = pk2(y[4], y[5]); w.w = pk2(y[6], y[7]);
            *(u32x4*)(Y + (size_t)row * 2048 + c0 + hh * 8) = w;
        }
    }
}

namespace att {
constexpr int D = 128, NW = 8, QBLK = 32, KVBLK = 64;
constexpr float SCALE = 0.088388347648318440f;
constexpr float THR = 8.f;
constexpr int LDK = 256;
constexpr size_t SHM_V = KVBLK * D * 2, SHM_K = KVBLK * D * 2;
constexpr size_t OFF_WS = 2 * SHM_V + 2 * SHM_K, OFF_OST = OFF_WS + NW * 64 * 4;
#define KSWZ(row, colB) ((row) * 256 + ((colB) ^ (((row) & 7) << 4)))
#define SBAR() __builtin_amdgcn_sched_barrier(0)
DEVI int crow(int r, int hi) { return (r & 3) + 8 * (r >> 2) + 4 * hi; }
DEVI unsigned cvtpk(float lo, float hi) { unsigned r; asm volatile("v_cvt_pk_bf16_f32 %0, %1, %2" : "=v"(r) : "v"(lo), "v"(hi)); return r; }
DEVI void partialSM(f32x16& p0, f32x16& p1, float& m_reg, float& mn, float& alpha) {
    constexpr float C = SCALE * 1.4426950408889634f;
    float pmax = p0[0];
#pragma unroll
    for (int r = 1; r < 16; ++r) pmax = fmaxf(pmax, p0[r]);
#pragma unroll
    for (int r = 0; r < 16; ++r) pmax = fmaxf(pmax, p1[r]);
    { auto rr = __builtin_amdgcn_permlane32_swap(__float_as_uint(pmax), __float_as_uint(pmax), false, false);
      pmax = fmaxf(__uint_as_float(rr[0]), __uint_as_float(rr[1])); }
    if (__builtin_expect(__all(pmax - m_reg <= THR / SCALE), 1)) { mn = m_reg; alpha = 1.f; }
    else { mn = fmaxf(m_reg, pmax); alpha = __builtin_amdgcn_exp2f((m_reg - mn) * C); m_reg = mn; }
    const float mnC = -mn * C;
#pragma unroll
    for (int r = 0; r < 16; ++r) p0[r] = fmaf(p0[r], C, mnC);
#pragma unroll
    for (int r = 0; r < 16; ++r) p1[r] = fmaf(p1[r], C, mnC);
#pragma unroll
    for (int r = 0; r < 16; ++r) p0[r] = __builtin_amdgcn_exp2f(p0[r]);
}
DEVI void finishSM(f32x16& p0, f32x16& p1, float alpha, float& l_reg, bf16x8& pa0, bf16x8& pa1, bf16x8& pa2, bf16x8& pa3) {
#pragma unroll
    for (int r = 0; r < 16; ++r) p1[r] = __builtin_amdgcn_exp2f(p1[r]);
    float ps = 0;
#pragma unroll
    for (int r = 0; r < 16; ++r) ps += p0[r];
#pragma unroll
    for (int r = 0; r < 16; ++r) ps += p1[r];
    { auto rr = __builtin_amdgcn_permlane32_swap(__float_as_uint(ps), __float_as_uint(ps), false, false);
      ps = __uint_as_float(rr[0]) + __uint_as_float(rr[1]); }
    l_reg = l_reg * alpha + ps;
#define PK4(P, BASE, OUT) do { unsigned a0 = cvtpk(P[BASE + 0], P[BASE + 1]), a1 = cvtpk(P[BASE + 2], P[BASE + 3]);   \
    unsigned b0 = cvtpk(P[BASE + 4], P[BASE + 5]), b1 = cvtpk(P[BASE + 6], P[BASE + 7]);                              \
    auto r0 = __builtin_amdgcn_permlane32_swap(a0, b0, false, false); auto r1 = __builtin_amdgcn_permlane32_swap(a1, b1, false, false); \
    u32x4 w = {r0[0], r1[0], r0[1], r1[1]}; OUT = *reinterpret_cast<bf16x8*>(&w); } while (0)
    PK4(p0, 0, pa0); PK4(p0, 8, pa1); PK4(p1, 0, pa2); PK4(p1, 8, pa3);
#undef PK4
}
DEVI void qkt(f32x16& p0, f32x16& p1, const char* Ks, const bf16x8* qr, int r32, int hi) {
    p0 = f32x16{}; p1 = f32x16{};
#pragma unroll
    for (int d0 = 0; d0 < 8; ++d0) { const int cb = (d0 * 16 + hi * 8) * 2;
        const bf16x8 b0 = *reinterpret_cast<const bf16x8*>(Ks + KSWZ(r32, cb));
        const bf16x8 b1 = *reinterpret_cast<const bf16x8*>(Ks + KSWZ(32 + r32, cb));
        p0 = __builtin_amdgcn_mfma_f32_32x32x16_bf16(b0, qr[d0], p0, 0, 0, 0);
        p1 = __builtin_amdgcn_mfma_f32_32x32x16_bf16(b1, qr[d0], p1, 0, 0, 0); }
}
DEVI int v_st(int k, int c) { const int kk = (k & ~0xC) | ((k & 4) << 1) | ((k & 8) >> 1); return ((kk >> 3) * 4 + (c >> 5)) * 512 + ((kk & 7) * 32 + (c & 31)) * 2; }
DEVI int v_rd_base(int lane) { return ((lane & 3) << 3) | (((lane >> 2) & 3) << 6) | (((lane >> 4) & 1) << 5) | (((lane >> 5) & 1) << 8); }
constexpr int v_rd_off(int d0, int ks, int half) { return d0 * 512 + ks * 4096 + half * 2048; }
template <int OFF> DEVI s16x4 tr_read(int vb) { s16x4 r; asm volatile("ds_read_b64_tr_b16 %0, %1 offset:%2" : "=&v"(r) : "v"(vb), "i"(OFF) : "memory"); return r; }
template <int D0> DEVI void pv_one(f32x16& od, int vb, bf16x8 pa0, bf16x8 pa1, bf16x8 pa2, bf16x8 pa3) {
    const s16x4 l0 = tr_read<v_rd_off(D0, 0, 0)>(vb), h0 = tr_read<v_rd_off(D0, 0, 1)>(vb), l1 = tr_read<v_rd_off(D0, 1, 0)>(vb), h1 = tr_read<v_rd_off(D0, 1, 1)>(vb);
    const s16x4 l2 = tr_read<v_rd_off(D0, 2, 0)>(vb), h2 = tr_read<v_rd_off(D0, 2, 1)>(vb), l3 = tr_read<v_rd_off(D0, 3, 0)>(vb), h3 = tr_read<v_rd_off(D0, 3, 1)>(vb);
    asm volatile("s_waitcnt lgkmcnt(0)" ::: "memory"); SBAR();
#define PK(L, H) (bf16x8){L[0], L[1], L[2], L[3], H[0], H[1], H[2], H[3]}
    od = __builtin_amdgcn_mfma_f32_32x32x16_bf16(pa0, PK(l0, h0), od, 0, 0, 0);
    od = __builtin_amdgcn_mfma_f32_32x32x16_bf16(pa1, PK(l1, h1), od, 0, 0, 0);
    od = __builtin_amdgcn_mfma_f32_32x32x16_bf16(pa2, PK(l2, h2), od, 0, 0, 0);
    od = __builtin_amdgcn_mfma_f32_32x32x16_bf16(pa3, PK(l3, h3), od, 0, 0, 0);
#undef PK
}
DEVI void pv_d0(f32x16* o, int vb, bf16x8 pa0, bf16x8 pa1, bf16x8 pa2, bf16x8 pa3) {
    pv_one<0>(o[0], vb, pa0, pa1, pa2, pa3); pv_one<1>(o[1], vb, pa0, pa1, pa2, pa3); pv_one<2>(o[2], vb, pa0, pa1, pa2, pa3); pv_one<3>(o[3], vb, pa0, pa1, pa2, pa3);
}
DEVI void wmask(f32x16& p0, f32x16& p1, int qp, int kt0, int hi) {
#pragma unroll
    for (int r = 0; r < 16; ++r) { const int kp = kt0 + crow(r, hi); const int d0 = qp - kp, d1 = d0 - 32;
        if (d0 > 128 || d0 < -128) p0[r] = -1e30f; if (d1 > 128 || d1 < -128) p1[r] = -1e30f; }
}
DEVI void attn_unit(const Args& a, int b, int h, int qb, char* lds) {
    unsigned char* ws = a.ws;
    const bf16_t* QAT = (const bf16_t*)(ws + WS_QAT); const bf16_t* KAT = (const bf16_t*)(ws + WS_KAT); const bf16_t* VAT = (const bf16_t*)(ws + WS_VAT);
    bf16_t* Y = (bf16_t*)(ws + WS_Y); const float* rope = (const float*)(ws + SM_ROPE);
    const int tid = threadIdx.x, wid = tid >> 6, lane = tid & 63, r32 = lane & 31, hi = lane >> 5;
    const int kvh = h >> 2, t0 = qb * 256;
    char* V_lds = lds; char* K_lds = lds + 2 * SHM_V;
    float* wsf = (float*)(lds + OFF_WS) + wid * 64; float* li_l = wsf; float* al_l = wsf + 32;
    float m_reg = -1e30f, l_reg = 0; f32x16 o[4] = {}; bf16x8 qr[8];
    const int qp = t0 + wid * QBLK + r32;
    {
        const bf16_t* Qw = QAT + (size_t)(b * SEQ + qp) * 1024 + h * 128 + hi * 8;
        u32x4 raw[8]; float ss = 0.f;
#pragma unroll
        for (int d0 = 0; d0 < 8; ++d0) { raw[d0] = *(const u32x4*)(Qw + d0 * 16);
#pragma unroll
            for (int i = 0; i < 4; ++i) { const float lo_ = bflo(raw[d0][i]), hi_ = bfhi(raw[d0][i]); ss += lo_ * lo_ + hi_ * hi_; } }
        { auto rr = __builtin_amdgcn_permlane32_swap(__float_as_uint(ss), __float_as_uint(ss), false, false); ss = __uint_as_float(rr[0]) + __uint_as_float(rr[1]); }
        const float rs = rsqrtf(ss * (1.f / 128.f) + EPS);
        const float* qnw = a.in[13];
#pragma unroll
        for (int half = 0; half < 2; ++half) {
            const float* ct = half == 0 ? rope + (qp >> 6) * 32 : rope + 16384 + (qp & 63) * 32;
            const float* st = half == 0 ? ct + 8192 : ct + 2048;
#pragma unroll
            for (int dd = 0; dd < 2; ++dd) {
                const int fi = dd * 16 + hi * 8, da = half * 4 + dd, db = da + 2;
                u32x4 oa, ob;
#pragma unroll
                for (int q4 = 0; q4 < 2; ++q4) {
                    const f32x4 c = *(const f32x4*)(ct + fi + 4 * q4), s = *(const f32x4*)(st + fi + 4 * q4);
                    const f32x4 wa = *(const f32x4*)(qnw + da * 16 + hi * 8 + 4 * q4), wb = *(const f32x4*)(qnw + db * 16 + hi * 8 + 4 * q4);
                    float ya[4], yb[4];
#pragma unroll
                    for (int j = 0; j < 4; ++j) {
                        const unsigned ra = raw[da][2 * q4 + (j >> 1)], rb = raw[db][2 * q4 + (j >> 1)];
                        const float x1 = ((j & 1) ? bfhi(ra) : bflo(ra)) * rs * wa[j], x2 = ((j & 1) ? bfhi(rb) : bflo(rb)) * rs * wb[j];
                        ya[j] = x1 * c[j] - x2 * s[j]; yb[j] = x2 * c[j] + x1 * s[j];
                    }
                    oa[2 * q4] = cvtpk(ya[0], ya[1]); oa[2 * q4 + 1] = cvtpk(ya[2], ya[3]); ob[2 * q4] = cvtpk(yb[0], yb[1]); ob[2 * q4 + 1] = cvtpk(yb[2], yb[3]);
                }
                qr[da] = *reinterpret_cast<bf16x8*>(&oa); qr[db] = *reinterpret_cast<bf16x8*>(&ob);
            }
        }
    }
    const int tk0 = t0 - 128 < 0 ? 0 : t0 - 128, tk1 = t0 + 384 > SEQ ? SEQ : t0 + 384;
    const int NT = 4 + (tk1 - tk0) / 64;
    const int ctxrow = ML + b * CTX, latrow = b * SEQ + tk0 - 256;
#define TROW(j) ((j) < 4 ? ctxrow + 64 * (j) : latrow + 64 * (j))
    const bf16_t* Kh = KAT + kvh * 128; const bf16_t* Vh = VAT + kvh * 128;
    const int sr = tid >> 4, sc = (tid & 15) * 8, vst0 = v_st(sr, sc), vst1 = v_st(32 + sr, sc);
    const int vb0 = (int)(uintptr_t)V_lds + v_rd_base(lane);
    struct { bf16x8 vs0, vs1, ks0, ks1; } sr_[1];
#define SLOAD(i, j) do { const int k0_ = TROW(j); sr_[i].vs0 = *(const bf16x8*)(Vh + (size_t)(k0_ + sr) * LDK + sc); sr_[i].vs1 = *(const bf16x8*)(Vh + (size_t)(k0_ + 32 + sr) * LDK + sc); \
    sr_[i].ks0 = *(const bf16x8*)(Kh + (size_t)(k0_ + sr) * LDK + sc); sr_[i].ks1 = *(const bf16x8*)(Kh + (size_t)(k0_ + 32 + sr) * LDK + sc); } while (0)
#define SWRITE(bf, i) do { *(bf16x8*)(V_lds + (bf) * SHM_V + vst0) = sr_[i].vs0; *(bf16x8*)(V_lds + (bf) * SHM_V + vst1) = sr_[i].vs1; const int kc = sc * 2; \
    *(bf16x8*)(K_lds + (bf) * SHM_K + KSWZ(sr, kc)) = sr_[i].ks0; *(bf16x8*)(K_lds + (bf) * SHM_K + KSWZ(32 + sr, kc)) = sr_[i].ks1; } while (0)
#define SWAIT() asm volatile("s_waitcnt vmcnt(0)" ::: "memory")
#define RESC(al) do { if (__any((al) < 1.f)) { if (hi == 0) al_l[r32] = (al); asm volatile("s_waitcnt lgkmcnt(0)" ::: "memory"); \
    _Pragma("unroll") for (int d = 0; d < 4; ++d) _Pragma("unroll") for (int r = 0; r < 16; ++r) o[d][r] *= al_l[crow(r, hi)]; } } while (0)
#define WMASK(P0, P1, j) do { if ((j) >= 4) wmask(P0, P1, qp, tk0 + 64 * ((j) - 4), hi); } while (0)
    f32x16 pA0, pA1, pB0, pB1; float mnA, mnB, alA, alB; bf16x8 pa0, pa1, pa2, pa3;
    constexpr int SE = 0, SO = 0;
    SLOAD(SE, 0); asm volatile("s_waitcnt vmcnt(0)" ::: "memory"); SWRITE(0, SE); __syncthreads();
    qkt(pA0, pA1, K_lds, qr, r32, hi); partialSM(pA0, pA1, m_reg, mnA, alA);
    SLOAD(SO, 1);
    SWAIT(); SWRITE(1, SO); __syncthreads();
    for (int j = 1; j + 1 < NT; j += 2) {
        SBAR(); qkt(pB0, pB1, K_lds + SHM_K, qr, r32, hi); WMASK(pB0, pB1, j);
        finishSM(pA0, pA1, alA, l_reg, pa0, pa1, pa2, pa3); SBAR();
        SLOAD(SO, j + 1); SBAR();
        pv_d0(o, vb0, pa0, pa1, pa2, pa3); partialSM(pB0, pB1, m_reg, mnB, alB);
        __syncthreads(); SWAIT(); SWRITE(0, SE);
        RESC(alB); __syncthreads();
        SBAR(); qkt(pA0, pA1, K_lds, qr, r32, hi); WMASK(pA0, pA1, j + 1);
        finishSM(pB0, pB1, alB, l_reg, pa0, pa1, pa2, pa3); SBAR();
        SLOAD(SE, j + 2); SBAR();
        pv_d0(o, vb0 + (int)SHM_V, pa0, pa1, pa2, pa3); partialSM(pA0, pA1, m_reg, mnA, alA);
        __syncthreads(); SWAIT(); SWRITE(1, SO);
        RESC(alA); __syncthreads();
    }
    SBAR(); qkt(pB0, pB1, K_lds + SHM_K, qr, r32, hi); WMASK(pB0, pB1, NT - 1);
    finishSM(pA0, pA1, alA, l_reg, pa0, pa1, pa2, pa3); SBAR();
    pv_d0(o, vb0, pa0, pa1, pa2, pa3); partialSM(pB0, pB1, m_reg, mnB, alB);
    __syncthreads(); RESC(alB);
    finishSM(pB0, pB1, alB, l_reg, pa0, pa1, pa2, pa3); SBAR();
    pv_d0(o, vb0 + (int)SHM_V, pa0, pa1, pa2, pa3);
    l_reg += __builtin_amdgcn_exp2f(a.in[15][h] * 1.4426950408889634f - m_reg * (SCALE * 1.4426950408889634f));
    if (hi == 0) li_l[r32] = l_reg; asm volatile("s_waitcnt lgkmcnt(0)" ::: "memory");
    float rli[16];
#pragma unroll
    for (int r = 0; r < 16; ++r) rli[r] = __builtin_amdgcn_rcpf(li_l[crow(r, hi)]);
    {
        bf16_t* stg = (bf16_t*)(lds + OFF_OST) + wid * 4096;
#pragma unroll
        for (int r = 0; r < 16; ++r) { const int orow = crow(r, hi);
#pragma unroll
            for (int d0 = 0; d0 < 4; ++d0) stg[orow * 128 + d0 * 32 + r32] = (bf16_t)f2bf(o[d0][r] * rli[r]); }
        asm volatile("s_waitcnt lgkmcnt(0)" ::: "memory");
        bf16_t* Ow = Y + (size_t)(b * SEQ + t0 + wid * QBLK) * 2048 + 1024 + h * 128;
#pragma unroll
        for (int i = 0; i < 8; ++i) { const int row = i * 4 + (lane >> 4), ch = lane & 15; const u32x4 v = *(const u32x4*)(stg + row * 128 + ch * 8); *(u32x4*)(Ow + (size_t)row * 2048 + ch * 8) = v; }
    }
    __syncthreads();
#undef TROW
#undef SLOAD
#undef SWRITE
#undef SWAIT
#undef RESC
#undef WMASK
}
#undef KSWZ
#undef SBAR
}

DEVI u32x4 ldu_(const bf16_t* base, int rr) {
    const int rc = rr < 0 ? 0 : (rr >= SEQ ? SEQ - 1 : rr);
    const u32x4 v = *(const u32x4*)(base + (size_t)rc * NUP);
    const unsigned m = (rr == rc) ? 0xffffffffu : 0u;
    return (u32x4){v[0] & m, v[1] & m, v[2] & m, v[3] & m};
}
DEVI void phase_ffnconv(const Args& a, int b, int tid) {
    unsigned char* ws = a.ws;
    const bf16_t* U = (const bf16_t*)(ws + WS_U); bf16_t* ACT = (bf16_t*)(ws + WS_ACT) + (size_t)b * SEQ * DFF;
    const float* cw = a.in[20]; const float* cb = a.in[21];
    if (tid < DFF / 8) {
        const int f0 = tid * 8, pn = f0 >> 7, j = f0 & 127, gc = 256 * pn + j, vc = gc + 128;
        float wg[3][8], wv[3][8], bg[8], bvv[8];
#pragma unroll
        for (int jt = 0; jt < 3; ++jt)
#pragma unroll
            for (int q = 0; q < 8; ++q) { wg[jt][q] = cw[jt * NUP + f0 + q]; wv[jt][q] = cw[jt * NUP + DFF + f0 + q]; }
#pragma unroll
        for (int q = 0; q < 8; ++q) { bg[q] = cb[f0 + q]; bvv[q] = cb[DFF + f0 + q]; }
        for (int it = blockIdx.x; it < SEQ / 32; it += gridDim.x) {
            const int r0 = it * 32;
            u32x4 gw_[3], vw_[3];
#define LDU(rr, c) ldu_(U + (c), (rr))
            gw_[0] = LDU(r0 - 1, gc); vw_[0] = LDU(r0 - 1, vc); gw_[1] = LDU(r0, gc); vw_[1] = LDU(r0, vc);
#pragma unroll 8
            for (int r = 0; r < 32; ++r) {
                gw_[2] = LDU(r0 + r + 1, gc); vw_[2] = LDU(r0 + r + 1, vc);
                float ug[8], uv[8];
#pragma unroll
                for (int q = 0; q < 8; ++q) { ug[q] = bg[q]; uv[q] = bvv[q]; }
#pragma unroll
                for (int jt = 0; jt < 3; ++jt)
#pragma unroll
                    for (int q = 0; q < 4; ++q) {
                        ug[2 * q] += bflo(gw_[jt][q]) * wg[jt][2 * q]; ug[2 * q + 1] += bfhi(gw_[jt][q]) * wg[jt][2 * q + 1];
                        uv[2 * q] += bflo(vw_[jt][q]) * wv[jt][2 * q]; uv[2 * q + 1] += bfhi(vw_[jt][q]) * wv[jt][2 * q + 1]; }
                u32x4 o;
                o.x = pk2(siluf(ug[0]) * uv[0], siluf(ug[1]) * uv[1]); o.y = pk2(siluf(ug[2]) * uv[2], siluf(ug[3]) * uv[3]);
                o.z = pk2(siluf(ug[4]) * uv[4], siluf(ug[5]) * uv[5]); o.w = pk2(siluf(ug[6]) * uv[6], siluf(ug[7]) * uv[7]);
                *(u32x4*)(ACT + (size_t)(r0 + r) * DFF + f0) = o;
                gw_[0] = gw_[1]; gw_[1] = gw_[2]; vw_[0] = vw_[1]; vw_[1] = vw_[2];
            }
#undef LDU
        }
    }
}

#define XB_TMO      128
#define XB_XCNT(j)  (256  + 64 * (j))
#define XB_XSUB(j)  (1280 + 64 * (j))
#define XB_XGEN(j)  (2304 + 64 * (j))
#define XB_TOP      3328
#define XB_TOPGEN   3392
#define XCD_BAR_WORDS 3456
#define XB_SPIN_CAP (1u << 18)
__device__ __forceinline__ unsigned xb_ld(unsigned* p)              { return __hip_atomic_load(p, __ATOMIC_RELAXED, __HIP_MEMORY_SCOPE_AGENT); }
__device__ __forceinline__ unsigned xb_add(unsigned* p, unsigned v) { return __hip_atomic_fetch_add(p, v, __ATOMIC_RELAXED, __HIP_MEMORY_SCOPE_AGENT); }
__device__ __forceinline__ unsigned xb_xcc_id() { return (unsigned)__builtin_amdgcn_s_getreg((3 << 11) | 20) & 0xFu; }
#define XB_SPIN(cond, bar) do { unsigned _sp = 0; while (cond) { __builtin_amdgcn_s_sleep(1); \
    if ((++_sp & 255u) == 0u) { if (xb_ld(&(bar)[XB_TMO])) break; if (_sp > XB_SPIN_CAP) { atomicAdd(&(bar)[XB_TMO], 1u); break; } } } } while (0)
struct XcdBarrier { unsigned* bar; unsigned x; volatile LAS unsigned* st; };
__device__ __forceinline__ XcdBarrier xcd_barrier_post(unsigned* bar, volatile LAS unsigned* st) {
    XcdBarrier b; b.bar = bar; b.x = xb_xcc_id(); b.st = st;
    if (threadIdx.x == 0) (void)xb_add(&bar[XB_XCNT(b.x)], 1u);
    return b;
}
__device__ __forceinline__ void xcd_barrier_complete(unsigned* bar, unsigned x, unsigned& nloc, unsigned& nx) {
    const unsigned G = gridDim.x * gridDim.y * gridDim.z;
    unsigned sum, cnt, mine, sp = 0u;
    for (;;) {
        sum = 0u; cnt = 0u; mine = 0u;
#pragma unroll
        for (unsigned j = 0; j < 16; ++j) { const unsigned c = xb_ld(&bar[XB_XCNT(j)]); sum += c; cnt += (c > 0u) ? 1u : 0u; mine = (j == x) ? c : mine; }
        if (sum == G) break;
        __builtin_amdgcn_s_sleep(1);
        if ((++sp & 255u) == 0u) { if (xb_ld(&bar[XB_TMO])) break; if (sp > XB_SPIN_CAP) { atomicAdd(&bar[XB_TMO], 1u); break; } }
    }
    nloc = mine > 0u ? mine : 1u; nx = cnt > 0u ? cnt : 1u;
}
__device__ __forceinline__ void xcd_barrier(const XcdBarrier& b) {
    asm volatile("s_waitcnt vmcnt(0)" ::: "memory");
    __syncthreads();
    if (threadIdx.x == 0) {
        unsigned* bar = b.bar;
        __builtin_amdgcn_s_waitcnt(0);
        unsigned nloc = b.st[0], nx = b.st[1];
        if (nloc == 0u) { xcd_barrier_complete(bar, b.x, nloc, nx); b.st[0] = nloc; b.st[1] = nx; }
        const unsigned old = xb_add(&bar[XB_XSUB(b.x)], 1u);
        const unsigned gen = old / nloc;
        if (old + 1u == (gen + 1u) * nloc) {
            __builtin_amdgcn_fence(__ATOMIC_RELEASE, "agent");
            asm volatile("s_waitcnt vmcnt(0)" ::: "memory");
            const unsigned og = xb_add(&bar[XB_TOP], 1u);
            const unsigned tg = og / nx;
            if (og + 1u == (tg + 1u) * nx) xb_add(&bar[XB_TOPGEN], 1u);
            else XB_SPIN(xb_ld(&bar[XB_TOPGEN]) == tg, bar);
            __builtin_amdgcn_fence(__ATOMIC_ACQUIRE, "agent");
            xb_add(&bar[XB_XGEN(b.x)], 1u);
            asm volatile("s_waitcnt vmcnt(0)" ::: "memory");
        } else {
            XB_SPIN(xb_ld(&bar[XB_XGEN(b.x)]) == gen, bar);
            __builtin_amdgcn_fence(__ATOMIC_ACQUIRE, "agent");
            asm volatile("s_waitcnt vmcnt(0)" ::: "memory");
        }
    }
    __syncthreads();
}

constexpr int NPHASE = 13;
__global__ void __launch_bounds__(512, 2) mega(Args a) {
    extern __shared__ __attribute__((aligned(16))) unsigned char lds_raw[];
    LAS unsigned char* lds = (LAS unsigned char*)lds_raw;
    const int tid = threadIdx.x, lane = tid & 63, wave = __builtin_amdgcn_readfirstlane(tid >> 6);
    unsigned char* ws = a.ws;
    const int lo = a.ph_lo, hi = a.ph_hi;
#define IN(k) (lo <= (k) && (k) < hi)
#if MK_ONE_LAUNCH
    volatile LAS unsigned* bst = (volatile LAS unsigned*)(lds + 147440);
    if (tid < 4) bst[tid] = 0u;
    __syncthreads();
    const XcdBarrier gbar = xcd_barrier_post((unsigned*)(ws + WS_CTL), bst);
#define SEAM(k) do { if (IN(k) && IN((k) + 1)) xcd_barrier(gbar); } while (0)
#else
#define SEAM(k) do { } while (0)
#endif
    const float* modacc = (const float*)(ws + CTL_MODACC);
    unsigned long long pr_prev = PROBE_MASK ? __builtin_amdgcn_s_memrealtime() : 0ull, pr_acc = 0ull;
#define STAMP(k) do { if (PROBE_MASK) { const unsigned long long now_ = __builtin_amdgcn_s_memrealtime(); if ((PROBE_MASK >> (k)) & 1u) pr_acc += now_ - pr_prev; pr_prev = now_; } } while (0)
    if (IN(0)) { phase0(a, lds, tid, lane, wave); } SEAM(0); STAMP(0);
    if (IN(1)) { phase1(a, tid, lane, wave); } SEAM(1); STAMP(1);
    if (IN(2)) {
        pg8::Gemm g{(const bf16_t*)(ws + WS_XN), (const bf16_t*)(ws + WS_WINA), MT, NA, 1024}; pg8::StaticOrder S; S.init(MT, NA, gridDim.x, blockIdx.x);
        EpiIn E{(const float*)(ws + SM_ROWSS1), (const float*)(ws + SM_SHWA), 0, (bf16_t*)(ws + WS_QKVR), nullptr, nullptr, nullptr, nullptr, (float*)(ws + WS_BA)};
        pg8::gemm_phase<EpiIn, pg8::StaticOrder, true, true>(lds, g, S, E);
    } SEAM(2); STAMP(2);
    if (IN(3)) { phase_dnprep(a, tid); } SEAM(3); STAMP(3);
    if (IN(4)) { phase_dnchunk(a, lds, tid, lane, wave); } SEAM(4); STAMP(4);
    if (IN(5)) { const unsigned long long t5_ = (PROBE_SUB == 4) ? __builtin_amdgcn_s_memrealtime() : 0ull; phase_dnscan2(a, lds, tid, lane, wave, pr_acc); if (PROBE_SUB == 4) pr_acc += __builtin_amdgcn_s_memrealtime() - t5_; } SEAM(5); STAMP(5);
    if (IN(6)) {
        pg8::Gemm g{(const bf16_t*)(ws + WS_XN), (const bf16_t*)(ws + WS_WINC), MT, NC, 1024}; pg8::StaticOrder S; S.init(MT, NC, gridDim.x, blockIdx.x);
        EpiIn E{(const float*)(ws + SM_ROWSS1), (const float*)(ws + SM_SHWA) + NA, 1, (bf16_t*)(ws + WS_GT), (bf16_t*)(ws + WS_QAT), (bf16_t*)(ws + WS_KAT), (bf16_t*)(ws + WS_VAT), (bf16_t*)(ws + WS_MG), nullptr};
        pg8::gemm_phase<EpiIn, pg8::StaticOrder, true, true>(lds, g, S, E);
    } SEAM(6); STAMP(6);
    if (IN(7)) { phase_prep2(a, lane, wave); } SEAM(7); STAMP(7);
    if (IN(8)) {
#pragma unroll 1
        for (int k = 0; k < 1024; ++k) {
            const int idx = 4 * ((int)blockIdx.x + (int)gridDim.x * (k >> 2)) + (k & 3); if (idx >= 1024) break;
            const int g = idx & 3, qb = (idx >> 2) & 63, kvh = (idx >> 8) & 1, b = idx >> 9;
            att::attn_unit(a, b, kvh * 4 + g, qb, (char*)lds_raw); }
    } SEAM(8); STAMP(8);
    if (IN(9)) {
        pg8::Gemm g{(const bf16_t*)(ws + WS_Y), (const bf16_t*)(ws + WS_WBR), ML, 1024, 2048}; pg8::StaticOrder S; S.init(ML, 1024, gridDim.x, blockIdx.x);
        EpiBr E{(const bf16_t*)(ws + WS_MG), (bf16_t*)(ws + WS_MERGED)};
        pg8::gemm_phase<EpiBr, pg8::StaticOrder, true, true>(lds, g, S, E);
    } SEAM(9); STAMP(9);
    if (IN(10)) {
        pg8::Gemm g{(const bf16_t*)(ws + WS_MERGED), (const bf16_t*)(ws + WS_WOUT), ML, 1024, 1024}; pg8::StaticOrder S; S.init(ML, 1024, gridDim.x, blockIdx.x);
        EpiOut E{a.in[0], modacc, a.in[5], a.in[7], a.out, (bf16_t*)(ws + WS_X1S), (float*)(ws + CTL_ROWSS2)};
        pg8::gemm_phase<EpiOut, pg8::StaticOrder, true, true>(lds, g, S, E);
    } SEAM(10); STAMP(10);
    if (IN(11)) {
        pg8::Gemm g{(const bf16_t*)(ws + WS_X1S), (const bf16_t*)(ws + WS_WUP), 2 * TPB * 256, NUP, 1024}; pg8::StaticOrder S; S.init(2 * TPB * 256, NUP, gridDim.x, blockIdx.x);
        EpiUpConv E{(const float*)(ws + CTL_ROWSS2), (const float*)(ws + SM_SHWF), a.in[20], a.in[21], (bf16_t*)(ws + WS_ACT), (LAS float*)(lds + 131072)};
        pg8::gemm_phase<EpiUpConv, pg8::StaticOrder, true, true>(lds, g, S, E);
    } SEAM(11); STAMP(11);
    if (IN(12)) {
        pg8::Gemm g{(const bf16_t*)(ws + WS_ACT), (const bf16_t*)(ws + WS_WDN), ML, 1024, DFF}; pg8::StaticOrder S; S.init(ML, 1024, gridDim.x, blockIdx.x);
        EpiDown E{modacc, a.in[5], a.out};
        pg8::gemm_phase<EpiDown, pg8::StaticOrder, true, true>(lds, g, S, E);
    }
    STAMP(12);
    if ((PROBE_MASK || PROBE_SUB) && blockIdx.x == 0) { const unsigned long long t0_ = __builtin_amdgcn_s_memrealtime(); while (__builtin_amdgcn_s_memrealtime() - t0_ < pr_acc) __builtin_amdgcn_s_sleep(8); }
#undef STAMP
#undef IN
#undef SEAM
}

extern "C" void kernel_launch(void* const* d_in, const int* in_sizes, int n_in, void* d_out, int out_size, void* d_ws, size_t ws_size, hipStream_t stream) {
    static int grid = 0;
    if (grid == 0) {
        if (n_in != 23 || in_sizes[0] != ML * DM || out_size != ML * DM || ws_size < WS_END) {
            fprintf(stderr, "kernel_launch: unexpected shapes n_in %d in0 %d out %d ws %zu (need %zu)\n", n_in, n_in > 0 ? in_sizes[0] : -1, out_size, ws_size, (size_t)WS_END); grid = -1; return; }
        int dev = 0, cus = 0, per_cu = 0;
        hipGetDevice(&dev); hipDeviceGetAttribute(&cus, hipDeviceAttributeMultiprocessorCount, dev);
        if (hipFuncSetAttribute((const void*)mega, hipFuncAttributeMaxDynamicSharedMemorySize, LDS_BYTES) != hipSuccess) { fprintf(stderr, "kernel_launch: hipFuncSetAttribute failed\n"); grid = -1; return; }
        hipOccupancyMaxActiveBlocksPerMultiprocessor(&per_cu, (const void*)mega, 512, LDS_BYTES);
        (void)hipGetLastError();
        if (per_cu < 1) { fprintf(stderr, "kernel_launch: occupancy query says %d blocks per CU\n", per_cu); per_cu = 1; }
        grid = cus;
    }
    if (grid < 0) return;
    hipMemsetAsync((char*)d_ws + WS_CTL, 0, CTL_ZERO_BYTES, stream);
    Args a{};
    for (int i = 0; i < 23; ++i) a.in[i] = (const float*)d_in[i];
    a.out = (float*)d_out; a.ws = (unsigned char*)d_ws;
#if MK_ONE_LAUNCH
    a.ph_lo = 0; a.ph_hi = NPHASE;
    void* args[] = {&a};
    hipError_t e = hipLaunchCooperativeKernel((const void*)mega, dim3(grid), dim3(512), args, LDS_BYTES, stream);
    if (e != hipSuccess) fprintf(stderr, "cooperative launch failed: %s (grid %d)\n", hipGetErrorString(e), grid);
#else
    for (int p = 0; p < NPHASE; ++p) {
        a.ph_lo = p; a.ph_hi = p + 1;
        hipLaunchKernelGGL(mega, dim3(grid), dim3(512), LDS_BYTES, stream, a);
    }
    hipError_t e = hipPeekAtLastError();
    if (e != hipSuccess) fprintf(stderr, "launch failed: %s\n", hipGetErrorString(e));
#endif
}
```

```cpp
#include <hip/hip_runtime.h>
#include <hip/hip_cooperative_groups.h>
#include <cstdio>
#include <cstdint>
namespace cg = cooperative_groups;

#ifndef PROBE_MASK
#define PROBE_MASK 0u
#endif
#ifndef PROBE_SUB
#define PROBE_SUB 0
#endif
#ifndef MK_ONE_LAUNCH
#define MK_ONE_LAUNCH 1
#endif

#define DEVI __device__ __forceinline__
#define LAS __attribute__((address_space(3)))
typedef unsigned short bf16_t;
typedef short bf16x8 __attribute__((ext_vector_type(8)));
typedef float f32x4 __attribute__((ext_vector_type(4)));
typedef float f32x2 __attribute__((ext_vector_type(2)));
typedef float f32x16 __attribute__((ext_vector_type(16)));
typedef unsigned u32x4 __attribute__((ext_vector_type(4)));
typedef unsigned u32x2 __attribute__((ext_vector_type(2)));
typedef short s16x4 __attribute__((ext_vector_type(4)));

constexpr int BATCH = 2, SEQ = 16384, DM = 1024, CTX = 256;
constexpr int ML = BATCH * SEQ;
constexpr int MC = BATCH * CTX;
constexpr int MT = ML + MC;
constexpr int NA = 3328;
constexpr int NC = 4608;
constexpr int NSH = NA + NC;
constexpr int DFF = 2816, NUP = 5632;
constexpr int RB = SEQ + 256;
constexpr int TPB = 65;
constexpr float EPS = 1e-6f;

constexpr size_t MiB = 1u << 20;
constexpr size_t WS_CTL = 0, CTL_ZERO_BYTES = 1 * MiB;
constexpr size_t CTL_XRANK = 24 * 1024;
constexpr size_t CTL_PROG = 32 * 1024;
constexpr size_t CTL_MODACC = 64 * 1024;
constexpr size_t CTL_ROWSS2 = 256 * 1024;
constexpr size_t WS_SMALL = 1 * MiB;
constexpr size_t SM_ROWSS1 = WS_SMALL;
constexpr size_t SM_SHWA = WS_SMALL + 256 * 1024;
constexpr size_t SM_SHWF = WS_SMALL + 384 * 1024;
constexpr size_t SM_ROPE = WS_SMALL + 512 * 1024;
constexpr size_t WS_BA = 2 * MiB;
constexpr size_t WS_G = 7 * MiB;
constexpr size_t WS_BETA = 10 * MiB;
constexpr size_t WS_WINA = 13 * MiB, WS_WINC = 20 * MiB, WS_WBR = 29 * MiB, WS_WOUT = 33 * MiB, WS_WUP = 35 * MiB, WS_WDN = 46 * MiB;
constexpr size_t WS_XN = 52 * MiB;
constexpr size_t WS_QKVR = 117 * MiB;
constexpr size_t WS_QKVP = 312 * MiB;
constexpr size_t WS_MG = 180 * MiB;
constexpr size_t WS_GT = 310 * MiB;
constexpr size_t WS_QAT = 375 * MiB;
constexpr size_t WS_KAT = 440 * MiB;
constexpr size_t WS_VAT = 457 * MiB;
constexpr size_t WS_Y = 52 * MiB;
constexpr size_t WS_MERGED = 375 * MiB;
constexpr size_t WS_X1S = 440 * MiB;
constexpr size_t WS_U = 52 * MiB;
constexpr size_t WS_ACT = 228 * MiB;
constexpr size_t WS_TQ = 117 * MiB;
constexpr size_t WS_AVEC = 248 * MiB;
constexpr size_t WS_END = 512 * MiB;

constexpr int LDS_BYTES = 147456;

DEVI float bf2f(unsigned short h) { return __uint_as_float((unsigned)h << 16); }
DEVI float bflo(unsigned w) { return __uint_as_float(w << 16); }
DEVI float bfhi(unsigned w) { return __uint_as_float(w & 0xffff0000u); }
typedef __bf16 bf16x2_t __attribute__((ext_vector_type(2)));
DEVI unsigned pk2(float lo, float hi) { const f32x2 v = {lo, hi}; const bf16x2_t b = __builtin_convertvector(v, bf16x2_t); return __builtin_bit_cast(unsigned, b); }
DEVI unsigned f2bf(float f) { return pk2(f, 0.f) & 0xffffu; }
DEVI float wave_sum(float v) {
#pragma unroll
    for (int o = 1; o < 64; o <<= 1) v += __shfl_xor(v, o);
    return v;
}
DEVI float siluf(float x) { return x * __builtin_amdgcn_rcpf(1.f + __expf(-x)); }
DEVI float sigmoidf_(float x) { return 1.f / (1.f + __expf(-x)); }

struct Args { const float* in[23]; float* out; unsigned char* ws; int ph_lo, ph_hi; };
struct KA {
    DEVI const float* in(int k) const { return ((const float* const*)__builtin_amdgcn_kernarg_segment_ptr())[k]; }
    DEVI float* out() const { return ((float* const*)__builtin_amdgcn_kernarg_segment_ptr())[23]; }
    DEVI unsigned char* ws() const { return ((unsigned char* const*)__builtin_amdgcn_kernarg_segment_ptr())[24]; }
};

namespace pg8 {
constexpr int BM = 256, BK = 64, HALF = 128, HTB = HALF * BK * 2, STAGE_BYTES = 8 * HTB, NXCD = 8, WGM = 8;
__host__ __device__ __forceinline__ int lds_byte(int r, int c) { const int st = (r >> 4) * 2 + (c >> 5), rr = r & 15, cc = c & 31, ob = rr * 64 + cc * 2; return st * 1024 + (ob ^ (((ob >> 9) & 1) << 5)); }
__host__ __device__ __forceinline__ void stage_rc(int b, int& R, int& C) { const int st = b / 1024, sb = b % 1024, swz = sb ^ (((sb >> 9) & 1) << 5); R = (st >> 1) * 16 + swz / 64; C = (st & 1) * 32 + (swz % 64) / 2; }
__host__ __device__ __forceinline__ int perm32(int rho) { const int n = rho >> 4, i = rho & 15; return 8 * (i >> 2) + 4 * n + (i & 3); }
struct Unit { int pm, pn; };
struct Gemm { const bf16_t* A; const bf16_t* Bt; int M, N, K; };
struct StaticOrder {
    int nM, nN, nwg, G, c;
    __device__ void init(int M, int N, int G_, int c_) { nM = M / BM; nN = N / BM; nwg = nM * nN; G = G_; c = c_; }
    __device__ bool next(int i, Unit& u) const {
        const long L = (long)i * G + c; if (L >= nwg) return false;
        int wgid = (int)L; { const int q = nwg / NXCD, r = nwg % NXCD, xcd = wgid % NXCD, off = wgid / NXCD; wgid = (xcd < r ? xcd * (q + 1) : r * (q + 1) + (xcd - r) * q) + off; }
        const int nig = WGM * nN, gid = wgid / nig, fm = gid * WGM, gsz = (nM - fm) < WGM ? (nM - fm) : WGM;
        u.pm = fm + ((wgid % nig) % gsz); u.pn = (wgid % nig) / gsz; return true;
    }
};
template <class Epi> __device__ __forceinline__ size_t a_off(const Epi& E, int pm, int K, size_t tstep) { if constexpr (Epi::AROW) return (size_t)E.arow(pm) * K * 2; else return (size_t)pm * tstep; }
template <class Epi, class Sched, bool ALIGN_EPI, bool SP2>
__device__ __forceinline__ void gemm_phase(LAS unsigned char* lds, const Gemm g, const Sched& S, const Epi& E) {
    const int tid = threadIdx.x, wid = __builtin_amdgcn_readfirstlane(tid >> 6), lane = tid & 63, wr = wid >> 2, wc = wid & 3, fr = lane & 15, fq = lane >> 4;
    const int K = g.K, nt = K / BK;
    unsigned voffA[2], voffB[2];
#pragma unroll
    for (int i = 0; i < 2; ++i) { int R, C; stage_rc(tid * 16 + i * 8192, R, C); const int Rb = Epi::PERM ? ((R & ~31) + perm32(R & 31)) : R;
        voffA[i] = (unsigned)(R * K + C) * 2u; voffB[i] = (unsigned)(Rb * K + C) * 2u; }
    const size_t kstep = (size_t)(BK * 2);
    const size_t hstep = (size_t)HALF * K * 2;
    const size_t tstep = 2 * hstep;
    const unsigned ldsw = (unsigned)wid * 1024u;
    const int aoff = lds_byte(wr * 64 + fr, fq * 8), boff = lds_byte(wc * 32 + fr, fq * 8);
#define PG8_SA(b, h) (((b) * 2 + (h)) * HTB)
#define PG8_SB(b, h) ((4 + (b) * 2 + (h)) * HTB)
#define PG8_STAGE(bufoff, gbase, voff) do { _Pragma("unroll") for (int _i = 0; _i < 2; ++_i) \
        __builtin_amdgcn_global_load_lds((const unsigned*)((const char*)(gbase) + (voff)[_i]), (LAS unsigned*)(lds + (bufoff) + ldsw + _i * 8192), 16, 0, 0); } while (0)
#define PG8_LDA(dst, b, h) do { _Pragma("unroll") for (int m = 0; m < 4; ++m) _Pragma("unroll") for (int k = 0; k < 2; ++k) dst[m][k] = *(const LAS bf16x8*)(lds + PG8_SA(b, h) + aoff + m * 2048 + k * 1024); } while (0)
#define PG8_LDB(dst, b, h) do { _Pragma("unroll") for (int n = 0; n < 2; ++n) _Pragma("unroll") for (int k = 0; k < 2; ++k) dst[n][k] = *(const LAS bf16x8*)(lds + PG8_SB(b, h) + boff + n * 2048 + k * 1024); } while (0)
#define PG8_MMA(ai, bj, At, Bt) do { __builtin_amdgcn_s_setprio(1); _Pragma("unroll") for (int m = 0; m < 4; ++m) _Pragma("unroll") for (int n = 0; n < 2; ++n) _Pragma("unroll") for (int k = 0; k < 2; ++k) \
        acc[ai][bj][m][n] = __builtin_amdgcn_mfma_f32_16x16x32_bf16(Bt[n][k], At[m][k], acc[ai][bj][m][n], 0, 0, 0); __builtin_amdgcn_s_setprio(0); } while (0)
#define PG8_WAIT_V(n) asm volatile("s_waitcnt vmcnt(" #n ")" ::: "memory")
#define PG8_WAIT_L(n) asm volatile("s_waitcnt lgkmcnt(" #n ")" ::: "memory")
#define PG8_BAR __builtin_amdgcn_s_barrier()
#define PG8_SCHED __builtin_amdgcn_sched_barrier(0)
    Unit cur, nxt; int ui = 0;
    if (!S.next(0, cur)) return;
    f32x4 acc[2][2][4][2];
#pragma unroll
    for (int a = 0; a < 2; ++a)
#pragma unroll
        for (int b = 0; b < 2; ++b)
#pragma unroll
            for (int m = 0; m < 4; ++m)
#pragma unroll
                for (int n = 0; n < 2; ++n) acc[a][b][m][n] = (f32x4){0.f, 0.f, 0.f, 0.f};
    bf16x8 At[4][2], B0[2][2], B1[2][2];
    const char* cA = (const char*)g.A + a_off<Epi>(E, cur.pm, K, tstep); const char* cB = (const char*)g.Bt + (size_t)cur.pn * tstep;
    if constexpr (SP2) {
        PG8_STAGE(PG8_SB(0, 0), cB, voffB); PG8_STAGE(PG8_SB(0, 1), cB + hstep, voffB); PG8_STAGE(PG8_SA(0, 0), cA, voffA); PG8_STAGE(PG8_SA(0, 1), cA + hstep, voffA);
        if (wr == 1) PG8_BAR;
        PG8_WAIT_V(2); PG8_BAR;
        PG8_STAGE(PG8_SB(1, 0), cB + kstep, voffB); PG8_STAGE(PG8_SA(1, 0), cA + kstep, voffA); PG8_STAGE(PG8_SB(1, 1), cB + hstep + kstep, voffB);
        PG8_WAIT_V(6); PG8_BAR;
    } else {
        PG8_STAGE(PG8_SB(0, 0), cB, voffB); PG8_STAGE(PG8_SA(0, 0), cA, voffA); PG8_STAGE(PG8_SB(0, 1), cB + hstep, voffB); PG8_STAGE(PG8_SA(0, 1), cA + hstep, voffA);
        if (wr == 1) PG8_BAR;
        PG8_WAIT_V(4); PG8_BAR;
        PG8_STAGE(PG8_SB(1, 0), cB + kstep, voffB); PG8_STAGE(PG8_SA(1, 0), cA + kstep, voffA); PG8_STAGE(PG8_SB(1, 1), cB + hstep + kstep, voffB);
        PG8_WAIT_V(6); PG8_BAR;
    }
    for (;;) {
        const bool has_next = S.next(ui + 1, nxt);
        const char* nA = has_next ? (const char*)g.A + a_off<Epi>(E, nxt.pm, K, tstep) : cA; const char* nB = has_next ? (const char*)g.Bt + (size_t)nxt.pn * tstep : cB;
#pragma unroll 1
        for (int t = 0; t < nt; t += 2) {
            const bool last = (t == nt - 2);
            if constexpr (Epi::MID) { if (t == nt / 2) E.mid(acc, cur, wr, wc, fr, fq); }
            const char* a1 = cA + (size_t)(t + 1) * kstep;
            const char* a2 = last ? nA : cA + (size_t)(t + 2) * kstep; const char* b2 = last ? nB : cB + (size_t)(t + 2) * kstep;
            const char* a3 = a2 + kstep; const char* b3 = b2 + kstep;
            if constexpr (SP2) {
            PG8_LDB(B0, 0, 0); PG8_LDB(B1, 0, 1); PG8_SCHED; PG8_LDA(At, 0, 0); PG8_STAGE(PG8_SA(1, 1), a1 + hstep, voffA);
            PG8_WAIT_V(8); PG8_WAIT_L(0); PG8_BAR; PG8_MMA(0, 0, At, B0); PG8_MMA(0, 1, At, B1); PG8_BAR; PG8_SCHED;
            PG8_LDA(At, 0, 1); PG8_STAGE(PG8_SB(0, 0), b2, voffB); PG8_STAGE(PG8_SB(0, 1), b2 + hstep, voffB); PG8_STAGE(PG8_SA(0, 0), a2, voffA);
            PG8_WAIT_V(8); PG8_WAIT_L(0); PG8_BAR; PG8_MMA(1, 0, At, B0); PG8_MMA(1, 1, At, B1); PG8_BAR; PG8_SCHED;
            PG8_LDB(B0, 1, 0); PG8_LDB(B1, 1, 1); PG8_SCHED; PG8_LDA(At, 1, 0); PG8_STAGE(PG8_SA(0, 1), a2 + hstep, voffA);
            PG8_WAIT_V(8); PG8_WAIT_L(0); PG8_BAR; PG8_MMA(0, 0, At, B0); PG8_MMA(0, 1, At, B1); PG8_BAR; PG8_SCHED;
            PG8_LDA(At, 1, 1); PG8_STAGE(PG8_SB(1, 0), b3, voffB); PG8_STAGE(PG8_SB(1, 1), b3 + hstep, voffB); PG8_STAGE(PG8_SA(1, 0), a3, voffA);
            PG8_WAIT_V(8); PG8_WAIT_L(0); PG8_BAR; PG8_MMA(1, 0, At, B0); PG8_MMA(1, 1, At, B1); PG8_BAR; PG8_SCHED;
            } else {
            PG8_LDB(B0, 0, 0); PG8_SCHED; PG8_LDA(At, 0, 0); PG8_STAGE(PG8_SA(1, 1), a1 + hstep, voffA);
            PG8_WAIT_L(8); PG8_BAR; PG8_WAIT_L(0); PG8_MMA(0, 0, At, B0); PG8_BAR; PG8_SCHED;
            PG8_LDB(B1, 0, 1); PG8_STAGE(PG8_SB(0, 0), b2, voffB);
            PG8_BAR; PG8_WAIT_L(0); PG8_MMA(0, 1, At, B1); PG8_BAR;
            PG8_LDA(At, 0, 1); PG8_STAGE(PG8_SA(0, 0), a2, voffA);
            PG8_BAR; PG8_WAIT_L(0); PG8_MMA(1, 0, At, B0); PG8_BAR; PG8_SCHED;
            PG8_STAGE(PG8_SB(0, 1), b2 + hstep, voffB);
            PG8_WAIT_V(6); PG8_BAR; PG8_MMA(1, 1, At, B1); PG8_BAR;
            PG8_LDB(B0, 1, 0); PG8_SCHED; PG8_LDA(At, 1, 0); PG8_STAGE(PG8_SA(0, 1), a2 + hstep, voffA);
            PG8_WAIT_L(8); PG8_BAR; PG8_WAIT_L(0); PG8_MMA(0, 0, At, B0); PG8_BAR; PG8_SCHED;
            PG8_LDB(B1, 1, 1); PG8_STAGE(PG8_SB(1, 0), b3, voffB);
            PG8_BAR; PG8_WAIT_L(0); PG8_MMA(0, 1, At, B1); PG8_BAR;
            PG8_LDA(At, 1, 1); PG8_STAGE(PG8_SA(1, 0), a3, voffA);
            PG8_BAR; PG8_WAIT_L(0); PG8_MMA(1, 0, At, B0); PG8_BAR; PG8_SCHED;
            PG8_STAGE(PG8_SB(1, 1), b3 + hstep, voffB);
            PG8_WAIT_V(6); PG8_BAR; PG8_MMA(1, 1, At, B1); PG8_BAR;
            }
        }
        if constexpr (ALIGN_EPI) { if (wr == 0) PG8_BAR; }
        E(acc, cur, wr, wc, fr, fq);
        if (!has_next) break;
#pragma unroll
        for (int a = 0; a < 2; ++a)
#pragma unroll
            for (int b = 0; b < 2; ++b)
#pragma unroll
                for (int m = 0; m < 4; ++m)
#pragma unroll
                    for (int n = 0; n < 2; ++n) acc[a][b][m][n] = (f32x4){0.f, 0.f, 0.f, 0.f};
        cur = nxt; cA = nA; cB = nB; ++ui;
        if constexpr (ALIGN_EPI) { if (wr == 1) PG8_BAR; }
    }
    PG8_WAIT_V(0);
    if constexpr (!ALIGN_EPI) { if (wr == 0) PG8_BAR; }
    PG8_BAR;
#undef PG8_SA
#undef PG8_SB
#undef PG8_STAGE
#undef PG8_LDA
#undef PG8_LDB
#undef PG8_MMA
#undef PG8_WAIT_V
#undef PG8_WAIT_L
#undef PG8_BAR
#undef PG8_SCHED
}
}
using pg8::HALF;

DEVI u32x4 pack8(const f32x4& a, const f32x4& b) { u32x4 w; w.x = pk2(a[0], a[1]); w.y = pk2(a[2], a[3]); w.z = pk2(b[0], b[1]); w.w = pk2(b[2], b[3]); return w; }

struct EpiIn {
    static constexpr bool PERM = true, MID = false, AROW = false;
    const float* rowss; const float* shW; int job;
    bf16_t *d0, *d1, *d2, *d3, *d4; float* ba;
    DEVI void operator()(const f32x4 (&acc)[2][2][4][2], const pg8::Unit& u, int wr, int wc, int fr, int fq) const {
        asm volatile("" : "+v"(fr), "+v"(fq));
        const int vs = u.pm < 64 ? 0 : (u.pm < 128 ? 1 : 2);
        bf16_t* base; int pitch, colt; bool isba = false;
        if (job == 0) { base = d0; pitch = 3072; colt = u.pn * 256; if (u.pn >= 12) isba = true; }
        else {
            if (u.pn < 4) { base = d0; pitch = 1024; colt = u.pn * 256; }
            else if (u.pn < 8) { base = d1; pitch = 1024; colt = (u.pn - 4) * 256; }
            else if (u.pn == 8) { base = d2; pitch = 256; colt = 0; }
            else if (u.pn == 9) { base = d3; pitch = 256; colt = 0; }
            else { base = d4; pitch = 2048; colt = (u.pn - 10) * 256; }
        }
        const int ncol0 = u.pn * 256 + wc * 32 + 8 * fq;
        f32x4 sv[2][2];
#pragma unroll
        for (int bj = 0; bj < 2; ++bj)
#pragma unroll
            for (int n = 0; n < 2; ++n) sv[bj][n] = *(const f32x4*)(shW + vs * NSH + ncol0 + bj * HALF + 4 * n);
        const int row0 = u.pm * 256 + wr * 64 + fr;
#pragma unroll
        for (int ai = 0; ai < 2; ++ai)
#pragma unroll
            for (int m = 0; m < 4; ++m) {
                const int row = row0 + ai * HALF + m * 16;
                const float rs = rsqrtf(rowss[row] * (1.f / 1024.f) + EPS);
                if (!isba) {
                    bf16_t* rowp = base + (size_t)row * pitch + colt + wc * 32 + 8 * fq;
#pragma unroll
                    for (int bj = 0; bj < 2; ++bj) { const f32x4 v0 = acc[ai][bj][m][0] * rs + sv[bj][0], v1 = acc[ai][bj][m][1] * rs + sv[bj][1]; *(u32x4*)(rowp + bj * HALF) = pack8(v0, v1); }
                } else if (wc == 0) {
                    float* rowp = ba + (size_t)row * 32 + 8 * fq;
                    *(f32x4*)(rowp) = acc[ai][0][m][0] * rs + sv[0][0]; *(f32x4*)(rowp + 4) = acc[ai][0][m][1] * rs + sv[0][1];
                }
            }
    }
};
struct EpiBr {
    static constexpr bool PERM = true, MID = true, AROW = false;
    const bf16_t* mg; bf16_t* out;
    DEVI void mid(f32x4 (&acc)[2][2][4][2], const pg8::Unit& u, int wr, int wc, int fr, int fq) const {
        asm volatile("" : "+v"(fr), "+v"(fq));
        const int row0 = u.pm * 256 + wr * 64 + fr, col0 = u.pn * 256 + wc * 32 + 8 * fq;
#pragma unroll
        for (int ai = 0; ai < 2; ++ai)
#pragma unroll
            for (int m = 0; m < 4; ++m) {
                const bf16_t* rp = mg + (size_t)(row0 + ai * HALF + m * 16) * 2048 + col0;
#pragma unroll
                for (int bj = 0; bj < 2; ++bj) {
                    const u32x4 gd = *(const u32x4*)(rp + bj * HALF), ga = *(const u32x4*)(rp + 1024 + bj * HALF);
                    float r[8];
#pragma unroll
                    for (int i = 0; i < 4; ++i) {
                        const float d0 = bflo(gd[i]), d1 = bfhi(gd[i]), a0 = bflo(ga[i]), a1 = bfhi(ga[i]);
                        r[2 * i] = (1.f + __expf(fminf(-a0, 80.f))) * __builtin_amdgcn_rcpf(1.f + __expf(fminf(-d0, 80.f)));
                        r[2 * i + 1] = (1.f + __expf(fminf(-a1, 80.f))) * __builtin_amdgcn_rcpf(1.f + __expf(fminf(-d1, 80.f)));
                    }
                    acc[ai][bj][m][0] *= (f32x4){r[0], r[1], r[2], r[3]}; acc[ai][bj][m][1] *= (f32x4){r[4], r[5], r[6], r[7]};
                    asm volatile("" ::: "memory");
                }
            }
    }
    DEVI void operator()(const f32x4 (&acc)[2][2][4][2], const pg8::Unit& u, int wr, int wc, int fr, int fq) const {
        asm volatile("" : "+v"(fr), "+v"(fq));
        const int row0 = u.pm * 256 + wr * 64 + fr, col0 = u.pn * 256 + wc * 32 + 8 * fq;
#pragma unroll
        for (int ai = 0; ai < 2; ++ai)
#pragma unroll
            for (int m = 0; m < 4; ++m) {
                const size_t row = (size_t)(row0 + ai * HALF + m * 16);
                const bf16_t* rp = mg + row * 2048 + 1024 + col0;
#pragma unroll
                for (int bj = 0; bj < 2; ++bj) {
                    const u32x4 ga = *(const u32x4*)(rp + bj * HALF);
                    float s[8];
#pragma unroll
                    for (int i = 0; i < 4; ++i) { s[2 * i] = __builtin_amdgcn_rcpf(1.f + __expf(fminf(-bflo(ga[i]), 80.f))); s[2 * i + 1] = __builtin_amdgcn_rcpf(1.f + __expf(fminf(-bfhi(ga[i]), 80.f))); }
                    const f32x4 v0 = acc[ai][bj][m][0] * (f32x4){s[0], s[1], s[2], s[3]}, v1 = acc[ai][bj][m][1] * (f32x4){s[4], s[5], s[6], s[7]};
                    *(u32x4*)(out + row * 1024 + col0 + bj * HALF) = pack8(v0, v1);
                }
            }
    }
};
struct EpiOut {
    static constexpr bool PERM = false, MID = false, AROW = false;
    const float* x; const float* modacc; const float* bada; const float* nwf; float* out; bf16_t* x1s; float* rowss2;
    DEVI void operator()(const f32x4 (&acc)[2][2][4][2], const pg8::Unit& u, int wr, int wc, int fr, int fq) const {
        asm volatile("" : "+v"(fr), "+v"(fq));
        const int b = u.pm >> 6; const int row0 = u.pm * 256 + wr * 64 + fr, col0 = u.pn * 256 + wc * 32 + 4 * fq;
        f32x4 ga[2][2], sc[2][2];
#pragma unroll
        for (int bj = 0; bj < 2; ++bj)
#pragma unroll
            for (int n = 0; n < 2; ++n) { const int c = col0 + bj * HALF + n * 16;
                ga[bj][n] = *(const f32x4*)(modacc + b * 6144 + 2048 + c) + *(const f32x4*)(bada + 2048 + c);
                sc[bj][n] = (*(const f32x4*)(modacc + b * 6144 + 4096 + c) + *(const f32x4*)(bada + 4096 + c) + 1.f) * *(const f32x4*)(nwf + c); }
#pragma unroll
        for (int ai = 0; ai < 2; ++ai)
#pragma unroll
            for (int m = 0; m < 4; ++m) {
                const size_t off = (size_t)(row0 + ai * HALF + m * 16) * 1024 + col0; float ss = 0.f;
#pragma unroll
                for (int bj = 0; bj < 2; ++bj)
#pragma unroll
                    for (int n = 0; n < 2; ++n) {
                        const f32x4 xv = *(const f32x4*)(x + off + bj * HALF + n * 16);
                        const f32x4 o = xv + ga[bj][n] * acc[ai][bj][m][n];
                        *(f32x4*)(out + off + bj * HALF + n * 16) = o;
                        ss += (o[0] * o[0] + o[1] * o[1]) + (o[2] * o[2] + o[3] * o[3]);
                        const f32x4 s = o * sc[bj][n]; u32x2 w; w.x = pk2(s[0], s[1]); w.y = pk2(s[2], s[3]);
                        *(u32x2*)(x1s + off + (size_t)(b * (RB - SEQ) + 1) * 1024 + bj * HALF + n * 16) = w;
                    }
                ss += __shfl_xor(ss, 16); ss += __shfl_xor(ss, 32);
                if (fq == 0) atomicAdd(rowss2 + row0 + ai * HALF + m * 16, ss);
            }
    }
};
DEVI f32x4 dpp_ror1(const f32x4& x) { f32x4 r;
#pragma unroll
    for (int i = 0; i < 4; ++i) r[i] = __int_as_float(__builtin_amdgcn_update_dpp(0, __float_as_int(x[i]), 0x121, 0xf, 0xf, false));
    return r; }
DEVI f32x4 dpp_rol1(const f32x4& x) { f32x4 r;
#pragma unroll
    for (int i = 0; i < 4; ++i) r[i] = __int_as_float(__builtin_amdgcn_update_dpp(0, __float_as_int(x[i]), 0x12F, 0xf, 0xf, false));
    return r; }
struct EpiUpConv {
    static constexpr bool PERM = true, MID = false, AROW = true;
    const float* rowss2; const float* shWf; const float* cw; const float* cb; bf16_t* act; LAS float* xb;
    DEVI int arow(int pm) const { const int b = pm / TPB, i = pm - b * TPB; return b * RB + 254 * i; }
    DEVI void operator()(f32x4 (&acc)[2][2][4][2], const pg8::Unit& u, int wr, int wc, int fr, int fq) const {
        asm volatile("" : "+v"(fr), "+v"(fq));
        const int b = u.pm / TPB, ti = u.pm - b * TPB, tok0 = 254 * ti - 1;
        const int cl0 = wc * 32 + 8 * fq;
#pragma unroll
        for (int bj = 0; bj < 2; ++bj) {
            const f32x4 sv0 = *(const f32x4*)(shWf + b * NUP + u.pn * 256 + bj * HALF + cl0), sv1 = *(const f32x4*)(shWf + b * NUP + u.pn * 256 + bj * HALF + cl0 + 4);
#pragma unroll
            for (int ai = 0; ai < 2; ++ai)
#pragma unroll
                for (int m = 0; m < 4; ++m) {
                    const int tok = tok0 + ai * HALF + wr * 64 + m * 16 + fr; const bool ok = tok >= 0 && tok < SEQ;
                    const float rs = ok ? rsqrtf(rowss2[b * SEQ + (ok ? tok : 0)] * (1.f / 1024.f) + EPS) : 0.f;
                    acc[ai][bj][m][0] = ok ? acc[ai][bj][m][0] * rs + sv0 : (f32x4){0.f, 0.f, 0.f, 0.f};
                    acc[ai][bj][m][1] = ok ? acc[ai][bj][m][1] * rs + sv1 : (f32x4){0.f, 0.f, 0.f, 0.f};
                }
        }
#pragma unroll
        for (int ai = 0; ai < 2; ++ai) { const int blk = 2 * ai + wr;
#pragma unroll
            for (int bj = 0; bj < 2; ++bj)
#pragma unroll
                for (int n = 0; n < 2; ++n) {
                    if (fr == 0) *(LAS f32x4*)(xb + (blk * 2 + 0) * 256 + bj * HALF + cl0 + 4 * n) = acc[ai][bj][0][n];
                    if (fr == 15) *(LAS f32x4*)(xb + (blk * 2 + 1) * 256 + bj * HALF + cl0 + 4 * n) = acc[ai][bj][3][n];
                } }
        asm volatile("s_waitcnt lgkmcnt(0)" ::: "memory"); __builtin_amdgcn_s_barrier(); asm volatile("" ::: "memory");
        const int f0 = u.pn * 128 + cl0;
#pragma unroll
        for (int n = 0; n < 2; ++n) {
            f32x4 wg[3], wv[3];
#pragma unroll
            for (int j = 0; j < 3; ++j) { wg[j] = *(const f32x4*)(cw + j * NUP + f0 + 4 * n); wv[j] = *(const f32x4*)(cw + j * NUP + DFF + f0 + 4 * n); }
            const f32x4 bgv = *(const f32x4*)(cb + f0 + 4 * n), bvv = *(const f32x4*)(cb + DFF + f0 + 4 * n);
#pragma unroll
            for (int ai = 0; ai < 2; ++ai) { const int blk = 2 * ai + wr;
                const f32x4 pgx = *(const LAS f32x4*)(xb + (((blk + 3) & 3) * 2 + 1) * 256 + cl0 + 4 * n), pvx = *(const LAS f32x4*)(xb + (((blk + 3) & 3) * 2 + 1) * 256 + HALF + cl0 + 4 * n);
                const f32x4 ngx = *(const LAS f32x4*)(xb + (((blk + 1) & 3) * 2 + 0) * 256 + cl0 + 4 * n), nvx = *(const LAS f32x4*)(xb + (((blk + 1) & 3) * 2 + 0) * 256 + HALF + cl0 + 4 * n);
#pragma unroll
                for (int m = 0; m < 4; ++m) {
                    f32x4 ug, uv;
                    { const f32x4 c = acc[ai][0][m][n], up = m > 0 ? acc[ai][0][m > 0 ? m - 1 : 0][n] : pgx, dn = m < 3 ? acc[ai][0][m < 3 ? m + 1 : 3][n] : ngx;
                      f32x4 pr = dpp_ror1(fr == 15 ? up : c), nx = dpp_rol1(fr == 0 ? dn : c);
                      asm volatile("" : "+v"(pr), "+v"(nx));
                      ug = bgv + wg[0] * pr + wg[1] * c + wg[2] * nx; }
                    { const f32x4 c = acc[ai][1][m][n], up = m > 0 ? acc[ai][1][m > 0 ? m - 1 : 0][n] : pvx, dn = m < 3 ? acc[ai][1][m < 3 ? m + 1 : 3][n] : nvx;
                      f32x4 pr = dpp_ror1(fr == 15 ? up : c), nx = dpp_rol1(fr == 0 ? dn : c);
                      asm volatile("" : "+v"(pr), "+v"(nx));
                      uv = bvv + wv[0] * pr + wv[1] * c + wv[2] * nx; }
                    const int r = ai * HALF + wr * 64 + m * 16 + fr, tok = tok0 + r;
                    if (r >= 1 && r <= 254 && tok < SEQ) {
                        u32x2 w; w.x = pk2(siluf(ug[0]) * uv[0], siluf(ug[1]) * uv[1]); w.y = pk2(siluf(ug[2]) * uv[2], siluf(ug[3]) * uv[3]);
                        *(u32x2*)(act + (size_t)(b * SEQ + tok) * DFF + f0 + 4 * n) = w; }
                    asm volatile("" ::: "memory");
                }
            }
        }
    }
};
struct EpiDown {
    static constexpr bool PERM = false, MID = false, AROW = false;
    const float* modacc; const float* bada; float* out;
    DEVI void operator()(const f32x4 (&acc)[2][2][4][2], const pg8::Unit& u, int wr, int wc, int fr, int fq) const {
        asm volatile("" : "+v"(fr), "+v"(fq));
        const int b = u.pm >> 6; const int row0 = u.pm * 256 + wr * 64 + fr, col0 = u.pn * 256 + wc * 32 + 4 * fq;
        f32x4 gf[2][2];
#pragma unroll
        for (int bj = 0; bj < 2; ++bj)
#pragma unroll
            for (int n = 0; n < 2; ++n) { const int c = col0 + bj * HALF + n * 16; gf[bj][n] = *(const f32x4*)(modacc + b * 6144 + 5120 + c) + *(const f32x4*)(bada + 5120 + c); }
#pragma unroll
        for (int ai = 0; ai < 2; ++ai)
#pragma unroll
            for (int m = 0; m < 4; ++m) {
                const size_t off = (size_t)(row0 + ai * HALF + m * 16) * 1024 + col0;
#pragma unroll
                for (int bj = 0; bj < 2; ++bj)
#pragma unroll
                    for (int n = 0; n < 2; ++n) { float* p = out + off + bj * HALF + n * 16; *(f32x4*)p = *(const f32x4*)p + gf[bj][n] * acc[ai][bj][m][n]; }
            }
    }
};

DEVI void transpose_item(const float* W, int srcN, int k0, int n0, bf16_t* dst  , int dstK, LAS float* scr, int lane) {
#pragma unroll 8
    for (int i = 0; i < 32; ++i) { const int kk = 2 * i + (lane >> 5); scr[kk * 33 + (lane & 31)] = W[(size_t)(k0 + kk) * srcN + n0 + (lane & 31)]; }
    asm volatile("s_waitcnt lgkmcnt(0)" ::: "memory");
    const int c = lane & 7;
#pragma unroll
    for (int j = 0; j < 4; ++j) { const int n = (lane >> 3) + 8 * j; const LAS float* s = scr + (8 * c) * 33 + n;
        u32x4 o; o.x = pk2(s[0 * 33], s[1 * 33]); o.y = pk2(s[2 * 33], s[3 * 33]); o.z = pk2(s[4 * 33], s[5 * 33]); o.w = pk2(s[6 * 33], s[7 * 33]);
        *(u32x4*)(dst + (size_t)n * dstK + 8 * c) = o; }
    asm volatile("s_waitcnt lgkmcnt(0)" ::: "memory");
}
DEVI void phase0(const KA& a, LAS unsigned char* lds, int tid, int lane, int wave) {
    unsigned char* ws = a.ws();
    bf16_t* WinA = (bf16_t*)(ws + WS_WINA); bf16_t* WinC = (bf16_t*)(ws + WS_WINC); bf16_t* Wbr = (bf16_t*)(ws + WS_WBR);
    bf16_t* Wout = (bf16_t*)(ws + WS_WOUT); bf16_t* Wup = (bf16_t*)(ws + WS_WUP); bf16_t* Wdn = (bf16_t*)(ws + WS_WDN);
    LAS float* scr = (LAS float*)(lds + wave * 16384);
    const int gw = blockIdx.x * 8 + wave, NGW = gridDim.x * 8;
    constexpr int I_IN = 16 * 241, I_BR = 16 * 32, I_UP = 16 * 176, I_DN = 44 * 32;
    constexpr int NITEMS = I_IN + 3 * I_BR + I_UP + I_DN;
    for (int it = gw; it < NITEMS; it += NGW) {
        int r = it;
        if (r < I_IN) { const int kb = r / 241, nb = r % 241, c0 = nb * 32; bf16_t* d; int row;
            if (c0 < 3072) { d = WinA; row = c0; } else if (c0 < 4096) { d = WinC; row = c0 - 3072; } else if (c0 == 4096) { d = WinA; row = 3072; }
            else if (c0 < 5152) { d = WinC; row = 1024 + (c0 - 4128); } else if (c0 < 5408) { d = WinC; row = 2048 + (c0 - 5152); }
            else if (c0 < 5664) { d = WinC; row = 2304 + (c0 - 5408); } else { d = WinC; row = 2560 + (c0 - 5664); }
            transpose_item(a.in(8), 7712, kb * 64, c0, d + (size_t)row * 1024 + kb * 64, 1024, scr, lane); continue; }
        r -= I_IN;
        if (r < I_BR) { const int kb = r / 32, nb = r % 32; transpose_item(a.in(16), 1024, kb * 64, nb * 32, Wbr + (size_t)(nb * 32) * 2048 + kb * 64, 2048, scr, lane); continue; }
        r -= I_BR;
        if (r < I_BR) { const int kb = r / 32, nb = r % 32; transpose_item(a.in(17), 1024, kb * 64, nb * 32, Wbr + (size_t)(nb * 32) * 2048 + 1024 + kb * 64, 2048, scr, lane); continue; }
        r -= I_BR;
        if (r < I_BR) { const int kb = r / 32, nb = r % 32; transpose_item(a.in(18), 1024, kb * 64, nb * 32, Wout + (size_t)(nb * 32) * 1024 + kb * 64, 1024, scr, lane); continue; }
        r -= I_BR;
        if (r < I_UP) { const int kb = r / 176, nb = r % 176, c0 = nb * 32; int row;
            if (c0 < DFF) row = 256 * (c0 / 128) + (c0 % 128); else { const int c1 = c0 - DFF; row = 256 * (c1 / 128) + 128 + (c1 % 128); }
            transpose_item(a.in(19), NUP, kb * 64, c0, Wup + (size_t)row * 1024 + kb * 64, 1024, scr, lane); continue; }
        r -= I_UP;
        { const int kb = r / 32, nb = r % 32; transpose_item(a.in(22), 1024, kb * 64, nb * 32, Wdn + (size_t)(nb * 32) * DFF + kb * 64, DFF, scr, lane); }
    }
    float* modacc = (float*)(ws + CTL_MODACC);
    for (int it = blockIdx.x; it < 12 * 16; it += gridDim.x) {
        const int cb = it % 12, ks = it / 12, n = cb * 512 + tid;
        float a0 = 0.f, a1 = 0.f, a2 = 0.f;
#pragma unroll 8
        for (int k = ks * 64; k < ks * 64 + 64; ++k) {
            const float w = a.in(4)[(size_t)k * 6144 + n];
            a0 += siluf(a.in(1)[k]) * w; a1 += siluf(a.in(1)[1024 + k]) * w; a2 += siluf(a.in(3)[k]) * w;
        }
        atomicAdd(modacc + n, a0); atomicAdd(modacc + 6144 + n, a1); atomicAdd(modacc + 12288 + n, a2);
    }
    float* rope = (float*)(ws + SM_ROPE);
    for (int i = blockIdx.x * 512 + tid; i < 320 * 32; i += gridDim.x * 512) {
        const int p = i >> 5, f = i & 31; const float inv = powf(10000.f, -(float)f / 32.f);
        if (p < 256) { const float ang = (float)p * inv; rope[p * 32 + f] = cosf(ang); rope[8192 + p * 32 + f] = sinf(ang); }
        else { const int q = p - 256; const float ang = (float)q * inv; rope[16384 + q * 32 + f] = cosf(ang); rope[16384 + 2048 + q * 32 + f] = sinf(ang); }
    }
}

DEVI void phase1(const KA& a, int tid, int lane, int wave) {
    unsigned char* ws = a.ws();
    const float* modacc = (const float*)(ws + CTL_MODACC); const float* bada = a.in(5);
    bf16_t* XN = (bf16_t*)(ws + WS_XN); float* rowss1 = (float*)(ws + SM_ROWSS1);
    const int gw = blockIdx.x * 8 + wave, NGW = gridDim.x * 8;
    for (int row = gw; row < MT; row += NGW) {
        const int vs = row < SEQ ? 0 : (row < ML ? 1 : 2);
        const float* xr = row < ML ? a.in(0) + (size_t)row * 1024 : a.in(2) + (size_t)(row - ML) * 1024;
        float ss = 0.f;
#pragma unroll
        for (int j = 0; j < 4; ++j) {
            const int c = 4 * lane + 256 * j;
            const f32x4 v = *(const f32x4*)(xr + c);
            ss += (v[0] * v[0] + v[1] * v[1]) + (v[2] * v[2] + v[3] * v[3]);
            const f32x4 s = (*(const f32x4*)(modacc + vs * 6144 + 1024 + c) + *(const f32x4*)(bada + 1024 + c) + 1.f) * *(const f32x4*)(a.in(6) + c);
            const f32x4 o = v * s; u32x2 w; w.x = pk2(o[0], o[1]); w.y = pk2(o[2], o[3]);
            *(u32x2*)(XN + (size_t)row * 1024 + c) = w;
        }
        ss = wave_sum(ss);
        if (lane == 0) rowss1[row] = ss;
    }
    const bf16_t* WinA = (const bf16_t*)(ws + WS_WINA); const bf16_t* WinC = (const bf16_t*)(ws + WS_WINC); const bf16_t* Wup = (const bf16_t*)(ws + WS_WUP);
    float* shWa = (float*)(ws + SM_SHWA); float* shWf = (float*)(ws + SM_SHWF);
    for (int n = gw; n < NSH + NUP; n += NGW) {
        const bool isf = n >= NSH;
        const bf16_t* wrow = isf ? Wup + (size_t)(n - NSH) * 1024 : (n < NA ? WinA + (size_t)n * 1024 : WinC + (size_t)(n - NA) * 1024);
        const int shoff = isf ? 3072 : 0;
        float s0 = 0.f, s1 = 0.f, s2 = 0.f;
#pragma unroll
        for (int h = 0; h < 2; ++h) {
            const int k0 = h * 512 + lane * 8;
            const u32x4 w = *(const u32x4*)(wrow + k0);
#pragma unroll
            for (int i = 0; i < 4; ++i) {
                const float wl = bflo(w[i]), wh = bfhi(w[i]); const int k = k0 + 2 * i;
                const float b0 = bada[shoff + k], b1 = bada[shoff + k + 1];
                s0 += (modacc[shoff + k] + b0) * wl + (modacc[shoff + k + 1] + b1) * wh;
                s1 += (modacc[6144 + shoff + k] + b0) * wl + (modacc[6144 + shoff + k + 1] + b1) * wh;
                s2 += (modacc[12288 + shoff + k] + b0) * wl + (modacc[12288 + shoff + k + 1] + b1) * wh;
            }
        }
        s0 = wave_sum(s0); s1 = wave_sum(s1); s2 = wave_sum(s2);
        if (lane == 0) {
            if (isf) { shWf[n - NSH] = s0; shWf[NUP + n - NSH] = s1; }
            else { shWa[n] = s0; shWa[NSH + n] = s1; shWa[2 * NSH + n] = s2; }
        }
    }
}

DEVI u32x4 ldrow_(const bf16_t* base, int seq_start, int seq_len, int tt) {
    const int tc = tt < 0 ? 0 : (tt >= seq_len ? seq_len - 1 : tt);
    const u32x4 v = *(const u32x4*)(base + (size_t)(seq_start + tc) * 3072);
    const unsigned m = (tt == tc) ? 0xffffffffu : 0u;
    return (u32x4){v[0] & m, v[1] & m, v[2] & m, v[3] & m};
}
DEVI void phase_dnprep(const KA& a, int tid) {
    unsigned char* ws = a.ws();
    const bf16_t* QR = (const bf16_t*)(ws + WS_QKVR); bf16_t* QP = (bf16_t*)(ws + WS_QKVP);
    const float* convw = a.in(9); const float* ba = (const float*)(ws + WS_BA);
    float* gb = (float*)(ws + WS_G); float* bb = (float*)(ws + WS_BETA);
    const int cgp = tid & 127, strip = tid >> 7;
    for (int it = blockIdx.x; it < 520 * 3; it += gridDim.x) {
        const int cidx = it / 3, sec = it - cidx * 3;
        int seq_start, t0, seq_len;
        if (cidx < 512) { seq_start = (cidx >> 8) * SEQ; t0 = (cidx & 255) * 64; seq_len = SEQ; }
        else { const int c2 = cidx - 512; seq_start = ML + (c2 >> 2) * CTX; t0 = (c2 & 3) * 64; seq_len = CTX; }
        const int col = sec * 1024 + cgp * 8;
        f32x4 w0[5], w1[5];
#pragma unroll
        for (int j = 0; j < 5; ++j) { w0[j] = *(const f32x4*)(convw + j * 3072 + col); w1[j] = *(const f32x4*)(convw + j * 3072 + col + 4); }
        const int tb = t0 + strip * 16;
        u32x4 win[5];
#define LDROW(tt) ldrow_(QR + col, seq_start, seq_len, (tt))
        win[0] = LDROW(tb - 2); win[1] = LDROW(tb - 1); win[2] = LDROW(tb); win[3] = LDROW(tb + 1);
#pragma unroll
        for (int r = 0; r < 16; ++r) {
            win[4] = LDROW(tb + r + 2);
            f32x4 acc0 = {0.f, 0.f, 0.f, 0.f}, acc1 = {0.f, 0.f, 0.f, 0.f};
#pragma unroll
            for (int j = 0; j < 5; ++j) { const u32x4 x = win[j];
                acc0 += (f32x4){bflo(x[0]), bfhi(x[0]), bflo(x[1]), bfhi(x[1])} * w0[j];
                acc1 += (f32x4){bflo(x[2]), bfhi(x[2]), bflo(x[3]), bfhi(x[3])} * w1[j]; }
            float y[8];
#pragma unroll
            for (int i = 0; i < 4; ++i) { y[i] = siluf(acc0[i]); y[4 + i] = siluf(acc1[i]); }
            if (sec < 2) {
                float ss = 0.f;
#pragma unroll
                for (int i = 0; i < 8; ++i) ss += y[i] * y[i];
                ss += __shfl_xor(ss, 1); ss += __shfl_xor(ss, 2); ss += __shfl_xor(ss, 4); ss += __shfl_xor(ss, 8);
                const float sc = rsqrtf(ss + EPS) * (sec == 0 ? 0.08838834764831845f : 1.f);
#pragma unroll
                for (int i = 0; i < 8; ++i) y[i] *= sc;
            }
            u32x4 o; o.x = pk2(y[0], y[1]); o.y = pk2(y[2], y[3]); o.z = pk2(y[4], y[5]); o.w = pk2(y[6], y[7]);
            *(u32x4*)(QP + (size_t)(seq_start + tb + r) * 3072 + col) = o;
            win[0] = win[1]; win[1] = win[2]; win[2] = win[3]; win[3] = win[4];
        }
#undef LDROW
        if (sec == 0) {
#pragma unroll
            for (int q = 0; q < 2; ++q) {
                const int e = tid + q * 512, r = e >> 4, idx = e & 15, row = seq_start + t0 + r;
                const float bv = ba[(size_t)row * 32 + idx], av = ba[(size_t)row * 32 + 16 + idx];
                const float xs = av + a.in(11)[idx];
                const float sp = fmaxf(xs, 0.f) + log1pf(expf(-fabsf(xs)));
                const float g = -expf(a.in(10)[idx]) * sp;
                const int dir = idx >> 3, h = idx & 7;
                gb[((size_t)dir * MT + row) * 8 + h] = g;
                bb[((size_t)dir * MT + row) * 8 + h] = 1.f / (1.f + expf(-bv));
            }
        }
    }
}

DEVI void phase_dnscan(const KA& a, int lane, int wave) {
    unsigned char* ws = a.ws();
    const bf16_t* QP = (const bf16_t*)(ws + WS_QKVP);
    const float* gb = (const float*)(ws + WS_G); const float* bb = (const float*)(ws + WS_BETA);
    bf16_t* Of = (bf16_t*)a.out(); bf16_t* Ob = Of + (size_t)ML * 1024;
    const int gw = blockIdx.x * 8 + wave, NGW = gridDim.x * 8;
    for (int item = gw; item < 2048; item += NGW) {
        const int chain = item >> 6, ep = item & 63, dir = chain >> 4, b = (chain >> 3) & 1, h = chain & 7;
        bf16_t* O = dir ? Ob : Of;
        float S00 = 0.f, S01 = 0.f, S10 = 0.f, S11 = 0.f;
        const int NTOK = CTX + SEQ;
        constexpr int U = 4;
        unsigned kq[U], qq[U], vv[U]; float gg[U], be[U]; int rows[U];
        auto rowof = [&](int s) -> int { if (s < CTX) { const int t = dir ? CTX - 1 - s : s; return ML + b * CTX + t; } const int t2 = s - CTX; const int t = dir ? SEQ - 1 - t2 : t2; return b * SEQ + t; };
#define SC_LOAD(i, s) do { const int row_ = rowof(s); rows[i] = row_; const bf16_t* p_ = QP + (size_t)row_ * 3072 + h * 128; \
        qq[i] = *(const unsigned*)(p_ + 2 * lane); kq[i] = *(const unsigned*)(p_ + 1024 + 2 * lane); vv[i] = *(const unsigned*)(p_ + 2048 + 2 * ep); \
        gg[i] = gb[((size_t)dir * MT + row_) * 8 + h]; be[i] = bb[((size_t)dir * MT + row_) * 8 + h]; } while (0)
        for (int s0 = 0; s0 < NTOK; s0 += U) {
#pragma unroll
            for (int i = 0; i < U; ++i) SC_LOAD(i, s0 + i);
#pragma unroll
            for (int i = 0; i < U; ++i) {
                const float k0 = bflo(kq[i]), k1 = bfhi(kq[i]), q0 = bflo(qq[i]), q1 = bfhi(qq[i]), v0 = bflo(vv[i]), v1 = bfhi(vv[i]);
                const float eg = __expf(gg[i]), bt = be[i];
                float p0 = k0 * S00 + k1 * S10, p1 = k0 * S01 + k1 * S11;
                p0 = wave_sum(p0); p1 = wave_sum(p1);
                const float vn0 = bt * (v0 - eg * p0), vn1 = bt * (v1 - eg * p1);
                S00 = eg * S00 + k0 * vn0; S01 = eg * S01 + k0 * vn1; S10 = eg * S10 + k1 * vn0; S11 = eg * S11 + k1 * vn1;
                float o0 = q0 * S00 + q1 * S10, o1 = q0 * S01 + q1 * S11;
                o0 = wave_sum(o0); o1 = wave_sum(o1);
                if (lane == 0 && rows[i] < ML) *(unsigned*)(O + (size_t)rows[i] * 1024 + h * 128 + 2 * ep) = pk2(o0, o1);
            }
        }
#undef SC_LOAD
    }
}

DEVI bf16x8 ld_b128(LAS const unsigned char* p) { return *(LAS const bf16x8*)p; }
DEVI bf16x8 ld_2b64(LAS const unsigned char* p0, LAS const unsigned char* p1) { const u32x2 a = *(LAS const u32x2*)p0, b = *(LAS const u32x2*)p1; u32x4 w = {a.x, a.y, b.x, b.y}; return __builtin_bit_cast(bf16x8, w); }
DEVI bf16x8 pack_frag(const f32x4& lo, const f32x4& hi) { u32x4 w = {pk2(lo[0], lo[1]), pk2(lo[2], lo[3]), pk2(hi[0], hi[1]), pk2(hi[2], hi[3])}; return __builtin_bit_cast(bf16x8, w); }
#define MFMA16(A, B, C) __builtin_amdgcn_mfma_f32_16x16x32_bf16(A, B, C, 0, 0, 0)
DEVI void phase_dnchunk(const KA& a, LAS unsigned char* lds, int tid, int lane, int wave) {
    unsigned char* ws = a.ws();
    const bf16_t* QP = (const bf16_t*)(ws + WS_QKVP); const float* gb = (const float*)(ws + WS_G); const float* bb = (const float*)(ws + WS_BETA);
    bf16_t* TQ = (bf16_t*)(ws + WS_TQ); float* AV = (float*)(ws + WS_AVEC);
    constexpr int KL = 0, QL = 17408, KKF = 34816, QKF = 52224, VEC = 131072;
    const int fr = lane & 15, g = lane >> 4, d = wave >> 2, wq = wave & 3;
    LAS unsigned char* dbase = lds + d * 64512;
    LAS float* Gg = (LAS float*)(lds + VEC); LAS float* Bv = Gg + 128; LAS float* GC = Gg + 256;
    for (int item = blockIdx.x; item < 520 * 8; item += gridDim.x) {
        const int cidx = item >> 3, h = item & 7;
        const int row0 = cidx < 512 ? cidx * 64 : ML + (cidx - 512) * 64;
#pragma unroll
        for (int i = 0; i < 2; ++i) { const int c = tid + i * 512, r = c >> 4, ch = c & 15;
            const bf16_t* src = QP + (size_t)(row0 + r) * 3072 + h * 128 + ch * 8;
            *(LAS u32x4*)(lds + QL + r * 272 + ch * 16) = *(const u32x4*)src; *(LAS u32x4*)(lds + KL + r * 272 + ch * 16) = *(const u32x4*)(src + 1024); }
        if (tid < 128) { const int dd = tid >> 6, pos = tid & 63; Gg[tid] = gb[((size_t)dd * MT + row0 + pos) * 8 + h]; Bv[tid] = bb[((size_t)dd * MT + row0 + pos) * 8 + h]; }
        __syncthreads();
        if (wave < 2) {
            const int dd = wave, pos = dd ? 63 - lane : lane; float x = Gg[dd * 64 + pos];
#pragma unroll
            for (int o = 1; o < 64; o <<= 1) { const float y = __shfl_up(x, o); if (lane >= o) x += y; }
            const float total = __shfl(x, 63);
            GC[dd * 64 + pos] = x;
            float* av = AV + ((size_t)item * 2 + dd) * 256;
            av[pos] = __expf(x); av[64 + pos] = Bv[dd * 64 + pos]; av[128 + pos] = __expf(total - x); if (lane == 0) av[192] = __expf(total);
        }
        {
            const int src = d ? QL : KL;
            f32x4 acc[4] = {{0.f, 0.f, 0.f, 0.f}, {0.f, 0.f, 0.f, 0.f}, {0.f, 0.f, 0.f, 0.f}, {0.f, 0.f, 0.f, 0.f}};
#pragma unroll
            for (int s4 = 0; s4 < 4; ++s4) { const bf16x8 A = ld_b128(lds + src + (16 * wq + fr) * 272 + (32 * s4 + 8 * g) * 2);
#pragma unroll
                for (int jt = 0; jt < 4; ++jt) { const bf16x8 Bf = ld_b128(lds + KL + (16 * jt + fr) * 272 + (32 * s4 + 8 * g) * 2); acc[jt] = MFMA16(A, Bf, acc[jt]); } }
            LAS float* dst = (LAS float*)(lds + (d ? QKF : KKF));
#pragma unroll
            for (int jt = 0; jt < 4; ++jt)
#pragma unroll
                for (int r = 0; r < 4; ++r) dst[(16 * wq + 4 * g + r) * 68 + 16 * jt + fr] = acc[jt][r];
        }
        __syncthreads();
        f32x4 P[4], qd[4];
        {
            const LAS float* kkf = (const LAS float*)(lds + KKF); const LAS float* qkf = (const LAS float*)(lds + QKF);
            float gci[4], bei[4];
#pragma unroll
            for (int r = 0; r < 4; ++r) { gci[r] = GC[d * 64 + 16 * wq + 4 * g + r]; bei[r] = Bv[d * 64 + 16 * wq + 4 * g + r]; }
#pragma unroll
            for (int jt = 0; jt < 4; ++jt) { const int j = 16 * jt + fr; const float gcj = GC[d * 64 + j];
#pragma unroll
                for (int r = 0; r < 4; ++r) { const int i = 16 * wq + 4 * g + r; const bool incl = d ? (i <= j) : (i >= j);
                    const float e = incl ? __expf(gci[r] - gcj) : 0.f;
                    qd[jt][r] = qkf[i * 68 + j] * e; P[jt][r] = (i != j) ? -bei[r] * kkf[i * 68 + j] * e : 0.f; } }
        }
        __syncthreads();
        {
#pragma unroll
            for (int jt = 0; jt < 4; ++jt) {
#pragma unroll
                for (int r = 0; r < 4; ++r) { const int i = 16 * wq + 4 * g + r, j = 16 * jt + fr;
                    *(LAS unsigned short*)(dbase + 0 + i * 144 + j * 2) = (unsigned short)f2bf(P[jt][r]);
                    *(LAS unsigned short*)(dbase + 36864 + 9216 + i * 144 + j * 2) = (unsigned short)f2bf(P[jt][r]);
                    *(LAS unsigned short*)(dbase + 55296 + i * 144 + j * 2) = (unsigned short)f2bf(qd[jt][r]); }
                u32x2 w = {pk2(P[jt][0], P[jt][1]), pk2(P[jt][2], P[jt][3])};
                *(LAS u32x2*)(dbase + 18432 + (16 * jt + fr) * 144 + (16 * wq + 4 * g) * 2) = w; }
        }
        __syncthreads();
        int cur = 0;
#pragma unroll 1
        for (int it = 0; it < 5; ++it) {
            LAS unsigned char* NRc = dbase + cur * 9216; LAS unsigned char* NTc = dbase + 18432 + cur * 9216;
            LAS unsigned char* NRn = dbase + (cur ^ 1) * 9216; LAS unsigned char* NTn = dbase + 18432 + (cur ^ 1) * 9216;
            LAS unsigned char* PRo = dbase + 36864 + ((it + 1) & 1) * 9216; LAS unsigned char* PRn = dbase + 36864 + (it & 1) * 9216;
            f32x4 n2[4] = {{0.f, 0.f, 0.f, 0.f}, {0.f, 0.f, 0.f, 0.f}, {0.f, 0.f, 0.f, 0.f}, {0.f, 0.f, 0.f, 0.f}};
#pragma unroll
            for (int s2 = 0; s2 < 2; ++s2) { const bf16x8 A = ld_b128(NRc + (16 * wq + fr) * 144 + (32 * s2 + 8 * g) * 2);
#pragma unroll
                for (int jt = 0; jt < 4; ++jt) { const bf16x8 Bf = ld_b128(NTc + (16 * jt + fr) * 144 + (32 * s2 + 8 * g) * 2); n2[jt] = MFMA16(A, Bf, n2[jt]); } }
#pragma unroll
            for (int jt = 0; jt < 4; ++jt) {
#pragma unroll
                for (int r = 0; r < 4; ++r) *(LAS unsigned short*)(NRn + (16 * wq + 4 * g + r) * 144 + (16 * jt + fr) * 2) = (unsigned short)f2bf(n2[jt][r]);
                u32x2 w = {pk2(n2[jt][0], n2[jt][1]), pk2(n2[jt][2], n2[jt][3])};
                *(LAS u32x2*)(NTn + (16 * jt + fr) * 144 + (16 * wq + 4 * g) * 2) = w;
                P[jt] += n2[jt]; }
            __syncthreads();
#pragma unroll
            for (int s2 = 0; s2 < 2; ++s2) { const bf16x8 A = ld_b128(PRo + (16 * wq + fr) * 144 + (32 * s2 + 8 * g) * 2);
#pragma unroll
                for (int jt = 0; jt < 4; ++jt) { const bf16x8 Bf = ld_b128(NTn + (16 * jt + fr) * 144 + (32 * s2 + 8 * g) * 2); P[jt] = MFMA16(A, Bf, P[jt]); } }
#pragma unroll
            for (int jt = 0; jt < 4; ++jt)
#pragma unroll
                for (int r = 0; r < 4; ++r) *(LAS unsigned short*)(PRn + (16 * wq + 4 * g + r) * 144 + (16 * jt + fr) * 2) = (unsigned short)f2bf(P[jt][r]);
            cur ^= 1;
        }
        __syncthreads();
        {
            bf16_t* dst = TQ + ((size_t)item * 2 + d) * 8192; const int t2 = tid & 255;
#pragma unroll
            for (int k = 0; k < 4; ++k) { const int c = t2 + 256 * k, mat = c >> 9, r = (c >> 3) & 63, ch = c & 7;
                const u32x4 v = *(LAS const u32x4*)(dbase + (mat ? 55296 : 36864) + r * 144 + ch * 16);
                *(u32x4*)(dst + mat * 4096 + r * 64 + ch * 8) = v; }
        }
        __syncthreads();
    }
}

DEVI void phase_dnchunk2(const KA& a, LAS unsigned char* lds, int tid, int lane, int wave) {
    unsigned char* ws = a.ws();
    const bf16_t* QP = (const bf16_t*)(ws + WS_QKVP); const float* gb = (const float*)(ws + WS_G); const float* bb = (const float*)(ws + WS_BETA);
    bf16_t* TQ = (bf16_t*)(ws + WS_TQ); float* AV = (float*)(ws + WS_AVEC);
    const int fr = lane & 15, g = lane >> 4, wi = wave >> 1, dir = wave & 1;
    LAS unsigned char* kl = lds + wi * 32768;
    LAS float* vec = (LAS float*)(lds + 131072 + wave * 1024);
    for (int grp = blockIdx.x; grp < 1040; grp += gridDim.x) {
        int tl = tid; asm volatile("" : "+v"(tl));
#pragma unroll
        for (int i = 0; i < 16; ++i) { const int c = tl + 512 * i, it = c >> 11, qk = (c >> 10) & 1, r = (c >> 4) & 63, ch = c & 15;
            const int item_ = grp * 4 + it, ci_ = item_ >> 3, h_ = item_ & 7; const int row0_ = ci_ < 512 ? ci_ * 64 : ML + (ci_ - 512) * 64;
            const u32x4 x = *(const u32x4*)(QP + (size_t)(row0_ + r) * 3072 + qk * 1024 + h_ * 128 + ch * 8);
            *(LAS u32x4*)(lds + it * 32768 + (qk ? 0 : 16384) + r * 256 + ((ch ^ (r & 15)) << 4)) = x; }
        const int item = grp * 4 + wi, cidx = item >> 3, h = item & 7;
        const int row0 = cidx < 512 ? cidx * 64 : ML + (cidx - 512) * 64;
        {
            const int pos = dir ? 63 - lane : lane;
            float x = gb[((size_t)dir * MT + row0 + pos) * 8 + h]; const float be = bb[((size_t)dir * MT + row0 + pos) * 8 + h];
#pragma unroll
            for (int o = 1; o < 64; o <<= 1) { const float y = __shfl_up(x, o); if (lane >= o) x += y; }
            const float total = __shfl(x, 63);
            vec[pos] = x; vec[64 + pos] = be;
            float* av = AV + ((size_t)item * 2 + dir) * 256;
            av[pos] = __expf(x); av[64 + pos] = be; av[128 + pos] = __expf(total - x); if (lane == 0) av[192] = __expf(total);
        }
        __syncthreads();
        bf16_t* tq = TQ + ((size_t)item * 2 + dir) * 8192;
        bf16x8 KF[4][4];
#pragma unroll
        for (int t = 0; t < 4; ++t)
#pragma unroll
            for (int ks = 0; ks < 4; ++ks) KF[t][ks] = ld_b128(kl + (16 * t + fr) * 256 + (((4 * ks + g) ^ fr) << 4));
        {
            bf16x8 QF[4][4];
#pragma unroll
            for (int t = 0; t < 4; ++t)
#pragma unroll
                for (int ks = 0; ks < 4; ++ks) QF[t][ks] = ld_b128(kl + 16384 + (16 * t + fr) * 256 + (((4 * ks + g) ^ fr) << 4));
#pragma unroll
            for (int rt = 0; rt < 4; ++rt)
#pragma unroll
                for (int ct = 0; ct < 4; ++ct) { f32x4 acc = {0.f, 0.f, 0.f, 0.f};
#pragma unroll
                    for (int ks = 0; ks < 4; ++ks) acc = MFMA16(KF[rt][ks], QF[ct][ks], acc);
                    float o[4]; const f32x4 gxv = *(const LAS f32x4*)(vec + 16 * rt + 4 * g); const float gyv = vec[16 * ct + fr];
#pragma unroll
                    for (int r = 0; r < 4; ++r) { const int x = 16 * rt + 4 * g + r, y = 16 * ct + fr; const bool inc = dir ? (y <= x) : (y >= x);
                        o[r] = inc ? acc[r] * __expf(gyv - gxv[r]) : 0.f; }
                    const u32x2 w = {pk2(o[0], o[1]), pk2(o[2], o[3])};
                    *(u32x2*)(tq + 4096 + (16 * ct + fr) * 64 + 16 * rt + 4 * g) = w; }
        }
        f32x4 PT[4][4]; bf16x8 XD[2][4], XT[2][4];
#pragma unroll
        for (int ct = 0; ct < 4; ++ct)
#pragma unroll
            for (int s2 = 0; s2 < 2; ++s2) { f32x4 nd[2], nt[2];
#pragma unroll
                for (int u = 0; u < 2; ++u) { const int rt = 2 * s2 + u; f32x4 acc = {0.f, 0.f, 0.f, 0.f};
#pragma unroll
                    for (int ks = 0; ks < 4; ++ks) acc = MFMA16(KF[rt][ks], KF[ct][ks], acc);
                    const f32x4 gxv = *(const LAS f32x4*)(vec + 16 * rt + 4 * g), bxv = *(const LAS f32x4*)(vec + 64 + 16 * rt + 4 * g); const float gyv = vec[16 * ct + fr], byv = vec[64 + 16 * ct + fr];
#pragma unroll
                    for (int r = 0; r < 4; ++r) { const int x = 16 * rt + 4 * g + r, y = 16 * ct + fr;
                        const bool cd = dir ? (x < y) : (x > y), ct_ = dir ? (y < x) : (y > x);
                        nd[u][r] = cd ? -bxv[r] * acc[r] * __expf(gxv[r] - gyv) : 0.f;
                        nt[u][r] = ct_ ? -byv * acc[r] * __expf(gyv - gxv[r]) : 0.f; }
                    PT[rt][ct] = nt[u]; }
                XD[s2][ct] = pack_frag(nd[0], nd[1]); XT[s2][ct] = pack_frag(nt[0], nt[1]); }
#pragma unroll 1
        for (int it = 0; it < 5; ++it) {
            bf16x8 XD2[2][4], XT2[2][4];
#pragma unroll
            for (int ct = 0; ct < 4; ++ct)
#pragma unroll
                for (int s2 = 0; s2 < 2; ++s2) { f32x4 t2[2];
#pragma unroll
                    for (int u = 0; u < 2; ++u) { const int rt = 2 * s2 + u; f32x4 acc = {0.f, 0.f, 0.f, 0.f};
                        acc = MFMA16(XT[0][rt], XD[0][ct], acc); acc = MFMA16(XT[1][rt], XD[1][ct], acc); t2[u] = acc; }
                    XD2[s2][ct] = pack_frag(t2[0], t2[1]); }
#pragma unroll
            for (int ct = 0; ct < 4; ++ct) { const bf16x8 pb0 = pack_frag(PT[0][ct], PT[1][ct]), pb1 = pack_frag(PT[2][ct], PT[3][ct]);
#pragma unroll
                for (int rt = 0; rt < 4; ++rt) { f32x4 acc = PT[rt][ct]; acc = MFMA16(XD2[0][rt], pb0, acc); acc = MFMA16(XD2[1][rt], pb1, acc); PT[rt][ct] = acc; } }
#pragma unroll
            for (int ct = 0; ct < 4; ++ct)
#pragma unroll
                for (int s2 = 0; s2 < 2; ++s2) { f32x4 t2[2];
#pragma unroll
                    for (int u = 0; u < 2; ++u) { const int rt = 2 * s2 + u; f32x4 acc = {0.f, 0.f, 0.f, 0.f};
                        acc = MFMA16(XD[0][rt], XT[0][ct], acc); acc = MFMA16(XD[1][rt], XT[1][ct], acc); t2[u] = acc; PT[rt][ct] += acc; }
                    XT2[s2][ct] = pack_frag(t2[0], t2[1]); }
#pragma unroll
            for (int s2 = 0; s2 < 2; ++s2)
#pragma unroll
                for (int ct = 0; ct < 4; ++ct) { XD[s2][ct] = XD2[s2][ct]; XT[s2][ct] = XT2[s2][ct]; }
        }
#pragma unroll
        for (int rt = 0; rt < 4; ++rt)
#pragma unroll
            for (int ct = 0; ct < 4; ++ct) { const u32x2 w = {pk2(PT[rt][ct][0], PT[rt][ct][1]), pk2(PT[rt][ct][2], PT[rt][ct][3])};
                *(u32x2*)(tq + (16 * ct + fr) * 64 + 16 * rt + 4 * g) = w; }
        __syncthreads();
    }
}

DEVI void phase_dnscan2(const KA& a, LAS unsigned char* lds, int tid, int lane, int wave, unsigned long long& pr_extra) {
    const int v = blockIdx.x;
    unsigned char* ws = a.ws();
    const bf16_t* QP = (const bf16_t*)(ws + WS_QKVP); const bf16_t* TQ = (const bf16_t*)(ws + WS_TQ); const float* AV = (const float*)(ws + WS_AVEC);
    unsigned* prog = (unsigned*)(ws + CTL_PROG);
    constexpr int NSTEP = 260;
    int vrole = v;
#if MK_ONE_LAUNCH
    {
        unsigned* bar_ = (unsigned*)(ws + WS_CTL); unsigned* xr_ = (unsigned*)(ws + CTL_XRANK);
        bool dyn = gridDim.x == 256;
#pragma unroll
        for (int j = 0; j < 16; ++j) { const unsigned c_ = __hip_atomic_load(&bar_[256 + 64 * j], __ATOMIC_RELAXED, __HIP_MEMORY_SCOPE_AGENT); dyn = dyn && (c_ == (j < 8 ? 32u : 0u)); }
        if (PROBE_SUB == 7 && !dyn) pr_extra += 50000ull;
        if (dyn) {
            const unsigned xcc = (unsigned)__builtin_amdgcn_s_getreg((3 << 11) | 20) & 0xFu;
            LAS unsigned* bw = (LAS unsigned*)(lds + 147200);
            if (tid == 0) *bw = __hip_atomic_fetch_add(&xr_[xcc * 64], 1u, __ATOMIC_RELAXED, __HIP_MEMORY_SCOPE_AGENT);
            __syncthreads();
            const unsigned rank = *bw & 31u;
            vrole = rank < 16u ? (int)(xcc + 8u * (rank >> 2) + 32u * (rank & 3u)) : (int)(128u + xcc + 8u * ((rank - 16u) >> 2) + 32u * ((rank - 16u) & 3u));
            __syncthreads();
        }
    }
#endif
    if (vrole < 128) {
    const int chain = (vrole & 7) + 8 * ((vrole >> 3) & 3), qt = vrole >> 5, dir = chain >> 4, b = (chain >> 3) & 1, h = chain & 7;
    bf16_t* O = (bf16_t*)a.out() + (size_t)dir * ML * 1024;
    constexpr int KL = 0, QL = 16384, TL = 32768, DL = 40960, VL = 49152, AL = 53248, BUFB = 54272, OT = 2 * BUFB, SBX = OT + 8192, XBX = SBX + 16384, FLG = XBX + 4096;
    const int fr0 = lane & 15, g0 = lane >> 4, ltid = tid - 256;
    auto step_cidx = [&](int s) -> int { if (s < 4) return 512 + b * 4 + (dir ? 3 - s : s); const int c = s - 4; return b * 256 + (dir ? 255 - c : c); };
    struct LSet { u32x4 q[4], k[4], t[2], d[2], v, av; };
#define LD_ISSUE(R, s_) do { const int cidx_ = step_cidx(s_); const int row0_ = cidx_ < 512 ? cidx_ * 64 : ML + (cidx_ - 512) * 64; \
        const bf16_t* tqb_ = TQ + ((size_t)(cidx_ * 8 + h) * 2 + dir) * 8192; const float* avb_ = AV + ((size_t)(cidx_ * 8 + h) * 2 + dir) * 256; \
        int lt_ = ltid; asm volatile("" : "+v"(lt_)); \
        const bf16_t* pq_ = QP + (size_t)(row0_ + (lt_ >> 4)) * 3072 + h * 128 + (lt_ & 15) * 8; \
        const bf16_t* pt_ = tqb_ + (lt_ >> 3) * 64 + (lt_ & 7) * 8; \
        _Pragma("unroll") for (int i = 0; i < 4; ++i) { R.q[i] = *(const u32x4*)(pq_ + (size_t)i * 16 * 3072); R.k[i] = *(const u32x4*)(pq_ + (size_t)i * 16 * 3072 + 1024); } \
        _Pragma("unroll") for (int i = 0; i < 2; ++i) { R.t[i] = *(const u32x4*)(pt_ + i * 32 * 64); R.d[i] = *(const u32x4*)(pt_ + 4096 + i * 32 * 64); } \
        R.v = *(const u32x4*)(QP + (size_t)(row0_ + (lt_ >> 2)) * 3072 + 2048 + h * 128 + qt * 32 + (lt_ & 3) * 8); \
        R.av = *(const u32x4*)(avb_ + (lt_ & 63) * 4); } while (0)
#define LD_WRITE(R, bo_) do { int lt_ = ltid; asm volatile("" : "+v"(lt_)); LAS unsigned char* B_ = lds + (bo_); \
        const int chq_ = lt_ & 15, cht_ = lt_ & 7; \
        _Pragma("unroll") for (int i = 0; i < 4; ++i) { const int r = (lt_ >> 4) + 16 * i; const int o_ = r * 256 + ((chq_ ^ (4 * (r & 3) + ((r >> 3) & 3))) << 4); \
            *(LAS u32x4*)(B_ + QL + o_) = R.q[i]; *(LAS u32x4*)(B_ + KL + o_) = R.k[i]; } \
        _Pragma("unroll") for (int i = 0; i < 2; ++i) { const int r = (lt_ >> 3) + 32 * i; const int o_ = r * 128 + ((cht_ ^ (2 * ((r >> 3) & 3) + ((r >> 1) & 1))) << 4); \
            *(LAS u32x4*)(B_ + TL + o_) = R.t[i]; *(LAS u32x4*)(B_ + DL + o_) = R.d[i]; } \
        { const int r = lt_ >> 2; *(LAS u32x4*)(B_ + VL + r * 64 + (((lt_ & 3) ^ (2 * ((r >> 3) & 1))) << 4)) = R.v; } \
        if (lt_ < 64) *(LAS u32x4*)(B_ + AL + lt_ * 16) = R.av; } while (0)
#define OT_OUT(s_) do { const int cidx_ = step_cidx(s_); const int row0_ = cidx_ * 64; LAS const unsigned char* ot_ = lds + OT + ((s_) & 1) * 4096; \
        int lt_ = ltid; asm volatile("" : "+v"(lt_)); \
        { const int r = lt_ >> 2, ch = lt_ & 3; \
            *(u32x4*)(O + (size_t)(row0_ + r) * 1024 + h * 128 + qt * 32 + ch * 8) = *(LAS const u32x4*)(ot_ + r * 64 + ((ch ^ (2 * ((r >> 3) & 1))) << 4)); } } while (0)
#define STEP_BAR(wsel) do { const unsigned long long tb_ = PROBE_SUB ? __builtin_amdgcn_s_memrealtime() : 0ull; \
        asm volatile("s_waitcnt lgkmcnt(0)" ::: "memory"); __builtin_amdgcn_s_barrier(); asm volatile("" ::: "memory"); \
        if ((PROBE_SUB == 1 && wave == 0 && (wsel) == 0) || (PROBE_SUB == 2 && wave == 4 && (wsel) == 1) || (PROBE_SUB == 3 && wave == 2 && (wsel) == 3)) pr_extra += __builtin_amdgcn_s_memrealtime() - tb_; } while (0)
#define LOAD_STEP(s, RW) do { STEP_BAR(1); \
            if (qt == 0 && ltid == 0) __hip_atomic_store(prog + chain * 64, (unsigned)((s) + 1), __ATOMIC_RELAXED, __HIP_MEMORY_SCOPE_AGENT); \
            { const unsigned long long tw_ = (PROBE_SUB == 5) ? __builtin_amdgcn_s_memrealtime() : 0ull; if ((s) + 1 < NSTEP) LD_WRITE(RW, (((s) + 1) & 1) * BUFB); \
              if (PROBE_SUB == 5 && wave == 4) { asm volatile("s_waitcnt lgkmcnt(0)" ::: "memory"); pr_extra += __builtin_amdgcn_s_memrealtime() - tw_; } } \
            if ((s) + 4 < NSTEP) LD_ISSUE(RW, (s) + 4); \
            if ((s) >= 5) OT_OUT((s) - 1); } while (0)
#define SBAR_() do {} while (0)
#define ROWK(pt) ((32 * ((pt) >> 1) + 4 * ((pt) & 1) + rowl) * 256)
#define ROWT(pt) ((32 * ((pt) >> 1) + 4 * ((pt) & 1) + rowl) * 128)
#define P0(pt) (32 * ((pt) >> 1) + 8 * g + 4 * ((pt) & 1))
#define LDK8(dst, base, pa) do { _Pragma("unroll") for (int s4 = 0; s4 < 4; ++s4) { dst[s4] = ld_b128(B + (base) + ROWK(pa) + (((4 * s4 + g) ^ fk) << 4)); dst[4 + s4] = ld_b128(B + (base) + ROWK((pa) + 1) + (((4 * s4 + g) ^ fk) << 4)); } } while (0)
#define LDT8(dst, base) do { _Pragma("unroll") for (int pt = 0; pt < 4; ++pt) { dst[2 * pt] = ld_b128(B + (base) + ROWT(pt) + ((g ^ ft) << 4)); dst[2 * pt + 1] = ld_b128(B + (base) + ROWT(pt) + (((4 + g) ^ ft) << 4)); } } while (0)
#define MM8(acc, fa, pa) do { _Pragma("unroll") for (int s4 = 0; s4 < 4; ++s4) { acc[pa] = MFMA16(fa[s4], Sb[s4], acc[pa]); acc[(pa) + 1] = MFMA16(fa[4 + s4], Sb[s4], acc[(pa) + 1]); } } while (0)
    if (wave >= 4) {
        LSet R0, R1, R2;
        LD_ISSUE(R0, 0); LD_WRITE(R0, 0); LD_ISSUE(R1, 1); LD_ISSUE(R2, 2); LD_ISSUE(R0, 3);
#pragma unroll 1
        for (int s0 = 0; s0 < NSTEP; s0 += 3) {
            LOAD_STEP(s0, R1);
            if (s0 + 1 < NSTEP) LOAD_STEP(s0 + 1, R2);
            if (s0 + 2 < NSTEP) LOAD_STEP(s0 + 2, R0);
        }
        STEP_BAR(2);
        OT_OUT(NSTEP - 1);
    } else if (wave < 2) {
        f32x4 S[8];
#pragma unroll
        for (int i = 0; i < 8; ++i) S[i] = (f32x4){0.f, 0.f, 0.f, 0.f};
        bf16x8 Sb[4];
#pragma unroll
        for (int s4 = 0; s4 < 4; ++s4) { Sb[s4] = (bf16x8){0, 0, 0, 0, 0, 0, 0, 0}; *(LAS bf16x8*)(lds + SBX + wave * 4096 + s4 * 1024 + lane * 16) = Sb[s4]; }
        if (lane == 0) *(LAS unsigned*)(lds + FLG + wave * 4) = 0u;
#pragma unroll 1
        for (int s = 0; s < NSTEP; ++s) {
            STEP_BAR(0);
            int fr = fr0, g = g0; asm volatile("" : "+v"(fr), "+v"(g));
            LAS const unsigned char* B = lds + (s & 1) * BUFB;
            const LAS float* avl = (const LAS float*)(B + AL);
            const int rowl = 8 * (fr >> 2) + (fr & 3);
            const int fk = 4 * (fr & 3) + (fr >> 2), ft = 2 * (fr >> 2) + ((fr >> 1) & 1);
            const int vcol = ((((2 * wave + (fr >> 3)) ^ (2 * (g & 1))) << 4) + (fr & 7) * 2);
            const int trq = fr >> 2, trp = fr & 3;
            LAS unsigned char* kp0 = (LAS unsigned char*)(B + KL + (8 * g + trq) * 256);
            const int fkt = 4 * trq + g;
#define KT_LOAD(dst, d0) do { _Pragma("unroll") for (int j = 0; j < 4; ++j) { const int dt_ = (d0) + j; const int co = (((4 * (dt_ >> 1) + trp) ^ fkt) << 4) + 8 * (dt_ & 1); \
                const s16x4 a0 = __builtin_bit_cast(s16x4, __builtin_amdgcn_ds_read_tr16_b64_v4i16((LAS s16x4*)(kp0 + co))), a1 = __builtin_bit_cast(s16x4, __builtin_amdgcn_ds_read_tr16_b64_v4i16((LAS s16x4*)(kp0 + co + 4 * 256))); \
                const s16x4 a2 = __builtin_bit_cast(s16x4, __builtin_amdgcn_ds_read_tr16_b64_v4i16((LAS s16x4*)(kp0 + co + 32 * 256))), a3 = __builtin_bit_cast(s16x4, __builtin_amdgcn_ds_read_tr16_b64_v4i16((LAS s16x4*)(kp0 + co + 36 * 256))); \
                dst[2 * j] = (bf16x8){a0[0], a0[1], a0[2], a0[3], a1[0], a1[1], a1[2], a1[3]}; dst[2 * j + 1] = (bf16x8){a2[0], a2[1], a2[2], a2[3], a3[0], a3[1], a3[2], a3[3]}; } } while (0)
            bf16x8 fA[8], fB[8], fC[8];
            f32x4 avp[4], bvp[4]; unsigned short vraw[4][4];
            const unsigned long long t6_ = (PROBE_SUB == 6) ? __builtin_amdgcn_s_memrealtime() : 0ull;
            LDK8(fA, KL, 0); LDK8(fB, KL, 2);
            if (PROBE_SUB == 6 && wave == 0) { asm volatile("s_waitcnt lgkmcnt(0)" ::: "memory"); pr_extra += __builtin_amdgcn_s_memrealtime() - t6_; }
#pragma unroll
            for (int pt = 0; pt < 4; ++pt) { avp[pt] = *(const LAS f32x4*)(avl + P0(pt)); bvp[pt] = *(const LAS f32x4*)(avl + 64 + P0(pt));
#pragma unroll
                for (int r = 0; r < 4; ++r) vraw[pt][r] = *(const LAS unsigned short*)(B + VL + (P0(pt) + r) * 64 + vcol); }
            f32x4 Z[4], X[4];
#pragma unroll
            for (int pt = 0; pt < 4; ++pt) Z[pt] = (f32x4){0.f, 0.f, 0.f, 0.f};
            SBAR_();
            LDT8(fC, TL); SBAR_(); MM8(Z, fA, 0); SBAR_();
            KT_LOAD(fA, 0); SBAR_(); MM8(Z, fB, 2); SBAR_();
#pragma unroll
            for (int pt = 0; pt < 4; ++pt)
#pragma unroll
                for (int r = 0; r < 4; ++r) Z[pt][r] = bvp[pt][r] * (bf2f(vraw[pt][r]) - avp[pt][r] * Z[pt][r]);
            KT_LOAD(fB, 4); SBAR_();
            { const bf16x8 Zb0 = pack_frag(Z[0], Z[1]), Zb1 = pack_frag(Z[2], Z[3]);
#pragma unroll
              for (int pt = 0; pt < 4; ++pt) { X[pt] = MFMA16(fC[2 * pt], Zb0, Z[pt]); X[pt] = MFMA16(fC[2 * pt + 1], Zb1, X[pt]); } }
            SBAR_();
            const float egl = avl[192];
            bf16x8 Xc0, Xc1;
            { const bf16x8 Xb0 = pack_frag(X[0], X[1]), Xb1 = pack_frag(X[2], X[3]);
              *(LAS bf16x8*)(lds + XBX + wave * 2048 + lane * 16) = Xb0; *(LAS bf16x8*)(lds + XBX + wave * 2048 + 1024 + lane * 16) = Xb1;
              if (lane == 0) *(LAS volatile unsigned*)(lds + FLG + wave * 4) = (unsigned)(s + 1);
              f32x4 cx[4];
#pragma unroll
              for (int pt = 0; pt < 4; ++pt) cx[pt] = X[pt] * *(const LAS f32x4*)(avl + 128 + P0(pt));
              Xc0 = pack_frag(cx[0], cx[1]); Xc1 = pack_frag(cx[2], cx[3]); }
            SBAR_();
#pragma unroll
            for (int j = 0; j < 4; ++j) { f32x4 sn = S[j] * egl; sn = MFMA16(fA[2 * j], Xc0, sn); S[j] = MFMA16(fA[2 * j + 1], Xc1, sn); }
            SBAR_();
#pragma unroll
            for (int j = 0; j < 4; ++j) { f32x4 sn = S[4 + j] * egl; sn = MFMA16(fB[2 * j], Xc0, sn); S[4 + j] = MFMA16(fB[2 * j + 1], Xc1, sn); }
#pragma unroll
            for (int s4 = 0; s4 < 4; ++s4) { Sb[s4] = pack_frag(S[2 * s4], S[2 * s4 + 1]); *(LAS bf16x8*)(lds + SBX + ((s + 1) & 1) * 8192 + wave * 4096 + s4 * 1024 + lane * 16) = Sb[s4]; }
#undef KT_LOAD
        }
        STEP_BAR(2);
    } else {
        const int sl = wave - 2;
#pragma unroll 1
        for (int s = 0; s < NSTEP; ++s) {
            STEP_BAR(3);
            if (s >= 4) {
            int fr = fr0, g = g0; asm volatile("" : "+v"(fr), "+v"(g));
            LAS const unsigned char* B = lds + (s & 1) * BUFB;
            const LAS float* avl = (const LAS float*)(B + AL);
            const int rowl = 8 * (fr >> 2) + (fr & 3);
            const int fk = 4 * (fr & 3) + (fr >> 2), ft = 2 * (fr >> 2) + ((fr >> 1) & 1);
            const int vcol = ((((2 * sl + (fr >> 3)) ^ (2 * (g & 1))) << 4) + (fr & 7) * 2);
            bf16x8 fA[8], fB[8], fC[8], Sb[4];
            LDK8(fA, QL, 0); LDK8(fB, QL, 2);
#pragma unroll
            for (int s4 = 0; s4 < 4; ++s4) Sb[s4] = *(const LAS bf16x8*)(lds + SBX + (s & 1) * 8192 + sl * 4096 + s4 * 1024 + lane * 16);
            f32x4 OQ[4], avp[4];
#pragma unroll
            for (int pt = 0; pt < 4; ++pt) { OQ[pt] = (f32x4){0.f, 0.f, 0.f, 0.f}; avp[pt] = *(const LAS f32x4*)(avl + P0(pt)); }
            SBAR_();
            LDT8(fC, DL); SBAR_(); MM8(OQ, fA, 0); SBAR_(); MM8(OQ, fB, 2); SBAR_();
            { unsigned spins = 0;
              while ((unsigned)__builtin_amdgcn_readfirstlane((int)*(LAS volatile unsigned*)(lds + FLG + sl * 4)) != (unsigned)(s + 1)) { __builtin_amdgcn_s_sleep(1); if (++spins > (1u << 22)) break; } }
            asm volatile("" ::: "memory");
            const bf16x8 Xb0 = *(const LAS bf16x8*)(lds + XBX + sl * 2048 + lane * 16), Xb1 = *(const LAS bf16x8*)(lds + XBX + sl * 2048 + 1024 + lane * 16);
#pragma unroll
            for (int pt = 0; pt < 4; ++pt) { f32x4 o2 = OQ[pt] * avp[pt]; o2 = MFMA16(fC[2 * pt], Xb0, o2); OQ[pt] = MFMA16(fC[2 * pt + 1], Xb1, o2); }
            { LAS unsigned char* ot = lds + OT + (s & 1) * 4096;
#pragma unroll
              for (int pt = 0; pt < 4; ++pt)
#pragma unroll
                  for (int r = 0; r < 4; ++r) *(LAS unsigned short*)(ot + (P0(pt) + r) * 64 + vcol) = (unsigned short)f2bf(OQ[pt][r]); }
            }
        }
        STEP_BAR(2);
    }
#undef LDK8
#undef LDT8
#undef MM8
#undef ROWK
#undef ROWT
#undef P0
#undef SBAR_
#undef LOAD_STEP
#undef STEP_BAR
#undef LD_ISSUE
#undef LD_WRITE
#undef OT_OUT
    } else {
        const int vp = vrole - 128, chain = (vp & 7) + 8 * ((vp >> 3) & 3), role = vp >> 5, dir = chain >> 4, b = (chain >> 3) & 1, h = chain & 7;
        const int nteam = (((int)gridDim.x - 128) >> 5) * 8;
        constexpr int PFD2 = 6;
        if (role * 8 + wave < nteam) {
#pragma unroll 1
        for (int st = role * 8 + wave; st < NSTEP; st += nteam) {
            unsigned spins = 0;
            while ((int)__builtin_amdgcn_readfirstlane((int)__hip_atomic_load(prog + chain * 64, __ATOMIC_RELAXED, __HIP_MEMORY_SCOPE_AGENT)) + PFD2 < st) { __builtin_amdgcn_s_sleep(8); if (++spins > (1u << 20)) break; }
            int cidx; if (st < 4) cidx = 512 + b * 4 + (dir ? 3 - st : st); else { const int c = st - 4; cidx = b * 256 + (dir ? 255 - c : c); }
            const int row0 = cidx < 512 ? cidx * 64 : ML + (cidx - 512) * 64;
            const char* tqb = (const char*)(TQ + ((size_t)(cidx * 8 + h) * 2 + dir) * 8192); const char* avb = (const char*)(AV + ((size_t)(cidx * 8 + h) * 2 + dir) * 256);
            unsigned acc = 0;
#pragma unroll
            for (int j = 0; j < 9; ++j) { const int L = j * 64 + lane; const char* p_;
                if (L < 384) { const int rw = L / 6, part = L - rw * 6; p_ = (const char*)(QP + (size_t)(row0 + rw) * 3072 + h * 128) + (part >> 1) * 2048 + (part & 1) * 128; }
                else if (L < 512) p_ = tqb + (L - 384) * 128; else p_ = avb + ((L - 512) & 7) * 128;
                acc ^= *(const unsigned*)p_; }
            asm volatile("" :: "v"(acc));
        }
        }
    }
}

DEVI void phase_prep2(const KA& a, int lane, int wave) {
    unsigned char* ws = a.ws();
    bf16_t* KAT = (bf16_t*)(ws + WS_KAT); const float* rope = (const float*)(ws + SM_ROPE); const float* knw = a.in(14);
    const int gw = blockIdx.x * 8 + wave, NGW = gridDim.x * 8;
    for (int row = gw; row < MT; row += NGW) {
        bf16_t* p = KAT + (size_t)row * 256 + lane * 4;
        const u32x2 w = *(const u32x2*)p;
        float x[4] = {bflo(w.x), bfhi(w.x), bflo(w.y), bfhi(w.y)};
        float ss = (x[0] * x[0] + x[1] * x[1]) + (x[2] * x[2] + x[3] * x[3]);
        ss += __shfl_xor(ss, 1); ss += __shfl_xor(ss, 2); ss += __shfl_xor(ss, 4); ss += __shfl_xor(ss, 8); ss += __shfl_xor(ss, 16);
        const float rs = rsqrtf(ss * (1.f / 128.f) + EPS);
        const int d = (lane & 31) * 4;
        const f32x4 nw = *(const f32x4*)(knw + d);
#pragma unroll
        for (int i = 0; i < 4; ++i) x[i] = x[i] * rs * nw[i];
        float pr[4];
#pragma unroll
        for (int i = 0; i < 4; ++i) pr[i] = __shfl_xor(x[i], 8);
        if (row < ML) {
            const int t = row & (SEQ - 1), lg = (lane & 31) >> 3, fi = (lane & 7) * 4;
            const float* ct = lg < 2 ? rope + (t >> 6) * 32 + fi : rope + 16384 + (t & 63) * 32 + fi;
            const float* st = lg < 2 ? ct + 8192 : ct + 2048;
            const f32x4 c = *(const f32x4*)ct, s = *(const f32x4*)st;
            const float sg = (lg & 1) ? 1.f : -1.f;
#pragma unroll
            for (int i = 0; i < 4; ++i) x[i] = x[i] * c[i] + sg * pr[i] * s[i];
        }
        u32x2 o; o.x = pk2(x[0], x[1]); o.y = pk2(x[2], x[3]);
        *(u32x2*)p = o;
    }
    const bf16_t* Of = (const bf16_t*)a.out(); const bf16_t* Ob = Of + (size_t)ML * 1024;
    const bf16_t* GT = (const bf16_t*)(ws + WS_GT); bf16_t* Y = (bf16_t*)(ws + WS_Y); const float* dnw = a.in(12);
    for (int row = gw; row < ML; row += NGW) {
        const int c0 = lane * 16;
        float o[16];
#pragma unroll
        for (int hh = 0; hh < 2; ++hh) {
            const u32x4 f = *(const u32x4*)(Of + (size_t)row * 1024 + c0 + hh * 8), bk = *(const u32x4*)(Ob + (size_t)row * 1024 + c0 + hh * 8);
#pragma unroll
            for (int i = 0; i < 4; ++i) { o[hh * 8 + 2 * i] = bflo(f[i]) + bflo(bk[i]); o[hh * 8 + 2 * i + 1] = bfhi(f[i]) + bfhi(bk[i]); }
        }
        float ss = 0.f;
#pragma unroll
        for (int i = 0; i < 16; ++i) ss += o[i] * o[i];
        ss += __shfl_xor(ss, 1); ss += __shfl_xor(ss, 2); ss += __shfl_xor(ss, 4);
        const float rs = rsqrtf(ss * (1.f / 128.f) + EPS);
        const int d0 = c0 & 127;
#pragma unroll
        for (int hh = 0; hh < 2; ++hh) {
            const u32x4 gt = *(const u32x4*)(GT + (size_t)row * 1024 + c0 + hh * 8);
            float y[8];
#pragma unroll
            for (int i = 0; i < 4; ++i) {
                y[2 * i] = o[hh * 8 + 2 * i] * rs * dnw[d0 + hh * 8 + 2 * i] * siluf(bflo(gt[i]));
                y[2 * i + 1] = o[hh * 8 + 2 * i + 1] * rs * dnw[d0 + hh * 8 + 2 * i + 1] * siluf(bfhi(gt[i]));
            }
            u32x4 w; w.x = pk2(y[0], y[1]); w.y = pk2(y[2], y[3]); w.z = pk2(y[4], y[5]); w.w = pk2(y[6], y[7]);
            *(u32x4*)(Y + (size_t)row * 2048 + c0 + hh * 8) = w;
        }
    }
}

namespace att {
constexpr int D = 128, NW = 8, QBLK = 32, KVBLK = 64;
constexpr float SCALE = 0.088388347648318440f;
constexpr float THR = 8.f;
constexpr int LDK = 256;
constexpr size_t SHM_V = KVBLK * D * 2, SHM_K = KVBLK * D * 2;
constexpr size_t OFF_WS = 2 * SHM_V + 2 * SHM_K, OFF_OST = OFF_WS + NW * 64 * 4;
#define KSWZ(row, colB) ((row) * 256 + ((colB) ^ (((row) & 7) << 4)))
#define SBAR() __builtin_amdgcn_sched_barrier(0)
DEVI int crow(int r, int hi) { return (r & 3) + 8 * (r >> 2) + 4 * hi; }
DEVI unsigned cvtpk(float lo, float hi) { unsigned r; asm volatile("v_cvt_pk_bf16_f32 %0, %1, %2" : "=v"(r) : "v"(lo), "v"(hi)); return r; }
DEVI void partialSM(f32x16& p0, f32x16& p1, float& m_reg, float& mn, float& alpha) {
    constexpr float C = SCALE * 1.4426950408889634f;
    float pmax = p0[0];
#pragma unroll
    for (int r = 1; r < 16; ++r) pmax = fmaxf(pmax, p0[r]);
#pragma unroll
    for (int r = 0; r < 16; ++r) pmax = fmaxf(pmax, p1[r]);
    { auto rr = __builtin_amdgcn_permlane32_swap(__float_as_uint(pmax), __float_as_uint(pmax), false, false);
      pmax = fmaxf(__uint_as_float(rr[0]), __uint_as_float(rr[1])); }
    if (__builtin_expect(__all(pmax - m_reg <= THR / SCALE), 1)) { mn = m_reg; alpha = 1.f; }
    else { mn = fmaxf(m_reg, pmax); alpha = __builtin_amdgcn_exp2f((m_reg - mn) * C); m_reg = mn; }
    const float mnC = -mn * C;
#pragma unroll
    for (int r = 0; r < 16; ++r) p0[r] = fmaf(p0[r], C, mnC);
#pragma unroll
    for (int r = 0; r < 16; ++r) p1[r] = fmaf(p1[r], C, mnC);
#pragma unroll
    for (int r = 0; r < 16; ++r) p0[r] = __builtin_amdgcn_exp2f(p0[r]);
}
DEVI void finishSM(f32x16& p0, f32x16& p1, float alpha, float& l_reg, bf16x8& pa0, bf16x8& pa1, bf16x8& pa2, bf16x8& pa3) {
#pragma unroll
    for (int r = 0; r < 16; ++r) p1[r] = __builtin_amdgcn_exp2f(p1[r]);
    float ps = 0;
#pragma unroll
    for (int r = 0; r < 16; ++r) ps += p0[r];
#pragma unroll
    for (int r = 0; r < 16; ++r) ps += p1[r];
    { auto rr = __builtin_amdgcn_permlane32_swap(__float_as_uint(ps), __float_as_uint(ps), false, false);
      ps = __uint_as_float(rr[0]) + __uint_as_float(rr[1]); }
    l_reg = l_reg * alpha + ps;
#define PK4(P, BASE, OUT) do { unsigned a0 = cvtpk(P[BASE + 0], P[BASE + 1]), a1 = cvtpk(P[BASE + 2], P[BASE + 3]);   \
    unsigned b0 = cvtpk(P[BASE + 4], P[BASE + 5]), b1 = cvtpk(P[BASE + 6], P[BASE + 7]);                              \
    auto r0 = __builtin_amdgcn_permlane32_swap(a0, b0, false, false); auto r1 = __builtin_amdgcn_permlane32_swap(a1, b1, false, false); \
    u32x4 w = {r0[0], r1[0], r0[1], r1[1]}; OUT = *reinterpret_cast<bf16x8*>(&w); } while (0)
    PK4(p0, 0, pa0); PK4(p0, 8, pa1); PK4(p1, 0, pa2); PK4(p1, 8, pa3);
#undef PK4
}
DEVI void qkt(f32x16& p0, f32x16& p1, const char* Ks, const bf16x8* qr, int r32, int hi) {
    p0 = f32x16{}; p1 = f32x16{};
#pragma unroll
    for (int d0 = 0; d0 < 8; ++d0) { const int cb = (d0 * 16 + hi * 8) * 2;
        const bf16x8 b0 = *reinterpret_cast<const bf16x8*>(Ks + KSWZ(r32, cb));
        const bf16x8 b1 = *reinterpret_cast<const bf16x8*>(Ks + KSWZ(32 + r32, cb));
        p0 = __builtin_amdgcn_mfma_f32_32x32x16_bf16(b0, qr[d0], p0, 0, 0, 0);
        p1 = __builtin_amdgcn_mfma_f32_32x32x16_bf16(b1, qr[d0], p1, 0, 0, 0); }
}
DEVI int v_st(int k, int c) { const int kk = (k & ~0xC) | ((k & 4) << 1) | ((k & 8) >> 1); return ((kk >> 3) * 4 + (c >> 5)) * 512 + ((kk & 7) * 32 + (c & 31)) * 2; }
DEVI int v_rd_base(int lane) { return ((lane & 3) << 3) | (((lane >> 2) & 3) << 6) | (((lane >> 4) & 1) << 5) | (((lane >> 5) & 1) << 8); }
constexpr int v_rd_off(int d0, int ks, int half) { return d0 * 512 + ks * 4096 + half * 2048; }
template <int OFF> DEVI s16x4 tr_read(int vb) { s16x4 r; asm volatile("ds_read_b64_tr_b16 %0, %1 offset:%2" : "=&v"(r) : "v"(vb), "i"(OFF) : "memory"); return r; }
template <int D0> DEVI void pv_one(f32x16& od, int vb, bf16x8 pa0, bf16x8 pa1, bf16x8 pa2, bf16x8 pa3) {
    const s16x4 l0 = tr_read<v_rd_off(D0, 0, 0)>(vb), h0 = tr_read<v_rd_off(D0, 0, 1)>(vb), l1 = tr_read<v_rd_off(D0, 1, 0)>(vb), h1 = tr_read<v_rd_off(D0, 1, 1)>(vb);
    const s16x4 l2 = tr_read<v_rd_off(D0, 2, 0)>(vb), h2 = tr_read<v_rd_off(D0, 2, 1)>(vb), l3 = tr_read<v_rd_off(D0, 3, 0)>(vb), h3 = tr_read<v_rd_off(D0, 3, 1)>(vb);
    asm volatile("s_waitcnt lgkmcnt(0)" ::: "memory"); SBAR();
#define PK(L, H) (bf16x8){L[0], L[1], L[2], L[3], H[0], H[1], H[2], H[3]}
    od = __builtin_amdgcn_mfma_f32_32x32x16_bf16(pa0, PK(l0, h0), od, 0, 0, 0);
    od = __builtin_amdgcn_mfma_f32_32x32x16_bf16(pa1, PK(l1, h1), od, 0, 0, 0);
    od = __builtin_amdgcn_mfma_f32_32x32x16_bf16(pa2, PK(l2, h2), od, 0, 0, 0);
    od = __builtin_amdgcn_mfma_f32_32x32x16_bf16(pa3, PK(l3, h3), od, 0, 0, 0);
#undef PK
}
DEVI void pv_d0(f32x16* o, int vb, bf16x8 pa0, bf16x8 pa1, bf16x8 pa2, bf16x8 pa3) {
    pv_one<0>(o[0], vb, pa0, pa1, pa2, pa3); pv_one<1>(o[1], vb, pa0, pa1, pa2, pa3); pv_one<2>(o[2], vb, pa0, pa1, pa2, pa3); pv_one<3>(o[3], vb, pa0, pa1, pa2, pa3);
}
DEVI void wmask(f32x16& p0, f32x16& p1, int qp, int kt0, int hi) {
#pragma unroll
    for (int r = 0; r < 16; ++r) { const int kp = kt0 + crow(r, hi); const int d0 = qp - kp, d1 = d0 - 32;
        if (d0 > 128 || d0 < -128) p0[r] = -1e30f; if (d1 > 128 || d1 < -128) p1[r] = -1e30f; }
}
DEVI void attn_unit(const KA& a, int b, int h, int qb, char* lds) {
    unsigned char* ws = a.ws();
    const bf16_t* QAT = (const bf16_t*)(ws + WS_QAT); const bf16_t* KAT = (const bf16_t*)(ws + WS_KAT); const bf16_t* VAT = (const bf16_t*)(ws + WS_VAT);
    bf16_t* Y = (bf16_t*)(ws + WS_Y); const float* rope = (const float*)(ws + SM_ROPE);
    const int tid = threadIdx.x, wid = tid >> 6, lane = tid & 63, r32 = lane & 31, hi = lane >> 5;
    const int kvh = h >> 2, t0 = qb * 256;
    char* V_lds = lds; char* K_lds = lds + 2 * SHM_V;
    float* wsf = (float*)(lds + OFF_WS) + wid * 64; float* li_l = wsf; float* al_l = wsf + 32;
    float m_reg = -1e30f, l_reg = 0; f32x16 o[4] = {}; bf16x8 qr[8];
    const int qp = t0 + wid * QBLK + r32;
    {
        const bf16_t* Qw = QAT + (size_t)(b * SEQ + qp) * 1024 + h * 128 + hi * 8;
        u32x4 raw[8]; float ss = 0.f;
#pragma unroll
        for (int d0 = 0; d0 < 8; ++d0) { raw[d0] = *(const u32x4*)(Qw + d0 * 16);
#pragma unroll
            for (int i = 0; i < 4; ++i) { const float lo_ = bflo(raw[d0][i]), hi_ = bfhi(raw[d0][i]); ss += lo_ * lo_ + hi_ * hi_; } }
        { auto rr = __builtin_amdgcn_permlane32_swap(__float_as_uint(ss), __float_as_uint(ss), false, false); ss = __uint_as_float(rr[0]) + __uint_as_float(rr[1]); }
        const float rs = rsqrtf(ss * (1.f / 128.f) + EPS);
        const float* qnw = a.in(13);
#pragma unroll
        for (int half = 0; half < 2; ++half) {
            const float* ct = half == 0 ? rope + (qp >> 6) * 32 : rope + 16384 + (qp & 63) * 32;
            const float* st = half == 0 ? ct + 8192 : ct + 2048;
#pragma unroll
            for (int dd = 0; dd < 2; ++dd) {
                const int fi = dd * 16 + hi * 8, da = half * 4 + dd, db = da + 2;
                u32x4 oa, ob;
#pragma unroll
                for (int q4 = 0; q4 < 2; ++q4) {
                    const f32x4 c = *(const f32x4*)(ct + fi + 4 * q4), s = *(const f32x4*)(st + fi + 4 * q4);
                    const f32x4 wa = *(const f32x4*)(qnw + da * 16 + hi * 8 + 4 * q4), wb = *(const f32x4*)(qnw + db * 16 + hi * 8 + 4 * q4);
                    float ya[4], yb[4];
#pragma unroll
                    for (int j = 0; j < 4; ++j) {
                        const unsigned ra = raw[da][2 * q4 + (j >> 1)], rb = raw[db][2 * q4 + (j >> 1)];
                        const float x1 = ((j & 1) ? bfhi(ra) : bflo(ra)) * rs * wa[j], x2 = ((j & 1) ? bfhi(rb) : bflo(rb)) * rs * wb[j];
                        ya[j] = x1 * c[j] - x2 * s[j]; yb[j] = x2 * c[j] + x1 * s[j];
                    }
                    oa[2 * q4] = cvtpk(ya[0], ya[1]); oa[2 * q4 + 1] = cvtpk(ya[2], ya[3]); ob[2 * q4] = cvtpk(yb[0], yb[1]); ob[2 * q4 + 1] = cvtpk(yb[2], yb[3]);
                }
                qr[da] = *reinterpret_cast<bf16x8*>(&oa); qr[db] = *reinterpret_cast<bf16x8*>(&ob);
            }
        }
    }
    const int tk0 = t0 - 128 < 0 ? 0 : t0 - 128, tk1 = t0 + 384 > SEQ ? SEQ : t0 + 384;
    const int NT = 4 + (tk1 - tk0) / 64;
    const int ctxrow = ML + b * CTX, latrow = b * SEQ + tk0 - 256;
#define TROW(j) ((j) < 4 ? ctxrow + 64 * (j) : latrow + 64 * (j))
    const bf16_t* Kh = KAT + kvh * 128; const bf16_t* Vh = VAT + kvh * 128;
    const int sr = tid >> 4, sc = (tid & 15) * 8, vst0 = v_st(sr, sc), vst1 = v_st(32 + sr, sc);
    const int vb0 = (int)(uintptr_t)V_lds + v_rd_base(lane);
    struct { bf16x8 vs0, vs1, ks0, ks1; } sr_[1];
#define SLOAD(i, j) do { const int k0_ = TROW(j); sr_[i].vs0 = *(const bf16x8*)(Vh + (size_t)(k0_ + sr) * LDK + sc); sr_[i].vs1 = *(const bf16x8*)(Vh + (size_t)(k0_ + 32 + sr) * LDK + sc); \
    sr_[i].ks0 = *(const bf16x8*)(Kh + (size_t)(k0_ + sr) * LDK + sc); sr_[i].ks1 = *(const bf16x8*)(Kh + (size_t)(k0_ + 32 + sr) * LDK + sc); } while (0)
#define SWRITE(bf, i) do { *(bf16x8*)(V_lds + (bf) * SHM_V + vst0) = sr_[i].vs0; *(bf16x8*)(V_lds + (bf) * SHM_V + vst1) = sr_[i].vs1; const int kc = sc * 2; \
    *(bf16x8*)(K_lds + (bf) * SHM_K + KSWZ(sr, kc)) = sr_[i].ks0; *(bf16x8*)(K_lds + (bf) * SHM_K + KSWZ(32 + sr, kc)) = sr_[i].ks1; } while (0)
#define SWAIT() asm volatile("s_waitcnt vmcnt(0)" ::: "memory")
#define RESC(al) do { if (__any((al) < 1.f)) { if (hi == 0) al_l[r32] = (al); asm volatile("s_waitcnt lgkmcnt(0)" ::: "memory"); \
    _Pragma("unroll") for (int d = 0; d < 4; ++d) _Pragma("unroll") for (int r = 0; r < 16; ++r) o[d][r] *= al_l[crow(r, hi)]; } } while (0)
#define WMASK(P0, P1, j) do { if ((j) >= 4) wmask(P0, P1, qp, tk0 + 64 * ((j) - 4), hi); } while (0)
    f32x16 pA0, pA1, pB0, pB1; float mnA, mnB, alA, alB; bf16x8 pa0, pa1, pa2, pa3;
    constexpr int SE = 0, SO = 0;
    SLOAD(SE, 0); asm volatile("s_waitcnt vmcnt(0)" ::: "memory"); SWRITE(0, SE); __syncthreads();
    qkt(pA0, pA1, K_lds, qr, r32, hi); partialSM(pA0, pA1, m_reg, mnA, alA);
    SLOAD(SO, 1);
    SWAIT(); SWRITE(1, SO); __syncthreads();
    for (int j = 1; j + 1 < NT; j += 2) {
        SBAR(); qkt(pB0, pB1, K_lds + SHM_K, qr, r32, hi); WMASK(pB0, pB1, j);
        finishSM(pA0, pA1, alA, l_reg, pa0, pa1, pa2, pa3); SBAR();
        SLOAD(SO, j + 1); SBAR();
        pv_d0(o, vb0, pa0, pa1, pa2, pa3); partialSM(pB0, pB1, m_reg, mnB, alB);
        __syncthreads(); SWAIT(); SWRITE(0, SE);
        RESC(alB); __syncthreads();
        SBAR(); qkt(pA0, pA1, K_lds, qr, r32, hi); WMASK(pA0, pA1, j + 1);
        finishSM(pB0, pB1, alB, l_reg, pa0, pa1, pa2, pa3); SBAR();
        SLOAD(SE, j + 2); SBAR();
        pv_d0(o, vb0 + (int)SHM_V, pa0, pa1, pa2, pa3); partialSM(pA0, pA1, m_reg, mnA, alA);
        __syncthreads(); SWAIT(); SWRITE(1, SO);
        RESC(alA); __syncthreads();
    }
    SBAR(); qkt(pB0, pB1, K_lds + SHM_K, qr, r32, hi); WMASK(pB0, pB1, NT - 1);
    finishSM(pA0, pA1, alA, l_reg, pa0, pa1, pa2, pa3); SBAR();
    pv_d0(o, vb0, pa0, pa1, pa2, pa3); partialSM(pB0, pB1, m_reg, mnB, alB);
    __syncthreads(); RESC(alB);
    finishSM(pB0, pB1, alB, l_reg, pa0, pa1, pa2, pa3); SBAR();
    pv_d0(o, vb0 + (int)SHM_V, pa0, pa1, pa2, pa3);
    l_reg += __builtin_amdgcn_exp2f(a.in(15)[h] * 1.4426950408889634f - m_reg * (SCALE * 1.4426950408889634f));
    if (hi == 0) li_l[r32] = l_reg; asm volatile("s_waitcnt lgkmcnt(0)" ::: "memory");
    float rli[16];
#pragma unroll
    for (int r = 0; r < 16; ++r) rli[r] = __builtin_amdgcn_rcpf(li_l[crow(r, hi)]);
    {
        bf16_t* stg = (bf16_t*)(lds + OFF_OST) + wid * 4096;
#pragma unroll
        for (int r = 0; r < 16; ++r) { const int orow = crow(r, hi);
#pragma unroll
            for (int d0 = 0; d0 < 4; ++d0) stg[orow * 128 + d0 * 32 + r32] = (bf16_t)f2bf(o[d0][r] * rli[r]); }
        asm volatile("s_waitcnt lgkmcnt(0)" ::: "memory");
        bf16_t* Ow = Y + (size_t)(b * SEQ + t0 + wid * QBLK) * 2048 + 1024 + h * 128;
#pragma unroll
        for (int i = 0; i < 8; ++i) { const int row = i * 4 + (lane >> 4), ch = lane & 15; const u32x4 v = *(const u32x4*)(stg + row * 128 + ch * 8); *(u32x4*)(Ow + (size_t)row * 2048 + ch * 8) = v; }
    }
    __syncthreads();
#undef TROW
#undef SLOAD
#undef SWRITE
#undef SWAIT
#undef RESC
#undef WMASK
}
#undef KSWZ
#undef SBAR
}

DEVI u32x4 ldu_(const bf16_t* base, int rr) {
    const int rc = rr < 0 ? 0 : (rr >= SEQ ? SEQ - 1 : rr);
    const u32x4 v = *(const u32x4*)(base + (size_t)rc * NUP);
    const unsigned m = (rr == rc) ? 0xffffffffu : 0u;
    return (u32x4){v[0] & m, v[1] & m, v[2] & m, v[3] & m};
}
DEVI void phase_ffnconv(const KA& a, int b, int tid) {
    unsigned char* ws = a.ws();
    const bf16_t* U = (const bf16_t*)(ws + WS_U); bf16_t* ACT = (bf16_t*)(ws + WS_ACT) + (size_t)b * SEQ * DFF;
    const float* cw = a.in(20); const float* cb = a.in(21);
    if (tid < DFF / 8) {
        const int f0 = tid * 8, pn = f0 >> 7, j = f0 & 127, gc = 256 * pn + j, vc = gc + 128;
        float wg[3][8], wv[3][8], bg[8], bvv[8];
#pragma unroll
        for (int jt = 0; jt < 3; ++jt)
#pragma unroll
            for (int q = 0; q < 8; ++q) { wg[jt][q] = cw[jt * NUP + f0 + q]; wv[jt][q] = cw[jt * NUP + DFF + f0 + q]; }
#pragma unroll
        for (int q = 0; q < 8; ++q) { bg[q] = cb[f0 + q]; bvv[q] = cb[DFF + f0 + q]; }
        for (int it = blockIdx.x; it < SEQ / 32; it += gridDim.x) {
            const int r0 = it * 32;
            u32x4 gw_[3], vw_[3];
#define LDU(rr, c) ldu_(U + (c), (rr))
            gw_[0] = LDU(r0 - 1, gc); vw_[0] = LDU(r0 - 1, vc); gw_[1] = LDU(r0, gc); vw_[1] = LDU(r0, vc);
#pragma unroll 8
            for (int r = 0; r < 32; ++r) {
                gw_[2] = LDU(r0 + r + 1, gc); vw_[2] = LDU(r0 + r + 1, vc);
                float ug[8], uv[8];
#pragma unroll
                for (int q = 0; q < 8; ++q) { ug[q] = bg[q]; uv[q] = bvv[q]; }
#pragma unroll
                for (int jt = 0; jt < 3; ++jt)
#pragma unroll
                    for (int q = 0; q < 4; ++q) {
                        ug[2 * q] += bflo(gw_[jt][q]) * wg[jt][2 * q]; ug[2 * q + 1] += bfhi(gw_[jt][q]) * wg[jt][2 * q + 1];
                        uv[2 * q] += bflo(vw_[jt][q]) * wv[jt][2 * q]; uv[2 * q + 1] += bfhi(vw_[jt][q]) * wv[jt][2 * q + 1]; }
                u32x4 o;
                o.x = pk2(siluf(ug[0]) * uv[0], siluf(ug[1]) * uv[1]); o.y = pk2(siluf(ug[2]) * uv[2], siluf(ug[3]) * uv[3]);
                o.z = pk2(siluf(ug[4]) * uv[4], siluf(ug[5]) * uv[5]); o.w = pk2(siluf(ug[6]) * uv[6], siluf(ug[7]) * uv[7]);
                *(u32x4*)(ACT + (size_t)(r0 + r) * DFF + f0) = o;
                gw_[0] = gw_[1]; gw_[1] = gw_[2]; vw_[0] = vw_[1]; vw_[1] = vw_[2];
            }
#undef LDU
        }
    }
}

#define XB_TMO      128
#define XB_XCNT(j)  (256  + 64 * (j))
#define XB_XSUB(j)  (1280 + 64 * (j))
#define XB_XGEN(j)  (2304 + 64 * (j))
#define XB_TOP      3328
#define XB_TOPGEN   3392
#define XCD_BAR_WORDS 3456
#define XB_SPIN_CAP (1u << 18)
__device__ __forceinline__ unsigned xb_ld(unsigned* p)              { return __hip_atomic_load(p, __ATOMIC_RELAXED, __HIP_MEMORY_SCOPE_AGENT); }
__device__ __forceinline__ unsigned xb_add(unsigned* p, unsigned v) { return __hip_atomic_fetch_add(p, v, __ATOMIC_RELAXED, __HIP_MEMORY_SCOPE_AGENT); }
__device__ __forceinline__ unsigned xb_xcc_id() { return (unsigned)__builtin_amdgcn_s_getreg((3 << 11) | 20) & 0xFu; }
#define XB_SPIN(cond, bar) do { unsigned _sp = 0; while (cond) { __builtin_amdgcn_s_sleep(1); \
    if ((++_sp & 255u) == 0u) { if (xb_ld(&(bar)[XB_TMO])) break; if (_sp > XB_SPIN_CAP) { atomicAdd(&(bar)[XB_TMO], 1u); break; } } } } while (0)
struct XcdBarrier { unsigned* bar; unsigned x; volatile LAS unsigned* st; };
__device__ __forceinline__ XcdBarrier xcd_barrier_post(unsigned* bar, volatile LAS unsigned* st) {
    XcdBarrier b; b.bar = bar; b.x = xb_xcc_id(); b.st = st;
    if (threadIdx.x == 0) (void)xb_add(&bar[XB_XCNT(b.x)], 1u);
    return b;
}
__device__ __forceinline__ void xcd_barrier_complete(unsigned* bar, unsigned x, unsigned& nloc, unsigned& nx) {
    const unsigned G = gridDim.x * gridDim.y * gridDim.z;
    unsigned sum, cnt, mine, sp = 0u;
    for (;;) {
        sum = 0u; cnt = 0u; mine = 0u;
#pragma unroll
        for (unsigned j = 0; j < 16; ++j) { const unsigned c = xb_ld(&bar[XB_XCNT(j)]); sum += c; cnt += (c > 0u) ? 1u : 0u; mine = (j == x) ? c : mine; }
        if (sum == G) break;
        __builtin_amdgcn_s_sleep(1);
        if ((++sp & 255u) == 0u) { if (xb_ld(&bar[XB_TMO])) break; if (sp > XB_SPIN_CAP) { atomicAdd(&bar[XB_TMO], 1u); break; } }
    }
    nloc = mine > 0u ? mine : 1u; nx = cnt > 0u ? cnt : 1u;
}
__device__ __forceinline__ void xcd_barrier(const XcdBarrier& b) {
    asm volatile("s_waitcnt vmcnt(0)" ::: "memory");
    __syncthreads();
    if (threadIdx.x == 0) {
        unsigned* bar = b.bar;
        __builtin_amdgcn_s_waitcnt(0);
        unsigned nloc = b.st[0], nx = b.st[1];
        if (nloc == 0u) { xcd_barrier_complete(bar, b.x, nloc, nx); b.st[0] = nloc; b.st[1] = nx; }
        const unsigned old = xb_add(&bar[XB_XSUB(b.x)], 1u);
        const unsigned gen = old / nloc;
        if (old + 1u == (gen + 1u) * nloc) {
            __builtin_amdgcn_fence(__ATOMIC_RELEASE, "agent");
            asm volatile("s_waitcnt vmcnt(0)" ::: "memory");
            const unsigned og = xb_add(&bar[XB_TOP], 1u);
            const unsigned tg = og / nx;
            if (og + 1u == (tg + 1u) * nx) xb_add(&bar[XB_TOPGEN], 1u);
            else XB_SPIN(xb_ld(&bar[XB_TOPGEN]) == tg, bar);
            __builtin_amdgcn_fence(__ATOMIC_ACQUIRE, "agent");
            xb_add(&bar[XB_XGEN(b.x)], 1u);
            asm volatile("s_waitcnt vmcnt(0)" ::: "memory");
        } else {
            XB_SPIN(xb_ld(&bar[XB_XGEN(b.x)]) == gen, bar);
            __builtin_amdgcn_fence(__ATOMIC_ACQUIRE, "agent");
            asm volatile("s_waitcnt vmcnt(0)" ::: "memory");
        }
    }
    __syncthreads();
}

constexpr int NPHASE = 13;
__global__ void __launch_bounds__(512, 2) mega(Args a_) {
    const KA a;
    extern __shared__ __attribute__((aligned(16))) unsigned char lds_raw[];
    LAS unsigned char* lds = (LAS unsigned char*)lds_raw;
    const int tid = threadIdx.x, lane = tid & 63, wave = __builtin_amdgcn_readfirstlane(tid >> 6);
    unsigned char* ws = a.ws();
    const int lo = a_.ph_lo, hi = a_.ph_hi;
#define IN(k) (lo <= (k) && (k) < hi)
#if MK_ONE_LAUNCH
    volatile LAS unsigned* bst = (volatile LAS unsigned*)(lds + 147440);
    if (tid < 4) bst[tid] = 0u;
    __syncthreads();
    const XcdBarrier gbar = xcd_barrier_post((unsigned*)(ws + WS_CTL), bst);
#define SEAM(k) do { if (IN(k) && IN((k) + 1)) xcd_barrier(gbar); } while (0)
#else
#define SEAM(k) do { } while (0)
#endif
    const float* modacc = (const float*)(ws + CTL_MODACC);
    unsigned long long pr_prev = PROBE_MASK ? __builtin_amdgcn_s_memrealtime() : 0ull, pr_acc = 0ull;
#define STAMP(k) do { if (PROBE_MASK) { const unsigned long long now_ = __builtin_amdgcn_s_memrealtime(); if ((PROBE_MASK >> (k)) & 1u) pr_acc += now_ - pr_prev; pr_prev = now_; } } while (0)
    if (IN(0)) { phase0(a, lds, tid, lane, wave); } SEAM(0); STAMP(0);
    if (IN(1)) { phase1(a, tid, lane, wave); } SEAM(1); STAMP(1);
    if (IN(2)) {
        pg8::Gemm g{(const bf16_t*)(ws + WS_XN), (const bf16_t*)(ws + WS_WINA), MT, NA, 1024}; pg8::StaticOrder S; S.init(MT, NA, gridDim.x, blockIdx.x);
        EpiIn E{(const float*)(ws + SM_ROWSS1), (const float*)(ws + SM_SHWA), 0, (bf16_t*)(ws + WS_QKVR), nullptr, nullptr, nullptr, nullptr, (float*)(ws + WS_BA)};
        pg8::gemm_phase<EpiIn, pg8::StaticOrder, true, true>(lds, g, S, E);
    } SEAM(2); STAMP(2);
    if (IN(3)) { phase_dnprep(a, tid); } SEAM(3); STAMP(3);
    if (IN(4)) { phase_dnchunk2(a, lds, tid, lane, wave); } SEAM(4); STAMP(4);
    if (IN(5)) { const unsigned long long t5_ = (PROBE_SUB == 4) ? __builtin_amdgcn_s_memrealtime() : 0ull; phase_dnscan2(a, lds, tid, lane, wave, pr_acc); if (PROBE_SUB == 4) pr_acc += __builtin_amdgcn_s_memrealtime() - t5_; } SEAM(5); STAMP(5);
    if (IN(6)) {
        pg8::Gemm g{(const bf16_t*)(ws + WS_XN), (const bf16_t*)(ws + WS_WINC), MT, NC, 1024}; pg8::StaticOrder S; S.init(MT, NC, gridDim.x, blockIdx.x);
        EpiIn E{(const float*)(ws + SM_ROWSS1), (const float*)(ws + SM_SHWA) + NA, 1, (bf16_t*)(ws + WS_GT), (bf16_t*)(ws + WS_QAT), (bf16_t*)(ws + WS_KAT), (bf16_t*)(ws + WS_VAT), (bf16_t*)(ws + WS_MG), nullptr};
        pg8::gemm_phase<EpiIn, pg8::StaticOrder, true, true>(lds, g, S, E);
    } SEAM(6); STAMP(6);
    if (IN(7)) { phase_prep2(a, lane, wave); } SEAM(7); STAMP(7);
    if (IN(8)) {
#pragma unroll 1
        for (int k = 0; k < 1024; ++k) {
            const int idx = 4 * ((int)blockIdx.x + (int)gridDim.x * (k >> 2)) + (k & 3); if (idx >= 1024) break;
            const int g = idx & 3, qb = (idx >> 2) & 63, kvh = (idx >> 8) & 1, b = idx >> 9;
            att::attn_unit(a, b, kvh * 4 + g, qb, (char*)lds_raw); }
    } SEAM(8); STAMP(8);
    if (IN(9)) {
        pg8::Gemm g{(const bf16_t*)(ws + WS_Y), (const bf16_t*)(ws + WS_WBR), ML, 1024, 2048}; pg8::StaticOrder S; S.init(ML, 1024, gridDim.x, blockIdx.x);
        EpiBr E{(const bf16_t*)(ws + WS_MG), (bf16_t*)(ws + WS_MERGED)};
        pg8::gemm_phase<EpiBr, pg8::StaticOrder, true, true>(lds, g, S, E);
    } SEAM(9); STAMP(9);
    if (IN(10)) {
        pg8::Gemm g{(const bf16_t*)(ws + WS_MERGED), (const bf16_t*)(ws + WS_WOUT), ML, 1024, 1024}; pg8::StaticOrder S; S.init(ML, 1024, gridDim.x, blockIdx.x);
        EpiOut E{a.in(0), modacc, a.in(5), a.in(7), a.out(), (bf16_t*)(ws + WS_X1S), (float*)(ws + CTL_ROWSS2)};
        pg8::gemm_phase<EpiOut, pg8::StaticOrder, true, true>(lds, g, S, E);
    } SEAM(10); STAMP(10);
    if (IN(11)) {
        pg8::Gemm g{(const bf16_t*)(ws + WS_X1S), (const bf16_t*)(ws + WS_WUP), 2 * TPB * 256, NUP, 1024}; pg8::StaticOrder S; S.init(2 * TPB * 256, NUP, gridDim.x, blockIdx.x);
        EpiUpConv E{(const float*)(ws + CTL_ROWSS2), (const float*)(ws + SM_SHWF), a.in(20), a.in(21), (bf16_t*)(ws + WS_ACT), (LAS float*)(lds + 131072)};
        pg8::gemm_phase<EpiUpConv, pg8::StaticOrder, true, true>(lds, g, S, E);
    } SEAM(11); STAMP(11);
    if (IN(12)) {
        pg8::Gemm g{(const bf16_t*)(ws + WS_ACT), (const bf16_t*)(ws + WS_WDN), ML, 1024, DFF}; pg8::StaticOrder S; S.init(ML, 1024, gridDim.x, blockIdx.x);
        EpiDown E{modacc, a.in(5), a.out()};
        pg8::gemm_phase<EpiDown, pg8::StaticOrder, true, true>(lds, g, S, E);
    }
    STAMP(12);
    if ((PROBE_MASK || PROBE_SUB) && blockIdx.x == 0) { const unsigned long long t0_ = __builtin_amdgcn_s_memrealtime(); while (__builtin_amdgcn_s_memrealtime() - t0_ < pr_acc) __builtin_amdgcn_s_sleep(8); }
#undef STAMP
#undef IN
#undef SEAM
}

extern "C" void kernel_launch(void* const* d_in, const int* in_sizes, int n_in, void* d_out, int out_size, void* d_ws, size_t ws_size, hipStream_t stream) {
    static int grid = 0;
    if (grid == 0) {
        if (n_in != 23 || in_sizes[0] != ML * DM || out_size != ML * DM || ws_size < WS_END) {
            fprintf(stderr, "kernel_launch: unexpected shapes n_in %d in0 %d out %d ws %zu (need %zu)\n", n_in, n_in > 0 ? in_sizes[0] : -1, out_size, ws_size, (size_t)WS_END); grid = -1; return; }
        int dev = 0, cus = 0, per_cu = 0;
        hipGetDevice(&dev); hipDeviceGetAttribute(&cus, hipDeviceAttributeMultiprocessorCount, dev);
        if (hipFuncSetAttribute((const void*)mega, hipFuncAttributeMaxDynamicSharedMemorySize, LDS_BYTES) != hipSuccess) { fprintf(stderr, "kernel_launch: hipFuncSetAttribute failed\n"); grid = -1; return; }
        hipOccupancyMaxActiveBlocksPerMultiprocessor(&per_cu, (const void*)mega, 512, LDS_BYTES);
        (void)hipGetLastError();
        if (per_cu < 1) { fprintf(stderr, "kernel_launch: occupancy query says %d blocks per CU\n", per_cu); per_cu = 1; }
        grid = cus;
    }
    if (grid < 0) return;
    hipMemsetAsync((char*)d_ws + WS_CTL, 0, CTL_ZERO_BYTES, stream);
    Args a{};
    for (int i = 0; i < 23; ++i) a.in[i] = (const float*)d_in[i];
    a.out = (float*)d_out; a.ws = (unsigned char*)d_ws;
#if MK_ONE_LAUNCH
    a.ph_lo = 0; a.ph_hi = NPHASE;
    void* args[] = {&a};
    hipError_t e = hipLaunchCooperativeKernel((const void*)mega, dim3(grid), dim3(512), args, LDS_BYTES, stream);
    if (e != hipSuccess) fprintf(stderr, "cooperative launch failed: %s (grid %d)\n", hipGetErrorString(e), grid);
#else
    for (int p = 0; p < NPHASE; ++p) {
        a.ph_lo = p; a.ph_hi = p + 1;
        hipLaunchKernelGGL(mega, dim3(grid), dim3(512), LDS_BYTES, stream, a);
    }
    hipError_t e = hipPeekAtLastError();
    if (e != hipSuccess) fprintf(stderr, "launch failed: %s\n", hipGetErrorString(e));
#endif
}
```

```cpp
#include <hip/hip_runtime.h>
#include <hip/hip_cooperative_groups.h>
#include <cstdio>
#include <cstdint>
namespace cg = cooperative_groups;

#ifndef PROBE_MASK
#define PROBE_MASK 0u
#endif
#ifndef PROBE_SUB
#define PROBE_SUB 0
#endif
#ifndef MK_ONE_LAUNCH
#define MK_ONE_LAUNCH 1
#endif

#define DEVI __device__ __forceinline__
#define LAS __attribute__((address_space(3)))
typedef unsigned short bf16_t;
typedef short bf16x8 __attribute__((ext_vector_type(8)));
typedef float f32x4 __attribute__((ext_vector_type(4)));
typedef float f32x2 __attribute__((ext_vector_type(2)));
typedef float f32x16 __attribute__((ext_vector_type(16)));
typedef unsigned u32x4 __attribute__((ext_vector_type(4)));
typedef unsigned u32x2 __attribute__((ext_vector_type(2)));
typedef short s16x4 __attribute__((ext_vector_type(4)));

constexpr int BATCH = 2, SEQ = 16384, DM = 1024, CTX = 256;
constexpr int ML = BATCH * SEQ;
constexpr int MC = BATCH * CTX;
constexpr int MT = ML + MC;
constexpr int NA = 3328;
constexpr int NC = 4608;
constexpr int NSH = NA + NC;
constexpr int DFF = 2816, NUP = 5632;
constexpr int RB = SEQ + 256;
constexpr int TPB = 65;
constexpr float EPS = 1e-6f;

constexpr size_t MiB = 1u << 20;
constexpr size_t WS_CTL = 0, CTL_ZERO_BYTES = 1 * MiB;
constexpr size_t CTL_XRANK = 24 * 1024;
constexpr size_t CTL_PROG = 32 * 1024;
constexpr size_t CTL_MODACC = 64 * 1024;
constexpr size_t CTL_ROWSS2 = 256 * 1024;
constexpr size_t WS_SMALL = 1 * MiB;
constexpr size_t SM_ROWSS1 = WS_SMALL;
constexpr size_t SM_SHWA = WS_SMALL + 256 * 1024;
constexpr size_t SM_SHWF = WS_SMALL + 384 * 1024;
constexpr size_t SM_ROPE = WS_SMALL + 512 * 1024;
constexpr size_t WS_BA = 2 * MiB;
constexpr size_t WS_CTXK = 6 * MiB + 256 * 1024;
constexpr size_t WS_CTXV = 6 * MiB + 512 * 1024;
constexpr size_t WS_G = 7 * MiB;
constexpr size_t WS_BETA = 10 * MiB;
constexpr size_t WS_WINA = 13 * MiB, WS_WINC = 20 * MiB, WS_WBR = 29 * MiB, WS_WOUT = 33 * MiB, WS_WUP = 35 * MiB, WS_WDN = 46 * MiB;
constexpr size_t WS_XN = 52 * MiB;
constexpr size_t WS_QKVR = 117 * MiB;
constexpr size_t WS_QKVP = 312 * MiB;
constexpr size_t WS_MG = 180 * MiB;
constexpr size_t WS_GT = 310 * MiB;
constexpr size_t WS_QAT = 375 * MiB;
constexpr size_t WS_KAT = 440 * MiB;
constexpr size_t WS_VAT = 457 * MiB;
constexpr size_t WS_Y = 52 * MiB;
constexpr size_t WS_MERGED = 375 * MiB;
constexpr size_t WS_X1S = 440 * MiB;
constexpr size_t WS_U = 52 * MiB;
constexpr size_t WS_ACT = 228 * MiB;
constexpr size_t WS_TQ = 117 * MiB;
constexpr size_t WS_AVEC = 248 * MiB;
constexpr size_t WS_END = 512 * MiB;

constexpr int LDS_BYTES = 147456;

DEVI float bf2f(unsigned short h) { return __uint_as_float((unsigned)h << 16); }
DEVI float bflo(unsigned w) { return __uint_as_float(w << 16); }
DEVI float bfhi(unsigned w) { return __uint_as_float(w & 0xffff0000u); }
typedef __bf16 bf16x2_t __attribute__((ext_vector_type(2)));
DEVI unsigned pk2(float lo, float hi) { const f32x2 v = {lo, hi}; const bf16x2_t b = __builtin_convertvector(v, bf16x2_t); return __builtin_bit_cast(unsigned, b); }
DEVI unsigned f2bf(float f) { return pk2(f, 0.f) & 0xffffu; }
DEVI float wave_sum(float v) {
#pragma unroll
    for (int o = 1; o < 64; o <<= 1) v += __shfl_xor(v, o);
    return v;
}
DEVI float siluf(float x) { return x * __builtin_amdgcn_rcpf(1.f + __expf(-x)); }
DEVI float sigmoidf_(float x) { return 1.f / (1.f + __expf(-x)); }

struct Args { const float* in[23]; float* out; unsigned char* ws; int ph_lo, ph_hi; };
struct KA {
    DEVI const float* in(int k) const { return ((const float* const*)__builtin_amdgcn_kernarg_segment_ptr())[k]; }
    DEVI float* out() const { return ((float* const*)__builtin_amdgcn_kernarg_segment_ptr())[23]; }
    DEVI unsigned char* ws() const { return ((unsigned char* const*)__builtin_amdgcn_kernarg_segment_ptr())[24]; }
};

namespace pg8 {
constexpr int BM = 256, BK = 64, HALF = 128, HTB = HALF * BK * 2, STAGE_BYTES = 8 * HTB, NXCD = 8, WGM = 8;
__host__ __device__ __forceinline__ int lds_byte(int r, int c) { const int st = (r >> 4) * 2 + (c >> 5), rr = r & 15, cc = c & 31, ob = rr * 64 + cc * 2; return st * 1024 + (ob ^ (((ob >> 9) & 1) << 5)); }
__host__ __device__ __forceinline__ void stage_rc(int b, int& R, int& C) { const int st = b / 1024, sb = b % 1024, swz = sb ^ (((sb >> 9) & 1) << 5); R = (st >> 1) * 16 + swz / 64; C = (st & 1) * 32 + (swz % 64) / 2; }
__host__ __device__ __forceinline__ int perm32(int rho) { const int n = rho >> 4, i = rho & 15; return 8 * (i >> 2) + 4 * n + (i & 3); }
struct Unit { int pm, pn; };
struct Gemm { const bf16_t* A; const bf16_t* Bt; int M, N, K; };
struct StaticOrder {
    int nM, nN, nwg, G, c;
    __device__ void init(int M, int N, int G_, int c_) { nM = M / BM; nN = N / BM; nwg = nM * nN; G = G_; c = c_; }
    __device__ bool next(int i, Unit& u) const {
        const long L = (long)i * G + c; if (L >= nwg) return false;
        int wgid = (int)L; { const int q = nwg / NXCD, r = nwg % NXCD, xcd = wgid % NXCD, off = wgid / NXCD; wgid = (xcd < r ? xcd * (q + 1) : r * (q + 1) + (xcd - r) * q) + off; }
        const int nig = WGM * nN, gid = wgid / nig, fm = gid * WGM, gsz = (nM - fm) < WGM ? (nM - fm) : WGM;
        u.pm = fm + ((wgid % nig) % gsz); u.pn = (wgid % nig) / gsz; return true;
    }
};
template <class Epi> __device__ __forceinline__ size_t a_off(const Epi& E, int pm, int K, size_t tstep) { if constexpr (Epi::AROW) return (size_t)E.arow(pm) * K * 2; else return (size_t)pm * tstep; }
template <class Epi, class Sched, bool ALIGN_EPI, bool SP2>
__device__ __forceinline__ void gemm_phase(LAS unsigned char* lds, const Gemm g, const Sched& S, const Epi& E) {
    const int tid = threadIdx.x, wid = __builtin_amdgcn_readfirstlane(tid >> 6), lane = tid & 63, wr = wid >> 2, wc = wid & 3, fr = lane & 15, fq = lane >> 4;
    const int K = g.K, nt = K / BK;
    unsigned voffA[2], voffB[2];
#pragma unroll
    for (int i = 0; i < 2; ++i) { int R, C; stage_rc(tid * 16 + i * 8192, R, C); const int Rb = Epi::PERM ? ((R & ~31) + perm32(R & 31)) : R;
        voffA[i] = (unsigned)(R * K + C) * 2u; voffB[i] = (unsigned)(Rb * K + C) * 2u; }
    const size_t kstep = (size_t)(BK * 2);
    const size_t hstep = (size_t)HALF * K * 2;
    const size_t tstep = 2 * hstep;
    const unsigned ldsw = (unsigned)wid * 1024u;
    const int aoff = lds_byte(wr * 64 + fr, fq * 8), boff = lds_byte(wc * 32 + fr, fq * 8);
#define PG8_SA(b, h) (((b) * 2 + (h)) * HTB)
#define PG8_SB(b, h) ((4 + (b) * 2 + (h)) * HTB)
#define PG8_STAGE(bufoff, gbase, voff) do { _Pragma("unroll") for (int _i = 0; _i < 2; ++_i) \
        __builtin_amdgcn_global_load_lds((const unsigned*)((const char*)(gbase) + (voff)[_i]), (LAS unsigned*)(lds + (bufoff) + ldsw + _i * 8192), 16, 0, 0); } while (0)
#define PG8_LDA(dst, b, h) do { _Pragma("unroll") for (int m = 0; m < 4; ++m) _Pragma("unroll") for (int k = 0; k < 2; ++k) dst[m][k] = *(const LAS bf16x8*)(lds + PG8_SA(b, h) + aoff + m * 2048 + k * 1024); } while (0)
#define PG8_LDB(dst, b, h) do { _Pragma("unroll") for (int n = 0; n < 2; ++n) _Pragma("unroll") for (int k = 0; k < 2; ++k) dst[n][k] = *(const LAS bf16x8*)(lds + PG8_SB(b, h) + boff + n * 2048 + k * 1024); } while (0)
#define PG8_MMA(ai, bj, At, Bt) do { __builtin_amdgcn_s_setprio(1); _Pragma("unroll") for (int m = 0; m < 4; ++m) _Pragma("unroll") for (int n = 0; n < 2; ++n) _Pragma("unroll") for (int k = 0; k < 2; ++k) \
        acc[ai][bj][m][n] = __builtin_amdgcn_mfma_f32_16x16x32_bf16(Bt[n][k], At[m][k], acc[ai][bj][m][n], 0, 0, 0); __builtin_amdgcn_s_setprio(0); } while (0)
#define PG8_WAIT_V(n) asm volatile("s_waitcnt vmcnt(" #n ")" ::: "memory")
#define PG8_WAIT_L(n) asm volatile("s_waitcnt lgkmcnt(" #n ")" ::: "memory")
#define PG8_BAR __builtin_amdgcn_s_barrier()
#define PG8_SCHED __builtin_amdgcn_sched_barrier(0)
    Unit cur, nxt; int ui = 0;
    if (!S.next(0, cur)) return;
    f32x4 acc[2][2][4][2];
#pragma unroll
    for (int a = 0; a < 2; ++a)
#pragma unroll
        for (int b = 0; b < 2; ++b)
#pragma unroll
            for (int m = 0; m < 4; ++m)
#pragma unroll
                for (int n = 0; n < 2; ++n) acc[a][b][m][n] = (f32x4){0.f, 0.f, 0.f, 0.f};
    bf16x8 At[4][2], B0[2][2], B1[2][2];
    const char* cA = (const char*)g.A + a_off<Epi>(E, cur.pm, K, tstep); const char* cB = (const char*)g.Bt + (size_t)cur.pn * tstep;
    if constexpr (SP2) {
        PG8_STAGE(PG8_SB(0, 0), cB, voffB); PG8_STAGE(PG8_SB(0, 1), cB + hstep, voffB); PG8_STAGE(PG8_SA(0, 0), cA, voffA); PG8_STAGE(PG8_SA(0, 1), cA + hstep, voffA);
        if (wr == 1) PG8_BAR;
        PG8_WAIT_V(2); PG8_BAR;
        PG8_STAGE(PG8_SB(1, 0), cB + kstep, voffB); PG8_STAGE(PG8_SA(1, 0), cA + kstep, voffA); PG8_STAGE(PG8_SB(1, 1), cB + hstep + kstep, voffB);
        PG8_WAIT_V(6); PG8_BAR;
    } else {
        PG8_STAGE(PG8_SB(0, 0), cB, voffB); PG8_STAGE(PG8_SA(0, 0), cA, voffA); PG8_STAGE(PG8_SB(0, 1), cB + hstep, voffB); PG8_STAGE(PG8_SA(0, 1), cA + hstep, voffA);
        if (wr == 1) PG8_BAR;
        PG8_WAIT_V(4); PG8_BAR;
        PG8_STAGE(PG8_SB(1, 0), cB + kstep, voffB); PG8_STAGE(PG8_SA(1, 0), cA + kstep, voffA); PG8_STAGE(PG8_SB(1, 1), cB + hstep + kstep, voffB);
        PG8_WAIT_V(6); PG8_BAR;
    }
    for (;;) {
        const bool has_next = S.next(ui + 1, nxt);
        const char* nA = has_next ? (const char*)g.A + a_off<Epi>(E, nxt.pm, K, tstep) : cA; const char* nB = has_next ? (const char*)g.Bt + (size_t)nxt.pn * tstep : cB;
#pragma unroll 1
        for (int t = 0; t < nt; t += 2) {
            const bool last = (t == nt - 2);
            if constexpr (Epi::MID) { if (t == nt / 2) E.mid(acc, cur, wr, wc, fr, fq); }
            const char* a1 = cA + (size_t)(t + 1) * kstep;
            const char* a2 = last ? nA : cA + (size_t)(t + 2) * kstep; const char* b2 = last ? nB : cB + (size_t)(t + 2) * kstep;
            const char* a3 = a2 + kstep; const char* b3 = b2 + kstep;
            if constexpr (SP2) {
            PG8_LDB(B0, 0, 0); PG8_LDB(B1, 0, 1); PG8_SCHED; PG8_LDA(At, 0, 0); PG8_STAGE(PG8_SA(1, 1), a1 + hstep, voffA);
            PG8_WAIT_V(8); PG8_WAIT_L(0); PG8_BAR; PG8_MMA(0, 0, At, B0); PG8_MMA(0, 1, At, B1); PG8_BAR; PG8_SCHED;
            PG8_LDA(At, 0, 1); PG8_STAGE(PG8_SB(0, 0), b2, voffB); PG8_STAGE(PG8_SB(0, 1), b2 + hstep, voffB); PG8_STAGE(PG8_SA(0, 0), a2, voffA);
            PG8_WAIT_V(8); PG8_WAIT_L(0); PG8_BAR; PG8_MMA(1, 0, At, B0); PG8_MMA(1, 1, At, B1); PG8_BAR; PG8_SCHED;
            PG8_LDB(B0, 1, 0); PG8_LDB(B1, 1, 1); PG8_SCHED; PG8_LDA(At, 1, 0); PG8_STAGE(PG8_SA(0, 1), a2 + hstep, voffA);
            PG8_WAIT_V(8); PG8_WAIT_L(0); PG8_BAR; PG8_MMA(0, 0, At, B0); PG8_MMA(0, 1, At, B1); PG8_BAR; PG8_SCHED;
            PG8_LDA(At, 1, 1); PG8_STAGE(PG8_SB(1, 0), b3, voffB); PG8_STAGE(PG8_SB(1, 1), b3 + hstep, voffB); PG8_STAGE(PG8_SA(1, 0), a3, voffA);
            PG8_WAIT_V(8); PG8_WAIT_L(0); PG8_BAR; PG8_MMA(1, 0, At, B0); PG8_MMA(1, 1, At, B1); PG8_BAR; PG8_SCHED;
            } else {
            PG8_LDB(B0, 0, 0); PG8_SCHED; PG8_LDA(At, 0, 0); PG8_STAGE(PG8_SA(1, 1), a1 + hstep, voffA);
            PG8_WAIT_L(8); PG8_BAR; PG8_WAIT_L(0); PG8_MMA(0, 0, At, B0); PG8_BAR; PG8_SCHED;
            PG8_LDB(B1, 0, 1); PG8_STAGE(PG8_SB(0, 0), b2, voffB);
            PG8_BAR; PG8_WAIT_L(0); PG8_MMA(0, 1, At, B1); PG8_BAR;
            PG8_LDA(At, 0, 1); PG8_STAGE(PG8_SA(0, 0), a2, voffA);
            PG8_BAR; PG8_WAIT_L(0); PG8_MMA(1, 0, At, B0); PG8_BAR; PG8_SCHED;
            PG8_STAGE(PG8_SB(0, 1), b2 + hstep, voffB);
            PG8_WAIT_V(6); PG8_BAR; PG8_MMA(1, 1, At, B1); PG8_BAR;
            PG8_LDB(B0, 1, 0); PG8_SCHED; PG8_LDA(At, 1, 0); PG8_STAGE(PG8_SA(0, 1), a2 + hstep, voffA);
            PG8_WAIT_L(8); PG8_BAR; PG8_WAIT_L(0); PG8_MMA(0, 0, At, B0); PG8_BAR; PG8_SCHED;
            PG8_LDB(B1, 1, 1); PG8_STAGE(PG8_SB(1, 0), b3, voffB);
            PG8_BAR; PG8_WAIT_L(0); PG8_MMA(0, 1, At, B1); PG8_BAR;
            PG8_LDA(At, 1, 1); PG8_STAGE(PG8_SA(1, 0), a3, voffA);
            PG8_BAR; PG8_WAIT_L(0); PG8_MMA(1, 0, At, B0); PG8_BAR; PG8_SCHED;
            PG8_STAGE(PG8_SB(1, 1), b3 + hstep, voffB);
            PG8_WAIT_V(6); PG8_BAR; PG8_MMA(1, 1, At, B1); PG8_BAR;
            }
        }
        if constexpr (ALIGN_EPI) { if (wr == 0) PG8_BAR; }
        E(acc, cur, wr, wc, fr, fq);
        if (!has_next) break;
#pragma unroll
        for (int a = 0; a < 2; ++a)
#pragma unroll
            for (int b = 0; b < 2; ++b)
#pragma unroll
                for (int m = 0; m < 4; ++m)
#pragma unroll
                    for (int n = 0; n < 2; ++n) acc[a][b][m][n] = (f32x4){0.f, 0.f, 0.f, 0.f};
        cur = nxt; cA = nA; cB = nB; ++ui;
        if constexpr (ALIGN_EPI) { if (wr == 1) PG8_BAR; }
    }
    PG8_WAIT_V(0);
    if constexpr (!ALIGN_EPI) { if (wr == 0) PG8_BAR; }
    PG8_BAR;
#undef PG8_SA
#undef PG8_SB
#undef PG8_STAGE
#undef PG8_LDA
#undef PG8_LDB
#undef PG8_MMA
#undef PG8_WAIT_V
#undef PG8_WAIT_L
#undef PG8_BAR
#undef PG8_SCHED
}
}
using pg8::HALF;

DEVI u32x4 pack8(const f32x4& a, const f32x4& b) { u32x4 w; w.x = pk2(a[0], a[1]); w.y = pk2(a[2], a[3]); w.z = pk2(b[0], b[1]); w.w = pk2(b[2], b[3]); return w; }

struct EpiIn {
    static constexpr bool PERM = true, MID = false, AROW = false;
    const float* rowss; const float* shW; int job;
    bf16_t *d0, *d1, *d2, *d3, *d4; float* ba;
    DEVI void operator()(const f32x4 (&acc)[2][2][4][2], const pg8::Unit& u, int wr, int wc, int fr, int fq) const {
        asm volatile("" : "+v"(fr), "+v"(fq));
        const int vs = u.pm < 64 ? 0 : (u.pm < 128 ? 1 : 2);
        bf16_t* base; int pitch, colt; bool isba = false;
        if (job == 0) { base = d0; pitch = 3072; colt = u.pn * 256; if (u.pn >= 12) isba = true; }
        else {
            if (u.pn < 4) { base = d0; pitch = 1024; colt = u.pn * 256; }
            else if (u.pn < 8) { base = d1; pitch = 1024; colt = (u.pn - 4) * 256; }
            else if (u.pn == 8) { base = d2; pitch = 256; colt = 0; }
            else if (u.pn == 9) { base = d3; pitch = 256; colt = 0; }
            else { base = d4; pitch = 2048; colt = (u.pn - 10) * 256; }
        }
        const int ncol0 = u.pn * 256 + wc * 32 + 8 * fq;
        f32x4 sv[2][2];
#pragma unroll
        for (int bj = 0; bj < 2; ++bj)
#pragma unroll
            for (int n = 0; n < 2; ++n) sv[bj][n] = *(const f32x4*)(shW + vs * NSH + ncol0 + bj * HALF + 4 * n);
        const int row0 = u.pm * 256 + wr * 64 + fr;
#pragma unroll
        for (int ai = 0; ai < 2; ++ai)
#pragma unroll
            for (int m = 0; m < 4; ++m) {
                const int row = row0 + ai * HALF + m * 16;
                const float rs = rsqrtf(rowss[row] * (1.f / 1024.f) + EPS);
                if (!isba) {
                    bf16_t* rowp = base + (size_t)row * pitch + colt + wc * 32 + 8 * fq;
#pragma unroll
                    for (int bj = 0; bj < 2; ++bj) { const f32x4 v0 = acc[ai][bj][m][0] * rs + sv[bj][0], v1 = acc[ai][bj][m][1] * rs + sv[bj][1]; *(u32x4*)(rowp + bj * HALF) = pack8(v0, v1); }
                } else if (wc == 0) {
                    float* rowp = ba + (size_t)row * 32 + 8 * fq;
                    *(f32x4*)(rowp) = acc[ai][0][m][0] * rs + sv[0][0]; *(f32x4*)(rowp + 4) = acc[ai][0][m][1] * rs + sv[0][1];
                }
            }
    }
};
struct TailOrder { int idx; __device__ bool next(int i, pg8::Unit& u) const { if (i == 0 && idx >= 0 && idx < 4) { u.pm = idx >> 1; u.pn = idx & 1; return true; } return false; } };
struct EpiCtxKV {
    static constexpr bool PERM = true, MID = false, AROW = false;
    const float* rowss; const float* shW; bf16_t* kat; bf16_t* vat;
    DEVI void operator()(const f32x4 (&acc)[2][2][4][2], const pg8::Unit& u, int wr, int wc, int fr, int fq) const {
        asm volatile("" : "+v"(fr), "+v"(fq));
        bf16_t* base = (u.pn == 0 ? kat : vat);
        const int ncol0 = u.pn * 256 + wc * 32 + 8 * fq;
#pragma unroll
        for (int bj = 0; bj < 2; ++bj) {
            const f32x4 sv0 = *(const f32x4*)(shW + ncol0 + bj * HALF), sv1 = *(const f32x4*)(shW + ncol0 + bj * HALF + 4);
#pragma unroll
            for (int ai = 0; ai < 2; ++ai)
#pragma unroll
                for (int m = 0; m < 4; ++m) { const int row = u.pm * 256 + ai * HALF + wr * 64 + m * 16 + fr;
                    const float rs = rsqrtf(rowss[row] * (1.f / 1024.f) + EPS);
                    *(u32x4*)(base + (size_t)row * 256 + wc * 32 + 8 * fq + bj * HALF) = pack8(acc[ai][bj][m][0] * rs + sv0, acc[ai][bj][m][1] * rs + sv1); }
        }
    }
};
struct EpiBr {
    static constexpr bool PERM = true, MID = true, AROW = false;
    const bf16_t* mg; bf16_t* out;
    DEVI void mid(f32x4 (&acc)[2][2][4][2], const pg8::Unit& u, int wr, int wc, int fr, int fq) const {
        asm volatile("" : "+v"(fr), "+v"(fq));
        const int row0 = u.pm * 256 + wr * 64 + fr, col0 = u.pn * 256 + wc * 32 + 8 * fq;
#pragma unroll
        for (int ai = 0; ai < 2; ++ai)
#pragma unroll
            for (int m = 0; m < 4; ++m) {
                const bf16_t* rp = mg + (size_t)(row0 + ai * HALF + m * 16) * 2048 + col0;
#pragma unroll
                for (int bj = 0; bj < 2; ++bj) {
                    const u32x4 gd = *(const u32x4*)(rp + bj * HALF), ga = *(const u32x4*)(rp + 1024 + bj * HALF);
                    float r[8];
#pragma unroll
                    for (int i = 0; i < 4; ++i) {
                        const float d0 = bflo(gd[i]), d1 = bfhi(gd[i]), a0 = bflo(ga[i]), a1 = bfhi(ga[i]);
                        r[2 * i] = (1.f + __expf(fminf(-a0, 80.f))) * __builtin_amdgcn_rcpf(1.f + __expf(fminf(-d0, 80.f)));
                        r[2 * i + 1] = (1.f + __expf(fminf(-a1, 80.f))) * __builtin_amdgcn_rcpf(1.f + __expf(fminf(-d1, 80.f)));
                    }
                    acc[ai][bj][m][0] *= (f32x4){r[0], r[1], r[2], r[3]}; acc[ai][bj][m][1] *= (f32x4){r[4], r[5], r[6], r[7]};
                    asm volatile("" ::: "memory");
                }
            }
    }
    DEVI void operator()(const f32x4 (&acc)[2][2][4][2], const pg8::Unit& u, int wr, int wc, int fr, int fq) const {
        asm volatile("" : "+v"(fr), "+v"(fq));
        const int row0 = u.pm * 256 + wr * 64 + fr, col0 = u.pn * 256 + wc * 32 + 8 * fq;
#pragma unroll
        for (int ai = 0; ai < 2; ++ai)
#pragma unroll
            for (int m = 0; m < 4; ++m) {
                const size_t row = (size_t)(row0 + ai * HALF + m * 16);
                const bf16_t* rp = mg + row * 2048 + 1024 + col0;
#pragma unroll
                for (int bj = 0; bj < 2; ++bj) {
                    const u32x4 ga = *(const u32x4*)(rp + bj * HALF);
                    float s[8];
#pragma unroll
                    for (int i = 0; i < 4; ++i) { s[2 * i] = __builtin_amdgcn_rcpf(1.f + __expf(fminf(-bflo(ga[i]), 80.f))); s[2 * i + 1] = __builtin_amdgcn_rcpf(1.f + __expf(fminf(-bfhi(ga[i]), 80.f))); }
                    const f32x4 v0 = acc[ai][bj][m][0] * (f32x4){s[0], s[1], s[2], s[3]}, v1 = acc[ai][bj][m][1] * (f32x4){s[4], s[5], s[6], s[7]};
                    *(u32x4*)(out + row * 1024 + col0 + bj * HALF) = pack8(v0, v1);
                }
            }
    }
};
struct EpiOut {
    static constexpr bool PERM = false, MID = false, AROW = false;
    const float* x; const float* modacc; const float* bada; const float* nwf; float* out; bf16_t* x1s; float* rowss2;
    DEVI void operator()(const f32x4 (&acc)[2][2][4][2], const pg8::Unit& u, int wr, int wc, int fr, int fq) const {
        asm volatile("" : "+v"(fr), "+v"(fq));
        const int b = u.pm >> 6; const int row0 = u.pm * 256 + wr * 64 + fr, col0 = u.pn * 256 + wc * 32 + 4 * fq;
        f32x4 ga[2][2], sc[2][2];
#pragma unroll
        for (int bj = 0; bj < 2; ++bj)
#pragma unroll
            for (int n = 0; n < 2; ++n) { const int c = col0 + bj * HALF + n * 16;
                ga[bj][n] = *(const f32x4*)(modacc + b * 6144 + 2048 + c) + *(const f32x4*)(bada + 2048 + c);
                sc[bj][n] = (*(const f32x4*)(modacc + b * 6144 + 4096 + c) + *(const f32x4*)(bada + 4096 + c) + 1.f) * *(const f32x4*)(nwf + c); }
#pragma unroll
        for (int ai = 0; ai < 2; ++ai)
#pragma unroll
            for (int m = 0; m < 4; ++m) {
                const size_t off = (size_t)(row0 + ai * HALF + m * 16) * 1024 + col0; float ss = 0.f;
#pragma unroll
                for (int bj = 0; bj < 2; ++bj)
#pragma unroll
                    for (int n = 0; n < 2; ++n) {
                        const f32x4 xv = *(const f32x4*)(x + off + bj * HALF + n * 16);
                        const f32x4 o = xv + ga[bj][n] * acc[ai][bj][m][n];
                        *(f32x4*)(out + off + bj * HALF + n * 16) = o;
                        ss += (o[0] * o[0] + o[1] * o[1]) + (o[2] * o[2] + o[3] * o[3]);
                        const f32x4 s = o * sc[bj][n]; u32x2 w; w.x = pk2(s[0], s[1]); w.y = pk2(s[2], s[3]);
                        *(u32x2*)(x1s + off + (size_t)(b * (RB - SEQ) + 1) * 1024 + bj * HALF + n * 16) = w;
                    }
                ss += __shfl_xor(ss, 16); ss += __shfl_xor(ss, 32);
                if (fq == 0) atomicAdd(rowss2 + row0 + ai * HALF + m * 16, ss);
            }
    }
};
DEVI f32x4 dpp_ror1(const f32x4& x) { f32x4 r;
#pragma unroll
    for (int i = 0; i < 4; ++i) r[i] = __int_as_float(__builtin_amdgcn_update_dpp(0, __float_as_int(x[i]), 0x121, 0xf, 0xf, false));
    return r; }
DEVI f32x4 dpp_rol1(const f32x4& x) { f32x4 r;
#pragma unroll
    for (int i = 0; i < 4; ++i) r[i] = __int_as_float(__builtin_amdgcn_update_dpp(0, __float_as_int(x[i]), 0x12F, 0xf, 0xf, false));
    return r; }
struct EpiUpConv {
    static constexpr bool PERM = true, MID = false, AROW = true;
    const float* rowss2; const float* shWf; const float* cw; const float* cb; bf16_t* act; LAS float* xb;
    DEVI int arow(int pm) const { const int b = pm / TPB, i = pm - b * TPB; return b * RB + 254 * i; }
    DEVI void operator()(f32x4 (&acc)[2][2][4][2], const pg8::Unit& u, int wr, int wc, int fr, int fq) const {
        asm volatile("" : "+v"(fr), "+v"(fq));
        const int b = u.pm / TPB, ti = u.pm - b * TPB, tok0 = 254 * ti - 1;
        const int cl0 = wc * 32 + 8 * fq;
#pragma unroll
        for (int bj = 0; bj < 2; ++bj) {
            const f32x4 sv0 = *(const f32x4*)(shWf + b * NUP + u.pn * 256 + bj * HALF + cl0), sv1 = *(const f32x4*)(shWf + b * NUP + u.pn * 256 + bj * HALF + cl0 + 4);
#pragma unroll
            for (int ai = 0; ai < 2; ++ai)
#pragma unroll
                for (int m = 0; m < 4; ++m) {
                    const int tok = tok0 + ai * HALF + wr * 64 + m * 16 + fr; const bool ok = tok >= 0 && tok < SEQ;
                    const float rs = ok ? rsqrtf(rowss2[b * SEQ + (ok ? tok : 0)] * (1.f / 1024.f) + EPS) : 0.f;
                    acc[ai][bj][m][0] = ok ? acc[ai][bj][m][0] * rs + sv0 : (f32x4){0.f, 0.f, 0.f, 0.f};
                    acc[ai][bj][m][1] = ok ? acc[ai][bj][m][1] * rs + sv1 : (f32x4){0.f, 0.f, 0.f, 0.f};
                }
        }
#pragma unroll
        for (int ai = 0; ai < 2; ++ai) { const int blk = 2 * ai + wr;
#pragma unroll
            for (int bj = 0; bj < 2; ++bj)
#pragma unroll
                for (int n = 0; n < 2; ++n) {
                    if (fr == 0) *(LAS f32x4*)(xb + (blk * 2 + 0) * 256 + bj * HALF + cl0 + 4 * n) = acc[ai][bj][0][n];
                    if (fr == 15) *(LAS f32x4*)(xb + (blk * 2 + 1) * 256 + bj * HALF + cl0 + 4 * n) = acc[ai][bj][3][n];
                } }
        asm volatile("s_waitcnt lgkmcnt(0)" ::: "memory"); __builtin_amdgcn_s_barrier(); asm volatile("" ::: "memory");
        const int f0 = u.pn * 128 + cl0;
#pragma unroll
        for (int n = 0; n < 2; ++n) {
            f32x4 wg[3], wv[3];
#pragma unroll
            for (int j = 0; j < 3; ++j) { wg[j] = *(const f32x4*)(cw + j * NUP + f0 + 4 * n); wv[j] = *(const f32x4*)(cw + j * NUP + DFF + f0 + 4 * n); }
            const f32x4 bgv = *(const f32x4*)(cb + f0 + 4 * n), bvv = *(const f32x4*)(cb + DFF + f0 + 4 * n);
#pragma unroll
            for (int ai = 0; ai < 2; ++ai) { const int blk = 2 * ai + wr;
                const f32x4 pgx = *(const LAS f32x4*)(xb + (((blk + 3) & 3) * 2 + 1) * 256 + cl0 + 4 * n), pvx = *(const LAS f32x4*)(xb + (((blk + 3) & 3) * 2 + 1) * 256 + HALF + cl0 + 4 * n);
                const f32x4 ngx = *(const LAS f32x4*)(xb + (((blk + 1) & 3) * 2 + 0) * 256 + cl0 + 4 * n), nvx = *(const LAS f32x4*)(xb + (((blk + 1) & 3) * 2 + 0) * 256 + HALF + cl0 + 4 * n);
#pragma unroll
                for (int m = 0; m < 4; ++m) {
                    f32x4 ug, uv;
                    { const f32x4 c = acc[ai][0][m][n], up = m > 0 ? acc[ai][0][m > 0 ? m - 1 : 0][n] : pgx, dn = m < 3 ? acc[ai][0][m < 3 ? m + 1 : 3][n] : ngx;
                      f32x4 pr = dpp_ror1(fr == 15 ? up : c), nx = dpp_rol1(fr == 0 ? dn : c);
                      asm volatile("" : "+v"(pr), "+v"(nx));
                      ug = bgv + wg[0] * pr + wg[1] * c + wg[2] * nx; }
                    { const f32x4 c = acc[ai][1][m][n], up = m > 0 ? acc[ai][1][m > 0 ? m - 1 : 0][n] : pvx, dn = m < 3 ? acc[ai][1][m < 3 ? m + 1 : 3][n] : nvx;
                      f32x4 pr = dpp_ror1(fr == 15 ? up : c), nx = dpp_rol1(fr == 0 ? dn : c);
                      asm volatile("" : "+v"(pr), "+v"(nx));
                      uv = bvv + wv[0] * pr + wv[1] * c + wv[2] * nx; }
                    const int r = ai * HALF + wr * 64 + m * 16 + fr, tok = tok0 + r;
                    if (r >= 1 && r <= 254 && tok < SEQ) {
                        u32x2 w; w.x = pk2(siluf(ug[0]) * uv[0], siluf(ug[1]) * uv[1]); w.y = pk2(siluf(ug[2]) * uv[2], siluf(ug[3]) * uv[3]);
                        *(u32x2*)(act + (size_t)(b * SEQ + tok) * DFF + f0 + 4 * n) = w; }
                    asm volatile("" ::: "memory");
                }
            }
        }
    }
};
struct EpiDown {
    static constexpr bool PERM = false, MID = false, AROW = false;
    const float* modacc; const float* bada; float* out;
    DEVI void operator()(const f32x4 (&acc)[2][2][4][2], const pg8::Unit& u, int wr, int wc, int fr, int fq) const {
        asm volatile("" : "+v"(fr), "+v"(fq));
        const int b = u.pm >> 6; const int row0 = u.pm * 256 + wr * 64 + fr, col0 = u.pn * 256 + wc * 32 + 4 * fq;
        f32x4 gf[2][2];
#pragma unroll
        for (int bj = 0; bj < 2; ++bj)
#pragma unroll
            for (int n = 0; n < 2; ++n) { const int c = col0 + bj * HALF + n * 16; gf[bj][n] = *(const f32x4*)(modacc + b * 6144 + 5120 + c) + *(const f32x4*)(bada + 5120 + c); }
#pragma unroll
        for (int ai = 0; ai < 2; ++ai)
#pragma unroll
            for (int m = 0; m < 4; ++m) {
                const size_t off = (size_t)(row0 + ai * HALF + m * 16) * 1024 + col0;
#pragma unroll
                for (int bj = 0; bj < 2; ++bj)
#pragma unroll
                    for (int n = 0; n < 2; ++n) { float* p = out + off + bj * HALF + n * 16; *(f32x4*)p = *(const f32x4*)p + gf[bj][n] * acc[ai][bj][m][n]; }
            }
    }
};

DEVI void transpose_item(const float* W, int srcN, int k0, int n0, bf16_t* dst  , int dstK, LAS float* scr, int lane) {
#pragma unroll 8
    for (int i = 0; i < 32; ++i) { const int kk = 2 * i + (lane >> 5); scr[kk * 33 + (lane & 31)] = W[(size_t)(k0 + kk) * srcN + n0 + (lane & 31)]; }
    asm volatile("s_waitcnt lgkmcnt(0)" ::: "memory");
    const int c = lane & 7;
#pragma unroll
    for (int j = 0; j < 4; ++j) { const int n = (lane >> 3) + 8 * j; const LAS float* s = scr + (8 * c) * 33 + n;
        u32x4 o; o.x = pk2(s[0 * 33], s[1 * 33]); o.y = pk2(s[2 * 33], s[3 * 33]); o.z = pk2(s[4 * 33], s[5 * 33]); o.w = pk2(s[6 * 33], s[7 * 33]);
        *(u32x4*)(dst + (size_t)n * dstK + 8 * c) = o; }
    asm volatile("s_waitcnt lgkmcnt(0)" ::: "memory");
}
DEVI void phase0(const KA& a, LAS unsigned char* lds, int tid, int lane, int wave) {
    unsigned char* ws = a.ws();
    bf16_t* WinA = (bf16_t*)(ws + WS_WINA); bf16_t* WinC = (bf16_t*)(ws + WS_WINC); bf16_t* Wbr = (bf16_t*)(ws + WS_WBR);
    bf16_t* Wout = (bf16_t*)(ws + WS_WOUT); bf16_t* Wup = (bf16_t*)(ws + WS_WUP); bf16_t* Wdn = (bf16_t*)(ws + WS_WDN);
    LAS float* scr = (LAS float*)(lds + wave * 16384);
    const int gw = blockIdx.x * 8 + wave, NGW = gridDim.x * 8;
    constexpr int I_IN = 16 * 241, I_BR = 16 * 32, I_UP = 16 * 176, I_DN = 44 * 32;
    constexpr int NITEMS = I_IN + 3 * I_BR + I_UP + I_DN;
    for (int it = gw; it < NITEMS; it += NGW) {
        int r = it;
        if (r < I_IN) { const int kb = r / 241, nb = r % 241, c0 = nb * 32; bf16_t* d; int row;
            if (c0 < 3072) { d = WinA; row = c0; } else if (c0 < 4096) { d = WinC; row = c0 - 3072; } else if (c0 == 4096) { d = WinA; row = 3072; }
            else if (c0 < 5152) { d = WinC; row = 1024 + (c0 - 4128); } else if (c0 < 5408) { d = WinC; row = 2048 + (c0 - 5152); }
            else if (c0 < 5664) { d = WinC; row = 2304 + (c0 - 5408); } else { d = WinC; row = 2560 + (c0 - 5664); }
            transpose_item(a.in(8), 7712, kb * 64, c0, d + (size_t)row * 1024 + kb * 64, 1024, scr, lane); continue; }
        r -= I_IN;
        if (r < I_BR) { const int kb = r / 32, nb = r % 32; transpose_item(a.in(16), 1024, kb * 64, nb * 32, Wbr + (size_t)(nb * 32) * 2048 + kb * 64, 2048, scr, lane); continue; }
        r -= I_BR;
        if (r < I_BR) { const int kb = r / 32, nb = r % 32; transpose_item(a.in(17), 1024, kb * 64, nb * 32, Wbr + (size_t)(nb * 32) * 2048 + 1024 + kb * 64, 2048, scr, lane); continue; }
        r -= I_BR;
        if (r < I_BR) { const int kb = r / 32, nb = r % 32; transpose_item(a.in(18), 1024, kb * 64, nb * 32, Wout + (size_t)(nb * 32) * 1024 + kb * 64, 1024, scr, lane); continue; }
        r -= I_BR;
        if (r < I_UP) { const int kb = r / 176, nb = r % 176, c0 = nb * 32; int row;
            if (c0 < DFF) row = 256 * (c0 / 128) + (c0 % 128); else { const int c1 = c0 - DFF; row = 256 * (c1 / 128) + 128 + (c1 % 128); }
            transpose_item(a.in(19), NUP, kb * 64, c0, Wup + (size_t)row * 1024 + kb * 64, 1024, scr, lane); continue; }
        r -= I_UP;
        { const int kb = r / 32, nb = r % 32; transpose_item(a.in(22), 1024, kb * 64, nb * 32, Wdn + (size_t)(nb * 32) * DFF + kb * 64, DFF, scr, lane); }
    }
    float* modacc = (float*)(ws + CTL_MODACC);
    for (int it = blockIdx.x; it < 12 * 16; it += gridDim.x) {
        const int cb = it % 12, ks = it / 12, n = cb * 512 + tid;
        float a0 = 0.f, a1 = 0.f, a2 = 0.f;
#pragma unroll 8
        for (int k = ks * 64; k < ks * 64 + 64; ++k) {
            const float w = a.in(4)[(size_t)k * 6144 + n];
            a0 += siluf(a.in(1)[k]) * w; a1 += siluf(a.in(1)[1024 + k]) * w; a2 += siluf(a.in(3)[k]) * w;
        }
        atomicAdd(modacc + n, a0); atomicAdd(modacc + 6144 + n, a1); atomicAdd(modacc + 12288 + n, a2);
    }
    float* rope = (float*)(ws + SM_ROPE);
    for (int i = blockIdx.x * 512 + tid; i < 320 * 32; i += gridDim.x * 512) {
        const int p = i >> 5, f = i & 31; const float inv = powf(10000.f, -(float)f / 32.f);
        if (p < 256) { const float ang = (float)p * inv; rope[p * 32 + f] = cosf(ang); rope[8192 + p * 32 + f] = sinf(ang); }
        else { const int q = p - 256; const float ang = (float)q * inv; rope[16384 + q * 32 + f] = cosf(ang); rope[16384 + 2048 + q * 32 + f] = sinf(ang); }
    }
}

DEVI void phase1(const KA& a, int tid, int lane, int wave) {
    unsigned char* ws = a.ws();
    const float* modacc = (const float*)(ws + CTL_MODACC); const float* bada = a.in(5);
    bf16_t* XN = (bf16_t*)(ws + WS_XN); float* rowss1 = (float*)(ws + SM_ROWSS1);
    const int gw = blockIdx.x * 8 + wave, NGW = gridDim.x * 8;
    for (int row = gw; row < MT; row += NGW) {
        const int vs = row < SEQ ? 0 : (row < ML ? 1 : 2);
        const float* xr = row < ML ? a.in(0) + (size_t)row * 1024 : a.in(2) + (size_t)(row - ML) * 1024;
        float ss = 0.f;
#pragma unroll
        for (int j = 0; j < 4; ++j) {
            const int c = 4 * lane + 256 * j;
            const f32x4 v = *(const f32x4*)(xr + c);
            ss += (v[0] * v[0] + v[1] * v[1]) + (v[2] * v[2] + v[3] * v[3]);
            const f32x4 s = (*(const f32x4*)(modacc + vs * 6144 + 1024 + c) + *(const f32x4*)(bada + 1024 + c) + 1.f) * *(const f32x4*)(a.in(6) + c);
            const f32x4 o = v * s; u32x2 w; w.x = pk2(o[0], o[1]); w.y = pk2(o[2], o[3]);
            *(u32x2*)(XN + (size_t)row * 1024 + c) = w;
        }
        ss = wave_sum(ss);
        if (lane == 0) rowss1[row] = ss;
    }
    const bf16_t* WinA = (const bf16_t*)(ws + WS_WINA); const bf16_t* WinC = (const bf16_t*)(ws + WS_WINC); const bf16_t* Wup = (const bf16_t*)(ws + WS_WUP);
    float* shWa = (float*)(ws + SM_SHWA); float* shWf = (float*)(ws + SM_SHWF);
    for (int n = gw; n < NSH + NUP; n += NGW) {
        const bool isf = n >= NSH;
        const bf16_t* wrow = isf ? Wup + (size_t)(n - NSH) * 1024 : (n < NA ? WinA + (size_t)n * 1024 : WinC + (size_t)(n - NA) * 1024);
        const int shoff = isf ? 3072 : 0;
        float s0 = 0.f, s1 = 0.f, s2 = 0.f;
#pragma unroll
        for (int h = 0; h < 2; ++h) {
            const int k0 = h * 512 + lane * 8;
            const u32x4 w = *(const u32x4*)(wrow + k0);
#pragma unroll
            for (int i = 0; i < 4; ++i) {
                const float wl = bflo(w[i]), wh = bfhi(w[i]); const int k = k0 + 2 * i;
                const float b0 = bada[shoff + k], b1 = bada[shoff + k + 1];
                s0 += (modacc[shoff + k] + b0) * wl + (modacc[shoff + k + 1] + b1) * wh;
                s1 += (modacc[6144 + shoff + k] + b0) * wl + (modacc[6144 + shoff + k + 1] + b1) * wh;
                s2 += (modacc[12288 + shoff + k] + b0) * wl + (modacc[12288 + shoff + k + 1] + b1) * wh;
            }
        }
        s0 = wave_sum(s0); s1 = wave_sum(s1); s2 = wave_sum(s2);
        if (lane == 0) {
            if (isf) { shWf[n - NSH] = s0; shWf[NUP + n - NSH] = s1; }
            else { shWa[n] = s0; shWa[NSH + n] = s1; shWa[2 * NSH + n] = s2; }
        }
    }
}

DEVI u32x4 ldrow_(const bf16_t* base, int seq_start, int seq_len, int tt) {
    const int tc = tt < 0 ? 0 : (tt >= seq_len ? seq_len - 1 : tt);
    const u32x4 v = *(const u32x4*)(base + (size_t)(seq_start + tc) * 3072);
    const unsigned m = (tt == tc) ? 0xffffffffu : 0u;
    return (u32x4){v[0] & m, v[1] & m, v[2] & m, v[3] & m};
}
DEVI void phase_dnprep(const KA& a, int tid) {
    unsigned char* ws = a.ws();
    const bf16_t* QR = (const bf16_t*)(ws + WS_QKVR); bf16_t* QP = (bf16_t*)(ws + WS_QKVP);
    const float* convw = a.in(9); const float* ba = (const float*)(ws + WS_BA);
    float* gb = (float*)(ws + WS_G); float* bb = (float*)(ws + WS_BETA);
    const int cgp = tid & 127, strip = tid >> 7;
    for (int it = blockIdx.x; it < 520 * 3; it += gridDim.x) {
        const int cidx = it / 3, sec = it - cidx * 3;
        int seq_start, t0, seq_len;
        if (cidx < 512) { seq_start = (cidx >> 8) * SEQ; t0 = (cidx & 255) * 64; seq_len = SEQ; }
        else { const int c2 = cidx - 512; seq_start = ML + (c2 >> 2) * CTX; t0 = (c2 & 3) * 64; seq_len = CTX; }
        const int col = sec * 1024 + cgp * 8;
        f32x4 w0[5], w1[5];
#pragma unroll
        for (int j = 0; j < 5; ++j) { w0[j] = *(const f32x4*)(convw + j * 3072 + col); w1[j] = *(const f32x4*)(convw + j * 3072 + col + 4); }
        const int tb = t0 + strip * 16;
        u32x4 win[5];
#define LDROW(tt) ldrow_(QR + col, seq_start, seq_len, (tt))
        win[0] = LDROW(tb - 2); win[1] = LDROW(tb - 1); win[2] = LDROW(tb); win[3] = LDROW(tb + 1);
#pragma unroll
        for (int r = 0; r < 16; ++r) {
            win[4] = LDROW(tb + r + 2);
            f32x4 acc0 = {0.f, 0.f, 0.f, 0.f}, acc1 = {0.f, 0.f, 0.f, 0.f};
#pragma unroll
            for (int j = 0; j < 5; ++j) { const u32x4 x = win[j];
                acc0 += (f32x4){bflo(x[0]), bfhi(x[0]), bflo(x[1]), bfhi(x[1])} * w0[j];
                acc1 += (f32x4){bflo(x[2]), bfhi(x[2]), bflo(x[3]), bfhi(x[3])} * w1[j]; }
            float y[8];
#pragma unroll
            for (int i = 0; i < 4; ++i) { y[i] = siluf(acc0[i]); y[4 + i] = siluf(acc1[i]); }
            if (sec < 2) {
                float ss = 0.f;
#pragma unroll
                for (int i = 0; i < 8; ++i) ss += y[i] * y[i];
                ss += __shfl_xor(ss, 1); ss += __shfl_xor(ss, 2); ss += __shfl_xor(ss, 4); ss += __shfl_xor(ss, 8);
                const float sc = rsqrtf(ss + EPS) * (sec == 0 ? 0.08838834764831845f : 1.f);
#pragma unroll
                for (int i = 0; i < 8; ++i) y[i] *= sc;
            }
            u32x4 o; o.x = pk2(y[0], y[1]); o.y = pk2(y[2], y[3]); o.z = pk2(y[4], y[5]); o.w = pk2(y[6], y[7]);
            *(u32x4*)(QP + (size_t)(seq_start + tb + r) * 3072 + col) = o;
            win[0] = win[1]; win[1] = win[2]; win[2] = win[3]; win[3] = win[4];
        }
#undef LDROW
        if (sec == 0) {
#pragma unroll
            for (int q = 0; q < 2; ++q) {
                const int e = tid + q * 512, r = e >> 4, idx = e & 15, row = seq_start + t0 + r;
                const float bv = ba[(size_t)row * 32 + idx], av = ba[(size_t)row * 32 + 16 + idx];
                const float xs = av + a.in(11)[idx];
                const float sp = fmaxf(xs, 0.f) + log1pf(expf(-fabsf(xs)));
                const float g = -expf(a.in(10)[idx]) * sp;
                const int dir = idx >> 3, h = idx & 7;
                gb[((size_t)dir * MT + row) * 8 + h] = g;
                bb[((size_t)dir * MT + row) * 8 + h] = 1.f / (1.f + expf(-bv));
            }
        }
    }
}

DEVI void phase_dnscan(const KA& a, int lane, int wave) {
    unsigned char* ws = a.ws();
    const bf16_t* QP = (const bf16_t*)(ws + WS_QKVP);
    const float* gb = (const float*)(ws + WS_G); const float* bb = (const float*)(ws + WS_BETA);
    bf16_t* Of = (bf16_t*)a.out(); bf16_t* Ob = Of + (size_t)ML * 1024;
    const int gw = blockIdx.x * 8 + wave, NGW = gridDim.x * 8;
    for (int item = gw; item < 2048; item += NGW) {
        const int chain = item >> 6, ep = item & 63, dir = chain >> 4, b = (chain >> 3) & 1, h = chain & 7;
        bf16_t* O = dir ? Ob : Of;
        float S00 = 0.f, S01 = 0.f, S10 = 0.f, S11 = 0.f;
        const int NTOK = CTX + SEQ;
        constexpr int U = 4;
        unsigned kq[U], qq[U], vv[U]; float gg[U], be[U]; int rows[U];
        auto rowof = [&](int s) -> int { if (s < CTX) { const int t = dir ? CTX - 1 - s : s; return ML + b * CTX + t; } const int t2 = s - CTX; const int t = dir ? SEQ - 1 - t2 : t2; return b * SEQ + t; };
#define SC_LOAD(i, s) do { const int row_ = rowof(s); rows[i] = row_; const bf16_t* p_ = QP + (size_t)row_ * 3072 + h * 128; \
        qq[i] = *(const unsigned*)(p_ + 2 * lane); kq[i] = *(const unsigned*)(p_ + 1024 + 2 * lane); vv[i] = *(const unsigned*)(p_ + 2048 + 2 * ep); \
        gg[i] = gb[((size_t)dir * MT + row_) * 8 + h]; be[i] = bb[((size_t)dir * MT + row_) * 8 + h]; } while (0)
        for (int s0 = 0; s0 < NTOK; s0 += U) {
#pragma unroll
            for (int i = 0; i < U; ++i) SC_LOAD(i, s0 + i);
#pragma unroll
            for (int i = 0; i < U; ++i) {
                const float k0 = bflo(kq[i]), k1 = bfhi(kq[i]), q0 = bflo(qq[i]), q1 = bfhi(qq[i]), v0 = bflo(vv[i]), v1 = bfhi(vv[i]);
                const float eg = __expf(gg[i]), bt = be[i];
                float p0 = k0 * S00 + k1 * S10, p1 = k0 * S01 + k1 * S11;
                p0 = wave_sum(p0); p1 = wave_sum(p1);
                const float vn0 = bt * (v0 - eg * p0), vn1 = bt * (v1 - eg * p1);
                S00 = eg * S00 + k0 * vn0; S01 = eg * S01 + k0 * vn1; S10 = eg * S10 + k1 * vn0; S11 = eg * S11 + k1 * vn1;
                float o0 = q0 * S00 + q1 * S10, o1 = q0 * S01 + q1 * S11;
                o0 = wave_sum(o0); o1 = wave_sum(o1);
                if (lane == 0 && rows[i] < ML) *(unsigned*)(O + (size_t)rows[i] * 1024 + h * 128 + 2 * ep) = pk2(o0, o1);
            }
        }
#undef SC_LOAD
    }
}

DEVI bf16x8 ld_b128(LAS const unsigned char* p) { return *(LAS const bf16x8*)p; }
DEVI bf16x8 ld_2b64(LAS const unsigned char* p0, LAS const unsigned char* p1) { const u32x2 a = *(LAS const u32x2*)p0, b = *(LAS const u32x2*)p1; u32x4 w = {a.x, a.y, b.x, b.y}; return __builtin_bit_cast(bf16x8, w); }
DEVI bf16x8 pack_frag(const f32x4& lo, const f32x4& hi) { u32x4 w = {pk2(lo[0], lo[1]), pk2(lo[2], lo[3]), pk2(hi[0], hi[1]), pk2(hi[2], hi[3])}; return __builtin_bit_cast(bf16x8, w); }
#define MFMA16(A, B, C) __builtin_amdgcn_mfma_f32_16x16x32_bf16(A, B, C, 0, 0, 0)
DEVI void phase_dnchunk(const KA& a, LAS unsigned char* lds, int tid, int lane, int wave) {
    unsigned char* ws = a.ws();
    const bf16_t* QP = (const bf16_t*)(ws + WS_QKVP); const float* gb = (const float*)(ws + WS_G); const float* bb = (const float*)(ws + WS_BETA);
    bf16_t* TQ = (bf16_t*)(ws + WS_TQ); float* AV = (float*)(ws + WS_AVEC);
    constexpr int KL = 0, QL = 17408, KKF = 34816, QKF = 52224, VEC = 131072;
    const int fr = lane & 15, g = lane >> 4, d = wave >> 2, wq = wave & 3;
    LAS unsigned char* dbase = lds + d * 64512;
    LAS float* Gg = (LAS float*)(lds + VEC); LAS float* Bv = Gg + 128; LAS float* GC = Gg + 256;
    for (int item = blockIdx.x; item < 520 * 8; item += gridDim.x) {
        const int cidx = item >> 3, h = item & 7;
        const int row0 = cidx < 512 ? cidx * 64 : ML + (cidx - 512) * 64;
#pragma unroll
        for (int i = 0; i < 2; ++i) { const int c = tid + i * 512, r = c >> 4, ch = c & 15;
            const bf16_t* src = QP + (size_t)(row0 + r) * 3072 + h * 128 + ch * 8;
            *(LAS u32x4*)(lds + QL + r * 272 + ch * 16) = *(const u32x4*)src; *(LAS u32x4*)(lds + KL + r * 272 + ch * 16) = *(const u32x4*)(src + 1024); }
        if (tid < 128) { const int dd = tid >> 6, pos = tid & 63; Gg[tid] = gb[((size_t)dd * MT + row0 + pos) * 8 + h]; Bv[tid] = bb[((size_t)dd * MT + row0 + pos) * 8 + h]; }
        __syncthreads();
        if (wave < 2) {
            const int dd = wave, pos = dd ? 63 - lane : lane; float x = Gg[dd * 64 + pos];
#pragma unroll
            for (int o = 1; o < 64; o <<= 1) { const float y = __shfl_up(x, o); if (lane >= o) x += y; }
            const float total = __shfl(x, 63);
            GC[dd * 64 + pos] = x;
            float* av = AV + ((size_t)item * 2 + dd) * 256;
            av[pos] = __expf(x); av[64 + pos] = Bv[dd * 64 + pos]; av[128 + pos] = __expf(total - x); if (lane == 0) av[192] = __expf(total);
        }
        {
            const int src = d ? QL : KL;
            f32x4 acc[4] = {{0.f, 0.f, 0.f, 0.f}, {0.f, 0.f, 0.f, 0.f}, {0.f, 0.f, 0.f, 0.f}, {0.f, 0.f, 0.f, 0.f}};
#pragma unroll
            for (int s4 = 0; s4 < 4; ++s4) { const bf16x8 A = ld_b128(lds + src + (16 * wq + fr) * 272 + (32 * s4 + 8 * g) * 2);
#pragma unroll
                for (int jt = 0; jt < 4; ++jt) { const bf16x8 Bf = ld_b128(lds + KL + (16 * jt + fr) * 272 + (32 * s4 + 8 * g) * 2); acc[jt] = MFMA16(A, Bf, acc[jt]); } }
            LAS float* dst = (LAS float*)(lds + (d ? QKF : KKF));
#pragma unroll
            for (int jt = 0; jt < 4; ++jt)
#pragma unroll
                for (int r = 0; r < 4; ++r) dst[(16 * wq + 4 * g + r) * 68 + 16 * jt + fr] = acc[jt][r];
        }
        __syncthreads();
        f32x4 P[4], qd[4];
        {
            const LAS float* kkf = (const LAS float*)(lds + KKF); const LAS float* qkf = (const LAS float*)(lds + QKF);
            float gci[4], bei[4];
#pragma unroll
            for (int r = 0; r < 4; ++r) { gci[r] = GC[d * 64 + 16 * wq + 4 * g + r]; bei[r] = Bv[d * 64 + 16 * wq + 4 * g + r]; }
#pragma unroll
            for (int jt = 0; jt < 4; ++jt) { const int j = 16 * jt + fr; const float gcj = GC[d * 64 + j];
#pragma unroll
                for (int r = 0; r < 4; ++r) { const int i = 16 * wq + 4 * g + r; const bool incl = d ? (i <= j) : (i >= j);
                    const float e = incl ? __expf(gci[r] - gcj) : 0.f;
                    qd[jt][r] = qkf[i * 68 + j] * e; P[jt][r] = (i != j) ? -bei[r] * kkf[i * 68 + j] * e : 0.f; } }
        }
        __syncthreads();
        {
#pragma unroll
            for (int jt = 0; jt < 4; ++jt) {
#pragma unroll
                for (int r = 0; r < 4; ++r) { const int i = 16 * wq + 4 * g + r, j = 16 * jt + fr;
                    *(LAS unsigned short*)(dbase + 0 + i * 144 + j * 2) = (unsigned short)f2bf(P[jt][r]);
                    *(LAS unsigned short*)(dbase + 36864 + 9216 + i * 144 + j * 2) = (unsigned short)f2bf(P[jt][r]);
                    *(LAS unsigned short*)(dbase + 55296 + i * 144 + j * 2) = (unsigned short)f2bf(qd[jt][r]); }
                u32x2 w = {pk2(P[jt][0], P[jt][1]), pk2(P[jt][2], P[jt][3])};
                *(LAS u32x2*)(dbase + 18432 + (16 * jt + fr) * 144 + (16 * wq + 4 * g) * 2) = w; }
        }
        __syncthreads();
        int cur = 0;
#pragma unroll 1
        for (int it = 0; it < 5; ++it) {
            LAS unsigned char* NRc = dbase + cur * 9216; LAS unsigned char* NTc = dbase + 18432 + cur * 9216;
            LAS unsigned char* NRn = dbase + (cur ^ 1) * 9216; LAS unsigned char* NTn = dbase + 18432 + (cur ^ 1) * 9216;
            LAS unsigned char* PRo = dbase + 36864 + ((it + 1) & 1) * 9216; LAS unsigned char* PRn = dbase + 36864 + (it & 1) * 9216;
            f32x4 n2[4] = {{0.f, 0.f, 0.f, 0.f}, {0.f, 0.f, 0.f, 0.f}, {0.f, 0.f, 0.f, 0.f}, {0.f, 0.f, 0.f, 0.f}};
#pragma unroll
            for (int s2 = 0; s2 < 2; ++s2) { const bf16x8 A = ld_b128(NRc + (16 * wq + fr) * 144 + (32 * s2 + 8 * g) * 2);
#pragma unroll
                for (int jt = 0; jt < 4; ++jt) { const bf16x8 Bf = ld_b128(NTc + (16 * jt + fr) * 144 + (32 * s2 + 8 * g) * 2); n2[jt] = MFMA16(A, Bf, n2[jt]); } }
#pragma unroll
            for (int jt = 0; jt < 4; ++jt) {
#pragma unroll
                for (int r = 0; r < 4; ++r) *(LAS unsigned short*)(NRn + (16 * wq + 4 * g + r) * 144 + (16 * jt + fr) * 2) = (unsigned short)f2bf(n2[jt][r]);
                u32x2 w = {pk2(n2[jt][0], n2[jt][1]), pk2(n2[jt][2], n2[jt][3])};
                *(LAS u32x2*)(NTn + (16 * jt + fr) * 144 + (16 * wq + 4 * g) * 2) = w;
                P[jt] += n2[jt]; }
            __syncthreads();
#pragma unroll
            for (int s2 = 0; s2 < 2; ++s2) { const bf16x8 A = ld_b128(PRo + (16 * wq + fr) * 144 + (32 * s2 + 8 * g) * 2);
#pragma unroll
                for (int jt = 0; jt < 4; ++jt) { const bf16x8 Bf = ld_b128(NTn + (16 * jt + fr) * 144 + (32 * s2 + 8 * g) * 2); P[jt] = MFMA16(A, Bf, P[jt]); } }
#pragma unroll
            for (int jt = 0; jt < 4; ++jt)
#pragma unroll
                for (int r = 0; r < 4; ++r) *(LAS unsigned short*)(PRn + (16 * wq + 4 * g + r) * 144 + (16 * jt + fr) * 2) = (unsigned short)f2bf(P[jt][r]);
            cur ^= 1;
        }
        __syncthreads();
        {
            bf16_t* dst = TQ + ((size_t)item * 2 + d) * 8192; const int t2 = tid & 255;
#pragma unroll
            for (int k = 0; k < 4; ++k) { const int c = t2 + 256 * k, mat = c >> 9, r = (c >> 3) & 63, ch = c & 7;
                const u32x4 v = *(LAS const u32x4*)(dbase + (mat ? 55296 : 36864) + r * 144 + ch * 16);
                *(u32x4*)(dst + mat * 4096 + r * 64 + ch * 8) = v; }
        }
        __syncthreads();
    }
}

DEVI void phase_dnchunk2(const KA& a, LAS unsigned char* lds, int tid, int lane, int wave) {
    unsigned char* ws = a.ws();
    const bf16_t* QP = (const bf16_t*)(ws + WS_QKVP); const float* gb = (const float*)(ws + WS_G); const float* bb = (const float*)(ws + WS_BETA);
    bf16_t* TQ = (bf16_t*)(ws + WS_TQ); float* AV = (float*)(ws + WS_AVEC);
    const int fr = lane & 15, g = lane >> 4, wi = wave >> 1, dir = wave & 1;
    LAS unsigned char* kl = lds + wi * 32768;
    LAS float* vec = (LAS float*)(lds + 131072 + wave * 1024);
    for (int grp = blockIdx.x; grp < 1040; grp += gridDim.x) {
        int tl = tid; asm volatile("" : "+v"(tl));
#pragma unroll
        for (int i = 0; i < 16; ++i) { const int c = tl + 512 * i, it = c >> 11, qk = (c >> 10) & 1, r = (c >> 4) & 63, ch = c & 15;
            const int item_ = grp * 4 + it, ci_ = item_ >> 3, h_ = item_ & 7; const int row0_ = ci_ < 512 ? ci_ * 64 : ML + (ci_ - 512) * 64;
            const u32x4 x = *(const u32x4*)(QP + (size_t)(row0_ + r) * 3072 + qk * 1024 + h_ * 128 + ch * 8);
            *(LAS u32x4*)(lds + it * 32768 + (qk ? 0 : 16384) + r * 256 + ((ch ^ (r & 15)) << 4)) = x; }
        const int item = grp * 4 + wi, cidx = item >> 3, h = item & 7;
        const int row0 = cidx < 512 ? cidx * 64 : ML + (cidx - 512) * 64;
        {
            const int pos = dir ? 63 - lane : lane;
            float x = gb[((size_t)dir * MT + row0 + pos) * 8 + h]; const float be = bb[((size_t)dir * MT + row0 + pos) * 8 + h];
#pragma unroll
            for (int o = 1; o < 64; o <<= 1) { const float y = __shfl_up(x, o); if (lane >= o) x += y; }
            const float total = __shfl(x, 63);
            vec[pos] = x; vec[64 + pos] = be;
            float* av = AV + ((size_t)item * 2 + dir) * 256;
            av[pos] = __expf(x); av[64 + pos] = be; av[128 + pos] = __expf(total - x); if (lane == 0) av[192] = __expf(total);
        }
        __syncthreads();
        bf16_t* tq = TQ + ((size_t)item * 2 + dir) * 8192;
        bf16x8 KF[4][4];
#pragma unroll
        for (int t = 0; t < 4; ++t)
#pragma unroll
            for (int ks = 0; ks < 4; ++ks) KF[t][ks] = ld_b128(kl + (16 * t + fr) * 256 + (((4 * ks + g) ^ fr) << 4));
        {
            bf16x8 QF[4][4];
#pragma unroll
            for (int t = 0; t < 4; ++t)
#pragma unroll
                for (int ks = 0; ks < 4; ++ks) QF[t][ks] = ld_b128(kl + 16384 + (16 * t + fr) * 256 + (((4 * ks + g) ^ fr) << 4));
#pragma unroll
            for (int rt = 0; rt < 4; ++rt)
#pragma unroll
                for (int ct = 0; ct < 4; ++ct) { f32x4 acc = {0.f, 0.f, 0.f, 0.f};
#pragma unroll
                    for (int ks = 0; ks < 4; ++ks) acc = MFMA16(KF[rt][ks], QF[ct][ks], acc);
                    float o[4]; const f32x4 gxv = *(const LAS f32x4*)(vec + 16 * rt + 4 * g); const float gyv = vec[16 * ct + fr];
#pragma unroll
                    for (int r = 0; r < 4; ++r) { const int x = 16 * rt + 4 * g + r, y = 16 * ct + fr; const bool inc = dir ? (y <= x) : (y >= x);
                        o[r] = inc ? acc[r] * __expf(gyv - gxv[r]) : 0.f; }
                    const u32x2 w = {pk2(o[0], o[1]), pk2(o[2], o[3])};
                    *(u32x2*)(tq + 4096 + (16 * ct + fr) * 64 + 16 * rt + 4 * g) = w; }
        }
        f32x4 PT[4][4]; bf16x8 XD[2][4], XT[2][4];
#pragma unroll
        for (int ct = 0; ct < 4; ++ct)
#pragma unroll
            for (int s2 = 0; s2 < 2; ++s2) { f32x4 nd[2], nt[2];
#pragma unroll
                for (int u = 0; u < 2; ++u) { const int rt = 2 * s2 + u; f32x4 acc = {0.f, 0.f, 0.f, 0.f};
#pragma unroll
                    for (int ks = 0; ks < 4; ++ks) acc = MFMA16(KF[rt][ks], KF[ct][ks], acc);
                    const f32x4 gxv = *(const LAS f32x4*)(vec + 16 * rt + 4 * g), bxv = *(const LAS f32x4*)(vec + 64 + 16 * rt + 4 * g); const float gyv = vec[16 * ct + fr], byv = vec[64 + 16 * ct + fr];
#pragma unroll
                    for (int r = 0; r < 4; ++r) { const int x = 16 * rt + 4 * g + r, y = 16 * ct + fr;
                        const bool cd = dir ? (x < y) : (x > y), ct_ = dir ? (y < x) : (y > x);
                        nd[u][r] = cd ? -bxv[r] * acc[r] * __expf(gxv[r] - gyv) : 0.f;
                        nt[u][r] = ct_ ? -byv * acc[r] * __expf(gyv - gxv[r]) : 0.f; }
                    PT[rt][ct] = nt[u]; }
                XD[s2][ct] = pack_frag(nd[0], nd[1]); XT[s2][ct] = pack_frag(nt[0], nt[1]); }
#pragma unroll 1
        for (int it = 0; it < 5; ++it) {
            bf16x8 XD2[2][4], XT2[2][4];
#pragma unroll
            for (int ct = 0; ct < 4; ++ct)
#pragma unroll
                for (int s2 = 0; s2 < 2; ++s2) { f32x4 t2[2];
#pragma unroll
                    for (int u = 0; u < 2; ++u) { const int rt = 2 * s2 + u; f32x4 acc = {0.f, 0.f, 0.f, 0.f};
                        acc = MFMA16(XT[0][rt], XD[0][ct], acc); acc = MFMA16(XT[1][rt], XD[1][ct], acc); t2[u] = acc; }
                    XD2[s2][ct] = pack_frag(t2[0], t2[1]); }
#pragma unroll
            for (int ct = 0; ct < 4; ++ct) { const bf16x8 pb0 = pack_frag(PT[0][ct], PT[1][ct]), pb1 = pack_frag(PT[2][ct], PT[3][ct]);
#pragma unroll
                for (int rt = 0; rt < 4; ++rt) { f32x4 acc = PT[rt][ct]; acc = MFMA16(XD2[0][rt], pb0, acc); acc = MFMA16(XD2[1][rt], pb1, acc); PT[rt][ct] = acc; } }
#pragma unroll
            for (int ct = 0; ct < 4; ++ct)
#pragma unroll
                for (int s2 = 0; s2 < 2; ++s2) { f32x4 t2[2];
#pragma unroll
                    for (int u = 0; u < 2; ++u) { const int rt = 2 * s2 + u; f32x4 acc = {0.f, 0.f, 0.f, 0.f};
                        acc = MFMA16(XD[0][rt], XT[0][ct], acc); acc = MFMA16(XD[1][rt], XT[1][ct], acc); t2[u] = acc; PT[rt][ct] += acc; }
                    XT2[s2][ct] = pack_frag(t2[0], t2[1]); }
#pragma unroll
            for (int s2 = 0; s2 < 2; ++s2)
#pragma unroll
                for (int ct = 0; ct < 4; ++ct) { XD[s2][ct] = XD2[s2][ct]; XT[s2][ct] = XT2[s2][ct]; }
        }
#pragma unroll
        for (int rt = 0; rt < 4; ++rt)
#pragma unroll
            for (int ct = 0; ct < 4; ++ct) { const u32x2 w = {pk2(PT[rt][ct][0], PT[rt][ct][1]), pk2(PT[rt][ct][2], PT[rt][ct][3])};
                *(u32x2*)(tq + (16 * ct + fr) * 64 + 16 * rt + 4 * g) = w; }
        __syncthreads();
    }
}

DEVI void phase_dnscan2(const KA& a, LAS unsigned char* lds, int tid, int lane, int wave, unsigned long long& pr_extra) {
    const int v = blockIdx.x;
    unsigned char* ws = a.ws();
    const bf16_t* QP = (const bf16_t*)(ws + WS_QKVP); const bf16_t* TQ = (const bf16_t*)(ws + WS_TQ); const float* AV = (const float*)(ws + WS_AVEC);
    unsigned* prog = (unsigned*)(ws + CTL_PROG);
    constexpr int NSTEP = 260;
    int vrole = v;
#if MK_ONE_LAUNCH
    {
        unsigned* bar_ = (unsigned*)(ws + WS_CTL); unsigned* xr_ = (unsigned*)(ws + CTL_XRANK);
        bool dyn = gridDim.x == 256;
#pragma unroll
        for (int j = 0; j < 16; ++j) { const unsigned c_ = __hip_atomic_load(&bar_[256 + 64 * j], __ATOMIC_RELAXED, __HIP_MEMORY_SCOPE_AGENT); dyn = dyn && (c_ == (j < 8 ? 32u : 0u)); }
        if (PROBE_SUB == 7 && !dyn) pr_extra += 50000ull;
        if (dyn) {
            const unsigned xcc = (unsigned)__builtin_amdgcn_s_getreg((3 << 11) | 20) & 0xFu;
            LAS unsigned* bw = (LAS unsigned*)(lds + 147200);
            if (tid == 0) *bw = __hip_atomic_fetch_add(&xr_[xcc * 64], 1u, __ATOMIC_RELAXED, __HIP_MEMORY_SCOPE_AGENT);
            __syncthreads();
            const unsigned rank = *bw & 31u;
            vrole = rank < 16u ? (int)(xcc + 8u * (rank >> 2) + 32u * (rank & 3u)) : (int)(128u + xcc + 8u * ((rank - 16u) >> 2) + 32u * ((rank - 16u) & 3u));
            __syncthreads();
        }
    }
#endif
    if (vrole < 128) {
    const int chain = (vrole & 7) + 8 * ((vrole >> 3) & 3), qt = vrole >> 5, dir = chain >> 4, b = (chain >> 3) & 1, h = chain & 7;
    bf16_t* O = (bf16_t*)a.out() + (size_t)dir * ML * 1024;
    constexpr int KL = 0, QL = 16384, TL = 32768, DL = 40960, VL = 49152, AL = 53248, BUFB = 54272, OT = 2 * BUFB, SBX = OT + 8192, XBX = SBX + 16384, FLG = XBX + 4096;
    const int fr0 = lane & 15, g0 = lane >> 4, ltid = tid - 256;
    auto step_cidx = [&](int s) -> int { if (s < 4) return 512 + b * 4 + (dir ? 3 - s : s); const int c = s - 4; return b * 256 + (dir ? 255 - c : c); };
    struct LSet { u32x4 q[4], k[4], t[2], d[2], v, av; };
#define LD_ISSUE(R, s_) do { const int cidx_ = step_cidx(s_); const int row0_ = cidx_ < 512 ? cidx_ * 64 : ML + (cidx_ - 512) * 64; \
        const bf16_t* tqb_ = TQ + ((size_t)(cidx_ * 8 + h) * 2 + dir) * 8192; const float* avb_ = AV + ((size_t)(cidx_ * 8 + h) * 2 + dir) * 256; \
        int lt_ = ltid; asm volatile("" : "+v"(lt_)); \
        const bf16_t* pq_ = QP + (size_t)(row0_ + (lt_ >> 4)) * 3072 + h * 128 + (lt_ & 15) * 8; \
        const bf16_t* pt_ = tqb_ + (lt_ >> 3) * 64 + (lt_ & 7) * 8; \
        _Pragma("unroll") for (int i = 0; i < 4; ++i) { R.q[i] = *(const u32x4*)(pq_ + (size_t)i * 16 * 3072); R.k[i] = *(const u32x4*)(pq_ + (size_t)i * 16 * 3072 + 1024); } \
        _Pragma("unroll") for (int i = 0; i < 2; ++i) { R.t[i] = *(const u32x4*)(pt_ + i * 32 * 64); R.d[i] = *(const u32x4*)(pt_ + 4096 + i * 32 * 64); } \
        R.v = *(const u32x4*)(QP + (size_t)(row0_ + (lt_ >> 2)) * 3072 + 2048 + h * 128 + qt * 32 + (lt_ & 3) * 8); \
        R.av = *(const u32x4*)(avb_ + (lt_ & 63) * 4); } while (0)
#define LD_WRITE(R, bo_) do { int lt_ = ltid; asm volatile("" : "+v"(lt_)); LAS unsigned char* B_ = lds + (bo_); \
        const int chq_ = lt_ & 15, cht_ = lt_ & 7; \
        _Pragma("unroll") for (int i = 0; i < 4; ++i) { const int r = (lt_ >> 4) + 16 * i; const int o_ = r * 256 + ((chq_ ^ (4 * (r & 3) + ((r >> 3) & 3))) << 4); \
            *(LAS u32x4*)(B_ + QL + o_) = R.q[i]; *(LAS u32x4*)(B_ + KL + o_) = R.k[i]; } \
        _Pragma("unroll") for (int i = 0; i < 2; ++i) { const int r = (lt_ >> 3) + 32 * i; const int o_ = r * 128 + ((cht_ ^ (2 * ((r >> 3) & 3) + ((r >> 1) & 1))) << 4); \
            *(LAS u32x4*)(B_ + TL + o_) = R.t[i]; *(LAS u32x4*)(B_ + DL + o_) = R.d[i]; } \
        { const int r = lt_ >> 2; *(LAS u32x4*)(B_ + VL + r * 64 + (((lt_ & 3) ^ (2 * ((r >> 3) & 1))) << 4)) = R.v; } \
        if (lt_ < 64) *(LAS u32x4*)(B_ + AL + lt_ * 16) = R.av; } while (0)
#define OT_OUT(s_) do { const int cidx_ = step_cidx(s_); const int row0_ = cidx_ * 64; LAS const unsigned char* ot_ = lds + OT + ((s_) & 1) * 4096; \
        int lt_ = ltid; asm volatile("" : "+v"(lt_)); \
        { const int r = lt_ >> 2, ch = lt_ & 3; \
            *(u32x4*)(O + (size_t)(row0_ + r) * 1024 + h * 128 + qt * 32 + ch * 8) = *(LAS const u32x4*)(ot_ + r * 64 + ((ch ^ (2 * ((r >> 3) & 1))) << 4)); } } while (0)
#define STEP_BAR(wsel) do { const unsigned long long tb_ = PROBE_SUB ? __builtin_amdgcn_s_memrealtime() : 0ull; \
        asm volatile("s_waitcnt lgkmcnt(0)" ::: "memory"); __builtin_amdgcn_s_barrier(); asm volatile("" ::: "memory"); \
        if ((PROBE_SUB == 1 && wave == 0 && (wsel) == 0) || (PROBE_SUB == 2 && wave == 4 && (wsel) == 1) || (PROBE_SUB == 3 && wave == 2 && (wsel) == 3)) pr_extra += __builtin_amdgcn_s_memrealtime() - tb_; } while (0)
#define LOAD_STEP(s, RW) do { STEP_BAR(1); \
            if (qt == 0 && ltid == 0) __hip_atomic_store(prog + chain * 64, (unsigned)((s) + 1), __ATOMIC_RELAXED, __HIP_MEMORY_SCOPE_AGENT); \
            { const unsigned long long tw_ = (PROBE_SUB == 5) ? __builtin_amdgcn_s_memrealtime() : 0ull; if ((s) + 1 < NSTEP) LD_WRITE(RW, (((s) + 1) & 1) * BUFB); \
              if (PROBE_SUB == 5 && wave == 4) { asm volatile("s_waitcnt lgkmcnt(0)" ::: "memory"); pr_extra += __builtin_amdgcn_s_memrealtime() - tw_; } } \
            if ((s) + 4 < NSTEP) LD_ISSUE(RW, (s) + 4); \
            if ((s) >= 5) OT_OUT((s) - 1); } while (0)
#define SBAR_() do {} while (0)
#define ROWK(pt) ((32 * ((pt) >> 1) + 4 * ((pt) & 1) + rowl) * 256)
#define ROWT(pt) ((32 * ((pt) >> 1) + 4 * ((pt) & 1) + rowl) * 128)
#define P0(pt) (32 * ((pt) >> 1) + 8 * g + 4 * ((pt) & 1))
#define LDK8(dst, base, pa) do { _Pragma("unroll") for (int s4 = 0; s4 < 4; ++s4) { dst[s4] = ld_b128(B + (base) + ROWK(pa) + (((4 * s4 + g) ^ fk) << 4)); dst[4 + s4] = ld_b128(B + (base) + ROWK((pa) + 1) + (((4 * s4 + g) ^ fk) << 4)); } } while (0)
#define LDT8(dst, base) do { _Pragma("unroll") for (int pt = 0; pt < 4; ++pt) { dst[2 * pt] = ld_b128(B + (base) + ROWT(pt) + ((g ^ ft) << 4)); dst[2 * pt + 1] = ld_b128(B + (base) + ROWT(pt) + (((4 + g) ^ ft) << 4)); } } while (0)
#define MM8(acc, fa, pa) do { _Pragma("unroll") for (int s4 = 0; s4 < 4; ++s4) { acc[pa] = MFMA16(fa[s4], Sb[s4], acc[pa]); acc[(pa) + 1] = MFMA16(fa[4 + s4], Sb[s4], acc[(pa) + 1]); } } while (0)
    if (wave >= 4) {
        LSet R0, R1, R2;
        LD_ISSUE(R0, 0); LD_WRITE(R0, 0); LD_ISSUE(R1, 1); LD_ISSUE(R2, 2); LD_ISSUE(R0, 3);
#pragma unroll 1
        for (int s0 = 0; s0 < NSTEP; s0 += 3) {
            LOAD_STEP(s0, R1);
            if (s0 + 1 < NSTEP) LOAD_STEP(s0 + 1, R2);
            if (s0 + 2 < NSTEP) LOAD_STEP(s0 + 2, R0);
        }
        STEP_BAR(2);
        OT_OUT(NSTEP - 1);
    } else if (wave < 2) {
        f32x4 S[8];
#pragma unroll
        for (int i = 0; i < 8; ++i) S[i] = (f32x4){0.f, 0.f, 0.f, 0.f};
        bf16x8 Sb[4];
#pragma unroll
        for (int s4 = 0; s4 < 4; ++s4) { Sb[s4] = (bf16x8){0, 0, 0, 0, 0, 0, 0, 0}; *(LAS bf16x8*)(lds + SBX + wave * 4096 + s4 * 1024 + lane * 16) = Sb[s4]; }
        if (lane == 0) *(LAS unsigned*)(lds + FLG + wave * 4) = 0u;
#pragma unroll 1
        for (int s = 0; s < NSTEP; ++s) {
            STEP_BAR(0);
            int fr = fr0, g = g0; asm volatile("" : "+v"(fr), "+v"(g));
            LAS const unsigned char* B = lds + (s & 1) * BUFB;
            const LAS float* avl = (const LAS float*)(B + AL);
            const int rowl = 8 * (fr >> 2) + (fr & 3);
            const int fk = 4 * (fr & 3) + (fr >> 2), ft = 2 * (fr >> 2) + ((fr >> 1) & 1);
            const int vcol = ((((2 * wave + (fr >> 3)) ^ (2 * (g & 1))) << 4) + (fr & 7) * 2);
            const int trq = fr >> 2, trp = fr & 3;
            LAS unsigned char* kp0 = (LAS unsigned char*)(B + KL + (8 * g + trq) * 256);
            const int fkt = 4 * trq + g;
#define KT_LOAD(dst, d0) do { _Pragma("unroll") for (int j = 0; j < 4; ++j) { const int dt_ = (d0) + j; const int co = (((4 * (dt_ >> 1) + trp) ^ fkt) << 4) + 8 * (dt_ & 1); \
                const s16x4 a0 = __builtin_bit_cast(s16x4, __builtin_amdgcn_ds_read_tr16_b64_v4i16((LAS s16x4*)(kp0 + co))), a1 = __builtin_bit_cast(s16x4, __builtin_amdgcn_ds_read_tr16_b64_v4i16((LAS s16x4*)(kp0 + co + 4 * 256))); \
                const s16x4 a2 = __builtin_bit_cast(s16x4, __builtin_amdgcn_ds_read_tr16_b64_v4i16((LAS s16x4*)(kp0 + co + 32 * 256))), a3 = __builtin_bit_cast(s16x4, __builtin_amdgcn_ds_read_tr16_b64_v4i16((LAS s16x4*)(kp0 + co + 36 * 256))); \
                dst[2 * j] = (bf16x8){a0[0], a0[1], a0[2], a0[3], a1[0], a1[1], a1[2], a1[3]}; dst[2 * j + 1] = (bf16x8){a2[0], a2[1], a2[2], a2[3], a3[0], a3[1], a3[2], a3[3]}; } } while (0)
            bf16x8 fA[8], fB[8], fC[8];
            f32x4 avp[4], bvp[4]; unsigned short vraw[4][4];
            const unsigned long long t6_ = (PROBE_SUB == 6) ? __builtin_amdgcn_s_memrealtime() : 0ull;
            LDK8(fA, KL, 0); LDK8(fB, KL, 2);
            if (PROBE_SUB == 6 && wave == 0) { asm volatile("s_waitcnt lgkmcnt(0)" ::: "memory"); pr_extra += __builtin_amdgcn_s_memrealtime() - t6_; }
#pragma unroll
            for (int pt = 0; pt < 4; ++pt) { avp[pt] = *(const LAS f32x4*)(avl + P0(pt)); bvp[pt] = *(const LAS f32x4*)(avl + 64 + P0(pt));
#pragma unroll
                for (int r = 0; r < 4; ++r) vraw[pt][r] = *(const LAS unsigned short*)(B + VL + (P0(pt) + r) * 64 + vcol); }
            f32x4 Z[4], X[4];
#pragma unroll
            for (int pt = 0; pt < 4; ++pt) Z[pt] = (f32x4){0.f, 0.f, 0.f, 0.f};
            SBAR_();
            LDT8(fC, TL); SBAR_(); MM8(Z, fA, 0); SBAR_();
            KT_LOAD(fA, 0); SBAR_(); MM8(Z, fB, 2); SBAR_();
#pragma unroll
            for (int pt = 0; pt < 4; ++pt)
#pragma unroll
                for (int r = 0; r < 4; ++r) Z[pt][r] = bvp[pt][r] * (bf2f(vraw[pt][r]) - avp[pt][r] * Z[pt][r]);
            KT_LOAD(fB, 4); SBAR_();
            { const bf16x8 Zb0 = pack_frag(Z[0], Z[1]), Zb1 = pack_frag(Z[2], Z[3]);
#pragma unroll
              for (int pt = 0; pt < 4; ++pt) { X[pt] = MFMA16(fC[2 * pt], Zb0, Z[pt]); X[pt] = MFMA16(fC[2 * pt + 1], Zb1, X[pt]); } }
            SBAR_();
            const float egl = avl[192];
            bf16x8 Xc0, Xc1;
            { const bf16x8 Xb0 = pack_frag(X[0], X[1]), Xb1 = pack_frag(X[2], X[3]);
              *(LAS bf16x8*)(lds + XBX + wave * 2048 + lane * 16) = Xb0; *(LAS bf16x8*)(lds + XBX + wave * 2048 + 1024 + lane * 16) = Xb1;
              if (lane == 0) *(LAS volatile unsigned*)(lds + FLG + wave * 4) = (unsigned)(s + 1);
              f32x4 cx[4];
#pragma unroll
              for (int pt = 0; pt < 4; ++pt) cx[pt] = X[pt] * *(const LAS f32x4*)(avl + 128 + P0(pt));
              Xc0 = pack_frag(cx[0], cx[1]); Xc1 = pack_frag(cx[2], cx[3]); }
            SBAR_();
#pragma unroll
            for (int j = 0; j < 4; ++j) { f32x4 sn = S[j] * egl; sn = MFMA16(fA[2 * j], Xc0, sn); S[j] = MFMA16(fA[2 * j + 1], Xc1, sn); }
            SBAR_();
#pragma unroll
            for (int j = 0; j < 4; ++j) { f32x4 sn = S[4 + j] * egl; sn = MFMA16(fB[2 * j], Xc0, sn); S[4 + j] = MFMA16(fB[2 * j + 1], Xc1, sn); }
#pragma unroll
            for (int s4 = 0; s4 < 4; ++s4) { Sb[s4] = pack_frag(S[2 * s4], S[2 * s4 + 1]); *(LAS bf16x8*)(lds + SBX + ((s + 1) & 1) * 8192 + wave * 4096 + s4 * 1024 + lane * 16) = Sb[s4]; }
#undef KT_LOAD
        }
        STEP_BAR(2);
    } else {
        const int sl = wave - 2;
#pragma unroll 1
        for (int s = 0; s < NSTEP; ++s) {
            STEP_BAR(3);
            if (s >= 4) {
            int fr = fr0, g = g0; asm volatile("" : "+v"(fr), "+v"(g));
            LAS const unsigned char* B = lds + (s & 1) * BUFB;
            const LAS float* avl = (const LAS float*)(B + AL);
            const int rowl = 8 * (fr >> 2) + (fr & 3);
            const int fk = 4 * (fr & 3) + (fr >> 2), ft = 2 * (fr >> 2) + ((fr >> 1) & 1);
            const int vcol = ((((2 * sl + (fr >> 3)) ^ (2 * (g & 1))) << 4) + (fr & 7) * 2);
            bf16x8 fA[8], fB[8], fC[8], Sb[4];
            LDK8(fA, QL, 0); LDK8(fB, QL, 2);
#pragma unroll
            for (int s4 = 0; s4 < 4; ++s4) Sb[s4] = *(const LAS bf16x8*)(lds + SBX + (s & 1) * 8192 + sl * 4096 + s4 * 1024 + lane * 16);
            f32x4 OQ[4], avp[4];
#pragma unroll
            for (int pt = 0; pt < 4; ++pt) { OQ[pt] = (f32x4){0.f, 0.f, 0.f, 0.f}; avp[pt] = *(const LAS f32x4*)(avl + P0(pt)); }
            SBAR_();
            LDT8(fC, DL); SBAR_(); MM8(OQ, fA, 0); SBAR_(); MM8(OQ, fB, 2); SBAR_();
            { unsigned spins = 0;
              while ((unsigned)__builtin_amdgcn_readfirstlane((int)*(LAS volatile unsigned*)(lds + FLG + sl * 4)) != (unsigned)(s + 1)) { __builtin_amdgcn_s_sleep(1); if (++spins > (1u << 22)) break; } }
            asm volatile("" ::: "memory");
            const bf16x8 Xb0 = *(const LAS bf16x8*)(lds + XBX + sl * 2048 + lane * 16), Xb1 = *(const LAS bf16x8*)(lds + XBX + sl * 2048 + 1024 + lane * 16);
#pragma unroll
            for (int pt = 0; pt < 4; ++pt) { f32x4 o2 = OQ[pt] * avp[pt]; o2 = MFMA16(fC[2 * pt], Xb0, o2); OQ[pt] = MFMA16(fC[2 * pt + 1], Xb1, o2); }
            { LAS unsigned char* ot = lds + OT + (s & 1) * 4096;
#pragma unroll
              for (int pt = 0; pt < 4; ++pt)
#pragma unroll
                  for (int r = 0; r < 4; ++r) *(LAS unsigned short*)(ot + (P0(pt) + r) * 64 + vcol) = (unsigned short)f2bf(OQ[pt][r]); }
            }
        }
        STEP_BAR(2);
    }
#undef LDK8
#undef LDT8
#undef MM8
#undef ROWK
#undef ROWT
#undef P0
#undef SBAR_
#undef LOAD_STEP
#undef STEP_BAR
#undef LD_ISSUE
#undef LD_WRITE
#undef OT_OUT
    } else {
        const int vp = vrole - 128, chain = (vp & 7) + 8 * ((vp >> 3) & 3), role = vp >> 5, dir = chain >> 4, b = (chain >> 3) & 1, h = chain & 7;
        const int nteam = (((int)gridDim.x - 128) >> 5) * 8;
        constexpr int PFD2 = 6;
        if (role * 8 + wave < nteam) {
#pragma unroll 1
        for (int st = role * 8 + wave; st < NSTEP; st += nteam) {
            unsigned spins = 0;
            while ((int)__builtin_amdgcn_readfirstlane((int)__hip_atomic_load(prog + chain * 64, __ATOMIC_RELAXED, __HIP_MEMORY_SCOPE_AGENT)) + PFD2 < st) { __builtin_amdgcn_s_sleep(8); if (++spins > (1u << 20)) break; }
            int cidx; if (st < 4) cidx = 512 + b * 4 + (dir ? 3 - st : st); else { const int c = st - 4; cidx = b * 256 + (dir ? 255 - c : c); }
            const int row0 = cidx < 512 ? cidx * 64 : ML + (cidx - 512) * 64;
            const char* tqb = (const char*)(TQ + ((size_t)(cidx * 8 + h) * 2 + dir) * 8192); const char* avb = (const char*)(AV + ((size_t)(cidx * 8 + h) * 2 + dir) * 256);
            unsigned acc = 0;
#pragma unroll
            for (int j = 0; j < 9; ++j) { const int L = j * 64 + lane; const char* p_;
                if (L < 384) { const int rw = L / 6, part = L - rw * 6; p_ = (const char*)(QP + (size_t)(row0 + rw) * 3072 + h * 128) + (part >> 1) * 2048 + (part & 1) * 128; }
                else if (L < 512) p_ = tqb + (L - 384) * 128; else p_ = avb + ((L - 512) & 7) * 128;
                acc ^= *(const unsigned*)p_; }
            asm volatile("" :: "v"(acc));
        }
        }
    }
}

DEVI void phase_prep2(const KA& a, int lane, int wave) {
    unsigned char* ws = a.ws();
    bf16_t* KAT = (bf16_t*)(ws + WS_KAT); const float* rope = (const float*)(ws + SM_ROPE); const float* knw = a.in(14);
    const int gw = blockIdx.x * 8 + wave, NGW = gridDim.x * 8;
    for (int row = gw; row < MT; row += NGW) {
        bf16_t* p = (row < ML ? KAT + (size_t)row * 256 : (bf16_t*)(ws + WS_CTXK) + (size_t)(row - ML) * 256) + lane * 4;
        const u32x2 w = *(const u32x2*)p;
        float x[4] = {bflo(w.x), bfhi(w.x), bflo(w.y), bfhi(w.y)};
        float ss = (x[0] * x[0] + x[1] * x[1]) + (x[2] * x[2] + x[3] * x[3]);
        ss += __shfl_xor(ss, 1); ss += __shfl_xor(ss, 2); ss += __shfl_xor(ss, 4); ss += __shfl_xor(ss, 8); ss += __shfl_xor(ss, 16);
        const float rs = rsqrtf(ss * (1.f / 128.f) + EPS);
        const int d = (lane & 31) * 4;
        const f32x4 nw = *(const f32x4*)(knw + d);
#pragma unroll
        for (int i = 0; i < 4; ++i) x[i] = x[i] * rs * nw[i];
        float pr[4];
#pragma unroll
        for (int i = 0; i < 4; ++i) pr[i] = __shfl_xor(x[i], 8);
        if (row < ML) {
            const int t = row & (SEQ - 1), lg = (lane & 31) >> 3, fi = (lane & 7) * 4;
            const float* ct = lg < 2 ? rope + (t >> 6) * 32 + fi : rope + 16384 + (t & 63) * 32 + fi;
            const float* st = lg < 2 ? ct + 8192 : ct + 2048;
            const f32x4 c = *(const f32x4*)ct, s = *(const f32x4*)st;
            const float sg = (lg & 1) ? 1.f : -1.f;
#pragma unroll
            for (int i = 0; i < 4; ++i) x[i] = x[i] * c[i] + sg * pr[i] * s[i];
        }
        u32x2 o; o.x = pk2(x[0], x[1]); o.y = pk2(x[2], x[3]);
        *(u32x2*)p = o;
    }
    const bf16_t* Of = (const bf16_t*)a.out(); const bf16_t* Ob = Of + (size_t)ML * 1024;
    const bf16_t* GT = (const bf16_t*)(ws + WS_GT); bf16_t* Y = (bf16_t*)(ws + WS_Y); const float* dnw = a.in(12);
    for (int row = gw; row < ML; row += NGW) {
        const int c0 = lane * 16;
        float o[16];
#pragma unroll
        for (int hh = 0; hh < 2; ++hh) {
            const u32x4 f = *(const u32x4*)(Of + (size_t)row * 1024 + c0 + hh * 8), bk = *(const u32x4*)(Ob + (size_t)row * 1024 + c0 + hh * 8);
#pragma unroll
            for (int i = 0; i < 4; ++i) { o[hh * 8 + 2 * i] = bflo(f[i]) + bflo(bk[i]); o[hh * 8 + 2 * i + 1] = bfhi(f[i]) + bfhi(bk[i]); }
        }
        float ss = 0.f;
#pragma unroll
        for (int i = 0; i < 16; ++i) ss += o[i] * o[i];
        ss += __shfl_xor(ss, 1); ss += __shfl_xor(ss, 2); ss += __shfl_xor(ss, 4);
        const float rs = rsqrtf(ss * (1.f / 128.f) + EPS);
        const int d0 = c0 & 127;
#pragma unroll
        for (int hh = 0; hh < 2; ++hh) {
            const u32x4 gt = *(const u32x4*)(GT + (size_t)row * 1024 + c0 + hh * 8);
            float y[8];
#pragma unroll
            for (int i = 0; i < 4; ++i) {
                y[2 * i] = o[hh * 8 + 2 * i] * rs * dnw[d0 + hh * 8 + 2 * i] * siluf(bflo(gt[i]));
                y[2 * i + 1] = o[hh * 8 + 2 * i + 1] * rs * dnw[d0 + hh * 8 + 2 * i + 1] * siluf(bfhi(gt[i]));
            }
            u32x4 w; w.x = pk2(y[0], y[1]); w.y = pk2(y[2], y[3]); w.z = pk2(y[4], y[5]); w.w = pk2(y[6], y[7]);
            *(u32x4*)(Y + (size_t)row * 2048 + c0 + hh * 8) = w;
        }
    }
}

namespace att {
constexpr int D = 128, NW = 8, QBLK = 32, KVBLK = 64;
constexpr float SCALE = 0.088388347648318440f;
constexpr float THR = 8.f;
constexpr int LDK = 256;
constexpr size_t SHM_V = KVBLK * D * 2, SHM_K = KVBLK * D * 2;
constexpr size_t OFF_WS = 2 * SHM_V + 2 * SHM_K, OFF_OST = OFF_WS + NW * 64 * 4;
#define KSWZ(row, colB) ((row) * 256 + ((colB) ^ (((row) & 7) << 4)))
#define SBAR() __builtin_amdgcn_sched_barrier(0)
DEVI int crow(int r, int hi) { return (r & 3) + 8 * (r >> 2) + 4 * hi; }
DEVI unsigned cvtpk(float lo, float hi) { unsigned r; asm volatile("v_cvt_pk_bf16_f32 %0, %1, %2" : "=v"(r) : "v"(lo), "v"(hi)); return r; }
DEVI void partialSM(f32x16& p0, f32x16& p1, float& m_reg, float& mn, float& alpha) {
    constexpr float C = SCALE * 1.4426950408889634f;
    float pmax = p0[0];
#pragma unroll
    for (int r = 1; r < 16; ++r) pmax = fmaxf(pmax, p0[r]);
#pragma unroll
    for (int r = 0; r < 16; ++r) pmax = fmaxf(pmax, p1[r]);
    { auto rr = __builtin_amdgcn_permlane32_swap(__float_as_uint(pmax), __float_as_uint(pmax), false, false);
      pmax = fmaxf(__uint_as_float(rr[0]), __uint_as_float(rr[1])); }
    if (__builtin_expect(__all(pmax - m_reg <= THR / SCALE), 1)) { mn = m_reg; alpha = 1.f; }
    else { mn = fmaxf(m_reg, pmax); alpha = __builtin_amdgcn_exp2f((m_reg - mn) * C); m_reg = mn; }
    const float mnC = -mn * C;
#pragma unroll
    for (int r = 0; r < 16; ++r) p0[r] = fmaf(p0[r], C, mnC);
#pragma unroll
    for (int r = 0; r < 16; ++r) p1[r] = fmaf(p1[r], C, mnC);
#pragma unroll
    for (int r = 0; r < 16; ++r) p0[r] = __builtin_amdgcn_exp2f(p0[r]);
}
DEVI void finishSM(f32x16& p0, f32x16& p1, float alpha, float& l_reg, bf16x8& pa0, bf16x8& pa1, bf16x8& pa2, bf16x8& pa3) {
#pragma unroll
    for (int r = 0; r < 16; ++r) p1[r] = __builtin_amdgcn_exp2f(p1[r]);
    float ps = 0;
#pragma unroll
    for (int r = 0; r < 16; ++r) ps += p0[r];
#pragma unroll
    for (int r = 0; r < 16; ++r) ps += p1[r];
    { auto rr = __builtin_amdgcn_permlane32_swap(__float_as_uint(ps), __float_as_uint(ps), false, false);
      ps = __uint_as_float(rr[0]) + __uint_as_float(rr[1]); }
    l_reg = l_reg * alpha + ps;
#define PK4(P, BASE, OUT) do { unsigned a0 = cvtpk(P[BASE + 0], P[BASE + 1]), a1 = cvtpk(P[BASE + 2], P[BASE + 3]);   \
    unsigned b0 = cvtpk(P[BASE + 4], P[BASE + 5]), b1 = cvtpk(P[BASE + 6], P[BASE + 7]);                              \
    auto r0 = __builtin_amdgcn_permlane32_swap(a0, b0, false, false); auto r1 = __builtin_amdgcn_permlane32_swap(a1, b1, false, false); \
    u32x4 w = {r0[0], r1[0], r0[1], r1[1]}; OUT = *reinterpret_cast<bf16x8*>(&w); } while (0)
    PK4(p0, 0, pa0); PK4(p0, 8, pa1); PK4(p1, 0, pa2); PK4(p1, 8, pa3);
#undef PK4
}
DEVI void qkt(f32x16& p0, f32x16& p1, const char* Ks, const bf16x8* qr, int r32, int hi) {
    p0 = f32x16{}; p1 = f32x16{};
#pragma unroll
    for (int d0 = 0; d0 < 8; ++d0) { const int cb = (d0 * 16 + hi * 8) * 2;
        const bf16x8 b0 = *reinterpret_cast<const bf16x8*>(Ks + KSWZ(r32, cb));
        const bf16x8 b1 = *reinterpret_cast<const bf16x8*>(Ks + KSWZ(32 + r32, cb));
        p0 = __builtin_amdgcn_mfma_f32_32x32x16_bf16(b0, qr[d0], p0, 0, 0, 0);
        p1 = __builtin_amdgcn_mfma_f32_32x32x16_bf16(b1, qr[d0], p1, 0, 0, 0); }
}
DEVI int v_st(int k, int c) { const int kk = (k & ~0xC) | ((k & 4) << 1) | ((k & 8) >> 1); return ((kk >> 3) * 4 + (c >> 5)) * 512 + ((kk & 7) * 32 + (c & 31)) * 2; }
DEVI int v_rd_base(int lane) { return ((lane & 3) << 3) | (((lane >> 2) & 3) << 6) | (((lane >> 4) & 1) << 5) | (((lane >> 5) & 1) << 8); }
constexpr int v_rd_off(int d0, int ks, int half) { return d0 * 512 + ks * 4096 + half * 2048; }
template <int OFF> DEVI s16x4 tr_read(int vb) { s16x4 r; asm volatile("ds_read_b64_tr_b16 %0, %1 offset:%2" : "=&v"(r) : "v"(vb), "i"(OFF) : "memory"); return r; }
template <int D0> DEVI void pv_one(f32x16& od, int vb, bf16x8 pa0, bf16x8 pa1, bf16x8 pa2, bf16x8 pa3) {
    const s16x4 l0 = tr_read<v_rd_off(D0, 0, 0)>(vb), h0 = tr_read<v_rd_off(D0, 0, 1)>(vb), l1 = tr_read<v_rd_off(D0, 1, 0)>(vb), h1 = tr_read<v_rd_off(D0, 1, 1)>(vb);
    const s16x4 l2 = tr_read<v_rd_off(D0, 2, 0)>(vb), h2 = tr_read<v_rd_off(D0, 2, 1)>(vb), l3 = tr_read<v_rd_off(D0, 3, 0)>(vb), h3 = tr_read<v_rd_off(D0, 3, 1)>(vb);
    asm volatile("s_waitcnt lgkmcnt(0)" ::: "memory"); SBAR();
#define PK(L, H) (bf16x8){L[0], L[1], L[2], L[3], H[0], H[1], H[2], H[3]}
    od = __builtin_amdgcn_mfma_f32_32x32x16_bf16(pa0, PK(l0, h0), od, 0, 0, 0);
    od = __builtin_amdgcn_mfma_f32_32x32x16_bf16(pa1, PK(l1, h1), od, 0, 0, 0);
    od = __builtin_amdgcn_mfma_f32_32x32x16_bf16(pa2, PK(l2, h2), od, 0, 0, 0);
    od = __builtin_amdgcn_mfma_f32_32x32x16_bf16(pa3, PK(l3, h3), od, 0, 0, 0);
#undef PK
}
DEVI void pv_d0(f32x16* o, int vb, bf16x8 pa0, bf16x8 pa1, bf16x8 pa2, bf16x8 pa3) {
    pv_one<0>(o[0], vb, pa0, pa1, pa2, pa3); pv_one<1>(o[1], vb, pa0, pa1, pa2, pa3); pv_one<2>(o[2], vb, pa0, pa1, pa2, pa3); pv_one<3>(o[3], vb, pa0, pa1, pa2, pa3);
}
DEVI void wmask(f32x16& p0, f32x16& p1, int qp, int kt0, int hi) {
#pragma unroll
    for (int r = 0; r < 16; ++r) { const int kp = kt0 + crow(r, hi); const int d0 = qp - kp, d1 = d0 - 32;
        if (d0 > 128 || d0 < -128) p0[r] = -1e30f; if (d1 > 128 || d1 < -128) p1[r] = -1e30f; }
}
DEVI void attn_unit(const KA& a, int b, int kvh, int tb, char* lds) {
    unsigned char* ws = a.ws();
    const bf16_t* QAT = (const bf16_t*)(ws + WS_QAT); const bf16_t* KAT = (const bf16_t*)(ws + WS_KAT); const bf16_t* VAT = (const bf16_t*)(ws + WS_VAT);
    bf16_t* Y = (bf16_t*)(ws + WS_Y); const float* rope = (const float*)(ws + SM_ROPE);
    const int tid = threadIdx.x, wid = __builtin_amdgcn_readfirstlane(tid >> 6), lane = tid & 63, r32 = lane & 31, hi = lane >> 5;
    const int h = kvh * 4 + (wid >> 1), t0 = tb * 64;
    char* V_lds = lds; char* K_lds = lds + 2 * SHM_V;
    float* wsf = (float*)(lds + OFF_WS) + wid * 64; float* li_l = wsf; float* al_l = wsf + 32;
    float m_reg = -1e30f, l_reg = 0; f32x16 o[4] = {}; bf16x8 qr[8];
    const int qp = t0 + (wid & 1) * QBLK + r32;
    {
        const bf16_t* Qw = QAT + (size_t)(b * SEQ + qp) * 1024 + h * 128 + hi * 8;
        u32x4 raw[8]; float ss = 0.f;
#pragma unroll
        for (int d0 = 0; d0 < 8; ++d0) { raw[d0] = *(const u32x4*)(Qw + d0 * 16);
#pragma unroll
            for (int i = 0; i < 4; ++i) { const float lo_ = bflo(raw[d0][i]), hi_ = bfhi(raw[d0][i]); ss += lo_ * lo_ + hi_ * hi_; } }
        { auto rr = __builtin_amdgcn_permlane32_swap(__float_as_uint(ss), __float_as_uint(ss), false, false); ss = __uint_as_float(rr[0]) + __uint_as_float(rr[1]); }
        const float rs = rsqrtf(ss * (1.f / 128.f) + EPS);
        const float* qnw = a.in(13);
#pragma unroll
        for (int half = 0; half < 2; ++half) {
            const float* ct = half == 0 ? rope + (qp >> 6) * 32 : rope + 16384 + (qp & 63) * 32;
            const float* st = half == 0 ? ct + 8192 : ct + 2048;
#pragma unroll
            for (int dd = 0; dd < 2; ++dd) {
                const int fi = dd * 16 + hi * 8, da = half * 4 + dd, db = da + 2;
                u32x4 oa, ob;
#pragma unroll
                for (int q4 = 0; q4 < 2; ++q4) {
                    const f32x4 c = *(const f32x4*)(ct + fi + 4 * q4), s = *(const f32x4*)(st + fi + 4 * q4);
                    const f32x4 wa = *(const f32x4*)(qnw + da * 16 + hi * 8 + 4 * q4), wb = *(const f32x4*)(qnw + db * 16 + hi * 8 + 4 * q4);
                    float ya[4], yb[4];
#pragma unroll
                    for (int j = 0; j < 4; ++j) {
                        const unsigned ra = raw[da][2 * q4 + (j >> 1)], rb = raw[db][2 * q4 + (j >> 1)];
                        const float x1 = ((j & 1) ? bfhi(ra) : bflo(ra)) * rs * wa[j], x2 = ((j & 1) ? bfhi(rb) : bflo(rb)) * rs * wb[j];
                        ya[j] = x1 * c[j] - x2 * s[j]; yb[j] = x2 * c[j] + x1 * s[j];
                    }
                    oa[2 * q4] = cvtpk(ya[0], ya[1]); oa[2 * q4 + 1] = cvtpk(ya[2], ya[3]); ob[2 * q4] = cvtpk(yb[0], yb[1]); ob[2 * q4 + 1] = cvtpk(yb[2], yb[3]);
                }
                qr[da] = *reinterpret_cast<bf16x8*>(&oa); qr[db] = *reinterpret_cast<bf16x8*>(&ob);
            }
        }
    }
    const int tk0 = t0 - 128 < 0 ? 0 : t0 - 128, tk1 = t0 + 192 > SEQ ? SEQ : t0 + 192;
    const int NTR = 4 + (tk1 - tk0) / 64, NT = (NTR + 1) & ~1;
    const int ctxrow = ML + b * CTX, latrow = b * SEQ + tk0 - 256;
#define TCTX(j) ((j) < 4 || (j) >= NTR)
#define TROW(j) (TCTX(j) ? b * CTX + 64 * ((j) & 3) : latrow + 64 * (j))
    const bf16_t* Kh = KAT + kvh * 128; const bf16_t* Vh = VAT + kvh * 128;
    const bf16_t* Kc = (const bf16_t*)(ws + WS_CTXK) + kvh * 128; const bf16_t* Vc = (const bf16_t*)(ws + WS_CTXV) + kvh * 128;
    const int sr = tid >> 4, sc = (tid & 15) * 8, vst0 = v_st(sr, sc), vst1 = v_st(32 + sr, sc);
    const int vb0 = (int)(uintptr_t)V_lds + v_rd_base(lane);
    struct { bf16x8 vs0, vs1, ks0, ks1; } sr_[1];
#define SLOAD(i, j) do { const int k0_ = TROW(j); const bf16_t* kb_ = TCTX(j) ? Kc : Kh; const bf16_t* vb_ = TCTX(j) ? Vc : Vh; \
    sr_[i].vs0 = *(const bf16x8*)(vb_ + (size_t)(k0_ + sr) * LDK + sc); sr_[i].vs1 = *(const bf16x8*)(vb_ + (size_t)(k0_ + 32 + sr) * LDK + sc); \
    sr_[i].ks0 = *(const bf16x8*)(kb_ + (size_t)(k0_ + sr) * LDK + sc); sr_[i].ks1 = *(const bf16x8*)(kb_ + (size_t)(k0_ + 32 + sr) * LDK + sc); } while (0)
#define SWRITE(bf, i) do { *(bf16x8*)(V_lds + (bf) * SHM_V + vst0) = sr_[i].vs0; *(bf16x8*)(V_lds + (bf) * SHM_V + vst1) = sr_[i].vs1; const int kc = sc * 2; \
    *(bf16x8*)(K_lds + (bf) * SHM_K + KSWZ(sr, kc)) = sr_[i].ks0; *(bf16x8*)(K_lds + (bf) * SHM_K + KSWZ(32 + sr, kc)) = sr_[i].ks1; } while (0)
#define SWAIT() asm volatile("s_waitcnt vmcnt(0)" ::: "memory")
#define RESC(al) do { if (__any((al) < 1.f)) { if (hi == 0) al_l[r32] = (al); asm volatile("s_waitcnt lgkmcnt(0)" ::: "memory"); \
    _Pragma("unroll") for (int d = 0; d < 4; ++d) _Pragma("unroll") for (int r = 0; r < 16; ++r) o[d][r] *= al_l[crow(r, hi)]; } } while (0)
#define WMASK(P0, P1, j) do { if ((j) >= 4) wmask(P0, P1, qp, (j) >= NTR ? 1000000 : tk0 + 64 * ((j) - 4), hi); } while (0)
    f32x16 pA0, pA1, pB0, pB1; float mnA, mnB, alA, alB; bf16x8 pa0, pa1, pa2, pa3;
    constexpr int SE = 0, SO = 0;
    SLOAD(SE, 0); asm volatile("s_waitcnt vmcnt(0)" ::: "memory"); SWRITE(0, SE); __syncthreads();
    qkt(pA0, pA1, K_lds, qr, r32, hi); partialSM(pA0, pA1, m_reg, mnA, alA);
    SLOAD(SO, 1);
    SWAIT(); SWRITE(1, SO); __syncthreads();
    for (int j = 1; j + 1 < NT; j += 2) {
        SBAR(); qkt(pB0, pB1, K_lds + SHM_K, qr, r32, hi); WMASK(pB0, pB1, j);
        finishSM(pA0, pA1, alA, l_reg, pa0, pa1, pa2, pa3); SBAR();
        SLOAD(SO, j + 1); SBAR();
        pv_d0(o, vb0, pa0, pa1, pa2, pa3); partialSM(pB0, pB1, m_reg, mnB, alB);
        __syncthreads(); SWAIT(); SWRITE(0, SE);
        RESC(alB); __syncthreads();
        SBAR(); qkt(pA0, pA1, K_lds, qr, r32, hi); WMASK(pA0, pA1, j + 1);
        finishSM(pB0, pB1, alB, l_reg, pa0, pa1, pa2, pa3); SBAR();
        SLOAD(SE, j + 2); SBAR();
        pv_d0(o, vb0 + (int)SHM_V, pa0, pa1, pa2, pa3); partialSM(pA0, pA1, m_reg, mnA, alA);
        __syncthreads(); SWAIT(); SWRITE(1, SO);
        RESC(alA); __syncthreads();
    }
    SBAR(); qkt(pB0, pB1, K_lds + SHM_K, qr, r32, hi); WMASK(pB0, pB1, NT - 1);
    finishSM(pA0, pA1, alA, l_reg, pa0, pa1, pa2, pa3); SBAR();
    pv_d0(o, vb0, pa0, pa1, pa2, pa3); partialSM(pB0, pB1, m_reg, mnB, alB);
    __syncthreads(); RESC(alB);
    finishSM(pB0, pB1, alB, l_reg, pa0, pa1, pa2, pa3); SBAR();
    pv_d0(o, vb0 + (int)SHM_V, pa0, pa1, pa2, pa3);
    l_reg += __builtin_amdgcn_exp2f(a.in(15)[h] * 1.4426950408889634f - m_reg * (SCALE * 1.4426950408889634f));
    if (hi == 0) li_l[r32] = l_reg; asm volatile("s_waitcnt lgkmcnt(0)" ::: "memory");
    float rli[16];
#pragma unroll
    for (int r = 0; r < 16; ++r) rli[r] = __builtin_amdgcn_rcpf(li_l[crow(r, hi)]);
    {
        bf16_t* stg = (bf16_t*)(lds + OFF_OST) + wid * 4096;
#pragma unroll
        for (int r = 0; r < 16; ++r) { const int orow = crow(r, hi);
#pragma unroll
            for (int d0 = 0; d0 < 4; ++d0) stg[orow * 128 + d0 * 32 + r32] = (bf16_t)f2bf(o[d0][r] * rli[r]); }
        asm volatile("s_waitcnt lgkmcnt(0)" ::: "memory");
        bf16_t* Ow = Y + (size_t)(b * SEQ + t0 + (wid & 1) * QBLK) * 2048 + 1024 + h * 128;
#pragma unroll
        for (int i = 0; i < 8; ++i) { const int row = i * 4 + (lane >> 4), ch = lane & 15; const u32x4 v = *(const u32x4*)(stg + row * 128 + ch * 8); *(u32x4*)(Ow + (size_t)row * 2048 + ch * 8) = v; }
    }
    __syncthreads();
#undef TROW
#undef TCTX
#undef SLOAD
#undef SWRITE
#undef SWAIT
#undef RESC
#undef WMASK
}
#undef KSWZ
#undef SBAR
}

DEVI u32x4 ldu_(const bf16_t* base, int rr) {
    const int rc = rr < 0 ? 0 : (rr >= SEQ ? SEQ - 1 : rr);
    const u32x4 v = *(const u32x4*)(base + (size_t)rc * NUP);
    const unsigned m = (rr == rc) ? 0xffffffffu : 0u;
    return (u32x4){v[0] & m, v[1] & m, v[2] & m, v[3] & m};
}
DEVI void phase_ffnconv(const KA& a, int b, int tid) {
    unsigned char* ws = a.ws();
    const bf16_t* U = (const bf16_t*)(ws + WS_U); bf16_t* ACT = (bf16_t*)(ws + WS_ACT) + (size_t)b * SEQ * DFF;
    const float* cw = a.in(20); const float* cb = a.in(21);
    if (tid < DFF / 8) {
        const int f0 = tid * 8, pn = f0 >> 7, j = f0 & 127, gc = 256 * pn + j, vc = gc + 128;
        float wg[3][8], wv[3][8], bg[8], bvv[8];
#pragma unroll
        for (int jt = 0; jt < 3; ++jt)
#pragma unroll
            for (int q = 0; q < 8; ++q) { wg[jt][q] = cw[jt * NUP + f0 + q]; wv[jt][q] = cw[jt * NUP + DFF + f0 + q]; }
#pragma unroll
        for (int q = 0; q < 8; ++q) { bg[q] = cb[f0 + q]; bvv[q] = cb[DFF + f0 + q]; }
        for (int it = blockIdx.x; it < SEQ / 32; it += gridDim.x) {
            const int r0 = it * 32;
            u32x4 gw_[3], vw_[3];
#define LDU(rr, c) ldu_(U + (c), (rr))
            gw_[0] = LDU(r0 - 1, gc); vw_[0] = LDU(r0 - 1, vc); gw_[1] = LDU(r0, gc); vw_[1] = LDU(r0, vc);
#pragma unroll 8
            for (int r = 0; r < 32; ++r) {
                gw_[2] = LDU(r0 + r + 1, gc); vw_[2] = LDU(r0 + r + 1, vc);
                float ug[8], uv[8];
#pragma unroll
                for (int q = 0; q < 8; ++q) { ug[q] = bg[q]; uv[q] = bvv[q]; }
#pragma unroll
                for (int jt = 0; jt < 3; ++jt)
#pragma unroll
                    for (int q = 0; q < 4; ++q) {
                        ug[2 * q] += bflo(gw_[jt][q]) * wg[jt][2 * q]; ug[2 * q + 1] += bfhi(gw_[jt][q]) * wg[jt][2 * q + 1];
                        uv[2 * q] += bflo(vw_[jt][q]) * wv[jt][2 * q]; uv[2 * q + 1] += bfhi(vw_[jt][q]) * wv[jt][2 * q + 1]; }
                u32x4 o;
                o.x = pk2(siluf(ug[0]) * uv[0], siluf(ug[1]) * uv[1]); o.y = pk2(siluf(ug[2]) * uv[2], siluf(ug[3]) * uv[3]);
                o.z = pk2(siluf(ug[4]) * uv[4], siluf(ug[5]) * uv[5]); o.w = pk2(siluf(ug[6]) * uv[6], siluf(ug[7]) * uv[7]);
                *(u32x4*)(ACT + (size_t)(r0 + r) * DFF + f0) = o;
                gw_[0] = gw_[1]; gw_[1] = gw_[2]; vw_[0] = vw_[1]; vw_[1] = vw_[2];
            }
#undef LDU
        }
    }
}

#define XB_TMO      128
#define XB_XCNT(j)  (256  + 64 * (j))
#define XB_XSUB(j)  (1280 + 64 * (j))
#define XB_XGEN(j)  (2304 + 64 * (j))
#define XB_TOP      3328
#define XB_TOPGEN   3392
#define XCD_BAR_WORDS 3456
#define XB_SPIN_CAP (1u << 18)
__device__ __forceinline__ unsigned xb_ld(unsigned* p)              { return __hip_atomic_load(p, __ATOMIC_RELAXED, __HIP_MEMORY_SCOPE_AGENT); }
__device__ __forceinline__ unsigned xb_add(unsigned* p, unsigned v) { return __hip_atomic_fetch_add(p, v, __ATOMIC_RELAXED, __HIP_MEMORY_SCOPE_AGENT); }
__device__ __forceinline__ unsigned xb_xcc_id() { return (unsigned)__builtin_amdgcn_s_getreg((3 << 11) | 20) & 0xFu; }
#define XB_SPIN(cond, bar) do { unsigned _sp = 0; while (cond) { __builtin_amdgcn_s_sleep(1); \
    if ((++_sp & 255u) == 0u) { if (xb_ld(&(bar)[XB_TMO])) break; if (_sp > XB_SPIN_CAP) { atomicAdd(&(bar)[XB_TMO], 1u); break; } } } } while (0)
struct XcdBarrier { unsigned* bar; unsigned x; volatile LAS unsigned* st; };
__device__ __forceinline__ XcdBarrier xcd_barrier_post(unsigned* bar, volatile LAS unsigned* st) {
    XcdBarrier b; b.bar = bar; b.x = xb_xcc_id(); b.st = st;
    if (threadIdx.x == 0) (void)xb_add(&bar[XB_XCNT(b.x)], 1u);
    return b;
}
__device__ __forceinline__ void xcd_barrier_complete(unsigned* bar, unsigned x, unsigned& nloc, unsigned& nx) {
    const unsigned G = gridDim.x * gridDim.y * gridDim.z;
    unsigned sum, cnt, mine, sp = 0u;
    for (;;) {
        sum = 0u; cnt = 0u; mine = 0u;
#pragma unroll
        for (unsigned j = 0; j < 16; ++j) { const unsigned c = xb_ld(&bar[XB_XCNT(j)]); sum += c; cnt += (c > 0u) ? 1u : 0u; mine = (j == x) ? c : mine; }
        if (sum == G) break;
        __builtin_amdgcn_s_sleep(1);
        if ((++sp & 255u) == 0u) { if (xb_ld(&bar[XB_TMO])) break; if (sp > XB_SPIN_CAP) { atomicAdd(&bar[XB_TMO], 1u); break; } }
    }
    nloc = mine > 0u ? mine : 1u; nx = cnt > 0u ? cnt : 1u;
}
__device__ __forceinline__ void xcd_barrier(const XcdBarrier& b) {
    asm volatile("s_waitcnt vmcnt(0)" ::: "memory");
    __syncthreads();
    if (threadIdx.x == 0) {
        unsigned* bar = b.bar;
        __builtin_amdgcn_s_waitcnt(0);
        unsigned nloc = b.st[0], nx = b.st[1];
        if (nloc == 0u) { xcd_barrier_complete(bar, b.x, nloc, nx); b.st[0] = nloc; b.st[1] = nx; }
        const unsigned old = xb_add(&bar[XB_XSUB(b.x)], 1u);
        const unsigned gen = old / nloc;
        if (old + 1u == (gen + 1u) * nloc) {
            __builtin_amdgcn_fence(__ATOMIC_RELEASE, "agent");
            asm volatile("s_waitcnt vmcnt(0)" ::: "memory");
            const unsigned og = xb_add(&bar[XB_TOP], 1u);
            const unsigned tg = og / nx;
            if (og + 1u == (tg + 1u) * nx) xb_add(&bar[XB_TOPGEN], 1u);
            else XB_SPIN(xb_ld(&bar[XB_TOPGEN]) == tg, bar);
            __builtin_amdgcn_fence(__ATOMIC_ACQUIRE, "agent");
            xb_add(&bar[XB_XGEN(b.x)], 1u);
            asm volatile("s_waitcnt vmcnt(0)" ::: "memory");
        } else {
            XB_SPIN(xb_ld(&bar[XB_XGEN(b.x)]) == gen, bar);
            __builtin_amdgcn_fence(__ATOMIC_ACQUIRE, "agent");
            asm volatile("s_waitcnt vmcnt(0)" ::: "memory");
        }
    }
    __syncthreads();
}

constexpr int NPHASE = 13;
__global__ void __launch_bounds__(512, 2) mega(Args a_) {
    const KA a;
    extern __shared__ __attribute__((aligned(16))) unsigned char lds_raw[];
    LAS unsigned char* lds = (LAS unsigned char*)lds_raw;
    const int tid = threadIdx.x, lane = tid & 63, wave = __builtin_amdgcn_readfirstlane(tid >> 6);
    unsigned char* ws = a.ws();
    const int lo = a_.ph_lo, hi = a_.ph_hi;
#define IN(k) (lo <= (k) && (k) < hi)
#if MK_ONE_LAUNCH
    volatile LAS unsigned* bst = (volatile LAS unsigned*)(lds + 147440);
    if (tid < 4) bst[tid] = 0u;
    __syncthreads();
    const XcdBarrier gbar = xcd_barrier_post((unsigned*)(ws + WS_CTL), bst);
#define SEAM(k) do { if (IN(k) && IN((k) + 1)) xcd_barrier(gbar); } while (0)
#else
#define SEAM(k) do { } while (0)
#endif
    const float* modacc = (const float*)(ws + CTL_MODACC);
    unsigned long long pr_prev = PROBE_MASK ? __builtin_amdgcn_s_memrealtime() : 0ull, pr_acc = 0ull;
#define STAMP(k) do { if (PROBE_MASK) { const unsigned long long now_ = __builtin_amdgcn_s_memrealtime(); if ((PROBE_MASK >> (k)) & 1u) pr_acc += now_ - pr_prev; pr_prev = now_; } } while (0)
    if (IN(0)) { phase0(a, lds, tid, lane, wave); } SEAM(0); STAMP(0);
    if (IN(1)) { phase1(a, tid, lane, wave); } SEAM(1); STAMP(1);
    if (IN(2)) {
        pg8::Gemm g{(const bf16_t*)(ws + WS_XN), (const bf16_t*)(ws + WS_WINA), MT, NA, 1024}; pg8::StaticOrder S; S.init(MT, NA, gridDim.x, blockIdx.x);
        EpiIn E{(const float*)(ws + SM_ROWSS1), (const float*)(ws + SM_SHWA), 0, (bf16_t*)(ws + WS_QKVR), nullptr, nullptr, nullptr, nullptr, (float*)(ws + WS_BA)};
        pg8::gemm_phase<EpiIn, pg8::StaticOrder, true, true>(lds, g, S, E);
        {
            pg8::Gemm g2{(const bf16_t*)(ws + WS_XN) + (size_t)ML * 1024, (const bf16_t*)(ws + WS_WINC) + (size_t)2048 * 1024, MC, 512, 1024};
            TailOrder T{(int)blockIdx.x - ((int)gridDim.x - 4)};
            EpiCtxKV E2{(const float*)(ws + SM_ROWSS1) + ML, (const float*)(ws + SM_SHWA) + 2 * NSH + NA + 2048, (bf16_t*)(ws + WS_CTXK), (bf16_t*)(ws + WS_CTXV)};
            pg8::gemm_phase<EpiCtxKV, TailOrder, true, true>(lds, g2, T, E2);
        }
    } SEAM(2); STAMP(2);
    if (IN(3)) { phase_dnprep(a, tid); } SEAM(3); STAMP(3);
    if (IN(4)) { phase_dnchunk2(a, lds, tid, lane, wave); } SEAM(4); STAMP(4);
    if (IN(5)) { const unsigned long long t5_ = (PROBE_SUB == 4) ? __builtin_amdgcn_s_memrealtime() : 0ull; phase_dnscan2(a, lds, tid, lane, wave, pr_acc); if (PROBE_SUB == 4) pr_acc += __builtin_amdgcn_s_memrealtime() - t5_; } SEAM(5); STAMP(5);
    if (IN(6)) {
        pg8::Gemm g{(const bf16_t*)(ws + WS_XN), (const bf16_t*)(ws + WS_WINC), ML, NC, 1024}; pg8::StaticOrder S; S.init(ML, NC, gridDim.x, blockIdx.x);
        EpiIn E{(const float*)(ws + SM_ROWSS1), (const float*)(ws + SM_SHWA) + NA, 1, (bf16_t*)(ws + WS_GT), (bf16_t*)(ws + WS_QAT), (bf16_t*)(ws + WS_KAT), (bf16_t*)(ws + WS_VAT), (bf16_t*)(ws + WS_MG), nullptr};
        pg8::gemm_phase<EpiIn, pg8::StaticOrder, true, true>(lds, g, S, E);
    } SEAM(6); STAMP(6);
    if (IN(7)) { phase_prep2(a, lane, wave); } SEAM(7); STAMP(7);
    if (IN(8)) {
#pragma unroll 1
        for (int idx = blockIdx.x; idx < 1024; idx += gridDim.x) {
            const int tb = idx & 255, kvh = (idx >> 8) & 1, b = idx >> 9;
            att::attn_unit(a, b, kvh, tb, (char*)lds_raw); }
    } SEAM(8); STAMP(8);
    if (IN(9)) {
        pg8::Gemm g{(const bf16_t*)(ws + WS_Y), (const bf16_t*)(ws + WS_WBR), ML, 1024, 2048}; pg8::StaticOrder S; S.init(ML, 1024, gridDim.x, blockIdx.x);
        EpiBr E{(const bf16_t*)(ws + WS_MG), (bf16_t*)(ws + WS_MERGED)};
        pg8::gemm_phase<EpiBr, pg8::StaticOrder, true, true>(lds, g, S, E);
    } SEAM(9); STAMP(9);
    if (IN(10)) {
        pg8::Gemm g{(const bf16_t*)(ws + WS_MERGED), (const bf16_t*)(ws + WS_WOUT), ML, 1024, 1024}; pg8::StaticOrder S; S.init(ML, 1024, gridDim.x, blockIdx.x);
        EpiOut E{a.in(0), modacc, a.in(5), a.in(7), a.out(), (bf16_t*)(ws + WS_X1S), (float*)(ws + CTL_ROWSS2)};
        pg8::gemm_phase<EpiOut, pg8::StaticOrder, true, true>(lds, g, S, E);
    } SEAM(10); STAMP(10);
    if (IN(11)) {
        pg8::Gemm g{(const bf16_t*)(ws + WS_X1S), (const bf16_t*)(ws + WS_WUP), 2 * TPB * 256, NUP, 1024}; pg8::StaticOrder S; S.init(2 * TPB * 256, NUP, gridDim.x, blockIdx.x);
        EpiUpConv E{(const float*)(ws + CTL_ROWSS2), (const float*)(ws + SM_SHWF), a.in(20), a.in(21), (bf16_t*)(ws + WS_ACT), (LAS float*)(lds + 131072)};
        pg8::gemm_phase<EpiUpConv, pg8::StaticOrder, true, true>(lds, g, S, E);
    } SEAM(11); STAMP(11);
    if (IN(12)) {
        pg8::Gemm g{(const bf16_t*)(ws + WS_ACT), (const bf16_t*)(ws + WS_WDN), ML, 1024, DFF}; pg8::StaticOrder S; S.init(ML, 1024, gridDim.x, blockIdx.x);
        EpiDown E{modacc, a.in(5), a.out()};
        pg8::gemm_phase<EpiDown, pg8::StaticOrder, true, true>(lds, g, S, E);
    }
    STAMP(12);
    if ((PROBE_MASK || PROBE_SUB) && blockIdx.x == 0) { const unsigned long long t0_ = __builtin_amdgcn_s_memrealtime(); while (__builtin_amdgcn_s_memrealtime() - t0_ < pr_acc) __builtin_amdgcn_s_sleep(8); }
#undef STAMP
#undef IN
#undef SEAM
}

extern "C" void kernel_launch(void* const* d_in, const int* in_sizes, int n_in, void* d_out, int out_size, void* d_ws, size_t ws_size, hipStream_t stream) {
    static int grid = 0;
    if (grid == 0) {
        if (n_in != 23 || in_sizes[0] != ML * DM || out_size != ML * DM || ws_size < WS_END) {
            fprintf(stderr, "kernel_launch: unexpected shapes n_in %d in0 %d out %d ws %zu (need %zu)\n", n_in, n_in > 0 ? in_sizes[0] : -1, out_size, ws_size, (size_t)WS_END); grid = -1; return; }
        int dev = 0, cus = 0, per_cu = 0;
        hipGetDevice(&dev); hipDeviceGetAttribute(&cus, hipDeviceAttributeMultiprocessorCount, dev);
        if (hipFuncSetAttribute((const void*)mega, hipFuncAttributeMaxDynamicSharedMemorySize, LDS_BYTES) != hipSuccess) { fprintf(stderr, "kernel_launch: hipFuncSetAttribute failed\n"); grid = -1; return; }
        hipOccupancyMaxActiveBlocksPerMultiprocessor(&per_cu, (const void*)mega, 512, LDS_BYTES);
        (void)hipGetLastError();
        if (per_cu < 1) { fprintf(stderr, "kernel_launch: occupancy query says %d blocks per CU\n", per_cu); per_cu = 1; }
        grid = cus;
    }
    if (grid < 0) return;
    hipMemsetAsync((char*)d_ws + WS_CTL, 0, CTL_ZERO_BYTES, stream);
    Args a{};
    for (int i = 0; i < 23; ++i) a.in[i] = (const float*)d_in[i];
    a.out = (float*)d_out; a.ws = (unsigned char*)d_ws;
#if MK_ONE_LAUNCH
    a.ph_lo = 0; a.ph_hi = NPHASE;
    void* args[] = {&a};
    hipError_t e = hipLaunchCooperativeKernel((const void*)mega, dim3(grid), dim3(512), args, LDS_BYTES, stream);
    if (e != hipSuccess) fprintf(stderr, "cooperative launch failed: %s (grid %d)\n", hipGetErrorString(e), grid);
#else
    for (int p = 0; p < NPHASE; ++p) {
        a.ph_lo = p; a.ph_hi = p + 1;
        hipLaunchKernelGGL(mega, dim3(grid), dim3(512), LDS_BYTES, stream, a);
    }
    hipError_t e = hipPeekAtLastError();
    if (e != hipSuccess) fprintf(stderr, "launch failed: %s\n", hipGetErrorString(e));
#endif
}
```

```cpp
#include <hip/hip_runtime.h>
#include <hip/hip_cooperative_groups.h>
#include <cstdio>
#include <cstdint>
namespace cg = cooperative_groups;

#ifndef PROBE_MASK
#define PROBE_MASK 0u
#endif
#ifndef PROBE_SUB
#define PROBE_SUB 0
#endif
#ifndef MK_ONE_LAUNCH
#define MK_ONE_LAUNCH 1
#endif

#define DEVI __device__ __forceinline__
#define LAS __attribute__((address_space(3)))
typedef unsigned short bf16_t;
typedef short bf16x8 __attribute__((ext_vector_type(8)));
typedef float f32x4 __attribute__((ext_vector_type(4)));
typedef float f32x2 __attribute__((ext_vector_type(2)));
typedef float f32x16 __attribute__((ext_vector_type(16)));
typedef unsigned u32x4 __attribute__((ext_vector_type(4)));
typedef unsigned u32x2 __attribute__((ext_vector_type(2)));
typedef short s16x4 __attribute__((ext_vector_type(4)));

constexpr int BATCH = 2, SEQ = 16384, DM = 1024, CTX = 256;
constexpr int ML = BATCH * SEQ;
constexpr int MC = BATCH * CTX;
constexpr int MT = ML + MC;
constexpr int NA = 3328;
constexpr int NC = 4608;
constexpr int NSH = NA + NC;
constexpr int DFF = 2816, NUP = 5632;
constexpr int RB = SEQ + 256;
constexpr int TPB = 65;
constexpr float EPS = 1e-6f;

constexpr size_t MiB = 1u << 20;
constexpr size_t WS_CTL = 0, CTL_ZERO_BYTES = 1 * MiB;
constexpr size_t CTL_XRANK = 24 * 1024;
constexpr size_t CTL_PROG = 32 * 1024;
constexpr size_t CTL_MODACC = 64 * 1024;
constexpr size_t CTL_ROWSS2 = 256 * 1024;
constexpr size_t WS_SMALL = 1 * MiB;
constexpr size_t SM_ROWSS1 = WS_SMALL;
constexpr size_t SM_SHWA = WS_SMALL + 256 * 1024;
constexpr size_t SM_SHWF = WS_SMALL + 384 * 1024;
constexpr size_t SM_ROPE = WS_SMALL + 512 * 1024;
constexpr size_t WS_BA = 2 * MiB;
constexpr size_t WS_CTXK = 6 * MiB + 256 * 1024;
constexpr size_t WS_CTXV = 6 * MiB + 512 * 1024;
constexpr size_t WS_G = 7 * MiB;
constexpr size_t WS_BETA = 10 * MiB;
constexpr size_t WS_WINA = 13 * MiB, WS_WINC = 20 * MiB, WS_WBR = 29 * MiB, WS_WOUT = 33 * MiB, WS_WUP = 35 * MiB, WS_WDN = 46 * MiB;
constexpr size_t WS_XN = 52 * MiB;
constexpr size_t WS_QKVR = 117 * MiB;
constexpr size_t WS_QKVP = 312 * MiB;
constexpr size_t WS_MG = 180 * MiB;
constexpr size_t WS_GT = 310 * MiB;
constexpr size_t WS_QAT = 375 * MiB;
constexpr size_t WS_KAT = 440 * MiB;
constexpr size_t WS_VAT = 457 * MiB;
constexpr size_t WS_Y = 52 * MiB;
constexpr size_t WS_MERGED = 375 * MiB;
constexpr size_t WS_X1S = 440 * MiB;
constexpr size_t WS_U = 52 * MiB;
constexpr size_t WS_ACT = 228 * MiB;
constexpr size_t WS_TQ = 117 * MiB;
constexpr size_t WS_AVEC = 248 * MiB;
constexpr size_t WS_END = 512 * MiB;

constexpr int LDS_BYTES = 147456;

DEVI float bf2f(unsigned short h) { return __uint_as_float((unsigned)h << 16); }
DEVI float bflo(unsigned w) { return __uint_as_float(w << 16); }
DEVI float bfhi(unsigned w) { return __uint_as_float(w & 0xffff0000u); }
typedef __bf16 bf16x2_t __attribute__((ext_vector_type(2)));
DEVI unsigned pk2(float lo, float hi) { const f32x2 v = {lo, hi}; const bf16x2_t b = __builtin_convertvector(v, bf16x2_t); return __builtin_bit_cast(unsigned, b); }
DEVI unsigned f2bf(float f) { return pk2(f, 0.f) & 0xffffu; }
DEVI float wave_sum(float v) {
#pragma unroll
    for (int o = 1; o < 64; o <<= 1) v += __shfl_xor(v, o);
    return v;
}
DEVI float siluf(float x) { return x * __builtin_amdgcn_rcpf(1.f + __expf(-x)); }
DEVI float sigmoidf_(float x) { return 1.f / (1.f + __expf(-x)); }

struct Args { const float* in[23]; float* out; unsigned char* ws; int ph_lo, ph_hi; };
struct KA {
    DEVI const float* in(int k) const { return ((const float* const*)__builtin_amdgcn_kernarg_segment_ptr())[k]; }
    DEVI float* out() const { return ((float* const*)__builtin_amdgcn_kernarg_segment_ptr())[23]; }
    DEVI unsigned char* ws() const { return ((unsigned char* const*)__builtin_amdgcn_kernarg_segment_ptr())[24]; }
};

namespace pg8 {
constexpr int BM = 256, BK = 64, HALF = 128, HTB = HALF * BK * 2, STAGE_BYTES = 8 * HTB, NXCD = 8, WGM = 8;
__host__ __device__ __forceinline__ int lds_byte(int r, int c) { const int st = (r >> 4) * 2 + (c >> 5), rr = r & 15, cc = c & 31, ob = rr * 64 + cc * 2; return st * 1024 + (ob ^ (((ob >> 9) & 1) << 5)); }
__host__ __device__ __forceinline__ void stage_rc(int b, int& R, int& C) { const int st = b / 1024, sb = b % 1024, swz = sb ^ (((sb >> 9) & 1) << 5); R = (st >> 1) * 16 + swz / 64; C = (st & 1) * 32 + (swz % 64) / 2; }
__host__ __device__ __forceinline__ int perm32(int rho) { const int n = rho >> 4, i = rho & 15; return 8 * (i >> 2) + 4 * n + (i & 3); }
struct Unit { int pm, pn; };
struct Gemm { const bf16_t* A; const bf16_t* Bt; int M, N, K; };
struct StaticOrder {
    int nM, nN, nwg, G, c;
    __device__ void init(int M, int N, int G_, int c_) { nM = M / BM; nN = N / BM; nwg = nM * nN; G = G_; c = c_; }
    __device__ bool next(int i, Unit& u) const {
        const long L = (long)i * G + c; if (L >= nwg) return false;
        int wgid = (int)L; { const int q = nwg / NXCD, r = nwg % NXCD, xcd = wgid % NXCD, off = wgid / NXCD; wgid = (xcd < r ? xcd * (q + 1) : r * (q + 1) + (xcd - r) * q) + off; }
        const int nig = WGM * nN, gid = wgid / nig, fm = gid * WGM, gsz = (nM - fm) < WGM ? (nM - fm) : WGM;
        u.pm = fm + ((wgid % nig) % gsz); u.pn = (wgid % nig) / gsz; return true;
    }
};
template <class Epi> __device__ __forceinline__ size_t a_off(const Epi& E, int pm, int K, size_t tstep) { if constexpr (Epi::AROW) return (size_t)E.arow(pm) * K * 2; else return (size_t)pm * tstep; }
template <class Epi, class Sched, bool ALIGN_EPI, bool SP2>
__device__ __forceinline__ void gemm_phase(LAS unsigned char* lds, const Gemm g, const Sched& S, const Epi& E) {
    const int tid = threadIdx.x, wid = __builtin_amdgcn_readfirstlane(tid >> 6), lane = tid & 63, wr = wid >> 2, wc = wid & 3, fr = lane & 15, fq = lane >> 4;
    const int K = g.K, nt = K / BK;
    unsigned voffA[2], voffB[2];
#pragma unroll
    for (int i = 0; i < 2; ++i) { int R, C; stage_rc(tid * 16 + i * 8192, R, C); const int Rb = Epi::PERM ? ((R & ~31) + perm32(R & 31)) : R;
        voffA[i] = (unsigned)(R * K + C) * 2u; voffB[i] = (unsigned)(Rb * K + C) * 2u; }
    const size_t kstep = (size_t)(BK * 2);
    const size_t hstep = (size_t)HALF * K * 2;
    const size_t tstep = 2 * hstep;
    const unsigned ldsw = (unsigned)wid * 1024u;
    const int aoff = lds_byte(wr * 64 + fr, fq * 8), boff = lds_byte(wc * 32 + fr, fq * 8);
#define PG8_SA(b, h) (((b) * 2 + (h)) * HTB)
#define PG8_SB(b, h) ((4 + (b) * 2 + (h)) * HTB)
#define PG8_STAGE(bufoff, gbase, voff) do { _Pragma("unroll") for (int _i = 0; _i < 2; ++_i) \
        __builtin_amdgcn_global_load_lds((const unsigned*)((const char*)(gbase) + (voff)[_i]), (LAS unsigned*)(lds + (bufoff) + ldsw + _i * 8192), 16, 0, 0); } while (0)
#define PG8_LDA(dst, b, h) do { _Pragma("unroll") for (int m = 0; m < 4; ++m) _Pragma("unroll") for (int k = 0; k < 2; ++k) dst[m][k] = *(const LAS bf16x8*)(lds + PG8_SA(b, h) + aoff + m * 2048 + k * 1024); } while (0)
#define PG8_LDB(dst, b, h) do { _Pragma("unroll") for (int n = 0; n < 2; ++n) _Pragma("unroll") for (int k = 0; k < 2; ++k) dst[n][k] = *(const LAS bf16x8*)(lds + PG8_SB(b, h) + boff + n * 2048 + k * 1024); } while (0)
#define PG8_MMA(ai, bj, At, Bt) do { __builtin_amdgcn_s_setprio(1); _Pragma("unroll") for (int m = 0; m < 4; ++m) _Pragma("unroll") for (int n = 0; n < 2; ++n) _Pragma("unroll") for (int k = 0; k < 2; ++k) \
        acc[ai][bj][m][n] = __builtin_amdgcn_mfma_f32_16x16x32_bf16(Bt[n][k], At[m][k], acc[ai][bj][m][n], 0, 0, 0); __builtin_amdgcn_s_setprio(0); } while (0)
#define PG8_WAIT_V(n) asm volatile("s_waitcnt vmcnt(" #n ")" ::: "memory")
#define PG8_WAIT_L(n) asm volatile("s_waitcnt lgkmcnt(" #n ")" ::: "memory")
#define PG8_BAR __builtin_amdgcn_s_barrier()
#define PG8_SCHED __builtin_amdgcn_sched_barrier(0)
    Unit cur, nxt; int ui = 0;
    if (!S.next(0, cur)) return;
    f32x4 acc[2][2][4][2];
#pragma unroll
    for (int a = 0; a < 2; ++a)
#pragma unroll
        for (int b = 0; b < 2; ++b)
#pragma unroll
            for (int m = 0; m < 4; ++m)
#pragma unroll
                for (int n = 0; n < 2; ++n) acc[a][b][m][n] = (f32x4){0.f, 0.f, 0.f, 0.f};
    bf16x8 At[4][2], B0[2][2], B1[2][2];
    const char* cA = (const char*)g.A + a_off<Epi>(E, cur.pm, K, tstep); const char* cB = (const char*)g.Bt + (size_t)cur.pn * tstep;
    if constexpr (SP2) {
        PG8_STAGE(PG8_SB(0, 0), cB, voffB); PG8_STAGE(PG8_SB(0, 1), cB + hstep, voffB); PG8_STAGE(PG8_SA(0, 0), cA, voffA); PG8_STAGE(PG8_SA(0, 1), cA + hstep, voffA);
        if (wr == 1) PG8_BAR;
        PG8_WAIT_V(2); PG8_BAR;
        PG8_STAGE(PG8_SB(1, 0), cB + kstep, voffB); PG8_STAGE(PG8_SA(1, 0), cA + kstep, voffA); PG8_STAGE(PG8_SB(1, 1), cB + hstep + kstep, voffB);
        PG8_WAIT_V(6); PG8_BAR;
    } else {
        PG8_STAGE(PG8_SB(0, 0), cB, voffB); PG8_STAGE(PG8_SA(0, 0), cA, voffA); PG8_STAGE(PG8_SB(0, 1), cB + hstep, voffB); PG8_STAGE(PG8_SA(0, 1), cA + hstep, voffA);
        if (wr == 1) PG8_BAR;
        PG8_WAIT_V(4); PG8_BAR;
        PG8_STAGE(PG8_SB(1, 0), cB + kstep, voffB); PG8_STAGE(PG8_SA(1, 0), cA + kstep, voffA); PG8_STAGE(PG8_SB(1, 1), cB + hstep + kstep, voffB);
        PG8_WAIT_V(6); PG8_BAR;
    }
    for (;;) {
        const bool has_next = S.next(ui + 1, nxt);
        const char* nA = has_next ? (const char*)g.A + a_off<Epi>(E, nxt.pm, K, tstep) : cA; const char* nB = has_next ? (const char*)g.Bt + (size_t)nxt.pn * tstep : cB;
#pragma unroll 1
        for (int t = 0; t < nt; t += 2) {
            const bool last = (t == nt - 2);
            if constexpr (Epi::MID) { if (t == nt / 2) E.mid(acc, cur, wr, wc, fr, fq); }
            const char* a1 = cA + (size_t)(t + 1) * kstep;
            const char* a2 = last ? nA : cA + (size_t)(t + 2) * kstep; const char* b2 = last ? nB : cB + (size_t)(t + 2) * kstep;
            const char* a3 = a2 + kstep; const char* b3 = b2 + kstep;
            if constexpr (SP2) {
            PG8_LDB(B0, 0, 0); PG8_LDB(B1, 0, 1); PG8_SCHED; PG8_LDA(At, 0, 0); PG8_STAGE(PG8_SA(1, 1), a1 + hstep, voffA);
            PG8_WAIT_V(8); PG8_WAIT_L(0); PG8_BAR; PG8_MMA(0, 0, At, B0); PG8_MMA(0, 1, At, B1); PG8_BAR; PG8_SCHED;
            PG8_LDA(At, 0, 1); PG8_STAGE(PG8_SB(0, 0), b2, voffB); PG8_STAGE(PG8_SB(0, 1), b2 + hstep, voffB); PG8_STAGE(PG8_SA(0, 0), a2, voffA);
            PG8_WAIT_V(8); PG8_WAIT_L(0); PG8_BAR; PG8_MMA(1, 0, At, B0); PG8_MMA(1, 1, At, B1); PG8_BAR; PG8_SCHED;
            PG8_LDB(B0, 1, 0); PG8_LDB(B1, 1, 1); PG8_SCHED; PG8_LDA(At, 1, 0); PG8_STAGE(PG8_SA(0, 1), a2 + hstep, voffA);
            PG8_WAIT_V(8); PG8_WAIT_L(0); PG8_BAR; PG8_MMA(0, 0, At, B0); PG8_MMA(0, 1, At, B1); PG8_BAR; PG8_SCHED;
            PG8_LDA(At, 1, 1); PG8_STAGE(PG8_SB(1, 0), b3, voffB); PG8_STAGE(PG8_SB(1, 1), b3 + hstep, voffB); PG8_STAGE(PG8_SA(1, 0), a3, voffA);
            PG8_WAIT_V(8); PG8_WAIT_L(0); PG8_BAR; PG8_MMA(1, 0, At, B0); PG8_MMA(1, 1, At, B1); PG8_BAR; PG8_SCHED;
            } else {
            PG8_LDB(B0, 0, 0); PG8_SCHED; PG8_LDA(At, 0, 0); PG8_STAGE(PG8_SA(1, 1), a1 + hstep, voffA);
            PG8_WAIT_L(8); PG8_BAR; PG8_WAIT_L(0); PG8_MMA(0, 0, At, B0); PG8_BAR; PG8_SCHED;
            PG8_LDB(B1, 0, 1); PG8_STAGE(PG8_SB(0, 0), b2, voffB);
            PG8_BAR; PG8_WAIT_L(0); PG8_MMA(0, 1, At, B1); PG8_BAR;
            PG8_LDA(At, 0, 1); PG8_STAGE(PG8_SA(0, 0), a2, voffA);
            PG8_BAR; PG8_WAIT_L(0); PG8_MMA(1, 0, At, B0); PG8_BAR; PG8_SCHED;
            PG8_STAGE(PG8_SB(0, 1), b2 + hstep, voffB);
            PG8_WAIT_V(6); PG8_BAR; PG8_MMA(1, 1, At, B1); PG8_BAR;
            PG8_LDB(B0, 1, 0); PG8_SCHED; PG8_LDA(At, 1, 0); PG8_STAGE(PG8_SA(0, 1), a2 + hstep, voffA);
            PG8_WAIT_L(8); PG8_BAR; PG8_WAIT_L(0); PG8_MMA(0, 0, At, B0); PG8_BAR; PG8_SCHED;
            PG8_LDB(B1, 1, 1); PG8_STAGE(PG8_SB(1, 0), b3, voffB);
            PG8_BAR; PG8_WAIT_L(0); PG8_MMA(0, 1, At, B1); PG8_BAR;
            PG8_LDA(At, 1, 1); PG8_STAGE(PG8_SA(1, 0), a3, voffA);
            PG8_BAR; PG8_WAIT_L(0); PG8_MMA(1, 0, At, B0); PG8_BAR; PG8_SCHED;
            PG8_STAGE(PG8_SB(1, 1), b3 + hstep, voffB);
            PG8_WAIT_V(6); PG8_BAR; PG8_MMA(1, 1, At, B1); PG8_BAR;
            }
        }
        if constexpr (ALIGN_EPI) { if (wr == 0) PG8_BAR; }
        E(acc, cur, wr, wc, fr, fq);
        if (!has_next) break;
#pragma unroll
        for (int a = 0; a < 2; ++a)
#pragma unroll
            for (int b = 0; b < 2; ++b)
#pragma unroll
                for (int m = 0; m < 4; ++m)
#pragma unroll
                    for (int n = 0; n < 2; ++n) acc[a][b][m][n] = (f32x4){0.f, 0.f, 0.f, 0.f};
        cur = nxt; cA = nA; cB = nB; ++ui;
        if constexpr (ALIGN_EPI) { if (wr == 1) PG8_BAR; }
    }
    PG8_WAIT_V(0);
    if constexpr (!ALIGN_EPI) { if (wr == 0) PG8_BAR; }
    PG8_BAR;
#undef PG8_SA
#undef PG8_SB
#undef PG8_STAGE
#undef PG8_LDA
#undef PG8_LDB
#undef PG8_MMA
#undef PG8_WAIT_V
#undef PG8_WAIT_L
#undef PG8_BAR
#undef PG8_SCHED
}
}
using pg8::HALF;

DEVI u32x4 pack8(const f32x4& a, const f32x4& b) { u32x4 w; w.x = pk2(a[0], a[1]); w.y = pk2(a[2], a[3]); w.z = pk2(b[0], b[1]); w.w = pk2(b[2], b[3]); return w; }

struct EpiIn {
    static constexpr bool PERM = true, MID = false, AROW = false;
    const float* rowss; const float* shW; int job;
    bf16_t *d0, *d1, *d2, *d3, *d4; float* ba;
    DEVI void operator()(const f32x4 (&acc)[2][2][4][2], const pg8::Unit& u, int wr, int wc, int fr, int fq) const {
        asm volatile("" : "+v"(fr), "+v"(fq));
        const int vs = u.pm < 64 ? 0 : (u.pm < 128 ? 1 : 2);
        bf16_t* base; int pitch, colt; bool isba = false;
        if (job == 0) { base = d0; pitch = 3072; colt = u.pn * 256; if (u.pn >= 12) isba = true; }
        else {
            if (u.pn < 4) { base = d0; pitch = 1024; colt = u.pn * 256; }
            else if (u.pn < 8) { base = d1; pitch = 1024; colt = (u.pn - 4) * 256; }
            else if (u.pn == 8) { base = d2; pitch = 256; colt = 0; }
            else if (u.pn == 9) { base = d3; pitch = 256; colt = 0; }
            else { base = d4; pitch = 2048; colt = (u.pn - 10) * 256; }
        }
        const int ncol0 = u.pn * 256 + wc * 32 + 8 * fq;
        f32x4 sv[2][2];
#pragma unroll
        for (int bj = 0; bj < 2; ++bj)
#pragma unroll
            for (int n = 0; n < 2; ++n) sv[bj][n] = *(const f32x4*)(shW + vs * NSH + ncol0 + bj * HALF + 4 * n);
        const int row0 = u.pm * 256 + wr * 64 + fr;
#pragma unroll
        for (int ai = 0; ai < 2; ++ai)
#pragma unroll
            for (int m = 0; m < 4; ++m) {
                const int row = row0 + ai * HALF + m * 16;
                const float rs = rsqrtf(rowss[row] * (1.f / 1024.f) + EPS);
                if (!isba) {
                    bf16_t* rowp = base + (size_t)row * pitch + colt + wc * 32 + 8 * fq;
#pragma unroll
                    for (int bj = 0; bj < 2; ++bj) { const f32x4 v0 = acc[ai][bj][m][0] * rs + sv[bj][0], v1 = acc[ai][bj][m][1] * rs + sv[bj][1]; *(u32x4*)(rowp + bj * HALF) = pack8(v0, v1); }
                } else if (wc == 0) {
                    float* rowp = ba + (size_t)row * 32 + 8 * fq;
                    *(f32x4*)(rowp) = acc[ai][0][m][0] * rs + sv[0][0]; *(f32x4*)(rowp + 4) = acc[ai][0][m][1] * rs + sv[0][1];
                }
            }
    }
};
struct TailOrder { int idx; __device__ bool next(int i, pg8::Unit& u) const { if (i == 0 && idx >= 0 && idx < 4) { u.pm = idx >> 1; u.pn = idx & 1; return true; } return false; } };
struct EpiCtxKV {
    static constexpr bool PERM = true, MID = false, AROW = false;
    const float* rowss; const float* shW; bf16_t* kat; bf16_t* vat;
    DEVI void operator()(const f32x4 (&acc)[2][2][4][2], const pg8::Unit& u, int wr, int wc, int fr, int fq) const {
        asm volatile("" : "+v"(fr), "+v"(fq));
        bf16_t* base = (u.pn == 0 ? kat : vat);
        const int ncol0 = u.pn * 256 + wc * 32 + 8 * fq;
#pragma unroll
        for (int bj = 0; bj < 2; ++bj) {
            const f32x4 sv0 = *(const f32x4*)(shW + ncol0 + bj * HALF), sv1 = *(const f32x4*)(shW + ncol0 + bj * HALF + 4);
#pragma unroll
            for (int ai = 0; ai < 2; ++ai)
#pragma unroll
                for (int m = 0; m < 4; ++m) { const int row = u.pm * 256 + ai * HALF + wr * 64 + m * 16 + fr;
                    const float rs = rsqrtf(rowss[row] * (1.f / 1024.f) + EPS);
                    *(u32x4*)(base + (size_t)row * 256 + wc * 32 + 8 * fq + bj * HALF) = pack8(acc[ai][bj][m][0] * rs + sv0, acc[ai][bj][m][1] * rs + sv1); }
        }
    }
};
struct EpiBr {
    static constexpr bool PERM = true, MID = true, AROW = false;
    const bf16_t* mg; bf16_t* out;
    DEVI void mid(f32x4 (&acc)[2][2][4][2], const pg8::Unit& u, int wr, int wc, int fr, int fq) const {
        asm volatile("" : "+v"(fr), "+v"(fq));
        const int row0 = u.pm * 256 + wr * 64 + fr, col0 = u.pn * 256 + wc * 32 + 8 * fq;
#pragma unroll
        for (int ai = 0; ai < 2; ++ai)
#pragma unroll
            for (int m = 0; m < 4; ++m) {
                const bf16_t* rp = mg + (size_t)(row0 + ai * HALF + m * 16) * 2048 + col0;
#pragma unroll
                for (int bj = 0; bj < 2; ++bj) {
                    const u32x4 gd = *(const u32x4*)(rp + bj * HALF), ga = *(const u32x4*)(rp + 1024 + bj * HALF);
                    float r[8];
#pragma unroll
                    for (int i = 0; i < 4; ++i) {
                        const float d0 = bflo(gd[i]), d1 = bfhi(gd[i]), a0 = bflo(ga[i]), a1 = bfhi(ga[i]);
                        r[2 * i] = (1.f + __expf(fminf(-a0, 80.f))) * __builtin_amdgcn_rcpf(1.f + __expf(fminf(-d0, 80.f)));
                        r[2 * i + 1] = (1.f + __expf(fminf(-a1, 80.f))) * __builtin_amdgcn_rcpf(1.f + __expf(fminf(-d1, 80.f)));
                    }
                    acc[ai][bj][m][0] *= (f32x4){r[0], r[1], r[2], r[3]}; acc[ai][bj][m][1] *= (f32x4){r[4], r[5], r[6], r[7]};
                    asm volatile("" ::: "memory");
                }
            }
    }
    DEVI void operator()(const f32x4 (&acc)[2][2][4][2], const pg8::Unit& u, int wr, int wc, int fr, int fq) const {
        asm volatile("" : "+v"(fr), "+v"(fq));
        const int row0 = u.pm * 256 + wr * 64 + fr, col0 = u.pn * 256 + wc * 32 + 8 * fq;
#pragma unroll
        for (int ai = 0; ai < 2; ++ai)
#pragma unroll
            for (int m = 0; m < 4; ++m) {
                const size_t row = (size_t)(row0 + ai * HALF + m * 16);
                const bf16_t* rp = mg + row * 2048 + 1024 + col0;
#pragma unroll
                for (int bj = 0; bj < 2; ++bj) {
                    const u32x4 ga = *(const u32x4*)(rp + bj * HALF);
                    float s[8];
#pragma unroll
                    for (int i = 0; i < 4; ++i) { s[2 * i] = __builtin_amdgcn_rcpf(1.f + __expf(fminf(-bflo(ga[i]), 80.f))); s[2 * i + 1] = __builtin_amdgcn_rcpf(1.f + __expf(fminf(-bfhi(ga[i]), 80.f))); }
                    const f32x4 v0 = acc[ai][bj][m][0] * (f32x4){s[0], s[1], s[2], s[3]}, v1 = acc[ai][bj][m][1] * (f32x4){s[4], s[5], s[6], s[7]};
                    *(u32x4*)(out + row * 1024 + col0 + bj * HALF) = pack8(v0, v1);
                }
            }
    }
};
struct EpiOut {
    static constexpr bool PERM = false, MID = false, AROW = false;
    const float* x; const float* modacc; const float* bada; const float* nwf; float* out; bf16_t* x1s; float* rowss2;
    DEVI void operator()(const f32x4 (&acc)[2][2][4][2], const pg8::Unit& u, int wr, int wc, int fr, int fq) const {
        asm volatile("" : "+v"(fr), "+v"(fq));
        const int b = u.pm >> 6; const int row0 = u.pm * 256 + wr * 64 + fr, col0 = u.pn * 256 + wc * 32 + 4 * fq;
        f32x4 ga[2][2], sc[2][2];
#pragma unroll
        for (int bj = 0; bj < 2; ++bj)
#pragma unroll
            for (int n = 0; n < 2; ++n) { const int c = col0 + bj * HALF + n * 16;
                ga[bj][n] = *(const f32x4*)(modacc + b * 6144 + 2048 + c) + *(const f32x4*)(bada + 2048 + c);
                sc[bj][n] = (*(const f32x4*)(modacc + b * 6144 + 4096 + c) + *(const f32x4*)(bada + 4096 + c) + 1.f) * *(const f32x4*)(nwf + c); }
#pragma unroll
        for (int ai = 0; ai < 2; ++ai)
#pragma unroll
            for (int m = 0; m < 4; ++m) {
                const size_t off = (size_t)(row0 + ai * HALF + m * 16) * 1024 + col0; float ss = 0.f;
#pragma unroll
                for (int bj = 0; bj < 2; ++bj)
#pragma unroll
                    for (int n = 0; n < 2; ++n) {
                        const f32x4 xv = *(const f32x4*)(x + off + bj * HALF + n * 16);
                        const f32x4 o = xv + ga[bj][n] * acc[ai][bj][m][n];
                        *(f32x4*)(out + off + bj * HALF + n * 16) = o;
                        ss += (o[0] * o[0] + o[1] * o[1]) + (o[2] * o[2] + o[3] * o[3]);
                        const f32x4 s = o * sc[bj][n]; u32x2 w; w.x = pk2(s[0], s[1]); w.y = pk2(s[2], s[3]);
                        *(u32x2*)(x1s + off + (size_t)(b * (RB - SEQ) + 1) * 1024 + bj * HALF + n * 16) = w;
                    }
                ss += __shfl_xor(ss, 16); ss += __shfl_xor(ss, 32);
                if (fq == 0) atomicAdd(rowss2 + row0 + ai * HALF + m * 16, ss);
            }
    }
};
DEVI f32x4 dpp_ror1(const f32x4& x) { f32x4 r;
#pragma unroll
    for (int i = 0; i < 4; ++i) r[i] = __int_as_float(__builtin_amdgcn_update_dpp(0, __float_as_int(x[i]), 0x121, 0xf, 0xf, false));
    return r; }
DEVI f32x4 dpp_rol1(const f32x4& x) { f32x4 r;
#pragma unroll
    for (int i = 0; i < 4; ++i) r[i] = __int_as_float(__builtin_amdgcn_update_dpp(0, __float_as_int(x[i]), 0x12F, 0xf, 0xf, false));
    return r; }
struct EpiUpConv {
    static constexpr bool PERM = true, MID = false, AROW = true;
    const float* rowss2; const float* shWf; const float* cw; const float* cb; bf16_t* act; LAS float* xb;
    DEVI int arow(int pm) const { const int b = pm / TPB, i = pm - b * TPB; return b * RB + 254 * i; }
    DEVI void operator()(f32x4 (&acc)[2][2][4][2], const pg8::Unit& u, int wr, int wc, int fr, int fq) const {
        asm volatile("" : "+v"(fr), "+v"(fq));
        const int b = u.pm / TPB, ti = u.pm - b * TPB, tok0 = 254 * ti - 1;
        const int cl0 = wc * 32 + 8 * fq;
#pragma unroll
        for (int bj = 0; bj < 2; ++bj) {
            const f32x4 sv0 = *(const f32x4*)(shWf + b * NUP + u.pn * 256 + bj * HALF + cl0), sv1 = *(const f32x4*)(shWf + b * NUP + u.pn * 256 + bj * HALF + cl0 + 4);
#pragma unroll
            for (int ai = 0; ai < 2; ++ai)
#pragma unroll
                for (int m = 0; m < 4; ++m) {
                    const int tok = tok0 + ai * HALF + wr * 64 + m * 16 + fr; const bool ok = tok >= 0 && tok < SEQ;
                    const float rs = ok ? rsqrtf(rowss2[b * SEQ + (ok ? tok : 0)] * (1.f / 1024.f) + EPS) : 0.f;
                    acc[ai][bj][m][0] = ok ? acc[ai][bj][m][0] * rs + sv0 : (f32x4){0.f, 0.f, 0.f, 0.f};
                    acc[ai][bj][m][1] = ok ? acc[ai][bj][m][1] * rs + sv1 : (f32x4){0.f, 0.f, 0.f, 0.f};
                }
        }
#pragma unroll
        for (int ai = 0; ai < 2; ++ai) { const int blk = 2 * ai + wr;
#pragma unroll
            for (int bj = 0; bj < 2; ++bj)
#pragma unroll
                for (int n = 0; n < 2; ++n) {
                    if (fr == 0) *(LAS f32x4*)(xb + (blk * 2 + 0) * 256 + bj * HALF + cl0 + 4 * n) = acc[ai][bj][0][n];
                    if (fr == 15) *(LAS f32x4*)(xb + (blk * 2 + 1) * 256 + bj * HALF + cl0 + 4 * n) = acc[ai][bj][3][n];
                } }
        asm volatile("s_waitcnt lgkmcnt(0)" ::: "memory"); __builtin_amdgcn_s_barrier(); asm volatile("" ::: "memory");
        const int f0 = u.pn * 128 + cl0;
#pragma unroll
        for (int n = 0; n < 2; ++n) {
            f32x4 wg[3], wv[3];
#pragma unroll
            for (int j = 0; j < 3; ++j) { wg[j] = *(const f32x4*)(cw + j * NUP + f0 + 4 * n); wv[j] = *(const f32x4*)(cw + j * NUP + DFF + f0 + 4 * n); }
            const f32x4 bgv = *(const f32x4*)(cb + f0 + 4 * n), bvv = *(const f32x4*)(cb + DFF + f0 + 4 * n);
#pragma unroll
            for (int ai = 0; ai < 2; ++ai) { const int blk = 2 * ai + wr;
                const f32x4 pgx = *(const LAS f32x4*)(xb + (((blk + 3) & 3) * 2 + 1) * 256 + cl0 + 4 * n), pvx = *(const LAS f32x4*)(xb + (((blk + 3) & 3) * 2 + 1) * 256 + HALF + cl0 + 4 * n);
                const f32x4 ngx = *(const LAS f32x4*)(xb + (((blk + 1) & 3) * 2 + 0) * 256 + cl0 + 4 * n), nvx = *(const LAS f32x4*)(xb + (((blk + 1) & 3) * 2 + 0) * 256 + HALF + cl0 + 4 * n);
#pragma unroll
                for (int m = 0; m < 4; ++m) {
                    f32x4 ug, uv;
                    { const f32x4 c = acc[ai][0][m][n], up = m > 0 ? acc[ai][0][m > 0 ? m - 1 : 0][n] : pgx, dn = m < 3 ? acc[ai][0][m < 3 ? m + 1 : 3][n] : ngx;
                      f32x4 pr = dpp_ror1(fr == 15 ? up : c), nx = dpp_rol1(fr == 0 ? dn : c);
                      asm volatile("" : "+v"(pr), "+v"(nx));
                      ug = bgv + wg[0] * pr + wg[1] * c + wg[2] * nx; }
                    { const f32x4 c = acc[ai][1][m][n], up = m > 0 ? acc[ai][1][m > 0 ? m - 1 : 0][n] : pvx, dn = m < 3 ? acc[ai][1][m < 3 ? m + 1 : 3][n] : nvx;
                      f32x4 pr = dpp_ror1(fr == 15 ? up : c), nx = dpp_rol1(fr == 0 ? dn : c);
                      asm volatile("" : "+v"(pr), "+v"(nx));
                      uv = bvv + wv[0] * pr + wv[1] * c + wv[2] * nx; }
                    const int r = ai * HALF + wr * 64 + m * 16 + fr, tok = tok0 + r;
                    if (r >= 1 && r <= 254 && tok < SEQ) {
                        u32x2 w; w.x = pk2(siluf(ug[0]) * uv[0], siluf(ug[1]) * uv[1]); w.y = pk2(siluf(ug[2]) * uv[2], siluf(ug[3]) * uv[3]);
                        *(u32x2*)(act + (size_t)(b * SEQ + tok) * DFF + f0 + 4 * n) = w; }
                    asm volatile("" ::: "memory");
                }
            }
        }
    }
};
struct EpiDown {
    static constexpr bool PERM = false, MID = false, AROW = false;
    const float* modacc; const float* bada; float* out;
    DEVI void operator()(const f32x4 (&acc)[2][2][4][2], const pg8::Unit& u, int wr, int wc, int fr, int fq) const {
        asm volatile("" : "+v"(fr), "+v"(fq));
        const int b = u.pm >> 6; const int row0 = u.pm * 256 + wr * 64 + fr, col0 = u.pn * 256 + wc * 32 + 4 * fq;
        f32x4 gf[2][2];
#pragma unroll
        for (int bj = 0; bj < 2; ++bj)
#pragma unroll
            for (int n = 0; n < 2; ++n) { const int c = col0 + bj * HALF + n * 16; gf[bj][n] = *(const f32x4*)(modacc + b * 6144 + 5120 + c) + *(const f32x4*)(bada + 5120 + c); }
#pragma unroll
        for (int ai = 0; ai < 2; ++ai)
#pragma unroll
            for (int m = 0; m < 4; ++m) {
                const size_t off = (size_t)(row0 + ai * HALF + m * 16) * 1024 + col0;
#pragma unroll
                for (int bj = 0; bj < 2; ++bj)
#pragma unroll
                    for (int n = 0; n < 2; ++n) { float* p = out + off + bj * HALF + n * 16; *(f32x4*)p = *(const f32x4*)p + gf[bj][n] * acc[ai][bj][m][n]; }
            }
    }
};

DEVI void transpose_item(const float* W, int srcN, int k0, int n0, bf16_t* dst  , int dstK, LAS float* scr, int lane) {
#pragma unroll
    for (int i = 0; i < 8; ++i) { const int kk = 8 * i + (lane >> 3), n4 = (lane & 7) * 4; const f32x4 v = *(const f32x4*)(W + (size_t)(k0 + kk) * srcN + n0 + n4);
        LAS float* d = scr + kk * 33 + n4; d[0] = v[0]; d[1] = v[1]; d[2] = v[2]; d[3] = v[3]; }
    asm volatile("s_waitcnt lgkmcnt(0)" ::: "memory");
    const int c = lane & 7;
#pragma unroll
    for (int j = 0; j < 4; ++j) { const int n = (lane >> 3) + 8 * j; const LAS float* s = scr + (8 * c) * 33 + n;
        u32x4 o; o.x = pk2(s[0 * 33], s[1 * 33]); o.y = pk2(s[2 * 33], s[3 * 33]); o.z = pk2(s[4 * 33], s[5 * 33]); o.w = pk2(s[6 * 33], s[7 * 33]);
        *(u32x4*)(dst + (size_t)n * dstK + 8 * c) = o; }
    asm volatile("s_waitcnt lgkmcnt(0)" ::: "memory");
}
DEVI void phase0(const KA& a, LAS unsigned char* lds, int tid, int lane, int wave) {
    unsigned char* ws = a.ws();
    bf16_t* WinA = (bf16_t*)(ws + WS_WINA); bf16_t* WinC = (bf16_t*)(ws + WS_WINC); bf16_t* Wbr = (bf16_t*)(ws + WS_WBR);
    bf16_t* Wout = (bf16_t*)(ws + WS_WOUT); bf16_t* Wup = (bf16_t*)(ws + WS_WUP); bf16_t* Wdn = (bf16_t*)(ws + WS_WDN);
    LAS float* scr = (LAS float*)(lds + wave * 16384);
    const int gw = blockIdx.x * 8 + wave, NGW = gridDim.x * 8;
    constexpr int I_IN = 16 * 241, I_BR = 16 * 32, I_UP = 16 * 176, I_DN = 44 * 32;
    constexpr int NITEMS = I_IN + 3 * I_BR + I_UP + I_DN;
    for (int it = gw; it < NITEMS; it += NGW) {
        int r = it;
        if (r < I_IN) { const int kb = r / 241, nb = r % 241, c0 = nb * 32; bf16_t* d; int row;
            if (c0 < 3072) { d = WinA; row = c0; } else if (c0 < 4096) { d = WinC; row = c0 - 3072; } else if (c0 == 4096) { d = WinA; row = 3072; }
            else if (c0 < 5152) { d = WinC; row = 1024 + (c0 - 4128); } else if (c0 < 5408) { d = WinC; row = 2048 + (c0 - 5152); }
            else if (c0 < 5664) { d = WinC; row = 2304 + (c0 - 5408); } else { d = WinC; row = 2560 + (c0 - 5664); }
            transpose_item(a.in(8), 7712, kb * 64, c0, d + (size_t)row * 1024 + kb * 64, 1024, scr, lane); continue; }
        r -= I_IN;
        if (r < I_BR) { const int kb = r / 32, nb = r % 32; transpose_item(a.in(16), 1024, kb * 64, nb * 32, Wbr + (size_t)(nb * 32) * 2048 + kb * 64, 2048, scr, lane); continue; }
        r -= I_BR;
        if (r < I_BR) { const int kb = r / 32, nb = r % 32; transpose_item(a.in(17), 1024, kb * 64, nb * 32, Wbr + (size_t)(nb * 32) * 2048 + 1024 + kb * 64, 2048, scr, lane); continue; }
        r -= I_BR;
        if (r < I_BR) { const int kb = r / 32, nb = r % 32; transpose_item(a.in(18), 1024, kb * 64, nb * 32, Wout + (size_t)(nb * 32) * 1024 + kb * 64, 1024, scr, lane); continue; }
        r -= I_BR;
        if (r < I_UP) { const int kb = r / 176, nb = r % 176, c0 = nb * 32; int row;
            if (c0 < DFF) row = 256 * (c0 / 128) + (c0 % 128); else { const int c1 = c0 - DFF; row = 256 * (c1 / 128) + 128 + (c1 % 128); }
            transpose_item(a.in(19), NUP, kb * 64, c0, Wup + (size_t)row * 1024 + kb * 64, 1024, scr, lane); continue; }
        r -= I_UP;
        { const int kb = r / 32, nb = r % 32; transpose_item(a.in(22), 1024, kb * 64, nb * 32, Wdn + (size_t)(nb * 32) * DFF + kb * 64, DFF, scr, lane); }
    }
    float* modacc = (float*)(ws + CTL_MODACC);
    for (int it = blockIdx.x; it < 12 * 16; it += gridDim.x) {
        const int cb = it % 12, ks = it / 12, n = cb * 512 + tid;
        float a0 = 0.f, a1 = 0.f, a2 = 0.f;
#pragma unroll 8
        for (int k = ks * 64; k < ks * 64 + 64; ++k) {
            const float w = a.in(4)[(size_t)k * 6144 + n];
            a0 += siluf(a.in(1)[k]) * w; a1 += siluf(a.in(1)[1024 + k]) * w; a2 += siluf(a.in(3)[k]) * w;
        }
        atomicAdd(modacc + n, a0); atomicAdd(modacc + 6144 + n, a1); atomicAdd(modacc + 12288 + n, a2);
    }
    float* rope = (float*)(ws + SM_ROPE);
    for (int i = blockIdx.x * 512 + tid; i < 320 * 32; i += gridDim.x * 512) {
        const int p = i >> 5, f = i & 31; const float inv = powf(10000.f, -(float)f / 32.f);
        if (p < 256) { const float ang = (float)p * inv; rope[p * 32 + f] = cosf(ang); rope[8192 + p * 32 + f] = sinf(ang); }
        else { const int q = p - 256; const float ang = (float)q * inv; rope[16384 + q * 32 + f] = cosf(ang); rope[16384 + 2048 + q * 32 + f] = sinf(ang); }
    }
}

DEVI void phase1(const KA& a, int tid, int lane, int wave) {
    unsigned char* ws = a.ws();
    const float* modacc = (const float*)(ws + CTL_MODACC); const float* bada = a.in(5);
    bf16_t* XN = (bf16_t*)(ws + WS_XN); float* rowss1 = (float*)(ws + SM_ROWSS1);
    const int gw = blockIdx.x * 8 + wave, NGW = gridDim.x * 8;
    {
        const int per = (MT + NGW - 1) / NGW, rbeg = gw * per, rend = rbeg + per < MT ? rbeg + per : MT;
        int vcur = -1; f32x4 sc[4];
        for (int row = rbeg; row < rend; row += 2) {
            const int vs = row < SEQ ? 0 : (row < ML ? 1 : 2);
            if (vs != vcur) { vcur = vs;
#pragma unroll
                for (int j = 0; j < 4; ++j) { const int c = 4 * lane + 256 * j; sc[j] = (*(const f32x4*)(modacc + vs * 6144 + 1024 + c) + *(const f32x4*)(bada + 1024 + c) + 1.f) * *(const f32x4*)(a.in(6) + c); } }
            const int row1 = row + 1; const bool two = row1 < rend && (row1 < SEQ ? 0 : (row1 < ML ? 1 : 2)) == vs;
            const float* xr0 = row < ML ? a.in(0) + (size_t)row * 1024 : a.in(2) + (size_t)(row - ML) * 1024;
            const float* xr1 = two ? (row1 < ML ? a.in(0) + (size_t)row1 * 1024 : a.in(2) + (size_t)(row1 - ML) * 1024) : xr0;
            f32x4 v0[4], v1[4];
#pragma unroll
            for (int j = 0; j < 4; ++j) { v0[j] = *(const f32x4*)(xr0 + 4 * lane + 256 * j); v1[j] = *(const f32x4*)(xr1 + 4 * lane + 256 * j); }
            float s0 = 0.f, s1 = 0.f;
#pragma unroll
            for (int j = 0; j < 4; ++j) { const int c = 4 * lane + 256 * j;
                s0 += (v0[j][0] * v0[j][0] + v0[j][1] * v0[j][1]) + (v0[j][2] * v0[j][2] + v0[j][3] * v0[j][3]);
                s1 += (v1[j][0] * v1[j][0] + v1[j][1] * v1[j][1]) + (v1[j][2] * v1[j][2] + v1[j][3] * v1[j][3]);
                const f32x4 o0 = v0[j] * sc[j], o1 = v1[j] * sc[j];
                u32x2 w; w.x = pk2(o0[0], o0[1]); w.y = pk2(o0[2], o0[3]); *(u32x2*)(XN + (size_t)row * 1024 + c) = w;
                if (two) { u32x2 w1; w1.x = pk2(o1[0], o1[1]); w1.y = pk2(o1[2], o1[3]); *(u32x2*)(XN + (size_t)row1 * 1024 + c) = w1; } }
            s0 = wave_sum(s0); s1 = wave_sum(s1);
            if (lane == 0) { rowss1[row] = s0; if (two) rowss1[row1] = s1; }
            if (!two) --row;
        }
    }
    const bf16_t* WinA = (const bf16_t*)(ws + WS_WINA); const bf16_t* WinC = (const bf16_t*)(ws + WS_WINC); const bf16_t* Wup = (const bf16_t*)(ws + WS_WUP);
    float* shWa = (float*)(ws + SM_SHWA); float* shWf = (float*)(ws + SM_SHWF);
    for (int n = gw; n < NSH + NUP; n += NGW) {
        const bool isf = n >= NSH;
        const bf16_t* wrow = isf ? Wup + (size_t)(n - NSH) * 1024 : (n < NA ? WinA + (size_t)n * 1024 : WinC + (size_t)(n - NA) * 1024);
        const int shoff = isf ? 3072 : 0;
        float s0 = 0.f, s1 = 0.f, s2 = 0.f;
#pragma unroll
        for (int h = 0; h < 2; ++h) {
            const int k0 = h * 512 + lane * 8;
            const u32x4 w = *(const u32x4*)(wrow + k0);
#pragma unroll
            for (int i = 0; i < 4; ++i) {
                const float wl = bflo(w[i]), wh = bfhi(w[i]); const int k = k0 + 2 * i;
                const float b0 = bada[shoff + k], b1 = bada[shoff + k + 1];
                s0 += (modacc[shoff + k] + b0) * wl + (modacc[shoff + k + 1] + b1) * wh;
                s1 += (modacc[6144 + shoff + k] + b0) * wl + (modacc[6144 + shoff + k + 1] + b1) * wh;
                s2 += (modacc[12288 + shoff + k] + b0) * wl + (modacc[12288 + shoff + k + 1] + b1) * wh;
            }
        }
        s0 = wave_sum(s0); s1 = wave_sum(s1); s2 = wave_sum(s2);
        if (lane == 0) {
            if (isf) { shWf[n - NSH] = s0; shWf[NUP + n - NSH] = s1; }
            else { shWa[n] = s0; shWa[NSH + n] = s1; shWa[2 * NSH + n] = s2; }
        }
    }
}

DEVI u32x4 ldrow_(const bf16_t* base, int seq_start, int seq_len, int tt) {
    const int tc = tt < 0 ? 0 : (tt >= seq_len ? seq_len - 1 : tt);
    const u32x4 v = *(const u32x4*)(base + (size_t)(seq_start + tc) * 3072);
    const unsigned m = (tt == tc) ? 0xffffffffu : 0u;
    return (u32x4){v[0] & m, v[1] & m, v[2] & m, v[3] & m};
}
DEVI void phase_dnprep(const KA& a, int tid) {
    unsigned char* ws = a.ws();
    const bf16_t* QR = (const bf16_t*)(ws + WS_QKVR); bf16_t* QP = (bf16_t*)(ws + WS_QKVP);
    const float* convw = a.in(9); const float* ba = (const float*)(ws + WS_BA);
    float* gb = (float*)(ws + WS_G); float* bb = (float*)(ws + WS_BETA);
    const int cgp = tid & 127, strip = tid >> 7;
    for (int it = blockIdx.x; it < 520 * 3; it += gridDim.x) {
        const int cidx = it / 3, sec = it - cidx * 3;
        int seq_start, t0, seq_len;
        if (cidx < 512) { seq_start = (cidx >> 8) * SEQ; t0 = (cidx & 255) * 64; seq_len = SEQ; }
        else { const int c2 = cidx - 512; seq_start = ML + (c2 >> 2) * CTX; t0 = (c2 & 3) * 64; seq_len = CTX; }
        const int col = sec * 1024 + cgp * 8;
        f32x4 w0[5], w1[5];
#pragma unroll
        for (int j = 0; j < 5; ++j) { w0[j] = *(const f32x4*)(convw + j * 3072 + col); w1[j] = *(const f32x4*)(convw + j * 3072 + col + 4); }
        const int tb = t0 + strip * 16;
        u32x4 win[5];
#define LDROW(tt) ldrow_(QR + col, seq_start, seq_len, (tt))
        win[0] = LDROW(tb - 2); win[1] = LDROW(tb - 1); win[2] = LDROW(tb); win[3] = LDROW(tb + 1);
#pragma unroll
        for (int r = 0; r < 16; ++r) {
            win[4] = LDROW(tb + r + 2);
            f32x4 acc0 = {0.f, 0.f, 0.f, 0.f}, acc1 = {0.f, 0.f, 0.f, 0.f};
#pragma unroll
            for (int j = 0; j < 5; ++j) { const u32x4 x = win[j];
                acc0 += (f32x4){bflo(x[0]), bfhi(x[0]), bflo(x[1]), bfhi(x[1])} * w0[j];
                acc1 += (f32x4){bflo(x[2]), bfhi(x[2]), bflo(x[3]), bfhi(x[3])} * w1[j]; }
            float y[8];
#pragma unroll
            for (int i = 0; i < 4; ++i) { y[i] = siluf(acc0[i]); y[4 + i] = siluf(acc1[i]); }
            if (sec < 2) {
                float ss = 0.f;
#pragma unroll
                for (int i = 0; i < 8; ++i) ss += y[i] * y[i];
                ss += __shfl_xor(ss, 1); ss += __shfl_xor(ss, 2); ss += __shfl_xor(ss, 4); ss += __shfl_xor(ss, 8);
                const float sc = rsqrtf(ss + EPS) * (sec == 0 ? 0.08838834764831845f : 1.f);
#pragma unroll
                for (int i = 0; i < 8; ++i) y[i] *= sc;
            }
            u32x4 o; o.x = pk2(y[0], y[1]); o.y = pk2(y[2], y[3]); o.z = pk2(y[4], y[5]); o.w = pk2(y[6], y[7]);
            *(u32x4*)(QP + (size_t)(seq_start + tb + r) * 3072 + col) = o;
            win[0] = win[1]; win[1] = win[2]; win[2] = win[3]; win[3] = win[4];
        }
#undef LDROW
        if (sec == 0) {
#pragma unroll
            for (int q = 0; q < 2; ++q) {
                const int e = tid + q * 512, r = e >> 4, idx = e & 15, row = seq_start + t0 + r;
                const float bv = ba[(size_t)row * 32 + idx], av = ba[(size_t)row * 32 + 16 + idx];
                const float xs = av + a.in(11)[idx];
                const float sp = fmaxf(xs, 0.f) + log1pf(expf(-fabsf(xs)));
                const float g = -expf(a.in(10)[idx]) * sp;
                const int dir = idx >> 3, h = idx & 7;
                gb[((size_t)dir * MT + row) * 8 + h] = g;
                bb[((size_t)dir * MT + row) * 8 + h] = 1.f / (1.f + expf(-bv));
            }
        }
    }
}

DEVI void phase_dnscan(const KA& a, int lane, int wave) {
    unsigned char* ws = a.ws();
    const bf16_t* QP = (const bf16_t*)(ws + WS_QKVP);
    const float* gb = (const float*)(ws + WS_G); const float* bb = (const float*)(ws + WS_BETA);
    bf16_t* Of = (bf16_t*)a.out(); bf16_t* Ob = Of + (size_t)ML * 1024;
    const int gw = blockIdx.x * 8 + wave, NGW = gridDim.x * 8;
    for (int item = gw; item < 2048; item += NGW) {
        const int chain = item >> 6, ep = item & 63, dir = chain >> 4, b = (chain >> 3) & 1, h = chain & 7;
        bf16_t* O = dir ? Ob : Of;
        float S00 = 0.f, S01 = 0.f, S10 = 0.f, S11 = 0.f;
        const int NTOK = CTX + SEQ;
        constexpr int U = 4;
        unsigned kq[U], qq[U], vv[U]; float gg[U], be[U]; int rows[U];
        auto rowof = [&](int s) -> int { if (s < CTX) { const int t = dir ? CTX - 1 - s : s; return ML + b * CTX + t; } const int t2 = s - CTX; const int t = dir ? SEQ - 1 - t2 : t2; return b * SEQ + t; };
#define SC_LOAD(i, s) do { const int row_ = rowof(s); rows[i] = row_; const bf16_t* p_ = QP + (size_t)row_ * 3072 + h * 128; \
        qq[i] = *(const unsigned*)(p_ + 2 * lane); kq[i] = *(const unsigned*)(p_ + 1024 + 2 * lane); vv[i] = *(const unsigned*)(p_ + 2048 + 2 * ep); \
        gg[i] = gb[((size_t)dir * MT + row_) * 8 + h]; be[i] = bb[((size_t)dir * MT + row_) * 8 + h]; } while (0)
        for (int s0 = 0; s0 < NTOK; s0 += U) {
#pragma unroll
            for (int i = 0; i < U; ++i) SC_LOAD(i, s0 + i);
#pragma unroll
            for (int i = 0; i < U; ++i) {
                const float k0 = bflo(kq[i]), k1 = bfhi(kq[i]), q0 = bflo(qq[i]), q1 = bfhi(qq[i]), v0 = bflo(vv[i]), v1 = bfhi(vv[i]);
                const float eg = __expf(gg[i]), bt = be[i];
                float p0 = k0 * S00 + k1 * S10, p1 = k0 * S01 + k1 * S11;
                p0 = wave_sum(p0); p1 = wave_sum(p1);
                const float vn0 = bt * (v0 - eg * p0), vn1 = bt * (v1 - eg * p1);
                S00 = eg * S00 + k0 * vn0; S01 = eg * S01 + k0 * vn1; S10 = eg * S10 + k1 * vn0; S11 = eg * S11 + k1 * vn1;
                float o0 = q0 * S00 + q1 * S10, o1 = q0 * S01 + q1 * S11;
                o0 = wave_sum(o0); o1 = wave_sum(o1);
                if (lane == 0 && rows[i] < ML) *(unsigned*)(O + (size_t)rows[i] * 1024 + h * 128 + 2 * ep) = pk2(o0, o1);
            }
        }
#undef SC_LOAD
    }
}

DEVI bf16x8 ld_b128(LAS const unsigned char* p) { return *(LAS const bf16x8*)p; }
DEVI bf16x8 ld_2b64(LAS const unsigned char* p0, LAS const unsigned char* p1) { const u32x2 a = *(LAS const u32x2*)p0, b = *(LAS const u32x2*)p1; u32x4 w = {a.x, a.y, b.x, b.y}; return __builtin_bit_cast(bf16x8, w); }
DEVI bf16x8 pack_frag(const f32x4& lo, const f32x4& hi) { u32x4 w = {pk2(lo[0], lo[1]), pk2(lo[2], lo[3]), pk2(hi[0], hi[1]), pk2(hi[2], hi[3])}; return __builtin_bit_cast(bf16x8, w); }
#define MFMA16(A, B, C) __builtin_amdgcn_mfma_f32_16x16x32_bf16(A, B, C, 0, 0, 0)
DEVI void phase_dnchunk(const KA& a, LAS unsigned char* lds, int tid, int lane, int wave) {
    unsigned char* ws = a.ws();
    const bf16_t* QP = (const bf16_t*)(ws + WS_QKVP); const float* gb = (const float*)(ws + WS_G); const float* bb = (const float*)(ws + WS_BETA);
    bf16_t* TQ = (bf16_t*)(ws + WS_TQ); float* AV = (float*)(ws + WS_AVEC);
    constexpr int KL = 0, QL = 17408, KKF = 34816, QKF = 52224, VEC = 131072;
    const int fr = lane & 15, g = lane >> 4, d = wave >> 2, wq = wave & 3;
    LAS unsigned char* dbase = lds + d * 64512;
    LAS float* Gg = (LAS float*)(lds + VEC); LAS float* Bv = Gg + 128; LAS float* GC = Gg + 256;
    for (int item = blockIdx.x; item < 520 * 8; item += gridDim.x) {
        const int cidx = item >> 3, h = item & 7;
        const int row0 = cidx < 512 ? cidx * 64 : ML + (cidx - 512) * 64;
#pragma unroll
        for (int i = 0; i < 2; ++i) { const int c = tid + i * 512, r = c >> 4, ch = c & 15;
            const bf16_t* src = QP + (size_t)(row0 + r) * 3072 + h * 128 + ch * 8;
            *(LAS u32x4*)(lds + QL + r * 272 + ch * 16) = *(const u32x4*)src; *(LAS u32x4*)(lds + KL + r * 272 + ch * 16) = *(const u32x4*)(src + 1024); }
        if (tid < 128) { const int dd = tid >> 6, pos = tid & 63; Gg[tid] = gb[((size_t)dd * MT + row0 + pos) * 8 + h]; Bv[tid] = bb[((size_t)dd * MT + row0 + pos) * 8 + h]; }
        __syncthreads();
        if (wave < 2) {
            const int dd = wave, pos = dd ? 63 - lane : lane; float x = Gg[dd * 64 + pos];
#pragma unroll
            for (int o = 1; o < 64; o <<= 1) { const float y = __shfl_up(x, o); if (lane >= o) x += y; }
            const float total = __shfl(x, 63);
            GC[dd * 64 + pos] = x;
            float* av = AV + ((size_t)item * 2 + dd) * 256;
            av[pos] = __expf(x); av[64 + pos] = Bv[dd * 64 + pos]; av[128 + pos] = __expf(total - x); if (lane == 0) av[192] = __expf(total);
        }
        {
            const int src = d ? QL : KL;
            f32x4 acc[4] = {{0.f, 0.f, 0.f, 0.f}, {0.f, 0.f, 0.f, 0.f}, {0.f, 0.f, 0.f, 0.f}, {0.f, 0.f, 0.f, 0.f}};
#pragma unroll
            for (int s4 = 0; s4 < 4; ++s4) { const bf16x8 A = ld_b128(lds + src + (16 * wq + fr) * 272 + (32 * s4 + 8 * g) * 2);
#pragma unroll
                for (int jt = 0; jt < 4; ++jt) { const bf16x8 Bf = ld_b128(lds + KL + (16 * jt + fr) * 272 + (32 * s4 + 8 * g) * 2); acc[jt] = MFMA16(A, Bf, acc[jt]); } }
            LAS float* dst = (LAS float*)(lds + (d ? QKF : KKF));
#pragma unroll
            for (int jt = 0; jt < 4; ++jt)
#pragma unroll
                for (int r = 0; r < 4; ++r) dst[(16 * wq + 4 * g + r) * 68 + 16 * jt + fr] = acc[jt][r];
        }
        __syncthreads();
        f32x4 P[4], qd[4];
        {
            const LAS float* kkf = (const LAS float*)(lds + KKF); const LAS float* qkf = (const LAS float*)(lds + QKF);
            float gci[4], bei[4];
#pragma unroll
            for (int r = 0; r < 4; ++r) { gci[r] = GC[d * 64 + 16 * wq + 4 * g + r]; bei[r] = Bv[d * 64 + 16 * wq + 4 * g + r]; }
#pragma unroll
            for (int jt = 0; jt < 4; ++jt) { const int j = 16 * jt + fr; const float gcj = GC[d * 64 + j];
#pragma unroll
                for (int r = 0; r < 4; ++r) { const int i = 16 * wq + 4 * g + r; const bool incl = d ? (i <= j) : (i >= j);
                    const float e = incl ? __expf(gci[r] - gcj) : 0.f;
                    qd[jt][r] = qkf[i * 68 + j] * e; P[jt][r] = (i != j) ? -bei[r] * kkf[i * 68 + j] * e : 0.f; } }
        }
        __syncthreads();
        {
#pragma unroll
            for (int jt = 0; jt < 4; ++jt) {
#pragma unroll
                for (int r = 0; r < 4; ++r) { const int i = 16 * wq + 4 * g + r, j = 16 * jt + fr;
                    *(LAS unsigned short*)(dbase + 0 + i * 144 + j * 2) = (unsigned short)f2bf(P[jt][r]);
                    *(LAS unsigned short*)(dbase + 36864 + 9216 + i * 144 + j * 2) = (unsigned short)f2bf(P[jt][r]);
                    *(LAS unsigned short*)(dbase + 55296 + i * 144 + j * 2) = (unsigned short)f2bf(qd[jt][r]); }
                u32x2 w = {pk2(P[jt][0], P[jt][1]), pk2(P[jt][2], P[jt][3])};
                *(LAS u32x2*)(dbase + 18432 + (16 * jt + fr) * 144 + (16 * wq + 4 * g) * 2) = w; }
        }
        __syncthreads();
        int cur = 0;
#pragma unroll 1
        for (int it = 0; it < 5; ++it) {
            LAS unsigned char* NRc = dbase + cur * 9216; LAS unsigned char* NTc = dbase + 18432 + cur * 9216;
            LAS unsigned char* NRn = dbase + (cur ^ 1) * 9216; LAS unsigned char* NTn = dbase + 18432 + (cur ^ 1) * 9216;
            LAS unsigned char* PRo = dbase + 36864 + ((it + 1) & 1) * 9216; LAS unsigned char* PRn = dbase + 36864 + (it & 1) * 9216;
            f32x4 n2[4] = {{0.f, 0.f, 0.f, 0.f}, {0.f, 0.f, 0.f, 0.f}, {0.f, 0.f, 0.f, 0.f}, {0.f, 0.f, 0.f, 0.f}};
#pragma unroll
            for (int s2 = 0; s2 < 2; ++s2) { const bf16x8 A = ld_b128(NRc + (16 * wq + fr) * 144 + (32 * s2 + 8 * g) * 2);
#pragma unroll
                for (int jt = 0; jt < 4; ++jt) { const bf16x8 Bf = ld_b128(NTc + (16 * jt + fr) * 144 + (32 * s2 + 8 * g) * 2); n2[jt] = MFMA16(A, Bf, n2[jt]); } }
#pragma unroll
            for (int jt = 0; jt < 4; ++jt) {
#pragma unroll
                for (int r = 0; r < 4; ++r) *(LAS unsigned short*)(NRn + (16 * wq + 4 * g + r) * 144 + (16 * jt + fr) * 2) = (unsigned short)f2bf(n2[jt][r]);
                u32x2 w = {pk2(n2[jt][0], n2[jt][1]), pk2(n2[jt][2], n2[jt][3])};
                *(LAS u32x2*)(NTn + (16 * jt + fr) * 144 + (16 * wq + 4 * g) * 2) = w;
                P[jt] += n2[jt]; }
            __syncthreads();
#pragma unroll
            for (int s2 = 0; s2 < 2; ++s2) { const bf16x8 A = ld_b128(PRo + (16 * wq + fr) * 144 + (32 * s2 + 8 * g) * 2);
#pragma unroll
                for (int jt = 0; jt < 4; ++jt) { const bf16x8 Bf = ld_b128(NTn + (16 * jt + fr) * 144 + (32 * s2 + 8 * g) * 2); P[jt] = MFMA16(A, Bf, P[jt]); } }
#pragma unroll
            for (int jt = 0; jt < 4; ++jt)
#pragma unroll
                for (int r = 0; r < 4; ++r) *(LAS unsigned short*)(PRn + (16 * wq + 4 * g + r) * 144 + (16 * jt + fr) * 2) = (unsigned short)f2bf(P[jt][r]);
            cur ^= 1;
        }
        __syncthreads();
        {
            bf16_t* dst = TQ + ((size_t)item * 2 + d) * 8192; const int t2 = tid & 255;
#pragma unroll
            for (int k = 0; k < 4; ++k) { const int c = t2 + 256 * k, mat = c >> 9, r = (c >> 3) & 63, ch = c & 7;
                const u32x4 v = *(LAS const u32x4*)(dbase + (mat ? 55296 : 36864) + r * 144 + ch * 16);
                *(u32x4*)(dst + mat * 4096 + r * 64 + ch * 8) = v; }
        }
        __syncthreads();
    }
}

DEVI void phase_dnchunk2(const KA& a, LAS unsigned char* lds, int tid, int lane, int wave) {
    unsigned char* ws = a.ws();
    const bf16_t* QP = (const bf16_t*)(ws + WS_QKVP); const float* gb = (const float*)(ws + WS_G); const float* bb = (const float*)(ws + WS_BETA);
    bf16_t* TQ = (bf16_t*)(ws + WS_TQ); float* AV = (float*)(ws + WS_AVEC);
    const int fr = lane & 15, g = lane >> 4, wi = wave >> 1, dir = wave & 1;
    LAS unsigned char* kl = lds + wi * 32768;
    LAS float* vec = (LAS float*)(lds + 131072 + wave * 1024);
    for (int grp = blockIdx.x; grp < 1040; grp += gridDim.x) {
        int tl = tid; asm volatile("" : "+v"(tl));
#pragma unroll
        for (int i = 0; i < 16; ++i) { const int c = tl + 512 * i, it = c >> 11, qk = (c >> 10) & 1, r = (c >> 4) & 63, ch = c & 15;
            const int item_ = grp * 4 + it, ci_ = item_ >> 3, h_ = item_ & 7; const int row0_ = ci_ < 512 ? ci_ * 64 : ML + (ci_ - 512) * 64;
            const u32x4 x = *(const u32x4*)(QP + (size_t)(row0_ + r) * 3072 + qk * 1024 + h_ * 128 + ch * 8);
            *(LAS u32x4*)(lds + it * 32768 + (qk ? 0 : 16384) + r * 256 + ((ch ^ (r & 15)) << 4)) = x; }
        const int item = grp * 4 + wi, cidx = item >> 3, h = item & 7;
        const int row0 = cidx < 512 ? cidx * 64 : ML + (cidx - 512) * 64;
        {
            const int pos = dir ? 63 - lane : lane;
            float x = gb[((size_t)dir * MT + row0 + pos) * 8 + h]; const float be = bb[((size_t)dir * MT + row0 + pos) * 8 + h];
#pragma unroll
            for (int o = 1; o < 64; o <<= 1) { const float y = __shfl_up(x, o); if (lane >= o) x += y; }
            const float total = __shfl(x, 63);
            vec[pos] = x; vec[64 + pos] = be;
            float* av = AV + ((size_t)item * 2 + dir) * 256;
            av[pos] = __expf(x); av[64 + pos] = be; av[128 + pos] = __expf(total - x); if (lane == 0) av[192] = __expf(total);
        }
        __syncthreads();
        bf16_t* tq = TQ + ((size_t)item * 2 + dir) * 8192;
        bf16x8 KF[4][4];
#pragma unroll
        for (int t = 0; t < 4; ++t)
#pragma unroll
            for (int ks = 0; ks < 4; ++ks) KF[t][ks] = ld_b128(kl + (16 * t + fr) * 256 + (((4 * ks + g) ^ fr) << 4));
        {
            bf16x8 QF[4][4];
#pragma unroll
            for (int t = 0; t < 4; ++t)
#pragma unroll
                for (int ks = 0; ks < 4; ++ks) QF[t][ks] = ld_b128(kl + 16384 + (16 * t + fr) * 256 + (((4 * ks + g) ^ fr) << 4));
#pragma unroll
            for (int rt = 0; rt < 4; ++rt)
#pragma unroll
                for (int ct = 0; ct < 4; ++ct) { f32x4 acc = {0.f, 0.f, 0.f, 0.f};
#pragma unroll
                    for (int ks = 0; ks < 4; ++ks) acc = MFMA16(KF[rt][ks], QF[ct][ks], acc);
                    float o[4]; const f32x4 gxv = *(const LAS f32x4*)(vec + 16 * rt + 4 * g); const float gyv = vec[16 * ct + fr];
#pragma unroll
                    for (int r = 0; r < 4; ++r) { const int x = 16 * rt + 4 * g + r, y = 16 * ct + fr; const bool inc = dir ? (y <= x) : (y >= x);
                        o[r] = inc ? acc[r] * __expf(gyv - gxv[r]) : 0.f; }
                    const u32x2 w = {pk2(o[0], o[1]), pk2(o[2], o[3])};
                    *(u32x2*)(tq + 4096 + (16 * ct + fr) * 64 + 16 * rt + 4 * g) = w; }
        }
        f32x4 PT[4][4]; bf16x8 XD[2][4], XT[2][4];
#pragma unroll
        for (int ct = 0; ct < 4; ++ct)
#pragma unroll
            for (int s2 = 0; s2 < 2; ++s2) { f32x4 nd[2], nt[2];
#pragma unroll
                for (int u = 0; u < 2; ++u) { const int rt = 2 * s2 + u; f32x4 acc = {0.f, 0.f, 0.f, 0.f};
#pragma unroll
                    for (int ks = 0; ks < 4; ++ks) acc = MFMA16(KF[rt][ks], KF[ct][ks], acc);
                    const f32x4 gxv = *(const LAS f32x4*)(vec + 16 * rt + 4 * g), bxv = *(const LAS f32x4*)(vec + 64 + 16 * rt + 4 * g); const float gyv = vec[16 * ct + fr], byv = vec[64 + 16 * ct + fr];
#pragma unroll
                    for (int r = 0; r < 4; ++r) { const int x = 16 * rt + 4 * g + r, y = 16 * ct + fr;
                        const bool cd = dir ? (x < y) : (x > y), ct_ = dir ? (y < x) : (y > x);
                        nd[u][r] = cd ? -bxv[r] * acc[r] * __expf(gxv[r] - gyv) : 0.f;
                        nt[u][r] = ct_ ? -byv * acc[r] * __expf(gyv - gxv[r]) : 0.f; }
                    PT[rt][ct] = nt[u]; }
                XD[s2][ct] = pack_frag(nd[0], nd[1]); XT[s2][ct] = pack_frag(nt[0], nt[1]); }
#pragma unroll 1
        for (int it = 0; it < 5; ++it) {
            bf16x8 XD2[2][4], XT2[2][4];
#pragma unroll
            for (int ct = 0; ct < 4; ++ct)
#pragma unroll
                for (int s2 = 0; s2 < 2; ++s2) { f32x4 t2[2];
#pragma unroll
                    for (int u = 0; u < 2; ++u) { const int rt = 2 * s2 + u; f32x4 acc = {0.f, 0.f, 0.f, 0.f};
                        acc = MFMA16(XT[0][rt], XD[0][ct], acc); acc = MFMA16(XT[1][rt], XD[1][ct], acc); t2[u] = acc; }
                    XD2[s2][ct] = pack_frag(t2[0], t2[1]); }
#pragma unroll
            for (int ct = 0; ct < 4; ++ct) { const bf16x8 pb0 = pack_frag(PT[0][ct], PT[1][ct]), pb1 = pack_frag(PT[2][ct], PT[3][ct]);
#pragma unroll
                for (int rt = 0; rt < 4; ++rt) { f32x4 acc = PT[rt][ct]; acc = MFMA16(XD2[0][rt], pb0, acc); acc = MFMA16(XD2[1][rt], pb1, acc); PT[rt][ct] = acc; } }
#pragma unroll
            for (int ct = 0; ct < 4; ++ct)
#pragma unroll
                for (int s2 = 0; s2 < 2; ++s2) { f32x4 t2[2];
#pragma unroll
                    for (int u = 0; u < 2; ++u) { const int rt = 2 * s2 + u; f32x4 acc = {0.f, 0.f, 0.f, 0.f};
                        acc = MFMA16(XD[0][rt], XT[0][ct], acc); acc = MFMA16(XD[1][rt], XT[1][ct], acc); t2[u] = acc; PT[rt][ct] += acc; }
                    XT2[s2][ct] = pack_frag(t2[0], t2[1]); }
#pragma unroll
            for (int s2 = 0; s2 < 2; ++s2)
#pragma unroll
                for (int ct = 0; ct < 4; ++ct) { XD[s2][ct] = XD2[s2][ct]; XT[s2][ct] = XT2[s2][ct]; }
        }
#pragma unroll
        for (int rt = 0; rt < 4; ++rt)
#pragma unroll
            for (int ct = 0; ct < 4; ++ct) { const u32x2 w = {pk2(PT[rt][ct][0], PT[rt][ct][1]), pk2(PT[rt][ct][2], PT[rt][ct][3])};
                *(u32x2*)(tq + (16 * ct + fr) * 64 + 16 * rt + 4 * g) = w; }
        __syncthreads();
    }
}

DEVI void phase_dnscan2(const KA& a, LAS unsigned char* lds, int tid, int lane, int wave, unsigned long long& pr_extra) {
    const int v = blockIdx.x;
    unsigned char* ws = a.ws();
    const bf16_t* QP = (const bf16_t*)(ws + WS_QKVP); const bf16_t* TQ = (const bf16_t*)(ws + WS_TQ); const float* AV = (const float*)(ws + WS_AVEC);
    unsigned* prog = (unsigned*)(ws + CTL_PROG);
    constexpr int NSTEP = 260;
    int vrole = v;
#if MK_ONE_LAUNCH
    {
        unsigned* bar_ = (unsigned*)(ws + WS_CTL); unsigned* xr_ = (unsigned*)(ws + CTL_XRANK);
        bool dyn = gridDim.x == 256;
#pragma unroll
        for (int j = 0; j < 16; ++j) { const unsigned c_ = __hip_atomic_load(&bar_[256 + 64 * j], __ATOMIC_RELAXED, __HIP_MEMORY_SCOPE_AGENT); dyn = dyn && (c_ == (j < 8 ? 32u : 0u)); }
        if (PROBE_SUB == 7 && !dyn) pr_extra += 50000ull;
        if (dyn) {
            const unsigned xcc = (unsigned)__builtin_amdgcn_s_getreg((3 << 11) | 20) & 0xFu;
            LAS unsigned* bw = (LAS unsigned*)(lds + 147200);
            if (tid == 0) *bw = __hip_atomic_fetch_add(&xr_[xcc * 64], 1u, __ATOMIC_RELAXED, __HIP_MEMORY_SCOPE_AGENT);
            __syncthreads();
            const unsigned rank = *bw & 31u;
            vrole = rank < 16u ? (int)(xcc + 8u * (rank >> 2) + 32u * (rank & 3u)) : (int)(128u + xcc + 8u * ((rank - 16u) >> 2) + 32u * ((rank - 16u) & 3u));
            __syncthreads();
        }
    }
#endif
    if (vrole < 128) {
    const int chain = (vrole & 7) + 8 * ((vrole >> 3) & 3), qt = vrole >> 5, dir = chain >> 4, b = (chain >> 3) & 1, h = chain & 7;
    bf16_t* O = (bf16_t*)a.out() + (size_t)dir * ML * 1024;
    constexpr int KL = 0, QL = 16384, TL = 32768, DL = 40960, VL = 49152, AL = 53248, BUFB = 54272, OT = 2 * BUFB, SBX = OT + 8192, XBX = SBX + 16384, FLG = XBX + 4096;
    const int fr0 = lane & 15, g0 = lane >> 4, ltid = tid - 256;
    auto step_cidx = [&](int s) -> int { if (s < 4) return 512 + b * 4 + (dir ? 3 - s : s); const int c = s - 4; return b * 256 + (dir ? 255 - c : c); };
    struct LSet { u32x4 q[4], k[4], t[2], d[2], v, av; };
#define LD_ISSUE(R, s_) do { const int cidx_ = step_cidx(s_); const int row0_ = cidx_ < 512 ? cidx_ * 64 : ML + (cidx_ - 512) * 64; \
        const bf16_t* tqb_ = TQ + ((size_t)(cidx_ * 8 + h) * 2 + dir) * 8192; const float* avb_ = AV + ((size_t)(cidx_ * 8 + h) * 2 + dir) * 256; \
        int lt_ = ltid; asm volatile("" : "+v"(lt_)); \
        const bf16_t* pq_ = QP + (size_t)(row0_ + (lt_ >> 4)) * 3072 + h * 128 + (lt_ & 15) * 8; \
        const bf16_t* pt_ = tqb_ + (lt_ >> 3) * 64 + (lt_ & 7) * 8; \
        _Pragma("unroll") for (int i = 0; i < 4; ++i) { R.q[i] = *(const u32x4*)(pq_ + (size_t)i * 16 * 3072); R.k[i] = *(const u32x4*)(pq_ + (size_t)i * 16 * 3072 + 1024); } \
        _Pragma("unroll") for (int i = 0; i < 2; ++i) { R.t[i] = *(const u32x4*)(pt_ + i * 32 * 64); R.d[i] = *(const u32x4*)(pt_ + 4096 + i * 32 * 64); } \
        R.v = *(const u32x4*)(QP + (size_t)(row0_ + (lt_ >> 2)) * 3072 + 2048 + h * 128 + qt * 32 + (lt_ & 3) * 8); \
        R.av = *(const u32x4*)(avb_ + (lt_ & 63) * 4); } while (0)
#define LD_WRITE(R, bo_) do { int lt_ = ltid; asm volatile("" : "+v"(lt_)); LAS unsigned char* B_ = lds + (bo_); \
        const int chq_ = lt_ & 15, cht_ = lt_ & 7; \
        _Pragma("unroll") for (int i = 0; i < 4; ++i) { const int r = (lt_ >> 4) + 16 * i; const int o_ = r * 256 + ((chq_ ^ (4 * (r & 3) + ((r >> 3) & 3))) << 4); \
            *(LAS u32x4*)(B_ + QL + o_) = R.q[i]; *(LAS u32x4*)(B_ + KL + o_) = R.k[i]; } \
        _Pragma("unroll") for (int i = 0; i < 2; ++i) { const int r = (lt_ >> 3) + 32 * i; const int o_ = r * 128 + ((cht_ ^ (2 * ((r >> 3) & 3) + ((r >> 1) & 1))) << 4); \
            *(LAS u32x4*)(B_ + TL + o_) = R.t[i]; *(LAS u32x4*)(B_ + DL + o_) = R.d[i]; } \
        { const int r = lt_ >> 2; *(LAS u32x4*)(B_ + VL + r * 64 + (((lt_ & 3) ^ (2 * ((r >> 3) & 1))) << 4)) = R.v; } \
        if (lt_ < 64) *(LAS u32x4*)(B_ + AL + lt_ * 16) = R.av; } while (0)
#define OT_OUT(s_) do { const int cidx_ = step_cidx(s_); const int row0_ = cidx_ * 64; LAS const unsigned char* ot_ = lds + OT + ((s_) & 1) * 4096; \
        int lt_ = ltid; asm volatile("" : "+v"(lt_)); \
        { const int r = lt_ >> 2, ch = lt_ & 3; \
            *(u32x4*)(O + (size_t)(row0_ + r) * 1024 + h * 128 + qt * 32 + ch * 8) = *(LAS const u32x4*)(ot_ + r * 64 + ((ch ^ (2 * ((r >> 3) & 1))) << 4)); } } while (0)
#define STEP_BAR(wsel) do { const unsigned long long tb_ = PROBE_SUB ? __builtin_amdgcn_s_memrealtime() : 0ull; \
        asm volatile("s_waitcnt lgkmcnt(0)" ::: "memory"); __builtin_amdgcn_s_barrier(); asm volatile("" ::: "memory"); \
        if ((PROBE_SUB == 1 && wave == 0 && (wsel) == 0) || (PROBE_SUB == 2 && wave == 4 && (wsel) == 1) || (PROBE_SUB == 3 && wave == 2 && (wsel) == 3)) pr_extra += __builtin_amdgcn_s_memrealtime() - tb_; } while (0)
#define LOAD_STEP(s, RW) do { STEP_BAR(1); \
            if (qt == 0 && ltid == 0) __hip_atomic_store(prog + chain * 64, (unsigned)((s) + 1), __ATOMIC_RELAXED, __HIP_MEMORY_SCOPE_AGENT); \
            { const unsigned long long tw_ = (PROBE_SUB == 5) ? __builtin_amdgcn_s_memrealtime() : 0ull; if ((s) + 1 < NSTEP) LD_WRITE(RW, (((s) + 1) & 1) * BUFB); \
              if (PROBE_SUB == 5 && wave == 4) { asm volatile("s_waitcnt lgkmcnt(0)" ::: "memory"); pr_extra += __builtin_amdgcn_s_memrealtime() - tw_; } } \
            if ((s) + 4 < NSTEP) LD_ISSUE(RW, (s) + 4); \
            if ((s) >= 5) OT_OUT((s) - 1); } while (0)
#define SBAR_() do {} while (0)
#define ROWK(pt) ((32 * ((pt) >> 1) + 4 * ((pt) & 1) + rowl) * 256)
#define ROWT(pt) ((32 * ((pt) >> 1) + 4 * ((pt) & 1) + rowl) * 128)
#define P0(pt) (32 * ((pt) >> 1) + 8 * g + 4 * ((pt) & 1))
#define LDK8(dst, base, pa) do { _Pragma("unroll") for (int s4 = 0; s4 < 4; ++s4) { dst[s4] = ld_b128(B + (base) + ROWK(pa) + (((4 * s4 + g) ^ fk) << 4)); dst[4 + s4] = ld_b128(B + (base) + ROWK((pa) + 1) + (((4 * s4 + g) ^ fk) << 4)); } } while (0)
#define LDT8(dst, base) do { _Pragma("unroll") for (int pt = 0; pt < 4; ++pt) { dst[2 * pt] = ld_b128(B + (base) + ROWT(pt) + ((g ^ ft) << 4)); dst[2 * pt + 1] = ld_b128(B + (base) + ROWT(pt) + (((4 + g) ^ ft) << 4)); } } while (0)
#define MM8(acc, fa, pa) do { _Pragma("unroll") for (int s4 = 0; s4 < 4; ++s4) { acc[pa] = MFMA16(fa[s4], Sb[s4], acc[pa]); acc[(pa) + 1] = MFMA16(fa[4 + s4], Sb[s4], acc[(pa) + 1]); } } while (0)
    if (wave >= 4) {
        LSet R0, R1, R2;
        LD_ISSUE(R0, 0); LD_WRITE(R0, 0); LD_ISSUE(R1, 1); LD_ISSUE(R2, 2); LD_ISSUE(R0, 3);
#pragma unroll 1
        for (int s0 = 0; s0 < NSTEP; s0 += 3) {
            LOAD_STEP(s0, R1);
            if (s0 + 1 < NSTEP) LOAD_STEP(s0 + 1, R2);
            if (s0 + 2 < NSTEP) LOAD_STEP(s0 + 2, R0);
        }
        STEP_BAR(2);
        OT_OUT(NSTEP - 1);
    } else if (wave < 2) {
        f32x4 S[8];
#pragma unroll
        for (int i = 0; i < 8; ++i) S[i] = (f32x4){0.f, 0.f, 0.f, 0.f};
        bf16x8 Sb[4];
#pragma unroll
        for (int s4 = 0; s4 < 4; ++s4) { Sb[s4] = (bf16x8){0, 0, 0, 0, 0, 0, 0, 0}; *(LAS bf16x8*)(lds + SBX + wave * 4096 + s4 * 1024 + lane * 16) = Sb[s4]; }
        if (lane == 0) *(LAS unsigned*)(lds + FLG + wave * 4) = 0u;
#pragma unroll 1
        for (int s = 0; s < NSTEP; ++s) {
            STEP_BAR(0);
            int fr = fr0, g = g0; asm volatile("" : "+v"(fr), "+v"(g));
            LAS const unsigned char* B = lds + (s & 1) * BUFB;
            const LAS float* avl = (const LAS float*)(B + AL);
            const int rowl = 8 * (fr >> 2) + (fr & 3);
            const int fk = 4 * (fr & 3) + (fr >> 2), ft = 2 * (fr >> 2) + ((fr >> 1) & 1);
            const int vcol = ((((2 * wave + (fr >> 3)) ^ (2 * (g & 1))) << 4) + (fr & 7) * 2);
            const int trq = fr >> 2, trp = fr & 3;
            LAS unsigned char* kp0 = (LAS unsigned char*)(B + KL + (8 * g + trq) * 256);
            const int fkt = 4 * trq + g;
#define KT_LOAD(dst, d0) do { _Pragma("unroll") for (int j = 0; j < 4; ++j) { const int dt_ = (d0) + j; const int co = (((4 * (dt_ >> 1) + trp) ^ fkt) << 4) + 8 * (dt_ & 1); \
                const s16x4 a0 = __builtin_bit_cast(s16x4, __builtin_amdgcn_ds_read_tr16_b64_v4i16((LAS s16x4*)(kp0 + co))), a1 = __builtin_bit_cast(s16x4, __builtin_amdgcn_ds_read_tr16_b64_v4i16((LAS s16x4*)(kp0 + co + 4 * 256))); \
                const s16x4 a2 = __builtin_bit_cast(s16x4, __builtin_amdgcn_ds_read_tr16_b64_v4i16((LAS s16x4*)(kp0 + co + 32 * 256))), a3 = __builtin_bit_cast(s16x4, __builtin_amdgcn_ds_read_tr16_b64_v4i16((LAS s16x4*)(kp0 + co + 36 * 256))); \
                dst[2 * j] = (bf16x8){a0[0], a0[1], a0[2], a0[3], a1[0], a1[1], a1[2], a1[3]}; dst[2 * j + 1] = (bf16x8){a2[0], a2[1], a2[2], a2[3], a3[0], a3[1], a3[2], a3[3]}; } } while (0)
            bf16x8 fA[8], fB[8], fC[8];
            f32x4 avp[4], bvp[4]; unsigned short vraw[4][4];
            const unsigned long long t6_ = (PROBE_SUB == 6) ? __builtin_amdgcn_s_memrealtime() : 0ull;
            LDK8(fA, KL, 0); LDK8(fB, KL, 2);
            if (PROBE_SUB == 6 && wave == 0) { asm volatile("s_waitcnt lgkmcnt(0)" ::: "memory"); pr_extra += __builtin_amdgcn_s_memrealtime() - t6_; }
#pragma unroll
            for (int pt = 0; pt < 4; ++pt) { avp[pt] = *(const LAS f32x4*)(avl + P0(pt)); bvp[pt] = *(const LAS f32x4*)(avl + 64 + P0(pt));
#pragma unroll
                for (int r = 0; r < 4; ++r) vraw[pt][r] = *(const LAS unsigned short*)(B + VL + (P0(pt) + r) * 64 + vcol); }
            f32x4 Z[4], X[4];
#pragma unroll
            for (int pt = 0; pt < 4; ++pt) Z[pt] = (f32x4){0.f, 0.f, 0.f, 0.f};
            SBAR_();
            LDT8(fC, TL); SBAR_(); MM8(Z, fA, 0); SBAR_();
            KT_LOAD(fA, 0); SBAR_(); MM8(Z, fB, 2); SBAR_();
#pragma unroll
            for (int pt = 0; pt < 4; ++pt)
#pragma unroll
                for (int r = 0; r < 4; ++r) Z[pt][r] = bvp[pt][r] * (bf2f(vraw[pt][r]) - avp[pt][r] * Z[pt][r]);
            KT_LOAD(fB, 4); SBAR_();
            { const bf16x8 Zb0 = pack_frag(Z[0], Z[1]), Zb1 = pack_frag(Z[2], Z[3]);
#pragma unroll
              for (int pt = 0; pt < 4; ++pt) { X[pt] = MFMA16(fC[2 * pt], Zb0, Z[pt]); X[pt] = MFMA16(fC[2 * pt + 1], Zb1, X[pt]); } }
            SBAR_();
            const float egl = avl[192];
            bf16x8 Xc0, Xc1;
            { const bf16x8 Xb0 = pack_frag(X[0], X[1]), Xb1 = pack_frag(X[2], X[3]);
              *(LAS bf16x8*)(lds + XBX + wave * 2048 + lane * 16) = Xb0; *(LAS bf16x8*)(lds + XBX + wave * 2048 + 1024 + lane * 16) = Xb1;
              if (lane == 0) *(LAS volatile unsigned*)(lds + FLG + wave * 4) = (unsigned)(s + 1);
              f32x4 cx[4];
#pragma unroll
              for (int pt = 0; pt < 4; ++pt) cx[pt] = X[pt] * *(const LAS f32x4*)(avl + 128 + P0(pt));
              Xc0 = pack_frag(cx[0], cx[1]); Xc1 = pack_frag(cx[2], cx[3]); }
            SBAR_();
#pragma unroll
            for (int j = 0; j < 4; ++j) { f32x4 sn = S[j] * egl; sn = MFMA16(fA[2 * j], Xc0, sn); S[j] = MFMA16(fA[2 * j + 1], Xc1, sn); }
            SBAR_();
#pragma unroll
            for (int j = 0; j < 4; ++j) { f32x4 sn = S[4 + j] * egl; sn = MFMA16(fB[2 * j], Xc0, sn); S[4 + j] = MFMA16(fB[2 * j + 1], Xc1, sn); }
#pragma unroll
            for (int s4 = 0; s4 < 4; ++s4) { Sb[s4] = pack_frag(S[2 * s4], S[2 * s4 + 1]); *(LAS bf16x8*)(lds + SBX + ((s + 1) & 1) * 8192 + wave * 4096 + s4 * 1024 + lane * 16) = Sb[s4]; }
#undef KT_LOAD
        }
        STEP_BAR(2);
    } else {
        const int sl = wave - 2;
#pragma unroll 1
        for (int s = 0; s < NSTEP; ++s) {
            STEP_BAR(3);
            if (s >= 4) {
            int fr = fr0, g = g0; asm volatile("" : "+v"(fr), "+v"(g));
            LAS const unsigned char* B = lds + (s & 1) * BUFB;
            const LAS float* avl = (const LAS float*)(B + AL);
            const int rowl = 8 * (fr >> 2) + (fr & 3);
            const int fk = 4 * (fr & 3) + (fr >> 2), ft = 2 * (fr >> 2) + ((fr >> 1) & 1);
            const int vcol = ((((2 * sl + (fr >> 3)) ^ (2 * (g & 1))) << 4) + (fr & 7) * 2);
            bf16x8 fA[8], fB[8], fC[8], Sb[4];
            LDK8(fA, QL, 0); LDK8(fB, QL, 2);
#pragma unroll
            for (int s4 = 0; s4 < 4; ++s4) Sb[s4] = *(const LAS bf16x8*)(lds + SBX + (s & 1) * 8192 + sl * 4096 + s4 * 1024 + lane * 16);
            f32x4 OQ[4], avp[4];
#pragma unroll
            for (int pt = 0; pt < 4; ++pt) { OQ[pt] = (f32x4){0.f, 0.f, 0.f, 0.f}; avp[pt] = *(const LAS f32x4*)(avl + P0(pt)); }
            SBAR_();
            LDT8(fC, DL); SBAR_(); MM8(OQ, fA, 0); SBAR_(); MM8(OQ, fB, 2); SBAR_();
            { unsigned spins = 0;
              while ((unsigned)__builtin_amdgcn_readfirstlane((int)*(LAS volatile unsigned*)(lds + FLG + sl * 4)) != (unsigned)(s + 1)) { __builtin_amdgcn_s_sleep(1); if (++spins > (1u << 22)) break; } }
            asm volatile("" ::: "memory");
            const bf16x8 Xb0 = *(const LAS bf16x8*)(lds + XBX + sl * 2048 + lane * 16), Xb1 = *(const LAS bf16x8*)(lds + XBX + sl * 2048 + 1024 + lane * 16);
#pragma unroll
            for (int pt = 0; pt < 4; ++pt) { f32x4 o2 = OQ[pt] * avp[pt]; o2 = MFMA16(fC[2 * pt], Xb0, o2); OQ[pt] = MFMA16(fC[2 * pt + 1], Xb1, o2); }
            { LAS unsigned char* ot = lds + OT + (s & 1) * 4096;
#pragma unroll
              for (int pt = 0; pt < 4; ++pt)
#pragma unroll
                  for (int r = 0; r < 4; ++r) *(LAS unsigned short*)(ot + (P0(pt) + r) * 64 + vcol) = (unsigned short)f2bf(OQ[pt][r]); }
            }
        }
        STEP_BAR(2);
    }
#undef LDK8
#undef LDT8
#undef MM8
#undef ROWK
#undef ROWT
#undef P0
#undef SBAR_
#undef LOAD_STEP
#undef STEP_BAR
#undef LD_ISSUE
#undef LD_WRITE
#undef OT_OUT
    } else {
        const int vp = vrole - 128, chain = (vp & 7) + 8 * ((vp >> 3) & 3), role = vp >> 5, dir = chain >> 4, b = (chain >> 3) & 1, h = chain & 7;
        const int nteam = (((int)gridDim.x - 128) >> 5) * 8;
        constexpr int PFD2 = 6;
        if (role * 8 + wave < nteam) {
#pragma unroll 1
        for (int st = role * 8 + wave; st < NSTEP; st += nteam) {
            unsigned spins = 0;
            while ((int)__builtin_amdgcn_readfirstlane((int)__hip_atomic_load(prog + chain * 64, __ATOMIC_RELAXED, __HIP_MEMORY_SCOPE_AGENT)) + PFD2 < st) { __builtin_amdgcn_s_sleep(8); if (++spins > (1u << 20)) break; }
            int cidx; if (st < 4) cidx = 512 + b * 4 + (dir ? 3 - st : st); else { const int c = st - 4; cidx = b * 256 + (dir ? 255 - c : c); }
            const int row0 = cidx < 512 ? cidx * 64 : ML + (cidx - 512) * 64;
            const char* tqb = (const char*)(TQ + ((size_t)(cidx * 8 + h) * 2 + dir) * 8192); const char* avb = (const char*)(AV + ((size_t)(cidx * 8 + h) * 2 + dir) * 256);
            unsigned acc = 0;
#pragma unroll
            for (int j = 0; j < 9; ++j) { const int L = j * 64 + lane; const char* p_;
                if (L < 384) { const int rw = L / 6, part = L - rw * 6; p_ = (const char*)(QP + (size_t)(row0 + rw) * 3072 + h * 128) + (part >> 1) * 2048 + (part & 1) * 128; }
                else if (L < 512) p_ = tqb + (L - 384) * 128; else p_ = avb + ((L - 512) & 7) * 128;
                acc ^= *(const unsigned*)p_; }
            asm volatile("" :: "v"(acc));
        }
        }
    }
}

DEVI void phase_prep2(const KA& a, int lane, int wave) {
    unsigned char* ws = a.ws();
    bf16_t* KAT = (bf16_t*)(ws + WS_KAT); const float* rope = (const float*)(ws + SM_ROPE); const float* knw = a.in(14);
    const int gw = blockIdx.x * 8 + wave, NGW = gridDim.x * 8;
    for (int row = gw; row < MT; row += NGW) {
        bf16_t* p = (row < ML ? KAT + (size_t)row * 256 : (bf16_t*)(ws + WS_CTXK) + (size_t)(row - ML) * 256) + lane * 4;
        const u32x2 w = *(const u32x2*)p;
        float x[4] = {bflo(w.x), bfhi(w.x), bflo(w.y), bfhi(w.y)};
        float ss = (x[0] * x[0] + x[1] * x[1]) + (x[2] * x[2] + x[3] * x[3]);
        ss += __shfl_xor(ss, 1); ss += __shfl_xor(ss, 2); ss += __shfl_xor(ss, 4); ss += __shfl_xor(ss, 8); ss += __shfl_xor(ss, 16);
        const float rs = rsqrtf(ss * (1.f / 128.f) + EPS);
        const int d = (lane & 31) * 4;
        const f32x4 nw = *(const f32x4*)(knw + d);
#pragma unroll
        for (int i = 0; i < 4; ++i) x[i] = x[i] * rs * nw[i];
        float pr[4];
#pragma unroll
        for (int i = 0; i < 4; ++i) pr[i] = __shfl_xor(x[i], 8);
        if (row < ML) {
            const int t = row & (SEQ - 1), lg = (lane & 31) >> 3, fi = (lane & 7) * 4;
            const float* ct = lg < 2 ? rope + (t >> 6) * 32 + fi : rope + 16384 + (t & 63) * 32 + fi;
            const float* st = lg < 2 ? ct + 8192 : ct + 2048;
            const f32x4 c = *(const f32x4*)ct, s = *(const f32x4*)st;
            const float sg = (lg & 1) ? 1.f : -1.f;
#pragma unroll
            for (int i = 0; i < 4; ++i) x[i] = x[i] * c[i] + sg * pr[i] * s[i];
        }
        u32x2 o; o.x = pk2(x[0], x[1]); o.y = pk2(x[2], x[3]);
        *(u32x2*)p = o;
    }
    const bf16_t* Of = (const bf16_t*)a.out(); const bf16_t* Ob = Of + (size_t)ML * 1024;
    const bf16_t* GT = (const bf16_t*)(ws + WS_GT); bf16_t* Y = (bf16_t*)(ws + WS_Y); const float* dnw = a.in(12);
    for (int row = gw; row < ML; row += NGW) {
        const int c0 = lane * 16;
        float o[16];
#pragma unroll
        for (int hh = 0; hh < 2; ++hh) {
            const u32x4 f = *(const u32x4*)(Of + (size_t)row * 1024 + c0 + hh * 8), bk = *(const u32x4*)(Ob + (size_t)row * 1024 + c0 + hh * 8);
#pragma unroll
            for (int i = 0; i < 4; ++i) { o[hh * 8 + 2 * i] = bflo(f[i]) + bflo(bk[i]); o[hh * 8 + 2 * i + 1] = bfhi(f[i]) + bfhi(bk[i]); }
        }
        float ss = 0.f;
#pragma unroll
        for (int i = 0; i < 16; ++i) ss += o[i] * o[i];
        ss += __shfl_xor(ss, 1); ss += __shfl_xor(ss, 2); ss += __shfl_xor(ss, 4);
        const float rs = rsqrtf(ss * (1.f / 128.f) + EPS);
        const int d0 = c0 & 127;
#pragma unroll
        for (int hh = 0; hh < 2; ++hh) {
            const u32x4 gt = *(const u32x4*)(GT + (size_t)row * 1024 + c0 + hh * 8);
            float y[8];
#pragma unroll
            for (int i = 0; i < 4; ++i) {
                y[2 * i] = o[hh * 8 + 2 * i] * rs * dnw[d0 + hh * 8 + 2 * i] * siluf(bflo(gt[i]));
                y[2 * i + 1] = o[hh * 8 + 2 * i + 1] * rs * dnw[d0 + hh * 8 + 2 * i + 1] * siluf(bfhi(gt[i]));
            }
            u32x4 w; w.x = pk2(y[0], y[1]); w.y = pk2(y[2], y[3]); w.z = pk2(y[4], y[5]); w.w = pk2(y[6], y[7]);
            *(u32x4*)(Y + (size_t)row * 2048 + c0 + hh * 8) = w;
        }
    }
}

namespace att {
constexpr int D = 128, NW = 8, QBLK = 32, KVBLK = 64;
constexpr float SCALE = 0.088388347648318440f;
constexpr float THR = 8.f;
constexpr int LDK = 256;
constexpr size_t SHM_V = KVBLK * D * 2, SHM_K = KVBLK * D * 2;
constexpr size_t OFF_WS = 2 * SHM_V + 2 * SHM_K, OFF_OST = OFF_WS + NW * 64 * 4;
#define KSWZ(row, colB) ((row) * 256 + ((colB) ^ (((row) & 7) << 4)))
#define SBAR() __builtin_amdgcn_sched_barrier(0)
DEVI int crow(int r, int hi) { return (r & 3) + 8 * (r >> 2) + 4 * hi; }
DEVI unsigned cvtpk(float lo, float hi) { unsigned r; asm volatile("v_cvt_pk_bf16_f32 %0, %1, %2" : "=v"(r) : "v"(lo), "v"(hi)); return r; }
DEVI void partialSM(f32x16& p0, f32x16& p1, float& m_reg, float& mn, float& alpha) {
    constexpr float C = SCALE * 1.4426950408889634f;
    float pmax = p0[0];
#pragma unroll
    for (int r = 1; r < 16; ++r) pmax = fmaxf(pmax, p0[r]);
#pragma unroll
    for (int r = 0; r < 16; ++r) pmax = fmaxf(pmax, p1[r]);
    { auto rr = __builtin_amdgcn_permlane32_swap(__float_as_uint(pmax), __float_as_uint(pmax), false, false);
      pmax = fmaxf(__uint_as_float(rr[0]), __uint_as_float(rr[1])); }
    if (__builtin_expect(__all(pmax - m_reg <= THR / SCALE), 1)) { mn = m_reg; alpha = 1.f; }
    else { mn = fmaxf(m_reg, pmax); alpha = __builtin_amdgcn_exp2f((m_reg - mn) * C); m_reg = mn; }
    const float mnC = -mn * C;
#pragma unroll
    for (int r = 0; r < 16; ++r) p0[r] = fmaf(p0[r], C, mnC);
#pragma unroll
    for (int r = 0; r < 16; ++r) p1[r] = fmaf(p1[r], C, mnC);
#pragma unroll
    for (int r = 0; r < 16; ++r) p0[r] = __builtin_amdgcn_exp2f(p0[r]);
}
DEVI void finishSM(f32x16& p0, f32x16& p1, float alpha, float& l_reg, bf16x8& pa0, bf16x8& pa1, bf16x8& pa2, bf16x8& pa3) {
#pragma unroll
    for (int r = 0; r < 16; ++r) p1[r] = __builtin_amdgcn_exp2f(p1[r]);
    float ps = 0;
#pragma unroll
    for (int r = 0; r < 16; ++r) ps += p0[r];
#pragma unroll
    for (int r = 0; r < 16; ++r) ps += p1[r];
    { auto rr = __builtin_amdgcn_permlane32_swap(__float_as_uint(ps), __float_as_uint(ps), false, false);
      ps = __uint_as_float(rr[0]) + __uint_as_float(rr[1]); }
    l_reg = l_reg * alpha + ps;
#define PK4(P, BASE, OUT) do { unsigned a0 = cvtpk(P[BASE + 0], P[BASE + 1]), a1 = cvtpk(P[BASE + 2], P[BASE + 3]);   \
    unsigned b0 = cvtpk(P[BASE + 4], P[BASE + 5]), b1 = cvtpk(P[BASE + 6], P[BASE + 7]);                              \
    auto r0 = __builtin_amdgcn_permlane32_swap(a0, b0, false, false); auto r1 = __builtin_amdgcn_permlane32_swap(a1, b1, false, false); \
    u32x4 w = {r0[0], r1[0], r0[1], r1[1]}; OUT = *reinterpret_cast<bf16x8*>(&w); } while (0)
    PK4(p0, 0, pa0); PK4(p0, 8, pa1); PK4(p1, 0, pa2); PK4(p1, 8, pa3);
#undef PK4
}
DEVI void qkt(f32x16& p0, f32x16& p1, const char* Ks, const bf16x8* qr, int r32, int hi) {
    p0 = f32x16{}; p1 = f32x16{};
#pragma unroll
    for (int d0 = 0; d0 < 8; ++d0) { const int cb = (d0 * 16 + hi * 8) * 2;
        const bf16x8 b0 = *reinterpret_cast<const bf16x8*>(Ks + KSWZ(r32, cb));
        const bf16x8 b1 = *reinterpret_cast<const bf16x8*>(Ks + KSWZ(32 + r32, cb));
        p0 = __builtin_amdgcn_mfma_f32_32x32x16_bf16(b0, qr[d0], p0, 0, 0, 0);
        p1 = __builtin_amdgcn_mfma_f32_32x32x16_bf16(b1, qr[d0], p1, 0, 0, 0); }
}
DEVI int v_st(int k, int c) { const int kk = (k & ~0xC) | ((k & 4) << 1) | ((k & 8) >> 1); return ((kk >> 3) * 4 + (c >> 5)) * 512 + ((kk & 7) * 32 + (c & 31)) * 2; }
DEVI int v_rd_base(int lane) { return ((lane & 3) << 3) | (((lane >> 2) & 3) << 6) | (((lane >> 4) & 1) << 5) | (((lane >> 5) & 1) << 8); }
constexpr int v_rd_off(int d0, int ks, int half) { return d0 * 512 + ks * 4096 + half * 2048; }
template <int OFF> DEVI s16x4 tr_read(int vb) { s16x4 r; asm volatile("ds_read_b64_tr_b16 %0, %1 offset:%2" : "=&v"(r) : "v"(vb), "i"(OFF) : "memory"); return r; }
template <int D0> DEVI void pv_one(f32x16& od, int vb, bf16x8 pa0, bf16x8 pa1, bf16x8 pa2, bf16x8 pa3) {
    const s16x4 l0 = tr_read<v_rd_off(D0, 0, 0)>(vb), h0 = tr_read<v_rd_off(D0, 0, 1)>(vb), l1 = tr_read<v_rd_off(D0, 1, 0)>(vb), h1 = tr_read<v_rd_off(D0, 1, 1)>(vb);
    const s16x4 l2 = tr_read<v_rd_off(D0, 2, 0)>(vb), h2 = tr_read<v_rd_off(D0, 2, 1)>(vb), l3 = tr_read<v_rd_off(D0, 3, 0)>(vb), h3 = tr_read<v_rd_off(D0, 3, 1)>(vb);
    asm volatile("s_waitcnt lgkmcnt(0)" ::: "memory"); SBAR();
#define PK(L, H) (bf16x8){L[0], L[1], L[2], L[3], H[0], H[1], H[2], H[3]}
    od = __builtin_amdgcn_mfma_f32_32x32x16_bf16(pa0, PK(l0, h0), od, 0, 0, 0);
    od = __builtin_amdgcn_mfma_f32_32x32x16_bf16(pa1, PK(l1, h1), od, 0, 0, 0);
    od = __builtin_amdgcn_mfma_f32_32x32x16_bf16(pa2, PK(l2, h2), od, 0, 0, 0);
    od = __builtin_amdgcn_mfma_f32_32x32x16_bf16(pa3, PK(l3, h3), od, 0, 0, 0);
#undef PK
}
DEVI void pv_d0(f32x16* o, int vb, bf16x8 pa0, bf16x8 pa1, bf16x8 pa2, bf16x8 pa3) {
    pv_one<0>(o[0], vb, pa0, pa1, pa2, pa3); pv_one<1>(o[1], vb, pa0, pa1, pa2, pa3); pv_one<2>(o[2], vb, pa0, pa1, pa2, pa3); pv_one<3>(o[3], vb, pa0, pa1, pa2, pa3);
}
DEVI void wmask(f32x16& p0, f32x16& p1, int qp, int kt0, int hi) {
#pragma unroll
    for (int r = 0; r < 16; ++r) { const int kp = kt0 + crow(r, hi); const int d0 = qp - kp, d1 = d0 - 32;
        if (d0 > 128 || d0 < -128) p0[r] = -1e30f; if (d1 > 128 || d1 < -128) p1[r] = -1e30f; }
}
DEVI void attn_unit(const KA& a, int b, int kvh, int tb, char* lds) {
    unsigned char* ws = a.ws();
    const bf16_t* QAT = (const bf16_t*)(ws + WS_QAT); const bf16_t* KAT = (const bf16_t*)(ws + WS_KAT); const bf16_t* VAT = (const bf16_t*)(ws + WS_VAT);
    bf16_t* Y = (bf16_t*)(ws + WS_Y); const float* rope = (const float*)(ws + SM_ROPE);
    const int tid = threadIdx.x, wid = __builtin_amdgcn_readfirstlane(tid >> 6), lane = tid & 63, r32 = lane & 31, hi = lane >> 5;
    const int h = kvh * 4 + (wid >> 1), t0 = tb * 64;
    char* V_lds = lds; char* K_lds = lds + 2 * SHM_V;
    float* wsf = (float*)(lds + OFF_WS) + wid * 64; float* li_l = wsf; float* al_l = wsf + 32;
    float m_reg = -1e30f, l_reg = 0; f32x16 o[4] = {}; bf16x8 qr[8];
    const int qp = t0 + (wid & 1) * QBLK + r32;
    {
        const bf16_t* Qw = QAT + (size_t)(b * SEQ + qp) * 1024 + h * 128 + hi * 8;
        u32x4 raw[8]; float ss = 0.f;
#pragma unroll
        for (int d0 = 0; d0 < 8; ++d0) { raw[d0] = *(const u32x4*)(Qw + d0 * 16);
#pragma unroll
            for (int i = 0; i < 4; ++i) { const float lo_ = bflo(raw[d0][i]), hi_ = bfhi(raw[d0][i]); ss += lo_ * lo_ + hi_ * hi_; } }
        { auto rr = __builtin_amdgcn_permlane32_swap(__float_as_uint(ss), __float_as_uint(ss), false, false); ss = __uint_as_float(rr[0]) + __uint_as_float(rr[1]); }
        const float rs = rsqrtf(ss * (1.f / 128.f) + EPS);
        const float* qnw = a.in(13);
#pragma unroll
        for (int half = 0; half < 2; ++half) {
            const float* ct = half == 0 ? rope + (qp >> 6) * 32 : rope + 16384 + (qp & 63) * 32;
            const float* st = half == 0 ? ct + 8192 : ct + 2048;
#pragma unroll
            for (int dd = 0; dd < 2; ++dd) {
                const int fi = dd * 16 + hi * 8, da = half * 4 + dd, db = da + 2;
                u32x4 oa, ob;
#pragma unroll
                for (int q4 = 0; q4 < 2; ++q4) {
                    const f32x4 c = *(const f32x4*)(ct + fi + 4 * q4), s = *(const f32x4*)(st + fi + 4 * q4);
                    const f32x4 wa = *(const f32x4*)(qnw + da * 16 + hi * 8 + 4 * q4), wb = *(const f32x4*)(qnw + db * 16 + hi * 8 + 4 * q4);
                    float ya[4], yb[4];
#pragma unroll
                    for (int j = 0; j < 4; ++j) {
                        const unsigned ra = raw[da][2 * q4 + (j >> 1)], rb = raw[db][2 * q4 + (j >> 1)];
                        const float x1 = ((j & 1) ? bfhi(ra) : bflo(ra)) * rs * wa[j], x2 = ((j & 1) ? bfhi(rb) : bflo(rb)) * rs * wb[j];
                        ya[j] = x1 * c[j] - x2 * s[j]; yb[j] = x2 * c[j] + x1 * s[j];
                    }
                    oa[2 * q4] = cvtpk(ya[0], ya[1]); oa[2 * q4 + 1] = cvtpk(ya[2], ya[3]); ob[2 * q4] = cvtpk(yb[0], yb[1]); ob[2 * q4 + 1] = cvtpk(yb[2], yb[3]);
                }
                qr[da] = *reinterpret_cast<bf16x8*>(&oa); qr[db] = *reinterpret_cast<bf16x8*>(&ob);
            }
        }
    }
    const int tk0 = t0 - 128 < 0 ? 0 : t0 - 128, tk1 = t0 + 192 > SEQ ? SEQ : t0 + 192;
    const int NTR = 4 + (tk1 - tk0) / 64, NT = (NTR + 1) & ~1;
    const int ctxrow = ML + b * CTX, latrow = b * SEQ + tk0 - 256;
#define TCTX(j) ((j) < 4 || (j) >= NTR)
#define TROW(j) (TCTX(j) ? b * CTX + 64 * ((j) & 3) : latrow + 64 * (j))
    const bf16_t* Kh = KAT + kvh * 128; const bf16_t* Vh = VAT + kvh * 128;
    const bf16_t* Kc = (const bf16_t*)(ws + WS_CTXK) + kvh * 128; const bf16_t* Vc = (const bf16_t*)(ws + WS_CTXV) + kvh * 128;
    const int sr = tid >> 4, sc = (tid & 15) * 8, vst0 = v_st(sr, sc), vst1 = v_st(32 + sr, sc);
    const int vb0 = (int)(uintptr_t)V_lds + v_rd_base(lane);
    struct { bf16x8 vs0, vs1, ks0, ks1; } sr_[1];
#define SLOAD(i, j) do { const int k0_ = TROW(j); const bf16_t* kb_ = TCTX(j) ? Kc : Kh; const bf16_t* vb_ = TCTX(j) ? Vc : Vh; \
    sr_[i].vs0 = *(const bf16x8*)(vb_ + (size_t)(k0_ + sr) * LDK + sc); sr_[i].vs1 = *(const bf16x8*)(vb_ + (size_t)(k0_ + 32 + sr) * LDK + sc); \
    sr_[i].ks0 = *(const bf16x8*)(kb_ + (size_t)(k0_ + sr) * LDK + sc); sr_[i].ks1 = *(const bf16x8*)(kb_ + (size_t)(k0_ + 32 + sr) * LDK + sc); } while (0)
#define SWRITE(bf, i) do { *(bf16x8*)(V_lds + (bf) * SHM_V + vst0) = sr_[i].vs0; *(bf16x8*)(V_lds + (bf) * SHM_V + vst1) = sr_[i].vs1; const int kc = sc * 2; \
    *(bf16x8*)(K_lds + (bf) * SHM_K + KSWZ(sr, kc)) = sr_[i].ks0; *(bf16x8*)(K_lds + (bf) * SHM_K + KSWZ(32 + sr, kc)) = sr_[i].ks1; } while (0)
#define SWAIT() asm volatile("s_waitcnt vmcnt(0)" ::: "memory")
#define RESC(al) do { if (__any((al) < 1.f)) { if (hi == 0) al_l[r32] = (al); asm volatile("s_waitcnt lgkmcnt(0)" ::: "memory"); \
    _Pragma("unroll") for (int d = 0; d < 4; ++d) _Pragma("unroll") for (int r = 0; r < 16; ++r) o[d][r] *= al_l[crow(r, hi)]; } } while (0)
#define WMASK(P0, P1, j) do { if ((j) >= 4) wmask(P0, P1, qp, (j) >= NTR ? 1000000 : tk0 + 64 * ((j) - 4), hi); } while (0)
    f32x16 pA0, pA1, pB0, pB1; float mnA, mnB, alA, alB; bf16x8 pa0, pa1, pa2, pa3;
    constexpr int SE = 0, SO = 0;
    SLOAD(SE, 0); asm volatile("s_waitcnt vmcnt(0)" ::: "memory"); SWRITE(0, SE); __syncthreads();
    qkt(pA0, pA1, K_lds, qr, r32, hi); partialSM(pA0, pA1, m_reg, mnA, alA);
    SLOAD(SO, 1);
    SWAIT(); SWRITE(1, SO); __syncthreads();
    for (int j = 1; j + 1 < NT; j += 2) {
        SBAR(); qkt(pB0, pB1, K_lds + SHM_K, qr, r32, hi); WMASK(pB0, pB1, j);
        finishSM(pA0, pA1, alA, l_reg, pa0, pa1, pa2, pa3); SBAR();
        SLOAD(SO, j + 1); SBAR();
        pv_d0(o, vb0, pa0, pa1, pa2, pa3); partialSM(pB0, pB1, m_reg, mnB, alB);
        __syncthreads(); SWAIT(); SWRITE(0, SE);
        RESC(alB); __syncthreads();
        SBAR(); qkt(pA0, pA1, K_lds, qr, r32, hi); WMASK(pA0, pA1, j + 1);
        finishSM(pB0, pB1, alB, l_reg, pa0, pa1, pa2, pa3); SBAR();
        SLOAD(SE, j + 2); SBAR();
        pv_d0(o, vb0 + (int)SHM_V, pa0, pa1, pa2, pa3); partialSM(pA0, pA1, m_reg, mnA, alA);
        __syncthreads(); SWAIT(); SWRITE(1, SO);
        RESC(alA); __syncthreads();
    }
    SBAR(); qkt(pB0, pB1, K_lds + SHM_K, qr, r32, hi); WMASK(pB0, pB1, NT - 1);
    finishSM(pA0, pA1, alA, l_reg, pa0, pa1, pa2, pa3); SBAR();
    pv_d0(o, vb0, pa0, pa1, pa2, pa3); partialSM(pB0, pB1, m_reg, mnB, alB);
    __syncthreads(); RESC(alB);
    finishSM(pB0, pB1, alB, l_reg, pa0, pa1, pa2, pa3); SBAR();
    pv_d0(o, vb0 + (int)SHM_V, pa0, pa1, pa2, pa3);
    l_reg += __builtin_amdgcn_exp2f(a.in(15)[h] * 1.4426950408889634f - m_reg * (SCALE * 1.4426950408889634f));
    if (hi == 0) li_l[r32] = l_reg; asm volatile("s_waitcnt lgkmcnt(0)" ::: "memory");
    float rli[16];
#pragma unroll
    for (int r = 0; r < 16; ++r) rli[r] = __builtin_amdgcn_rcpf(li_l[crow(r, hi)]);
    {
        bf16_t* stg = (bf16_t*)(lds + OFF_OST) + wid * 4096;
#pragma unroll
        for (int r = 0; r < 16; ++r) { const int orow = crow(r, hi);
#pragma unroll
            for (int d0 = 0; d0 < 4; ++d0) stg[orow * 128 + d0 * 32 + r32] = (bf16_t)f2bf(o[d0][r] * rli[r]); }
        asm volatile("s_waitcnt lgkmcnt(0)" ::: "memory");
        bf16_t* Ow = Y + (size_t)(b * SEQ + t0 + (wid & 1) * QBLK) * 2048 + 1024 + h * 128;
#pragma unroll
        for (int i = 0; i < 8; ++i) { const int row = i * 4 + (lane >> 4), ch = lane & 15; const u32x4 v = *(const u32x4*)(stg + row * 128 + ch * 8); *(u32x4*)(Ow + (size_t)row * 2048 + ch * 8) = v; }
    }
    __syncthreads();
#undef TROW
#undef TCTX
#undef SLOAD
#undef SWRITE
#undef SWAIT
#undef RESC
#undef WMASK
}
#undef KSWZ
#undef SBAR
}

DEVI u32x4 ldu_(const bf16_t* base, int rr) {
    const int rc = rr < 0 ? 0 : (rr >= SEQ ? SEQ - 1 : rr);
    const u32x4 v = *(const u32x4*)(base + (size_t)rc * NUP);
    const unsigned m = (rr == rc) ? 0xffffffffu : 0u;
    return (u32x4){v[0] & m, v[1] & m, v[2] & m, v[3] & m};
}
DEVI void phase_ffnconv(const KA& a, int b, int tid) {
    unsigned char* ws = a.ws();
    const bf16_t* U = (const bf16_t*)(ws + WS_U); bf16_t* ACT = (bf16_t*)(ws + WS_ACT) + (size_t)b * SEQ * DFF;
    const float* cw = a.in(20); const float* cb = a.in(21);
    if (tid < DFF / 8) {
        const int f0 = tid * 8, pn = f0 >> 7, j = f0 & 127, gc = 256 * pn + j, vc = gc + 128;
        float wg[3][8], wv[3][8], bg[8], bvv[8];
#pragma unroll
        for (int jt = 0; jt < 3; ++jt)
#pragma unroll
            for (int q = 0; q < 8; ++q) { wg[jt][q] = cw[jt * NUP + f0 + q]; wv[jt][q] = cw[jt * NUP + DFF + f0 + q]; }
#pragma unroll
        for (int q = 0; q < 8; ++q) { bg[q] = cb[f0 + q]; bvv[q] = cb[DFF + f0 + q]; }
        for (int it = blockIdx.x; it < SEQ / 32; it += gridDim.x) {
            const int r0 = it * 32;
            u32x4 gw_[3], vw_[3];
#define LDU(rr, c) ldu_(U + (c), (rr))
            gw_[0] = LDU(r0 - 1, gc); vw_[0] = LDU(r0 - 1, vc); gw_[1] = LDU(r0, gc); vw_[1] = LDU(r0, vc);
#pragma unroll 8
            for (int r = 0; r < 32; ++r) {
                gw_[2] = LDU(r0 + r + 1, gc); vw_[2] = LDU(r0 + r + 1, vc);
                float ug[8], uv[8];
#pragma unroll
                for (int q = 0; q < 8; ++q) { ug[q] = bg[q]; uv[q] = bvv[q]; }
#pragma unroll
                for (int jt = 0; jt < 3; ++jt)
#pragma unroll
                    for (int q = 0; q < 4; ++q) {
                        ug[2 * q] += bflo(gw_[jt][q]) * wg[jt][2 * q]; ug[2 * q + 1] += bfhi(gw_[jt][q]) * wg[jt][2 * q + 1];
                        uv[2 * q] += bflo(vw_[jt][q]) * wv[jt][2 * q]; uv[2 * q + 1] += bfhi(vw_[jt][q]) * wv[jt][2 * q + 1]; }
                u32x4 o;
                o.x = pk2(siluf(ug[0]) * uv[0], siluf(ug[1]) * uv[1]); o.y = pk2(siluf(ug[2]) * uv[2], siluf(ug[3]) * uv[3]);
                o.z = pk2(siluf(ug[4]) * uv[4], siluf(ug[5]) * uv[5]); o.w = pk2(siluf(ug[6]) * uv[6], siluf(ug[7]) * uv[7]);
                *(u32x4*)(ACT + (size_t)(r0 + r) * DFF + f0) = o;
                gw_[0] = gw_[1]; gw_[1] = gw_[2]; vw_[0] = vw_[1]; vw_[1] = vw_[2];
            }
#undef LDU
        }
    }
}

#define XB_TMO      128
#define XB_XCNT(j)  (256  + 64 * (j))
#define XB_XSUB(j)  (1280 + 64 * (j))
#define XB_XGEN(j)  (2304 + 64 * (j))
#define XB_TOP      3328
#define XB_TOPGEN   3392
#define XCD_BAR_WORDS 3456
#define XB_SPIN_CAP (1u << 18)
__device__ __forceinline__ unsigned xb_ld(unsigned* p)              { return __hip_atomic_load(p, __ATOMIC_RELAXED, __HIP_MEMORY_SCOPE_AGENT); }
__device__ __forceinline__ unsigned xb_add(unsigned* p, unsigned v) { return __hip_atomic_fetch_add(p, v, __ATOMIC_RELAXED, __HIP_MEMORY_SCOPE_AGENT); }
__device__ __forceinline__ unsigned xb_xcc_id() { return (unsigned)__builtin_amdgcn_s_getreg((3 << 11) | 20) & 0xFu; }
#define XB_SPIN(cond, bar) do { unsigned _sp = 0; while (cond) { __builtin_amdgcn_s_sleep(1); \
    if ((++_sp & 255u) == 0u) { if (xb_ld(&(bar)[XB_TMO])) break; if (_sp > XB_SPIN_CAP) { atomicAdd(&(bar)[XB_TMO], 1u); break; } } } } while (0)
struct XcdBarrier { unsigned* bar; unsigned x; volatile LAS unsigned* st; };
__device__ __forceinline__ XcdBarrier xcd_barrier_post(unsigned* bar, volatile LAS unsigned* st) {
    XcdBarrier b; b.bar = bar; b.x = xb_xcc_id(); b.st = st;
    if (threadIdx.x == 0) (void)xb_add(&bar[XB_XCNT(b.x)], 1u);
    return b;
}
__device__ __forceinline__ void xcd_barrier_complete(unsigned* bar, unsigned x, unsigned& nloc, unsigned& nx) {
    const unsigned G = gridDim.x * gridDim.y * gridDim.z;
    unsigned sum, cnt, mine, sp = 0u;
    for (;;) {
        sum = 0u; cnt = 0u; mine = 0u;
#pragma unroll
        for (unsigned j = 0; j < 16; ++j) { const unsigned c = xb_ld(&bar[XB_XCNT(j)]); sum += c; cnt += (c > 0u) ? 1u : 0u; mine = (j == x) ? c : mine; }
        if (sum == G) break;
        __builtin_amdgcn_s_sleep(1);
        if ((++sp & 255u) == 0u) { if (xb_ld(&bar[XB_TMO])) break; if (sp > XB_SPIN_CAP) { atomicAdd(&bar[XB_TMO], 1u); break; } }
    }
    nloc = mine > 0u ? mine : 1u; nx = cnt > 0u ? cnt : 1u;
}
__device__ __forceinline__ void xcd_barrier(const XcdBarrier& b) {
    asm volatile("s_waitcnt vmcnt(0)" ::: "memory");
    __syncthreads();
    if (threadIdx.x == 0) {
        unsigned* bar = b.bar;
        __builtin_amdgcn_s_waitcnt(0);
        unsigned nloc = b.st[0], nx = b.st[1];
        if (nloc == 0u) { xcd_barrier_complete(bar, b.x, nloc, nx); b.st[0] = nloc; b.st[1] = nx; }
        const unsigned old = xb_add(&bar[XB_XSUB(b.x)], 1u);
        const unsigned gen = old / nloc;
        if (old + 1u == (gen + 1u) * nloc) {
            __builtin_amdgcn_fence(__ATOMIC_RELEASE, "agent");
            asm volatile("s_waitcnt vmcnt(0)" ::: "memory");
            const unsigned og = xb_add(&bar[XB_TOP], 1u);
            const unsigned tg = og / nx;
            if (og + 1u == (tg + 1u) * nx) xb_add(&bar[XB_TOPGEN], 1u);
            else XB_SPIN(xb_ld(&bar[XB_TOPGEN]) == tg, bar);
            __builtin_amdgcn_fence(__ATOMIC_ACQUIRE, "agent");
            xb_add(&bar[XB_XGEN(b.x)], 1u);
            asm volatile("s_waitcnt vmcnt(0)" ::: "memory");
        } else {
            XB_SPIN(xb_ld(&bar[XB_XGEN(b.x)]) == gen, bar);
            __builtin_amdgcn_fence(__ATOMIC_ACQUIRE, "agent");
            asm volatile("s_waitcnt vmcnt(0)" ::: "memory");
        }
    }
    __syncthreads();
}

constexpr int NPHASE = 13;
__global__ void __launch_bounds__(512, 2) mega(Args a_) {
    const KA a;
    extern __shared__ __attribute__((aligned(16))) unsigned char lds_raw[];
    LAS unsigned char* lds = (LAS unsigned char*)lds_raw;
    const int tid = threadIdx.x, lane = tid & 63, wave = __builtin_amdgcn_readfirstlane(tid >> 6);
    unsigned char* ws = a.ws();
    const int lo = a_.ph_lo, hi = a_.ph_hi;
#define IN(k) (lo <= (k) && (k) < hi)
#if MK_ONE_LAUNCH
    volatile LAS unsigned* bst = (volatile LAS unsigned*)(lds + 147440);
    if (tid < 4) bst[tid] = 0u;
    __syncthreads();
    const XcdBarrier gbar = xcd_barrier_post((unsigned*)(ws + WS_CTL), bst);
#define SEAM(k) do { if (IN(k) && IN((k) + 1)) xcd_barrier(gbar); } while (0)
#else
#define SEAM(k) do { } while (0)
#endif
    const float* modacc = (const float*)(ws + CTL_MODACC);
    unsigned long long pr_prev = PROBE_MASK ? __builtin_amdgcn_s_memrealtime() : 0ull, pr_acc = 0ull;
#define STAMP(k) do { if (PROBE_MASK) { const unsigned long long now_ = __builtin_amdgcn_s_memrealtime(); if ((PROBE_MASK >> (k)) & 1u) pr_acc += now_ - pr_prev; pr_prev = now_; } } while (0)
    if (IN(0)) { phase0(a, lds, tid, lane, wave); } SEAM(0); STAMP(0);
    if (IN(1)) { phase1(a, tid, lane, wave); } SEAM(1); STAMP(1);
    if (IN(2)) {
        pg8::Gemm g{(const bf16_t*)(ws + WS_XN), (const bf16_t*)(ws + WS_WINA), MT, NA, 1024}; pg8::StaticOrder S; S.init(MT, NA, gridDim.x, blockIdx.x);
        EpiIn E{(const float*)(ws + SM_ROWSS1), (const float*)(ws + SM_SHWA), 0, (bf16_t*)(ws + WS_QKVR), nullptr, nullptr, nullptr, nullptr, (float*)(ws + WS_BA)};
        pg8::gemm_phase<EpiIn, pg8::StaticOrder, true, true>(lds, g, S, E);
        {
            pg8::Gemm g2{(const bf16_t*)(ws + WS_XN) + (size_t)ML * 1024, (const bf16_t*)(ws + WS_WINC) + (size_t)2048 * 1024, MC, 512, 1024};
            TailOrder T{(int)blockIdx.x - ((int)gridDim.x - 4)};
            EpiCtxKV E2{(const float*)(ws + SM_ROWSS1) + ML, (const float*)(ws + SM_SHWA) + 2 * NSH + NA + 2048, (bf16_t*)(ws + WS_CTXK), (bf16_t*)(ws + WS_CTXV)};
            pg8::gemm_phase<EpiCtxKV, TailOrder, true, true>(lds, g2, T, E2);
        }
    } SEAM(2); STAMP(2);
    if (IN(3)) { phase_dnprep(a, tid); } SEAM(3); STAMP(3);
    if (IN(4)) { phase_dnchunk2(a, lds, tid, lane, wave); } SEAM(4); STAMP(4);
    if (IN(5)) { const unsigned long long t5_ = (PROBE_SUB == 4) ? __builtin_amdgcn_s_memrealtime() : 0ull; phase_dnscan2(a, lds, tid, lane, wave, pr_acc); if (PROBE_SUB == 4) pr_acc += __builtin_amdgcn_s_memrealtime() - t5_; } SEAM(5); STAMP(5);
    if (IN(6)) {
        pg8::Gemm g{(const bf16_t*)(ws + WS_XN), (const bf16_t*)(ws + WS_WINC), ML, NC, 1024}; pg8::StaticOrder S; S.init(ML, NC, gridDim.x, blockIdx.x);
        EpiIn E{(const float*)(ws + SM_ROWSS1), (const float*)(ws + SM_SHWA) + NA, 1, (bf16_t*)(ws + WS_GT), (bf16_t*)(ws + WS_QAT), (bf16_t*)(ws + WS_KAT), (bf16_t*)(ws + WS_VAT), (bf16_t*)(ws + WS_MG), nullptr};
        pg8::gemm_phase<EpiIn, pg8::StaticOrder, true, true>(lds, g, S, E);
    } SEAM(6); STAMP(6);
    if (IN(7)) { phase_prep2(a, lane, wave); } SEAM(7); STAMP(7);
    if (IN(8)) {
#pragma unroll 1
        for (int idx = blockIdx.x; idx < 1024; idx += gridDim.x) {
            const int tb = idx & 255, kvh = (idx >> 8) & 1, b = idx >> 9;
            att::attn_unit(a, b, kvh, tb, (char*)lds_raw); }
    } SEAM(8); STAMP(8);
    if (IN(9)) {
        pg8::Gemm g{(const bf16_t*)(ws + WS_Y), (const bf16_t*)(ws + WS_WBR), ML, 1024, 2048}; pg8::StaticOrder S; S.init(ML, 1024, gridDim.x, blockIdx.x);
        EpiBr E{(const bf16_t*)(ws + WS_MG), (bf16_t*)(ws + WS_MERGED)};
        pg8::gemm_phase<EpiBr, pg8::StaticOrder, true, true>(lds, g, S, E);
    } SEAM(9); STAMP(9);
    if (IN(10)) {
        pg8::Gemm g{(const bf16_t*)(ws + WS_MERGED), (const bf16_t*)(ws + WS_WOUT), ML, 1024, 1024}; pg8::StaticOrder S; S.init(ML, 1024, gridDim.x, blockIdx.x);
        EpiOut E{a.in(0), modacc, a.in(5), a.in(7), a.out(), (bf16_t*)(ws + WS_X1S), (float*)(ws + CTL_ROWSS2)};
        pg8::gemm_phase<EpiOut, pg8::StaticOrder, true, true>(lds, g, S, E);
    } SEAM(10); STAMP(10);
    if (IN(11)) {
        pg8::Gemm g{(const bf16_t*)(ws + WS_X1S), (const bf16_t*)(ws + WS_WUP), 2 * TPB * 256, NUP, 1024}; pg8::StaticOrder S; S.init(2 * TPB * 256, NUP, gridDim.x, blockIdx.x);
        EpiUpConv E{(const float*)(ws + CTL_ROWSS2), (const float*)(ws + SM_SHWF), a.in(20), a.in(21), (bf16_t*)(ws + WS_ACT), (LAS float*)(lds + 131072)};
        pg8::gemm_phase<EpiUpConv, pg8::StaticOrder, true, true>(lds, g, S, E);
    } SEAM(11); STAMP(11);
    if (IN(12)) {
        pg8::Gemm g{(const bf16_t*)(ws + WS_ACT), (const bf16_t*)(ws + WS_WDN), ML, 1024, DFF}; pg8::StaticOrder S; S.init(ML, 1024, gridDim.x, blockIdx.x);
        EpiDown E{modacc, a.in(5), a.out()};
        pg8::gemm_phase<EpiDown, pg8::StaticOrder, true, true>(lds, g, S, E);
    }
    STAMP(12);
    if ((PROBE_MASK || PROBE_SUB) && blockIdx.x == 0) { const unsigned long long t0_ = __builtin_amdgcn_s_memrealtime(); while (__builtin_amdgcn_s_memrealtime() - t0_ < pr_acc) __builtin_amdgcn_s_sleep(8); }
#undef STAMP
#undef IN
#undef SEAM
}

extern "C" void kernel_launch(void* const* d_in, const int* in_sizes, int n_in, void* d_out, int out_size, void* d_ws, size_t ws_size, hipStream_t stream) {
    static int grid = 0;
    if (grid == 0) {
        if (n_in != 23 || in_sizes[0] != ML * DM || out_size != ML * DM || ws_size < WS_END) {
            fprintf(stderr, "kernel_launch: unexpected shapes n_in %d in0 %d out %d ws %zu (need %zu)\n", n_in, n_in > 0 ? in_sizes[0] : -1, out_size, ws_size, (size_t)WS_END); grid = -1; return; }
        int dev = 0, cus = 0, per_cu = 0;
        hipGetDevice(&dev); hipDeviceGetAttribute(&cus, hipDeviceAttributeMultiprocessorCount, dev);
        if (hipFuncSetAttribute((const void*)mega, hipFuncAttributeMaxDynamicSharedMemorySize, LDS_BYTES) != hipSuccess) { fprintf(stderr, "kernel_launch: hipFuncSetAttribute failed\n"); grid = -1; return; }
        hipOccupancyMaxActiveBlocksPerMultiprocessor(&per_cu, (const void*)mega, 512, LDS_BYTES);
        (void)hipGetLastError();
        if (per_cu < 1) { fprintf(stderr, "kernel_launch: occupancy query says %d blocks per CU\n", per_cu); per_cu = 1; }
        grid = cus;
    }
    if (grid < 0) return;
    hipMemsetAsync((char*)d_ws + WS_CTL, 0, CTL_ZERO_BYTES, stream);
    Args a{};
    for (int i = 0; i < 23; ++i) a.in[i] = (const float*)d_in[i];
    a.out = (float*)d_out; a.ws = (unsigned char*)d_ws;
#if MK_ONE_LAUNCH
    a.ph_lo = 0; a.ph_hi = NPHASE;
    void* args[] = {&a};
    hipError_t e = hipLaunchCooperativeKernel((const void*)mega, dim3(grid), dim3(512), args, LDS_BYTES, stream);
    if (e != hipSuccess) fprintf(stderr, "cooperative launch failed: %s (grid %d)\n", hipGetErrorString(e), grid);
#else
    for (int p = 0; p < NPHASE; ++p) {
        a.ph_lo = p; a.ph_hi = p + 1;
        hipLaunchKernelGGL(mega, dim3(grid), dim3(512), LDS_BYTES, stream, a);
    }
    hipError_t e = hipPeekAtLastError();
    if (e != hipSuccess) fprintf(stderr, "launch failed: %s\n", hipGetErrorString(e));
#endif
}
```

```cpp
#include <hip/hip_runtime.h>
#include <hip/hip_cooperative_groups.h>
#include <cstdio>
#include <cstdint>
namespace cg = cooperative_groups;

#ifndef PROBE_MASK
#define PROBE_MASK 0u
#endif
#ifndef PROBE_SUB
#define PROBE_SUB 0
#endif
#ifndef MK_ONE_LAUNCH
#define MK_ONE_LAUNCH 1
#endif

#define DEVI __device__ __forceinline__
#define LAS __attribute__((address_space(3)))
typedef unsigned short bf16_t;
typedef short bf16x8 __attribute__((ext_vector_type(8)));
typedef float f32x4 __attribute__((ext_vector_type(4)));
typedef float f32x2 __attribute__((ext_vector_type(2)));
typedef float f32x16 __attribute__((ext_vector_type(16)));
typedef unsigned u32x4 __attribute__((ext_vector_type(4)));
typedef unsigned u32x2 __attribute__((ext_vector_type(2)));
typedef short s16x4 __attribute__((ext_vector_type(4)));

constexpr int BATCH = 2, SEQ = 16384, DM = 1024, CTX = 256;
constexpr int ML = BATCH * SEQ;
constexpr int MC = BATCH * CTX;
constexpr int MT = ML + MC;
constexpr int NA = 3328;
constexpr int NC = 4608;
constexpr int NSH = NA + NC;
constexpr int DFF = 2816, NUP = 5632;
constexpr int RB = SEQ + 256;
constexpr int TPB = 65;
constexpr float EPS = 1e-6f;

constexpr size_t MiB = 1u << 20;
constexpr size_t WS_CTL = 0, CTL_ZERO_BYTES = 1 * MiB;
constexpr size_t CTL_XRANK = 24 * 1024;
constexpr size_t CTL_PROG = 32 * 1024;
constexpr size_t CTL_MODACC = 64 * 1024;
constexpr size_t CTL_ROWSS2 = 256 * 1024;
constexpr size_t WS_SMALL = 1 * MiB;
constexpr size_t SM_ROWSS1 = WS_SMALL;
constexpr size_t SM_SHWA = WS_SMALL + 256 * 1024;
constexpr size_t SM_SHWF = WS_SMALL + 384 * 1024;
constexpr size_t SM_ROPE = WS_SMALL + 512 * 1024;
constexpr size_t WS_BA = 2 * MiB;
constexpr size_t WS_CTXK = 6 * MiB + 256 * 1024;
constexpr size_t WS_CTXV = 6 * MiB + 512 * 1024;
constexpr size_t WS_G = 7 * MiB;
constexpr size_t WS_BETA = 10 * MiB;
constexpr size_t WS_WINA = 13 * MiB, WS_WINC = 20 * MiB, WS_WBR = 29 * MiB, WS_WOUT = 33 * MiB, WS_WUP = 35 * MiB, WS_WDN = 46 * MiB;
constexpr size_t WS_XN = 52 * MiB;
constexpr size_t WS_QKVR = 117 * MiB;
constexpr size_t WS_QKVP = 312 * MiB;
constexpr size_t WS_MG = 180 * MiB;
constexpr size_t WS_GT = 310 * MiB;
constexpr size_t WS_QAT = 375 * MiB;
constexpr size_t WS_KAT = 440 * MiB;
constexpr size_t WS_VAT = 457 * MiB;
constexpr size_t WS_Y = 52 * MiB;
constexpr size_t WS_MERGED = 375 * MiB;
constexpr size_t WS_X1S = 440 * MiB;
constexpr size_t WS_U = 52 * MiB;
constexpr size_t WS_ACT = 228 * MiB;
constexpr size_t WS_TQ = 117 * MiB;
constexpr size_t WS_AVEC = 248 * MiB;
constexpr size_t WS_END = 512 * MiB;

constexpr int LDS_BYTES = 147456;

DEVI float bf2f(unsigned short h) { return __uint_as_float((unsigned)h << 16); }
DEVI float bflo(unsigned w) { return __uint_as_float(w << 16); }
DEVI float bfhi(unsigned w) { return __uint_as_float(w & 0xffff0000u); }
typedef __bf16 bf16x2_t __attribute__((ext_vector_type(2)));
DEVI unsigned pk2(float lo, float hi) { const f32x2 v = {lo, hi}; const bf16x2_t b = __builtin_convertvector(v, bf16x2_t); return __builtin_bit_cast(unsigned, b); }
DEVI unsigned f2bf(float f) { return pk2(f, 0.f) & 0xffffu; }
DEVI float wave_sum(float v) {
#pragma unroll
    for (int o = 1; o < 64; o <<= 1) v += __shfl_xor(v, o);
    return v;
}
DEVI float siluf(float x) { return x * __builtin_amdgcn_rcpf(1.f + __expf(-x)); }
DEVI float sigmoidf_(float x) { return 1.f / (1.f + __expf(-x)); }

struct Args { const float* in[23]; float* out; unsigned char* ws; int ph_lo, ph_hi; };
struct KA {
    DEVI const float* in(int k) const { return ((const float* const*)__builtin_amdgcn_kernarg_segment_ptr())[k]; }
    DEVI float* out() const { return ((float* const*)__builtin_amdgcn_kernarg_segment_ptr())[23]; }
    DEVI unsigned char* ws() const { return ((unsigned char* const*)__builtin_amdgcn_kernarg_segment_ptr())[24]; }
};

namespace pg8 {
constexpr int BM = 256, BK = 64, HALF = 128, HTB = HALF * BK * 2, STAGE_BYTES = 8 * HTB, NXCD = 8, WGM = 8;
__host__ __device__ __forceinline__ int lds_byte(int r, int c) { const int st = (r >> 4) * 2 + (c >> 5), rr = r & 15, cc = c & 31, ob = rr * 64 + cc * 2; return st * 1024 + (ob ^ (((ob >> 9) & 1) << 5)); }
__host__ __device__ __forceinline__ void stage_rc(int b, int& R, int& C) { const int st = b / 1024, sb = b % 1024, swz = sb ^ (((sb >> 9) & 1) << 5); R = (st >> 1) * 16 + swz / 64; C = (st & 1) * 32 + (swz % 64) / 2; }
__host__ __device__ __forceinline__ int perm32(int rho) { const int n = rho >> 4, i = rho & 15; return 8 * (i >> 2) + 4 * n + (i & 3); }
struct Unit { int pm, pn; };
struct Gemm { const bf16_t* A; const bf16_t* Bt; int M, N, K; };
struct StaticOrder {
    int nM, nN, nwg, G, c;
    __device__ void init(int M, int N, int G_, int c_) { nM = M / BM; nN = N / BM; nwg = nM * nN; G = G_; c = c_; }
    __device__ bool next(int i, Unit& u) const {
        const long L = (long)i * G + c; if (L >= nwg) return false;
        int wgid = (int)L; { const int q = nwg / NXCD, r = nwg % NXCD, xcd = wgid % NXCD, off = wgid / NXCD; wgid = (xcd < r ? xcd * (q + 1) : r * (q + 1) + (xcd - r) * q) + off; }
        const int nig = WGM * nN, gid = wgid / nig, fm = gid * WGM, gsz = (nM - fm) < WGM ? (nM - fm) : WGM;
        u.pm = fm + ((wgid % nig) % gsz); u.pn = (wgid % nig) / gsz; return true;
    }
};
template <class Epi> __device__ __forceinline__ size_t a_off(const Epi& E, int pm, int K, size_t tstep) { if constexpr (Epi::AROW) return (size_t)E.arow(pm) * K * 2; else return (size_t)pm * tstep; }
template <class Epi, class Sched, bool ALIGN_EPI, bool SP2>
__device__ __forceinline__ void gemm_phase(LAS unsigned char* lds, const Gemm g, const Sched& S, const Epi& E) {
    const int tid = threadIdx.x, wid = __builtin_amdgcn_readfirstlane(tid >> 6), lane = tid & 63, wr = wid >> 2, wc = wid & 3, fr = lane & 15, fq = lane >> 4;
    const int K = g.K, nt = K / BK;
    unsigned voffA[2], voffB[2];
#pragma unroll
    for (int i = 0; i < 2; ++i) { int R, C; stage_rc(tid * 16 + i * 8192, R, C); const int Rb = Epi::PERM ? ((R & ~31) + perm32(R & 31)) : R;
        voffA[i] = (unsigned)(R * K + C) * 2u; voffB[i] = (unsigned)(Rb * K + C) * 2u; }
    const size_t kstep = (size_t)(BK * 2);
    const size_t hstep = (size_t)HALF * K * 2;
    const size_t tstep = 2 * hstep;
    const unsigned ldsw = (unsigned)wid * 1024u;
    const int aoff = lds_byte(wr * 64 + fr, fq * 8), boff = lds_byte(wc * 32 + fr, fq * 8);
#define PG8_SA(b, h) (((b) * 2 + (h)) * HTB)
#define PG8_SB(b, h) ((4 + (b) * 2 + (h)) * HTB)
#define PG8_STAGE(bufoff, gbase, voff) do { _Pragma("unroll") for (int _i = 0; _i < 2; ++_i) \
        __builtin_amdgcn_global_load_lds((const unsigned*)((const char*)(gbase) + (voff)[_i]), (LAS unsigned*)(lds + (bufoff) + ldsw + _i * 8192), 16, 0, 0); } while (0)
#define PG8_LDA(dst, b, h) do { _Pragma("unroll") for (int m = 0; m < 4; ++m) _Pragma("unroll") for (int k = 0; k < 2; ++k) dst[m][k] = *(const LAS bf16x8*)(lds + PG8_SA(b, h) + aoff + m * 2048 + k * 1024); } while (0)
#define PG8_LDB(dst, b, h) do { _Pragma("unroll") for (int n = 0; n < 2; ++n) _Pragma("unroll") for (int k = 0; k < 2; ++k) dst[n][k] = *(const LAS bf16x8*)(lds + PG8_SB(b, h) + boff + n * 2048 + k * 1024); } while (0)
#define PG8_MMA(ai, bj, At, Bt) do { __builtin_amdgcn_s_setprio(1); _Pragma("unroll") for (int m = 0; m < 4; ++m) _Pragma("unroll") for (int n = 0; n < 2; ++n) _Pragma("unroll") for (int k = 0; k < 2; ++k) \
        acc[ai][bj][m][n] = __builtin_amdgcn_mfma_f32_16x16x32_bf16(Bt[n][k], At[m][k], acc[ai][bj][m][n], 0, 0, 0); __builtin_amdgcn_s_setprio(0); } while (0)
#define PG8_WAIT_V(n) asm volatile("s_waitcnt vmcnt(" #n ")" ::: "memory")
#define PG8_WAIT_L(n) asm volatile("s_waitcnt lgkmcnt(" #n ")" ::: "memory")
#define PG8_BAR __builtin_amdgcn_s_barrier()
#define PG8_SCHED __builtin_amdgcn_sched_barrier(0)
    Unit cur, nxt; int ui = 0;
    if (!S.next(0, cur)) return;
    f32x4 acc[2][2][4][2];
#pragma unroll
    for (int a = 0; a < 2; ++a)
#pragma unroll
        for (int b = 0; b < 2; ++b)
#pragma unroll
            for (int m = 0; m < 4; ++m)
#pragma unroll
                for (int n = 0; n < 2; ++n) acc[a][b][m][n] = (f32x4){0.f, 0.f, 0.f, 0.f};
    bf16x8 At[4][2], B0[2][2], B1[2][2];
    const char* cA = (const char*)g.A + a_off<Epi>(E, cur.pm, K, tstep); const char* cB = (const char*)g.Bt + (size_t)cur.pn * tstep;
    if constexpr (SP2) {
        PG8_STAGE(PG8_SB(0, 0), cB, voffB); PG8_STAGE(PG8_SB(0, 1), cB + hstep, voffB); PG8_STAGE(PG8_SA(0, 0), cA, voffA); PG8_STAGE(PG8_SA(0, 1), cA + hstep, voffA);
        if (wr == 1) PG8_BAR;
        PG8_WAIT_V(2); PG8_BAR;
        PG8_STAGE(PG8_SB(1, 0), cB + kstep, voffB); PG8_STAGE(PG8_SA(1, 0), cA + kstep, voffA); PG8_STAGE(PG8_SB(1, 1), cB + hstep + kstep, voffB);
        PG8_WAIT_V(6); PG8_BAR;
    } else {
        PG8_STAGE(PG8_SB(0, 0), cB, voffB); PG8_STAGE(PG8_SA(0, 0), cA, voffA); PG8_STAGE(PG8_SB(0, 1), cB + hstep, voffB); PG8_STAGE(PG8_SA(0, 1), cA + hstep, voffA);
        if (wr == 1) PG8_BAR;
        PG8_WAIT_V(4); PG8_BAR;
        PG8_STAGE(PG8_SB(1, 0), cB + kstep, voffB); PG8_STAGE(PG8_SA(1, 0), cA + kstep, voffA); PG8_STAGE(PG8_SB(1, 1), cB + hstep + kstep, voffB);
        PG8_WAIT_V(6); PG8_BAR;
    }
    for (;;) {
        const bool has_next = S.next(ui + 1, nxt);
        const char* nA = has_next ? (const char*)g.A + a_off<Epi>(E, nxt.pm, K, tstep) : cA; const char* nB = has_next ? (const char*)g.Bt + (size_t)nxt.pn * tstep : cB;
#pragma unroll 1
        for (int t = 0; t < nt; t += 2) {
            const bool last = (t == nt - 2);
            if constexpr (Epi::MID) { if (t == nt / 2) E.mid(acc, cur, wr, wc, fr, fq); }
            const char* a1 = cA + (size_t)(t + 1) * kstep;
            const char* a2 = last ? nA : cA + (size_t)(t + 2) * kstep; const char* b2 = last ? nB : cB + (size_t)(t + 2) * kstep;
            const char* a3 = a2 + kstep; const char* b3 = b2 + kstep;
            if constexpr (SP2) {
            PG8_LDB(B0, 0, 0); PG8_LDB(B1, 0, 1); PG8_SCHED; PG8_LDA(At, 0, 0); PG8_STAGE(PG8_SA(1, 1), a1 + hstep, voffA);
            PG8_WAIT_V(8); PG8_WAIT_L(0); PG8_BAR; PG8_MMA(0, 0, At, B0); PG8_MMA(0, 1, At, B1); PG8_BAR; PG8_SCHED;
            PG8_LDA(At, 0, 1); PG8_STAGE(PG8_SB(0, 0), b2, voffB); PG8_STAGE(PG8_SB(0, 1), b2 + hstep, voffB); PG8_STAGE(PG8_SA(0, 0), a2, voffA);
            PG8_WAIT_V(8); PG8_WAIT_L(0); PG8_BAR; PG8_MMA(1, 0, At, B0); PG8_MMA(1, 1, At, B1); PG8_BAR; PG8_SCHED;
            PG8_LDB(B0, 1, 0); PG8_LDB(B1, 1, 1); PG8_SCHED; PG8_LDA(At, 1, 0); PG8_STAGE(PG8_SA(0, 1), a2 + hstep, voffA);
            PG8_WAIT_V(8); PG8_WAIT_L(0); PG8_BAR; PG8_MMA(0, 0, At, B0); PG8_MMA(0, 1, At, B1); PG8_BAR; PG8_SCHED;
            PG8_LDA(At, 1, 1); PG8_STAGE(PG8_SB(1, 0), b3, voffB); PG8_STAGE(PG8_SB(1, 1), b3 + hstep, voffB); PG8_STAGE(PG8_SA(1, 0), a3, voffA);
            PG8_WAIT_V(8); PG8_WAIT_L(0); PG8_BAR; PG8_MMA(1, 0, At, B0); PG8_MMA(1, 1, At, B1); PG8_BAR; PG8_SCHED;
            } else {
            PG8_LDB(B0, 0, 0); PG8_SCHED; PG8_LDA(At, 0, 0); PG8_STAGE(PG8_SA(1, 1), a1 + hstep, voffA);
            PG8_WAIT_L(8); PG8_BAR; PG8_WAIT_L(0); PG8_MMA(0, 0, At, B0); PG8_BAR; PG8_SCHED;
            PG8_LDB(B1, 0, 1); PG8_STAGE(PG8_SB(0, 0), b2, voffB);
            PG8_BAR; PG8_WAIT_L(0); PG8_MMA(0, 1, At, B1); PG8_BAR;
            PG8_LDA(At, 0, 1); PG8_STAGE(PG8_SA(0, 0), a2, voffA);
            PG8_BAR; PG8_WAIT_L(0); PG8_MMA(1, 0, At, B0); PG8_BAR; PG8_SCHED;
            PG8_STAGE(PG8_SB(0, 1), b2 + hstep, voffB);
            PG8_WAIT_V(6); PG8_BAR; PG8_MMA(1, 1, At, B1); PG8_BAR;
            PG8_LDB(B0, 1, 0); PG8_SCHED; PG8_LDA(At, 1, 0); PG8_STAGE(PG8_SA(0, 1), a2 + hstep, voffA);
            PG8_WAIT_L(8); PG8_BAR; PG8_WAIT_L(0); PG8_MMA(0, 0, At, B0); PG8_BAR; PG8_SCHED;
            PG8_LDB(B1, 1, 1); PG8_STAGE(PG8_SB(1, 0), b3, voffB);
            PG8_BAR; PG8_WAIT_L(0); PG8_MMA(0, 1, At, B1); PG8_BAR;
            PG8_LDA(At, 1, 1); PG8_STAGE(PG8_SA(1, 0), a3, voffA);
            PG8_BAR; PG8_WAIT_L(0); PG8_MMA(1, 0, At, B0); PG8_BAR; PG8_SCHED;
            PG8_STAGE(PG8_SB(1, 1), b3 + hstep, voffB);
            PG8_WAIT_V(6); PG8_BAR; PG8_MMA(1, 1, At, B1); PG8_BAR;
            }
        }
        if constexpr (ALIGN_EPI) { if (wr == 0) PG8_BAR; }
        E(acc, cur, wr, wc, fr, fq);
        if (!has_next) break;
#pragma unroll
        for (int a = 0; a < 2; ++a)
#pragma unroll
            for (int b = 0; b < 2; ++b)
#pragma unroll
                for (int m = 0; m < 4; ++m)
#pragma unroll
                    for (int n = 0; n < 2; ++n) acc[a][b][m][n] = (f32x4){0.f, 0.f, 0.f, 0.f};
        cur = nxt; cA = nA; cB = nB; ++ui;
        if constexpr (ALIGN_EPI) { if (wr == 1) PG8_BAR; }
    }
    PG8_WAIT_V(0);
    if constexpr (!ALIGN_EPI) { if (wr == 0) PG8_BAR; }
    PG8_BAR;
#undef PG8_SA
#undef PG8_SB
#undef PG8_STAGE
#undef PG8_LDA
#undef PG8_LDB
#undef PG8_MMA
#undef PG8_WAIT_V
#undef PG8_WAIT_L
#undef PG8_BAR
#undef PG8_SCHED
}
}
using pg8::HALF;

DEVI u32x4 pack8(const f32x4& a, const f32x4& b) { u32x4 w; w.x = pk2(a[0], a[1]); w.y = pk2(a[2], a[3]); w.z = pk2(b[0], b[1]); w.w = pk2(b[2], b[3]); return w; }

struct EpiIn {
    static constexpr bool PERM = true, MID = false, AROW = false;
    const float* rowss; const float* shW; int job;
    bf16_t *d0, *d1, *d2, *d3, *d4; float* ba;
    DEVI void operator()(const f32x4 (&acc)[2][2][4][2], const pg8::Unit& u, int wr, int wc, int fr, int fq) const {
        asm volatile("" : "+v"(fr), "+v"(fq));
        const int vs = u.pm < 64 ? 0 : (u.pm < 128 ? 1 : 2);
        bf16_t* base; int pitch, colt; bool isba = false;
        if (job == 0) { base = d0; pitch = 3072; colt = u.pn * 256; if (u.pn >= 12) isba = true; }
        else {
            if (u.pn < 4) { base = d0; pitch = 1024; colt = u.pn * 256; }
            else if (u.pn < 8) { base = d1; pitch = 1024; colt = (u.pn - 4) * 256; }
            else if (u.pn == 8) { base = d2; pitch = 256; colt = 0; }
            else if (u.pn == 9) { base = d3; pitch = 256; colt = 0; }
            else { base = d4; pitch = 2048; colt = (u.pn - 10) * 256; }
        }
        const int ncol0 = u.pn * 256 + wc * 32 + 8 * fq;
        f32x4 sv[2][2];
#pragma unroll
        for (int bj = 0; bj < 2; ++bj)
#pragma unroll
            for (int n = 0; n < 2; ++n) sv[bj][n] = *(const f32x4*)(shW + vs * NSH + ncol0 + bj * HALF + 4 * n);
        const int row0 = u.pm * 256 + wr * 64 + fr;
#pragma unroll
        for (int ai = 0; ai < 2; ++ai)
#pragma unroll
            for (int m = 0; m < 4; ++m) {
                const int row = row0 + ai * HALF + m * 16;
                const float rs = rsqrtf(rowss[row] * (1.f / 1024.f) + EPS);
                if (!isba) {
                    bf16_t* rowp = base + (size_t)row * pitch + colt + wc * 32 + 8 * fq;
#pragma unroll
                    for (int bj = 0; bj < 2; ++bj) { const f32x4 v0 = acc[ai][bj][m][0] * rs + sv[bj][0], v1 = acc[ai][bj][m][1] * rs + sv[bj][1]; *(u32x4*)(rowp + bj * HALF) = pack8(v0, v1); }
                } else if (wc == 0) {
                    float* rowp = ba + (size_t)row * 32 + 8 * fq;
                    *(f32x4*)(rowp) = acc[ai][0][m][0] * rs + sv[0][0]; *(f32x4*)(rowp + 4) = acc[ai][0][m][1] * rs + sv[0][1];
                }
            }
    }
};
struct TailOrder { int idx; __device__ bool next(int i, pg8::Unit& u) const { if (i == 0 && idx >= 0 && idx < 4) { u.pm = idx >> 1; u.pn = idx & 1; return true; } return false; } };
struct EpiCtxKV {
    static constexpr bool PERM = true, MID = false, AROW = false;
    const float* rowss; const float* shW; bf16_t* kat; bf16_t* vat;
    DEVI void operator()(const f32x4 (&acc)[2][2][4][2], const pg8::Unit& u, int wr, int wc, int fr, int fq) const {
        asm volatile("" : "+v"(fr), "+v"(fq));
        bf16_t* base = (u.pn == 0 ? kat : vat);
        const int ncol0 = u.pn * 256 + wc * 32 + 8 * fq;
#pragma unroll
        for (int bj = 0; bj < 2; ++bj) {
            const f32x4 sv0 = *(const f32x4*)(shW + ncol0 + bj * HALF), sv1 = *(const f32x4*)(shW + ncol0 + bj * HALF + 4);
#pragma unroll
            for (int ai = 0; ai < 2; ++ai)
#pragma unroll
                for (int m = 0; m < 4; ++m) { const int row = u.pm * 256 + ai * HALF + wr * 64 + m * 16 + fr;
                    const float rs = rsqrtf(rowss[row] * (1.f / 1024.f) + EPS);
                    *(u32x4*)(base + (size_t)row * 256 + wc * 32 + 8 * fq + bj * HALF) = pack8(acc[ai][bj][m][0] * rs + sv0, acc[ai][bj][m][1] * rs + sv1); }
        }
    }
};
struct EpiBr {
    static constexpr bool PERM = true, MID = true, AROW = false;
    const bf16_t* mg; bf16_t* out;
    DEVI void mid(f32x4 (&acc)[2][2][4][2], const pg8::Unit& u, int wr, int wc, int fr, int fq) const {
        asm volatile("" : "+v"(fr), "+v"(fq));
        const int row0 = u.pm * 256 + wr * 64 + fr, col0 = u.pn * 256 + wc * 32 + 8 * fq;
#pragma unroll
        for (int ai = 0; ai < 2; ++ai)
#pragma unroll
            for (int m = 0; m < 4; ++m) {
                const bf16_t* rp = mg + (size_t)(row0 + ai * HALF + m * 16) * 2048 + col0;
#pragma unroll
                for (int bj = 0; bj < 2; ++bj) {
                    const u32x4 gd = *(const u32x4*)(rp + bj * HALF), ga = *(const u32x4*)(rp + 1024 + bj * HALF);
                    float r[8];
#pragma unroll
                    for (int i = 0; i < 4; ++i) {
                        const float d0 = bflo(gd[i]), d1 = bfhi(gd[i]), a0 = bflo(ga[i]), a1 = bfhi(ga[i]);
                        r[2 * i] = (1.f + __expf(fminf(-a0, 80.f))) * __builtin_amdgcn_rcpf(1.f + __expf(fminf(-d0, 80.f)));
                        r[2 * i + 1] = (1.f + __expf(fminf(-a1, 80.f))) * __builtin_amdgcn_rcpf(1.f + __expf(fminf(-d1, 80.f)));
                    }
                    acc[ai][bj][m][0] *= (f32x4){r[0], r[1], r[2], r[3]}; acc[ai][bj][m][1] *= (f32x4){r[4], r[5], r[6], r[7]};
                    asm volatile("" ::: "memory");
                }
            }
    }
    DEVI void operator()(const f32x4 (&acc)[2][2][4][2], const pg8::Unit& u, int wr, int wc, int fr, int fq) const {
        asm volatile("" : "+v"(fr), "+v"(fq));
        const int row0 = u.pm * 256 + wr * 64 + fr, col0 = u.pn * 256 + wc * 32 + 8 * fq;
#pragma unroll
        for (int ai = 0; ai < 2; ++ai)
#pragma unroll
            for (int m = 0; m < 4; ++m) {
                const size_t row = (size_t)(row0 + ai * HALF + m * 16);
                const bf16_t* rp = mg + row * 2048 + 1024 + col0;
#pragma unroll
                for (int bj = 0; bj < 2; ++bj) {
                    const u32x4 ga = *(const u32x4*)(rp + bj * HALF);
                    float s[8];
#pragma unroll
                    for (int i = 0; i < 4; ++i) { s[2 * i] = __builtin_amdgcn_rcpf(1.f + __expf(fminf(-bflo(ga[i]), 80.f))); s[2 * i + 1] = __builtin_amdgcn_rcpf(1.f + __expf(fminf(-bfhi(ga[i]), 80.f))); }
                    const f32x4 v0 = acc[ai][bj][m][0] * (f32x4){s[0], s[1], s[2], s[3]}, v1 = acc[ai][bj][m][1] * (f32x4){s[4], s[5], s[6], s[7]};
                    *(u32x4*)(out + row * 1024 + col0 + bj * HALF) = pack8(v0, v1);
                }
            }
    }
};
struct EpiOut {
    static constexpr bool PERM = false, MID = false, AROW = false;
    const float* x; const float* modacc; const float* bada; const float* nwf; float* out; bf16_t* x1s; float* rowss2;
    DEVI void operator()(const f32x4 (&acc)[2][2][4][2], const pg8::Unit& u, int wr, int wc, int fr, int fq) const {
        asm volatile("" : "+v"(fr), "+v"(fq));
        const int b = u.pm >> 6; const int row0 = u.pm * 256 + wr * 64 + fr, col0 = u.pn * 256 + wc * 32 + 4 * fq;
        f32x4 ga[2][2], sc[2][2];
#pragma unroll
        for (int bj = 0; bj < 2; ++bj)
#pragma unroll
            for (int n = 0; n < 2; ++n) { const int c = col0 + bj * HALF + n * 16;
                ga[bj][n] = *(const f32x4*)(modacc + b * 6144 + 2048 + c) + *(const f32x4*)(bada + 2048 + c);
                sc[bj][n] = (*(const f32x4*)(modacc + b * 6144 + 4096 + c) + *(const f32x4*)(bada + 4096 + c) + 1.f) * *(const f32x4*)(nwf + c); }
#pragma unroll
        for (int ai = 0; ai < 2; ++ai)
#pragma unroll
            for (int m = 0; m < 4; ++m) {
                const size_t off = (size_t)(row0 + ai * HALF + m * 16) * 1024 + col0; float ss = 0.f;
#pragma unroll
                for (int bj = 0; bj < 2; ++bj)
#pragma unroll
                    for (int n = 0; n < 2; ++n) {
                        const f32x4 xv = *(const f32x4*)(x + off + bj * HALF + n * 16);
                        const f32x4 o = xv + ga[bj][n] * acc[ai][bj][m][n];
                        *(f32x4*)(out + off + bj * HALF + n * 16) = o;
                        ss += (o[0] * o[0] + o[1] * o[1]) + (o[2] * o[2] + o[3] * o[3]);
                        const f32x4 s = o * sc[bj][n]; u32x2 w; w.x = pk2(s[0], s[1]); w.y = pk2(s[2], s[3]);
                        *(u32x2*)(x1s + off + (size_t)(b * (RB - SEQ) + 1) * 1024 + bj * HALF + n * 16) = w;
                    }
                ss += __shfl_xor(ss, 16); ss += __shfl_xor(ss, 32);
                if (fq == 0) atomicAdd(rowss2 + row0 + ai * HALF + m * 16, ss);
            }
    }
};
DEVI f32x4 dpp_ror1(const f32x4& x) { f32x4 r;
#pragma unroll
    for (int i = 0; i < 4; ++i) r[i] = __int_as_float(__builtin_amdgcn_update_dpp(0, __float_as_int(x[i]), 0x121, 0xf, 0xf, false));
    return r; }
DEVI f32x4 dpp_rol1(const f32x4& x) { f32x4 r;
#pragma unroll
    for (int i = 0; i < 4; ++i) r[i] = __int_as_float(__builtin_amdgcn_update_dpp(0, __float_as_int(x[i]), 0x12F, 0xf, 0xf, false));
    return r; }
struct EpiUpConv {
    static constexpr bool PERM = true, MID = false, AROW = true;
    const float* rowss2; const float* shWf; const float* cw; const float* cb; bf16_t* act; LAS float* xb;
    DEVI int arow(int pm) const { const int b = pm / TPB, i = pm - b * TPB; return b * RB + 254 * i; }
    DEVI void operator()(f32x4 (&acc)[2][2][4][2], const pg8::Unit& u, int wr, int wc, int fr, int fq) const {
        asm volatile("" : "+v"(fr), "+v"(fq));
        const int b = u.pm / TPB, ti = u.pm - b * TPB, tok0 = 254 * ti - 1;
        const int cl0 = wc * 32 + 8 * fq;
#pragma unroll
        for (int bj = 0; bj < 2; ++bj) {
            const f32x4 sv0 = *(const f32x4*)(shWf + b * NUP + u.pn * 256 + bj * HALF + cl0), sv1 = *(const f32x4*)(shWf + b * NUP + u.pn * 256 + bj * HALF + cl0 + 4);
#pragma unroll
            for (int ai = 0; ai < 2; ++ai)
#pragma unroll
                for (int m = 0; m < 4; ++m) {
                    const int tok = tok0 + ai * HALF + wr * 64 + m * 16 + fr; const bool ok = tok >= 0 && tok < SEQ;
                    const float rs = ok ? rsqrtf(rowss2[b * SEQ + (ok ? tok : 0)] * (1.f / 1024.f) + EPS) : 0.f;
                    acc[ai][bj][m][0] = ok ? acc[ai][bj][m][0] * rs + sv0 : (f32x4){0.f, 0.f, 0.f, 0.f};
                    acc[ai][bj][m][1] = ok ? acc[ai][bj][m][1] * rs + sv1 : (f32x4){0.f, 0.f, 0.f, 0.f};
                }
        }
#pragma unroll
        for (int ai = 0; ai < 2; ++ai) { const int blk = 2 * ai + wr;
#pragma unroll
            for (int bj = 0; bj < 2; ++bj)
#pragma unroll
                for (int n = 0; n < 2; ++n) {
                    if (fr == 0) *(LAS f32x4*)(xb + (blk * 2 + 0) * 256 + bj * HALF + cl0 + 4 * n) = acc[ai][bj][0][n];
                    if (fr == 15) *(LAS f32x4*)(xb + (blk * 2 + 1) * 256 + bj * HALF + cl0 + 4 * n) = acc[ai][bj][3][n];
                } }
        asm volatile("s_waitcnt lgkmcnt(0)" ::: "memory"); __builtin_amdgcn_s_barrier(); asm volatile("" ::: "memory");
        const int f0 = u.pn * 128 + cl0;
#pragma unroll
        for (int n = 0; n < 2; ++n) {
            f32x4 wg[3], wv[3];
#pragma unroll
            for (int j = 0; j < 3; ++j) { wg[j] = *(const f32x4*)(cw + j * NUP + f0 + 4 * n); wv[j] = *(const f32x4*)(cw + j * NUP + DFF + f0 + 4 * n); }
            const f32x4 bgv = *(const f32x4*)(cb + f0 + 4 * n), bvv = *(const f32x4*)(cb + DFF + f0 + 4 * n);
#pragma unroll
            for (int ai = 0; ai < 2; ++ai) { const int blk = 2 * ai + wr;
                const f32x4 pgx = *(const LAS f32x4*)(xb + (((blk + 3) & 3) * 2 + 1) * 256 + cl0 + 4 * n), pvx = *(const LAS f32x4*)(xb + (((blk + 3) & 3) * 2 + 1) * 256 + HALF + cl0 + 4 * n);
                const f32x4 ngx = *(const LAS f32x4*)(xb + (((blk + 1) & 3) * 2 + 0) * 256 + cl0 + 4 * n), nvx = *(const LAS f32x4*)(xb + (((blk + 1) & 3) * 2 + 0) * 256 + HALF + cl0 + 4 * n);
#pragma unroll
                for (int m = 0; m < 4; ++m) {
                    f32x4 ug, uv;
                    { const f32x4 c = acc[ai][0][m][n], up = m > 0 ? acc[ai][0][m > 0 ? m - 1 : 0][n] : pgx, dn = m < 3 ? acc[ai][0][m < 3 ? m + 1 : 3][n] : ngx;
                      f32x4 pr = dpp_ror1(fr == 15 ? up : c), nx = dpp_rol1(fr == 0 ? dn : c);
                      asm volatile("" : "+v"(pr), "+v"(nx));
                      ug = bgv + wg[0] * pr + wg[1] * c + wg[2] * nx; }
                    { const f32x4 c = acc[ai][1][m][n], up = m > 0 ? acc[ai][1][m > 0 ? m - 1 : 0][n] : pvx, dn = m < 3 ? acc[ai][1][m < 3 ? m + 1 : 3][n] : nvx;
                      f32x4 pr = dpp_ror1(fr == 15 ? up : c), nx = dpp_rol1(fr == 0 ? dn : c);
                      asm volatile("" : "+v"(pr), "+v"(nx));
                      uv = bvv + wv[0] * pr + wv[1] * c + wv[2] * nx; }
                    const int r = ai * HALF + wr * 64 + m * 16 + fr, tok = tok0 + r;
                    if (r >= 1 && r <= 254 && tok < SEQ) {
                        u32x2 w; w.x = pk2(siluf(ug[0]) * uv[0], siluf(ug[1]) * uv[1]); w.y = pk2(siluf(ug[2]) * uv[2], siluf(ug[3]) * uv[3]);
                        *(u32x2*)(act + (size_t)(b * SEQ + tok) * DFF + f0 + 4 * n) = w; }
                    asm volatile("" ::: "memory");
                }
            }
        }
    }
};
struct EpiDown {
    static constexpr bool PERM = false, MID = false, AROW = false;
    const float* modacc; const float* bada; float* out;
    DEVI void operator()(const f32x4 (&acc)[2][2][4][2], const pg8::Unit& u, int wr, int wc, int fr, int fq) const {
        asm volatile("" : "+v"(fr), "+v"(fq));
        const int b = u.pm >> 6; const int row0 = u.pm * 256 + wr * 64 + fr, col0 = u.pn * 256 + wc * 32 + 4 * fq;
        f32x4 gf[2][2];
#pragma unroll
        for (int bj = 0; bj < 2; ++bj)
#pragma unroll
            for (int n = 0; n < 2; ++n) { const int c = col0 + bj * HALF + n * 16; gf[bj][n] = *(const f32x4*)(modacc + b * 6144 + 5120 + c) + *(const f32x4*)(bada + 5120 + c); }
#pragma unroll
        for (int ai = 0; ai < 2; ++ai)
#pragma unroll
            for (int m = 0; m < 4; ++m) {
                const size_t off = (size_t)(row0 + ai * HALF + m * 16) * 1024 + col0;
#pragma unroll
                for (int bj = 0; bj < 2; ++bj)
#pragma unroll
                    for (int n = 0; n < 2; ++n) { float* p = out + off + bj * HALF + n * 16; *(f32x4*)p = *(const f32x4*)p + gf[bj][n] * acc[ai][bj][m][n]; }
            }
    }
};

DEVI void transpose_item(const float* W, int srcN, int k0, int n0, bf16_t* dst  , int dstK, LAS float* scr, int lane) {
#pragma unroll
    for (int i = 0; i < 8; ++i) { const int kk = 8 * i + (lane >> 3), n4 = (lane & 7) * 4; const f32x4 v = *(const f32x4*)(W + (size_t)(k0 + kk) * srcN + n0 + n4);
        LAS float* d = scr + kk * 33 + n4; d[0] = v[0]; d[1] = v[1]; d[2] = v[2]; d[3] = v[3]; }
    asm volatile("s_waitcnt lgkmcnt(0)" ::: "memory");
    const int c = lane & 7;
#pragma unroll
    for (int j = 0; j < 4; ++j) { const int n = (lane >> 3) + 8 * j; const LAS float* s = scr + (8 * c) * 33 + n;
        u32x4 o; o.x = pk2(s[0 * 33], s[1 * 33]); o.y = pk2(s[2 * 33], s[3 * 33]); o.z = pk2(s[4 * 33], s[5 * 33]); o.w = pk2(s[6 * 33], s[7 * 33]);
        *(u32x4*)(dst + (size_t)n * dstK + 8 * c) = o; }
    asm volatile("s_waitcnt lgkmcnt(0)" ::: "memory");
}
DEVI void phase0(const KA& a, LAS unsigned char* lds, int tid, int lane, int wave) {
    unsigned char* ws = a.ws();
    bf16_t* WinA = (bf16_t*)(ws + WS_WINA); bf16_t* WinC = (bf16_t*)(ws + WS_WINC); bf16_t* Wbr = (bf16_t*)(ws + WS_WBR);
    bf16_t* Wout = (bf16_t*)(ws + WS_WOUT); bf16_t* Wup = (bf16_t*)(ws + WS_WUP); bf16_t* Wdn = (bf16_t*)(ws + WS_WDN);
    LAS float* scr = (LAS float*)(lds + wave * 16384);
    const int gw = blockIdx.x * 8 + wave, NGW = gridDim.x * 8;
    constexpr int I_IN = 16 * 241, I_BR = 16 * 32, I_UP = 16 * 176, I_DN = 44 * 32;
    constexpr int NITEMS = I_IN + 3 * I_BR + I_UP + I_DN;
    for (int it = gw; it < NITEMS; it += NGW) {
        int r = it;
        if (r < I_IN) { const int kb = r / 241, nb = r % 241, c0 = nb * 32; bf16_t* d; int row;
            if (c0 < 3072) { d = WinA; row = c0; } else if (c0 < 4096) { d = WinC; row = c0 - 3072; } else if (c0 == 4096) { d = WinA; row = 3072; }
            else if (c0 < 5152) { d = WinC; row = 1024 + (c0 - 4128); } else if (c0 < 5408) { d = WinC; row = 2048 + (c0 - 5152); }
            else if (c0 < 5664) { d = WinC; row = 2304 + (c0 - 5408); } else { d = WinC; row = 2560 + (c0 - 5664); }
            transpose_item(a.in(8), 7712, kb * 64, c0, d + (size_t)row * 1024 + kb * 64, 1024, scr, lane); continue; }
        r -= I_IN;
        if (r < I_BR) { const int kb = r / 32, nb = r % 32; transpose_item(a.in(16), 1024, kb * 64, nb * 32, Wbr + (size_t)(nb * 32) * 2048 + kb * 64, 2048, scr, lane); continue; }
        r -= I_BR;
        if (r < I_BR) { const int kb = r / 32, nb = r % 32; transpose_item(a.in(17), 1024, kb * 64, nb * 32, Wbr + (size_t)(nb * 32) * 2048 + 1024 + kb * 64, 2048, scr, lane); continue; }
        r -= I_BR;
        if (r < I_BR) { const int kb = r / 32, nb = r % 32; transpose_item(a.in(18), 1024, kb * 64, nb * 32, Wout + (size_t)(nb * 32) * 1024 + kb * 64, 1024, scr, lane); continue; }
        r -= I_BR;
        if (r < I_UP) { const int kb = r / 176, nb = r % 176, c0 = nb * 32; int row;
            if (c0 < DFF) row = 256 * (c0 / 128) + (c0 % 128); else { const int c1 = c0 - DFF; row = 256 * (c1 / 128) + 128 + (c1 % 128); }
            transpose_item(a.in(19), NUP, kb * 64, c0, Wup + (size_t)row * 1024 + kb * 64, 1024, scr, lane); continue; }
        r -= I_UP;
        { const int kb = r / 32, nb = r % 32; transpose_item(a.in(22), 1024, kb * 64, nb * 32, Wdn + (size_t)(nb * 32) * DFF + kb * 64, DFF, scr, lane); }
    }
    float* modacc = (float*)(ws + CTL_MODACC);
    for (int it = blockIdx.x; it < 12 * 16; it += gridDim.x) {
        const int cb = it % 12, ks = it / 12, n = cb * 512 + tid;
        float a0 = 0.f, a1 = 0.f, a2 = 0.f;
#pragma unroll 8
        for (int k = ks * 64; k < ks * 64 + 64; ++k) {
            const float w = a.in(4)[(size_t)k * 6144 + n];
            a0 += siluf(a.in(1)[k]) * w; a1 += siluf(a.in(1)[1024 + k]) * w; a2 += siluf(a.in(3)[k]) * w;
        }
        atomicAdd(modacc + n, a0); atomicAdd(modacc + 6144 + n, a1); atomicAdd(modacc + 12288 + n, a2);
    }
    float* rope = (float*)(ws + SM_ROPE);
    for (int i = blockIdx.x * 512 + tid; i < 320 * 32; i += gridDim.x * 512) {
        const int p = i >> 5, f = i & 31; const float inv = powf(10000.f, -(float)f / 32.f);
        if (p < 256) { const float ang = (float)p * inv; rope[p * 32 + f] = cosf(ang); rope[8192 + p * 32 + f] = sinf(ang); }
        else { const int q = p - 256; const float ang = (float)q * inv; rope[16384 + q * 32 + f] = cosf(ang); rope[16384 + 2048 + q * 32 + f] = sinf(ang); }
    }
}

DEVI void phase1(const KA& a, int tid, int lane, int wave) {
    unsigned char* ws = a.ws();
    const float* modacc = (const float*)(ws + CTL_MODACC); const float* bada = a.in(5);
    bf16_t* XN = (bf16_t*)(ws + WS_XN); float* rowss1 = (float*)(ws + SM_ROWSS1);
    const int gw = blockIdx.x * 8 + wave, NGW = gridDim.x * 8;
    {
        const int per = (MT + NGW - 1) / NGW, rbeg = gw * per, rend = rbeg + per < MT ? rbeg + per : MT;
        int vcur = -1; f32x4 sc[4];
        for (int row = rbeg; row < rend; row += 2) {
            const int vs = row < SEQ ? 0 : (row < ML ? 1 : 2);
            if (vs != vcur) { vcur = vs;
#pragma unroll
                for (int j = 0; j < 4; ++j) { const int c = 4 * lane + 256 * j; sc[j] = (*(const f32x4*)(modacc + vs * 6144 + 1024 + c) + *(const f32x4*)(bada + 1024 + c) + 1.f) * *(const f32x4*)(a.in(6) + c); } }
            const int row1 = row + 1; const bool two = row1 < rend && (row1 < SEQ ? 0 : (row1 < ML ? 1 : 2)) == vs;
            const float* xr0 = row < ML ? a.in(0) + (size_t)row * 1024 : a.in(2) + (size_t)(row - ML) * 1024;
            const float* xr1 = two ? (row1 < ML ? a.in(0) + (size_t)row1 * 1024 : a.in(2) + (size_t)(row1 - ML) * 1024) : xr0;
            f32x4 v0[4], v1[4];
#pragma unroll
            for (int j = 0; j < 4; ++j) { v0[j] = *(const f32x4*)(xr0 + 4 * lane + 256 * j); v1[j] = *(const f32x4*)(xr1 + 4 * lane + 256 * j); }
            float s0 = 0.f, s1 = 0.f;
#pragma unroll
            for (int j = 0; j < 4; ++j) { const int c = 4 * lane + 256 * j;
                s0 += (v0[j][0] * v0[j][0] + v0[j][1] * v0[j][1]) + (v0[j][2] * v0[j][2] + v0[j][3] * v0[j][3]);
                s1 += (v1[j][0] * v1[j][0] + v1[j][1] * v1[j][1]) + (v1[j][2] * v1[j][2] + v1[j][3] * v1[j][3]);
                const f32x4 o0 = v0[j] * sc[j], o1 = v1[j] * sc[j];
                u32x2 w; w.x = pk2(o0[0], o0[1]); w.y = pk2(o0[2], o0[3]); *(u32x2*)(XN + (size_t)row * 1024 + c) = w;
                if (two) { u32x2 w1; w1.x = pk2(o1[0], o1[1]); w1.y = pk2(o1[2], o1[3]); *(u32x2*)(XN + (size_t)row1 * 1024 + c) = w1; } }
            s0 = wave_sum(s0); s1 = wave_sum(s1);
            if (lane == 0) { rowss1[row] = s0; if (two) rowss1[row1] = s1; }
            if (!two) --row;
        }
    }
    const bf16_t* WinA = (const bf16_t*)(ws + WS_WINA); const bf16_t* WinC = (const bf16_t*)(ws + WS_WINC); const bf16_t* Wup = (const bf16_t*)(ws + WS_WUP);
    float* shWa = (float*)(ws + SM_SHWA); float* shWf = (float*)(ws + SM_SHWF);
    for (int n = gw; n < NSH + NUP; n += NGW) {
        const bool isf = n >= NSH;
        const bf16_t* wrow = isf ? Wup + (size_t)(n - NSH) * 1024 : (n < NA ? WinA + (size_t)n * 1024 : WinC + (size_t)(n - NA) * 1024);
        const int shoff = isf ? 3072 : 0;
        float s0 = 0.f, s1 = 0.f, s2 = 0.f;
#pragma unroll
        for (int h = 0; h < 2; ++h) {
            const int k0 = h * 512 + lane * 8;
            const u32x4 w = *(const u32x4*)(wrow + k0);
#pragma unroll
            for (int i = 0; i < 4; ++i) {
                const float wl = bflo(w[i]), wh = bfhi(w[i]); const int k = k0 + 2 * i;
                const float b0 = bada[shoff + k], b1 = bada[shoff + k + 1];
                s0 += (modacc[shoff + k] + b0) * wl + (modacc[shoff + k + 1] + b1) * wh;
                s1 += (modacc[6144 + shoff + k] + b0) * wl + (modacc[6144 + shoff + k + 1] + b1) * wh;
                s2 += (modacc[12288 + shoff + k] + b0) * wl + (modacc[12288 + shoff + k + 1] + b1) * wh;
            }
        }
        s0 = wave_sum(s0); s1 = wave_sum(s1); s2 = wave_sum(s2);
        if (lane == 0) {
            if (isf) { shWf[n - NSH] = s0; shWf[NUP + n - NSH] = s1; }
            else { shWa[n] = s0; shWa[NSH + n] = s1; shWa[2 * NSH + n] = s2; }
        }
    }
}

DEVI u32x4 ldrow_(const bf16_t* base, int seq_start, int seq_len, int tt) {
    const int tc = tt < 0 ? 0 : (tt >= seq_len ? seq_len - 1 : tt);
    const u32x4 v = *(const u32x4*)(base + (size_t)(seq_start + tc) * 3072);
    const unsigned m = (tt == tc) ? 0xffffffffu : 0u;
    return (u32x4){v[0] & m, v[1] & m, v[2] & m, v[3] & m};
}
DEVI void phase_dnprep(const KA& a, int tid) {
    unsigned char* ws = a.ws();
    const bf16_t* QR = (const bf16_t*)(ws + WS_QKVR); bf16_t* QP = (bf16_t*)(ws + WS_QKVP);
    const float* convw = a.in(9); const float* ba = (const float*)(ws + WS_BA);
    float* gb = (float*)(ws + WS_G); float* bb = (float*)(ws + WS_BETA);
    const int cgp = tid & 127, strip = tid >> 7;
    for (int it = blockIdx.x; it < 520 * 3; it += gridDim.x) {
        const int cidx = it / 3, sec = it - cidx * 3;
        int seq_start, t0, seq_len;
        if (cidx < 512) { seq_start = (cidx >> 8) * SEQ; t0 = (cidx & 255) * 64; seq_len = SEQ; }
        else { const int c2 = cidx - 512; seq_start = ML + (c2 >> 2) * CTX; t0 = (c2 & 3) * 64; seq_len = CTX; }
        const int col = sec * 1024 + cgp * 8;
        f32x4 w0[5], w1[5];
#pragma unroll
        for (int j = 0; j < 5; ++j) { w0[j] = *(const f32x4*)(convw + j * 3072 + col); w1[j] = *(const f32x4*)(convw + j * 3072 + col + 4); }
        const int tb = t0 + strip * 16;
        u32x4 win[5];
#define LDROW(tt) ldrow_(QR + col, seq_start, seq_len, (tt))
        win[0] = LDROW(tb - 2); win[1] = LDROW(tb - 1); win[2] = LDROW(tb); win[3] = LDROW(tb + 1);
#pragma unroll
        for (int r = 0; r < 16; ++r) {
            win[4] = LDROW(tb + r + 2);
            f32x4 acc0 = {0.f, 0.f, 0.f, 0.f}, acc1 = {0.f, 0.f, 0.f, 0.f};
#pragma unroll
            for (int j = 0; j < 5; ++j) { const u32x4 x = win[j];
                acc0 += (f32x4){bflo(x[0]), bfhi(x[0]), bflo(x[1]), bfhi(x[1])} * w0[j];
                acc1 += (f32x4){bflo(x[2]), bfhi(x[2]), bflo(x[3]), bfhi(x[3])} * w1[j]; }
            float y[8];
#pragma unroll
            for (int i = 0; i < 4; ++i) { y[i] = siluf(acc0[i]); y[4 + i] = siluf(acc1[i]); }
            if (sec < 2) {
                float ss = 0.f;
#pragma unroll
                for (int i = 0; i < 8; ++i) ss += y[i] * y[i];
                ss += __shfl_xor(ss, 1); ss += __shfl_xor(ss, 2); ss += __shfl_xor(ss, 4); ss += __shfl_xor(ss, 8);
                const float sc = rsqrtf(ss + EPS) * (sec == 0 ? 0.08838834764831845f : 1.f);
#pragma unroll
                for (int i = 0; i < 8; ++i) y[i] *= sc;
            }
            u32x4 o; o.x = pk2(y[0], y[1]); o.y = pk2(y[2], y[3]); o.z = pk2(y[4], y[5]); o.w = pk2(y[6], y[7]);
            *(u32x4*)(QP + (size_t)(seq_start + tb + r) * 3072 + col) = o;
            win[0] = win[1]; win[1] = win[2]; win[2] = win[3]; win[3] = win[4];
        }
#undef LDROW
        if (sec == 0) {
#pragma unroll
            for (int q = 0; q < 2; ++q) {
                const int e = tid + q * 512, r = e >> 4, idx = e & 15, row = seq_start + t0 + r;
                const float bv = ba[(size_t)row * 32 + idx], av = ba[(size_t)row * 32 + 16 + idx];
                const float xs = av + a.in(11)[idx];
                const float sp = fmaxf(xs, 0.f) + log1pf(expf(-fabsf(xs)));
                const float g = -expf(a.in(10)[idx]) * sp;
                const int dir = idx >> 3, h = idx & 7;
                gb[((size_t)dir * MT + row) * 8 + h] = g;
                bb[((size_t)dir * MT + row) * 8 + h] = 1.f / (1.f + expf(-bv));
            }
        }
    }
}

DEVI void phase_dnscan(const KA& a, int lane, int wave) {
    unsigned char* ws = a.ws();
    const bf16_t* QP = (const bf16_t*)(ws + WS_QKVP);
    const float* gb = (const float*)(ws + WS_G); const float* bb = (const float*)(ws + WS_BETA);
    bf16_t* Of = (bf16_t*)a.out(); bf16_t* Ob = Of + (size_t)ML * 1024;
    const int gw = blockIdx.x * 8 + wave, NGW = gridDim.x * 8;
    for (int item = gw; item < 2048; item += NGW) {
        const int chain = item >> 6, ep = item & 63, dir = chain >> 4, b = (chain >> 3) & 1, h = chain & 7;
        bf16_t* O = dir ? Ob : Of;
        float S00 = 0.f, S01 = 0.f, S10 = 0.f, S11 = 0.f;
        const int NTOK = CTX + SEQ;
        constexpr int U = 4;
        unsigned kq[U], qq[U], vv[U]; float gg[U], be[U]; int rows[U];
        auto rowof = [&](int s) -> int { if (s < CTX) { const int t = dir ? CTX - 1 - s : s; return ML + b * CTX + t; } const int t2 = s - CTX; const int t = dir ? SEQ - 1 - t2 : t2; return b * SEQ + t; };
#define SC_LOAD(i, s) do { const int row_ = rowof(s); rows[i] = row_; const bf16_t* p_ = QP + (size_t)row_ * 3072 + h * 128; \
        qq[i] = *(const unsigned*)(p_ + 2 * lane); kq[i] = *(const unsigned*)(p_ + 1024 + 2 * lane); vv[i] = *(const unsigned*)(p_ + 2048 + 2 * ep); \
        gg[i] = gb[((size_t)dir * MT + row_) * 8 + h]; be[i] = bb[((size_t)dir * MT + row_) * 8 + h]; } while (0)
        for (int s0 = 0; s0 < NTOK; s0 += U) {
#pragma unroll
            for (int i = 0; i < U; ++i) SC_LOAD(i, s0 + i);
#pragma unroll
            for (int i = 0; i < U; ++i) {
                const float k0 = bflo(kq[i]), k1 = bfhi(kq[i]), q0 = bflo(qq[i]), q1 = bfhi(qq[i]), v0 = bflo(vv[i]), v1 = bfhi(vv[i]);
                const float eg = __expf(gg[i]), bt = be[i];
                float p0 = k0 * S00 + k1 * S10, p1 = k0 * S01 + k1 * S11;
                p0 = wave_sum(p0); p1 = wave_sum(p1);
                const float vn0 = bt * (v0 - eg * p0), vn1 = bt * (v1 - eg * p1);
                S00 = eg * S00 + k0 * vn0; S01 = eg * S01 + k0 * vn1; S10 = eg * S10 + k1 * vn0; S11 = eg * S11 + k1 * vn1;
                float o0 = q0 * S00 + q1 * S10, o1 = q0 * S01 + q1 * S11;
                o0 = wave_sum(o0); o1 = wave_sum(o1);
                if (lane == 0 && rows[i] < ML) *(unsigned*)(O + (size_t)rows[i] * 1024 + h * 128 + 2 * ep) = pk2(o0, o1);
            }
        }
#undef SC_LOAD
    }
}

DEVI bf16x8 ld_b128(LAS const unsigned char* p) { return *(LAS const bf16x8*)p; }
DEVI bf16x8 ld_2b64(LAS const unsigned char* p0, LAS const unsigned char* p1) { const u32x2 a = *(LAS const u32x2*)p0, b = *(LAS const u32x2*)p1; u32x4 w = {a.x, a.y, b.x, b.y}; return __builtin_bit_cast(bf16x8, w); }
DEVI bf16x8 pack_frag(const f32x4& lo, const f32x4& hi) { u32x4 w = {pk2(lo[0], lo[1]), pk2(lo[2], lo[3]), pk2(hi[0], hi[1]), pk2(hi[2], hi[3])}; return __builtin_bit_cast(bf16x8, w); }
#define MFMA16(A, B, C) __builtin_amdgcn_mfma_f32_16x16x32_bf16(A, B, C, 0, 0, 0)
DEVI void phase_dnchunk(const KA& a, LAS unsigned char* lds, int tid, int lane, int wave) {
    unsigned char* ws = a.ws();
    const bf16_t* QP = (const bf16_t*)(ws + WS_QKVP); const float* gb = (const float*)(ws + WS_G); const float* bb = (const float*)(ws + WS_BETA);
    bf16_t* TQ = (bf16_t*)(ws + WS_TQ); float* AV = (float*)(ws + WS_AVEC);
    constexpr int KL = 0, QL = 17408, KKF = 34816, QKF = 52224, VEC = 131072;
    const int fr = lane & 15, g = lane >> 4, d = wave >> 2, wq = wave & 3;
    LAS unsigned char* dbase = lds + d * 64512;
    LAS float* Gg = (LAS float*)(lds + VEC); LAS float* Bv = Gg + 128; LAS float* GC = Gg + 256;
    for (int item = blockIdx.x; item < 520 * 8; item += gridDim.x) {
        const int cidx = item >> 3, h = item & 7;
        const int row0 = cidx < 512 ? cidx * 64 : ML + (cidx - 512) * 64;
#pragma unroll
        for (int i = 0; i < 2; ++i) { const int c = tid + i * 512, r = c >> 4, ch = c & 15;
            const bf16_t* src = QP + (size_t)(row0 + r) * 3072 + h * 128 + ch * 8;
            *(LAS u32x4*)(lds + QL + r * 272 + ch * 16) = *(const u32x4*)src; *(LAS u32x4*)(lds + KL + r * 272 + ch * 16) = *(const u32x4*)(src + 1024); }
        if (tid < 128) { const int dd = tid >> 6, pos = tid & 63; Gg[tid] = gb[((size_t)dd * MT + row0 + pos) * 8 + h]; Bv[tid] = bb[((size_t)dd * MT + row0 + pos) * 8 + h]; }
        __syncthreads();
        if (wave < 2) {
            const int dd = wave, pos = dd ? 63 - lane : lane; float x = Gg[dd * 64 + pos];
#pragma unroll
            for (int o = 1; o < 64; o <<= 1) { const float y = __shfl_up(x, o); if (lane >= o) x += y; }
            const float total = __shfl(x, 63);
            GC[dd * 64 + pos] = x;
            float* av = AV + ((size_t)item * 2 + dd) * 256;
            av[pos] = __expf(x); av[64 + pos] = Bv[dd * 64 + pos]; av[128 + pos] = __expf(total - x); if (lane == 0) av[192] = __expf(total);
        }
        {
            const int src = d ? QL : KL;
            f32x4 acc[4] = {{0.f, 0.f, 0.f, 0.f}, {0.f, 0.f, 0.f, 0.f}, {0.f, 0.f, 0.f, 0.f}, {0.f, 0.f, 0.f, 0.f}};
#pragma unroll
            for (int s4 = 0; s4 < 4; ++s4) { const bf16x8 A = ld_b128(lds + src + (16 * wq + fr) * 272 + (32 * s4 + 8 * g) * 2);
#pragma unroll
                for (int jt = 0; jt < 4; ++jt) { const bf16x8 Bf = ld_b128(lds + KL + (16 * jt + fr) * 272 + (32 * s4 + 8 * g) * 2); acc[jt] = MFMA16(A, Bf, acc[jt]); } }
            LAS float* dst = (LAS float*)(lds + (d ? QKF : KKF));
#pragma unroll
            for (int jt = 0; jt < 4; ++jt)
#pragma unroll
                for (int r = 0; r < 4; ++r) dst[(16 * wq + 4 * g + r) * 68 + 16 * jt + fr] = acc[jt][r];
        }
        __syncthreads();
        f32x4 P[4], qd[4];
        {
            const LAS float* kkf = (const LAS float*)(lds + KKF); const LAS float* qkf = (const LAS float*)(lds + QKF);
            float gci[4], bei[4];
#pragma unroll
            for (int r = 0; r < 4; ++r) { gci[r] = GC[d * 64 + 16 * wq + 4 * g + r]; bei[r] = Bv[d * 64 + 16 * wq + 4 * g + r]; }
#pragma unroll
            for (int jt = 0; jt < 4; ++jt) { const int j = 16 * jt + fr; const float gcj = GC[d * 64 + j];
#pragma unroll
                for (int r = 0; r < 4; ++r) { const int i = 16 * wq + 4 * g + r; const bool incl = d ? (i <= j) : (i >= j);
                    const float e = incl ? __expf(gci[r] - gcj) : 0.f;
                    qd[jt][r] = qkf[i * 68 + j] * e; P[jt][r] = (i != j) ? -bei[r] * kkf[i * 68 + j] * e : 0.f; } }
        }
        __syncthreads();
        {
#pragma unroll
            for (int jt = 0; jt < 4; ++jt) {
#pragma unroll
                for (int r = 0; r < 4; ++r) { const int i = 16 * wq + 4 * g + r, j = 16 * jt + fr;
                    *(LAS unsigned short*)(dbase + 0 + i * 144 + j * 2) = (unsigned short)f2bf(P[jt][r]);
                    *(LAS unsigned short*)(dbase + 36864 + 9216 + i * 144 + j * 2) = (unsigned short)f2bf(P[jt][r]);
                    *(LAS unsigned short*)(dbase + 55296 + i * 144 + j * 2) = (unsigned short)f2bf(qd[jt][r]); }
                u32x2 w = {pk2(P[jt][0], P[jt][1]), pk2(P[jt][2], P[jt][3])};
                *(LAS u32x2*)(dbase + 18432 + (16 * jt + fr) * 144 + (16 * wq + 4 * g) * 2) = w; }
        }
        __syncthreads();
        int cur = 0;
#pragma unroll 1
        for (int it = 0; it < 5; ++it) {
            LAS unsigned char* NRc = dbase + cur * 9216; LAS unsigned char* NTc = dbase + 18432 + cur * 9216;
            LAS unsigned char* NRn = dbase + (cur ^ 1) * 9216; LAS unsigned char* NTn = dbase + 18432 + (cur ^ 1) * 9216;
            LAS unsigned char* PRo = dbase + 36864 + ((it + 1) & 1) * 9216; LAS unsigned char* PRn = dbase + 36864 + (it & 1) * 9216;
            f32x4 n2[4] = {{0.f, 0.f, 0.f, 0.f}, {0.f, 0.f, 0.f, 0.f}, {0.f, 0.f, 0.f, 0.f}, {0.f, 0.f, 0.f, 0.f}};
#pragma unroll
            for (int s2 = 0; s2 < 2; ++s2) { const bf16x8 A = ld_b128(NRc + (16 * wq + fr) * 144 + (32 * s2 + 8 * g) * 2);
#pragma unroll
                for (int jt = 0; jt < 4; ++jt) { const bf16x8 Bf = ld_b128(NTc + (16 * jt + fr) * 144 + (32 * s2 + 8 * g) * 2); n2[jt] = MFMA16(A, Bf, n2[jt]); } }
#pragma unroll
            for (int jt = 0; jt < 4; ++jt) {
#pragma unroll
                for (int r = 0; r < 4; ++r) *(LAS unsigned short*)(NRn + (16 * wq + 4 * g + r) * 144 + (16 * jt + fr) * 2) = (unsigned short)f2bf(n2[jt][r]);
                u32x2 w = {pk2(n2[jt][0], n2[jt][1]), pk2(n2[jt][2], n2[jt][3])};
                *(LAS u32x2*)(NTn + (16 * jt + fr) * 144 + (16 * wq + 4 * g) * 2) = w;
                P[jt] += n2[jt]; }
            __syncthreads();
#pragma unroll
            for (int s2 = 0; s2 < 2; ++s2) { const bf16x8 A = ld_b128(PRo + (16 * wq + fr) * 144 + (32 * s2 + 8 * g) * 2);
#pragma unroll
                for (int jt = 0; jt < 4; ++jt) { const bf16x8 Bf = ld_b128(NTn + (16 * jt + fr) * 144 + (32 * s2 + 8 * g) * 2); P[jt] = MFMA16(A, Bf, P[jt]); } }
#pragma unroll
            for (int jt = 0; jt < 4; ++jt)
#pragma unroll
                for (int r = 0; r < 4; ++r) *(LAS unsigned short*)(PRn + (16 * wq + 4 * g + r) * 144 + (16 * jt + fr) * 2) = (unsigned short)f2bf(P[jt][r]);
            cur ^= 1;
        }
        __syncthreads();
        {
            bf16_t* dst = TQ + ((size_t)item * 2 + d) * 8192; const int t2 = tid & 255;
#pragma unroll
            for (int k = 0; k < 4; ++k) { const int c = t2 + 256 * k, mat = c >> 9, r = (c >> 3) & 63, ch = c & 7;
                const u32x4 v = *(LAS const u32x4*)(dbase + (mat ? 55296 : 36864) + r * 144 + ch * 16);
                *(u32x4*)(dst + mat * 4096 + r * 64 + ch * 8) = v; }
        }
        __syncthreads();
    }
}

DEVI void phase_dnchunk2(const KA& a, LAS unsigned char* lds, int tid, int lane, int wave) {
    unsigned char* ws = a.ws();
    const bf16_t* QP = (const bf16_t*)(ws + WS_QKVP); const float* gb = (const float*)(ws + WS_G); const float* bb = (const float*)(ws + WS_BETA);
    bf16_t* TQ = (bf16_t*)(ws + WS_TQ); float* AV = (float*)(ws + WS_AVEC);
    const int fr = lane & 15, g = lane >> 4, wi = wave >> 1, dir = wave & 1;
    LAS unsigned char* kl = lds + wi * 32768;
    LAS float* vec = (LAS float*)(lds + 131072 + wave * 1024);
    for (int grp = blockIdx.x; grp < 1040; grp += gridDim.x) {
        int tl = tid; asm volatile("" : "+v"(tl));
#pragma unroll
        for (int i = 0; i < 16; ++i) { const int c = tl + 512 * i, it = c >> 11, qk = (c >> 10) & 1, r = (c >> 4) & 63, ch = c & 15;
            const int item_ = grp * 4 + it, ci_ = item_ >> 3, h_ = item_ & 7; const int row0_ = ci_ < 512 ? ci_ * 64 : ML + (ci_ - 512) * 64;
            const u32x4 x = *(const u32x4*)(QP + (size_t)(row0_ + r) * 3072 + qk * 1024 + h_ * 128 + ch * 8);
            *(LAS u32x4*)(lds + it * 32768 + (qk ? 0 : 16384) + r * 256 + ((ch ^ (r & 15)) << 4)) = x; }
        const int item = grp * 4 + wi, cidx = item >> 3, h = item & 7;
        const int row0 = cidx < 512 ? cidx * 64 : ML + (cidx - 512) * 64;
        {
            const int pos = dir ? 63 - lane : lane;
            float x = gb[((size_t)dir * MT + row0 + pos) * 8 + h]; const float be = bb[((size_t)dir * MT + row0 + pos) * 8 + h];
#pragma unroll
            for (int o = 1; o < 64; o <<= 1) { const float y = __shfl_up(x, o); if (lane >= o) x += y; }
            const float total = __shfl(x, 63);
            vec[pos] = x; vec[64 + pos] = be;
            float* av = AV + ((size_t)item * 2 + dir) * 256;
            av[pos] = __expf(x); av[64 + pos] = be; av[128 + pos] = __expf(total - x); if (lane == 0) av[192] = __expf(total);
        }
        __syncthreads();
        bf16_t* tq = TQ + ((size_t)item * 2 + dir) * 8192;
        bf16x8 KF[4][4];
#pragma unroll
        for (int t = 0; t < 4; ++t)
#pragma unroll
            for (int ks = 0; ks < 4; ++ks) KF[t][ks] = ld_b128(kl + (16 * t + fr) * 256 + (((4 * ks + g) ^ fr) << 4));
        {
            bf16x8 QF[4][4];
#pragma unroll
            for (int t = 0; t < 4; ++t)
#pragma unroll
                for (int ks = 0; ks < 4; ++ks) QF[t][ks] = ld_b128(kl + 16384 + (16 * t + fr) * 256 + (((4 * ks + g) ^ fr) << 4));
#pragma unroll
            for (int rt = 0; rt < 4; ++rt)
#pragma unroll
                for (int ct = 0; ct < 4; ++ct) { f32x4 acc = {0.f, 0.f, 0.f, 0.f};
#pragma unroll
                    for (int ks = 0; ks < 4; ++ks) acc = MFMA16(KF[rt][ks], QF[ct][ks], acc);
                    float o[4]; const f32x4 gxv = *(const LAS f32x4*)(vec + 16 * rt + 4 * g); const float gyv = vec[16 * ct + fr];
#pragma unroll
                    for (int r = 0; r < 4; ++r) { const int x = 16 * rt + 4 * g + r, y = 16 * ct + fr; const bool inc = dir ? (y <= x) : (y >= x);
                        o[r] = inc ? acc[r] * __expf(gyv - gxv[r]) : 0.f; }
                    const u32x2 w = {pk2(o[0], o[1]), pk2(o[2], o[3])};
                    *(u32x2*)(tq + 4096 + (16 * ct + fr) * 64 + 16 * rt + 4 * g) = w; }
        }
        f32x4 PT[4][4]; bf16x8 XD[2][4], XT[2][4];
#pragma unroll
        for (int ct = 0; ct < 4; ++ct)
#pragma unroll
            for (int s2 = 0; s2 < 2; ++s2) { f32x4 nd[2], nt[2];
#pragma unroll
                for (int u = 0; u < 2; ++u) { const int rt = 2 * s2 + u; f32x4 acc = {0.f, 0.f, 0.f, 0.f};
#pragma unroll
                    for (int ks = 0; ks < 4; ++ks) acc = MFMA16(KF[rt][ks], KF[ct][ks], acc);
                    const f32x4 gxv = *(const LAS f32x4*)(vec + 16 * rt + 4 * g), bxv = *(const LAS f32x4*)(vec + 64 + 16 * rt + 4 * g); const float gyv = vec[16 * ct + fr], byv = vec[64 + 16 * ct + fr];
#pragma unroll
                    for (int r = 0; r < 4; ++r) { const int x = 16 * rt + 4 * g + r, y = 16 * ct + fr;
                        const bool cd = dir ? (x < y) : (x > y), ct_ = dir ? (y < x) : (y > x);
                        nd[u][r] = cd ? -bxv[r] * acc[r] * __expf(gxv[r] - gyv) : 0.f;
                        nt[u][r] = ct_ ? -byv * acc[r] * __expf(gyv - gxv[r]) : 0.f; }
                    PT[rt][ct] = nt[u]; }
                XD[s2][ct] = pack_frag(nd[0], nd[1]); XT[s2][ct] = pack_frag(nt[0], nt[1]); }
#pragma unroll 1
        for (int it = 0; it < 5; ++it) {
            bf16x8 XD2[2][4], XT2[2][4];
#pragma unroll
            for (int ct = 0; ct < 4; ++ct)
#pragma unroll
                for (int s2 = 0; s2 < 2; ++s2) { f32x4 t2[2];
#pragma unroll
                    for (int u = 0; u < 2; ++u) { const int rt = 2 * s2 + u; f32x4 acc = {0.f, 0.f, 0.f, 0.f};
                        acc = MFMA16(XT[0][rt], XD[0][ct], acc); acc = MFMA16(XT[1][rt], XD[1][ct], acc); t2[u] = acc; }
                    XD2[s2][ct] = pack_frag(t2[0], t2[1]); }
#pragma unroll
            for (int ct = 0; ct < 4; ++ct) { const bf16x8 pb0 = pack_frag(PT[0][ct], PT[1][ct]), pb1 = pack_frag(PT[2][ct], PT[3][ct]);
#pragma unroll
                for (int rt = 0; rt < 4; ++rt) { f32x4 acc = PT[rt][ct]; acc = MFMA16(XD2[0][rt], pb0, acc); acc = MFMA16(XD2[1][rt], pb1, acc); PT[rt][ct] = acc; } }
#pragma unroll
            for (int ct = 0; ct < 4; ++ct)
#pragma unroll
                for (int s2 = 0; s2 < 2; ++s2) { f32x4 t2[2];
#pragma unroll
                    for (int u = 0; u < 2; ++u) { const int rt = 2 * s2 + u; f32x4 acc = {0.f, 0.f, 0.f, 0.f};
                        acc = MFMA16(XD[0][rt], XT[0][ct], acc); acc = MFMA16(XD[1][rt], XT[1][ct], acc); t2[u] = acc; PT[rt][ct] += acc; }
                    XT2[s2][ct] = pack_frag(t2[0], t2[1]); }
#pragma unroll
            for (int s2 = 0; s2 < 2; ++s2)
#pragma unroll
                for (int ct = 0; ct < 4; ++ct) { XD[s2][ct] = XD2[s2][ct]; XT[s2][ct] = XT2[s2][ct]; }
        }
#pragma unroll
        for (int rt = 0; rt < 4; ++rt)
#pragma unroll
            for (int ct = 0; ct < 4; ++ct) { const u32x2 w = {pk2(PT[rt][ct][0], PT[rt][ct][1]), pk2(PT[rt][ct][2], PT[rt][ct][3])};
                *(u32x2*)(tq + (16 * ct + fr) * 64 + 16 * rt + 4 * g) = w; }
        __syncthreads();
    }
}

DEVI void phase_dnscan2(const KA& a, LAS unsigned char* lds, int tid, int lane, int wave, unsigned long long& pr_extra) {
    const int v = blockIdx.x;
    unsigned char* ws = a.ws();
    const bf16_t* QP = (const bf16_t*)(ws + WS_QKVP); const bf16_t* TQ = (const bf16_t*)(ws + WS_TQ); const float* AV = (const float*)(ws + WS_AVEC);
    unsigned* prog = (unsigned*)(ws + CTL_PROG);
    constexpr int NSTEP = 260;
    int vrole = v;
#if MK_ONE_LAUNCH
    {
        unsigned* bar_ = (unsigned*)(ws + WS_CTL); unsigned* xr_ = (unsigned*)(ws + CTL_XRANK);
        bool dyn = gridDim.x == 256;
#pragma unroll
        for (int j = 0; j < 16; ++j) { const unsigned c_ = __hip_atomic_load(&bar_[256 + 64 * j], __ATOMIC_RELAXED, __HIP_MEMORY_SCOPE_AGENT); dyn = dyn && (c_ == (j < 8 ? 32u : 0u)); }
        if (PROBE_SUB == 7 && !dyn) pr_extra += 50000ull;
        if (dyn) {
            const unsigned xcc = (unsigned)__builtin_amdgcn_s_getreg((3 << 11) | 20) & 0xFu;
            LAS unsigned* bw = (LAS unsigned*)(lds + 147200);
            if (tid == 0) *bw = __hip_atomic_fetch_add(&xr_[xcc * 64], 1u, __ATOMIC_RELAXED, __HIP_MEMORY_SCOPE_AGENT);
            __syncthreads();
            const unsigned rank = *bw & 31u;
            vrole = rank < 16u ? (int)(xcc + 8u * (rank >> 2) + 32u * (rank & 3u)) : (int)(128u + xcc + 8u * ((rank - 16u) >> 2) + 32u * ((rank - 16u) & 3u));
            __syncthreads();
        }
    }
#endif
    if (vrole < 128) {
    const int chain = (vrole & 7) + 8 * ((vrole >> 3) & 3), qt = vrole >> 5, dir = chain >> 4, b = (chain >> 3) & 1, h = chain & 7;
    bf16_t* O = (bf16_t*)a.out() + (size_t)dir * ML * 1024;
    constexpr int KL = 0, QL = 16384, TL = 32768, DL = 40960, VL = 49152, AL = 53248, BUFB = 54272, OT = 2 * BUFB, SBX = OT + 8192, XBX = SBX + 16384, FLG = XBX + 4096;
    const int fr0 = lane & 15, g0 = lane >> 4, ltid = tid - 256;
    auto step_cidx = [&](int s) -> int { if (s < 4) return 512 + b * 4 + (dir ? 3 - s : s); const int c = s - 4; return b * 256 + (dir ? 255 - c : c); };
    struct LSet { u32x4 q[4], k[4], t[2], d[2], v, av; };
#define LD_ISSUE(R, s_) do { const int cidx_ = step_cidx(s_); const int row0_ = cidx_ < 512 ? cidx_ * 64 : ML + (cidx_ - 512) * 64; \
        const bf16_t* tqb_ = TQ + ((size_t)(cidx_ * 8 + h) * 2 + dir) * 8192; const float* avb_ = AV + ((size_t)(cidx_ * 8 + h) * 2 + dir) * 256; \
        int lt_ = ltid; asm volatile("" : "+v"(lt_)); \
        const bf16_t* pq_ = QP + (size_t)(row0_ + (lt_ >> 4)) * 3072 + h * 128 + (lt_ & 15) * 8; \
        const bf16_t* pt_ = tqb_ + (lt_ >> 3) * 64 + (lt_ & 7) * 8; \
        _Pragma("unroll") for (int i = 0; i < 4; ++i) { R.q[i] = *(const u32x4*)(pq_ + (size_t)i * 16 * 3072); R.k[i] = *(const u32x4*)(pq_ + (size_t)i * 16 * 3072 + 1024); } \
        _Pragma("unroll") for (int i = 0; i < 2; ++i) { R.t[i] = *(const u32x4*)(pt_ + i * 32 * 64); R.d[i] = *(const u32x4*)(pt_ + 4096 + i * 32 * 64); } \
        R.v = *(const u32x4*)(QP + (size_t)(row0_ + (lt_ >> 2)) * 3072 + 2048 + h * 128 + qt * 32 + (lt_ & 3) * 8); \
        R.av = *(const u32x4*)(avb_ + (lt_ & 63) * 4); } while (0)
#define LD_WRITE(R, bo_) do { int lt_ = ltid; asm volatile("" : "+v"(lt_)); LAS unsigned char* B_ = lds + (bo_); \
        const int chq_ = lt_ & 15, cht_ = lt_ & 7; \
        _Pragma("unroll") for (int i = 0; i < 4; ++i) { const int r = (lt_ >> 4) + 16 * i; const int o_ = r * 256 + ((chq_ ^ (4 * (r & 3) + ((r >> 3) & 3))) << 4); \
            *(LAS u32x4*)(B_ + QL + o_) = R.q[i]; *(LAS u32x4*)(B_ + KL + o_) = R.k[i]; } \
        _Pragma("unroll") for (int i = 0; i < 2; ++i) { const int r = (lt_ >> 3) + 32 * i; const int o_ = r * 128 + ((cht_ ^ (2 * ((r >> 3) & 3) + ((r >> 1) & 1))) << 4); \
            *(LAS u32x4*)(B_ + TL + o_) = R.t[i]; *(LAS u32x4*)(B_ + DL + o_) = R.d[i]; } \
        { const int r = lt_ >> 2; *(LAS u32x4*)(B_ + VL + r * 64 + (((lt_ & 3) ^ (2 * ((r >> 3) & 1))) << 4)) = R.v; } \
        if (lt_ < 64) *(LAS u32x4*)(B_ + AL + lt_ * 16) = R.av; } while (0)
#define OT_OUT(s_) do { const int cidx_ = step_cidx(s_); const int row0_ = cidx_ * 64; LAS const unsigned char* ot_ = lds + OT + ((s_) & 1) * 4096; \
        int lt_ = ltid; asm volatile("" : "+v"(lt_)); \
        { const int r = lt_ >> 2, ch = lt_ & 3; \
            *(u32x4*)(O + (size_t)(row0_ + r) * 1024 + h * 128 + qt * 32 + ch * 8) = *(LAS const u32x4*)(ot_ + r * 64 + ((ch ^ (2 * ((r >> 3) & 1))) << 4)); } } while (0)
#define STEP_BAR(wsel) do { const unsigned long long tb_ = PROBE_SUB ? __builtin_amdgcn_s_memrealtime() : 0ull; \
        asm volatile("s_waitcnt lgkmcnt(0)" ::: "memory"); __builtin_amdgcn_s_barrier(); asm volatile("" ::: "memory"); \
        if ((PROBE_SUB == 1 && wave == 0 && (wsel) == 0) || (PROBE_SUB == 2 && wave == 4 && (wsel) == 1) || (PROBE_SUB == 3 && wave == 2 && (wsel) == 3)) pr_extra += __builtin_amdgcn_s_memrealtime() - tb_; } while (0)
#define LOAD_STEP(s, RW) do { STEP_BAR(1); \
            if (qt == 0 && ltid == 0) __hip_atomic_store(prog + chain * 64, (unsigned)((s) + 1), __ATOMIC_RELAXED, __HIP_MEMORY_SCOPE_AGENT); \
            { const unsigned long long tw_ = (PROBE_SUB == 5) ? __builtin_amdgcn_s_memrealtime() : 0ull; if ((s) + 1 < NSTEP) LD_WRITE(RW, (((s) + 1) & 1) * BUFB); \
              if (PROBE_SUB == 5 && wave == 4) { asm volatile("s_waitcnt lgkmcnt(0)" ::: "memory"); pr_extra += __builtin_amdgcn_s_memrealtime() - tw_; } } \
            if ((s) + 4 < NSTEP) LD_ISSUE(RW, (s) + 4); \
            if ((s) >= 5) OT_OUT((s) - 1); } while (0)
#define SBAR_() do {} while (0)
#define ROWK(pt) ((32 * ((pt) >> 1) + 4 * ((pt) & 1) + rowl) * 256)
#define ROWT(pt) ((32 * ((pt) >> 1) + 4 * ((pt) & 1) + rowl) * 128)
#define P0(pt) (32 * ((pt) >> 1) + 8 * g + 4 * ((pt) & 1))
#define LDK8(dst, base, pa) do { _Pragma("unroll") for (int s4 = 0; s4 < 4; ++s4) { dst[s4] = ld_b128(B + (base) + ROWK(pa) + (((4 * s4 + g) ^ fk) << 4)); dst[4 + s4] = ld_b128(B + (base) + ROWK((pa) + 1) + (((4 * s4 + g) ^ fk) << 4)); } } while (0)
#define LDT8(dst, base) do { _Pragma("unroll") for (int pt = 0; pt < 4; ++pt) { dst[2 * pt] = ld_b128(B + (base) + ROWT(pt) + ((g ^ ft) << 4)); dst[2 * pt + 1] = ld_b128(B + (base) + ROWT(pt) + (((4 + g) ^ ft) << 4)); } } while (0)
#define MM8(acc, fa, pa) do { _Pragma("unroll") for (int s4 = 0; s4 < 4; ++s4) { acc[pa] = MFMA16(fa[s4], Sb[s4], acc[pa]); acc[(pa) + 1] = MFMA16(fa[4 + s4], Sb[s4], acc[(pa) + 1]); } } while (0)
    if (wave >= 4) {
        LSet R0, R1, R2;
        LD_ISSUE(R0, 0); LD_WRITE(R0, 0); LD_ISSUE(R1, 1); LD_ISSUE(R2, 2); LD_ISSUE(R0, 3);
#pragma unroll 1
        for (int s0 = 0; s0 < NSTEP; s0 += 3) {
            LOAD_STEP(s0, R1);
            if (s0 + 1 < NSTEP) LOAD_STEP(s0 + 1, R2);
            if (s0 + 2 < NSTEP) LOAD_STEP(s0 + 2, R0);
        }
        STEP_BAR(2);
        OT_OUT(NSTEP - 1);
    } else if (wave < 2) {
        __builtin_amdgcn_s_setprio(3);
        f32x4 S[8];
#pragma unroll
        for (int i = 0; i < 8; ++i) S[i] = (f32x4){0.f, 0.f, 0.f, 0.f};
        bf16x8 Sb[4];
#pragma unroll
        for (int s4 = 0; s4 < 4; ++s4) { Sb[s4] = (bf16x8){0, 0, 0, 0, 0, 0, 0, 0}; *(LAS bf16x8*)(lds + SBX + wave * 4096 + s4 * 1024 + lane * 16) = Sb[s4]; }
        if (lane == 0) *(LAS unsigned*)(lds + FLG + wave * 4) = 0u;
#pragma unroll 1
        for (int s = 0; s < NSTEP; ++s) {
            STEP_BAR(0);
            int fr = fr0, g = g0; asm volatile("" : "+v"(fr), "+v"(g));
            LAS const unsigned char* B = lds + (s & 1) * BUFB;
            const LAS float* avl = (const LAS float*)(B + AL);
            const int rowl = 8 * (fr >> 2) + (fr & 3);
            const int fk = 4 * (fr & 3) + (fr >> 2), ft = 2 * (fr >> 2) + ((fr >> 1) & 1);
            const int vcol = ((((2 * wave + (fr >> 3)) ^ (2 * (g & 1))) << 4) + (fr & 7) * 2);
            const int trq = fr >> 2, trp = fr & 3;
            LAS unsigned char* kp0 = (LAS unsigned char*)(B + KL + (8 * g + trq) * 256);
            const int fkt = 4 * trq + g;
#define KT_LOAD(dst, d0) do { _Pragma("unroll") for (int j = 0; j < 4; ++j) { const int dt_ = (d0) + j; const int co = (((4 * (dt_ >> 1) + trp) ^ fkt) << 4) + 8 * (dt_ & 1); \
                const s16x4 a0 = __builtin_bit_cast(s16x4, __builtin_amdgcn_ds_read_tr16_b64_v4i16((LAS s16x4*)(kp0 + co))), a1 = __builtin_bit_cast(s16x4, __builtin_amdgcn_ds_read_tr16_b64_v4i16((LAS s16x4*)(kp0 + co + 4 * 256))); \
                const s16x4 a2 = __builtin_bit_cast(s16x4, __builtin_amdgcn_ds_read_tr16_b64_v4i16((LAS s16x4*)(kp0 + co + 32 * 256))), a3 = __builtin_bit_cast(s16x4, __builtin_amdgcn_ds_read_tr16_b64_v4i16((LAS s16x4*)(kp0 + co + 36 * 256))); \
                dst[2 * j] = (bf16x8){a0[0], a0[1], a0[2], a0[3], a1[0], a1[1], a1[2], a1[3]}; dst[2 * j + 1] = (bf16x8){a2[0], a2[1], a2[2], a2[3], a3[0], a3[1], a3[2], a3[3]}; } } while (0)
            bf16x8 fA[8], fB[8], fC[8];
            f32x4 avp[4], bvp[4]; unsigned short vraw[4][4];
            const unsigned long long t6_ = (PROBE_SUB == 6) ? __builtin_amdgcn_s_memrealtime() : 0ull;
            LDK8(fA, KL, 0); LDK8(fB, KL, 2);
            if (PROBE_SUB == 6 && wave == 0) { asm volatile("s_waitcnt lgkmcnt(0)" ::: "memory"); pr_extra += __builtin_amdgcn_s_memrealtime() - t6_; }
#pragma unroll
            for (int pt = 0; pt < 4; ++pt) { avp[pt] = *(const LAS f32x4*)(avl + P0(pt)); bvp[pt] = *(const LAS f32x4*)(avl + 64 + P0(pt));
#pragma unroll
                for (int r = 0; r < 4; ++r) vraw[pt][r] = *(const LAS unsigned short*)(B + VL + (P0(pt) + r) * 64 + vcol); }
            f32x4 Z[4], X[4];
#pragma unroll
            for (int pt = 0; pt < 4; ++pt) Z[pt] = (f32x4){0.f, 0.f, 0.f, 0.f};
            SBAR_();
            LDT8(fC, TL); SBAR_(); MM8(Z, fA, 0); SBAR_();
            KT_LOAD(fA, 0); SBAR_(); MM8(Z, fB, 2); SBAR_();
#pragma unroll
            for (int pt = 0; pt < 4; ++pt)
#pragma unroll
                for (int r = 0; r < 4; ++r) Z[pt][r] = bvp[pt][r] * (bf2f(vraw[pt][r]) - avp[pt][r] * Z[pt][r]);
            KT_LOAD(fB, 4); SBAR_();
            { const bf16x8 Zb0 = pack_frag(Z[0], Z[1]), Zb1 = pack_frag(Z[2], Z[3]);
#pragma unroll
              for (int pt = 0; pt < 4; ++pt) { X[pt] = MFMA16(fC[2 * pt], Zb0, Z[pt]); X[pt] = MFMA16(fC[2 * pt + 1], Zb1, X[pt]); } }
            SBAR_();
            const float egl = avl[192];
            bf16x8 Xc0, Xc1;
            { const bf16x8 Xb0 = pack_frag(X[0], X[1]), Xb1 = pack_frag(X[2], X[3]);
              *(LAS bf16x8*)(lds + XBX + wave * 2048 + lane * 16) = Xb0; *(LAS bf16x8*)(lds + XBX + wave * 2048 + 1024 + lane * 16) = Xb1;
              if (lane == 0) *(LAS volatile unsigned*)(lds + FLG + wave * 4) = (unsigned)(s + 1);
              f32x4 cx[4];
#pragma unroll
              for (int pt = 0; pt < 4; ++pt) cx[pt] = X[pt] * *(const LAS f32x4*)(avl + 128 + P0(pt));
              Xc0 = pack_frag(cx[0], cx[1]); Xc1 = pack_frag(cx[2], cx[3]); }
            SBAR_();
#pragma unroll
            for (int j = 0; j < 4; ++j) { f32x4 sn = S[j] * egl; sn = MFMA16(fA[2 * j], Xc0, sn); S[j] = MFMA16(fA[2 * j + 1], Xc1, sn); }
            SBAR_();
#pragma unroll
            for (int j = 0; j < 4; ++j) { f32x4 sn = S[4 + j] * egl; sn = MFMA16(fB[2 * j], Xc0, sn); S[4 + j] = MFMA16(fB[2 * j + 1], Xc1, sn); }
#pragma unroll
            for (int s4 = 0; s4 < 4; ++s4) { Sb[s4] = pack_frag(S[2 * s4], S[2 * s4 + 1]); *(LAS bf16x8*)(lds + SBX + ((s + 1) & 1) * 8192 + wave * 4096 + s4 * 1024 + lane * 16) = Sb[s4]; }
#undef KT_LOAD
        }
        STEP_BAR(2);
        __builtin_amdgcn_s_setprio(0);
    } else {
        const int sl = wave - 2;
#pragma unroll 1
        for (int s = 0; s < NSTEP; ++s) {
            STEP_BAR(3);
            if (s >= 4) {
            int fr = fr0, g = g0; asm volatile("" : "+v"(fr), "+v"(g));
            LAS const unsigned char* B = lds + (s & 1) * BUFB;
            const LAS float* avl = (const LAS float*)(B + AL);
            const int rowl = 8 * (fr >> 2) + (fr & 3);
            const int fk = 4 * (fr & 3) + (fr >> 2), ft = 2 * (fr >> 2) + ((fr >> 1) & 1);
            const int vcol = ((((2 * sl + (fr >> 3)) ^ (2 * (g & 1))) << 4) + (fr & 7) * 2);
            bf16x8 fA[8], fB[8], fC[8], Sb[4];
            LDK8(fA, QL, 0); LDK8(fB, QL, 2);
#pragma unroll
            for (int s4 = 0; s4 < 4; ++s4) Sb[s4] = *(const LAS bf16x8*)(lds + SBX + (s & 1) * 8192 + sl * 4096 + s4 * 1024 + lane * 16);
            f32x4 OQ[4], avp[4];
#pragma unroll
            for (int pt = 0; pt < 4; ++pt) { OQ[pt] = (f32x4){0.f, 0.f, 0.f, 0.f}; avp[pt] = *(const LAS f32x4*)(avl + P0(pt)); }
            SBAR_();
            LDT8(fC, DL); SBAR_(); MM8(OQ, fA, 0); SBAR_(); MM8(OQ, fB, 2); SBAR_();
            { unsigned spins = 0;
              while ((unsigned)__builtin_amdgcn_readfirstlane((int)*(LAS volatile unsigned*)(lds + FLG + sl * 4)) != (unsigned)(s + 1)) { __builtin_amdgcn_s_sleep(1); if (++spins > (1u << 22)) break; } }
            asm volatile("" ::: "memory");
            const bf16x8 Xb0 = *(const LAS bf16x8*)(lds + XBX + sl * 2048 + lane * 16), Xb1 = *(const LAS bf16x8*)(lds + XBX + sl * 2048 + 1024 + lane * 16);
#pragma unroll
            for (int pt = 0; pt < 4; ++pt) { f32x4 o2 = OQ[pt] * avp[pt]; o2 = MFMA16(fC[2 * pt], Xb0, o2); OQ[pt] = MFMA16(fC[2 * pt + 1], Xb1, o2); }
            { LAS unsigned char* ot = lds + OT + (s & 1) * 4096;
#pragma unroll
              for (int pt = 0; pt < 4; ++pt)
#pragma unroll
                  for (int r = 0; r < 4; ++r) *(LAS unsigned short*)(ot + (P0(pt) + r) * 64 + vcol) = (unsigned short)f2bf(OQ[pt][r]); }
            }
        }
        STEP_BAR(2);
    }
#undef LDK8
#undef LDT8
#undef MM8
#undef ROWK
#undef ROWT
#undef P0
#undef SBAR_
#undef LOAD_STEP
#undef STEP_BAR
#undef LD_ISSUE
#undef LD_WRITE
#undef OT_OUT
    } else {
        const int vp = vrole - 128, chain = (vp & 7) + 8 * ((vp >> 3) & 3), role = vp >> 5, dir = chain >> 4, b = (chain >> 3) & 1, h = chain & 7;
        const int nteam = (((int)gridDim.x - 128) >> 5) * 8;
        constexpr int PFD2 = 6;
        if (role * 8 + wave < nteam) {
#pragma unroll 1
        for (int st = role * 8 + wave; st < NSTEP; st += nteam) {
            unsigned spins = 0;
            while ((int)__builtin_amdgcn_readfirstlane((int)__hip_atomic_load(prog + chain * 64, __ATOMIC_RELAXED, __HIP_MEMORY_SCOPE_AGENT)) + PFD2 < st) { __builtin_amdgcn_s_sleep(8); if (++spins > (1u << 20)) break; }
            int cidx; if (st < 4) cidx = 512 + b * 4 + (dir ? 3 - st : st); else { const int c = st - 4; cidx = b * 256 + (dir ? 255 - c : c); }
            const int row0 = cidx < 512 ? cidx * 64 : ML + (cidx - 512) * 64;
            const char* tqb = (const char*)(TQ + ((size_t)(cidx * 8 + h) * 2 + dir) * 8192); const char* avb = (const char*)(AV + ((size_t)(cidx * 8 + h) * 2 + dir) * 256);
            unsigned acc = 0;
#pragma unroll
            for (int j = 0; j < 9; ++j) { const int L = j * 64 + lane; const char* p_;
                if (L < 384) { const int rw = L / 6, part = L - rw * 6; p_ = (const char*)(QP + (size_t)(row0 + rw) * 3072 + h * 128) + (part >> 1) * 2048 + (part & 1) * 128; }
                else if (L < 512) p_ = tqb + (L - 384) * 128; else p_ = avb + ((L - 512) & 7) * 128;
                acc ^= *(const unsigned*)p_; }
            asm volatile("" :: "v"(acc));
        }
        }
    }
}

DEVI void phase_prep2(const KA& a, int lane, int wave) {
    unsigned char* ws = a.ws();
    bf16_t* KAT = (bf16_t*)(ws + WS_KAT); const float* rope = (const float*)(ws + SM_ROPE); const float* knw = a.in(14);
    const int gw = blockIdx.x * 8 + wave, NGW = gridDim.x * 8;
    for (int row = gw; row < MT; row += NGW) {
        bf16_t* p = (row < ML ? KAT + (size_t)row * 256 : (bf16_t*)(ws + WS_CTXK) + (size_t)(row - ML) * 256) + lane * 4;
        const u32x2 w = *(const u32x2*)p;
        float x[4] = {bflo(w.x), bfhi(w.x), bflo(w.y), bfhi(w.y)};
        float ss = (x[0] * x[0] + x[1] * x[1]) + (x[2] * x[2] + x[3] * x[3]);
        ss += __shfl_xor(ss, 1); ss += __shfl_xor(ss, 2); ss += __shfl_xor(ss, 4); ss += __shfl_xor(ss, 8); ss += __shfl_xor(ss, 16);
        const float rs = rsqrtf(ss * (1.f / 128.f) + EPS);
        const int d = (lane & 31) * 4;
        const f32x4 nw = *(const f32x4*)(knw + d);
#pragma unroll
        for (int i = 0; i < 4; ++i) x[i] = x[i] * rs * nw[i];
        float pr[4];
#pragma unroll
        for (int i = 0; i < 4; ++i) pr[i] = __shfl_xor(x[i], 8);
        if (row < ML) {
            const int t = row & (SEQ - 1), lg = (lane & 31) >> 3, fi = (lane & 7) * 4;
            const float* ct = lg < 2 ? rope + (t >> 6) * 32 + fi : rope + 16384 + (t & 63) * 32 + fi;
            const float* st = lg < 2 ? ct + 8192 : ct + 2048;
            const f32x4 c = *(const f32x4*)ct, s = *(const f32x4*)st;
            const float sg = (lg & 1) ? 1.f : -1.f;
#pragma unroll
            for (int i = 0; i < 4; ++i) x[i] = x[i] * c[i] + sg * pr[i] * s[i];
        }
        u32x2 o; o.x = pk2(x[0], x[1]); o.y = pk2(x[2], x[3]);
        *(u32x2*)p = o;
    }
    const bf16_t* Of = (const bf16_t*)a.out(); const bf16_t* Ob = Of + (size_t)ML * 1024;
    const bf16_t* GT = (const bf16_t*)(ws + WS_GT); bf16_t* Y = (bf16_t*)(ws + WS_Y); const float* dnw = a.in(12);
    for (int row = gw; row < ML; row += NGW) {
        const int c0 = lane * 16;
        float o[16];
#pragma unroll
        for (int hh = 0; hh < 2; ++hh) {
            const u32x4 f = *(const u32x4*)(Of + (size_t)row * 1024 + c0 + hh * 8), bk = *(const u32x4*)(Ob + (size_t)row * 1024 + c0 + hh * 8);
#pragma unroll
            for (int i = 0; i < 4; ++i) { o[hh * 8 + 2 * i] = bflo(f[i]) + bflo(bk[i]); o[hh * 8 + 2 * i + 1] = bfhi(f[i]) + bfhi(bk[i]); }
        }
        float ss = 0.f;
#pragma unroll
        for (int i = 0; i < 16; ++i) ss += o[i] * o[i];
        ss += __shfl_xor(ss, 1); ss += __shfl_xor(ss, 2); ss += __shfl_xor(ss, 4);
        const float rs = rsqrtf(ss * (1.f / 128.f) + EPS);
        const int d0 = c0 & 127;
#pragma unroll
        for (int hh = 0; hh < 2; ++hh) {
            const u32x4 gt = *(const u32x4*)(GT + (size_t)row * 1024 + c0 + hh * 8);
            float y[8];
#pragma unroll
            for (int i = 0; i < 4; ++i) {
                y[2 * i] = o[hh * 8 + 2 * i] * rs * dnw[d0 + hh * 8 + 2 * i] * siluf(bflo(gt[i]));
                y[2 * i + 1] = o[hh * 8 + 2 * i + 1] * rs * dnw[d0 + hh * 8 + 2 * i + 1] * siluf(bfhi(gt[i]));
            }
            u32x4 w; w.x = pk2(y[0], y[1]); w.y = pk2(y[2], y[3]); w.z = pk2(y[4], y[5]); w.w = pk2(y[6], y[7]);
            *(u32x4*)(Y + (size_t)row * 2048 + c0 + hh * 8) = w;
        }
    }
}

namespace att {
constexpr int D = 128, NW = 8, QBLK = 32, KVBLK = 64;
constexpr float SCALE = 0.088388347648318440f;
constexpr float THR = 8.f;
constexpr int LDK = 256;
constexpr size_t SHM_V = KVBLK * D * 2, SHM_K = KVBLK * D * 2;
constexpr size_t OFF_WS = 2 * SHM_V + 2 * SHM_K, OFF_OST = OFF_WS + NW * 64 * 4;
#define KSWZ(row, colB) ((row) * 256 + ((colB) ^ (((row) & 7) << 4)))
#define SBAR() __builtin_amdgcn_sched_barrier(0)
DEVI int crow(int r, int hi) { return (r & 3) + 8 * (r >> 2) + 4 * hi; }
DEVI unsigned cvtpk(float lo, float hi) { unsigned r; asm volatile("v_cvt_pk_bf16_f32 %0, %1, %2" : "=v"(r) : "v"(lo), "v"(hi)); return r; }
DEVI void partialSM(f32x16& p0, f32x16& p1, float& m_reg, float& mn, float& alpha) {
    constexpr float C = SCALE * 1.4426950408889634f;
    float pmax = p0[0];
#pragma unroll
    for (int r = 1; r < 16; ++r) pmax = fmaxf(pmax, p0[r]);
#pragma unroll
    for (int r = 0; r < 16; ++r) pmax = fmaxf(pmax, p1[r]);
    { auto rr = __builtin_amdgcn_permlane32_swap(__float_as_uint(pmax), __float_as_uint(pmax), false, false);
      pmax = fmaxf(__uint_as_float(rr[0]), __uint_as_float(rr[1])); }
    if (__builtin_expect(__all(pmax - m_reg <= THR / SCALE), 1)) { mn = m_reg; alpha = 1.f; }
    else { mn = fmaxf(m_reg, pmax); alpha = __builtin_amdgcn_exp2f((m_reg - mn) * C); m_reg = mn; }
    const float mnC = -mn * C;
#pragma unroll
    for (int r = 0; r < 16; ++r) p0[r] = fmaf(p0[r], C, mnC);
#pragma unroll
    for (int r = 0; r < 16; ++r) p1[r] = fmaf(p1[r], C, mnC);
#pragma unroll
    for (int r = 0; r < 16; ++r) p0[r] = __builtin_amdgcn_exp2f(p0[r]);
}
DEVI void finishSM(f32x16& p0, f32x16& p1, float alpha, float& l_reg, bf16x8& pa0, bf16x8& pa1, bf16x8& pa2, bf16x8& pa3) {
#pragma unroll
    for (int r = 0; r < 16; ++r) p1[r] = __builtin_amdgcn_exp2f(p1[r]);
    float ps = 0;
#pragma unroll
    for (int r = 0; r < 16; ++r) ps += p0[r];
#pragma unroll
    for (int r = 0; r < 16; ++r) ps += p1[r];
    { auto rr = __builtin_amdgcn_permlane32_swap(__float_as_uint(ps), __float_as_uint(ps), false, false);
      ps = __uint_as_float(rr[0]) + __uint_as_float(rr[1]); }
    l_reg = l_reg * alpha + ps;
#define PK4(P, BASE, OUT) do { unsigned a0 = cvtpk(P[BASE + 0], P[BASE + 1]), a1 = cvtpk(P[BASE + 2], P[BASE + 3]);   \
    unsigned b0 = cvtpk(P[BASE + 4], P[BASE + 5]), b1 = cvtpk(P[BASE + 6], P[BASE + 7]);                              \
    auto r0 = __builtin_amdgcn_permlane32_swap(a0, b0, false, false); auto r1 = __builtin_amdgcn_permlane32_swap(a1, b1, false, false); \
    u32x4 w = {r0[0], r1[0], r0[1], r1[1]}; OUT = *reinterpret_cast<bf16x8*>(&w); } while (0)
    PK4(p0, 0, pa0); PK4(p0, 8, pa1); PK4(p1, 0, pa2); PK4(p1, 8, pa3);
#undef PK4
}
DEVI void qkt(f32x16& p0, f32x16& p1, const char* Ks, const bf16x8* qr, int r32, int hi) {
    p0 = f32x16{}; p1 = f32x16{};
#pragma unroll
    for (int d0 = 0; d0 < 8; ++d0) { const int cb = (d0 * 16 + hi * 8) * 2;
        const bf16x8 b0 = *reinterpret_cast<const bf16x8*>(Ks + KSWZ(r32, cb));
        const bf16x8 b1 = *reinterpret_cast<const bf16x8*>(Ks + KSWZ(32 + r32, cb));
        p0 = __builtin_amdgcn_mfma_f32_32x32x16_bf16(b0, qr[d0], p0, 0, 0, 0);
        p1 = __builtin_amdgcn_mfma_f32_32x32x16_bf16(b1, qr[d0], p1, 0, 0, 0); }
}
DEVI int v_st(int k, int c) { const int kk = (k & ~0xC) | ((k & 4) << 1) | ((k & 8) >> 1); return ((kk >> 3) * 4 + (c >> 5)) * 512 + ((kk & 7) * 32 + (c & 31)) * 2; }
DEVI int v_rd_base(int lane) { return ((lane & 3) << 3) | (((lane >> 2) & 3) << 6) | (((lane >> 4) & 1) << 5) | (((lane >> 5) & 1) << 8); }
constexpr int v_rd_off(int d0, int ks, int half) { return d0 * 512 + ks * 4096 + half * 2048; }
template <int OFF> DEVI s16x4 tr_read(int vb) { s16x4 r; asm volatile("ds_read_b64_tr_b16 %0, %1 offset:%2" : "=&v"(r) : "v"(vb), "i"(OFF) : "memory"); return r; }
template <int D0> DEVI void pv_one(f32x16& od, int vb, bf16x8 pa0, bf16x8 pa1, bf16x8 pa2, bf16x8 pa3) {
    const s16x4 l0 = tr_read<v_rd_off(D0, 0, 0)>(vb), h0 = tr_read<v_rd_off(D0, 0, 1)>(vb), l1 = tr_read<v_rd_off(D0, 1, 0)>(vb), h1 = tr_read<v_rd_off(D0, 1, 1)>(vb);
    const s16x4 l2 = tr_read<v_rd_off(D0, 2, 0)>(vb), h2 = tr_read<v_rd_off(D0, 2, 1)>(vb), l3 = tr_read<v_rd_off(D0, 3, 0)>(vb), h3 = tr_read<v_rd_off(D0, 3, 1)>(vb);
    asm volatile("s_waitcnt lgkmcnt(0)" ::: "memory"); SBAR();
#define PK(L, H) (bf16x8){L[0], L[1], L[2], L[3], H[0], H[1], H[2], H[3]}
    od = __builtin_amdgcn_mfma_f32_32x32x16_bf16(pa0, PK(l0, h0), od, 0, 0, 0);
    od = __builtin_amdgcn_mfma_f32_32x32x16_bf16(pa1, PK(l1, h1), od, 0, 0, 0);
    od = __builtin_amdgcn_mfma_f32_32x32x16_bf16(pa2, PK(l2, h2), od, 0, 0, 0);
    od = __builtin_amdgcn_mfma_f32_32x32x16_bf16(pa3, PK(l3, h3), od, 0, 0, 0);
#undef PK
}
DEVI void pv_d0(f32x16* o, int vb, bf16x8 pa0, bf16x8 pa1, bf16x8 pa2, bf16x8 pa3) {
    pv_one<0>(o[0], vb, pa0, pa1, pa2, pa3); pv_one<1>(o[1], vb, pa0, pa1, pa2, pa3); pv_one<2>(o[2], vb, pa0, pa1, pa2, pa3); pv_one<3>(o[3], vb, pa0, pa1, pa2, pa3);
}
DEVI void wmask(f32x16& p0, f32x16& p1, int qp, int kt0, int hi) {
#pragma unroll
    for (int r = 0; r < 16; ++r) { const int kp = kt0 + crow(r, hi); const int d0 = qp - kp, d1 = d0 - 32;
        if (d0 > 128 || d0 < -128) p0[r] = -1e30f; if (d1 > 128 || d1 < -128) p1[r] = -1e30f; }
}
DEVI void attn_unit(const KA& a, int b, int kvh, int tb, char* lds) {
    unsigned char* ws = a.ws();
    const bf16_t* QAT = (const bf16_t*)(ws + WS_QAT); const bf16_t* KAT = (const bf16_t*)(ws + WS_KAT); const bf16_t* VAT = (const bf16_t*)(ws + WS_VAT);
    bf16_t* Y = (bf16_t*)(ws + WS_Y); const float* rope = (const float*)(ws + SM_ROPE);
    const int tid = threadIdx.x, wid = __builtin_amdgcn_readfirstlane(tid >> 6), lane = tid & 63, r32 = lane & 31, hi = lane >> 5;
    const int h = kvh * 4 + (wid >> 1), t0 = tb * 64;
    char* V_lds = lds; char* K_lds = lds + 2 * SHM_V;
    float* wsf = (float*)(lds + OFF_WS) + wid * 64; float* li_l = wsf; float* al_l = wsf + 32;
    float m_reg = -1e30f, l_reg = 0; f32x16 o[4] = {}; bf16x8 qr[8];
    const int qp = t0 + (wid & 1) * QBLK + r32;
    {
        const bf16_t* Qw = QAT + (size_t)(b * SEQ + qp) * 1024 + h * 128 + hi * 8;
        u32x4 raw[8]; float ss = 0.f;
#pragma unroll
        for (int d0 = 0; d0 < 8; ++d0) { raw[d0] = *(const u32x4*)(Qw + d0 * 16);
#pragma unroll
            for (int i = 0; i < 4; ++i) { const float lo_ = bflo(raw[d0][i]), hi_ = bfhi(raw[d0][i]); ss += lo_ * lo_ + hi_ * hi_; } }
        { auto rr = __builtin_amdgcn_permlane32_swap(__float_as_uint(ss), __float_as_uint(ss), false, false); ss = __uint_as_float(rr[0]) + __uint_as_float(rr[1]); }
        const float rs = rsqrtf(ss * (1.f / 128.f) + EPS);
        const float* qnw = a.in(13);
#pragma unroll
        for (int half = 0; half < 2; ++half) {
            const float* ct = half == 0 ? rope + (qp >> 6) * 32 : rope + 16384 + (qp & 63) * 32;
            const float* st = half == 0 ? ct + 8192 : ct + 2048;
#pragma unroll
            for (int dd = 0; dd < 2; ++dd) {
                const int fi = dd * 16 + hi * 8, da = half * 4 + dd, db = da + 2;
                u32x4 oa, ob;
#pragma unroll
                for (int q4 = 0; q4 < 2; ++q4) {
                    const f32x4 c = *(const f32x4*)(ct + fi + 4 * q4), s = *(const f32x4*)(st + fi + 4 * q4);
                    const f32x4 wa = *(const f32x4*)(qnw + da * 16 + hi * 8 + 4 * q4), wb = *(const f32x4*)(qnw + db * 16 + hi * 8 + 4 * q4);
                    float ya[4], yb[4];
#pragma unroll
                    for (int j = 0; j < 4; ++j) {
                        const unsigned ra = raw[da][2 * q4 + (j >> 1)], rb = raw[db][2 * q4 + (j >> 1)];
                        const float x1 = ((j & 1) ? bfhi(ra) : bflo(ra)) * rs * wa[j], x2 = ((j & 1) ? bfhi(rb) : bflo(rb)) * rs * wb[j];
                        ya[j] = x1 * c[j] - x2 * s[j]; yb[j] = x2 * c[j] + x1 * s[j];
                    }
                    oa[2 * q4] = cvtpk(ya[0], ya[1]); oa[2 * q4 + 1] = cvtpk(ya[2], ya[3]); ob[2 * q4] = cvtpk(yb[0], yb[1]); ob[2 * q4 + 1] = cvtpk(yb[2], yb[3]);
                }
                qr[da] = *reinterpret_cast<bf16x8*>(&oa); qr[db] = *reinterpret_cast<bf16x8*>(&ob);
            }
        }
    }
    const int tk0 = t0 - 128 < 0 ? 0 : t0 - 128, tk1 = t0 + 192 > SEQ ? SEQ : t0 + 192;
    const int NTR = 4 + (tk1 - tk0) / 64, NT = (NTR + 1) & ~1;
    const int ctxrow = ML + b * CTX, latrow = b * SEQ + tk0 - 256;
#define TCTX(j) ((j) < 4 || (j) >= NTR)
#define TROW(j) (TCTX(j) ? b * CTX + 64 * ((j) & 3) : latrow + 64 * (j))
    const bf16_t* Kh = KAT + kvh * 128; const bf16_t* Vh = VAT + kvh * 128;
    const bf16_t* Kc = (const bf16_t*)(ws + WS_CTXK) + kvh * 128; const bf16_t* Vc = (const bf16_t*)(ws + WS_CTXV) + kvh * 128;
    const int sr = tid >> 4, sc = (tid & 15) * 8, vst0 = v_st(sr, sc), vst1 = v_st(32 + sr, sc);
    const int vb0 = (int)(uintptr_t)V_lds + v_rd_base(lane);
    struct { bf16x8 vs0, vs1, ks0, ks1; } sr_[1];
#define SLOAD(i, j) do { const int k0_ = TROW(j); const bf16_t* kb_ = TCTX(j) ? Kc : Kh; const bf16_t* vb_ = TCTX(j) ? Vc : Vh; \
    sr_[i].vs0 = *(const bf16x8*)(vb_ + (size_t)(k0_ + sr) * LDK + sc); sr_[i].vs1 = *(const bf16x8*)(vb_ + (size_t)(k0_ + 32 + sr) * LDK + sc); \
    sr_[i].ks0 = *(const bf16x8*)(kb_ + (size_t)(k0_ + sr) * LDK + sc); sr_[i].ks1 = *(const bf16x8*)(kb_ + (size_t)(k0_ + 32 + sr) * LDK + sc); } while (0)
#define SWRITE(bf, i) do { *(bf16x8*)(V_lds + (bf) * SHM_V + vst0) = sr_[i].vs0; *(bf16x8*)(V_lds + (bf) * SHM_V + vst1) = sr_[i].vs1; const int kc = sc * 2; \
    *(bf16x8*)(K_lds + (bf) * SHM_K + KSWZ(sr, kc)) = sr_[i].ks0; *(bf16x8*)(K_lds + (bf) * SHM_K + KSWZ(32 + sr, kc)) = sr_[i].ks1; } while (0)
#define SWAIT() asm volatile("s_waitcnt vmcnt(0)" ::: "memory")
#define RESC(al) do { if (__any((al) < 1.f)) { if (hi == 0) al_l[r32] = (al); asm volatile("s_waitcnt lgkmcnt(0)" ::: "memory"); \
    _Pragma("unroll") for (int d = 0; d < 4; ++d) _Pragma("unroll") for (int r = 0; r < 16; ++r) o[d][r] *= al_l[crow(r, hi)]; } } while (0)
#define WMASK(P0, P1, j) do { if ((j) >= 4) wmask(P0, P1, qp, (j) >= NTR ? 1000000 : tk0 + 64 * ((j) - 4), hi); } while (0)
    f32x16 pA0, pA1, pB0, pB1; float mnA, mnB, alA, alB; bf16x8 pa0, pa1, pa2, pa3;
    constexpr int SE = 0, SO = 0;
    SLOAD(SE, 0); asm volatile("s_waitcnt vmcnt(0)" ::: "memory"); SWRITE(0, SE); __syncthreads();
    qkt(pA0, pA1, K_lds, qr, r32, hi); partialSM(pA0, pA1, m_reg, mnA, alA);
    SLOAD(SO, 1);
    SWAIT(); SWRITE(1, SO); __syncthreads();
    for (int j = 1; j + 1 < NT; j += 2) {
        SBAR(); qkt(pB0, pB1, K_lds + SHM_K, qr, r32, hi); WMASK(pB0, pB1, j);
        finishSM(pA0, pA1, alA, l_reg, pa0, pa1, pa2, pa3); SBAR();
        SLOAD(SO, j + 1); SBAR();
        pv_d0(o, vb0, pa0, pa1, pa2, pa3); partialSM(pB0, pB1, m_reg, mnB, alB);
        __syncthreads(); SWAIT(); SWRITE(0, SE);
        RESC(alB); __syncthreads();
        SBAR(); qkt(pA0, pA1, K_lds, qr, r32, hi); WMASK(pA0, pA1, j + 1);
        finishSM(pB0, pB1, alB, l_reg, pa0, pa1, pa2, pa3); SBAR();
        SLOAD(SE, j + 2); SBAR();
        pv_d0(o, vb0 + (int)SHM_V, pa0, pa1, pa2, pa3); partialSM(pA0, pA1, m_reg, mnA, alA);
        __syncthreads(); SWAIT(); SWRITE(1, SO);
        RESC(alA); __syncthreads();
    }
    SBAR(); qkt(pB0, pB1, K_lds + SHM_K, qr, r32, hi); WMASK(pB0, pB1, NT - 1);
    finishSM(pA0, pA1, alA, l_reg, pa0, pa1, pa2, pa3); SBAR();
    pv_d0(o, vb0, pa0, pa1, pa2, pa3); partialSM(pB0, pB1, m_reg, mnB, alB);
    __syncthreads(); RESC(alB);
    finishSM(pB0, pB1, alB, l_reg, pa0, pa1, pa2, pa3); SBAR();
    pv_d0(o, vb0 + (int)SHM_V, pa0, pa1, pa2, pa3);
    l_reg += __builtin_amdgcn_exp2f(a.in(15)[h] * 1.4426950408889634f - m_reg * (SCALE * 1.4426950408889634f));
    if (hi == 0) li_l[r32] = l_reg; asm volatile("s_waitcnt lgkmcnt(0)" ::: "memory");
    float rli[16];
#pragma unroll
    for (int r = 0; r < 16; ++r) rli[r] = __builtin_amdgcn_rcpf(li_l[crow(r, hi)]);
    {
        bf16_t* stg = (bf16_t*)(lds + OFF_OST) + wid * 4096;
#pragma unroll
        for (int r = 0; r < 16; ++r) { const int orow = crow(r, hi);
#pragma unroll
            for (int d0 = 0; d0 < 4; ++d0) stg[orow * 128 + d0 * 32 + r32] = (bf16_t)f2bf(o[d0][r] * rli[r]); }
        asm volatile("s_waitcnt lgkmcnt(0)" ::: "memory");
        bf16_t* Ow = Y + (size_t)(b * SEQ + t0 + (wid & 1) * QBLK) * 2048 + 1024 + h * 128;
#pragma unroll
        for (int i = 0; i < 8; ++i) { const int row = i * 4 + (lane >> 4), ch = lane & 15; const u32x4 v = *(const u32x4*)(stg + row * 128 + ch * 8); *(u32x4*)(Ow + (size_t)row * 2048 + ch * 8) = v; }
    }
    __syncthreads();
#undef TROW
#undef TCTX
#undef SLOAD
#undef SWRITE
#undef SWAIT
#undef RESC
#undef WMASK
}
#undef KSWZ
#undef SBAR
}

DEVI u32x4 ldu_(const bf16_t* base, int rr) {
    const int rc = rr < 0 ? 0 : (rr >= SEQ ? SEQ - 1 : rr);
    const u32x4 v = *(const u32x4*)(base + (size_t)rc * NUP);
    const unsigned m = (rr == rc) ? 0xffffffffu : 0u;
    return (u32x4){v[0] & m, v[1] & m, v[2] & m, v[3] & m};
}
DEVI void phase_ffnconv(const KA& a, int b, int tid) {
    unsigned char* ws = a.ws();
    const bf16_t* U = (const bf16_t*)(ws + WS_U); bf16_t* ACT = (bf16_t*)(ws + WS_ACT) + (size_t)b * SEQ * DFF;
    const float* cw = a.in(20); const float* cb = a.in(21);
    if (tid < DFF / 8) {
        const int f0 = tid * 8, pn = f0 >> 7, j = f0 & 127, gc = 256 * pn + j, vc = gc + 128;
        float wg[3][8], wv[3][8], bg[8], bvv[8];
#pragma unroll
        for (int jt = 0; jt < 3; ++jt)
#pragma unroll
            for (int q = 0; q < 8; ++q) { wg[jt][q] = cw[jt * NUP + f0 + q]; wv[jt][q] = cw[jt * NUP + DFF + f0 + q]; }
#pragma unroll
        for (int q = 0; q < 8; ++q) { bg[q] = cb[f0 + q]; bvv[q] = cb[DFF + f0 + q]; }
        for (int it = blockIdx.x; it < SEQ / 32; it += gridDim.x) {
            const int r0 = it * 32;
            u32x4 gw_[3], vw_[3];
#define LDU(rr, c) ldu_(U + (c), (rr))
            gw_[0] = LDU(r0 - 1, gc); vw_[0] = LDU(r0 - 1, vc); gw_[1] = LDU(r0, gc); vw_[1] = LDU(r0, vc);
#pragma unroll 8
            for (int r = 0; r < 32; ++r) {
                gw_[2] = LDU(r0 + r + 1, gc); vw_[2] = LDU(r0 + r + 1, vc);
                float ug[8], uv[8];
#pragma unroll
                for (int q = 0; q < 8; ++q) { ug[q] = bg[q]; uv[q] = bvv[q]; }
#pragma unroll
                for (int jt = 0; jt < 3; ++jt)
#pragma unroll
                    for (int q = 0; q < 4; ++q) {
                        ug[2 * q] += bflo(gw_[jt][q]) * wg[jt][2 * q]; ug[2 * q + 1] += bfhi(gw_[jt][q]) * wg[jt][2 * q + 1];
                        uv[2 * q] += bflo(vw_[jt][q]) * wv[jt][2 * q]; uv[2 * q + 1] += bfhi(vw_[jt][q]) * wv[jt][2 * q + 1]; }
                u32x4 o;
                o.x = pk2(siluf(ug[0]) * uv[0], siluf(ug[1]) * uv[1]); o.y = pk2(siluf(ug[2]) * uv[2], siluf(ug[3]) * uv[3]);
                o.z = pk2(siluf(ug[4]) * uv[4], siluf(ug[5]) * uv[5]); o.w = pk2(siluf(ug[6]) * uv[6], siluf(ug[7]) * uv[7]);
                *(u32x4*)(ACT + (size_t)(r0 + r) * DFF + f0) = o;
                gw_[0] = gw_[1]; gw_[1] = gw_[2]; vw_[0] = vw_[1]; vw_[1] = vw_[2];
            }
#undef LDU
        }
    }
}

#define XB_TMO      128
#define XB_XCNT(j)  (256  + 64 * (j))
#define XB_XSUB(j)  (1280 + 64 * (j))
#define XB_XGEN(j)  (2304 + 64 * (j))
#define XB_TOP      3328
#define XB_TOPGEN   3392
#define XCD_BAR_WORDS 3456
#define XB_SPIN_CAP (1u << 18)
__device__ __forceinline__ unsigned xb_ld(unsigned* p)              { return __hip_atomic_load(p, __ATOMIC_RELAXED, __HIP_MEMORY_SCOPE_AGENT); }
__device__ __forceinline__ unsigned xb_add(unsigned* p, unsigned v) { return __hip_atomic_fetch_add(p, v, __ATOMIC_RELAXED, __HIP_MEMORY_SCOPE_AGENT); }
__device__ __forceinline__ unsigned xb_xcc_id() { return (unsigned)__builtin_amdgcn_s_getreg((3 << 11) | 20) & 0xFu; }
#define XB_SPIN(cond, bar) do { unsigned _sp = 0; while (cond) { __builtin_amdgcn_s_sleep(1); \
    if ((++_sp & 255u) == 0u) { if (xb_ld(&(bar)[XB_TMO])) break; if (_sp > XB_SPIN_CAP) { atomicAdd(&(bar)[XB_TMO], 1u); break; } } } } while (0)
struct XcdBarrier { unsigned* bar; unsigned x; volatile LAS unsigned* st; };
__device__ __forceinline__ XcdBarrier xcd_barrier_post(unsigned* bar, volatile LAS unsigned* st) {
    XcdBarrier b; b.bar = bar; b.x = xb_xcc_id(); b.st = st;
    if (threadIdx.x == 0) (void)xb_add(&bar[XB_XCNT(b.x)], 1u);
    return b;
}
__device__ __forceinline__ void xcd_barrier_complete(unsigned* bar, unsigned x, unsigned& nloc, unsigned& nx) {
    const unsigned G = gridDim.x * gridDim.y * gridDim.z;
    unsigned sum, cnt, mine, sp = 0u;
    for (;;) {
        sum = 0u; cnt = 0u; mine = 0u;
#pragma unroll
        for (unsigned j = 0; j < 16; ++j) { const unsigned c = xb_ld(&bar[XB_XCNT(j)]); sum += c; cnt += (c > 0u) ? 1u : 0u; mine = (j == x) ? c : mine; }
        if (sum == G) break;
        __builtin_amdgcn_s_sleep(1);
        if ((++sp & 255u) == 0u) { if (xb_ld(&bar[XB_TMO])) break; if (sp > XB_SPIN_CAP) { atomicAdd(&bar[XB_TMO], 1u); break; } }
    }
    nloc = mine > 0u ? mine : 1u; nx = cnt > 0u ? cnt : 1u;
}
__device__ __forceinline__ void xcd_barrier(const XcdBarrier& b) {
    asm volatile("s_waitcnt vmcnt(0)" ::: "memory");
    __syncthreads();
    if (threadIdx.x == 0) {
        unsigned* bar = b.bar;
        __builtin_amdgcn_s_waitcnt(0);
        unsigned nloc = b.st[0], nx = b.st[1];
        if (nloc == 0u) { xcd_barrier_complete(bar, b.x, nloc, nx); b.st[0] = nloc; b.st[1] = nx; }
        const unsigned old = xb_add(&bar[XB_XSUB(b.x)], 1u);
        const unsigned gen = old / nloc;
        if (old + 1u == (gen + 1u) * nloc) {
            __builtin_amdgcn_fence(__ATOMIC_RELEASE, "agent");
            asm volatile("s_waitcnt vmcnt(0)" ::: "memory");
            const unsigned og = xb_add(&bar[XB_TOP], 1u);
            const unsigned tg = og / nx;
            if (og + 1u == (tg + 1u) * nx) xb_add(&bar[XB_TOPGEN], 1u);
            else XB_SPIN(xb_ld(&bar[XB_TOPGEN]) == tg, bar);
            __builtin_amdgcn_fence(__ATOMIC_ACQUIRE, "agent");
            xb_add(&bar[XB_XGEN(b.x)], 1u);
            asm volatile("s_waitcnt vmcnt(0)" ::: "memory");
        } else {
            XB_SPIN(xb_ld(&bar[XB_XGEN(b.x)]) == gen, bar);
            __builtin_amdgcn_fence(__ATOMIC_ACQUIRE, "agent");
            asm volatile("s_waitcnt vmcnt(0)" ::: "memory");
        }
    }
    __syncthreads();
}

constexpr int NPHASE = 13;
__global__ void __launch_bounds__(512, 2) mega(Args a_) {
    const KA a;
    extern __shared__ __attribute__((aligned(16))) unsigned char lds_raw[];
    LAS unsigned char* lds = (LAS unsigned char*)lds_raw;
    const int tid = threadIdx.x, lane = tid & 63, wave = __builtin_amdgcn_readfirstlane(tid >> 6);
    unsigned char* ws = a.ws();
    const int lo = a_.ph_lo, hi = a_.ph_hi;
#define IN(k) (lo <= (k) && (k) < hi)
#if MK_ONE_LAUNCH
    volatile LAS unsigned* bst = (volatile LAS unsigned*)(lds + 147440);
    if (tid < 4) bst[tid] = 0u;
    __syncthreads();
    const XcdBarrier gbar = xcd_barrier_post((unsigned*)(ws + WS_CTL), bst);
#define SEAM(k) do { if (IN(k) && IN((k) + 1)) xcd_barrier(gbar); } while (0)
#else
#define SEAM(k) do { } while (0)
#endif
    const float* modacc = (const float*)(ws + CTL_MODACC);
    unsigned long long pr_prev = PROBE_MASK ? __builtin_amdgcn_s_memrealtime() : 0ull, pr_acc = 0ull;
#define STAMP(k) do { if (PROBE_MASK) { const unsigned long long now_ = __builtin_amdgcn_s_memrealtime(); if ((PROBE_MASK >> (k)) & 1u) pr_acc += now_ - pr_prev; pr_prev = now_; } } while (0)
    if (IN(0)) { phase0(a, lds, tid, lane, wave); } SEAM(0); STAMP(0);
    if (IN(1)) { phase1(a, tid, lane, wave); } SEAM(1); STAMP(1);
    if (IN(2)) {
        pg8::Gemm g{(const bf16_t*)(ws + WS_XN), (const bf16_t*)(ws + WS_WINA), MT, NA, 1024}; pg8::StaticOrder S; S.init(MT, NA, gridDim.x, blockIdx.x);
        EpiIn E{(const float*)(ws + SM_ROWSS1), (const float*)(ws + SM_SHWA), 0, (bf16_t*)(ws + WS_QKVR), nullptr, nullptr, nullptr, nullptr, (float*)(ws + WS_BA)};
        pg8::gemm_phase<EpiIn, pg8::StaticOrder, true, true>(lds, g, S, E);
        {
            pg8::Gemm g2{(const bf16_t*)(ws + WS_XN) + (size_t)ML * 1024, (const bf16_t*)(ws + WS_WINC) + (size_t)2048 * 1024, MC, 512, 1024};
            TailOrder T{(int)blockIdx.x - ((int)gridDim.x - 4)};
            EpiCtxKV E2{(const float*)(ws + SM_ROWSS1) + ML, (const float*)(ws + SM_SHWA) + 2 * NSH + NA + 2048, (bf16_t*)(ws + WS_CTXK), (bf16_t*)(ws + WS_CTXV)};
            pg8::gemm_phase<EpiCtxKV, TailOrder, true, true>(lds, g2, T, E2);
        }
    } SEAM(2); STAMP(2);
    if (IN(3)) { phase_dnprep(a, tid); } SEAM(3); STAMP(3);
    if (IN(4)) { phase_dnchunk2(a, lds, tid, lane, wave); } SEAM(4); STAMP(4);
    if (IN(5)) { const unsigned long long t5_ = (PROBE_SUB == 4) ? __builtin_amdgcn_s_memrealtime() : 0ull; phase_dnscan2(a, lds, tid, lane, wave, pr_acc); if (PROBE_SUB == 4) pr_acc += __builtin_amdgcn_s_memrealtime() - t5_; } SEAM(5); STAMP(5);
    if (IN(6)) {
        pg8::Gemm g{(const bf16_t*)(ws + WS_XN), (const bf16_t*)(ws + WS_WINC), ML, NC, 1024}; pg8::StaticOrder S; S.init(ML, NC, gridDim.x, blockIdx.x);
        EpiIn E{(const float*)(ws + SM_ROWSS1), (const float*)(ws + SM_SHWA) + NA, 1, (bf16_t*)(ws + WS_GT), (bf16_t*)(ws + WS_QAT), (bf16_t*)(ws + WS_KAT), (bf16_t*)(ws + WS_VAT), (bf16_t*)(ws + WS_MG), nullptr};
        pg8::gemm_phase<EpiIn, pg8::StaticOrder, true, true>(lds, g, S, E);
    } SEAM(6); STAMP(6);
    if (IN(7)) { phase_prep2(a, lane, wave); } SEAM(7); STAMP(7);
    if (IN(8)) {
#pragma unroll 1
        for (int idx = blockIdx.x; idx < 1024; idx += gridDim.x) {
            const int tb = idx & 255, kvh = (idx >> 8) & 1, b = idx >> 9;
            att::attn_unit(a, b, kvh, tb, (char*)lds_raw); }
    } SEAM(8); STAMP(8);
    if (IN(9)) {
        pg8::Gemm g{(const bf16_t*)(ws + WS_Y), (const bf16_t*)(ws + WS_WBR), ML, 1024, 2048}; pg8::StaticOrder S; S.init(ML, 1024, gridDim.x, blockIdx.x);
        EpiBr E{(const bf16_t*)(ws + WS_MG), (bf16_t*)(ws + WS_MERGED)};
        pg8::gemm_phase<EpiBr, pg8::StaticOrder, true, true>(lds, g, S, E);
    } SEAM(9); STAMP(9);
    if (IN(10)) {
        pg8::Gemm g{(const bf16_t*)(ws + WS_MERGED), (const bf16_t*)(ws + WS_WOUT), ML, 1024, 1024}; pg8::StaticOrder S; S.init(ML, 1024, gridDim.x, blockIdx.x);
        EpiOut E{a.in(0), modacc, a.in(5), a.in(7), a.out(), (bf16_t*)(ws + WS_X1S), (float*)(ws + CTL_ROWSS2)};
        pg8::gemm_phase<EpiOut, pg8::StaticOrder, true, true>(lds, g, S, E);
    } SEAM(10); STAMP(10);
    if (IN(11)) {
        pg8::Gemm g{(const bf16_t*)(ws + WS_X1S), (const bf16_t*)(ws + WS_WUP), 2 * TPB * 256, NUP, 1024}; pg8::StaticOrder S; S.init(2 * TPB * 256, NUP, gridDim.x, blockIdx.x);
        EpiUpConv E{(const float*)(ws + CTL_ROWSS2), (const float*)(ws + SM_SHWF), a.in(20), a.in(21), (bf16_t*)(ws + WS_ACT), (LAS float*)(lds + 131072)};
        pg8::gemm_phase<EpiUpConv, pg8::StaticOrder, true, true>(lds, g, S, E);
    } SEAM(11); STAMP(11);
    if (IN(12)) {
        pg8::Gemm g{(const bf16_t*)(ws + WS_ACT), (const bf16_t*)(ws + WS_WDN), ML, 1024, DFF}; pg8::StaticOrder S; S.init(ML, 1024, gridDim.x, blockIdx.x);
        EpiDown E{modacc, a.in(5), a.out()};
        pg8::gemm_phase<EpiDown, pg8::StaticOrder, true, true>(lds, g, S, E);
    }
    STAMP(12);
    if ((PROBE_MASK || PROBE_SUB) && blockIdx.x == 0) { const unsigned long long t0_ = __builtin_amdgcn_s_memrealtime(); while (__builtin_amdgcn_s_memrealtime() - t0_ < pr_acc) __builtin_amdgcn_s_sleep(8); }
#undef STAMP
#undef IN
#undef SEAM
}

extern "C" void kernel_launch(void* const* d_in, const int* in_sizes, int n_in, void* d_out, int out_size, void* d_ws, size_t ws_size, hipStream_t stream) {
    static int grid = 0;
    if (grid == 0) {
        if (n_in != 23 || in_sizes[0] != ML * DM || out_size != ML * DM || ws_size < WS_END) {
            fprintf(stderr, "kernel_launch: unexpected shapes n_in %d in0 %d out %d ws %zu (need %zu)\n", n_in, n_in > 0 ? in_sizes[0] : -1, out_size, ws_size, (size_t)WS_END); grid = -1; return; }
        int dev = 0, cus = 0, per_cu = 0;
        hipGetDevice(&dev); hipDeviceGetAttribute(&cus, hipDeviceAttributeMultiprocessorCount, dev);
        if (hipFuncSetAttribute((const void*)mega, hipFuncAttributeMaxDynamicSharedMemorySize, LDS_BYTES) != hipSuccess) { fprintf(stderr, "kernel_launch: hipFuncSetAttribute failed\n"); grid = -1; return; }
        hipOccupancyMaxActiveBlocksPerMultiprocessor(&per_cu, (const void*)mega, 512, LDS_BYTES);
        (void)hipGetLastError();
        if (per_cu < 1) { fprintf(stderr, "kernel_launch: occupancy query says %d blocks per CU\n", per_cu); per_cu = 1; }
        grid = cus;
    }
    if (grid < 0) return;
    hipMemsetAsync((char*)d_ws + WS_CTL, 0, CTL_ZERO_BYTES, stream);
    Args a{};
    for (int i = 0; i < 23; ++i) a.in[i] = (const float*)d_in[i];
    a.out = (float*)d_out; a.ws = (unsigned char*)d_ws;
#if MK_ONE_LAUNCH
    a.ph_lo = 0; a.ph_hi = NPHASE;
    void* args[] = {&a};
    hipError_t e = hipLaunchCooperativeKernel((const void*)mega, dim3(grid), dim3(512), args, LDS_BYTES, stream);
    if (e != hipSuccess) fprintf(stderr, "cooperative launch failed: %s (grid %d)\n", hipGetErrorString(e), grid);
#else
    for (int p = 0; p < NPHASE; ++p) {
        a.ph_lo = p; a.ph_hi = p + 1;
        hipLaunchKernelGGL(mega, dim3(grid), dim3(512), LDS_BYTES, stream, a);
    }
    hipError_t e = hipPeekAtLastError();
    if (e != hipSuccess) fprintf(stderr, "launch failed: %s\n", hipGetErrorString(e));
#endif
}
```

```cpp
#include <hip/hip_runtime.h>
#include <hip/hip_cooperative_groups.h>
#include <cstdio>
#include <cstdint>
namespace cg = cooperative_groups;

#ifndef PROBE_MASK
#define PROBE_MASK 0u
#endif
#ifndef PROBE_SUB
#define PROBE_SUB 0
#endif
#ifndef MK_ONE_LAUNCH
#define MK_ONE_LAUNCH 1
#endif

#define DEVI __device__ __forceinline__
#define LAS __attribute__((address_space(3)))
typedef unsigned short bf16_t;
typedef short bf16x8 __attribute__((ext_vector_type(8)));
typedef float f32x4 __attribute__((ext_vector_type(4)));
typedef float f32x2 __attribute__((ext_vector_type(2)));
typedef float f32x16 __attribute__((ext_vector_type(16)));
typedef unsigned u32x4 __attribute__((ext_vector_type(4)));
typedef unsigned u32x2 __attribute__((ext_vector_type(2)));
typedef short s16x4 __attribute__((ext_vector_type(4)));

constexpr int BATCH = 2, SEQ = 16384, DM = 1024, CTX = 256;
constexpr int ML = BATCH * SEQ;
constexpr int MC = BATCH * CTX;
constexpr int MT = ML + MC;
constexpr int NA = 3328;
constexpr int NC = 4608;
constexpr int NSH = NA + NC;
constexpr int DFF = 2816, NUP = 5632;
constexpr int RB = SEQ + 256;
constexpr int TPB = 65;
constexpr float EPS = 1e-6f;

constexpr size_t MiB = 1u << 20;
constexpr size_t WS_CTL = 0, CTL_ZERO_BYTES = 1 * MiB;
constexpr size_t CTL_XRANK = 24 * 1024;
constexpr size_t CTL_PROG = 32 * 1024;
constexpr size_t CTL_MODACC = 64 * 1024;
constexpr size_t CTL_ROWSS2 = 256 * 1024;
constexpr size_t WS_SMALL = 1 * MiB;
constexpr size_t SM_ROWSS1 = WS_SMALL;
constexpr size_t SM_SHWA = WS_SMALL + 256 * 1024;
constexpr size_t SM_SHWF = WS_SMALL + 384 * 1024;
constexpr size_t SM_ROPE = WS_SMALL + 512 * 1024;
constexpr size_t WS_BA = 2 * MiB;
constexpr size_t WS_CTXK = 6 * MiB + 256 * 1024;
constexpr size_t WS_CTXV = 6 * MiB + 512 * 1024;
constexpr size_t WS_G = 7 * MiB;
constexpr size_t WS_BETA = 10 * MiB;
constexpr size_t WS_WINA = 13 * MiB, WS_WINC = 20 * MiB, WS_WBR = 29 * MiB, WS_WOUT = 33 * MiB, WS_WUP = 35 * MiB, WS_WDN = 46 * MiB;
constexpr size_t WS_XN = 52 * MiB;
constexpr size_t WS_QKVR = 117 * MiB;
constexpr size_t WS_QKVP = 312 * MiB;
constexpr size_t WS_MG = 180 * MiB;
constexpr size_t WS_GT = 310 * MiB;
constexpr size_t WS_QAT = 375 * MiB;
constexpr size_t WS_KAT = 440 * MiB;
constexpr size_t WS_VAT = 457 * MiB;
constexpr size_t WS_Y = 52 * MiB;
constexpr size_t WS_MERGED = 375 * MiB;
constexpr size_t WS_X1S = 440 * MiB;
constexpr size_t WS_U = 52 * MiB;
constexpr size_t WS_ACT = 228 * MiB;
constexpr size_t WS_TQ = 117 * MiB;
constexpr size_t WS_AVEC = 248 * MiB;
constexpr size_t WS_END = 512 * MiB;

constexpr int LDS_BYTES = 147456;

DEVI float bf2f(unsigned short h) { return __uint_as_float((unsigned)h << 16); }
DEVI float bflo(unsigned w) { return __uint_as_float(w << 16); }
DEVI float bfhi(unsigned w) { return __uint_as_float(w & 0xffff0000u); }
typedef __bf16 bf16x2_t __attribute__((ext_vector_type(2)));
DEVI unsigned pk2(float lo, float hi) { const f32x2 v = {lo, hi}; const bf16x2_t b = __builtin_convertvector(v, bf16x2_t); return __builtin_bit_cast(unsigned, b); }
DEVI unsigned f2bf(float f) { return pk2(f, 0.f) & 0xffffu; }
DEVI float wave_sum(float v) {
#pragma unroll
    for (int o = 1; o < 64; o <<= 1) v += __shfl_xor(v, o);
    return v;
}
DEVI float siluf(float x) { return x * __builtin_amdgcn_rcpf(1.f + __expf(-x)); }
DEVI float sigmoidf_(float x) { return 1.f / (1.f + __expf(-x)); }

struct Args { const float* in[23]; float* out; unsigned char* ws; int ph_lo, ph_hi; };
struct KA {
    DEVI const float* in(int k) const { return ((const float* const*)__builtin_amdgcn_kernarg_segment_ptr())[k]; }
    DEVI float* out() const { return ((float* const*)__builtin_amdgcn_kernarg_segment_ptr())[23]; }
    DEVI unsigned char* ws() const { return ((unsigned char* const*)__builtin_amdgcn_kernarg_segment_ptr())[24]; }
};

namespace pg8 {
constexpr int BM = 256, BK = 64, HALF = 128, HTB = HALF * BK * 2, STAGE_BYTES = 8 * HTB, NXCD = 8, WGM = 8;
__host__ __device__ __forceinline__ int lds_byte(int r, int c) { const int st = (r >> 4) * 2 + (c >> 5), rr = r & 15, cc = c & 31, ob = rr * 64 + cc * 2; return st * 1024 + (ob ^ (((ob >> 9) & 1) << 5)); }
__host__ __device__ __forceinline__ void stage_rc(int b, int& R, int& C) { const int st = b / 1024, sb = b % 1024, swz = sb ^ (((sb >> 9) & 1) << 5); R = (st >> 1) * 16 + swz / 64; C = (st & 1) * 32 + (swz % 64) / 2; }
__host__ __device__ __forceinline__ int perm32(int rho) { const int n = rho >> 4, i = rho & 15; return 8 * (i >> 2) + 4 * n + (i & 3); }
struct Unit { int pm, pn; };
struct Gemm { const bf16_t* A; const bf16_t* Bt; int M, N, K; };
struct StaticOrder {
    int nM, nN, nwg, G, c;
    __device__ void init(int M, int N, int G_, int c_) { nM = M / BM; nN = N / BM; nwg = nM * nN; G = G_; c = c_; }
    __device__ bool next(int i, Unit& u) const {
        const long L = (long)i * G + c; if (L >= nwg) return false;
        int wgid = (int)L; { const int q = nwg / NXCD, r = nwg % NXCD, xcd = wgid % NXCD, off = wgid / NXCD; wgid = (xcd < r ? xcd * (q + 1) : r * (q + 1) + (xcd - r) * q) + off; }
        const int nig = WGM * nN, gid = wgid / nig, fm = gid * WGM, gsz = (nM - fm) < WGM ? (nM - fm) : WGM;
        u.pm = fm + ((wgid % nig) % gsz); u.pn = (wgid % nig) / gsz; return true;
    }
};
template <class Epi> __device__ __forceinline__ size_t a_off(const Epi& E, int pm, int K, size_t tstep) { if constexpr (Epi::AROW) return (size_t)E.arow(pm) * K * 2; else return (size_t)pm * tstep; }
template <class Epi, class Sched, bool ALIGN_EPI, bool SP2>
__device__ __forceinline__ void gemm_phase(LAS unsigned char* lds, const Gemm g, const Sched& S, const Epi& E) {
    const int tid = threadIdx.x, wid = __builtin_amdgcn_readfirstlane(tid >> 6), lane = tid & 63, wr = wid >> 2, wc = wid & 3, fr = lane & 15, fq = lane >> 4;
    const int K = g.K, nt = K / BK;
    unsigned voffA[2], voffB[2];
#pragma unroll
    for (int i = 0; i < 2; ++i) { int R, C; stage_rc(tid * 16 + i * 8192, R, C); const int Rb = Epi::PERM ? ((R & ~31) + perm32(R & 31)) : R;
        voffA[i] = (unsigned)(R * K + C) * 2u; voffB[i] = (unsigned)(Rb * K + C) * 2u; }
    const size_t kstep = (size_t)(BK * 2);
    const size_t hstep = (size_t)HALF * K * 2;
    const size_t tstep = 2 * hstep;
    const unsigned ldsw = (unsigned)wid * 1024u;
    const int aoff = lds_byte(wr * 64 + fr, fq * 8), boff = lds_byte(wc * 32 + fr, fq * 8);
#define PG8_SA(b, h) (((b) * 2 + (h)) * HTB)
#define PG8_SB(b, h) ((4 + (b) * 2 + (h)) * HTB)
#define PG8_STAGE(bufoff, gbase, voff) do { _Pragma("unroll") for (int _i = 0; _i < 2; ++_i) \
        __builtin_amdgcn_global_load_lds((const unsigned*)((const char*)(gbase) + (voff)[_i]), (LAS unsigned*)(lds + (bufoff) + ldsw + _i * 8192), 16, 0, 0); } while (0)
#define PG8_LDA(dst, b, h) do { _Pragma("unroll") for (int m = 0; m < 4; ++m) _Pragma("unroll") for (int k = 0; k < 2; ++k) dst[m][k] = *(const LAS bf16x8*)(lds + PG8_SA(b, h) + aoff + m * 2048 + k * 1024); } while (0)
#define PG8_LDB(dst, b, h) do { _Pragma("unroll") for (int n = 0; n < 2; ++n) _Pragma("unroll") for (int k = 0; k < 2; ++k) dst[n][k] = *(const LAS bf16x8*)(lds + PG8_SB(b, h) + boff + n * 2048 + k * 1024); } while (0)
#define PG8_MMA(ai, bj, At, Bt) do { __builtin_amdgcn_s_setprio(1); _Pragma("unroll") for (int m = 0; m < 4; ++m) _Pragma("unroll") for (int n = 0; n < 2; ++n) _Pragma("unroll") for (int k = 0; k < 2; ++k) \
        acc[ai][bj][m][n] = __builtin_amdgcn_mfma_f32_16x16x32_bf16(Bt[n][k], At[m][k], acc[ai][bj][m][n], 0, 0, 0); __builtin_amdgcn_s_setprio(0); } while (0)
#define PG8_WAIT_V(n) asm volatile("s_waitcnt vmcnt(" #n ")" ::: "memory")
#define PG8_WAIT_L(n) asm volatile("s_waitcnt lgkmcnt(" #n ")" ::: "memory")
#define PG8_BAR __builtin_amdgcn_s_barrier()
#define PG8_SCHED __builtin_amdgcn_sched_barrier(0)
    Unit cur, nxt; int ui = 0;
    if (!S.next(0, cur)) return;
    f32x4 acc[2][2][4][2];
#pragma unroll
    for (int a = 0; a < 2; ++a)
#pragma unroll
        for (int b = 0; b < 2; ++b)
#pragma unroll
            for (int m = 0; m < 4; ++m)
#pragma unroll
                for (int n = 0; n < 2; ++n) acc[a][b][m][n] = (f32x4){0.f, 0.f, 0.f, 0.f};
    bf16x8 At[4][2], B0[2][2], B1[2][2];
    const char* cA = (const char*)g.A + a_off<Epi>(E, cur.pm, K, tstep); const char* cB = (const char*)g.Bt + (size_t)cur.pn * tstep;
    if constexpr (SP2) {
        PG8_STAGE(PG8_SB(0, 0), cB, voffB); PG8_STAGE(PG8_SB(0, 1), cB + hstep, voffB); PG8_STAGE(PG8_SA(0, 0), cA, voffA); PG8_STAGE(PG8_SA(0, 1), cA + hstep, voffA);
        if (wr == 1) PG8_BAR;
        PG8_WAIT_V(2); PG8_BAR;
        PG8_STAGE(PG8_SB(1, 0), cB + kstep, voffB); PG8_STAGE(PG8_SA(1, 0), cA + kstep, voffA); PG8_STAGE(PG8_SB(1, 1), cB + hstep + kstep, voffB);
        PG8_WAIT_V(6); PG8_BAR;
    } else {
        PG8_STAGE(PG8_SB(0, 0), cB, voffB); PG8_STAGE(PG8_SA(0, 0), cA, voffA); PG8_STAGE(PG8_SB(0, 1), cB + hstep, voffB); PG8_STAGE(PG8_SA(0, 1), cA + hstep, voffA);
        if (wr == 1) PG8_BAR;
        PG8_WAIT_V(4); PG8_BAR;
        PG8_STAGE(PG8_SB(1, 0), cB + kstep, voffB); PG8_STAGE(PG8_SA(1, 0), cA + kstep, voffA); PG8_STAGE(PG8_SB(1, 1), cB + hstep + kstep, voffB);
        PG8_WAIT_V(6); PG8_BAR;
    }
    for (;;) {
        const bool has_next = S.next(ui + 1, nxt);
        const char* nA = has_next ? (const char*)g.A + a_off<Epi>(E, nxt.pm, K, tstep) : cA; const char* nB = has_next ? (const char*)g.Bt + (size_t)nxt.pn * tstep : cB;
#pragma unroll 1
        for (int t = 0; t < nt; t += 2) {
            const bool last = (t == nt - 2);
            if constexpr (Epi::MID) { if (t == nt / 2) E.mid(acc, cur, wr, wc, fr, fq); }
            const char* a1 = cA + (size_t)(t + 1) * kstep;
            const char* a2 = last ? nA : cA + (size_t)(t + 2) * kstep; const char* b2 = last ? nB : cB + (size_t)(t + 2) * kstep;
            const char* a3 = a2 + kstep; const char* b3 = b2 + kstep;
            if constexpr (SP2) {
            PG8_LDB(B0, 0, 0); PG8_LDB(B1, 0, 1); PG8_SCHED; PG8_LDA(At, 0, 0); PG8_STAGE(PG8_SA(1, 1), a1 + hstep, voffA);
            PG8_WAIT_V(8); PG8_WAIT_L(0); PG8_BAR; PG8_MMA(0, 0, At, B0); PG8_MMA(0, 1, At, B1); PG8_BAR; PG8_SCHED;
            PG8_LDA(At, 0, 1); PG8_STAGE(PG8_SB(0, 0), b2, voffB); PG8_STAGE(PG8_SB(0, 1), b2 + hstep, voffB); PG8_STAGE(PG8_SA(0, 0), a2, voffA);
            PG8_WAIT_V(8); PG8_WAIT_L(0); PG8_BAR; PG8_MMA(1, 0, At, B0); PG8_MMA(1, 1, At, B1); PG8_BAR; PG8_SCHED;
            PG8_LDB(B0, 1, 0); PG8_LDB(B1, 1, 1); PG8_SCHED; PG8_LDA(At, 1, 0); PG8_STAGE(PG8_SA(0, 1), a2 + hstep, voffA);
            PG8_WAIT_V(8); PG8_WAIT_L(0); PG8_BAR; PG8_MMA(0, 0, At, B0); PG8_MMA(0, 1, At, B1); PG8_BAR; PG8_SCHED;
            PG8_LDA(At, 1, 1); PG8_STAGE(PG8_SB(1, 0), b3, voffB); PG8_STAGE(PG8_SB(1, 1), b3 + hstep, voffB); PG8_STAGE(PG8_SA(1, 0), a3, voffA);
            PG8_WAIT_V(8); PG8_WAIT_L(0); PG8_BAR; PG8_MMA(1, 0, At, B0); PG8_MMA(1, 1, At, B1); PG8_BAR; PG8_SCHED;
            } else {
            PG8_LDB(B0, 0, 0); PG8_SCHED; PG8_LDA(At, 0, 0); PG8_STAGE(PG8_SA(1, 1), a1 + hstep, voffA);
            PG8_WAIT_L(8); PG8_BAR; PG8_WAIT_L(0); PG8_MMA(0, 0, At, B0); PG8_BAR; PG8_SCHED;
            PG8_LDB(B1, 0, 1); PG8_STAGE(PG8_SB(0, 0), b2, voffB);
            PG8_BAR; PG8_WAIT_L(0); PG8_MMA(0, 1, At, B1); PG8_BAR;
            PG8_LDA(At, 0, 1); PG8_STAGE(PG8_SA(0, 0), a2, voffA);
            PG8_BAR; PG8_WAIT_L(0); PG8_MMA(1, 0, At, B0); PG8_BAR; PG8_SCHED;
            PG8_STAGE(PG8_SB(0, 1), b2 + hstep, voffB);
            PG8_WAIT_V(6); PG8_BAR; PG8_MMA(1, 1, At, B1); PG8_BAR;
            PG8_LDB(B0, 1, 0); PG8_SCHED; PG8_LDA(At, 1, 0); PG8_STAGE(PG8_SA(0, 1), a2 + hstep, voffA);
            PG8_WAIT_L(8); PG8_BAR; PG8_WAIT_L(0); PG8_MMA(0, 0, At, B0); PG8_BAR; PG8_SCHED;
            PG8_LDB(B1, 1, 1); PG8_STAGE(PG8_SB(1, 0), b3, voffB);
            PG8_BAR; PG8_WAIT_L(0); PG8_MMA(0, 1, At, B1); PG8_BAR;
            PG8_LDA(At, 1, 1); PG8_STAGE(PG8_SA(1, 0), a3, voffA);
            PG8_BAR; PG8_WAIT_L(0); PG8_MMA(1, 0, At, B0); PG8_BAR; PG8_SCHED;
            PG8_STAGE(PG8_SB(1, 1), b3 + hstep, voffB);
            PG8_WAIT_V(6); PG8_BAR; PG8_MMA(1, 1, At, B1); PG8_BAR;
            }
        }
        if constexpr (ALIGN_EPI) { if (wr == 0) PG8_BAR; }
        E(acc, cur, wr, wc, fr, fq);
        if (!has_next) break;
#pragma unroll
        for (int a = 0; a < 2; ++a)
#pragma unroll
            for (int b = 0; b < 2; ++b)
#pragma unroll
                for (int m = 0; m < 4; ++m)
#pragma unroll
                    for (int n = 0; n < 2; ++n) acc[a][b][m][n] = (f32x4){0.f, 0.f, 0.f, 0.f};
        cur = nxt; cA = nA; cB = nB; ++ui;
        if constexpr (ALIGN_EPI) { if (wr == 1) PG8_BAR; }
    }
    PG8_WAIT_V(0);
    if constexpr (!ALIGN_EPI) { if (wr == 0) PG8_BAR; }
    PG8_BAR;
#undef PG8_SA
#undef PG8_SB
#undef PG8_STAGE
#undef PG8_LDA
#undef PG8_LDB
#undef PG8_MMA
#undef PG8_WAIT_V
#undef PG8_WAIT_L
#undef PG8_BAR
#undef PG8_SCHED
}
}
using pg8::HALF;

DEVI u32x4 pack8(const f32x4& a, const f32x4& b) { u32x4 w; w.x = pk2(a[0], a[1]); w.y = pk2(a[2], a[3]); w.z = pk2(b[0], b[1]); w.w = pk2(b[2], b[3]); return w; }

struct EpiIn {
    static constexpr bool PERM = true, MID = false, AROW = false;
    const float* rowss; const float* shW; int job;
    bf16_t *d0, *d1, *d2, *d3, *d4; float* ba;
    DEVI void operator()(const f32x4 (&acc)[2][2][4][2], const pg8::Unit& u, int wr, int wc, int fr, int fq) const {
        asm volatile("" : "+v"(fr), "+v"(fq));
        const int vs = u.pm < 64 ? 0 : (u.pm < 128 ? 1 : 2);
        bf16_t* base; int pitch, colt; bool isba = false;
        if (job == 0) { base = d0; pitch = 3072; colt = u.pn * 256; if (u.pn >= 12) isba = true; }
        else {
            if (u.pn < 4) { base = d0; pitch = 1024; colt = u.pn * 256; }
            else if (u.pn < 8) { base = d1; pitch = 1024; colt = (u.pn - 4) * 256; }
            else if (u.pn == 8) { base = d2; pitch = 256; colt = 0; }
            else if (u.pn == 9) { base = d3; pitch = 256; colt = 0; }
            else { base = d4; pitch = 2048; colt = (u.pn - 10) * 256; }
        }
        const int ncol0 = u.pn * 256 + wc * 32 + 8 * fq;
        f32x4 sv[2][2];
#pragma unroll
        for (int bj = 0; bj < 2; ++bj)
#pragma unroll
            for (int n = 0; n < 2; ++n) sv[bj][n] = *(const f32x4*)(shW + vs * NSH + ncol0 + bj * HALF + 4 * n);
        const int row0 = u.pm * 256 + wr * 64 + fr;
#pragma unroll
        for (int ai = 0; ai < 2; ++ai)
#pragma unroll
            for (int m = 0; m < 4; ++m) {
                const int row = row0 + ai * HALF + m * 16;
                const float rs = rsqrtf(rowss[row] * (1.f / 1024.f) + EPS);
                if (!isba) {
                    bf16_t* rowp = base + (size_t)row * pitch + colt + wc * 32 + 8 * fq;
#pragma unroll
                    for (int bj = 0; bj < 2; ++bj) { const f32x4 v0 = acc[ai][bj][m][0] * rs + sv[bj][0], v1 = acc[ai][bj][m][1] * rs + sv[bj][1]; *(u32x4*)(rowp + bj * HALF) = pack8(v0, v1); }
                } else if (wc == 0) {
                    float* rowp = ba + (size_t)row * 32 + 8 * fq;
                    *(f32x4*)(rowp) = acc[ai][0][m][0] * rs + sv[0][0]; *(f32x4*)(rowp + 4) = acc[ai][0][m][1] * rs + sv[0][1];
                }
            }
    }
};
struct TailOrder { int idx; __device__ bool next(int i, pg8::Unit& u) const { if (i == 0 && idx >= 0 && idx < 4) { u.pm = idx >> 1; u.pn = idx & 1; return true; } return false; } };
struct EpiCtxKV {
    static constexpr bool PERM = true, MID = false, AROW = false;
    const float* rowss; const float* shW; bf16_t* kat; bf16_t* vat;
    DEVI void operator()(const f32x4 (&acc)[2][2][4][2], const pg8::Unit& u, int wr, int wc, int fr, int fq) const {
        asm volatile("" : "+v"(fr), "+v"(fq));
        bf16_t* base = (u.pn == 0 ? kat : vat);
        const int ncol0 = u.pn * 256 + wc * 32 + 8 * fq;
#pragma unroll
        for (int bj = 0; bj < 2; ++bj) {
            const f32x4 sv0 = *(const f32x4*)(shW + ncol0 + bj * HALF), sv1 = *(const f32x4*)(shW + ncol0 + bj * HALF + 4);
#pragma unroll
            for (int ai = 0; ai < 2; ++ai)
#pragma unroll
                for (int m = 0; m < 4; ++m) { const int row = u.pm * 256 + ai * HALF + wr * 64 + m * 16 + fr;
                    const float rs = rsqrtf(rowss[row] * (1.f / 1024.f) + EPS);
                    *(u32x4*)(base + (size_t)row * 256 + wc * 32 + 8 * fq + bj * HALF) = pack8(acc[ai][bj][m][0] * rs + sv0, acc[ai][bj][m][1] * rs + sv1); }
        }
    }
};
struct EpiBr {
    static constexpr bool PERM = true, MID = true, AROW = false;
    const bf16_t* mg; bf16_t* out;
    DEVI void mid(f32x4 (&acc)[2][2][4][2], const pg8::Unit& u, int wr, int wc, int fr, int fq) const {
        asm volatile("" : "+v"(fr), "+v"(fq));
        const int row0 = u.pm * 256 + wr * 64 + fr, col0 = u.pn * 256 + wc * 32 + 8 * fq;
#pragma unroll
        for (int ai = 0; ai < 2; ++ai)
#pragma unroll
            for (int m = 0; m < 4; ++m) {
                const bf16_t* rp = mg + (size_t)(row0 + ai * HALF + m * 16) * 2048 + col0;
#pragma unroll
                for (int bj = 0; bj < 2; ++bj) {
                    const u32x4 gd = *(const u32x4*)(rp + bj * HALF), ga = *(const u32x4*)(rp + 1024 + bj * HALF);
                    float r[8];
#pragma unroll
                    for (int i = 0; i < 4; ++i) {
                        const float d0 = bflo(gd[i]), d1 = bfhi(gd[i]), a0 = bflo(ga[i]), a1 = bfhi(ga[i]);
                        r[2 * i] = (1.f + __expf(fminf(-a0, 80.f))) * __builtin_amdgcn_rcpf(1.f + __expf(fminf(-d0, 80.f)));
                        r[2 * i + 1] = (1.f + __expf(fminf(-a1, 80.f))) * __builtin_amdgcn_rcpf(1.f + __expf(fminf(-d1, 80.f)));
                    }
                    acc[ai][bj][m][0] *= (f32x4){r[0], r[1], r[2], r[3]}; acc[ai][bj][m][1] *= (f32x4){r[4], r[5], r[6], r[7]};
                    asm volatile("" ::: "memory");
                }
            }
    }
    DEVI void operator()(const f32x4 (&acc)[2][2][4][2], const pg8::Unit& u, int wr, int wc, int fr, int fq) const {
        asm volatile("" : "+v"(fr), "+v"(fq));
        const int row0 = u.pm * 256 + wr * 64 + fr, col0 = u.pn * 256 + wc * 32 + 8 * fq;
#pragma unroll
        for (int ai = 0; ai < 2; ++ai)
#pragma unroll
            for (int m = 0; m < 4; ++m) {
                const size_t row = (size_t)(row0 + ai * HALF + m * 16);
                const bf16_t* rp = mg + row * 2048 + 1024 + col0;
#pragma unroll
                for (int bj = 0; bj < 2; ++bj) {
                    const u32x4 ga = *(const u32x4*)(rp + bj * HALF);
                    float s[8];
#pragma unroll
                    for (int i = 0; i < 4; ++i) { s[2 * i] = __builtin_amdgcn_rcpf(1.f + __expf(fminf(-bflo(ga[i]), 80.f))); s[2 * i + 1] = __builtin_amdgcn_rcpf(1.f + __expf(fminf(-bfhi(ga[i]), 80.f))); }
                    const f32x4 v0 = acc[ai][bj][m][0] * (f32x4){s[0], s[1], s[2], s[3]}, v1 = acc[ai][bj][m][1] * (f32x4){s[4], s[5], s[6], s[7]};
                    *(u32x4*)(out + row * 1024 + col0 + bj * HALF) = pack8(v0, v1);
                }
            }
    }
};
struct EpiOut {
    static constexpr bool PERM = false, MID = false, AROW = false;
    const float* x; const float* modacc; const float* bada; const float* nwf; float* out; bf16_t* x1s; float* rowss2;
    DEVI void operator()(const f32x4 (&acc)[2][2][4][2], const pg8::Unit& u, int wr, int wc, int fr, int fq) const {
        asm volatile("" : "+v"(fr), "+v"(fq));
        const int b = u.pm >> 6; const int row0 = u.pm * 256 + wr * 64 + fr, col0 = u.pn * 256 + wc * 32 + 4 * fq;
        f32x4 ga[2][2], sc[2][2];
#pragma unroll
        for (int bj = 0; bj < 2; ++bj)
#pragma unroll
            for (int n = 0; n < 2; ++n) { const int c = col0 + bj * HALF + n * 16;
                ga[bj][n] = *(const f32x4*)(modacc + b * 6144 + 2048 + c) + *(const f32x4*)(bada + 2048 + c);
                sc[bj][n] = (*(const f32x4*)(modacc + b * 6144 + 4096 + c) + *(const f32x4*)(bada + 4096 + c) + 1.f) * *(const f32x4*)(nwf + c); }
#pragma unroll
        for (int ai = 0; ai < 2; ++ai)
#pragma unroll
            for (int m = 0; m < 4; ++m) {
                const size_t off = (size_t)(row0 + ai * HALF + m * 16) * 1024 + col0; float ss = 0.f;
#pragma unroll
                for (int bj = 0; bj < 2; ++bj)
#pragma unroll
                    for (int n = 0; n < 2; ++n) {
                        const f32x4 xv = *(const f32x4*)(x + off + bj * HALF + n * 16);
                        const f32x4 o = xv + ga[bj][n] * acc[ai][bj][m][n];
                        *(f32x4*)(out + off + bj * HALF + n * 16) = o;
                        ss += (o[0] * o[0] + o[1] * o[1]) + (o[2] * o[2] + o[3] * o[3]);
                        const f32x4 s = o * sc[bj][n]; u32x2 w; w.x = pk2(s[0], s[1]); w.y = pk2(s[2], s[3]);
                        *(u32x2*)(x1s + off + (size_t)(b * (RB - SEQ) + 1) * 1024 + bj * HALF + n * 16) = w;
                    }
                ss += __shfl_xor(ss, 16); ss += __shfl_xor(ss, 32);
                if (fq == 0) atomicAdd(rowss2 + row0 + ai * HALF + m * 16, ss);
            }
    }
};
DEVI f32x4 dpp_ror1(const f32x4& x) { f32x4 r;
#pragma unroll
    for (int i = 0; i < 4; ++i) r[i] = __int_as_float(__builtin_amdgcn_update_dpp(0, __float_as_int(x[i]), 0x121, 0xf, 0xf, false));
    return r; }
DEVI f32x4 dpp_rol1(const f32x4& x) { f32x4 r;
#pragma unroll
    for (int i = 0; i < 4; ++i) r[i] = __int_as_float(__builtin_amdgcn_update_dpp(0, __float_as_int(x[i]), 0x12F, 0xf, 0xf, false));
    return r; }
struct EpiUpConv {
    static constexpr bool PERM = true, MID = false, AROW = true;
    const float* rowss2; const float* shWf; const float* cw; const float* cb; bf16_t* act; LAS float* xb;
    DEVI int arow(int pm) const { const int b = pm / TPB, i = pm - b * TPB; return b * RB + 254 * i; }
    DEVI void operator()(f32x4 (&acc)[2][2][4][2], const pg8::Unit& u, int wr, int wc, int fr, int fq) const {
        asm volatile("" : "+v"(fr), "+v"(fq));
        const int b = u.pm / TPB, ti = u.pm - b * TPB, tok0 = 254 * ti - 1;
        const int cl0 = wc * 32 + 8 * fq;
#pragma unroll
        for (int bj = 0; bj < 2; ++bj) {
            const f32x4 sv0 = *(const f32x4*)(shWf + b * NUP + u.pn * 256 + bj * HALF + cl0), sv1 = *(const f32x4*)(shWf + b * NUP + u.pn * 256 + bj * HALF + cl0 + 4);
#pragma unroll
            for (int ai = 0; ai < 2; ++ai)
#pragma unroll
                for (int m = 0; m < 4; ++m) {
                    const int tok = tok0 + ai * HALF + wr * 64 + m * 16 + fr; const bool ok = tok >= 0 && tok < SEQ;
                    const float rs = ok ? rsqrtf(rowss2[b * SEQ + (ok ? tok : 0)] * (1.f / 1024.f) + EPS) : 0.f;
                    acc[ai][bj][m][0] = ok ? acc[ai][bj][m][0] * rs + sv0 : (f32x4){0.f, 0.f, 0.f, 0.f};
                    acc[ai][bj][m][1] = ok ? acc[ai][bj][m][1] * rs + sv1 : (f32x4){0.f, 0.f, 0.f, 0.f};
                }
        }
#pragma unroll
        for (int ai = 0; ai < 2; ++ai) { const int blk = 2 * ai + wr;
#pragma unroll
            for (int bj = 0; bj < 2; ++bj)
#pragma unroll
                for (int n = 0; n < 2; ++n) {
                    if (fr == 0) *(LAS f32x4*)(xb + (blk * 2 + 0) * 256 + bj * HALF + cl0 + 4 * n) = acc[ai][bj][0][n];
                    if (fr == 15) *(LAS f32x4*)(xb + (blk * 2 + 1) * 256 + bj * HALF + cl0 + 4 * n) = acc[ai][bj][3][n];
                } }
        asm volatile("s_waitcnt lgkmcnt(0)" ::: "memory"); __builtin_amdgcn_s_barrier(); asm volatile("" ::: "memory");
        const int f0 = u.pn * 128 + cl0;
#pragma unroll
        for (int n = 0; n < 2; ++n) {
            f32x4 wg[3], wv[3];
#pragma unroll
            for (int j = 0; j < 3; ++j) { wg[j] = *(const f32x4*)(cw + j * NUP + f0 + 4 * n); wv[j] = *(const f32x4*)(cw + j * NUP + DFF + f0 + 4 * n); }
            const f32x4 bgv = *(const f32x4*)(cb + f0 + 4 * n), bvv = *(const f32x4*)(cb + DFF + f0 + 4 * n);
#pragma unroll
            for (int ai = 0; ai < 2; ++ai) { const int blk = 2 * ai + wr;
                const f32x4 pgx = *(const LAS f32x4*)(xb + (((blk + 3) & 3) * 2 + 1) * 256 + cl0 + 4 * n), pvx = *(const LAS f32x4*)(xb + (((blk + 3) & 3) * 2 + 1) * 256 + HALF + cl0 + 4 * n);
                const f32x4 ngx = *(const LAS f32x4*)(xb + (((blk + 1) & 3) * 2 + 0) * 256 + cl0 + 4 * n), nvx = *(const LAS f32x4*)(xb + (((blk + 1) & 3) * 2 + 0) * 256 + HALF + cl0 + 4 * n);
#pragma unroll
                for (int m = 0; m < 4; ++m) {
                    f32x4 ug, uv;
                    { const f32x4 c = acc[ai][0][m][n], up = m > 0 ? acc[ai][0][m > 0 ? m - 1 : 0][n] : pgx, dn = m < 3 ? acc[ai][0][m < 3 ? m + 1 : 3][n] : ngx;
                      f32x4 pr = dpp_ror1(fr == 15 ? up : c), nx = dpp_rol1(fr == 0 ? dn : c);
                      asm volatile("" : "+v"(pr), "+v"(nx));
                      ug = bgv + wg[0] * pr + wg[1] * c + wg[2] * nx; }
                    { const f32x4 c = acc[ai][1][m][n], up = m > 0 ? acc[ai][1][m > 0 ? m - 1 : 0][n] : pvx, dn = m < 3 ? acc[ai][1][m < 3 ? m + 1 : 3][n] : nvx;
                      f32x4 pr = dpp_ror1(fr == 15 ? up : c), nx = dpp_rol1(fr == 0 ? dn : c);
                      asm volatile("" : "+v"(pr), "+v"(nx));
                      uv = bvv + wv[0] * pr + wv[1] * c + wv[2] * nx; }
                    const int r = ai * HALF + wr * 64 + m * 16 + fr, tok = tok0 + r;
                    if (r >= 1 && r <= 254 && tok < SEQ) {
                        u32x2 w; w.x = pk2(siluf(ug[0]) * uv[0], siluf(ug[1]) * uv[1]); w.y = pk2(siluf(ug[2]) * uv[2], siluf(ug[3]) * uv[3]);
                        *(u32x2*)(act + (size_t)(b * SEQ + tok) * DFF + f0 + 4 * n) = w; }
                    asm volatile("" ::: "memory");
                }
            }
        }
    }
};
struct EpiDown {
    static constexpr bool PERM = false, MID = false, AROW = false;
    const float* modacc; const float* bada; float* out;
    DEVI void operator()(const f32x4 (&acc)[2][2][4][2], const pg8::Unit& u, int wr, int wc, int fr, int fq) const {
        asm volatile("" : "+v"(fr), "+v"(fq));
        const int b = u.pm >> 6; const int row0 = u.pm * 256 + wr * 64 + fr, col0 = u.pn * 256 + wc * 32 + 4 * fq;
        f32x4 gf[2][2];
#pragma unroll
        for (int bj = 0; bj < 2; ++bj)
#pragma unroll
            for (int n = 0; n < 2; ++n) { const int c = col0 + bj * HALF + n * 16; gf[bj][n] = *(const f32x4*)(modacc + b * 6144 + 5120 + c) + *(const f32x4*)(bada + 5120 + c); }
#pragma unroll
        for (int ai = 0; ai < 2; ++ai)
#pragma unroll
            for (int m = 0; m < 4; ++m) {
                const size_t off = (size_t)(row0 + ai * HALF + m * 16) * 1024 + col0;
#pragma unroll
                for (int bj = 0; bj < 2; ++bj)
#pragma unroll
                    for (int n = 0; n < 2; ++n) { float* p = out + off + bj * HALF + n * 16; *(f32x4*)p = *(const f32x4*)p + gf[bj][n] * acc[ai][bj][m][n]; }
            }
    }
};

DEVI void transpose_item(const float* W, int srcN, int k0, int n0, bf16_t* dst  , int dstK, LAS float* scr, int lane) {
#pragma unroll
    for (int i = 0; i < 8; ++i) { const int kk = 8 * i + (lane >> 3), n4 = (lane & 7) * 4; const f32x4 v = *(const f32x4*)(W + (size_t)(k0 + kk) * srcN + n0 + n4);
        LAS float* d = scr + kk * 33 + n4; d[0] = v[0]; d[1] = v[1]; d[2] = v[2]; d[3] = v[3]; }
    asm volatile("s_waitcnt lgkmcnt(0)" ::: "memory");
    const int c = lane & 7;
#pragma unroll
    for (int j = 0; j < 4; ++j) { const int n = (lane >> 3) + 8 * j; const LAS float* s = scr + (8 * c) * 33 + n;
        u32x4 o; o.x = pk2(s[0 * 33], s[1 * 33]); o.y = pk2(s[2 * 33], s[3 * 33]); o.z = pk2(s[4 * 33], s[5 * 33]); o.w = pk2(s[6 * 33], s[7 * 33]);
        *(u32x4*)(dst + (size_t)n * dstK + 8 * c) = o; }
    asm volatile("s_waitcnt lgkmcnt(0)" ::: "memory");
}
DEVI void phase0(const KA& a, LAS unsigned char* lds, int tid, int lane, int wave) {
    unsigned char* ws = a.ws();
    bf16_t* WinA = (bf16_t*)(ws + WS_WINA); bf16_t* WinC = (bf16_t*)(ws + WS_WINC); bf16_t* Wbr = (bf16_t*)(ws + WS_WBR);
    bf16_t* Wout = (bf16_t*)(ws + WS_WOUT); bf16_t* Wup = (bf16_t*)(ws + WS_WUP); bf16_t* Wdn = (bf16_t*)(ws + WS_WDN);
    LAS float* scr = (LAS float*)(lds + wave * 16384);
    const int gw = blockIdx.x * 8 + wave, NGW = gridDim.x * 8;
    constexpr int I_IN = 16 * 241, I_BR = 16 * 32, I_UP = 16 * 176, I_DN = 44 * 32;
    constexpr int NITEMS = I_IN + 3 * I_BR + I_UP + I_DN;
    for (int it = gw; it < NITEMS; it += NGW) {
        int r = it;
        if (r < I_IN) { const int kb = r / 241, nb = r % 241, c0 = nb * 32; bf16_t* d; int row;
            if (c0 < 3072) { d = WinA; row = c0; } else if (c0 < 4096) { d = WinC; row = c0 - 3072; } else if (c0 == 4096) { d = WinA; row = 3072; }
            else if (c0 < 5152) { d = WinC; row = 1024 + (c0 - 4128); } else if (c0 < 5408) { d = WinC; row = 2048 + (c0 - 5152); }
            else if (c0 < 5664) { d = WinC; row = 2304 + (c0 - 5408); } else { d = WinC; row = 2560 + (c0 - 5664); }
            transpose_item(a.in(8), 7712, kb * 64, c0, d + (size_t)row * 1024 + kb * 64, 1024, scr, lane); continue; }
        r -= I_IN;
        if (r < I_BR) { const int kb = r / 32, nb = r % 32; transpose_item(a.in(16), 1024, kb * 64, nb * 32, Wbr + (size_t)(nb * 32) * 2048 + kb * 64, 2048, scr, lane); continue; }
        r -= I_BR;
        if (r < I_BR) { const int kb = r / 32, nb = r % 32; transpose_item(a.in(17), 1024, kb * 64, nb * 32, Wbr + (size_t)(nb * 32) * 2048 + 1024 + kb * 64, 2048, scr, lane); continue; }
        r -= I_BR;
        if (r < I_BR) { const int kb = r / 32, nb = r % 32; transpose_item(a.in(18), 1024, kb * 64, nb * 32, Wout + (size_t)(nb * 32) * 1024 + kb * 64, 1024, scr, lane); continue; }
        r -= I_BR;
        if (r < I_UP) { const int kb = r / 176, nb = r % 176, c0 = nb * 32; int row;
            if (c0 < DFF) row = 256 * (c0 / 128) + (c0 % 128); else { const int c1 = c0 - DFF; row = 256 * (c1 / 128) + 128 + (c1 % 128); }
            transpose_item(a.in(19), NUP, kb * 64, c0, Wup + (size_t)row * 1024 + kb * 64, 1024, scr, lane); continue; }
        r -= I_UP;
        { const int kb = r / 32, nb = r % 32; transpose_item(a.in(22), 1024, kb * 64, nb * 32, Wdn + (size_t)(nb * 32) * DFF + kb * 64, DFF, scr, lane); }
    }
    float* modacc = (float*)(ws + CTL_MODACC);
    for (int it = blockIdx.x; it < 12 * 16; it += gridDim.x) {
        const int cb = it % 12, ks = it / 12, n = cb * 512 + tid;
        float a0 = 0.f, a1 = 0.f, a2 = 0.f;
#pragma unroll 8
        for (int k = ks * 64; k < ks * 64 + 64; ++k) {
            const float w = a.in(4)[(size_t)k * 6144 + n];
            a0 += siluf(a.in(1)[k]) * w; a1 += siluf(a.in(1)[1024 + k]) * w; a2 += siluf(a.in(3)[k]) * w;
        }
        atomicAdd(modacc + n, a0); atomicAdd(modacc + 6144 + n, a1); atomicAdd(modacc + 12288 + n, a2);
    }
    float* rope = (float*)(ws + SM_ROPE);
    for (int i = blockIdx.x * 512 + tid; i < 320 * 32; i += gridDim.x * 512) {
        const int p = i >> 5, f = i & 31; const float inv = powf(10000.f, -(float)f / 32.f);
        if (p < 256) { const float ang = (float)p * inv; rope[p * 32 + f] = cosf(ang); rope[8192 + p * 32 + f] = sinf(ang); }
        else { const int q = p - 256; const float ang = (float)q * inv; rope[16384 + q * 32 + f] = cosf(ang); rope[16384 + 2048 + q * 32 + f] = sinf(ang); }
    }
}

DEVI void phase1(const KA& a, int tid, int lane, int wave) {
    unsigned char* ws = a.ws();
    const float* modacc = (const float*)(ws + CTL_MODACC); const float* bada = a.in(5);
    bf16_t* XN = (bf16_t*)(ws + WS_XN); float* rowss1 = (float*)(ws + SM_ROWSS1);
    const int gw = blockIdx.x * 8 + wave, NGW = gridDim.x * 8;
    {
        const int per = (MT + NGW - 1) / NGW, rbeg = gw * per, rend = rbeg + per < MT ? rbeg + per : MT;
        int vcur = -1; f32x4 sc[4];
        for (int row = rbeg; row < rend; row += 2) {
            const int vs = row < SEQ ? 0 : (row < ML ? 1 : 2);
            if (vs != vcur) { vcur = vs;
#pragma unroll
                for (int j = 0; j < 4; ++j) { const int c = 4 * lane + 256 * j; sc[j] = (*(const f32x4*)(modacc + vs * 6144 + 1024 + c) + *(const f32x4*)(bada + 1024 + c) + 1.f) * *(const f32x4*)(a.in(6) + c); } }
            const int row1 = row + 1; const bool two = row1 < rend && (row1 < SEQ ? 0 : (row1 < ML ? 1 : 2)) == vs;
            const float* xr0 = row < ML ? a.in(0) + (size_t)row * 1024 : a.in(2) + (size_t)(row - ML) * 1024;
            const float* xr1 = two ? (row1 < ML ? a.in(0) + (size_t)row1 * 1024 : a.in(2) + (size_t)(row1 - ML) * 1024) : xr0;
            f32x4 v0[4], v1[4];
#pragma unroll
            for (int j = 0; j < 4; ++j) { v0[j] = *(const f32x4*)(xr0 + 4 * lane + 256 * j); v1[j] = *(const f32x4*)(xr1 + 4 * lane + 256 * j); }
            float s0 = 0.f, s1 = 0.f;
#pragma unroll
            for (int j = 0; j < 4; ++j) { const int c = 4 * lane + 256 * j;
                s0 += (v0[j][0] * v0[j][0] + v0[j][1] * v0[j][1]) + (v0[j][2] * v0[j][2] + v0[j][3] * v0[j][3]);
                s1 += (v1[j][0] * v1[j][0] + v1[j][1] * v1[j][1]) + (v1[j][2] * v1[j][2] + v1[j][3] * v1[j][3]);
                const f32x4 o0 = v0[j] * sc[j], o1 = v1[j] * sc[j];
                u32x2 w; w.x = pk2(o0[0], o0[1]); w.y = pk2(o0[2], o0[3]); *(u32x2*)(XN + (size_t)row * 1024 + c) = w;
                if (two) { u32x2 w1; w1.x = pk2(o1[0], o1[1]); w1.y = pk2(o1[2], o1[3]); *(u32x2*)(XN + (size_t)row1 * 1024 + c) = w1; } }
            s0 = wave_sum(s0); s1 = wave_sum(s1);
            if (lane == 0) { rowss1[row] = s0; if (two) rowss1[row1] = s1; }
            if (!two) --row;
        }
    }
    const bf16_t* WinA = (const bf16_t*)(ws + WS_WINA); const bf16_t* WinC = (const bf16_t*)(ws + WS_WINC); const bf16_t* Wup = (const bf16_t*)(ws + WS_WUP);
    float* shWa = (float*)(ws + SM_SHWA); float* shWf = (float*)(ws + SM_SHWF);
    for (int n = gw; n < NSH + NUP; n += NGW) {
        const bool isf = n >= NSH;
        const bf16_t* wrow = isf ? Wup + (size_t)(n - NSH) * 1024 : (n < NA ? WinA + (size_t)n * 1024 : WinC + (size_t)(n - NA) * 1024);
        const int shoff = isf ? 3072 : 0;
        float s0 = 0.f, s1 = 0.f, s2 = 0.f;
#pragma unroll
        for (int h = 0; h < 2; ++h) {
            const int k0 = h * 512 + lane * 8;
            const u32x4 w = *(const u32x4*)(wrow + k0);
#pragma unroll
            for (int i = 0; i < 4; ++i) {
                const float wl = bflo(w[i]), wh = bfhi(w[i]); const int k = k0 + 2 * i;
                const float b0 = bada[shoff + k], b1 = bada[shoff + k + 1];
                s0 += (modacc[shoff + k] + b0) * wl + (modacc[shoff + k + 1] + b1) * wh;
                s1 += (modacc[6144 + shoff + k] + b0) * wl + (modacc[6144 + shoff + k + 1] + b1) * wh;
                s2 += (modacc[12288 + shoff + k] + b0) * wl + (modacc[12288 + shoff + k + 1] + b1) * wh;
            }
        }
        s0 = wave_sum(s0); s1 = wave_sum(s1); s2 = wave_sum(s2);
        if (lane == 0) {
            if (isf) { shWf[n - NSH] = s0; shWf[NUP + n - NSH] = s1; }
            else { shWa[n] = s0; shWa[NSH + n] = s1; shWa[2 * NSH + n] = s2; }
        }
    }
}

DEVI u32x4 ldrow_(const bf16_t* base, int seq_start, int seq_len, int tt) {
    const int tc = tt < 0 ? 0 : (tt >= seq_len ? seq_len - 1 : tt);
    const u32x4 v = *(const u32x4*)(base + (size_t)(seq_start + tc) * 3072);
    const unsigned m = (tt == tc) ? 0xffffffffu : 0u;
    return (u32x4){v[0] & m, v[1] & m, v[2] & m, v[3] & m};
}
DEVI void phase_dnprep(const KA& a, int tid) {
    unsigned char* ws = a.ws();
    const bf16_t* QR = (const bf16_t*)(ws + WS_QKVR); bf16_t* QP = (bf16_t*)(ws + WS_QKVP);
    const float* convw = a.in(9); const float* ba = (const float*)(ws + WS_BA);
    float* gb = (float*)(ws + WS_G); float* bb = (float*)(ws + WS_BETA);
    const int cgp = tid & 127, strip = tid >> 7;
    u32x4 cur[20], nxt[20];
#define PREP_GEOM(it_, seq_start_, t0_, seq_len_, col_) const int cidx_ = (it_) / 3, sec_ = (it_) - cidx_ * 3; int seq_start_, t0_, seq_len_; \
        if (cidx_ < 512) { seq_start_ = (cidx_ >> 8) * SEQ; t0_ = (cidx_ & 255) * 64; seq_len_ = SEQ; } \
        else { const int c2_ = cidx_ - 512; seq_start_ = ML + (c2_ >> 2) * CTX; t0_ = (c2_ & 3) * 64; seq_len_ = CTX; } \
        const int col_ = sec_ * 1024 + cgp * 8;
#define PREP_LOAD(dst, it_) do { PREP_GEOM(it_, ss_, t0__, sl_, cl_) const int tb_ = t0__ + strip * 16; \
        _Pragma("unroll") for (int r = 0; r < 20; ++r) dst[r] = ldrow_(QR + cl_, ss_, sl_, tb_ + r - 2); } while (0)
    if ((int)blockIdx.x < 520 * 3) PREP_LOAD(cur, (int)blockIdx.x);
    for (int it = blockIdx.x; it < 520 * 3; it += gridDim.x) {
        if (it + (int)gridDim.x < 520 * 3) PREP_LOAD(nxt, it + (int)gridDim.x);
        PREP_GEOM(it, seq_start, t0, seq_len, col)
        const int sec = sec_;
        f32x4 w0[5], w1[5];
#pragma unroll
        for (int j = 0; j < 5; ++j) { w0[j] = *(const f32x4*)(convw + j * 3072 + col); w1[j] = *(const f32x4*)(convw + j * 3072 + col + 4); }
        const int tb = t0 + strip * 16;
#pragma unroll
        for (int r = 0; r < 16; ++r) {
            f32x4 acc0 = {0.f, 0.f, 0.f, 0.f}, acc1 = {0.f, 0.f, 0.f, 0.f};
#pragma unroll
            for (int j = 0; j < 5; ++j) { const u32x4 x = cur[r + j];
                acc0 += (f32x4){bflo(x[0]), bfhi(x[0]), bflo(x[1]), bfhi(x[1])} * w0[j];
                acc1 += (f32x4){bflo(x[2]), bfhi(x[2]), bflo(x[3]), bfhi(x[3])} * w1[j]; }
            float y[8];
#pragma unroll
            for (int i = 0; i < 4; ++i) { y[i] = siluf(acc0[i]); y[4 + i] = siluf(acc1[i]); }
            if (sec < 2) {
                float ss = 0.f;
#pragma unroll
                for (int i = 0; i < 8; ++i) ss += y[i] * y[i];
                ss += __shfl_xor(ss, 1); ss += __shfl_xor(ss, 2); ss += __shfl_xor(ss, 4); ss += __shfl_xor(ss, 8);
                const float sc = rsqrtf(ss + EPS) * (sec == 0 ? 0.08838834764831845f : 1.f);
#pragma unroll
                for (int i = 0; i < 8; ++i) y[i] *= sc;
            }
            u32x4 o; o.x = pk2(y[0], y[1]); o.y = pk2(y[2], y[3]); o.z = pk2(y[4], y[5]); o.w = pk2(y[6], y[7]);
            *(u32x4*)(QP + (size_t)(seq_start + tb + r) * 3072 + col) = o;
        }
        if (sec == 0) {
#pragma unroll
            for (int q = 0; q < 2; ++q) {
                const int e = tid + q * 512, r = e >> 4, idx = e & 15, row = seq_start + t0 + r;
                const float bv = ba[(size_t)row * 32 + idx], av = ba[(size_t)row * 32 + 16 + idx];
                const float xs = av + a.in(11)[idx];
                const float sp = fmaxf(xs, 0.f) + log1pf(expf(-fabsf(xs)));
                const float g = -expf(a.in(10)[idx]) * sp;
                const int dir = idx >> 3, h = idx & 7;
                gb[((size_t)dir * MT + row) * 8 + h] = g;
                bb[((size_t)dir * MT + row) * 8 + h] = 1.f / (1.f + expf(-bv));
            }
        }
#pragma unroll
        for (int r = 0; r < 20; ++r) cur[r] = nxt[r];
    }
#undef PREP_LOAD
#undef PREP_GEOM
}

DEVI void phase_dnscan(const KA& a, int lane, int wave) {
    unsigned char* ws = a.ws();
    const bf16_t* QP = (const bf16_t*)(ws + WS_QKVP);
    const float* gb = (const float*)(ws + WS_G); const float* bb = (const float*)(ws + WS_BETA);
    bf16_t* Of = (bf16_t*)a.out(); bf16_t* Ob = Of + (size_t)ML * 1024;
    const int gw = blockIdx.x * 8 + wave, NGW = gridDim.x * 8;
    for (int item = gw; item < 2048; item += NGW) {
        const int chain = item >> 6, ep = item & 63, dir = chain >> 4, b = (chain >> 3) & 1, h = chain & 7;
        bf16_t* O = dir ? Ob : Of;
        float S00 = 0.f, S01 = 0.f, S10 = 0.f, S11 = 0.f;
        const int NTOK = CTX + SEQ;
        constexpr int U = 4;
        unsigned kq[U], qq[U], vv[U]; float gg[U], be[U]; int rows[U];
        auto rowof = [&](int s) -> int { if (s < CTX) { const int t = dir ? CTX - 1 - s : s; return ML + b * CTX + t; } const int t2 = s - CTX; const int t = dir ? SEQ - 1 - t2 : t2; return b * SEQ + t; };
#define SC_LOAD(i, s) do { const int row_ = rowof(s); rows[i] = row_; const bf16_t* p_ = QP + (size_t)row_ * 3072 + h * 128; \
        qq[i] = *(const unsigned*)(p_ + 2 * lane); kq[i] = *(const unsigned*)(p_ + 1024 + 2 * lane); vv[i] = *(const unsigned*)(p_ + 2048 + 2 * ep); \
        gg[i] = gb[((size_t)dir * MT + row_) * 8 + h]; be[i] = bb[((size_t)dir * MT + row_) * 8 + h]; } while (0)
        for (int s0 = 0; s0 < NTOK; s0 += U) {
#pragma unroll
            for (int i = 0; i < U; ++i) SC_LOAD(i, s0 + i);
#pragma unroll
            for (int i = 0; i < U; ++i) {
                const float k0 = bflo(kq[i]), k1 = bfhi(kq[i]), q0 = bflo(qq[i]), q1 = bfhi(qq[i]), v0 = bflo(vv[i]), v1 = bfhi(vv[i]);
                const float eg = __expf(gg[i]), bt = be[i];
                float p0 = k0 * S00 + k1 * S10, p1 = k0 * S01 + k1 * S11;
                p0 = wave_sum(p0); p1 = wave_sum(p1);
                const float vn0 = bt * (v0 - eg * p0), vn1 = bt * (v1 - eg * p1);
                S00 = eg * S00 + k0 * vn0; S01 = eg * S01 + k0 * vn1; S10 = eg * S10 + k1 * vn0; S11 = eg * S11 + k1 * vn1;
                float o0 = q0 * S00 + q1 * S10, o1 = q0 * S01 + q1 * S11;
                o0 = wave_sum(o0); o1 = wave_sum(o1);
                if (lane == 0 && rows[i] < ML) *(unsigned*)(O + (size_t)rows[i] * 1024 + h * 128 + 2 * ep) = pk2(o0, o1);
            }
        }
#undef SC_LOAD
    }
}

DEVI bf16x8 ld_b128(LAS const unsigned char* p) { return *(LAS const bf16x8*)p; }
DEVI bf16x8 ld_2b64(LAS const unsigned char* p0, LAS const unsigned char* p1) { const u32x2 a = *(LAS const u32x2*)p0, b = *(LAS const u32x2*)p1; u32x4 w = {a.x, a.y, b.x, b.y}; return __builtin_bit_cast(bf16x8, w); }
DEVI bf16x8 pack_frag(const f32x4& lo, const f32x4& hi) { u32x4 w = {pk2(lo[0], lo[1]), pk2(lo[2], lo[3]), pk2(hi[0], hi[1]), pk2(hi[2], hi[3])}; return __builtin_bit_cast(bf16x8, w); }
#define MFMA16(A, B, C) __builtin_amdgcn_mfma_f32_16x16x32_bf16(A, B, C, 0, 0, 0)
DEVI void phase_dnchunk(const KA& a, LAS unsigned char* lds, int tid, int lane, int wave) {
    unsigned char* ws = a.ws();
    const bf16_t* QP = (const bf16_t*)(ws + WS_QKVP); const float* gb = (const float*)(ws + WS_G); const float* bb = (const float*)(ws + WS_BETA);
    bf16_t* TQ = (bf16_t*)(ws + WS_TQ); float* AV = (float*)(ws + WS_AVEC);
    constexpr int KL = 0, QL = 17408, KKF = 34816, QKF = 52224, VEC = 131072;
    const int fr = lane & 15, g = lane >> 4, d = wave >> 2, wq = wave & 3;
    LAS unsigned char* dbase = lds + d * 64512;
    LAS float* Gg = (LAS float*)(lds + VEC); LAS float* Bv = Gg + 128; LAS float* GC = Gg + 256;
    for (int item = blockIdx.x; item < 520 * 8; item += gridDim.x) {
        const int cidx = item >> 3, h = item & 7;
        const int row0 = cidx < 512 ? cidx * 64 : ML + (cidx - 512) * 64;
#pragma unroll
        for (int i = 0; i < 2; ++i) { const int c = tid + i * 512, r = c >> 4, ch = c & 15;
            const bf16_t* src = QP + (size_t)(row0 + r) * 3072 + h * 128 + ch * 8;
            *(LAS u32x4*)(lds + QL + r * 272 + ch * 16) = *(const u32x4*)src; *(LAS u32x4*)(lds + KL + r * 272 + ch * 16) = *(const u32x4*)(src + 1024); }
        if (tid < 128) { const int dd = tid >> 6, pos = tid & 63; Gg[tid] = gb[((size_t)dd * MT + row0 + pos) * 8 + h]; Bv[tid] = bb[((size_t)dd * MT + row0 + pos) * 8 + h]; }
        __syncthreads();
        if (wave < 2) {
            const int dd = wave, pos = dd ? 63 - lane : lane; float x = Gg[dd * 64 + pos];
#pragma unroll
            for (int o = 1; o < 64; o <<= 1) { const float y = __shfl_up(x, o); if (lane >= o) x += y; }
            const float total = __shfl(x, 63);
            GC[dd * 64 + pos] = x;
            float* av = AV + ((size_t)item * 2 + dd) * 256;
            av[pos] = __expf(x); av[64 + pos] = Bv[dd * 64 + pos]; av[128 + pos] = __expf(total - x); if (lane == 0) av[192] = __expf(total);
        }
        {
            const int src = d ? QL : KL;
            f32x4 acc[4] = {{0.f, 0.f, 0.f, 0.f}, {0.f, 0.f, 0.f, 0.f}, {0.f, 0.f, 0.f, 0.f}, {0.f, 0.f, 0.f, 0.f}};
#pragma unroll
            for (int s4 = 0; s4 < 4; ++s4) { const bf16x8 A = ld_b128(lds + src + (16 * wq + fr) * 272 + (32 * s4 + 8 * g) * 2);
#pragma unroll
                for (int jt = 0; jt < 4; ++jt) { const bf16x8 Bf = ld_b128(lds + KL + (16 * jt + fr) * 272 + (32 * s4 + 8 * g) * 2); acc[jt] = MFMA16(A, Bf, acc[jt]); } }
            LAS float* dst = (LAS float*)(lds + (d ? QKF : KKF));
#pragma unroll
            for (int jt = 0; jt < 4; ++jt)
#pragma unroll
                for (int r = 0; r < 4; ++r) dst[(16 * wq + 4 * g + r) * 68 + 16 * jt + fr] = acc[jt][r];
        }
        __syncthreads();
        f32x4 P[4], qd[4];
        {
            const LAS float* kkf = (const LAS float*)(lds + KKF); const LAS float* qkf = (const LAS float*)(lds + QKF);
            float gci[4], bei[4];
#pragma unroll
            for (int r = 0; r < 4; ++r) { gci[r] = GC[d * 64 + 16 * wq + 4 * g + r]; bei[r] = Bv[d * 64 + 16 * wq + 4 * g + r]; }
#pragma unroll
            for (int jt = 0; jt < 4; ++jt) { const int j = 16 * jt + fr; const float gcj = GC[d * 64 + j];
#pragma unroll
                for (int r = 0; r < 4; ++r) { const int i = 16 * wq + 4 * g + r; const bool incl = d ? (i <= j) : (i >= j);
                    const float e = incl ? __expf(gci[r] - gcj) : 0.f;
                    qd[jt][r] = qkf[i * 68 + j] * e; P[jt][r] = (i != j) ? -bei[r] * kkf[i * 68 + j] * e : 0.f; } }
        }
        __syncthreads();
        {
#pragma unroll
            for (int jt = 0; jt < 4; ++jt) {
#pragma unroll
                for (int r = 0; r < 4; ++r) { const int i = 16 * wq + 4 * g + r, j = 16 * jt + fr;
                    *(LAS unsigned short*)(dbase + 0 + i * 144 + j * 2) = (unsigned short)f2bf(P[jt][r]);
                    *(LAS unsigned short*)(dbase + 36864 + 9216 + i * 144 + j * 2) = (unsigned short)f2bf(P[jt][r]);
                    *(LAS unsigned short*)(dbase + 55296 + i * 144 + j * 2) = (unsigned short)f2bf(qd[jt][r]); }
                u32x2 w = {pk2(P[jt][0], P[jt][1]), pk2(P[jt][2], P[jt][3])};
                *(LAS u32x2*)(dbase + 18432 + (16 * jt + fr) * 144 + (16 * wq + 4 * g) * 2) = w; }
        }
        __syncthreads();
        int cur = 0;
#pragma unroll 1
        for (int it = 0; it < 5; ++it) {
            LAS unsigned char* NRc = dbase + cur * 9216; LAS unsigned char* NTc = dbase + 18432 + cur * 9216;
            LAS unsigned char* NRn = dbase + (cur ^ 1) * 9216; LAS unsigned char* NTn = dbase + 18432 + (cur ^ 1) * 9216;
            LAS unsigned char* PRo = dbase + 36864 + ((it + 1) & 1) * 9216; LAS unsigned char* PRn = dbase + 36864 + (it & 1) * 9216;
            f32x4 n2[4] = {{0.f, 0.f, 0.f, 0.f}, {0.f, 0.f, 0.f, 0.f}, {0.f, 0.f, 0.f, 0.f}, {0.f, 0.f, 0.f, 0.f}};
#pragma unroll
            for (int s2 = 0; s2 < 2; ++s2) { const bf16x8 A = ld_b128(NRc + (16 * wq + fr) * 144 + (32 * s2 + 8 * g) * 2);
#pragma unroll
                for (int jt = 0; jt < 4; ++jt) { const bf16x8 Bf = ld_b128(NTc + (16 * jt + fr) * 144 + (32 * s2 + 8 * g) * 2); n2[jt] = MFMA16(A, Bf, n2[jt]); } }
#pragma unroll
            for (int jt = 0; jt < 4; ++jt) {
#pragma unroll
                for (int r = 0; r < 4; ++r) *(LAS unsigned short*)(NRn + (16 * wq + 4 * g + r) * 144 + (16 * jt + fr) * 2) = (unsigned short)f2bf(n2[jt][r]);
                u32x2 w = {pk2(n2[jt][0], n2[jt][1]), pk2(n2[jt][2], n2[jt][3])};
                *(LAS u32x2*)(NTn + (16 * jt + fr) * 144 + (16 * wq + 4 * g) * 2) = w;
                P[jt] += n2[jt]; }
            __syncthreads();
#pragma unroll
            for (int s2 = 0; s2 < 2; ++s2) { const bf16x8 A = ld_b128(PRo + (16 * wq + fr) * 144 + (32 * s2 + 8 * g) * 2);
#pragma unroll
                for (int jt = 0; jt < 4; ++jt) { const bf16x8 Bf = ld_b128(NTn + (16 * jt + fr) * 144 + (32 * s2 + 8 * g) * 2); P[jt] = MFMA16(A, Bf, P[jt]); } }
#pragma unroll
            for (int jt = 0; jt < 4; ++jt)
#pragma unroll
                for (int r = 0; r < 4; ++r) *(LAS unsigned short*)(PRn + (16 * wq + 4 * g + r) * 144 + (16 * jt + fr) * 2) = (unsigned short)f2bf(P[jt][r]);
            cur ^= 1;
        }
        __syncthreads();
        {
            bf16_t* dst = TQ + ((size_t)item * 2 + d) * 8192; const int t2 = tid & 255;
#pragma unroll
            for (int k = 0; k < 4; ++k) { const int c = t2 + 256 * k, mat = c >> 9, r = (c >> 3) & 63, ch = c & 7;
                const u32x4 v = *(LAS const u32x4*)(dbase + (mat ? 55296 : 36864) + r * 144 + ch * 16);
                *(u32x4*)(dst + mat * 4096 + r * 64 + ch * 8) = v; }
        }
        __syncthreads();
    }
}

DEVI void phase_dnchunk2(const KA& a, LAS unsigned char* lds, int tid, int lane, int wave) {
    unsigned char* ws = a.ws();
    const bf16_t* QP = (const bf16_t*)(ws + WS_QKVP); const float* gb = (const float*)(ws + WS_G); const float* bb = (const float*)(ws + WS_BETA);
    bf16_t* TQ = (bf16_t*)(ws + WS_TQ); float* AV = (float*)(ws + WS_AVEC);
    const int fr = lane & 15, g = lane >> 4, wi = wave >> 1, dir = wave & 1;
    LAS unsigned char* kl = lds + wi * 32768;
    LAS float* vec = (LAS float*)(lds + 131072 + wave * 1024);
    for (int grp = blockIdx.x; grp < 1040; grp += gridDim.x) {
        int tl = tid; asm volatile("" : "+v"(tl));
#pragma unroll
        for (int i = 0; i < 16; ++i) { const int c = tl + 512 * i, it = c >> 11, qk = (c >> 10) & 1, r = (c >> 4) & 63, ch = c & 15;
            const int item_ = grp * 4 + it, ci_ = item_ >> 3, h_ = item_ & 7; const int row0_ = ci_ < 512 ? ci_ * 64 : ML + (ci_ - 512) * 64;
            const u32x4 x = *(const u32x4*)(QP + (size_t)(row0_ + r) * 3072 + qk * 1024 + h_ * 128 + ch * 8);
            *(LAS u32x4*)(lds + it * 32768 + (qk ? 0 : 16384) + r * 256 + ((ch ^ (r & 15)) << 4)) = x; }
        const int item = grp * 4 + wi, cidx = item >> 3, h = item & 7;
        const int row0 = cidx < 512 ? cidx * 64 : ML + (cidx - 512) * 64;
        {
            const int pos = dir ? 63 - lane : lane;
            float x = gb[((size_t)dir * MT + row0 + pos) * 8 + h]; const float be = bb[((size_t)dir * MT + row0 + pos) * 8 + h];
#pragma unroll
            for (int o = 1; o < 64; o <<= 1) { const float y = __shfl_up(x, o); if (lane >= o) x += y; }
            const float total = __shfl(x, 63);
            vec[pos] = x; vec[64 + pos] = be;
            float* av = AV + ((size_t)item * 2 + dir) * 256;
            av[pos] = __expf(x); av[64 + pos] = be; av[128 + pos] = __expf(total - x); if (lane == 0) av[192] = __expf(total);
        }
        __syncthreads();
        bf16_t* tq = TQ + ((size_t)item * 2 + dir) * 8192;
        bf16x8 KF[4][4];
#pragma unroll
        for (int t = 0; t < 4; ++t)
#pragma unroll
            for (int ks = 0; ks < 4; ++ks) KF[t][ks] = ld_b128(kl + (16 * t + fr) * 256 + (((4 * ks + g) ^ fr) << 4));
        {
            bf16x8 QF[4][4];
#pragma unroll
            for (int t = 0; t < 4; ++t)
#pragma unroll
                for (int ks = 0; ks < 4; ++ks) QF[t][ks] = ld_b128(kl + 16384 + (16 * t + fr) * 256 + (((4 * ks + g) ^ fr) << 4));
#pragma unroll
            for (int rt = 0; rt < 4; ++rt)
#pragma unroll
                for (int ct = 0; ct < 4; ++ct) { f32x4 acc = {0.f, 0.f, 0.f, 0.f};
#pragma unroll
                    for (int ks = 0; ks < 4; ++ks) acc = MFMA16(KF[rt][ks], QF[ct][ks], acc);
                    float o[4]; const f32x4 gxv = *(const LAS f32x4*)(vec + 16 * rt + 4 * g); const float gyv = vec[16 * ct + fr];
#pragma unroll
                    for (int r = 0; r < 4; ++r) { const int x = 16 * rt + 4 * g + r, y = 16 * ct + fr; const bool inc = dir ? (y <= x) : (y >= x);
                        o[r] = inc ? acc[r] * __expf(gyv - gxv[r]) : 0.f; }
                    const u32x2 w = {pk2(o[0], o[1]), pk2(o[2], o[3])};
                    *(u32x2*)(tq + 4096 + (16 * ct + fr) * 64 + 16 * rt + 4 * g) = w; }
        }
        f32x4 PT[4][4]; bf16x8 XD[2][4], XT[2][4];
#pragma unroll
        for (int ct = 0; ct < 4; ++ct)
#pragma unroll
            for (int s2 = 0; s2 < 2; ++s2) { f32x4 nd[2], nt[2];
#pragma unroll
                for (int u = 0; u < 2; ++u) { const int rt = 2 * s2 + u; f32x4 acc = {0.f, 0.f, 0.f, 0.f};
#pragma unroll
                    for (int ks = 0; ks < 4; ++ks) acc = MFMA16(KF[rt][ks], KF[ct][ks], acc);
                    const f32x4 gxv = *(const LAS f32x4*)(vec + 16 * rt + 4 * g), bxv = *(const LAS f32x4*)(vec + 64 + 16 * rt + 4 * g); const float gyv = vec[16 * ct + fr], byv = vec[64 + 16 * ct + fr];
#pragma unroll
                    for (int r = 0; r < 4; ++r) { const int x = 16 * rt + 4 * g + r, y = 16 * ct + fr;
                        const bool cd = dir ? (x < y) : (x > y), ct_ = dir ? (y < x) : (y > x);
                        nd[u][r] = cd ? -bxv[r] * acc[r] * __expf(gxv[r] - gyv) : 0.f;
                        nt[u][r] = ct_ ? -byv * acc[r] * __expf(gyv - gxv[r]) : 0.f; }
                    PT[rt][ct] = nt[u]; }
                XD[s2][ct] = pack_frag(nd[0], nd[1]); XT[s2][ct] = pack_frag(nt[0], nt[1]); }
#pragma unroll 1
        for (int it = 0; it < 5; ++it) {
            bf16x8 XD2[2][4], XT2[2][4];
#pragma unroll
            for (int ct = 0; ct < 4; ++ct)
#pragma unroll
                for (int s2 = 0; s2 < 2; ++s2) { f32x4 t2[2];
#pragma unroll
                    for (int u = 0; u < 2; ++u) { const int rt = 2 * s2 + u; f32x4 acc = {0.f, 0.f, 0.f, 0.f};
                        acc = MFMA16(XT[0][rt], XD[0][ct], acc); acc = MFMA16(XT[1][rt], XD[1][ct], acc); t2[u] = acc; }
                    XD2[s2][ct] = pack_frag(t2[0], t2[1]); }
#pragma unroll
            for (int ct = 0; ct < 4; ++ct) { const bf16x8 pb0 = pack_frag(PT[0][ct], PT[1][ct]), pb1 = pack_frag(PT[2][ct], PT[3][ct]);
#pragma unroll
                for (int rt = 0; rt < 4; ++rt) { f32x4 acc = PT[rt][ct]; acc = MFMA16(XD2[0][rt], pb0, acc); acc = MFMA16(XD2[1][rt], pb1, acc); PT[rt][ct] = acc; } }
#pragma unroll
            for (int ct = 0; ct < 4; ++ct)
#pragma unroll
                for (int s2 = 0; s2 < 2; ++s2) { f32x4 t2[2];
#pragma unroll
                    for (int u = 0; u < 2; ++u) { const int rt = 2 * s2 + u; f32x4 acc = {0.f, 0.f, 0.f, 0.f};
                        acc = MFMA16(XD[0][rt], XT[0][ct], acc); acc = MFMA16(XD[1][rt], XT[1][ct], acc); t2[u] = acc; PT[rt][ct] += acc; }
                    XT2[s2][ct] = pack_frag(t2[0], t2[1]); }
#pragma unroll
            for (int s2 = 0; s2 < 2; ++s2)
#pragma unroll
                for (int ct = 0; ct < 4; ++ct) { XD[s2][ct] = XD2[s2][ct]; XT[s2][ct] = XT2[s2][ct]; }
        }
#pragma unroll
        for (int rt = 0; rt < 4; ++rt)
#pragma unroll
            for (int ct = 0; ct < 4; ++ct) { const u32x2 w = {pk2(PT[rt][ct][0], PT[rt][ct][1]), pk2(PT[rt][ct][2], PT[rt][ct][3])};
                *(u32x2*)(tq + (16 * ct + fr) * 64 + 16 * rt + 4 * g) = w; }
        __syncthreads();
    }
}

DEVI void phase_dnscan2(const KA& a, LAS unsigned char* lds, int tid, int lane, int wave, unsigned long long& pr_extra) {
    const int v = blockIdx.x;
    unsigned char* ws = a.ws();
    const bf16_t* QP = (const bf16_t*)(ws + WS_QKVP); const bf16_t* TQ = (const bf16_t*)(ws + WS_TQ); const float* AV = (const float*)(ws + WS_AVEC);
    unsigned* prog = (unsigned*)(ws + CTL_PROG);
    constexpr int NSTEP = 260;
    int vrole = v;
#if MK_ONE_LAUNCH
    {
        unsigned* bar_ = (unsigned*)(ws + WS_CTL); unsigned* xr_ = (unsigned*)(ws + CTL_XRANK);
        bool dyn = gridDim.x == 256;
#pragma unroll
        for (int j = 0; j < 16; ++j) { const unsigned c_ = __hip_atomic_load(&bar_[256 + 64 * j], __ATOMIC_RELAXED, __HIP_MEMORY_SCOPE_AGENT); dyn = dyn && (c_ == (j < 8 ? 32u : 0u)); }
        if (PROBE_SUB == 7 && !dyn) pr_extra += 50000ull;
        if (dyn) {
            const unsigned xcc = (unsigned)__builtin_amdgcn_s_getreg((3 << 11) | 20) & 0xFu;
            LAS unsigned* bw = (LAS unsigned*)(lds + 147200);
            if (tid == 0) *bw = __hip_atomic_fetch_add(&xr_[xcc * 64], 1u, __ATOMIC_RELAXED, __HIP_MEMORY_SCOPE_AGENT);
            __syncthreads();
            const unsigned rank = *bw & 31u;
            vrole = rank < 16u ? (int)(xcc + 8u * (rank >> 2) + 32u * (rank & 3u)) : (int)(128u + xcc + 8u * ((rank - 16u) >> 2) + 32u * ((rank - 16u) & 3u));
            __syncthreads();
        }
    }
#endif
    if (vrole < 128) {
    const int chain = (vrole & 7) + 8 * ((vrole >> 3) & 3), qt = vrole >> 5, dir = chain >> 4, b = (chain >> 3) & 1, h = chain & 7;
    bf16_t* O = (bf16_t*)a.out() + (size_t)dir * ML * 1024;
    constexpr int KL = 0, QL = 16384, TL = 32768, DL = 40960, VL = 49152, AL = 53248, BUFB = 54272, OT = 2 * BUFB, SBX = OT + 8192, XBX = SBX + 16384, FLG = XBX + 4096;
    const int fr0 = lane & 15, g0 = lane >> 4, ltid = tid - 256;
    auto step_cidx = [&](int s) -> int { if (s < 4) return 512 + b * 4 + (dir ? 3 - s : s); const int c = s - 4; return b * 256 + (dir ? 255 - c : c); };
    struct LSet { u32x4 q[4], k[4], t[2], d[2], v, av; };
#define LD_ISSUE(R, s_) do { const int cidx_ = step_cidx(s_); const int row0_ = cidx_ < 512 ? cidx_ * 64 : ML + (cidx_ - 512) * 64; \
        const bf16_t* tqb_ = TQ + ((size_t)(cidx_ * 8 + h) * 2 + dir) * 8192; const float* avb_ = AV + ((size_t)(cidx_ * 8 + h) * 2 + dir) * 256; \
        int lt_ = ltid; asm volatile("" : "+v"(lt_)); \
        const bf16_t* pq_ = QP + (size_t)(row0_ + (lt_ >> 4)) * 3072 + h * 128 + (lt_ & 15) * 8; \
        const bf16_t* pt_ = tqb_ + (lt_ >> 3) * 64 + (lt_ & 7) * 8; \
        _Pragma("unroll") for (int i = 0; i < 4; ++i) { R.q[i] = *(const u32x4*)(pq_ + (size_t)i * 16 * 3072); R.k[i] = *(const u32x4*)(pq_ + (size_t)i * 16 * 3072 + 1024); } \
        _Pragma("unroll") for (int i = 0; i < 2; ++i) { R.t[i] = *(const u32x4*)(pt_ + i * 32 * 64); R.d[i] = *(const u32x4*)(pt_ + 4096 + i * 32 * 64); } \
        R.v = *(const u32x4*)(QP + (size_t)(row0_ + (lt_ >> 2)) * 3072 + 2048 + h * 128 + qt * 32 + (lt_ & 3) * 8); \
        R.av = *(const u32x4*)(avb_ + (lt_ & 63) * 4); } while (0)
#define LD_WRITE(R, bo_) do { int lt_ = ltid; asm volatile("" : "+v"(lt_)); LAS unsigned char* B_ = lds + (bo_); \
        const int chq_ = lt_ & 15, cht_ = lt_ & 7; \
        _Pragma("unroll") for (int i = 0; i < 4; ++i) { const int r = (lt_ >> 4) + 16 * i; const int o_ = r * 256 + ((chq_ ^ (4 * (r & 3) + ((r >> 3) & 3))) << 4); \
            *(LAS u32x4*)(B_ + QL + o_) = R.q[i]; *(LAS u32x4*)(B_ + KL + o_) = R.k[i]; } \
        _Pragma("unroll") for (int i = 0; i < 2; ++i) { const int r = (lt_ >> 3) + 32 * i; const int o_ = r * 128 + ((cht_ ^ (2 * ((r >> 3) & 3) + ((r >> 1) & 1))) << 4); \
            *(LAS u32x4*)(B_ + TL + o_) = R.t[i]; *(LAS u32x4*)(B_ + DL + o_) = R.d[i]; } \
        { const int r = lt_ >> 2; *(LAS u32x4*)(B_ + VL + r * 64 + (((lt_ & 3) ^ (2 * ((r >> 3) & 1))) << 4)) = R.v; } \
        if (lt_ < 64) *(LAS u32x4*)(B_ + AL + lt_ * 16) = R.av; } while (0)
#define OT_OUT(s_) do { const int cidx_ = step_cidx(s_); const int row0_ = cidx_ * 64; LAS const unsigned char* ot_ = lds + OT + ((s_) & 1) * 4096; \
        int lt_ = ltid; asm volatile("" : "+v"(lt_)); \
        { const int r = lt_ >> 2, ch = lt_ & 3; \
            *(u32x4*)(O + (size_t)(row0_ + r) * 1024 + h * 128 + qt * 32 + ch * 8) = *(LAS const u32x4*)(ot_ + r * 64 + ((ch ^ (2 * ((r >> 3) & 1))) << 4)); } } while (0)
#define STEP_BAR(wsel) do { const unsigned long long tb_ = PROBE_SUB ? __builtin_amdgcn_s_memrealtime() : 0ull; \
        asm volatile("s_waitcnt lgkmcnt(0)" ::: "memory"); __builtin_amdgcn_s_barrier(); asm volatile("" ::: "memory"); \
        if ((PROBE_SUB == 1 && wave == 0 && (wsel) == 0) || (PROBE_SUB == 2 && wave == 4 && (wsel) == 1) || (PROBE_SUB == 3 && wave == 2 && (wsel) == 3)) pr_extra += __builtin_amdgcn_s_memrealtime() - tb_; } while (0)
#define LOAD_STEP(s, RW) do { STEP_BAR(1); \
            if (qt == 0 && ltid == 0) __hip_atomic_store(prog + chain * 64, (unsigned)((s) + 1), __ATOMIC_RELAXED, __HIP_MEMORY_SCOPE_AGENT); \
            { const unsigned long long tw_ = (PROBE_SUB == 5) ? __builtin_amdgcn_s_memrealtime() : 0ull; if ((s) + 1 < NSTEP) LD_WRITE(RW, (((s) + 1) & 1) * BUFB); \
              if (PROBE_SUB == 5 && wave == 4) { asm volatile("s_waitcnt lgkmcnt(0)" ::: "memory"); pr_extra += __builtin_amdgcn_s_memrealtime() - tw_; } } \
            if ((s) + 4 < NSTEP) LD_ISSUE(RW, (s) + 4); \
            if ((s) >= 5) OT_OUT((s) - 1); } while (0)
#define SBAR_() do {} while (0)
#define ROWK(pt) ((32 * ((pt) >> 1) + 4 * ((pt) & 1) + rowl) * 256)
#define ROWT(pt) ((32 * ((pt) >> 1) + 4 * ((pt) & 1) + rowl) * 128)
#define P0(pt) (32 * ((pt) >> 1) + 8 * g + 4 * ((pt) & 1))
#define LDK8(dst, base, pa) do { _Pragma("unroll") for (int s4 = 0; s4 < 4; ++s4) { dst[s4] = ld_b128(B + (base) + ROWK(pa) + (((4 * s4 + g) ^ fk) << 4)); dst[4 + s4] = ld_b128(B + (base) + ROWK((pa) + 1) + (((4 * s4 + g) ^ fk) << 4)); } } while (0)
#define LDT8(dst, base) do { _Pragma("unroll") for (int pt = 0; pt < 4; ++pt) { dst[2 * pt] = ld_b128(B + (base) + ROWT(pt) + ((g ^ ft) << 4)); dst[2 * pt + 1] = ld_b128(B + (base) + ROWT(pt) + (((4 + g) ^ ft) << 4)); } } while (0)
#define MM8(acc, fa, pa) do { _Pragma("unroll") for (int s4 = 0; s4 < 4; ++s4) { acc[pa] = MFMA16(fa[s4], Sb[s4], acc[pa]); acc[(pa) + 1] = MFMA16(fa[4 + s4], Sb[s4], acc[(pa) + 1]); } } while (0)
    if (wave >= 4) {
        LSet R0, R1, R2;
        LD_ISSUE(R0, 0); LD_WRITE(R0, 0); LD_ISSUE(R1, 1); LD_ISSUE(R2, 2); LD_ISSUE(R0, 3);
#pragma unroll 1
        for (int s0 = 0; s0 < NSTEP; s0 += 3) {
            LOAD_STEP(s0, R1);
            if (s0 + 1 < NSTEP) LOAD_STEP(s0 + 1, R2);
            if (s0 + 2 < NSTEP) LOAD_STEP(s0 + 2, R0);
        }
        STEP_BAR(2);
        OT_OUT(NSTEP - 1);
    } else if (wave < 2) {
        __builtin_amdgcn_s_setprio(3);
        f32x4 S[8];
#pragma unroll
        for (int i = 0; i < 8; ++i) S[i] = (f32x4){0.f, 0.f, 0.f, 0.f};
        bf16x8 Sb[4];
#pragma unroll
        for (int s4 = 0; s4 < 4; ++s4) { Sb[s4] = (bf16x8){0, 0, 0, 0, 0, 0, 0, 0}; *(LAS bf16x8*)(lds + SBX + wave * 4096 + s4 * 1024 + lane * 16) = Sb[s4]; }
        if (lane == 0) *(LAS unsigned*)(lds + FLG + wave * 4) = 0u;
#pragma unroll 1
        for (int s = 0; s < NSTEP; ++s) {
            STEP_BAR(0);
            int fr = fr0, g = g0; asm volatile("" : "+v"(fr), "+v"(g));
            LAS const unsigned char* B = lds + (s & 1) * BUFB;
            const LAS float* avl = (const LAS float*)(B + AL);
            const int rowl = 8 * (fr >> 2) + (fr & 3);
            const int fk = 4 * (fr & 3) + (fr >> 2), ft = 2 * (fr >> 2) + ((fr >> 1) & 1);
            const int vcol = ((((2 * wave + (fr >> 3)) ^ (2 * (g & 1))) << 4) + (fr & 7) * 2);
            const int trq = fr >> 2, trp = fr & 3;
            LAS unsigned char* kp0 = (LAS unsigned char*)(B + KL + (8 * g + trq) * 256);
            const int fkt = 4 * trq + g;
#define KT_LOAD(dst, d0) do { _Pragma("unroll") for (int j = 0; j < 4; ++j) { const int dt_ = (d0) + j; const int co = (((4 * (dt_ >> 1) + trp) ^ fkt) << 4) + 8 * (dt_ & 1); \
                const s16x4 a0 = __builtin_bit_cast(s16x4, __builtin_amdgcn_ds_read_tr16_b64_v4i16((LAS s16x4*)(kp0 + co))), a1 = __builtin_bit_cast(s16x4, __builtin_amdgcn_ds_read_tr16_b64_v4i16((LAS s16x4*)(kp0 + co + 4 * 256))); \
                const s16x4 a2 = __builtin_bit_cast(s16x4, __builtin_amdgcn_ds_read_tr16_b64_v4i16((LAS s16x4*)(kp0 + co + 32 * 256))), a3 = __builtin_bit_cast(s16x4, __builtin_amdgcn_ds_read_tr16_b64_v4i16((LAS s16x4*)(kp0 + co + 36 * 256))); \
                dst[2 * j] = (bf16x8){a0[0], a0[1], a0[2], a0[3], a1[0], a1[1], a1[2], a1[3]}; dst[2 * j + 1] = (bf16x8){a2[0], a2[1], a2[2], a2[3], a3[0], a3[1], a3[2], a3[3]}; } } while (0)
            bf16x8 fA[8], fB[8], fC[8];
            f32x4 avp[4], bvp[4]; unsigned short vraw[4][4];
            const unsigned long long t6_ = (PROBE_SUB == 6) ? __builtin_amdgcn_s_memrealtime() : 0ull;
            LDK8(fA, KL, 0); LDK8(fB, KL, 2);
            if (PROBE_SUB == 6 && wave == 0) { asm volatile("s_waitcnt lgkmcnt(0)" ::: "memory"); pr_extra += __builtin_amdgcn_s_memrealtime() - t6_; }
#pragma unroll
            for (int pt = 0; pt < 4; ++pt) { avp[pt] = *(const LAS f32x4*)(avl + P0(pt)); bvp[pt] = *(const LAS f32x4*)(avl + 64 + P0(pt));
#pragma unroll
                for (int r = 0; r < 4; ++r) vraw[pt][r] = *(const LAS unsigned short*)(B + VL + (P0(pt) + r) * 64 + vcol); }
            f32x4 Z[4], X[4];
#pragma unroll
            for (int pt = 0; pt < 4; ++pt) Z[pt] = (f32x4){0.f, 0.f, 0.f, 0.f};
            SBAR_();
            LDT8(fC, TL); SBAR_(); MM8(Z, fA, 0); SBAR_();
            KT_LOAD(fA, 0); SBAR_(); MM8(Z, fB, 2); SBAR_();
#pragma unroll
            for (int pt = 0; pt < 4; ++pt)
#pragma unroll
                for (int r = 0; r < 4; ++r) Z[pt][r] = bvp[pt][r] * (bf2f(vraw[pt][r]) - avp[pt][r] * Z[pt][r]);
            KT_LOAD(fB, 4); SBAR_();
            { const bf16x8 Zb0 = pack_frag(Z[0], Z[1]), Zb1 = pack_frag(Z[2], Z[3]);
#pragma unroll
              for (int pt = 0; pt < 4; ++pt) { X[pt] = MFMA16(fC[2 * pt], Zb0, Z[pt]); X[pt] = MFMA16(fC[2 * pt + 1], Zb1, X[pt]); } }
            SBAR_();
            const float egl = avl[192];
            bf16x8 Xc0, Xc1;
            { const bf16x8 Xb0 = pack_frag(X[0], X[1]), Xb1 = pack_frag(X[2], X[3]);
              *(LAS bf16x8*)(lds + XBX + wave * 2048 + lane * 16) = Xb0; *(LAS bf16x8*)(lds + XBX + wave * 2048 + 1024 + lane * 16) = Xb1;
              if (lane == 0) *(LAS volatile unsigned*)(lds + FLG + wave * 4) = (unsigned)(s + 1);
              f32x4 cx[4];
#pragma unroll
              for (int pt = 0; pt < 4; ++pt) cx[pt] = X[pt] * *(const LAS f32x4*)(avl + 128 + P0(pt));
              Xc0 = pack_frag(cx[0], cx[1]); Xc1 = pack_frag(cx[2], cx[3]); }
            SBAR_();
#pragma unroll
            for (int j = 0; j < 4; ++j) { f32x4 sn = S[j] * egl; sn = MFMA16(fA[2 * j], Xc0, sn); S[j] = MFMA16(fA[2 * j + 1], Xc1, sn); }
            SBAR_();
#pragma unroll
            for (int j = 0; j < 4; ++j) { f32x4 sn = S[4 + j] * egl; sn = MFMA16(fB[2 * j], Xc0, sn); S[4 + j] = MFMA16(fB[2 * j + 1], Xc1, sn); }
#pragma unroll
            for (int s4 = 0; s4 < 4; ++s4) { Sb[s4] = pack_frag(S[2 * s4], S[2 * s4 + 1]); *(LAS bf16x8*)(lds + SBX + ((s + 1) & 1) * 8192 + wave * 4096 + s4 * 1024 + lane * 16) = Sb[s4]; }
#undef KT_LOAD
        }
        STEP_BAR(2);
        __builtin_amdgcn_s_setprio(0);
    } else {
        const int sl = wave - 2;
#pragma unroll 1
        for (int s = 0; s < NSTEP; ++s) {
            STEP_BAR(3);
            if (s >= 4) {
            int fr = fr0, g = g0; asm volatile("" : "+v"(fr), "+v"(g));
            LAS const unsigned char* B = lds + (s & 1) * BUFB;
            const LAS float* avl = (const LAS float*)(B + AL);
            const int rowl = 8 * (fr >> 2) + (fr & 3);
            const int fk = 4 * (fr & 3) + (fr >> 2), ft = 2 * (fr >> 2) + ((fr >> 1) & 1);
            const int vcol = ((((2 * sl + (fr >> 3)) ^ (2 * (g & 1))) << 4) + (fr & 7) * 2);
            bf16x8 fA[8], fB[8], fC[8], Sb[4];
            LDK8(fA, QL, 0); LDK8(fB, QL, 2);
#pragma unroll
            for (int s4 = 0; s4 < 4; ++s4) Sb[s4] = *(const LAS bf16x8*)(lds + SBX + (s & 1) * 8192 + sl * 4096 + s4 * 1024 + lane * 16);
            f32x4 OQ[4], avp[4];
#pragma unroll
            for (int pt = 0; pt < 4; ++pt) { OQ[pt] = (f32x4){0.f, 0.f, 0.f, 0.f}; avp[pt] = *(const LAS f32x4*)(avl + P0(pt)); }
            SBAR_();
            LDT8(fC, DL); SBAR_(); MM8(OQ, fA, 0); SBAR_(); MM8(OQ, fB, 2); SBAR_();
            { unsigned spins = 0;
              while ((unsigned)__builtin_amdgcn_readfirstlane((int)*(LAS volatile unsigned*)(lds + FLG + sl * 4)) != (unsigned)(s + 1)) { __builtin_amdgcn_s_sleep(1); if (++spins > (1u << 22)) break; } }
            asm volatile("" ::: "memory");
            const bf16x8 Xb0 = *(const LAS bf16x8*)(lds + XBX + sl * 2048 + lane * 16), Xb1 = *(const LAS bf16x8*)(lds + XBX + sl * 2048 + 1024 + lane * 16);
#pragma unroll
            for (int pt = 0; pt < 4; ++pt) { f32x4 o2 = OQ[pt] * avp[pt]; o2 = MFMA16(fC[2 * pt], Xb0, o2); OQ[pt] = MFMA16(fC[2 * pt + 1], Xb1, o2); }
            { LAS unsigned char* ot = lds + OT + (s & 1) * 4096;
#pragma unroll
              for (int pt = 0; pt < 4; ++pt)
#pragma unroll
                  for (int r = 0; r < 4; ++r) *(LAS unsigned short*)(ot + (P0(pt) + r) * 64 + vcol) = (unsigned short)f2bf(OQ[pt][r]); }
            }
        }
        STEP_BAR(2);
    }
#undef LDK8
#undef LDT8
#undef MM8
#undef ROWK
#undef ROWT
#undef P0
#undef SBAR_
#undef LOAD_STEP
#undef STEP_BAR
#undef LD_ISSUE
#undef LD_WRITE
#undef OT_OUT
    } else {
        const int vp = vrole - 128, chain = (vp & 7) + 8 * ((vp >> 3) & 3), role = vp >> 5, dir = chain >> 4, b = (chain >> 3) & 1, h = chain & 7;
        const int nteam = (((int)gridDim.x - 128) >> 5) * 8;
        constexpr int PFD2 = 6;
        if (role * 8 + wave < nteam) {
#pragma unroll 1
        for (int st = role * 8 + wave; st < NSTEP; st += nteam) {
            unsigned spins = 0;
            while ((int)__builtin_amdgcn_readfirstlane((int)__hip_atomic_load(prog + chain * 64, __ATOMIC_RELAXED, __HIP_MEMORY_SCOPE_AGENT)) + PFD2 < st) { __builtin_amdgcn_s_sleep(8); if (++spins > (1u << 20)) break; }
            int cidx; if (st < 4) cidx = 512 + b * 4 + (dir ? 3 - st : st); else { const int c = st - 4; cidx = b * 256 + (dir ? 255 - c : c); }
            const int row0 = cidx < 512 ? cidx * 64 : ML + (cidx - 512) * 64;
            const char* tqb = (const char*)(TQ + ((size_t)(cidx * 8 + h) * 2 + dir) * 8192); const char* avb = (const char*)(AV + ((size_t)(cidx * 8 + h) * 2 + dir) * 256);
            unsigned acc = 0;
#pragma unroll
            for (int j = 0; j < 9; ++j) { const int L = j * 64 + lane; const char* p_;
                if (L < 384) { const int rw = L / 6, part = L - rw * 6; p_ = (const char*)(QP + (size_t)(row0 + rw) * 3072 + h * 128) + (part >> 1) * 2048 + (part & 1) * 128; }
                else if (L < 512) p_ = tqb + (L - 384) * 128; else p_ = avb + ((L - 512) & 7) * 128;
                acc ^= *(const unsigned*)p_; }
            asm volatile("" :: "v"(acc));
        }
        }
    }
}

DEVI void phase_prep2(const KA& a, int lane, int wave) {
    unsigned char* ws = a.ws();
    bf16_t* KAT = (bf16_t*)(ws + WS_KAT); const float* rope = (const float*)(ws + SM_ROPE); const float* knw = a.in(14);
    const int gw = blockIdx.x * 8 + wave, NGW = gridDim.x * 8;
    for (int row = gw; row < MT; row += NGW) {
        bf16_t* p = (row < ML ? KAT + (size_t)row * 256 : (bf16_t*)(ws + WS_CTXK) + (size_t)(row - ML) * 256) + lane * 4;
        const u32x2 w = *(const u32x2*)p;
        float x[4] = {bflo(w.x), bfhi(w.x), bflo(w.y), bfhi(w.y)};
        float ss = (x[0] * x[0] + x[1] * x[1]) + (x[2] * x[2] + x[3] * x[3]);
        ss += __shfl_xor(ss, 1); ss += __shfl_xor(ss, 2); ss += __shfl_xor(ss, 4); ss += __shfl_xor(ss, 8); ss += __shfl_xor(ss, 16);
        const float rs = rsqrtf(ss * (1.f / 128.f) + EPS);
        const int d = (lane & 31) * 4;
        const f32x4 nw = *(const f32x4*)(knw + d);
#pragma unroll
        for (int i = 0; i < 4; ++i) x[i] = x[i] * rs * nw[i];
        float pr[4];
#pragma unroll
        for (int i = 0; i < 4; ++i) pr[i] = __shfl_xor(x[i], 8);
        if (row < ML) {
            const int t = row & (SEQ - 1), lg = (lane & 31) >> 3, fi = (lane & 7) * 4;
            const float* ct = lg < 2 ? rope + (t >> 6) * 32 + fi : rope + 16384 + (t & 63) * 32 + fi;
            const float* st = lg < 2 ? ct + 8192 : ct + 2048;
            const f32x4 c = *(const f32x4*)ct, s = *(const f32x4*)st;
            const float sg = (lg & 1) ? 1.f : -1.f;
#pragma unroll
            for (int i = 0; i < 4; ++i) x[i] = x[i] * c[i] + sg * pr[i] * s[i];
        }
        u32x2 o; o.x = pk2(x[0], x[1]); o.y = pk2(x[2], x[3]);
        *(u32x2*)p = o;
    }
    const bf16_t* Of = (const bf16_t*)a.out(); const bf16_t* Ob = Of + (size_t)ML * 1024;
    const bf16_t* GT = (const bf16_t*)(ws + WS_GT); bf16_t* Y = (bf16_t*)(ws + WS_Y); const float* dnw = a.in(12);
    for (int row = gw; row < ML; row += NGW) {
        const int c0 = lane * 16;
        float o[16];
#pragma unroll
        for (int hh = 0; hh < 2; ++hh) {
            const u32x4 f = *(const u32x4*)(Of + (size_t)row * 1024 + c0 + hh * 8), bk = *(const u32x4*)(Ob + (size_t)row * 1024 + c0 + hh * 8);
#pragma unroll
            for (int i = 0; i < 4; ++i) { o[hh * 8 + 2 * i] = bflo(f[i]) + bflo(bk[i]); o[hh * 8 + 2 * i + 1] = bfhi(f[i]) + bfhi(bk[i]); }
        }
        float ss = 0.f;
#pragma unroll
        for (int i = 0; i < 16; ++i) ss += o[i] * o[i];
        ss += __shfl_xor(ss, 1); ss += __shfl_xor(ss, 2); ss += __shfl_xor(ss, 4);
        const float rs = rsqrtf(ss * (1.f / 128.f) + EPS);
        const int d0 = c0 & 127;
#pragma unroll
        for (int hh = 0; hh < 2; ++hh) {
            const u32x4 gt = *(const u32x4*)(GT + (size_t)row * 1024 + c0 + hh * 8);
            float y[8];
#pragma unroll
            for (int i = 0; i < 4; ++i) {
                y[2 * i] = o[hh * 8 + 2 * i] * rs * dnw[d0 + hh * 8 + 2 * i] * siluf(bflo(gt[i]));
                y[2 * i + 1] = o[hh * 8 + 2 * i + 1] * rs * dnw[d0 + hh * 8 + 2 * i + 1] * siluf(bfhi(gt[i]));
            }
            u32x4 w; w.x = pk2(y[0], y[1]); w.y = pk2(y[2], y[3]); w.z = pk2(y[4], y[5]); w.w = pk2(y[6], y[7]);
            *(u32x4*)(Y + (size_t)row * 2048 + c0 + hh * 8) = w;
        }
    }
}

namespace att {
constexpr int D = 128, NW = 8, QBLK = 32, KVBLK = 64;
constexpr float SCALE = 0.088388347648318440f;
constexpr float THR = 8.f;
constexpr int LDK = 256;
constexpr size_t SHM_V = KVBLK * D * 2, SHM_K = KVBLK * D * 2;
constexpr size_t OFF_WS = 2 * SHM_V + 2 * SHM_K, OFF_OST = OFF_WS + NW * 64 * 4;
#define KSWZ(row, colB) ((row) * 256 + ((colB) ^ (((row) & 7) << 4)))
#define SBAR() __builtin_amdgcn_sched_barrier(0)
DEVI int crow(int r, int hi) { return (r & 3) + 8 * (r >> 2) + 4 * hi; }
DEVI unsigned cvtpk(float lo, float hi) { unsigned r; asm volatile("v_cvt_pk_bf16_f32 %0, %1, %2" : "=v"(r) : "v"(lo), "v"(hi)); return r; }
DEVI void partialSM(f32x16& p0, f32x16& p1, float& m_reg, float& mn, float& alpha) {
    constexpr float C = SCALE * 1.4426950408889634f;
    float pmax = p0[0];
#pragma unroll
    for (int r = 1; r < 16; ++r) pmax = fmaxf(pmax, p0[r]);
#pragma unroll
    for (int r = 0; r < 16; ++r) pmax = fmaxf(pmax, p1[r]);
    { auto rr = __builtin_amdgcn_permlane32_swap(__float_as_uint(pmax), __float_as_uint(pmax), false, false);
      pmax = fmaxf(__uint_as_float(rr[0]), __uint_as_float(rr[1])); }
    if (__builtin_expect(__all(pmax - m_reg <= THR / SCALE), 1)) { mn = m_reg; alpha = 1.f; }
    else { mn = fmaxf(m_reg, pmax); alpha = __builtin_amdgcn_exp2f((m_reg - mn) * C); m_reg = mn; }
    const float mnC = -mn * C;
#pragma unroll
    for (int r = 0; r < 16; ++r) p0[r] = fmaf(p0[r], C, mnC);
#pragma unroll
    for (int r = 0; r < 16; ++r) p1[r] = fmaf(p1[r], C, mnC);
#pragma unroll
    for (int r = 0; r < 16; ++r) p0[r] = __builtin_amdgcn_exp2f(p0[r]);
}
DEVI void finishSM(f32x16& p0, f32x16& p1, float alpha, float& l_reg, bf16x8& pa0, bf16x8& pa1, bf16x8& pa2, bf16x8& pa3) {
#pragma unroll
    for (int r = 0; r < 16; ++r) p1[r] = __builtin_amdgcn_exp2f(p1[r]);
    float ps = 0;
#pragma unroll
    for (int r = 0; r < 16; ++r) ps += p0[r];
#pragma unroll
    for (int r = 0; r < 16; ++r) ps += p1[r];
    { auto rr = __builtin_amdgcn_permlane32_swap(__float_as_uint(ps), __float_as_uint(ps), false, false);
      ps = __uint_as_float(rr[0]) + __uint_as_float(rr[1]); }
    l_reg = l_reg * alpha + ps;
#define PK4(P, BASE, OUT) do { unsigned a0 = cvtpk(P[BASE + 0], P[BASE + 1]), a1 = cvtpk(P[BASE + 2], P[BASE + 3]);   \
    unsigned b0 = cvtpk(P[BASE + 4], P[BASE + 5]), b1 = cvtpk(P[BASE + 6], P[BASE + 7]);                              \
    auto r0 = __builtin_amdgcn_permlane32_swap(a0, b0, false, false); auto r1 = __builtin_amdgcn_permlane32_swap(a1, b1, false, false); \
    u32x4 w = {r0[0], r1[0], r0[1], r1[1]}; OUT = *reinterpret_cast<bf16x8*>(&w); } while (0)
    PK4(p0, 0, pa0); PK4(p0, 8, pa1); PK4(p1, 0, pa2); PK4(p1, 8, pa3);
#undef PK4
}
DEVI void qkt(f32x16& p0, f32x16& p1, const char* Ks, const bf16x8* qr, int r32, int hi) {
    p0 = f32x16{}; p1 = f32x16{};
#pragma unroll
    for (int d0 = 0; d0 < 8; ++d0) { const int cb = (d0 * 16 + hi * 8) * 2;
        const bf16x8 b0 = *reinterpret_cast<const bf16x8*>(Ks + KSWZ(r32, cb));
        const bf16x8 b1 = *reinterpret_cast<const bf16x8*>(Ks + KSWZ(32 + r32, cb));
        p0 = __builtin_amdgcn_mfma_f32_32x32x16_bf16(b0, qr[d0], p0, 0, 0, 0);
        p1 = __builtin_amdgcn_mfma_f32_32x32x16_bf16(b1, qr[d0], p1, 0, 0, 0); }
}
DEVI int v_st(int k, int c) { const int kk = (k & ~0xC) | ((k & 4) << 1) | ((k & 8) >> 1); return ((kk >> 3) * 4 + (c >> 5)) * 512 + ((kk & 7) * 32 + (c & 31)) * 2; }
DEVI int v_rd_base(int lane) { return ((lane & 3) << 3) | (((lane >> 2) & 3) << 6) | (((lane >> 4) & 1) << 5) | (((lane >> 5) & 1) << 8); }
constexpr int v_rd_off(int d0, int ks, int half) { return d0 * 512 + ks * 4096 + half * 2048; }
template <int OFF> DEVI s16x4 tr_read(int vb) { s16x4 r; asm volatile("ds_read_b64_tr_b16 %0, %1 offset:%2" : "=&v"(r) : "v"(vb), "i"(OFF) : "memory"); return r; }
template <int D0> DEVI void pv_one(f32x16& od, int vb, bf16x8 pa0, bf16x8 pa1, bf16x8 pa2, bf16x8 pa3) {
    const s16x4 l0 = tr_read<v_rd_off(D0, 0, 0)>(vb), h0 = tr_read<v_rd_off(D0, 0, 1)>(vb), l1 = tr_read<v_rd_off(D0, 1, 0)>(vb), h1 = tr_read<v_rd_off(D0, 1, 1)>(vb);
    const s16x4 l2 = tr_read<v_rd_off(D0, 2, 0)>(vb), h2 = tr_read<v_rd_off(D0, 2, 1)>(vb), l3 = tr_read<v_rd_off(D0, 3, 0)>(vb), h3 = tr_read<v_rd_off(D0, 3, 1)>(vb);
    asm volatile("s_waitcnt lgkmcnt(0)" ::: "memory"); SBAR();
#define PK(L, H) (bf16x8){L[0], L[1], L[2], L[3], H[0], H[1], H[2], H[3]}
    od = __builtin_amdgcn_mfma_f32_32x32x16_bf16(pa0, PK(l0, h0), od, 0, 0, 0);
    od = __builtin_amdgcn_mfma_f32_32x32x16_bf16(pa1, PK(l1, h1), od, 0, 0, 0);
    od = __builtin_amdgcn_mfma_f32_32x32x16_bf16(pa2, PK(l2, h2), od, 0, 0, 0);
    od = __builtin_amdgcn_mfma_f32_32x32x16_bf16(pa3, PK(l3, h3), od, 0, 0, 0);
#undef PK
}
DEVI void pv_d0(f32x16* o, int vb, bf16x8 pa0, bf16x8 pa1, bf16x8 pa2, bf16x8 pa3) {
    pv_one<0>(o[0], vb, pa0, pa1, pa2, pa3); pv_one<1>(o[1], vb, pa0, pa1, pa2, pa3); pv_one<2>(o[2], vb, pa0, pa1, pa2, pa3); pv_one<3>(o[3], vb, pa0, pa1, pa2, pa3);
}
DEVI void wmask(f32x16& p0, f32x16& p1, int qp, int kt0, int hi) {
#pragma unroll
    for (int r = 0; r < 16; ++r) { const int kp = kt0 + crow(r, hi); const int d0 = qp - kp, d1 = d0 - 32;
        if (d0 > 128 || d0 < -128) p0[r] = -1e30f; if (d1 > 128 || d1 < -128) p1[r] = -1e30f; }
}
DEVI void attn_unit(const KA& a, int b, int kvh, int tb, char* lds) {
    unsigned char* ws = a.ws();
    const bf16_t* QAT = (const bf16_t*)(ws + WS_QAT); const bf16_t* KAT = (const bf16_t*)(ws + WS_KAT); const bf16_t* VAT = (const bf16_t*)(ws + WS_VAT);
    bf16_t* Y = (bf16_t*)(ws + WS_Y); const float* rope = (const float*)(ws + SM_ROPE);
    const int tid = threadIdx.x, wid = __builtin_amdgcn_readfirstlane(tid >> 6), lane = tid & 63, r32 = lane & 31, hi = lane >> 5;
    const int h = kvh * 4 + (wid >> 1), t0 = tb * 64;
    char* V_lds = lds; char* K_lds = lds + 2 * SHM_V;
    float* wsf = (float*)(lds + OFF_WS) + wid * 64; float* li_l = wsf; float* al_l = wsf + 32;
    float m_reg = -1e30f, l_reg = 0; f32x16 o[4] = {}; bf16x8 qr[8];
    const int qp = t0 + (wid & 1) * QBLK + r32;
    {
        const bf16_t* Qw = QAT + (size_t)(b * SEQ + qp) * 1024 + h * 128 + hi * 8;
        u32x4 raw[8]; float ss = 0.f;
#pragma unroll
        for (int d0 = 0; d0 < 8; ++d0) { raw[d0] = *(const u32x4*)(Qw + d0 * 16);
#pragma unroll
            for (int i = 0; i < 4; ++i) { const float lo_ = bflo(raw[d0][i]), hi_ = bfhi(raw[d0][i]); ss += lo_ * lo_ + hi_ * hi_; } }
        { auto rr = __builtin_amdgcn_permlane32_swap(__float_as_uint(ss), __float_as_uint(ss), false, false); ss = __uint_as_float(rr[0]) + __uint_as_float(rr[1]); }
        const float rs = rsqrtf(ss * (1.f / 128.f) + EPS);
        const float* qnw = a.in(13);
#pragma unroll
        for (int half = 0; half < 2; ++half) {
            const float* ct = half == 0 ? rope + (qp >> 6) * 32 : rope + 16384 + (qp & 63) * 32;
            const float* st = half == 0 ? ct + 8192 : ct + 2048;
#pragma unroll
            for (int dd = 0; dd < 2; ++dd) {
                const int fi = dd * 16 + hi * 8, da = half * 4 + dd, db = da + 2;
                u32x4 oa, ob;
#pragma unroll
                for (int q4 = 0; q4 < 2; ++q4) {
                    const f32x4 c = *(const f32x4*)(ct + fi + 4 * q4), s = *(const f32x4*)(st + fi + 4 * q4);
                    const f32x4 wa = *(const f32x4*)(qnw + da * 16 + hi * 8 + 4 * q4), wb = *(const f32x4*)(qnw + db * 16 + hi * 8 + 4 * q4);
                    float ya[4], yb[4];
#pragma unroll
                    for (int j = 0; j < 4; ++j) {
                        const unsigned ra = raw[da][2 * q4 + (j >> 1)], rb = raw[db][2 * q4 + (j >> 1)];
                        const float x1 = ((j & 1) ? bfhi(ra) : bflo(ra)) * rs * wa[j], x2 = ((j & 1) ? bfhi(rb) : bflo(rb)) * rs * wb[j];
                        ya[j] = x1 * c[j] - x2 * s[j]; yb[j] = x2 * c[j] + x1 * s[j];
                    }
                    oa[2 * q4] = cvtpk(ya[0], ya[1]); oa[2 * q4 + 1] = cvtpk(ya[2], ya[3]); ob[2 * q4] = cvtpk(yb[0], yb[1]); ob[2 * q4 + 1] = cvtpk(yb[2], yb[3]);
                }
                qr[da] = *reinterpret_cast<bf16x8*>(&oa); qr[db] = *reinterpret_cast<bf16x8*>(&ob);
            }
        }
    }
    const int tk0 = t0 - 128 < 0 ? 0 : t0 - 128, tk1 = t0 + 192 > SEQ ? SEQ : t0 + 192;
    const int NTR = 4 + (tk1 - tk0) / 64, NT = (NTR + 1) & ~1;
    const int ctxrow = ML + b * CTX, latrow = b * SEQ + tk0 - 256;
#define TCTX(j) ((j) < 4 || (j) >= NTR)
#define TROW(j) (TCTX(j) ? b * CTX + 64 * ((j) & 3) : latrow + 64 * (j))
    const bf16_t* Kh = KAT + kvh * 128; const bf16_t* Vh = VAT + kvh * 128;
    const bf16_t* Kc = (const bf16_t*)(ws + WS_CTXK) + kvh * 128; const bf16_t* Vc = (const bf16_t*)(ws + WS_CTXV) + kvh * 128;
    const int sr = tid >> 4, sc = (tid & 15) * 8, vst0 = v_st(sr, sc), vst1 = v_st(32 + sr, sc);
    const int vb0 = (int)(uintptr_t)V_lds + v_rd_base(lane);
    struct { bf16x8 vs0, vs1, ks0, ks1; } sr_[1];
#define SLOAD(i, j) do { const int k0_ = TROW(j); const bf16_t* kb_ = TCTX(j) ? Kc : Kh; const bf16_t* vb_ = TCTX(j) ? Vc : Vh; \
    sr_[i].vs0 = *(const bf16x8*)(vb_ + (size_t)(k0_ + sr) * LDK + sc); sr_[i].vs1 = *(const bf16x8*)(vb_ + (size_t)(k0_ + 32 + sr) * LDK + sc); \
    sr_[i].ks0 = *(const bf16x8*)(kb_ + (size_t)(k0_ + sr) * LDK + sc); sr_[i].ks1 = *(const bf16x8*)(kb_ + (size_t)(k0_ + 32 + sr) * LDK + sc); } while (0)
#define SWRITE(bf, i) do { *(bf16x8*)(V_lds + (bf) * SHM_V + vst0) = sr_[i].vs0; *(bf16x8*)(V_lds + (bf) * SHM_V + vst1) = sr_[i].vs1; const int kc = sc * 2; \
    *(bf16x8*)(K_lds + (bf) * SHM_K + KSWZ(sr, kc)) = sr_[i].ks0; *(bf16x8*)(K_lds + (bf) * SHM_K + KSWZ(32 + sr, kc)) = sr_[i].ks1; } while (0)
#define SWAIT() asm volatile("s_waitcnt vmcnt(0)" ::: "memory")
#define RESC(al) do { if (__any((al) < 1.f)) { if (hi == 0) al_l[r32] = (al); asm volatile("s_waitcnt lgkmcnt(0)" ::: "memory"); \
    _Pragma("unroll") for (int d = 0; d < 4; ++d) _Pragma("unroll") for (int r = 0; r < 16; ++r) o[d][r] *= al_l[crow(r, hi)]; } } while (0)
#define WMASK(P0, P1, j) do { if ((j) >= 4) wmask(P0, P1, qp, (j) >= NTR ? 1000000 : tk0 + 64 * ((j) - 4), hi); } while (0)
    f32x16 pA0, pA1, pB0, pB1; float mnA, mnB, alA, alB; bf16x8 pa0, pa1, pa2, pa3;
    constexpr int SE = 0, SO = 0;
    SLOAD(SE, 0); asm volatile("s_waitcnt vmcnt(0)" ::: "memory"); SWRITE(0, SE); __syncthreads();
    qkt(pA0, pA1, K_lds, qr, r32, hi); partialSM(pA0, pA1, m_reg, mnA, alA);
    SLOAD(SO, 1);
    SWAIT(); SWRITE(1, SO); __syncthreads();
    for (int j = 1; j + 1 < NT; j += 2) {
        SBAR(); qkt(pB0, pB1, K_lds + SHM_K, qr, r32, hi); WMASK(pB0, pB1, j);
        finishSM(pA0, pA1, alA, l_reg, pa0, pa1, pa2, pa3); SBAR();
        SLOAD(SO, j + 1); SBAR();
        pv_d0(o, vb0, pa0, pa1, pa2, pa3); partialSM(pB0, pB1, m_reg, mnB, alB);
        __syncthreads(); SWAIT(); SWRITE(0, SE);
        RESC(alB); __syncthreads();
        SBAR(); qkt(pA0, pA1, K_lds, qr, r32, hi); WMASK(pA0, pA1, j + 1);
        finishSM(pB0, pB1, alB, l_reg, pa0, pa1, pa2, pa3); SBAR();
        SLOAD(SE, j + 2); SBAR();
        pv_d0(o, vb0 + (int)SHM_V, pa0, pa1, pa2, pa3); partialSM(pA0, pA1, m_reg, mnA, alA);
        __syncthreads(); SWAIT(); SWRITE(1, SO);
        RESC(alA); __syncthreads();
    }
    SBAR(); qkt(pB0, pB1, K_lds + SHM_K, qr, r32, hi); WMASK(pB0, pB1, NT - 1);
    finishSM(pA0, pA1, alA, l_reg, pa0, pa1, pa2, pa3); SBAR();
    pv_d0(o, vb0, pa0, pa1, pa2, pa3); partialSM(pB0, pB1, m_reg, mnB, alB);
    __syncthreads(); RESC(alB);
    finishSM(pB0, pB1, alB, l_reg, pa0, pa1, pa2, pa3); SBAR();
    pv_d0(o, vb0 + (int)SHM_V, pa0, pa1, pa2, pa3);
    l_reg += __builtin_amdgcn_exp2f(a.in(15)[h] * 1.4426950408889634f - m_reg * (SCALE * 1.4426950408889634f));
    if (hi == 0) li_l[r32] = l_reg; asm volatile("s_waitcnt lgkmcnt(0)" ::: "memory");
    float rli[16];
#pragma unroll
    for (int r = 0; r < 16; ++r) rli[r] = __builtin_amdgcn_rcpf(li_l[crow(r, hi)]);
    {
        bf16_t* stg = (bf16_t*)(lds + OFF_OST) + wid * 4096;
#pragma unroll
        for (int r = 0; r < 16; ++r) { const int orow = crow(r, hi);
#pragma unroll
            for (int d0 = 0; d0 < 4; ++d0) stg[orow * 128 + d0 * 32 + r32] = (bf16_t)f2bf(o[d0][r] * rli[r]); }
        asm volatile("s_waitcnt lgkmcnt(0)" ::: "memory");
        bf16_t* Ow = Y + (size_t)(b * SEQ + t0 + (wid & 1) * QBLK) * 2048 + 1024 + h * 128;
#pragma unroll
        for (int i = 0; i < 8; ++i) { const int row = i * 4 + (lane >> 4), ch = lane & 15; const u32x4 v = *(const u32x4*)(stg + row * 128 + ch * 8); *(u32x4*)(Ow + (size_t)row * 2048 + ch * 8) = v; }
    }
    __syncthreads();
#undef TROW
#undef TCTX
#undef SLOAD
#undef SWRITE
#undef SWAIT
#undef RESC
#undef WMASK
}
#undef KSWZ
#undef SBAR
}

DEVI u32x4 ldu_(const bf16_t* base, int rr) {
    const int rc = rr < 0 ? 0 : (rr >= SEQ ? SEQ - 1 : rr);
    const u32x4 v = *(const u32x4*)(base + (size_t)rc * NUP);
    const unsigned m = (rr == rc) ? 0xffffffffu : 0u;
    return (u32x4){v[0] & m, v[1] & m, v[2] & m, v[3] & m};
}
DEVI void phase_ffnconv(const KA& a, int b, int tid) {
    unsigned char* ws = a.ws();
    const bf16_t* U = (const bf16_t*)(ws + WS_U); bf16_t* ACT = (bf16_t*)(ws + WS_ACT) + (size_t)b * SEQ * DFF;
    const float* cw = a.in(20); const float* cb = a.in(21);
    if (tid < DFF / 8) {
        const int f0 = tid * 8, pn = f0 >> 7, j = f0 & 127, gc = 256 * pn + j, vc = gc + 128;
        float wg[3][8], wv[3][8], bg[8], bvv[8];
#pragma unroll
        for (int jt = 0; jt < 3; ++jt)
#pragma unroll
            for (int q = 0; q < 8; ++q) { wg[jt][q] = cw[jt * NUP + f0 + q]; wv[jt][q] = cw[jt * NUP + DFF + f0 + q]; }
#pragma unroll
        for (int q = 0; q < 8; ++q) { bg[q] = cb[f0 + q]; bvv[q] = cb[DFF + f0 + q]; }
        for (int it = blockIdx.x; it < SEQ / 32; it += gridDim.x) {
            const int r0 = it * 32;
            u32x4 gw_[3], vw_[3];
#define LDU(rr, c) ldu_(U + (c), (rr))
            gw_[0] = LDU(r0 - 1, gc); vw_[0] = LDU(r0 - 1, vc); gw_[1] = LDU(r0, gc); vw_[1] = LDU(r0, vc);
#pragma unroll 8
            for (int r = 0; r < 32; ++r) {
                gw_[2] = LDU(r0 + r + 1, gc); vw_[2] = LDU(r0 + r + 1, vc);
                float ug[8], uv[8];
#pragma unroll
                for (int q = 0; q < 8; ++q) { ug[q] = bg[q]; uv[q] = bvv[q]; }
#pragma unroll
                for (int jt = 0; jt < 3; ++jt)
#pragma unroll
                    for (int q = 0; q < 4; ++q) {
                        ug[2 * q] += bflo(gw_[jt][q]) * wg[jt][2 * q]; ug[2 * q + 1] += bfhi(gw_[jt][q]) * wg[jt][2 * q + 1];
                        uv[2 * q] += bflo(vw_[jt][q]) * wv[jt][2 * q]; uv[2 * q + 1] += bfhi(vw_[jt][q]) * wv[jt][2 * q + 1]; }
                u32x4 o;
                o.x = pk2(siluf(ug[0]) * uv[0], siluf(ug[1]) * uv[1]); o.y = pk2(siluf(ug[2]) * uv[2], siluf(ug[3]) * uv[3]);
                o.z = pk2(siluf(ug[4]) * uv[4], siluf(ug[5]) * uv[5]); o.w = pk2(siluf(ug[6]) * uv[6], siluf(ug[7]) * uv[7]);
                *(u32x4*)(ACT + (size_t)(r0 + r) * DFF + f0) = o;
                gw_[0] = gw_[1]; gw_[1] = gw_[2]; vw_[0] = vw_[1]; vw_[1] = vw_[2];
            }
#undef LDU
        }
    }
}

#define XB_TMO      128
#define XB_XCNT(j)  (256  + 64 * (j))
#define XB_XSUB(j)  (1280 + 64 * (j))
#define XB_XGEN(j)  (2304 + 64 * (j))
#define XB_TOP      3328
#define XB_TOPGEN   3392
#define XCD_BAR_WORDS 3456
#define XB_SPIN_CAP (1u << 18)
__device__ __forceinline__ unsigned xb_ld(unsigned* p)              { return __hip_atomic_load(p, __ATOMIC_RELAXED, __HIP_MEMORY_SCOPE_AGENT); }
__device__ __forceinline__ unsigned xb_add(unsigned* p, unsigned v) { return __hip_atomic_fetch_add(p, v, __ATOMIC_RELAXED, __HIP_MEMORY_SCOPE_AGENT); }
__device__ __forceinline__ unsigned xb_xcc_id() { return (unsigned)__builtin_amdgcn_s_getreg((3 << 11) | 20) & 0xFu; }
#define XB_SPIN(cond, bar) do { unsigned _sp = 0; while (cond) { __builtin_amdgcn_s_sleep(1); \
    if ((++_sp & 255u) == 0u) { if (xb_ld(&(bar)[XB_TMO])) break; if (_sp > XB_SPIN_CAP) { atomicAdd(&(bar)[XB_TMO], 1u); break; } } } } while (0)
struct XcdBarrier { unsigned* bar; unsigned x; volatile LAS unsigned* st; };
__device__ __forceinline__ XcdBarrier xcd_barrier_post(unsigned* bar, volatile LAS unsigned* st) {
    XcdBarrier b; b.bar = bar; b.x = xb_xcc_id(); b.st = st;
    if (threadIdx.x == 0) (void)xb_add(&bar[XB_XCNT(b.x)], 1u);
    return b;
}
__device__ __forceinline__ void xcd_barrier_complete(unsigned* bar, unsigned x, unsigned& nloc, unsigned& nx) {
    const unsigned G = gridDim.x * gridDim.y * gridDim.z;
    unsigned sum, cnt, mine, sp = 0u;
    for (;;) {
        sum = 0u; cnt = 0u; mine = 0u;
#pragma unroll
        for (unsigned j = 0; j < 16; ++j) { const unsigned c = xb_ld(&bar[XB_XCNT(j)]); sum += c; cnt += (c > 0u) ? 1u : 0u; mine = (j == x) ? c : mine; }
        if (sum == G) break;
        __builtin_amdgcn_s_sleep(1);
        if ((++sp & 255u) == 0u) { if (xb_ld(&bar[XB_TMO])) break; if (sp > XB_SPIN_CAP) { atomicAdd(&bar[XB_TMO], 1u); break; } }
    }
    nloc = mine > 0u ? mine : 1u; nx = cnt > 0u ? cnt : 1u;
}
__device__ __forceinline__ void xcd_barrier(const XcdBarrier& b) {
    asm volatile("s_waitcnt vmcnt(0)" ::: "memory");
    __syncthreads();
    if (threadIdx.x == 0) {
        unsigned* bar = b.bar;
        __builtin_amdgcn_s_waitcnt(0);
        unsigned nloc = b.st[0], nx = b.st[1];
        if (nloc == 0u) { xcd_barrier_complete(bar, b.x, nloc, nx); b.st[0] = nloc; b.st[1] = nx; }
        const unsigned old = xb_add(&bar[XB_XSUB(b.x)], 1u);
        const unsigned gen = old / nloc;
        if (old + 1u == (gen + 1u) * nloc) {
            __builtin_amdgcn_fence(__ATOMIC_RELEASE, "agent");
            asm volatile("s_waitcnt vmcnt(0)" ::: "memory");
            const unsigned og = xb_add(&bar[XB_TOP], 1u);
            const unsigned tg = og / nx;
            if (og + 1u == (tg + 1u) * nx) xb_add(&bar[XB_TOPGEN], 1u);
            else XB_SPIN(xb_ld(&bar[XB_TOPGEN]) == tg, bar);
            __builtin_amdgcn_fence(__ATOMIC_ACQUIRE, "agent");
            xb_add(&bar[XB_XGEN(b.x)], 1u);
            asm volatile("s_waitcnt vmcnt(0)" ::: "memory");
        } else {
            XB_SPIN(xb_ld(&bar[XB_XGEN(b.x)]) == gen, bar);
            __builtin_amdgcn_fence(__ATOMIC_ACQUIRE, "agent");
            asm volatile("s_waitcnt vmcnt(0)" ::: "memory");
        }
    }
    __syncthreads();
}

constexpr int NPHASE = 13;
__global__ void __launch_bounds__(512, 2) mega(Args a_) {
    const KA a;
    extern __shared__ __attribute__((aligned(16))) unsigned char lds_raw[];
    LAS unsigned char* lds = (LAS unsigned char*)lds_raw;
    const int tid = threadIdx.x, lane = tid & 63, wave = __builtin_amdgcn_readfirstlane(tid >> 6);
    unsigned char* ws = a.ws();
    const int lo = a_.ph_lo, hi = a_.ph_hi;
#define IN(k) (lo <= (k) && (k) < hi)
#if MK_ONE_LAUNCH
    volatile LAS unsigned* bst = (volatile LAS unsigned*)(lds + 147440);
    if (tid < 4) bst[tid] = 0u;
    __syncthreads();
    const XcdBarrier gbar = xcd_barrier_post((unsigned*)(ws + WS_CTL), bst);
#define SEAM(k) do { if (IN(k) && IN((k) + 1)) xcd_barrier(gbar); } while (0)
#else
#define SEAM(k) do { } while (0)
#endif
    const float* modacc = (const float*)(ws + CTL_MODACC);
    unsigned long long pr_prev = PROBE_MASK ? __builtin_amdgcn_s_memrealtime() : 0ull, pr_acc = 0ull;
#define STAMP(k) do { if (PROBE_MASK) { const unsigned long long now_ = __builtin_amdgcn_s_memrealtime(); if ((PROBE_MASK >> (k)) & 1u) pr_acc += now_ - pr_prev; pr_prev = now_; } } while (0)
    if (IN(0)) { phase0(a, lds, tid, lane, wave); } SEAM(0); STAMP(0);
    if (IN(1)) { phase1(a, tid, lane, wave); } SEAM(1); STAMP(1);
    if (IN(2)) {
        pg8::Gemm g{(const bf16_t*)(ws + WS_XN), (const bf16_t*)(ws + WS_WINA), MT, NA, 1024}; pg8::StaticOrder S; S.init(MT, NA, gridDim.x, blockIdx.x);
        EpiIn E{(const float*)(ws + SM_ROWSS1), (const float*)(ws + SM_SHWA), 0, (bf16_t*)(ws + WS_QKVR), nullptr, nullptr, nullptr, nullptr, (float*)(ws + WS_BA)};
        pg8::gemm_phase<EpiIn, pg8::StaticOrder, true, true>(lds, g, S, E);
        {
            pg8::Gemm g2{(const bf16_t*)(ws + WS_XN) + (size_t)ML * 1024, (const bf16_t*)(ws + WS_WINC) + (size_t)2048 * 1024, MC, 512, 1024};
            TailOrder T{(int)blockIdx.x - ((int)gridDim.x - 4)};
            EpiCtxKV E2{(const float*)(ws + SM_ROWSS1) + ML, (const float*)(ws + SM_SHWA) + 2 * NSH + NA + 2048, (bf16_t*)(ws + WS_CTXK), (bf16_t*)(ws + WS_CTXV)};
            pg8::gemm_phase<EpiCtxKV, TailOrder, true, true>(lds, g2, T, E2);
        }
    } SEAM(2); STAMP(2);
    if (IN(3)) { phase_dnprep(a, tid); } SEAM(3); STAMP(3);
    if (IN(4)) { phase_dnchunk2(a, lds, tid, lane, wave); } SEAM(4); STAMP(4);
    if (IN(5)) { const unsigned long long t5_ = (PROBE_SUB == 4) ? __builtin_amdgcn_s_memrealtime() : 0ull; phase_dnscan2(a, lds, tid, lane, wave, pr_acc); if (PROBE_SUB == 4) pr_acc += __builtin_amdgcn_s_memrealtime() - t5_; } SEAM(5); STAMP(5);
    if (IN(6)) {
        pg8::Gemm g{(const bf16_t*)(ws + WS_XN), (const bf16_t*)(ws + WS_WINC), ML, NC, 1024}; pg8::StaticOrder S; S.init(ML, NC, gridDim.x, blockIdx.x);
        EpiIn E{(const float*)(ws + SM_ROWSS1), (const float*)(ws + SM_SHWA) + NA, 1, (bf16_t*)(ws + WS_GT), (bf16_t*)(ws + WS_QAT), (bf16_t*)(ws + WS_KAT), (bf16_t*)(ws + WS_VAT), (bf16_t*)(ws + WS_MG), nullptr};
        pg8::gemm_phase<EpiIn, pg8::StaticOrder, true, true>(lds, g, S, E);
    } SEAM(6); STAMP(6);
    if (IN(7)) { phase_prep2(a, lane, wave); } SEAM(7); STAMP(7);
    if (IN(8)) {
#pragma unroll 1
        for (int idx = blockIdx.x; idx < 1024; idx += gridDim.x) {
            const int tb = idx & 255, kvh = (idx >> 8) & 1, b = idx >> 9;
            att::attn_unit(a, b, kvh, tb, (char*)lds_raw); }
    } SEAM(8); STAMP(8);
    if (IN(9)) {
        pg8::Gemm g{(const bf16_t*)(ws + WS_Y), (const bf16_t*)(ws + WS_WBR), ML, 1024, 2048}; pg8::StaticOrder S; S.init(ML, 1024, gridDim.x, blockIdx.x);
        EpiBr E{(const bf16_t*)(ws + WS_MG), (bf16_t*)(ws + WS_MERGED)};
        pg8::gemm_phase<EpiBr, pg8::StaticOrder, true, true>(lds, g, S, E);
    } SEAM(9); STAMP(9);
    if (IN(10)) {
        pg8::Gemm g{(const bf16_t*)(ws + WS_MERGED), (const bf16_t*)(ws + WS_WOUT), ML, 1024, 1024}; pg8::StaticOrder S; S.init(ML, 1024, gridDim.x, blockIdx.x);
        EpiOut E{a.in(0), modacc, a.in(5), a.in(7), a.out(), (bf16_t*)(ws + WS_X1S), (float*)(ws + CTL_ROWSS2)};
        pg8::gemm_phase<EpiOut, pg8::StaticOrder, true, true>(lds, g, S, E);
    } SEAM(10); STAMP(10);
    if (IN(11)) {
        pg8::Gemm g{(const bf16_t*)(ws + WS_X1S), (const bf16_t*)(ws + WS_WUP), 2 * TPB * 256, NUP, 1024}; pg8::StaticOrder S; S.init(2 * TPB * 256, NUP, gridDim.x, blockIdx.x);
        EpiUpConv E{(const float*)(ws + CTL_ROWSS2), (const float*)(ws + SM_SHWF), a.in(20), a.in(21), (bf16_t*)(ws + WS_ACT), (LAS float*)(lds + 131072)};
        pg8::gemm_phase<EpiUpConv, pg8::StaticOrder, true, true>(lds, g, S, E);
    } SEAM(11); STAMP(11);
    if (IN(12)) {
        pg8::Gemm g{(const bf16_t*)(ws + WS_ACT), (const bf16_t*)(ws + WS_WDN), ML, 1024, DFF}; pg8::StaticOrder S; S.init(ML, 1024, gridDim.x, blockIdx.x);
        EpiDown E{modacc, a.in(5), a.out()};
        pg8::gemm_phase<EpiDown, pg8::StaticOrder, true, true>(lds, g, S, E);
    }
    STAMP(12);
    if ((PROBE_MASK || PROBE_SUB) && blockIdx.x == 0) { const unsigned long long t0_ = __builtin_amdgcn_s_memrealtime(); while (__builtin_amdgcn_s_memrealtime() - t0_ < pr_acc) __builtin_amdgcn_s_sleep(8); }
#undef STAMP
#undef IN
#undef SEAM
}

extern "C" void kernel_launch(void* const* d_in, const int* in_sizes, int n_in, void* d_out, int out_size, void* d_ws, size_t ws_size, hipStream_t stream) {
    static int grid = 0;
    if (grid == 0) {
        if (n_in != 23 || in_sizes[0] != ML * DM || out_size != ML * DM || ws_size < WS_END) {
            fprintf(stderr, "kernel_launch: unexpected shapes n_in %d in0 %d out %d ws %zu (need %zu)\n", n_in, n_in > 0 ? in_sizes[0] : -1, out_size, ws_size, (size_t)WS_END); grid = -1; return; }
        int dev = 0, cus = 0, per_cu = 0;
        hipGetDevice(&dev); hipDeviceGetAttribute(&cus, hipDeviceAttributeMultiprocessorCount, dev);
        if (hipFuncSetAttribute((const void*)mega, hipFuncAttributeMaxDynamicSharedMemorySize, LDS_BYTES) != hipSuccess) { fprintf(stderr, "kernel_launch: hipFuncSetAttribute failed\n"); grid = -1; return; }
        hipOccupancyMaxActiveBlocksPerMultiprocessor(&per_cu, (const void*)mega, 512, LDS_BYTES);
        (void)hipGetLastError();
        if (per_cu < 1) { fprintf(stderr, "kernel_launch: occupancy query says %d blocks per CU\n", per_cu); per_cu = 1; }
        grid = cus;
    }
    if (grid < 0) return;
    hipMemsetAsync((char*)d_ws + WS_CTL, 0, CTL_ZERO_BYTES, stream);
    Args a{};
    for (int i = 0; i < 23; ++i) a.in[i] = (const float*)d_in[i];
    a.out = (float*)d_out; a.ws = (unsigned char*)d_ws;
#if MK_ONE_LAUNCH
    a.ph_lo = 0; a.ph_hi = NPHASE;
    void* args[] = {&a};
    hipError_t e = hipLaunchCooperativeKernel((const void*)mega, dim3(grid), dim3(512), args, LDS_BYTES, stream);
    if (e != hipSuccess) fprintf(stderr, "cooperative launch failed: %s (grid %d)\n", hipGetErrorString(e), grid);
#else
    for (int p = 0; p < NPHASE; ++p) {
        a.ph_lo = p; a.ph_hi = p + 1;
        hipLaunchKernelGGL(mega, dim3(grid), dim3(512), LDS_BYTES, stream, a);
    }
    hipError_t e = hipPeekAtLastError();
    if (e != hipSuccess) fprintf(stderr, "launch failed: %s\n", hipGetErrorString(e));
#endif
}
```

```cpp
#include <hip/hip_runtime.h>
#include <hip/hip_cooperative_groups.h>
#include <cstdio>
#include <cstdint>
namespace cg = cooperative_groups;

#ifndef PROBE_MASK
#define PROBE_MASK 0u
#endif
#ifndef PROBE_SUB
#define PROBE_SUB 0
#endif
#ifndef MK_ONE_LAUNCH
#define MK_ONE_LAUNCH 1
#endif

#define DEVI __device__ __forceinline__
#define LAS __attribute__((address_space(3)))
#define GAS __attribute__((address_space(1)))
typedef unsigned short bf16_t;
typedef short bf16x8 __attribute__((ext_vector_type(8)));
typedef float f32x4 __attribute__((ext_vector_type(4)));
typedef float f32x2 __attribute__((ext_vector_type(2)));
typedef float f32x16 __attribute__((ext_vector_type(16)));
typedef unsigned u32x4 __attribute__((ext_vector_type(4)));
typedef unsigned u32x2 __attribute__((ext_vector_type(2)));
typedef short s16x4 __attribute__((ext_vector_type(4)));

constexpr int BATCH = 2, SEQ = 16384, DM = 1024, CTX = 256;
constexpr int ML = BATCH * SEQ;
constexpr int MC = BATCH * CTX;
constexpr int MT = ML + MC;
constexpr int NA = 3328;
constexpr int NC = 4608;
constexpr int NSH = NA + NC;
constexpr int DFF = 2816, NUP = 5632;
constexpr int RB = SEQ + 256;
constexpr int TPB = 65;
constexpr float EPS = 1e-6f;

constexpr size_t MiB = 1u << 20;
constexpr size_t WS_CTL = 0, CTL_ZERO_BYTES = 1 * MiB;
constexpr size_t CTL_XRANK = 24 * 1024;
constexpr size_t CTL_PROG = 32 * 1024;
constexpr size_t CTL_RDY = 512 * 1024;
constexpr size_t CTL_DBG = 48 * 1024;
constexpr size_t CTL_MODACC = 64 * 1024;
constexpr size_t CTL_ROWSS2 = 256 * 1024;
constexpr size_t WS_SMALL = 1 * MiB;
constexpr size_t SM_ROWSS1 = WS_SMALL;
constexpr size_t SM_SHWA = WS_SMALL + 256 * 1024;
constexpr size_t SM_SHWF = WS_SMALL + 384 * 1024;
constexpr size_t SM_ROPE = WS_SMALL + 512 * 1024;
constexpr size_t WS_BA = 2 * MiB;
constexpr size_t WS_CTXK = 6 * MiB + 256 * 1024;
constexpr size_t WS_CTXV = 6 * MiB + 512 * 1024;
constexpr size_t WS_G = 7 * MiB;
constexpr size_t WS_BETA = 10 * MiB;
constexpr size_t WS_WINA = 13 * MiB, WS_WINC = 20 * MiB, WS_WBR = 29 * MiB, WS_WOUT = 33 * MiB, WS_WUP = 35 * MiB, WS_WDN = 46 * MiB;
constexpr size_t WS_XN = 52 * MiB;
constexpr size_t WS_QKVR = 117 * MiB;
constexpr size_t WS_QKVP = 312 * MiB;
constexpr size_t WS_MG = 180 * MiB;
constexpr size_t WS_GT = 310 * MiB;
constexpr size_t WS_QAT = 375 * MiB;
constexpr size_t WS_KAT = 440 * MiB;
constexpr size_t WS_VAT = 457 * MiB;
constexpr size_t WS_Y = 52 * MiB;
constexpr size_t WS_MERGED = 375 * MiB;
constexpr size_t WS_X1S = 440 * MiB;
constexpr size_t WS_U = 52 * MiB;
constexpr size_t WS_ACT = 228 * MiB;
constexpr size_t WS_TQ = 117 * MiB;
constexpr size_t WS_AVEC = 248 * MiB;
constexpr size_t WS_END = 512 * MiB;

constexpr int LDS_BYTES = 147456;

DEVI float bf2f(unsigned short h) { return __uint_as_float((unsigned)h << 16); }
DEVI float bflo(unsigned w) { return __uint_as_float(w << 16); }
DEVI float bfhi(unsigned w) { return __uint_as_float(w & 0xffff0000u); }
typedef __bf16 bf16x2_t __attribute__((ext_vector_type(2)));
DEVI unsigned pk2(float lo, float hi) { const f32x2 v = {lo, hi}; const bf16x2_t b = __builtin_convertvector(v, bf16x2_t); return __builtin_bit_cast(unsigned, b); }
DEVI unsigned f2bf(float f) { return pk2(f, 0.f) & 0xffffu; }
DEVI float wave_sum(float v) {
#pragma unroll
    for (int o = 1; o < 64; o <<= 1) v += __shfl_xor(v, o);
    return v;
}
DEVI float siluf(float x) { return x * __builtin_amdgcn_rcpf(1.f + __expf(-x)); }
DEVI float sigmoidf_(float x) { return 1.f / (1.f + __expf(-x)); }

struct Args { const float* in[23]; float* out; unsigned char* ws; int ph_lo, ph_hi; };
struct KA {
    DEVI const float* in(int k) const { return ((const float* const*)__builtin_amdgcn_kernarg_segment_ptr())[k]; }
    DEVI float* out() const { return ((float* const*)__builtin_amdgcn_kernarg_segment_ptr())[23]; }
    DEVI unsigned char* ws() const { return ((unsigned char* const*)__builtin_amdgcn_kernarg_segment_ptr())[24]; }
};

namespace pg8 {
constexpr int BM = 256, BK = 64, HALF = 128, HTB = HALF * BK * 2, STAGE_BYTES = 8 * HTB, NXCD = 8, WGM = 8;
__host__ __device__ __forceinline__ int lds_byte(int r, int c) { const int st = (r >> 4) * 2 + (c >> 5), rr = r & 15, cc = c & 31, ob = rr * 64 + cc * 2; return st * 1024 + (ob ^ (((ob >> 9) & 1) << 5)); }
__host__ __device__ __forceinline__ void stage_rc(int b, int& R, int& C) { const int st = b / 1024, sb = b % 1024, swz = sb ^ (((sb >> 9) & 1) << 5); R = (st >> 1) * 16 + swz / 64; C = (st & 1) * 32 + (swz % 64) / 2; }
__host__ __device__ __forceinline__ int perm32(int rho) { const int n = rho >> 4, i = rho & 15; return 8 * (i >> 2) + 4 * n + (i & 3); }
struct Unit { int pm, pn; };
struct Gemm { const bf16_t* A; const bf16_t* Bt; int M, N, K; };
struct StaticOrder {
    int nM, nN, nwg, G, c;
    __device__ void init(int M, int N, int G_, int c_) { nM = M / BM; nN = N / BM; nwg = nM * nN; G = G_; c = c_; }
    __device__ bool next(int i, Unit& u) const {
        const long L = (long)i * G + c; if (L >= nwg) return false;
        int wgid = (int)L; { const int q = nwg / NXCD, r = nwg % NXCD, xcd = wgid % NXCD, off = wgid / NXCD; wgid = (xcd < r ? xcd * (q + 1) : r * (q + 1) + (xcd - r) * q) + off; }
        const int nig = WGM * nN, gid = wgid / nig, fm = gid * WGM, gsz = (nM - fm) < WGM ? (nM - fm) : WGM;
        u.pm = fm + ((wgid % nig) % gsz); u.pn = (wgid % nig) / gsz; return true;
    }
};
template <class Epi> __device__ __forceinline__ size_t a_off(const Epi& E, int pm, int K, size_t tstep) { if constexpr (Epi::AROW) return (size_t)E.arow(pm) * K * 2; else return (size_t)pm * tstep; }
template <class Epi, class Sched, bool ALIGN_EPI, bool SP2>
__device__ __forceinline__ void gemm_phase(LAS unsigned char* lds, const Gemm g, const Sched& S, const Epi& E) {
    const int tid = threadIdx.x, wid = __builtin_amdgcn_readfirstlane(tid >> 6), lane = tid & 63, wr = wid >> 2, wc = wid & 3, fr = lane & 15, fq = lane >> 4;
    const int K = g.K, nt = K / BK;
    unsigned voffA[2], voffB[2];
#pragma unroll
    for (int i = 0; i < 2; ++i) { int R, C; stage_rc(tid * 16 + i * 8192, R, C); const int Rb = Epi::PERM ? ((R & ~31) + perm32(R & 31)) : R;
        voffA[i] = (unsigned)(R * K + C) * 2u; voffB[i] = (unsigned)(Rb * K + C) * 2u; }
    const size_t kstep = (size_t)(BK * 2);
    const size_t hstep = (size_t)HALF * K * 2;
    const size_t tstep = 2 * hstep;
    const unsigned ldsw = (unsigned)wid * 1024u;
    const int aoff = lds_byte(wr * 64 + fr, fq * 8), boff = lds_byte(wc * 32 + fr, fq * 8);
#define PG8_SA(b, h) (((b) * 2 + (h)) * HTB)
#define PG8_SB(b, h) ((4 + (b) * 2 + (h)) * HTB)
#define PG8_STAGE(bufoff, gbase, voff) do { _Pragma("unroll") for (int _i = 0; _i < 2; ++_i) \
        __builtin_amdgcn_global_load_lds((const unsigned*)((const char*)(gbase) + (voff)[_i]), (LAS unsigned*)(lds + (bufoff) + ldsw + _i * 8192), 16, 0, 0); } while (0)
#define PG8_LDA(dst, b, h) do { _Pragma("unroll") for (int m = 0; m < 4; ++m) _Pragma("unroll") for (int k = 0; k < 2; ++k) dst[m][k] = *(const LAS bf16x8*)(lds + PG8_SA(b, h) + aoff + m * 2048 + k * 1024); } while (0)
#define PG8_LDB(dst, b, h) do { _Pragma("unroll") for (int n = 0; n < 2; ++n) _Pragma("unroll") for (int k = 0; k < 2; ++k) dst[n][k] = *(const LAS bf16x8*)(lds + PG8_SB(b, h) + boff + n * 2048 + k * 1024); } while (0)
#define PG8_MMA(ai, bj, At, Bt) do { __builtin_amdgcn_s_setprio(1); _Pragma("unroll") for (int m = 0; m < 4; ++m) _Pragma("unroll") for (int n = 0; n < 2; ++n) _Pragma("unroll") for (int k = 0; k < 2; ++k) \
        acc[ai][bj][m][n] = __builtin_amdgcn_mfma_f32_16x16x32_bf16(Bt[n][k], At[m][k], acc[ai][bj][m][n], 0, 0, 0); __builtin_amdgcn_s_setprio(0); } while (0)
#define PG8_WAIT_V(n) asm volatile("s_waitcnt vmcnt(" #n ")" ::: "memory")
#define PG8_WAIT_L(n) asm volatile("s_waitcnt lgkmcnt(" #n ")" ::: "memory")
#define PG8_BAR __builtin_amdgcn_s_barrier()
#define PG8_SCHED __builtin_amdgcn_sched_barrier(0)
    Unit cur, nxt; int ui = 0;
    if (!S.next(0, cur)) return;
    f32x4 acc[2][2][4][2];
#pragma unroll
    for (int a = 0; a < 2; ++a)
#pragma unroll
        for (int b = 0; b < 2; ++b)
#pragma unroll
            for (int m = 0; m < 4; ++m)
#pragma unroll
                for (int n = 0; n < 2; ++n) acc[a][b][m][n] = (f32x4){0.f, 0.f, 0.f, 0.f};
    bf16x8 At[4][2], B0[2][2], B1[2][2];
    const char* cA = (const char*)g.A + a_off<Epi>(E, cur.pm, K, tstep); const char* cB = (const char*)g.Bt + (size_t)cur.pn * tstep;
    if constexpr (SP2) {
        PG8_STAGE(PG8_SB(0, 0), cB, voffB); PG8_STAGE(PG8_SB(0, 1), cB + hstep, voffB); PG8_STAGE(PG8_SA(0, 0), cA, voffA); PG8_STAGE(PG8_SA(0, 1), cA + hstep, voffA);
        if (wr == 1) PG8_BAR;
        PG8_WAIT_V(2); PG8_BAR;
        PG8_STAGE(PG8_SB(1, 0), cB + kstep, voffB); PG8_STAGE(PG8_SA(1, 0), cA + kstep, voffA); PG8_STAGE(PG8_SB(1, 1), cB + hstep + kstep, voffB);
        PG8_WAIT_V(6); PG8_BAR;
    } else {
        PG8_STAGE(PG8_SB(0, 0), cB, voffB); PG8_STAGE(PG8_SA(0, 0), cA, voffA); PG8_STAGE(PG8_SB(0, 1), cB + hstep, voffB); PG8_STAGE(PG8_SA(0, 1), cA + hstep, voffA);
        if (wr == 1) PG8_BAR;
        PG8_WAIT_V(4); PG8_BAR;
        PG8_STAGE(PG8_SB(1, 0), cB + kstep, voffB); PG8_STAGE(PG8_SA(1, 0), cA + kstep, voffA); PG8_STAGE(PG8_SB(1, 1), cB + hstep + kstep, voffB);
        PG8_WAIT_V(6); PG8_BAR;
    }
    for (;;) {
        const bool has_next = S.next(ui + 1, nxt);
        const char* nA = has_next ? (const char*)g.A + a_off<Epi>(E, nxt.pm, K, tstep) : cA; const char* nB = has_next ? (const char*)g.Bt + (size_t)nxt.pn * tstep : cB;
#pragma unroll 1
        for (int t = 0; t < nt; t += 2) {
            const bool last = (t == nt - 2);
            if constexpr (Epi::MID) { if (t == nt / 2) E.mid(acc, cur, wr, wc, fr, fq); }
            const char* a1 = cA + (size_t)(t + 1) * kstep;
            const char* a2 = last ? nA : cA + (size_t)(t + 2) * kstep; const char* b2 = last ? nB : cB + (size_t)(t + 2) * kstep;
            const char* a3 = a2 + kstep; const char* b3 = b2 + kstep;
            if constexpr (SP2) {
            PG8_LDB(B0, 0, 0); PG8_LDB(B1, 0, 1); PG8_SCHED; PG8_LDA(At, 0, 0); PG8_STAGE(PG8_SA(1, 1), a1 + hstep, voffA);
            PG8_WAIT_V(8); PG8_WAIT_L(0); PG8_BAR; PG8_MMA(0, 0, At, B0); PG8_MMA(0, 1, At, B1); PG8_BAR; PG8_SCHED;
            PG8_LDA(At, 0, 1); PG8_STAGE(PG8_SB(0, 0), b2, voffB); PG8_STAGE(PG8_SB(0, 1), b2 + hstep, voffB); PG8_STAGE(PG8_SA(0, 0), a2, voffA);
            PG8_WAIT_V(8); PG8_WAIT_L(0); PG8_BAR; PG8_MMA(1, 0, At, B0); PG8_MMA(1, 1, At, B1); PG8_BAR; PG8_SCHED;
            PG8_LDB(B0, 1, 0); PG8_LDB(B1, 1, 1); PG8_SCHED; PG8_LDA(At, 1, 0); PG8_STAGE(PG8_SA(0, 1), a2 + hstep, voffA);
            PG8_WAIT_V(8); PG8_WAIT_L(0); PG8_BAR; PG8_MMA(0, 0, At, B0); PG8_MMA(0, 1, At, B1); PG8_BAR; PG8_SCHED;
            PG8_LDA(At, 1, 1); PG8_STAGE(PG8_SB(1, 0), b3, voffB); PG8_STAGE(PG8_SB(1, 1), b3 + hstep, voffB); PG8_STAGE(PG8_SA(1, 0), a3, voffA);
            PG8_WAIT_V(8); PG8_WAIT_L(0); PG8_BAR; PG8_MMA(1, 0, At, B0); PG8_MMA(1, 1, At, B1); PG8_BAR; PG8_SCHED;
            } else {
            PG8_LDB(B0, 0, 0); PG8_SCHED; PG8_LDA(At, 0, 0); PG8_STAGE(PG8_SA(1, 1), a1 + hstep, voffA);
            PG8_WAIT_L(8); PG8_BAR; PG8_WAIT_L(0); PG8_MMA(0, 0, At, B0); PG8_BAR; PG8_SCHED;
            PG8_LDB(B1, 0, 1); PG8_STAGE(PG8_SB(0, 0), b2, voffB);
            PG8_BAR; PG8_WAIT_L(0); PG8_MMA(0, 1, At, B1); PG8_BAR;
            PG8_LDA(At, 0, 1); PG8_STAGE(PG8_SA(0, 0), a2, voffA);
            PG8_BAR; PG8_WAIT_L(0); PG8_MMA(1, 0, At, B0); PG8_BAR; PG8_SCHED;
            PG8_STAGE(PG8_SB(0, 1), b2 + hstep, voffB);
            PG8_WAIT_V(6); PG8_BAR; PG8_MMA(1, 1, At, B1); PG8_BAR;
            PG8_LDB(B0, 1, 0); PG8_SCHED; PG8_LDA(At, 1, 0); PG8_STAGE(PG8_SA(0, 1), a2 + hstep, voffA);
            PG8_WAIT_L(8); PG8_BAR; PG8_WAIT_L(0); PG8_MMA(0, 0, At, B0); PG8_BAR; PG8_SCHED;
            PG8_LDB(B1, 1, 1); PG8_STAGE(PG8_SB(1, 0), b3, voffB);
            PG8_BAR; PG8_WAIT_L(0); PG8_MMA(0, 1, At, B1); PG8_BAR;
            PG8_LDA(At, 1, 1); PG8_STAGE(PG8_SA(1, 0), a3, voffA);
            PG8_BAR; PG8_WAIT_L(0); PG8_MMA(1, 0, At, B0); PG8_BAR; PG8_SCHED;
            PG8_STAGE(PG8_SB(1, 1), b3 + hstep, voffB);
            PG8_WAIT_V(6); PG8_BAR; PG8_MMA(1, 1, At, B1); PG8_BAR;
            }
        }
        if constexpr (ALIGN_EPI) { if (wr == 0) PG8_BAR; }
        E(acc, cur, wr, wc, fr, fq);
        if (!has_next) break;
#pragma unroll
        for (int a = 0; a < 2; ++a)
#pragma unroll
            for (int b = 0; b < 2; ++b)
#pragma unroll
                for (int m = 0; m < 4; ++m)
#pragma unroll
                    for (int n = 0; n < 2; ++n) acc[a][b][m][n] = (f32x4){0.f, 0.f, 0.f, 0.f};
        cur = nxt; cA = nA; cB = nB; ++ui;
        if constexpr (ALIGN_EPI) { if (wr == 1) PG8_BAR; }
    }
    PG8_WAIT_V(0);
    if constexpr (!ALIGN_EPI) { if (wr == 0) PG8_BAR; }
    PG8_BAR;
#undef PG8_SA
#undef PG8_SB
#undef PG8_STAGE
#undef PG8_LDA
#undef PG8_LDB
#undef PG8_MMA
#undef PG8_WAIT_V
#undef PG8_WAIT_L
#undef PG8_BAR
#undef PG8_SCHED
}
}
using pg8::HALF;

DEVI u32x4 pack8(const f32x4& a, const f32x4& b) { u32x4 w; w.x = pk2(a[0], a[1]); w.y = pk2(a[2], a[3]); w.z = pk2(b[0], b[1]); w.w = pk2(b[2], b[3]); return w; }

struct EpiIn {
    static constexpr bool PERM = true, MID = false, AROW = false;
    const float* rowss; const float* shW; int job;
    bf16_t *d0, *d1, *d2, *d3, *d4; float* ba;
    DEVI void operator()(const f32x4 (&acc)[2][2][4][2], const pg8::Unit& u, int wr, int wc, int fr, int fq) const {
        asm volatile("" : "+v"(fr), "+v"(fq));
        const int vs = u.pm < 64 ? 0 : (u.pm < 128 ? 1 : 2);
        bf16_t* base; int pitch, colt; bool isba = false;
        if (job == 0) { base = d0; pitch = 3072; colt = u.pn * 256; if (u.pn >= 12) isba = true; }
        else {
            if (u.pn < 4) { base = d0; pitch = 1024; colt = u.pn * 256; }
            else if (u.pn < 8) { base = d1; pitch = 1024; colt = (u.pn - 4) * 256; }
            else if (u.pn == 8) { base = d2; pitch = 256; colt = 0; }
            else if (u.pn == 9) { base = d3; pitch = 256; colt = 0; }
            else { base = d4; pitch = 2048; colt = (u.pn - 10) * 256; }
        }
        const int ncol0 = u.pn * 256 + wc * 32 + 8 * fq;
        f32x4 sv[2][2];
#pragma unroll
        for (int bj = 0; bj < 2; ++bj)
#pragma unroll
            for (int n = 0; n < 2; ++n) sv[bj][n] = *(const f32x4*)(shW + vs * NSH + ncol0 + bj * HALF + 4 * n);
        const int row0 = u.pm * 256 + wr * 64 + fr;
#pragma unroll
        for (int ai = 0; ai < 2; ++ai)
#pragma unroll
            for (int m = 0; m < 4; ++m) {
                const int row = row0 + ai * HALF + m * 16;
                const float rs = rsqrtf(rowss[row] * (1.f / 1024.f) + EPS);
                if (!isba) {
                    bf16_t* rowp = base + (size_t)row * pitch + colt + wc * 32 + 8 * fq;
#pragma unroll
                    for (int bj = 0; bj < 2; ++bj) { const f32x4 v0 = acc[ai][bj][m][0] * rs + sv[bj][0], v1 = acc[ai][bj][m][1] * rs + sv[bj][1]; *(u32x4*)(rowp + bj * HALF) = pack8(v0, v1); }
                } else if (wc == 0) {
                    float* rowp = ba + (size_t)row * 32 + 8 * fq;
                    *(f32x4*)(rowp) = acc[ai][0][m][0] * rs + sv[0][0]; *(f32x4*)(rowp + 4) = acc[ai][0][m][1] * rs + sv[0][1];
                }
            }
    }
};
struct TailOrder { int idx; __device__ bool next(int i, pg8::Unit& u) const { if (i == 0 && idx >= 0 && idx < 4) { u.pm = idx >> 1; u.pn = idx & 1; return true; } return false; } };
struct EpiCtxKV {
    static constexpr bool PERM = true, MID = false, AROW = false;
    const float* rowss; const float* shW; bf16_t* kat; bf16_t* vat;
    DEVI void operator()(const f32x4 (&acc)[2][2][4][2], const pg8::Unit& u, int wr, int wc, int fr, int fq) const {
        asm volatile("" : "+v"(fr), "+v"(fq));
        bf16_t* base = (u.pn == 0 ? kat : vat);
        const int ncol0 = u.pn * 256 + wc * 32 + 8 * fq;
#pragma unroll
        for (int bj = 0; bj < 2; ++bj) {
            const f32x4 sv0 = *(const f32x4*)(shW + ncol0 + bj * HALF), sv1 = *(const f32x4*)(shW + ncol0 + bj * HALF + 4);
#pragma unroll
            for (int ai = 0; ai < 2; ++ai)
#pragma unroll
                for (int m = 0; m < 4; ++m) { const int row = u.pm * 256 + ai * HALF + wr * 64 + m * 16 + fr;
                    const float rs = rsqrtf(rowss[row] * (1.f / 1024.f) + EPS);
                    *(u32x4*)(base + (size_t)row * 256 + wc * 32 + 8 * fq + bj * HALF) = pack8(acc[ai][bj][m][0] * rs + sv0, acc[ai][bj][m][1] * rs + sv1); }
        }
    }
};
struct EpiBr {
    static constexpr bool PERM = true, MID = true, AROW = false;
    const bf16_t* mg; bf16_t* out;
    DEVI void mid(f32x4 (&acc)[2][2][4][2], const pg8::Unit& u, int wr, int wc, int fr, int fq) const {
        asm volatile("" : "+v"(fr), "+v"(fq));
        const int row0 = u.pm * 256 + wr * 64 + fr, col0 = u.pn * 256 + wc * 32 + 8 * fq;
#pragma unroll
        for (int ai = 0; ai < 2; ++ai)
#pragma unroll
            for (int m = 0; m < 4; ++m) {
                const bf16_t* rp = mg + (size_t)(row0 + ai * HALF + m * 16) * 2048 + col0;
#pragma unroll
                for (int bj = 0; bj < 2; ++bj) {
                    const u32x4 gd = *(const u32x4*)(rp + bj * HALF), ga = *(const u32x4*)(rp + 1024 + bj * HALF);
                    float r[8];
#pragma unroll
                    for (int i = 0; i < 4; ++i) {
                        const float d0 = bflo(gd[i]), d1 = bfhi(gd[i]), a0 = bflo(ga[i]), a1 = bfhi(ga[i]);
                        r[2 * i] = (1.f + __expf(fminf(-a0, 80.f))) * __builtin_amdgcn_rcpf(1.f + __expf(fminf(-d0, 80.f)));
                        r[2 * i + 1] = (1.f + __expf(fminf(-a1, 80.f))) * __builtin_amdgcn_rcpf(1.f + __expf(fminf(-d1, 80.f)));
                    }
                    acc[ai][bj][m][0] *= (f32x4){r[0], r[1], r[2], r[3]}; acc[ai][bj][m][1] *= (f32x4){r[4], r[5], r[6], r[7]};
                    asm volatile("" ::: "memory");
                }
            }
    }
    DEVI void operator()(const f32x4 (&acc)[2][2][4][2], const pg8::Unit& u, int wr, int wc, int fr, int fq) const {
        asm volatile("" : "+v"(fr), "+v"(fq));
        const int row0 = u.pm * 256 + wr * 64 + fr, col0 = u.pn * 256 + wc * 32 + 8 * fq;
#pragma unroll
        for (int ai = 0; ai < 2; ++ai)
#pragma unroll
            for (int m = 0; m < 4; ++m) {
                const size_t row = (size_t)(row0 + ai * HALF + m * 16);
                const bf16_t* rp = mg + row * 2048 + 1024 + col0;
#pragma unroll
                for (int bj = 0; bj < 2; ++bj) {
                    const u32x4 ga = *(const u32x4*)(rp + bj * HALF);
                    float s[8];
#pragma unroll
                    for (int i = 0; i < 4; ++i) { s[2 * i] = __builtin_amdgcn_rcpf(1.f + __expf(fminf(-bflo(ga[i]), 80.f))); s[2 * i + 1] = __builtin_amdgcn_rcpf(1.f + __expf(fminf(-bfhi(ga[i]), 80.f))); }
                    const f32x4 v0 = acc[ai][bj][m][0] * (f32x4){s[0], s[1], s[2], s[3]}, v1 = acc[ai][bj][m][1] * (f32x4){s[4], s[5], s[6], s[7]};
                    *(u32x4*)(out + row * 1024 + col0 + bj * HALF) = pack8(v0, v1);
                }
            }
    }
};
struct EpiOut {
    static constexpr bool PERM = false, MID = false, AROW = false;
    const float* x; const float* modacc; const float* bada; const float* nwf; float* out; bf16_t* x1s; float* rowss2;
    DEVI void operator()(const f32x4 (&acc)[2][2][4][2], const pg8::Unit& u, int wr, int wc, int fr, int fq) const {
        asm volatile("" : "+v"(fr), "+v"(fq));
        const int b = u.pm >> 6; const int row0 = u.pm * 256 + wr * 64 + fr, col0 = u.pn * 256 + wc * 32 + 4 * fq;
        f32x4 ga[2][2], sc[2][2];
#pragma unroll
        for (int bj = 0; bj < 2; ++bj)
#pragma unroll
            for (int n = 0; n < 2; ++n) { const int c = col0 + bj * HALF + n * 16;
                ga[bj][n] = *(const f32x4*)(modacc + b * 6144 + 2048 + c) + *(const f32x4*)(bada + 2048 + c);
                sc[bj][n] = (*(const f32x4*)(modacc + b * 6144 + 4096 + c) + *(const f32x4*)(bada + 4096 + c) + 1.f) * *(const f32x4*)(nwf + c); }
#pragma unroll
        for (int ai = 0; ai < 2; ++ai)
#pragma unroll
            for (int m = 0; m < 4; ++m) {
                const size_t off = (size_t)(row0 + ai * HALF + m * 16) * 1024 + col0; float ss = 0.f;
#pragma unroll
                for (int bj = 0; bj < 2; ++bj)
#pragma unroll
                    for (int n = 0; n < 2; ++n) {
                        const f32x4 xv = *(const f32x4*)(x + off + bj * HALF + n * 16);
                        const f32x4 o = xv + ga[bj][n] * acc[ai][bj][m][n];
                        *(f32x4*)(out + off + bj * HALF + n * 16) = o;
                        ss += (o[0] * o[0] + o[1] * o[1]) + (o[2] * o[2] + o[3] * o[3]);
                        const f32x4 s = o * sc[bj][n]; u32x2 w; w.x = pk2(s[0], s[1]); w.y = pk2(s[2], s[3]);
                        *(u32x2*)(x1s + off + (size_t)(b * (RB - SEQ) + 1) * 1024 + bj * HALF + n * 16) = w;
                    }
                ss += __shfl_xor(ss, 16); ss += __shfl_xor(ss, 32);
                if (fq == 0) atomicAdd(rowss2 + row0 + ai * HALF + m * 16, ss);
            }
    }
};
DEVI f32x4 dpp_ror1(const f32x4& x) { f32x4 r;
#pragma unroll
    for (int i = 0; i < 4; ++i) r[i] = __int_as_float(__builtin_amdgcn_update_dpp(0, __float_as_int(x[i]), 0x121, 0xf, 0xf, false));
    return r; }
DEVI f32x4 dpp_rol1(const f32x4& x) { f32x4 r;
#pragma unroll
    for (int i = 0; i < 4; ++i) r[i] = __int_as_float(__builtin_amdgcn_update_dpp(0, __float_as_int(x[i]), 0x12F, 0xf, 0xf, false));
    return r; }
struct EpiUpConv {
    static constexpr bool PERM = true, MID = false, AROW = true;
    const float* rowss2; const float* shWf; const float* cw; const float* cb; bf16_t* act; LAS float* xb;
    DEVI int arow(int pm) const { const int b = pm / TPB, i = pm - b * TPB; return b * RB + 254 * i; }
    DEVI void operator()(f32x4 (&acc)[2][2][4][2], const pg8::Unit& u, int wr, int wc, int fr, int fq) const {
        asm volatile("" : "+v"(fr), "+v"(fq));
        const int b = u.pm / TPB, ti = u.pm - b * TPB, tok0 = 254 * ti - 1;
        const int cl0 = wc * 32 + 8 * fq;
#pragma unroll
        for (int bj = 0; bj < 2; ++bj) {
            const f32x4 sv0 = *(const f32x4*)(shWf + b * NUP + u.pn * 256 + bj * HALF + cl0), sv1 = *(const f32x4*)(shWf + b * NUP + u.pn * 256 + bj * HALF + cl0 + 4);
#pragma unroll
            for (int ai = 0; ai < 2; ++ai)
#pragma unroll
                for (int m = 0; m < 4; ++m) {
                    const int tok = tok0 + ai * HALF + wr * 64 + m * 16 + fr; const bool ok = tok >= 0 && tok < SEQ;
                    const float rs = ok ? rsqrtf(rowss2[b * SEQ + (ok ? tok : 0)] * (1.f / 1024.f) + EPS) : 0.f;
                    acc[ai][bj][m][0] = ok ? acc[ai][bj][m][0] * rs + sv0 : (f32x4){0.f, 0.f, 0.f, 0.f};
                    acc[ai][bj][m][1] = ok ? acc[ai][bj][m][1] * rs + sv1 : (f32x4){0.f, 0.f, 0.f, 0.f};
                }
        }
#pragma unroll
        for (int ai = 0; ai < 2; ++ai) { const int blk = 2 * ai + wr;
#pragma unroll
            for (int bj = 0; bj < 2; ++bj)
#pragma unroll
                for (int n = 0; n < 2; ++n) {
                    if (fr == 0) *(LAS f32x4*)(xb + (blk * 2 + 0) * 256 + bj * HALF + cl0 + 4 * n) = acc[ai][bj][0][n];
                    if (fr == 15) *(LAS f32x4*)(xb + (blk * 2 + 1) * 256 + bj * HALF + cl0 + 4 * n) = acc[ai][bj][3][n];
                } }
        asm volatile("s_waitcnt lgkmcnt(0)" ::: "memory"); __builtin_amdgcn_s_barrier(); asm volatile("" ::: "memory");
        const int f0 = u.pn * 128 + cl0;
#pragma unroll
        for (int n = 0; n < 2; ++n) {
            f32x4 wg[3], wv[3];
#pragma unroll
            for (int j = 0; j < 3; ++j) { wg[j] = *(const f32x4*)(cw + j * NUP + f0 + 4 * n); wv[j] = *(const f32x4*)(cw + j * NUP + DFF + f0 + 4 * n); }
            const f32x4 bgv = *(const f32x4*)(cb + f0 + 4 * n), bvv = *(const f32x4*)(cb + DFF + f0 + 4 * n);
#pragma unroll
            for (int ai = 0; ai < 2; ++ai) { const int blk = 2 * ai + wr;
                const f32x4 pgx = *(const LAS f32x4*)(xb + (((blk + 3) & 3) * 2 + 1) * 256 + cl0 + 4 * n), pvx = *(const LAS f32x4*)(xb + (((blk + 3) & 3) * 2 + 1) * 256 + HALF + cl0 + 4 * n);
                const f32x4 ngx = *(const LAS f32x4*)(xb + (((blk + 1) & 3) * 2 + 0) * 256 + cl0 + 4 * n), nvx = *(const LAS f32x4*)(xb + (((blk + 1) & 3) * 2 + 0) * 256 + HALF + cl0 + 4 * n);
#pragma unroll
                for (int m = 0; m < 4; ++m) {
                    f32x4 ug, uv;
                    { const f32x4 c = acc[ai][0][m][n], up = m > 0 ? acc[ai][0][m > 0 ? m - 1 : 0][n] : pgx, dn = m < 3 ? acc[ai][0][m < 3 ? m + 1 : 3][n] : ngx;
                      f32x4 pr = dpp_ror1(fr == 15 ? up : c), nx = dpp_rol1(fr == 0 ? dn : c);
                      asm volatile("" : "+v"(pr), "+v"(nx));
                      ug = bgv + wg[0] * pr + wg[1] * c + wg[2] * nx; }
                    { const f32x4 c = acc[ai][1][m][n], up = m > 0 ? acc[ai][1][m > 0 ? m - 1 : 0][n] : pvx, dn = m < 3 ? acc[ai][1][m < 3 ? m + 1 : 3][n] : nvx;
                      f32x4 pr = dpp_ror1(fr == 15 ? up : c), nx = dpp_rol1(fr == 0 ? dn : c);
                      asm volatile("" : "+v"(pr), "+v"(nx));
                      uv = bvv + wv[0] * pr + wv[1] * c + wv[2] * nx; }
                    const int r = ai * HALF + wr * 64 + m * 16 + fr, tok = tok0 + r;
                    if (r >= 1 && r <= 254 && tok < SEQ) {
                        u32x2 w; w.x = pk2(siluf(ug[0]) * uv[0], siluf(ug[1]) * uv[1]); w.y = pk2(siluf(ug[2]) * uv[2], siluf(ug[3]) * uv[3]);
                        *(u32x2*)(act + (size_t)(b * SEQ + tok) * DFF + f0 + 4 * n) = w; }
                    asm volatile("" ::: "memory");
                }
            }
        }
    }
};
struct EpiDown {
    static constexpr bool PERM = false, MID = false, AROW = false;
    const float* modacc; const float* bada; float* out;
    DEVI void operator()(const f32x4 (&acc)[2][2][4][2], const pg8::Unit& u, int wr, int wc, int fr, int fq) const {
        asm volatile("" : "+v"(fr), "+v"(fq));
        const int b = u.pm >> 6; const int row0 = u.pm * 256 + wr * 64 + fr, col0 = u.pn * 256 + wc * 32 + 4 * fq;
        f32x4 gf[2][2];
#pragma unroll
        for (int bj = 0; bj < 2; ++bj)
#pragma unroll
            for (int n = 0; n < 2; ++n) { const int c = col0 + bj * HALF + n * 16; gf[bj][n] = *(const f32x4*)(modacc + b * 6144 + 5120 + c) + *(const f32x4*)(bada + 5120 + c); }
#pragma unroll
        for (int ai = 0; ai < 2; ++ai)
#pragma unroll
            for (int m = 0; m < 4; ++m) {
                const size_t off = (size_t)(row0 + ai * HALF + m * 16) * 1024 + col0;
#pragma unroll
                for (int bj = 0; bj < 2; ++bj)
#pragma unroll
                    for (int n = 0; n < 2; ++n) { float* p = out + off + bj * HALF + n * 16; *(f32x4*)p = *(const f32x4*)p + gf[bj][n] * acc[ai][bj][m][n]; }
            }
    }
};

DEVI void transpose_item(const float* W, int srcN, int k0, int n0, bf16_t* dst  , int dstK, LAS float* scr, int lane) {
#pragma unroll
    for (int i = 0; i < 8; ++i) { const int kk = 8 * i + (lane >> 3), n4 = (lane & 7) * 4; const f32x4 v = *(const f32x4*)(W + (size_t)(k0 + kk) * srcN + n0 + n4);
        LAS float* d = scr + kk * 33 + n4; d[0] = v[0]; d[1] = v[1]; d[2] = v[2]; d[3] = v[3]; }
    asm volatile("s_waitcnt lgkmcnt(0)" ::: "memory");
    const int c = lane & 7;
#pragma unroll
    for (int j = 0; j < 4; ++j) { const int n = (lane >> 3) + 8 * j; const LAS float* s = scr + (8 * c) * 33 + n;
        u32x4 o; o.x = pk2(s[0 * 33], s[1 * 33]); o.y = pk2(s[2 * 33], s[3 * 33]); o.z = pk2(s[4 * 33], s[5 * 33]); o.w = pk2(s[6 * 33], s[7 * 33]);
        *(u32x4*)(dst + (size_t)n * dstK + 8 * c) = o; }
    asm volatile("s_waitcnt lgkmcnt(0)" ::: "memory");
}
DEVI void phase0(const KA& a, LAS unsigned char* lds, int tid, int lane, int wave) {
    unsigned char* ws = a.ws();
    bf16_t* WinA = (bf16_t*)(ws + WS_WINA); bf16_t* WinC = (bf16_t*)(ws + WS_WINC); bf16_t* Wbr = (bf16_t*)(ws + WS_WBR);
    bf16_t* Wout = (bf16_t*)(ws + WS_WOUT); bf16_t* Wup = (bf16_t*)(ws + WS_WUP); bf16_t* Wdn = (bf16_t*)(ws + WS_WDN);
    LAS float* scr = (LAS float*)(lds + wave * 16384);
    const int gw = blockIdx.x * 8 + wave, NGW = gridDim.x * 8;
    constexpr int I_IN = 16 * 241, I_BR = 16 * 32, I_UP = 16 * 176, I_DN = 44 * 32;
    constexpr int NITEMS = I_IN + 3 * I_BR + I_UP + I_DN;
    for (int it = gw; it < NITEMS; it += NGW) {
        int r = it;
        if (r < I_IN) { const int kb = r / 241, nb = r % 241, c0 = nb * 32; bf16_t* d; int row;
            if (c0 < 3072) { d = WinA; row = c0; } else if (c0 < 4096) { d = WinC; row = c0 - 3072; } else if (c0 == 4096) { d = WinA; row = 3072; }
            else if (c0 < 5152) { d = WinC; row = 1024 + (c0 - 4128); } else if (c0 < 5408) { d = WinC; row = 2048 + (c0 - 5152); }
            else if (c0 < 5664) { d = WinC; row = 2304 + (c0 - 5408); } else { d = WinC; row = 2560 + (c0 - 5664); }
            transpose_item(a.in(8), 7712, kb * 64, c0, d + (size_t)row * 1024 + kb * 64, 1024, scr, lane); continue; }
        r -= I_IN;
        if (r < I_BR) { const int kb = r / 32, nb = r % 32; transpose_item(a.in(16), 1024, kb * 64, nb * 32, Wbr + (size_t)(nb * 32) * 2048 + kb * 64, 2048, scr, lane); continue; }
        r -= I_BR;
        if (r < I_BR) { const int kb = r / 32, nb = r % 32; transpose_item(a.in(17), 1024, kb * 64, nb * 32, Wbr + (size_t)(nb * 32) * 2048 + 1024 + kb * 64, 2048, scr, lane); continue; }
        r -= I_BR;
        if (r < I_BR) { const int kb = r / 32, nb = r % 32; transpose_item(a.in(18), 1024, kb * 64, nb * 32, Wout + (size_t)(nb * 32) * 1024 + kb * 64, 1024, scr, lane); continue; }
        r -= I_BR;
        if (r < I_UP) { const int kb = r / 176, nb = r % 176, c0 = nb * 32; int row;
            if (c0 < DFF) row = 256 * (c0 / 128) + (c0 % 128); else { const int c1 = c0 - DFF; row = 256 * (c1 / 128) + 128 + (c1 % 128); }
            transpose_item(a.in(19), NUP, kb * 64, c0, Wup + (size_t)row * 1024 + kb * 64, 1024, scr, lane); continue; }
        r -= I_UP;
        { const int kb = r / 32, nb = r % 32; transpose_item(a.in(22), 1024, kb * 64, nb * 32, Wdn + (size_t)(nb * 32) * DFF + kb * 64, DFF, scr, lane); }
    }
    float* modacc = (float*)(ws + CTL_MODACC);
    for (int it = blockIdx.x; it < 12 * 16; it += gridDim.x) {
        const int cb = it % 12, ks = it / 12, n = cb * 512 + tid;
        float a0 = 0.f, a1 = 0.f, a2 = 0.f;
#pragma unroll 8
        for (int k = ks * 64; k < ks * 64 + 64; ++k) {
            const float w = a.in(4)[(size_t)k * 6144 + n];
            a0 += siluf(a.in(1)[k]) * w; a1 += siluf(a.in(1)[1024 + k]) * w; a2 += siluf(a.in(3)[k]) * w;
        }
        atomicAdd(modacc + n, a0); atomicAdd(modacc + 6144 + n, a1); atomicAdd(modacc + 12288 + n, a2);
    }
    float* rope = (float*)(ws + SM_ROPE);
    for (int i = blockIdx.x * 512 + tid; i < 320 * 32; i += gridDim.x * 512) {
        const int p = i >> 5, f = i & 31; const float inv = powf(10000.f, -(float)f / 32.f);
        if (p < 256) { const float ang = (float)p * inv; rope[p * 32 + f] = cosf(ang); rope[8192 + p * 32 + f] = sinf(ang); }
        else { const int q = p - 256; const float ang = (float)q * inv; rope[16384 + q * 32 + f] = cosf(ang); rope[16384 + 2048 + q * 32 + f] = sinf(ang); }
    }
}

DEVI void phase1(const KA& a, int tid, int lane, int wave) {
    unsigned char* ws = a.ws();
    const float* modacc = (const float*)(ws + CTL_MODACC); const float* bada = a.in(5);
    bf16_t* XN = (bf16_t*)(ws + WS_XN); float* rowss1 = (float*)(ws + SM_ROWSS1);
    const int gw = blockIdx.x * 8 + wave, NGW = gridDim.x * 8;
    {
        const int per = (MT + NGW - 1) / NGW, rbeg = gw * per, rend = rbeg + per < MT ? rbeg + per : MT;
        int vcur = -1; f32x4 sc[4];
        for (int row = rbeg; row < rend; row += 2) {
            const int vs = row < SEQ ? 0 : (row < ML ? 1 : 2);
            if (vs != vcur) { vcur = vs;
#pragma unroll
                for (int j = 0; j < 4; ++j) { const int c = 4 * lane + 256 * j; sc[j] = (*(const f32x4*)(modacc + vs * 6144 + 1024 + c) + *(const f32x4*)(bada + 1024 + c) + 1.f) * *(const f32x4*)(a.in(6) + c); } }
            const int row1 = row + 1; const bool two = row1 < rend && (row1 < SEQ ? 0 : (row1 < ML ? 1 : 2)) == vs;
            const float* xr0 = row < ML ? a.in(0) + (size_t)row * 1024 : a.in(2) + (size_t)(row - ML) * 1024;
            const float* xr1 = two ? (row1 < ML ? a.in(0) + (size_t)row1 * 1024 : a.in(2) + (size_t)(row1 - ML) * 1024) : xr0;
            f32x4 v0[4], v1[4];
#pragma unroll
            for (int j = 0; j < 4; ++j) { v0[j] = *(const f32x4*)(xr0 + 4 * lane + 256 * j); v1[j] = *(const f32x4*)(xr1 + 4 * lane + 256 * j); }
            float s0 = 0.f, s1 = 0.f;
#pragma unroll
            for (int j = 0; j < 4; ++j) { const int c = 4 * lane + 256 * j;
                s0 += (v0[j][0] * v0[j][0] + v0[j][1] * v0[j][1]) + (v0[j][2] * v0[j][2] + v0[j][3] * v0[j][3]);
                s1 += (v1[j][0] * v1[j][0] + v1[j][1] * v1[j][1]) + (v1[j][2] * v1[j][2] + v1[j][3] * v1[j][3]);
                const f32x4 o0 = v0[j] * sc[j], o1 = v1[j] * sc[j];
                u32x2 w; w.x = pk2(o0[0], o0[1]); w.y = pk2(o0[2], o0[3]); *(u32x2*)(XN + (size_t)row * 1024 + c) = w;
                if (two) { u32x2 w1; w1.x = pk2(o1[0], o1[1]); w1.y = pk2(o1[2], o1[3]); *(u32x2*)(XN + (size_t)row1 * 1024 + c) = w1; } }
            s0 = wave_sum(s0); s1 = wave_sum(s1);
            if (lane == 0) { rowss1[row] = s0; if (two) rowss1[row1] = s1; }
            if (!two) --row;
        }
    }
    const bf16_t* WinA = (const bf16_t*)(ws + WS_WINA); const bf16_t* WinC = (const bf16_t*)(ws + WS_WINC); const bf16_t* Wup = (const bf16_t*)(ws + WS_WUP);
    float* shWa = (float*)(ws + SM_SHWA); float* shWf = (float*)(ws + SM_SHWF);
    for (int n = gw; n < NSH + NUP; n += NGW) {
        const bool isf = n >= NSH;
        const bf16_t* wrow = isf ? Wup + (size_t)(n - NSH) * 1024 : (n < NA ? WinA + (size_t)n * 1024 : WinC + (size_t)(n - NA) * 1024);
        const int shoff = isf ? 3072 : 0;
        float s0 = 0.f, s1 = 0.f, s2 = 0.f;
#pragma unroll
        for (int h = 0; h < 2; ++h) {
            const int k0 = h * 512 + lane * 8;
            const u32x4 w = *(const u32x4*)(wrow + k0);
#pragma unroll
            for (int i = 0; i < 4; ++i) {
                const float wl = bflo(w[i]), wh = bfhi(w[i]); const int k = k0 + 2 * i;
                const float b0 = bada[shoff + k], b1 = bada[shoff + k + 1];
                s0 += (modacc[shoff + k] + b0) * wl + (modacc[shoff + k + 1] + b1) * wh;
                s1 += (modacc[6144 + shoff + k] + b0) * wl + (modacc[6144 + shoff + k + 1] + b1) * wh;
                s2 += (modacc[12288 + shoff + k] + b0) * wl + (modacc[12288 + shoff + k + 1] + b1) * wh;
            }
        }
        s0 = wave_sum(s0); s1 = wave_sum(s1); s2 = wave_sum(s2);
        if (lane == 0) {
            if (isf) { shWf[n - NSH] = s0; shWf[NUP + n - NSH] = s1; }
            else { shWa[n] = s0; shWa[NSH + n] = s1; shWa[2 * NSH + n] = s2; }
        }
    }
}

DEVI u32x4 ldrow_(const bf16_t* base, int seq_start, int seq_len, int tt) {
    const int tc = tt < 0 ? 0 : (tt >= seq_len ? seq_len - 1 : tt);
    const u32x4 v = *(const u32x4*)(base + (size_t)(seq_start + tc) * 3072);
    const unsigned m = (tt == tc) ? 0xffffffffu : 0u;
    return (u32x4){v[0] & m, v[1] & m, v[2] & m, v[3] & m};
}
DEVI void phase_dnprep(const KA& a, int tid) {
    unsigned char* ws = a.ws();
    const bf16_t* QR = (const bf16_t*)(ws + WS_QKVR); bf16_t* QP = (bf16_t*)(ws + WS_QKVP);
    const float* convw = a.in(9); const float* ba = (const float*)(ws + WS_BA);
    float* gb = (float*)(ws + WS_G); float* bb = (float*)(ws + WS_BETA);
    const int cgp = tid & 127, strip = tid >> 7;
    u32x4 cur[20], nxt[20];
#define PREP_GEOM(it_, seq_start_, t0_, seq_len_, col_) const int cidx_ = (it_) / 3, sec_ = (it_) - cidx_ * 3; int seq_start_, t0_, seq_len_; \
        if (cidx_ < 512) { seq_start_ = (cidx_ >> 8) * SEQ; t0_ = (cidx_ & 255) * 64; seq_len_ = SEQ; } \
        else { const int c2_ = cidx_ - 512; seq_start_ = ML + (c2_ >> 2) * CTX; t0_ = (c2_ & 3) * 64; seq_len_ = CTX; } \
        const int col_ = sec_ * 1024 + cgp * 8;
#define PREP_LOAD(dst, it_) do { PREP_GEOM(it_, ss_, t0__, sl_, cl_) const int tb_ = t0__ + strip * 16; \
        _Pragma("unroll") for (int r = 0; r < 20; ++r) dst[r] = ldrow_(QR + cl_, ss_, sl_, tb_ + r - 2); } while (0)
    if ((int)blockIdx.x < 520 * 3) PREP_LOAD(cur, (int)blockIdx.x);
    for (int it = blockIdx.x; it < 520 * 3; it += gridDim.x) {
        if (it + (int)gridDim.x < 520 * 3) PREP_LOAD(nxt, it + (int)gridDim.x);
        PREP_GEOM(it, seq_start, t0, seq_len, col)
        const int sec = sec_;
        f32x4 w0[5], w1[5];
#pragma unroll
        for (int j = 0; j < 5; ++j) { w0[j] = *(const f32x4*)(convw + j * 3072 + col); w1[j] = *(const f32x4*)(convw + j * 3072 + col + 4); }
        const int tb = t0 + strip * 16;
#pragma unroll
        for (int r = 0; r < 16; ++r) {
            f32x4 acc0 = {0.f, 0.f, 0.f, 0.f}, acc1 = {0.f, 0.f, 0.f, 0.f};
#pragma unroll
            for (int j = 0; j < 5; ++j) { const u32x4 x = cur[r + j];
                acc0 += (f32x4){bflo(x[0]), bfhi(x[0]), bflo(x[1]), bfhi(x[1])} * w0[j];
                acc1 += (f32x4){bflo(x[2]), bfhi(x[2]), bflo(x[3]), bfhi(x[3])} * w1[j]; }
            float y[8];
#pragma unroll
            for (int i = 0; i < 4; ++i) { y[i] = siluf(acc0[i]); y[4 + i] = siluf(acc1[i]); }
            if (sec < 2) {
                float ss = 0.f;
#pragma unroll
                for (int i = 0; i < 8; ++i) ss += y[i] * y[i];
                ss += __shfl_xor(ss, 1); ss += __shfl_xor(ss, 2); ss += __shfl_xor(ss, 4); ss += __shfl_xor(ss, 8);
                const float sc = rsqrtf(ss + EPS) * (sec == 0 ? 0.08838834764831845f : 1.f);
#pragma unroll
                for (int i = 0; i < 8; ++i) y[i] *= sc;
            }
            u32x4 o; o.x = pk2(y[0], y[1]); o.y = pk2(y[2], y[3]); o.z = pk2(y[4], y[5]); o.w = pk2(y[6], y[7]);
            *(u32x4*)(QP + (size_t)(seq_start + tb + r) * 3072 + col) = o;
        }
        if (sec == 0) {
#pragma unroll
            for (int q = 0; q < 2; ++q) {
                const int e = tid + q * 512, r = e >> 4, idx = e & 15, row = seq_start + t0 + r;
                const float bv = ba[(size_t)row * 32 + idx], av = ba[(size_t)row * 32 + 16 + idx];
                const float xs = av + a.in(11)[idx];
                const float sp = fmaxf(xs, 0.f) + log1pf(expf(-fabsf(xs)));
                const float g = -expf(a.in(10)[idx]) * sp;
                const int dir = idx >> 3, h = idx & 7;
                gb[((size_t)dir * MT + row) * 8 + h] = g;
                bb[((size_t)dir * MT + row) * 8 + h] = 1.f / (1.f + expf(-bv));
            }
        }
#pragma unroll
        for (int r = 0; r < 20; ++r) cur[r] = nxt[r];
    }
#undef PREP_LOAD
#undef PREP_GEOM
}

DEVI void phase_dnscan(const KA& a, int lane, int wave) {
    unsigned char* ws = a.ws();
    const bf16_t* QP = (const bf16_t*)(ws + WS_QKVP);
    const float* gb = (const float*)(ws + WS_G); const float* bb = (const float*)(ws + WS_BETA);
    bf16_t* Of = (bf16_t*)a.out(); bf16_t* Ob = Of + (size_t)ML * 1024;
    const int gw = blockIdx.x * 8 + wave, NGW = gridDim.x * 8;
    for (int item = gw; item < 2048; item += NGW) {
        const int chain = item >> 6, ep = item & 63, dir = chain >> 4, b = (chain >> 3) & 1, h = chain & 7;
        bf16_t* O = dir ? Ob : Of;
        float S00 = 0.f, S01 = 0.f, S10 = 0.f, S11 = 0.f;
        const int NTOK = CTX + SEQ;
        constexpr int U = 4;
        unsigned kq[U], qq[U], vv[U]; float gg[U], be[U]; int rows[U];
        auto rowof = [&](int s) -> int { if (s < CTX) { const int t = dir ? CTX - 1 - s : s; return ML + b * CTX + t; } const int t2 = s - CTX; const int t = dir ? SEQ - 1 - t2 : t2; return b * SEQ + t; };
#define SC_LOAD(i, s) do { const int row_ = rowof(s); rows[i] = row_; const bf16_t* p_ = QP + (size_t)row_ * 3072 + h * 128; \
        qq[i] = *(const unsigned*)(p_ + 2 * lane); kq[i] = *(const unsigned*)(p_ + 1024 + 2 * lane); vv[i] = *(const unsigned*)(p_ + 2048 + 2 * ep); \
        gg[i] = gb[((size_t)dir * MT + row_) * 8 + h]; be[i] = bb[((size_t)dir * MT + row_) * 8 + h]; } while (0)
        for (int s0 = 0; s0 < NTOK; s0 += U) {
#pragma unroll
            for (int i = 0; i < U; ++i) SC_LOAD(i, s0 + i);
#pragma unroll
            for (int i = 0; i < U; ++i) {
                const float k0 = bflo(kq[i]), k1 = bfhi(kq[i]), q0 = bflo(qq[i]), q1 = bfhi(qq[i]), v0 = bflo(vv[i]), v1 = bfhi(vv[i]);
                const float eg = __expf(gg[i]), bt = be[i];
                float p0 = k0 * S00 + k1 * S10, p1 = k0 * S01 + k1 * S11;
                p0 = wave_sum(p0); p1 = wave_sum(p1);
                const float vn0 = bt * (v0 - eg * p0), vn1 = bt * (v1 - eg * p1);
                S00 = eg * S00 + k0 * vn0; S01 = eg * S01 + k0 * vn1; S10 = eg * S10 + k1 * vn0; S11 = eg * S11 + k1 * vn1;
                float o0 = q0 * S00 + q1 * S10, o1 = q0 * S01 + q1 * S11;
                o0 = wave_sum(o0); o1 = wave_sum(o1);
                if (lane == 0 && rows[i] < ML) *(unsigned*)(O + (size_t)rows[i] * 1024 + h * 128 + 2 * ep) = pk2(o0, o1);
            }
        }
#undef SC_LOAD
    }
}

DEVI bf16x8 ld_b128(LAS const unsigned char* p) { return *(LAS const bf16x8*)p; }
DEVI bf16x8 ld_2b64(LAS const unsigned char* p0, LAS const unsigned char* p1) { const u32x2 a = *(LAS const u32x2*)p0, b = *(LAS const u32x2*)p1; u32x4 w = {a.x, a.y, b.x, b.y}; return __builtin_bit_cast(bf16x8, w); }
DEVI bf16x8 pack_frag(const f32x4& lo, const f32x4& hi) { u32x4 w = {pk2(lo[0], lo[1]), pk2(lo[2], lo[3]), pk2(hi[0], hi[1]), pk2(hi[2], hi[3])}; return __builtin_bit_cast(bf16x8, w); }
#define MFMA16(A, B, C) __builtin_amdgcn_mfma_f32_16x16x32_bf16(A, B, C, 0, 0, 0)
DEVI void phase_dnchunk(const KA& a, LAS unsigned char* lds, int tid, int lane, int wave) {
    unsigned char* ws = a.ws();
    const bf16_t* QP = (const bf16_t*)(ws + WS_QKVP); const float* gb = (const float*)(ws + WS_G); const float* bb = (const float*)(ws + WS_BETA);
    bf16_t* TQ = (bf16_t*)(ws + WS_TQ); float* AV = (float*)(ws + WS_AVEC);
    constexpr int KL = 0, QL = 17408, KKF = 34816, QKF = 52224, VEC = 131072;
    const int fr = lane & 15, g = lane >> 4, d = wave >> 2, wq = wave & 3;
    LAS unsigned char* dbase = lds + d * 64512;
    LAS float* Gg = (LAS float*)(lds + VEC); LAS float* Bv = Gg + 128; LAS float* GC = Gg + 256;
    for (int item = blockIdx.x; item < 520 * 8; item += gridDim.x) {
        const int cidx = item >> 3, h = item & 7;
        const int row0 = cidx < 512 ? cidx * 64 : ML + (cidx - 512) * 64;
#pragma unroll
        for (int i = 0; i < 2; ++i) { const int c = tid + i * 512, r = c >> 4, ch = c & 15;
            const bf16_t* src = QP + (size_t)(row0 + r) * 3072 + h * 128 + ch * 8;
            *(LAS u32x4*)(lds + QL + r * 272 + ch * 16) = *(const u32x4*)src; *(LAS u32x4*)(lds + KL + r * 272 + ch * 16) = *(const u32x4*)(src + 1024); }
        if (tid < 128) { const int dd = tid >> 6, pos = tid & 63; Gg[tid] = gb[((size_t)dd * MT + row0 + pos) * 8 + h]; Bv[tid] = bb[((size_t)dd * MT + row0 + pos) * 8 + h]; }
        __syncthreads();
        if (wave < 2) {
            const int dd = wave, pos = dd ? 63 - lane : lane; float x = Gg[dd * 64 + pos];
#pragma unroll
            for (int o = 1; o < 64; o <<= 1) { const float y = __shfl_up(x, o); if (lane >= o) x += y; }
            const float total = __shfl(x, 63);
            GC[dd * 64 + pos] = x;
            float* av = AV + ((size_t)item * 2 + dd) * 256;
            av[pos] = __expf(x); av[64 + pos] = Bv[dd * 64 + pos]; av[128 + pos] = __expf(total - x); if (lane == 0) av[192] = __expf(total);
        }
        {
            const int src = d ? QL : KL;
            f32x4 acc[4] = {{0.f, 0.f, 0.f, 0.f}, {0.f, 0.f, 0.f, 0.f}, {0.f, 0.f, 0.f, 0.f}, {0.f, 0.f, 0.f, 0.f}};
#pragma unroll
            for (int s4 = 0; s4 < 4; ++s4) { const bf16x8 A = ld_b128(lds + src + (16 * wq + fr) * 272 + (32 * s4 + 8 * g) * 2);
#pragma unroll
                for (int jt = 0; jt < 4; ++jt) { const bf16x8 Bf = ld_b128(lds + KL + (16 * jt + fr) * 272 + (32 * s4 + 8 * g) * 2); acc[jt] = MFMA16(A, Bf, acc[jt]); } }
            LAS float* dst = (LAS float*)(lds + (d ? QKF : KKF));
#pragma unroll
            for (int jt = 0; jt < 4; ++jt)
#pragma unroll
                for (int r = 0; r < 4; ++r) dst[(16 * wq + 4 * g + r) * 68 + 16 * jt + fr] = acc[jt][r];
        }
        __syncthreads();
        f32x4 P[4], qd[4];
        {
            const LAS float* kkf = (const LAS float*)(lds + KKF); const LAS float* qkf = (const LAS float*)(lds + QKF);
            float gci[4], bei[4];
#pragma unroll
            for (int r = 0; r < 4; ++r) { gci[r] = GC[d * 64 + 16 * wq + 4 * g + r]; bei[r] = Bv[d * 64 + 16 * wq + 4 * g + r]; }
#pragma unroll
            for (int jt = 0; jt < 4; ++jt) { const int j = 16 * jt + fr; const float gcj = GC[d * 64 + j];
#pragma unroll
                for (int r = 0; r < 4; ++r) { const int i = 16 * wq + 4 * g + r; const bool incl = d ? (i <= j) : (i >= j);
                    const float e = incl ? __expf(gci[r] - gcj) : 0.f;
                    qd[jt][r] = qkf[i * 68 + j] * e; P[jt][r] = (i != j) ? -bei[r] * kkf[i * 68 + j] * e : 0.f; } }
        }
        __syncthreads();
        {
#pragma unroll
            for (int jt = 0; jt < 4; ++jt) {
#pragma unroll
                for (int r = 0; r < 4; ++r) { const int i = 16 * wq + 4 * g + r, j = 16 * jt + fr;
                    *(LAS unsigned short*)(dbase + 0 + i * 144 + j * 2) = (unsigned short)f2bf(P[jt][r]);
                    *(LAS unsigned short*)(dbase + 36864 + 9216 + i * 144 + j * 2) = (unsigned short)f2bf(P[jt][r]);
                    *(LAS unsigned short*)(dbase + 55296 + i * 144 + j * 2) = (unsigned short)f2bf(qd[jt][r]); }
                u32x2 w = {pk2(P[jt][0], P[jt][1]), pk2(P[jt][2], P[jt][3])};
                *(LAS u32x2*)(dbase + 18432 + (16 * jt + fr) * 144 + (16 * wq + 4 * g) * 2) = w; }
        }
        __syncthreads();
        int cur = 0;
#pragma unroll 1
        for (int it = 0; it < 5; ++it) {
            LAS unsigned char* NRc = dbase + cur * 9216; LAS unsigned char* NTc = dbase + 18432 + cur * 9216;
            LAS unsigned char* NRn = dbase + (cur ^ 1) * 9216; LAS unsigned char* NTn = dbase + 18432 + (cur ^ 1) * 9216;
            LAS unsigned char* PRo = dbase + 36864 + ((it + 1) & 1) * 9216; LAS unsigned char* PRn = dbase + 36864 + (it & 1) * 9216;
            f32x4 n2[4] = {{0.f, 0.f, 0.f, 0.f}, {0.f, 0.f, 0.f, 0.f}, {0.f, 0.f, 0.f, 0.f}, {0.f, 0.f, 0.f, 0.f}};
#pragma unroll
            for (int s2 = 0; s2 < 2; ++s2) { const bf16x8 A = ld_b128(NRc + (16 * wq + fr) * 144 + (32 * s2 + 8 * g) * 2);
#pragma unroll
                for (int jt = 0; jt < 4; ++jt) { const bf16x8 Bf = ld_b128(NTc + (16 * jt + fr) * 144 + (32 * s2 + 8 * g) * 2); n2[jt] = MFMA16(A, Bf, n2[jt]); } }
#pragma unroll
            for (int jt = 0; jt < 4; ++jt) {
#pragma unroll
                for (int r = 0; r < 4; ++r) *(LAS unsigned short*)(NRn + (16 * wq + 4 * g + r) * 144 + (16 * jt + fr) * 2) = (unsigned short)f2bf(n2[jt][r]);
                u32x2 w = {pk2(n2[jt][0], n2[jt][1]), pk2(n2[jt][2], n2[jt][3])};
                *(LAS u32x2*)(NTn + (16 * jt + fr) * 144 + (16 * wq + 4 * g) * 2) = w;
                P[jt] += n2[jt]; }
            __syncthreads();
#pragma unroll
            for (int s2 = 0; s2 < 2; ++s2) { const bf16x8 A = ld_b128(PRo + (16 * wq + fr) * 144 + (32 * s2 + 8 * g) * 2);
#pragma unroll
                for (int jt = 0; jt < 4; ++jt) { const bf16x8 Bf = ld_b128(NTn + (16 * jt + fr) * 144 + (32 * s2 + 8 * g) * 2); P[jt] = MFMA16(A, Bf, P[jt]); } }
#pragma unroll
            for (int jt = 0; jt < 4; ++jt)
#pragma unroll
                for (int r = 0; r < 4; ++r) *(LAS unsigned short*)(PRn + (16 * wq + 4 * g + r) * 144 + (16 * jt + fr) * 2) = (unsigned short)f2bf(P[jt][r]);
            cur ^= 1;
        }
        __syncthreads();
        {
            bf16_t* dst = TQ + ((size_t)item * 2 + d) * 8192; const int t2 = tid & 255;
#pragma unroll
            for (int k = 0; k < 4; ++k) { const int c = t2 + 256 * k, mat = c >> 9, r = (c >> 3) & 63, ch = c & 7;
                const u32x4 v = *(LAS const u32x4*)(dbase + (mat ? 55296 : 36864) + r * 144 + ch * 16);
                *(u32x4*)(dst + mat * 4096 + r * 64 + ch * 8) = v; }
        }
        __syncthreads();
    }
}

DEVI void phase_dnchunk2(const KA& a, LAS unsigned char* lds, int tid, int lane, int wave) {
    unsigned char* ws = a.ws();
    const bf16_t* QP = (const bf16_t*)(ws + WS_QKVP); const float* gb = (const float*)(ws + WS_G); const float* bb = (const float*)(ws + WS_BETA);
    bf16_t* TQ = (bf16_t*)(ws + WS_TQ); float* AV = (float*)(ws + WS_AVEC);
    const int fr = lane & 15, g = lane >> 4, wi = wave >> 1, dir = wave & 1;
    LAS unsigned char* kl = lds + wi * 32768;
    LAS float* vec = (LAS float*)(lds + 131072 + wave * 1024);
    for (int grp = blockIdx.x; grp < 1040; grp += gridDim.x) {
        int tl = tid; asm volatile("" : "+v"(tl));
#pragma unroll
        for (int i = 0; i < 16; ++i) { const int c = tl + 512 * i, it = c >> 11, qk = (c >> 10) & 1, r = (c >> 4) & 63, ch = c & 15;
            const int item_ = grp * 4 + it, ci_ = item_ >> 3, h_ = item_ & 7; const int row0_ = ci_ < 512 ? ci_ * 64 : ML + (ci_ - 512) * 64;
            const u32x4 x = *(const u32x4*)(QP + (size_t)(row0_ + r) * 3072 + qk * 1024 + h_ * 128 + ch * 8);
            *(LAS u32x4*)(lds + it * 32768 + (qk ? 0 : 16384) + r * 256 + ((ch ^ (r & 15)) << 4)) = x; }
        const int item = grp * 4 + wi, cidx = item >> 3, h = item & 7;
        const int row0 = cidx < 512 ? cidx * 64 : ML + (cidx - 512) * 64;
        {
            const int pos = dir ? 63 - lane : lane;
            float x = gb[((size_t)dir * MT + row0 + pos) * 8 + h]; const float be = bb[((size_t)dir * MT + row0 + pos) * 8 + h];
#pragma unroll
            for (int o = 1; o < 64; o <<= 1) { const float y = __shfl_up(x, o); if (lane >= o) x += y; }
            const float total = __shfl(x, 63);
            vec[pos] = x; vec[64 + pos] = be;
            float* av = AV + ((size_t)item * 2 + dir) * 256;
            av[pos] = __expf(x); av[64 + pos] = be; av[128 + pos] = __expf(total - x); if (lane == 0) av[192] = __expf(total);
        }
        __syncthreads();
        bf16_t* tq = TQ + ((size_t)item * 2 + dir) * 8192;
        bf16x8 KF[4][4];
#pragma unroll
        for (int t = 0; t < 4; ++t)
#pragma unroll
            for (int ks = 0; ks < 4; ++ks) KF[t][ks] = ld_b128(kl + (16 * t + fr) * 256 + (((4 * ks + g) ^ fr) << 4));
        {
            bf16x8 QF[4][4];
#pragma unroll
            for (int t = 0; t < 4; ++t)
#pragma unroll
                for (int ks = 0; ks < 4; ++ks) QF[t][ks] = ld_b128(kl + 16384 + (16 * t + fr) * 256 + (((4 * ks + g) ^ fr) << 4));
#pragma unroll
            for (int rt = 0; rt < 4; ++rt)
#pragma unroll
                for (int ct = 0; ct < 4; ++ct) { f32x4 acc = {0.f, 0.f, 0.f, 0.f};
#pragma unroll
                    for (int ks = 0; ks < 4; ++ks) acc = MFMA16(KF[rt][ks], QF[ct][ks], acc);
                    float o[4]; const f32x4 gxv = *(const LAS f32x4*)(vec + 16 * rt + 4 * g); const float gyv = vec[16 * ct + fr];
#pragma unroll
                    for (int r = 0; r < 4; ++r) { const int x = 16 * rt + 4 * g + r, y = 16 * ct + fr; const bool inc = dir ? (y <= x) : (y >= x);
                        o[r] = inc ? acc[r] * __expf(gyv - gxv[r]) : 0.f; }
                    const u32x2 w = {pk2(o[0], o[1]), pk2(o[2], o[3])};
                    *(u32x2*)(tq + 4096 + (16 * ct + fr) * 64 + 16 * rt + 4 * g) = w; }
        }
        f32x4 PT[4][4]; bf16x8 XD[2][4], XT[2][4];
#pragma unroll
        for (int ct = 0; ct < 4; ++ct)
#pragma unroll
            for (int s2 = 0; s2 < 2; ++s2) { f32x4 nd[2], nt[2];
#pragma unroll
                for (int u = 0; u < 2; ++u) { const int rt = 2 * s2 + u; f32x4 acc = {0.f, 0.f, 0.f, 0.f};
#pragma unroll
                    for (int ks = 0; ks < 4; ++ks) acc = MFMA16(KF[rt][ks], KF[ct][ks], acc);
                    const f32x4 gxv = *(const LAS f32x4*)(vec + 16 * rt + 4 * g), bxv = *(const LAS f32x4*)(vec + 64 + 16 * rt + 4 * g); const float gyv = vec[16 * ct + fr], byv = vec[64 + 16 * ct + fr];
#pragma unroll
                    for (int r = 0; r < 4; ++r) { const int x = 16 * rt + 4 * g + r, y = 16 * ct + fr;
                        const bool cd = dir ? (x < y) : (x > y), ct_ = dir ? (y < x) : (y > x);
                        nd[u][r] = cd ? -bxv[r] * acc[r] * __expf(gxv[r] - gyv) : 0.f;
                        nt[u][r] = ct_ ? -byv * acc[r] * __expf(gyv - gxv[r]) : 0.f; }
                    PT[rt][ct] = nt[u]; }
                XD[s2][ct] = pack_frag(nd[0], nd[1]); XT[s2][ct] = pack_frag(nt[0], nt[1]); }
#pragma unroll 1
        for (int it = 0; it < 5; ++it) {
            bf16x8 XD2[2][4], XT2[2][4];
#pragma unroll
            for (int ct = 0; ct < 4; ++ct)
#pragma unroll
                for (int s2 = 0; s2 < 2; ++s2) { f32x4 t2[2];
#pragma unroll
                    for (int u = 0; u < 2; ++u) { const int rt = 2 * s2 + u; f32x4 acc = {0.f, 0.f, 0.f, 0.f};
                        acc = MFMA16(XT[0][rt], XD[0][ct], acc); acc = MFMA16(XT[1][rt], XD[1][ct], acc); t2[u] = acc; }
                    XD2[s2][ct] = pack_frag(t2[0], t2[1]); }
#pragma unroll
            for (int ct = 0; ct < 4; ++ct) { const bf16x8 pb0 = pack_frag(PT[0][ct], PT[1][ct]), pb1 = pack_frag(PT[2][ct], PT[3][ct]);
#pragma unroll
                for (int rt = 0; rt < 4; ++rt) { f32x4 acc = PT[rt][ct]; acc = MFMA16(XD2[0][rt], pb0, acc); acc = MFMA16(XD2[1][rt], pb1, acc); PT[rt][ct] = acc; } }
#pragma unroll
            for (int ct = 0; ct < 4; ++ct)
#pragma unroll
                for (int s2 = 0; s2 < 2; ++s2) { f32x4 t2[2];
#pragma unroll
                    for (int u = 0; u < 2; ++u) { const int rt = 2 * s2 + u; f32x4 acc = {0.f, 0.f, 0.f, 0.f};
                        acc = MFMA16(XD[0][rt], XT[0][ct], acc); acc = MFMA16(XD[1][rt], XT[1][ct], acc); t2[u] = acc; PT[rt][ct] += acc; }
                    XT2[s2][ct] = pack_frag(t2[0], t2[1]); }
#pragma unroll
            for (int s2 = 0; s2 < 2; ++s2)
#pragma unroll
                for (int ct = 0; ct < 4; ++ct) { XD[s2][ct] = XD2[s2][ct]; XT[s2][ct] = XT2[s2][ct]; }
        }
#pragma unroll
        for (int rt = 0; rt < 4; ++rt)
#pragma unroll
            for (int ct = 0; ct < 4; ++ct) { const u32x2 w = {pk2(PT[rt][ct][0], PT[rt][ct][1]), pk2(PT[rt][ct][2], PT[rt][ct][3])};
                *(u32x2*)(tq + (16 * ct + fr) * 64 + 16 * rt + 4 * g) = w; }
        __syncthreads();
    }
}

DEVI void st_wt8(bf16_t* p, unsigned lo, unsigned hi) { __hip_atomic_store((GAS unsigned long long*)p, (unsigned long long)lo | ((unsigned long long)hi << 32), __ATOMIC_RELAXED, __HIP_MEMORY_SCOPE_AGENT); }
DEVI void st_wt4(float* p, float v) { __hip_atomic_store((GAS unsigned*)p, __float_as_uint(v), __ATOMIC_RELAXED, __HIP_MEMORY_SCOPE_AGENT); }
DEVI void dnchunk_item(const KA& a, LAS float* vec, int cidx, int h, int dir, int lane_) {
    unsigned char* ws = a.ws();
    const bf16_t* QP = (const bf16_t*)(ws + WS_QKVP); const float* gb = (const float*)(ws + WS_G); const float* bb = (const float*)(ws + WS_BETA);
    bf16_t* TQ = (bf16_t*)(ws + WS_TQ); float* AV = (float*)(ws + WS_AVEC);
    int lane = lane_; asm volatile("" : "+v"(lane));
    const int fr = lane & 15, g = lane >> 4;
    const int item = cidx * 8 + h;
    const int row0 = cidx < 512 ? cidx * 64 : ML + (cidx - 512) * 64;
    const bf16_t* kb = QP + (size_t)(row0 + fr) * 3072 + 1024 + h * 128 + g * 8;
    bf16x8 KF[4][4];
#pragma unroll
    for (int t = 0; t < 4; ++t)
#pragma unroll
        for (int ks = 0; ks < 4; ++ks) KF[t][ks] = *(const bf16x8*)(kb + (size_t)t * 16 * 3072 + ks * 32);
    {
        const int pos = dir ? 63 - lane : lane;
        float x = gb[((size_t)dir * MT + row0 + pos) * 8 + h]; const float be = bb[((size_t)dir * MT + row0 + pos) * 8 + h];
#pragma unroll
        for (int o = 1; o < 64; o <<= 1) { const float y = __shfl_up(x, o); if (lane >= o) x += y; }
        const float total = __shfl(x, 63);
        vec[pos] = x; vec[64 + pos] = be;
        float* av = AV + ((size_t)item * 2 + dir) * 256;
        st_wt4(av + pos, __expf(x)); st_wt4(av + 64 + pos, be); st_wt4(av + 128 + pos, __expf(total - x)); if (lane == 0) st_wt4(av + 192, __expf(total));
    }
    asm volatile("s_waitcnt lgkmcnt(0)" ::: "memory");
    bf16_t* tq = TQ + ((size_t)item * 2 + dir) * 8192;
    {
        bf16x8 QF[4][4];
#pragma unroll
        for (int t = 0; t < 4; ++t)
#pragma unroll
            for (int ks = 0; ks < 4; ++ks) QF[t][ks] = *(const bf16x8*)(kb - 1024 + (size_t)t * 16 * 3072 + ks * 32);
#pragma unroll
        for (int rt = 0; rt < 4; ++rt)
#pragma unroll
            for (int ct = 0; ct < 4; ++ct) { f32x4 acc = {0.f, 0.f, 0.f, 0.f};
#pragma unroll
                for (int ks = 0; ks < 4; ++ks) acc = MFMA16(KF[rt][ks], QF[ct][ks], acc);
                float o[4]; const f32x4 gxv = *(const LAS f32x4*)(vec + 16 * rt + 4 * g); const float gyv = vec[16 * ct + fr];
#pragma unroll
                for (int r = 0; r < 4; ++r) { const int x = 16 * rt + 4 * g + r, y = 16 * ct + fr; const bool inc = dir ? (y <= x) : (y >= x);
                    o[r] = inc ? acc[r] * __expf(gyv - gxv[r]) : 0.f; }
                st_wt8(tq + 4096 + (16 * ct + fr) * 64 + 16 * rt + 4 * g, pk2(o[0], o[1]), pk2(o[2], o[3])); }
    }
    f32x4 PT[4][4]; bf16x8 XD[2][4], XT[2][4];
#pragma unroll
    for (int ct = 0; ct < 4; ++ct)
#pragma unroll
        for (int s2 = 0; s2 < 2; ++s2) { f32x4 nd[2], nt[2];
#pragma unroll
            for (int u = 0; u < 2; ++u) { const int rt = 2 * s2 + u; f32x4 acc = {0.f, 0.f, 0.f, 0.f};
#pragma unroll
                for (int ks = 0; ks < 4; ++ks) acc = MFMA16(KF[rt][ks], KF[ct][ks], acc);
                const f32x4 gxv = *(const LAS f32x4*)(vec + 16 * rt + 4 * g), bxv = *(const LAS f32x4*)(vec + 64 + 16 * rt + 4 * g); const float gyv = vec[16 * ct + fr], byv = vec[64 + 16 * ct + fr];
#pragma unroll
                for (int r = 0; r < 4; ++r) { const int x = 16 * rt + 4 * g + r, y = 16 * ct + fr;
                    const bool cd = dir ? (x < y) : (x > y), ct_ = dir ? (y < x) : (y > x);
                    nd[u][r] = cd ? -bxv[r] * acc[r] * __expf(gxv[r] - gyv) : 0.f;
                    nt[u][r] = ct_ ? -byv * acc[r] * __expf(gyv - gxv[r]) : 0.f; }
                PT[rt][ct] = nt[u]; }
            XD[s2][ct] = pack_frag(nd[0], nd[1]); XT[s2][ct] = pack_frag(nt[0], nt[1]); }
#pragma unroll 1
    for (int it = 0; it < 5; ++it) {
        bf16x8 XD2[2][4], XT2[2][4];
#pragma unroll
        for (int ct = 0; ct < 4; ++ct)
#pragma unroll
            for (int s2 = 0; s2 < 2; ++s2) { f32x4 t2[2];
#pragma unroll
                for (int u = 0; u < 2; ++u) { const int rt = 2 * s2 + u; f32x4 acc = {0.f, 0.f, 0.f, 0.f};
                    acc = MFMA16(XT[0][rt], XD[0][ct], acc); acc = MFMA16(XT[1][rt], XD[1][ct], acc); t2[u] = acc; }
                XD2[s2][ct] = pack_frag(t2[0], t2[1]); }
#pragma unroll
        for (int ct = 0; ct < 4; ++ct) { const bf16x8 pb0 = pack_frag(PT[0][ct], PT[1][ct]), pb1 = pack_frag(PT[2][ct], PT[3][ct]);
#pragma unroll
            for (int rt = 0; rt < 4; ++rt) { f32x4 acc = PT[rt][ct]; acc = MFMA16(XD2[0][rt], pb0, acc); acc = MFMA16(XD2[1][rt], pb1, acc); PT[rt][ct] = acc; } }
#pragma unroll
        for (int ct = 0; ct < 4; ++ct)
#pragma unroll
            for (int s2 = 0; s2 < 2; ++s2) { f32x4 t2[2];
#pragma unroll
                for (int u = 0; u < 2; ++u) { const int rt = 2 * s2 + u; f32x4 acc = {0.f, 0.f, 0.f, 0.f};
                    acc = MFMA16(XD[0][rt], XT[0][ct], acc); acc = MFMA16(XD[1][rt], XT[1][ct], acc); t2[u] = acc; PT[rt][ct] += acc; }
                XT2[s2][ct] = pack_frag(t2[0], t2[1]); }
#pragma unroll
        for (int s2 = 0; s2 < 2; ++s2)
#pragma unroll
            for (int ct = 0; ct < 4; ++ct) { XD[s2][ct] = XD2[s2][ct]; XT[s2][ct] = XT2[s2][ct]; }
    }
#pragma unroll
    for (int rt = 0; rt < 4; ++rt)
#pragma unroll
        for (int ct = 0; ct < 4; ++ct) st_wt8(tq + (16 * ct + fr) * 64 + 16 * rt + 4 * g, pk2(PT[rt][ct][0], PT[rt][ct][1]), pk2(PT[rt][ct][2], PT[rt][ct][3]));
    asm volatile("s_waitcnt vmcnt(0)" ::: "memory");
}

DEVI void phase_dnscan2(const KA& a, LAS unsigned char* lds, int tid, int lane, int wave, unsigned long long& pr_extra) {
    const int v = blockIdx.x;
    unsigned char* ws = a.ws();
    const bf16_t* QP = (const bf16_t*)(ws + WS_QKVP); const bf16_t* TQ = (const bf16_t*)(ws + WS_TQ); const float* AV = (const float*)(ws + WS_AVEC);
    constexpr int NSTEP = 260;
    int vrole = v;
#if MK_ONE_LAUNCH
    {
        unsigned* bar_ = (unsigned*)(ws + WS_CTL); unsigned* xr_ = (unsigned*)(ws + CTL_XRANK);
        bool dyn = gridDim.x == 256;
#pragma unroll
        for (int j = 0; j < 16; ++j) { const unsigned c_ = __hip_atomic_load(&bar_[256 + 64 * j], __ATOMIC_RELAXED, __HIP_MEMORY_SCOPE_AGENT); dyn = dyn && (c_ == (j < 8 ? 32u : 0u)); }
        if (PROBE_SUB == 7 && !dyn) pr_extra += 50000ull;
        if (dyn) {
            const unsigned xcc = (unsigned)__builtin_amdgcn_s_getreg((3 << 11) | 20) & 0xFu;
            LAS unsigned* bw = (LAS unsigned*)(lds + 147200);
            if (tid == 0) *bw = __hip_atomic_fetch_add(&xr_[xcc * 64], 1u, __ATOMIC_RELAXED, __HIP_MEMORY_SCOPE_AGENT);
            __syncthreads();
            const unsigned rank = *bw & 31u;
            vrole = rank < 16u ? (int)(xcc + 8u * (rank >> 2) + 32u * (rank & 3u)) : (int)(128u + xcc + 8u * ((rank - 16u) >> 2) + 32u * ((rank - 16u) & 3u));
            __syncthreads();
        }
    }
#endif
    GAS unsigned* rdy = (GAS unsigned*)(ws + CTL_RDY);
    {
        LAS float* vec = (LAS float*)(lds + 131072 + wave * 1024);
        const int npw = ((int)gridDim.x - 128) * 8;
        int it = vrole < 128 ? vrole * 8 + wave : 1024 + (vrole - 128) * 8 + wave;
        const unsigned long long tp0_ = (PROBE_SUB >= 8) ? __builtin_amdgcn_s_memrealtime() : 0ull;
#pragma unroll 1
        while (it < NSTEP * 32) {
            const int s_ = it >> 5, ch_ = it & 31, dir_ = ch_ >> 4, b_ = (ch_ >> 3) & 1, h_ = ch_ & 7;
            int cidx_; if (s_ < 4) cidx_ = 512 + b_ * 4 + (dir_ ? 3 - s_ : s_); else { const int c_ = s_ - 4; cidx_ = b_ * 256 + (dir_ ? 255 - c_ : c_); }
            dnchunk_item(a, vec, cidx_, h_, dir_, lane);
            if (lane == 0) __hip_atomic_store(rdy + ch_ * 264 + s_, 1u, __ATOMIC_RELAXED, __HIP_MEMORY_SCOPE_AGENT);
            if (vrole < 128) break;
            it += npw;
        }
        if (PROBE_SUB >= 8 && lane == 0) atomicMax((unsigned*)(ws + CTL_DBG) + (vrole < 128 ? 0 : 1), (unsigned)(__builtin_amdgcn_s_memrealtime() - tp0_));
        __syncthreads();
    }
    if (vrole < 128) {
    const int chain = (vrole & 7) + 8 * ((vrole >> 3) & 3), qt = vrole >> 5, dir = chain >> 4, b = (chain >> 3) & 1, h = chain & 7;
    bf16_t* O = (bf16_t*)a.out() + (size_t)dir * ML * 1024;
    const __amdgpu_buffer_rsrc_t hrs = __builtin_amdgcn_make_buffer_rsrc((void*)(ws + WS_TQ), (short)0, (int)(WS_AVEC + 16 * MiB - WS_TQ), 0x00020000);
    GAS unsigned* myrdy = rdy + chain * 264;
    constexpr int KL = 0, QL = 16384, TL = 32768, DL = 40960, VL = 49152, AL = 53248, BUFB = 54272, OT = 2 * BUFB, SBX = OT + 8192, XBX = SBX + 16384, FLG = XBX + 4096;
    const int fr0 = lane & 15, g0 = lane >> 4, ltid = tid - 256;
    auto step_cidx = [&](int s) -> int { if (s < 4) return 512 + b * 4 + (dir ? 3 - s : s); const int c = s - 4; return b * 256 + (dir ? 255 - c : c); };
    struct LSet { u32x4 q[4], k[4], t[2], d[2], v, av; };
#define LD_ISSUE(R, s_) do { const int cidx_ = step_cidx(s_); const int row0_ = cidx_ < 512 ? cidx_ * 64 : ML + (cidx_ - 512) * 64; \
        const unsigned tqo_ = (unsigned)((cidx_ * 8 + h) * 2 + dir) * 16384u, avo_ = (unsigned)(WS_AVEC - WS_TQ) + (unsigned)((cidx_ * 8 + h) * 2 + dir) * 1024u; \
        int lt_ = ltid; asm volatile("" : "+v"(lt_)); \
        const bf16_t* pq_ = QP + (size_t)(row0_ + (lt_ >> 4)) * 3072 + h * 128 + (lt_ & 15) * 8; \
        const unsigned pt_ = tqo_ + (unsigned)((lt_ >> 3) * 64 + (lt_ & 7) * 8) * 2u; \
        _Pragma("unroll") for (int i = 0; i < 4; ++i) { R.q[i] = *(const u32x4*)(pq_ + (size_t)i * 16 * 3072); R.k[i] = *(const u32x4*)(pq_ + (size_t)i * 16 * 3072 + 1024); } \
        _Pragma("unroll") for (int i = 0; i < 2; ++i) { R.t[i] = __builtin_bit_cast(u32x4, __builtin_amdgcn_raw_buffer_load_b128(hrs, (int)(pt_ + i * 4096), 0, 16)); \
                                                        R.d[i] = __builtin_bit_cast(u32x4, __builtin_amdgcn_raw_buffer_load_b128(hrs, (int)(pt_ + 8192 + i * 4096), 0, 16)); } \
        R.v = *(const u32x4*)(QP + (size_t)(row0_ + (lt_ >> 2)) * 3072 + 2048 + h * 128 + qt * 32 + (lt_ & 3) * 8); \
        R.av = __builtin_bit_cast(u32x4, __builtin_amdgcn_raw_buffer_load_b128(hrs, (int)(avo_ + (unsigned)(lt_ & 63) * 16u), 0, 16)); } while (0)
#define RDY_POLL(s_) (((s_) < NSTEP) ? __hip_atomic_load(myrdy + (s_), __ATOMIC_RELAXED, __HIP_MEMORY_SCOPE_AGENT) : 1u)
#define RDY_WAIT(pf_, s_) do { if ((s_) < NSTEP && __builtin_amdgcn_readfirstlane((int)(pf_)) == 0) { unsigned sp_ = 0; const unsigned long long tq0_ = (PROBE_SUB >= 8) ? __builtin_amdgcn_s_memrealtime() : 0ull; \
        while (__builtin_amdgcn_readfirstlane((int)__hip_atomic_load(myrdy + (s_), __ATOMIC_RELAXED, __HIP_MEMORY_SCOPE_AGENT)) == 0) { __builtin_amdgcn_s_sleep(2); if (++sp_ > (1u << 22)) break; } \
        if (PROBE_SUB >= 8) { const unsigned dt_ = (unsigned)(__builtin_amdgcn_s_memrealtime() - tq0_); if ((s_) >= 4) spin_acc += dt_; else spin_first += dt_; } } \
        asm volatile("" ::: "memory"); } while (0)
#define LD_WRITE(R, bo_) do { int lt_ = ltid; asm volatile("" : "+v"(lt_)); LAS unsigned char* B_ = lds + (bo_); \
        const int chq_ = lt_ & 15, cht_ = lt_ & 7; \
        _Pragma("unroll") for (int i = 0; i < 4; ++i) { const int r = (lt_ >> 4) + 16 * i; const int o_ = r * 256 + ((chq_ ^ (4 * (r & 3) + ((r >> 3) & 3))) << 4); \
            *(LAS u32x4*)(B_ + QL + o_) = R.q[i]; *(LAS u32x4*)(B_ + KL + o_) = R.k[i]; } \
        _Pragma("unroll") for (int i = 0; i < 2; ++i) { const int r = (lt_ >> 3) + 32 * i; const int o_ = r * 128 + ((cht_ ^ (2 * ((r >> 3) & 3) + ((r >> 1) & 1))) << 4); \
            *(LAS u32x4*)(B_ + TL + o_) = R.t[i]; *(LAS u32x4*)(B_ + DL + o_) = R.d[i]; } \
        { const int r = lt_ >> 2; *(LAS u32x4*)(B_ + VL + r * 64 + (((lt_ & 3) ^ (2 * ((r >> 3) & 1))) << 4)) = R.v; } \
        if (lt_ < 64) *(LAS u32x4*)(B_ + AL + lt_ * 16) = R.av; } while (0)
#define OT_OUT(s_) do { const int cidx_ = step_cidx(s_); const int row0_ = cidx_ * 64; LAS const unsigned char* ot_ = lds + OT + ((s_) & 1) * 4096; \
        int lt_ = ltid; asm volatile("" : "+v"(lt_)); \
        { const int r = lt_ >> 2, ch = lt_ & 3; \
            *(u32x4*)(O + (size_t)(row0_ + r) * 1024 + h * 128 + qt * 32 + ch * 8) = *(LAS const u32x4*)(ot_ + r * 64 + ((ch ^ (2 * ((r >> 3) & 1))) << 4)); } } while (0)
#define STEP_BAR(wsel) do { const unsigned long long tb_ = PROBE_SUB ? __builtin_amdgcn_s_memrealtime() : 0ull; \
        asm volatile("s_waitcnt lgkmcnt(0)" ::: "memory"); __builtin_amdgcn_s_barrier(); asm volatile("" ::: "memory"); \
        if ((PROBE_SUB == 1 && wave == 0 && (wsel) == 0) || (PROBE_SUB == 2 && wave == 4 && (wsel) == 1) || (PROBE_SUB == 3 && wave == 2 && (wsel) == 3)) pr_extra += __builtin_amdgcn_s_memrealtime() - tb_; } while (0)
#define LOAD_STEP(s, RW, PU, PI) do { STEP_BAR(1); \
            { const unsigned long long tw_ = (PROBE_SUB == 5) ? __builtin_amdgcn_s_memrealtime() : 0ull; if ((s) + 1 < NSTEP) LD_WRITE(RW, (((s) + 1) & 1) * BUFB); \
              if (PROBE_SUB == 5 && wave == 4) { asm volatile("s_waitcnt lgkmcnt(0)" ::: "memory"); pr_extra += __builtin_amdgcn_s_memrealtime() - tw_; } } \
            PI = RDY_POLL((s) + 6); \
            if ((s) + 4 < NSTEP) { RDY_WAIT(PU, (s) + 4); LD_ISSUE(RW, (s) + 4); } \
            if ((s) >= 5) OT_OUT((s) - 1); } while (0)
#define LOAD_STEP_U(s, RW, PU, PI) do { STEP_BAR(1); \
            LD_WRITE(RW, (((s) + 1) & 1) * BUFB); \
            PI = __hip_atomic_load(myrdy + (s) + 6, __ATOMIC_RELAXED, __HIP_MEMORY_SCOPE_AGENT); \
            RDY_WAIT(PU, (s) + 4); LD_ISSUE(RW, (s) + 4); \
            OT_OUT((s) - 1); } while (0)
#define SBAR_() do {} while (0)
#define ROWK(pt) ((32 * ((pt) >> 1) + 4 * ((pt) & 1) + rowl) * 256)
#define ROWT(pt) ((32 * ((pt) >> 1) + 4 * ((pt) & 1) + rowl) * 128)
#define P0(pt) (32 * ((pt) >> 1) + 8 * g + 4 * ((pt) & 1))
#define LDK8(dst, base, pa) do { _Pragma("unroll") for (int s4 = 0; s4 < 4; ++s4) { dst[s4] = ld_b128(B + (base) + ROWK(pa) + (((4 * s4 + g) ^ fk) << 4)); dst[4 + s4] = ld_b128(B + (base) + ROWK((pa) + 1) + (((4 * s4 + g) ^ fk) << 4)); } } while (0)
#define LDT8(dst, base) do { _Pragma("unroll") for (int pt = 0; pt < 4; ++pt) { dst[2 * pt] = ld_b128(B + (base) + ROWT(pt) + ((g ^ ft) << 4)); dst[2 * pt + 1] = ld_b128(B + (base) + ROWT(pt) + (((4 + g) ^ ft) << 4)); } } while (0)
#define MM8(acc, fa, pa) do { _Pragma("unroll") for (int s4 = 0; s4 < 4; ++s4) { acc[pa] = MFMA16(fa[s4], Sb[s4], acc[pa]); acc[(pa) + 1] = MFMA16(fa[4 + s4], Sb[s4], acc[(pa) + 1]); } } while (0)
    if (wave >= 4) {
        LSet R0, R1, R2;
        unsigned pf0, pf1, pf2; unsigned spin_acc = 0, spin_first = 0; const unsigned long long tl0_ = (PROBE_SUB >= 8) ? __builtin_amdgcn_s_memrealtime() : 0ull;
        RDY_WAIT(0u, 0); LD_ISSUE(R0, 0); LD_WRITE(R0, 0); RDY_WAIT(0u, 1); LD_ISSUE(R1, 1); RDY_WAIT(0u, 2); LD_ISSUE(R2, 2); RDY_WAIT(0u, 3); LD_ISSUE(R0, 3);
        pf0 = RDY_POLL(4); pf1 = RDY_POLL(5); pf2 = 0u;
        LOAD_STEP(0, R1, pf0, pf2); LOAD_STEP(1, R2, pf1, pf0); LOAD_STEP(2, R0, pf2, pf1); LOAD_STEP(3, R1, pf0, pf2); LOAD_STEP(4, R2, pf1, pf0); LOAD_STEP(5, R0, pf2, pf1); LOAD_STEP(6, R1, pf0, pf2);
#pragma unroll 1
        for (int s0 = 7; s0 < NSTEP - 4; s0 += 3) {
            LOAD_STEP_U(s0, R2, pf1, pf0);
            LOAD_STEP_U(s0 + 1, R0, pf2, pf1);
            LOAD_STEP_U(s0 + 2, R1, pf0, pf2);
        }
        LOAD_STEP(NSTEP - 4, R2, pf1, pf0); LOAD_STEP(NSTEP - 3, R0, pf2, pf1); LOAD_STEP(NSTEP - 2, R1, pf0, pf2); LOAD_STEP(NSTEP - 1, R2, pf1, pf0);
        STEP_BAR(2);
        OT_OUT(NSTEP - 1);
        if (PROBE_SUB >= 8 && wave == 4 && lane == 0) { unsigned* dbg_ = (unsigned*)(ws + CTL_DBG); atomicMax(dbg_ + 2, spin_first); atomicMax(dbg_ + 3, spin_acc); atomicMax(dbg_ + 4, (unsigned)(__builtin_amdgcn_s_memrealtime() - tl0_)); }
    } else if (wave < 2) {
        __builtin_amdgcn_s_setprio(3);
        f32x4 S[8];
#pragma unroll
        for (int i = 0; i < 8; ++i) S[i] = (f32x4){0.f, 0.f, 0.f, 0.f};
        bf16x8 Sb[4];
#pragma unroll
        for (int s4 = 0; s4 < 4; ++s4) { Sb[s4] = (bf16x8){0, 0, 0, 0, 0, 0, 0, 0}; *(LAS bf16x8*)(lds + SBX + wave * 4096 + s4 * 1024 + lane * 16) = Sb[s4]; }
        if (lane == 0) *(LAS unsigned*)(lds + FLG + wave * 4) = 0u;
#pragma unroll 1
        for (int s = 0; s < NSTEP; ++s) {
            STEP_BAR(0);
            int fr = fr0, g = g0; asm volatile("" : "+v"(fr), "+v"(g));
            LAS const unsigned char* B = lds + (s & 1) * BUFB;
            const LAS float* avl = (const LAS float*)(B + AL);
            const int rowl = 8 * (fr >> 2) + (fr & 3);
            const int fk = 4 * (fr & 3) + (fr >> 2), ft = 2 * (fr >> 2) + ((fr >> 1) & 1);
            const int vcol = ((((2 * wave + (fr >> 3)) ^ (2 * (g & 1))) << 4) + (fr & 7) * 2);
            const int trq = fr >> 2, trp = fr & 3;
            LAS unsigned char* kp0 = (LAS unsigned char*)(B + KL + (8 * g + trq) * 256);
            const int fkt = 4 * trq + g;
#define KT_LOAD(dst, d0) do { _Pragma("unroll") for (int j = 0; j < 4; ++j) { const int dt_ = (d0) + j; const int co = (((4 * (dt_ >> 1) + trp) ^ fkt) << 4) + 8 * (dt_ & 1); \
                const s16x4 a0 = __builtin_bit_cast(s16x4, __builtin_amdgcn_ds_read_tr16_b64_v4i16((LAS s16x4*)(kp0 + co))), a1 = __builtin_bit_cast(s16x4, __builtin_amdgcn_ds_read_tr16_b64_v4i16((LAS s16x4*)(kp0 + co + 4 * 256))); \
                const s16x4 a2 = __builtin_bit_cast(s16x4, __builtin_amdgcn_ds_read_tr16_b64_v4i16((LAS s16x4*)(kp0 + co + 32 * 256))), a3 = __builtin_bit_cast(s16x4, __builtin_amdgcn_ds_read_tr16_b64_v4i16((LAS s16x4*)(kp0 + co + 36 * 256))); \
                dst[2 * j] = (bf16x8){a0[0], a0[1], a0[2], a0[3], a1[0], a1[1], a1[2], a1[3]}; dst[2 * j + 1] = (bf16x8){a2[0], a2[1], a2[2], a2[3], a3[0], a3[1], a3[2], a3[3]}; } } while (0)
            bf16x8 fA[8], fB[8], fC[8];
            f32x4 avp[4], bvp[4]; unsigned short vraw[4][4];
            const unsigned long long t6_ = (PROBE_SUB == 6) ? __builtin_amdgcn_s_memrealtime() : 0ull;
            LDK8(fA, KL, 0); LDK8(fB, KL, 2);
            if (PROBE_SUB == 6 && wave == 0) { asm volatile("s_waitcnt lgkmcnt(0)" ::: "memory"); pr_extra += __builtin_amdgcn_s_memrealtime() - t6_; }
#pragma unroll
            for (int pt = 0; pt < 4; ++pt) { avp[pt] = *(const LAS f32x4*)(avl + P0(pt)); bvp[pt] = *(const LAS f32x4*)(avl + 64 + P0(pt));
#pragma unroll
                for (int r = 0; r < 4; ++r) vraw[pt][r] = *(const LAS unsigned short*)(B + VL + (P0(pt) + r) * 64 + vcol); }
            f32x4 Z[4], X[4];
#pragma unroll
            for (int pt = 0; pt < 4; ++pt) Z[pt] = (f32x4){0.f, 0.f, 0.f, 0.f};
            SBAR_();
            LDT8(fC, TL); SBAR_(); MM8(Z, fA, 0); SBAR_();
            KT_LOAD(fA, 0); SBAR_(); MM8(Z, fB, 2); SBAR_();
#pragma unroll
            for (int pt = 0; pt < 4; ++pt)
#pragma unroll
                for (int r = 0; r < 4; ++r) Z[pt][r] = bvp[pt][r] * (bf2f(vraw[pt][r]) - avp[pt][r] * Z[pt][r]);
            KT_LOAD(fB, 4); SBAR_();
            { const bf16x8 Zb0 = pack_frag(Z[0], Z[1]), Zb1 = pack_frag(Z[2], Z[3]);
#pragma unroll
              for (int pt = 0; pt < 4; ++pt) { X[pt] = MFMA16(fC[2 * pt], Zb0, Z[pt]); X[pt] = MFMA16(fC[2 * pt + 1], Zb1, X[pt]); } }
            SBAR_();
            const float egl = avl[192];
            bf16x8 Xc0, Xc1;
            { const bf16x8 Xb0 = pack_frag(X[0], X[1]), Xb1 = pack_frag(X[2], X[3]);
              *(LAS bf16x8*)(lds + XBX + wave * 2048 + lane * 16) = Xb0; *(LAS bf16x8*)(lds + XBX + wave * 2048 + 1024 + lane * 16) = Xb1;
              if (lane == 0) *(LAS volatile unsigned*)(lds + FLG + wave * 4) = (unsigned)(s + 1);
              f32x4 cx[4];
#pragma unroll
              for (int pt = 0; pt < 4; ++pt) cx[pt] = X[pt] * *(const LAS f32x4*)(avl + 128 + P0(pt));
              Xc0 = pack_frag(cx[0], cx[1]); Xc1 = pack_frag(cx[2], cx[3]); }
            SBAR_();
#pragma unroll
            for (int j = 0; j < 4; ++j) { f32x4 sn = S[j] * egl; sn = MFMA16(fA[2 * j], Xc0, sn); S[j] = MFMA16(fA[2 * j + 1], Xc1, sn); }
            SBAR_();
#pragma unroll
            for (int j = 0; j < 4; ++j) { f32x4 sn = S[4 + j] * egl; sn = MFMA16(fB[2 * j], Xc0, sn); S[4 + j] = MFMA16(fB[2 * j + 1], Xc1, sn); }
#pragma unroll
            for (int s4 = 0; s4 < 4; ++s4) { Sb[s4] = pack_frag(S[2 * s4], S[2 * s4 + 1]); *(LAS bf16x8*)(lds + SBX + ((s + 1) & 1) * 8192 + wave * 4096 + s4 * 1024 + lane * 16) = Sb[s4]; }
#undef KT_LOAD
        }
        STEP_BAR(2);
        __builtin_amdgcn_s_setprio(0);
    } else {
        const int sl = wave - 2;
#pragma unroll 1
        for (int s = 0; s < NSTEP; ++s) {
            STEP_BAR(3);
            if (s >= 4) {
            int fr = fr0, g = g0; asm volatile("" : "+v"(fr), "+v"(g));
            LAS const unsigned char* B = lds + (s & 1) * BUFB;
            const LAS float* avl = (const LAS float*)(B + AL);
            const int rowl = 8 * (fr >> 2) + (fr & 3);
            const int fk = 4 * (fr & 3) + (fr >> 2), ft = 2 * (fr >> 2) + ((fr >> 1) & 1);
            const int vcol = ((((2 * sl + (fr >> 3)) ^ (2 * (g & 1))) << 4) + (fr & 7) * 2);
            bf16x8 fA[8], fB[8], fC[8], Sb[4];
            LDK8(fA, QL, 0); LDK8(fB, QL, 2);
#pragma unroll
            for (int s4 = 0; s4 < 4; ++s4) Sb[s4] = *(const LAS bf16x8*)(lds + SBX + (s & 1) * 8192 + sl * 4096 + s4 * 1024 + lane * 16);
            f32x4 OQ[4], avp[4];
#pragma unroll
            for (int pt = 0; pt < 4; ++pt) { OQ[pt] = (f32x4){0.f, 0.f, 0.f, 0.f}; avp[pt] = *(const LAS f32x4*)(avl + P0(pt)); }
            SBAR_();
            LDT8(fC, DL); SBAR_(); MM8(OQ, fA, 0); SBAR_(); MM8(OQ, fB, 2); SBAR_();
            { unsigned spins = 0;
              while ((unsigned)__builtin_amdgcn_readfirstlane((int)*(LAS volatile unsigned*)(lds + FLG + sl * 4)) != (unsigned)(s + 1)) { __builtin_amdgcn_s_sleep(1); if (++spins > (1u << 22)) break; } }
            asm volatile("" ::: "memory");
            const bf16x8 Xb0 = *(const LAS bf16x8*)(lds + XBX + sl * 2048 + lane * 16), Xb1 = *(const LAS bf16x8*)(lds + XBX + sl * 2048 + 1024 + lane * 16);
#pragma unroll
            for (int pt = 0; pt < 4; ++pt) { f32x4 o2 = OQ[pt] * avp[pt]; o2 = MFMA16(fC[2 * pt], Xb0, o2); OQ[pt] = MFMA16(fC[2 * pt + 1], Xb1, o2); }
            { LAS unsigned char* ot = lds + OT + (s & 1) * 4096;
#pragma unroll
              for (int pt = 0; pt < 4; ++pt)
#pragma unroll
                  for (int r = 0; r < 4; ++r) *(LAS unsigned short*)(ot + (P0(pt) + r) * 64 + vcol) = (unsigned short)f2bf(OQ[pt][r]); }
            }
        }
        STEP_BAR(2);
    }
#undef LDK8
#undef LDT8
#undef MM8
#undef ROWK
#undef ROWT
#undef P0
#undef SBAR_
#undef LOAD_STEP
#undef LOAD_STEP_U
#undef STEP_BAR
#undef LD_ISSUE
#undef RDY_POLL
#undef RDY_WAIT
#undef LD_WRITE
#undef OT_OUT
    }
}

DEVI void phase_prep2(const KA& a, int lane, int wave) {
    unsigned char* ws = a.ws();
    bf16_t* KAT = (bf16_t*)(ws + WS_KAT); const float* rope = (const float*)(ws + SM_ROPE); const float* knw = a.in(14);
    const int gw = blockIdx.x * 8 + wave, NGW = gridDim.x * 8;
    for (int row = gw; row < MT; row += NGW) {
        bf16_t* p = (row < ML ? KAT + (size_t)row * 256 : (bf16_t*)(ws + WS_CTXK) + (size_t)(row - ML) * 256) + lane * 4;
        const u32x2 w = *(const u32x2*)p;
        float x[4] = {bflo(w.x), bfhi(w.x), bflo(w.y), bfhi(w.y)};
        float ss = (x[0] * x[0] + x[1] * x[1]) + (x[2] * x[2] + x[3] * x[3]);
        ss += __shfl_xor(ss, 1); ss += __shfl_xor(ss, 2); ss += __shfl_xor(ss, 4); ss += __shfl_xor(ss, 8); ss += __shfl_xor(ss, 16);
        const float rs = rsqrtf(ss * (1.f / 128.f) + EPS);
        const int d = (lane & 31) * 4;
        const f32x4 nw = *(const f32x4*)(knw + d);
#pragma unroll
        for (int i = 0; i < 4; ++i) x[i] = x[i] * rs * nw[i];
        float pr[4];
#pragma unroll
        for (int i = 0; i < 4; ++i) pr[i] = __shfl_xor(x[i], 8);
        if (row < ML) {
            const int t = row & (SEQ - 1), lg = (lane & 31) >> 3, fi = (lane & 7) * 4;
            const float* ct = lg < 2 ? rope + (t >> 6) * 32 + fi : rope + 16384 + (t & 63) * 32 + fi;
            const float* st = lg < 2 ? ct + 8192 : ct + 2048;
            const f32x4 c = *(const f32x4*)ct, s = *(const f32x4*)st;
            const float sg = (lg & 1) ? 1.f : -1.f;
#pragma unroll
            for (int i = 0; i < 4; ++i) x[i] = x[i] * c[i] + sg * pr[i] * s[i];
        }
        u32x2 o; o.x = pk2(x[0], x[1]); o.y = pk2(x[2], x[3]);
        *(u32x2*)p = o;
    }
    const bf16_t* Of = (const bf16_t*)a.out(); const bf16_t* Ob = Of + (size_t)ML * 1024;
    const bf16_t* GT = (const bf16_t*)(ws + WS_GT); bf16_t* Y = (bf16_t*)(ws + WS_Y); const float* dnw = a.in(12);
    for (int row = gw; row < ML; row += NGW) {
        const int c0 = lane * 16;
        float o[16];
#pragma unroll
        for (int hh = 0; hh < 2; ++hh) {
            const u32x4 f = *(const u32x4*)(Of + (size_t)row * 1024 + c0 + hh * 8), bk = *(const u32x4*)(Ob + (size_t)row * 1024 + c0 + hh * 8);
#pragma unroll
            for (int i = 0; i < 4; ++i) { o[hh * 8 + 2 * i] = bflo(f[i]) + bflo(bk[i]); o[hh * 8 + 2 * i + 1] = bfhi(f[i]) + bfhi(bk[i]); }
        }
        float ss = 0.f;
#pragma unroll
        for (int i = 0; i < 16; ++i) ss += o[i] * o[i];
        ss += __shfl_xor(ss, 1); ss += __shfl_xor(ss, 2); ss += __shfl_xor(ss, 4);
        const float rs = rsqrtf(ss * (1.f / 128.f) + EPS);
        const int d0 = c0 & 127;
#pragma unroll
        for (int hh = 0; hh < 2; ++hh) {
            const u32x4 gt = *(const u32x4*)(GT + (size_t)row * 1024 + c0 + hh * 8);
            float y[8];
#pragma unroll
            for (int i = 0; i < 4; ++i) {
                y[2 * i] = o[hh * 8 + 2 * i] * rs * dnw[d0 + hh * 8 + 2 * i] * siluf(bflo(gt[i]));
                y[2 * i + 1] = o[hh * 8 + 2 * i + 1] * rs * dnw[d0 + hh * 8 + 2 * i + 1] * siluf(bfhi(gt[i]));
            }
            u32x4 w; w.x = pk2(y[0], y[1]); w.y = pk2(y[2], y[3]); w.z = pk2(y[4], y[5]); w.w = pk2(y[6], y[7]);
            *(u32x4*)(Y + (size_t)row * 2048 + c0 + hh * 8) = w;
        }
    }
}

namespace att {
constexpr int D = 128, NW = 8, QBLK = 32, KVBLK = 64;
constexpr float SCALE = 0.088388347648318440f;
constexpr float THR = 8.f;
constexpr int LDK = 256;
constexpr size_t SHM_V = KVBLK * D * 2, SHM_K = KVBLK * D * 2;
constexpr size_t OFF_WS = 2 * SHM_V + 2 * SHM_K, OFF_OST = OFF_WS + NW * 64 * 4;
#define KSWZ(row, colB) ((row) * 256 + ((colB) ^ (((row) & 7) << 4)))
#define SBAR() __builtin_amdgcn_sched_barrier(0)
DEVI int crow(int r, int hi) { return (r & 3) + 8 * (r >> 2) + 4 * hi; }
DEVI unsigned cvtpk(float lo, float hi) { unsigned r; asm volatile("v_cvt_pk_bf16_f32 %0, %1, %2" : "=v"(r) : "v"(lo), "v"(hi)); return r; }
DEVI void partialSM(f32x16& p0, f32x16& p1, float& m_reg, float& mn, float& alpha) {
    constexpr float C = SCALE * 1.4426950408889634f;
    float pmax = p0[0];
#pragma unroll
    for (int r = 1; r < 16; ++r) pmax = fmaxf(pmax, p0[r]);
#pragma unroll
    for (int r = 0; r < 16; ++r) pmax = fmaxf(pmax, p1[r]);
    { auto rr = __builtin_amdgcn_permlane32_swap(__float_as_uint(pmax), __float_as_uint(pmax), false, false);
      pmax = fmaxf(__uint_as_float(rr[0]), __uint_as_float(rr[1])); }
    if (__builtin_expect(__all(pmax - m_reg <= THR / SCALE), 1)) { mn = m_reg; alpha = 1.f; }
    else { mn = fmaxf(m_reg, pmax); alpha = __builtin_amdgcn_exp2f((m_reg - mn) * C); m_reg = mn; }
    const float mnC = -mn * C;
#pragma unroll
    for (int r = 0; r < 16; ++r) p0[r] = fmaf(p0[r], C, mnC);
#pragma unroll
    for (int r = 0; r < 16; ++r) p1[r] = fmaf(p1[r], C, mnC);
#pragma unroll
    for (int r = 0; r < 16; ++r) p0[r] = __builtin_amdgcn_exp2f(p0[r]);
}
DEVI void finishSM(f32x16& p0, f32x16& p1, float alpha, float& l_reg, bf16x8& pa0, bf16x8& pa1, bf16x8& pa2, bf16x8& pa3) {
#pragma unroll
    for (int r = 0; r < 16; ++r) p1[r] = __builtin_amdgcn_exp2f(p1[r]);
    float ps = 0;
#pragma unroll
    for (int r = 0; r < 16; ++r) ps += p0[r];
#pragma unroll
    for (int r = 0; r < 16; ++r) ps += p1[r];
    { auto rr = __builtin_amdgcn_permlane32_swap(__float_as_uint(ps), __float_as_uint(ps), false, false);
      ps = __uint_as_float(rr[0]) + __uint_as_float(rr[1]); }
    l_reg = l_reg * alpha + ps;
#define PK4(P, BASE, OUT) do { unsigned a0 = cvtpk(P[BASE + 0], P[BASE + 1]), a1 = cvtpk(P[BASE + 2], P[BASE + 3]);   \
    unsigned b0 = cvtpk(P[BASE + 4], P[BASE + 5]), b1 = cvtpk(P[BASE + 6], P[BASE + 7]);                              \
    auto r0 = __builtin_amdgcn_permlane32_swap(a0, b0, false, false); auto r1 = __builtin_amdgcn_permlane32_swap(a1, b1, false, false); \
    u32x4 w = {r0[0], r1[0], r0[1], r1[1]}; OUT = *reinterpret_cast<bf16x8*>(&w); } while (0)
    PK4(p0, 0, pa0); PK4(p0, 8, pa1); PK4(p1, 0, pa2); PK4(p1, 8, pa3);
#undef PK4
}
DEVI void qkt(f32x16& p0, f32x16& p1, const char* Ks, const bf16x8* qr, int r32, int hi) {
    p0 = f32x16{}; p1 = f32x16{};
#pragma unroll
    for (int d0 = 0; d0 < 8; ++d0) { const int cb = (d0 * 16 + hi * 8) * 2;
        const bf16x8 b0 = *reinterpret_cast<const bf16x8*>(Ks + KSWZ(r32, cb));
        const bf16x8 b1 = *reinterpret_cast<const bf16x8*>(Ks + KSWZ(32 + r32, cb));
        p0 = __builtin_amdgcn_mfma_f32_32x32x16_bf16(b0, qr[d0], p0, 0, 0, 0);
        p1 = __builtin_amdgcn_mfma_f32_32x32x16_bf16(b1, qr[d0], p1, 0, 0, 0); }
}
DEVI int v_st(int k, int c) { const int kk = (k & ~0xC) | ((k & 4) << 1) | ((k & 8) >> 1); return ((kk >> 3) * 4 + (c >> 5)) * 512 + ((kk & 7) * 32 + (c & 31)) * 2; }
DEVI int v_rd_base(int lane) { return ((lane & 3) << 3) | (((lane >> 2) & 3) << 6) | (((lane >> 4) & 1) << 5) | (((lane >> 5) & 1) << 8); }
constexpr int v_rd_off(int d0, int ks, int half) { return d0 * 512 + ks * 4096 + half * 2048; }
template <int OFF> DEVI s16x4 tr_read(int vb) { s16x4 r; asm volatile("ds_read_b64_tr_b16 %0, %1 offset:%2" : "=&v"(r) : "v"(vb), "i"(OFF) : "memory"); return r; }
template <int D0> DEVI void pv_one(f32x16& od, int vb, bf16x8 pa0, bf16x8 pa1, bf16x8 pa2, bf16x8 pa3) {
    const s16x4 l0 = tr_read<v_rd_off(D0, 0, 0)>(vb), h0 = tr_read<v_rd_off(D0, 0, 1)>(vb), l1 = tr_read<v_rd_off(D0, 1, 0)>(vb), h1 = tr_read<v_rd_off(D0, 1, 1)>(vb);
    const s16x4 l2 = tr_read<v_rd_off(D0, 2, 0)>(vb), h2 = tr_read<v_rd_off(D0, 2, 1)>(vb), l3 = tr_read<v_rd_off(D0, 3, 0)>(vb), h3 = tr_read<v_rd_off(D0, 3, 1)>(vb);
    asm volatile("s_waitcnt lgkmcnt(0)" ::: "memory"); SBAR();
#define PK(L, H) (bf16x8){L[0], L[1], L[2], L[3], H[0], H[1], H[2], H[3]}
    od = __builtin_amdgcn_mfma_f32_32x32x16_bf16(pa0, PK(l0, h0), od, 0, 0, 0);
    od = __builtin_amdgcn_mfma_f32_32x32x16_bf16(pa1, PK(l1, h1), od, 0, 0, 0);
    od = __builtin_amdgcn_mfma_f32_32x32x16_bf16(pa2, PK(l2, h2), od, 0, 0, 0);
    od = __builtin_amdgcn_mfma_f32_32x32x16_bf16(pa3, PK(l3, h3), od, 0, 0, 0);
#undef PK
}
DEVI void pv_d0(f32x16* o, int vb, bf16x8 pa0, bf16x8 pa1, bf16x8 pa2, bf16x8 pa3) {
    pv_one<0>(o[0], vb, pa0, pa1, pa2, pa3); pv_one<1>(o[1], vb, pa0, pa1, pa2, pa3); pv_one<2>(o[2], vb, pa0, pa1, pa2, pa3); pv_one<3>(o[3], vb, pa0, pa1, pa2, pa3);
}
DEVI void wmask(f32x16& p0, f32x16& p1, int qp, int kt0, int hi) {
#pragma unroll
    for (int r = 0; r < 16; ++r) { const int kp = kt0 + crow(r, hi); const int d0 = qp - kp, d1 = d0 - 32;
        if (d0 > 128 || d0 < -128) p0[r] = -1e30f; if (d1 > 128 || d1 < -128) p1[r] = -1e30f; }
}
DEVI void attn_unit(const KA& a, int b, int kvh, int tb, char* lds) {
    unsigned char* ws = a.ws();
    const bf16_t* QAT = (const bf16_t*)(ws + WS_QAT); const bf16_t* KAT = (const bf16_t*)(ws + WS_KAT); const bf16_t* VAT = (const bf16_t*)(ws + WS_VAT);
    bf16_t* Y = (bf16_t*)(ws + WS_Y); const float* rope = (const float*)(ws + SM_ROPE);
    const int tid = threadIdx.x, wid = __builtin_amdgcn_readfirstlane(tid >> 6), lane = tid & 63, r32 = lane & 31, hi = lane >> 5;
    const int h = kvh * 4 + (wid >> 1), t0 = tb * 64;
    char* V_lds = lds; char* K_lds = lds + 2 * SHM_V;
    float* wsf = (float*)(lds + OFF_WS) + wid * 64; float* li_l = wsf; float* al_l = wsf + 32;
    float m_reg = -1e30f, l_reg = 0; f32x16 o[4] = {}; bf16x8 qr[8];
    const int qp = t0 + (wid & 1) * QBLK + r32;
    {
        const bf16_t* Qw = QAT + (size_t)(b * SEQ + qp) * 1024 + h * 128 + hi * 8;
        u32x4 raw[8]; float ss = 0.f;
#pragma unroll
        for (int d0 = 0; d0 < 8; ++d0) { raw[d0] = *(const u32x4*)(Qw + d0 * 16);
#pragma unroll
            for (int i = 0; i < 4; ++i) { const float lo_ = bflo(raw[d0][i]), hi_ = bfhi(raw[d0][i]); ss += lo_ * lo_ + hi_ * hi_; } }
        { auto rr = __builtin_amdgcn_permlane32_swap(__float_as_uint(ss), __float_as_uint(ss), false, false); ss = __uint_as_float(rr[0]) + __uint_as_float(rr[1]); }
        const float rs = rsqrtf(ss * (1.f / 128.f) + EPS);
        const float* qnw = a.in(13);
#pragma unroll
        for (int half = 0; half < 2; ++half) {
            const float* ct = half == 0 ? rope + (qp >> 6) * 32 : rope + 16384 + (qp & 63) * 32;
            const float* st = half == 0 ? ct + 8192 : ct + 2048;
#pragma unroll
            for (int dd = 0; dd < 2; ++dd) {
                const int fi = dd * 16 + hi * 8, da = half * 4 + dd, db = da + 2;
                u32x4 oa, ob;
#pragma unroll
                for (int q4 = 0; q4 < 2; ++q4) {
                    const f32x4 c = *(const f32x4*)(ct + fi + 4 * q4), s = *(const f32x4*)(st + fi + 4 * q4);
                    const f32x4 wa = *(const f32x4*)(qnw + da * 16 + hi * 8 + 4 * q4), wb = *(const f32x4*)(qnw + db * 16 + hi * 8 + 4 * q4);
                    float ya[4], yb[4];
#pragma unroll
                    for (int j = 0; j < 4; ++j) {
                        const unsigned ra = raw[da][2 * q4 + (j >> 1)], rb = raw[db][2 * q4 + (j >> 1)];
                        const float x1 = ((j & 1) ? bfhi(ra) : bflo(ra)) * rs * wa[j], x2 = ((j & 1) ? bfhi(rb) : bflo(rb)) * rs * wb[j];
                        ya[j] = x1 * c[j] - x2 * s[j]; yb[j] = x2 * c[j] + x1 * s[j];
                    }
                    oa[2 * q4] = cvtpk(ya[0], ya[1]); oa[2 * q4 + 1] = cvtpk(ya[2], ya[3]); ob[2 * q4] = cvtpk(yb[0], yb[1]); ob[2 * q4 + 1] = cvtpk(yb[2], yb[3]);
                }
                qr[da] = *reinterpret_cast<bf16x8*>(&oa); qr[db] = *reinterpret_cast<bf16x8*>(&ob);
            }
        }
    }
    const int tk0 = t0 - 128 < 0 ? 0 : t0 - 128, tk1 = t0 + 192 > SEQ ? SEQ : t0 + 192;
    const int NTR = 4 + (tk1 - tk0) / 64, NT = (NTR + 1) & ~1;
    const int ctxrow = ML + b * CTX, latrow = b * SEQ + tk0 - 256;
#define TCTX(j) ((j) < 4 || (j) >= NTR)
#define TROW(j) (TCTX(j) ? b * CTX + 64 * ((j) & 3) : latrow + 64 * (j))
    const bf16_t* Kh = KAT + kvh * 128; const bf16_t* Vh = VAT + kvh * 128;
    const bf16_t* Kc = (const bf16_t*)(ws + WS_CTXK) + kvh * 128; const bf16_t* Vc = (const bf16_t*)(ws + WS_CTXV) + kvh * 128;
    const int sr = tid >> 4, sc = (tid & 15) * 8, vst0 = v_st(sr, sc), vst1 = v_st(32 + sr, sc);
    const int vb0 = (int)(uintptr_t)V_lds + v_rd_base(lane);
    struct { bf16x8 vs0, vs1, ks0, ks1; } sr_[1];
#define SLOAD(i, j) do { const int k0_ = TROW(j); const bf16_t* kb_ = TCTX(j) ? Kc : Kh; const bf16_t* vb_ = TCTX(j) ? Vc : Vh; \
    sr_[i].vs0 = *(const bf16x8*)(vb_ + (size_t)(k0_ + sr) * LDK + sc); sr_[i].vs1 = *(const bf16x8*)(vb_ + (size_t)(k0_ + 32 + sr) * LDK + sc); \
    sr_[i].ks0 = *(const bf16x8*)(kb_ + (size_t)(k0_ + sr) * LDK + sc); sr_[i].ks1 = *(const bf16x8*)(kb_ + (size_t)(k0_ + 32 + sr) * LDK + sc); } while (0)
#define SWRITE(bf, i) do { *(bf16x8*)(V_lds + (bf) * SHM_V + vst0) = sr_[i].vs0; *(bf16x8*)(V_lds + (bf) * SHM_V + vst1) = sr_[i].vs1; const int kc = sc * 2; \
    *(bf16x8*)(K_lds + (bf) * SHM_K + KSWZ(sr, kc)) = sr_[i].ks0; *(bf16x8*)(K_lds + (bf) * SHM_K + KSWZ(32 + sr, kc)) = sr_[i].ks1; } while (0)
#define SWAIT() asm volatile("s_waitcnt vmcnt(0)" ::: "memory")
#define RESC(al) do { if (__any((al) < 1.f)) { if (hi == 0) al_l[r32] = (al); asm volatile("s_waitcnt lgkmcnt(0)" ::: "memory"); \
    _Pragma("unroll") for (int d = 0; d < 4; ++d) _Pragma("unroll") for (int r = 0; r < 16; ++r) o[d][r] *= al_l[crow(r, hi)]; } } while (0)
#define WMASK(P0, P1, j) do { if ((j) >= 4) wmask(P0, P1, qp, (j) >= NTR ? 1000000 : tk0 + 64 * ((j) - 4), hi); } while (0)
    f32x16 pA0, pA1, pB0, pB1; float mnA, mnB, alA, alB; bf16x8 pa0, pa1, pa2, pa3;
    constexpr int SE = 0, SO = 0;
    SLOAD(SE, 0); asm volatile("s_waitcnt vmcnt(0)" ::: "memory"); SWRITE(0, SE); __syncthreads();
    qkt(pA0, pA1, K_lds, qr, r32, hi); partialSM(pA0, pA1, m_reg, mnA, alA);
    SLOAD(SO, 1);
    SWAIT(); SWRITE(1, SO); __syncthreads();
    for (int j = 1; j + 1 < NT; j += 2) {
        SBAR(); qkt(pB0, pB1, K_lds + SHM_K, qr, r32, hi); WMASK(pB0, pB1, j);
        finishSM(pA0, pA1, alA, l_reg, pa0, pa1, pa2, pa3); SBAR();
        SLOAD(SO, j + 1); SBAR();
        pv_d0(o, vb0, pa0, pa1, pa2, pa3); partialSM(pB0, pB1, m_reg, mnB, alB);
        __syncthreads(); SWAIT(); SWRITE(0, SE);
        RESC(alB); __syncthreads();
        SBAR(); qkt(pA0, pA1, K_lds, qr, r32, hi); WMASK(pA0, pA1, j + 1);
        finishSM(pB0, pB1, alB, l_reg, pa0, pa1, pa2, pa3); SBAR();
        SLOAD(SE, j + 2); SBAR();
        pv_d0(o, vb0 + (int)SHM_V, pa0, pa1, pa2, pa3); partialSM(pA0, pA1, m_reg, mnA, alA);
        __syncthreads(); SWAIT(); SWRITE(1, SO);
        RESC(alA); __syncthreads();
    }
    SBAR(); qkt(pB0, pB1, K_lds + SHM_K, qr, r32, hi); WMASK(pB0, pB1, NT - 1);
    finishSM(pA0, pA1, alA, l_reg, pa0, pa1, pa2, pa3); SBAR();
    pv_d0(o, vb0, pa0, pa1, pa2, pa3); partialSM(pB0, pB1, m_reg, mnB, alB);
    __syncthreads(); RESC(alB);
    finishSM(pB0, pB1, alB, l_reg, pa0, pa1, pa2, pa3); SBAR();
    pv_d0(o, vb0 + (int)SHM_V, pa0, pa1, pa2, pa3);
    l_reg += __builtin_amdgcn_exp2f(a.in(15)[h] * 1.4426950408889634f - m_reg * (SCALE * 1.4426950408889634f));
    if (hi == 0) li_l[r32] = l_reg; asm volatile("s_waitcnt lgkmcnt(0)" ::: "memory");
    float rli[16];
#pragma unroll
    for (int r = 0; r < 16; ++r) rli[r] = __builtin_amdgcn_rcpf(li_l[crow(r, hi)]);
    {
        bf16_t* stg = (bf16_t*)(lds + OFF_OST) + wid * 4096;
#pragma unroll
        for (int r = 0; r < 16; ++r) { const int orow = crow(r, hi);
#pragma unroll
            for (int d0 = 0; d0 < 4; ++d0) stg[orow * 128 + d0 * 32 + r32] = (bf16_t)f2bf(o[d0][r] * rli[r]); }
        asm volatile("s_waitcnt lgkmcnt(0)" ::: "memory");
        bf16_t* Ow = Y + (size_t)(b * SEQ + t0 + (wid & 1) * QBLK) * 2048 + 1024 + h * 128;
#pragma unroll
        for (int i = 0; i < 8; ++i) { const int row = i * 4 + (lane >> 4), ch = lane & 15; const u32x4 v = *(const u32x4*)(stg + row * 128 + ch * 8); *(u32x4*)(Ow + (size_t)row * 2048 + ch * 8) = v; }
    }
    __syncthreads();
#undef TROW
#undef TCTX
#undef SLOAD
#undef SWRITE
#undef SWAIT
#undef RESC
#undef WMASK
}
#undef KSWZ
#undef SBAR
}

DEVI u32x4 ldu_(const bf16_t* base, int rr) {
    const int rc = rr < 0 ? 0 : (rr >= SEQ ? SEQ - 1 : rr);
    const u32x4 v = *(const u32x4*)(base + (size_t)rc * NUP);
    const unsigned m = (rr == rc) ? 0xffffffffu : 0u;
    return (u32x4){v[0] & m, v[1] & m, v[2] & m, v[3] & m};
}
DEVI void phase_ffnconv(const KA& a, int b, int tid) {
    unsigned char* ws = a.ws();
    const bf16_t* U = (const bf16_t*)(ws + WS_U); bf16_t* ACT = (bf16_t*)(ws + WS_ACT) + (size_t)b * SEQ * DFF;
    const float* cw = a.in(20); const float* cb = a.in(21);
    if (tid < DFF / 8) {
        const int f0 = tid * 8, pn = f0 >> 7, j = f0 & 127, gc = 256 * pn + j, vc = gc + 128;
        float wg[3][8], wv[3][8], bg[8], bvv[8];
#pragma unroll
        for (int jt = 0; jt < 3; ++jt)
#pragma unroll
            for (int q = 0; q < 8; ++q) { wg[jt][q] = cw[jt * NUP + f0 + q]; wv[jt][q] = cw[jt * NUP + DFF + f0 + q]; }
#pragma unroll
        for (int q = 0; q < 8; ++q) { bg[q] = cb[f0 + q]; bvv[q] = cb[DFF + f0 + q]; }
        for (int it = blockIdx.x; it < SEQ / 32; it += gridDim.x) {
            const int r0 = it * 32;
            u32x4 gw_[3], vw_[3];
#define LDU(rr, c) ldu_(U + (c), (rr))
            gw_[0] = LDU(r0 - 1, gc); vw_[0] = LDU(r0 - 1, vc); gw_[1] = LDU(r0, gc); vw_[1] = LDU(r0, vc);
#pragma unroll 8
            for (int r = 0; r < 32; ++r) {
                gw_[2] = LDU(r0 + r + 1, gc); vw_[2] = LDU(r0 + r + 1, vc);
                float ug[8], uv[8];
#pragma unroll
                for (int q = 0; q < 8; ++q) { ug[q] = bg[q]; uv[q] = bvv[q]; }
#pragma unroll
                for (int jt = 0; jt < 3; ++jt)
#pragma unroll
                    for (int q = 0; q < 4; ++q) {
                        ug[2 * q] += bflo(gw_[jt][q]) * wg[jt][2 * q]; ug[2 * q + 1] += bfhi(gw_[jt][q]) * wg[jt][2 * q + 1];
                        uv[2 * q] += bflo(vw_[jt][q]) * wv[jt][2 * q]; uv[2 * q + 1] += bfhi(vw_[jt][q]) * wv[jt][2 * q + 1]; }
                u32x4 o;
                o.x = pk2(siluf(ug[0]) * uv[0], siluf(ug[1]) * uv[1]); o.y = pk2(siluf(ug[2]) * uv[2], siluf(ug[3]) * uv[3]);
                o.z = pk2(siluf(ug[4]) * uv[4], siluf(ug[5]) * uv[5]); o.w = pk2(siluf(ug[6]) * uv[6], siluf(ug[7]) * uv[7]);
                *(u32x4*)(ACT + (size_t)(r0 + r) * DFF + f0) = o;
                gw_[0] = gw_[1]; gw_[1] = gw_[2]; vw_[0] = vw_[1]; vw_[1] = vw_[2];
            }
#undef LDU
        }
    }
}

#define XB_TMO      128
#define XB_XCNT(j)  (256  + 64 * (j))
#define XB_XSUB(j)  (1280 + 64 * (j))
#define XB_XGEN(j)  (2304 + 64 * (j))
#define XB_TOP      3328
#define XB_TOPGEN   3392
#define XCD_BAR_WORDS 3456
#define XB_SPIN_CAP (1u << 18)
__device__ __forceinline__ unsigned xb_ld(unsigned* p)              { return __hip_atomic_load(p, __ATOMIC_RELAXED, __HIP_MEMORY_SCOPE_AGENT); }
__device__ __forceinline__ unsigned xb_add(unsigned* p, unsigned v) { return __hip_atomic_fetch_add(p, v, __ATOMIC_RELAXED, __HIP_MEMORY_SCOPE_AGENT); }
__device__ __forceinline__ unsigned xb_xcc_id() { return (unsigned)__builtin_amdgcn_s_getreg((3 << 11) | 20) & 0xFu; }
#define XB_SPIN(cond, bar) do { unsigned _sp = 0; while (cond) { __builtin_amdgcn_s_sleep(1); \
    if ((++_sp & 255u) == 0u) { if (xb_ld(&(bar)[XB_TMO])) break; if (_sp > XB_SPIN_CAP) { atomicAdd(&(bar)[XB_TMO], 1u); break; } } } } while (0)
struct XcdBarrier { unsigned* bar; unsigned x; volatile LAS unsigned* st; };
__device__ __forceinline__ XcdBarrier xcd_barrier_post(unsigned* bar, volatile LAS unsigned* st) {
    XcdBarrier b; b.bar = bar; b.x = xb_xcc_id(); b.st = st;
    if (threadIdx.x == 0) (void)xb_add(&bar[XB_XCNT(b.x)], 1u);
    return b;
}
__device__ __forceinline__ void xcd_barrier_complete(unsigned* bar, unsigned x, unsigned& nloc, unsigned& nx) {
    const unsigned G = gridDim.x * gridDim.y * gridDim.z;
    unsigned sum, cnt, mine, sp = 0u;
    for (;;) {
        sum = 0u; cnt = 0u; mine = 0u;
#pragma unroll
        for (unsigned j = 0; j < 16; ++j) { const unsigned c = xb_ld(&bar[XB_XCNT(j)]); sum += c; cnt += (c > 0u) ? 1u : 0u; mine = (j == x) ? c : mine; }
        if (sum == G) break;
        __builtin_amdgcn_s_sleep(1);
        if ((++sp & 255u) == 0u) { if (xb_ld(&bar[XB_TMO])) break; if (sp > XB_SPIN_CAP) { atomicAdd(&bar[XB_TMO], 1u); break; } }
    }
    nloc = mine > 0u ? mine : 1u; nx = cnt > 0u ? cnt : 1u;
}
__device__ __forceinline__ void xcd_barrier(const XcdBarrier& b) {
    asm volatile("s_waitcnt vmcnt(0)" ::: "memory");
    __syncthreads();
    if (threadIdx.x == 0) {
        unsigned* bar = b.bar;
        __builtin_amdgcn_s_waitcnt(0);
        unsigned nloc = b.st[0], nx = b.st[1];
        if (nloc == 0u) { xcd_barrier_complete(bar, b.x, nloc, nx); b.st[0] = nloc; b.st[1] = nx; }
        const unsigned old = xb_add(&bar[XB_XSUB(b.x)], 1u);
        const unsigned gen = old / nloc;
        if (old + 1u == (gen + 1u) * nloc) {
            __builtin_amdgcn_fence(__ATOMIC_RELEASE, "agent");
            asm volatile("s_waitcnt vmcnt(0)" ::: "memory");
            const unsigned og = xb_add(&bar[XB_TOP], 1u);
            const unsigned tg = og / nx;
            if (og + 1u == (tg + 1u) * nx) xb_add(&bar[XB_TOPGEN], 1u);
            else XB_SPIN(xb_ld(&bar[XB_TOPGEN]) == tg, bar);
            __builtin_amdgcn_fence(__ATOMIC_ACQUIRE, "agent");
            xb_add(&bar[XB_XGEN(b.x)], 1u);
            asm volatile("s_waitcnt vmcnt(0)" ::: "memory");
        } else {
            XB_SPIN(xb_ld(&bar[XB_XGEN(b.x)]) == gen, bar);
            __builtin_amdgcn_fence(__ATOMIC_ACQUIRE, "agent");
            asm volatile("s_waitcnt vmcnt(0)" ::: "memory");
        }
    }
    __syncthreads();
}

constexpr int NPHASE = 13;
__global__ void __launch_bounds__(512, 2) mega(Args a_) {
    const KA a;
    extern __shared__ __attribute__((aligned(16))) unsigned char lds_raw[];
    LAS unsigned char* lds = (LAS unsigned char*)lds_raw;
    const int tid = threadIdx.x, lane = tid & 63, wave = __builtin_amdgcn_readfirstlane(tid >> 6);
    unsigned char* ws = a.ws();
    const int lo = a_.ph_lo, hi = a_.ph_hi;
#define IN(k) (lo <= (k) && (k) < hi)
#if MK_ONE_LAUNCH
    volatile LAS unsigned* bst = (volatile LAS unsigned*)(lds + 147440);
    if (tid < 4) bst[tid] = 0u;
    __syncthreads();
    const XcdBarrier gbar = xcd_barrier_post((unsigned*)(ws + WS_CTL), bst);
#define SEAM(k) do { if (IN(k) && IN((k) + 1)) xcd_barrier(gbar); } while (0)
#else
#define SEAM(k) do { } while (0)
#endif
    const float* modacc = (const float*)(ws + CTL_MODACC);
    unsigned long long pr_prev = PROBE_MASK ? __builtin_amdgcn_s_memrealtime() : 0ull, pr_acc = 0ull;
#define STAMP(k) do { if (PROBE_MASK) { const unsigned long long now_ = __builtin_amdgcn_s_memrealtime(); if ((PROBE_MASK >> (k)) & 1u) pr_acc += now_ - pr_prev; pr_prev = now_; } } while (0)
    if (IN(0)) { phase0(a, lds, tid, lane, wave); } SEAM(0); STAMP(0);
    if (IN(1)) { phase1(a, tid, lane, wave); } SEAM(1); STAMP(1);
    if (IN(2)) {
        pg8::Gemm g{(const bf16_t*)(ws + WS_XN), (const bf16_t*)(ws + WS_WINA), MT, NA, 1024}; pg8::StaticOrder S; S.init(MT, NA, gridDim.x, blockIdx.x);
        EpiIn E{(const float*)(ws + SM_ROWSS1), (const float*)(ws + SM_SHWA), 0, (bf16_t*)(ws + WS_QKVR), nullptr, nullptr, nullptr, nullptr, (float*)(ws + WS_BA)};
        pg8::gemm_phase<EpiIn, pg8::StaticOrder, true, true>(lds, g, S, E);
        {
            pg8::Gemm g2{(const bf16_t*)(ws + WS_XN) + (size_t)ML * 1024, (const bf16_t*)(ws + WS_WINC) + (size_t)2048 * 1024, MC, 512, 1024};
            TailOrder T{(int)blockIdx.x - ((int)gridDim.x - 4)};
            EpiCtxKV E2{(const float*)(ws + SM_ROWSS1) + ML, (const float*)(ws + SM_SHWA) + 2 * NSH + NA + 2048, (bf16_t*)(ws + WS_CTXK), (bf16_t*)(ws + WS_CTXV)};
            pg8::gemm_phase<EpiCtxKV, TailOrder, true, true>(lds, g2, T, E2);
        }
    } SEAM(2); STAMP(2);
    if (IN(3)) { phase_dnprep(a, tid); } SEAM(3); STAMP(3);
    STAMP(4);
    if (IN(5)) { const unsigned long long t5_ = (PROBE_SUB == 4) ? __builtin_amdgcn_s_memrealtime() : 0ull; phase_dnscan2(a, lds, tid, lane, wave, pr_acc); if (PROBE_SUB == 4) pr_acc += __builtin_amdgcn_s_memrealtime() - t5_; } SEAM(5); STAMP(5);
    if (IN(6)) {
        pg8::Gemm g{(const bf16_t*)(ws + WS_XN), (const bf16_t*)(ws + WS_WINC), ML, NC, 1024}; pg8::StaticOrder S; S.init(ML, NC, gridDim.x, blockIdx.x);
        EpiIn E{(const float*)(ws + SM_ROWSS1), (const float*)(ws + SM_SHWA) + NA, 1, (bf16_t*)(ws + WS_GT), (bf16_t*)(ws + WS_QAT), (bf16_t*)(ws + WS_KAT), (bf16_t*)(ws + WS_VAT), (bf16_t*)(ws + WS_MG), nullptr};
        pg8::gemm_phase<EpiIn, pg8::StaticOrder, true, true>(lds, g, S, E);
    } SEAM(6); STAMP(6);
    if (IN(7)) { phase_prep2(a, lane, wave); } SEAM(7); STAMP(7);
    if (IN(8)) {
        const int G_ = (int)gridDim.x, vcu_ = (G_ % 8 == 0) ? ((int)blockIdx.x % 8) * (G_ / 8) + (int)blockIdx.x / 8 : (int)blockIdx.x;
#pragma unroll 1
        for (int idx = vcu_; idx < 1024; idx += G_) {
            const int tb = idx & 255, kvh = (idx >> 8) & 1, b = idx >> 9;
            att::attn_unit(a, b, kvh, tb, (char*)lds_raw); }
    } SEAM(8); STAMP(8);
    if (IN(9)) {
        pg8::Gemm g{(const bf16_t*)(ws + WS_Y), (const bf16_t*)(ws + WS_WBR), ML, 1024, 2048}; pg8::StaticOrder S; S.init(ML, 1024, gridDim.x, blockIdx.x);
        EpiBr E{(const bf16_t*)(ws + WS_MG), (bf16_t*)(ws + WS_MERGED)};
        pg8::gemm_phase<EpiBr, pg8::StaticOrder, true, true>(lds, g, S, E);
    } SEAM(9); STAMP(9);
    if (IN(10)) {
        pg8::Gemm g{(const bf16_t*)(ws + WS_MERGED), (const bf16_t*)(ws + WS_WOUT), ML, 1024, 1024}; pg8::StaticOrder S; S.init(ML, 1024, gridDim.x, blockIdx.x);
        EpiOut E{a.in(0), modacc, a.in(5), a.in(7), a.out(), (bf16_t*)(ws + WS_X1S), (float*)(ws + CTL_ROWSS2)};
        pg8::gemm_phase<EpiOut, pg8::StaticOrder, true, true>(lds, g, S, E);
    } SEAM(10); STAMP(10);
    if (IN(11)) {
        pg8::Gemm g{(const bf16_t*)(ws + WS_X1S), (const bf16_t*)(ws + WS_WUP), 2 * TPB * 256, NUP, 1024}; pg8::StaticOrder S; S.init(2 * TPB * 256, NUP, gridDim.x, blockIdx.x);
        EpiUpConv E{(const float*)(ws + CTL_ROWSS2), (const float*)(ws + SM_SHWF), a.in(20), a.in(21), (bf16_t*)(ws + WS_ACT), (LAS float*)(lds + 131072)};
        pg8::gemm_phase<EpiUpConv, pg8::StaticOrder, true, true>(lds, g, S, E);
    } SEAM(11); STAMP(11);
    if (IN(12)) {
        pg8::Gemm g{(const bf16_t*)(ws + WS_ACT), (const bf16_t*)(ws + WS_WDN), ML, 1024, DFF}; pg8::StaticOrder S; S.init(ML, 1024, gridDim.x, blockIdx.x);
        EpiDown E{modacc, a.in(5), a.out()};
        pg8::gemm_phase<EpiDown, pg8::StaticOrder, true, true>(lds, g, S, E);
    }
    STAMP(12);
    if (PROBE_SUB >= 8 && blockIdx.x == 0) pr_acc += __hip_atomic_load((unsigned*)(ws + CTL_DBG) + (PROBE_SUB - 8), __ATOMIC_RELAXED, __HIP_MEMORY_SCOPE_AGENT);
    if ((PROBE_MASK || PROBE_SUB) && blockIdx.x == 0) { const unsigned long long t0_ = __builtin_amdgcn_s_memrealtime(); while (__builtin_amdgcn_s_memrealtime() - t0_ < pr_acc) __builtin_amdgcn_s_sleep(8); }
#undef STAMP
#undef IN
#undef SEAM
}

extern "C" void kernel_launch(void* const* d_in, const int* in_sizes, int n_in, void* d_out, int out_size, void* d_ws, size_t ws_size, hipStream_t stream) {
    static int grid = 0;
    if (grid == 0) {
        if (n_in != 23 || in_sizes[0] != ML * DM || out_size != ML * DM || ws_size < WS_END) {
            fprintf(stderr, "kernel_launch: unexpected shapes n_in %d in0 %d out %d ws %zu (need %zu)\n", n_in, n_in > 0 ? in_sizes[0] : -1, out_size, ws_size, (size_t)WS_END); grid = -1; return; }
        int dev = 0, cus = 0, per_cu = 0;
        hipGetDevice(&dev); hipDeviceGetAttribute(&cus, hipDeviceAttributeMultiprocessorCount, dev);
        if (hipFuncSetAttribute((const void*)mega, hipFuncAttributeMaxDynamicSharedMemorySize, LDS_BYTES) != hipSuccess) { fprintf(stderr, "kernel_launch: hipFuncSetAttribute failed\n"); grid = -1; return; }
        hipOccupancyMaxActiveBlocksPerMultiprocessor(&per_cu, (const void*)mega, 512, LDS_BYTES);
        (void)hipGetLastError();
        if (per_cu < 1) { fprintf(stderr, "kernel_launch: occupancy query says %d blocks per CU\n", per_cu); per_cu = 1; }
        if (cus < 160) { fprintf(stderr, "kernel_launch: %d CUs: the scan phase needs 128 scan workgroups plus chunk producers\n", cus); grid = -1; return; }
        grid = cus;
    }
    if (grid < 0) return;
    hipMemsetAsync((char*)d_ws + WS_CTL, 0, CTL_ZERO_BYTES, stream);
    Args a{};
    for (int i = 0; i < 23; ++i) a.in[i] = (const float*)d_in[i];
    a.out = (float*)d_out; a.ws = (unsigned char*)d_ws;
#if MK_ONE_LAUNCH
    a.ph_lo = 0; a.ph_hi = NPHASE;
    void* args[] = {&a};
    hipError_t e = hipLaunchCooperativeKernel((const void*)mega, dim3(grid), dim3(512), args, LDS_BYTES, stream);
    if (e != hipSuccess) fprintf(stderr, "cooperative launch failed: %s (grid %d)\n", hipGetErrorString(e), grid);
#else
    for (int p = 0; p < NPHASE; ++p) {
        a.ph_lo = p; a.ph_hi = p + 1;
        hipLaunchKernelGGL(mega, dim3(grid), dim3(512), LDS_BYTES, stream, a);
    }
    hipError_t e = hipPeekAtLastError();
    if (e != hipSuccess) fprintf(stderr, "launch failed: %s\n", hipGetErrorString(e));
#endif
}
```

```cpp
#include <hip/hip_runtime.h>
#include <hip/hip_cooperative_groups.h>
#include <cstdio>
#include <cstdint>
namespace cg = cooperative_groups;

#ifndef PROBE_MASK
#define PROBE_MASK 0u
#endif
#ifndef PROBE_SUB
#define PROBE_SUB 0
#endif
#ifndef MK_ONE_LAUNCH
#define MK_ONE_LAUNCH 1
#endif

#define DEVI __device__ __forceinline__
#define LAS __attribute__((address_space(3)))
#define GAS __attribute__((address_space(1)))
typedef unsigned short bf16_t;
typedef short bf16x8 __attribute__((ext_vector_type(8)));
typedef float f32x4 __attribute__((ext_vector_type(4)));
typedef float f32x2 __attribute__((ext_vector_type(2)));
typedef float f32x16 __attribute__((ext_vector_type(16)));
typedef unsigned u32x4 __attribute__((ext_vector_type(4)));
typedef unsigned u32x2 __attribute__((ext_vector_type(2)));
typedef short s16x4 __attribute__((ext_vector_type(4)));

constexpr int BATCH = 2, SEQ = 16384, DM = 1024, CTX = 256;
constexpr int ML = BATCH * SEQ;
constexpr int MC = BATCH * CTX;
constexpr int MT = ML + MC;
constexpr int NA = 3328;
constexpr int NC = 4608;
constexpr int NSH = NA + NC;
constexpr int DFF = 2816, NUP = 5632;
constexpr int RB = SEQ + 256;
constexpr int TPB = 65;
constexpr float EPS = 1e-6f;

constexpr size_t MiB = 1u << 20;
constexpr size_t WS_CTL = 0, CTL_ZERO_BYTES = 1 * MiB;
constexpr size_t CTL_XRANK = 24 * 1024;
constexpr size_t CTL_PROG = 32 * 1024;
constexpr size_t CTL_RDY = 512 * 1024;
constexpr size_t CTL_DBG = 48 * 1024;
constexpr size_t CTL_MODACC = 64 * 1024;
constexpr size_t CTL_ROWSS2 = 256 * 1024;
constexpr size_t WS_SMALL = 1 * MiB;
constexpr size_t SM_ROWSS1 = WS_SMALL;
constexpr size_t SM_SHWA = WS_SMALL + 256 * 1024;
constexpr size_t SM_SHWF = WS_SMALL + 384 * 1024;
constexpr size_t SM_ROPE = WS_SMALL + 512 * 1024;
constexpr size_t WS_BA = 2 * MiB;
constexpr size_t WS_CTXK = 6 * MiB + 256 * 1024;
constexpr size_t WS_CTXV = 6 * MiB + 512 * 1024;
constexpr size_t WS_G = 7 * MiB;
constexpr size_t WS_BETA = 10 * MiB;
constexpr size_t WS_WINA = 13 * MiB, WS_WINC = 20 * MiB, WS_WBR = 29 * MiB, WS_WOUT = 33 * MiB, WS_WUP = 35 * MiB, WS_WDN = 46 * MiB;
constexpr size_t WS_XN = 52 * MiB;
constexpr size_t WS_QKVR = 117 * MiB;
constexpr size_t WS_QKVP = 312 * MiB;
constexpr size_t WS_MG = 180 * MiB;
constexpr size_t WS_GT = 310 * MiB;
constexpr size_t WS_QAT = 375 * MiB;
constexpr size_t WS_KAT = 440 * MiB;
constexpr size_t WS_VAT = 457 * MiB;
constexpr size_t WS_Y = 52 * MiB;
constexpr size_t WS_MERGED = 375 * MiB;
constexpr size_t WS_X1S = 440 * MiB;
constexpr size_t WS_U = 52 * MiB;
constexpr size_t WS_ACT = 228 * MiB;
constexpr size_t WS_TQ = 117 * MiB;
constexpr size_t WS_AVEC = 248 * MiB;
constexpr size_t WS_END = 512 * MiB;

constexpr int LDS_BYTES = 147456;

DEVI float bf2f(unsigned short h) { return __uint_as_float((unsigned)h << 16); }
DEVI float bflo(unsigned w) { return __uint_as_float(w << 16); }
DEVI float bfhi(unsigned w) { return __uint_as_float(w & 0xffff0000u); }
typedef __bf16 bf16x2_t __attribute__((ext_vector_type(2)));
DEVI unsigned pk2(float lo, float hi) { const f32x2 v = {lo, hi}; const bf16x2_t b = __builtin_convertvector(v, bf16x2_t); return __builtin_bit_cast(unsigned, b); }
DEVI unsigned f2bf(float f) { return pk2(f, 0.f) & 0xffffu; }
DEVI float wave_sum(float v) {
#pragma unroll
    for (int o = 1; o < 64; o <<= 1) v += __shfl_xor(v, o);
    return v;
}
DEVI float siluf(float x) { return x * __builtin_amdgcn_rcpf(1.f + __expf(-x)); }
DEVI float sigmoidf_(float x) { return 1.f / (1.f + __expf(-x)); }

struct Args { const float* in[23]; float* out; unsigned char* ws; int ph_lo, ph_hi; };
struct KA {
    DEVI const float* in(int k) const { return ((const float* const*)__builtin_amdgcn_kernarg_segment_ptr())[k]; }
    DEVI float* out() const { return ((float* const*)__builtin_amdgcn_kernarg_segment_ptr())[23]; }
    DEVI unsigned char* ws() const { return ((unsigned char* const*)__builtin_amdgcn_kernarg_segment_ptr())[24]; }
};

namespace pg8 {
constexpr int BM = 256, BK = 64, HALF = 128, HTB = HALF * BK * 2, STAGE_BYTES = 8 * HTB, NXCD = 8, WGM = 8;
__host__ __device__ __forceinline__ int lds_byte(int r, int c) { const int st = (r >> 4) * 2 + (c >> 5), rr = r & 15, cc = c & 31, ob = rr * 64 + cc * 2; return st * 1024 + (ob ^ (((ob >> 9) & 1) << 5)); }
__host__ __device__ __forceinline__ void stage_rc(int b, int& R, int& C) { const int st = b / 1024, sb = b % 1024, swz = sb ^ (((sb >> 9) & 1) << 5); R = (st >> 1) * 16 + swz / 64; C = (st & 1) * 32 + (swz % 64) / 2; }
__host__ __device__ __forceinline__ int perm32(int rho) { const int n = rho >> 4, i = rho & 15; return 8 * (i >> 2) + 4 * n + (i & 3); }
struct Unit { int pm, pn; };
struct Gemm { const bf16_t* A; const bf16_t* Bt; int M, N, K; };
struct StaticOrder {
    int nM, nN, nwg, G, c;
    __device__ void init(int M, int N, int G_, int c_) { nM = M / BM; nN = N / BM; nwg = nM * nN; G = G_; c = c_; }
    __device__ bool next(int i, Unit& u) const {
        const long L = (long)i * G + c; if (L >= nwg) return false;
        int wgid = (int)L; { const int q = nwg / NXCD, r = nwg % NXCD, xcd = wgid % NXCD, off = wgid / NXCD; wgid = (xcd < r ? xcd * (q + 1) : r * (q + 1) + (xcd - r) * q) + off; }
        const int nig = WGM * nN, gid = wgid / nig, fm = gid * WGM, gsz = (nM - fm) < WGM ? (nM - fm) : WGM;
        u.pm = fm + ((wgid % nig) % gsz); u.pn = (wgid % nig) / gsz; return true;
    }
};
template <class Epi> __device__ __forceinline__ size_t a_off(const Epi& E, int pm, int K, size_t tstep) { if constexpr (Epi::AROW) return (size_t)E.arow(pm) * K * 2; else return (size_t)pm * tstep; }
template <class Epi, class Sched, bool ALIGN_EPI, bool SP2>
__device__ __forceinline__ void gemm_phase(LAS unsigned char* lds, const Gemm g, const Sched& S, const Epi& E) {
    const int tid = threadIdx.x, wid = __builtin_amdgcn_readfirstlane(tid >> 6), lane = tid & 63, wr = wid >> 2, wc = wid & 3, fr = lane & 15, fq = lane >> 4;
    const int K = g.K, nt = K / BK;
    unsigned voffA[2], voffB[2];
#pragma unroll
    for (int i = 0; i < 2; ++i) { int R, C; stage_rc(tid * 16 + i * 8192, R, C); const int Rb = Epi::PERM ? ((R & ~31) + perm32(R & 31)) : R;
        voffA[i] = (unsigned)(R * K + C) * 2u; voffB[i] = (unsigned)(Rb * K + C) * 2u; }
    const size_t kstep = (size_t)(BK * 2);
    const size_t hstep = (size_t)HALF * K * 2;
    const size_t tstep = 2 * hstep;
    const unsigned ldsw = (unsigned)wid * 1024u;
    const int aoff = lds_byte(wr * 64 + fr, fq * 8), boff = lds_byte(wc * 32 + fr, fq * 8);
#define PG8_SA(b, h) (((b) * 2 + (h)) * HTB)
#define PG8_SB(b, h) ((4 + (b) * 2 + (h)) * HTB)
#define PG8_STAGE(bufoff, gbase, voff) do { _Pragma("unroll") for (int _i = 0; _i < 2; ++_i) \
        __builtin_amdgcn_global_load_lds((const unsigned*)((const char*)(gbase) + (voff)[_i]), (LAS unsigned*)(lds + (bufoff) + ldsw + _i * 8192), 16, 0, 0); } while (0)
#define PG8_LDA(dst, b, h) do { _Pragma("unroll") for (int m = 0; m < 4; ++m) _Pragma("unroll") for (int k = 0; k < 2; ++k) dst[m][k] = *(const LAS bf16x8*)(lds + PG8_SA(b, h) + aoff + m * 2048 + k * 1024); } while (0)
#define PG8_LDB(dst, b, h) do { _Pragma("unroll") for (int n = 0; n < 2; ++n) _Pragma("unroll") for (int k = 0; k < 2; ++k) dst[n][k] = *(const LAS bf16x8*)(lds + PG8_SB(b, h) + boff + n * 2048 + k * 1024); } while (0)
#define PG8_MMA(ai, bj, At, Bt) do { __builtin_amdgcn_s_setprio(1); _Pragma("unroll") for (int m = 0; m < 4; ++m) _Pragma("unroll") for (int n = 0; n < 2; ++n) _Pragma("unroll") for (int k = 0; k < 2; ++k) \
        acc[ai][bj][m][n] = __builtin_amdgcn_mfma_f32_16x16x32_bf16(Bt[n][k], At[m][k], acc[ai][bj][m][n], 0, 0, 0); __builtin_amdgcn_s_setprio(0); } while (0)
#define PG8_WAIT_V(n) asm volatile("s_waitcnt vmcnt(" #n ")" ::: "memory")
#define PG8_WAIT_L(n) asm volatile("s_waitcnt lgkmcnt(" #n ")" ::: "memory")
#define PG8_BAR __builtin_amdgcn_s_barrier()
#define PG8_SCHED __builtin_amdgcn_sched_barrier(0)
    Unit cur, nxt; int ui = 0;
    if (!S.next(0, cur)) return;
    f32x4 acc[2][2][4][2];
#pragma unroll
    for (int a = 0; a < 2; ++a)
#pragma unroll
        for (int b = 0; b < 2; ++b)
#pragma unroll
            for (int m = 0; m < 4; ++m)
#pragma unroll
                for (int n = 0; n < 2; ++n) acc[a][b][m][n] = (f32x4){0.f, 0.f, 0.f, 0.f};
    bf16x8 At[4][2], B0[2][2], B1[2][2];
    const char* cA = (const char*)g.A + a_off<Epi>(E, cur.pm, K, tstep); const char* cB = (const char*)g.Bt + (size_t)cur.pn * tstep;
    if constexpr (SP2) {
        PG8_STAGE(PG8_SB(0, 0), cB, voffB); PG8_STAGE(PG8_SB(0, 1), cB + hstep, voffB); PG8_STAGE(PG8_SA(0, 0), cA, voffA); PG8_STAGE(PG8_SA(0, 1), cA + hstep, voffA);
        if (wr == 1) PG8_BAR;
        PG8_WAIT_V(2); PG8_BAR;
        PG8_STAGE(PG8_SB(1, 0), cB + kstep, voffB); PG8_STAGE(PG8_SA(1, 0), cA + kstep, voffA); PG8_STAGE(PG8_SB(1, 1), cB + hstep + kstep, voffB);
        PG8_WAIT_V(6); PG8_BAR;
    } else {
        PG8_STAGE(PG8_SB(0, 0), cB, voffB); PG8_STAGE(PG8_SA(0, 0), cA, voffA); PG8_STAGE(PG8_SB(0, 1), cB + hstep, voffB); PG8_STAGE(PG8_SA(0, 1), cA + hstep, voffA);
        if (wr == 1) PG8_BAR;
        PG8_WAIT_V(4); PG8_BAR;
        PG8_STAGE(PG8_SB(1, 0), cB + kstep, voffB); PG8_STAGE(PG8_SA(1, 0), cA + kstep, voffA); PG8_STAGE(PG8_SB(1, 1), cB + hstep + kstep, voffB);
        PG8_WAIT_V(6); PG8_BAR;
    }
    for (;;) {
        const bool has_next = S.next(ui + 1, nxt);
        const char* nA = has_next ? (const char*)g.A + a_off<Epi>(E, nxt.pm, K, tstep) : cA; const char* nB = has_next ? (const char*)g.Bt + (size_t)nxt.pn * tstep : cB;
#pragma unroll 1
        for (int t = 0; t < nt; t += 2) {
            const bool last = (t == nt - 2);
            if constexpr (Epi::MID) { if (t == nt / 2) E.mid(acc, cur, wr, wc, fr, fq); }
            const char* a1 = cA + (size_t)(t + 1) * kstep;
            const char* a2 = last ? nA : cA + (size_t)(t + 2) * kstep; const char* b2 = last ? nB : cB + (size_t)(t + 2) * kstep;
            const char* a3 = a2 + kstep; const char* b3 = b2 + kstep;
            if constexpr (SP2) {
            PG8_LDB(B0, 0, 0); PG8_LDB(B1, 0, 1); PG8_SCHED; PG8_LDA(At, 0, 0); PG8_STAGE(PG8_SA(1, 1), a1 + hstep, voffA);
            PG8_WAIT_V(8); PG8_WAIT_L(0); PG8_BAR; PG8_MMA(0, 0, At, B0); PG8_MMA(0, 1, At, B1); PG8_BAR; PG8_SCHED;
            PG8_LDA(At, 0, 1); PG8_STAGE(PG8_SB(0, 0), b2, voffB); PG8_STAGE(PG8_SB(0, 1), b2 + hstep, voffB); PG8_STAGE(PG8_SA(0, 0), a2, voffA);
            PG8_WAIT_V(8); PG8_WAIT_L(0); PG8_BAR; PG8_MMA(1, 0, At, B0); PG8_MMA(1, 1, At, B1); PG8_BAR; PG8_SCHED;
            PG8_LDB(B0, 1, 0); PG8_LDB(B1, 1, 1); PG8_SCHED; PG8_LDA(At, 1, 0); PG8_STAGE(PG8_SA(0, 1), a2 + hstep, voffA);
            PG8_WAIT_V(8); PG8_WAIT_L(0); PG8_BAR; PG8_MMA(0, 0, At, B0); PG8_MMA(0, 1, At, B1); PG8_BAR; PG8_SCHED;
            PG8_LDA(At, 1, 1); PG8_STAGE(PG8_SB(1, 0), b3, voffB); PG8_STAGE(PG8_SB(1, 1), b3 + hstep, voffB); PG8_STAGE(PG8_SA(1, 0), a3, voffA);
            PG8_WAIT_V(8); PG8_WAIT_L(0); PG8_BAR; PG8_MMA(1, 0, At, B0); PG8_MMA(1, 1, At, B1); PG8_BAR; PG8_SCHED;
            } else {
            PG8_LDB(B0, 0, 0); PG8_SCHED; PG8_LDA(At, 0, 0); PG8_STAGE(PG8_SA(1, 1), a1 + hstep, voffA);
            PG8_WAIT_L(8); PG8_BAR; PG8_WAIT_L(0); PG8_MMA(0, 0, At, B0); PG8_BAR; PG8_SCHED;
            PG8_LDB(B1, 0, 1); PG8_STAGE(PG8_SB(0, 0), b2, voffB);
            PG8_BAR; PG8_WAIT_L(0); PG8_MMA(0, 1, At, B1); PG8_BAR;
            PG8_LDA(At, 0, 1); PG8_STAGE(PG8_SA(0, 0), a2, voffA);
            PG8_BAR; PG8_WAIT_L(0); PG8_MMA(1, 0, At, B0); PG8_BAR; PG8_SCHED;
            PG8_STAGE(PG8_SB(0, 1), b2 + hstep, voffB);
            PG8_WAIT_V(6); PG8_BAR; PG8_MMA(1, 1, At, B1); PG8_BAR;
            PG8_LDB(B0, 1, 0); PG8_SCHED; PG8_LDA(At, 1, 0); PG8_STAGE(PG8_SA(0, 1), a2 + hstep, voffA);
            PG8_WAIT_L(8); PG8_BAR; PG8_WAIT_L(0); PG8_MMA(0, 0, At, B0); PG8_BAR; PG8_SCHED;
            PG8_LDB(B1, 1, 1); PG8_STAGE(PG8_SB(1, 0), b3, voffB);
            PG8_BAR; PG8_WAIT_L(0); PG8_MMA(0, 1, At, B1); PG8_BAR;
            PG8_LDA(At, 1, 1); PG8_STAGE(PG8_SA(1, 0), a3, voffA);
            PG8_BAR; PG8_WAIT_L(0); PG8_MMA(1, 0, At, B0); PG8_BAR; PG8_SCHED;
            PG8_STAGE(PG8_SB(1, 1), b3 + hstep, voffB);
            PG8_WAIT_V(6); PG8_BAR; PG8_MMA(1, 1, At, B1); PG8_BAR;
            }
        }
        if constexpr (ALIGN_EPI) { if (wr == 0) PG8_BAR; }
        E(acc, cur, wr, wc, fr, fq);
        if (!has_next) break;
#pragma unroll
        for (int a = 0; a < 2; ++a)
#pragma unroll
            for (int b = 0; b < 2; ++b)
#pragma unroll
                for (int m = 0; m < 4; ++m)
#pragma unroll
                    for (int n = 0; n < 2; ++n) acc[a][b][m][n] = (f32x4){0.f, 0.f, 0.f, 0.f};
        cur = nxt; cA = nA; cB = nB; ++ui;
        if constexpr (ALIGN_EPI) { if (wr == 1) PG8_BAR; }
    }
    PG8_WAIT_V(0);
    if constexpr (!ALIGN_EPI) { if (wr == 0) PG8_BAR; }
    PG8_BAR;
#undef PG8_SA
#undef PG8_SB
#undef PG8_STAGE
#undef PG8_LDA
#undef PG8_LDB
#undef PG8_MMA
#undef PG8_WAIT_V
#undef PG8_WAIT_L
#undef PG8_BAR
#undef PG8_SCHED
}
}
using pg8::HALF;

DEVI u32x4 pack8(const f32x4& a, const f32x4& b) { u32x4 w; w.x = pk2(a[0], a[1]); w.y = pk2(a[2], a[3]); w.z = pk2(b[0], b[1]); w.w = pk2(b[2], b[3]); return w; }

struct EpiIn {
    static constexpr bool PERM = true, MID = false, AROW = false;
    const float* rowss; const float* shW; int job;
    bf16_t *d0, *d1, *d2, *d3, *d4; float* ba;
    DEVI void operator()(const f32x4 (&acc)[2][2][4][2], const pg8::Unit& u, int wr, int wc, int fr, int fq) const {
        asm volatile("" : "+v"(fr), "+v"(fq));
        const int vs = u.pm < 64 ? 0 : (u.pm < 128 ? 1 : 2);
        bf16_t* base; int pitch, colt; bool isba = false;
        if (job == 0) { base = d0; pitch = 3072; colt = u.pn * 256; if (u.pn >= 12) isba = true; }
        else {
            if (u.pn < 4) { base = d0; pitch = 1024; colt = u.pn * 256; }
            else if (u.pn < 8) { base = d1; pitch = 1024; colt = (u.pn - 4) * 256; }
            else if (u.pn == 8) { base = d2; pitch = 256; colt = 0; }
            else if (u.pn == 9) { base = d3; pitch = 256; colt = 0; }
            else { base = d4; pitch = 2048; colt = (u.pn - 10) * 256; }
        }
        const int ncol0 = u.pn * 256 + wc * 32 + 8 * fq;
        f32x4 sv[2][2];
#pragma unroll
        for (int bj = 0; bj < 2; ++bj)
#pragma unroll
            for (int n = 0; n < 2; ++n) sv[bj][n] = *(const f32x4*)(shW + vs * NSH + ncol0 + bj * HALF + 4 * n);
        const int row0 = u.pm * 256 + wr * 64 + fr;
#pragma unroll
        for (int ai = 0; ai < 2; ++ai)
#pragma unroll
            for (int m = 0; m < 4; ++m) {
                const int row = row0 + ai * HALF + m * 16;
                const float rs = rsqrtf(rowss[row] * (1.f / 1024.f) + EPS);
                if (!isba) {
                    bf16_t* rowp = base + (size_t)row * pitch + colt + wc * 32 + 8 * fq;
#pragma unroll
                    for (int bj = 0; bj < 2; ++bj) { const f32x4 v0 = acc[ai][bj][m][0] * rs + sv[bj][0], v1 = acc[ai][bj][m][1] * rs + sv[bj][1]; *(u32x4*)(rowp + bj * HALF) = pack8(v0, v1); }
                } else if (wc == 0) {
                    float* rowp = ba + (size_t)row * 32 + 8 * fq;
                    *(f32x4*)(rowp) = acc[ai][0][m][0] * rs + sv[0][0]; *(f32x4*)(rowp + 4) = acc[ai][0][m][1] * rs + sv[0][1];
                }
            }
    }
};
struct TailOrder { int idx; __device__ bool next(int i, pg8::Unit& u) const { if (i == 0 && idx >= 0 && idx < 4) { u.pm = idx >> 1; u.pn = idx & 1; return true; } return false; } };
struct EpiCtxKV {
    static constexpr bool PERM = true, MID = false, AROW = false;
    const float* rowss; const float* shW; bf16_t* kat; bf16_t* vat;
    DEVI void operator()(const f32x4 (&acc)[2][2][4][2], const pg8::Unit& u, int wr, int wc, int fr, int fq) const {
        asm volatile("" : "+v"(fr), "+v"(fq));
        bf16_t* base = (u.pn == 0 ? kat : vat);
        const int ncol0 = u.pn * 256 + wc * 32 + 8 * fq;
#pragma unroll
        for (int bj = 0; bj < 2; ++bj) {
            const f32x4 sv0 = *(const f32x4*)(shW + ncol0 + bj * HALF), sv1 = *(const f32x4*)(shW + ncol0 + bj * HALF + 4);
#pragma unroll
            for (int ai = 0; ai < 2; ++ai)
#pragma unroll
                for (int m = 0; m < 4; ++m) { const int row = u.pm * 256 + ai * HALF + wr * 64 + m * 16 + fr;
                    const float rs = rsqrtf(rowss[row] * (1.f / 1024.f) + EPS);
                    *(u32x4*)(base + (size_t)row * 256 + wc * 32 + 8 * fq + bj * HALF) = pack8(acc[ai][bj][m][0] * rs + sv0, acc[ai][bj][m][1] * rs + sv1); }
        }
    }
};
struct EpiBr {
    static constexpr bool PERM = true, MID = true, AROW = false;
    const bf16_t* mg; bf16_t* out;
    DEVI void mid(f32x4 (&acc)[2][2][4][2], const pg8::Unit& u, int wr, int wc, int fr, int fq) const {
        asm volatile("" : "+v"(fr), "+v"(fq));
        const int row0 = u.pm * 256 + wr * 64 + fr, col0 = u.pn * 256 + wc * 32 + 8 * fq;
#pragma unroll
        for (int ai = 0; ai < 2; ++ai)
#pragma unroll
            for (int m = 0; m < 4; ++m) {
                const bf16_t* rp = mg + (size_t)(row0 + ai * HALF + m * 16) * 2048 + col0;
#pragma unroll
                for (int bj = 0; bj < 2; ++bj) {
                    const u32x4 gd = *(const u32x4*)(rp + bj * HALF), ga = *(const u32x4*)(rp + 1024 + bj * HALF);
                    float r[8];
#pragma unroll
                    for (int i = 0; i < 4; ++i) {
                        const float d0 = bflo(gd[i]), d1 = bfhi(gd[i]), a0 = bflo(ga[i]), a1 = bfhi(ga[i]);
                        r[2 * i] = (1.f + __expf(fminf(-a0, 80.f))) * __builtin_amdgcn_rcpf(1.f + __expf(fminf(-d0, 80.f)));
                        r[2 * i + 1] = (1.f + __expf(fminf(-a1, 80.f))) * __builtin_amdgcn_rcpf(1.f + __expf(fminf(-d1, 80.f)));
                    }
                    acc[ai][bj][m][0] *= (f32x4){r[0], r[1], r[2], r[3]}; acc[ai][bj][m][1] *= (f32x4){r[4], r[5], r[6], r[7]};
                    asm volatile("" ::: "memory");
                }
            }
    }
    DEVI void operator()(const f32x4 (&acc)[2][2][4][2], const pg8::Unit& u, int wr, int wc, int fr, int fq) const {
        asm volatile("" : "+v"(fr), "+v"(fq));
        const int row0 = u.pm * 256 + wr * 64 + fr, col0 = u.pn * 256 + wc * 32 + 8 * fq;
#pragma unroll
        for (int ai = 0; ai < 2; ++ai)
#pragma unroll
            for (int m = 0; m < 4; ++m) {
                const size_t row = (size_t)(row0 + ai * HALF + m * 16);
                const bf16_t* rp = mg + row * 2048 + 1024 + col0;
#pragma unroll
                for (int bj = 0; bj < 2; ++bj) {
                    const u32x4 ga = *(const u32x4*)(rp + bj * HALF);
                    float s[8];
#pragma unroll
                    for (int i = 0; i < 4; ++i) { s[2 * i] = __builtin_amdgcn_rcpf(1.f + __expf(fminf(-bflo(ga[i]), 80.f))); s[2 * i + 1] = __builtin_amdgcn_rcpf(1.f + __expf(fminf(-bfhi(ga[i]), 80.f))); }
                    const f32x4 v0 = acc[ai][bj][m][0] * (f32x4){s[0], s[1], s[2], s[3]}, v1 = acc[ai][bj][m][1] * (f32x4){s[4], s[5], s[6], s[7]};
                    *(u32x4*)(out + row * 1024 + col0 + bj * HALF) = pack8(v0, v1);
                }
            }
    }
};
struct EpiOut {
    static constexpr bool PERM = false, MID = false, AROW = false;
    const float* x; const float* modacc; const float* bada; const float* nwf; float* out; bf16_t* x1s; float* rowss2;
    DEVI void operator()(const f32x4 (&acc)[2][2][4][2], const pg8::Unit& u, int wr, int wc, int fr, int fq) const {
        asm volatile("" : "+v"(fr), "+v"(fq));
        const int b = u.pm >> 6; const int row0 = u.pm * 256 + wr * 64 + fr, col0 = u.pn * 256 + wc * 32 + 4 * fq;
        f32x4 ga[2][2], sc[2][2];
#pragma unroll
        for (int bj = 0; bj < 2; ++bj)
#pragma unroll
            for (int n = 0; n < 2; ++n) { const int c = col0 + bj * HALF + n * 16;
                ga[bj][n] = *(const f32x4*)(modacc + b * 6144 + 2048 + c) + *(const f32x4*)(bada + 2048 + c);
                sc[bj][n] = (*(const f32x4*)(modacc + b * 6144 + 4096 + c) + *(const f32x4*)(bada + 4096 + c) + 1.f) * *(const f32x4*)(nwf + c); }
#pragma unroll
        for (int ai = 0; ai < 2; ++ai)
#pragma unroll
            for (int m = 0; m < 4; ++m) {
                const size_t off = (size_t)(row0 + ai * HALF + m * 16) * 1024 + col0; float ss = 0.f;
#pragma unroll
                for (int bj = 0; bj < 2; ++bj)
#pragma unroll
                    for (int n = 0; n < 2; ++n) {
                        const f32x4 xv = *(const f32x4*)(x + off + bj * HALF + n * 16);
                        const f32x4 o = xv + ga[bj][n] * acc[ai][bj][m][n];
                        *(f32x4*)(out + off + bj * HALF + n * 16) = o;
                        ss += (o[0] * o[0] + o[1] * o[1]) + (o[2] * o[2] + o[3] * o[3]);
                        const f32x4 s = o * sc[bj][n]; u32x2 w; w.x = pk2(s[0], s[1]); w.y = pk2(s[2], s[3]);
                        *(u32x2*)(x1s + off + (size_t)(b * (RB - SEQ) + 1) * 1024 + bj * HALF + n * 16) = w;
                    }
                ss += __shfl_xor(ss, 16); ss += __shfl_xor(ss, 32);
                if (fq == 0) atomicAdd(rowss2 + row0 + ai * HALF + m * 16, ss);
            }
    }
};
DEVI f32x4 dpp_ror1(const f32x4& x) { f32x4 r;
#pragma unroll
    for (int i = 0; i < 4; ++i) r[i] = __int_as_float(__builtin_amdgcn_update_dpp(0, __float_as_int(x[i]), 0x121, 0xf, 0xf, false));
    return r; }
DEVI f32x4 dpp_rol1(const f32x4& x) { f32x4 r;
#pragma unroll
    for (int i = 0; i < 4; ++i) r[i] = __int_as_float(__builtin_amdgcn_update_dpp(0, __float_as_int(x[i]), 0x12F, 0xf, 0xf, false));
    return r; }
struct EpiUpConv {
    static constexpr bool PERM = true, MID = false, AROW = true;
    const float* rowss2; const float* shWf; const float* cw; const float* cb; bf16_t* act; LAS float* xb;
    DEVI int arow(int pm) const { const int b = pm / TPB, i = pm - b * TPB; return b * RB + 254 * i; }
    DEVI void operator()(f32x4 (&acc)[2][2][4][2], const pg8::Unit& u, int wr, int wc, int fr, int fq) const {
        asm volatile("" : "+v"(fr), "+v"(fq));
        const int b = u.pm / TPB, ti = u.pm - b * TPB, tok0 = 254 * ti - 1;
        const int cl0 = wc * 32 + 8 * fq;
#pragma unroll
        for (int bj = 0; bj < 2; ++bj) {
            const f32x4 sv0 = *(const f32x4*)(shWf + b * NUP + u.pn * 256 + bj * HALF + cl0), sv1 = *(const f32x4*)(shWf + b * NUP + u.pn * 256 + bj * HALF + cl0 + 4);
#pragma unroll
            for (int ai = 0; ai < 2; ++ai)
#pragma unroll
                for (int m = 0; m < 4; ++m) {
                    const int tok = tok0 + ai * HALF + wr * 64 + m * 16 + fr; const bool ok = tok >= 0 && tok < SEQ;
                    const float rs = ok ? rsqrtf(rowss2[b * SEQ + (ok ? tok : 0)] * (1.f / 1024.f) + EPS) : 0.f;
                    acc[ai][bj][m][0] = ok ? acc[ai][bj][m][0] * rs + sv0 : (f32x4){0.f, 0.f, 0.f, 0.f};
                    acc[ai][bj][m][1] = ok ? acc[ai][bj][m][1] * rs + sv1 : (f32x4){0.f, 0.f, 0.f, 0.f};
                }
        }
#pragma unroll
        for (int ai = 0; ai < 2; ++ai) { const int blk = 2 * ai + wr;
#pragma unroll
            for (int bj = 0; bj < 2; ++bj)
#pragma unroll
                for (int n = 0; n < 2; ++n) {
                    if (fr == 0) *(LAS f32x4*)(xb + (blk * 2 + 0) * 256 + bj * HALF + cl0 + 4 * n) = acc[ai][bj][0][n];
                    if (fr == 15) *(LAS f32x4*)(xb + (blk * 2 + 1) * 256 + bj * HALF + cl0 + 4 * n) = acc[ai][bj][3][n];
                } }
        asm volatile("s_waitcnt lgkmcnt(0)" ::: "memory"); __builtin_amdgcn_s_barrier(); asm volatile("" ::: "memory");
        const int f0 = u.pn * 128 + cl0;
#pragma unroll
        for (int n = 0; n < 2; ++n) {
            f32x4 wg[3], wv[3];
#pragma unroll
            for (int j = 0; j < 3; ++j) { wg[j] = *(const f32x4*)(cw + j * NUP + f0 + 4 * n); wv[j] = *(const f32x4*)(cw + j * NUP + DFF + f0 + 4 * n); }
            const f32x4 bgv = *(const f32x4*)(cb + f0 + 4 * n), bvv = *(const f32x4*)(cb + DFF + f0 + 4 * n);
#pragma unroll
            for (int ai = 0; ai < 2; ++ai) { const int blk = 2 * ai + wr;
                const f32x4 pgx = *(const LAS f32x4*)(xb + (((blk + 3) & 3) * 2 + 1) * 256 + cl0 + 4 * n), pvx = *(const LAS f32x4*)(xb + (((blk + 3) & 3) * 2 + 1) * 256 + HALF + cl0 + 4 * n);
                const f32x4 ngx = *(const LAS f32x4*)(xb + (((blk + 1) & 3) * 2 + 0) * 256 + cl0 + 4 * n), nvx = *(const LAS f32x4*)(xb + (((blk + 1) & 3) * 2 + 0) * 256 + HALF + cl0 + 4 * n);
#pragma unroll
                for (int m = 0; m < 4; ++m) {
                    f32x4 ug, uv;
                    { const f32x4 c = acc[ai][0][m][n], up = m > 0 ? acc[ai][0][m > 0 ? m - 1 : 0][n] : pgx, dn = m < 3 ? acc[ai][0][m < 3 ? m + 1 : 3][n] : ngx;
                      f32x4 pr = dpp_ror1(fr == 15 ? up : c), nx = dpp_rol1(fr == 0 ? dn : c);
                      asm volatile("" : "+v"(pr), "+v"(nx));
                      ug = bgv + wg[0] * pr + wg[1] * c + wg[2] * nx; }
                    { const f32x4 c = acc[ai][1][m][n], up = m > 0 ? acc[ai][1][m > 0 ? m - 1 : 0][n] : pvx, dn = m < 3 ? acc[ai][1][m < 3 ? m + 1 : 3][n] : nvx;
                      f32x4 pr = dpp_ror1(fr == 15 ? up : c), nx = dpp_rol1(fr == 0 ? dn : c);
                      asm volatile("" : "+v"(pr), "+v"(nx));
                      uv = bvv + wv[0] * pr + wv[1] * c + wv[2] * nx; }
                    const int r = ai * HALF + wr * 64 + m * 16 + fr, tok = tok0 + r;
                    if (r >= 1 && r <= 254 && tok < SEQ) {
                        u32x2 w; w.x = pk2(siluf(ug[0]) * uv[0], siluf(ug[1]) * uv[1]); w.y = pk2(siluf(ug[2]) * uv[2], siluf(ug[3]) * uv[3]);
                        *(u32x2*)(act + (size_t)(b * SEQ + tok) * DFF + f0 + 4 * n) = w; }
                    asm volatile("" ::: "memory");
                }
            }
        }
    }
};
struct EpiDown {
    static constexpr bool PERM = false, MID = false, AROW = false;
    const float* modacc; const float* bada; float* out;
    DEVI void operator()(const f32x4 (&acc)[2][2][4][2], const pg8::Unit& u, int wr, int wc, int fr, int fq) const {
        asm volatile("" : "+v"(fr), "+v"(fq));
        const int b = u.pm >> 6; const int row0 = u.pm * 256 + wr * 64 + fr, col0 = u.pn * 256 + wc * 32 + 4 * fq;
        f32x4 gf[2][2];
#pragma unroll
        for (int bj = 0; bj < 2; ++bj)
#pragma unroll
            for (int n = 0; n < 2; ++n) { const int c = col0 + bj * HALF + n * 16; gf[bj][n] = *(const f32x4*)(modacc + b * 6144 + 5120 + c) + *(const f32x4*)(bada + 5120 + c); }
#pragma unroll
        for (int ai = 0; ai < 2; ++ai)
#pragma unroll
            for (int m = 0; m < 4; ++m) {
                const size_t off = (size_t)(row0 + ai * HALF + m * 16) * 1024 + col0;
#pragma unroll
                for (int bj = 0; bj < 2; ++bj)
#pragma unroll
                    for (int n = 0; n < 2; ++n) { float* p = out + off + bj * HALF + n * 16; *(f32x4*)p = *(const f32x4*)p + gf[bj][n] * acc[ai][bj][m][n]; }
            }
    }
};

DEVI void transpose_item(const float* W, int srcN, int k0, int n0, bf16_t* dst  , int dstK, LAS float* scr, int lane) {
#pragma unroll
    for (int i = 0; i < 8; ++i) { const int kk = 8 * i + (lane >> 3), n4 = (lane & 7) * 4; const f32x4 v = *(const f32x4*)(W + (size_t)(k0 + kk) * srcN + n0 + n4);
        LAS float* d = scr + kk * 33 + n4; d[0] = v[0]; d[1] = v[1]; d[2] = v[2]; d[3] = v[3]; }
    asm volatile("s_waitcnt lgkmcnt(0)" ::: "memory");
    const int c = lane & 7;
#pragma unroll
    for (int j = 0; j < 4; ++j) { const int n = (lane >> 3) + 8 * j; const LAS float* s = scr + (8 * c) * 33 + n;
        u32x4 o; o.x = pk2(s[0 * 33], s[1 * 33]); o.y = pk2(s[2 * 33], s[3 * 33]); o.z = pk2(s[4 * 33], s[5 * 33]); o.w = pk2(s[6 * 33], s[7 * 33]);
        *(u32x4*)(dst + (size_t)n * dstK + 8 * c) = o; }
    asm volatile("s_waitcnt lgkmcnt(0)" ::: "memory");
}
DEVI void phase0(const KA& a, LAS unsigned char* lds, int tid, int lane, int wave) {
    unsigned char* ws = a.ws();
    bf16_t* WinA = (bf16_t*)(ws + WS_WINA); bf16_t* WinC = (bf16_t*)(ws + WS_WINC); bf16_t* Wbr = (bf16_t*)(ws + WS_WBR);
    bf16_t* Wout = (bf16_t*)(ws + WS_WOUT); bf16_t* Wup = (bf16_t*)(ws + WS_WUP); bf16_t* Wdn = (bf16_t*)(ws + WS_WDN);
    LAS float* scr = (LAS float*)(lds + wave * 16384);
    const int gw = blockIdx.x * 8 + wave, NGW = gridDim.x * 8;
    constexpr int I_IN = 16 * 241, I_BR = 16 * 32, I_UP = 16 * 176, I_DN = 44 * 32;
    constexpr int NITEMS = I_IN + 3 * I_BR + I_UP + I_DN;
    for (int it = gw; it < NITEMS; it += NGW) {
        int r = it;
        if (r < I_IN) { const int kb = r / 241, nb = r % 241, c0 = nb * 32; bf16_t* d; int row;
            if (c0 < 3072) { d = WinA; row = c0; } else if (c0 < 4096) { d = WinC; row = c0 - 3072; } else if (c0 == 4096) { d = WinA; row = 3072; }
            else if (c0 < 5152) { d = WinC; row = 1024 + (c0 - 4128); } else if (c0 < 5408) { d = WinC; row = 2048 + (c0 - 5152); }
            else if (c0 < 5664) { d = WinC; row = 2304 + (c0 - 5408); } else { d = WinC; row = 2560 + (c0 - 5664); }
            transpose_item(a.in(8), 7712, kb * 64, c0, d + (size_t)row * 1024 + kb * 64, 1024, scr, lane); continue; }
        r -= I_IN;
        if (r < I_BR) { const int kb = r / 32, nb = r % 32; transpose_item(a.in(16), 1024, kb * 64, nb * 32, Wbr + (size_t)(nb * 32) * 2048 + kb * 64, 2048, scr, lane); continue; }
        r -= I_BR;
        if (r < I_BR) { const int kb = r / 32, nb = r % 32; transpose_item(a.in(17), 1024, kb * 64, nb * 32, Wbr + (size_t)(nb * 32) * 2048 + 1024 + kb * 64, 2048, scr, lane); continue; }
        r -= I_BR;
        if (r < I_BR) { const int kb = r / 32, nb = r % 32; transpose_item(a.in(18), 1024, kb * 64, nb * 32, Wout + (size_t)(nb * 32) * 1024 + kb * 64, 1024, scr, lane); continue; }
        r -= I_BR;
        if (r < I_UP) { const int kb = r / 176, nb = r % 176, c0 = nb * 32; int row;
            if (c0 < DFF) row = 256 * (c0 / 128) + (c0 % 128); else { const int c1 = c0 - DFF; row = 256 * (c1 / 128) + 128 + (c1 % 128); }
            transpose_item(a.in(19), NUP, kb * 64, c0, Wup + (size_t)row * 1024 + kb * 64, 1024, scr, lane); continue; }
        r -= I_UP;
        { const int kb = r / 32, nb = r % 32; transpose_item(a.in(22), 1024, kb * 64, nb * 32, Wdn + (size_t)(nb * 32) * DFF + kb * 64, DFF, scr, lane); }
    }
    float* modacc = (float*)(ws + CTL_MODACC);
    for (int it = blockIdx.x; it < 12 * 16; it += gridDim.x) {
        const int cb = it % 12, ks = it / 12, n = cb * 512 + tid;
        float a0 = 0.f, a1 = 0.f, a2 = 0.f;
#pragma unroll 8
        for (int k = ks * 64; k < ks * 64 + 64; ++k) {
            const float w = a.in(4)[(size_t)k * 6144 + n];
            a0 += siluf(a.in(1)[k]) * w; a1 += siluf(a.in(1)[1024 + k]) * w; a2 += siluf(a.in(3)[k]) * w;
        }
        atomicAdd(modacc + n, a0); atomicAdd(modacc + 6144 + n, a1); atomicAdd(modacc + 12288 + n, a2);
    }
    float* rope = (float*)(ws + SM_ROPE);
    for (int i = blockIdx.x * 512 + tid; i < 320 * 32; i += gridDim.x * 512) {
        const int p = i >> 5, f = i & 31; const float inv = powf(10000.f, -(float)f / 32.f);
        if (p < 256) { const float ang = (float)p * inv; rope[p * 32 + f] = cosf(ang); rope[8192 + p * 32 + f] = sinf(ang); }
        else { const int q = p - 256; const float ang = (float)q * inv; rope[16384 + q * 32 + f] = cosf(ang); rope[16384 + 2048 + q * 32 + f] = sinf(ang); }
    }
}

DEVI void phase1(const KA& a, int tid, int lane, int wave) {
    unsigned char* ws = a.ws();
    const float* modacc = (const float*)(ws + CTL_MODACC); const float* bada = a.in(5);
    bf16_t* XN = (bf16_t*)(ws + WS_XN); float* rowss1 = (float*)(ws + SM_ROWSS1);
    const int gw = blockIdx.x * 8 + wave, NGW = gridDim.x * 8;
    {
        const int per = (MT + NGW - 1) / NGW, rbeg = gw * per, rend = rbeg + per < MT ? rbeg + per : MT;
        int vcur = -1; f32x4 sc[4];
        for (int row = rbeg; row < rend; row += 2) {
            const int vs = row < SEQ ? 0 : (row < ML ? 1 : 2);
            if (vs != vcur) { vcur = vs;
#pragma unroll
                for (int j = 0; j < 4; ++j) { const int c = 4 * lane + 256 * j; sc[j] = (*(const f32x4*)(modacc + vs * 6144 + 1024 + c) + *(const f32x4*)(bada + 1024 + c) + 1.f) * *(const f32x4*)(a.in(6) + c); } }
            const int row1 = row + 1; const bool two = row1 < rend && (row1 < SEQ ? 0 : (row1 < ML ? 1 : 2)) == vs;
            const float* xr0 = row < ML ? a.in(0) + (size_t)row * 1024 : a.in(2) + (size_t)(row - ML) * 1024;
            const float* xr1 = two ? (row1 < ML ? a.in(0) + (size_t)row1 * 1024 : a.in(2) + (size_t)(row1 - ML) * 1024) : xr0;
            f32x4 v0[4], v1[4];
#pragma unroll
            for (int j = 0; j < 4; ++j) { v0[j] = *(const f32x4*)(xr0 + 4 * lane + 256 * j); v1[j] = *(const f32x4*)(xr1 + 4 * lane + 256 * j); }
            float s0 = 0.f, s1 = 0.f;
#pragma unroll
            for (int j = 0; j < 4; ++j) { const int c = 4 * lane + 256 * j;
                s0 += (v0[j][0] * v0[j][0] + v0[j][1] * v0[j][1]) + (v0[j][2] * v0[j][2] + v0[j][3] * v0[j][3]);
                s1 += (v1[j][0] * v1[j][0] + v1[j][1] * v1[j][1]) + (v1[j][2] * v1[j][2] + v1[j][3] * v1[j][3]);
                const f32x4 o0 = v0[j] * sc[j], o1 = v1[j] * sc[j];
                u32x2 w; w.x = pk2(o0[0], o0[1]); w.y = pk2(o0[2], o0[3]); *(u32x2*)(XN + (size_t)row * 1024 + c) = w;
                if (two) { u32x2 w1; w1.x = pk2(o1[0], o1[1]); w1.y = pk2(o1[2], o1[3]); *(u32x2*)(XN + (size_t)row1 * 1024 + c) = w1; } }
            s0 = wave_sum(s0); s1 = wave_sum(s1);
            if (lane == 0) { rowss1[row] = s0; if (two) rowss1[row1] = s1; }
            if (!two) --row;
        }
    }
    const bf16_t* WinA = (const bf16_t*)(ws + WS_WINA); const bf16_t* WinC = (const bf16_t*)(ws + WS_WINC); const bf16_t* Wup = (const bf16_t*)(ws + WS_WUP);
    float* shWa = (float*)(ws + SM_SHWA); float* shWf = (float*)(ws + SM_SHWF);
    for (int n = gw; n < NSH + NUP; n += NGW) {
        const bool isf = n >= NSH;
        const bf16_t* wrow = isf ? Wup + (size_t)(n - NSH) * 1024 : (n < NA ? WinA + (size_t)n * 1024 : WinC + (size_t)(n - NA) * 1024);
        const int shoff = isf ? 3072 : 0;
        float s0 = 0.f, s1 = 0.f, s2 = 0.f;
#pragma unroll
        for (int h = 0; h < 2; ++h) {
            const int k0 = h * 512 + lane * 8;
            const u32x4 w = *(const u32x4*)(wrow + k0);
#pragma unroll
            for (int i = 0; i < 4; ++i) {
                const float wl = bflo(w[i]), wh = bfhi(w[i]); const int k = k0 + 2 * i;
                const float b0 = bada[shoff + k], b1 = bada[shoff + k + 1];
                s0 += (modacc[shoff + k] + b0) * wl + (modacc[shoff + k + 1] + b1) * wh;
                s1 += (modacc[6144 + shoff + k] + b0) * wl + (modacc[6144 + shoff + k + 1] + b1) * wh;
                s2 += (modacc[12288 + shoff + k] + b0) * wl + (modacc[12288 + shoff + k + 1] + b1) * wh;
            }
        }
        s0 = wave_sum(s0); s1 = wave_sum(s1); s2 = wave_sum(s2);
        if (lane == 0) {
            if (isf) { shWf[n - NSH] = s0; shWf[NUP + n - NSH] = s1; }
            else { shWa[n] = s0; shWa[NSH + n] = s1; shWa[2 * NSH + n] = s2; }
        }
    }
}

DEVI u32x4 ldrow_(const bf16_t* base, int seq_start, int seq_len, int tt) {
    const int tc = tt < 0 ? 0 : (tt >= seq_len ? seq_len - 1 : tt);
    const u32x4 v = *(const u32x4*)(base + (size_t)(seq_start + tc) * 3072);
    const unsigned m = (tt == tc) ? 0xffffffffu : 0u;
    return (u32x4){v[0] & m, v[1] & m, v[2] & m, v[3] & m};
}
DEVI void phase_dnprep(const KA& a, int tid) {
    unsigned char* ws = a.ws();
    const bf16_t* QR = (const bf16_t*)(ws + WS_QKVR); bf16_t* QP = (bf16_t*)(ws + WS_QKVP);
    const float* convw = a.in(9); const float* ba = (const float*)(ws + WS_BA);
    float* gb = (float*)(ws + WS_G); float* bb = (float*)(ws + WS_BETA);
    const int cgp = tid & 127, strip = tid >> 7;
    u32x4 cur[20], nxt[20];
#define PREP_GEOM(it_, seq_start_, t0_, seq_len_, col_) const int cidx_ = (it_) / 3, sec_ = (it_) - cidx_ * 3; int seq_start_, t0_, seq_len_; \
        if (cidx_ < 512) { seq_start_ = (cidx_ >> 8) * SEQ; t0_ = (cidx_ & 255) * 64; seq_len_ = SEQ; } \
        else { const int c2_ = cidx_ - 512; seq_start_ = ML + (c2_ >> 2) * CTX; t0_ = (c2_ & 3) * 64; seq_len_ = CTX; } \
        const int col_ = sec_ * 1024 + cgp * 8;
#define PREP_LOAD(dst, it_) do { PREP_GEOM(it_, ss_, t0__, sl_, cl_) const int tb_ = t0__ + strip * 16; \
        _Pragma("unroll") for (int r = 0; r < 20; ++r) dst[r] = ldrow_(QR + cl_, ss_, sl_, tb_ + r - 2); } while (0)
    if ((int)blockIdx.x < 520 * 3) PREP_LOAD(cur, (int)blockIdx.x);
    for (int it = blockIdx.x; it < 520 * 3; it += gridDim.x) {
        if (it + (int)gridDim.x < 520 * 3) PREP_LOAD(nxt, it + (int)gridDim.x);
        PREP_GEOM(it, seq_start, t0, seq_len, col)
        const int sec = sec_;
        f32x4 w0[5], w1[5];
#pragma unroll
        for (int j = 0; j < 5; ++j) { w0[j] = *(const f32x4*)(convw + j * 3072 + col); w1[j] = *(const f32x4*)(convw + j * 3072 + col + 4); }
        const int tb = t0 + strip * 16;
#pragma unroll
        for (int r = 0; r < 16; ++r) {
            f32x4 acc0 = {0.f, 0.f, 0.f, 0.f}, acc1 = {0.f, 0.f, 0.f, 0.f};
#pragma unroll
            for (int j = 0; j < 5; ++j) { const u32x4 x = cur[r + j];
                acc0 += (f32x4){bflo(x[0]), bfhi(x[0]), bflo(x[1]), bfhi(x[1])} * w0[j];
                acc1 += (f32x4){bflo(x[2]), bfhi(x[2]), bflo(x[3]), bfhi(x[3])} * w1[j]; }
            float y[8];
#pragma unroll
            for (int i = 0; i < 4; ++i) { y[i] = siluf(acc0[i]); y[4 + i] = siluf(acc1[i]); }
            if (sec < 2) {
                float ss = 0.f;
#pragma unroll
                for (int i = 0; i < 8; ++i) ss += y[i] * y[i];
                ss += __shfl_xor(ss, 1); ss += __shfl_xor(ss, 2); ss += __shfl_xor(ss, 4); ss += __shfl_xor(ss, 8);
                const float sc = rsqrtf(ss + EPS) * (sec == 0 ? 0.08838834764831845f : 1.f);
#pragma unroll
                for (int i = 0; i < 8; ++i) y[i] *= sc;
            }
            u32x4 o; o.x = pk2(y[0], y[1]); o.y = pk2(y[2], y[3]); o.z = pk2(y[4], y[5]); o.w = pk2(y[6], y[7]);
            *(u32x4*)(QP + (size_t)(seq_start + tb + r) * 3072 + col) = o;
        }
        if (sec == 0) {
#pragma unroll
            for (int q = 0; q < 2; ++q) {
                const int e = tid + q * 512, r = e >> 4, idx = e & 15, row = seq_start + t0 + r;
                const float bv = ba[(size_t)row * 32 + idx], av = ba[(size_t)row * 32 + 16 + idx];
                const float xs = av + a.in(11)[idx];
                const float sp = fmaxf(xs, 0.f) + log1pf(expf(-fabsf(xs)));
                const float g = -expf(a.in(10)[idx]) * sp;
                const int dir = idx >> 3, h = idx & 7;
                gb[((size_t)dir * MT + row) * 8 + h] = g;
                bb[((size_t)dir * MT + row) * 8 + h] = 1.f / (1.f + expf(-bv));
            }
        }
#pragma unroll
        for (int r = 0; r < 20; ++r) cur[r] = nxt[r];
    }
#undef PREP_LOAD
#undef PREP_GEOM
}

DEVI void phase_dnscan(const KA& a, int lane, int wave) {
    unsigned char* ws = a.ws();
    const bf16_t* QP = (const bf16_t*)(ws + WS_QKVP);
    const float* gb = (const float*)(ws + WS_G); const float* bb = (const float*)(ws + WS_BETA);
    bf16_t* Of = (bf16_t*)a.out(); bf16_t* Ob = Of + (size_t)ML * 1024;
    const int gw = blockIdx.x * 8 + wave, NGW = gridDim.x * 8;
    for (int item = gw; item < 2048; item += NGW) {
        const int chain = item >> 6, ep = item & 63, dir = chain >> 4, b = (chain >> 3) & 1, h = chain & 7;
        bf16_t* O = dir ? Ob : Of;
        float S00 = 0.f, S01 = 0.f, S10 = 0.f, S11 = 0.f;
        const int NTOK = CTX + SEQ;
        constexpr int U = 4;
        unsigned kq[U], qq[U], vv[U]; float gg[U], be[U]; int rows[U];
        auto rowof = [&](int s) -> int { if (s < CTX) { const int t = dir ? CTX - 1 - s : s; return ML + b * CTX + t; } const int t2 = s - CTX; const int t = dir ? SEQ - 1 - t2 : t2; return b * SEQ + t; };
#define SC_LOAD(i, s) do { const int row_ = rowof(s); rows[i] = row_; const bf16_t* p_ = QP + (size_t)row_ * 3072 + h * 128; \
        qq[i] = *(const unsigned*)(p_ + 2 * lane); kq[i] = *(const unsigned*)(p_ + 1024 + 2 * lane); vv[i] = *(const unsigned*)(p_ + 2048 + 2 * ep); \
        gg[i] = gb[((size_t)dir * MT + row_) * 8 + h]; be[i] = bb[((size_t)dir * MT + row_) * 8 + h]; } while (0)
        for (int s0 = 0; s0 < NTOK; s0 += U) {
#pragma unroll
            for (int i = 0; i < U; ++i) SC_LOAD(i, s0 + i);
#pragma unroll
            for (int i = 0; i < U; ++i) {
                const float k0 = bflo(kq[i]), k1 = bfhi(kq[i]), q0 = bflo(qq[i]), q1 = bfhi(qq[i]), v0 = bflo(vv[i]), v1 = bfhi(vv[i]);
                const float eg = __expf(gg[i]), bt = be[i];
                float p0 = k0 * S00 + k1 * S10, p1 = k0 * S01 + k1 * S11;
                p0 = wave_sum(p0); p1 = wave_sum(p1);
                const float vn0 = bt * (v0 - eg * p0), vn1 = bt * (v1 - eg * p1);
                S00 = eg * S00 + k0 * vn0; S01 = eg * S01 + k0 * vn1; S10 = eg * S10 + k1 * vn0; S11 = eg * S11 + k1 * vn1;
                float o0 = q0 * S00 + q1 * S10, o1 = q0 * S01 + q1 * S11;
                o0 = wave_sum(o0); o1 = wave_sum(o1);
                if (lane == 0 && rows[i] < ML) *(unsigned*)(O + (size_t)rows[i] * 1024 + h * 128 + 2 * ep) = pk2(o0, o1);
            }
        }
#undef SC_LOAD
    }
}

DEVI bf16x8 ld_b128(LAS const unsigned char* p) { return *(LAS const bf16x8*)p; }
DEVI bf16x8 ld_2b64(LAS const unsigned char* p0, LAS const unsigned char* p1) { const u32x2 a = *(LAS const u32x2*)p0, b = *(LAS const u32x2*)p1; u32x4 w = {a.x, a.y, b.x, b.y}; return __builtin_bit_cast(bf16x8, w); }
DEVI bf16x8 pack_frag(const f32x4& lo, const f32x4& hi) { u32x4 w = {pk2(lo[0], lo[1]), pk2(lo[2], lo[3]), pk2(hi[0], hi[1]), pk2(hi[2], hi[3])}; return __builtin_bit_cast(bf16x8, w); }
#define MFMA16(A, B, C) __builtin_amdgcn_mfma_f32_16x16x32_bf16(A, B, C, 0, 0, 0)
DEVI void phase_dnchunk(const KA& a, LAS unsigned char* lds, int tid, int lane, int wave) {
    unsigned char* ws = a.ws();
    const bf16_t* QP = (const bf16_t*)(ws + WS_QKVP); const float* gb = (const float*)(ws + WS_G); const float* bb = (const float*)(ws + WS_BETA);
    bf16_t* TQ = (bf16_t*)(ws + WS_TQ); float* AV = (float*)(ws + WS_AVEC);
    constexpr int KL = 0, QL = 17408, KKF = 34816, QKF = 52224, VEC = 131072;
    const int fr = lane & 15, g = lane >> 4, d = wave >> 2, wq = wave & 3;
    LAS unsigned char* dbase = lds + d * 64512;
    LAS float* Gg = (LAS float*)(lds + VEC); LAS float* Bv = Gg + 128; LAS float* GC = Gg + 256;
    for (int item = blockIdx.x; item < 520 * 8; item += gridDim.x) {
        const int cidx = item >> 3, h = item & 7;
        const int row0 = cidx < 512 ? cidx * 64 : ML + (cidx - 512) * 64;
#pragma unroll
        for (int i = 0; i < 2; ++i) { const int c = tid + i * 512, r = c >> 4, ch = c & 15;
            const bf16_t* src = QP + (size_t)(row0 + r) * 3072 + h * 128 + ch * 8;
            *(LAS u32x4*)(lds + QL + r * 272 + ch * 16) = *(const u32x4*)src; *(LAS u32x4*)(lds + KL + r * 272 + ch * 16) = *(const u32x4*)(src + 1024); }
        if (tid < 128) { const int dd = tid >> 6, pos = tid & 63; Gg[tid] = gb[((size_t)dd * MT + row0 + pos) * 8 + h]; Bv[tid] = bb[((size_t)dd * MT + row0 + pos) * 8 + h]; }
        __syncthreads();
        if (wave < 2) {
            const int dd = wave, pos = dd ? 63 - lane : lane; float x = Gg[dd * 64 + pos];
#pragma unroll
            for (int o = 1; o < 64; o <<= 1) { const float y = __shfl_up(x, o); if (lane >= o) x += y; }
            const float total = __shfl(x, 63);
            GC[dd * 64 + pos] = x;
            float* av = AV + ((size_t)item * 2 + dd) * 256;
            av[pos] = __expf(x); av[64 + pos] = Bv[dd * 64 + pos]; av[128 + pos] = __expf(total - x); if (lane == 0) av[192] = __expf(total);
        }
        {
            const int src = d ? QL : KL;
            f32x4 acc[4] = {{0.f, 0.f, 0.f, 0.f}, {0.f, 0.f, 0.f, 0.f}, {0.f, 0.f, 0.f, 0.f}, {0.f, 0.f, 0.f, 0.f}};
#pragma unroll
            for (int s4 = 0; s4 < 4; ++s4) { const bf16x8 A = ld_b128(lds + src + (16 * wq + fr) * 272 + (32 * s4 + 8 * g) * 2);
#pragma unroll
                for (int jt = 0; jt < 4; ++jt) { const bf16x8 Bf = ld_b128(lds + KL + (16 * jt + fr) * 272 + (32 * s4 + 8 * g) * 2); acc[jt] = MFMA16(A, Bf, acc[jt]); } }
            LAS float* dst = (LAS float*)(lds + (d ? QKF : KKF));
#pragma unroll
            for (int jt = 0; jt < 4; ++jt)
#pragma unroll
                for (int r = 0; r < 4; ++r) dst[(16 * wq + 4 * g + r) * 68 + 16 * jt + fr] = acc[jt][r];
        }
        __syncthreads();
        f32x4 P[4], qd[4];
        {
            const LAS float* kkf = (const LAS float*)(lds + KKF); const LAS float* qkf = (const LAS float*)(lds + QKF);
            float gci[4], bei[4];
#pragma unroll
            for (int r = 0; r < 4; ++r) { gci[r] = GC[d * 64 + 16 * wq + 4 * g + r]; bei[r] = Bv[d * 64 + 16 * wq + 4 * g + r]; }
#pragma unroll
            for (int jt = 0; jt < 4; ++jt) { const int j = 16 * jt + fr; const float gcj = GC[d * 64 + j];
#pragma unroll
                for (int r = 0; r < 4; ++r) { const int i = 16 * wq + 4 * g + r; const bool incl = d ? (i <= j) : (i >= j);
                    const float e = incl ? __expf(gci[r] - gcj) : 0.f;
                    qd[jt][r] = qkf[i * 68 + j] * e; P[jt][r] = (i != j) ? -bei[r] * kkf[i * 68 + j] * e : 0.f; } }
        }
        __syncthreads();
        {
#pragma unroll
            for (int jt = 0; jt < 4; ++jt) {
#pragma unroll
                for (int r = 0; r < 4; ++r) { const int i = 16 * wq + 4 * g + r, j = 16 * jt + fr;
                    *(LAS unsigned short*)(dbase + 0 + i * 144 + j * 2) = (unsigned short)f2bf(P[jt][r]);
                    *(LAS unsigned short*)(dbase + 36864 + 9216 + i * 144 + j * 2) = (unsigned short)f2bf(P[jt][r]);
                    *(LAS unsigned short*)(dbase + 55296 + i * 144 + j * 2) = (unsigned short)f2bf(qd[jt][r]); }
                u32x2 w = {pk2(P[jt][0], P[jt][1]), pk2(P[jt][2], P[jt][3])};
                *(LAS u32x2*)(dbase + 18432 + (16 * jt + fr) * 144 + (16 * wq + 4 * g) * 2) = w; }
        }
        __syncthreads();
        int cur = 0;
#pragma unroll 1
        for (int it = 0; it < 5; ++it) {
            LAS unsigned char* NRc = dbase + cur * 9216; LAS unsigned char* NTc = dbase + 18432 + cur * 9216;
            LAS unsigned char* NRn = dbase + (cur ^ 1) * 9216; LAS unsigned char* NTn = dbase + 18432 + (cur ^ 1) * 9216;
            LAS unsigned char* PRo = dbase + 36864 + ((it + 1) & 1) * 9216; LAS unsigned char* PRn = dbase + 36864 + (it & 1) * 9216;
            f32x4 n2[4] = {{0.f, 0.f, 0.f, 0.f}, {0.f, 0.f, 0.f, 0.f}, {0.f, 0.f, 0.f, 0.f}, {0.f, 0.f, 0.f, 0.f}};
#pragma unroll
            for (int s2 = 0; s2 < 2; ++s2) { const bf16x8 A = ld_b128(NRc + (16 * wq + fr) * 144 + (32 * s2 + 8 * g) * 2);
#pragma unroll
                for (int jt = 0; jt < 4; ++jt) { const bf16x8 Bf = ld_b128(NTc + (16 * jt + fr) * 144 + (32 * s2 + 8 * g) * 2); n2[jt] = MFMA16(A, Bf, n2[jt]); } }
#pragma unroll
            for (int jt = 0; jt < 4; ++jt) {
#pragma unroll
                for (int r = 0; r < 4; ++r) *(LAS unsigned short*)(NRn + (16 * wq + 4 * g + r) * 144 + (16 * jt + fr) * 2) = (unsigned short)f2bf(n2[jt][r]);
                u32x2 w = {pk2(n2[jt][0], n2[jt][1]), pk2(n2[jt][2], n2[jt][3])};
                *(LAS u32x2*)(NTn + (16 * jt + fr) * 144 + (16 * wq + 4 * g) * 2) = w;
                P[jt] += n2[jt]; }
            __syncthreads();
#pragma unroll
            for (int s2 = 0; s2 < 2; ++s2) { const bf16x8 A = ld_b128(PRo + (16 * wq + fr) * 144 + (32 * s2 + 8 * g) * 2);
#pragma unroll
                for (int jt = 0; jt < 4; ++jt) { const bf16x8 Bf = ld_b128(NTn + (16 * jt + fr) * 144 + (32 * s2 + 8 * g) * 2); P[jt] = MFMA16(A, Bf, P[jt]); } }
#pragma unroll
            for (int jt = 0; jt < 4; ++jt)
#pragma unroll
                for (int r = 0; r < 4; ++r) *(LAS unsigned short*)(PRn + (16 * wq + 4 * g + r) * 144 + (16 * jt + fr) * 2) = (unsigned short)f2bf(P[jt][r]);
            cur ^= 1;
        }
        __syncthreads();
        {
            bf16_t* dst = TQ + ((size_t)item * 2 + d) * 8192; const int t2 = tid & 255;
#pragma unroll
            for (int k = 0; k < 4; ++k) { const int c = t2 + 256 * k, mat = c >> 9, r = (c >> 3) & 63, ch = c & 7;
                const u32x4 v = *(LAS const u32x4*)(dbase + (mat ? 55296 : 36864) + r * 144 + ch * 16);
                *(u32x4*)(dst + mat * 4096 + r * 64 + ch * 8) = v; }
        }
        __syncthreads();
    }
}

DEVI void phase_dnchunk2(const KA& a, LAS unsigned char* lds, int tid, int lane, int wave) {
    unsigned char* ws = a.ws();
    const bf16_t* QP = (const bf16_t*)(ws + WS_QKVP); const float* gb = (const float*)(ws + WS_G); const float* bb = (const float*)(ws + WS_BETA);
    bf16_t* TQ = (bf16_t*)(ws + WS_TQ); float* AV = (float*)(ws + WS_AVEC);
    const int fr = lane & 15, g = lane >> 4, wi = wave >> 1, dir = wave & 1;
    LAS unsigned char* kl = lds + wi * 32768;
    LAS float* vec = (LAS float*)(lds + 131072 + wave * 1024);
    for (int grp = blockIdx.x; grp < 1040; grp += gridDim.x) {
        int tl = tid; asm volatile("" : "+v"(tl));
#pragma unroll
        for (int i = 0; i < 16; ++i) { const int c = tl + 512 * i, it = c >> 11, qk = (c >> 10) & 1, r = (c >> 4) & 63, ch = c & 15;
            const int item_ = grp * 4 + it, ci_ = item_ >> 3, h_ = item_ & 7; const int row0_ = ci_ < 512 ? ci_ * 64 : ML + (ci_ - 512) * 64;
            const u32x4 x = *(const u32x4*)(QP + (size_t)(row0_ + r) * 3072 + qk * 1024 + h_ * 128 + ch * 8);
            *(LAS u32x4*)(lds + it * 32768 + (qk ? 0 : 16384) + r * 256 + ((ch ^ (r & 15)) << 4)) = x; }
        const int item = grp * 4 + wi, cidx = item >> 3, h = item & 7;
        const int row0 = cidx < 512 ? cidx * 64 : ML + (cidx - 512) * 64;
        {
            const int pos = dir ? 63 - lane : lane;
            float x = gb[((size_t)dir * MT + row0 + pos) * 8 + h]; const float be = bb[((size_t)dir * MT + row0 + pos) * 8 + h];
#pragma unroll
            for (int o = 1; o < 64; o <<= 1) { const float y = __shfl_up(x, o); if (lane >= o) x += y; }
            const float total = __shfl(x, 63);
            vec[pos] = x; vec[64 + pos] = be;
            float* av = AV + ((size_t)item * 2 + dir) * 256;
            av[pos] = __expf(x); av[64 + pos] = be; av[128 + pos] = __expf(total - x); if (lane == 0) av[192] = __expf(total);
        }
        __syncthreads();
        bf16_t* tq = TQ + ((size_t)item * 2 + dir) * 8192;
        bf16x8 KF[4][4];
#pragma unroll
        for (int t = 0; t < 4; ++t)
#pragma unroll
            for (int ks = 0; ks < 4; ++ks) KF[t][ks] = ld_b128(kl + (16 * t + fr) * 256 + (((4 * ks + g) ^ fr) << 4));
        {
            bf16x8 QF[4][4];
#pragma unroll
            for (int t = 0; t < 4; ++t)
#pragma unroll
                for (int ks = 0; ks < 4; ++ks) QF[t][ks] = ld_b128(kl + 16384 + (16 * t + fr) * 256 + (((4 * ks + g) ^ fr) << 4));
#pragma unroll
            for (int rt = 0; rt < 4; ++rt)
#pragma unroll
                for (int ct = 0; ct < 4; ++ct) { f32x4 acc = {0.f, 0.f, 0.f, 0.f};
#pragma unroll
                    for (int ks = 0; ks < 4; ++ks) acc = MFMA16(KF[rt][ks], QF[ct][ks], acc);
                    float o[4]; const f32x4 gxv = *(const LAS f32x4*)(vec + 16 * rt + 4 * g); const float gyv = vec[16 * ct + fr];
#pragma unroll
                    for (int r = 0; r < 4; ++r) { const int x = 16 * rt + 4 * g + r, y = 16 * ct + fr; const bool inc = dir ? (y <= x) : (y >= x);
                        o[r] = inc ? acc[r] * __expf(gyv - gxv[r]) : 0.f; }
                    const u32x2 w = {pk2(o[0], o[1]), pk2(o[2], o[3])};
                    *(u32x2*)(tq + 4096 + (16 * ct + fr) * 64 + 16 * rt + 4 * g) = w; }
        }
        f32x4 PT[4][4]; bf16x8 XD[2][4], XT[2][4];
#pragma unroll
        for (int ct = 0; ct < 4; ++ct)
#pragma unroll
            for (int s2 = 0; s2 < 2; ++s2) { f32x4 nd[2], nt[2];
#pragma unroll
                for (int u = 0; u < 2; ++u) { const int rt = 2 * s2 + u; f32x4 acc = {0.f, 0.f, 0.f, 0.f};
#pragma unroll
                    for (int ks = 0; ks < 4; ++ks) acc = MFMA16(KF[rt][ks], KF[ct][ks], acc);
                    const f32x4 gxv = *(const LAS f32x4*)(vec + 16 * rt + 4 * g), bxv = *(const LAS f32x4*)(vec + 64 + 16 * rt + 4 * g); const float gyv = vec[16 * ct + fr], byv = vec[64 + 16 * ct + fr];
#pragma unroll
                    for (int r = 0; r < 4; ++r) { const int x = 16 * rt + 4 * g + r, y = 16 * ct + fr;
                        const bool cd = dir ? (x < y) : (x > y), ct_ = dir ? (y < x) : (y > x);
                        nd[u][r] = cd ? -bxv[r] * acc[r] * __expf(gxv[r] - gyv) : 0.f;
                        nt[u][r] = ct_ ? -byv * acc[r] * __expf(gyv - gxv[r]) : 0.f; }
                    PT[rt][ct] = nt[u]; }
                XD[s2][ct] = pack_frag(nd[0], nd[1]); XT[s2][ct] = pack_frag(nt[0], nt[1]); }
#pragma unroll 1
        for (int it = 0; it < 5; ++it) {
            bf16x8 XD2[2][4], XT2[2][4];
#pragma unroll
            for (int ct = 0; ct < 4; ++ct)
#pragma unroll
                for (int s2 = 0; s2 < 2; ++s2) { f32x4 t2[2];
#pragma unroll
                    for (int u = 0; u < 2; ++u) { const int rt = 2 * s2 + u; f32x4 acc = {0.f, 0.f, 0.f, 0.f};
                        acc = MFMA16(XT[0][rt], XD[0][ct], acc); acc = MFMA16(XT[1][rt], XD[1][ct], acc); t2[u] = acc; }
                    XD2[s2][ct] = pack_frag(t2[0], t2[1]); }
#pragma unroll
            for (int ct = 0; ct < 4; ++ct) { const bf16x8 pb0 = pack_frag(PT[0][ct], PT[1][ct]), pb1 = pack_frag(PT[2][ct], PT[3][ct]);
#pragma unroll
                for (int rt = 0; rt < 4; ++rt) { f32x4 acc = PT[rt][ct]; acc = MFMA16(XD2[0][rt], pb0, acc); acc = MFMA16(XD2[1][rt], pb1, acc); PT[rt][ct] = acc; } }
#pragma unroll
            for (int ct = 0; ct < 4; ++ct)
#pragma unroll
                for (int s2 = 0; s2 < 2; ++s2) { f32x4 t2[2];
#pragma unroll
                    for (int u = 0; u < 2; ++u) { const int rt = 2 * s2 + u; f32x4 acc = {0.f, 0.f, 0.f, 0.f};
                        acc = MFMA16(XD[0][rt], XT[0][ct], acc); acc = MFMA16(XD[1][rt], XT[1][ct], acc); t2[u] = acc; PT[rt][ct] += acc; }
                    XT2[s2][ct] = pack_frag(t2[0], t2[1]); }
#pragma unroll
            for (int s2 = 0; s2 < 2; ++s2)
#pragma unroll
                for (int ct = 0; ct < 4; ++ct) { XD[s2][ct] = XD2[s2][ct]; XT[s2][ct] = XT2[s2][ct]; }
        }
#pragma unroll
        for (int rt = 0; rt < 4; ++rt)
#pragma unroll
            for (int ct = 0; ct < 4; ++ct) { const u32x2 w = {pk2(PT[rt][ct][0], PT[rt][ct][1]), pk2(PT[rt][ct][2], PT[rt][ct][3])};
                *(u32x2*)(tq + (16 * ct + fr) * 64 + 16 * rt + 4 * g) = w; }
        __syncthreads();
    }
}

DEVI void st_wt8(bf16_t* p, unsigned lo, unsigned hi) { __hip_atomic_store((GAS unsigned long long*)p, (unsigned long long)lo | ((unsigned long long)hi << 32), __ATOMIC_RELAXED, __HIP_MEMORY_SCOPE_AGENT); }
DEVI void st_wt4(float* p, float v) { __hip_atomic_store((GAS unsigned*)p, __float_as_uint(v), __ATOMIC_RELAXED, __HIP_MEMORY_SCOPE_AGENT); }
DEVI void dnchunk_item(const KA& a, LAS float* vec, int cidx, int h, int dir, int lane_) {
    unsigned char* ws = a.ws();
    const bf16_t* QP = (const bf16_t*)(ws + WS_QKVP); const float* gb = (const float*)(ws + WS_G); const float* bb = (const float*)(ws + WS_BETA);
    bf16_t* TQ = (bf16_t*)(ws + WS_TQ); float* AV = (float*)(ws + WS_AVEC);
    int lane = lane_; asm volatile("" : "+v"(lane));
    const int fr = lane & 15, g = lane >> 4;
    const int item = cidx * 8 + h;
    const int row0 = cidx < 512 ? cidx * 64 : ML + (cidx - 512) * 64;
    const bf16_t* kb = QP + (size_t)(row0 + fr) * 3072 + 1024 + h * 128 + g * 8;
    bf16x8 KF[4][4];
#pragma unroll
    for (int t = 0; t < 4; ++t)
#pragma unroll
        for (int ks = 0; ks < 4; ++ks) KF[t][ks] = *(const bf16x8*)(kb + (size_t)t * 16 * 3072 + ks * 32);
    {
        const int pos = dir ? 63 - lane : lane;
        float x = gb[((size_t)dir * MT + row0 + pos) * 8 + h]; const float be = bb[((size_t)dir * MT + row0 + pos) * 8 + h];
#pragma unroll
        for (int o = 1; o < 64; o <<= 1) { const float y = __shfl_up(x, o); if (lane >= o) x += y; }
        const float total = __shfl(x, 63);
        vec[pos] = x; vec[64 + pos] = be;
        float* av = AV + ((size_t)item * 2 + dir) * 256;
        st_wt4(av + pos, __expf(x)); st_wt4(av + 64 + pos, be); st_wt4(av + 128 + pos, __expf(total - x)); if (lane == 0) st_wt4(av + 192, __expf(total));
    }
    asm volatile("s_waitcnt lgkmcnt(0)" ::: "memory");
    bf16_t* tq = TQ + ((size_t)item * 2 + dir) * 8192;
    {
        bf16x8 QF[4][4];
#pragma unroll
        for (int t = 0; t < 4; ++t)
#pragma unroll
            for (int ks = 0; ks < 4; ++ks) QF[t][ks] = *(const bf16x8*)(kb - 1024 + (size_t)t * 16 * 3072 + ks * 32);
#pragma unroll
        for (int rt = 0; rt < 4; ++rt)
#pragma unroll
            for (int ct = 0; ct < 4; ++ct) { f32x4 acc = {0.f, 0.f, 0.f, 0.f};
#pragma unroll
                for (int ks = 0; ks < 4; ++ks) acc = MFMA16(KF[rt][ks], QF[ct][ks], acc);
                float o[4]; const f32x4 gxv = *(const LAS f32x4*)(vec + 16 * rt + 4 * g); const float gyv = vec[16 * ct + fr];
#pragma unroll
                for (int r = 0; r < 4; ++r) { const int x = 16 * rt + 4 * g + r, y = 16 * ct + fr; const bool inc = dir ? (y <= x) : (y >= x);
                    o[r] = inc ? acc[r] * __expf(gyv - gxv[r]) : 0.f; }
                st_wt8(tq + 4096 + (16 * ct + fr) * 64 + 16 * rt + 4 * g, pk2(o[0], o[1]), pk2(o[2], o[3])); }
    }
    f32x4 PT[4][4]; bf16x8 XD[2][4], XT[2][4];
#pragma unroll
    for (int ct = 0; ct < 4; ++ct)
#pragma unroll
        for (int s2 = 0; s2 < 2; ++s2) { f32x4 nd[2], nt[2];
#pragma unroll
            for (int u = 0; u < 2; ++u) { const int rt = 2 * s2 + u; f32x4 acc = {0.f, 0.f, 0.f, 0.f};
#pragma unroll
                for (int ks = 0; ks < 4; ++ks) acc = MFMA16(KF[rt][ks], KF[ct][ks], acc);
                const f32x4 gxv = *(const LAS f32x4*)(vec + 16 * rt + 4 * g), bxv = *(const LAS f32x4*)(vec + 64 + 16 * rt + 4 * g); const float gyv = vec[16 * ct + fr], byv = vec[64 + 16 * ct + fr];
#pragma unroll
                for (int r = 0; r < 4; ++r) { const int x = 16 * rt + 4 * g + r, y = 16 * ct + fr;
                    const bool cd = dir ? (x < y) : (x > y), ct_ = dir ? (y < x) : (y > x);
                    nd[u][r] = cd ? -bxv[r] * acc[r] * __expf(gxv[r] - gyv) : 0.f;
                    nt[u][r] = ct_ ? -byv * acc[r] * __expf(gyv - gxv[r]) : 0.f; }
                PT[rt][ct] = nt[u]; }
            XD[s2][ct] = pack_frag(nd[0], nd[1]); XT[s2][ct] = pack_frag(nt[0], nt[1]); }
#pragma unroll 1
    for (int it = 0; it < 5; ++it) {
        bf16x8 XD2[2][4], XT2[2][4];
#pragma unroll
        for (int ct = 0; ct < 4; ++ct)
#pragma unroll
            for (int s2 = 0; s2 < 2; ++s2) { f32x4 t2[2];
#pragma unroll
                for (int u = 0; u < 2; ++u) { const int rt = 2 * s2 + u; f32x4 acc = {0.f, 0.f, 0.f, 0.f};
                    acc = MFMA16(XT[0][rt], XD[0][ct], acc); acc = MFMA16(XT[1][rt], XD[1][ct], acc); t2[u] = acc; }
                XD2[s2][ct] = pack_frag(t2[0], t2[1]); }
#pragma unroll
        for (int ct = 0; ct < 4; ++ct) { const bf16x8 pb0 = pack_frag(PT[0][ct], PT[1][ct]), pb1 = pack_frag(PT[2][ct], PT[3][ct]);
#pragma unroll
            for (int rt = 0; rt < 4; ++rt) { f32x4 acc = PT[rt][ct]; acc = MFMA16(XD2[0][rt], pb0, acc); acc = MFMA16(XD2[1][rt], pb1, acc); PT[rt][ct] = acc; } }
#pragma unroll
        for (int ct = 0; ct < 4; ++ct)
#pragma unroll
            for (int s2 = 0; s2 < 2; ++s2) { f32x4 t2[2];
#pragma unroll
                for (int u = 0; u < 2; ++u) { const int rt = 2 * s2 + u; f32x4 acc = {0.f, 0.f, 0.f, 0.f};
                    acc = MFMA16(XD[0][rt], XT[0][ct], acc); acc = MFMA16(XD[1][rt], XT[1][ct], acc); t2[u] = acc; PT[rt][ct] += acc; }
                XT2[s2][ct] = pack_frag(t2[0], t2[1]); }
#pragma unroll
        for (int s2 = 0; s2 < 2; ++s2)
#pragma unroll
            for (int ct = 0; ct < 4; ++ct) { XD[s2][ct] = XD2[s2][ct]; XT[s2][ct] = XT2[s2][ct]; }
    }
#pragma unroll
    for (int rt = 0; rt < 4; ++rt)
#pragma unroll
        for (int ct = 0; ct < 4; ++ct) st_wt8(tq + (16 * ct + fr) * 64 + 16 * rt + 4 * g, pk2(PT[rt][ct][0], PT[rt][ct][1]), pk2(PT[rt][ct][2], PT[rt][ct][3]));
    asm volatile("s_waitcnt vmcnt(0)" ::: "memory");
}

DEVI void phase_dnscan2(const KA& a, LAS unsigned char* lds, int tid, int lane, int wave, unsigned long long& pr_extra) {
    const int v = blockIdx.x;
    unsigned char* ws = a.ws();
    const bf16_t* QP = (const bf16_t*)(ws + WS_QKVP); const bf16_t* TQ = (const bf16_t*)(ws + WS_TQ); const float* AV = (const float*)(ws + WS_AVEC);
    constexpr int NSTEP = 260;
    int vrole = v;
#if MK_ONE_LAUNCH
    {
        unsigned* bar_ = (unsigned*)(ws + WS_CTL); unsigned* xr_ = (unsigned*)(ws + CTL_XRANK);
        bool dyn = gridDim.x == 256;
#pragma unroll
        for (int j = 0; j < 16; ++j) { const unsigned c_ = __hip_atomic_load(&bar_[256 + 64 * j], __ATOMIC_RELAXED, __HIP_MEMORY_SCOPE_AGENT); dyn = dyn && (c_ == (j < 8 ? 32u : 0u)); }
        if (PROBE_SUB == 7 && !dyn) pr_extra += 50000ull;
        if (dyn) {
            const unsigned xcc = (unsigned)__builtin_amdgcn_s_getreg((3 << 11) | 20) & 0xFu;
            LAS unsigned* bw = (LAS unsigned*)(lds + 147200);
            if (tid == 0) *bw = __hip_atomic_fetch_add(&xr_[xcc * 64], 1u, __ATOMIC_RELAXED, __HIP_MEMORY_SCOPE_AGENT);
            __syncthreads();
            const unsigned rank = *bw & 31u;
            vrole = rank < 16u ? (int)(xcc + 8u * (rank >> 2) + 32u * (rank & 3u)) : (int)(128u + xcc + 8u * ((rank - 16u) >> 2) + 32u * ((rank - 16u) & 3u));
            __syncthreads();
        }
    }
#endif
    GAS unsigned* rdy = (GAS unsigned*)(ws + CTL_RDY);
    {
        LAS float* vec = (LAS float*)(lds + 131072 + wave * 1024);
        const int npw = ((int)gridDim.x - 128) * 7;
        int it = vrole < 128 ? vrole * 8 + wave : 1024 + (vrole - 128) * 7 + wave;
        const unsigned long long tp0_ = (PROBE_SUB >= 8) ? __builtin_amdgcn_s_memrealtime() : 0ull;
        if (vrole >= 128 && wave == 7) {
            const int vp = vrole - 128, chain = (vp & 7) + 8 * ((vp >> 3) & 3), role = vp >> 5, dir = chain >> 4, b = (chain >> 3) & 1, h = chain & 7;
            const int nteam = ((int)gridDim.x - 128) >> 5;
            GAS unsigned* prog = (GAS unsigned*)(ws + CTL_PROG);
            constexpr int PFD2 = 6;
#pragma unroll 1
            for (int st = role; st < NSTEP; st += nteam) {
                unsigned spins = 0;
                while ((int)__builtin_amdgcn_readfirstlane((int)__hip_atomic_load(prog + chain * 64, __ATOMIC_RELAXED, __HIP_MEMORY_SCOPE_AGENT)) + PFD2 < st) { __builtin_amdgcn_s_sleep(8); if (++spins > (1u << 20)) break; }
                while (__builtin_amdgcn_readfirstlane((int)__hip_atomic_load(rdy + chain * 264 + st, __ATOMIC_RELAXED, __HIP_MEMORY_SCOPE_AGENT)) == 0) { __builtin_amdgcn_s_sleep(8); if (++spins > (1u << 20)) break; }
                asm volatile("" ::: "memory");
                int cidx; if (st < 4) cidx = 512 + b * 4 + (dir ? 3 - st : st); else { const int c = st - 4; cidx = b * 256 + (dir ? 255 - c : c); }
                const int row0 = cidx < 512 ? cidx * 64 : ML + (cidx - 512) * 64;
                const char* tqb = (const char*)(TQ + ((size_t)(cidx * 8 + h) * 2 + dir) * 8192); const char* avb = (const char*)(AV + ((size_t)(cidx * 8 + h) * 2 + dir) * 256);
                unsigned acc = 0;
#pragma unroll
                for (int j = 0; j < 9; ++j) { const int L = j * 64 + lane; const char* p_;
                    if (L < 384) { const int rw = L / 6, part = L - rw * 6; p_ = (const char*)(QP + (size_t)(row0 + rw) * 3072 + h * 128) + (part >> 1) * 2048 + (part & 1) * 128; }
                    else if (L < 512) p_ = tqb + (L - 384) * 128; else p_ = avb + ((L - 512) & 7) * 128;
                    acc ^= *(const unsigned*)p_; }
                asm volatile("" :: "v"(acc));
            }
        } else {
#pragma unroll 1
        while (it < NSTEP * 32) {
            const int s_ = it >> 5, ch_ = it & 31, dir_ = ch_ >> 4, b_ = (ch_ >> 3) & 1, h_ = ch_ & 7;
            int cidx_; if (s_ < 4) cidx_ = 512 + b_ * 4 + (dir_ ? 3 - s_ : s_); else { const int c_ = s_ - 4; cidx_ = b_ * 256 + (dir_ ? 255 - c_ : c_); }
            dnchunk_item(a, vec, cidx_, h_, dir_, lane);
            if (lane == 0) __hip_atomic_store(rdy + ch_ * 264 + s_, 1u, __ATOMIC_RELAXED, __HIP_MEMORY_SCOPE_AGENT);
            if (vrole < 128) break;
            it += npw;
        }
        }
        if (PROBE_SUB >= 8 && lane == 0) atomicMax((unsigned*)(ws + CTL_DBG) + (vrole < 128 ? 0 : 1), (unsigned)(__builtin_amdgcn_s_memrealtime() - tp0_));
        __syncthreads();
    }
    if (vrole < 128) {
    const int chain = (vrole & 7) + 8 * ((vrole >> 3) & 3), qt = vrole >> 5, dir = chain >> 4, b = (chain >> 3) & 1, h = chain & 7;
    bf16_t* O = (bf16_t*)a.out() + (size_t)dir * ML * 1024;
    const __amdgpu_buffer_rsrc_t hrs = __builtin_amdgcn_make_buffer_rsrc((void*)(ws + WS_TQ), (short)0, (int)(WS_AVEC + 16 * MiB - WS_TQ), 0x00020000);
    GAS unsigned* myrdy = rdy + chain * 264; GAS unsigned* prog = (GAS unsigned*)(ws + CTL_PROG);
    constexpr int KL = 0, QL = 16384, TL = 32768, DL = 40960, VL = 49152, AL = 53248, BUFB = 54272, OT = 2 * BUFB, SBX = OT + 8192, XBX = SBX + 16384, FLG = XBX + 4096;
    const int fr0 = lane & 15, g0 = lane >> 4, ltid = tid - 256;
    auto step_cidx = [&](int s) -> int { if (s < 4) return 512 + b * 4 + (dir ? 3 - s : s); const int c = s - 4; return b * 256 + (dir ? 255 - c : c); };
    struct LSet { u32x4 q[4], k[4], t[2], d[2], v, av; };
#define LD_ISSUE(R, s_) do { const int cidx_ = step_cidx(s_); const int row0_ = cidx_ < 512 ? cidx_ * 64 : ML + (cidx_ - 512) * 64; \
        const unsigned tqo_ = (unsigned)((cidx_ * 8 + h) * 2 + dir) * 16384u, avo_ = (unsigned)(WS_AVEC - WS_TQ) + (unsigned)((cidx_ * 8 + h) * 2 + dir) * 1024u; \
        int lt_ = ltid; asm volatile("" : "+v"(lt_)); \
        const bf16_t* pq_ = QP + (size_t)(row0_ + (lt_ >> 4)) * 3072 + h * 128 + (lt_ & 15) * 8; \
        const unsigned pt_ = tqo_ + (unsigned)((lt_ >> 3) * 64 + (lt_ & 7) * 8) * 2u; \
        _Pragma("unroll") for (int i = 0; i < 4; ++i) { R.q[i] = *(const u32x4*)(pq_ + (size_t)i * 16 * 3072); R.k[i] = *(const u32x4*)(pq_ + (size_t)i * 16 * 3072 + 1024); } \
        _Pragma("unroll") for (int i = 0; i < 2; ++i) { R.t[i] = __builtin_bit_cast(u32x4, __builtin_amdgcn_raw_buffer_load_b128(hrs, (int)(pt_ + i * 4096), 0, 16)); \
                                                        R.d[i] = __builtin_bit_cast(u32x4, __builtin_amdgcn_raw_buffer_load_b128(hrs, (int)(pt_ + 8192 + i * 4096), 0, 16)); } \
        R.v = *(const u32x4*)(QP + (size_t)(row0_ + (lt_ >> 2)) * 3072 + 2048 + h * 128 + qt * 32 + (lt_ & 3) * 8); \
        R.av = __builtin_bit_cast(u32x4, __builtin_amdgcn_raw_buffer_load_b128(hrs, (int)(avo_ + (unsigned)(lt_ & 63) * 16u), 0, 16)); } while (0)
#define RDY_POLL(s_) (((s_) < NSTEP) ? __hip_atomic_load(myrdy + (s_), __ATOMIC_RELAXED, __HIP_MEMORY_SCOPE_AGENT) : 1u)
#define RDY_WAIT(pf_, s_) do { if ((s_) < NSTEP && __builtin_amdgcn_readfirstlane((int)(pf_)) == 0) { unsigned sp_ = 0; const unsigned long long tq0_ = (PROBE_SUB >= 8) ? __builtin_amdgcn_s_memrealtime() : 0ull; \
        while (__builtin_amdgcn_readfirstlane((int)__hip_atomic_load(myrdy + (s_), __ATOMIC_RELAXED, __HIP_MEMORY_SCOPE_AGENT)) == 0) { __builtin_amdgcn_s_sleep(2); if (++sp_ > (1u << 22)) break; } \
        if (PROBE_SUB >= 8) { const unsigned dt_ = (unsigned)(__builtin_amdgcn_s_memrealtime() - tq0_); if ((s_) >= 4) spin_acc += dt_; else spin_first += dt_; } } \
        asm volatile("" ::: "memory"); } while (0)
#define LD_WRITE(R, bo_) do { int lt_ = ltid; asm volatile("" : "+v"(lt_)); LAS unsigned char* B_ = lds + (bo_); \
        const int chq_ = lt_ & 15, cht_ = lt_ & 7; \
        _Pragma("unroll") for (int i = 0; i < 4; ++i) { const int r = (lt_ >> 4) + 16 * i; const int o_ = r * 256 + ((chq_ ^ (4 * (r & 3) + ((r >> 3) & 3))) << 4); \
            *(LAS u32x4*)(B_ + QL + o_) = R.q[i]; *(LAS u32x4*)(B_ + KL + o_) = R.k[i]; } \
        _Pragma("unroll") for (int i = 0; i < 2; ++i) { const int r = (lt_ >> 3) + 32 * i; const int o_ = r * 128 + ((cht_ ^ (2 * ((r >> 3) & 3) + ((r >> 1) & 1))) << 4); \
            *(LAS u32x4*)(B_ + TL + o_) = R.t[i]; *(LAS u32x4*)(B_ + DL + o_) = R.d[i]; } \
        { const int r = lt_ >> 2; *(LAS u32x4*)(B_ + VL + r * 64 + (((lt_ & 3) ^ (2 * ((r >> 3) & 1))) << 4)) = R.v; } \
        if (lt_ < 64) *(LAS u32x4*)(B_ + AL + lt_ * 16) = R.av; } while (0)
#define OT_OUT(s_) do { const int cidx_ = step_cidx(s_); const int row0_ = cidx_ * 64; LAS const unsigned char* ot_ = lds + OT + ((s_) & 1) * 4096; \
        int lt_ = ltid; asm volatile("" : "+v"(lt_)); \
        { const int r = lt_ >> 2, ch = lt_ & 3; \
            *(u32x4*)(O + (size_t)(row0_ + r) * 1024 + h * 128 + qt * 32 + ch * 8) = *(LAS const u32x4*)(ot_ + r * 64 + ((ch ^ (2 * ((r >> 3) & 1))) << 4)); } } while (0)
#define STEP_BAR(wsel) do { const unsigned long long tb_ = PROBE_SUB ? __builtin_amdgcn_s_memrealtime() : 0ull; \
        asm volatile("s_waitcnt lgkmcnt(0)" ::: "memory"); __builtin_amdgcn_s_barrier(); asm volatile("" ::: "memory"); \
        if ((PROBE_SUB == 1 && wave == 0 && (wsel) == 0) || (PROBE_SUB == 2 && wave == 4 && (wsel) == 1) || (PROBE_SUB == 3 && wave == 2 && (wsel) == 3)) pr_extra += __builtin_amdgcn_s_memrealtime() - tb_; } while (0)
#define LOAD_STEP(s, RW, PU, PI) do { STEP_BAR(1); \
            if (ltid == 0) __hip_atomic_store(prog + chain * 64, (unsigned)((s) + 1), __ATOMIC_RELAXED, __HIP_MEMORY_SCOPE_AGENT); \
            { const unsigned long long tw_ = (PROBE_SUB == 5) ? __builtin_amdgcn_s_memrealtime() : 0ull; if ((s) + 1 < NSTEP) LD_WRITE(RW, (((s) + 1) & 1) * BUFB); \
              if (PROBE_SUB == 5 && wave == 4) { asm volatile("s_waitcnt lgkmcnt(0)" ::: "memory"); pr_extra += __builtin_amdgcn_s_memrealtime() - tw_; } } \
            PI = RDY_POLL((s) + 6); \
            if ((s) + 4 < NSTEP) { RDY_WAIT(PU, (s) + 4); LD_ISSUE(RW, (s) + 4); } \
            if ((s) >= 5) OT_OUT((s) - 1); } while (0)
#define LOAD_STEP_U(s, RW, PU, PI) do { STEP_BAR(1); \
            if (ltid == 0) __hip_atomic_store(prog + chain * 64, (unsigned)((s) + 1), __ATOMIC_RELAXED, __HIP_MEMORY_SCOPE_AGENT); \
            LD_WRITE(RW, (((s) + 1) & 1) * BUFB); \
            PI = __hip_atomic_load(myrdy + (s) + 6, __ATOMIC_RELAXED, __HIP_MEMORY_SCOPE_AGENT); \
            RDY_WAIT(PU, (s) + 4); LD_ISSUE(RW, (s) + 4); \
            OT_OUT((s) - 1); } while (0)
#define SBAR_() do {} while (0)
#define ROWK(pt) ((32 * ((pt) >> 1) + 4 * ((pt) & 1) + rowl) * 256)
#define ROWT(pt) ((32 * ((pt) >> 1) + 4 * ((pt) & 1) + rowl) * 128)
#define P0(pt) (32 * ((pt) >> 1) + 8 * g + 4 * ((pt) & 1))
#define LDK8(dst, base, pa) do { _Pragma("unroll") for (int s4 = 0; s4 < 4; ++s4) { dst[s4] = ld_b128(B + (base) + ROWK(pa) + (((4 * s4 + g) ^ fk) << 4)); dst[4 + s4] = ld_b128(B + (base) + ROWK((pa) + 1) + (((4 * s4 + g) ^ fk) << 4)); } } while (0)
#define LDT8(dst, base) do { _Pragma("unroll") for (int pt = 0; pt < 4; ++pt) { dst[2 * pt] = ld_b128(B + (base) + ROWT(pt) + ((g ^ ft) << 4)); dst[2 * pt + 1] = ld_b128(B + (base) + ROWT(pt) + (((4 + g) ^ ft) << 4)); } } while (0)
#define MM8(acc, fa, pa) do { _Pragma("unroll") for (int s4 = 0; s4 < 4; ++s4) { acc[pa] = MFMA16(fa[s4], Sb[s4], acc[pa]); acc[(pa) + 1] = MFMA16(fa[4 + s4], Sb[s4], acc[(pa) + 1]); } } while (0)
    if (wave >= 4) {
        LSet R0, R1, R2;
        unsigned pf0, pf1, pf2; unsigned spin_acc = 0, spin_first = 0; const unsigned long long tl0_ = (PROBE_SUB >= 8) ? __builtin_amdgcn_s_memrealtime() : 0ull;
        RDY_WAIT(0u, 0); LD_ISSUE(R0, 0); LD_WRITE(R0, 0); RDY_WAIT(0u, 1); LD_ISSUE(R1, 1); RDY_WAIT(0u, 2); LD_ISSUE(R2, 2); RDY_WAIT(0u, 3); LD_ISSUE(R0, 3);
        pf0 = RDY_POLL(4); pf1 = RDY_POLL(5); pf2 = 0u;
        LOAD_STEP(0, R1, pf0, pf2); LOAD_STEP(1, R2, pf1, pf0); LOAD_STEP(2, R0, pf2, pf1); LOAD_STEP(3, R1, pf0, pf2); LOAD_STEP(4, R2, pf1, pf0); LOAD_STEP(5, R0, pf2, pf1); LOAD_STEP(6, R1, pf0, pf2);
#pragma unroll 1
        for (int s0 = 7; s0 < NSTEP - 4; s0 += 3) {
            LOAD_STEP_U(s0, R2, pf1, pf0);
            LOAD_STEP_U(s0 + 1, R0, pf2, pf1);
            LOAD_STEP_U(s0 + 2, R1, pf0, pf2);
        }
        LOAD_STEP(NSTEP - 4, R2, pf1, pf0); LOAD_STEP(NSTEP - 3, R0, pf2, pf1); LOAD_STEP(NSTEP - 2, R1, pf0, pf2); LOAD_STEP(NSTEP - 1, R2, pf1, pf0);
        STEP_BAR(2);
        OT_OUT(NSTEP - 1);
        if (PROBE_SUB >= 8 && wave == 4 && lane == 0) { unsigned* dbg_ = (unsigned*)(ws + CTL_DBG); atomicMax(dbg_ + 2, spin_first); atomicMax(dbg_ + 3, spin_acc); atomicMax(dbg_ + 4, (unsigned)(__builtin_amdgcn_s_memrealtime() - tl0_)); }
    } else if (wave < 2) {
        __builtin_amdgcn_s_setprio(3);
        f32x4 S[8];
#pragma unroll
        for (int i = 0; i < 8; ++i) S[i] = (f32x4){0.f, 0.f, 0.f, 0.f};
        bf16x8 Sb[4];
#pragma unroll
        for (int s4 = 0; s4 < 4; ++s4) { Sb[s4] = (bf16x8){0, 0, 0, 0, 0, 0, 0, 0}; *(LAS bf16x8*)(lds + SBX + wave * 4096 + s4 * 1024 + lane * 16) = Sb[s4]; }
        if (lane == 0) *(LAS unsigned*)(lds + FLG + wave * 4) = 0u;
#pragma unroll 1
        for (int s = 0; s < NSTEP; ++s) {
            STEP_BAR(0);
            int fr = fr0, g = g0; asm volatile("" : "+v"(fr), "+v"(g));
            LAS const unsigned char* B = lds + (s & 1) * BUFB;
            const LAS float* avl = (const LAS float*)(B + AL);
            const int rowl = 8 * (fr >> 2) + (fr & 3);
            const int fk = 4 * (fr & 3) + (fr >> 2), ft = 2 * (fr >> 2) + ((fr >> 1) & 1);
            const int vcol = ((((2 * wave + (fr >> 3)) ^ (2 * (g & 1))) << 4) + (fr & 7) * 2);
            const int trq = fr >> 2, trp = fr & 3;
            LAS unsigned char* kp0 = (LAS unsigned char*)(B + KL + (8 * g + trq) * 256);
            const int fkt = 4 * trq + g;
#define KT_LOAD(dst, d0) do { _Pragma("unroll") for (int j = 0; j < 4; ++j) { const int dt_ = (d0) + j; const int co = (((4 * (dt_ >> 1) + trp) ^ fkt) << 4) + 8 * (dt_ & 1); \
                const s16x4 a0 = __builtin_bit_cast(s16x4, __builtin_amdgcn_ds_read_tr16_b64_v4i16((LAS s16x4*)(kp0 + co))), a1 = __builtin_bit_cast(s16x4, __builtin_amdgcn_ds_read_tr16_b64_v4i16((LAS s16x4*)(kp0 + co + 4 * 256))); \
                const s16x4 a2 = __builtin_bit_cast(s16x4, __builtin_amdgcn_ds_read_tr16_b64_v4i16((LAS s16x4*)(kp0 + co + 32 * 256))), a3 = __builtin_bit_cast(s16x4, __builtin_amdgcn_ds_read_tr16_b64_v4i16((LAS s16x4*)(kp0 + co + 36 * 256))); \
                dst[2 * j] = (bf16x8){a0[0], a0[1], a0[2], a0[3], a1[0], a1[1], a1[2], a1[3]}; dst[2 * j + 1] = (bf16x8){a2[0], a2[1], a2[2], a2[3], a3[0], a3[1], a3[2], a3[3]}; } } while (0)
            bf16x8 fA[8], fB[8], fC[8];
            f32x4 avp[4], bvp[4]; unsigned short vraw[4][4];
            const unsigned long long t6_ = (PROBE_SUB == 6) ? __builtin_amdgcn_s_memrealtime() : 0ull;
            LDK8(fA, KL, 0); LDK8(fB, KL, 2);
            if (PROBE_SUB == 6 && wave == 0) { asm volatile("s_waitcnt lgkmcnt(0)" ::: "memory"); pr_extra += __builtin_amdgcn_s_memrealtime() - t6_; }
#pragma unroll
            for (int pt = 0; pt < 4; ++pt) { avp[pt] = *(const LAS f32x4*)(avl + P0(pt)); bvp[pt] = *(const LAS f32x4*)(avl + 64 + P0(pt));
#pragma unroll
                for (int r = 0; r < 4; ++r) vraw[pt][r] = *(const LAS unsigned short*)(B + VL + (P0(pt) + r) * 64 + vcol); }
            f32x4 Z[4], X[4];
#pragma unroll
            for (int pt = 0; pt < 4; ++pt) Z[pt] = (f32x4){0.f, 0.f, 0.f, 0.f};
            SBAR_();
            LDT8(fC, TL); SBAR_(); MM8(Z, fA, 0); SBAR_();
            KT_LOAD(fA, 0); SBAR_(); MM8(Z, fB, 2); SBAR_();
#pragma unroll
            for (int pt = 0; pt < 4; ++pt)
#pragma unroll
                for (int r = 0; r < 4; ++r) Z[pt][r] = bvp[pt][r] * (bf2f(vraw[pt][r]) - avp[pt][r] * Z[pt][r]);
            KT_LOAD(fB, 4); SBAR_();
            { const bf16x8 Zb0 = pack_frag(Z[0], Z[1]), Zb1 = pack_frag(Z[2], Z[3]);
#pragma unroll
              for (int pt = 0; pt < 4; ++pt) { X[pt] = MFMA16(fC[2 * pt], Zb0, Z[pt]); X[pt] = MFMA16(fC[2 * pt + 1], Zb1, X[pt]); } }
            SBAR_();
            const float egl = avl[192];
            bf16x8 Xc0, Xc1;
            { const bf16x8 Xb0 = pack_frag(X[0], X[1]), Xb1 = pack_frag(X[2], X[3]);
              *(LAS bf16x8*)(lds + XBX + wave * 2048 + lane * 16) = Xb0; *(LAS bf16x8*)(lds + XBX + wave * 2048 + 1024 + lane * 16) = Xb1;
              if (lane == 0) *(LAS volatile unsigned*)(lds + FLG + wave * 4) = (unsigned)(s + 1);
              f32x4 cx[4];
#pragma unroll
              for (int pt = 0; pt < 4; ++pt) cx[pt] = X[pt] * *(const LAS f32x4*)(avl + 128 + P0(pt));
              Xc0 = pack_frag(cx[0], cx[1]); Xc1 = pack_frag(cx[2], cx[3]); }
            SBAR_();
#pragma unroll
            for (int j = 0; j < 4; ++j) { f32x4 sn = S[j] * egl; sn = MFMA16(fA[2 * j], Xc0, sn); S[j] = MFMA16(fA[2 * j + 1], Xc1, sn); }
            SBAR_();
#pragma unroll
            for (int j = 0; j < 4; ++j) { f32x4 sn = S[4 + j] * egl; sn = MFMA16(fB[2 * j], Xc0, sn); S[4 + j] = MFMA16(fB[2 * j + 1], Xc1, sn); }
#pragma unroll
            for (int s4 = 0; s4 < 4; ++s4) { Sb[s4] = pack_frag(S[2 * s4], S[2 * s4 + 1]); *(LAS bf16x8*)(lds + SBX + ((s + 1) & 1) * 8192 + wave * 4096 + s4 * 1024 + lane * 16) = Sb[s4]; }
#undef KT_LOAD
        }
        STEP_BAR(2);
        __builtin_amdgcn_s_setprio(0);
    } else {
        const int sl = wave - 2;
#pragma unroll 1
        for (int s = 0; s < NSTEP; ++s) {
            STEP_BAR(3);
            if (s >= 4) {
            int fr = fr0, g = g0; asm volatile("" : "+v"(fr), "+v"(g));
            LAS const unsigned char* B = lds + (s & 1) * BUFB;
            const LAS float* avl = (const LAS float*)(B + AL);
            const int rowl = 8 * (fr >> 2) + (fr & 3);
            const int fk = 4 * (fr & 3) + (fr >> 2), ft = 2 * (fr >> 2) + ((fr >> 1) & 1);
            const int vcol = ((((2 * sl + (fr >> 3)) ^ (2 * (g & 1))) << 4) + (fr & 7) * 2);
            bf16x8 fA[8], fB[8], fC[8], Sb[4];
            LDK8(fA, QL, 0); LDK8(fB, QL, 2);
#pragma unroll
            for (int s4 = 0; s4 < 4; ++s4) Sb[s4] = *(const LAS bf16x8*)(lds + SBX + (s & 1) * 8192 + sl * 4096 + s4 * 1024 + lane * 16);
            f32x4 OQ[4], avp[4];
#pragma unroll
            for (int pt = 0; pt < 4; ++pt) { OQ[pt] = (f32x4){0.f, 0.f, 0.f, 0.f}; avp[pt] = *(const LAS f32x4*)(avl + P0(pt)); }
            SBAR_();
            LDT8(fC, DL); SBAR_(); MM8(OQ, fA, 0); SBAR_(); MM8(OQ, fB, 2); SBAR_();
            { unsigned spins = 0;
              while ((unsigned)__builtin_amdgcn_readfirstlane((int)*(LAS volatile unsigned*)(lds + FLG + sl * 4)) != (unsigned)(s + 1)) { __builtin_amdgcn_s_sleep(1); if (++spins > (1u << 22)) break; } }
            asm volatile("" ::: "memory");
            const bf16x8 Xb0 = *(const LAS bf16x8*)(lds + XBX + sl * 2048 + lane * 16), Xb1 = *(const LAS bf16x8*)(lds + XBX + sl * 2048 + 1024 + lane * 16);
#pragma unroll
            for (int pt = 0; pt < 4; ++pt) { f32x4 o2 = OQ[pt] * avp[pt]; o2 = MFMA16(fC[2 * pt], Xb0, o2); OQ[pt] = MFMA16(fC[2 * pt + 1], Xb1, o2); }
            { LAS unsigned char* ot = lds + OT + (s & 1) * 4096;
#pragma unroll
              for (int pt = 0; pt < 4; ++pt)
#pragma unroll
                  for (int r = 0; r < 4; ++r) *(LAS unsigned short*)(ot + (P0(pt) + r) * 64 + vcol) = (unsigned short)f2bf(OQ[pt][r]); }
            }
        }
        STEP_BAR(2);
    }
#undef LDK8
#undef LDT8
#undef MM8
#undef ROWK
#undef ROWT
#undef P0
#undef SBAR_
#undef LOAD_STEP
#undef LOAD_STEP_U
#undef STEP_BAR
#undef LD_ISSUE
#undef RDY_POLL
#undef RDY_WAIT
#undef LD_WRITE
#undef OT_OUT
    }
}

DEVI void phase_prep2(const KA& a, int lane, int wave) {
    unsigned char* ws = a.ws();
    bf16_t* KAT = (bf16_t*)(ws + WS_KAT); const float* rope = (const float*)(ws + SM_ROPE); const float* knw = a.in(14);
    const int gw = blockIdx.x * 8 + wave, NGW = gridDim.x * 8;
    for (int row = gw; row < MT; row += NGW) {
        bf16_t* p = (row < ML ? KAT + (size_t)row * 256 : (bf16_t*)(ws + WS_CTXK) + (size_t)(row - ML) * 256) + lane * 4;
        const u32x2 w = *(const u32x2*)p;
        float x[4] = {bflo(w.x), bfhi(w.x), bflo(w.y), bfhi(w.y)};
        float ss = (x[0] * x[0] + x[1] * x[1]) + (x[2] * x[2] + x[3] * x[3]);
        ss += __shfl_xor(ss, 1); ss += __shfl_xor(ss, 2); ss += __shfl_xor(ss, 4); ss += __shfl_xor(ss, 8); ss += __shfl_xor(ss, 16);
        const float rs = rsqrtf(ss * (1.f / 128.f) + EPS);
        const int d = (lane & 31) * 4;
        const f32x4 nw = *(const f32x4*)(knw + d);
#pragma unroll
        for (int i = 0; i < 4; ++i) x[i] = x[i] * rs * nw[i];
        float pr[4];
#pragma unroll
        for (int i = 0; i < 4; ++i) pr[i] = __shfl_xor(x[i], 8);
        if (row < ML) {
            const int t = row & (SEQ - 1), lg = (lane & 31) >> 3, fi = (lane & 7) * 4;
            const float* ct = lg < 2 ? rope + (t >> 6) * 32 + fi : rope + 16384 + (t & 63) * 32 + fi;
            const float* st = lg < 2 ? ct + 8192 : ct + 2048;
            const f32x4 c = *(const f32x4*)ct, s = *(const f32x4*)st;
            const float sg = (lg & 1) ? 1.f : -1.f;
#pragma unroll
            for (int i = 0; i < 4; ++i) x[i] = x[i] * c[i] + sg * pr[i] * s[i];
        }
        u32x2 o; o.x = pk2(x[0], x[1]); o.y = pk2(x[2], x[3]);
        *(u32x2*)p = o;
    }
    const bf16_t* Of = (const bf16_t*)a.out(); const bf16_t* Ob = Of + (size_t)ML * 1024;
    const bf16_t* GT = (const bf16_t*)(ws + WS_GT); bf16_t* Y = (bf16_t*)(ws + WS_Y); const float* dnw = a.in(12);
    for (int row = gw; row < ML; row += NGW) {
        const int c0 = lane * 16;
        float o[16];
#pragma unroll
        for (int hh = 0; hh < 2; ++hh) {
            const u32x4 f = *(const u32x4*)(Of + (size_t)row * 1024 + c0 + hh * 8), bk = *(const u32x4*)(Ob + (size_t)row * 1024 + c0 + hh * 8);
#pragma unroll
            for (int i = 0; i < 4; ++i) { o[hh * 8 + 2 * i] = bflo(f[i]) + bflo(bk[i]); o[hh * 8 + 2 * i + 1] = bfhi(f[i]) + bfhi(bk[i]); }
        }
        float ss = 0.f;
#pragma unroll
        for (int i = 0; i < 16; ++i) ss += o[i] * o[i];
        ss += __shfl_xor(ss, 1); ss += __shfl_xor(ss, 2); ss += __shfl_xor(ss, 4);
        const float rs = rsqrtf(ss * (1.f / 128.f) + EPS);
        const int d0 = c0 & 127;
#pragma unroll
        for (int hh = 0; hh < 2; ++hh) {
            const u32x4 gt = *(const u32x4*)(GT + (size_t)row * 1024 + c0 + hh * 8);
            float y[8];
#pragma unroll
            for (int i = 0; i < 4; ++i) {
                y[2 * i] = o[hh * 8 + 2 * i] * rs * dnw[d0 + hh * 8 + 2 * i] * siluf(bflo(gt[i]));
                y[2 * i + 1] = o[hh * 8 + 2 * i + 1] * rs * dnw[d0 + hh * 8 + 2 * i + 1] * siluf(bfhi(gt[i]));
            }
            u32x4 w; w.x = pk2(y[0], y[1]); w.y = pk2(y[2], y[3]); w.z = pk2(y[4], y[5]); w.w = pk2(y[6], y[7]);
            *(u32x4*)(Y + (size_t)row * 2048 + c0 + hh * 8) = w;
        }
    }
}

namespace att {
constexpr int D = 128, NW = 8, QBLK = 32, KVBLK = 64;
constexpr float SCALE = 0.088388347648318440f;
constexpr float THR = 8.f;
constexpr int LDK = 256;
constexpr size_t SHM_V = KVBLK * D * 2, SHM_K = KVBLK * D * 2;
constexpr size_t OFF_WS = 2 * SHM_V + 2 * SHM_K, OFF_OST = OFF_WS + NW * 64 * 4;
#define KSWZ(row, colB) ((row) * 256 + ((colB) ^ (((row) & 7) << 4)))
#define SBAR() __builtin_amdgcn_sched_barrier(0)
DEVI int crow(int r, int hi) { return (r & 3) + 8 * (r >> 2) + 4 * hi; }
DEVI unsigned cvtpk(float lo, float hi) { unsigned r; asm volatile("v_cvt_pk_bf16_f32 %0, %1, %2" : "=v"(r) : "v"(lo), "v"(hi)); return r; }
DEVI void partialSM(f32x16& p0, f32x16& p1, float& m_reg, float& mn, float& alpha) {
    constexpr float C = SCALE * 1.4426950408889634f;
    float pmax = p0[0];
#pragma unroll
    for (int r = 1; r < 16; ++r) pmax = fmaxf(pmax, p0[r]);
#pragma unroll
    for (int r = 0; r < 16; ++r) pmax = fmaxf(pmax, p1[r]);
    { auto rr = __builtin_amdgcn_permlane32_swap(__float_as_uint(pmax), __float_as_uint(pmax), false, false);
      pmax = fmaxf(__uint_as_float(rr[0]), __uint_as_float(rr[1])); }
    if (__builtin_expect(__all(pmax - m_reg <= THR / SCALE), 1)) { mn = m_reg; alpha = 1.f; }
    else { mn = fmaxf(m_reg, pmax); alpha = __builtin_amdgcn_exp2f((m_reg - mn) * C); m_reg = mn; }
    const float mnC = -mn * C;
#pragma unroll
    for (int r = 0; r < 16; ++r) p0[r] = fmaf(p0[r], C, mnC);
#pragma unroll
    for (int r = 0; r < 16; ++r) p1[r] = fmaf(p1[r], C, mnC);
#pragma unroll
    for (int r = 0; r < 16; ++r) p0[r] = __builtin_amdgcn_exp2f(p0[r]);
}
DEVI void finishSM(f32x16& p0, f32x16& p1, float alpha, float& l_reg, bf16x8& pa0, bf16x8& pa1, bf16x8& pa2, bf16x8& pa3) {
#pragma unroll
    for (int r = 0; r < 16; ++r) p1[r] = __builtin_amdgcn_exp2f(p1[r]);
    float ps = 0;
#pragma unroll
    for (int r = 0; r < 16; ++r) ps += p0[r];
#pragma unroll
    for (int r = 0; r < 16; ++r) ps += p1[r];
    { auto rr = __builtin_amdgcn_permlane32_swap(__float_as_uint(ps), __float_as_uint(ps), false, false);
      ps = __uint_as_float(rr[0]) + __uint_as_float(rr[1]); }
    l_reg = l_reg * alpha + ps;
#define PK4(P, BASE, OUT) do { unsigned a0 = cvtpk(P[BASE + 0], P[BASE + 1]), a1 = cvtpk(P[BASE + 2], P[BASE + 3]);   \
    unsigned b0 = cvtpk(P[BASE + 4], P[BASE + 5]), b1 = cvtpk(P[BASE + 6], P[BASE + 7]);                              \
    auto r0 = __builtin_amdgcn_permlane32_swap(a0, b0, false, false); auto r1 = __builtin_amdgcn_permlane32_swap(a1, b1, false, false); \
    u32x4 w = {r0[0], r1[0], r0[1], r1[1]}; OUT = *reinterpret_cast<bf16x8*>(&w); } while (0)
    PK4(p0, 0, pa0); PK4(p0, 8, pa1); PK4(p1, 0, pa2); PK4(p1, 8, pa3);
#undef PK4
}
DEVI void qkt(f32x16& p0, f32x16& p1, const char* Ks, const bf16x8* qr, int r32, int hi) {
    p0 = f32x16{}; p1 = f32x16{};
#pragma unroll
    for (int d0 = 0; d0 < 8; ++d0) { const int cb = (d0 * 16 + hi * 8) * 2;
        const bf16x8 b0 = *reinterpret_cast<const bf16x8*>(Ks + KSWZ(r32, cb));
        const bf16x8 b1 = *reinterpret_cast<const bf16x8*>(Ks + KSWZ(32 + r32, cb));
        p0 = __builtin_amdgcn_mfma_f32_32x32x16_bf16(b0, qr[d0], p0, 0, 0, 0);
        p1 = __builtin_amdgcn_mfma_f32_32x32x16_bf16(b1, qr[d0], p1, 0, 0, 0); }
}
DEVI int v_st(int k, int c) { const int kk = (k & ~0xC) | ((k & 4) << 1) | ((k & 8) >> 1); return ((kk >> 3) * 4 + (c >> 5)) * 512 + ((kk & 7) * 32 + (c & 31)) * 2; }
DEVI int v_rd_base(int lane) { return ((lane & 3) << 3) | (((lane >> 2) & 3) << 6) | (((lane >> 4) & 1) << 5) | (((lane >> 5) & 1) << 8); }
constexpr int v_rd_off(int d0, int ks, int half) { return d0 * 512 + ks * 4096 + half * 2048; }
template <int OFF> DEVI s16x4 tr_read(int vb) { s16x4 r; asm volatile("ds_read_b64_tr_b16 %0, %1 offset:%2" : "=&v"(r) : "v"(vb), "i"(OFF) : "memory"); return r; }
template <int D0> DEVI void pv_one(f32x16& od, int vb, bf16x8 pa0, bf16x8 pa1, bf16x8 pa2, bf16x8 pa3) {
    const s16x4 l0 = tr_read<v_rd_off(D0, 0, 0)>(vb), h0 = tr_read<v_rd_off(D0, 0, 1)>(vb), l1 = tr_read<v_rd_off(D0, 1, 0)>(vb), h1 = tr_read<v_rd_off(D0, 1, 1)>(vb);
    const s16x4 l2 = tr_read<v_rd_off(D0, 2, 0)>(vb), h2 = tr_read<v_rd_off(D0, 2, 1)>(vb), l3 = tr_read<v_rd_off(D0, 3, 0)>(vb), h3 = tr_read<v_rd_off(D0, 3, 1)>(vb);
    asm volatile("s_waitcnt lgkmcnt(0)" ::: "memory"); SBAR();
#define PK(L, H) (bf16x8){L[0], L[1], L[2], L[3], H[0], H[1], H[2], H[3]}
    od = __builtin_amdgcn_mfma_f32_32x32x16_bf16(pa0, PK(l0, h0), od, 0, 0, 0);
    od = __builtin_amdgcn_mfma_f32_32x32x16_bf16(pa1, PK(l1, h1), od, 0, 0, 0);
    od = __builtin_amdgcn_mfma_f32_32x32x16_bf16(pa2, PK(l2, h2), od, 0, 0, 0);
    od = __builtin_amdgcn_mfma_f32_32x32x16_bf16(pa3, PK(l3, h3), od, 0, 0, 0);
#undef PK
}
DEVI void pv_d0(f32x16* o, int vb, bf16x8 pa0, bf16x8 pa1, bf16x8 pa2, bf16x8 pa3) {
    pv_one<0>(o[0], vb, pa0, pa1, pa2, pa3); pv_one<1>(o[1], vb, pa0, pa1, pa2, pa3); pv_one<2>(o[2], vb, pa0, pa1, pa2, pa3); pv_one<3>(o[3], vb, pa0, pa1, pa2, pa3);
}
DEVI void wmask(f32x16& p0, f32x16& p1, int qp, int kt0, int hi) {
#pragma unroll
    for (int r = 0; r < 16; ++r) { const int kp = kt0 + crow(r, hi); const int d0 = qp - kp, d1 = d0 - 32;
        if (d0 > 128 || d0 < -128) p0[r] = -1e30f; if (d1 > 128 || d1 < -128) p1[r] = -1e30f; }
}
DEVI void attn_unit(const KA& a, int b, int kvh, int tb, char* lds) {
    unsigned char* ws = a.ws();
    const bf16_t* QAT = (const bf16_t*)(ws + WS_QAT); const bf16_t* KAT = (const bf16_t*)(ws + WS_KAT); const bf16_t* VAT = (const bf16_t*)(ws + WS_VAT);
    bf16_t* Y = (bf16_t*)(ws + WS_Y); const float* rope = (const float*)(ws + SM_ROPE);
    const int tid = threadIdx.x, wid = __builtin_amdgcn_readfirstlane(tid >> 6), lane = tid & 63, r32 = lane & 31, hi = lane >> 5;
    const int h = kvh * 4 + (wid >> 1), t0 = tb * 64;
    char* V_lds = lds; char* K_lds = lds + 2 * SHM_V;
    float* wsf = (float*)(lds + OFF_WS) + wid * 64; float* li_l = wsf; float* al_l = wsf + 32;
    float m_reg = -1e30f, l_reg = 0; f32x16 o[4] = {}; bf16x8 qr[8];
    const int qp = t0 + (wid & 1) * QBLK + r32;
    {
        const bf16_t* Qw = QAT + (size_t)(b * SEQ + qp) * 1024 + h * 128 + hi * 8;
        u32x4 raw[8]; float ss = 0.f;
#pragma unroll
        for (int d0 = 0; d0 < 8; ++d0) { raw[d0] = *(const u32x4*)(Qw + d0 * 16);
#pragma unroll
            for (int i = 0; i < 4; ++i) { const float lo_ = bflo(raw[d0][i]), hi_ = bfhi(raw[d0][i]); ss += lo_ * lo_ + hi_ * hi_; } }
        { auto rr = __builtin_amdgcn_permlane32_swap(__float_as_uint(ss), __float_as_uint(ss), false, false); ss = __uint_as_float(rr[0]) + __uint_as_float(rr[1]); }
        const float rs = rsqrtf(ss * (1.f / 128.f) + EPS);
        const float* qnw = a.in(13);
#pragma unroll
        for (int half = 0; half < 2; ++half) {
            const float* ct = half == 0 ? rope + (qp >> 6) * 32 : rope + 16384 + (qp & 63) * 32;
            const float* st = half == 0 ? ct + 8192 : ct + 2048;
#pragma unroll
            for (int dd = 0; dd < 2; ++dd) {
                const int fi = dd * 16 + hi * 8, da = half * 4 + dd, db = da + 2;
                u32x4 oa, ob;
#pragma unroll
                for (int q4 = 0; q4 < 2; ++q4) {
                    const f32x4 c = *(const f32x4*)(ct + fi + 4 * q4), s = *(const f32x4*)(st + fi + 4 * q4);
                    const f32x4 wa = *(const f32x4*)(qnw + da * 16 + hi * 8 + 4 * q4), wb = *(const f32x4*)(qnw + db * 16 + hi * 8 + 4 * q4);
                    float ya[4], yb[4];
#pragma unroll
                    for (int j = 0; j < 4; ++j) {
                        const unsigned ra = raw[da][2 * q4 + (j >> 1)], rb = raw[db][2 * q4 + (j >> 1)];
                        const float x1 = ((j & 1) ? bfhi(ra) : bflo(ra)) * rs * wa[j], x2 = ((j & 1) ? bfhi(rb) : bflo(rb)) * rs * wb[j];
                        ya[j] = x1 * c[j] - x2 * s[j]; yb[j] = x2 * c[j] + x1 * s[j];
                    }
                    oa[2 * q4] = cvtpk(ya[0], ya[1]); oa[2 * q4 + 1] = cvtpk(ya[2], ya[3]); ob[2 * q4] = cvtpk(yb[0], yb[1]); ob[2 * q4 + 1] = cvtpk(yb[2], yb[3]);
                }
                qr[da] = *reinterpret_cast<bf16x8*>(&oa); qr[db] = *reinterpret_cast<bf16x8*>(&ob);
            }
        }
    }
    const int tk0 = t0 - 128 < 0 ? 0 : t0 - 128, tk1 = t0 + 192 > SEQ ? SEQ : t0 + 192;
    const int NTR = 4 + (tk1 - tk0) / 64, NT = (NTR + 1) & ~1;
    const int ctxrow = ML + b * CTX, latrow = b * SEQ + tk0 - 256;
#define TCTX(j) ((j) < 4 || (j) >= NTR)
#define TROW(j) (TCTX(j) ? b * CTX + 64 * ((j) & 3) : latrow + 64 * (j))
    const bf16_t* Kh = KAT + kvh * 128; const bf16_t* Vh = VAT + kvh * 128;
    const bf16_t* Kc = (const bf16_t*)(ws + WS_CTXK) + kvh * 128; const bf16_t* Vc = (const bf16_t*)(ws + WS_CTXV) + kvh * 128;
    const int sr = tid >> 4, sc = (tid & 15) * 8, vst0 = v_st(sr, sc), vst1 = v_st(32 + sr, sc);
    const int vb0 = (int)(uintptr_t)V_lds + v_rd_base(lane);
    struct { bf16x8 vs0, vs1, ks0, ks1; } sr_[1];
#define SLOAD(i, j) do { const int k0_ = TROW(j); const bf16_t* kb_ = TCTX(j) ? Kc : Kh; const bf16_t* vb_ = TCTX(j) ? Vc : Vh; \
    sr_[i].vs0 = *(const bf16x8*)(vb_ + (size_t)(k0_ + sr) * LDK + sc); sr_[i].vs1 = *(const bf16x8*)(vb_ + (size_t)(k0_ + 32 + sr) * LDK + sc); \
    sr_[i].ks0 = *(const bf16x8*)(kb_ + (size_t)(k0_ + sr) * LDK + sc); sr_[i].ks1 = *(const bf16x8*)(kb_ + (size_t)(k0_ + 32 + sr) * LDK + sc); } while (0)
#define SWRITE(bf, i) do { *(bf16x8*)(V_lds + (bf) * SHM_V + vst0) = sr_[i].vs0; *(bf16x8*)(V_lds + (bf) * SHM_V + vst1) = sr_[i].vs1; const int kc = sc * 2; \
    *(bf16x8*)(K_lds + (bf) * SHM_K + KSWZ(sr, kc)) = sr_[i].ks0; *(bf16x8*)(K_lds + (bf) * SHM_K + KSWZ(32 + sr, kc)) = sr_[i].ks1; } while (0)
#define SWAIT() asm volatile("s_waitcnt vmcnt(0)" ::: "memory")
#define RESC(al) do { if (__any((al) < 1.f)) { if (hi == 0) al_l[r32] = (al); asm volatile("s_waitcnt lgkmcnt(0)" ::: "memory"); \
    _Pragma("unroll") for (int d = 0; d < 4; ++d) _Pragma("unroll") for (int r = 0; r < 16; ++r) o[d][r] *= al_l[crow(r, hi)]; } } while (0)
#define WMASK(P0, P1, j) do { if ((j) >= 4) wmask(P0, P1, qp, (j) >= NTR ? 1000000 : tk0 + 64 * ((j) - 4), hi); } while (0)
    f32x16 pA0, pA1, pB0, pB1; float mnA, mnB, alA, alB; bf16x8 pa0, pa1, pa2, pa3;
    constexpr int SE = 0, SO = 0;
    SLOAD(SE, 0); asm volatile("s_waitcnt vmcnt(0)" ::: "memory"); SWRITE(0, SE); __syncthreads();
    qkt(pA0, pA1, K_lds, qr, r32, hi); partialSM(pA0, pA1, m_reg, mnA, alA);
    SLOAD(SO, 1);
    SWAIT(); SWRITE(1, SO); __syncthreads();
    for (int j = 1; j + 1 < NT; j += 2) {
        SBAR(); qkt(pB0, pB1, K_lds + SHM_K, qr, r32, hi); WMASK(pB0, pB1, j);
        finishSM(pA0, pA1, alA, l_reg, pa0, pa1, pa2, pa3); SBAR();
        SLOAD(SO, j + 1); SBAR();
        pv_d0(o, vb0, pa0, pa1, pa2, pa3); partialSM(pB0, pB1, m_reg, mnB, alB);
        __syncthreads(); SWAIT(); SWRITE(0, SE);
        RESC(alB); __syncthreads();
        SBAR(); qkt(pA0, pA1, K_lds, qr, r32, hi); WMASK(pA0, pA1, j + 1);
        finishSM(pB0, pB1, alB, l_reg, pa0, pa1, pa2, pa3); SBAR();
        SLOAD(SE, j + 2); SBAR();
        pv_d0(o, vb0 + (int)SHM_V, pa0, pa1, pa2, pa3); partialSM(pA0, pA1, m_reg, mnA, alA);
        __syncthreads(); SWAIT(); SWRITE(1, SO);
        RESC(alA); __syncthreads();
    }
    SBAR(); qkt(pB0, pB1, K_lds + SHM_K, qr, r32, hi); WMASK(pB0, pB1, NT - 1);
    finishSM(pA0, pA1, alA, l_reg, pa0, pa1, pa2, pa3); SBAR();
    pv_d0(o, vb0, pa0, pa1, pa2, pa3); partialSM(pB0, pB1, m_reg, mnB, alB);
    __syncthreads(); RESC(alB);
    finishSM(pB0, pB1, alB, l_reg, pa0, pa1, pa2, pa3); SBAR();
    pv_d0(o, vb0 + (int)SHM_V, pa0, pa1, pa2, pa3);
    l_reg += __builtin_amdgcn_exp2f(a.in(15)[h] * 1.4426950408889634f - m_reg * (SCALE * 1.4426950408889634f));
    if (hi == 0) li_l[r32] = l_reg; asm volatile("s_waitcnt lgkmcnt(0)" ::: "memory");
    float rli[16];
#pragma unroll
    for (int r = 0; r < 16; ++r) rli[r] = __builtin_amdgcn_rcpf(li_l[crow(r, hi)]);
    {
        bf16_t* stg = (bf16_t*)(lds + OFF_OST) + wid * 4096;
#pragma unroll
        for (int r = 0; r < 16; ++r) { const int orow = crow(r, hi);
#pragma unroll
            for (int d0 = 0; d0 < 4; ++d0) stg[orow * 128 + d0 * 32 + r32] = (bf16_t)f2bf(o[d0][r] * rli[r]); }
        asm volatile("s_waitcnt lgkmcnt(0)" ::: "memory");
        bf16_t* Ow = Y + (size_t)(b * SEQ + t0 + (wid & 1) * QBLK) * 2048 + 1024 + h * 128;
#pragma unroll
        for (int i = 0; i < 8; ++i) { const int row = i * 4 + (lane >> 4), ch = lane & 15; const u32x4 v = *(const u32x4*)(stg + row * 128 + ch * 8); *(u32x4*)(Ow + (size_t)row * 2048 + ch * 8) = v; }
    }
    __syncthreads();
#undef TROW
#undef TCTX
#undef SLOAD
#undef SWRITE
#undef SWAIT
#undef RESC
#undef WMASK
}
#undef KSWZ
#undef SBAR
}

DEVI u32x4 ldu_(const bf16_t* base, int rr) {
    const int rc = rr < 0 ? 0 : (rr >= SEQ ? SEQ - 1 : rr);
    const u32x4 v = *(const u32x4*)(base + (size_t)rc * NUP);
    const unsigned m = (rr == rc) ? 0xffffffffu : 0u;
    return (u32x4){v[0] & m, v[1] & m, v[2] & m, v[3] & m};
}
DEVI void phase_ffnconv(const KA& a, int b, int tid) {
    unsigned char* ws = a.ws();
    const bf16_t* U = (const bf16_t*)(ws + WS_U); bf16_t* ACT = (bf16_t*)(ws + WS_ACT) + (size_t)b * SEQ * DFF;
    const float* cw = a.in(20); const float* cb = a.in(21);
    if (tid < DFF / 8) {
        const int f0 = tid * 8, pn = f0 >> 7, j = f0 & 127, gc = 256 * pn + j, vc = gc + 128;
        float wg[3][8], wv[3][8], bg[8], bvv[8];
#pragma unroll
        for (int jt = 0; jt < 3; ++jt)
#pragma unroll
            for (int q = 0; q < 8; ++q) { wg[jt][q] = cw[jt * NUP + f0 + q]; wv[jt][q] = cw[jt * NUP + DFF + f0 + q]; }
#pragma unroll
        for (int q = 0; q < 8; ++q) { bg[q] = cb[f0 + q]; bvv[q] = cb[DFF + f0 + q]; }
        for (int it = blockIdx.x; it < SEQ / 32; it += gridDim.x) {
            const int r0 = it * 32;
            u32x4 gw_[3], vw_[3];
#define LDU(rr, c) ldu_(U + (c), (rr))
            gw_[0] = LDU(r0 - 1, gc); vw_[0] = LDU(r0 - 1, vc); gw_[1] = LDU(r0, gc); vw_[1] = LDU(r0, vc);
#pragma unroll 8
            for (int r = 0; r < 32; ++r) {
                gw_[2] = LDU(r0 + r + 1, gc); vw_[2] = LDU(r0 + r + 1, vc);
                float ug[8], uv[8];
#pragma unroll
                for (int q = 0; q < 8; ++q) { ug[q] = bg[q]; uv[q] = bvv[q]; }
#pragma unroll
                for (int jt = 0; jt < 3; ++jt)
#pragma unroll
                    for (int q = 0; q < 4; ++q) {
                        ug[2 * q] += bflo(gw_[jt][q]) * wg[jt][2 * q]; ug[2 * q + 1] += bfhi(gw_[jt][q]) * wg[jt][2 * q + 1];
                        uv[2 * q] += bflo(vw_[jt][q]) * wv[jt][2 * q]; uv[2 * q + 1] += bfhi(vw_[jt][q]) * wv[jt][2 * q + 1]; }
                u32x4 o;
                o.x = pk2(siluf(ug[0]) * uv[0], siluf(ug[1]) * uv[1]); o.y = pk2(siluf(ug[2]) * uv[2], siluf(ug[3]) * uv[3]);
                o.z = pk2(siluf(ug[4]) * uv[4], siluf(ug[5]) * uv[5]); o.w = pk2(siluf(ug[6]) * uv[6], siluf(ug[7]) * uv[7]);
                *(u32x4*)(ACT + (size_t)(r0 + r) * DFF + f0) = o;
                gw_[0] = gw_[1]; gw_[1] = gw_[2]; vw_[0] = vw_[1]; vw_[1] = vw_[2];
            }
#undef LDU
        }
    }
}

#define XB_TMO      128
#define XB_XCNT(j)  (256  + 64 * (j))
#define XB_XSUB(j)  (1280 + 64 * (j))
#define XB_XGEN(j)  (2304 + 64 * (j))
#define XB_TOP      3328
#define XB_TOPGEN   3392
#define XCD_BAR_WORDS 3456
#define XB_SPIN_CAP (1u << 18)
__device__ __forceinline__ unsigned xb_ld(unsigned* p)              { return __hip_atomic_load(p, __ATOMIC_RELAXED, __HIP_MEMORY_SCOPE_AGENT); }
__device__ __forceinline__ unsigned xb_add(unsigned* p, unsigned v) { return __hip_atomic_fetch_add(p, v, __ATOMIC_RELAXED, __HIP_MEMORY_SCOPE_AGENT); }
__device__ __forceinline__ unsigned xb_xcc_id() { return (unsigned)__builtin_amdgcn_s_getreg((3 << 11) | 20) & 0xFu; }
#define XB_SPIN(cond, bar) do { unsigned _sp = 0; while (cond) { __builtin_amdgcn_s_sleep(1); \
    if ((++_sp & 255u) == 0u) { if (xb_ld(&(bar)[XB_TMO])) break; if (_sp > XB_SPIN_CAP) { atomicAdd(&(bar)[XB_TMO], 1u); break; } } } } while (0)
struct XcdBarrier { unsigned* bar; unsigned x; volatile LAS unsigned* st; };
__device__ __forceinline__ XcdBarrier xcd_barrier_post(unsigned* bar, volatile LAS unsigned* st) {
    XcdBarrier b; b.bar = bar; b.x = xb_xcc_id(); b.st = st;
    if (threadIdx.x == 0) (void)xb_add(&bar[XB_XCNT(b.x)], 1u);
    return b;
}
__device__ __forceinline__ void xcd_barrier_complete(unsigned* bar, unsigned x, unsigned& nloc, unsigned& nx) {
    const unsigned G = gridDim.x * gridDim.y * gridDim.z;
    unsigned sum, cnt, mine, sp = 0u;
    for (;;) {
        sum = 0u; cnt = 0u; mine = 0u;
#pragma unroll
        for (unsigned j = 0; j < 16; ++j) { const unsigned c = xb_ld(&bar[XB_XCNT(j)]); sum += c; cnt += (c > 0u) ? 1u : 0u; mine = (j == x) ? c : mine; }
        if (sum == G) break;
        __builtin_amdgcn_s_sleep(1);
        if ((++sp & 255u) == 0u) { if (xb_ld(&bar[XB_TMO])) break; if (sp > XB_SPIN_CAP) { atomicAdd(&bar[XB_TMO], 1u); break; } }
    }
    nloc = mine > 0u ? mine : 1u; nx = cnt > 0u ? cnt : 1u;
}
__device__ __forceinline__ void xcd_barrier(const XcdBarrier& b) {
    asm volatile("s_waitcnt vmcnt(0)" ::: "memory");
    __syncthreads();
    if (threadIdx.x == 0) {
        unsigned* bar = b.bar;
        __builtin_amdgcn_s_waitcnt(0);
        unsigned nloc = b.st[0], nx = b.st[1];
        if (nloc == 0u) { xcd_barrier_complete(bar, b.x, nloc, nx); b.st[0] = nloc; b.st[1] = nx; }
        const unsigned old = xb_add(&bar[XB_XSUB(b.x)], 1u);
        const unsigned gen = old / nloc;
        if (old + 1u == (gen + 1u) * nloc) {
            __builtin_amdgcn_fence(__ATOMIC_RELEASE, "agent");
            asm volatile("s_waitcnt vmcnt(0)" ::: "memory");
            const unsigned og = xb_add(&bar[XB_TOP], 1u);
            const unsigned tg = og / nx;
            if (og + 1u == (tg + 1u) * nx) xb_add(&bar[XB_TOPGEN], 1u);
            else XB_SPIN(xb_ld(&bar[XB_TOPGEN]) == tg, bar);
            __builtin_amdgcn_fence(__ATOMIC_ACQUIRE, "agent");
            xb_add(&bar[XB_XGEN(b.x)], 1u);
            asm volatile("s_waitcnt vmcnt(0)" ::: "memory");
        } else {
            XB_SPIN(xb_ld(&bar[XB_XGEN(b.x)]) == gen, bar);
            __builtin_amdgcn_fence(__ATOMIC_ACQUIRE, "agent");
            asm volatile("s_waitcnt vmcnt(0)" ::: "memory");
        }
    }
    __syncthreads();
}

constexpr int NPHASE = 13;
__global__ void __launch_bounds__(512, 2) mega(Args a_) {
    const KA a;
    extern __shared__ __attribute__((aligned(16))) unsigned char lds_raw[];
    LAS unsigned char* lds = (LAS unsigned char*)lds_raw;
    const int tid = threadIdx.x, lane = tid & 63, wave = __builtin_amdgcn_readfirstlane(tid >> 6);
    unsigned char* ws = a.ws();
    const int lo = a_.ph_lo, hi = a_.ph_hi;
#define IN(k) (lo <= (k) && (k) < hi)
#if MK_ONE_LAUNCH
    volatile LAS unsigned* bst = (volatile LAS unsigned*)(lds + 147440);
    if (tid < 4) bst[tid] = 0u;
    __syncthreads();
    const XcdBarrier gbar = xcd_barrier_post((unsigned*)(ws + WS_CTL), bst);
#define SEAM(k) do { if (IN(k) && IN((k) + 1)) xcd_barrier(gbar); } while (0)
#else
#define SEAM(k) do { } while (0)
#endif
    const float* modacc = (const float*)(ws + CTL_MODACC);
    unsigned long long pr_prev = PROBE_MASK ? __builtin_amdgcn_s_memrealtime() : 0ull, pr_acc = 0ull;
#define STAMP(k) do { if (PROBE_MASK) { const unsigned long long now_ = __builtin_amdgcn_s_memrealtime(); if ((PROBE_MASK >> (k)) & 1u) pr_acc += now_ - pr_prev; pr_prev = now_; } } while (0)
    if (IN(0)) { phase0(a, lds, tid, lane, wave); } SEAM(0); STAMP(0);
    if (IN(1)) { phase1(a, tid, lane, wave); } SEAM(1); STAMP(1);
    if (IN(2)) {
        pg8::Gemm g{(const bf16_t*)(ws + WS_XN), (const bf16_t*)(ws + WS_WINA), MT, NA, 1024}; pg8::StaticOrder S; S.init(MT, NA, gridDim.x, blockIdx.x);
        EpiIn E{(const float*)(ws + SM_ROWSS1), (const float*)(ws + SM_SHWA), 0, (bf16_t*)(ws + WS_QKVR), nullptr, nullptr, nullptr, nullptr, (float*)(ws + WS_BA)};
        pg8::gemm_phase<EpiIn, pg8::StaticOrder, true, true>(lds, g, S, E);
        {
            pg8::Gemm g2{(const bf16_t*)(ws + WS_XN) + (size_t)ML * 1024, (const bf16_t*)(ws + WS_WINC) + (size_t)2048 * 1024, MC, 512, 1024};
            TailOrder T{(int)blockIdx.x - ((int)gridDim.x - 4)};
            EpiCtxKV E2{(const float*)(ws + SM_ROWSS1) + ML, (const float*)(ws + SM_SHWA) + 2 * NSH + NA + 2048, (bf16_t*)(ws + WS_CTXK), (bf16_t*)(ws + WS_CTXV)};
            pg8::gemm_phase<EpiCtxKV, TailOrder, true, true>(lds, g2, T, E2);
        }
    } SEAM(2); STAMP(2);
    if (IN(3)) { phase_dnprep(a, tid); } SEAM(3); STAMP(3);
    STAMP(4);
    if (IN(5)) { const unsigned long long t5_ = (PROBE_SUB == 4) ? __builtin_amdgcn_s_memrealtime() : 0ull; phase_dnscan2(a, lds, tid, lane, wave, pr_acc); if (PROBE_SUB == 4) pr_acc += __builtin_amdgcn_s_memrealtime() - t5_; } SEAM(5); STAMP(5);
    if (IN(6)) {
        pg8::Gemm g{(const bf16_t*)(ws + WS_XN), (const bf16_t*)(ws + WS_WINC), ML, NC, 1024}; pg8::StaticOrder S; S.init(ML, NC, gridDim.x, blockIdx.x);
        EpiIn E{(const float*)(ws + SM_ROWSS1), (const float*)(ws + SM_SHWA) + NA, 1, (bf16_t*)(ws + WS_GT), (bf16_t*)(ws + WS_QAT), (bf16_t*)(ws + WS_KAT), (bf16_t*)(ws + WS_VAT), (bf16_t*)(ws + WS_MG), nullptr};
        pg8::gemm_phase<EpiIn, pg8::StaticOrder, true, true>(lds, g, S, E);
    } SEAM(6); STAMP(6);
    if (IN(7)) { phase_prep2(a, lane, wave); } SEAM(7); STAMP(7);
    if (IN(8)) {
        const int G_ = (int)gridDim.x, vcu_ = (G_ % 8 == 0) ? ((int)blockIdx.x % 8) * (G_ / 8) + (int)blockIdx.x / 8 : (int)blockIdx.x;
#pragma unroll 1
        for (int idx = vcu_; idx < 1024; idx += G_) {
            const int tb = idx & 255, kvh = (idx >> 8) & 1, b = idx >> 9;
            att::attn_unit(a, b, kvh, tb, (char*)lds_raw); }
    } SEAM(8); STAMP(8);
    if (IN(9)) {
        pg8::Gemm g{(const bf16_t*)(ws + WS_Y), (const bf16_t*)(ws + WS_WBR), ML, 1024, 2048}; pg8::StaticOrder S; S.init(ML, 1024, gridDim.x, blockIdx.x);
        EpiBr E{(const bf16_t*)(ws + WS_MG), (bf16_t*)(ws + WS_MERGED)};
        pg8::gemm_phase<EpiBr, pg8::StaticOrder, true, true>(lds, g, S, E);
    } SEAM(9); STAMP(9);
    if (IN(10)) {
        pg8::Gemm g{(const bf16_t*)(ws + WS_MERGED), (const bf16_t*)(ws + WS_WOUT), ML, 1024, 1024}; pg8::StaticOrder S; S.init(ML, 1024, gridDim.x, blockIdx.x);
        EpiOut E{a.in(0), modacc, a.in(5), a.in(7), a.out(), (bf16_t*)(ws + WS_X1S), (float*)(ws + CTL_ROWSS2)};
        pg8::gemm_phase<EpiOut, pg8::StaticOrder, true, true>(lds, g, S, E);
    } SEAM(10); STAMP(10);
    if (IN(11)) {
        pg8::Gemm g{(const bf16_t*)(ws + WS_X1S), (const bf16_t*)(ws + WS_WUP), 2 * TPB * 256, NUP, 1024}; pg8::StaticOrder S; S.init(2 * TPB * 256, NUP, gridDim.x, blockIdx.x);
        EpiUpConv E{(const float*)(ws + CTL_ROWSS2), (const float*)(ws + SM_SHWF), a.in(20), a.in(21), (bf16_t*)(ws + WS_ACT), (LAS float*)(lds + 131072)};
        pg8::gemm_phase<EpiUpConv, pg8::StaticOrder, true, true>(lds, g, S, E);
    } SEAM(11); STAMP(11);
    if (IN(12)) {
        pg8::Gemm g{(const bf16_t*)(ws + WS_ACT), (const bf16_t*)(ws + WS_WDN), ML, 1024, DFF}; pg8::StaticOrder S; S.init(ML, 1024, gridDim.x, blockIdx.x);
        EpiDown E{modacc, a.in(5), a.out()};
        pg8::gemm_phase<EpiDown, pg8::StaticOrder, true, true>(lds, g, S, E);
    }
    STAMP(12);
    if (PROBE_SUB >= 8 && blockIdx.x == 0) pr_acc += __hip_atomic_load((unsigned*)(ws + CTL_DBG) + (PROBE_SUB - 8), __ATOMIC_RELAXED, __HIP_MEMORY_SCOPE_AGENT);
    if ((PROBE_MASK || PROBE_SUB) && blockIdx.x == 0) { const unsigned long long t0_ = __builtin_amdgcn_s_memrealtime(); while (__builtin_amdgcn_s_memrealtime() - t0_ < pr_acc) __builtin_amdgcn_s_sleep(8); }
#undef STAMP
#undef IN
#undef SEAM
}

extern "C" void kernel_launch(void* const* d_in, const int* in_sizes, int n_in, void* d_out, int out_size, void* d_ws, size_t ws_size, hipStream_t stream) {
    static int grid = 0;
    if (grid == 0) {
        if (n_in != 23 || in_sizes[0] != ML * DM || out_size != ML * DM || ws_size < WS_END) {
            fprintf(stderr, "kernel_launch: unexpected shapes n_in %d in0 %d out %d ws %zu (need %zu)\n", n_in, n_in > 0 ? in_sizes[0] : -1, out_size, ws_size, (size_t)WS_END); grid = -1; return; }
        int dev = 0, cus = 0, per_cu = 0;
        hipGetDevice(&dev); hipDeviceGetAttribute(&cus, hipDeviceAttributeMultiprocessorCount, dev);
        if (hipFuncSetAttribute((const void*)mega, hipFuncAttributeMaxDynamicSharedMemorySize, LDS_BYTES) != hipSuccess) { fprintf(stderr, "kernel_launch: hipFuncSetAttribute failed\n"); grid = -1; return; }
        hipOccupancyMaxActiveBlocksPerMultiprocessor(&per_cu, (const void*)mega, 512, LDS_BYTES);
        (void)hipGetLastError();
        if (per_cu < 1) { fprintf(stderr, "kernel_launch: occupancy query says %d blocks per CU\n", per_cu); per_cu = 1; }
        if (cus < 160) { fprintf(stderr, "kernel_launch: %d CUs: the scan phase needs 128 scan workgroups plus chunk producers\n", cus); grid = -1; return; }
        grid = cus;
    }
    if (grid < 0) return;
    hipMemsetAsync((char*)d_ws + WS_CTL, 0, CTL_ZERO_BYTES, stream);
    Args a{};
    for (int i = 0; i < 23; ++i) a.in[i] = (const float*)d_in[i];
    a.out = (float*)d_out; a.ws = (unsigned char*)d_ws;
#if MK_ONE_LAUNCH
    a.ph_lo = 0; a.ph_hi = NPHASE;
    void* args[] = {&a};
    hipError_t e = hipLaunchCooperativeKernel((const void*)mega, dim3(grid), dim3(512), args, LDS_BYTES, stream);
    if (e != hipSuccess) fprintf(stderr, "cooperative launch failed: %s (grid %d)\n", hipGetErrorString(e), grid);
#else
    for (int p = 0; p < NPHASE; ++p) {
        a.ph_lo = p; a.ph_hi = p + 1;
        hipLaunchKernelGGL(mega, dim3(grid), dim3(512), LDS_BYTES, stream, a);
    }
    hipError_t e = hipPeekAtLastError();
    if (e != hipSuccess) fprintf(stderr, "launch failed: %s\n", hipGetErrorString(e));
#endif
}
```
